# Optimizing an MI355X kernel written in HIP

```python
import math
import jax
import jax.numpy as jnp
from jax import lax
import numpy as np

D_MODEL = 1024
BATCH = 16
SEQ = 256
DEPTH = 2
DEC_BATCH = 4
DEC_SEQ = 1024
PAST_LEN = 512

GRID_W = 64
EPS = 1e-6
GLA_HEADS = 4
GLA_DK = 64
GLA_DV = 128
GLA_WIDTH = GLA_HEADS * GLA_DV
GLA_GATE_RANK = 16
GLA_GATE_NORM = 16.0
GLA_CHUNK = 64
MLA_HEADS = 4
MLA_Q_LORA = 384
MLA_KV_LORA = 256
MLA_NOPE = 64
MLA_ROPE = 32
MLA_QK = MLA_NOPE + MLA_ROPE
MLA_DV = 128
MLA_WIDTH = MLA_HEADS * MLA_DV
ROPE_THETA = 10000.0
Q_BLOCK = 128
S5_WIDTH = 512
S5_GROUP = 16
S5_GROUPS = S5_WIDTH // S5_GROUP
S5_STATE = 64
DT_MIN = 1e-3
DT_MAX = 1e-1
N_BRANCH = 3
IN_SPLITS = (GLA_HEADS * GLA_DK, GLA_HEADS * GLA_DK, GLA_WIDTH, GLA_GATE_RANK, GLA_GATE_RANK, GLA_WIDTH,
             MLA_Q_LORA, MLA_KV_LORA, MLA_ROPE, MLA_WIDTH,
             S5_WIDTH, S5_WIDTH,
             N_BRANCH * D_MODEL)
D_IN = sum(IN_SPLITS)

kernel_name = 'hybrid_gla_mla_s5_diffusion_step'


def rms_norm(x, w):
    xf = x.astype(jnp.float32)
    y = xf * lax.rsqrt(jnp.mean(xf * xf, axis=-1, keepdims=True) + EPS)
    return (y * w.astype(jnp.float32)).astype(x.dtype)


def split_cols(z, sizes):
    return jnp.split(z, np.cumsum(np.array(sizes))[:-1].tolist(), axis=-1)


def axial_rope_tables(n_tok):
    rows = n_tok // GRID_W
    r = jnp.repeat(jnp.arange(rows, dtype=jnp.float32), GRID_W)
    col = jnp.tile(jnp.arange(GRID_W, dtype=jnp.float32), rows)
    n_freq = MLA_ROPE // 4
    inv = ROPE_THETA ** (-jnp.arange(n_freq, dtype=jnp.float32) / n_freq)
    ang = jnp.concatenate([r[:, None] * inv, col[:, None] * inv], axis=-1)
    return jnp.cos(ang), jnp.sin(ang)


def apply_rope_tail(x, rope):
    cos, sin = rope
    cos = cos[:, None, :].astype(x.dtype)
    sin = sin[:, None, :].astype(x.dtype)
    x_nope, x1, x2 = jnp.split(x, [MLA_NOPE, MLA_NOPE + MLA_ROPE // 2], axis=-1)
    return jnp.concatenate([x_nope, x1 * cos - x2 * sin, x1 * sin + x2 * cos], axis=-1)


def block_attention(q, k, v):
    bsz, heads, nq, dk = q.shape
    scale = dk ** -0.5
    qb = q.reshape(bsz, heads, nq // Q_BLOCK, Q_BLOCK, dk).transpose(2, 0, 1, 3, 4)

    def one_block(q_blk):
        s = jnp.einsum('bhqd,bhkd->bhqk', q_blk, k).astype(jnp.float32) * scale
        p = jax.nn.softmax(s, axis=-1).astype(v.dtype)
        return jnp.einsum('bhqk,bhkd->bhqd', p, v)

    o = lax.map(one_block, qb)
    return o.transpose(1, 2, 0, 3, 4).reshape(bsz, heads, nq, v.shape[-1])


def gla_chunk_scan(q, k, v, log_a, s0):
    bsz, heads, n, dk = q.shape
    nc = n // GLA_CHUNK

    def chunks(t):
        return t.reshape(bsz, heads, nc, GLA_CHUNK, t.shape[-1]).transpose(2, 0, 1, 3, 4)

    mask = jnp.tril(jnp.ones((GLA_CHUNK, GLA_CHUNK), dtype=bool))

    def step(s, inp):
        qi, ki, vi, ai = inp
        bcum = jnp.cumsum(ai, axis=-2)
        blast = bcum[..., -1:, :]
        qd = qi * jnp.exp(bcum).astype(qi.dtype)
        kd = ki * jnp.exp(-bcum).astype(ki.dtype)
        att = jnp.where(mask, jnp.einsum('bhcd,bhsd->bhcs', qd, kd), 0)
        o = jnp.einsum('bhcd,bhde->bhce', qd, s) + jnp.einsum('bhcs,bhse->bhce', att, vi)
        kr = ki * jnp.exp(blast - bcum).astype(ki.dtype)
        s_new = jnp.exp(blast[..., 0, :])[..., None].astype(s.dtype) * s + jnp.einsum('bhcd,bhce->bhde', kr, vi)
        return s_new, o

    s_fin, o = lax.scan(step, s0, (chunks(q), chunks(k), chunks(v), chunks(log_a)))
    return o.transpose(1, 2, 0, 3, 4).reshape(bsz, heads, n, v.shape[-1]), s_fin


def gla_mixer(q, k, v, a_low_f, a_low_b, w_a2, b_a, o_norm, ctx):
    bsz, n, _ = q.shape

    def heads(t, d):
        return t.reshape(bsz, n, GLA_HEADS, d).transpose(0, 2, 1, 3)

    qh = heads(q, GLA_DK) * (GLA_DK ** -0.5)
    kh = heads(k, GLA_DK)
    vh = heads(v, GLA_DV)
    log_af = heads(jax.nn.log_sigmoid((a_low_f @ w_a2[0] + b_a[0]).astype(jnp.float32)) / GLA_GATE_NORM, GLA_DK)
    log_ab = heads(jax.nn.log_sigmoid((a_low_b @ w_a2[1] + b_a[1]).astype(jnp.float32)) / GLA_GATE_NORM, GLA_DK)
    if ctx is None:
        s_f0 = jnp.zeros((bsz, GLA_HEADS, GLA_DK, GLA_DV), v.dtype)
        s_b0 = s_f0
    else:
        s_f0, s_b0 = ctx
    o_f, s_f = gla_chunk_scan(qh, kh, vh, log_af, s_f0)

    def flip(t):
        return jnp.flip(t, axis=2)

    o_b, s_b = gla_chunk_scan(flip(qh), flip(kh), flip(vh), flip(log_ab), s_b0)
    o = rms_norm((o_f + flip(o_b)).transpose(0, 2, 1, 3), o_norm)
    return o.reshape(bsz, n, GLA_WIDTH), jnp.stack([s_f, s_b], axis=1)


def mla_keys_values(ckv, k_rope, w_uk, w_uv, kh_norm, rope):
    bsz, n, _ = ckv.shape
    k_nope = (ckv @ w_uk).reshape(bsz, n, MLA_HEADS, MLA_NOPE)
    v = (ckv @ w_uv).reshape(bsz, n, MLA_HEADS, MLA_DV)
    k_pe = jnp.broadcast_to(k_rope[:, :, None, :], (bsz, n, MLA_HEADS, MLA_ROPE))
    k = rms_norm(jnp.concatenate([k_nope, k_pe], axis=-1), kh_norm)
    if rope is not None:
        k = apply_rope_tail(k, rope)
    return k.transpose(0, 2, 1, 3), v.transpose(0, 2, 1, 3)


def mla_mixer(cq_raw, ckv_raw, k_rope, q_norm, w_uq, kv_norm, w_uk, w_uv, qh_norm, kh_norm, rope, ctx):
    bsz, n, _ = cq_raw.shape
    q = (rms_norm(cq_raw, q_norm) @ w_uq).reshape(bsz, n, MLA_HEADS, MLA_QK)
    q = rms_norm(q, qh_norm)
    if rope is not None:
        q = apply_rope_tail(q, rope)
    ckv = rms_norm(ckv_raw, kv_norm)
    k, v = mla_keys_values(ckv, k_rope, w_uk, w_uv, kh_norm, rope)
    if ctx is not None:
        kc, vc = mla_keys_values(ctx[0], ctx[1], w_uk, w_uv, kh_norm, None)
        k = jnp.concatenate([kc, k], axis=2)
        v = jnp.concatenate([vc, v], axis=2)
    o = block_attention(q.transpose(0, 2, 1, 3), k, v)
    return o.transpose(0, 2, 1, 3).reshape(bsz, n, MLA_WIDTH), (ckv, k_rope)


def s5_discretise(a_re, a_im, log_dt):
    dt = jnp.exp(log_dt)[:, None]
    mag = jnp.exp(a_re * dt)
    ab_re = mag * jnp.cos(a_im * dt)
    ab_im = mag * jnp.sin(a_im * dt)
    den = a_re * a_re + a_im * a_im
    n_re = ab_re - 1.0
    coef_re = (n_re * a_re + ab_im * a_im) / den
    coef_im = (ab_im * a_re - n_re * a_im) / den
    return ab_re, ab_im, coef_re, coef_im


def complex_linear_scan(ab_re, ab_im, u_re, u_im, x0_re, x0_im):
    u_re = u_re.at[:, 0].add(ab_re * x0_re - ab_im * x0_im)
    u_im = u_im.at[:, 0].add(ab_re * x0_im + ab_im * x0_re)
    a_re = jnp.broadcast_to(ab_re, u_re.shape)
    a_im = jnp.broadcast_to(ab_im, u_im.shape)

    def combine(e1, e2):
        a1r, a1i, b1r, b1i = e1
        a2r, a2i, b2r, b2i = e2
        return (a1r * a2r - a1i * a2i, a1r * a2i + a1i * a2r,
                a2r * b1r - a2i * b1i + b2r, a2r * b1i + a2i * b1r + b2i)

    _, _, x_re, x_im = lax.associative_scan(combine, (a_re, a_im, u_re, u_im), axis=1)
    return x_re, x_im


def s5_mixer(u, a_re, a_im, log_dt, b_re, b_im, c_re, c_im, d_skip, w_glu, b_glu, ctx):
    bsz, n, _ = u.shape
    ug = u.reshape(bsz, n, S5_GROUPS, S5_GROUP)
    bu_re = jnp.einsum('blgp,gnp->blgn', ug, b_re)
    bu_im = jnp.einsum('blgp,gnp->blgn', ug, b_im)
    y = d_skip * u
    finals = []
    for d in range(2):
        ab_re, ab_im, cf_re, cf_im = s5_discretise(a_re[d], a_im[d], log_dt[d])
        ub_re = cf_re * bu_re - cf_im * bu_im
        ub_im = cf_re * bu_im + cf_im * bu_re
        if d == 1:
            ub_re = jnp.flip(ub_re, axis=1)
            ub_im = jnp.flip(ub_im, axis=1)
        if ctx is None:
            x0_re = jnp.zeros((bsz, S5_GROUPS, S5_STATE), u.dtype)
            x0_im = x0_re
        else:
            x0_re, x0_im = ctx[:, d, 0], ctx[:, d, 1]
        x_re, x_im = complex_linear_scan(ab_re, ab_im, ub_re, ub_im, x0_re, x0_im)
        finals.append(jnp.stack([x_re[:, -1], x_im[:, -1]], axis=1))
        if d == 1:
            x_re = jnp.flip(x_re, axis=1)
            x_im = jnp.flip(x_im, axis=1)
        y_ssm = jnp.einsum('blgn,gpn->blgp', x_re, c_re) - jnp.einsum('blgn,gpn->blgp', x_im, c_im)
        y = y + y_ssm.reshape(bsz, n, S5_WIDTH)
    z = jax.nn.gelu(y) @ w_glu + b_glu
    out = z[..., :S5_WIDTH] * jax.nn.sigmoid(z[..., S5_WIDTH:])
    return out, jnp.stack(finals, axis=1)


def trunk_layer(x, cond, rope, ctx, p):
    ada = jax.nn.silu(cond) @ p['w_ada'] + p['b_ada']
    shift, scale, gate = jnp.split(ada[:, None, :], 3, axis=-1)
    h = rms_norm(x, p['norm_w']) * (1.0 + scale) + shift
    (gq, gk, gv, gaf, gab, g_gate, mq, mkv, mkr, m_gate, su, s_gate, merge) = split_cols(h @ p['w_in'], IN_SPLITS)
    if ctx is None:
        ctx_mla, ctx_gla, ctx_s5 = None, None, None
    else:
        ctx_mla, ctx_gla, ctx_s5 = ctx
    o_a, st_gla = gla_mixer(gq, gk, gv, gaf, gab, p['gla_w_a2'], p['gla_b_a'], p['gla_o_norm'], ctx_gla)
    o_b, st_mla = mla_mixer(mq, mkv, mkr, p['mla_q_norm'], p['mla_w_uq'], p['mla_kv_norm'], p['mla_w_uk'],
                            p['mla_w_uv'], p['mla_qh_norm'], p['mla_kh_norm'], rope, ctx_mla)
    o_c, st_s5 = s5_mixer(su, p['s5_a_re'], p['s5_a_im'], p['s5_log_dt'], p['s5_b_re'], p['s5_b_im'],
                          p['s5_c_re'], p['s5_c_im'], p['s5_d'], p['s5_w_glu'], p['s5_b_glu'], ctx_s5)
    g_a, g_b, g_c = jnp.split(jax.nn.sigmoid(merge), 3, axis=-1)
    mixed = (g_a * ((o_a * jax.nn.silu(g_gate)) @ p['w_bo_gla'])
             + g_b * ((o_b * jax.nn.silu(m_gate)) @ p['w_bo_mla'])
             + g_c * ((o_c * jax.nn.silu(s_gate)) @ p['w_bo_s5']))
    y = x + gate * (mixed @ p['w_out'])
    return y, (st_mla, st_gla, st_s5)


def setup_inputs(seed: int = 0) -> dict:
    key = jax.random.key(seed)
    keys = jax.random.split(key, 64)
    counter = [0]

    def nxt():
        counter[0] += 1
        return keys[counter[0] - 1]

    def nrm(shape, scale):
        return scale * jax.random.normal(nxt(), shape, jnp.float32)

    L = DEPTH
    n_idx = jnp.arange(S5_STATE, dtype=jnp.float32)
    log_dt = math.log(DT_MIN) + jax.random.uniform(nxt(), (L, 2, S5_GROUPS), jnp.float32) * (math.log(DT_MAX) - math.log(DT_MIN))
    return {
        'x_prompt': nrm((BATCH, SEQ, D_MODEL), 1.0),
        'x_sample': nrm((DEC_BATCH, DEC_SEQ, D_MODEL), 1.0),
        'c': nrm((DEC_BATCH, D_MODEL), 1.0),
        'c_ctx': nrm((D_MODEL,), 1.0),
        'cache_mla_ckv': nrm((DEC_BATCH, L, PAST_LEN, MLA_KV_LORA), 1.0),
        'cache_mla_krope': nrm((DEC_BATCH, L, PAST_LEN, MLA_ROPE), 1.0),
        'state_gla': nrm((DEC_BATCH, L, 2, GLA_HEADS, GLA_DK, GLA_DV), 0.5),
        'state_s5': nrm((DEC_BATCH, L, 2, 2, S5_GROUPS, S5_STATE), 0.1),
        'norm_w': 1.0 + nrm((L, D_MODEL), 0.02),
        'w_ada': nrm((L, D_MODEL, 3 * D_MODEL), 0.5 * D_MODEL ** -0.5),
        'b_ada': nrm((L, 3 * D_MODEL), 0.02),
        'w_in': nrm((L, D_MODEL, D_IN), D_MODEL ** -0.5),
        'gla_w_a2': nrm((L, 2, GLA_GATE_RANK, GLA_HEADS * GLA_DK), GLA_GATE_RANK ** -0.5),
        'gla_b_a': nrm((L, 2, GLA_HEADS * GLA_DK), 0.1),
        'gla_o_norm': 1.0 + nrm((L, GLA_DV), 0.02),
        'mla_q_norm': 1.0 + nrm((L, MLA_Q_LORA), 0.02),
        'mla_w_uq': nrm((L, MLA_Q_LORA, MLA_HEADS * MLA_QK), MLA_Q_LORA ** -0.5),
        'mla_kv_norm': 1.0 + nrm((L, MLA_KV_LORA), 0.02),
        'mla_w_uk': nrm((L, MLA_KV_LORA, MLA_HEADS * MLA_NOPE), MLA_KV_LORA ** -0.5),
        'mla_w_uv': nrm((L, MLA_KV_LORA, MLA_HEADS * MLA_DV), MLA_KV_LORA ** -0.5),
        'mla_qh_norm': 1.0 + nrm((L, MLA_QK), 0.02),
        'mla_kh_norm': 1.0 + nrm((L, MLA_QK), 0.02),
        's5_a_re': -0.5 * jnp.exp(nrm((L, 2, S5_GROUPS, S5_STATE), 0.05)),
        's5_a_im': jnp.pi * n_idx + nrm((L, 2, S5_GROUPS, S5_STATE), 0.01),
        's5_log_dt': log_dt,
        's5_b_re': nrm((L, S5_GROUPS, S5_STATE, S5_GROUP), (2 * S5_GROUP) ** -0.5),
        's5_b_im': nrm((L, S5_GROUPS, S5_STATE, S5_GROUP), (2 * S5_GROUP) ** -0.5),
        's5_c_re': nrm((L, S5_GROUPS, S5_GROUP, S5_STATE), (2 * S5_STATE) ** -0.5),
        's5_c_im': nrm((L, S5_GROUPS, S5_GROUP, S5_STATE), (2 * S5_STATE) ** -0.5),
        's5_d': nrm((L, S5_WIDTH), 1.0),
        's5_w_glu': nrm((L, S5_WIDTH, 2 * S5_WIDTH), S5_WIDTH ** -0.5),
        's5_b_glu': nrm((L, 2 * S5_WIDTH), 0.02),
        'w_bo_gla': nrm((L, GLA_WIDTH, D_MODEL), GLA_WIDTH ** -0.5),
        'w_bo_mla': nrm((L, MLA_WIDTH, D_MODEL), MLA_WIDTH ** -0.5),
        'w_bo_s5': nrm((L, S5_WIDTH, D_MODEL), S5_WIDTH ** -0.5),
        'w_out': nrm((L, D_MODEL, D_MODEL), D_MODEL ** -0.5),
    }


def reference(x_prompt, x_sample, c, c_ctx, cache_mla_ckv, cache_mla_krope, state_gla, state_s5,
              norm_w, w_ada, b_ada, w_in, gla_w_a2, gla_b_a, gla_o_norm,
              mla_q_norm, mla_w_uq, mla_kv_norm, mla_w_uk, mla_w_uv, mla_qh_norm, mla_kh_norm,
              s5_a_re, s5_a_im, s5_log_dt, s5_b_re, s5_b_im, s5_c_re, s5_c_im, s5_d, s5_w_glu, s5_b_glu,
              w_bo_gla, w_bo_mla, w_bo_s5, w_out):
    cond_ctx = jnp.broadcast_to(c_ctx[None, :], (x_prompt.shape[0], D_MODEL))
    rope = axial_rope_tables(x_sample.shape[1])
    hp = x_prompt
    hs = x_sample
    ckv_l, krope_l, gla_l, s5_l = [], [], [], []
    for l in range(DEPTH):
        p = {
            'norm_w': norm_w[l], 'w_ada': w_ada[l], 'b_ada': b_ada[l], 'w_in': w_in[l],
            'gla_w_a2': gla_w_a2[l], 'gla_b_a': gla_b_a[l], 'gla_o_norm': gla_o_norm[l],
            'mla_q_norm': mla_q_norm[l], 'mla_w_uq': mla_w_uq[l], 'mla_kv_norm': mla_kv_norm[l],
            'mla_w_uk': mla_w_uk[l], 'mla_w_uv': mla_w_uv[l], 'mla_qh_norm': mla_qh_norm[l],
            'mla_kh_norm': mla_kh_norm[l],
            's5_a_re': s5_a_re[l], 's5_a_im': s5_a_im[l], 's5_log_dt': s5_log_dt[l],
            's5_b_re': s5_b_re[l], 's5_b_im': s5_b_im[l], 's5_c_re': s5_c_re[l], 's5_c_im': s5_c_im[l],
            's5_d': s5_d[l], 's5_w_glu': s5_w_glu[l], 's5_b_glu': s5_b_glu[l],
            'w_bo_gla': w_bo_gla[l], 'w_bo_mla': w_bo_mla[l], 'w_bo_s5': w_bo_s5[l], 'w_out': w_out[l],
        }
        hp, (st_mla, st_gla, st_s5) = trunk_layer(hp, cond_ctx, None, None, p)
        ckv_l.append(st_mla[0])
        krope_l.append(st_mla[1])
        gla_l.append(st_gla)
        s5_l.append(st_s5)
        ctx = ((cache_mla_ckv[:, l], cache_mla_krope[:, l]),
               (state_gla[:, l, 0], state_gla[:, l, 1]),
               state_s5[:, l])
        hs, _ = trunk_layer(hs, c, rope, ctx, p)
    new_mla_ckv = jnp.stack(ckv_l, axis=1)
    new_mla_krope = jnp.stack(krope_l, axis=1)
    new_state_gla = jnp.stack(gla_l, axis=1)
    new_state_s5 = jnp.stack(s5_l, axis=1)
    return (hp, hs, new_mla_ckv, new_mla_krope, new_state_gla, new_state_s5)
```

```cpp
#include <hip/hip_runtime.h>
#include <hip/hip_cooperative_groups.h>
#include <cstdio>
namespace cg = cooperative_groups;
namespace pg8 {
#define PG8_LAS __attribute__((address_space(3)))
typedef unsigned short bf16_t;
typedef short bf16x8 __attribute__((ext_vector_type(8)));
typedef float f32x4 __attribute__((ext_vector_type(4)));
typedef unsigned u32x4 __attribute__((ext_vector_type(4)));
constexpr int BM = 256, BK = 64, HALF = 128, HTB = HALF * BK * 2  , STAGE_BYTES = 8 * HTB, NXCD = 8, WGM = 8;

__host__ __device__ __forceinline__ int lds_byte(int r, int c) { const int st = (r >> 4) * 2 + (c >> 5), rr = r & 15, cc = c & 31, ob = rr * 64 + cc * 2; return st * 1024 + (ob ^ (((ob >> 9) & 1) << 5)); }
__host__ __device__ __forceinline__ void stage_rc(int b, int& R, int& C) { const int st = b / 1024, sb = b % 1024, swz = sb ^ (((sb >> 9) & 1) << 5); R = (st >> 1) * 16 + swz / 64; C = (st & 1) * 32 + (swz % 64) / 2; }
__host__ __device__ __forceinline__ int perm32(int rho) { const int n = rho >> 4, i = rho & 15; return 8 * (i >> 2) + 4 * n + (i & 3); }

struct Unit { int pm, pn; };
struct Gemm { const bf16_t* A; const bf16_t* Bt; int M, N, K; };

struct StaticOrder {
    int nM, nN, nwg, G, c;
    __host__ __device__ void init(int M, int N, int G_, int c_) { nM = M / BM; nN = N / BM; nwg = nM * nN; G = G_; c = c_; }
    __host__ __device__ bool next(int i, Unit& u) const {
        const long L = (long)i * G + c; if (L >= nwg) return false;
        int wgid = (int)L; { const int q = nwg / NXCD, r = nwg % NXCD, xcd = wgid % NXCD, off = wgid / NXCD; wgid = (xcd < r ? xcd * (q + 1) : r * (q + 1) + (xcd - r) * q) + off; }
        const int nig = WGM * nN, gid = wgid / nig, fm = gid * WGM, gsz = (nM - fm) < WGM ? (nM - fm) : WGM;
        u.pm = fm + ((wgid % nig) % gsz); u.pn = (wgid % nig) / gsz; return true;
    }
    __device__ __forceinline__ void a_ready(const Unit&) const {}
    __device__ __forceinline__ void done(const Unit&) const {}
};
__device__ __forceinline__ unsigned cvt_pk_bf16(float lo, float hi) { unsigned r; asm volatile("v_cvt_pk_bf16_f32 %0, %1, %2" : "=v"(r) : "v"(lo), "v"(hi)); return r; }
typedef float f32x2 __attribute__((ext_vector_type(2)));
template <class Epi, class Sched, bool STAMP = false>
__device__ __forceinline__ void gemm_phase(PG8_LAS unsigned char* lds, const Gemm g, const Sched& S, const Epi& E, unsigned long long* stamps) {
    int tid_ = (int)threadIdx.x; asm volatile("" : "+v"(tid_)); const int tid = tid_, wid = __builtin_amdgcn_readfirstlane(tid >> 6), lane = tid & 63, wr = wid >> 2, wc = wid & 3, fr = lane & 15, fq = lane >> 4;
    int K_ = g.K; asm volatile("" : "+s"(K_)); const int K = K_, nt = K / BK;
    int ts_lo = 0, ts_hi = 0, nts = 0; const unsigned long long rt_entry = STAMP ? (unsigned long long)wall_clock64() : 0ull;
#define PG8_STAMP() do { if (STAMP && wid == 0 && nts < 64) { const unsigned long long _c = (unsigned long long)clock64(); \
        ts_lo = (lane == nts) ? (int)(unsigned)_c : ts_lo; ts_hi = (lane == nts) ? (int)(unsigned)(_c >> 32) : ts_hi; ++nts; } } while (0)
    PG8_STAMP();
    unsigned voffA[2], voffB[2];
#pragma unroll
    for (int i = 0; i < 2; ++i) { int R, C; stage_rc(tid * 16 + i * 8192, R, C); const int Rb = Epi::PERM ? ((R & ~31) + perm32(R & 31)) : R;
        voffA[i] = (unsigned)(R * K + C) * 2u; voffB[i] = (unsigned)(Rb * K + C) * 2u; }
    const size_t kstep = (size_t)(BK * 2);
    const size_t hstep = (size_t)HALF * K * 2;
    const size_t tstep = 2 * hstep;
    const unsigned ldsw = (unsigned)wid * 1024u;
    const int aoff = lds_byte(wr * 64 + fr, fq * 8), boff = lds_byte(wc * 32 + fr, fq * 8);
#define PG8_SA(b, h) (((b) * 2 + (h)) * HTB)
#define PG8_SB(b, h) ((4 + (b) * 2 + (h)) * HTB)
#define PG8_STAGE(bufoff, gbase, voff) do { _Pragma("unroll") for (int _i = 0; _i < 2; ++_i) \
        __builtin_amdgcn_global_load_lds((const unsigned*)((const char*)(gbase) + (voff)[_i]), (PG8_LAS unsigned*)(lds + (bufoff) + ldsw + _i * 8192), 16, 0, 0); } while (0)
#define PG8_LDA(dst, b, h) do { _Pragma("unroll") for (int m = 0; m < 4; ++m) _Pragma("unroll") for (int k = 0; k < 2; ++k) dst[m][k] = *(const PG8_LAS bf16x8*)(lds + PG8_SA(b, h) + aoff + m * 2048 + k * 1024); } while (0)
#define PG8_LDB(dst, b, h) do { _Pragma("unroll") for (int n = 0; n < 2; ++n) _Pragma("unroll") for (int k = 0; k < 2; ++k) dst[n][k] = *(const PG8_LAS bf16x8*)(lds + PG8_SB(b, h) + boff + n * 2048 + k * 1024); } while (0)
#define PG8_MMA(ai, bj, At, Bt) do { __builtin_amdgcn_s_setprio(1); _Pragma("unroll") for (int m = 0; m < 4; ++m) _Pragma("unroll") for (int n = 0; n < 2; ++n) _Pragma("unroll") for (int k = 0; k < 2; ++k) \
        acc[ai][bj][m][n] = __builtin_amdgcn_mfma_f32_16x16x32_bf16(Bt[n][k], At[m][k], acc[ai][bj][m][n], 0, 0, 0); __builtin_amdgcn_s_setprio(0); } while (0)
#define PG8_WAIT_V(n) asm volatile("s_waitcnt vmcnt(" #n ")" ::: "memory")
#define PG8_WAIT_L(n) asm volatile("s_waitcnt lgkmcnt(" #n ")" ::: "memory")
#define PG8_BAR __builtin_amdgcn_s_barrier()
#define PG8_SCHED __builtin_amdgcn_sched_barrier(0)
    Unit cur, nxt; int ui = 0;
    if (!S.next(0, cur)) return;
    f32x4 acc[2][2][4][2];
#pragma unroll
    for (int a = 0; a < 2; ++a)
#pragma unroll
        for (int b = 0; b < 2; ++b)
#pragma unroll
            for (int m = 0; m < 4; ++m)
#pragma unroll
                for (int n = 0; n < 2; ++n) acc[a][b][m][n] = (f32x4){0.f, 0.f, 0.f, 0.f};
    bf16x8 At[4][2], B0[2][2], B1[2][2];
    const char* cA = (const char*)g.A + (size_t)cur.pm * tstep; const char* cB = (const char*)g.Bt + (size_t)cur.pn * tstep;
    S.a_ready(cur);
    PG8_STAGE(PG8_SB(0, 0), cB, voffB); PG8_STAGE(PG8_SA(0, 0), cA, voffA); PG8_STAGE(PG8_SB(0, 1), cB + hstep, voffB); PG8_STAGE(PG8_SA(0, 1), cA + hstep, voffA);
    if (wr == 1) PG8_BAR;
    PG8_WAIT_V(4); PG8_BAR;
    PG8_STAGE(PG8_SB(1, 0), cB + kstep, voffB); PG8_STAGE(PG8_SA(1, 0), cA + kstep, voffA); PG8_STAGE(PG8_SB(1, 1), cB + hstep + kstep, voffB);
    PG8_WAIT_V(6); PG8_BAR;
    PG8_STAMP();
    for (;;) {
        const bool has_next = S.next(ui + 1, nxt);
        const char* nA = has_next ? (const char*)g.A + (size_t)nxt.pm * tstep : cA; const char* nB = has_next ? (const char*)g.Bt + (size_t)nxt.pn * tstep : cB;
        for (int t = 0; t < nt; t += 2) {
            const bool last = (t == nt - 2);
            const char* a1 = cA + (size_t)(t + 1) * kstep;
            const char* a2 = last ? nA : cA + (size_t)(t + 2) * kstep; const char* b2 = last ? nB : cB + (size_t)(t + 2) * kstep;
            const char* a3 = a2 + kstep; const char* b3 = b2 + kstep;
            if (last && has_next) S.a_ready(nxt);
            PG8_LDB(B0, 0, 0); PG8_SCHED; PG8_LDA(At, 0, 0); PG8_STAGE(PG8_SA(1, 1), a1 + hstep, voffA);
            PG8_WAIT_L(8); PG8_BAR; PG8_WAIT_L(0); PG8_MMA(0, 0, At, B0); PG8_BAR; PG8_SCHED;
            PG8_LDB(B1, 0, 1); PG8_STAGE(PG8_SB(0, 0), b2, voffB);
            PG8_BAR; PG8_WAIT_L(0); PG8_MMA(0, 1, At, B1); PG8_BAR;
            PG8_LDA(At, 0, 1); PG8_STAGE(PG8_SA(0, 0), a2, voffA);
            PG8_BAR; PG8_WAIT_L(0); PG8_MMA(1, 0, At, B0); PG8_BAR; PG8_SCHED;
            PG8_STAGE(PG8_SB(0, 1), b2 + hstep, voffB);
            PG8_WAIT_V(6); PG8_BAR; PG8_MMA(1, 1, At, B1); PG8_BAR;
            PG8_LDB(B0, 1, 0); PG8_SCHED; PG8_LDA(At, 1, 0); PG8_STAGE(PG8_SA(0, 1), a2 + hstep, voffA);
            PG8_WAIT_L(8); PG8_BAR; PG8_WAIT_L(0); PG8_MMA(0, 0, At, B0); PG8_BAR; PG8_SCHED;
            PG8_LDB(B1, 1, 1); PG8_STAGE(PG8_SB(1, 0), b3, voffB);
            PG8_BAR; PG8_WAIT_L(0); PG8_MMA(0, 1, At, B1); PG8_BAR;
            PG8_LDA(At, 1, 1); PG8_STAGE(PG8_SA(1, 0), a3, voffA);
            PG8_BAR; PG8_WAIT_L(0); PG8_MMA(1, 0, At, B0); PG8_BAR; PG8_SCHED;
            PG8_STAGE(PG8_SB(1, 1), b3 + hstep, voffB);
            PG8_WAIT_V(6); PG8_BAR; PG8_MMA(1, 1, At, B1); PG8_BAR;
        }
        PG8_STAMP();
        if constexpr (!Epi::AFTER_DRAIN) { E(acc, cur, wr, wc, fr, fq); S.done(cur); }
        PG8_STAMP();
        if (!has_next) break;
#pragma unroll
        for (int a = 0; a < 2; ++a)
#pragma unroll
            for (int b = 0; b < 2; ++b)
#pragma unroll
                for (int m = 0; m < 4; ++m)
#pragma unroll
                    for (int n = 0; n < 2; ++n) acc[a][b][m][n] = (f32x4){0.f, 0.f, 0.f, 0.f};
        cur = nxt; cA = nA; cB = nB; ++ui;
    }
    PG8_WAIT_V(0);
    if (wr == 0) PG8_BAR;
    PG8_BAR;
    if constexpr (Epi::AFTER_DRAIN) { E.fused(acc, cur, wr, wc, fr, fq, lds, wid, lane); S.done(cur); }
    PG8_STAMP();
    if (STAMP && wid == 0) { stamps[lane] = lane < nts ? (((unsigned long long)(unsigned)ts_hi << 32) | (unsigned)ts_lo) : 0ull;
        if (lane == 62) stamps[62] = rt_entry; if (lane == 63) stamps[63] = (unsigned long long)wall_clock64(); }
#undef PG8_STAMP
#undef PG8_SA
#undef PG8_SB
#undef PG8_STAGE
#undef PG8_LDA
#undef PG8_LDB
#undef PG8_MMA
#undef PG8_WAIT_V
#undef PG8_WAIT_L
#undef PG8_BAR
#undef PG8_SCHED
}
}
using pg8::bf16_t; using pg8::bf16x8; using pg8::f32x4; using pg8::u32x4; using pg8::Unit;
#define LAS __attribute__((address_space(3)))
typedef unsigned u32x2 __attribute__((ext_vector_type(2)));
typedef LAS unsigned char* lds_t;
__device__ __forceinline__ int tid_opaque() { int t = (int)threadIdx.x; asm volatile("" : "+v"(t)); return t; }
typedef float f32x2_t __attribute__((ext_vector_type(2)));

enum { I_XP = 0, I_XS, I_C, I_CCTX, I_CKV, I_CKR, I_SGLA, I_SS5, I_NORMW, I_WADA, I_BADA, I_WIN, I_WA2, I_BA, I_ONORM, I_QNORM, I_WUQ, I_KVNORM, I_WUK, I_WUV,
       I_QHNORM, I_KHNORM, I_ARE, I_AIM, I_LOGDT, I_BRE, I_BIM, I_CRE, I_CIM, I_S5D, I_WGLU, I_BGLU, I_WBOG, I_WBOM, I_WBOS, I_WOUT, N_IN };
struct KParams { const float* in[N_IN]; float* out; unsigned char* ws; };
struct Params { const float* const* in; float* out; unsigned char* ws; };

constexpr int LDZ = 6912;
constexpr int ZQ = 0, ZK = 256, ZV = 512, ZGA = 1024, ZGG = 1056, ZMQ = 1568, ZMKV = 1952, ZMKR = 2208, ZMG = 2240, ZSU = 2752, ZSG = 3264, ZMERGE = 3776;
constexpr size_t OUT_YP = 0, OUT_CKV = 8388608, OUT_KR = 10485760, OUT_GLA = 10747904, OUT_S5 = 12845056;
constexpr size_t OFF_WIN = 0;
constexpr size_t OFF_QD = OFF_WIN, OFF_KN = OFF_WIN + 8388608;
constexpr size_t OFF_WUQ = OFF_WIN + 14155776;
constexpr size_t OFF_WKV = OFF_WUQ + 393216;
constexpr size_t OFF_WGLU = OFF_WKV + 393216;
constexpr size_t OFF_WBO = OFF_WGLU + 1048576;
constexpr size_t OFF_WOUT = OFF_WBO + 3145728;
constexpr size_t OFF_S5M = OFF_WOUT + 2097152;
constexpr size_t OFF_V = OFF_S5M;
constexpr size_t OFF_P16 = OFF_S5M + 12582912;
constexpr size_t OFF_ADA = OFF_P16 + 32768;
constexpr size_t OFF_ROPE = OFF_ADA + 122880;
constexpr size_t OFF_CTX0 = OFF_ROPE + 131072;
constexpr size_t OFF_CKVN = OFF_CTX0 + 1048576;
constexpr size_t OFF_CTX1 = OFF_CKVN + 4194304;
constexpr size_t OFF_HB = OFF_CTX1 + 1048576;
constexpr size_t OFF_Z = OFF_HB + 16777216;
constexpr size_t OFF_KV = OFF_Z + 113246208;
constexpr size_t OFF_AGLA = OFF_KV, OFF_AMLA = OFF_KV + 8388608;
constexpr size_t OFF_DEC = OFF_KV + 33554432;
constexpr size_t OFF_ST = OFF_DEC + 262144;
constexpr size_t OFF_AQ = OFF_ST + 16777216;
constexpr size_t OFF_QRAW = OFF_AQ + 6291456;
constexpr size_t OFF_AS5 = OFF_QRAW + 6291456;
constexpr size_t OFF_YG = OFF_AS5 + 8388608;
constexpr size_t OFF_TBL = OFF_YG + 8388608;
constexpr size_t WS_END = OFF_TBL + 512;
constexpr int DYN_LDS = 147456;

__device__ __forceinline__ float bf2f(bf16_t b) { return __uint_as_float(((unsigned)b) << 16); }
__device__ __forceinline__ bf16_t f2bf(float f) { unsigned u = __float_as_uint(f); u += 0x7FFFu + ((u >> 16) & 1u); return (bf16_t)(u >> 16); }
__device__ __forceinline__ unsigned pk2(float lo, float hi) { return pg8::cvt_pk_bf16(lo, hi); }
__device__ __forceinline__ float lo16(unsigned w) { return __uint_as_float(w << 16); }
__device__ __forceinline__ float hi16(unsigned w) { return __uint_as_float(w & 0xffff0000u); }
__device__ __forceinline__ float sigmoidf_(float x) { return 1.f / (1.f + __expf(-x)); }
__device__ __forceinline__ float siluf_(float x) { return x / (1.f + __expf(-x)); }
__device__ __forceinline__ void store8(bf16_t* p, const f32x4& a, const f32x4& b) { u32x4 w; w.x = pk2(a[0], a[1]); w.y = pk2(a[2], a[3]); w.z = pk2(b[0], b[1]); w.w = pk2(b[2], b[3]); *(u32x4*)p = w; }
#define MFMA16(a, b, c) __builtin_amdgcn_mfma_f32_16x16x32_bf16(a, b, c, 0, 0, 0)
#define LDSFRAG(ptr) (*(const LAS bf16x8*)(ptr))

struct Order : pg8::StaticOrder {
    __device__ void setup(int M, int N, int rot) { const int G = (int)gridDim.x; init(M, N, G, (int)((blockIdx.x + (unsigned)rot) % (unsigned)G)); }
};

struct EpiZ { static constexpr bool PERM = true, AFTER_DRAIN = false; bf16_t* Z;
    __device__ __forceinline__ void operator()(const f32x4 (&acc)[2][2][4][2], const Unit& u, int wr, int wc, int fr, int fq) const {
        const int row0 = u.pm * 256 + wr * 64 + fr, col0 = u.pn * 256 + wc * 32 + 8 * fq;
#pragma unroll
        for (int ai = 0; ai < 2; ++ai)
#pragma unroll
            for (int m = 0; m < 4; ++m) { bf16_t* rp = Z + (size_t)(row0 + ai * 128 + m * 16) * LDZ + col0;
#pragma unroll
                for (int bj = 0; bj < 2; ++bj) store8(rp + bj * 128, acc[ai][bj][m][0], acc[ai][bj][m][1]); }
    } };
struct EpiQ { static constexpr bool PERM = true, AFTER_DRAIN = false; bf16_t* Q;
    __device__ __forceinline__ void operator()(const f32x4 (&acc)[2][2][4][2], const Unit& u, int wr, int wc, int fr, int fq) const {
        const int row0 = u.pm * 256 + wr * 64 + fr, col0 = u.pn * 256 + wc * 32 + 8 * fq;
#pragma unroll
        for (int ai = 0; ai < 2; ++ai)
#pragma unroll
            for (int m = 0; m < 4; ++m) { bf16_t* rp = Q + (size_t)(row0 + ai * 128 + m * 16) * 384 + col0;
#pragma unroll
                for (int bj = 0; bj < 2; ++bj) if (col0 + bj * 128 < 384) store8(rp + bj * 128, acc[ai][bj][m][0], acc[ai][bj][m][1]);
                __builtin_amdgcn_sched_barrier(0); }
    } };
struct EpiKV { static constexpr bool PERM = true, AFTER_DRAIN = false; bf16_t* KN; bf16_t* V; int layer;
    __device__ __forceinline__ void operator()(const f32x4 (&acc)[2][2][4][2], const Unit& u, int wr, int wc, int fr, int fq) const {
        int rb = u.pm * 256; if (layer == 0) rb = rb < 2048 ? 8192 + rb : rb - 2048;
        const int row0 = rb + wr * 64 + fr, cl = wc * 32 + 8 * fq;
#pragma unroll
        for (int ai = 0; ai < 2; ++ai)
#pragma unroll
            for (int m = 0; m < 4; ++m) { const size_t r = (size_t)(row0 + ai * 128 + m * 16);
                bf16_t* rp = u.pn == 0 ? KN + r * 256 + cl : V + r * 512 + (u.pn - 1) * 256 + cl;
#pragma unroll
                for (int bj = 0; bj < 2; ++bj) store8(rp + bj * 128, acc[ai][bj][m][0], acc[ai][bj][m][1]);
                __builtin_amdgcn_sched_barrier(0); }
    } };
struct EpiGLU { static constexpr bool PERM = true, AFTER_DRAIN = false; bf16_t* O; const bf16_t* Z; const float* bias;
    __device__ __forceinline__ void operator()(const f32x4 (&acc)[2][2][4][2], const Unit& u, int wr, int wc, int fr, int fq) const {
        const int row0 = u.pm * 256 + wr * 64 + fr, oc = u.pn * 128 + wc * 32 + 8 * fq;
        float bv[8], bg[8];
#pragma unroll
        for (int i = 0; i < 8; ++i) { bv[i] = bias[oc + i]; bg[i] = bias[512 + oc + i]; }
#pragma unroll
        for (int ai = 0; ai < 2; ++ai)
#pragma unroll
            for (int m = 0; m < 4; ++m) { const size_t r = (size_t)(row0 + ai * 128 + m * 16);
                const u32x4 sg = *(const u32x4*)(Z + r * LDZ + ZSG + oc);
                float g[8] = { lo16(sg.x), hi16(sg.x), lo16(sg.y), hi16(sg.y), lo16(sg.z), hi16(sg.z), lo16(sg.w), hi16(sg.w) };
                float o[8];
#pragma unroll
                for (int i = 0; i < 8; ++i) { const float zv = acc[ai][0][m][i >> 2][i & 3] + bv[i], zg = acc[ai][1][m][i >> 2][i & 3] + bg[i]; o[i] = zv * sigmoidf_(zg) * siluf_(g[i]); }
                u32x4 w; w.x = pk2(o[0], o[1]); w.y = pk2(o[2], o[3]); w.z = pk2(o[4], o[5]); w.w = pk2(o[6], o[7]);
                *(u32x4*)(O + r * 512 + oc) = w; __builtin_amdgcn_sched_barrier(0); }
    } };
struct EpiBo { static constexpr bool PERM = true, AFTER_DRAIN = false; bf16_t* MIX; const bf16_t* Z; int branch;
    __device__ __forceinline__ void operator()(const f32x4 (&acc)[2][2][4][2], const Unit& u, int wr, int wc, int fr, int fq) const {
        const int row0 = u.pm * 256 + wr * 64 + fr, col0 = u.pn * 256 + wc * 32 + 8 * fq;
#pragma unroll
        for (int ai = 0; ai < 2; ++ai)
#pragma unroll
            for (int m = 0; m < 4; ++m) { const size_t r = (size_t)(row0 + ai * 128 + m * 16);
#pragma unroll
                for (int bj = 0; bj < 2; ++bj) { const int c = col0 + bj * 128;
                    const u32x4 sg = *(const u32x4*)(Z + r * LDZ + ZMERGE + branch * 1024 + c);
                    float g[8] = { lo16(sg.x), hi16(sg.x), lo16(sg.y), hi16(sg.y), lo16(sg.z), hi16(sg.z), lo16(sg.w), hi16(sg.w) };
                    float o[8];
#pragma unroll
                    for (int i = 0; i < 8; ++i) o[i] = sigmoidf_(g[i]) * acc[ai][bj][m][i >> 2][i & 3];
                    bf16_t* mp = MIX + r * 1024 + c;
                    if (branch > 0) { const u32x4 pv = *(const u32x4*)mp;
                        o[0] += lo16(pv.x); o[1] += hi16(pv.x); o[2] += lo16(pv.y); o[3] += hi16(pv.y); o[4] += lo16(pv.z); o[5] += hi16(pv.z); o[6] += lo16(pv.w); o[7] += hi16(pv.w); }
                    u32x4 w; w.x = pk2(o[0], o[1]); w.y = pk2(o[2], o[3]); w.z = pk2(o[4], o[5]); w.w = pk2(o[6], o[7]);
                    *(u32x4*)mp = w; __builtin_amdgcn_sched_barrier(0); } }
    } };
struct EpiOut { static constexpr bool PERM = false, AFTER_DRAIN = false; float* Y; const float* xp; const float* xs; const float* ada;
    __device__ __forceinline__ void operator()(const f32x4 (&acc)[2][2][4][2], const Unit& u, int wr, int wc, int fr, int fq) const {
        const int row0 = u.pm * 256 + wr * 64 + fr, col0 = u.pn * 256 + wc * 32 + 4 * fq;
        const int ar = u.pm < 16 ? 0 : 1 + ((u.pm - 16) >> 2);
        const float* gp = ada + ar * 3072 + 2048;
        f32x4 gv[2][2];
#pragma unroll
        for (int bj = 0; bj < 2; ++bj)
#pragma unroll
            for (int n = 0; n < 2; ++n) gv[bj][n] = *(const f32x4*)(gp + col0 + bj * 128 + n * 16);
#pragma unroll
        for (int ai = 0; ai < 2; ++ai)
#pragma unroll
            for (int m = 0; m < 4; ++m) { const int r = row0 + ai * 128 + m * 16;
                const float* xr = (r < 4096 ? xp + (size_t)r * 1024 : xs + (size_t)(r - 4096) * 1024) + col0;
                float* yr = Y + (size_t)r * 1024 + col0;
#pragma unroll
                for (int bj = 0; bj < 2; ++bj)
#pragma unroll
                    for (int n = 0; n < 2; ++n) { const f32x4 xv = *(const f32x4*)(xr + bj * 128 + n * 16); *(f32x4*)(yr + bj * 128 + n * 16) = xv + gv[bj][n] * acc[ai][bj][m][n]; } }
    } };

__device__ void job_ada(const Params& p, int j, lds_t lds) {
    LAS float* sc = (LAS float*)lds; LAS float* red = sc + 5 * 1024;
    const int l = j / 48, c0 = (j % 48) * 64, tid = tid_opaque();
    for (int i = tid; i < 5 * 1024; i += 512) { const int r = i >> 10, k = i & 1023; const float v = r == 0 ? p.in[I_CCTX][k] : p.in[I_C][(r - 1) * 1024 + k]; sc[i] = v / (1.f + expf(-v)); }
    __syncthreads();
    const int col = tid & 63, kg = tid >> 6; const float* W = p.in[I_WADA] + (size_t)l * 1024 * 3072 + c0 + col;
    float a0 = 0.f, a1 = 0.f, a2 = 0.f, a3 = 0.f, a4 = 0.f;
    for (int k = kg * 128; k < kg * 128 + 128; ++k) { const float w = W[(size_t)k * 3072]; a0 += sc[k] * w; a1 += sc[1024 + k] * w; a2 += sc[2048 + k] * w; a3 += sc[3072 + k] * w; a4 += sc[4096 + k] * w; }
    red[(kg * 5 + 0) * 64 + col] = a0; red[(kg * 5 + 1) * 64 + col] = a1; red[(kg * 5 + 2) * 64 + col] = a2; red[(kg * 5 + 3) * 64 + col] = a3; red[(kg * 5 + 4) * 64 + col] = a4;
    __syncthreads();
    if (tid < 320) { const int r = tid / 64, cc = tid % 64; float s = p.in[I_BADA][l * 3072 + c0 + cc];
        for (int g = 0; g < 8; ++g) s += red[(g * 5 + r) * 64 + cc];
        ((float*)(p.ws + OFF_ADA))[(l * 5 + r) * 3072 + c0 + cc] = s; }
    __syncthreads();
}
__device__ void job_ctx(const Params& p, int j) {
    const int base = j * 4096 + tid_opaque() * 8; const int l = base / (2048 * 256), rem = base % (2048 * 256), row = rem >> 8, c = rem & 255, b = row >> 9, jj = row & 511;
    const float* s = p.in[I_CKV] + ((size_t)((b * 2 + l) * 512 + jj)) * 256 + c;
    const f32x4 v0 = *(const f32x4*)s, v1 = *(const f32x4*)(s + 4);
    bf16_t* d = (bf16_t*)(p.ws + (l == 0 ? OFF_CTX0 : OFF_CTX1)) + (size_t)row * 256 + c;
    store8(d, v0, v1);
}
__device__ void job_rope(const Params& p, int j) {
    const int idx = j * 512 + tid_opaque(), pos = idx >> 4, i = idx & 15, f = i & 7;
    const float inv = powf(10000.f, -(float)f / 8.f); const float ang = (float)(i < 8 ? (pos >> 6) : (pos & 63)) * inv;
    float* R = (float*)(p.ws + OFF_ROPE); R[idx] = cosf(ang); R[16384 + idx] = sinf(ang);
}

__device__ void job_prep(const Params& p, int l, int j) {
    const int tid = tid_opaque(), wid = tid >> 6, lane = tid & 63, row = j * 8 + wid;
    const float* x = l == 0 ? (row < 4096 ? p.in[I_XP] + (size_t)row * 1024 : p.in[I_XS] + (size_t)(row - 4096) * 1024) : p.out + (size_t)row * 1024;
    const int ar = row < 4096 ? 0 : 1 + ((row - 4096) >> 10);
    const float* ada = (const float*)(p.ws + OFF_ADA) + (l * 5 + ar) * 3072; const float* nw = p.in[I_NORMW] + l * 1024;
    f32x4 v[4]; float ss = 0.f;
#pragma unroll
    for (int i = 0; i < 4; ++i) { v[i] = *(const f32x4*)(x + i * 256 + lane * 4); ss += v[i][0] * v[i][0] + v[i][1] * v[i][1] + v[i][2] * v[i][2] + v[i][3] * v[i][3]; }
#pragma unroll
    for (int o = 1; o < 64; o <<= 1) ss += __shfl_xor(ss, o);
    const float rstd = rsqrtf(ss * (1.f / 1024.f) + 1e-6f);
    bf16_t* h = (bf16_t*)(p.ws + OFF_HB) + (size_t)row * 1024;
#pragma unroll
    for (int i = 0; i < 4; ++i) { const int c = i * 256 + lane * 4; const f32x4 w = *(const f32x4*)(nw + c), sh = *(const f32x4*)(ada + c), sc = *(const f32x4*)(ada + 1024 + c);
        float o[4];
#pragma unroll
        for (int k = 0; k < 4; ++k) o[k] = v[i][k] * rstd * w[k] * (1.f + sc[k]) + sh[k];
        u32x2 pk; pk.x = pk2(o[0], o[1]); pk.y = pk2(o[2], o[3]); *(u32x2*)(h + c) = pk; }
}
__device__ void wt_tile(const float* src, int ldsrc, int scol, bf16_t* dst, int K, int n0, int k0, lds_t lds) {
    LAS float* t = (LAS float*)lds; const int tid = tid_opaque();
    if (scol >= 0) {
#pragma unroll
        for (int i = 0; i < 8; ++i) { const int kk = i * 8 + (tid >> 6), nn = tid & 63; t[kk * 65 + nn] = src[(size_t)(k0 + kk) * ldsrc + scol + nn]; }
    }
    __syncthreads();
    const int n = tid >> 3, kc = tid & 7; u32x4 w = {0u, 0u, 0u, 0u};
    if (scol >= 0) { const LAS float* s = t + (kc * 8) * 65 + n; w.x = pk2(s[0], s[65]); w.y = pk2(s[130], s[195]); w.z = pk2(s[260], s[325]); w.w = pk2(s[390], s[455]); }
    *(u32x4*)(dst + (size_t)(n0 + n) * K + k0 + kc * 8) = w;
    __syncthreads();
}
constexpr int WT_WIN = 108 * 16, WT_WUQ = 8 * 6, WT_WKV = 12 * 4, WT_WGLU = 16 * 8, WT_WBO = 16 * 8, WT_WOUT = 16 * 16, WT_TOTAL = WT_WIN + WT_WUQ + WT_WKV + WT_WGLU + 3 * WT_WBO + WT_WOUT;
__device__ void job_wt(const Params& p, int l, int t, lds_t lds) {
    if (t < WT_WIN) { const int nt = t / 16, kt = t % 16; wt_tile(p.in[I_WIN] + (size_t)l * 1024 * 6848, 6848, nt < 107 ? nt * 64 : -1, (bf16_t*)(p.ws + OFF_WIN), 1024, nt * 64, kt * 64, lds); return; } t -= WT_WIN;
    if (t < WT_WUQ) { const int nt = t / 6, kt = t % 6; wt_tile(p.in[I_WUQ] + (size_t)l * 384 * 384, 384, nt < 6 ? nt * 64 : -1, (bf16_t*)(p.ws + OFF_WUQ), 384, nt * 64, kt * 64, lds); return; } t -= WT_WUQ;
    if (t < WT_WKV) { const int nt = t / 4, kt = t % 4;
        if (nt < 4) wt_tile(p.in[I_WUK] + (size_t)l * 256 * 256, 256, nt * 64, (bf16_t*)(p.ws + OFF_WKV), 256, nt * 64, kt * 64, lds);
        else wt_tile(p.in[I_WUV] + (size_t)l * 256 * 512, 512, (nt - 4) * 64, (bf16_t*)(p.ws + OFF_WKV), 256, nt * 64, kt * 64, lds);
        return; } t -= WT_WKV;
    if (t < WT_WGLU) { const int nt = t / 8, kt = t % 8, n0 = nt * 64; const int scol = ((n0 >> 7) & 1) * 512 + (n0 >> 8) * 128 + (n0 & 127);
        wt_tile(p.in[I_WGLU] + (size_t)l * 512 * 1024, 1024, scol, (bf16_t*)(p.ws + OFF_WGLU), 512, n0, kt * 64, lds); return; } t -= WT_WGLU;
    if (t < 3 * WT_WBO) { const int br = t / WT_WBO, tt = t % WT_WBO, nt = tt / 8, kt = tt % 8;
        wt_tile(p.in[I_WBOG + br] + (size_t)l * 512 * 1024, 1024, nt * 64, (bf16_t*)(p.ws + OFF_WBO) + (size_t)br * 1024 * 512, 512, nt * 64, kt * 64, lds); return; } t -= 3 * WT_WBO;
    { const int nt = t / 16, kt = t % 16; wt_tile(p.in[I_WOUT] + (size_t)l * 1024 * 1024, 1024, nt * 64, (bf16_t*)(p.ws + OFF_WOUT), 1024, nt * 64, kt * 64, lds); }
}
__device__ void job_s5setup(const Params& p, int l, int j, lds_t lds) {
    const int g = j / 3, which = j % 3, tid = tid_opaque();
    LAS f32x2_t* pw = (LAS f32x2_t*)lds;
    LAS f32x2_t* Bt = pw + 2 * 17 * 64;
    LAS f32x2_t* Cn = Bt + 2 * 64 * 16;
    LAS float* Kt = (LAS float*)(Cn + 64 * 16);
    if (tid < 128) { const int d = tid >> 6, n = tid & 63;
        const float dt = expf(p.in[I_LOGDT][(l * 2 + d) * 32 + g]);
        const float are = p.in[I_ARE][((l * 2 + d) * 32 + g) * 64 + n], aim = p.in[I_AIM][((l * 2 + d) * 32 + g) * 64 + n];
        for (int tau = 0; tau <= 16; ++tau) { const float mag = expf(are * dt * (float)tau); float s, c; sincosf(aim * dt * (float)tau, &s, &c); pw[(d * 17 + tau) * 64 + n] = (f32x2_t){mag * c, mag * s}; }
        float s1, c1; sincosf(aim * dt, &s1, &c1); float sh = sinf(0.5f * aim * dt);
        const float em1 = expm1f(are * dt), mag1 = em1 + 1.f;
        const float nre = em1 * c1 - 2.f * sh * sh, abim = mag1 * s1, den = are * are + aim * aim;
        const float cfr = (nre * are + abim * aim) / den, cfi = (abim * are - nre * aim) / den;
        for (int q = 0; q < 16; ++q) { const float br = p.in[I_BRE][((size_t)(l * 32 + g) * 64 + n) * 16 + q], bi = p.in[I_BIM][((size_t)(l * 32 + g) * 64 + n) * 16 + q];
            Bt[(d * 64 + n) * 16 + q] = (f32x2_t){cfr * br - cfi * bi, cfr * bi + cfi * br}; }
        if (which == 1) ((f32x2_t*)(p.ws + OFF_P16))[(g * 2 + d) * 64 + n] = pw[(d * 17 + 16) * 64 + n];
    }
    for (int i = tid; i < 1024; i += 512) { const int n = i >> 4, pp = i & 15; Cn[i] = (f32x2_t){p.in[I_CRE][((size_t)(l * 32 + g) * 16 + pp) * 64 + n], p.in[I_CIM][((size_t)(l * 32 + g) * 16 + pp) * 64 + n]}; }
    __syncthreads();
    bf16_t* M = (bf16_t*)(p.ws + OFF_S5M) + (size_t)(g * 3 + which) * 65536;
    if (which == 0) {
        for (int i = tid; i < 8192; i += 512) { const int d = i >> 12, tau = (i >> 8) & 15, pp = (i >> 4) & 15, q = i & 15; float s = 0.f;
            for (int n = 0; n < 64; ++n) { const f32x2_t c = Cn[n * 16 + pp], w = pw[(d * 17 + tau) * 64 + n], b = Bt[(d * 64 + n) * 16 + q];
                const float cwr = c.x * w.x - c.y * w.y, cwi = c.x * w.y + c.y * w.x; s += cwr * b.x - cwi * b.y; }
            Kt[i] = s; }
        __syncthreads();
        for (int i = tid; i < 65536; i += 512) { const int no = i >> 8, k = i & 255, t = no >> 4, pp = no & 15, s = k >> 4, q = k & 15; float v;
            if (t > s) v = Kt[(0 * 16 + (t - s)) * 256 + pp * 16 + q];
            else if (t < s) v = Kt[(1 * 16 + (s - t)) * 256 + pp * 16 + q];
            else { v = Kt[pp * 16 + q] + Kt[16 * 256 + pp * 16 + q]; if (pp == q) v += p.in[I_S5D][l * 512 + g * 16 + pp]; }
            M[i] = f2bf(v); }
    } else if (which == 1) {
        for (int i = tid; i < 65536; i += 512) { const int no = i >> 8, k = i & 255, d = no >> 7, ri = (no >> 6) & 1, n = no & 63, s = k >> 4, q = k & 15; const int e = d == 0 ? 15 - s : s;
            const f32x2_t w = pw[(d * 17 + e) * 64 + n], b = Bt[(d * 64 + n) * 16 + q];
            M[i] = f2bf(ri == 0 ? w.x * b.x - w.y * b.y : w.x * b.y + w.y * b.x); }
    } else {
        for (int i = tid; i < 65536; i += 512) { const int no = i >> 8, k = i & 255, t = no >> 4, pp = no & 15, d = k >> 7, ri = (k >> 6) & 1, n = k & 63; const int e = d == 0 ? t + 1 : 16 - t;
            const f32x2_t c = Cn[n * 16 + pp], w = pw[(d * 17 + e) * 64 + n];
            M[i] = f2bf(ri == 0 ? c.x * w.x - c.y * w.y : -(c.x * w.y + c.y * w.x)); }
    }
    __syncthreads();
}

__device__ __forceinline__ float gelu_tanh(float x) { const float u = 0.7978845608f * (x + 0.044715f * x * x * x); const float t = 1.f - 2.f / (1.f + __expf(2.f * u)); return 0.5f * x * (1.f + t); }
__device__ void job_s5(const Params& p, int l, int j, lds_t lds) {
    const int tid = tid_opaque(), wid = tid >> 6, lane = tid & 63, lr = lane & 15, lq = lane >> 4;
    int bb, g; if (j < 128) { bb = 16 + (j >> 5); g = j & 31; } else { bb = (j - 128) >> 5; g = (j - 128) & 31; }
    const int M = bb < 16 ? 16 : 64, MT = M >> 4; const int tok0 = bb < 16 ? bb * 256 : 4096 + (bb - 16) * 1024;
    LAS bf16_t* Us = (LAS bf16_t*)lds; LAS bf16_t* Xs = Us + 64 * 264; LAS float* Xin = (LAS float*)(lds + 2 * 64 * 264 * 2);
    const bf16_t* Z = (const bf16_t*)(p.ws + OFF_Z);
    for (int idx = tid; idx < M * 32; idx += 512) { const int tok = idx >> 1, hf = idx & 1;
        *(LAS u32x4*)(Us + (tok >> 4) * 264 + (tok & 15) * 16 + hf * 8) = *(const u32x4*)(Z + (size_t)(tok0 + tok) * LDZ + ZSU + g * 16 + hf * 8); }
    __syncthreads();
    const bf16_t* TT = (const bf16_t*)(p.ws + OFF_S5M) + (size_t)(g * 3) * 65536; const bf16_t* G = TT + 65536; const bf16_t* Cc = G + 65536;
    f32x4 acc[4][2];
#pragma unroll
    for (int a = 0; a < 4; ++a) { acc[a][0] = (f32x4){0.f, 0.f, 0.f, 0.f}; acc[a][1] = acc[a][0]; }
    for (int ks = 0; ks < 8; ++ks) {
        bf16x8 b0 = *(const bf16x8*)(G + (size_t)(wid * 32 + lr) * 256 + ks * 32 + lq * 8), b1 = *(const bf16x8*)(G + (size_t)(wid * 32 + 16 + lr) * 256 + ks * 32 + lq * 8);
#pragma unroll
        for (int mt = 0; mt < 4; ++mt) if (mt < MT) { const bf16x8 a = LDSFRAG(Us + (mt * 16 + lr) * 264 + ks * 32 + lq * 8); acc[mt][0] = MFMA16(a, b0, acc[mt][0]); acc[mt][1] = MFMA16(a, b1, acc[mt][1]); }
    }
#pragma unroll
    for (int mt = 0; mt < 4; ++mt) if (mt < MT)
#pragma unroll
        for (int ct = 0; ct < 2; ++ct)
#pragma unroll
            for (int r = 0; r < 4; ++r) Xin[(mt * 16 + lq * 4 + r) * 260 + wid * 32 + ct * 16 + lr] = acc[mt][ct][r];
    __syncthreads();
    if (tid < 128) { const int d = tid >> 6, n = tid & 63; const f32x2_t a16 = ((const f32x2_t*)(p.ws + OFF_P16))[(g * 2 + d) * 64 + n];
        float xr = 0.f, xi = 0.f;
        if (bb >= 16) { const size_t o = ((size_t)(((bb - 16) * 2 + l) * 2 + d) * 2) * 2048 + g * 64 + n; xr = p.in[I_SS5][o]; xi = p.in[I_SS5][o + 2048]; }
        const int cre = d * 128 + n, cim = cre + 64;
        for (int i = 0; i < M; ++i) { const int c = d == 0 ? i : M - 1 - i;
            Xs[c * 264 + cre] = f2bf(xr); Xs[c * 264 + cim] = f2bf(xi);
            const float ur = Xin[c * 260 + cre], ui = Xin[c * 260 + cim];
            const float nr = a16.x * xr - a16.y * xi + ur, ni = a16.x * xi + a16.y * xr + ui; xr = nr; xi = ni; }
        if (bb < 16) { const size_t o = OUT_S5 + ((size_t)((bb * 2 + l) * 2 + d) * 2) * 2048 + g * 64 + n; p.out[o] = xr; p.out[o + 2048] = xi; }
    }
    __syncthreads();
#pragma unroll
    for (int a = 0; a < 4; ++a) { acc[a][0] = (f32x4){0.f, 0.f, 0.f, 0.f}; acc[a][1] = acc[a][0]; }
    for (int ks = 0; ks < 16; ++ks) { const bf16_t* Bm = ks < 8 ? TT : Cc; const LAS bf16_t* Am = ks < 8 ? Us : Xs; const int kk = (ks & 7) * 32 + lq * 8;
        bf16x8 b0 = *(const bf16x8*)(Bm + (size_t)(wid * 32 + lr) * 256 + kk), b1 = *(const bf16x8*)(Bm + (size_t)(wid * 32 + 16 + lr) * 256 + kk);
#pragma unroll
        for (int mt = 0; mt < 4; ++mt) if (mt < MT) { const bf16x8 a = LDSFRAG(Am + (mt * 16 + lr) * 264 + kk); acc[mt][0] = MFMA16(a, b0, acc[mt][0]); acc[mt][1] = MFMA16(a, b1, acc[mt][1]); }
    }
    bf16_t* Yg = (bf16_t*)(p.ws + OFF_YG);
#pragma unroll
    for (int mt = 0; mt < 4; ++mt) if (mt < MT)
#pragma unroll
        for (int ct = 0; ct < 2; ++ct)
#pragma unroll
            for (int r = 0; r < 4; ++r) { const int chunk = mt * 16 + lq * 4 + r, t = wid * 2 + ct;
                Yg[(size_t)(tok0 + chunk * 16 + t) * 512 + g * 16 + lr] = f2bf(gelu_tanh(acc[mt][ct][r])); }
    __syncthreads();
}
__device__ void job_mlaprep(const Params& p, int l, int j) {
    const int tid = tid_opaque(), wid = tid >> 6, lane = tid & 63, row = j * 8 + wid;
    const bf16_t* z = (const bf16_t*)(p.ws + OFF_Z) + (size_t)row * LDZ;
    float q[6], kv[4]; float sq = 0.f, sk = 0.f;
#pragma unroll
    for (int i = 0; i < 6; ++i) { q[i] = bf2f(z[ZMQ + i * 64 + lane]); sq += q[i] * q[i]; }
#pragma unroll
    for (int i = 0; i < 4; ++i) { kv[i] = bf2f(z[ZMKV + i * 64 + lane]); sk += kv[i] * kv[i]; }
#pragma unroll
    for (int o = 1; o < 64; o <<= 1) { sq += __shfl_xor(sq, o); sk += __shfl_xor(sk, o); }
    const float rq = rsqrtf(sq * (1.f / 384.f) + 1e-6f), rk = rsqrtf(sk * (1.f / 256.f) + 1e-6f);
    bf16_t* aq = (bf16_t*)(p.ws + OFF_AQ) + (size_t)row * 384; bf16_t* ck = (bf16_t*)(p.ws + OFF_CKVN) + (size_t)row * 256;
#pragma unroll
    for (int i = 0; i < 6; ++i) aq[i * 64 + lane] = f2bf(q[i] * rq * p.in[I_QNORM][l * 384 + i * 64 + lane]);
    const bool prompt = row < 4096; const int b = row >> 8, t = row & 255;
#pragma unroll
    for (int i = 0; i < 4; ++i) { const float v = kv[i] * rk * p.in[I_KVNORM][l * 256 + i * 64 + lane]; ck[i * 64 + lane] = f2bf(v);
        if (prompt) p.out[OUT_CKV + ((size_t)((b * 2 + l) * 256 + t)) * 256 + i * 64 + lane] = v; }
    if (prompt && lane < 32) p.out[OUT_KR + ((size_t)((b * 2 + l) * 256 + t)) * 32 + lane] = bf2f(z[ZMKR + lane]);
}
__device__ __forceinline__ float logsigmoidf_(float x) { return fminf(x, 0.f) - log1pf(expf(-fabsf(x))); }
__device__ void job_glaA(const Params& p, int l, int j, lds_t lds) {
    const int tid = tid_opaque(), wid = tid >> 6, lane = tid & 63, lr = lane & 15, lq = lane >> 4;
    const int ck = j >> 2, h = j & 3, tok0 = ck * 64;
    LAS bf16_t* QDf = (LAS bf16_t*)lds; LAS bf16_t* QDb = QDf + 4608; LAS bf16_t* KDf = QDb + 4608; LAS bf16_t* KDb = KDf + 4608; LAS bf16_t* KRf = KDb + 4608; LAS bf16_t* KRb = KRf + 4608;
    LAS bf16_t* VT = KRb + 4608;
    LAS bf16_t* ATT = VT + 9216;
    LAS float* GA = (LAS float*)(ATT + 4608);
    LAS float* TOT = GA + 2048;
    const bf16_t* Z = (const bf16_t*)(p.ws + OFF_Z);
    { const int c = tid >> 3, part = tid & 7; const u32x2 gv = *(const u32x2*)(Z + (size_t)(tok0 + c) * LDZ + ZGA + part * 4);
      GA[c * 32 + part * 4 + 0] = lo16(gv.x); GA[c * 32 + part * 4 + 1] = hi16(gv.x); GA[c * 32 + part * 4 + 2] = lo16(gv.y); GA[c * 32 + part * 4 + 3] = hi16(gv.y);
      const bf16_t* vp = Z + (size_t)(tok0 + c) * LDZ + ZV + h * 128 + part * 16;
      const u32x4 v0 = *(const u32x4*)vp, v1 = *(const u32x4*)(vp + 8);
      const unsigned w[8] = { v0.x, v0.y, v0.z, v0.w, v1.x, v1.y, v1.z, v1.w };
#pragma unroll
      for (int i = 0; i < 8; ++i) { VT[(part * 16 + 2 * i) * 72 + c] = (bf16_t)(w[i] & 0xffffu); VT[(part * 16 + 2 * i + 1) * 72 + c] = (bf16_t)(w[i] >> 16); } }
    __syncthreads();
    const int d = tid & 63, cg_ = tid >> 6;
    float laf[8], lab[8];
    { float wf[16], wb[16];
#pragma unroll
      for (int r = 0; r < 16; ++r) { wf[r] = p.in[I_WA2][((size_t)((l * 2 + 0) * 16 + r)) * 256 + h * 64 + d]; wb[r] = p.in[I_WA2][((size_t)((l * 2 + 1) * 16 + r)) * 256 + h * 64 + d]; }
      const float bf_ = p.in[I_BA][(l * 2 + 0) * 256 + h * 64 + d], bb_ = p.in[I_BA][(l * 2 + 1) * 256 + h * 64 + d];
#pragma unroll
      for (int i = 0; i < 8; ++i) { const int c = cg_ * 8 + i; float xf = bf_, xb = bb_;
#pragma unroll
          for (int r = 0; r < 16; ++r) { xf += GA[c * 32 + r] * wf[r]; xb += GA[c * 32 + 16 + r] * wb[r]; }
          laf[i] = logsigmoidf_(xf) * (1.f / 16.f); lab[i] = logsigmoidf_(xb) * (1.f / 16.f); } }
#pragma unroll
    for (int i = 1; i < 8; ++i) laf[i] += laf[i - 1];
#pragma unroll
    for (int i = 6; i >= 0; --i) lab[i] += lab[i + 1];
    TOT[(0 * 8 + cg_) * 64 + d] = laf[7]; TOT[(1 * 8 + cg_) * 64 + d] = lab[0];
    __syncthreads();
    float offf = 0.f, offb = 0.f, Tf = 0.f, Tb = 0.f;
#pragma unroll
    for (int g = 0; g < 8; ++g) { const float a = TOT[g * 64 + d], b = TOT[(8 + g) * 64 + d]; Tf += a; Tb += b; if (g < cg_) offf += a; if (g > cg_) offb += b; }
    bf16_t* QD = (bf16_t*)(p.ws + OFF_QD);
#pragma unroll
    for (int i = 0; i < 8; ++i) { const int c = cg_ * 8 + i; const size_t zr = (size_t)(tok0 + c) * LDZ;
        const float q = bf2f(Z[zr + ZQ + h * 64 + d]) * 0.125f, k = bf2f(Z[zr + ZK + h * 64 + d]);
        const float bf_ = offf + laf[i], bb_ = offb + lab[i];
        const bf16_t qf = f2bf(q * expf(bf_)), qb = f2bf(q * expf(bb_));
        QDf[c * 72 + d] = qf; QDb[c * 72 + d] = qb;
        KDf[c * 72 + d] = f2bf(k * expf(-bf_)); KDb[c * 72 + d] = f2bf(k * expf(-bb_));
        KRf[d * 72 + c] = f2bf(k * expf(Tf - bf_)); KRb[d * 72 + c] = f2bf(k * expf(Tb - bb_));
        QD[(size_t)(tok0 + c) * 256 + h * 64 + d] = qf; QD[(size_t)(8192 + tok0 + c) * 256 + h * 64 + d] = qb; }
    if (cg_ == 0) { float* DEC = (float*)(p.ws + OFF_DEC); DEC[((0 * 128 + ck) * 4 + h) * 64 + d] = expf(Tf); DEC[((1 * 128 + ck) * 4 + h) * 64 + d] = expf(Tb); }
    __syncthreads();
#pragma unroll
    for (int q2 = 0; q2 < 2; ++q2) { const int tt = wid * 2 + q2, ti = tt >> 2, tj = tt & 3; f32x4 af = {0.f, 0.f, 0.f, 0.f}, ab = af;
#pragma unroll
        for (int ks = 0; ks < 2; ++ks) { const int ko = ks * 32 + lq * 8;
            af = MFMA16(LDSFRAG(QDf + (ti * 16 + lr) * 72 + ko), LDSFRAG(KDf + (tj * 16 + lr) * 72 + ko), af);
            ab = MFMA16(LDSFRAG(QDb + (ti * 16 + lr) * 72 + ko), LDSFRAG(KDb + (tj * 16 + lr) * 72 + ko), ab); }
#pragma unroll
        for (int r = 0; r < 4; ++r) { const int c = ti * 16 + lq * 4 + r, s = tj * 16 + lr; const float v = (s <= c ? af[r] : 0.f) + (s >= c ? ab[r] : 0.f); ATT[c * 72 + s] = f2bf(v); } }
    __syncthreads();
    bf16x8 vb[2];
#pragma unroll
    for (int ks = 0; ks < 2; ++ks) vb[ks] = LDSFRAG(VT + (wid * 16 + lr) * 72 + ks * 32 + lq * 8);
    float* OI = (float*)(p.ws + OFF_HB); float* KV = (float*)(p.ws + OFF_KV);
#pragma unroll
    for (int ct = 0; ct < 4; ++ct) { f32x4 a = {0.f, 0.f, 0.f, 0.f};
#pragma unroll
        for (int ks = 0; ks < 2; ++ks) a = MFMA16(LDSFRAG(ATT + (ct * 16 + lr) * 72 + ks * 32 + lq * 8), vb[ks], a);
#pragma unroll
        for (int r = 0; r < 4; ++r) OI[(size_t)(tok0 + ct * 16 + lq * 4 + r) * 512 + h * 128 + wid * 16 + lr] = a[r]; }
#pragma unroll
    for (int dir = 0; dir < 2; ++dir) { const LAS bf16_t* KR = dir == 0 ? KRf : KRb; float* kvp = KV + ((size_t)((dir * 128 + ck) * 4 + h)) * 8192;
#pragma unroll
        for (int dt = 0; dt < 4; ++dt) { f32x4 a = {0.f, 0.f, 0.f, 0.f};
#pragma unroll
            for (int ks = 0; ks < 2; ++ks) a = MFMA16(LDSFRAG(KR + (dt * 16 + lr) * 72 + ks * 32 + lq * 8), vb[ks], a);
#pragma unroll
            for (int r = 0; r < 4; ++r) kvp[(dt * 16 + lq * 4 + r) * 128 + wid * 16 + lr] = a[r]; } }
    __syncthreads();
}

__device__ void job_glaB(const Params& p, int l, int j) {
    const int slab = j & 15, h = (j >> 4) & 3, rest = j >> 6, bb = rest % 20, dir = rest / 20;
    const int idx = slab * 512 + tid_opaque(), d = idx >> 7;
    const int nck = bb < 16 ? 4 : 16, ck0 = bb < 16 ? bb * 4 : 64 + (bb - 16) * 16;
    float S = 0.f;
    if (bb >= 16) S = p.in[I_SGLA][((size_t)((((bb - 16) * 2 + l) * 2 + dir) * 4 + h)) * 8192 + idx];
    const float* KV = (const float*)(p.ws + OFF_KV); const float* DEC = (const float*)(p.ws + OFF_DEC); bf16_t* ST = (bf16_t*)(p.ws + OFF_ST);
    for (int i = 0; i < nck; ++i) { const int ck = dir == 0 ? ck0 + i : ck0 + nck - 1 - i; const size_t it = (size_t)((dir * 128 + ck) * 4 + h);
        ST[it * 8192 + idx] = f2bf(S); S = DEC[it * 64 + d] * S + KV[it * 8192 + idx]; }
    if (bb < 16) p.out[OUT_GLA + ((size_t)(((bb * 2 + l) * 2 + dir) * 4 + h)) * 8192 + idx] = S;
}

__device__ void job_glaC(const Params& p, int l, int j, lds_t lds) {
    const int tid = tid_opaque(), wid = tid >> 6, lane = tid & 63, lr = lane & 15, lq = lane >> 4;
    const int ck = j >> 2, h = j & 3, tok0 = ck * 64;
    LAS bf16_t* Aq = (LAS bf16_t*)lds;
    LAS bf16_t* BT = Aq + 64 * 136;
    LAS float* Os = (LAS float*)(BT + 128 * 136);
    const bf16_t* QD = (const bf16_t*)(p.ws + OFF_QD); const bf16_t* ST = (const bf16_t*)(p.ws + OFF_ST);
#pragma unroll
    for (int it = 0; it < 2; ++it) { const int idx = tid + it * 512, c = idx >> 4, rem = idx & 15, dir = rem >> 3, dc = rem & 7;
        *(LAS u32x4*)(Aq + c * 136 + dir * 64 + dc * 8) = *(const u32x4*)(QD + (size_t)(dir * 8192 + tok0 + c) * 256 + h * 64 + dc * 8); }
#pragma unroll
    for (int it = 0; it < 4; ++it) { const int idx = tid + it * 512, dir = idx >> 10, d = (idx >> 4) & 63, ec = idx & 15;
        const u32x4 v = *(const u32x4*)(ST + ((size_t)((dir * 128 + ck) * 4 + h)) * 8192 + d * 128 + ec * 8);
        const unsigned w[4] = { v.x, v.y, v.z, v.w };
#pragma unroll
        for (int i = 0; i < 4; ++i) { BT[(ec * 8 + 2 * i) * 136 + dir * 64 + d] = (bf16_t)(w[i] & 0xffffu); BT[(ec * 8 + 2 * i + 1) * 136 + dir * 64 + d] = (bf16_t)(w[i] >> 16); } }
    __syncthreads();
    const int ct = wid & 3, eh = wid >> 2; const float* OI = (const float*)(p.ws + OFF_HB);
    bf16x8 af[4];
#pragma unroll
    for (int ks = 0; ks < 4; ++ks) af[ks] = LDSFRAG(Aq + (ct * 16 + lr) * 136 + ks * 32 + lq * 8);
#pragma unroll
    for (int e4 = 0; e4 < 4; ++e4) { const int et = eh * 4 + e4; f32x4 a = {0.f, 0.f, 0.f, 0.f};
#pragma unroll
        for (int ks = 0; ks < 4; ++ks) a = MFMA16(af[ks], LDSFRAG(BT + (et * 16 + lr) * 136 + ks * 32 + lq * 8), a);
#pragma unroll
        for (int r = 0; r < 4; ++r) { const int row = ct * 16 + lq * 4 + r, col = et * 16 + lr; Os[row * 132 + col] = a[r] + OI[(size_t)(tok0 + row) * 512 + h * 128 + col]; } }
    __syncthreads();
    { const int c = tid >> 3, part = tid & 7; float o[16]; float ss = 0.f;
#pragma unroll
      for (int i = 0; i < 16; ++i) { o[i] = Os[c * 132 + part * 16 + i]; ss += o[i] * o[i]; }
      ss += __shfl_xor(ss, 1); ss += __shfl_xor(ss, 2); ss += __shfl_xor(ss, 4);
      const float rstd = rsqrtf(ss * (1.f / 128.f) + 1e-6f);
      const bf16_t* gz = (const bf16_t*)(p.ws + OFF_Z) + (size_t)(tok0 + c) * LDZ + ZGG + h * 128 + part * 16;
      const u32x4 g0 = *(const u32x4*)gz, g1 = *(const u32x4*)(gz + 8);
      const unsigned gw[8] = { g0.x, g0.y, g0.z, g0.w, g1.x, g1.y, g1.z, g1.w };
      unsigned ow[8];
#pragma unroll
      for (int i = 0; i < 8; ++i) { const float n0 = p.in[I_ONORM][l * 128 + part * 16 + 2 * i], n1 = p.in[I_ONORM][l * 128 + part * 16 + 2 * i + 1];
          ow[i] = pk2(o[2 * i] * rstd * n0 * siluf_(lo16(gw[i])), o[2 * i + 1] * rstd * n1 * siluf_(hi16(gw[i]))); }
      bf16_t* ap = (bf16_t*)(p.ws + OFF_AGLA) + (size_t)(tok0 + c) * 512 + h * 128 + part * 16;
      *(u32x4*)ap = (u32x4){ow[0], ow[1], ow[2], ow[3]}; *(u32x4*)(ap + 8) = (u32x4){ow[4], ow[5], ow[6], ow[7]}; }
    __syncthreads();
}
__device__ __forceinline__ void head_row_finish(float (&x)[16], int p8, const float* nw, bool rope, int pos, const float* R, float mul, LAS bf16_t* dst) {
    float ss = 0.f; const int cnt = p8 < 4 ? 16 : 8;
#pragma unroll
    for (int i = 0; i < 16; ++i) if (i < cnt) ss += x[i] * x[i];
    ss += __shfl_xor(ss, 1); ss += __shfl_xor(ss, 2); ss += __shfl_xor(ss, 4);
    const float rstd = rsqrtf(ss * (1.f / 96.f) + 1e-6f) * mul;
    if (p8 < 4) { unsigned w[8];
#pragma unroll
        for (int i = 0; i < 8; ++i) w[i] = pk2(x[2 * i] * rstd * nw[p8 * 16 + 2 * i], x[2 * i + 1] * rstd * nw[p8 * 16 + 2 * i + 1]);
        *(LAS u32x4*)(dst + p8 * 16) = (u32x4){w[0], w[1], w[2], w[3]}; *(LAS u32x4*)(dst + p8 * 16 + 8) = (u32x4){w[4], w[5], w[6], w[7]};
    } else { const int i0 = (p8 - 4) * 4; float o1[4], o2[4];
#pragma unroll
        for (int i = 0; i < 4; ++i) { const float a = x[i] * rstd * nw[64 + i0 + i], b = x[4 + i] * rstd * nw[80 + i0 + i];
            if (rope) { const float c = R[pos * 16 + i0 + i], s = R[16384 + pos * 16 + i0 + i]; o1[i] = a * c - b * s; o2[i] = a * s + b * c; } else { o1[i] = a; o2[i] = b; } }
        *(LAS u32x2*)(dst + 64 + i0) = (u32x2){pk2(o1[0], o1[1]), pk2(o1[2], o1[3])}; *(LAS u32x2*)(dst + 80 + i0) = (u32x2){pk2(o2[0], o2[1]), pk2(o2[2], o2[3])}; }
}
__device__ __forceinline__ void ld16bf(const bf16_t* s, float (&x)[16]) { const u32x4 a = *(const u32x4*)s, b = *(const u32x4*)(s + 8);
    x[0] = lo16(a.x); x[1] = hi16(a.x); x[2] = lo16(a.y); x[3] = hi16(a.y); x[4] = lo16(a.z); x[5] = hi16(a.z); x[6] = lo16(a.w); x[7] = hi16(a.w);
    x[8] = lo16(b.x); x[9] = hi16(b.x); x[10] = lo16(b.y); x[11] = hi16(b.y); x[12] = lo16(b.z); x[13] = hi16(b.z); x[14] = lo16(b.w); x[15] = hi16(b.w); }
__device__ __forceinline__ void ld4bf(const bf16_t* s, float* x) { const u32x2 a = *(const u32x2*)s; x[0] = lo16(a.x); x[1] = hi16(a.x); x[2] = lo16(a.y); x[3] = hi16(a.y); }
__device__ void job_attn(const Params& p, int l, int j, lds_t lds) {
    const int tid = tid_opaque(), wid = tid >> 6, lane = tid & 63, lr = lane & 15, lq = lane >> 4;
    const bool smp = j < 256; int b, h, qb; if (smp) { b = j >> 6; h = (j >> 4) & 3; qb = j & 15; } else { const int jj = j - 256; b = jj >> 4; h = (jj >> 2) & 3; qb = jj & 3; }
    const int qtok0 = smp ? 4096 + b * 1024 + qb * 64 : b * 256 + qb * 64; const int nkt = smp ? 12 : 2;
    LAS bf16_t* Ks = (LAS bf16_t*)lds;
    LAS bf16_t* VTs = Ks + 128 * 104;
    LAS bf16_t* Ps = VTs + 128 * 136 + wid * 16 * 72;
    LAS float* Mg = (LAS float*)(lds + (128 * 104 + 128 * 136 + 8 * 16 * 72) * 2);
    const bf16_t* Z = (const bf16_t*)(p.ws + OFF_Z); const bf16_t* KN = (const bf16_t*)(p.ws + OFF_KN); const bf16_t* Vb = (const bf16_t*)(p.ws + OFF_V); const float* R = (const float*)(p.ws + OFF_ROPE);
    const float* qhn = p.in[I_QHNORM] + l * 96; const float* khn = p.in[I_KHNORM] + l * 96;
    { const int row = tid >> 3, p8 = tid & 7, tok = qtok0 + row; const bf16_t* qr = (const bf16_t*)(p.ws + OFF_QRAW) + (size_t)tok * 384 + h * 96; float x[16];
      if (p8 < 4) ld16bf(qr + p8 * 16, x); else { ld4bf(qr + 64 + (p8 - 4) * 4, x); ld4bf(qr + 80 + (p8 - 4) * 4, x + 4); }
      head_row_finish(x, p8, qhn, smp, qb * 64 + row, R, 0.10206207261596575f * 1.4426950408889634f, Ks + row * 104); }
    __syncthreads();
    const int rt = wid & 3, kh = wid >> 2;
    bf16x8 qa[3];
#pragma unroll
    for (int ks = 0; ks < 3; ++ks) qa[ks] = LDSFRAG(Ks + (rt * 16 + lr) * 104 + ks * 32 + lq * 8);
    __syncthreads();
    f32x4 oacc[8]; float mrow[4], lrow[4];
#pragma unroll
    for (int e = 0; e < 8; ++e) oacc[e] = (f32x4){0.f, 0.f, 0.f, 0.f};
#pragma unroll
    for (int r = 0; r < 4; ++r) { mrow[r] = -1e30f; lrow[r] = 0.f; }
    for (int kt = 0; kt < nkt; ++kt) {
#pragma unroll 1
        for (int ps = 0; ps < 2; ++ps) { const int key = ps * 64 + (tid >> 3), p8 = tid & 7, jk = kt * 128 + key; float x[16]; int knrow; bool rope = false; int pos = 0; const float* krf = nullptr;
            if (smp) { if (jk < 512) { knrow = 8192 + b * 512 + jk; krf = p.in[I_CKR] + ((size_t)((b * 2 + l) * 512 + jk)) * 32; } else { pos = jk - 512; knrow = 4096 + b * 1024 + pos; rope = true; } }
            else knrow = b * 256 + jk;
            if (p8 < 4) ld16bf(KN + (size_t)knrow * 256 + h * 64 + p8 * 16, x);
            else if (krf) { const f32x4 a = *(const f32x4*)(krf + (p8 - 4) * 4), c = *(const f32x4*)(krf + 16 + (p8 - 4) * 4); x[0] = a[0]; x[1] = a[1]; x[2] = a[2]; x[3] = a[3]; x[4] = c[0]; x[5] = c[1]; x[6] = c[2]; x[7] = c[3]; }
            else { const bf16_t* kr = Z + (size_t)knrow * LDZ + ZMKR; ld4bf(kr + (p8 - 4) * 4, x); ld4bf(kr + 16 + (p8 - 4) * 4, x + 4); }
            head_row_finish(x, p8, khn, rope, pos, R, 1.f, Ks + key * 104); }
        { const int key = tid >> 2, part = tid & 3, jk = kt * 128 + key; int vrow;
          if (smp) vrow = jk < 512 ? 8192 + b * 512 + jk : 4096 + b * 1024 + (jk - 512); else vrow = b * 256 + jk;
          const bf16_t* vp = Vb + (size_t)vrow * 512 + h * 128 + part * 32;
#pragma unroll 1
          for (int c4 = 0; c4 < 4; ++c4) { const u32x4 v = *(const u32x4*)(vp + c4 * 8); const unsigned w[4] = { v.x, v.y, v.z, v.w };
#pragma unroll
              for (int i = 0; i < 4; ++i) { const int e = part * 32 + c4 * 8 + 2 * i; VTs[e * 136 + key] = (bf16_t)(w[i] & 0xffffu); VTs[(e + 1) * 136 + key] = (bf16_t)(w[i] >> 16); } } }
        __syncthreads();
        const int kbase = kh * 64;
        f32x4 sacc[4];
#pragma unroll
        for (int nt = 0; nt < 4; ++nt) { sacc[nt] = (f32x4){0.f, 0.f, 0.f, 0.f};
#pragma unroll
            for (int ks = 0; ks < 3; ++ks) sacc[nt] = MFMA16(qa[ks], LDSFRAG(Ks + (kbase + nt * 16 + lr) * 104 + ks * 32 + lq * 8), sacc[nt]); }
        float alpha[4];
#pragma unroll
        for (int r = 0; r < 4; ++r) { float mx = fmaxf(fmaxf(sacc[0][r], sacc[1][r]), fmaxf(sacc[2][r], sacc[3][r]));
            mx = fmaxf(mx, __shfl_xor(mx, 1)); mx = fmaxf(mx, __shfl_xor(mx, 2)); mx = fmaxf(mx, __shfl_xor(mx, 4)); mx = fmaxf(mx, __shfl_xor(mx, 8));
            const float mn = fmaxf(mrow[r], mx); alpha[r] = exp2f(mrow[r] - mn); mrow[r] = mn; float rs = 0.f;
#pragma unroll
            for (int nt = 0; nt < 4; ++nt) { const float pv = exp2f(sacc[nt][r] - mn); rs += pv; Ps[(lq * 4 + r) * 72 + nt * 16 + lr] = f2bf(pv); }
            lrow[r] = lrow[r] * alpha[r] + rs; }
#pragma unroll
        for (int e = 0; e < 8; ++e) { oacc[e][0] *= alpha[0]; oacc[e][1] *= alpha[1]; oacc[e][2] *= alpha[2]; oacc[e][3] *= alpha[3]; }
        asm volatile("s_waitcnt lgkmcnt(0)" ::: "memory");
#pragma unroll
        for (int k2 = 0; k2 < 2; ++k2) { const bf16x8 pa = LDSFRAG(Ps + lr * 72 + k2 * 32 + lq * 8);
#pragma unroll
            for (int e = 0; e < 8; ++e) oacc[e] = MFMA16(pa, LDSFRAG(VTs + (e * 16 + lr) * 136 + kbase + k2 * 32 + lq * 8), oacc[e]); }
        __syncthreads();
    }
#pragma unroll
    for (int r = 0; r < 4; ++r) { float s = lrow[r]; s += __shfl_xor(s, 1); s += __shfl_xor(s, 2); s += __shfl_xor(s, 4); s += __shfl_xor(s, 8); lrow[r] = s; }
    LAS float* Mo = Mg + rt * 16 * 132; LAS float* Ml = Mg + 4 * 16 * 132 + rt * 32;
    if (kh == 1) {
#pragma unroll
        for (int e = 0; e < 8; ++e)
#pragma unroll
            for (int r = 0; r < 4; ++r) Mo[(lq * 4 + r) * 132 + e * 16 + lr] = oacc[e][r];
        if (lr == 0) {
#pragma unroll
            for (int r = 0; r < 4; ++r) { Ml[(lq * 4 + r) * 2] = mrow[r]; Ml[(lq * 4 + r) * 2 + 1] = lrow[r]; } }
    }
    __syncthreads();
    if (kh == 0) { bf16_t* AM = (bf16_t*)(p.ws + OFF_AMLA);
#pragma unroll
        for (int r = 0; r < 4; ++r) { const int row = lq * 4 + r; const float m2 = Ml[row * 2], l2 = Ml[row * 2 + 1]; const float mm = fmaxf(mrow[r], m2), a1 = exp2f(mrow[r] - mm), a2 = exp2f(m2 - mm);
            const float inv = 1.f / (lrow[r] * a1 + l2 * a2); const int tok = qtok0 + rt * 16 + row;
#pragma unroll
            for (int e = 0; e < 8; ++e) { const int col = e * 16 + lr; const float o = (oacc[e][r] * a1 + Mo[row * 132 + col] * a2) * inv;
                const float gt = bf2f(Z[(size_t)tok * LDZ + ZMG + h * 128 + col]); AM[(size_t)tok * 512 + h * 128 + col] = f2bf(o * siluf_(gt)); } } }
    __syncthreads();
}

constexpr int N_PHASES = 15;
#ifndef S3M
#define S3M 15
#endif
#ifndef ONLY_S
#define ONLY_S -1
#endif
__device__ __forceinline__ void run_phase(const Params& p, int ph, lds_t lds) {
    const int G = (int)gridDim.x, bid = (int)blockIdx.x;
    if (ph == 0 && (ONLY_S < 0 || ONLY_S == 7)) {
        for (int j = bid; j < 96 + 256 + 32; j += G) { if (j < 96) job_ada(p, j, lds); else if (j < 352) job_ctx(p, j - 96); else job_rope(p, j - 352); }
        return;
    }
    const int l = (ph - 1) / 7, s = (ph - 1) % 7;
    unsigned char* ws = p.ws;
    if (s == 0 && (ONLY_S < 0 || ONLY_S == 0)) {
        for (int j = bid; j < 96 + WT_TOTAL + 1024; j += G) { if (j < 96) job_s5setup(p, l, j, lds); else if (j < 96 + WT_TOTAL) job_wt(p, l, j - 96, lds); else job_prep(p, l, j - 96 - WT_TOTAL); }
    } else if (s == 1 && (ONLY_S < 0 || ONLY_S == 1)) {
        Order S; S.setup(8192, 6912, 0); pg8::Gemm g{(const bf16_t*)(ws + OFF_HB), (const bf16_t*)(ws + OFF_WIN), 8192, 6912, 1024}; EpiZ E{(bf16_t*)(ws + OFF_Z)};
        pg8::gemm_phase<EpiZ, Order>(lds, g, S, E, nullptr);
    } else if (s == 2 && (ONLY_S < 0 || ONLY_S == 2)) {
        for (int j = bid; j < 640 + 512 + 1024; j += G) { if (j < 640) job_s5(p, l, j, lds); else if (j < 1152) job_glaA(p, l, j - 640, lds); else job_mlaprep(p, l, j - 1152); }
    } else if (s == 3 && (ONLY_S < 0 || ONLY_S == 3)) {
        if (S3M & 1) for (int j = bid; j < 2560; j += G) job_glaB(p, l, j);
        if (S3M & 2) { Order S; S.setup(8192, 1024, 0); pg8::Gemm g{(const bf16_t*)(ws + OFF_YG), (const bf16_t*)(ws + OFF_WGLU), 8192, 1024, 512}; EpiGLU E{(bf16_t*)(ws + OFF_AS5), (const bf16_t*)(ws + OFF_Z), p.in[I_BGLU] + l * 1024};
          pg8::gemm_phase<EpiGLU, Order>(lds, g, S, E, nullptr); }
        if (S3M & 4) { Order S; S.setup(10240, 768, 128); pg8::Gemm g{(const bf16_t*)(ws + (l == 0 ? OFF_CTX0 : OFF_CKVN)), (const bf16_t*)(ws + OFF_WKV), 10240, 768, 256}; EpiKV E{(bf16_t*)(ws + OFF_KN), (bf16_t*)(ws + OFF_V), l};
          pg8::gemm_phase<EpiKV, Order>(lds, g, S, E, nullptr); }
        if (S3M & 8) { Order S; S.setup(8192, 512, 248); pg8::Gemm g{(const bf16_t*)(ws + OFF_AQ), (const bf16_t*)(ws + OFF_WUQ), 8192, 512, 384}; EpiQ E{(bf16_t*)(ws + OFF_QRAW)};
          pg8::gemm_phase<EpiQ, Order>(lds, g, S, E, nullptr); }
    } else if (s == 4 && (ONLY_S < 0 || ONLY_S == 4)) {
        for (int j = bid; j < 512 + 512; j += G) { if (j < 512) job_attn(p, l, j, lds); else job_glaC(p, l, j - 512, lds); }
    } else if (s == 5 && (ONLY_S < 0 || ONLY_S == 5)) {
        for (int br = 0; br < 3; ++br) { Order S; S.setup(8192, 1024, 0);
            pg8::Gemm g{(const bf16_t*)(ws + (br == 0 ? OFF_AGLA : br == 1 ? OFF_AMLA : OFF_AS5)), (const bf16_t*)(ws + OFF_WBO) + (size_t)br * 1024 * 512, 8192, 1024, 512};
            EpiBo E{(bf16_t*)(ws + OFF_HB), (const bf16_t*)(ws + OFF_Z), br};
            pg8::gemm_phase<EpiBo, Order>(lds, g, S, E, nullptr); }
    } else if (s == 6 && (ONLY_S < 0 || ONLY_S == 6)) {
        Order S; S.setup(8192, 1024, 0); pg8::Gemm g{(const bf16_t*)(ws + OFF_HB), (const bf16_t*)(ws + OFF_WOUT), 8192, 1024, 1024};
        EpiOut E{p.out, l == 0 ? p.in[I_XP] : p.out, l == 0 ? p.in[I_XS] : p.out + (size_t)4096 * 1024, (const float*)(ws + OFF_ADA) + l * 5 * 3072};
        pg8::gemm_phase<EpiOut, Order>(lds, g, S, E, nullptr);
    }
}
__global__ __launch_bounds__(512, 2) void mega(KParams kp, int ph0, int ph1) {
    extern __shared__ __attribute__((aligned(16))) unsigned char shm[];
    lds_t lds = (lds_t)shm;
    if (threadIdx.x < N_IN) ((const float**)(kp.ws + OFF_TBL))[threadIdx.x] = kp.in[threadIdx.x];
    __threadfence(); __syncthreads();
    for (int ph = ph0; ph < ph1; ++ph) {
        Params p; { const float* const* tb = (const float* const*)(kp.ws + OFF_TBL); float* o = kp.out; unsigned char* w = kp.ws; asm volatile("" : "+s"(tb), "+s"(o), "+s"(w)); p.in = tb; p.out = o; p.ws = w; }
        run_phase(p, ph, lds);
        if (ph + 1 < ph1) { __syncthreads(); cg::this_grid().sync(); }
    }
}

#ifndef N_LAUNCH_MODE
#define N_LAUNCH_MODE 0
#endif
extern "C" void kernel_launch(void* const* d_in, const int* in_sizes, int n_in, void* d_out, int out_size, void* d_ws, size_t ws_size, hipStream_t stream) {
    static int grid = 0;
    if (grid == 0) {
        if (n_in != N_IN || ws_size < WS_END) { fprintf(stderr, "kernel_launch: unexpected n_in %d / ws %zu (need %zu)\n", n_in, ws_size, (size_t)WS_END); grid = -1; return; }
        int dev = 0, cus = 0, per_cu = 0;
        hipGetDevice(&dev); hipDeviceGetAttribute(&cus, hipDeviceAttributeMultiprocessorCount, dev);
        hipFuncSetAttribute((const void*)mega, hipFuncAttributeMaxDynamicSharedMemorySize, DYN_LDS);
        hipOccupancyMaxActiveBlocksPerMultiprocessor(&per_cu, (const void*)mega, 512, DYN_LDS);
        if (per_cu < 1) { fprintf(stderr, "kernel_launch: occupancy query says %d blocks per CU\n", per_cu); per_cu = 1; }
        (void)hipGetLastError();
        grid = cus;
    }
    if (grid < 0) return;
    KParams p{};
    for (int i = 0; i < N_IN; ++i) p.in[i] = (const float*)d_in[i];
    p.out = (float*)d_out; p.ws = (unsigned char*)d_ws;
#if N_LAUNCH_MODE == 0
    for (int ph = 0; ph < N_PHASES; ++ph) { hipLaunchKernelGGL(mega, dim3(grid), dim3(512), DYN_LDS, stream, p, ph, ph + 1); }
#else
    int ph0 = 0, ph1 = N_PHASES; void* args[] = {&p, &ph0, &ph1};
    hipError_t e = hipLaunchCooperativeKernel((const void*)mega, dim3(grid), dim3(512), args, DYN_LDS, stream);
    if (e != hipSuccess) fprintf(stderr, "cooperative launch failed: %s (grid %d)\n", hipGetErrorString(e), grid);
#endif
}
```

```cpp
#include <hip/hip_runtime.h>
#include <hip/hip_cooperative_groups.h>
#include <cstdio>
namespace cg = cooperative_groups;
namespace pg8 {
#define PG8_LAS __attribute__((address_space(3)))
typedef unsigned short bf16_t;
typedef short bf16x8 __attribute__((ext_vector_type(8)));
typedef float f32x4 __attribute__((ext_vector_type(4)));
typedef unsigned u32x4 __attribute__((ext_vector_type(4)));
constexpr int BM = 256, BK = 64, HALF = 128, HTB = HALF * BK * 2  , STAGE_BYTES = 8 * HTB, NXCD = 8, WGM = 8;

__host__ __device__ __forceinline__ int lds_byte(int r, int c) { const int st = (r >> 4) * 2 + (c >> 5), rr = r & 15, cc = c & 31, ob = rr * 64 + cc * 2; return st * 1024 + (ob ^ (((ob >> 9) & 1) << 5)); }
__host__ __device__ __forceinline__ void stage_rc(int b, int& R, int& C) { const int st = b / 1024, sb = b % 1024, swz = sb ^ (((sb >> 9) & 1) << 5); R = (st >> 1) * 16 + swz / 64; C = (st & 1) * 32 + (swz % 64) / 2; }
__host__ __device__ __forceinline__ int perm32(int rho) { const int n = rho >> 4, i = rho & 15; return 8 * (i >> 2) + 4 * n + (i & 3); }

struct Unit { int pm, pn; };
struct Gemm { const bf16_t* A; const bf16_t* Bt; int M, N, K; };

struct StaticOrder {
    int nM, nN, nwg, G, c;
    __host__ __device__ void init(int M, int N, int G_, int c_) { nM = M / BM; nN = N / BM; nwg = nM * nN; G = G_; c = c_; }
    __host__ __device__ bool next(int i, Unit& u) const {
        const long L = (long)i * G + c; if (L >= nwg) return false;
        int wgid = (int)L; { const int q = nwg / NXCD, r = nwg % NXCD, xcd = wgid % NXCD, off = wgid / NXCD; wgid = (xcd < r ? xcd * (q + 1) : r * (q + 1) + (xcd - r) * q) + off; }
        const int nig = WGM * nN, gid = wgid / nig, fm = gid * WGM, gsz = (nM - fm) < WGM ? (nM - fm) : WGM;
        u.pm = fm + ((wgid % nig) % gsz); u.pn = (wgid % nig) / gsz; return true;
    }
    __device__ __forceinline__ void a_ready(const Unit&) const {}
    __device__ __forceinline__ void done(const Unit&) const {}
};
__device__ __forceinline__ unsigned cvt_pk_bf16(float lo, float hi) { unsigned r; asm volatile("v_cvt_pk_bf16_f32 %0, %1, %2" : "=v"(r) : "v"(lo), "v"(hi)); return r; }
typedef float f32x2 __attribute__((ext_vector_type(2)));
template <class Epi, class Sched, bool STAMP = false>
__device__ __forceinline__ void gemm_phase(PG8_LAS unsigned char* lds, const Gemm g, const Sched& S, const Epi& E, unsigned long long* stamps) {
    int tid_ = (int)threadIdx.x; asm volatile("" : "+v"(tid_)); const int tid = tid_, wid = __builtin_amdgcn_readfirstlane(tid >> 6), lane = tid & 63, wr = wid >> 2, wc = wid & 3, fr = lane & 15, fq = lane >> 4;
    int K_ = g.K; asm volatile("" : "+s"(K_)); const int K = K_, nt = K / BK;
    int ts_lo = 0, ts_hi = 0, nts = 0; const unsigned long long rt_entry = STAMP ? (unsigned long long)wall_clock64() : 0ull;
#define PG8_STAMP() do { if (STAMP && wid == 0 && nts < 64) { const unsigned long long _c = (unsigned long long)clock64(); \
        ts_lo = (lane == nts) ? (int)(unsigned)_c : ts_lo; ts_hi = (lane == nts) ? (int)(unsigned)(_c >> 32) : ts_hi; ++nts; } } while (0)
    PG8_STAMP();
    unsigned voffA[2], voffB[2];
#pragma unroll
    for (int i = 0; i < 2; ++i) { int R, C; stage_rc(tid * 16 + i * 8192, R, C); const int Rb = Epi::PERM ? ((R & ~31) + perm32(R & 31)) : R;
        voffA[i] = (unsigned)(R * K + C) * 2u; voffB[i] = (unsigned)(Rb * K + C) * 2u; }
    const size_t kstep = (size_t)(BK * 2);
    const size_t hstep = (size_t)HALF * K * 2;
    const size_t tstep = 2 * hstep;
    const unsigned ldsw = (unsigned)wid * 1024u;
    const int aoff = lds_byte(wr * 64 + fr, fq * 8), boff = lds_byte(wc * 32 + fr, fq * 8);
#define PG8_SA(b, h) (((b) * 2 + (h)) * HTB)
#define PG8_SB(b, h) ((4 + (b) * 2 + (h)) * HTB)
#define PG8_STAGE(bufoff, gbase, voff) do { _Pragma("unroll") for (int _i = 0; _i < 2; ++_i) \
        __builtin_amdgcn_global_load_lds((const unsigned*)((const char*)(gbase) + (voff)[_i]), (PG8_LAS unsigned*)(lds + (bufoff) + ldsw + _i * 8192), 16, 0, 0); } while (0)
#define PG8_LDA(dst, b, h) do { _Pragma("unroll") for (int m = 0; m < 4; ++m) _Pragma("unroll") for (int k = 0; k < 2; ++k) dst[m][k] = *(const PG8_LAS bf16x8*)(lds + PG8_SA(b, h) + aoff + m * 2048 + k * 1024); } while (0)
#define PG8_LDB(dst, b, h) do { _Pragma("unroll") for (int n = 0; n < 2; ++n) _Pragma("unroll") for (int k = 0; k < 2; ++k) dst[n][k] = *(const PG8_LAS bf16x8*)(lds + PG8_SB(b, h) + boff + n * 2048 + k * 1024); } while (0)
#define PG8_MMA(ai, bj, At, Bt) do { __builtin_amdgcn_s_setprio(1); _Pragma("unroll") for (int m = 0; m < 4; ++m) _Pragma("unroll") for (int n = 0; n < 2; ++n) _Pragma("unroll") for (int k = 0; k < 2; ++k) \
        acc[ai][bj][m][n] = __builtin_amdgcn_mfma_f32_16x16x32_bf16(Bt[n][k], At[m][k], acc[ai][bj][m][n], 0, 0, 0); __builtin_amdgcn_s_setprio(0); } while (0)
#define PG8_WAIT_V(n) asm volatile("s_waitcnt vmcnt(" #n ")" ::: "memory")
#define PG8_WAIT_L(n) asm volatile("s_waitcnt lgkmcnt(" #n ")" ::: "memory")
#define PG8_BAR __builtin_amdgcn_s_barrier()
#define PG8_SCHED __builtin_amdgcn_sched_barrier(0)
    Unit cur, nxt; int ui = 0;
    if (!S.next(0, cur)) return;
    f32x4 acc[2][2][4][2];
#pragma unroll
    for (int a = 0; a < 2; ++a)
#pragma unroll
        for (int b = 0; b < 2; ++b)
#pragma unroll
            for (int m = 0; m < 4; ++m)
#pragma unroll
                for (int n = 0; n < 2; ++n) acc[a][b][m][n] = (f32x4){0.f, 0.f, 0.f, 0.f};
    bf16x8 At[4][2], B0[2][2], B1[2][2];
    const char* cA = (const char*)g.A + (size_t)cur.pm * tstep; const char* cB = (const char*)g.Bt + (size_t)cur.pn * tstep;
    S.a_ready(cur);
    PG8_STAGE(PG8_SB(0, 0), cB, voffB); PG8_STAGE(PG8_SA(0, 0), cA, voffA); PG8_STAGE(PG8_SB(0, 1), cB + hstep, voffB); PG8_STAGE(PG8_SA(0, 1), cA + hstep, voffA);
    if (wr == 1) PG8_BAR;
    PG8_WAIT_V(4); PG8_BAR;
    PG8_STAGE(PG8_SB(1, 0), cB + kstep, voffB); PG8_STAGE(PG8_SA(1, 0), cA + kstep, voffA); PG8_STAGE(PG8_SB(1, 1), cB + hstep + kstep, voffB);
    PG8_WAIT_V(6); PG8_BAR;
    PG8_STAMP();
    for (;;) {
        const bool has_next = S.next(ui + 1, nxt);
        const char* nA = has_next ? (const char*)g.A + (size_t)nxt.pm * tstep : cA; const char* nB = has_next ? (const char*)g.Bt + (size_t)nxt.pn * tstep : cB;
        for (int t = 0; t < nt; t += 2) {
            const bool last = (t == nt - 2);
            const char* a1 = cA + (size_t)(t + 1) * kstep;
            const char* a2 = last ? nA : cA + (size_t)(t + 2) * kstep; const char* b2 = last ? nB : cB + (size_t)(t + 2) * kstep;
            const char* a3 = a2 + kstep; const char* b3 = b2 + kstep;
            if (last && has_next) S.a_ready(nxt);
            PG8_LDB(B0, 0, 0); PG8_SCHED; PG8_LDA(At, 0, 0); PG8_STAGE(PG8_SA(1, 1), a1 + hstep, voffA);
            PG8_WAIT_L(8); PG8_BAR; PG8_WAIT_L(0); PG8_MMA(0, 0, At, B0); PG8_BAR; PG8_SCHED;
            PG8_LDB(B1, 0, 1); PG8_STAGE(PG8_SB(0, 0), b2, voffB);
            PG8_BAR; PG8_WAIT_L(0); PG8_MMA(0, 1, At, B1); PG8_BAR;
            PG8_LDA(At, 0, 1); PG8_STAGE(PG8_SA(0, 0), a2, voffA);
            PG8_BAR; PG8_WAIT_L(0); PG8_MMA(1, 0, At, B0); PG8_BAR; PG8_SCHED;
            PG8_STAGE(PG8_SB(0, 1), b2 + hstep, voffB);
            PG8_WAIT_V(6); PG8_BAR; PG8_MMA(1, 1, At, B1); PG8_BAR;
            PG8_LDB(B0, 1, 0); PG8_SCHED; PG8_LDA(At, 1, 0); PG8_STAGE(PG8_SA(0, 1), a2 + hstep, voffA);
            PG8_WAIT_L(8); PG8_BAR; PG8_WAIT_L(0); PG8_MMA(0, 0, At, B0); PG8_BAR; PG8_SCHED;
            PG8_LDB(B1, 1, 1); PG8_STAGE(PG8_SB(1, 0), b3, voffB);
            PG8_BAR; PG8_WAIT_L(0); PG8_MMA(0, 1, At, B1); PG8_BAR;
            PG8_LDA(At, 1, 1); PG8_STAGE(PG8_SA(1, 0), a3, voffA);
            PG8_BAR; PG8_WAIT_L(0); PG8_MMA(1, 0, At, B0); PG8_BAR; PG8_SCHED;
            PG8_STAGE(PG8_SB(1, 1), b3 + hstep, voffB);
            PG8_WAIT_V(6); PG8_BAR; PG8_MMA(1, 1, At, B1); PG8_BAR;
        }
        PG8_STAMP();
        if constexpr (!Epi::AFTER_DRAIN) { E(acc, cur, wr, wc, fr, fq); S.done(cur); }
        PG8_STAMP();
        if (!has_next) break;
#pragma unroll
        for (int a = 0; a < 2; ++a)
#pragma unroll
            for (int b = 0; b < 2; ++b)
#pragma unroll
                for (int m = 0; m < 4; ++m)
#pragma unroll
                    for (int n = 0; n < 2; ++n) acc[a][b][m][n] = (f32x4){0.f, 0.f, 0.f, 0.f};
        cur = nxt; cA = nA; cB = nB; ++ui;
    }
    PG8_WAIT_V(0);
    if (wr == 0) PG8_BAR;
    PG8_BAR;
    if constexpr (Epi::AFTER_DRAIN) { E.fused(acc, cur, wr, wc, fr, fq, lds, wid, lane); S.done(cur); }
    PG8_STAMP();
    if (STAMP && wid == 0) { stamps[lane] = lane < nts ? (((unsigned long long)(unsigned)ts_hi << 32) | (unsigned)ts_lo) : 0ull;
        if (lane == 62) stamps[62] = rt_entry; if (lane == 63) stamps[63] = (unsigned long long)wall_clock64(); }
#undef PG8_STAMP
#undef PG8_SA
#undef PG8_SB
#undef PG8_STAGE
#undef PG8_LDA
#undef PG8_LDB
#undef PG8_MMA
#undef PG8_WAIT_V
#undef PG8_WAIT_L
#undef PG8_BAR
#undef PG8_SCHED
}
}
using pg8::bf16_t; using pg8::bf16x8; using pg8::f32x4; using pg8::u32x4; using pg8::Unit;
#define LAS __attribute__((address_space(3)))
typedef unsigned u32x2 __attribute__((ext_vector_type(2)));
typedef LAS unsigned char* lds_t;
__device__ __forceinline__ int tid_opaque() { int t = (int)threadIdx.x; asm volatile("" : "+v"(t)); return t; }
typedef float f32x2_t __attribute__((ext_vector_type(2)));

enum { I_XP = 0, I_XS, I_C, I_CCTX, I_CKV, I_CKR, I_SGLA, I_SS5, I_NORMW, I_WADA, I_BADA, I_WIN, I_WA2, I_BA, I_ONORM, I_QNORM, I_WUQ, I_KVNORM, I_WUK, I_WUV,
       I_QHNORM, I_KHNORM, I_ARE, I_AIM, I_LOGDT, I_BRE, I_BIM, I_CRE, I_CIM, I_S5D, I_WGLU, I_BGLU, I_WBOG, I_WBOM, I_WBOS, I_WOUT, N_IN };
struct KParams { const float* in[N_IN]; float* out; unsigned char* ws; };
struct Params { const float* const* in; float* out; unsigned char* ws; };

constexpr int LDZ = 6912;
constexpr int ZQ = 0, ZK = 256, ZV = 512, ZGA = 1024, ZGG = 1056, ZMQ = 1568, ZMKV = 1952, ZMKR = 2208, ZMG = 2240, ZSU = 2752, ZSG = 3264, ZMERGE = 3776;
constexpr size_t OUT_YP = 0, OUT_CKV = 8388608, OUT_KR = 10485760, OUT_GLA = 10747904, OUT_S5 = 12845056;
constexpr size_t OFF_WIN = 0;
constexpr size_t OFF_QD = OFF_WIN, OFF_KN = OFF_WIN + 8388608;
constexpr size_t OFF_WUQ = OFF_WIN + 14155776;
constexpr size_t OFF_WKV = OFF_WUQ + 393216;
constexpr size_t OFF_WGLU = OFF_WKV + 393216;
constexpr size_t OFF_WBO = OFF_WGLU + 1048576;
constexpr size_t OFF_WOUT = OFF_WBO + 3145728;
constexpr size_t OFF_S5M = OFF_WOUT + 2097152;
constexpr size_t OFF_V = OFF_S5M;
constexpr size_t OFF_P16 = OFF_S5M + 12582912;
constexpr size_t OFF_ADA = OFF_P16 + 32768;
constexpr size_t OFF_ROPE = OFF_ADA + 122880;
constexpr size_t OFF_CTX0 = OFF_ROPE + 131072;
constexpr size_t OFF_CKVN = OFF_CTX0 + 1048576;
constexpr size_t OFF_CTX1 = OFF_CKVN + 4194304;
constexpr size_t OFF_HB = OFF_CTX1 + 1048576;
constexpr size_t OFF_Z = OFF_HB + 16777216;
constexpr size_t OFF_KV = OFF_Z + 113246208;
constexpr size_t OFF_AGLA = OFF_KV, OFF_AMLA = OFF_KV + 8388608;
constexpr size_t OFF_DEC = OFF_KV + 33554432;
constexpr size_t OFF_ST = OFF_DEC + 262144;
constexpr size_t OFF_AQ = OFF_ST + 16777216;
constexpr size_t OFF_QRAW = OFF_AQ + 6291456;
constexpr size_t OFF_AS5 = OFF_QRAW + 6291456;
constexpr size_t OFF_YG = OFF_AS5 + 8388608;
constexpr size_t OFF_TBL = OFF_YG + 8388608;
constexpr size_t WS_END = OFF_TBL + 512;
constexpr int DYN_LDS = 147456;

__device__ __forceinline__ float bf2f(bf16_t b) { return __uint_as_float(((unsigned)b) << 16); }
__device__ __forceinline__ bf16_t f2bf(float f) { unsigned u = __float_as_uint(f); u += 0x7FFFu + ((u >> 16) & 1u); return (bf16_t)(u >> 16); }
__device__ __forceinline__ unsigned pk2(float lo, float hi) { return pg8::cvt_pk_bf16(lo, hi); }
__device__ __forceinline__ float lo16(unsigned w) { return __uint_as_float(w << 16); }
__device__ __forceinline__ float hi16(unsigned w) { return __uint_as_float(w & 0xffff0000u); }
__device__ __forceinline__ float sigmoidf_(float x) { return 1.f / (1.f + __expf(-x)); }
__device__ __forceinline__ float siluf_(float x) { return x / (1.f + __expf(-x)); }
__device__ __forceinline__ void store8(bf16_t* p, const f32x4& a, const f32x4& b) { u32x4 w; w.x = pk2(a[0], a[1]); w.y = pk2(a[2], a[3]); w.z = pk2(b[0], b[1]); w.w = pk2(b[2], b[3]); *(u32x4*)p = w; }
#define MFMA16(a, b, c) __builtin_amdgcn_mfma_f32_16x16x32_bf16(a, b, c, 0, 0, 0)
#define LDSFRAG(ptr) (*(const LAS bf16x8*)(ptr))

struct Order : pg8::StaticOrder {
    __device__ void setup(int M, int N, int rot) { const int G = (int)gridDim.x; init(M, N, G, (int)((blockIdx.x + (unsigned)rot) % (unsigned)G)); }
};

struct EpiZ { static constexpr bool PERM = true, AFTER_DRAIN = false; bf16_t* Z;
    __device__ __forceinline__ void operator()(const f32x4 (&acc)[2][2][4][2], const Unit& u, int wr, int wc, int fr, int fq) const {
        const int row0 = u.pm * 256 + wr * 64 + fr, col0 = u.pn * 256 + wc * 32 + 8 * fq;
#pragma unroll
        for (int ai = 0; ai < 2; ++ai)
#pragma unroll
            for (int m = 0; m < 4; ++m) { bf16_t* rp = Z + (size_t)(row0 + ai * 128 + m * 16) * LDZ + col0;
#pragma unroll
                for (int bj = 0; bj < 2; ++bj) store8(rp + bj * 128, acc[ai][bj][m][0], acc[ai][bj][m][1]); }
    } };
struct EpiQ { static constexpr bool PERM = true, AFTER_DRAIN = false; bf16_t* Q;
    __device__ __forceinline__ void operator()(const f32x4 (&acc)[2][2][4][2], const Unit& u, int wr, int wc, int fr, int fq) const {
        const int row0 = u.pm * 256 + wr * 64 + fr, col0 = u.pn * 256 + wc * 32 + 8 * fq;
#pragma unroll
        for (int ai = 0; ai < 2; ++ai)
#pragma unroll
            for (int m = 0; m < 4; ++m) { bf16_t* rp = Q + (size_t)(row0 + ai * 128 + m * 16) * 384 + col0;
#pragma unroll
                for (int bj = 0; bj < 2; ++bj) if (col0 + bj * 128 < 384) store8(rp + bj * 128, acc[ai][bj][m][0], acc[ai][bj][m][1]);
                __builtin_amdgcn_sched_barrier(0); }
    } };
struct EpiKV { static constexpr bool PERM = true, AFTER_DRAIN = false; bf16_t* KN; bf16_t* V; int layer;
    __device__ __forceinline__ void operator()(const f32x4 (&acc)[2][2][4][2], const Unit& u, int wr, int wc, int fr, int fq) const {
        int rb = u.pm * 256; if (layer == 0) rb = rb < 2048 ? 8192 + rb : rb - 2048;
        const int row0 = rb + wr * 64 + fr, cl = wc * 32 + 8 * fq;
#pragma unroll
        for (int ai = 0; ai < 2; ++ai)
#pragma unroll
            for (int m = 0; m < 4; ++m) { const size_t r = (size_t)(row0 + ai * 128 + m * 16);
                bf16_t* rp = u.pn == 0 ? KN + r * 256 + cl : V + r * 512 + (u.pn - 1) * 256 + cl;
#pragma unroll
                for (int bj = 0; bj < 2; ++bj) store8(rp + bj * 128, acc[ai][bj][m][0], acc[ai][bj][m][1]);
                __builtin_amdgcn_sched_barrier(0); }
    } };
struct EpiGLU { static constexpr bool PERM = true, AFTER_DRAIN = false; bf16_t* O; const bf16_t* Z; const float* bias;
    __device__ __forceinline__ void operator()(const f32x4 (&acc)[2][2][4][2], const Unit& u, int wr, int wc, int fr, int fq) const {
        const int row0 = u.pm * 256 + wr * 64 + fr, oc = u.pn * 128 + wc * 32 + 8 * fq;
        float bv[8], bg[8];
#pragma unroll
        for (int i = 0; i < 8; ++i) { bv[i] = bias[oc + i]; bg[i] = bias[512 + oc + i]; }
#pragma unroll
        for (int ai = 0; ai < 2; ++ai)
#pragma unroll
            for (int m = 0; m < 4; ++m) { const size_t r = (size_t)(row0 + ai * 128 + m * 16);
                const u32x4 sg = *(const u32x4*)(Z + r * LDZ + ZSG + oc);
                float g[8] = { lo16(sg.x), hi16(sg.x), lo16(sg.y), hi16(sg.y), lo16(sg.z), hi16(sg.z), lo16(sg.w), hi16(sg.w) };
                float o[8];
#pragma unroll
                for (int i = 0; i < 8; ++i) { const float zv = acc[ai][0][m][i >> 2][i & 3] + bv[i], zg = acc[ai][1][m][i >> 2][i & 3] + bg[i]; o[i] = zv * sigmoidf_(zg) * siluf_(g[i]); }
                u32x4 w; w.x = pk2(o[0], o[1]); w.y = pk2(o[2], o[3]); w.z = pk2(o[4], o[5]); w.w = pk2(o[6], o[7]);
                *(u32x4*)(O + r * 512 + oc) = w; __builtin_amdgcn_sched_barrier(0); }
    } };
struct EpiBo { static constexpr bool PERM = true, AFTER_DRAIN = false; bf16_t* MIX; const bf16_t* Z; int branch;
    __device__ __forceinline__ void operator()(const f32x4 (&acc)[2][2][4][2], const Unit& u, int wr, int wc, int fr, int fq) const {
        const int row0 = u.pm * 256 + wr * 64 + fr, col0 = u.pn * 256 + wc * 32 + 8 * fq;
#pragma unroll
        for (int ai = 0; ai < 2; ++ai)
#pragma unroll
            for (int m = 0; m < 4; ++m) { const size_t r = (size_t)(row0 + ai * 128 + m * 16);
#pragma unroll
                for (int bj = 0; bj < 2; ++bj) { const int c = col0 + bj * 128;
                    const u32x4 sg = *(const u32x4*)(Z + r * LDZ + ZMERGE + branch * 1024 + c);
                    float g[8] = { lo16(sg.x), hi16(sg.x), lo16(sg.y), hi16(sg.y), lo16(sg.z), hi16(sg.z), lo16(sg.w), hi16(sg.w) };
                    float o[8];
#pragma unroll
                    for (int i = 0; i < 8; ++i) o[i] = sigmoidf_(g[i]) * acc[ai][bj][m][i >> 2][i & 3];
                    bf16_t* mp = MIX + r * 1024 + c;
                    if (branch > 0) { const u32x4 pv = *(const u32x4*)mp;
                        o[0] += lo16(pv.x); o[1] += hi16(pv.x); o[2] += lo16(pv.y); o[3] += hi16(pv.y); o[4] += lo16(pv.z); o[5] += hi16(pv.z); o[6] += lo16(pv.w); o[7] += hi16(pv.w); }
                    u32x4 w; w.x = pk2(o[0], o[1]); w.y = pk2(o[2], o[3]); w.z = pk2(o[4], o[5]); w.w = pk2(o[6], o[7]);
                    *(u32x4*)mp = w; __builtin_amdgcn_sched_barrier(0); } }
    } };
struct EpiOut { static constexpr bool PERM = false, AFTER_DRAIN = false; float* Y; const float* xp; const float* xs; const float* ada;
    __device__ __forceinline__ void operator()(const f32x4 (&acc)[2][2][4][2], const Unit& u, int wr, int wc, int fr, int fq) const {
        const int row0 = u.pm * 256 + wr * 64 + fr, col0 = u.pn * 256 + wc * 32 + 4 * fq;
        const int ar = u.pm < 16 ? 0 : 1 + ((u.pm - 16) >> 2);
        const float* gp = ada + ar * 3072 + 2048;
        f32x4 gv[2][2];
#pragma unroll
        for (int bj = 0; bj < 2; ++bj)
#pragma unroll
            for (int n = 0; n < 2; ++n) gv[bj][n] = *(const f32x4*)(gp + col0 + bj * 128 + n * 16);
#pragma unroll
        for (int ai = 0; ai < 2; ++ai)
#pragma unroll
            for (int m = 0; m < 4; ++m) { const int r = row0 + ai * 128 + m * 16;
                const float* xr = (r < 4096 ? xp + (size_t)r * 1024 : xs + (size_t)(r - 4096) * 1024) + col0;
                float* yr = Y + (size_t)r * 1024 + col0;
#pragma unroll
                for (int bj = 0; bj < 2; ++bj)
#pragma unroll
                    for (int n = 0; n < 2; ++n) { const f32x4 xv = *(const f32x4*)(xr + bj * 128 + n * 16); *(f32x4*)(yr + bj * 128 + n * 16) = xv + gv[bj][n] * acc[ai][bj][m][n]; } }
    } };

__device__ void job_ada(const Params& p, int j, lds_t lds) {
    LAS float* sc = (LAS float*)lds; LAS float* red = sc + 5 * 1024;
    const int l = j / 48, c0 = (j % 48) * 64, tid = tid_opaque();
    for (int i = tid; i < 5 * 1024; i += 512) { const int r = i >> 10, k = i & 1023; const float v = r == 0 ? p.in[I_CCTX][k] : p.in[I_C][(r - 1) * 1024 + k]; sc[i] = v / (1.f + expf(-v)); }
    __syncthreads();
    const int col = tid & 63, kg = tid >> 6; const float* W = p.in[I_WADA] + (size_t)l * 1024 * 3072 + c0 + col;
    float a0 = 0.f, a1 = 0.f, a2 = 0.f, a3 = 0.f, a4 = 0.f;
    for (int k = kg * 128; k < kg * 128 + 128; ++k) { const float w = W[(size_t)k * 3072]; a0 += sc[k] * w; a1 += sc[1024 + k] * w; a2 += sc[2048 + k] * w; a3 += sc[3072 + k] * w; a4 += sc[4096 + k] * w; }
    red[(kg * 5 + 0) * 64 + col] = a0; red[(kg * 5 + 1) * 64 + col] = a1; red[(kg * 5 + 2) * 64 + col] = a2; red[(kg * 5 + 3) * 64 + col] = a3; red[(kg * 5 + 4) * 64 + col] = a4;
    __syncthreads();
    if (tid < 320) { const int r = tid / 64, cc = tid % 64; float s = p.in[I_BADA][l * 3072 + c0 + cc];
        for (int g = 0; g < 8; ++g) s += red[(g * 5 + r) * 64 + cc];
        ((float*)(p.ws + OFF_ADA))[(l * 5 + r) * 3072 + c0 + cc] = s; }
    __syncthreads();
}
__device__ void job_ctx(const Params& p, int j) {
    const int base = j * 4096 + tid_opaque() * 8; const int l = base / (2048 * 256), rem = base % (2048 * 256), row = rem >> 8, c = rem & 255, b = row >> 9, jj = row & 511;
    const float* s = p.in[I_CKV] + ((size_t)((b * 2 + l) * 512 + jj)) * 256 + c;
    const f32x4 v0 = *(const f32x4*)s, v1 = *(const f32x4*)(s + 4);
    bf16_t* d = (bf16_t*)(p.ws + (l == 0 ? OFF_CTX0 : OFF_CTX1)) + (size_t)row * 256 + c;
    store8(d, v0, v1);
}
__device__ void job_rope(const Params& p, int j) {
    const int idx = j * 512 + tid_opaque(), pos = idx >> 4, i = idx & 15, f = i & 7;
    const float inv = powf(10000.f, -(float)f / 8.f); const float ang = (float)(i < 8 ? (pos >> 6) : (pos & 63)) * inv;
    float* R = (float*)(p.ws + OFF_ROPE); R[idx] = cosf(ang); R[16384 + idx] = sinf(ang);
}

__device__ void job_prep(const Params& p, int l, int j) {
    const int tid = tid_opaque(), wid = tid >> 6, lane = tid & 63, row = j * 8 + wid;
    const float* x = l == 0 ? (row < 4096 ? p.in[I_XP] + (size_t)row * 1024 : p.in[I_XS] + (size_t)(row - 4096) * 1024) : p.out + (size_t)row * 1024;
    const int ar = row < 4096 ? 0 : 1 + ((row - 4096) >> 10);
    const float* ada = (const float*)(p.ws + OFF_ADA) + (l * 5 + ar) * 3072; const float* nw = p.in[I_NORMW] + l * 1024;
    f32x4 v[4]; float ss = 0.f;
#pragma unroll
    for (int i = 0; i < 4; ++i) { v[i] = *(const f32x4*)(x + i * 256 + lane * 4); ss += v[i][0] * v[i][0] + v[i][1] * v[i][1] + v[i][2] * v[i][2] + v[i][3] * v[i][3]; }
#pragma unroll
    for (int o = 1; o < 64; o <<= 1) ss += __shfl_xor(ss, o);
    const float rstd = rsqrtf(ss * (1.f / 1024.f) + 1e-6f);
    bf16_t* h = (bf16_t*)(p.ws + OFF_HB) + (size_t)row * 1024;
#pragma unroll
    for (int i = 0; i < 4; ++i) { const int c = i * 256 + lane * 4; const f32x4 w = *(const f32x4*)(nw + c), sh = *(const f32x4*)(ada + c), sc = *(const f32x4*)(ada + 1024 + c);
        float o[4];
#pragma unroll
        for (int k = 0; k < 4; ++k) o[k] = v[i][k] * rstd * w[k] * (1.f + sc[k]) + sh[k];
        u32x2 pk; pk.x = pk2(o[0], o[1]); pk.y = pk2(o[2], o[3]); *(u32x2*)(h + c) = pk; }
}
__device__ void wt_tile(const float* src, int ldsrc, int scol, bf16_t* dst, int K, int n0, int k0, lds_t lds) {
    LAS float* t = (LAS float*)lds; const int tid = tid_opaque();
    if (scol >= 0) {
#pragma unroll
        for (int i = 0; i < 8; ++i) { const int kk = i * 8 + (tid >> 6), nn = tid & 63; t[kk * 65 + nn] = src[(size_t)(k0 + kk) * ldsrc + scol + nn]; }
    }
    __syncthreads();
    const int n = tid >> 3, kc = tid & 7; u32x4 w = {0u, 0u, 0u, 0u};
    if (scol >= 0) { const LAS float* s = t + (kc * 8) * 65 + n; w.x = pk2(s[0], s[65]); w.y = pk2(s[130], s[195]); w.z = pk2(s[260], s[325]); w.w = pk2(s[390], s[455]); }
    *(u32x4*)(dst + (size_t)(n0 + n) * K + k0 + kc * 8) = w;
    __syncthreads();
}
constexpr int WT_WIN = 108 * 16, WT_WUQ = 8 * 6, WT_WKV = 12 * 4, WT_WGLU = 16 * 8, WT_WBO = 16 * 8, WT_WOUT = 16 * 16, WT_TOTAL = WT_WIN + WT_WUQ + WT_WKV + WT_WGLU + 3 * WT_WBO + WT_WOUT;
__device__ void job_wt(const Params& p, int l, int t, lds_t lds) {
    if (t < WT_WIN) { const int nt = t / 16, kt = t % 16; wt_tile(p.in[I_WIN] + (size_t)l * 1024 * 6848, 6848, nt < 107 ? nt * 64 : -1, (bf16_t*)(p.ws + OFF_WIN), 1024, nt * 64, kt * 64, lds); return; } t -= WT_WIN;
    if (t < WT_WUQ) { const int nt = t / 6, kt = t % 6; wt_tile(p.in[I_WUQ] + (size_t)l * 384 * 384, 384, nt < 6 ? nt * 64 : -1, (bf16_t*)(p.ws + OFF_WUQ), 384, nt * 64, kt * 64, lds); return; } t -= WT_WUQ;
    if (t < WT_WKV) { const int nt = t / 4, kt = t % 4;
        if (nt < 4) wt_tile(p.in[I_WUK] + (size_t)l * 256 * 256, 256, nt * 64, (bf16_t*)(p.ws + OFF_WKV), 256, nt * 64, kt * 64, lds);
        else wt_tile(p.in[I_WUV] + (size_t)l * 256 * 512, 512, (nt - 4) * 64, (bf16_t*)(p.ws + OFF_WKV), 256, nt * 64, kt * 64, lds);
        return; } t -= WT_WKV;
    if (t < WT_WGLU) { const int nt = t / 8, kt = t % 8, n0 = nt * 64; const int scol = ((n0 >> 7) & 1) * 512 + (n0 >> 8) * 128 + (n0 & 127);
        wt_tile(p.in[I_WGLU] + (size_t)l * 512 * 1024, 1024, scol, (bf16_t*)(p.ws + OFF_WGLU), 512, n0, kt * 64, lds); return; } t -= WT_WGLU;
    if (t < 3 * WT_WBO) { const int br = t / WT_WBO, tt = t % WT_WBO, nt = tt / 8, kt = tt % 8;
        wt_tile(p.in[I_WBOG + br] + (size_t)l * 512 * 1024, 1024, nt * 64, (bf16_t*)(p.ws + OFF_WBO) + (size_t)br * 1024 * 512, 512, nt * 64, kt * 64, lds); return; } t -= 3 * WT_WBO;
    { const int nt = t / 16, kt = t % 16; wt_tile(p.in[I_WOUT] + (size_t)l * 1024 * 1024, 1024, nt * 64, (bf16_t*)(p.ws + OFF_WOUT), 1024, nt * 64, kt * 64, lds); }
}
__device__ void job_s5setup(const Params& p, int l, int j, lds_t lds) {
    const int g = j / 3, which = j % 3, tid = tid_opaque();
    LAS f32x2_t* pw = (LAS f32x2_t*)lds;
    LAS f32x2_t* Bt = pw + 2 * 17 * 64;
    LAS f32x2_t* Cn = Bt + 2 * 64 * 16;
    LAS float* Kt = (LAS float*)(Cn + 64 * 16);
    if (tid < 128) { const int d = tid >> 6, n = tid & 63;
        const float dt = expf(p.in[I_LOGDT][(l * 2 + d) * 32 + g]);
        const float are = p.in[I_ARE][((l * 2 + d) * 32 + g) * 64 + n], aim = p.in[I_AIM][((l * 2 + d) * 32 + g) * 64 + n];
        for (int tau = 0; tau <= 16; ++tau) { const float mag = expf(are * dt * (float)tau); float s, c; sincosf(aim * dt * (float)tau, &s, &c); pw[(d * 17 + tau) * 64 + n] = (f32x2_t){mag * c, mag * s}; }
        float s1, c1; sincosf(aim * dt, &s1, &c1); float sh = sinf(0.5f * aim * dt);
        const float em1 = expm1f(are * dt), mag1 = em1 + 1.f;
        const float nre = em1 * c1 - 2.f * sh * sh, abim = mag1 * s1, den = are * are + aim * aim;
        const float cfr = (nre * are + abim * aim) / den, cfi = (abim * are - nre * aim) / den;
        for (int q = 0; q < 16; ++q) { const float br = p.in[I_BRE][((size_t)(l * 32 + g) * 64 + n) * 16 + q], bi = p.in[I_BIM][((size_t)(l * 32 + g) * 64 + n) * 16 + q];
            Bt[(d * 64 + n) * 16 + q] = (f32x2_t){cfr * br - cfi * bi, cfr * bi + cfi * br}; }
        if (which == 1) ((f32x2_t*)(p.ws + OFF_P16))[(g * 2 + d) * 64 + n] = pw[(d * 17 + 16) * 64 + n];
    }
    for (int i = tid; i < 1024; i += 512) { const int n = i >> 4, pp = i & 15; Cn[i] = (f32x2_t){p.in[I_CRE][((size_t)(l * 32 + g) * 16 + pp) * 64 + n], p.in[I_CIM][((size_t)(l * 32 + g) * 16 + pp) * 64 + n]}; }
    __syncthreads();
    bf16_t* M = (bf16_t*)(p.ws + OFF_S5M) + (size_t)(g * 3 + which) * 65536;
    if (which == 0) {
        for (int i = tid; i < 8192; i += 512) { const int d = i >> 12, tau = (i >> 8) & 15, pp = (i >> 4) & 15, q = i & 15; float s = 0.f;
            for (int n = 0; n < 64; ++n) { const f32x2_t c = Cn[n * 16 + pp], w = pw[(d * 17 + tau) * 64 + n], b = Bt[(d * 64 + n) * 16 + q];
                const float cwr = c.x * w.x - c.y * w.y, cwi = c.x * w.y + c.y * w.x; s += cwr * b.x - cwi * b.y; }
            Kt[i] = s; }
        __syncthreads();
        for (int i = tid; i < 65536; i += 512) { const int no = i >> 8, k = i & 255, t = no >> 4, pp = no & 15, s = k >> 4, q = k & 15; float v;
            if (t > s) v = Kt[(0 * 16 + (t - s)) * 256 + pp * 16 + q];
            else if (t < s) v = Kt[(1 * 16 + (s - t)) * 256 + pp * 16 + q];
            else { v = Kt[pp * 16 + q] + Kt[16 * 256 + pp * 16 + q]; if (pp == q) v += p.in[I_S5D][l * 512 + g * 16 + pp]; }
            M[i] = f2bf(v); }
    } else if (which == 1) {
        for (int i = tid; i < 65536; i += 512) { const int no = i >> 8, k = i & 255, d = no >> 7, ri = (no >> 6) & 1, n = no & 63, s = k >> 4, q = k & 15; const int e = d == 0 ? 15 - s : s;
            const f32x2_t w = pw[(d * 17 + e) * 64 + n], b = Bt[(d * 64 + n) * 16 + q];
            M[i] = f2bf(ri == 0 ? w.x * b.x - w.y * b.y : w.x * b.y + w.y * b.x); }
    } else {
        for (int i = tid; i < 65536; i += 512) { const int no = i >> 8, k = i & 255, t = no >> 4, pp = no & 15, d = k >> 7, ri = (k >> 6) & 1, n = k & 63; const int e = d == 0 ? t + 1 : 16 - t;
            const f32x2_t c = Cn[n * 16 + pp], w = pw[(d * 17 + e) * 64 + n];
            M[i] = f2bf(ri == 0 ? c.x * w.x - c.y * w.y : -(c.x * w.y + c.y * w.x)); }
    }
    __syncthreads();
}

__device__ __forceinline__ float gelu_tanh(float x) { const float u = 0.7978845608f * (x + 0.044715f * x * x * x); const float t = 1.f - 2.f / (1.f + __expf(2.f * u)); return 0.5f * x * (1.f + t); }
__device__ void job_s5(const Params& p, int l, int j, lds_t lds) {
    const int tid = tid_opaque(), wid = tid >> 6, lane = tid & 63, lr = lane & 15, lq = lane >> 4;
    int bb, g; if (j < 128) { bb = 16 + (j >> 5); g = j & 31; } else { bb = (j - 128) >> 5; g = (j - 128) & 31; }
    const int M = bb < 16 ? 16 : 64, MT = M >> 4; const int tok0 = bb < 16 ? bb * 256 : 4096 + (bb - 16) * 1024;
    LAS bf16_t* Us = (LAS bf16_t*)lds; LAS bf16_t* Xs = Us + 64 * 264; LAS float* Xin = (LAS float*)(lds + 2 * 64 * 264 * 2);
    const bf16_t* Z = (const bf16_t*)(p.ws + OFF_Z);
    for (int idx = tid; idx < M * 32; idx += 512) { const int tok = idx >> 1, hf = idx & 1;
        *(LAS u32x4*)(Us + (tok >> 4) * 264 + (tok & 15) * 16 + hf * 8) = *(const u32x4*)(Z + (size_t)(tok0 + tok) * LDZ + ZSU + g * 16 + hf * 8); }
    __syncthreads();
    const bf16_t* TT = (const bf16_t*)(p.ws + OFF_S5M) + (size_t)(g * 3) * 65536; const bf16_t* G = TT + 65536; const bf16_t* Cc = G + 65536;
    f32x4 acc[4][2];
#pragma unroll
    for (int a = 0; a < 4; ++a) { acc[a][0] = (f32x4){0.f, 0.f, 0.f, 0.f}; acc[a][1] = acc[a][0]; }
    for (int ks = 0; ks < 8; ++ks) {
        bf16x8 b0 = *(const bf16x8*)(G + (size_t)(wid * 32 + lr) * 256 + ks * 32 + lq * 8), b1 = *(const bf16x8*)(G + (size_t)(wid * 32 + 16 + lr) * 256 + ks * 32 + lq * 8);
#pragma unroll
        for (int mt = 0; mt < 4; ++mt) if (mt < MT) { const bf16x8 a = LDSFRAG(Us + (mt * 16 + lr) * 264 + ks * 32 + lq * 8); acc[mt][0] = MFMA16(a, b0, acc[mt][0]); acc[mt][1] = MFMA16(a, b1, acc[mt][1]); }
    }
#pragma unroll
    for (int mt = 0; mt < 4; ++mt) if (mt < MT)
#pragma unroll
        for (int ct = 0; ct < 2; ++ct)
#pragma unroll
            for (int r = 0; r < 4; ++r) Xin[(mt * 16 + lq * 4 + r) * 260 + wid * 32 + ct * 16 + lr] = acc[mt][ct][r];
    __syncthreads();
    if (tid < 128) { const int d = tid >> 6, n = tid & 63; const f32x2_t a16 = ((const f32x2_t*)(p.ws + OFF_P16))[(g * 2 + d) * 64 + n];
        float xr = 0.f, xi = 0.f;
        if (bb >= 16) { const size_t o = ((size_t)(((bb - 16) * 2 + l) * 2 + d) * 2) * 2048 + g * 64 + n; xr = p.in[I_SS5][o]; xi = p.in[I_SS5][o + 2048]; }
        const int cre = d * 128 + n, cim = cre + 64;
        for (int i = 0; i < M; ++i) { const int c = d == 0 ? i : M - 1 - i;
            Xs[c * 264 + cre] = f2bf(xr); Xs[c * 264 + cim] = f2bf(xi);
            const float ur = Xin[c * 260 + cre], ui = Xin[c * 260 + cim];
            const float nr = a16.x * xr - a16.y * xi + ur, ni = a16.x * xi + a16.y * xr + ui; xr = nr; xi = ni; }
        if (bb < 16) { const size_t o = OUT_S5 + ((size_t)((bb * 2 + l) * 2 + d) * 2) * 2048 + g * 64 + n; p.out[o] = xr; p.out[o + 2048] = xi; }
    }
    __syncthreads();
#pragma unroll
    for (int a = 0; a < 4; ++a) { acc[a][0] = (f32x4){0.f, 0.f, 0.f, 0.f}; acc[a][1] = acc[a][0]; }
    for (int ks = 0; ks < 16; ++ks) { const bf16_t* Bm = ks < 8 ? TT : Cc; const LAS bf16_t* Am = ks < 8 ? Us : Xs; const int kk = (ks & 7) * 32 + lq * 8;
        bf16x8 b0 = *(const bf16x8*)(Bm + (size_t)(wid * 32 + lr) * 256 + kk), b1 = *(const bf16x8*)(Bm + (size_t)(wid * 32 + 16 + lr) * 256 + kk);
#pragma unroll
        for (int mt = 0; mt < 4; ++mt) if (mt < MT) { const bf16x8 a = LDSFRAG(Am + (mt * 16 + lr) * 264 + kk); acc[mt][0] = MFMA16(a, b0, acc[mt][0]); acc[mt][1] = MFMA16(a, b1, acc[mt][1]); }
    }
    bf16_t* Yg = (bf16_t*)(p.ws + OFF_YG);
#pragma unroll
    for (int mt = 0; mt < 4; ++mt) if (mt < MT)
#pragma unroll
        for (int ct = 0; ct < 2; ++ct)
#pragma unroll
            for (int r = 0; r < 4; ++r) { const int chunk = mt * 16 + lq * 4 + r, t = wid * 2 + ct;
                Yg[(size_t)(tok0 + chunk * 16 + t) * 512 + g * 16 + lr] = f2bf(gelu_tanh(acc[mt][ct][r])); }
    __syncthreads();
}
__device__ void job_mlaprep(const Params& p, int l, int j) {
    const int tid = tid_opaque(), wid = tid >> 6, lane = tid & 63, row = j * 8 + wid;
    const bf16_t* z = (const bf16_t*)(p.ws + OFF_Z) + (size_t)row * LDZ;
    float q[6], kv[4]; float sq = 0.f, sk = 0.f;
#pragma unroll
    for (int i = 0; i < 6; ++i) { q[i] = bf2f(z[ZMQ + i * 64 + lane]); sq += q[i] * q[i]; }
#pragma unroll
    for (int i = 0; i < 4; ++i) { kv[i] = bf2f(z[ZMKV + i * 64 + lane]); sk += kv[i] * kv[i]; }
#pragma unroll
    for (int o = 1; o < 64; o <<= 1) { sq += __shfl_xor(sq, o); sk += __shfl_xor(sk, o); }
    const float rq = rsqrtf(sq * (1.f / 384.f) + 1e-6f), rk = rsqrtf(sk * (1.f / 256.f) + 1e-6f);
    bf16_t* aq = (bf16_t*)(p.ws + OFF_AQ) + (size_t)row * 384; bf16_t* ck = (bf16_t*)(p.ws + OFF_CKVN) + (size_t)row * 256;
#pragma unroll
    for (int i = 0; i < 6; ++i) aq[i * 64 + lane] = f2bf(q[i] * rq * p.in[I_QNORM][l * 384 + i * 64 + lane]);
    const bool prompt = row < 4096; const int b = row >> 8, t = row & 255;
#pragma unroll
    for (int i = 0; i < 4; ++i) { const float v = kv[i] * rk * p.in[I_KVNORM][l * 256 + i * 64 + lane]; ck[i * 64 + lane] = f2bf(v);
        if (prompt) p.out[OUT_CKV + ((size_t)((b * 2 + l) * 256 + t)) * 256 + i * 64 + lane] = v; }
    if (prompt && lane < 32) p.out[OUT_KR + ((size_t)((b * 2 + l) * 256 + t)) * 32 + lane] = bf2f(z[ZMKR + lane]);
}
__device__ __forceinline__ float logsigmoidf_(float x) { return fminf(x, 0.f) - log1pf(expf(-fabsf(x))); }
__device__ void job_glaA(const Params& p, int l, int j, lds_t lds) {
    const int tid = tid_opaque(), wid = tid >> 6, lane = tid & 63, lr = lane & 15, lq = lane >> 4;
    const int ck = j >> 2, h = j & 3, tok0 = ck * 64;
    LAS bf16_t* QDf = (LAS bf16_t*)lds; LAS bf16_t* QDb = QDf + 4608; LAS bf16_t* KDf = QDb + 4608; LAS bf16_t* KDb = KDf + 4608; LAS bf16_t* KRf = KDb + 4608; LAS bf16_t* KRb = KRf + 4608;
    LAS bf16_t* VT = KRb + 4608;
    LAS bf16_t* ATT = VT + 9216;
    LAS float* GA = (LAS float*)(ATT + 4608);
    LAS float* TOT = GA + 2048;
    const bf16_t* Z = (const bf16_t*)(p.ws + OFF_Z);
    { const int c = tid >> 3, part = tid & 7; const u32x2 gv = *(const u32x2*)(Z + (size_t)(tok0 + c) * LDZ + ZGA + part * 4);
      GA[c * 32 + part * 4 + 0] = lo16(gv.x); GA[c * 32 + part * 4 + 1] = hi16(gv.x); GA[c * 32 + part * 4 + 2] = lo16(gv.y); GA[c * 32 + part * 4 + 3] = hi16(gv.y);
      const bf16_t* vp = Z + (size_t)(tok0 + c) * LDZ + ZV + h * 128 + part * 16;
      const u32x4 v0 = *(const u32x4*)vp, v1 = *(const u32x4*)(vp + 8);
      const unsigned w[8] = { v0.x, v0.y, v0.z, v0.w, v1.x, v1.y, v1.z, v1.w };
#pragma unroll
      for (int i = 0; i < 8; ++i) { VT[(part * 16 + 2 * i) * 72 + c] = (bf16_t)(w[i] & 0xffffu); VT[(part * 16 + 2 * i + 1) * 72 + c] = (bf16_t)(w[i] >> 16); } }
    __syncthreads();
    const int d = tid & 63, cg_ = tid >> 6;
    float laf[8], lab[8];
    { float wf[16], wb[16];
#pragma unroll
      for (int r = 0; r < 16; ++r) { wf[r] = p.in[I_WA2][((size_t)((l * 2 + 0) * 16 + r)) * 256 + h * 64 + d]; wb[r] = p.in[I_WA2][((size_t)((l * 2 + 1) * 16 + r)) * 256 + h * 64 + d]; }
      const float bf_ = p.in[I_BA][(l * 2 + 0) * 256 + h * 64 + d], bb_ = p.in[I_BA][(l * 2 + 1) * 256 + h * 64 + d];
#pragma unroll
      for (int i = 0; i < 8; ++i) { const int c = cg_ * 8 + i; float xf = bf_, xb = bb_;
#pragma unroll
          for (int r = 0; r < 16; ++r) { xf += GA[c * 32 + r] * wf[r]; xb += GA[c * 32 + 16 + r] * wb[r]; }
          laf[i] = logsigmoidf_(xf) * (1.f / 16.f); lab[i] = logsigmoidf_(xb) * (1.f / 16.f); } }
#pragma unroll
    for (int i = 1; i < 8; ++i) laf[i] += laf[i - 1];
#pragma unroll
    for (int i = 6; i >= 0; --i) lab[i] += lab[i + 1];
    TOT[(0 * 8 + cg_) * 64 + d] = laf[7]; TOT[(1 * 8 + cg_) * 64 + d] = lab[0];
    __syncthreads();
    float offf = 0.f, offb = 0.f, Tf = 0.f, Tb = 0.f;
#pragma unroll
    for (int g = 0; g < 8; ++g) { const float a = TOT[g * 64 + d], b = TOT[(8 + g) * 64 + d]; Tf += a; Tb += b; if (g < cg_) offf += a; if (g > cg_) offb += b; }
    bf16_t* QD = (bf16_t*)(p.ws + OFF_QD);
#pragma unroll
    for (int i = 0; i < 8; ++i) { const int c = cg_ * 8 + i; const size_t zr = (size_t)(tok0 + c) * LDZ;
        const float q = bf2f(Z[zr + ZQ + h * 64 + d]) * 0.125f, k = bf2f(Z[zr + ZK + h * 64 + d]);
        const float bf_ = offf + laf[i], bb_ = offb + lab[i];
        const bf16_t qf = f2bf(q * expf(bf_)), qb = f2bf(q * expf(bb_));
        QDf[c * 72 + d] = qf; QDb[c * 72 + d] = qb;
        KDf[c * 72 + d] = f2bf(k * expf(-bf_)); KDb[c * 72 + d] = f2bf(k * expf(-bb_));
        KRf[d * 72 + c] = f2bf(k * expf(Tf - bf_)); KRb[d * 72 + c] = f2bf(k * expf(Tb - bb_));
        QD[(size_t)(tok0 + c) * 256 + h * 64 + d] = qf; QD[(size_t)(8192 + tok0 + c) * 256 + h * 64 + d] = qb; }
    if (cg_ == 0) { float* DEC = (float*)(p.ws + OFF_DEC); DEC[((0 * 128 + ck) * 4 + h) * 64 + d] = expf(Tf); DEC[((1 * 128 + ck) * 4 + h) * 64 + d] = expf(Tb); }
    __syncthreads();
#pragma unroll
    for (int q2 = 0; q2 < 2; ++q2) { const int tt = wid * 2 + q2, ti = tt >> 2, tj = tt & 3; f32x4 af = {0.f, 0.f, 0.f, 0.f}, ab = af;
#pragma unroll
        for (int ks = 0; ks < 2; ++ks) { const int ko = ks * 32 + lq * 8;
            af = MFMA16(LDSFRAG(QDf + (ti * 16 + lr) * 72 + ko), LDSFRAG(KDf + (tj * 16 + lr) * 72 + ko), af);
            ab = MFMA16(LDSFRAG(QDb + (ti * 16 + lr) * 72 + ko), LDSFRAG(KDb + (tj * 16 + lr) * 72 + ko), ab); }
#pragma unroll
        for (int r = 0; r < 4; ++r) { const int c = ti * 16 + lq * 4 + r, s = tj * 16 + lr; const float v = (s <= c ? af[r] : 0.f) + (s >= c ? ab[r] : 0.f); ATT[c * 72 + s] = f2bf(v); } }
    __syncthreads();
    bf16x8 vb[2];
#pragma unroll
    for (int ks = 0; ks < 2; ++ks) vb[ks] = LDSFRAG(VT + (wid * 16 + lr) * 72 + ks * 32 + lq * 8);
    float* OI = (float*)(p.ws + OFF_HB); float* KV = (float*)(p.ws + OFF_KV);
#pragma unroll
    for (int ct = 0; ct < 4; ++ct) { f32x4 a = {0.f, 0.f, 0.f, 0.f};
#pragma unroll
        for (int ks = 0; ks < 2; ++ks) a = MFMA16(LDSFRAG(ATT + (ct * 16 + lr) * 72 + ks * 32 + lq * 8), vb[ks], a);
#pragma unroll
        for (int r = 0; r < 4; ++r) OI[(size_t)(tok0 + ct * 16 + lq * 4 + r) * 512 + h * 128 + wid * 16 + lr] = a[r]; }
#pragma unroll
    for (int dir = 0; dir < 2; ++dir) { const LAS bf16_t* KR = dir == 0 ? KRf : KRb; float* kvp = KV + ((size_t)((dir * 128 + ck) * 4 + h)) * 8192;
#pragma unroll
        for (int dt = 0; dt < 4; ++dt) { f32x4 a = {0.f, 0.f, 0.f, 0.f};
#pragma unroll
            for (int ks = 0; ks < 2; ++ks) a = MFMA16(LDSFRAG(KR + (dt * 16 + lr) * 72 + ks * 32 + lq * 8), vb[ks], a);
#pragma unroll
            for (int r = 0; r < 4; ++r) kvp[(dt * 16 + lq * 4 + r) * 128 + wid * 16 + lr] = a[r]; } }
    __syncthreads();
}

__device__ void job_glaB(const Params& p, int l, int j) {
    const int slab = j & 15, h = (j >> 4) & 3, rest = j >> 6, bb = rest % 20, dir = rest / 20;
    const int idx = slab * 512 + tid_opaque(), d = idx >> 7;
    const int nck = bb < 16 ? 4 : 16, ck0 = bb < 16 ? bb * 4 : 64 + (bb - 16) * 16;
    float S = 0.f;
    if (bb >= 16) S = p.in[I_SGLA][((size_t)((((bb - 16) * 2 + l) * 2 + dir) * 4 + h)) * 8192 + idx];
    const float* KV = (const float*)(p.ws + OFF_KV); const float* DEC = (const float*)(p.ws + OFF_DEC); bf16_t* ST = (bf16_t*)(p.ws + OFF_ST);
    for (int i = 0; i < nck; ++i) { const int ck = dir == 0 ? ck0 + i : ck0 + nck - 1 - i; const size_t it = (size_t)((dir * 128 + ck) * 4 + h);
        ST[it * 8192 + idx] = f2bf(S); S = DEC[it * 64 + d] * S + KV[it * 8192 + idx]; }
    if (bb < 16) p.out[OUT_GLA + ((size_t)(((bb * 2 + l) * 2 + dir) * 4 + h)) * 8192 + idx] = S;
}

__device__ void job_glaC(const Params& p, int l, int j, lds_t lds) {
    const int tid = tid_opaque(), wid = tid >> 6, lane = tid & 63, lr = lane & 15, lq = lane >> 4;
    const int ck = j >> 2, h = j & 3, tok0 = ck * 64;
    LAS bf16_t* Aq = (LAS bf16_t*)lds;
    LAS bf16_t* BT = Aq + 64 * 136;
    LAS float* Os = (LAS float*)(BT + 128 * 136);
    const bf16_t* QD = (const bf16_t*)(p.ws + OFF_QD); const bf16_t* ST = (const bf16_t*)(p.ws + OFF_ST);
#pragma unroll
    for (int it = 0; it < 2; ++it) { const int idx = tid + it * 512, c = idx >> 4, rem = idx & 15, dir = rem >> 3, dc = rem & 7;
        *(LAS u32x4*)(Aq + c * 136 + dir * 64 + dc * 8) = *(const u32x4*)(QD + (size_t)(dir * 8192 + tok0 + c) * 256 + h * 64 + dc * 8); }
#pragma unroll
    for (int it = 0; it < 4; ++it) { const int idx = tid + it * 512, dir = idx >> 10, d = (idx >> 4) & 63, ec = idx & 15;
        const u32x4 v = *(const u32x4*)(ST + ((size_t)((dir * 128 + ck) * 4 + h)) * 8192 + d * 128 + ec * 8);
        const unsigned w[4] = { v.x, v.y, v.z, v.w };
#pragma unroll
        for (int i = 0; i < 4; ++i) { BT[(ec * 8 + 2 * i) * 136 + dir * 64 + d] = (bf16_t)(w[i] & 0xffffu); BT[(ec * 8 + 2 * i + 1) * 136 + dir * 64 + d] = (bf16_t)(w[i] >> 16); } }
    __syncthreads();
    const int ct = wid & 3, eh = wid >> 2; const float* OI = (const float*)(p.ws + OFF_HB);
    bf16x8 af[4];
#pragma unroll
    for (int ks = 0; ks < 4; ++ks) af[ks] = LDSFRAG(Aq + (ct * 16 + lr) * 136 + ks * 32 + lq * 8);
#pragma unroll
    for (int e4 = 0; e4 < 4; ++e4) { const int et = eh * 4 + e4; f32x4 a = {0.f, 0.f, 0.f, 0.f};
#pragma unroll
        for (int ks = 0; ks < 4; ++ks) a = MFMA16(af[ks], LDSFRAG(BT + (et * 16 + lr) * 136 + ks * 32 + lq * 8), a);
#pragma unroll
        for (int r = 0; r < 4; ++r) { const int row = ct * 16 + lq * 4 + r, col = et * 16 + lr; Os[row * 132 + col] = a[r] + OI[(size_t)(tok0 + row) * 512 + h * 128 + col]; } }
    __syncthreads();
    { const int c = tid >> 3, part = tid & 7; float o[16]; float ss = 0.f;
#pragma unroll
      for (int i = 0; i < 16; ++i) { o[i] = Os[c * 132 + part * 16 + i]; ss += o[i] * o[i]; }
      ss += __shfl_xor(ss, 1); ss += __shfl_xor(ss, 2); ss += __shfl_xor(ss, 4);
      const float rstd = rsqrtf(ss * (1.f / 128.f) + 1e-6f);
      const bf16_t* gz = (const bf16_t*)(p.ws + OFF_Z) + (size_t)(tok0 + c) * LDZ + ZGG + h * 128 + part * 16;
      const u32x4 g0 = *(const u32x4*)gz, g1 = *(const u32x4*)(gz + 8);
      const unsigned gw[8] = { g0.x, g0.y, g0.z, g0.w, g1.x, g1.y, g1.z, g1.w };
      unsigned ow[8];
#pragma unroll
      for (int i = 0; i < 8; ++i) { const float n0 = p.in[I_ONORM][l * 128 + part * 16 + 2 * i], n1 = p.in[I_ONORM][l * 128 + part * 16 + 2 * i + 1];
          ow[i] = pk2(o[2 * i] * rstd * n0 * siluf_(lo16(gw[i])), o[2 * i + 1] * rstd * n1 * siluf_(hi16(gw[i]))); }
      bf16_t* ap = (bf16_t*)(p.ws + OFF_AGLA) + (size_t)(tok0 + c) * 512 + h * 128 + part * 16;
      *(u32x4*)ap = (u32x4){ow[0], ow[1], ow[2], ow[3]}; *(u32x4*)(ap + 8) = (u32x4){ow[4], ow[5], ow[6], ow[7]}; }
    __syncthreads();
}
__device__ __forceinline__ void head_row_finish(float (&x)[16], int p8, const float* nw, bool rope, int pos, const float* R, float mul, LAS bf16_t* dst) {
    float ss = 0.f; const int cnt = p8 < 4 ? 16 : 8;
#pragma unroll
    for (int i = 0; i < 16; ++i) if (i < cnt) ss += x[i] * x[i];
    ss += __shfl_xor(ss, 1); ss += __shfl_xor(ss, 2); ss += __shfl_xor(ss, 4);
    const float rstd = rsqrtf(ss * (1.f / 96.f) + 1e-6f) * mul;
    if (p8 < 4) { unsigned w[8];
#pragma unroll
        for (int i = 0; i < 8; ++i) w[i] = pk2(x[2 * i] * rstd * nw[p8 * 16 + 2 * i], x[2 * i + 1] * rstd * nw[p8 * 16 + 2 * i + 1]);
        *(LAS u32x4*)(dst + p8 * 16) = (u32x4){w[0], w[1], w[2], w[3]}; *(LAS u32x4*)(dst + p8 * 16 + 8) = (u32x4){w[4], w[5], w[6], w[7]};
    } else { const int i0 = (p8 - 4) * 4; float o1[4], o2[4];
#pragma unroll
        for (int i = 0; i < 4; ++i) { const float a = x[i] * rstd * nw[64 + i0 + i], b = x[4 + i] * rstd * nw[80 + i0 + i];
            if (rope) { const float c = R[pos * 16 + i0 + i], s = R[16384 + pos * 16 + i0 + i]; o1[i] = a * c - b * s; o2[i] = a * s + b * c; } else { o1[i] = a; o2[i] = b; } }
        *(LAS u32x2*)(dst + 64 + i0) = (u32x2){pk2(o1[0], o1[1]), pk2(o1[2], o1[3])}; *(LAS u32x2*)(dst + 80 + i0) = (u32x2){pk2(o2[0], o2[1]), pk2(o2[2], o2[3])}; }
}
__device__ __forceinline__ void ld16bf(const bf16_t* s, float (&x)[16]) { const u32x4 a = *(const u32x4*)s, b = *(const u32x4*)(s + 8);
    x[0] = lo16(a.x); x[1] = hi16(a.x); x[2] = lo16(a.y); x[3] = hi16(a.y); x[4] = lo16(a.z); x[5] = hi16(a.z); x[6] = lo16(a.w); x[7] = hi16(a.w);
    x[8] = lo16(b.x); x[9] = hi16(b.x); x[10] = lo16(b.y); x[11] = hi16(b.y); x[12] = lo16(b.z); x[13] = hi16(b.z); x[14] = lo16(b.w); x[15] = hi16(b.w); }
__device__ __forceinline__ void ld4bf(const bf16_t* s, float* x) { const u32x2 a = *(const u32x2*)s; x[0] = lo16(a.x); x[1] = hi16(a.x); x[2] = lo16(a.y); x[3] = hi16(a.y); }
__device__ void job_attn(const Params& p, int l, int j, lds_t lds) {
    const int tid = tid_opaque(), wid = tid >> 6, lane = tid & 63, lr = lane & 15, lq = lane >> 4;
    const bool smp = j < 256; int b, h, qb; if (smp) { b = j >> 6; h = (j >> 4) & 3; qb = j & 15; } else { const int jj = j - 256; b = jj >> 4; h = (jj >> 2) & 3; qb = jj & 3; }
    const int qtok0 = smp ? 4096 + b * 1024 + qb * 64 : b * 256 + qb * 64; const int nkt = smp ? 12 : 2;
    LAS bf16_t* Ks = (LAS bf16_t*)lds;
    LAS bf16_t* VTs = Ks + 128 * 104;
    LAS bf16_t* Ps = VTs + 128 * 136 + wid * 16 * 72;
    LAS float* Mg = (LAS float*)(lds + (128 * 104 + 128 * 136 + 8 * 16 * 72) * 2);
    const bf16_t* Z = (const bf16_t*)(p.ws + OFF_Z); const bf16_t* KN = (const bf16_t*)(p.ws + OFF_KN); const bf16_t* Vb = (const bf16_t*)(p.ws + OFF_V); const float* R = (const float*)(p.ws + OFF_ROPE);
    const float* qhn = p.in[I_QHNORM] + l * 96; const float* khn = p.in[I_KHNORM] + l * 96;
    { const int row = tid >> 3, p8 = tid & 7, tok = qtok0 + row; const bf16_t* qr = (const bf16_t*)(p.ws + OFF_QRAW) + (size_t)tok * 384 + h * 96; float x[16];
      if (p8 < 4) ld16bf(qr + p8 * 16, x); else { ld4bf(qr + 64 + (p8 - 4) * 4, x); ld4bf(qr + 80 + (p8 - 4) * 4, x + 4); }
      head_row_finish(x, p8, qhn, smp, qb * 64 + row, R, 0.10206207261596575f * 1.4426950408889634f, Ks + row * 104); }
    __syncthreads();
    const int rt = wid & 3, kh = wid >> 2;
    bf16x8 qa[3];
#pragma unroll
    for (int ks = 0; ks < 3; ++ks) qa[ks] = LDSFRAG(Ks + (rt * 16 + lr) * 104 + ks * 32 + lq * 8);
    __syncthreads();
    f32x4 oacc[8]; float mrow[4], lrow[4];
#pragma unroll
    for (int e = 0; e < 8; ++e) oacc[e] = (f32x4){0.f, 0.f, 0.f, 0.f};
#pragma unroll
    for (int r = 0; r < 4; ++r) { mrow[r] = -1e30f; lrow[r] = 0.f; }
    for (int kt = 0; kt < nkt; ++kt) {
#pragma unroll 1
        for (int ps = 0; ps < 2; ++ps) { const int key = ps * 64 + (tid >> 3), p8 = tid & 7, jk = kt * 128 + key; float x[16]; int knrow; bool rope = false; int pos = 0; const float* krf = nullptr;
            if (smp) { if (jk < 512) { knrow = 8192 + b * 512 + jk; krf = p.in[I_CKR] + ((size_t)((b * 2 + l) * 512 + jk)) * 32; } else { pos = jk - 512; knrow = 4096 + b * 1024 + pos; rope = true; } }
            else knrow = b * 256 + jk;
            if (p8 < 4) ld16bf(KN + (size_t)knrow * 256 + h * 64 + p8 * 16, x);
            else if (krf) { const f32x4 a = *(const f32x4*)(krf + (p8 - 4) * 4), c = *(const f32x4*)(krf + 16 + (p8 - 4) * 4); x[0] = a[0]; x[1] = a[1]; x[2] = a[2]; x[3] = a[3]; x[4] = c[0]; x[5] = c[1]; x[6] = c[2]; x[7] = c[3]; }
            else { const bf16_t* kr = Z + (size_t)knrow * LDZ + ZMKR; ld4bf(kr + (p8 - 4) * 4, x); ld4bf(kr + 16 + (p8 - 4) * 4, x + 4); }
            head_row_finish(x, p8, khn, rope, pos, R, 1.f, Ks + key * 104); }
        { const int key = tid >> 2, part = tid & 3, jk = kt * 128 + key; int vrow;
          if (smp) vrow = jk < 512 ? 8192 + b * 512 + jk : 4096 + b * 1024 + (jk - 512); else vrow = b * 256 + jk;
          const bf16_t* vp = Vb + (size_t)vrow * 512 + h * 128 + part * 32;
#pragma unroll 1
          for (int c4 = 0; c4 < 4; ++c4) { const u32x4 v = *(const u32x4*)(vp + c4 * 8); const unsigned w[4] = { v.x, v.y, v.z, v.w };
#pragma unroll
              for (int i = 0; i < 4; ++i) { const int e = part * 32 + c4 * 8 + 2 * i; VTs[e * 136 + key] = (bf16_t)(w[i] & 0xffffu); VTs[(e + 1) * 136 + key] = (bf16_t)(w[i] >> 16); } } }
        __syncthreads();
        const int kbase = kh * 64;
        f32x4 sacc[4];
#pragma unroll
        for (int nt = 0; nt < 4; ++nt) { sacc[nt] = (f32x4){0.f, 0.f, 0.f, 0.f};
#pragma unroll
            for (int ks = 0; ks < 3; ++ks) sacc[nt] = MFMA16(qa[ks], LDSFRAG(Ks + (kbase + nt * 16 + lr) * 104 + ks * 32 + lq * 8), sacc[nt]); }
        float alpha[4];
#pragma unroll
        for (int r = 0; r < 4; ++r) { float mx = fmaxf(fmaxf(sacc[0][r], sacc[1][r]), fmaxf(sacc[2][r], sacc[3][r]));
            mx = fmaxf(mx, __shfl_xor(mx, 1)); mx = fmaxf(mx, __shfl_xor(mx, 2)); mx = fmaxf(mx, __shfl_xor(mx, 4)); mx = fmaxf(mx, __shfl_xor(mx, 8));
            const float mn = fmaxf(mrow[r], mx); alpha[r] = exp2f(mrow[r] - mn); mrow[r] = mn; float rs = 0.f;
#pragma unroll
            for (int nt = 0; nt < 4; ++nt) { const float pv = exp2f(sacc[nt][r] - mn); rs += pv; Ps[(lq * 4 + r) * 72 + nt * 16 + lr] = f2bf(pv); }
            lrow[r] = lrow[r] * alpha[r] + rs; }
#pragma unroll
        for (int e = 0; e < 8; ++e) { oacc[e][0] *= alpha[0]; oacc[e][1] *= alpha[1]; oacc[e][2] *= alpha[2]; oacc[e][3] *= alpha[3]; }
        asm volatile("s_waitcnt lgkmcnt(0)" ::: "memory");
#pragma unroll
        for (int k2 = 0; k2 < 2; ++k2) { const bf16x8 pa = LDSFRAG(Ps + lr * 72 + k2 * 32 + lq * 8);
#pragma unroll
            for (int e = 0; e < 8; ++e) oacc[e] = MFMA16(pa, LDSFRAG(VTs + (e * 16 + lr) * 136 + kbase + k2 * 32 + lq * 8), oacc[e]); }
        __syncthreads();
    }
#pragma unroll
    for (int r = 0; r < 4; ++r) { float s = lrow[r]; s += __shfl_xor(s, 1); s += __shfl_xor(s, 2); s += __shfl_xor(s, 4); s += __shfl_xor(s, 8); lrow[r] = s; }
    LAS float* Mo = Mg + rt * 16 * 132; LAS float* Ml = Mg + 4 * 16 * 132 + rt * 32;
    if (kh == 1) {
#pragma unroll
        for (int e = 0; e < 8; ++e)
#pragma unroll
            for (int r = 0; r < 4; ++r) Mo[(lq * 4 + r) * 132 + e * 16 + lr] = oacc[e][r];
        if (lr == 0) {
#pragma unroll
            for (int r = 0; r < 4; ++r) { Ml[(lq * 4 + r) * 2] = mrow[r]; Ml[(lq * 4 + r) * 2 + 1] = lrow[r]; } }
    }
    __syncthreads();
    if (kh == 0) { bf16_t* AM = (bf16_t*)(p.ws + OFF_AMLA);
#pragma unroll
        for (int r = 0; r < 4; ++r) { const int row = lq * 4 + r; const float m2 = Ml[row * 2], l2 = Ml[row * 2 + 1]; const float mm = fmaxf(mrow[r], m2), a1 = exp2f(mrow[r] - mm), a2 = exp2f(m2 - mm);
            const float inv = 1.f / (lrow[r] * a1 + l2 * a2); const int tok = qtok0 + rt * 16 + row;
#pragma unroll
            for (int e = 0; e < 8; ++e) { const int col = e * 16 + lr; const float o = (oacc[e][r] * a1 + Mo[row * 132 + col] * a2) * inv;
                const float gt = bf2f(Z[(size_t)tok * LDZ + ZMG + h * 128 + col]); AM[(size_t)tok * 512 + h * 128 + col] = f2bf(o * siluf_(gt)); } } }
    __syncthreads();
}

constexpr int N_PHASES = 15;
#ifndef S3M
#define S3M 15
#endif
#ifndef ONLY_S
#define ONLY_S -1
#endif
__device__ __forceinline__ void run_phase(const Params& p, int ph, lds_t lds) {
    const int G = (int)gridDim.x, bid = (int)blockIdx.x;
    if (ph == 0 && (ONLY_S < 0 || ONLY_S == 7)) {
        for (int j = bid; j < 96 + 256 + 32; j += G) { if (j < 96) job_ada(p, j, lds); else if (j < 352) job_ctx(p, j - 96); else job_rope(p, j - 352); }
        return;
    }
    const int l = (ph - 1) / 7, s = (ph - 1) % 7;
    unsigned char* ws = p.ws;
    if (s == 0 && (ONLY_S < 0 || ONLY_S == 0)) {
        for (int j = bid; j < 96 + WT_TOTAL + 1024; j += G) { if (j < 96) job_s5setup(p, l, j, lds); else if (j < 96 + WT_TOTAL) job_wt(p, l, j - 96, lds); else job_prep(p, l, j - 96 - WT_TOTAL); }
    } else if (s == 1 && (ONLY_S < 0 || ONLY_S == 1)) {
        Order S; S.setup(8192, 6912, 0); pg8::Gemm g{(const bf16_t*)(ws + OFF_HB), (const bf16_t*)(ws + OFF_WIN), 8192, 6912, 1024}; EpiZ E{(bf16_t*)(ws + OFF_Z)};
        pg8::gemm_phase<EpiZ, Order>(lds, g, S, E, nullptr);
    } else if (s == 2 && (ONLY_S < 0 || ONLY_S == 2)) {
        for (int j = bid; j < 640 + 512 + 1024; j += G) { if (j < 640) job_s5(p, l, j, lds); else if (j < 1152) job_glaA(p, l, j - 640, lds); else job_mlaprep(p, l, j - 1152); }
    } else if (s == 3 && (ONLY_S < 0 || ONLY_S == 3)) {
        if (S3M & 1) for (int j = bid; j < 2560; j += G) job_glaB(p, l, j);
        if (S3M & 2) { Order S; S.setup(8192, 1024, 0); pg8::Gemm g{(const bf16_t*)(ws + OFF_YG), (const bf16_t*)(ws + OFF_WGLU), 8192, 1024, 512}; EpiGLU E{(bf16_t*)(ws + OFF_AS5), (const bf16_t*)(ws + OFF_Z), p.in[I_BGLU] + l * 1024};
          pg8::gemm_phase<EpiGLU, Order>(lds, g, S, E, nullptr); }
        if (S3M & 4) { Order S; S.setup(10240, 768, 128); pg8::Gemm g{(const bf16_t*)(ws + (l == 0 ? OFF_CTX0 : OFF_CKVN)), (const bf16_t*)(ws + OFF_WKV), 10240, 768, 256}; EpiKV E{(bf16_t*)(ws + OFF_KN), (bf16_t*)(ws + OFF_V), l};
          pg8::gemm_phase<EpiKV, Order>(lds, g, S, E, nullptr); }
        if (S3M & 8) { Order S; S.setup(8192, 512, 248); pg8::Gemm g{(const bf16_t*)(ws + OFF_AQ), (const bf16_t*)(ws + OFF_WUQ), 8192, 512, 384}; EpiQ E{(bf16_t*)(ws + OFF_QRAW)};
          pg8::gemm_phase<EpiQ, Order>(lds, g, S, E, nullptr); }
    } else if (s == 4 && (ONLY_S < 0 || ONLY_S == 4)) {
        for (int j = bid; j < 512 + 512; j += G) { if (j < 512) job_attn(p, l, j, lds); else job_glaC(p, l, j - 512, lds); }
    } else if (s == 5 && (ONLY_S < 0 || ONLY_S == 5)) {
        for (int br = 0; br < 3; ++br) { Order S; S.setup(8192, 1024, 0);
            pg8::Gemm g{(const bf16_t*)(ws + (br == 0 ? OFF_AGLA : br == 1 ? OFF_AMLA : OFF_AS5)), (const bf16_t*)(ws + OFF_WBO) + (size_t)br * 1024 * 512, 8192, 1024, 512};
            EpiBo E{(bf16_t*)(ws + OFF_HB), (const bf16_t*)(ws + OFF_Z), br};
            pg8::gemm_phase<EpiBo, Order>(lds, g, S, E, nullptr); }
    } else if (s == 6 && (ONLY_S < 0 || ONLY_S == 6)) {
        Order S; S.setup(8192, 1024, 0); pg8::Gemm g{(const bf16_t*)(ws + OFF_HB), (const bf16_t*)(ws + OFF_WOUT), 8192, 1024, 1024};
        EpiOut E{p.out, l == 0 ? p.in[I_XP] : p.out, l == 0 ? p.in[I_XS] : p.out + (size_t)4096 * 1024, (const float*)(ws + OFF_ADA) + l * 5 * 3072};
        pg8::gemm_phase<EpiOut, Order>(lds, g, S, E, nullptr);
    }
}
__global__ __launch_bounds__(512, 2) void mega(KParams kp, int ph0, int ph1) {
    extern __shared__ __attribute__((aligned(16))) unsigned char shm[];
    lds_t lds = (lds_t)shm;
    if (threadIdx.x < N_IN) ((const float**)(kp.ws + OFF_TBL))[threadIdx.x] = kp.in[threadIdx.x];
    __threadfence(); __syncthreads();
    for (int ph = ph0; ph < ph1; ++ph) {
        Params p; { const float* const* tb = (const float* const*)(kp.ws + OFF_TBL); float* o = kp.out; unsigned char* w = kp.ws; asm volatile("" : "+s"(tb), "+s"(o), "+s"(w)); p.in = tb; p.out = o; p.ws = w; }
        run_phase(p, ph, lds);
        if (ph + 1 < ph1) { __syncthreads(); cg::this_grid().sync(); }
    }
}

#ifndef N_LAUNCH_MODE
#define N_LAUNCH_MODE 1
#endif
extern "C" void kernel_launch(void* const* d_in, const int* in_sizes, int n_in, void* d_out, int out_size, void* d_ws, size_t ws_size, hipStream_t stream) {
    static int grid = 0;
    if (grid == 0) {
        if (n_in != N_IN || ws_size < WS_END) { fprintf(stderr, "kernel_launch: unexpected n_in %d / ws %zu (need %zu)\n", n_in, ws_size, (size_t)WS_END); grid = -1; return; }
        int dev = 0, cus = 0, per_cu = 0;
        hipGetDevice(&dev); hipDeviceGetAttribute(&cus, hipDeviceAttributeMultiprocessorCount, dev);
        hipFuncSetAttribute((const void*)mega, hipFuncAttributeMaxDynamicSharedMemorySize, DYN_LDS);
        hipOccupancyMaxActiveBlocksPerMultiprocessor(&per_cu, (const void*)mega, 512, DYN_LDS);
        if (per_cu < 1) { fprintf(stderr, "kernel_launch: occupancy query says %d blocks per CU\n", per_cu); per_cu = 1; }
        (void)hipGetLastError();
        grid = cus;
    }
    if (grid < 0) return;
    KParams p{};
    for (int i = 0; i < N_IN; ++i) p.in[i] = (const float*)d_in[i];
    p.out = (float*)d_out; p.ws = (unsigned char*)d_ws;
#if N_LAUNCH_MODE == 0
    for (int ph = 0; ph < N_PHASES; ++ph) { hipLaunchKernelGGL(mega, dim3(grid), dim3(512), DYN_LDS, stream, p, ph, ph + 1); }
#else
    int ph0 = 0, ph1 = N_PHASES; void* args[] = {&p, &ph0, &ph1};
    hipError_t e = hipLaunchCooperativeKernel((const void*)mega, dim3(grid), dim3(512), args, DYN_LDS, stream);
    if (e != hipSuccess) fprintf(stderr, "cooperative launch failed: %s (grid %d)\n", hipGetErrorString(e), grid);
#endif
}
```

```cpp
#include <hip/hip_runtime.h>
#include <hip/hip_cooperative_groups.h>
#include <cstdio>
namespace cg = cooperative_groups;
namespace pg8 {
#define PG8_LAS __attribute__((address_space(3)))
typedef unsigned short bf16_t;
typedef short bf16x8 __attribute__((ext_vector_type(8)));
typedef float f32x4 __attribute__((ext_vector_type(4)));
typedef unsigned u32x4 __attribute__((ext_vector_type(4)));
constexpr int BM = 256, BK = 64, HALF = 128, HTB = HALF * BK * 2  , STAGE_BYTES = 8 * HTB, NXCD = 8, WGM = 8;

__host__ __device__ __forceinline__ int lds_byte(int r, int c) { const int st = (r >> 4) * 2 + (c >> 5), rr = r & 15, cc = c & 31, ob = rr * 64 + cc * 2; return st * 1024 + (ob ^ (((ob >> 9) & 1) << 5)); }
__host__ __device__ __forceinline__ void stage_rc(int b, int& R, int& C) { const int st = b / 1024, sb = b % 1024, swz = sb ^ (((sb >> 9) & 1) << 5); R = (st >> 1) * 16 + swz / 64; C = (st & 1) * 32 + (swz % 64) / 2; }
__host__ __device__ __forceinline__ int perm32(int rho) { const int n = rho >> 4, i = rho & 15; return 8 * (i >> 2) + 4 * n + (i & 3); }

struct Unit { int pm, pn; };
struct Gemm { const bf16_t* A; const bf16_t* Bt; int M, N, K; };

struct StaticOrder {
    int nM, nN, nwg, G, c;
    __host__ __device__ void init(int M, int N, int G_, int c_) { nM = M / BM; nN = N / BM; nwg = nM * nN; G = G_; c = c_; }
    __host__ __device__ bool next(int i, Unit& u) const {
        const long L = (long)i * G + c; if (L >= nwg) return false;
        int wgid = (int)L; { const int q = nwg / NXCD, r = nwg % NXCD, xcd = wgid % NXCD, off = wgid / NXCD; wgid = (xcd < r ? xcd * (q + 1) : r * (q + 1) + (xcd - r) * q) + off; }
        const int nig = WGM * nN, gid = wgid / nig, fm = gid * WGM, gsz = (nM - fm) < WGM ? (nM - fm) : WGM;
        u.pm = fm + ((wgid % nig) % gsz); u.pn = (wgid % nig) / gsz; return true;
    }
    __device__ __forceinline__ void a_ready(const Unit&) const {}
    __device__ __forceinline__ void done(const Unit&) const {}
};
__device__ __forceinline__ unsigned cvt_pk_bf16(float lo, float hi) { unsigned r; asm volatile("v_cvt_pk_bf16_f32 %0, %1, %2" : "=v"(r) : "v"(lo), "v"(hi)); return r; }
typedef float f32x2 __attribute__((ext_vector_type(2)));
template <class Epi, class Sched, bool STAMP = false>
__device__ __forceinline__ void gemm_phase(PG8_LAS unsigned char* lds, const Gemm g, const Sched& S, const Epi& E, unsigned long long* stamps) {
    int tid_ = (int)threadIdx.x; asm volatile("" : "+v"(tid_)); const int tid = tid_, wid = __builtin_amdgcn_readfirstlane(tid >> 6), lane = tid & 63, wr = wid >> 2, wc = wid & 3, fr = lane & 15, fq = lane >> 4;
    int K_ = g.K; asm volatile("" : "+s"(K_)); const int K = K_, nt = K / BK;
    int ts_lo = 0, ts_hi = 0, nts = 0; const unsigned long long rt_entry = STAMP ? (unsigned long long)wall_clock64() : 0ull;
#define PG8_STAMP() do { if (STAMP && wid == 0 && nts < 64) { const unsigned long long _c = (unsigned long long)clock64(); \
        ts_lo = (lane == nts) ? (int)(unsigned)_c : ts_lo; ts_hi = (lane == nts) ? (int)(unsigned)(_c >> 32) : ts_hi; ++nts; } } while (0)
    PG8_STAMP();
    unsigned voffA[2], voffB[2];
#pragma unroll
    for (int i = 0; i < 2; ++i) { int R, C; stage_rc(tid * 16 + i * 8192, R, C); const int Rb = Epi::PERM ? ((R & ~31) + perm32(R & 31)) : R;
        voffA[i] = (unsigned)(R * K + C) * 2u; voffB[i] = (unsigned)(Rb * K + C) * 2u; }
    const size_t kstep = (size_t)(BK * 2);
    const size_t hstep = (size_t)HALF * K * 2;
    const size_t tstep = 2 * hstep;
    const unsigned ldsw = (unsigned)wid * 1024u;
    const int aoff = lds_byte(wr * 64 + fr, fq * 8), boff = lds_byte(wc * 32 + fr, fq * 8);
#define PG8_SA(b, h) (((b) * 2 + (h)) * HTB)
#define PG8_SB(b, h) ((4 + (b) * 2 + (h)) * HTB)
#define PG8_STAGE(bufoff, gbase, voff) do { _Pragma("unroll") for (int _i = 0; _i < 2; ++_i) \
        __builtin_amdgcn_global_load_lds((const unsigned*)((const char*)(gbase) + (voff)[_i]), (PG8_LAS unsigned*)(lds + (bufoff) + ldsw + _i * 8192), 16, 0, 0); } while (0)
#define PG8_LDA(dst, b, h) do { _Pragma("unroll") for (int m = 0; m < 4; ++m) _Pragma("unroll") for (int k = 0; k < 2; ++k) dst[m][k] = *(const PG8_LAS bf16x8*)(lds + PG8_SA(b, h) + aoff + m * 2048 + k * 1024); } while (0)
#define PG8_LDB(dst, b, h) do { _Pragma("unroll") for (int n = 0; n < 2; ++n) _Pragma("unroll") for (int k = 0; k < 2; ++k) dst[n][k] = *(const PG8_LAS bf16x8*)(lds + PG8_SB(b, h) + boff + n * 2048 + k * 1024); } while (0)
#define PG8_MMA(ai, bj, At, Bt) do { __builtin_amdgcn_s_setprio(1); _Pragma("unroll") for (int m = 0; m < 4; ++m) _Pragma("unroll") for (int n = 0; n < 2; ++n) _Pragma("unroll") for (int k = 0; k < 2; ++k) \
        acc[ai][bj][m][n] = __builtin_amdgcn_mfma_f32_16x16x32_bf16(Bt[n][k], At[m][k], acc[ai][bj][m][n], 0, 0, 0); __builtin_amdgcn_s_setprio(0); } while (0)
#define PG8_WAIT_V(n) asm volatile("s_waitcnt vmcnt(" #n ")" ::: "memory")
#define PG8_WAIT_L(n) asm volatile("s_waitcnt lgkmcnt(" #n ")" ::: "memory")
#define PG8_BAR __builtin_amdgcn_s_barrier()
#define PG8_SCHED __builtin_amdgcn_sched_barrier(0)
    Unit cur, nxt; int ui = 0;
    if (!S.next(0, cur)) return;
    f32x4 acc[2][2][4][2];
#pragma unroll
    for (int a = 0; a < 2; ++a)
#pragma unroll
        for (int b = 0; b < 2; ++b)
#pragma unroll
            for (int m = 0; m < 4; ++m)
#pragma unroll
                for (int n = 0; n < 2; ++n) acc[a][b][m][n] = (f32x4){0.f, 0.f, 0.f, 0.f};
    bf16x8 At[4][2], B0[2][2], B1[2][2];
    const char* cA = (const char*)g.A + (size_t)cur.pm * tstep; const char* cB = (const char*)g.Bt + (size_t)cur.pn * tstep;
    S.a_ready(cur);
    PG8_STAGE(PG8_SB(0, 0), cB, voffB); PG8_STAGE(PG8_SA(0, 0), cA, voffA); PG8_STAGE(PG8_SB(0, 1), cB + hstep, voffB); PG8_STAGE(PG8_SA(0, 1), cA + hstep, voffA);
    if (wr == 1) PG8_BAR;
    PG8_WAIT_V(4); PG8_BAR;
    PG8_STAGE(PG8_SB(1, 0), cB + kstep, voffB); PG8_STAGE(PG8_SA(1, 0), cA + kstep, voffA); PG8_STAGE(PG8_SB(1, 1), cB + hstep + kstep, voffB);
    PG8_WAIT_V(6); PG8_BAR;
    PG8_STAMP();
    for (;;) {
        const bool has_next = S.next(ui + 1, nxt);
        const char* nA = has_next ? (const char*)g.A + (size_t)nxt.pm * tstep : cA; const char* nB = has_next ? (const char*)g.Bt + (size_t)nxt.pn * tstep : cB;
        for (int t = 0; t < nt; t += 2) {
            const bool last = (t == nt - 2);
            const char* a1 = cA + (size_t)(t + 1) * kstep;
            const char* a2 = last ? nA : cA + (size_t)(t + 2) * kstep; const char* b2 = last ? nB : cB + (size_t)(t + 2) * kstep;
            const char* a3 = a2 + kstep; const char* b3 = b2 + kstep;
            if (last && has_next) S.a_ready(nxt);
            PG8_LDB(B0, 0, 0); PG8_SCHED; PG8_LDA(At, 0, 0); PG8_STAGE(PG8_SA(1, 1), a1 + hstep, voffA);
            PG8_WAIT_L(8); PG8_BAR; PG8_WAIT_L(0); PG8_MMA(0, 0, At, B0); PG8_BAR; PG8_SCHED;
            PG8_LDB(B1, 0, 1); PG8_STAGE(PG8_SB(0, 0), b2, voffB);
            PG8_BAR; PG8_WAIT_L(0); PG8_MMA(0, 1, At, B1); PG8_BAR;
            PG8_LDA(At, 0, 1); PG8_STAGE(PG8_SA(0, 0), a2, voffA);
            PG8_BAR; PG8_WAIT_L(0); PG8_MMA(1, 0, At, B0); PG8_BAR; PG8_SCHED;
            PG8_STAGE(PG8_SB(0, 1), b2 + hstep, voffB);
            PG8_WAIT_V(6); PG8_BAR; PG8_MMA(1, 1, At, B1); PG8_BAR;
            PG8_LDB(B0, 1, 0); PG8_SCHED; PG8_LDA(At, 1, 0); PG8_STAGE(PG8_SA(0, 1), a2 + hstep, voffA);
            PG8_WAIT_L(8); PG8_BAR; PG8_WAIT_L(0); PG8_MMA(0, 0, At, B0); PG8_BAR; PG8_SCHED;
            PG8_LDB(B1, 1, 1); PG8_STAGE(PG8_SB(1, 0), b3, voffB);
            PG8_BAR; PG8_WAIT_L(0); PG8_MMA(0, 1, At, B1); PG8_BAR;
            PG8_LDA(At, 1, 1); PG8_STAGE(PG8_SA(1, 0), a3, voffA);
            PG8_BAR; PG8_WAIT_L(0); PG8_MMA(1, 0, At, B0); PG8_BAR; PG8_SCHED;
            PG8_STAGE(PG8_SB(1, 1), b3 + hstep, voffB);
            PG8_WAIT_V(6); PG8_BAR; PG8_MMA(1, 1, At, B1); PG8_BAR;
        }
        PG8_STAMP();
        if constexpr (!Epi::AFTER_DRAIN) { E(acc, cur, wr, wc, fr, fq); S.done(cur); }
        PG8_STAMP();
        if (!has_next) break;
#pragma unroll
        for (int a = 0; a < 2; ++a)
#pragma unroll
            for (int b = 0; b < 2; ++b)
#pragma unroll
                for (int m = 0; m < 4; ++m)
#pragma unroll
                    for (int n = 0; n < 2; ++n) acc[a][b][m][n] = (f32x4){0.f, 0.f, 0.f, 0.f};
        cur = nxt; cA = nA; cB = nB; ++ui;
    }
    PG8_WAIT_V(0);
    if (wr == 0) PG8_BAR;
    PG8_BAR;
    if constexpr (Epi::AFTER_DRAIN) { E.fused(acc, cur, wr, wc, fr, fq, lds, wid, lane); S.done(cur); }
    PG8_STAMP();
    if (STAMP && wid == 0) { stamps[lane] = lane < nts ? (((unsigned long long)(unsigned)ts_hi << 32) | (unsigned)ts_lo) : 0ull;
        if (lane == 62) stamps[62] = rt_entry; if (lane == 63) stamps[63] = (unsigned long long)wall_clock64(); }
#undef PG8_STAMP
#undef PG8_SA
#undef PG8_SB
#undef PG8_STAGE
#undef PG8_LDA
#undef PG8_LDB
#undef PG8_MMA
#undef PG8_WAIT_V
#undef PG8_WAIT_L
#undef PG8_BAR
#undef PG8_SCHED
}
}
using pg8::bf16_t; using pg8::bf16x8; using pg8::f32x4; using pg8::u32x4; using pg8::Unit;
#define LAS __attribute__((address_space(3)))
typedef unsigned u32x2 __attribute__((ext_vector_type(2)));
typedef LAS unsigned char* lds_t;
__device__ __forceinline__ int tid_opaque() { int t = (int)threadIdx.x; asm volatile("" : "+v"(t)); return t; }
typedef float f32x2_t __attribute__((ext_vector_type(2)));

enum { I_XP = 0, I_XS, I_C, I_CCTX, I_CKV, I_CKR, I_SGLA, I_SS5, I_NORMW, I_WADA, I_BADA, I_WIN, I_WA2, I_BA, I_ONORM, I_QNORM, I_WUQ, I_KVNORM, I_WUK, I_WUV,
       I_QHNORM, I_KHNORM, I_ARE, I_AIM, I_LOGDT, I_BRE, I_BIM, I_CRE, I_CIM, I_S5D, I_WGLU, I_BGLU, I_WBOG, I_WBOM, I_WBOS, I_WOUT, N_IN };
struct KParams { const float* in[N_IN]; float* out; unsigned char* ws; };
struct Params { const float* const* in; float* out; unsigned char* ws; };

constexpr int LDZ = 6912;
constexpr int ZQ = 0, ZK = 256, ZV = 512, ZGA = 1024, ZGG = 1056, ZMQ = 1568, ZMKV = 1952, ZMKR = 2208, ZMG = 2240, ZSU = 2752, ZSG = 3264, ZMERGE = 3776;
constexpr size_t OUT_YP = 0, OUT_CKV = 8388608, OUT_KR = 10485760, OUT_GLA = 10747904, OUT_S5 = 12845056;
constexpr size_t OFF_WIN = 0;
constexpr size_t OFF_QD = OFF_WIN, OFF_KN = OFF_WIN + 8388608;
constexpr size_t OFF_WUQ = OFF_WIN + 14155776;
constexpr size_t OFF_WKV = OFF_WUQ + 393216;
constexpr size_t OFF_WGLU = OFF_WKV + 393216;
constexpr size_t OFF_WBO = OFF_WGLU + 1048576;
constexpr size_t OFF_WOUT = OFF_WBO + 3145728;
constexpr size_t OFF_S5M = OFF_WOUT + 2097152;
constexpr size_t OFF_V = OFF_S5M;
constexpr size_t OFF_P16 = OFF_S5M + 12582912;
constexpr size_t OFF_ADA = OFF_P16 + 32768;
constexpr size_t OFF_ROPE = OFF_ADA + 122880;
constexpr size_t OFF_CTX0 = OFF_ROPE + 131072;
constexpr size_t OFF_CKVN = OFF_CTX0 + 1048576;
constexpr size_t OFF_CTX1 = OFF_CKVN + 4194304;
constexpr size_t OFF_HB = OFF_CTX1 + 1048576;
constexpr size_t OFF_Z = OFF_HB + 16777216;
constexpr size_t OFF_KV = OFF_Z + 113246208;
constexpr size_t OFF_AGLA = OFF_KV, OFF_AMLA = OFF_KV + 8388608;
constexpr size_t OFF_DEC = OFF_KV + 33554432;
constexpr size_t OFF_ST = OFF_DEC + 262144;
constexpr size_t OFF_AQ = OFF_ST + 16777216;
constexpr size_t OFF_QRAW = OFF_AQ + 6291456;
constexpr size_t OFF_AS5 = OFF_QRAW + 6291456;
constexpr size_t OFF_YG = OFF_AS5 + 8388608;
constexpr size_t OFF_TBL = OFF_YG + 8388608;
constexpr size_t OFF_BAR = OFF_TBL + 512;
constexpr size_t WS_END = OFF_BAR + 16384;
constexpr int DYN_LDS = 147456;

__device__ __forceinline__ float bf2f(bf16_t b) { return __uint_as_float(((unsigned)b) << 16); }
__device__ __forceinline__ bf16_t f2bf(float f) { unsigned u = __float_as_uint(f); u += 0x7FFFu + ((u >> 16) & 1u); return (bf16_t)(u >> 16); }
__device__ __forceinline__ unsigned pk2(float lo, float hi) { return pg8::cvt_pk_bf16(lo, hi); }
__device__ __forceinline__ float lo16(unsigned w) { return __uint_as_float(w << 16); }
__device__ __forceinline__ float hi16(unsigned w) { return __uint_as_float(w & 0xffff0000u); }
__device__ __forceinline__ float sigmoidf_(float x) { return 1.f / (1.f + __expf(-x)); }
__device__ __forceinline__ float siluf_(float x) { return x / (1.f + __expf(-x)); }
__device__ __forceinline__ void store8(bf16_t* p, const f32x4& a, const f32x4& b) { u32x4 w; w.x = pk2(a[0], a[1]); w.y = pk2(a[2], a[3]); w.z = pk2(b[0], b[1]); w.w = pk2(b[2], b[3]); *(u32x4*)p = w; }
#define MFMA16(a, b, c) __builtin_amdgcn_mfma_f32_16x16x32_bf16(a, b, c, 0, 0, 0)
#define LDSFRAG(ptr) (*(const LAS bf16x8*)(ptr))

struct Order : pg8::StaticOrder {
    __device__ void setup(int M, int N, int rot) { const int G = (int)gridDim.x; init(M, N, G, (int)((blockIdx.x + (unsigned)rot) % (unsigned)G)); }
};

struct EpiZ { static constexpr bool PERM = true, AFTER_DRAIN = false; bf16_t* Z;
    __device__ __forceinline__ void operator()(const f32x4 (&acc)[2][2][4][2], const Unit& u, int wr, int wc, int fr, int fq) const {
        const int row0 = u.pm * 256 + wr * 64 + fr, col0 = u.pn * 256 + wc * 32 + 8 * fq;
#pragma unroll
        for (int ai = 0; ai < 2; ++ai)
#pragma unroll
            for (int m = 0; m < 4; ++m) { bf16_t* rp = Z + (size_t)(row0 + ai * 128 + m * 16) * LDZ + col0;
#pragma unroll
                for (int bj = 0; bj < 2; ++bj) store8(rp + bj * 128, acc[ai][bj][m][0], acc[ai][bj][m][1]); }
    } };
struct EpiQ { static constexpr bool PERM = true, AFTER_DRAIN = false; bf16_t* Q;
    __device__ __forceinline__ void operator()(const f32x4 (&acc)[2][2][4][2], const Unit& u, int wr, int wc, int fr, int fq) const {
        const int row0 = u.pm * 256 + wr * 64 + fr, col0 = u.pn * 256 + wc * 32 + 8 * fq;
#pragma unroll
        for (int ai = 0; ai < 2; ++ai)
#pragma unroll
            for (int m = 0; m < 4; ++m) { bf16_t* rp = Q + (size_t)(row0 + ai * 128 + m * 16) * 384 + col0;
#pragma unroll
                for (int bj = 0; bj < 2; ++bj) if (col0 + bj * 128 < 384) store8(rp + bj * 128, acc[ai][bj][m][0], acc[ai][bj][m][1]);
                }
    } };
struct EpiKV { static constexpr bool PERM = true, AFTER_DRAIN = false; bf16_t* KN; bf16_t* V; int layer;
    __device__ __forceinline__ void operator()(const f32x4 (&acc)[2][2][4][2], const Unit& u, int wr, int wc, int fr, int fq) const {
        int rb = u.pm * 256; if (layer == 0) rb = rb < 2048 ? 8192 + rb : rb - 2048;
        const int row0 = rb + wr * 64 + fr, cl = wc * 32 + 8 * fq;
#pragma unroll
        for (int ai = 0; ai < 2; ++ai)
#pragma unroll
            for (int m = 0; m < 4; ++m) { const size_t r = (size_t)(row0 + ai * 128 + m * 16);
                bf16_t* rp = u.pn == 0 ? KN + r * 256 + cl : V + r * 512 + (u.pn - 1) * 256 + cl;
#pragma unroll
                for (int bj = 0; bj < 2; ++bj) store8(rp + bj * 128, acc[ai][bj][m][0], acc[ai][bj][m][1]);
                }
    } };
struct EpiGLU { static constexpr bool PERM = true, AFTER_DRAIN = false; bf16_t* O; const bf16_t* Z; const float* bias;
    __device__ __forceinline__ void operator()(const f32x4 (&acc)[2][2][4][2], const Unit& u, int wr, int wc, int fr, int fq) const {
        const int row0 = u.pm * 256 + wr * 64 + fr, oc = u.pn * 128 + wc * 32 + 8 * fq;
        float bv[8], bg[8];
#pragma unroll
        for (int i = 0; i < 8; ++i) { bv[i] = bias[oc + i]; bg[i] = bias[512 + oc + i]; }
#pragma unroll
        for (int ai = 0; ai < 2; ++ai)
#pragma unroll
            for (int m = 0; m < 4; ++m) { const size_t r = (size_t)(row0 + ai * 128 + m * 16);
                const u32x4 sg = *(const u32x4*)(Z + r * LDZ + ZSG + oc);
                float g[8] = { lo16(sg.x), hi16(sg.x), lo16(sg.y), hi16(sg.y), lo16(sg.z), hi16(sg.z), lo16(sg.w), hi16(sg.w) };
                float o[8];
#pragma unroll
                for (int i = 0; i < 8; ++i) { const float zv = acc[ai][0][m][i >> 2][i & 3] + bv[i], zg = acc[ai][1][m][i >> 2][i & 3] + bg[i]; o[i] = zv * sigmoidf_(zg) * siluf_(g[i]); }
                u32x4 w; w.x = pk2(o[0], o[1]); w.y = pk2(o[2], o[3]); w.z = pk2(o[4], o[5]); w.w = pk2(o[6], o[7]);
                *(u32x4*)(O + r * 512 + oc) = w; }
    } };
struct EpiBo { static constexpr bool PERM = true, AFTER_DRAIN = false; bf16_t* MIX; const bf16_t* Z; int branch;
    __device__ __forceinline__ void operator()(const f32x4 (&acc)[2][2][4][2], const Unit& u, int wr, int wc, int fr, int fq) const {
        const int row0 = u.pm * 256 + wr * 64 + fr, col0 = u.pn * 256 + wc * 32 + 8 * fq;
#pragma unroll
        for (int ai = 0; ai < 2; ++ai)
#pragma unroll
            for (int m = 0; m < 4; ++m) { const size_t r = (size_t)(row0 + ai * 128 + m * 16);
#pragma unroll
                for (int bj = 0; bj < 2; ++bj) { const int c = col0 + bj * 128;
                    const u32x4 sg = *(const u32x4*)(Z + r * LDZ + ZMERGE + branch * 1024 + c);
                    float g[8] = { lo16(sg.x), hi16(sg.x), lo16(sg.y), hi16(sg.y), lo16(sg.z), hi16(sg.z), lo16(sg.w), hi16(sg.w) };
                    float o[8];
#pragma unroll
                    for (int i = 0; i < 8; ++i) o[i] = sigmoidf_(g[i]) * acc[ai][bj][m][i >> 2][i & 3];
                    bf16_t* mp = MIX + r * 1024 + c;
                    if (branch > 0) { const u32x4 pv = *(const u32x4*)mp;
                        o[0] += lo16(pv.x); o[1] += hi16(pv.x); o[2] += lo16(pv.y); o[3] += hi16(pv.y); o[4] += lo16(pv.z); o[5] += hi16(pv.z); o[6] += lo16(pv.w); o[7] += hi16(pv.w); }
                    u32x4 w; w.x = pk2(o[0], o[1]); w.y = pk2(o[2], o[3]); w.z = pk2(o[4], o[5]); w.w = pk2(o[6], o[7]);
                    *(u32x4*)mp = w; } }
    } };
struct EpiOut { static constexpr bool PERM = false, AFTER_DRAIN = false; float* Y; const float* xp; const float* xs; const float* ada;
    __device__ __forceinline__ void operator()(const f32x4 (&acc)[2][2][4][2], const Unit& u, int wr, int wc, int fr, int fq) const {
        const int row0 = u.pm * 256 + wr * 64 + fr, col0 = u.pn * 256 + wc * 32 + 4 * fq;
        const int ar = u.pm < 16 ? 0 : 1 + ((u.pm - 16) >> 2);
        const float* gp = ada + ar * 3072 + 2048;
        f32x4 gv[2][2];
#pragma unroll
        for (int bj = 0; bj < 2; ++bj)
#pragma unroll
            for (int n = 0; n < 2; ++n) gv[bj][n] = *(const f32x4*)(gp + col0 + bj * 128 + n * 16);
#pragma unroll
        for (int ai = 0; ai < 2; ++ai)
#pragma unroll
            for (int m = 0; m < 4; ++m) { const int r = row0 + ai * 128 + m * 16;
                const float* xr = (r < 4096 ? xp + (size_t)r * 1024 : xs + (size_t)(r - 4096) * 1024) + col0;
                float* yr = Y + (size_t)r * 1024 + col0;
#pragma unroll
                for (int bj = 0; bj < 2; ++bj)
#pragma unroll
                    for (int n = 0; n < 2; ++n) { const f32x4 xv = *(const f32x4*)(xr + bj * 128 + n * 16); *(f32x4*)(yr + bj * 128 + n * 16) = xv + gv[bj][n] * acc[ai][bj][m][n]; } }
    } };

__device__ void job_ada(const Params& p, int j, lds_t lds) {
    LAS float* sc = (LAS float*)lds; LAS float* red = sc + 5 * 1024;
    const int l = j / 96, c0 = (j % 96) * 32, tid = tid_opaque();
    for (int i = tid; i < 5 * 1024; i += 512) { const int r = i >> 10, k = i & 1023; const float v = r == 0 ? p.in[I_CCTX][k] : p.in[I_C][(r - 1) * 1024 + k]; sc[i] = v / (1.f + expf(-v)); }
    __syncthreads();
    const int col = tid & 31, kg = tid >> 5; const float* W = p.in[I_WADA] + (size_t)l * 1024 * 3072 + (size_t)(kg * 64) * 3072 + c0 + col;
    float a0 = 0.f, a1 = 0.f, a2 = 0.f, a3 = 0.f, a4 = 0.f;
#pragma unroll 1
    for (int kb = 0; kb < 64; kb += 16) { float w[16];
#pragma unroll
        for (int i = 0; i < 16; ++i) w[i] = W[(size_t)(kb + i) * 3072];
#pragma unroll
        for (int i = 0; i < 16; ++i) { const int k = kg * 64 + kb + i; a0 += sc[k] * w[i]; a1 += sc[1024 + k] * w[i]; a2 += sc[2048 + k] * w[i]; a3 += sc[3072 + k] * w[i]; a4 += sc[4096 + k] * w[i]; } }
    red[(kg * 5 + 0) * 32 + col] = a0; red[(kg * 5 + 1) * 32 + col] = a1; red[(kg * 5 + 2) * 32 + col] = a2; red[(kg * 5 + 3) * 32 + col] = a3; red[(kg * 5 + 4) * 32 + col] = a4;
    __syncthreads();
    if (tid < 160) { const int r = tid >> 5, cc = tid & 31; float s = p.in[I_BADA][l * 3072 + c0 + cc];
        for (int g = 0; g < 16; ++g) s += red[(g * 5 + r) * 32 + cc];
        ((float*)(p.ws + OFF_ADA))[(l * 5 + r) * 3072 + c0 + cc] = s; }
    __syncthreads();
}
__device__ void job_ctx(const Params& p, int j) {
    const int base = j * 4096 + tid_opaque() * 8; const int l = base / (2048 * 256), rem = base % (2048 * 256), row = rem >> 8, c = rem & 255, b = row >> 9, jj = row & 511;
    const float* s = p.in[I_CKV] + ((size_t)((b * 2 + l) * 512 + jj)) * 256 + c;
    const f32x4 v0 = *(const f32x4*)s, v1 = *(const f32x4*)(s + 4);
    bf16_t* d = (bf16_t*)(p.ws + (l == 0 ? OFF_CTX0 : OFF_CTX1)) + (size_t)row * 256 + c;
    store8(d, v0, v1);
}
__device__ void job_rope(const Params& p, int j) {
    const int idx = j * 512 + tid_opaque(), pos = idx >> 4, i = idx & 15, f = i & 7;
    const float inv = powf(10000.f, -(float)f / 8.f); const float ang = (float)(i < 8 ? (pos >> 6) : (pos & 63)) * inv;
    float* R = (float*)(p.ws + OFF_ROPE); R[idx] = cosf(ang); R[16384 + idx] = sinf(ang);
}

__device__ void job_prep(const Params& p, int l, int j) {
    const int tid = tid_opaque(), wid = tid >> 6, lane = tid & 63, row = j * 8 + wid;
    const float* x = l == 0 ? (row < 4096 ? p.in[I_XP] + (size_t)row * 1024 : p.in[I_XS] + (size_t)(row - 4096) * 1024) : p.out + (size_t)row * 1024;
    const int ar = row < 4096 ? 0 : 1 + ((row - 4096) >> 10);
    const float* ada = (const float*)(p.ws + OFF_ADA) + (l * 5 + ar) * 3072; const float* nw = p.in[I_NORMW] + l * 1024;
    f32x4 v[4]; float ss = 0.f;
#pragma unroll
    for (int i = 0; i < 4; ++i) { v[i] = *(const f32x4*)(x + i * 256 + lane * 4); ss += v[i][0] * v[i][0] + v[i][1] * v[i][1] + v[i][2] * v[i][2] + v[i][3] * v[i][3]; }
#pragma unroll
    for (int o = 1; o < 64; o <<= 1) ss += __shfl_xor(ss, o);
    const float rstd = rsqrtf(ss * (1.f / 1024.f) + 1e-6f);
    bf16_t* h = (bf16_t*)(p.ws + OFF_HB) + (size_t)row * 1024;
#pragma unroll
    for (int i = 0; i < 4; ++i) { const int c = i * 256 + lane * 4; const f32x4 w = *(const f32x4*)(nw + c), sh = *(const f32x4*)(ada + c), sc = *(const f32x4*)(ada + 1024 + c);
        float o[4];
#pragma unroll
        for (int k = 0; k < 4; ++k) o[k] = v[i][k] * rstd * w[k] * (1.f + sc[k]) + sh[k];
        u32x2 pk; pk.x = pk2(o[0], o[1]); pk.y = pk2(o[2], o[3]); *(u32x2*)(h + c) = pk; }
}
__device__ void wt_tile(const float* src, int ldsrc, int scol, bf16_t* dst, int K, int n0, int k0, lds_t lds) {
    LAS float* t = (LAS float*)lds; const int tid = tid_opaque();
    if (scol >= 0) {
#pragma unroll
        for (int i = 0; i < 8; ++i) { const int kk = i * 8 + (tid >> 6), nn = tid & 63; t[kk * 65 + nn] = src[(size_t)(k0 + kk) * ldsrc + scol + nn]; }
    }
    __syncthreads();
    const int n = tid >> 3, kc = tid & 7; u32x4 w = {0u, 0u, 0u, 0u};
    if (scol >= 0) { const LAS float* s = t + (kc * 8) * 65 + n; w.x = pk2(s[0], s[65]); w.y = pk2(s[130], s[195]); w.z = pk2(s[260], s[325]); w.w = pk2(s[390], s[455]); }
    *(u32x4*)(dst + (size_t)(n0 + n) * K + k0 + kc * 8) = w;
    __syncthreads();
}
constexpr int WT_WIN = 108 * 16, WT_WUQ = 8 * 6, WT_WKV = 12 * 4, WT_WGLU = 16 * 8, WT_WBO = 16 * 8, WT_WOUT = 16 * 16, WT_TOTAL = WT_WIN + WT_WUQ + WT_WKV + WT_WGLU + 3 * WT_WBO + WT_WOUT;
__device__ void job_wt(const Params& p, int l, int t, lds_t lds) {
    if (t < WT_WIN) { const int nt = t / 16, kt = t % 16; wt_tile(p.in[I_WIN] + (size_t)l * 1024 * 6848, 6848, nt < 107 ? nt * 64 : -1, (bf16_t*)(p.ws + OFF_WIN), 1024, nt * 64, kt * 64, lds); return; } t -= WT_WIN;
    if (t < WT_WUQ) { const int nt = t / 6, kt = t % 6; wt_tile(p.in[I_WUQ] + (size_t)l * 384 * 384, 384, nt < 6 ? nt * 64 : -1, (bf16_t*)(p.ws + OFF_WUQ), 384, nt * 64, kt * 64, lds); return; } t -= WT_WUQ;
    if (t < WT_WKV) { const int nt = t / 4, kt = t % 4;
        if (nt < 4) wt_tile(p.in[I_WUK] + (size_t)l * 256 * 256, 256, nt * 64, (bf16_t*)(p.ws + OFF_WKV), 256, nt * 64, kt * 64, lds);
        else wt_tile(p.in[I_WUV] + (size_t)l * 256 * 512, 512, (nt - 4) * 64, (bf16_t*)(p.ws + OFF_WKV), 256, nt * 64, kt * 64, lds);
        return; } t -= WT_WKV;
    if (t < WT_WGLU) { const int nt = t / 8, kt = t % 8, n0 = nt * 64; const int scol = ((n0 >> 7) & 1) * 512 + (n0 >> 8) * 128 + (n0 & 127);
        wt_tile(p.in[I_WGLU] + (size_t)l * 512 * 1024, 1024, scol, (bf16_t*)(p.ws + OFF_WGLU), 512, n0, kt * 64, lds); return; } t -= WT_WGLU;
    if (t < 3 * WT_WBO) { const int br = t / WT_WBO, tt = t % WT_WBO, nt = tt / 8, kt = tt % 8;
        wt_tile(p.in[I_WBOG + br] + (size_t)l * 512 * 1024, 1024, nt * 64, (bf16_t*)(p.ws + OFF_WBO) + (size_t)br * 1024 * 512, 512, nt * 64, kt * 64, lds); return; } t -= 3 * WT_WBO;
    { const int nt = t / 16, kt = t % 16; wt_tile(p.in[I_WOUT] + (size_t)l * 1024 * 1024, 1024, nt * 64, (bf16_t*)(p.ws + OFF_WOUT), 1024, nt * 64, kt * 64, lds); }
}
__device__ void job_s5setup(const Params& p, int l, int j, lds_t lds) {
    const int g = j / 3, which = j % 3, tid = tid_opaque();
    LAS f32x2_t* pw = (LAS f32x2_t*)lds;
    LAS f32x2_t* Bt = pw + 2 * 17 * 64;
    LAS f32x2_t* Cn = Bt + 2 * 64 * 16;
    LAS float* Kt = (LAS float*)(Cn + 64 * 16);
    if (tid < 128) { const int d = tid >> 6, n = tid & 63;
        const float dt = expf(p.in[I_LOGDT][(l * 2 + d) * 32 + g]);
        const float are = p.in[I_ARE][((l * 2 + d) * 32 + g) * 64 + n], aim = p.in[I_AIM][((l * 2 + d) * 32 + g) * 64 + n];
        for (int tau = 0; tau <= 16; ++tau) { const float mag = expf(are * dt * (float)tau); float s, c; sincosf(aim * dt * (float)tau, &s, &c); pw[(d * 17 + tau) * 64 + n] = (f32x2_t){mag * c, mag * s}; }
        float s1, c1; sincosf(aim * dt, &s1, &c1); float sh = sinf(0.5f * aim * dt);
        const float em1 = expm1f(are * dt), mag1 = em1 + 1.f;
        const float nre = em1 * c1 - 2.f * sh * sh, abim = mag1 * s1, den = are * are + aim * aim;
        const float cfr = (nre * are + abim * aim) / den, cfi = (abim * are - nre * aim) / den;
        for (int q = 0; q < 16; ++q) { const float br = p.in[I_BRE][((size_t)(l * 32 + g) * 64 + n) * 16 + q], bi = p.in[I_BIM][((size_t)(l * 32 + g) * 64 + n) * 16 + q];
            Bt[(d * 64 + n) * 16 + q] = (f32x2_t){cfr * br - cfi * bi, cfr * bi + cfi * br}; }
        if (which == 1) ((f32x2_t*)(p.ws + OFF_P16))[(g * 2 + d) * 64 + n] = pw[(d * 17 + 16) * 64 + n];
    }
    for (int i = tid; i < 1024; i += 512) { const int n = i >> 4, pp = i & 15; Cn[i] = (f32x2_t){p.in[I_CRE][((size_t)(l * 32 + g) * 16 + pp) * 64 + n], p.in[I_CIM][((size_t)(l * 32 + g) * 16 + pp) * 64 + n]}; }
    __syncthreads();
    bf16_t* M = (bf16_t*)(p.ws + OFF_S5M) + (size_t)(g * 3 + which) * 65536;
    if (which == 0) {
        for (int i = tid; i < 8192; i += 512) { const int d = i >> 12, tau = (i >> 8) & 15, pp = (i >> 4) & 15, q = i & 15; float s = 0.f;
            for (int n = 0; n < 64; ++n) { const f32x2_t c = Cn[n * 16 + pp], w = pw[(d * 17 + tau) * 64 + n], b = Bt[(d * 64 + n) * 16 + q];
                const float cwr = c.x * w.x - c.y * w.y, cwi = c.x * w.y + c.y * w.x; s += cwr * b.x - cwi * b.y; }
            Kt[i] = s; }
        __syncthreads();
        for (int i = tid; i < 65536; i += 512) { const int no = i >> 8, k = i & 255, t = no >> 4, pp = no & 15, s = k >> 4, q = k & 15; float v;
            if (t > s) v = Kt[(0 * 16 + (t - s)) * 256 + pp * 16 + q];
            else if (t < s) v = Kt[(1 * 16 + (s - t)) * 256 + pp * 16 + q];
            else { v = Kt[pp * 16 + q] + Kt[16 * 256 + pp * 16 + q]; if (pp == q) v += p.in[I_S5D][l * 512 + g * 16 + pp]; }
            M[i] = f2bf(v); }
    } else if (which == 1) {
        for (int i = tid; i < 65536; i += 512) { const int no = i >> 8, k = i & 255, d = no >> 7, ri = (no >> 6) & 1, n = no & 63, s = k >> 4, q = k & 15; const int e = d == 0 ? 15 - s : s;
            const f32x2_t w = pw[(d * 17 + e) * 64 + n], b = Bt[(d * 64 + n) * 16 + q];
            M[i] = f2bf(ri == 0 ? w.x * b.x - w.y * b.y : w.x * b.y + w.y * b.x); }
    } else {
        for (int i = tid; i < 65536; i += 512) { const int no = i >> 8, k = i & 255, t = no >> 4, pp = no & 15, d = k >> 7, ri = (k >> 6) & 1, n = k & 63; const int e = d == 0 ? t + 1 : 16 - t;
            const f32x2_t c = Cn[n * 16 + pp], w = pw[(d * 17 + e) * 64 + n];
            M[i] = f2bf(ri == 0 ? c.x * w.x - c.y * w.y : -(c.x * w.y + c.y * w.x)); }
    }
    __syncthreads();
}

__device__ __forceinline__ float gelu_tanh(float x) { const float u = 0.7978845608f * (x + 0.044715f * x * x * x); const float t = 1.f - 2.f / (1.f + __expf(2.f * u)); return 0.5f * x * (1.f + t); }
__device__ void job_s5(const Params& p, int l, int j, lds_t lds) {
    const int tid = tid_opaque(), wid = tid >> 6, lane = tid & 63, lr = lane & 15, lq = lane >> 4;
    int bb, g; if (j < 128) { bb = 16 + (j >> 5); g = j & 31; } else { bb = (j - 128) >> 5; g = (j - 128) & 31; }
    const int M = bb < 16 ? 16 : 64, MT = M >> 4; const int tok0 = bb < 16 ? bb * 256 : 4096 + (bb - 16) * 1024;
    LAS bf16_t* Us = (LAS bf16_t*)lds; LAS bf16_t* Xs = Us + 64 * 264; LAS float* Xin = (LAS float*)(lds + 2 * 64 * 264 * 2);
    const bf16_t* Z = (const bf16_t*)(p.ws + OFF_Z);
    for (int idx = tid; idx < M * 32; idx += 512) { const int tok = idx >> 1, hf = idx & 1;
        *(LAS u32x4*)(Us + (tok >> 4) * 264 + (tok & 15) * 16 + hf * 8) = *(const u32x4*)(Z + (size_t)(tok0 + tok) * LDZ + ZSU + g * 16 + hf * 8); }
    __syncthreads();
    const bf16_t* TT = (const bf16_t*)(p.ws + OFF_S5M) + (size_t)(g * 3) * 65536; const bf16_t* G = TT + 65536; const bf16_t* Cc = G + 65536;
    f32x4 acc[4][2];
#pragma unroll
    for (int a = 0; a < 4; ++a) { acc[a][0] = (f32x4){0.f, 0.f, 0.f, 0.f}; acc[a][1] = acc[a][0]; }
    for (int ks = 0; ks < 8; ++ks) {
        bf16x8 b0 = *(const bf16x8*)(G + (size_t)(wid * 32 + lr) * 256 + ks * 32 + lq * 8), b1 = *(const bf16x8*)(G + (size_t)(wid * 32 + 16 + lr) * 256 + ks * 32 + lq * 8);
#pragma unroll
        for (int mt = 0; mt < 4; ++mt) if (mt < MT) { const bf16x8 a = LDSFRAG(Us + (mt * 16 + lr) * 264 + ks * 32 + lq * 8); acc[mt][0] = MFMA16(a, b0, acc[mt][0]); acc[mt][1] = MFMA16(a, b1, acc[mt][1]); }
    }
#pragma unroll
    for (int mt = 0; mt < 4; ++mt) if (mt < MT)
#pragma unroll
        for (int ct = 0; ct < 2; ++ct)
#pragma unroll
            for (int r = 0; r < 4; ++r) Xin[(mt * 16 + lq * 4 + r) * 260 + wid * 32 + ct * 16 + lr] = acc[mt][ct][r];
    __syncthreads();
    if (tid < 128) { const int d = tid >> 6, n = tid & 63; const f32x2_t a16 = ((const f32x2_t*)(p.ws + OFF_P16))[(g * 2 + d) * 64 + n];
        float xr = 0.f, xi = 0.f;
        if (bb >= 16) { const size_t o = ((size_t)(((bb - 16) * 2 + l) * 2 + d) * 2) * 2048 + g * 64 + n; xr = p.in[I_SS5][o]; xi = p.in[I_SS5][o + 2048]; }
        const int cre = d * 128 + n, cim = cre + 64;
        for (int i = 0; i < M; ++i) { const int c = d == 0 ? i : M - 1 - i;
            Xs[c * 264 + cre] = f2bf(xr); Xs[c * 264 + cim] = f2bf(xi);
            const float ur = Xin[c * 260 + cre], ui = Xin[c * 260 + cim];
            const float nr = a16.x * xr - a16.y * xi + ur, ni = a16.x * xi + a16.y * xr + ui; xr = nr; xi = ni; }
        if (bb < 16) { const size_t o = OUT_S5 + ((size_t)((bb * 2 + l) * 2 + d) * 2) * 2048 + g * 64 + n; p.out[o] = xr; p.out[o + 2048] = xi; }
    }
    __syncthreads();
#pragma unroll
    for (int a = 0; a < 4; ++a) { acc[a][0] = (f32x4){0.f, 0.f, 0.f, 0.f}; acc[a][1] = acc[a][0]; }
    for (int ks = 0; ks < 16; ++ks) { const bf16_t* Bm = ks < 8 ? TT : Cc; const LAS bf16_t* Am = ks < 8 ? Us : Xs; const int kk = (ks & 7) * 32 + lq * 8;
        bf16x8 b0 = *(const bf16x8*)(Bm + (size_t)(wid * 32 + lr) * 256 + kk), b1 = *(const bf16x8*)(Bm + (size_t)(wid * 32 + 16 + lr) * 256 + kk);
#pragma unroll
        for (int mt = 0; mt < 4; ++mt) if (mt < MT) { const bf16x8 a = LDSFRAG(Am + (mt * 16 + lr) * 264 + kk); acc[mt][0] = MFMA16(a, b0, acc[mt][0]); acc[mt][1] = MFMA16(a, b1, acc[mt][1]); }
    }
    bf16_t* Yg = (bf16_t*)(p.ws + OFF_YG);
#pragma unroll
    for (int mt = 0; mt < 4; ++mt) if (mt < MT)
#pragma unroll
        for (int ct = 0; ct < 2; ++ct)
#pragma unroll
            for (int r = 0; r < 4; ++r) { const int chunk = mt * 16 + lq * 4 + r, t = wid * 2 + ct;
                Yg[(size_t)(tok0 + chunk * 16 + t) * 512 + g * 16 + lr] = f2bf(gelu_tanh(acc[mt][ct][r])); }
    __syncthreads();
}
__device__ void job_mlaprep(const Params& p, int l, int j) {
    const int tid = tid_opaque(), wid = tid >> 6, lane = tid & 63, row = j * 8 + wid;
    const bf16_t* z = (const bf16_t*)(p.ws + OFF_Z) + (size_t)row * LDZ;
    float q[6], kv[4]; float sq = 0.f, sk = 0.f;
#pragma unroll
    for (int i = 0; i < 6; ++i) { q[i] = bf2f(z[ZMQ + i * 64 + lane]); sq += q[i] * q[i]; }
#pragma unroll
    for (int i = 0; i < 4; ++i) { kv[i] = bf2f(z[ZMKV + i * 64 + lane]); sk += kv[i] * kv[i]; }
#pragma unroll
    for (int o = 1; o < 64; o <<= 1) { sq += __shfl_xor(sq, o); sk += __shfl_xor(sk, o); }
    const float rq = rsqrtf(sq * (1.f / 384.f) + 1e-6f), rk = rsqrtf(sk * (1.f / 256.f) + 1e-6f);
    bf16_t* aq = (bf16_t*)(p.ws + OFF_AQ) + (size_t)row * 384; bf16_t* ck = (bf16_t*)(p.ws + OFF_CKVN) + (size_t)row * 256;
#pragma unroll
    for (int i = 0; i < 6; ++i) aq[i * 64 + lane] = f2bf(q[i] * rq * p.in[I_QNORM][l * 384 + i * 64 + lane]);
    const bool prompt = row < 4096; const int b = row >> 8, t = row & 255;
#pragma unroll
    for (int i = 0; i < 4; ++i) { const float v = kv[i] * rk * p.in[I_KVNORM][l * 256 + i * 64 + lane]; ck[i * 64 + lane] = f2bf(v);
        if (prompt) p.out[OUT_CKV + ((size_t)((b * 2 + l) * 256 + t)) * 256 + i * 64 + lane] = v; }
    if (prompt && lane < 32) p.out[OUT_KR + ((size_t)((b * 2 + l) * 256 + t)) * 32 + lane] = bf2f(z[ZMKR + lane]);
}
__device__ __forceinline__ float logsigmoidf_(float x) { return fminf(x, 0.f) - log1pf(expf(-fabsf(x))); }
__device__ void job_glaA(const Params& p, int l, int j, lds_t lds) {
    const int tid = tid_opaque(), wid = tid >> 6, lane = tid & 63, lr = lane & 15, lq = lane >> 4;
    const int ck = j >> 2, h = j & 3, tok0 = ck * 64;
    LAS bf16_t* QDf = (LAS bf16_t*)lds; LAS bf16_t* QDb = QDf + 4608; LAS bf16_t* KDf = QDb + 4608; LAS bf16_t* KDb = KDf + 4608; LAS bf16_t* KRf = KDb + 4608; LAS bf16_t* KRb = KRf + 4608;
    LAS bf16_t* VT = KRb + 4608;
    LAS bf16_t* ATT = VT + 9216;
    LAS float* GA = (LAS float*)(ATT + 4608);
    LAS float* TOT = GA + 2048;
    const bf16_t* Z = (const bf16_t*)(p.ws + OFF_Z);
    { const int c = tid >> 3, part = tid & 7; const u32x2 gv = *(const u32x2*)(Z + (size_t)(tok0 + c) * LDZ + ZGA + part * 4);
      GA[c * 32 + part * 4 + 0] = lo16(gv.x); GA[c * 32 + part * 4 + 1] = hi16(gv.x); GA[c * 32 + part * 4 + 2] = lo16(gv.y); GA[c * 32 + part * 4 + 3] = hi16(gv.y);
      const bf16_t* vp = Z + (size_t)(tok0 + c) * LDZ + ZV + h * 128 + part * 16;
      const u32x4 v0 = *(const u32x4*)vp, v1 = *(const u32x4*)(vp + 8);
      const unsigned w[8] = { v0.x, v0.y, v0.z, v0.w, v1.x, v1.y, v1.z, v1.w };
#pragma unroll
      for (int i = 0; i < 8; ++i) { VT[(part * 16 + 2 * i) * 72 + c] = (bf16_t)(w[i] & 0xffffu); VT[(part * 16 + 2 * i + 1) * 72 + c] = (bf16_t)(w[i] >> 16); } }
    __syncthreads();
    const int d = tid & 63, cg_ = tid >> 6;
    float laf[8], lab[8];
    { float wf[16], wb[16];
#pragma unroll
      for (int r = 0; r < 16; ++r) { wf[r] = p.in[I_WA2][((size_t)((l * 2 + 0) * 16 + r)) * 256 + h * 64 + d]; wb[r] = p.in[I_WA2][((size_t)((l * 2 + 1) * 16 + r)) * 256 + h * 64 + d]; }
      const float bf_ = p.in[I_BA][(l * 2 + 0) * 256 + h * 64 + d], bb_ = p.in[I_BA][(l * 2 + 1) * 256 + h * 64 + d];
#pragma unroll
      for (int i = 0; i < 8; ++i) { const int c = cg_ * 8 + i; float xf = bf_, xb = bb_;
#pragma unroll
          for (int r = 0; r < 16; ++r) { xf += GA[c * 32 + r] * wf[r]; xb += GA[c * 32 + 16 + r] * wb[r]; }
          laf[i] = logsigmoidf_(xf) * (1.f / 16.f); lab[i] = logsigmoidf_(xb) * (1.f / 16.f); } }
#pragma unroll
    for (int i = 1; i < 8; ++i) laf[i] += laf[i - 1];
#pragma unroll
    for (int i = 6; i >= 0; --i) lab[i] += lab[i + 1];
    TOT[(0 * 8 + cg_) * 64 + d] = laf[7]; TOT[(1 * 8 + cg_) * 64 + d] = lab[0];
    __syncthreads();
    float offf = 0.f, offb = 0.f, Tf = 0.f, Tb = 0.f;
#pragma unroll
    for (int g = 0; g < 8; ++g) { const float a = TOT[g * 64 + d], b = TOT[(8 + g) * 64 + d]; Tf += a; Tb += b; if (g < cg_) offf += a; if (g > cg_) offb += b; }
    bf16_t* QD = (bf16_t*)(p.ws + OFF_QD);
#pragma unroll
    for (int i = 0; i < 8; ++i) { const int c = cg_ * 8 + i; const size_t zr = (size_t)(tok0 + c) * LDZ;
        const float q = bf2f(Z[zr + ZQ + h * 64 + d]) * 0.125f, k = bf2f(Z[zr + ZK + h * 64 + d]);
        const float bf_ = offf + laf[i], bb_ = offb + lab[i];
        const bf16_t qf = f2bf(q * expf(bf_)), qb = f2bf(q * expf(bb_));
        QDf[c * 72 + d] = qf; QDb[c * 72 + d] = qb;
        KDf[c * 72 + d] = f2bf(k * expf(-bf_)); KDb[c * 72 + d] = f2bf(k * expf(-bb_));
        KRf[d * 72 + c] = f2bf(k * expf(Tf - bf_)); KRb[d * 72 + c] = f2bf(k * expf(Tb - bb_));
        QD[(size_t)(tok0 + c) * 256 + h * 64 + d] = qf; QD[(size_t)(8192 + tok0 + c) * 256 + h * 64 + d] = qb; }
    if (cg_ == 0) { float* DEC = (float*)(p.ws + OFF_DEC); DEC[((0 * 128 + ck) * 4 + h) * 64 + d] = expf(Tf); DEC[((1 * 128 + ck) * 4 + h) * 64 + d] = expf(Tb); }
    __syncthreads();
#pragma unroll
    for (int q2 = 0; q2 < 2; ++q2) { const int tt = wid * 2 + q2, ti = tt >> 2, tj = tt & 3; f32x4 af = {0.f, 0.f, 0.f, 0.f}, ab = af;
#pragma unroll
        for (int ks = 0; ks < 2; ++ks) { const int ko = ks * 32 + lq * 8;
            af = MFMA16(LDSFRAG(QDf + (ti * 16 + lr) * 72 + ko), LDSFRAG(KDf + (tj * 16 + lr) * 72 + ko), af);
            ab = MFMA16(LDSFRAG(QDb + (ti * 16 + lr) * 72 + ko), LDSFRAG(KDb + (tj * 16 + lr) * 72 + ko), ab); }
#pragma unroll
        for (int r = 0; r < 4; ++r) { const int c = ti * 16 + lq * 4 + r, s = tj * 16 + lr; const float v = (s <= c ? af[r] : 0.f) + (s >= c ? ab[r] : 0.f); ATT[c * 72 + s] = f2bf(v); } }
    __syncthreads();
    bf16x8 vb[2];
#pragma unroll
    for (int ks = 0; ks < 2; ++ks) vb[ks] = LDSFRAG(VT + (wid * 16 + lr) * 72 + ks * 32 + lq * 8);
    float* OI = (float*)(p.ws + OFF_HB); float* KV = (float*)(p.ws + OFF_KV);
#pragma unroll
    for (int ct = 0; ct < 4; ++ct) { f32x4 a = {0.f, 0.f, 0.f, 0.f};
#pragma unroll
        for (int ks = 0; ks < 2; ++ks) a = MFMA16(LDSFRAG(ATT + (ct * 16 + lr) * 72 + ks * 32 + lq * 8), vb[ks], a);
#pragma unroll
        for (int r = 0; r < 4; ++r) OI[(size_t)(tok0 + ct * 16 + lq * 4 + r) * 512 + h * 128 + wid * 16 + lr] = a[r]; }
#pragma unroll
    for (int dir = 0; dir < 2; ++dir) { const LAS bf16_t* KR = dir == 0 ? KRf : KRb; float* kvp = KV + ((size_t)((dir * 128 + ck) * 4 + h)) * 8192;
#pragma unroll
        for (int dt = 0; dt < 4; ++dt) { f32x4 a = {0.f, 0.f, 0.f, 0.f};
#pragma unroll
            for (int ks = 0; ks < 2; ++ks) a = MFMA16(LDSFRAG(KR + (dt * 16 + lr) * 72 + ks * 32 + lq * 8), vb[ks], a);
#pragma unroll
            for (int r = 0; r < 4; ++r) kvp[(dt * 16 + lq * 4 + r) * 128 + wid * 16 + lr] = a[r]; } }
    __syncthreads();
}

__device__ void job_glaB(const Params& p, int l, int j) {
    const int slab = j & 15, h = (j >> 4) & 3, rest = j >> 6, bb = rest % 20, dir = rest / 20;
    const int idx = slab * 512 + tid_opaque(), d = idx >> 7;
    const int nck = bb < 16 ? 4 : 16, ck0 = bb < 16 ? bb * 4 : 64 + (bb - 16) * 16;
    float S = 0.f;
    if (bb >= 16) S = p.in[I_SGLA][((size_t)((((bb - 16) * 2 + l) * 2 + dir) * 4 + h)) * 8192 + idx];
    const float* KV = (const float*)(p.ws + OFF_KV); const float* DEC = (const float*)(p.ws + OFF_DEC); bf16_t* ST = (bf16_t*)(p.ws + OFF_ST);
    for (int i = 0; i < nck; ++i) { const int ck = dir == 0 ? ck0 + i : ck0 + nck - 1 - i; const size_t it = (size_t)((dir * 128 + ck) * 4 + h);
        ST[it * 8192 + idx] = f2bf(S); S = DEC[it * 64 + d] * S + KV[it * 8192 + idx]; }
    if (bb < 16) p.out[OUT_GLA + ((size_t)(((bb * 2 + l) * 2 + dir) * 4 + h)) * 8192 + idx] = S;
}

__device__ void job_glaC(const Params& p, int l, int j, lds_t lds) {
    const int tid = tid_opaque(), wid = tid >> 6, lane = tid & 63, lr = lane & 15, lq = lane >> 4;
    const int ck = j >> 2, h = j & 3, tok0 = ck * 64;
    LAS bf16_t* Aq = (LAS bf16_t*)lds;
    LAS bf16_t* BT = Aq + 64 * 136;
    LAS float* Os = (LAS float*)(BT + 128 * 136);
    const bf16_t* QD = (const bf16_t*)(p.ws + OFF_QD); const bf16_t* ST = (const bf16_t*)(p.ws + OFF_ST);
#pragma unroll
    for (int it = 0; it < 2; ++it) { const int idx = tid + it * 512, c = idx >> 4, rem = idx & 15, dir = rem >> 3, dc = rem & 7;
        *(LAS u32x4*)(Aq + c * 136 + dir * 64 + dc * 8) = *(const u32x4*)(QD + (size_t)(dir * 8192 + tok0 + c) * 256 + h * 64 + dc * 8); }
#pragma unroll
    for (int it = 0; it < 4; ++it) { const int idx = tid + it * 512, dir = idx >> 10, d = (idx >> 4) & 63, ec = idx & 15;
        const u32x4 v = *(const u32x4*)(ST + ((size_t)((dir * 128 + ck) * 4 + h)) * 8192 + d * 128 + ec * 8);
        const unsigned w[4] = { v.x, v.y, v.z, v.w };
#pragma unroll
        for (int i = 0; i < 4; ++i) { BT[(ec * 8 + 2 * i) * 136 + dir * 64 + d] = (bf16_t)(w[i] & 0xffffu); BT[(ec * 8 + 2 * i + 1) * 136 + dir * 64 + d] = (bf16_t)(w[i] >> 16); } }
    __syncthreads();
    const int ct = wid & 3, eh = wid >> 2; const float* OI = (const float*)(p.ws + OFF_HB);
    bf16x8 af[4];
#pragma unroll
    for (int ks = 0; ks < 4; ++ks) af[ks] = LDSFRAG(Aq + (ct * 16 + lr) * 136 + ks * 32 + lq * 8);
#pragma unroll
    for (int e4 = 0; e4 < 4; ++e4) { const int et = eh * 4 + e4; f32x4 a = {0.f, 0.f, 0.f, 0.f};
#pragma unroll
        for (int ks = 0; ks < 4; ++ks) a = MFMA16(af[ks], LDSFRAG(BT + (et * 16 + lr) * 136 + ks * 32 + lq * 8), a);
#pragma unroll
        for (int r = 0; r < 4; ++r) { const int row = ct * 16 + lq * 4 + r, col = et * 16 + lr; Os[row * 132 + col] = a[r] + OI[(size_t)(tok0 + row) * 512 + h * 128 + col]; } }
    __syncthreads();
    { const int c = tid >> 3, part = tid & 7; float o[16]; float ss = 0.f;
#pragma unroll
      for (int i = 0; i < 16; ++i) { o[i] = Os[c * 132 + part * 16 + i]; ss += o[i] * o[i]; }
      ss += __shfl_xor(ss, 1); ss += __shfl_xor(ss, 2); ss += __shfl_xor(ss, 4);
      const float rstd = rsqrtf(ss * (1.f / 128.f) + 1e-6f);
      const bf16_t* gz = (const bf16_t*)(p.ws + OFF_Z) + (size_t)(tok0 + c) * LDZ + ZGG + h * 128 + part * 16;
      const u32x4 g0 = *(const u32x4*)gz, g1 = *(const u32x4*)(gz + 8);
      const unsigned gw[8] = { g0.x, g0.y, g0.z, g0.w, g1.x, g1.y, g1.z, g1.w };
      unsigned ow[8];
#pragma unroll
      for (int i = 0; i < 8; ++i) { const float n0 = p.in[I_ONORM][l * 128 + part * 16 + 2 * i], n1 = p.in[I_ONORM][l * 128 + part * 16 + 2 * i + 1];
          ow[i] = pk2(o[2 * i] * rstd * n0 * siluf_(lo16(gw[i])), o[2 * i + 1] * rstd * n1 * siluf_(hi16(gw[i]))); }
      bf16_t* ap = (bf16_t*)(p.ws + OFF_AGLA) + (size_t)(tok0 + c) * 512 + h * 128 + part * 16;
      *(u32x4*)ap = (u32x4){ow[0], ow[1], ow[2], ow[3]}; *(u32x4*)(ap + 8) = (u32x4){ow[4], ow[5], ow[6], ow[7]}; }
    __syncthreads();
}
__device__ __forceinline__ void head_row_finish(float (&x)[16], int p8, const float* nw, bool rope, int pos, const float* R, float mul, LAS bf16_t* dst) {
    float ss = 0.f; const int cnt = p8 < 4 ? 16 : 8;
#pragma unroll
    for (int i = 0; i < 16; ++i) if (i < cnt) ss += x[i] * x[i];
    ss += __shfl_xor(ss, 1); ss += __shfl_xor(ss, 2); ss += __shfl_xor(ss, 4);
    const float rstd = rsqrtf(ss * (1.f / 96.f) + 1e-6f) * mul;
    if (p8 < 4) { unsigned w[8];
#pragma unroll
        for (int i = 0; i < 8; ++i) w[i] = pk2(x[2 * i] * rstd * nw[p8 * 16 + 2 * i], x[2 * i + 1] * rstd * nw[p8 * 16 + 2 * i + 1]);
        *(LAS u32x4*)(dst + p8 * 16) = (u32x4){w[0], w[1], w[2], w[3]}; *(LAS u32x4*)(dst + p8 * 16 + 8) = (u32x4){w[4], w[5], w[6], w[7]};
    } else { const int i0 = (p8 - 4) * 4; float o1[4], o2[4];
#pragma unroll
        for (int i = 0; i < 4; ++i) { const float a = x[i] * rstd * nw[64 + i0 + i], b = x[4 + i] * rstd * nw[80 + i0 + i];
            if (rope) { const float c = R[pos * 16 + i0 + i], s = R[16384 + pos * 16 + i0 + i]; o1[i] = a * c - b * s; o2[i] = a * s + b * c; } else { o1[i] = a; o2[i] = b; } }
        *(LAS u32x2*)(dst + 64 + i0) = (u32x2){pk2(o1[0], o1[1]), pk2(o1[2], o1[3])}; *(LAS u32x2*)(dst + 80 + i0) = (u32x2){pk2(o2[0], o2[1]), pk2(o2[2], o2[3])}; }
}
__device__ __forceinline__ void ld16bf(const bf16_t* s, float (&x)[16]) { const u32x4 a = *(const u32x4*)s, b = *(const u32x4*)(s + 8);
    x[0] = lo16(a.x); x[1] = hi16(a.x); x[2] = lo16(a.y); x[3] = hi16(a.y); x[4] = lo16(a.z); x[5] = hi16(a.z); x[6] = lo16(a.w); x[7] = hi16(a.w);
    x[8] = lo16(b.x); x[9] = hi16(b.x); x[10] = lo16(b.y); x[11] = hi16(b.y); x[12] = lo16(b.z); x[13] = hi16(b.z); x[14] = lo16(b.w); x[15] = hi16(b.w); }
__device__ __forceinline__ void ld4bf(const bf16_t* s, float* x) { const u32x2 a = *(const u32x2*)s; x[0] = lo16(a.x); x[1] = hi16(a.x); x[2] = lo16(a.y); x[3] = hi16(a.y); }
__device__ void job_attn(const Params& p, int l, int j, lds_t lds) {
    const int tid = tid_opaque(), wid = tid >> 6, lane = tid & 63, lr = lane & 15, lq = lane >> 4;
    const bool smp = j < 256; int b, h, qb; if (smp) { b = j >> 6; h = (j >> 4) & 3; qb = j & 15; } else { const int jj = j - 256; b = jj >> 4; h = (jj >> 2) & 3; qb = jj & 3; }
    const int qtok0 = smp ? 4096 + b * 1024 + qb * 64 : b * 256 + qb * 64; const int nkt = smp ? 12 : 2;
    LAS bf16_t* Ks = (LAS bf16_t*)lds;
    LAS bf16_t* VTs = Ks + 128 * 104;
    LAS bf16_t* Ps = VTs + 128 * 136 + wid * 16 * 72;
    LAS float* Mg = (LAS float*)(lds + (128 * 104 + 128 * 136 + 8 * 16 * 72) * 2);
    const bf16_t* Z = (const bf16_t*)(p.ws + OFF_Z); const bf16_t* KN = (const bf16_t*)(p.ws + OFF_KN); const bf16_t* Vb = (const bf16_t*)(p.ws + OFF_V); const float* R = (const float*)(p.ws + OFF_ROPE);
    const float* qhn = p.in[I_QHNORM] + l * 96; const float* khn = p.in[I_KHNORM] + l * 96;
    { const int row = tid >> 3, p8 = tid & 7, tok = qtok0 + row; const bf16_t* qr = (const bf16_t*)(p.ws + OFF_QRAW) + (size_t)tok * 384 + h * 96; float x[16];
      if (p8 < 4) ld16bf(qr + p8 * 16, x); else { ld4bf(qr + 64 + (p8 - 4) * 4, x); ld4bf(qr + 80 + (p8 - 4) * 4, x + 4); }
      head_row_finish(x, p8, qhn, smp, qb * 64 + row, R, 0.10206207261596575f * 1.4426950408889634f, Ks + row * 104); }
    __syncthreads();
    const int rt = wid & 3, kh = wid >> 2;
    bf16x8 qa[3];
#pragma unroll
    for (int ks = 0; ks < 3; ++ks) qa[ks] = LDSFRAG(Ks + (rt * 16 + lr) * 104 + ks * 32 + lq * 8);
    __syncthreads();
    f32x4 oacc[8]; float mrow[4], lrow[4];
#pragma unroll
    for (int e = 0; e < 8; ++e) oacc[e] = (f32x4){0.f, 0.f, 0.f, 0.f};
#pragma unroll
    for (int r = 0; r < 4; ++r) { mrow[r] = -1e30f; lrow[r] = 0.f; }
    for (int kt = 0; kt < nkt; ++kt) {
#pragma unroll 1
        for (int ps = 0; ps < 2; ++ps) { const int key = ps * 64 + (tid >> 3), p8 = tid & 7, jk = kt * 128 + key; float x[16]; int knrow; bool rope = false; int pos = 0; const float* krf = nullptr;
            if (smp) { if (jk < 512) { knrow = 8192 + b * 512 + jk; krf = p.in[I_CKR] + ((size_t)((b * 2 + l) * 512 + jk)) * 32; } else { pos = jk - 512; knrow = 4096 + b * 1024 + pos; rope = true; } }
            else knrow = b * 256 + jk;
            if (p8 < 4) ld16bf(KN + (size_t)knrow * 256 + h * 64 + p8 * 16, x);
            else if (krf) { const f32x4 a = *(const f32x4*)(krf + (p8 - 4) * 4), c = *(const f32x4*)(krf + 16 + (p8 - 4) * 4); x[0] = a[0]; x[1] = a[1]; x[2] = a[2]; x[3] = a[3]; x[4] = c[0]; x[5] = c[1]; x[6] = c[2]; x[7] = c[3]; }
            else { const bf16_t* kr = Z + (size_t)knrow * LDZ + ZMKR; ld4bf(kr + (p8 - 4) * 4, x); ld4bf(kr + 16 + (p8 - 4) * 4, x + 4); }
            head_row_finish(x, p8, khn, rope, pos, R, 1.f, Ks + key * 104); }
        { const int key = tid >> 2, part = tid & 3, jk = kt * 128 + key; int vrow;
          if (smp) vrow = jk < 512 ? 8192 + b * 512 + jk : 4096 + b * 1024 + (jk - 512); else vrow = b * 256 + jk;
          const bf16_t* vp = Vb + (size_t)vrow * 512 + h * 128 + part * 32;
#pragma unroll 1
          for (int c4 = 0; c4 < 4; ++c4) { const u32x4 v = *(const u32x4*)(vp + c4 * 8); const unsigned w[4] = { v.x, v.y, v.z, v.w };
#pragma unroll
              for (int i = 0; i < 4; ++i) { const int e = part * 32 + c4 * 8 + 2 * i; VTs[e * 136 + key] = (bf16_t)(w[i] & 0xffffu); VTs[(e + 1) * 136 + key] = (bf16_t)(w[i] >> 16); } } }
        __syncthreads();
        const int kbase = kh * 64;
        f32x4 sacc[4];
#pragma unroll
        for (int nt = 0; nt < 4; ++nt) { sacc[nt] = (f32x4){0.f, 0.f, 0.f, 0.f};
#pragma unroll
            for (int ks = 0; ks < 3; ++ks) sacc[nt] = MFMA16(qa[ks], LDSFRAG(Ks + (kbase + nt * 16 + lr) * 104 + ks * 32 + lq * 8), sacc[nt]); }
        float alpha[4];
#pragma unroll
        for (int r = 0; r < 4; ++r) { float mx = fmaxf(fmaxf(sacc[0][r], sacc[1][r]), fmaxf(sacc[2][r], sacc[3][r]));
            mx = fmaxf(mx, __shfl_xor(mx, 1)); mx = fmaxf(mx, __shfl_xor(mx, 2)); mx = fmaxf(mx, __shfl_xor(mx, 4)); mx = fmaxf(mx, __shfl_xor(mx, 8));
            const float mn = fmaxf(mrow[r], mx); alpha[r] = exp2f(mrow[r] - mn); mrow[r] = mn; float rs = 0.f;
#pragma unroll
            for (int nt = 0; nt < 4; ++nt) { const float pv = exp2f(sacc[nt][r] - mn); rs += pv; Ps[(lq * 4 + r) * 72 + nt * 16 + lr] = f2bf(pv); }
            lrow[r] = lrow[r] * alpha[r] + rs; }
#pragma unroll
        for (int e = 0; e < 8; ++e) { oacc[e][0] *= alpha[0]; oacc[e][1] *= alpha[1]; oacc[e][2] *= alpha[2]; oacc[e][3] *= alpha[3]; }
        asm volatile("s_waitcnt lgkmcnt(0)" ::: "memory");
#pragma unroll
        for (int k2 = 0; k2 < 2; ++k2) { const bf16x8 pa = LDSFRAG(Ps + lr * 72 + k2 * 32 + lq * 8);
#pragma unroll
            for (int e = 0; e < 8; ++e) oacc[e] = MFMA16(pa, LDSFRAG(VTs + (e * 16 + lr) * 136 + kbase + k2 * 32 + lq * 8), oacc[e]); }
        __syncthreads();
    }
#pragma unroll
    for (int r = 0; r < 4; ++r) { float s = lrow[r]; s += __shfl_xor(s, 1); s += __shfl_xor(s, 2); s += __shfl_xor(s, 4); s += __shfl_xor(s, 8); lrow[r] = s; }
    LAS float* Mo = Mg + rt * 16 * 132; LAS float* Ml = Mg + 4 * 16 * 132 + rt * 32;
    if (kh == 1) {
#pragma unroll
        for (int e = 0; e < 8; ++e)
#pragma unroll
            for (int r = 0; r < 4; ++r) Mo[(lq * 4 + r) * 132 + e * 16 + lr] = oacc[e][r];
        if (lr == 0) {
#pragma unroll
            for (int r = 0; r < 4; ++r) { Ml[(lq * 4 + r) * 2] = mrow[r]; Ml[(lq * 4 + r) * 2 + 1] = lrow[r]; } }
    }
    __syncthreads();
    if (kh == 0) { bf16_t* AM = (bf16_t*)(p.ws + OFF_AMLA);
#pragma unroll
        for (int r = 0; r < 4; ++r) { const int row = lq * 4 + r; const float m2 = Ml[row * 2], l2 = Ml[row * 2 + 1]; const float mm = fmaxf(mrow[r], m2), a1 = exp2f(mrow[r] - mm), a2 = exp2f(m2 - mm);
            const float inv = 1.f / (lrow[r] * a1 + l2 * a2); const int tok = qtok0 + rt * 16 + row;
#pragma unroll
            for (int e = 0; e < 8; ++e) { const int col = e * 16 + lr; const float o = (oacc[e][r] * a1 + Mo[row * 132 + col] * a2) * inv;
                const float gt = bf2f(Z[(size_t)tok * LDZ + ZMG + h * 128 + col]); AM[(size_t)tok * 512 + h * 128 + col] = f2bf(o * siluf_(gt)); } } }
    __syncthreads();
}


#define XB_TMO      128
#define XB_XCNT(j)  (256  + 64 * (j))
#define XB_XSUB(j)  (1280 + 64 * (j))
#define XB_XGEN(j)  (2304 + 64 * (j))
#define XB_TOP      3328
#define XB_TOPGEN   3392
#define XCD_BAR_WORDS 3456
#define XB_SPIN_CAP (1u << 18)

__device__ __forceinline__ unsigned xb_ld(unsigned* p)              { return __hip_atomic_load(p, __ATOMIC_RELAXED, __HIP_MEMORY_SCOPE_AGENT); }
__device__ __forceinline__ unsigned xb_add(unsigned* p, unsigned v) { return __hip_atomic_fetch_add(p, v, __ATOMIC_RELAXED, __HIP_MEMORY_SCOPE_AGENT); }
__device__ __forceinline__ unsigned xb_xcc_id() { return (unsigned)__builtin_amdgcn_s_getreg((3 << 11) | 20) & 0xFu; }
#define XB_SPIN(cond, bar) do { unsigned _sp = 0; while (cond) { __builtin_amdgcn_s_sleep(1); \
    if ((++_sp & 255u) == 0u) { if (xb_ld(&(bar)[XB_TMO])) break; if (_sp > XB_SPIN_CAP) { atomicAdd(&(bar)[XB_TMO], 1u); break; } } } } while (0)

struct XcdBarrier {
    unsigned* bar; unsigned x;
    volatile LAS unsigned* st;
};

__device__ __forceinline__ XcdBarrier xcd_barrier_post(unsigned* bar, volatile LAS unsigned* st) {
    XcdBarrier b; b.bar = bar; b.x = xb_xcc_id(); b.st = st;
    if (threadIdx.x == 0) (void)xb_add(&bar[XB_XCNT(b.x)], 1u);
    return b;
}
__device__ __forceinline__ void xcd_barrier_complete(unsigned* bar, unsigned x, unsigned& nloc, unsigned& nx) {
    const unsigned G = gridDim.x * gridDim.y * gridDim.z;
    unsigned sum, cnt, mine, sp = 0u;
    for (;;) {
        sum = 0u; cnt = 0u; mine = 0u;
#pragma unroll
        for (unsigned j = 0; j < 16; ++j) { const unsigned c = xb_ld(&bar[XB_XCNT(j)]); sum += c; cnt += (c > 0u) ? 1u : 0u; mine = (j == x) ? c : mine; }
        if (sum == G) break;
        __builtin_amdgcn_s_sleep(1);
        if ((++sp & 255u) == 0u) { if (xb_ld(&bar[XB_TMO])) break; if (sp > XB_SPIN_CAP) { atomicAdd(&bar[XB_TMO], 1u); break; } }
    }
    nloc = mine > 0u ? mine : 1u; nx = cnt > 0u ? cnt : 1u;
}

__device__ __forceinline__ void xcd_barrier(const XcdBarrier& b) {
    asm volatile("s_waitcnt vmcnt(0)" ::: "memory");
    __syncthreads();
    if (threadIdx.x == 0) {
        unsigned* bar = b.bar;
        __builtin_amdgcn_s_waitcnt(0);
        unsigned nloc = b.st[0], nx = b.st[1];
        if (nloc == 0u) { xcd_barrier_complete(bar, b.x, nloc, nx); b.st[0] = nloc; b.st[1] = nx; }
        const unsigned old = xb_add(&bar[XB_XSUB(b.x)], 1u);
        const unsigned gen = old / nloc;
        if (old + 1u == (gen + 1u) * nloc) {
            __builtin_amdgcn_fence(__ATOMIC_RELEASE, "agent");
            asm volatile("s_waitcnt vmcnt(0)" ::: "memory");
            const unsigned og = xb_add(&bar[XB_TOP], 1u);
            const unsigned tg = og / nx;
            if (og + 1u == (tg + 1u) * nx) xb_add(&bar[XB_TOPGEN], 1u);
            else XB_SPIN(xb_ld(&bar[XB_TOPGEN]) == tg, bar);
            __builtin_amdgcn_fence(__ATOMIC_ACQUIRE, "agent");
            xb_add(&bar[XB_XGEN(b.x)], 1u);
            asm volatile("s_waitcnt vmcnt(0)" ::: "memory");
        } else {
            XB_SPIN(xb_ld(&bar[XB_XGEN(b.x)]) == gen, bar);
            __builtin_amdgcn_fence(__ATOMIC_ACQUIRE, "agent");
            asm volatile("s_waitcnt vmcnt(0)" ::: "memory");
        }
    }
    __syncthreads();
}

constexpr int N_PHASES = 15;
#ifndef S3M
#define S3M 15
#endif
#ifndef ONLY_S
#define ONLY_S -1
#endif
__device__ __forceinline__ void run_phase(const Params& p, int ph, lds_t lds) {
    const int G = (int)gridDim.x, bid = (int)blockIdx.x;
    if (ph == 0 && (ONLY_S < 0 || ONLY_S == 7)) {
        for (int j = bid; j < 192 + 256 + 32; j += G) { if (j < 192) job_ada(p, j, lds); else if (j < 448) job_ctx(p, j - 192); else job_rope(p, j - 448); }
        return;
    }
    const int l = (ph - 1) / 7, s = (ph - 1) % 7;
    unsigned char* ws = p.ws;
    if (s == 0 && (ONLY_S < 0 || ONLY_S == 0)) {
        for (int j = bid; j < 96 + WT_TOTAL + 1024; j += G) { if (j < 96) job_s5setup(p, l, j, lds); else if (j < 96 + WT_TOTAL) job_wt(p, l, j - 96, lds); else job_prep(p, l, j - 96 - WT_TOTAL); }
    } else if (s == 1 && (ONLY_S < 0 || ONLY_S == 1)) {
        Order S; S.setup(8192, 6912, 0); pg8::Gemm g{(const bf16_t*)(ws + OFF_HB), (const bf16_t*)(ws + OFF_WIN), 8192, 6912, 1024}; EpiZ E{(bf16_t*)(ws + OFF_Z)};
        pg8::gemm_phase<EpiZ, Order>(lds, g, S, E, nullptr);
    } else if (s == 2 && (ONLY_S < 0 || ONLY_S == 2)) {
        for (int j = bid; j < 640 + 512 + 1024; j += G) { if (j < 640) job_s5(p, l, j, lds); else if (j < 1152) job_glaA(p, l, j - 640, lds); else job_mlaprep(p, l, j - 1152); }
    } else if (s == 3 && (ONLY_S < 0 || ONLY_S == 3)) {
        if (S3M & 1) for (int j = bid; j < 2560; j += G) job_glaB(p, l, j);
        if (S3M & 2) { Order S; S.setup(8192, 1024, 0); pg8::Gemm g{(const bf16_t*)(ws + OFF_YG), (const bf16_t*)(ws + OFF_WGLU), 8192, 1024, 512}; EpiGLU E{(bf16_t*)(ws + OFF_AS5), (const bf16_t*)(ws + OFF_Z), p.in[I_BGLU] + l * 1024};
          pg8::gemm_phase<EpiGLU, Order>(lds, g, S, E, nullptr); }
        if (S3M & 4) { Order S; S.setup(10240, 768, 128); pg8::Gemm g{(const bf16_t*)(ws + (l == 0 ? OFF_CTX0 : OFF_CKVN)), (const bf16_t*)(ws + OFF_WKV), 10240, 768, 256}; EpiKV E{(bf16_t*)(ws + OFF_KN), (bf16_t*)(ws + OFF_V), l};
          pg8::gemm_phase<EpiKV, Order>(lds, g, S, E, nullptr); }
        if (S3M & 8) { Order S; S.setup(8192, 512, 248); pg8::Gemm g{(const bf16_t*)(ws + OFF_AQ), (const bf16_t*)(ws + OFF_WUQ), 8192, 512, 384}; EpiQ E{(bf16_t*)(ws + OFF_QRAW)};
          pg8::gemm_phase<EpiQ, Order>(lds, g, S, E, nullptr); }
    } else if (s == 4 && (ONLY_S < 0 || ONLY_S == 4)) {
        for (int j = bid; j < 512 + 512; j += G) { if (j < 512) job_attn(p, l, j, lds); else job_glaC(p, l, j - 512, lds); }
    } else if (s == 5 && (ONLY_S < 0 || ONLY_S == 5)) {
        for (int br = 0; br < 3; ++br) { Order S; S.setup(8192, 1024, 0);
            pg8::Gemm g{(const bf16_t*)(ws + (br == 0 ? OFF_AGLA : br == 1 ? OFF_AMLA : OFF_AS5)), (const bf16_t*)(ws + OFF_WBO) + (size_t)br * 1024 * 512, 8192, 1024, 512};
            EpiBo E{(bf16_t*)(ws + OFF_HB), (const bf16_t*)(ws + OFF_Z), br};
            pg8::gemm_phase<EpiBo, Order>(lds, g, S, E, nullptr); }
    } else if (s == 6 && (ONLY_S < 0 || ONLY_S == 6)) {
        Order S; S.setup(8192, 1024, 0); pg8::Gemm g{(const bf16_t*)(ws + OFF_HB), (const bf16_t*)(ws + OFF_WOUT), 8192, 1024, 1024};
        EpiOut E{p.out, l == 0 ? p.in[I_XP] : p.out, l == 0 ? p.in[I_XS] : p.out + (size_t)4096 * 1024, (const float*)(ws + OFF_ADA) + l * 5 * 3072};
        pg8::gemm_phase<EpiOut, Order>(lds, g, S, E, nullptr);
    }
}
__global__ __launch_bounds__(512, 2) void mega(KParams kp, int ph0, int ph1) {
    extern __shared__ __attribute__((aligned(16))) unsigned char shm[];
    lds_t lds = (lds_t)shm;
    if (threadIdx.x < N_IN) ((const float**)(kp.ws + OFF_TBL))[threadIdx.x] = kp.in[threadIdx.x];
    volatile LAS unsigned* xst = (volatile LAS unsigned*)(lds + DYN_LDS - 16);
    if (threadIdx.x == 0) { xst[0] = 0u; xst[1] = 0u; }
    __threadfence(); __syncthreads();
    XcdBarrier xb = xcd_barrier_post((unsigned*)(kp.ws + OFF_BAR), xst);
    if (ph0 > ph1) cg::this_grid().sync();
    for (int ph = ph0; ph < ph1; ++ph) {
        Params p; { const float* const* tb = (const float* const*)(kp.ws + OFF_TBL); float* o = kp.out; unsigned char* w = kp.ws; asm volatile("" : "+s"(tb), "+s"(o), "+s"(w)); p.in = tb; p.out = o; p.ws = w; }
        run_phase(p, ph, lds);
#ifdef REPEAT_S
        if (ph > 0 && (ph - 1) % 7 == REPEAT_S && (REPEAT_S != 6 || ph < 8)) { xcd_barrier(xb); run_phase(p, ph, lds); }
#endif
        if (ph + 1 < ph1) xcd_barrier(xb);
    }
}

#ifndef N_LAUNCH_MODE
#define N_LAUNCH_MODE 1
#endif
extern "C" void kernel_launch(void* const* d_in, const int* in_sizes, int n_in, void* d_out, int out_size, void* d_ws, size_t ws_size, hipStream_t stream) {
    static int grid = 0;
    if (grid == 0) {
        if (n_in != N_IN || ws_size < WS_END) { fprintf(stderr, "kernel_launch: unexpected n_in %d / ws %zu (need %zu)\n", n_in, ws_size, (size_t)WS_END); grid = -1; return; }
        int dev = 0, cus = 0, per_cu = 0;
        hipGetDevice(&dev); hipDeviceGetAttribute(&cus, hipDeviceAttributeMultiprocessorCount, dev);
        hipFuncSetAttribute((const void*)mega, hipFuncAttributeMaxDynamicSharedMemorySize, DYN_LDS);
        hipOccupancyMaxActiveBlocksPerMultiprocessor(&per_cu, (const void*)mega, 512, DYN_LDS);
        if (per_cu < 1) { fprintf(stderr, "kernel_launch: occupancy query says %d blocks per CU\n", per_cu); per_cu = 1; }
        (void)hipGetLastError();
        grid = cus;
    }
    if (grid < 0) return;
    hipMemsetAsync((char*)d_ws + OFF_BAR, 0, 16384, stream);
    KParams p{};
    for (int i = 0; i < N_IN; ++i) p.in[i] = (const float*)d_in[i];
    p.out = (float*)d_out; p.ws = (unsigned char*)d_ws;
#if N_LAUNCH_MODE == 0
    for (int ph = 0; ph < N_PHASES; ++ph) { hipLaunchKernelGGL(mega, dim3(grid), dim3(512), DYN_LDS, stream, p, ph, ph + 1); }
#else
    int ph0 = 0, ph1 = N_PHASES; void* args[] = {&p, &ph0, &ph1};
    hipError_t e = hipLaunchCooperativeKernel((const void*)mega, dim3(grid), dim3(512), args, DYN_LDS, stream);
    if (e != hipSuccess) fprintf(stderr, "cooperative launch failed: %s (grid %d)\n", hipGetErrorString(e), grid);
#endif
}
```

```cpp
#include <hip/hip_runtime.h>
#include <hip/hip_cooperative_groups.h>
#include <cstdio>
namespace cg = cooperative_groups;
namespace pg8 {
#define PG8_LAS __attribute__((address_space(3)))
typedef unsigned short bf16_t;
typedef short bf16x8 __attribute__((ext_vector_type(8)));
typedef float f32x4 __attribute__((ext_vector_type(4)));
typedef unsigned u32x4 __attribute__((ext_vector_type(4)));
constexpr int BM = 256, BK = 64, HALF = 128, HTB = HALF * BK * 2  , STAGE_BYTES = 8 * HTB, NXCD = 8, WGM = 8;

__host__ __device__ __forceinline__ int lds_byte(int r, int c) { const int st = (r >> 4) * 2 + (c >> 5), rr = r & 15, cc = c & 31, ob = rr * 64 + cc * 2; return st * 1024 + (ob ^ (((ob >> 9) & 1) << 5)); }
__host__ __device__ __forceinline__ void stage_rc(int b, int& R, int& C) { const int st = b / 1024, sb = b % 1024, swz = sb ^ (((sb >> 9) & 1) << 5); R = (st >> 1) * 16 + swz / 64; C = (st & 1) * 32 + (swz % 64) / 2; }
__host__ __device__ __forceinline__ int perm32(int rho) { const int n = rho >> 4, i = rho & 15; return 8 * (i >> 2) + 4 * n + (i & 3); }

struct Unit { int pm, pn; };
struct Gemm { const bf16_t* A; const bf16_t* Bt; int M, N, K; };

struct StaticOrder {
    int nM, nN, nwg, G, c;
    __host__ __device__ void init(int M, int N, int G_, int c_) { nM = M / BM; nN = N / BM; nwg = nM * nN; G = G_; c = c_; }
    __host__ __device__ bool next(int i, Unit& u) const {
        const long L = (long)i * G + c; if (L >= nwg) return false;
        int wgid = (int)L; { const int q = nwg / NXCD, r = nwg % NXCD, xcd = wgid % NXCD, off = wgid / NXCD; wgid = (xcd < r ? xcd * (q + 1) : r * (q + 1) + (xcd - r) * q) + off; }
        const int nig = WGM * nN, gid = wgid / nig, fm = gid * WGM, gsz = (nM - fm) < WGM ? (nM - fm) : WGM;
        u.pm = fm + ((wgid % nig) % gsz); u.pn = (wgid % nig) / gsz; return true;
    }
    __device__ __forceinline__ void a_ready(const Unit&) const {}
    __device__ __forceinline__ void done(const Unit&) const {}
};
__device__ __forceinline__ unsigned cvt_pk_bf16(float lo, float hi) { unsigned r; asm volatile("v_cvt_pk_bf16_f32 %0, %1, %2" : "=v"(r) : "v"(lo), "v"(hi)); return r; }
typedef float f32x2 __attribute__((ext_vector_type(2)));
template <class Epi, class Sched, bool STAMP = false>
__device__ __forceinline__ void gemm_phase(PG8_LAS unsigned char* lds, const Gemm g, const Sched& S, const Epi& E, unsigned long long* stamps) {
    int tid_ = (int)threadIdx.x; asm volatile("" : "+v"(tid_)); const int tid = tid_, wid = __builtin_amdgcn_readfirstlane(tid >> 6), lane = tid & 63, wr = wid >> 2, wc = wid & 3, fr = lane & 15, fq = lane >> 4;
    int K_ = g.K; asm volatile("" : "+s"(K_)); const int K = K_, nt = K / BK;
    int ts_lo = 0, ts_hi = 0, nts = 0; const unsigned long long rt_entry = STAMP ? (unsigned long long)wall_clock64() : 0ull;
#define PG8_STAMP() do { if (STAMP && wid == 0 && nts < 64) { const unsigned long long _c = (unsigned long long)clock64(); \
        ts_lo = (lane == nts) ? (int)(unsigned)_c : ts_lo; ts_hi = (lane == nts) ? (int)(unsigned)(_c >> 32) : ts_hi; ++nts; } } while (0)
    PG8_STAMP();
    unsigned voffA[2], voffB[2];
#pragma unroll
    for (int i = 0; i < 2; ++i) { int R, C; stage_rc(tid * 16 + i * 8192, R, C); const int Rb = Epi::PERM ? ((R & ~31) + perm32(R & 31)) : R;
        voffA[i] = (unsigned)(R * K + C) * 2u; voffB[i] = (unsigned)(Rb * K + C) * 2u; }
    const size_t kstep = (size_t)(BK * 2);
    const size_t hstep = (size_t)HALF * K * 2;
    const size_t tstep = 2 * hstep;
    const unsigned ldsw = (unsigned)wid * 1024u;
    const int aoff = lds_byte(wr * 64 + fr, fq * 8), boff = lds_byte(wc * 32 + fr, fq * 8);
#define PG8_SA(b, h) (((b) * 2 + (h)) * HTB)
#define PG8_SB(b, h) ((4 + (b) * 2 + (h)) * HTB)
#define PG8_STAGE(bufoff, gbase, voff) do { _Pragma("unroll") for (int _i = 0; _i < 2; ++_i) \
        __builtin_amdgcn_global_load_lds((const unsigned*)((const char*)(gbase) + (voff)[_i]), (PG8_LAS unsigned*)(lds + (bufoff) + ldsw + _i * 8192), 16, 0, 0); } while (0)
#define PG8_LDA(dst, b, h) do { _Pragma("unroll") for (int m = 0; m < 4; ++m) _Pragma("unroll") for (int k = 0; k < 2; ++k) dst[m][k] = *(const PG8_LAS bf16x8*)(lds + PG8_SA(b, h) + aoff + m * 2048 + k * 1024); } while (0)
#define PG8_LDB(dst, b, h) do { _Pragma("unroll") for (int n = 0; n < 2; ++n) _Pragma("unroll") for (int k = 0; k < 2; ++k) dst[n][k] = *(const PG8_LAS bf16x8*)(lds + PG8_SB(b, h) + boff + n * 2048 + k * 1024); } while (0)
#define PG8_MMA(ai, bj, At, Bt) do { __builtin_amdgcn_s_setprio(1); _Pragma("unroll") for (int m = 0; m < 4; ++m) _Pragma("unroll") for (int n = 0; n < 2; ++n) _Pragma("unroll") for (int k = 0; k < 2; ++k) \
        acc[ai][bj][m][n] = __builtin_amdgcn_mfma_f32_16x16x32_bf16(Bt[n][k], At[m][k], acc[ai][bj][m][n], 0, 0, 0); __builtin_amdgcn_s_setprio(0); } while (0)
#define PG8_WAIT_V(n) asm volatile("s_waitcnt vmcnt(" #n ")" ::: "memory")
#define PG8_WAIT_L(n) asm volatile("s_waitcnt lgkmcnt(" #n ")" ::: "memory")
#define PG8_BAR __builtin_amdgcn_s_barrier()
#define PG8_SCHED __builtin_amdgcn_sched_barrier(0)
    Unit cur, nxt; int ui = 0;
    if (!S.next(0, cur)) return;
    f32x4 acc[2][2][4][2];
#pragma unroll
    for (int a = 0; a < 2; ++a)
#pragma unroll
        for (int b = 0; b < 2; ++b)
#pragma unroll
            for (int m = 0; m < 4; ++m)
#pragma unroll
                for (int n = 0; n < 2; ++n) acc[a][b][m][n] = (f32x4){0.f, 0.f, 0.f, 0.f};
    bf16x8 At[4][2], B0[2][2], B1[2][2];
    const char* cA = (const char*)g.A + (size_t)cur.pm * tstep; const char* cB = (const char*)g.Bt + (size_t)cur.pn * tstep;
    S.a_ready(cur);
    PG8_STAGE(PG8_SB(0, 0), cB, voffB); PG8_STAGE(PG8_SA(0, 0), cA, voffA); PG8_STAGE(PG8_SB(0, 1), cB + hstep, voffB); PG8_STAGE(PG8_SA(0, 1), cA + hstep, voffA);
    if (wr == 1) PG8_BAR;
    PG8_WAIT_V(4); PG8_BAR;
    PG8_STAGE(PG8_SB(1, 0), cB + kstep, voffB); PG8_STAGE(PG8_SA(1, 0), cA + kstep, voffA); PG8_STAGE(PG8_SB(1, 1), cB + hstep + kstep, voffB);
    PG8_WAIT_V(6); PG8_BAR;
    PG8_STAMP();
    for (;;) {
        const bool has_next = S.next(ui + 1, nxt);
        const char* nA = has_next ? (const char*)g.A + (size_t)nxt.pm * tstep : cA; const char* nB = has_next ? (const char*)g.Bt + (size_t)nxt.pn * tstep : cB;
        for (int t = 0; t < nt; t += 2) {
            const bool last = (t == nt - 2);
            const char* a1 = cA + (size_t)(t + 1) * kstep;
            const char* a2 = last ? nA : cA + (size_t)(t + 2) * kstep; const char* b2 = last ? nB : cB + (size_t)(t + 2) * kstep;
            const char* a3 = a2 + kstep; const char* b3 = b2 + kstep;
            if (last && has_next) S.a_ready(nxt);
            PG8_LDB(B0, 0, 0); PG8_SCHED; PG8_LDA(At, 0, 0); PG8_STAGE(PG8_SA(1, 1), a1 + hstep, voffA);
            PG8_WAIT_L(8); PG8_BAR; PG8_WAIT_L(0); PG8_MMA(0, 0, At, B0); PG8_BAR; PG8_SCHED;
            PG8_LDB(B1, 0, 1); PG8_STAGE(PG8_SB(0, 0), b2, voffB);
            PG8_BAR; PG8_WAIT_L(0); PG8_MMA(0, 1, At, B1); PG8_BAR;
            PG8_LDA(At, 0, 1); PG8_STAGE(PG8_SA(0, 0), a2, voffA);
            PG8_BAR; PG8_WAIT_L(0); PG8_MMA(1, 0, At, B0); PG8_BAR; PG8_SCHED;
            PG8_STAGE(PG8_SB(0, 1), b2 + hstep, voffB);
            PG8_WAIT_V(6); PG8_BAR; PG8_MMA(1, 1, At, B1); PG8_BAR;
            PG8_LDB(B0, 1, 0); PG8_SCHED; PG8_LDA(At, 1, 0); PG8_STAGE(PG8_SA(0, 1), a2 + hstep, voffA);
            PG8_WAIT_L(8); PG8_BAR; PG8_WAIT_L(0); PG8_MMA(0, 0, At, B0); PG8_BAR; PG8_SCHED;
            PG8_LDB(B1, 1, 1); PG8_STAGE(PG8_SB(1, 0), b3, voffB);
            PG8_BAR; PG8_WAIT_L(0); PG8_MMA(0, 1, At, B1); PG8_BAR;
            PG8_LDA(At, 1, 1); PG8_STAGE(PG8_SA(1, 0), a3, voffA);
            PG8_BAR; PG8_WAIT_L(0); PG8_MMA(1, 0, At, B0); PG8_BAR; PG8_SCHED;
            PG8_STAGE(PG8_SB(1, 1), b3 + hstep, voffB);
            PG8_WAIT_V(6); PG8_BAR; PG8_MMA(1, 1, At, B1); PG8_BAR;
        }
        PG8_STAMP();
        if constexpr (!Epi::AFTER_DRAIN) { E(acc, cur, wr, wc, fr, fq); S.done(cur); }
        PG8_STAMP();
        if (!has_next) break;
#pragma unroll
        for (int a = 0; a < 2; ++a)
#pragma unroll
            for (int b = 0; b < 2; ++b)
#pragma unroll
                for (int m = 0; m < 4; ++m)
#pragma unroll
                    for (int n = 0; n < 2; ++n) acc[a][b][m][n] = (f32x4){0.f, 0.f, 0.f, 0.f};
        cur = nxt; cA = nA; cB = nB; ++ui;
    }
    PG8_WAIT_V(0);
    if (wr == 0) PG8_BAR;
    PG8_BAR;
    if constexpr (Epi::AFTER_DRAIN) { E.fused(acc, cur, wr, wc, fr, fq, lds, wid, lane); S.done(cur); }
    PG8_STAMP();
    if (STAMP && wid == 0) { stamps[lane] = lane < nts ? (((unsigned long long)(unsigned)ts_hi << 32) | (unsigned)ts_lo) : 0ull;
        if (lane == 62) stamps[62] = rt_entry; if (lane == 63) stamps[63] = (unsigned long long)wall_clock64(); }
#undef PG8_STAMP
#undef PG8_SA
#undef PG8_SB
#undef PG8_STAGE
#undef PG8_LDA
#undef PG8_LDB
#undef PG8_MMA
#undef PG8_WAIT_V
#undef PG8_WAIT_L
#undef PG8_BAR
#undef PG8_SCHED
}
}
using pg8::bf16_t; using pg8::bf16x8; using pg8::f32x4; using pg8::u32x4; using pg8::Unit;
#define LAS __attribute__((address_space(3)))
typedef unsigned u32x2 __attribute__((ext_vector_type(2)));
typedef LAS unsigned char* lds_t;
__device__ __forceinline__ int tid_opaque() { int t = (int)threadIdx.x; asm volatile("" : "+v"(t)); return t; }
typedef float f32x2_t __attribute__((ext_vector_type(2)));

enum { I_XP = 0, I_XS, I_C, I_CCTX, I_CKV, I_CKR, I_SGLA, I_SS5, I_NORMW, I_WADA, I_BADA, I_WIN, I_WA2, I_BA, I_ONORM, I_QNORM, I_WUQ, I_KVNORM, I_WUK, I_WUV,
       I_QHNORM, I_KHNORM, I_ARE, I_AIM, I_LOGDT, I_BRE, I_BIM, I_CRE, I_CIM, I_S5D, I_WGLU, I_BGLU, I_WBOG, I_WBOM, I_WBOS, I_WOUT, N_IN };
struct KParams { const float* in[N_IN]; float* out; unsigned char* ws; };
struct Params { const float* const* in; float* out; unsigned char* ws; };

constexpr int LDZ = 6912;
constexpr int ZQ = 0, ZK = 256, ZV = 512, ZGA = 1024, ZGG = 1056, ZMQ = 1568, ZMKV = 1952, ZMKR = 2208, ZMG = 2240, ZSU = 2752, ZSG = 3264, ZMERGE = 3776;
constexpr size_t OUT_YP = 0, OUT_CKV = 8388608, OUT_KR = 10485760, OUT_GLA = 10747904, OUT_S5 = 12845056;
constexpr size_t OFF_WIN = 0;
constexpr size_t OFF_QD = OFF_WIN, OFF_KN = OFF_WIN + 8388608;
constexpr size_t OFF_WUQ = OFF_WIN + 14155776;
constexpr size_t OFF_WKV = OFF_WUQ + 393216;
constexpr size_t OFF_WGLU = OFF_WKV + 393216;
constexpr size_t OFF_WBO = OFF_WGLU + 1048576;
constexpr size_t OFF_WOUT = OFF_WBO + 3145728;
constexpr size_t OFF_S5M = OFF_WOUT + 2097152;
constexpr size_t OFF_V = OFF_S5M;
constexpr size_t OFF_P16 = OFF_S5M + 12582912;
constexpr size_t OFF_ADA = OFF_P16 + 32768;
constexpr size_t OFF_ROPE = OFF_ADA + 122880;
constexpr size_t OFF_CTX0 = OFF_ROPE + 131072;
constexpr size_t OFF_CKVN = OFF_CTX0 + 1048576;
constexpr size_t OFF_CTX1 = OFF_CKVN + 4194304;
constexpr size_t OFF_HB = OFF_CTX1 + 1048576;
constexpr size_t OFF_Z = OFF_HB + 16777216;
constexpr size_t OFF_KV = OFF_Z + 113246208;
constexpr size_t OFF_AGLA = OFF_KV, OFF_AMLA = OFF_KV + 8388608;
constexpr size_t OFF_DEC = OFF_KV + 33554432;
constexpr size_t OFF_ST = OFF_DEC + 262144;
constexpr size_t OFF_AQ = OFF_ST + 16777216;
constexpr size_t OFF_QRAW = OFF_AQ + 6291456;
constexpr size_t OFF_AS5 = OFF_QRAW + 6291456;
constexpr size_t OFF_YG = OFF_AS5 + 8388608;
constexpr size_t OFF_TBL = OFF_YG + 8388608;
constexpr size_t OFF_BAR = OFF_TBL + 512;
constexpr size_t OFF_KF = OFF_BAR + 16384;
constexpr size_t WS_END = OFF_KF + 7864320;
constexpr int DYN_LDS = 147456;

__device__ __forceinline__ float bf2f(bf16_t b) { return __uint_as_float(((unsigned)b) << 16); }
__device__ __forceinline__ bf16_t f2bf(float f) { unsigned u = __float_as_uint(f); u += 0x7FFFu + ((u >> 16) & 1u); return (bf16_t)(u >> 16); }
__device__ __forceinline__ unsigned pk2(float lo, float hi) { return pg8::cvt_pk_bf16(lo, hi); }
__device__ __forceinline__ float lo16(unsigned w) { return __uint_as_float(w << 16); }
__device__ __forceinline__ float hi16(unsigned w) { return __uint_as_float(w & 0xffff0000u); }
__device__ __forceinline__ float sigmoidf_(float x) { return 1.f / (1.f + __expf(-x)); }
__device__ __forceinline__ float siluf_(float x) { return x / (1.f + __expf(-x)); }
__device__ __forceinline__ void store8(bf16_t* p, const f32x4& a, const f32x4& b) { u32x4 w; w.x = pk2(a[0], a[1]); w.y = pk2(a[2], a[3]); w.z = pk2(b[0], b[1]); w.w = pk2(b[2], b[3]); *(u32x4*)p = w; }
#define MFMA16(a, b, c) __builtin_amdgcn_mfma_f32_16x16x32_bf16(a, b, c, 0, 0, 0)
#define LDSFRAG(ptr) (*(const LAS bf16x8*)(ptr))

struct Order : pg8::StaticOrder {
    __device__ void setup(int M, int N, int rot) { const int G = (int)gridDim.x; init(M, N, G, (int)((blockIdx.x + (unsigned)rot) % (unsigned)G)); }
};

struct EpiZ { static constexpr bool PERM = true, AFTER_DRAIN = false; bf16_t* Z;
    __device__ __forceinline__ void operator()(const f32x4 (&acc)[2][2][4][2], const Unit& u, int wr, int wc, int fr, int fq) const {
        const int row0 = u.pm * 256 + wr * 64 + fr, col0 = u.pn * 256 + wc * 32 + 8 * fq;
#pragma unroll
        for (int ai = 0; ai < 2; ++ai)
#pragma unroll
            for (int m = 0; m < 4; ++m) { bf16_t* rp = Z + (size_t)(row0 + ai * 128 + m * 16) * LDZ + col0;
#pragma unroll
                for (int bj = 0; bj < 2; ++bj) store8(rp + bj * 128, acc[ai][bj][m][0], acc[ai][bj][m][1]); }
    } };
struct EpiQ { static constexpr bool PERM = true, AFTER_DRAIN = false; bf16_t* Q;
    __device__ __forceinline__ void operator()(const f32x4 (&acc)[2][2][4][2], const Unit& u, int wr, int wc, int fr, int fq) const {
        const int row0 = u.pm * 256 + wr * 64 + fr, col0 = u.pn * 256 + wc * 32 + 8 * fq;
#pragma unroll
        for (int ai = 0; ai < 2; ++ai)
#pragma unroll
            for (int m = 0; m < 4; ++m) { bf16_t* rp = Q + (size_t)(row0 + ai * 128 + m * 16) * 384 + col0;
#pragma unroll
                for (int bj = 0; bj < 2; ++bj) if (col0 + bj * 128 < 384) store8(rp + bj * 128, acc[ai][bj][m][0], acc[ai][bj][m][1]);
                }
    } };
struct EpiKV { static constexpr bool PERM = true, AFTER_DRAIN = false; bf16_t* KF; bf16_t* V; int layer; const bf16_t* Z; const float* ckr; const float* khn; const float* R;
    __device__ __forceinline__ void operator()(const f32x4 (&acc)[2][2][4][2], const Unit& u, int wr, int wc, int fr, int fq) const {
        int rb = u.pm * 256; if (layer == 0) rb = rb < 2048 ? 8192 + rb : rb - 2048;
        const int row0 = rb + wr * 64 + fr;
        if (u.pn > 0) { const int cl = wc * 32 + 8 * fq;
#pragma unroll
            for (int ai = 0; ai < 2; ++ai)
#pragma unroll
                for (int m = 0; m < 4; ++m) { bf16_t* rp = V + (size_t)(row0 + ai * 128 + m * 16) * 512 + (u.pn - 1) * 256 + cl;
#pragma unroll
                    for (int bj = 0; bj < 2; ++bj) store8(rp + bj * 128, acc[ai][bj][m][0], acc[ai][bj][m][1]); }
            return; }
        float wn[2][8], w1[4], w2[4];
#pragma unroll
        for (int bj = 0; bj < 2; ++bj)
#pragma unroll
            for (int i = 0; i < 8; ++i) wn[bj][i] = khn[32 * bj + 8 * fq + i];
#pragma unroll
        for (int i = 0; i < 4; ++i) { w1[i] = khn[64 + 4 * fq + i]; w2[i] = khn[80 + 4 * fq + i]; }
#pragma unroll
        for (int ai = 0; ai < 2; ++ai)
#pragma unroll
            for (int m = 0; m < 4; ++m) { const int r = row0 + ai * 128 + m * 16;
                float x1[4], x2[4];
                if (r >= 8192) { const int j = r - 8192; const float* kr = ckr + ((size_t)(((j >> 9) * 2 + layer) * 512 + (j & 511))) * 32 + 4 * fq;
                    const f32x4 a = *(const f32x4*)kr, b = *(const f32x4*)(kr + 16); x1[0] = a[0]; x1[1] = a[1]; x1[2] = a[2]; x1[3] = a[3]; x2[0] = b[0]; x2[1] = b[1]; x2[2] = b[2]; x2[3] = b[3]; }
                else { const bf16_t* kr = Z + (size_t)r * LDZ + ZMKR + 4 * fq; const u32x2 a = *(const u32x2*)kr, b = *(const u32x2*)(kr + 16);
                    x1[0] = lo16(a.x); x1[1] = hi16(a.x); x1[2] = lo16(a.y); x1[3] = hi16(a.y); x2[0] = lo16(b.x); x2[1] = hi16(b.x); x2[2] = lo16(b.y); x2[3] = hi16(b.y); }
                float ss = 0.f;
#pragma unroll
                for (int bj = 0; bj < 2; ++bj)
#pragma unroll
                    for (int i = 0; i < 8; ++i) { const float v = acc[ai][bj][m][i >> 2][i & 3]; ss += v * v; }
#pragma unroll
                for (int i = 0; i < 4; ++i) ss += x1[i] * x1[i] + x2[i] * x2[i];
                ss += __shfl_xor(ss, 16); ss += __shfl_xor(ss, 32);
                const float rstd = rsqrtf(ss * (1.f / 96.f) + 1e-6f);
                bf16_t* kp = KF + (size_t)r * 384 + wc * 96;
#pragma unroll
                for (int bj = 0; bj < 2; ++bj) { u32x4 w; const f32x4 v0 = acc[ai][bj][m][0], v1 = acc[ai][bj][m][1];
                    w.x = pk2(v0[0] * rstd * wn[bj][0], v0[1] * rstd * wn[bj][1]); w.y = pk2(v0[2] * rstd * wn[bj][2], v0[3] * rstd * wn[bj][3]);
                    w.z = pk2(v1[0] * rstd * wn[bj][4], v1[1] * rstd * wn[bj][5]); w.w = pk2(v1[2] * rstd * wn[bj][6], v1[3] * rstd * wn[bj][7]);
                    *(u32x4*)(kp + 32 * bj + 8 * fq) = w; }
                float o1[4], o2[4]; const bool rot = r >= 4096 && r < 8192; const int pos = (r - 4096) & 1023;
#pragma unroll
                for (int i = 0; i < 4; ++i) { const float a = x1[i] * rstd * w1[i], b = x2[i] * rstd * w2[i];
                    if (rot) { const float c = R[pos * 16 + 4 * fq + i], sn = R[16384 + pos * 16 + 4 * fq + i]; o1[i] = a * c - b * sn; o2[i] = a * sn + b * c; } else { o1[i] = a; o2[i] = b; } }
                *(u32x2*)(kp + 64 + 4 * fq) = (u32x2){pk2(o1[0], o1[1]), pk2(o1[2], o1[3])}; *(u32x2*)(kp + 80 + 4 * fq) = (u32x2){pk2(o2[0], o2[1]), pk2(o2[2], o2[3])}; }
    } };
struct EpiGLU { static constexpr bool PERM = true, AFTER_DRAIN = false; bf16_t* O; const bf16_t* Z; const float* bias;
    __device__ __forceinline__ void operator()(const f32x4 (&acc)[2][2][4][2], const Unit& u, int wr, int wc, int fr, int fq) const {
        const int row0 = u.pm * 256 + wr * 64 + fr, oc = u.pn * 128 + wc * 32 + 8 * fq;
        float bv[8], bg[8];
#pragma unroll
        for (int i = 0; i < 8; ++i) { bv[i] = bias[oc + i]; bg[i] = bias[512 + oc + i]; }
        u32x4 sgv[2][4];
#pragma unroll
        for (int ai = 0; ai < 2; ++ai)
#pragma unroll
            for (int m = 0; m < 4; ++m) sgv[ai][m] = *(const u32x4*)(Z + (size_t)(row0 + ai * 128 + m * 16) * LDZ + ZSG + oc);
#pragma unroll
        for (int ai = 0; ai < 2; ++ai)
#pragma unroll
            for (int m = 0; m < 4; ++m) { const size_t r = (size_t)(row0 + ai * 128 + m * 16);
                const u32x4 sg = sgv[ai][m];
                float g[8] = { lo16(sg.x), hi16(sg.x), lo16(sg.y), hi16(sg.y), lo16(sg.z), hi16(sg.z), lo16(sg.w), hi16(sg.w) };
                float o[8];
#pragma unroll
                for (int i = 0; i < 8; ++i) { const float zv = acc[ai][0][m][i >> 2][i & 3] + bv[i], zg = acc[ai][1][m][i >> 2][i & 3] + bg[i]; o[i] = zv * sigmoidf_(zg) * siluf_(g[i]); }
                u32x4 w; w.x = pk2(o[0], o[1]); w.y = pk2(o[2], o[3]); w.z = pk2(o[4], o[5]); w.w = pk2(o[6], o[7]);
                *(u32x4*)(O + r * 512 + oc) = w; }
    } };
struct EpiBo { static constexpr bool PERM = true, AFTER_DRAIN = false; bf16_t* MIX; const bf16_t* Z; int branch;
    __device__ __forceinline__ void operator()(const f32x4 (&acc)[2][2][4][2], const Unit& u, int wr, int wc, int fr, int fq) const {
        const int row0 = u.pm * 256 + wr * 64 + fr, col0 = u.pn * 256 + wc * 32 + 8 * fq;
        u32x4 gz[2][4][2];
#pragma unroll
        for (int ai = 0; ai < 2; ++ai)
#pragma unroll
            for (int m = 0; m < 4; ++m)
#pragma unroll
                for (int bj = 0; bj < 2; ++bj) gz[ai][m][bj] = *(const u32x4*)(Z + (size_t)(row0 + ai * 128 + m * 16) * LDZ + ZMERGE + branch * 1024 + col0 + bj * 128);
#pragma unroll
        for (int ai = 0; ai < 2; ++ai)
#pragma unroll
            for (int m = 0; m < 4; ++m) { const size_t r = (size_t)(row0 + ai * 128 + m * 16);
#pragma unroll
                for (int bj = 0; bj < 2; ++bj) { const int c = col0 + bj * 128;
                    const u32x4 sg = gz[ai][m][bj];
                    float g[8] = { lo16(sg.x), hi16(sg.x), lo16(sg.y), hi16(sg.y), lo16(sg.z), hi16(sg.z), lo16(sg.w), hi16(sg.w) };
                    float o[8];
#pragma unroll
                    for (int i = 0; i < 8; ++i) o[i] = sigmoidf_(g[i]) * acc[ai][bj][m][i >> 2][i & 3];
                    bf16_t* mp = MIX + r * 1024 + c;
                    if (branch > 0) { const u32x4 pv = *(const u32x4*)mp;
                        o[0] += lo16(pv.x); o[1] += hi16(pv.x); o[2] += lo16(pv.y); o[3] += hi16(pv.y); o[4] += lo16(pv.z); o[5] += hi16(pv.z); o[6] += lo16(pv.w); o[7] += hi16(pv.w); }
                    u32x4 w; w.x = pk2(o[0], o[1]); w.y = pk2(o[2], o[3]); w.z = pk2(o[4], o[5]); w.w = pk2(o[6], o[7]);
                    *(u32x4*)mp = w; } }
    } };
struct EpiOut { static constexpr bool PERM = false, AFTER_DRAIN = false; float* Y; const float* xp; const float* xs; const float* ada;
    __device__ __forceinline__ void operator()(const f32x4 (&acc)[2][2][4][2], const Unit& u, int wr, int wc, int fr, int fq) const {
        const int row0 = u.pm * 256 + wr * 64 + fr, col0 = u.pn * 256 + wc * 32 + 4 * fq;
        const int ar = u.pm < 16 ? 0 : 1 + ((u.pm - 16) >> 2);
        const float* gp = ada + ar * 3072 + 2048;
        f32x4 gv[2][2];
#pragma unroll
        for (int bj = 0; bj < 2; ++bj)
#pragma unroll
            for (int n = 0; n < 2; ++n) gv[bj][n] = *(const f32x4*)(gp + col0 + bj * 128 + n * 16);
#pragma unroll
        for (int ai = 0; ai < 2; ++ai)
#pragma unroll
            for (int m = 0; m < 4; ++m) { const int r = row0 + ai * 128 + m * 16;
                const float* xr = (r < 4096 ? xp + (size_t)r * 1024 : xs + (size_t)(r - 4096) * 1024) + col0;
                float* yr = Y + (size_t)r * 1024 + col0;
#pragma unroll
                for (int bj = 0; bj < 2; ++bj)
#pragma unroll
                    for (int n = 0; n < 2; ++n) { const f32x4 xv = *(const f32x4*)(xr + bj * 128 + n * 16); *(f32x4*)(yr + bj * 128 + n * 16) = xv + gv[bj][n] * acc[ai][bj][m][n]; } }
    } };

__device__ void job_ada(const Params& p, int j, lds_t lds) {
    LAS float* sc = (LAS float*)lds; LAS float* red = sc + 5 * 1024;
    const int l = j / 96, c0 = (j % 96) * 32, tid = tid_opaque();
    for (int i = tid; i < 5 * 1024; i += 512) { const int r = i >> 10, k = i & 1023; const float v = r == 0 ? p.in[I_CCTX][k] : p.in[I_C][(r - 1) * 1024 + k]; sc[i] = v / (1.f + expf(-v)); }
    __syncthreads();
    const int col = tid & 31, kg = tid >> 5; const float* W = p.in[I_WADA] + (size_t)l * 1024 * 3072 + (size_t)(kg * 64) * 3072 + c0 + col;
    float a0 = 0.f, a1 = 0.f, a2 = 0.f, a3 = 0.f, a4 = 0.f;
#pragma unroll 1
    for (int kb = 0; kb < 64; kb += 16) { float w[16];
#pragma unroll
        for (int i = 0; i < 16; ++i) w[i] = W[(size_t)(kb + i) * 3072];
#pragma unroll
        for (int i = 0; i < 16; ++i) { const int k = kg * 64 + kb + i; a0 += sc[k] * w[i]; a1 += sc[1024 + k] * w[i]; a2 += sc[2048 + k] * w[i]; a3 += sc[3072 + k] * w[i]; a4 += sc[4096 + k] * w[i]; } }
    red[(kg * 5 + 0) * 32 + col] = a0; red[(kg * 5 + 1) * 32 + col] = a1; red[(kg * 5 + 2) * 32 + col] = a2; red[(kg * 5 + 3) * 32 + col] = a3; red[(kg * 5 + 4) * 32 + col] = a4;
    __syncthreads();
    if (tid < 160) { const int r = tid >> 5, cc = tid & 31; float s = p.in[I_BADA][l * 3072 + c0 + cc];
        for (int g = 0; g < 16; ++g) s += red[(g * 5 + r) * 32 + cc];
        ((float*)(p.ws + OFF_ADA))[(l * 5 + r) * 3072 + c0 + cc] = s; }
    __syncthreads();
}
__device__ void job_ctx(const Params& p, int j) {
    const int base = j * 4096 + tid_opaque() * 8; const int l = base / (2048 * 256), rem = base % (2048 * 256), row = rem >> 8, c = rem & 255, b = row >> 9, jj = row & 511;
    const float* s = p.in[I_CKV] + ((size_t)((b * 2 + l) * 512 + jj)) * 256 + c;
    const f32x4 v0 = *(const f32x4*)s, v1 = *(const f32x4*)(s + 4);
    bf16_t* d = (bf16_t*)(p.ws + (l == 0 ? OFF_CTX0 : OFF_CTX1)) + (size_t)row * 256 + c;
    store8(d, v0, v1);
}
__device__ void job_rope(const Params& p, int j) {
    const int idx = j * 512 + tid_opaque(), pos = idx >> 4, i = idx & 15, f = i & 7;
    const float inv = powf(10000.f, -(float)f / 8.f); const float ang = (float)(i < 8 ? (pos >> 6) : (pos & 63)) * inv;
    float* R = (float*)(p.ws + OFF_ROPE); R[idx] = cosf(ang); R[16384 + idx] = sinf(ang);
}

__device__ void job_prep(const Params& p, int l, int j) {
    const int tid = tid_opaque(), wid = tid >> 6, lane = tid & 63, row = j * 8 + wid;
    const float* x = l == 0 ? (row < 4096 ? p.in[I_XP] + (size_t)row * 1024 : p.in[I_XS] + (size_t)(row - 4096) * 1024) : p.out + (size_t)row * 1024;
    const int ar = row < 4096 ? 0 : 1 + ((row - 4096) >> 10);
    const float* ada = (const float*)(p.ws + OFF_ADA) + (l * 5 + ar) * 3072; const float* nw = p.in[I_NORMW] + l * 1024;
    f32x4 v[4]; float ss = 0.f;
#pragma unroll
    for (int i = 0; i < 4; ++i) { v[i] = *(const f32x4*)(x + i * 256 + lane * 4); ss += v[i][0] * v[i][0] + v[i][1] * v[i][1] + v[i][2] * v[i][2] + v[i][3] * v[i][3]; }
#pragma unroll
    for (int o = 1; o < 64; o <<= 1) ss += __shfl_xor(ss, o);
    const float rstd = rsqrtf(ss * (1.f / 1024.f) + 1e-6f);
    bf16_t* h = (bf16_t*)(p.ws + OFF_HB) + (size_t)row * 1024;
#pragma unroll
    for (int i = 0; i < 4; ++i) { const int c = i * 256 + lane * 4; const f32x4 w = *(const f32x4*)(nw + c), sh = *(const f32x4*)(ada + c), sc = *(const f32x4*)(ada + 1024 + c);
        float o[4];
#pragma unroll
        for (int k = 0; k < 4; ++k) o[k] = v[i][k] * rstd * w[k] * (1.f + sc[k]) + sh[k];
        u32x2 pk; pk.x = pk2(o[0], o[1]); pk.y = pk2(o[2], o[3]); *(u32x2*)(h + c) = pk; }
}
__device__ void wt_tile(const float* src, int ldsrc, int sbase, int nvalid, int mode, bf16_t* dst, int K, int n0, int k0, lds_t lds) {
    LAS float* t = (LAS float*)lds; const int tid = tid_opaque();
    const int nn = tid & 255, kh = tid >> 8; const int sc = mode == 0 ? sbase + nn : mode == 1 ? ((nn >> 7) & 1) * 512 + sbase + (nn & 127) : ((nn >> 5) & 3) * 64 + (nn >> 7) * 32 + (nn & 31); const bool ok = mode != 0 || nn < nvalid;
    float v[32];
#pragma unroll
    for (int i = 0; i < 32; ++i) v[i] = ok ? src[(size_t)(k0 + 2 * i + kh) * ldsrc + sc] : 0.f;
#pragma unroll
    for (int i = 0; i < 32; ++i) t[(2 * i + kh) * 257 + nn] = v[i];
    __syncthreads();
#pragma unroll
    for (int ps = 0; ps < 4; ++ps) { const int n = ps * 64 + (tid >> 3), kc = tid & 7; const LAS float* s = t + (kc * 8) * 257 + n; u32x4 w;
        w.x = pk2(s[0], s[257]); w.y = pk2(s[514], s[771]); w.z = pk2(s[1028], s[1285]); w.w = pk2(s[1542], s[1799]);
        *(u32x4*)(dst + (size_t)(n0 + n) * K + k0 + kc * 8) = w; }
    __syncthreads();
}
constexpr int WT_WIN = 27 * 16, WT_WUQ = 2 * 6, WT_WKV = 3 * 4, WT_WGLU = 4 * 8, WT_WBO = 4 * 8, WT_WOUT = 4 * 16, WT_TOTAL = WT_WIN + WT_WUQ + WT_WKV + WT_WGLU + 3 * WT_WBO + WT_WOUT;
__device__ void job_wt(const Params& p, int l, int t, lds_t lds) {
    if (t < WT_WIN) { const int nt = t / 16, kt = t % 16; wt_tile(p.in[I_WIN] + (size_t)l * 1024 * 6848, 6848, nt * 256, 6848 - nt * 256, 0, (bf16_t*)(p.ws + OFF_WIN), 1024, nt * 256, kt * 64, lds); return; } t -= WT_WIN;
    if (t < WT_WUQ) { const int nt = t / 6, kt = t % 6; wt_tile(p.in[I_WUQ] + (size_t)l * 384 * 384, 384, nt * 256, 384 - nt * 256, 0, (bf16_t*)(p.ws + OFF_WUQ), 384, nt * 256, kt * 64, lds); return; } t -= WT_WUQ;
    if (t < WT_WKV) { const int nt = t / 4, kt = t % 4;
        if (nt == 0) wt_tile(p.in[I_WUK] + (size_t)l * 256 * 256, 256, 0, 256, 2, (bf16_t*)(p.ws + OFF_WKV), 256, 0, kt * 64, lds);
        else wt_tile(p.in[I_WUV] + (size_t)l * 256 * 512, 512, (nt - 1) * 256, 256, 0, (bf16_t*)(p.ws + OFF_WKV), 256, nt * 256, kt * 64, lds);
        return; } t -= WT_WKV;
    if (t < WT_WGLU) { const int nt = t / 8, kt = t % 8; wt_tile(p.in[I_WGLU] + (size_t)l * 512 * 1024, 1024, nt * 128, 256, 1, (bf16_t*)(p.ws + OFF_WGLU), 512, nt * 256, kt * 64, lds); return; } t -= WT_WGLU;
    if (t < 3 * WT_WBO) { const int br = t / WT_WBO, tt = t % WT_WBO, nt = tt / 8, kt = tt % 8;
        wt_tile(p.in[I_WBOG + br] + (size_t)l * 512 * 1024, 1024, nt * 256, 256, 0, (bf16_t*)(p.ws + OFF_WBO) + (size_t)br * 1024 * 512, 512, nt * 256, kt * 64, lds); return; } t -= 3 * WT_WBO;
    { const int nt = t / 16, kt = t % 16; wt_tile(p.in[I_WOUT] + (size_t)l * 1024 * 1024, 1024, nt * 256, 256, 0, (bf16_t*)(p.ws + OFF_WOUT), 1024, nt * 256, kt * 64, lds); }
}
__device__ void job_s5setup(const Params& p, int l, int j, lds_t lds) {
    const int g = j / 3, which = j % 3, tid = tid_opaque();
    LAS f32x2_t* pw = (LAS f32x2_t*)lds;
    LAS f32x2_t* Bt = pw + 2 * 17 * 64;
    LAS f32x2_t* Cn = Bt + 2 * 64 * 16;
    LAS float* Kt = (LAS float*)(Cn + 64 * 16);
    if (tid < 128) { const int d = tid >> 6, n = tid & 63;
        const float dt = expf(p.in[I_LOGDT][(l * 2 + d) * 32 + g]);
        const float are = p.in[I_ARE][((l * 2 + d) * 32 + g) * 64 + n], aim = p.in[I_AIM][((l * 2 + d) * 32 + g) * 64 + n];
        for (int tau = 0; tau <= 16; ++tau) { const float mag = expf(are * dt * (float)tau); float s, c; sincosf(aim * dt * (float)tau, &s, &c); pw[(d * 17 + tau) * 64 + n] = (f32x2_t){mag * c, mag * s}; }
        float s1, c1; sincosf(aim * dt, &s1, &c1); float sh = sinf(0.5f * aim * dt);
        const float em1 = expm1f(are * dt), mag1 = em1 + 1.f;
        const float nre = em1 * c1 - 2.f * sh * sh, abim = mag1 * s1, den = are * are + aim * aim;
        const float cfr = (nre * are + abim * aim) / den, cfi = (abim * are - nre * aim) / den;
        for (int q = 0; q < 16; ++q) { const float br = p.in[I_BRE][((size_t)(l * 32 + g) * 64 + n) * 16 + q], bi = p.in[I_BIM][((size_t)(l * 32 + g) * 64 + n) * 16 + q];
            Bt[(d * 64 + n) * 16 + q] = (f32x2_t){cfr * br - cfi * bi, cfr * bi + cfi * br}; }
        if (which == 1) ((f32x2_t*)(p.ws + OFF_P16))[(g * 2 + d) * 64 + n] = pw[(d * 17 + 16) * 64 + n];
    }
    for (int i = tid; i < 1024; i += 512) { const int n = i >> 4, pp = i & 15; Cn[i] = (f32x2_t){p.in[I_CRE][((size_t)(l * 32 + g) * 16 + pp) * 64 + n], p.in[I_CIM][((size_t)(l * 32 + g) * 16 + pp) * 64 + n]}; }
    __syncthreads();
    bf16_t* M = (bf16_t*)(p.ws + OFF_S5M) + (size_t)(g * 3 + which) * 65536;
    if (which == 0) {
        for (int i = tid; i < 8192; i += 512) { const int d = i >> 12, tau = (i >> 8) & 15, pp = (i >> 4) & 15, q = i & 15; float s = 0.f;
            for (int n = 0; n < 64; ++n) { const f32x2_t c = Cn[n * 16 + pp], w = pw[(d * 17 + tau) * 64 + n], b = Bt[(d * 64 + n) * 16 + q];
                const float cwr = c.x * w.x - c.y * w.y, cwi = c.x * w.y + c.y * w.x; s += cwr * b.x - cwi * b.y; }
            Kt[i] = s; }
        __syncthreads();
        for (int i = tid; i < 65536; i += 512) { const int no = i >> 8, k = i & 255, t = no >> 4, pp = no & 15, s = k >> 4, q = k & 15; float v;
            if (t > s) v = Kt[(0 * 16 + (t - s)) * 256 + pp * 16 + q];
            else if (t < s) v = Kt[(1 * 16 + (s - t)) * 256 + pp * 16 + q];
            else { v = Kt[pp * 16 + q] + Kt[16 * 256 + pp * 16 + q]; if (pp == q) v += p.in[I_S5D][l * 512 + g * 16 + pp]; }
            M[i] = f2bf(v); }
    } else if (which == 1) {
        for (int i = tid; i < 65536; i += 512) { const int no = i >> 8, k = i & 255, d = no >> 7, ri = (no >> 6) & 1, n = no & 63, s = k >> 4, q = k & 15; const int e = d == 0 ? 15 - s : s;
            const f32x2_t w = pw[(d * 17 + e) * 64 + n], b = Bt[(d * 64 + n) * 16 + q];
            M[i] = f2bf(ri == 0 ? w.x * b.x - w.y * b.y : w.x * b.y + w.y * b.x); }
    } else {
        for (int i = tid; i < 65536; i += 512) { const int no = i >> 8, k = i & 255, t = no >> 4, pp = no & 15, d = k >> 7, ri = (k >> 6) & 1, n = k & 63; const int e = d == 0 ? t + 1 : 16 - t;
            const f32x2_t c = Cn[n * 16 + pp], w = pw[(d * 17 + e) * 64 + n];
            M[i] = f2bf(ri == 0 ? c.x * w.x - c.y * w.y : -(c.x * w.y + c.y * w.x)); }
    }
    __syncthreads();
}

__device__ __forceinline__ float gelu_tanh(float x) { const float u = 0.7978845608f * (x + 0.044715f * x * x * x); const float t = 1.f - 2.f / (1.f + __expf(2.f * u)); return 0.5f * x * (1.f + t); }
__device__ void job_s5(const Params& p, int l, int j, lds_t lds) {
    const int tid = tid_opaque(), wid = tid >> 6, lane = tid & 63, lr = lane & 15, lq = lane >> 4;
    int bb, g; if (j < 128) { bb = 16 + (j >> 5); g = j & 31; } else { bb = (j - 128) >> 5; g = (j - 128) & 31; }
    const int M = bb < 16 ? 16 : 64, MT = M >> 4; const int tok0 = bb < 16 ? bb * 256 : 4096 + (bb - 16) * 1024;
    LAS bf16_t* Us = (LAS bf16_t*)lds; LAS bf16_t* Xs = Us + 64 * 264; LAS float* Xin = (LAS float*)(lds + 2 * 64 * 264 * 2);
    const bf16_t* Z = (const bf16_t*)(p.ws + OFF_Z);
    for (int idx = tid; idx < M * 32; idx += 512) { const int tok = idx >> 1, hf = idx & 1;
        *(LAS u32x4*)(Us + (tok >> 4) * 264 + (tok & 15) * 16 + hf * 8) = *(const u32x4*)(Z + (size_t)(tok0 + tok) * LDZ + ZSU + g * 16 + hf * 8); }
    __syncthreads();
    const bf16_t* TT = (const bf16_t*)(p.ws + OFF_S5M) + (size_t)(g * 3) * 65536; const bf16_t* G = TT + 65536; const bf16_t* Cc = G + 65536;
    f32x4 acc[4][2];
#pragma unroll
    for (int a = 0; a < 4; ++a) { acc[a][0] = (f32x4){0.f, 0.f, 0.f, 0.f}; acc[a][1] = acc[a][0]; }
    for (int ks = 0; ks < 8; ++ks) {
        bf16x8 b0 = *(const bf16x8*)(G + (size_t)(wid * 32 + lr) * 256 + ks * 32 + lq * 8), b1 = *(const bf16x8*)(G + (size_t)(wid * 32 + 16 + lr) * 256 + ks * 32 + lq * 8);
#pragma unroll
        for (int mt = 0; mt < 4; ++mt) if (mt < MT) { const bf16x8 a = LDSFRAG(Us + (mt * 16 + lr) * 264 + ks * 32 + lq * 8); acc[mt][0] = MFMA16(a, b0, acc[mt][0]); acc[mt][1] = MFMA16(a, b1, acc[mt][1]); }
    }
#pragma unroll
    for (int mt = 0; mt < 4; ++mt) if (mt < MT)
#pragma unroll
        for (int ct = 0; ct < 2; ++ct)
#pragma unroll
            for (int r = 0; r < 4; ++r) Xin[(mt * 16 + lq * 4 + r) * 260 + wid * 32 + ct * 16 + lr] = acc[mt][ct][r];
    __syncthreads();
    if (tid < 128) { const int d = tid >> 6, n = tid & 63; const f32x2_t a16 = ((const f32x2_t*)(p.ws + OFF_P16))[(g * 2 + d) * 64 + n];
        float xr = 0.f, xi = 0.f;
        if (bb >= 16) { const size_t o = ((size_t)(((bb - 16) * 2 + l) * 2 + d) * 2) * 2048 + g * 64 + n; xr = p.in[I_SS5][o]; xi = p.in[I_SS5][o + 2048]; }
        const int cre = d * 128 + n, cim = cre + 64;
        for (int i = 0; i < M; ++i) { const int c = d == 0 ? i : M - 1 - i;
            Xs[c * 264 + cre] = f2bf(xr); Xs[c * 264 + cim] = f2bf(xi);
            const float ur = Xin[c * 260 + cre], ui = Xin[c * 260 + cim];
            const float nr = a16.x * xr - a16.y * xi + ur, ni = a16.x * xi + a16.y * xr + ui; xr = nr; xi = ni; }
        if (bb < 16) { const size_t o = OUT_S5 + ((size_t)((bb * 2 + l) * 2 + d) * 2) * 2048 + g * 64 + n; p.out[o] = xr; p.out[o + 2048] = xi; }
    }
    __syncthreads();
#pragma unroll
    for (int a = 0; a < 4; ++a) { acc[a][0] = (f32x4){0.f, 0.f, 0.f, 0.f}; acc[a][1] = acc[a][0]; }
    for (int ks = 0; ks < 16; ++ks) { const bf16_t* Bm = ks < 8 ? TT : Cc; const LAS bf16_t* Am = ks < 8 ? Us : Xs; const int kk = (ks & 7) * 32 + lq * 8;
        bf16x8 b0 = *(const bf16x8*)(Bm + (size_t)(wid * 32 + lr) * 256 + kk), b1 = *(const bf16x8*)(Bm + (size_t)(wid * 32 + 16 + lr) * 256 + kk);
#pragma unroll
        for (int mt = 0; mt < 4; ++mt) if (mt < MT) { const bf16x8 a = LDSFRAG(Am + (mt * 16 + lr) * 264 + kk); acc[mt][0] = MFMA16(a, b0, acc[mt][0]); acc[mt][1] = MFMA16(a, b1, acc[mt][1]); }
    }
    bf16_t* Yg = (bf16_t*)(p.ws + OFF_YG);
#pragma unroll
    for (int mt = 0; mt < 4; ++mt) if (mt < MT)
#pragma unroll
        for (int ct = 0; ct < 2; ++ct)
#pragma unroll
            for (int r = 0; r < 4; ++r) { const int chunk = mt * 16 + lq * 4 + r, t = wid * 2 + ct;
                Yg[(size_t)(tok0 + chunk * 16 + t) * 512 + g * 16 + lr] = f2bf(gelu_tanh(acc[mt][ct][r])); }
    __syncthreads();
}
__device__ void job_mlaprep(const Params& p, int l, int j) {
    const int tid = tid_opaque(), wid = tid >> 6, lane = tid & 63, row = j * 8 + wid;
    const bf16_t* z = (const bf16_t*)(p.ws + OFF_Z) + (size_t)row * LDZ;
    float q[6], kv[4]; float sq = 0.f, sk = 0.f;
#pragma unroll
    for (int i = 0; i < 6; ++i) { q[i] = bf2f(z[ZMQ + i * 64 + lane]); sq += q[i] * q[i]; }
#pragma unroll
    for (int i = 0; i < 4; ++i) { kv[i] = bf2f(z[ZMKV + i * 64 + lane]); sk += kv[i] * kv[i]; }
#pragma unroll
    for (int o = 1; o < 64; o <<= 1) { sq += __shfl_xor(sq, o); sk += __shfl_xor(sk, o); }
    const float rq = rsqrtf(sq * (1.f / 384.f) + 1e-6f), rk = rsqrtf(sk * (1.f / 256.f) + 1e-6f);
    bf16_t* aq = (bf16_t*)(p.ws + OFF_AQ) + (size_t)row * 384; bf16_t* ck = (bf16_t*)(p.ws + OFF_CKVN) + (size_t)row * 256;
#pragma unroll
    for (int i = 0; i < 6; ++i) aq[i * 64 + lane] = f2bf(q[i] * rq * p.in[I_QNORM][l * 384 + i * 64 + lane]);
    const bool prompt = row < 4096; const int b = row >> 8, t = row & 255;
#pragma unroll
    for (int i = 0; i < 4; ++i) { const float v = kv[i] * rk * p.in[I_KVNORM][l * 256 + i * 64 + lane]; ck[i * 64 + lane] = f2bf(v);
        if (prompt) p.out[OUT_CKV + ((size_t)((b * 2 + l) * 256 + t)) * 256 + i * 64 + lane] = v; }
    if (prompt && lane < 32) p.out[OUT_KR + ((size_t)((b * 2 + l) * 256 + t)) * 32 + lane] = bf2f(z[ZMKR + lane]);
}
__device__ __forceinline__ float logsigmoidf_(float x) { return fminf(x, 0.f) - log1pf(expf(-fabsf(x))); }
__device__ void job_glaA(const Params& p, int l, int j, lds_t lds) {
    const int tid = tid_opaque(), wid = tid >> 6, lane = tid & 63, lr = lane & 15, lq = lane >> 4;
    const int ck = j >> 2, h = j & 3, tok0 = ck * 64;
    LAS bf16_t* QDf = (LAS bf16_t*)lds; LAS bf16_t* QDb = QDf + 4608; LAS bf16_t* KDf = QDb + 4608; LAS bf16_t* KDb = KDf + 4608; LAS bf16_t* KRf = KDb + 4608; LAS bf16_t* KRb = KRf + 4608;
    LAS bf16_t* VT = KRb + 4608;
    LAS bf16_t* ATT = VT + 9216;
    LAS float* GA = (LAS float*)(ATT + 4608);
    LAS float* TOT = GA + 2048;
    const bf16_t* Z = (const bf16_t*)(p.ws + OFF_Z);
    { const int c = tid >> 3, part = tid & 7; const u32x2 gv = *(const u32x2*)(Z + (size_t)(tok0 + c) * LDZ + ZGA + part * 4);
      GA[c * 32 + part * 4 + 0] = lo16(gv.x); GA[c * 32 + part * 4 + 1] = hi16(gv.x); GA[c * 32 + part * 4 + 2] = lo16(gv.y); GA[c * 32 + part * 4 + 3] = hi16(gv.y);
      const bf16_t* vp = Z + (size_t)(tok0 + c) * LDZ + ZV + h * 128 + part * 16;
      const u32x4 v0 = *(const u32x4*)vp, v1 = *(const u32x4*)(vp + 8);
      const unsigned w[8] = { v0.x, v0.y, v0.z, v0.w, v1.x, v1.y, v1.z, v1.w };
#pragma unroll
      for (int i = 0; i < 8; ++i) { VT[(part * 16 + 2 * i) * 72 + c] = (bf16_t)(w[i] & 0xffffu); VT[(part * 16 + 2 * i + 1) * 72 + c] = (bf16_t)(w[i] >> 16); } }
    __syncthreads();
    const int d = tid & 63, cg_ = tid >> 6;
    float laf[8], lab[8];
    { float wf[16], wb[16];
#pragma unroll
      for (int r = 0; r < 16; ++r) { wf[r] = p.in[I_WA2][((size_t)((l * 2 + 0) * 16 + r)) * 256 + h * 64 + d]; wb[r] = p.in[I_WA2][((size_t)((l * 2 + 1) * 16 + r)) * 256 + h * 64 + d]; }
      const float bf_ = p.in[I_BA][(l * 2 + 0) * 256 + h * 64 + d], bb_ = p.in[I_BA][(l * 2 + 1) * 256 + h * 64 + d];
#pragma unroll
      for (int i = 0; i < 8; ++i) { const int c = cg_ * 8 + i; float xf = bf_, xb = bb_;
#pragma unroll
          for (int r = 0; r < 16; ++r) { xf += GA[c * 32 + r] * wf[r]; xb += GA[c * 32 + 16 + r] * wb[r]; }
          laf[i] = logsigmoidf_(xf) * (1.f / 16.f); lab[i] = logsigmoidf_(xb) * (1.f / 16.f); } }
#pragma unroll
    for (int i = 1; i < 8; ++i) laf[i] += laf[i - 1];
#pragma unroll
    for (int i = 6; i >= 0; --i) lab[i] += lab[i + 1];
    TOT[(0 * 8 + cg_) * 64 + d] = laf[7]; TOT[(1 * 8 + cg_) * 64 + d] = lab[0];
    __syncthreads();
    float offf = 0.f, offb = 0.f, Tf = 0.f, Tb = 0.f;
#pragma unroll
    for (int g = 0; g < 8; ++g) { const float a = TOT[g * 64 + d], b = TOT[(8 + g) * 64 + d]; Tf += a; Tb += b; if (g < cg_) offf += a; if (g > cg_) offb += b; }
    bf16_t* QD = (bf16_t*)(p.ws + OFF_QD);
#pragma unroll
    for (int i = 0; i < 8; ++i) { const int c = cg_ * 8 + i; const size_t zr = (size_t)(tok0 + c) * LDZ;
        const float q = bf2f(Z[zr + ZQ + h * 64 + d]) * 0.125f, k = bf2f(Z[zr + ZK + h * 64 + d]);
        const float bf_ = offf + laf[i], bb_ = offb + lab[i];
        const bf16_t qf = f2bf(q * expf(bf_)), qb = f2bf(q * expf(bb_));
        QDf[c * 72 + d] = qf; QDb[c * 72 + d] = qb;
        KDf[c * 72 + d] = f2bf(k * expf(-bf_)); KDb[c * 72 + d] = f2bf(k * expf(-bb_));
        KRf[d * 72 + c] = f2bf(k * expf(Tf - bf_)); KRb[d * 72 + c] = f2bf(k * expf(Tb - bb_));
        QD[(size_t)(tok0 + c) * 256 + h * 64 + d] = qf; QD[(size_t)(8192 + tok0 + c) * 256 + h * 64 + d] = qb; }
    if (cg_ == 0) { float* DEC = (float*)(p.ws + OFF_DEC); DEC[((0 * 128 + ck) * 4 + h) * 64 + d] = expf(Tf); DEC[((1 * 128 + ck) * 4 + h) * 64 + d] = expf(Tb); }
    __syncthreads();
#pragma unroll
    for (int q2 = 0; q2 < 2; ++q2) { const int tt = wid * 2 + q2, ti = tt >> 2, tj = tt & 3; f32x4 af = {0.f, 0.f, 0.f, 0.f}, ab = af;
#pragma unroll
        for (int ks = 0; ks < 2; ++ks) { const int ko = ks * 32 + lq * 8;
            af = MFMA16(LDSFRAG(QDf + (ti * 16 + lr) * 72 + ko), LDSFRAG(KDf + (tj * 16 + lr) * 72 + ko), af);
            ab = MFMA16(LDSFRAG(QDb + (ti * 16 + lr) * 72 + ko), LDSFRAG(KDb + (tj * 16 + lr) * 72 + ko), ab); }
#pragma unroll
        for (int r = 0; r < 4; ++r) { const int c = ti * 16 + lq * 4 + r, s = tj * 16 + lr; const float v = (s <= c ? af[r] : 0.f) + (s >= c ? ab[r] : 0.f); ATT[c * 72 + s] = f2bf(v); } }
    __syncthreads();
    bf16x8 vb[2];
#pragma unroll
    for (int ks = 0; ks < 2; ++ks) vb[ks] = LDSFRAG(VT + (wid * 16 + lr) * 72 + ks * 32 + lq * 8);
    float* OI = (float*)(p.ws + OFF_HB); float* KV = (float*)(p.ws + OFF_KV);
#pragma unroll
    for (int ct = 0; ct < 4; ++ct) { f32x4 a = {0.f, 0.f, 0.f, 0.f};
#pragma unroll
        for (int ks = 0; ks < 2; ++ks) a = MFMA16(LDSFRAG(ATT + (ct * 16 + lr) * 72 + ks * 32 + lq * 8), vb[ks], a);
#pragma unroll
        for (int r = 0; r < 4; ++r) OI[(size_t)(tok0 + ct * 16 + lq * 4 + r) * 512 + h * 128 + wid * 16 + lr] = a[r]; }
#pragma unroll
    for (int dir = 0; dir < 2; ++dir) { const LAS bf16_t* KR = dir == 0 ? KRf : KRb; float* kvp = KV + ((size_t)((dir * 128 + ck) * 4 + h)) * 8192;
#pragma unroll
        for (int dt = 0; dt < 4; ++dt) { f32x4 a = {0.f, 0.f, 0.f, 0.f};
#pragma unroll
            for (int ks = 0; ks < 2; ++ks) a = MFMA16(LDSFRAG(KR + (dt * 16 + lr) * 72 + ks * 32 + lq * 8), vb[ks], a);
#pragma unroll
            for (int r = 0; r < 4; ++r) kvp[(dt * 16 + lq * 4 + r) * 128 + wid * 16 + lr] = a[r]; } }
    __syncthreads();
}

__device__ void job_glaB(const Params& p, int l, int j) {
    const int slab = j & 15, h = (j >> 4) & 3, rest = j >> 6, bb = rest % 20, dir = rest / 20;
    const int idx = slab * 512 + tid_opaque(), d = idx >> 7;
    const int nck = bb < 16 ? 4 : 16, ck0 = bb < 16 ? bb * 4 : 64 + (bb - 16) * 16;
    float S = 0.f;
    if (bb >= 16) S = p.in[I_SGLA][((size_t)((((bb - 16) * 2 + l) * 2 + dir) * 4 + h)) * 8192 + idx];
    const float* KV = (const float*)(p.ws + OFF_KV); const float* DEC = (const float*)(p.ws + OFF_DEC); bf16_t* ST = (bf16_t*)(p.ws + OFF_ST);
    for (int i = 0; i < nck; ++i) { const int ck = dir == 0 ? ck0 + i : ck0 + nck - 1 - i; const size_t it = (size_t)((dir * 128 + ck) * 4 + h);
        ST[it * 8192 + idx] = f2bf(S); S = DEC[it * 64 + d] * S + KV[it * 8192 + idx]; }
    if (bb < 16) p.out[OUT_GLA + ((size_t)(((bb * 2 + l) * 2 + dir) * 4 + h)) * 8192 + idx] = S;
}

__device__ void job_glaC(const Params& p, int l, int j, lds_t lds) {
    const int tid = tid_opaque(), wid = tid >> 6, lane = tid & 63, lr = lane & 15, lq = lane >> 4;
    const int ck = j >> 2, h = j & 3, tok0 = ck * 64;
    LAS bf16_t* Aq = (LAS bf16_t*)lds;
    LAS bf16_t* BT = Aq + 64 * 136;
    LAS float* Os = (LAS float*)(BT + 128 * 136);
    const bf16_t* QD = (const bf16_t*)(p.ws + OFF_QD); const bf16_t* ST = (const bf16_t*)(p.ws + OFF_ST);
#pragma unroll
    for (int it = 0; it < 2; ++it) { const int idx = tid + it * 512, c = idx >> 4, rem = idx & 15, dir = rem >> 3, dc = rem & 7;
        *(LAS u32x4*)(Aq + c * 136 + dir * 64 + dc * 8) = *(const u32x4*)(QD + (size_t)(dir * 8192 + tok0 + c) * 256 + h * 64 + dc * 8); }
#pragma unroll
    for (int it = 0; it < 4; ++it) { const int idx = tid + it * 512, dir = idx >> 10, d = (idx >> 4) & 63, ec = idx & 15;
        const u32x4 v = *(const u32x4*)(ST + ((size_t)((dir * 128 + ck) * 4 + h)) * 8192 + d * 128 + ec * 8);
        const unsigned w[4] = { v.x, v.y, v.z, v.w };
#pragma unroll
        for (int i = 0; i < 4; ++i) { BT[(ec * 8 + 2 * i) * 136 + dir * 64 + d] = (bf16_t)(w[i] & 0xffffu); BT[(ec * 8 + 2 * i + 1) * 136 + dir * 64 + d] = (bf16_t)(w[i] >> 16); } }
    __syncthreads();
    const int ct = wid & 3, eh = wid >> 2; const float* OI = (const float*)(p.ws + OFF_HB);
    bf16x8 af[4];
#pragma unroll
    for (int ks = 0; ks < 4; ++ks) af[ks] = LDSFRAG(Aq + (ct * 16 + lr) * 136 + ks * 32 + lq * 8);
#pragma unroll
    for (int e4 = 0; e4 < 4; ++e4) { const int et = eh * 4 + e4; f32x4 a = {0.f, 0.f, 0.f, 0.f};
#pragma unroll
        for (int ks = 0; ks < 4; ++ks) a = MFMA16(af[ks], LDSFRAG(BT + (et * 16 + lr) * 136 + ks * 32 + lq * 8), a);
#pragma unroll
        for (int r = 0; r < 4; ++r) { const int row = ct * 16 + lq * 4 + r, col = et * 16 + lr; Os[row * 132 + col] = a[r] + OI[(size_t)(tok0 + row) * 512 + h * 128 + col]; } }
    __syncthreads();
    { const int c = tid >> 3, part = tid & 7; float o[16]; float ss = 0.f;
#pragma unroll
      for (int i = 0; i < 16; ++i) { o[i] = Os[c * 132 + part * 16 + i]; ss += o[i] * o[i]; }
      ss += __shfl_xor(ss, 1); ss += __shfl_xor(ss, 2); ss += __shfl_xor(ss, 4);
      const float rstd = rsqrtf(ss * (1.f / 128.f) + 1e-6f);
      const bf16_t* gz = (const bf16_t*)(p.ws + OFF_Z) + (size_t)(tok0 + c) * LDZ + ZGG + h * 128 + part * 16;
      const u32x4 g0 = *(const u32x4*)gz, g1 = *(const u32x4*)(gz + 8);
      const unsigned gw[8] = { g0.x, g0.y, g0.z, g0.w, g1.x, g1.y, g1.z, g1.w };
      unsigned ow[8];
#pragma unroll
      for (int i = 0; i < 8; ++i) { const float n0 = p.in[I_ONORM][l * 128 + part * 16 + 2 * i], n1 = p.in[I_ONORM][l * 128 + part * 16 + 2 * i + 1];
          ow[i] = pk2(o[2 * i] * rstd * n0 * siluf_(lo16(gw[i])), o[2 * i + 1] * rstd * n1 * siluf_(hi16(gw[i]))); }
      bf16_t* ap = (bf16_t*)(p.ws + OFF_AGLA) + (size_t)(tok0 + c) * 512 + h * 128 + part * 16;
      *(u32x4*)ap = (u32x4){ow[0], ow[1], ow[2], ow[3]}; *(u32x4*)(ap + 8) = (u32x4){ow[4], ow[5], ow[6], ow[7]}; }
    __syncthreads();
}
__device__ __forceinline__ void head_row_finish(float (&x)[16], int p8, const float* nw, bool rope, int pos, const float* R, float mul, LAS bf16_t* dst) {
    float ss = 0.f; const int cnt = p8 < 4 ? 16 : 8;
#pragma unroll
    for (int i = 0; i < 16; ++i) if (i < cnt) ss += x[i] * x[i];
    ss += __shfl_xor(ss, 1); ss += __shfl_xor(ss, 2); ss += __shfl_xor(ss, 4);
    const float rstd = rsqrtf(ss * (1.f / 96.f) + 1e-6f) * mul;
    if (p8 < 4) { unsigned w[8];
#pragma unroll
        for (int i = 0; i < 8; ++i) w[i] = pk2(x[2 * i] * rstd * nw[p8 * 16 + 2 * i], x[2 * i + 1] * rstd * nw[p8 * 16 + 2 * i + 1]);
        *(LAS u32x4*)(dst + p8 * 16) = (u32x4){w[0], w[1], w[2], w[3]}; *(LAS u32x4*)(dst + p8 * 16 + 8) = (u32x4){w[4], w[5], w[6], w[7]};
    } else { const int i0 = (p8 - 4) * 4; float o1[4], o2[4];
#pragma unroll
        for (int i = 0; i < 4; ++i) { const float a = x[i] * rstd * nw[64 + i0 + i], b = x[4 + i] * rstd * nw[80 + i0 + i];
            if (rope) { const float c = R[pos * 16 + i0 + i], s = R[16384 + pos * 16 + i0 + i]; o1[i] = a * c - b * s; o2[i] = a * s + b * c; } else { o1[i] = a; o2[i] = b; } }
        *(LAS u32x2*)(dst + 64 + i0) = (u32x2){pk2(o1[0], o1[1]), pk2(o1[2], o1[3])}; *(LAS u32x2*)(dst + 80 + i0) = (u32x2){pk2(o2[0], o2[1]), pk2(o2[2], o2[3])}; }
}
__device__ __forceinline__ void ld16bf(const bf16_t* s, float (&x)[16]) { const u32x4 a = *(const u32x4*)s, b = *(const u32x4*)(s + 8);
    x[0] = lo16(a.x); x[1] = hi16(a.x); x[2] = lo16(a.y); x[3] = hi16(a.y); x[4] = lo16(a.z); x[5] = hi16(a.z); x[6] = lo16(a.w); x[7] = hi16(a.w);
    x[8] = lo16(b.x); x[9] = hi16(b.x); x[10] = lo16(b.y); x[11] = hi16(b.y); x[12] = lo16(b.z); x[13] = hi16(b.z); x[14] = lo16(b.w); x[15] = hi16(b.w); }
__device__ __forceinline__ void ld4bf(const bf16_t* s, float* x) { const u32x2 a = *(const u32x2*)s; x[0] = lo16(a.x); x[1] = hi16(a.x); x[2] = lo16(a.y); x[3] = hi16(a.y); }
__device__ void job_attn(const Params& p, int l, int j, lds_t lds) {
    const int tid = tid_opaque(), wid = tid >> 6, lane = tid & 63, lr = lane & 15, lq = lane >> 4;
    const bool smp = j < 256; int b, h, qb; if (smp) { b = j >> 6; h = (j >> 4) & 3; qb = j & 15; } else { const int jj = j - 256; b = jj >> 4; h = (jj >> 2) & 3; qb = jj & 3; }
    const int qtok0 = smp ? 4096 + b * 1024 + qb * 64 : b * 256 + qb * 64; const int nkt = smp ? 12 : 2;
    LAS bf16_t* Ks = (LAS bf16_t*)lds;
    LAS bf16_t* VTs = Ks + 128 * 104;
    LAS bf16_t* Ps = VTs + 128 * 136 + wid * 16 * 72;
    LAS float* Mg = (LAS float*)(lds + (128 * 104 + 128 * 136 + 8 * 16 * 72) * 2);
    const bf16_t* Z = (const bf16_t*)(p.ws + OFF_Z); const bf16_t* KF = (const bf16_t*)(p.ws + OFF_KF); const bf16_t* Vb = (const bf16_t*)(p.ws + OFF_V); const float* R = (const float*)(p.ws + OFF_ROPE);
    const float* qhn = p.in[I_QHNORM] + l * 96;
    u32x4 kreg[3], vreg[4];
    auto rowbase = [&](int kt) { return smp ? (kt < 4 ? 8192 + b * 512 + kt * 128 : 4096 + b * 1024 + (kt - 4) * 128) : b * 256 + kt * 128; };
    auto issue = [&](int kt) { const int rb = rowbase(kt);
#pragma unroll
        for (int i = 0; i < 3; ++i) { const int idx = tid + 512 * i, key = idx / 12, part = idx - key * 12; kreg[i] = *(const u32x4*)(KF + (size_t)(rb + key) * 384 + h * 96 + part * 8); }
#pragma unroll
        for (int i = 0; i < 4; ++i) { const int idx = tid + 512 * i, key = idx >> 4, part = idx & 15; vreg[i] = *(const u32x4*)(Vb + (size_t)(rb + key) * 512 + h * 128 + part * 8); } };
    auto commit = [&]() {
#pragma unroll
        for (int i = 0; i < 3; ++i) { const int idx = tid + 512 * i, key = idx / 12, part = idx - key * 12; *(LAS u32x4*)(Ks + key * 104 + part * 8) = kreg[i]; }
#pragma unroll
        for (int i = 0; i < 4; ++i) { const int idx = tid + 512 * i, key = idx >> 4, part = idx & 15; const int kx = key ^ ((part & 7) << 3); const unsigned w[4] = { vreg[i].x, vreg[i].y, vreg[i].z, vreg[i].w };
#pragma unroll
            for (int e = 0; e < 4; ++e) { VTs[(part * 8 + 2 * e) * 136 + kx] = (bf16_t)(w[e] & 0xffffu); VTs[(part * 8 + 2 * e + 1) * 136 + kx] = (bf16_t)(w[e] >> 16); } } };
    issue(0);
    { const int row = tid >> 3, p8 = tid & 7, tok = qtok0 + row; const bf16_t* qr = (const bf16_t*)(p.ws + OFF_QRAW) + (size_t)tok * 384 + h * 96; float x[16];
      if (p8 < 4) ld16bf(qr + p8 * 16, x); else { ld4bf(qr + 64 + (p8 - 4) * 4, x); ld4bf(qr + 80 + (p8 - 4) * 4, x + 4); }
      head_row_finish(x, p8, qhn, smp, qb * 64 + row, R, 0.10206207261596575f * 1.4426950408889634f, Ks + row * 104); }
    __syncthreads();
    const int rt = wid & 3, kh = wid >> 2;
    bf16x8 qa[3];
#pragma unroll
    for (int ks = 0; ks < 3; ++ks) qa[ks] = LDSFRAG(Ks + (rt * 16 + lr) * 104 + ks * 32 + lq * 8);
    __syncthreads();
    commit();
    __syncthreads();
    f32x4 oacc[8]; float mrow[4], lrow[4];
#pragma unroll
    for (int e = 0; e < 8; ++e) oacc[e] = (f32x4){0.f, 0.f, 0.f, 0.f};
#pragma unroll
    for (int r = 0; r < 4; ++r) { mrow[r] = -1e30f; lrow[r] = 0.f; }
    const int kbase = kh * 64;
    for (int kt = 0; kt < nkt; ++kt) {
        if (kt + 1 < nkt) issue(kt + 1);
        f32x4 sacc[4];
#pragma unroll
        for (int nt = 0; nt < 4; ++nt) { sacc[nt] = (f32x4){0.f, 0.f, 0.f, 0.f};
#pragma unroll
            for (int ks = 0; ks < 3; ++ks) sacc[nt] = MFMA16(qa[ks], LDSFRAG(Ks + (kbase + nt * 16 + lr) * 104 + ks * 32 + lq * 8), sacc[nt]); }
        float alpha[4];
#pragma unroll
        for (int r = 0; r < 4; ++r) { float mx = fmaxf(fmaxf(sacc[0][r], sacc[1][r]), fmaxf(sacc[2][r], sacc[3][r]));
            mx = fmaxf(mx, __shfl_xor(mx, 1)); mx = fmaxf(mx, __shfl_xor(mx, 2)); mx = fmaxf(mx, __shfl_xor(mx, 4)); mx = fmaxf(mx, __shfl_xor(mx, 8));
            const float mn = fmaxf(mrow[r], mx); alpha[r] = exp2f(mrow[r] - mn); mrow[r] = mn; float rs = 0.f;
#pragma unroll
            for (int nt = 0; nt < 4; ++nt) { const float pv = exp2f(sacc[nt][r] - mn); rs += pv; Ps[(lq * 4 + r) * 72 + nt * 16 + lr] = f2bf(pv); }
            lrow[r] = lrow[r] * alpha[r] + rs; }
#pragma unroll
        for (int e = 0; e < 8; ++e) { oacc[e][0] *= alpha[0]; oacc[e][1] *= alpha[1]; oacc[e][2] *= alpha[2]; oacc[e][3] *= alpha[3]; }
        asm volatile("s_waitcnt lgkmcnt(0)" ::: "memory");
#pragma unroll
        for (int k2 = 0; k2 < 2; ++k2) { const bf16x8 pa = LDSFRAG(Ps + lr * 72 + k2 * 32 + lq * 8);
#pragma unroll
            for (int e = 0; e < 8; ++e) { const int er = e * 16 + lr; oacc[e] = MFMA16(pa, LDSFRAG(VTs + er * 136 + ((kbase + k2 * 32 + lq * 8) ^ (((er >> 3) & 7) << 3))), oacc[e]); } }
        __syncthreads();
        if (kt + 1 < nkt) { commit(); __syncthreads(); }
    }
#pragma unroll
    for (int r = 0; r < 4; ++r) { float s = lrow[r]; s += __shfl_xor(s, 1); s += __shfl_xor(s, 2); s += __shfl_xor(s, 4); s += __shfl_xor(s, 8); lrow[r] = s; }
    LAS float* Mo = Mg + rt * 16 * 132; LAS float* Ml = Mg + 4 * 16 * 132 + rt * 32;
    if (kh == 1) {
#pragma unroll
        for (int e = 0; e < 8; ++e)
#pragma unroll
            for (int r = 0; r < 4; ++r) Mo[(lq * 4 + r) * 132 + e * 16 + lr] = oacc[e][r];
        if (lr == 0) {
#pragma unroll
            for (int r = 0; r < 4; ++r) { Ml[(lq * 4 + r) * 2] = mrow[r]; Ml[(lq * 4 + r) * 2 + 1] = lrow[r]; } }
    }
    __syncthreads();
    if (kh == 0) { bf16_t* AM = (bf16_t*)(p.ws + OFF_AMLA);
#pragma unroll
        for (int r = 0; r < 4; ++r) { const int row = lq * 4 + r; const float m2 = Ml[row * 2], l2 = Ml[row * 2 + 1]; const float mm = fmaxf(mrow[r], m2), a1 = exp2f(mrow[r] - mm), a2 = exp2f(m2 - mm);
            const float inv = 1.f / (lrow[r] * a1 + l2 * a2); const int tok = qtok0 + rt * 16 + row;
#pragma unroll
            for (int e = 0; e < 8; ++e) { const int col = e * 16 + lr; const float o = (oacc[e][r] * a1 + Mo[row * 132 + col] * a2) * inv;
                const float gt = bf2f(Z[(size_t)tok * LDZ + ZMG + h * 128 + col]); AM[(size_t)tok * 512 + h * 128 + col] = f2bf(o * siluf_(gt)); } } }
    __syncthreads();
}


#define XB_TMO      128
#define XB_XCNT(j)  (256  + 64 * (j))
#define XB_XSUB(j)  (1280 + 64 * (j))
#define XB_XGEN(j)  (2304 + 64 * (j))
#define XB_TOP      3328
#define XB_TOPGEN   3392
#define XCD_BAR_WORDS 3456
#define XB_SPIN_CAP (1u << 18)

__device__ __forceinline__ unsigned xb_ld(unsigned* p)              { return __hip_atomic_load(p, __ATOMIC_RELAXED, __HIP_MEMORY_SCOPE_AGENT); }
__device__ __forceinline__ unsigned xb_add(unsigned* p, unsigned v) { return __hip_atomic_fetch_add(p, v, __ATOMIC_RELAXED, __HIP_MEMORY_SCOPE_AGENT); }
__device__ __forceinline__ unsigned xb_xcc_id() { return (unsigned)__builtin_amdgcn_s_getreg((3 << 11) | 20) & 0xFu; }
#define XB_SPIN(cond, bar) do { unsigned _sp = 0; while (cond) { __builtin_amdgcn_s_sleep(1); \
    if ((++_sp & 255u) == 0u) { if (xb_ld(&(bar)[XB_TMO])) break; if (_sp > XB_SPIN_CAP) { atomicAdd(&(bar)[XB_TMO], 1u); break; } } } } while (0)

struct XcdBarrier {
    unsigned* bar; unsigned x;
    volatile LAS unsigned* st;
};

__device__ __forceinline__ XcdBarrier xcd_barrier_post(unsigned* bar, volatile LAS unsigned* st) {
    XcdBarrier b; b.bar = bar; b.x = xb_xcc_id(); b.st = st;
    if (threadIdx.x == 0) (void)xb_add(&bar[XB_XCNT(b.x)], 1u);
    return b;
}
__device__ __forceinline__ void xcd_barrier_complete(unsigned* bar, unsigned x, unsigned& nloc, unsigned& nx) {
    const unsigned G = gridDim.x * gridDim.y * gridDim.z;
    unsigned sum, cnt, mine, sp = 0u;
    for (;;) {
        sum = 0u; cnt = 0u; mine = 0u;
#pragma unroll
        for (unsigned j = 0; j < 16; ++j) { const unsigned c = xb_ld(&bar[XB_XCNT(j)]); sum += c; cnt += (c > 0u) ? 1u : 0u; mine = (j == x) ? c : mine; }
        if (sum == G) break;
        __builtin_amdgcn_s_sleep(1);
        if ((++sp & 255u) == 0u) { if (xb_ld(&bar[XB_TMO])) break; if (sp > XB_SPIN_CAP) { atomicAdd(&bar[XB_TMO], 1u); break; } }
    }
    nloc = mine > 0u ? mine : 1u; nx = cnt > 0u ? cnt : 1u;
}

__device__ __forceinline__ void xcd_barrier(const XcdBarrier& b) {
    asm volatile("s_waitcnt vmcnt(0)" ::: "memory");
    __syncthreads();
    if (threadIdx.x == 0) {
        unsigned* bar = b.bar;
        __builtin_amdgcn_s_waitcnt(0);
        unsigned nloc = b.st[0], nx = b.st[1];
        if (nloc == 0u) { xcd_barrier_complete(bar, b.x, nloc, nx); b.st[0] = nloc; b.st[1] = nx; }
        const unsigned old = xb_add(&bar[XB_XSUB(b.x)], 1u);
        const unsigned gen = old / nloc;
        if (old + 1u == (gen + 1u) * nloc) {
            __builtin_amdgcn_fence(__ATOMIC_RELEASE, "agent");
            asm volatile("s_waitcnt vmcnt(0)" ::: "memory");
            const unsigned og = xb_add(&bar[XB_TOP], 1u);
            const unsigned tg = og / nx;
            if (og + 1u == (tg + 1u) * nx) xb_add(&bar[XB_TOPGEN], 1u);
            else XB_SPIN(xb_ld(&bar[XB_TOPGEN]) == tg, bar);
            __builtin_amdgcn_fence(__ATOMIC_ACQUIRE, "agent");
            xb_add(&bar[XB_XGEN(b.x)], 1u);
            asm volatile("s_waitcnt vmcnt(0)" ::: "memory");
        } else {
            XB_SPIN(xb_ld(&bar[XB_XGEN(b.x)]) == gen, bar);
            __builtin_amdgcn_fence(__ATOMIC_ACQUIRE, "agent");
            asm volatile("s_waitcnt vmcnt(0)" ::: "memory");
        }
    }
    __syncthreads();
}

constexpr int N_PHASES = 15;
#ifndef S3M
#define S3M 15
#endif
#ifndef ONLY_S
#define ONLY_S -1
#endif
__device__ __forceinline__ void run_phase(const Params& p, int ph, lds_t lds) {
    const int G = (int)gridDim.x, bid = (int)blockIdx.x;
    if (ph == 0 && (ONLY_S < 0 || ONLY_S == 7)) {
        for (int j = bid; j < 192 + 256 + 32; j += G) { if (j < 192) job_ada(p, j, lds); else if (j < 448) job_ctx(p, j - 192); else job_rope(p, j - 448); }
        return;
    }
    const int l = (ph - 1) / 7, s = (ph - 1) % 7;
    unsigned char* ws = p.ws;
    if (s == 0 && (ONLY_S < 0 || ONLY_S == 0)) {
        for (int j = bid; j < 96 + WT_TOTAL + 1024; j += G) { if (j < 96) job_s5setup(p, l, j, lds); else if (j < 96 + WT_TOTAL) job_wt(p, l, j - 96, lds); else job_prep(p, l, j - 96 - WT_TOTAL); }
    } else if (s == 1 && (ONLY_S < 0 || ONLY_S == 1)) {
        Order S; S.setup(8192, 6912, 0); pg8::Gemm g{(const bf16_t*)(ws + OFF_HB), (const bf16_t*)(ws + OFF_WIN), 8192, 6912, 1024}; EpiZ E{(bf16_t*)(ws + OFF_Z)};
        pg8::gemm_phase<EpiZ, Order>(lds, g, S, E, nullptr);
    } else if (s == 2 && (ONLY_S < 0 || ONLY_S == 2)) {
        for (int j = bid; j < 640 + 512 + 1024; j += G) { if (j < 640) job_s5(p, l, j, lds); else if (j < 1152) job_glaA(p, l, j - 640, lds); else job_mlaprep(p, l, j - 1152); }
    } else if (s == 3 && (ONLY_S < 0 || ONLY_S == 3)) {
        if (S3M & 1) for (int j = bid; j < 2560; j += G) job_glaB(p, l, j);
        if (S3M & 2) { Order S; S.setup(8192, 1024, 0); pg8::Gemm g{(const bf16_t*)(ws + OFF_YG), (const bf16_t*)(ws + OFF_WGLU), 8192, 1024, 512}; EpiGLU E{(bf16_t*)(ws + OFF_AS5), (const bf16_t*)(ws + OFF_Z), p.in[I_BGLU] + l * 1024};
          pg8::gemm_phase<EpiGLU, Order>(lds, g, S, E, nullptr); }
        if (S3M & 4) { Order S; S.setup(10240, 768, 128); pg8::Gemm g{(const bf16_t*)(ws + (l == 0 ? OFF_CTX0 : OFF_CKVN)), (const bf16_t*)(ws + OFF_WKV), 10240, 768, 256}; EpiKV E{(bf16_t*)(ws + OFF_KF), (bf16_t*)(ws + OFF_V), l, (const bf16_t*)(ws + OFF_Z), p.in[I_CKR], p.in[I_KHNORM] + l * 96, (const float*)(ws + OFF_ROPE)};
          pg8::gemm_phase<EpiKV, Order>(lds, g, S, E, nullptr); }
        if (S3M & 8) { Order S; S.setup(8192, 512, 248); pg8::Gemm g{(const bf16_t*)(ws + OFF_AQ), (const bf16_t*)(ws + OFF_WUQ), 8192, 512, 384}; EpiQ E{(bf16_t*)(ws + OFF_QRAW)};
          pg8::gemm_phase<EpiQ, Order>(lds, g, S, E, nullptr); }
    } else if (s == 4 && (ONLY_S < 0 || ONLY_S == 4)) {
        for (int j = bid; j < 512 + 512; j += G) { if (j < 512) job_attn(p, l, j, lds); else job_glaC(p, l, j - 512, lds); }
    } else if (s == 5 && (ONLY_S < 0 || ONLY_S == 5)) {
        for (int br = 0; br < 3; ++br) { Order S; S.setup(8192, 1024, 0);
            pg8::Gemm g{(const bf16_t*)(ws + (br == 0 ? OFF_AGLA : br == 1 ? OFF_AMLA : OFF_AS5)), (const bf16_t*)(ws + OFF_WBO) + (size_t)br * 1024 * 512, 8192, 1024, 512};
            EpiBo E{(bf16_t*)(ws + OFF_HB), (const bf16_t*)(ws + OFF_Z), br};
            pg8::gemm_phase<EpiBo, Order>(lds, g, S, E, nullptr); }
    } else if (s == 6 && (ONLY_S < 0 || ONLY_S == 6)) {
        Order S; S.setup(8192, 1024, 0); pg8::Gemm g{(const bf16_t*)(ws + OFF_HB), (const bf16_t*)(ws + OFF_WOUT), 8192, 1024, 1024};
        EpiOut E{p.out, l == 0 ? p.in[I_XP] : p.out, l == 0 ? p.in[I_XS] : p.out + (size_t)4096 * 1024, (const float*)(ws + OFF_ADA) + l * 5 * 3072};
        pg8::gemm_phase<EpiOut, Order>(lds, g, S, E, nullptr);
    }
}
__global__ __launch_bounds__(512, 2) void mega(KParams kp, int ph0, int ph1) {
    extern __shared__ __attribute__((aligned(16))) unsigned char shm[];
    lds_t lds = (lds_t)shm;
    if (threadIdx.x < N_IN) ((const float**)(kp.ws + OFF_TBL))[threadIdx.x] = kp.in[threadIdx.x];
    volatile LAS unsigned* xst = (volatile LAS unsigned*)(lds + DYN_LDS - 16);
    if (threadIdx.x == 0) { xst[0] = 0u; xst[1] = 0u; }
    __threadfence(); __syncthreads();
    XcdBarrier xb = xcd_barrier_post((unsigned*)(kp.ws + OFF_BAR), xst);
    if (ph0 > ph1) cg::this_grid().sync();
    for (int ph = ph0; ph < ph1; ++ph) {
        Params p; { const float* const* tb = (const float* const*)(kp.ws + OFF_TBL); float* o = kp.out; unsigned char* w = kp.ws; asm volatile("" : "+s"(tb), "+s"(o), "+s"(w)); p.in = tb; p.out = o; p.ws = w; }
        run_phase(p, ph, lds);
#ifdef REPEAT_S
        if ((REPEAT_S == 7 && ph == 0) || (ph > 0 && (ph - 1) % 7 == REPEAT_S && (REPEAT_S != 6 || ph < 8))) { xcd_barrier(xb); run_phase(p, ph, lds); }
#endif
        if (ph + 1 < ph1) xcd_barrier(xb);
    }
}

#ifndef N_LAUNCH_MODE
#define N_LAUNCH_MODE 1
#endif
extern "C" void kernel_launch(void* const* d_in, const int* in_sizes, int n_in, void* d_out, int out_size, void* d_ws, size_t ws_size, hipStream_t stream) {
    static int grid = 0;
    if (grid == 0) {
        if (n_in != N_IN || ws_size < WS_END) { fprintf(stderr, "kernel_launch: unexpected n_in %d / ws %zu (need %zu)\n", n_in, ws_size, (size_t)WS_END); grid = -1; return; }
        int dev = 0, cus = 0, per_cu = 0;
        hipGetDevice(&dev); hipDeviceGetAttribute(&cus, hipDeviceAttributeMultiprocessorCount, dev);
        hipFuncSetAttribute((const void*)mega, hipFuncAttributeMaxDynamicSharedMemorySize, DYN_LDS);
        hipOccupancyMaxActiveBlocksPerMultiprocessor(&per_cu, (const void*)mega, 512, DYN_LDS);
        if (per_cu < 1) { fprintf(stderr, "kernel_launch: occupancy query says %d blocks per CU\n", per_cu); per_cu = 1; }
        (void)hipGetLastError();
        grid = cus;
    }
    if (grid < 0) return;
    hipMemsetAsync((char*)d_ws + OFF_BAR, 0, 16384, stream);
    KParams p{};
    for (int i = 0; i < N_IN; ++i) p.in[i] = (const float*)d_in[i];
    p.out = (float*)d_out; p.ws = (unsigned char*)d_ws;
#if N_LAUNCH_MODE == 0
    for (int ph = 0; ph < N_PHASES; ++ph) { hipLaunchKernelGGL(mega, dim3(grid), dim3(512), DYN_LDS, stream, p, ph, ph + 1); }
#else
    int ph0 = 0, ph1 = N_PHASES; void* args[] = {&p, &ph0, &ph1};
    hipError_t e = hipLaunchCooperativeKernel((const void*)mega, dim3(grid), dim3(512), args, DYN_LDS, stream);
    if (e != hipSuccess) fprintf(stderr, "cooperative launch failed: %s (grid %d)\n", hipGetErrorString(e), grid);
#endif
}
```

```cpp
#include <hip/hip_runtime.h>
#include <hip/hip_cooperative_groups.h>
#include <cstdio>
namespace cg = cooperative_groups;
namespace pg8 {
#define PG8_LAS __attribute__((address_space(3)))
typedef unsigned short bf16_t;
typedef short bf16x8 __attribute__((ext_vector_type(8)));
typedef float f32x4 __attribute__((ext_vector_type(4)));
typedef unsigned u32x4 __attribute__((ext_vector_type(4)));
constexpr int BM = 256, BK = 64, HALF = 128, HTB = HALF * BK * 2  , STAGE_BYTES = 8 * HTB, NXCD = 8, WGM = 8;

__host__ __device__ __forceinline__ int lds_byte(int r, int c) { const int st = (r >> 4) * 2 + (c >> 5), rr = r & 15, cc = c & 31, ob = rr * 64 + cc * 2; return st * 1024 + (ob ^ (((ob >> 9) & 1) << 5)); }
__host__ __device__ __forceinline__ void stage_rc(int b, int& R, int& C) { const int st = b / 1024, sb = b % 1024, swz = sb ^ (((sb >> 9) & 1) << 5); R = (st >> 1) * 16 + swz / 64; C = (st & 1) * 32 + (swz % 64) / 2; }
__host__ __device__ __forceinline__ int perm32(int rho) { const int n = rho >> 4, i = rho & 15; return 8 * (i >> 2) + 4 * n + (i & 3); }

struct Unit { int pm, pn; };
struct Gemm { const bf16_t* A; const bf16_t* Bt; int M, N, K; };

struct StaticOrder {
    int nM, nN, nwg, G, c;
    __host__ __device__ void init(int M, int N, int G_, int c_) { nM = M / BM; nN = N / BM; nwg = nM * nN; G = G_; c = c_; }
    __host__ __device__ bool next(int i, Unit& u) const {
        const long L = (long)i * G + c; if (L >= nwg) return false;
        int wgid = (int)L; { const int q = nwg / NXCD, r = nwg % NXCD, xcd = wgid % NXCD, off = wgid / NXCD; wgid = (xcd < r ? xcd * (q + 1) : r * (q + 1) + (xcd - r) * q) + off; }
        const int nig = WGM * nN, gid = wgid / nig, fm = gid * WGM, gsz = (nM - fm) < WGM ? (nM - fm) : WGM;
        u.pm = fm + ((wgid % nig) % gsz); u.pn = (wgid % nig) / gsz; return true;
    }
    __device__ __forceinline__ void a_ready(const Unit&) const {}
    __device__ __forceinline__ void done(const Unit&) const {}
};
__device__ __forceinline__ unsigned cvt_pk_bf16(float lo, float hi) { unsigned r; asm volatile("v_cvt_pk_bf16_f32 %0, %1, %2" : "=v"(r) : "v"(lo), "v"(hi)); return r; }
typedef float f32x2 __attribute__((ext_vector_type(2)));
template <class Epi, class Sched, bool STAMP = false>
__device__ __forceinline__ void gemm_phase(PG8_LAS unsigned char* lds, const Gemm g, const Sched& S, const Epi& E, unsigned long long* stamps) {
    int tid_ = (int)threadIdx.x; asm volatile("" : "+v"(tid_)); const int tid = tid_, wid = __builtin_amdgcn_readfirstlane(tid >> 6), lane = tid & 63, wr = wid >> 2, wc = wid & 3, fr = lane & 15, fq = lane >> 4;
    int K_ = g.K; asm volatile("" : "+s"(K_)); const int K = K_, nt = K / BK;
    int ts_lo = 0, ts_hi = 0, nts = 0; const unsigned long long rt_entry = STAMP ? (unsigned long long)wall_clock64() : 0ull;
#define PG8_STAMP() do { if (STAMP && wid == 0 && nts < 64) { const unsigned long long _c = (unsigned long long)clock64(); \
        ts_lo = (lane == nts) ? (int)(unsigned)_c : ts_lo; ts_hi = (lane == nts) ? (int)(unsigned)(_c >> 32) : ts_hi; ++nts; } } while (0)
    PG8_STAMP();
    unsigned voffA[2], voffB[2];
#pragma unroll
    for (int i = 0; i < 2; ++i) { int R, C; stage_rc(tid * 16 + i * 8192, R, C); const int Rb = Epi::PERM ? ((R & ~31) + perm32(R & 31)) : R;
        voffA[i] = (unsigned)(R * K + C) * 2u; voffB[i] = (unsigned)(Rb * K + C) * 2u; }
    const size_t kstep = (size_t)(BK * 2);
    const size_t hstep = (size_t)HALF * K * 2;
    const size_t tstep = 2 * hstep;
    const unsigned ldsw = (unsigned)wid * 1024u;
    const int aoff = lds_byte(wr * 64 + fr, fq * 8), boff = lds_byte(wc * 32 + fr, fq * 8);
#define PG8_SA(b, h) (((b) * 2 + (h)) * HTB)
#define PG8_SB(b, h) ((4 + (b) * 2 + (h)) * HTB)
#define PG8_STAGE(bufoff, gbase, voff) do { _Pragma("unroll") for (int _i = 0; _i < 2; ++_i) \
        __builtin_amdgcn_global_load_lds((const unsigned*)((const char*)(gbase) + (voff)[_i]), (PG8_LAS unsigned*)(lds + (bufoff) + ldsw + _i * 8192), 16, 0, 0); } while (0)
#define PG8_LDA(dst, b, h) do { _Pragma("unroll") for (int m = 0; m < 4; ++m) _Pragma("unroll") for (int k = 0; k < 2; ++k) dst[m][k] = *(const PG8_LAS bf16x8*)(lds + PG8_SA(b, h) + aoff + m * 2048 + k * 1024); } while (0)
#define PG8_LDB(dst, b, h) do { _Pragma("unroll") for (int n = 0; n < 2; ++n) _Pragma("unroll") for (int k = 0; k < 2; ++k) dst[n][k] = *(const PG8_LAS bf16x8*)(lds + PG8_SB(b, h) + boff + n * 2048 + k * 1024); } while (0)
#define PG8_MMA(ai, bj, At, Bt) do { __builtin_amdgcn_s_setprio(1); _Pragma("unroll") for (int m = 0; m < 4; ++m) _Pragma("unroll") for (int n = 0; n < 2; ++n) _Pragma("unroll") for (int k = 0; k < 2; ++k) \
        acc[ai][bj][m][n] = __builtin_amdgcn_mfma_f32_16x16x32_bf16(Bt[n][k], At[m][k], acc[ai][bj][m][n], 0, 0, 0); __builtin_amdgcn_s_setprio(0); } while (0)
#define PG8_WAIT_V(n) asm volatile("s_waitcnt vmcnt(" #n ")" ::: "memory")
#define PG8_WAIT_L(n) asm volatile("s_waitcnt lgkmcnt(" #n ")" ::: "memory")
#define PG8_BAR __builtin_amdgcn_s_barrier()
#define PG8_SCHED __builtin_amdgcn_sched_barrier(0)
    Unit cur, nxt; int ui = 0;
    if (!S.next(0, cur)) return;
    f32x4 acc[2][2][4][2];
#pragma unroll
    for (int a = 0; a < 2; ++a)
#pragma unroll
        for (int b = 0; b < 2; ++b)
#pragma unroll
            for (int m = 0; m < 4; ++m)
#pragma unroll
                for (int n = 0; n < 2; ++n) acc[a][b][m][n] = (f32x4){0.f, 0.f, 0.f, 0.f};
    bf16x8 At[4][2], B0[2][2], B1[2][2];
    const char* cA = (const char*)g.A + (size_t)cur.pm * tstep; const char* cB = (const char*)g.Bt + (size_t)cur.pn * tstep;
    S.a_ready(cur);
    PG8_STAGE(PG8_SB(0, 0), cB, voffB); PG8_STAGE(PG8_SA(0, 0), cA, voffA); PG8_STAGE(PG8_SB(0, 1), cB + hstep, voffB); PG8_STAGE(PG8_SA(0, 1), cA + hstep, voffA);
    if (wr == 1) PG8_BAR;
    PG8_WAIT_V(4); PG8_BAR;
    PG8_STAGE(PG8_SB(1, 0), cB + kstep, voffB); PG8_STAGE(PG8_SA(1, 0), cA + kstep, voffA); PG8_STAGE(PG8_SB(1, 1), cB + hstep + kstep, voffB);
    PG8_WAIT_V(6); PG8_BAR;
    PG8_STAMP();
    for (;;) {
        const bool has_next = S.next(ui + 1, nxt);
        const char* nA = has_next ? (const char*)g.A + (size_t)nxt.pm * tstep : cA; const char* nB = has_next ? (const char*)g.Bt + (size_t)nxt.pn * tstep : cB;
        for (int t = 0; t < nt; t += 2) {
            const bool last = (t == nt - 2);
            const char* a1 = cA + (size_t)(t + 1) * kstep;
            const char* a2 = last ? nA : cA + (size_t)(t + 2) * kstep; const char* b2 = last ? nB : cB + (size_t)(t + 2) * kstep;
            const char* a3 = a2 + kstep; const char* b3 = b2 + kstep;
            if (last && has_next) S.a_ready(nxt);
            PG8_LDB(B0, 0, 0); PG8_SCHED; PG8_LDA(At, 0, 0); PG8_STAGE(PG8_SA(1, 1), a1 + hstep, voffA);
            PG8_WAIT_L(8); PG8_BAR; PG8_WAIT_L(0); PG8_MMA(0, 0, At, B0); PG8_BAR; PG8_SCHED;
            PG8_LDB(B1, 0, 1); PG8_STAGE(PG8_SB(0, 0), b2, voffB);
            PG8_BAR; PG8_WAIT_L(0); PG8_MMA(0, 1, At, B1); PG8_BAR;
            PG8_LDA(At, 0, 1); PG8_STAGE(PG8_SA(0, 0), a2, voffA);
            PG8_BAR; PG8_WAIT_L(0); PG8_MMA(1, 0, At, B0); PG8_BAR; PG8_SCHED;
            PG8_STAGE(PG8_SB(0, 1), b2 + hstep, voffB);
            PG8_WAIT_V(6); PG8_BAR; PG8_MMA(1, 1, At, B1); PG8_BAR;
            PG8_LDB(B0, 1, 0); PG8_SCHED; PG8_LDA(At, 1, 0); PG8_STAGE(PG8_SA(0, 1), a2 + hstep, voffA);
            PG8_WAIT_L(8); PG8_BAR; PG8_WAIT_L(0); PG8_MMA(0, 0, At, B0); PG8_BAR; PG8_SCHED;
            PG8_LDB(B1, 1, 1); PG8_STAGE(PG8_SB(1, 0), b3, voffB);
            PG8_BAR; PG8_WAIT_L(0); PG8_MMA(0, 1, At, B1); PG8_BAR;
            PG8_LDA(At, 1, 1); PG8_STAGE(PG8_SA(1, 0), a3, voffA);
            PG8_BAR; PG8_WAIT_L(0); PG8_MMA(1, 0, At, B0); PG8_BAR; PG8_SCHED;
            PG8_STAGE(PG8_SB(1, 1), b3 + hstep, voffB);
            PG8_WAIT_V(6); PG8_BAR; PG8_MMA(1, 1, At, B1); PG8_BAR;
        }
        PG8_STAMP();
        if constexpr (!Epi::AFTER_DRAIN) { E(acc, cur, wr, wc, fr, fq); S.done(cur); }
        PG8_STAMP();
        if (!has_next) break;
#pragma unroll
        for (int a = 0; a < 2; ++a)
#pragma unroll
            for (int b = 0; b < 2; ++b)
#pragma unroll
                for (int m = 0; m < 4; ++m)
#pragma unroll
                    for (int n = 0; n < 2; ++n) acc[a][b][m][n] = (f32x4){0.f, 0.f, 0.f, 0.f};
        cur = nxt; cA = nA; cB = nB; ++ui;
    }
    PG8_WAIT_V(0);
    if (wr == 0) PG8_BAR;
    PG8_BAR;
    if constexpr (Epi::AFTER_DRAIN) { E.fused(acc, cur, wr, wc, fr, fq, lds, wid, lane); S.done(cur); }
    PG8_STAMP();
    if (STAMP && wid == 0) { stamps[lane] = lane < nts ? (((unsigned long long)(unsigned)ts_hi << 32) | (unsigned)ts_lo) : 0ull;
        if (lane == 62) stamps[62] = rt_entry; if (lane == 63) stamps[63] = (unsigned long long)wall_clock64(); }
#undef PG8_STAMP
#undef PG8_SA
#undef PG8_SB
#undef PG8_STAGE
#undef PG8_LDA
#undef PG8_LDB
#undef PG8_MMA
#undef PG8_WAIT_V
#undef PG8_WAIT_L
#undef PG8_BAR
#undef PG8_SCHED
}
}
using pg8::bf16_t; using pg8::bf16x8; using pg8::f32x4; using pg8::u32x4; using pg8::Unit;
#define LAS __attribute__((address_space(3)))
typedef unsigned u32x2 __attribute__((ext_vector_type(2)));
typedef LAS unsigned char* lds_t;
__device__ __forceinline__ int tid_opaque() { int t = (int)threadIdx.x; asm volatile("" : "+v"(t)); return t; }
typedef float f32x2_t __attribute__((ext_vector_type(2)));

enum { I_XP = 0, I_XS, I_C, I_CCTX, I_CKV, I_CKR, I_SGLA, I_SS5, I_NORMW, I_WADA, I_BADA, I_WIN, I_WA2, I_BA, I_ONORM, I_QNORM, I_WUQ, I_KVNORM, I_WUK, I_WUV,
       I_QHNORM, I_KHNORM, I_ARE, I_AIM, I_LOGDT, I_BRE, I_BIM, I_CRE, I_CIM, I_S5D, I_WGLU, I_BGLU, I_WBOG, I_WBOM, I_WBOS, I_WOUT, N_IN };
struct KParams { const float* in[N_IN]; float* out; unsigned char* ws; };
struct Params { const float* const* in; float* out; unsigned char* ws; };

constexpr int LDZ = 6912;
constexpr int ZQ = 0, ZK = 256, ZV = 512, ZGA = 1024, ZGG = 1056, ZMQ = 1568, ZMKV = 1952, ZMKR = 2208, ZMG = 2240, ZSU = 2752, ZSG = 3264, ZMERGE = 3776;
constexpr size_t OUT_YP = 0, OUT_CKV = 8388608, OUT_KR = 10485760, OUT_GLA = 10747904, OUT_S5 = 12845056;
constexpr size_t OFF_WIN = 0;
constexpr size_t OFF_QD = OFF_WIN, OFF_KN = OFF_WIN + 8388608;
constexpr size_t OFF_WUQ = OFF_WIN + 14155776;
constexpr size_t OFF_WKV = OFF_WUQ + 393216;
constexpr size_t OFF_WGLU = OFF_WKV + 393216;
constexpr size_t OFF_WBO = OFF_WGLU + 1048576;
constexpr size_t OFF_WOUT = OFF_WBO + 3145728;
constexpr size_t OFF_S5M = OFF_WOUT + 2097152;
constexpr size_t OFF_V = OFF_S5M;
constexpr size_t OFF_P16 = OFF_S5M + 12582912;
constexpr size_t OFF_ADA = OFF_P16 + 32768;
constexpr size_t OFF_ROPE = OFF_ADA + 122880;
constexpr size_t OFF_CTX0 = OFF_ROPE + 131072;
constexpr size_t OFF_CKVN = OFF_CTX0 + 1048576;
constexpr size_t OFF_CTX1 = OFF_CKVN + 4194304;
constexpr size_t OFF_HB = OFF_CTX1 + 1048576;
constexpr size_t OFF_Z = OFF_HB + 16777216;
constexpr size_t OFF_KV = OFF_Z + 113246208;
constexpr size_t OFF_AGLA = OFF_KV, OFF_AMLA = OFF_KV + 8388608;
constexpr size_t OFF_DEC = OFF_KV + 33554432;
constexpr size_t OFF_ST = OFF_DEC + 262144;
constexpr size_t OFF_AQ = OFF_ST + 16777216;
constexpr size_t OFF_QRAW = OFF_AQ + 6291456;
constexpr size_t OFF_AS5 = OFF_QRAW + 6291456;
constexpr size_t OFF_YG = OFF_AS5 + 8388608;
constexpr size_t OFF_TBL = OFF_YG + 8388608;
constexpr size_t OFF_BAR = OFF_TBL + 512;
constexpr size_t OFF_KF = OFF_BAR + 16384;
constexpr size_t WS_END = OFF_KF + 7864320;
constexpr int DYN_LDS = 147456;

__device__ __forceinline__ float bf2f(bf16_t b) { return __uint_as_float(((unsigned)b) << 16); }
__device__ __forceinline__ bf16_t f2bf(float f) { unsigned u = __float_as_uint(f); u += 0x7FFFu + ((u >> 16) & 1u); return (bf16_t)(u >> 16); }
__device__ __forceinline__ unsigned pk2(float lo, float hi) { return pg8::cvt_pk_bf16(lo, hi); }
__device__ __forceinline__ float lo16(unsigned w) { return __uint_as_float(w << 16); }
__device__ __forceinline__ float hi16(unsigned w) { return __uint_as_float(w & 0xffff0000u); }
__device__ __forceinline__ float sigmoidf_(float x) { return 1.f / (1.f + __expf(-x)); }
__device__ __forceinline__ float siluf_(float x) { return x / (1.f + __expf(-x)); }
__device__ __forceinline__ void store8(bf16_t* p, const f32x4& a, const f32x4& b) { u32x4 w; w.x = pk2(a[0], a[1]); w.y = pk2(a[2], a[3]); w.z = pk2(b[0], b[1]); w.w = pk2(b[2], b[3]); *(u32x4*)p = w; }
#define MFMA16(a, b, c) __builtin_amdgcn_mfma_f32_16x16x32_bf16(a, b, c, 0, 0, 0)
#define LDSFRAG(ptr) (*(const LAS bf16x8*)(ptr))

struct Order : pg8::StaticOrder {
    __device__ void setup(int M, int N, int rot) { const int G = (int)gridDim.x; init(M, N, G, (int)((blockIdx.x + (unsigned)rot) % (unsigned)G)); }
};

struct EpiZ { static constexpr bool PERM = true, AFTER_DRAIN = false; bf16_t* Z;
    __device__ __forceinline__ void operator()(const f32x4 (&acc)[2][2][4][2], const Unit& u, int wr, int wc, int fr, int fq) const {
        const int row0 = u.pm * 256 + wr * 64 + fr, col0 = u.pn * 256 + wc * 32 + 8 * fq;
#pragma unroll
        for (int ai = 0; ai < 2; ++ai)
#pragma unroll
            for (int m = 0; m < 4; ++m) { bf16_t* rp = Z + (size_t)(row0 + ai * 128 + m * 16) * LDZ + col0;
#pragma unroll
                for (int bj = 0; bj < 2; ++bj) store8(rp + bj * 128, acc[ai][bj][m][0], acc[ai][bj][m][1]); }
    } };
struct EpiQ { static constexpr bool PERM = true, AFTER_DRAIN = false; bf16_t* Q;
    __device__ __forceinline__ void operator()(const f32x4 (&acc)[2][2][4][2], const Unit& u, int wr, int wc, int fr, int fq) const {
        const int row0 = u.pm * 256 + wr * 64 + fr, col0 = u.pn * 256 + wc * 32 + 8 * fq;
#pragma unroll
        for (int ai = 0; ai < 2; ++ai)
#pragma unroll
            for (int m = 0; m < 4; ++m) { bf16_t* rp = Q + (size_t)(row0 + ai * 128 + m * 16) * 384 + col0;
#pragma unroll
                for (int bj = 0; bj < 2; ++bj) if (col0 + bj * 128 < 384) store8(rp + bj * 128, acc[ai][bj][m][0], acc[ai][bj][m][1]);
                }
    } };
struct EpiKV { static constexpr bool PERM = true, AFTER_DRAIN = false; bf16_t* KF; bf16_t* V; int layer; const bf16_t* Z; const float* ckr; const float* khn; const float* R;
    __device__ __forceinline__ void operator()(const f32x4 (&acc)[2][2][4][2], const Unit& u, int wr, int wc, int fr, int fq) const {
        int rb = u.pm * 256; if (layer == 0) rb = rb < 2048 ? 8192 + rb : rb - 2048;
        const int row0 = rb + wr * 64 + fr;
        if (u.pn > 0) {
#pragma unroll
            for (int ai = 0; ai < 2; ++ai)
#pragma unroll
                for (int m = 0; m < 4; ++m) { const int r = row0 + ai * 128 + m * 16; bf16_t* bp; int st;
                    if (r < 4096) { bp = V + (size_t)(r >> 8) * 4 * 128 * 256 + (r & 255); st = 256; }
                    else if (r < 8192) { bp = V + 2097152 + (size_t)((r - 4096) >> 10) * 4 * 128 * 1536 + 512 + ((r - 4096) & 1023); st = 1536; }
                    else { bp = V + 2097152 + (size_t)((r - 8192) >> 9) * 4 * 128 * 1536 + ((r - 8192) & 511); st = 1536; }
#pragma unroll
                    for (int bj = 0; bj < 2; ++bj) { bf16_t* hp = bp + (size_t)((((u.pn - 1) * 2 + bj) * 128) + wc * 32 + 8 * fq) * st;
#pragma unroll
                        for (int i = 0; i < 8; i += 2) { const unsigned w = pk2(acc[ai][bj][m][i >> 2][i & 3], acc[ai][bj][m][i >> 2][(i & 3) + 1]); hp[(size_t)i * st] = (bf16_t)(w & 0xffffu); hp[(size_t)(i + 1) * st] = (bf16_t)(w >> 16); } } }
            return; }
        float wn[2][8], w1[4], w2[4];
#pragma unroll
        for (int bj = 0; bj < 2; ++bj)
#pragma unroll
            for (int i = 0; i < 8; ++i) wn[bj][i] = khn[32 * bj + 8 * fq + i];
#pragma unroll
        for (int i = 0; i < 4; ++i) { w1[i] = khn[64 + 4 * fq + i]; w2[i] = khn[80 + 4 * fq + i]; }
#pragma unroll
        for (int ai = 0; ai < 2; ++ai)
#pragma unroll
          for (int mh = 0; mh < 4; mh += 1) {
            float x1[4][4], x2[4][4], cs[4][4], sn[4][4];
#pragma unroll
            for (int m = mh; m < mh + 1; ++m) { const int r = row0 + ai * 128 + m * 16;
                if (r >= 8192) { const int j = r - 8192; const float* kr = ckr + ((size_t)(((j >> 9) * 2 + layer) * 512 + (j & 511))) * 32 + 4 * fq;
                    const f32x4 a = *(const f32x4*)kr, b = *(const f32x4*)(kr + 16);
#pragma unroll
                    for (int i = 0; i < 4; ++i) { x1[m][i] = a[i]; x2[m][i] = b[i]; } }
                else { const bf16_t* kr = Z + (size_t)r * LDZ + ZMKR + 4 * fq; const u32x2 a = *(const u32x2*)kr, b = *(const u32x2*)(kr + 16);
                    x1[m][0] = lo16(a.x); x1[m][1] = hi16(a.x); x1[m][2] = lo16(a.y); x1[m][3] = hi16(a.y); x2[m][0] = lo16(b.x); x2[m][1] = hi16(b.x); x2[m][2] = lo16(b.y); x2[m][3] = hi16(b.y); }
                const bool rot = r >= 4096 && r < 8192; const int pos = (r - 4096) & 1023;
                if (rot) { const f32x4 c = *(const f32x4*)(R + pos * 16 + 4 * fq), s_ = *(const f32x4*)(R + 16384 + pos * 16 + 4 * fq);
#pragma unroll
                    for (int i = 0; i < 4; ++i) { cs[m][i] = c[i]; sn[m][i] = s_[i]; } }
                else {
#pragma unroll
                    for (int i = 0; i < 4; ++i) { cs[m][i] = 1.f; sn[m][i] = 0.f; } } }
#pragma unroll
            for (int m = mh; m < mh + 1; ++m) { const int r = row0 + ai * 128 + m * 16;
                float ss = 0.f;
#pragma unroll
                for (int bj = 0; bj < 2; ++bj)
#pragma unroll
                    for (int i = 0; i < 8; ++i) { const float v = acc[ai][bj][m][i >> 2][i & 3]; ss += v * v; }
#pragma unroll
                for (int i = 0; i < 4; ++i) ss += x1[m][i] * x1[m][i] + x2[m][i] * x2[m][i];
                ss += __shfl_xor(ss, 16); ss += __shfl_xor(ss, 32);
                const float rstd = rsqrtf(ss * (1.f / 96.f) + 1e-6f);
                bf16_t* kp = KF + (size_t)r * 384 + wc * 96;
#pragma unroll
                for (int bj = 0; bj < 2; ++bj) { u32x4 w; const f32x4 v0 = acc[ai][bj][m][0], v1 = acc[ai][bj][m][1];
                    w.x = pk2(v0[0] * rstd * wn[bj][0], v0[1] * rstd * wn[bj][1]); w.y = pk2(v0[2] * rstd * wn[bj][2], v0[3] * rstd * wn[bj][3]);
                    w.z = pk2(v1[0] * rstd * wn[bj][4], v1[1] * rstd * wn[bj][5]); w.w = pk2(v1[2] * rstd * wn[bj][6], v1[3] * rstd * wn[bj][7]);
                    *(u32x4*)(kp + 32 * bj + 8 * fq) = w; }
                float o1[4], o2[4];
#pragma unroll
                for (int i = 0; i < 4; ++i) { const float a = x1[m][i] * rstd * w1[i], b = x2[m][i] * rstd * w2[i]; o1[i] = a * cs[m][i] - b * sn[m][i]; o2[i] = a * sn[m][i] + b * cs[m][i]; }
                *(u32x2*)(kp + 64 + 4 * fq) = (u32x2){pk2(o1[0], o1[1]), pk2(o1[2], o1[3])}; *(u32x2*)(kp + 80 + 4 * fq) = (u32x2){pk2(o2[0], o2[1]), pk2(o2[2], o2[3])}; }
            __builtin_amdgcn_sched_barrier(0); }
    } };
struct EpiGLU { static constexpr bool PERM = true, AFTER_DRAIN = false; bf16_t* O; const bf16_t* Z; const float* bias;
    __device__ __forceinline__ void operator()(const f32x4 (&acc)[2][2][4][2], const Unit& u, int wr, int wc, int fr, int fq) const {
        const int row0 = u.pm * 256 + wr * 64 + fr, oc = u.pn * 128 + wc * 32 + 8 * fq;
        float bv[8], bg[8];
#pragma unroll
        for (int i = 0; i < 8; ++i) { bv[i] = bias[oc + i]; bg[i] = bias[512 + oc + i]; }
        u32x4 sgv[2][4];
#pragma unroll
        for (int ai = 0; ai < 2; ++ai)
#pragma unroll
            for (int m = 0; m < 4; ++m) sgv[ai][m] = *(const u32x4*)(Z + (size_t)(row0 + ai * 128 + m * 16) * LDZ + ZSG + oc);
#pragma unroll
        for (int ai = 0; ai < 2; ++ai)
#pragma unroll
            for (int m = 0; m < 4; ++m) { const size_t r = (size_t)(row0 + ai * 128 + m * 16);
                const u32x4 sg = sgv[ai][m];
                float g[8] = { lo16(sg.x), hi16(sg.x), lo16(sg.y), hi16(sg.y), lo16(sg.z), hi16(sg.z), lo16(sg.w), hi16(sg.w) };
                float o[8];
#pragma unroll
                for (int i = 0; i < 8; ++i) { const float zv = acc[ai][0][m][i >> 2][i & 3] + bv[i], zg = acc[ai][1][m][i >> 2][i & 3] + bg[i]; o[i] = zv * sigmoidf_(zg) * siluf_(g[i]); }
                u32x4 w; w.x = pk2(o[0], o[1]); w.y = pk2(o[2], o[3]); w.z = pk2(o[4], o[5]); w.w = pk2(o[6], o[7]);
                *(u32x4*)(O + r * 512 + oc) = w; }
    } };
struct EpiBo { static constexpr bool PERM = true, AFTER_DRAIN = false; bf16_t* MIX; const bf16_t* Z; int branch;
    __device__ __forceinline__ void operator()(const f32x4 (&acc)[2][2][4][2], const Unit& u, int wr, int wc, int fr, int fq) const {
        const int row0 = u.pm * 256 + wr * 64 + fr, col0 = u.pn * 256 + wc * 32 + 8 * fq;
#pragma unroll
        for (int ai = 0; ai < 2; ++ai)
#pragma unroll
          for (int mh = 0; mh < 4; mh += 2) {
            u32x4 gz[4][2], pv[4][2];
#pragma unroll
            for (int m = mh; m < mh + 2; ++m)
#pragma unroll
                for (int bj = 0; bj < 2; ++bj) { const size_t r = (size_t)(row0 + ai * 128 + m * 16);
                    gz[m][bj] = *(const u32x4*)(Z + r * LDZ + ZMERGE + branch * 1024 + col0 + bj * 128);
                    pv[m][bj] = branch > 0 ? *(const u32x4*)(MIX + r * 1024 + col0 + bj * 128) : (u32x4){0u, 0u, 0u, 0u}; }
#pragma unroll
            for (int m = mh; m < mh + 2; ++m) { const size_t r = (size_t)(row0 + ai * 128 + m * 16);
#pragma unroll
                for (int bj = 0; bj < 2; ++bj) { const u32x4 sg = gz[m][bj], pp = pv[m][bj];
                    const float g[8] = { lo16(sg.x), hi16(sg.x), lo16(sg.y), hi16(sg.y), lo16(sg.z), hi16(sg.z), lo16(sg.w), hi16(sg.w) };
                    const float q[8] = { lo16(pp.x), hi16(pp.x), lo16(pp.y), hi16(pp.y), lo16(pp.z), hi16(pp.z), lo16(pp.w), hi16(pp.w) };
                    float o[8];
#pragma unroll
                    for (int i = 0; i < 8; ++i) o[i] = q[i] + sigmoidf_(g[i]) * acc[ai][bj][m][i >> 2][i & 3];
                    u32x4 w; w.x = pk2(o[0], o[1]); w.y = pk2(o[2], o[3]); w.z = pk2(o[4], o[5]); w.w = pk2(o[6], o[7]);
                    *(u32x4*)(MIX + r * 1024 + col0 + bj * 128) = w; } }
            __builtin_amdgcn_sched_barrier(0); }
    } };
struct EpiOut { static constexpr bool PERM = false, AFTER_DRAIN = false; float* Y; const float* xp; const float* xs; const float* ada;
    __device__ __forceinline__ void operator()(const f32x4 (&acc)[2][2][4][2], const Unit& u, int wr, int wc, int fr, int fq) const {
        const int row0 = u.pm * 256 + wr * 64 + fr, col0 = u.pn * 256 + wc * 32 + 4 * fq;
        const int ar = u.pm < 16 ? 0 : 1 + ((u.pm - 16) >> 2);
        const float* gp = ada + ar * 3072 + 2048;
        f32x4 gv[2][2];
#pragma unroll
        for (int bj = 0; bj < 2; ++bj)
#pragma unroll
            for (int n = 0; n < 2; ++n) gv[bj][n] = *(const f32x4*)(gp + col0 + bj * 128 + n * 16);
#pragma unroll
        for (int ai = 0; ai < 2; ++ai)
#pragma unroll
          for (int mh = 0; mh < 4; mh += 2) {
            f32x4 xv[4][2][2];
#pragma unroll
            for (int m = mh; m < mh + 2; ++m) { const int r = row0 + ai * 128 + m * 16;
                const float* xr = (r < 4096 ? xp + (size_t)r * 1024 : xs + (size_t)(r - 4096) * 1024) + col0;
#pragma unroll
                for (int bj = 0; bj < 2; ++bj)
#pragma unroll
                    for (int n = 0; n < 2; ++n) xv[m][bj][n] = *(const f32x4*)(xr + bj * 128 + n * 16); }
#pragma unroll
            for (int m = mh; m < mh + 2; ++m) { const int r = row0 + ai * 128 + m * 16;
                float* yr = Y + (size_t)r * 1024 + col0;
#pragma unroll
                for (int bj = 0; bj < 2; ++bj)
#pragma unroll
                    for (int n = 0; n < 2; ++n) *(f32x4*)(yr + bj * 128 + n * 16) = xv[m][bj][n] + gv[bj][n] * acc[ai][bj][m][n]; }
            __builtin_amdgcn_sched_barrier(0); }
    } };

__device__ void job_ada(const Params& p, int j, lds_t lds) {
    LAS float* sc = (LAS float*)lds; LAS float* red = sc + 5 * 1024;
    const int l = j / 96, c0 = (j % 96) * 32, tid = tid_opaque();
    for (int i = tid; i < 5 * 1024; i += 512) { const int r = i >> 10, k = i & 1023; const float v = r == 0 ? p.in[I_CCTX][k] : p.in[I_C][(r - 1) * 1024 + k]; sc[i] = v / (1.f + expf(-v)); }
    __syncthreads();
    const int col = tid & 31, kg = tid >> 5; const float* W = p.in[I_WADA] + (size_t)l * 1024 * 3072 + (size_t)(kg * 64) * 3072 + c0 + col;
    float a0 = 0.f, a1 = 0.f, a2 = 0.f, a3 = 0.f, a4 = 0.f;
#pragma unroll 1
    for (int kb = 0; kb < 64; kb += 16) { float w[16];
#pragma unroll
        for (int i = 0; i < 16; ++i) w[i] = W[(size_t)(kb + i) * 3072];
#pragma unroll
        for (int i = 0; i < 16; ++i) { const int k = kg * 64 + kb + i; a0 += sc[k] * w[i]; a1 += sc[1024 + k] * w[i]; a2 += sc[2048 + k] * w[i]; a3 += sc[3072 + k] * w[i]; a4 += sc[4096 + k] * w[i]; } }
    red[(kg * 5 + 0) * 32 + col] = a0; red[(kg * 5 + 1) * 32 + col] = a1; red[(kg * 5 + 2) * 32 + col] = a2; red[(kg * 5 + 3) * 32 + col] = a3; red[(kg * 5 + 4) * 32 + col] = a4;
    __syncthreads();
    if (tid < 160) { const int r = tid >> 5, cc = tid & 31; float s = p.in[I_BADA][l * 3072 + c0 + cc];
        for (int g = 0; g < 16; ++g) s += red[(g * 5 + r) * 32 + cc];
        ((float*)(p.ws + OFF_ADA))[(l * 5 + r) * 3072 + c0 + cc] = s; }
    __syncthreads();
}
__device__ void job_ctx(const Params& p, int j) {
    const int base = j * 4096 + tid_opaque() * 8; const int l = base / (2048 * 256), rem = base % (2048 * 256), row = rem >> 8, c = rem & 255, b = row >> 9, jj = row & 511;
    const float* s = p.in[I_CKV] + ((size_t)((b * 2 + l) * 512 + jj)) * 256 + c;
    const f32x4 v0 = *(const f32x4*)s, v1 = *(const f32x4*)(s + 4);
    bf16_t* d = (bf16_t*)(p.ws + (l == 0 ? OFF_CTX0 : OFF_CTX1)) + (size_t)row * 256 + c;
    store8(d, v0, v1);
}
__device__ void job_rope(const Params& p, int j) {
    const int idx = j * 512 + tid_opaque(), pos = idx >> 4, i = idx & 15, f = i & 7;
    const float inv = powf(10000.f, -(float)f / 8.f); const float ang = (float)(i < 8 ? (pos >> 6) : (pos & 63)) * inv;
    float* R = (float*)(p.ws + OFF_ROPE); R[idx] = cosf(ang); R[16384 + idx] = sinf(ang);
}

__device__ void job_prep(const Params& p, int l, int j) {
    const int tid = tid_opaque(), wid = tid >> 6, lane = tid & 63, row = j * 8 + wid;
    const float* x = l == 0 ? (row < 4096 ? p.in[I_XP] + (size_t)row * 1024 : p.in[I_XS] + (size_t)(row - 4096) * 1024) : p.out + (size_t)row * 1024;
    const int ar = row < 4096 ? 0 : 1 + ((row - 4096) >> 10);
    const float* ada = (const float*)(p.ws + OFF_ADA) + (l * 5 + ar) * 3072; const float* nw = p.in[I_NORMW] + l * 1024;
    f32x4 v[4]; float ss = 0.f;
#pragma unroll
    for (int i = 0; i < 4; ++i) { v[i] = *(const f32x4*)(x + i * 256 + lane * 4); ss += v[i][0] * v[i][0] + v[i][1] * v[i][1] + v[i][2] * v[i][2] + v[i][3] * v[i][3]; }
#pragma unroll
    for (int o = 1; o < 64; o <<= 1) ss += __shfl_xor(ss, o);
    const float rstd = rsqrtf(ss * (1.f / 1024.f) + 1e-6f);
    bf16_t* h = (bf16_t*)(p.ws + OFF_HB) + (size_t)row * 1024;
#pragma unroll
    for (int i = 0; i < 4; ++i) { const int c = i * 256 + lane * 4; const f32x4 w = *(const f32x4*)(nw + c), sh = *(const f32x4*)(ada + c), sc = *(const f32x4*)(ada + 1024 + c);
        float o[4];
#pragma unroll
        for (int k = 0; k < 4; ++k) o[k] = v[i][k] * rstd * w[k] * (1.f + sc[k]) + sh[k];
        u32x2 pk; pk.x = pk2(o[0], o[1]); pk.y = pk2(o[2], o[3]); *(u32x2*)(h + c) = pk; }
}
__device__ void wt_tile(const float* src, int ldsrc, int sbase, int nvalid, int mode, bf16_t* dst, int K, int n0, int k0, lds_t lds) {
    LAS float* t = (LAS float*)lds; const int tid = tid_opaque();
    const int nn = tid & 255, kh = tid >> 8; const int sc = mode == 0 ? sbase + nn : mode == 1 ? ((nn >> 7) & 1) * 512 + sbase + (nn & 127) : ((nn >> 5) & 3) * 64 + (nn >> 7) * 32 + (nn & 31); const bool ok = mode != 0 || nn < nvalid;
    float v[32];
#pragma unroll
    for (int i = 0; i < 32; ++i) v[i] = ok ? src[(size_t)(k0 + 2 * i + kh) * ldsrc + sc] : 0.f;
#pragma unroll
    for (int i = 0; i < 32; ++i) t[(2 * i + kh) * 257 + nn] = v[i];
    __syncthreads();
#pragma unroll
    for (int ps = 0; ps < 4; ++ps) { const int n = ps * 64 + (tid >> 3), kc = tid & 7; const LAS float* s = t + (kc * 8) * 257 + n; u32x4 w;
        w.x = pk2(s[0], s[257]); w.y = pk2(s[514], s[771]); w.z = pk2(s[1028], s[1285]); w.w = pk2(s[1542], s[1799]);
        *(u32x4*)(dst + (size_t)(n0 + n) * K + k0 + kc * 8) = w; }
    __syncthreads();
}
constexpr int WT_WIN = 27 * 16, WT_WUQ = 2 * 6, WT_WKV = 3 * 4, WT_WGLU = 4 * 8, WT_WBO = 4 * 8, WT_WOUT = 4 * 16, WT_EARLY = WT_WIN + WT_WUQ + WT_WKV + WT_WGLU, WT_TOTAL = WT_EARLY + 3 * WT_WBO + WT_WOUT;
__device__ void job_wt(const Params& p, int l, int t, lds_t lds) {
    if (t < WT_WIN) { const int nt = t / 16, kt = t % 16; wt_tile(p.in[I_WIN] + (size_t)l * 1024 * 6848, 6848, nt * 256, 6848 - nt * 256, 0, (bf16_t*)(p.ws + OFF_WIN), 1024, nt * 256, kt * 64, lds); return; } t -= WT_WIN;
    if (t < WT_WUQ) { const int nt = t / 6, kt = t % 6; wt_tile(p.in[I_WUQ] + (size_t)l * 384 * 384, 384, nt * 256, 384 - nt * 256, 0, (bf16_t*)(p.ws + OFF_WUQ), 384, nt * 256, kt * 64, lds); return; } t -= WT_WUQ;
    if (t < WT_WKV) { const int nt = t / 4, kt = t % 4;
        if (nt == 0) wt_tile(p.in[I_WUK] + (size_t)l * 256 * 256, 256, 0, 256, 2, (bf16_t*)(p.ws + OFF_WKV), 256, 0, kt * 64, lds);
        else wt_tile(p.in[I_WUV] + (size_t)l * 256 * 512, 512, (nt - 1) * 256, 256, 0, (bf16_t*)(p.ws + OFF_WKV), 256, nt * 256, kt * 64, lds);
        return; } t -= WT_WKV;
    if (t < WT_WGLU) { const int nt = t / 8, kt = t % 8; wt_tile(p.in[I_WGLU] + (size_t)l * 512 * 1024, 1024, nt * 128, 256, 1, (bf16_t*)(p.ws + OFF_WGLU), 512, nt * 256, kt * 64, lds); return; } t -= WT_WGLU;
    if (t < 3 * WT_WBO) { const int br = t / WT_WBO, tt = t % WT_WBO, nt = tt / 8, kt = tt % 8;
        wt_tile(p.in[I_WBOG + br] + (size_t)l * 512 * 1024, 1024, nt * 256, 256, 0, (bf16_t*)(p.ws + OFF_WBO) + (size_t)br * 1024 * 512, 512, nt * 256, kt * 64, lds); return; } t -= 3 * WT_WBO;
    { const int nt = t / 16, kt = t % 16; wt_tile(p.in[I_WOUT] + (size_t)l * 1024 * 1024, 1024, nt * 256, 256, 0, (bf16_t*)(p.ws + OFF_WOUT), 1024, nt * 256, kt * 64, lds); }
}
__device__ void job_s5setup(const Params& p, int l, int j, lds_t lds) {
    const int g = j / 3, which = j % 3, tid = tid_opaque();
    LAS f32x2_t* pw = (LAS f32x2_t*)lds;
    LAS f32x2_t* Bt = pw + 2 * 17 * 64;
    LAS f32x2_t* Cn = Bt + 2 * 64 * 16;
    LAS float* Kt = (LAS float*)(Cn + 64 * 16);
    LAS float* raw = Kt + 8192;
    { const size_t gb = (size_t)(l * 32 + g) * 1024;
      for (int i = tid; i < 1024; i += 512) { raw[i] = p.in[I_BRE][gb + i]; raw[1024 + i] = p.in[I_BIM][gb + i]; raw[2048 + i] = p.in[I_CRE][gb + i]; raw[3072 + i] = p.in[I_CIM][gb + i]; }
      if (tid < 128) { const int d = tid >> 6, n = tid & 63; raw[4096 + tid] = p.in[I_ARE][((l * 2 + d) * 32 + g) * 64 + n]; raw[4224 + tid] = p.in[I_AIM][((l * 2 + d) * 32 + g) * 64 + n]; }
      if (tid < 2) raw[4352 + tid] = p.in[I_LOGDT][(l * 2 + tid) * 32 + g]; }
    __syncthreads();
    if (tid < 128) { const int d = tid >> 6, n = tid & 63;
        const float dt = expf(raw[4352 + d]);
        const float are = raw[4096 + tid], aim = raw[4224 + tid];
        for (int tau = 0; tau <= 16; ++tau) { const float mag = expf(are * dt * (float)tau); float s, c; sincosf(aim * dt * (float)tau, &s, &c); pw[(d * 17 + tau) * 64 + n] = (f32x2_t){mag * c, mag * s}; }
        float s1, c1; sincosf(aim * dt, &s1, &c1); float sh = sinf(0.5f * aim * dt);
        const float em1 = expm1f(are * dt), mag1 = em1 + 1.f;
        const float nre = em1 * c1 - 2.f * sh * sh, abim = mag1 * s1, den = are * are + aim * aim;
        const float cfr = (nre * are + abim * aim) / den, cfi = (abim * are - nre * aim) / den;
        for (int q = 0; q < 16; ++q) { const float br = raw[n * 16 + q], bi = raw[1024 + n * 16 + q];
            Bt[(d * 64 + n) * 16 + q] = (f32x2_t){cfr * br - cfi * bi, cfr * bi + cfi * br}; }
        if (which == 1) ((f32x2_t*)(p.ws + OFF_P16))[(g * 2 + d) * 64 + n] = pw[(d * 17 + 16) * 64 + n];
    }
    for (int i = tid; i < 1024; i += 512) { const int n = i >> 4, pp = i & 15; Cn[i] = (f32x2_t){raw[2048 + pp * 64 + n], raw[3072 + pp * 64 + n]}; }
    __syncthreads();
    bf16_t* M = (bf16_t*)(p.ws + OFF_S5M) + (size_t)(g * 3 + which) * 65536;
    if (which == 0) {
        for (int i = tid; i < 8192; i += 512) { const int d = i >> 12, tau = (i >> 8) & 15, pp = (i >> 4) & 15, q = i & 15; float s = 0.f;
#pragma unroll 16
            for (int n = 0; n < 64; ++n) { const f32x2_t c = Cn[n * 16 + pp], w = pw[(d * 17 + tau) * 64 + n], b = Bt[(d * 64 + n) * 16 + q];
                const float cwr = c.x * w.x - c.y * w.y, cwi = c.x * w.y + c.y * w.x; s += cwr * b.x - cwi * b.y; }
            Kt[i] = s; }
        __syncthreads();
#pragma unroll 8
        for (int i = tid; i < 65536; i += 512) { const int no = i >> 8, k = i & 255, t = no >> 4, pp = no & 15, s = k >> 4, q = k & 15; float v;
            if (t > s) v = Kt[(0 * 16 + (t - s)) * 256 + pp * 16 + q];
            else if (t < s) v = Kt[(1 * 16 + (s - t)) * 256 + pp * 16 + q];
            else { v = Kt[pp * 16 + q] + Kt[16 * 256 + pp * 16 + q]; if (pp == q) v += p.in[I_S5D][l * 512 + g * 16 + pp]; }
            M[i] = f2bf(v); }
    } else if (which == 1) {
#pragma unroll 8
        for (int i = tid; i < 65536; i += 512) { const int no = i >> 8, k = i & 255, d = no >> 7, ri = (no >> 6) & 1, n = no & 63, s = k >> 4, q = k & 15; const int e = d == 0 ? 15 - s : s;
            const f32x2_t w = pw[(d * 17 + e) * 64 + n], b = Bt[(d * 64 + n) * 16 + q];
            M[i] = f2bf(ri == 0 ? w.x * b.x - w.y * b.y : w.x * b.y + w.y * b.x); }
    } else {
#pragma unroll 8
        for (int i = tid; i < 65536; i += 512) { const int no = i >> 8, k = i & 255, t = no >> 4, pp = no & 15, d = k >> 7, ri = (k >> 6) & 1, n = k & 63; const int e = d == 0 ? t + 1 : 16 - t;
            const f32x2_t c = Cn[n * 16 + pp], w = pw[(d * 17 + e) * 64 + n];
            M[i] = f2bf(ri == 0 ? c.x * w.x - c.y * w.y : -(c.x * w.y + c.y * w.x)); }
    }
    __syncthreads();
}

__device__ __forceinline__ float gelu_tanh(float x) { const float u = 0.7978845608f * (x + 0.044715f * x * x * x); const float t = 1.f - 2.f / (1.f + __expf(2.f * u)); return 0.5f * x * (1.f + t); }
__device__ void job_s5(const Params& p, int l, int j, lds_t lds) {
    const int tid = tid_opaque(), wid = tid >> 6, lane = tid & 63, lr = lane & 15, lq = lane >> 4;
    int bb, g; if (j < 128) { bb = 16 + (j >> 5); g = j & 31; } else { bb = (j - 128) >> 5; g = (j - 128) & 31; }
    const int M = bb < 16 ? 16 : 64, MT = M >> 4; const int tok0 = bb < 16 ? bb * 256 : 4096 + (bb - 16) * 1024;
    LAS bf16_t* Us = (LAS bf16_t*)lds; LAS bf16_t* Xs = Us + 64 * 264; LAS float* Xin = (LAS float*)(lds + 2 * 64 * 264 * 2);
    const bf16_t* Z = (const bf16_t*)(p.ws + OFF_Z);
    for (int idx = tid; idx < M * 32; idx += 512) { const int tok = idx >> 1, hf = idx & 1;
        *(LAS u32x4*)(Us + (tok >> 4) * 264 + (tok & 15) * 16 + hf * 8) = *(const u32x4*)(Z + (size_t)(tok0 + tok) * LDZ + ZSU + g * 16 + hf * 8); }
    __syncthreads();
    const bf16_t* TT = (const bf16_t*)(p.ws + OFF_S5M) + (size_t)(g * 3) * 65536; const bf16_t* G = TT + 65536; const bf16_t* Cc = G + 65536;
    f32x4 acc[4][2];
#pragma unroll
    for (int a = 0; a < 4; ++a) { acc[a][0] = (f32x4){0.f, 0.f, 0.f, 0.f}; acc[a][1] = acc[a][0]; }
    { bf16x8 bq[8][2];
#pragma unroll
      for (int ks = 0; ks < 8; ++ks) { bq[ks][0] = *(const bf16x8*)(G + (size_t)(wid * 32 + lr) * 256 + ks * 32 + lq * 8); bq[ks][1] = *(const bf16x8*)(G + (size_t)(wid * 32 + 16 + lr) * 256 + ks * 32 + lq * 8); }
#pragma unroll
      for (int ks = 0; ks < 8; ++ks)
#pragma unroll
        for (int mt = 0; mt < 4; ++mt) if (mt < MT) { const bf16x8 a = LDSFRAG(Us + (mt * 16 + lr) * 264 + ks * 32 + lq * 8); acc[mt][0] = MFMA16(a, bq[ks][0], acc[mt][0]); acc[mt][1] = MFMA16(a, bq[ks][1], acc[mt][1]); } }
#pragma unroll
    for (int mt = 0; mt < 4; ++mt) if (mt < MT)
#pragma unroll
        for (int ct = 0; ct < 2; ++ct)
#pragma unroll
            for (int r = 0; r < 4; ++r) Xin[(mt * 16 + lq * 4 + r) * 260 + wid * 32 + ct * 16 + lr] = acc[mt][ct][r];
    __syncthreads();
    if (tid < 128) { const int d = tid >> 6, n = tid & 63; const f32x2_t a16 = ((const f32x2_t*)(p.ws + OFF_P16))[(g * 2 + d) * 64 + n];
        float xr = 0.f, xi = 0.f;
        if (bb >= 16) { const size_t o = ((size_t)(((bb - 16) * 2 + l) * 2 + d) * 2) * 2048 + g * 64 + n; xr = p.in[I_SS5][o]; xi = p.in[I_SS5][o + 2048]; }
        const int cre = d * 128 + n, cim = cre + 64;
        for (int i = 0; i < M; ++i) { const int c = d == 0 ? i : M - 1 - i;
            Xs[c * 264 + cre] = f2bf(xr); Xs[c * 264 + cim] = f2bf(xi);
            const float ur = Xin[c * 260 + cre], ui = Xin[c * 260 + cim];
            const float nr = a16.x * xr - a16.y * xi + ur, ni = a16.x * xi + a16.y * xr + ui; xr = nr; xi = ni; }
        if (bb < 16) { const size_t o = OUT_S5 + ((size_t)((bb * 2 + l) * 2 + d) * 2) * 2048 + g * 64 + n; p.out[o] = xr; p.out[o + 2048] = xi; }
    }
    __syncthreads();
#pragma unroll
    for (int a = 0; a < 4; ++a) { acc[a][0] = (f32x4){0.f, 0.f, 0.f, 0.f}; acc[a][1] = acc[a][0]; }
#pragma unroll
    for (int hf = 0; hf < 2; ++hf) { const bf16_t* Bm = hf == 0 ? TT : Cc; const LAS bf16_t* Am = hf == 0 ? Us : Xs; bf16x8 bq[8][2];
#pragma unroll
      for (int ks = 0; ks < 8; ++ks) { bq[ks][0] = *(const bf16x8*)(Bm + (size_t)(wid * 32 + lr) * 256 + ks * 32 + lq * 8); bq[ks][1] = *(const bf16x8*)(Bm + (size_t)(wid * 32 + 16 + lr) * 256 + ks * 32 + lq * 8); }
#pragma unroll
      for (int ks = 0; ks < 8; ++ks)
#pragma unroll
        for (int mt = 0; mt < 4; ++mt) if (mt < MT) { const bf16x8 a = LDSFRAG(Am + (mt * 16 + lr) * 264 + ks * 32 + lq * 8); acc[mt][0] = MFMA16(a, bq[ks][0], acc[mt][0]); acc[mt][1] = MFMA16(a, bq[ks][1], acc[mt][1]); } }
    bf16_t* Yg = (bf16_t*)(p.ws + OFF_YG);
#pragma unroll
    for (int mt = 0; mt < 4; ++mt) if (mt < MT)
#pragma unroll
        for (int ct = 0; ct < 2; ++ct)
#pragma unroll
            for (int r = 0; r < 4; ++r) { const int chunk = mt * 16 + lq * 4 + r, t = wid * 2 + ct;
                Yg[(size_t)(tok0 + chunk * 16 + t) * 512 + g * 16 + lr] = f2bf(gelu_tanh(acc[mt][ct][r])); }
    __syncthreads();
}
__device__ void job_mlaprep(const Params& p, int l, int j) {
    const int tid = tid_opaque(), wid = tid >> 6, lane = tid & 63, row = j * 8 + wid;
    const bf16_t* z = (const bf16_t*)(p.ws + OFF_Z) + (size_t)row * LDZ;
    float q[6], kv[4]; float sq = 0.f, sk = 0.f;
#pragma unroll
    for (int i = 0; i < 6; ++i) { q[i] = bf2f(z[ZMQ + i * 64 + lane]); sq += q[i] * q[i]; }
#pragma unroll
    for (int i = 0; i < 4; ++i) { kv[i] = bf2f(z[ZMKV + i * 64 + lane]); sk += kv[i] * kv[i]; }
#pragma unroll
    for (int o = 1; o < 64; o <<= 1) { sq += __shfl_xor(sq, o); sk += __shfl_xor(sk, o); }
    const float rq = rsqrtf(sq * (1.f / 384.f) + 1e-6f), rk = rsqrtf(sk * (1.f / 256.f) + 1e-6f);
    bf16_t* aq = (bf16_t*)(p.ws + OFF_AQ) + (size_t)row * 384; bf16_t* ck = (bf16_t*)(p.ws + OFF_CKVN) + (size_t)row * 256;
#pragma unroll
    for (int i = 0; i < 6; ++i) aq[i * 64 + lane] = f2bf(q[i] * rq * p.in[I_QNORM][l * 384 + i * 64 + lane]);
    const bool prompt = row < 4096; const int b = row >> 8, t = row & 255;
#pragma unroll
    for (int i = 0; i < 4; ++i) { const float v = kv[i] * rk * p.in[I_KVNORM][l * 256 + i * 64 + lane]; ck[i * 64 + lane] = f2bf(v);
        if (prompt) p.out[OUT_CKV + ((size_t)((b * 2 + l) * 256 + t)) * 256 + i * 64 + lane] = v; }
    if (prompt && lane < 32) p.out[OUT_KR + ((size_t)((b * 2 + l) * 256 + t)) * 32 + lane] = bf2f(z[ZMKR + lane]);
}
__device__ __forceinline__ float logsigmoidf_(float x) { return fminf(x, 0.f) - log1pf(expf(-fabsf(x))); }
__device__ void job_glaA(const Params& p, int l, int j, lds_t lds) {
    const int tid = tid_opaque(), wid = tid >> 6, lane = tid & 63, lr = lane & 15, lq = lane >> 4;
    const int ck = j >> 2, h = j & 3, tok0 = ck * 64;
    LAS bf16_t* QDf = (LAS bf16_t*)lds; LAS bf16_t* QDb = QDf + 4608; LAS bf16_t* KDf = QDb + 4608; LAS bf16_t* KDb = KDf + 4608; LAS bf16_t* KRf = KDb + 4608; LAS bf16_t* KRb = KRf + 4608;
    LAS bf16_t* VT = KRb + 4608;
    LAS bf16_t* ATT = VT + 9216;
    LAS float* GA = (LAS float*)(ATT + 4608);
    LAS float* TOT = GA + 2048;
    const bf16_t* Z = (const bf16_t*)(p.ws + OFF_Z);
    { const int c = tid >> 3, part = tid & 7; const u32x2 gv = *(const u32x2*)(Z + (size_t)(tok0 + c) * LDZ + ZGA + part * 4);
      GA[c * 32 + part * 4 + 0] = lo16(gv.x); GA[c * 32 + part * 4 + 1] = hi16(gv.x); GA[c * 32 + part * 4 + 2] = lo16(gv.y); GA[c * 32 + part * 4 + 3] = hi16(gv.y);
      const bf16_t* vp = Z + (size_t)(tok0 + c) * LDZ + ZV + h * 128 + part * 16;
      const u32x4 v0 = *(const u32x4*)vp, v1 = *(const u32x4*)(vp + 8);
      const unsigned w[8] = { v0.x, v0.y, v0.z, v0.w, v1.x, v1.y, v1.z, v1.w };
#pragma unroll
      for (int i = 0; i < 8; ++i) { VT[(part * 16 + 2 * i) * 72 + c] = (bf16_t)(w[i] & 0xffffu); VT[(part * 16 + 2 * i + 1) * 72 + c] = (bf16_t)(w[i] >> 16); } }
    __syncthreads();
    const int d = tid & 63, cg_ = tid >> 6;
    float laf[8], lab[8]; bf16_t qraw[8], kraw[8];
#pragma unroll
    for (int i = 0; i < 8; ++i) { const size_t zr = (size_t)(tok0 + cg_ * 8 + i) * LDZ; qraw[i] = Z[zr + ZQ + h * 64 + d]; kraw[i] = Z[zr + ZK + h * 64 + d]; }
    { float wf[16], wb[16];
#pragma unroll
      for (int r = 0; r < 16; ++r) { wf[r] = p.in[I_WA2][((size_t)((l * 2 + 0) * 16 + r)) * 256 + h * 64 + d]; wb[r] = p.in[I_WA2][((size_t)((l * 2 + 1) * 16 + r)) * 256 + h * 64 + d]; }
      const float bf_ = p.in[I_BA][(l * 2 + 0) * 256 + h * 64 + d], bb_ = p.in[I_BA][(l * 2 + 1) * 256 + h * 64 + d];
#pragma unroll
      for (int i = 0; i < 8; ++i) { const int c = cg_ * 8 + i; float xf = bf_, xb = bb_;
#pragma unroll
          for (int r = 0; r < 16; ++r) { xf += GA[c * 32 + r] * wf[r]; xb += GA[c * 32 + 16 + r] * wb[r]; }
          laf[i] = logsigmoidf_(xf) * (1.f / 16.f); lab[i] = logsigmoidf_(xb) * (1.f / 16.f); } }
#pragma unroll
    for (int i = 1; i < 8; ++i) laf[i] += laf[i - 1];
#pragma unroll
    for (int i = 6; i >= 0; --i) lab[i] += lab[i + 1];
    TOT[(0 * 8 + cg_) * 64 + d] = laf[7]; TOT[(1 * 8 + cg_) * 64 + d] = lab[0];
    __syncthreads();
    float offf = 0.f, offb = 0.f, Tf = 0.f, Tb = 0.f;
#pragma unroll
    for (int g = 0; g < 8; ++g) { const float a = TOT[g * 64 + d], b = TOT[(8 + g) * 64 + d]; Tf += a; Tb += b; if (g < cg_) offf += a; if (g > cg_) offb += b; }
    bf16_t* QD = (bf16_t*)(p.ws + OFF_QD);
#pragma unroll
    for (int i = 0; i < 8; ++i) { const int c = cg_ * 8 + i;
        const float q = bf2f(qraw[i]) * 0.125f, k = bf2f(kraw[i]);
        const float bf_ = offf + laf[i], bb_ = offb + lab[i];
        const bf16_t qf = f2bf(q * expf(bf_)), qb = f2bf(q * expf(bb_));
        QDf[c * 72 + d] = qf; QDb[c * 72 + d] = qb;
        KDf[c * 72 + d] = f2bf(k * expf(-bf_)); KDb[c * 72 + d] = f2bf(k * expf(-bb_));
        KRf[d * 72 + c] = f2bf(k * expf(Tf - bf_)); KRb[d * 72 + c] = f2bf(k * expf(Tb - bb_));
        QD[(size_t)(tok0 + c) * 256 + h * 64 + d] = qf; QD[(size_t)(8192 + tok0 + c) * 256 + h * 64 + d] = qb; }
    if (cg_ == 0) { float* DEC = (float*)(p.ws + OFF_DEC); DEC[((0 * 128 + ck) * 4 + h) * 64 + d] = expf(Tf); DEC[((1 * 128 + ck) * 4 + h) * 64 + d] = expf(Tb); }
    __syncthreads();
#pragma unroll
    for (int q2 = 0; q2 < 2; ++q2) { const int tt = wid * 2 + q2, ti = tt >> 2, tj = tt & 3; f32x4 af = {0.f, 0.f, 0.f, 0.f}, ab = af;
#pragma unroll
        for (int ks = 0; ks < 2; ++ks) { const int ko = ks * 32 + lq * 8;
            af = MFMA16(LDSFRAG(QDf + (ti * 16 + lr) * 72 + ko), LDSFRAG(KDf + (tj * 16 + lr) * 72 + ko), af);
            ab = MFMA16(LDSFRAG(QDb + (ti * 16 + lr) * 72 + ko), LDSFRAG(KDb + (tj * 16 + lr) * 72 + ko), ab); }
#pragma unroll
        for (int r = 0; r < 4; ++r) { const int c = ti * 16 + lq * 4 + r, s = tj * 16 + lr; const float v = (s <= c ? af[r] : 0.f) + (s >= c ? ab[r] : 0.f); ATT[c * 72 + s] = f2bf(v); } }
    __syncthreads();
    bf16x8 vb[2];
#pragma unroll
    for (int ks = 0; ks < 2; ++ks) vb[ks] = LDSFRAG(VT + (wid * 16 + lr) * 72 + ks * 32 + lq * 8);
    float* OI = (float*)(p.ws + OFF_HB); float* KV = (float*)(p.ws + OFF_KV);
#pragma unroll
    for (int ct = 0; ct < 4; ++ct) { f32x4 a = {0.f, 0.f, 0.f, 0.f};
#pragma unroll
        for (int ks = 0; ks < 2; ++ks) a = MFMA16(LDSFRAG(ATT + (ct * 16 + lr) * 72 + ks * 32 + lq * 8), vb[ks], a);
#pragma unroll
        for (int r = 0; r < 4; ++r) OI[(size_t)(tok0 + ct * 16 + lq * 4 + r) * 512 + h * 128 + wid * 16 + lr] = a[r]; }
#pragma unroll
    for (int dir = 0; dir < 2; ++dir) { const LAS bf16_t* KR = dir == 0 ? KRf : KRb; float* kvp = KV + ((size_t)((dir * 128 + ck) * 4 + h)) * 8192;
#pragma unroll
        for (int dt = 0; dt < 4; ++dt) { f32x4 a = {0.f, 0.f, 0.f, 0.f};
#pragma unroll
            for (int ks = 0; ks < 2; ++ks) a = MFMA16(LDSFRAG(KR + (dt * 16 + lr) * 72 + ks * 32 + lq * 8), vb[ks], a);
#pragma unroll
            for (int r = 0; r < 4; ++r) kvp[(dt * 16 + lq * 4 + r) * 128 + wid * 16 + lr] = a[r]; } }
    __syncthreads();
}

__device__ void job_glaB(const Params& p, int l, int j) {
    const int slab = j & 15, h = (j >> 4) & 3, rest = j >> 6, bb = rest % 20, dir = rest / 20;
    const int idx = slab * 512 + tid_opaque(), d = idx >> 7;
    const int nck = bb < 16 ? 4 : 16, ck0 = bb < 16 ? bb * 4 : 64 + (bb - 16) * 16;
    float S = 0.f;
    if (bb >= 16) S = p.in[I_SGLA][((size_t)((((bb - 16) * 2 + l) * 2 + dir) * 4 + h)) * 8192 + idx];
    const float* KV = (const float*)(p.ws + OFF_KV); const float* DEC = (const float*)(p.ws + OFF_DEC); bf16_t* ST = (bf16_t*)(p.ws + OFF_ST);
    for (int i = 0; i < nck; ++i) { const int ck = dir == 0 ? ck0 + i : ck0 + nck - 1 - i; const size_t it = (size_t)((dir * 128 + ck) * 4 + h);
        ST[it * 8192 + idx] = f2bf(S); S = DEC[it * 64 + d] * S + KV[it * 8192 + idx]; }
    if (bb < 16) p.out[OUT_GLA + ((size_t)(((bb * 2 + l) * 2 + dir) * 4 + h)) * 8192 + idx] = S;
}

__device__ void job_glaC(const Params& p, int l, int j, lds_t lds) {
    const int tid = tid_opaque(), wid = tid >> 6, lane = tid & 63, lr = lane & 15, lq = lane >> 4;
    const int ck = j >> 2, h = j & 3, tok0 = ck * 64;
    LAS bf16_t* Aq = (LAS bf16_t*)lds;
    LAS bf16_t* BT = Aq + 64 * 136;
    LAS float* Os = (LAS float*)(BT + 128 * 136);
    const bf16_t* QD = (const bf16_t*)(p.ws + OFF_QD); const bf16_t* ST = (const bf16_t*)(p.ws + OFF_ST);
#pragma unroll
    for (int it = 0; it < 2; ++it) { const int idx = tid + it * 512, c = idx >> 4, rem = idx & 15, dir = rem >> 3, dc = rem & 7;
        *(LAS u32x4*)(Aq + c * 136 + dir * 64 + dc * 8) = *(const u32x4*)(QD + (size_t)(dir * 8192 + tok0 + c) * 256 + h * 64 + dc * 8); }
#pragma unroll
    for (int it = 0; it < 4; ++it) { const int idx = tid + it * 512, dir = idx >> 10, d = (idx >> 4) & 63, ec = idx & 15;
        const u32x4 v = *(const u32x4*)(ST + ((size_t)((dir * 128 + ck) * 4 + h)) * 8192 + d * 128 + ec * 8);
        const unsigned w[4] = { v.x, v.y, v.z, v.w };
#pragma unroll
        for (int i = 0; i < 4; ++i) { BT[(ec * 8 + 2 * i) * 136 + dir * 64 + d] = (bf16_t)(w[i] & 0xffffu); BT[(ec * 8 + 2 * i + 1) * 136 + dir * 64 + d] = (bf16_t)(w[i] >> 16); } }
    __syncthreads();
    const int ct = wid & 3, eh = wid >> 2; const float* OI = (const float*)(p.ws + OFF_HB);
    float oi[4][4];
#pragma unroll
    for (int e4 = 0; e4 < 4; ++e4)
#pragma unroll
        for (int r = 0; r < 4; ++r) oi[e4][r] = OI[(size_t)(tok0 + ct * 16 + lq * 4 + r) * 512 + h * 128 + (eh * 4 + e4) * 16 + lr];
    bf16x8 af[4];
#pragma unroll
    for (int ks = 0; ks < 4; ++ks) af[ks] = LDSFRAG(Aq + (ct * 16 + lr) * 136 + ks * 32 + lq * 8);
#pragma unroll
    for (int e4 = 0; e4 < 4; ++e4) { const int et = eh * 4 + e4; f32x4 a = {0.f, 0.f, 0.f, 0.f};
#pragma unroll
        for (int ks = 0; ks < 4; ++ks) a = MFMA16(af[ks], LDSFRAG(BT + (et * 16 + lr) * 136 + ks * 32 + lq * 8), a);
#pragma unroll
        for (int r = 0; r < 4; ++r) { const int row = ct * 16 + lq * 4 + r, col = et * 16 + lr; Os[row * 132 + col] = a[r] + oi[e4][r]; } }
    __syncthreads();
    { const int c = tid >> 3, part = tid & 7; float o[16]; float ss = 0.f;
#pragma unroll
      for (int i = 0; i < 16; ++i) { o[i] = Os[c * 132 + part * 16 + i]; ss += o[i] * o[i]; }
      ss += __shfl_xor(ss, 1); ss += __shfl_xor(ss, 2); ss += __shfl_xor(ss, 4);
      const float rstd = rsqrtf(ss * (1.f / 128.f) + 1e-6f);
      const bf16_t* gz = (const bf16_t*)(p.ws + OFF_Z) + (size_t)(tok0 + c) * LDZ + ZGG + h * 128 + part * 16;
      const u32x4 g0 = *(const u32x4*)gz, g1 = *(const u32x4*)(gz + 8);
      const unsigned gw[8] = { g0.x, g0.y, g0.z, g0.w, g1.x, g1.y, g1.z, g1.w };
      unsigned ow[8];
#pragma unroll
      for (int i = 0; i < 8; ++i) { const float n0 = p.in[I_ONORM][l * 128 + part * 16 + 2 * i], n1 = p.in[I_ONORM][l * 128 + part * 16 + 2 * i + 1];
          ow[i] = pk2(o[2 * i] * rstd * n0 * siluf_(lo16(gw[i])), o[2 * i + 1] * rstd * n1 * siluf_(hi16(gw[i]))); }
      bf16_t* ap = (bf16_t*)(p.ws + OFF_AGLA) + (size_t)(tok0 + c) * 512 + h * 128 + part * 16;
      *(u32x4*)ap = (u32x4){ow[0], ow[1], ow[2], ow[3]}; *(u32x4*)(ap + 8) = (u32x4){ow[4], ow[5], ow[6], ow[7]}; }
    __syncthreads();
}
__device__ __forceinline__ void head_row_finish(float (&x)[16], int p8, const float* nw, bool rope, int pos, const float* R, float mul, LAS bf16_t* dst) {
    float ss = 0.f; const int cnt = p8 < 4 ? 16 : 8;
#pragma unroll
    for (int i = 0; i < 16; ++i) if (i < cnt) ss += x[i] * x[i];
    ss += __shfl_xor(ss, 1); ss += __shfl_xor(ss, 2); ss += __shfl_xor(ss, 4);
    const float rstd = rsqrtf(ss * (1.f / 96.f) + 1e-6f) * mul;
    if (p8 < 4) { unsigned w[8];
#pragma unroll
        for (int i = 0; i < 8; ++i) w[i] = pk2(x[2 * i] * rstd * nw[p8 * 16 + 2 * i], x[2 * i + 1] * rstd * nw[p8 * 16 + 2 * i + 1]);
        *(LAS u32x4*)(dst + p8 * 16) = (u32x4){w[0], w[1], w[2], w[3]}; *(LAS u32x4*)(dst + p8 * 16 + 8) = (u32x4){w[4], w[5], w[6], w[7]};
    } else { const int i0 = (p8 - 4) * 4; float o1[4], o2[4];
#pragma unroll
        for (int i = 0; i < 4; ++i) { const float a = x[i] * rstd * nw[64 + i0 + i], b = x[4 + i] * rstd * nw[80 + i0 + i];
            if (rope) { const float c = R[pos * 16 + i0 + i], s = R[16384 + pos * 16 + i0 + i]; o1[i] = a * c - b * s; o2[i] = a * s + b * c; } else { o1[i] = a; o2[i] = b; } }
        *(LAS u32x2*)(dst + 64 + i0) = (u32x2){pk2(o1[0], o1[1]), pk2(o1[2], o1[3])}; *(LAS u32x2*)(dst + 80 + i0) = (u32x2){pk2(o2[0], o2[1]), pk2(o2[2], o2[3])}; }
}
__device__ __forceinline__ void ld16bf(const bf16_t* s, float (&x)[16]) { const u32x4 a = *(const u32x4*)s, b = *(const u32x4*)(s + 8);
    x[0] = lo16(a.x); x[1] = hi16(a.x); x[2] = lo16(a.y); x[3] = hi16(a.y); x[4] = lo16(a.z); x[5] = hi16(a.z); x[6] = lo16(a.w); x[7] = hi16(a.w);
    x[8] = lo16(b.x); x[9] = hi16(b.x); x[10] = lo16(b.y); x[11] = hi16(b.y); x[12] = lo16(b.z); x[13] = hi16(b.z); x[14] = lo16(b.w); x[15] = hi16(b.w); }
__device__ __forceinline__ void ld4bf(const bf16_t* s, float* x) { const u32x2 a = *(const u32x2*)s; x[0] = lo16(a.x); x[1] = hi16(a.x); x[2] = lo16(a.y); x[3] = hi16(a.y); }
__device__ void job_attn(const Params& p, int l, int j, lds_t lds) {
    const int tid = tid_opaque(), wid = tid >> 6, lane = tid & 63, lr = lane & 15, lq = lane >> 4;
    const bool smp = j < 256; int b, h, qb; if (smp) { b = j >> 6; h = (j >> 4) & 3; qb = j & 15; } else { const int jj = j - 256; b = jj >> 4; h = (jj >> 2) & 3; qb = jj & 3; }
    const int qtok0 = smp ? 4096 + b * 1024 + qb * 64 : b * 256 + qb * 64; const int nkt = smp ? 12 : 2;
    LAS bf16_t* Ks = (LAS bf16_t*)lds;
    LAS bf16_t* VTs = Ks + 128 * 104;
    LAS bf16_t* Ps = VTs + 128 * 136 + wid * 16 * 72;
    LAS float* Mg = (LAS float*)(lds + (128 * 104 + 128 * 136 + 8 * 16 * 72) * 2);
    const bf16_t* Z = (const bf16_t*)(p.ws + OFF_Z); const bf16_t* KF = (const bf16_t*)(p.ws + OFF_KF); const bf16_t* Vb = (const bf16_t*)(p.ws + OFF_V); const float* R = (const float*)(p.ws + OFF_ROPE);
    const float* qhn = p.in[I_QHNORM] + l * 96;
    u32x4 kreg[3], vreg[4];
    const int vst = smp ? 1536 : 256; const bf16_t* vtb = smp ? Vb + 2097152 + (size_t)(b * 4 + h) * 128 * 1536 : Vb + (size_t)(b * 4 + h) * 128 * 256;
    auto rowbase = [&](int kt) { return smp ? (kt < 4 ? 8192 + b * 512 + kt * 128 : 4096 + b * 1024 + (kt - 4) * 128) : b * 256 + kt * 128; };
    auto issue = [&](int kt) { const int rb = rowbase(kt);
#pragma unroll
        for (int i = 0; i < 3; ++i) { const int idx = tid + 512 * i, key = idx / 12, part = idx - key * 12; kreg[i] = *(const u32x4*)(KF + (size_t)(rb + key) * 384 + h * 96 + part * 8); }
#pragma unroll
        for (int i = 0; i < 4; ++i) { const int idx = tid + 512 * i, e = idx >> 4, part = idx & 15; vreg[i] = *(const u32x4*)(vtb + (size_t)e * vst + kt * 128 + part * 8); } };
    auto commit = [&]() {
#pragma unroll
        for (int i = 0; i < 3; ++i) { const int idx = tid + 512 * i, key = idx / 12, part = idx - key * 12; *(LAS u32x4*)(Ks + key * 104 + part * 8) = kreg[i]; }
#pragma unroll
        for (int i = 0; i < 4; ++i) { const int idx = tid + 512 * i, e = idx >> 4, part = idx & 15; *(LAS u32x4*)(VTs + e * 136 + part * 8) = vreg[i]; } };
    issue(0);
    { const int row = tid >> 3, p8 = tid & 7, tok = qtok0 + row; const bf16_t* qr = (const bf16_t*)(p.ws + OFF_QRAW) + (size_t)tok * 384 + h * 96; float x[16];
      if (p8 < 4) ld16bf(qr + p8 * 16, x); else { ld4bf(qr + 64 + (p8 - 4) * 4, x); ld4bf(qr + 80 + (p8 - 4) * 4, x + 4); }
      head_row_finish(x, p8, qhn, smp, qb * 64 + row, R, 0.10206207261596575f * 1.4426950408889634f, Ks + row * 104); }
    __syncthreads();
    const int rt = wid & 3, kh = wid >> 2;
    bf16x8 qa[3];
#pragma unroll
    for (int ks = 0; ks < 3; ++ks) qa[ks] = LDSFRAG(Ks + (rt * 16 + lr) * 104 + ks * 32 + lq * 8);
    __syncthreads();
    commit();
    __syncthreads();
    f32x4 oacc[8]; float mrow[4], lrow[4];
#pragma unroll
    for (int e = 0; e < 8; ++e) oacc[e] = (f32x4){0.f, 0.f, 0.f, 0.f};
#pragma unroll
    for (int r = 0; r < 4; ++r) { mrow[r] = -1e30f; lrow[r] = 0.f; }
    const int kbase = kh * 64;
    for (int kt = 0; kt < nkt; ++kt) {
        if (kt + 1 < nkt) issue(kt + 1);
        f32x4 sacc[4];
#pragma unroll
        for (int nt = 0; nt < 4; ++nt) { sacc[nt] = (f32x4){0.f, 0.f, 0.f, 0.f};
#pragma unroll
            for (int ks = 0; ks < 3; ++ks) sacc[nt] = MFMA16(qa[ks], LDSFRAG(Ks + (kbase + nt * 16 + lr) * 104 + ks * 32 + lq * 8), sacc[nt]); }
        float alpha[4];
#pragma unroll
        for (int r = 0; r < 4; ++r) { float mx = fmaxf(fmaxf(sacc[0][r], sacc[1][r]), fmaxf(sacc[2][r], sacc[3][r]));
            mx = fmaxf(mx, __shfl_xor(mx, 1)); mx = fmaxf(mx, __shfl_xor(mx, 2)); mx = fmaxf(mx, __shfl_xor(mx, 4)); mx = fmaxf(mx, __shfl_xor(mx, 8));
            const float mn = fmaxf(mrow[r], mx); alpha[r] = __builtin_amdgcn_exp2f(mrow[r] - mn); mrow[r] = mn; float rs = 0.f;
#pragma unroll
            for (int nt = 0; nt < 4; ++nt) { const float pv = __builtin_amdgcn_exp2f(sacc[nt][r] - mn); rs += pv; Ps[(lq * 4 + r) * 72 + nt * 16 + lr] = f2bf(pv); }
            lrow[r] = lrow[r] * alpha[r] + rs; }
#pragma unroll
        for (int e = 0; e < 8; ++e) { oacc[e][0] *= alpha[0]; oacc[e][1] *= alpha[1]; oacc[e][2] *= alpha[2]; oacc[e][3] *= alpha[3]; }
        asm volatile("s_waitcnt lgkmcnt(0)" ::: "memory");
#pragma unroll
        for (int k2 = 0; k2 < 2; ++k2) { const bf16x8 pa = LDSFRAG(Ps + lr * 72 + k2 * 32 + lq * 8);
#pragma unroll
            for (int e = 0; e < 8; ++e) { const int er = e * 16 + lr; oacc[e] = MFMA16(pa, LDSFRAG(VTs + er * 136 + kbase + k2 * 32 + lq * 8), oacc[e]); } }
        __syncthreads();
        if (kt + 1 < nkt) { commit(); __syncthreads(); }
    }
#pragma unroll
    for (int r = 0; r < 4; ++r) { float s = lrow[r]; s += __shfl_xor(s, 1); s += __shfl_xor(s, 2); s += __shfl_xor(s, 4); s += __shfl_xor(s, 8); lrow[r] = s; }
    LAS float* Mo = Mg + rt * 16 * 132; LAS float* Ml = Mg + 4 * 16 * 132 + rt * 32;
    bf16_t gtv[4][8];
    if (kh == 0) {
#pragma unroll
        for (int r = 0; r < 4; ++r)
#pragma unroll
            for (int e = 0; e < 8; ++e) gtv[r][e] = Z[(size_t)(qtok0 + rt * 16 + lq * 4 + r) * LDZ + ZMG + h * 128 + e * 16 + lr]; }
    if (kh == 1) {
#pragma unroll
        for (int e = 0; e < 8; ++e)
#pragma unroll
            for (int r = 0; r < 4; ++r) Mo[(lq * 4 + r) * 132 + e * 16 + lr] = oacc[e][r];
        if (lr == 0) {
#pragma unroll
            for (int r = 0; r < 4; ++r) { Ml[(lq * 4 + r) * 2] = mrow[r]; Ml[(lq * 4 + r) * 2 + 1] = lrow[r]; } }
    }
    __syncthreads();
    if (kh == 0) { bf16_t* AM = (bf16_t*)(p.ws + OFF_AMLA);
#pragma unroll
        for (int r = 0; r < 4; ++r) { const int row = lq * 4 + r; const float m2 = Ml[row * 2], l2 = Ml[row * 2 + 1]; const float mm = fmaxf(mrow[r], m2), a1 = exp2f(mrow[r] - mm), a2 = exp2f(m2 - mm);
            const float inv = 1.f / (lrow[r] * a1 + l2 * a2); const int tok = qtok0 + rt * 16 + row;
#pragma unroll
            for (int e = 0; e < 8; ++e) { const int col = e * 16 + lr; const float o = (oacc[e][r] * a1 + Mo[row * 132 + col] * a2) * inv;
                const float gt = bf2f(gtv[r][e]); AM[(size_t)tok * 512 + h * 128 + col] = f2bf(o * siluf_(gt)); } } }
    __syncthreads();
}


#define XB_TMO      128
#define XB_XCNT(j)  (256  + 64 * (j))
#define XB_XSUB(j)  (1280 + 64 * (j))
#define XB_XGEN(j)  (2304 + 64 * (j))
#define XB_TOP      3328
#define XB_TOPGEN   3392
#define XCD_BAR_WORDS 3456
#define XB_SPIN_CAP (1u << 18)

__device__ __forceinline__ unsigned xb_ld(unsigned* p)              { return __hip_atomic_load(p, __ATOMIC_RELAXED, __HIP_MEMORY_SCOPE_AGENT); }
__device__ __forceinline__ unsigned xb_add(unsigned* p, unsigned v) { return __hip_atomic_fetch_add(p, v, __ATOMIC_RELAXED, __HIP_MEMORY_SCOPE_AGENT); }
__device__ __forceinline__ unsigned xb_xcc_id() { return (unsigned)__builtin_amdgcn_s_getreg((3 << 11) | 20) & 0xFu; }
#define XB_SPIN(cond, bar) do { unsigned _sp = 0; while (cond) { __builtin_amdgcn_s_sleep(1); \
    if ((++_sp & 255u) == 0u) { if (xb_ld(&(bar)[XB_TMO])) break; if (_sp > XB_SPIN_CAP) { atomicAdd(&(bar)[XB_TMO], 1u); break; } } } } while (0)

struct XcdBarrier {
    unsigned* bar; unsigned x;
    volatile LAS unsigned* st;
};

__device__ __forceinline__ XcdBarrier xcd_barrier_post(unsigned* bar, volatile LAS unsigned* st) {
    XcdBarrier b; b.bar = bar; b.x = xb_xcc_id(); b.st = st;
    if (threadIdx.x == 0) (void)xb_add(&bar[XB_XCNT(b.x)], 1u);
    return b;
}
__device__ __forceinline__ void xcd_barrier_complete(unsigned* bar, unsigned x, unsigned& nloc, unsigned& nx) {
    const unsigned G = gridDim.x * gridDim.y * gridDim.z;
    unsigned sum, cnt, mine, sp = 0u;
    for (;;) {
        sum = 0u; cnt = 0u; mine = 0u;
#pragma unroll
        for (unsigned j = 0; j < 16; ++j) { const unsigned c = xb_ld(&bar[XB_XCNT(j)]); sum += c; cnt += (c > 0u) ? 1u : 0u; mine = (j == x) ? c : mine; }
        if (sum == G) break;
        __builtin_amdgcn_s_sleep(1);
        if ((++sp & 255u) == 0u) { if (xb_ld(&bar[XB_TMO])) break; if (sp > XB_SPIN_CAP) { atomicAdd(&bar[XB_TMO], 1u); break; } }
    }
    nloc = mine > 0u ? mine : 1u; nx = cnt > 0u ? cnt : 1u;
}

__device__ __forceinline__ void xcd_barrier(const XcdBarrier& b) {
    asm volatile("s_waitcnt vmcnt(0)" ::: "memory");
    __syncthreads();
    if (threadIdx.x == 0) {
        unsigned* bar = b.bar;
        __builtin_amdgcn_s_waitcnt(0);
        unsigned nloc = b.st[0], nx = b.st[1];
        if (nloc == 0u) { xcd_barrier_complete(bar, b.x, nloc, nx); b.st[0] = nloc; b.st[1] = nx; }
        const unsigned old = xb_add(&bar[XB_XSUB(b.x)], 1u);
        const unsigned gen = old / nloc;
        if (old + 1u == (gen + 1u) * nloc) {
            __builtin_amdgcn_fence(__ATOMIC_RELEASE, "agent");
            asm volatile("s_waitcnt vmcnt(0)" ::: "memory");
            const unsigned og = xb_add(&bar[XB_TOP], 1u);
            const unsigned tg = og / nx;
            if (og + 1u == (tg + 1u) * nx) xb_add(&bar[XB_TOPGEN], 1u);
            else XB_SPIN(xb_ld(&bar[XB_TOPGEN]) == tg, bar);
            __builtin_amdgcn_fence(__ATOMIC_ACQUIRE, "agent");
            xb_add(&bar[XB_XGEN(b.x)], 1u);
            asm volatile("s_waitcnt vmcnt(0)" ::: "memory");
        } else {
            XB_SPIN(xb_ld(&bar[XB_XGEN(b.x)]) == gen, bar);
            __builtin_amdgcn_fence(__ATOMIC_ACQUIRE, "agent");
            asm volatile("s_waitcnt vmcnt(0)" ::: "memory");
        }
    }
    __syncthreads();
}

constexpr int N_PHASES = 15;
#ifndef REPEAT_MASK
#define REPEAT_MASK 0xff
#endif
#ifndef ONLY_S
#define ONLY_S -1
#endif
__device__ __forceinline__ void run_phase(const Params& p, int ph, lds_t lds, int mask = 0xff) {
    const int G = (int)gridDim.x, bid = (int)blockIdx.x;
    if (ph == 0 && (ONLY_S < 0 || ONLY_S == 7)) {
        for (int j = bid; j < 192 + 256 + 32; j += G) { if (j < 192) job_ada(p, j, lds); else if (j < 448) job_ctx(p, j - 192); else job_rope(p, j - 448); }
        return;
    }
    const int l = (ph - 1) / 7, s = (ph - 1) % 7;
    unsigned char* ws = p.ws;
    if (s == 0 && (ONLY_S < 0 || ONLY_S == 0)) {
        if (l == 0 || G < 256) { for (int j = bid; j < 96 + WT_TOTAL + 1024; j += G) { if (j < 96) { if (mask & 1) job_s5setup(p, l, j, lds); } else if (j < 96 + WT_TOTAL) { if (mask & 2) job_wt(p, l, j - 96, lds); } else if (mask & 4) job_prep(p, l, j - 96 - WT_TOTAL); } }
        else { for (int j = bid; j < WT_WOUT + 1024; j += G) { if (j < WT_WOUT) job_wt(p, l, WT_EARLY + 3 * WT_WBO + j, lds); else job_prep(p, l, j - WT_WOUT); } }
    } else if (s == 1 && (ONLY_S < 0 || ONLY_S == 1)) {
        Order S; S.setup(8192, 6912, 0); pg8::Gemm g{(const bf16_t*)(ws + OFF_HB), (const bf16_t*)(ws + OFF_WIN), 8192, 6912, 1024}; EpiZ E{(bf16_t*)(ws + OFF_Z)};
        pg8::gemm_phase<EpiZ, Order>(lds, g, S, E, nullptr);
    } else if (s == 2 && (ONLY_S < 0 || ONLY_S == 2)) {
        for (int j = bid; j < 640 + 512 + 1024; j += G) { if (j < 640) { if (mask & 1) job_s5(p, l, j, lds); } else if (j < 1152) { if (mask & 2) job_glaA(p, l, j - 640, lds); } else if (mask & 4) job_mlaprep(p, l, j - 1152); }
    } else if (s == 3 && (ONLY_S < 0 || ONLY_S == 3)) {
        if (mask & 1) for (int j = bid; j < 2560; j += G) job_glaB(p, l, j);
        if (mask & 2) { Order S; S.setup(8192, 1024, 0); pg8::Gemm g{(const bf16_t*)(ws + OFF_YG), (const bf16_t*)(ws + OFF_WGLU), 8192, 1024, 512}; EpiGLU E{(bf16_t*)(ws + OFF_AS5), (const bf16_t*)(ws + OFF_Z), p.in[I_BGLU] + l * 1024};
          pg8::gemm_phase<EpiGLU, Order>(lds, g, S, E, nullptr); }
        if (mask & 4) { Order S; S.setup(10240, 768, 128); pg8::Gemm g{(const bf16_t*)(ws + (l == 0 ? OFF_CTX0 : OFF_CKVN)), (const bf16_t*)(ws + OFF_WKV), 10240, 768, 256}; EpiKV E{(bf16_t*)(ws + OFF_KF), (bf16_t*)(ws + OFF_V), l, (const bf16_t*)(ws + OFF_Z), p.in[I_CKR], p.in[I_KHNORM] + l * 96, (const float*)(ws + OFF_ROPE)};
          pg8::gemm_phase<EpiKV, Order>(lds, g, S, E, nullptr); }
        if (mask & 8) { Order S; S.setup(8192, 512, 248); pg8::Gemm g{(const bf16_t*)(ws + OFF_AQ), (const bf16_t*)(ws + OFF_WUQ), 8192, 512, 384}; EpiQ E{(bf16_t*)(ws + OFF_QRAW)};
          pg8::gemm_phase<EpiQ, Order>(lds, g, S, E, nullptr); }
    } else if (s == 4 && (ONLY_S < 0 || ONLY_S == 4)) {
        for (int j = bid; j < 512 + 512; j += G) { if (j < 512) { if (mask & 1) job_attn(p, l, j, lds); } else if (mask & 2) job_glaC(p, l, j - 512, lds); }
    } else if (s == 5 && (ONLY_S < 0 || ONLY_S == 5)) {
        if (l == 0 && mask == 0xff && G >= 256 && bid >= 128) { for (int j = bid - 128; j < 96 + WT_EARLY; j += G - 128) { if (j < 96) job_s5setup(p, 1, j, lds); else job_wt(p, 1, j - 96, lds); } }
        for (int br = 0; br < 3; ++br) { Order S; S.setup(8192, 1024, 0);
            pg8::Gemm g{(const bf16_t*)(ws + (br == 0 ? OFF_AGLA : br == 1 ? OFF_AMLA : OFF_AS5)), (const bf16_t*)(ws + OFF_WBO) + (size_t)br * 1024 * 512, 8192, 1024, 512};
            EpiBo E{(bf16_t*)(ws + OFF_HB), (const bf16_t*)(ws + OFF_Z), br};
            pg8::gemm_phase<EpiBo, Order>(lds, g, S, E, nullptr); }
    } else if (s == 6 && (ONLY_S < 0 || ONLY_S == 6)) {
        if (l == 0 && mask == 0xff && G >= 256 && bid >= 128) { for (int j = bid - 128; j < 3 * WT_WBO; j += G - 128) job_wt(p, 1, WT_EARLY + j, lds); }
        Order S; S.setup(8192, 1024, 0); pg8::Gemm g{(const bf16_t*)(ws + OFF_HB), (const bf16_t*)(ws + OFF_WOUT), 8192, 1024, 1024};
        EpiOut E{p.out, l == 0 ? p.in[I_XP] : p.out, l == 0 ? p.in[I_XS] : p.out + (size_t)4096 * 1024, (const float*)(ws + OFF_ADA) + l * 5 * 3072};
        pg8::gemm_phase<EpiOut, Order>(lds, g, S, E, nullptr);
    }
}
__global__ __launch_bounds__(512, 2) void mega(KParams kp, int ph0, int ph1) {
    extern __shared__ __attribute__((aligned(16))) unsigned char shm[];
    lds_t lds = (lds_t)shm;
    if (threadIdx.x < N_IN) ((const float**)(kp.ws + OFF_TBL))[threadIdx.x] = kp.in[threadIdx.x];
    volatile LAS unsigned* xst = (volatile LAS unsigned*)(lds + DYN_LDS - 16);
    if (threadIdx.x == 0) { xst[0] = 0u; xst[1] = 0u; }
    __threadfence(); __syncthreads();
    XcdBarrier xb = xcd_barrier_post((unsigned*)(kp.ws + OFF_BAR), xst);
    if (ph0 > ph1) cg::this_grid().sync();
    for (int ph = ph0; ph < ph1; ++ph) {
        Params p; { const float* const* tb = (const float* const*)(kp.ws + OFF_TBL); float* o = kp.out; unsigned char* w = kp.ws; asm volatile("" : "+s"(tb), "+s"(o), "+s"(w)); p.in = tb; p.out = o; p.ws = w; }
        run_phase(p, ph, lds);
#ifdef REPEAT_S
        if ((REPEAT_S == 7 && ph == 0) || (ph > 0 && (ph - 1) % 7 == REPEAT_S && (REPEAT_S != 6 || ph < 8))) { xcd_barrier(xb); run_phase(p, ph, lds, REPEAT_MASK); }
#endif
        if (ph + 1 < ph1) xcd_barrier(xb);
    }
}

#ifndef N_LAUNCH_MODE
#define N_LAUNCH_MODE 1
#endif
extern "C" void kernel_launch(void* const* d_in, const int* in_sizes, int n_in, void* d_out, int out_size, void* d_ws, size_t ws_size, hipStream_t stream) {
    static int grid = 0;
    if (grid == 0) {
        if (n_in != N_IN || ws_size < WS_END) { fprintf(stderr, "kernel_launch: unexpected n_in %d / ws %zu (need %zu)\n", n_in, ws_size, (size_t)WS_END); grid = -1; return; }
        int dev = 0, cus = 0, per_cu = 0;
        hipGetDevice(&dev); hipDeviceGetAttribute(&cus, hipDeviceAttributeMultiprocessorCount, dev);
        hipFuncSetAttribute((const void*)mega, hipFuncAttributeMaxDynamicSharedMemorySize, DYN_LDS);
        hipOccupancyMaxActiveBlocksPerMultiprocessor(&per_cu, (const void*)mega, 512, DYN_LDS);
        if (per_cu < 1) { fprintf(stderr, "kernel_launch: occupancy query says %d blocks per CU\n", per_cu); per_cu = 1; }
        (void)hipGetLastError();
        grid = cus;
    }
    if (grid < 0) return;
    hipMemsetAsync((char*)d_ws + OFF_BAR, 0, 16384, stream);
    KParams p{};
    for (int i = 0; i < N_IN; ++i) p.in[i] = (const float*)d_in[i];
    p.out = (float*)d_out; p.ws = (unsigned char*)d_ws;
#if N_LAUNCH_MODE == 0
    for (int ph = 0; ph < N_PHASES; ++ph) { hipLaunchKernelGGL(mega, dim3(grid), dim3(512), DYN_LDS, stream, p, ph, ph + 1); }
#else
    int ph0 = 0, ph1 = N_PHASES; void* args[] = {&p, &ph0, &ph1};
    hipError_t e = hipLaunchCooperativeKernel((const void*)mega, dim3(grid), dim3(512), args, DYN_LDS, stream);
    if (e != hipSuccess) fprintf(stderr, "cooperative launch failed: %s (grid %d)\n", hipGetErrorString(e), grid);
#endif
}
```

```cpp
#include <hip/hip_runtime.h>
#include <hip/hip_cooperative_groups.h>
#include <cstdio>
namespace cg = cooperative_groups;
namespace pg8 {
#define PG8_LAS __attribute__((address_space(3)))
typedef unsigned short bf16_t;
typedef short bf16x8 __attribute__((ext_vector_type(8)));
typedef float f32x4 __attribute__((ext_vector_type(4)));
typedef unsigned u32x4 __attribute__((ext_vector_type(4)));
constexpr int BM = 256, BK = 64, HALF = 128, HTB = HALF * BK * 2  , STAGE_BYTES = 8 * HTB, NXCD = 8, WGM = 8;

__host__ __device__ __forceinline__ int lds_byte(int r, int c) { const int st = (r >> 4) * 2 + (c >> 5), rr = r & 15, cc = c & 31, ob = rr * 64 + cc * 2; return st * 1024 + (ob ^ (((ob >> 9) & 1) << 5)); }
__host__ __device__ __forceinline__ void stage_rc(int b, int& R, int& C) { const int st = b / 1024, sb = b % 1024, swz = sb ^ (((sb >> 9) & 1) << 5); R = (st >> 1) * 16 + swz / 64; C = (st & 1) * 32 + (swz % 64) / 2; }
__host__ __device__ __forceinline__ int perm32(int rho) { const int n = rho >> 4, i = rho & 15; return 8 * (i >> 2) + 4 * n + (i & 3); }

struct Unit { int pm, pn; };
struct Gemm { const bf16_t* A; const bf16_t* Bt; int M, N, K; };

struct StaticOrder {
    int nM, nN, nwg, G, c;
    __host__ __device__ void init(int M, int N, int G_, int c_) { nM = M / BM; nN = N / BM; nwg = nM * nN; G = G_; c = c_; }
    __host__ __device__ bool next(int i, Unit& u) const {
        const long L = (long)i * G + c; if (L >= nwg) return false;
        int wgid = (int)L; { const int q = nwg / NXCD, r = nwg % NXCD, xcd = wgid % NXCD, off = wgid / NXCD; wgid = (xcd < r ? xcd * (q + 1) : r * (q + 1) + (xcd - r) * q) + off; }
        const int nig = WGM * nN, gid = wgid / nig, fm = gid * WGM, gsz = (nM - fm) < WGM ? (nM - fm) : WGM;
        u.pm = fm + ((wgid % nig) % gsz); u.pn = (wgid % nig) / gsz; return true;
    }
    __device__ __forceinline__ void a_ready(const Unit&) const {}
    __device__ __forceinline__ void done(const Unit&) const {}
};
__device__ __forceinline__ unsigned cvt_pk_bf16(float lo, float hi) { unsigned r; asm volatile("v_cvt_pk_bf16_f32 %0, %1, %2" : "=v"(r) : "v"(lo), "v"(hi)); return r; }
typedef float f32x2 __attribute__((ext_vector_type(2)));
template <class Epi, class Sched, bool STAMP = false>
__device__ __forceinline__ void gemm_phase(PG8_LAS unsigned char* lds, const Gemm g, const Sched& S, const Epi& E, unsigned long long* stamps) {
    int tid_ = (S.wid << 6) | (int)__builtin_amdgcn_mbcnt_hi(~0u, __builtin_amdgcn_mbcnt_lo(~0u, 0u)); asm volatile("" : "+v"(tid_)); const int tid = tid_, wid = __builtin_amdgcn_readfirstlane(tid >> 6), lane = tid & 63, wr = wid >> 2, wc = wid & 3, fr = lane & 15, fq = lane >> 4;
    int K_ = g.K; asm volatile("" : "+s"(K_)); const int K = K_, nt = K / BK;
    int ts_lo = 0, ts_hi = 0, nts = 0; const unsigned long long rt_entry = STAMP ? (unsigned long long)wall_clock64() : 0ull;
#define PG8_STAMP() do { if (STAMP && wid == 0 && nts < 64) { const unsigned long long _c = (unsigned long long)clock64(); \
        ts_lo = (lane == nts) ? (int)(unsigned)_c : ts_lo; ts_hi = (lane == nts) ? (int)(unsigned)(_c >> 32) : ts_hi; ++nts; } } while (0)
    PG8_STAMP();
    unsigned voffA[2], voffB[2];
#pragma unroll
    for (int i = 0; i < 2; ++i) { int R, C; stage_rc(tid * 16 + i * 8192, R, C); const int Rb = Epi::PERM ? ((R & ~31) + perm32(R & 31)) : R;
        voffA[i] = (unsigned)(R * K + C) * 2u; voffB[i] = (unsigned)(Rb * K + C) * 2u; }
    const size_t kstep = (size_t)(BK * 2);
    const size_t hstep = (size_t)HALF * K * 2;
    const size_t tstep = 2 * hstep;
    const unsigned ldsw = (unsigned)wid * 1024u;
    const int aoff = lds_byte(wr * 64 + fr, fq * 8), boff = lds_byte(wc * 32 + fr, fq * 8);
#define PG8_SA(b, h) (((b) * 2 + (h)) * HTB)
#define PG8_SB(b, h) ((4 + (b) * 2 + (h)) * HTB)
#define PG8_STAGE(bufoff, gbase, voff) do { _Pragma("unroll") for (int _i = 0; _i < 2; ++_i) \
        __builtin_amdgcn_global_load_lds((const unsigned*)((const char*)(gbase) + (voff)[_i]), (PG8_LAS unsigned*)(lds + (bufoff) + ldsw + _i * 8192), 16, 0, 0); } while (0)
#define PG8_LDA(dst, b, h) do { _Pragma("unroll") for (int m = 0; m < 4; ++m) _Pragma("unroll") for (int k = 0; k < 2; ++k) dst[m][k] = *(const PG8_LAS bf16x8*)(lds + PG8_SA(b, h) + aoff + m * 2048 + k * 1024); } while (0)
#define PG8_LDB(dst, b, h) do { _Pragma("unroll") for (int n = 0; n < 2; ++n) _Pragma("unroll") for (int k = 0; k < 2; ++k) dst[n][k] = *(const PG8_LAS bf16x8*)(lds + PG8_SB(b, h) + boff + n * 2048 + k * 1024); } while (0)
#define PG8_MMA(ai, bj, At, Bt) do { __builtin_amdgcn_s_setprio(1); _Pragma("unroll") for (int m = 0; m < 4; ++m) _Pragma("unroll") for (int n = 0; n < 2; ++n) _Pragma("unroll") for (int k = 0; k < 2; ++k) \
        acc[ai][bj][m][n] = __builtin_amdgcn_mfma_f32_16x16x32_bf16(Bt[n][k], At[m][k], acc[ai][bj][m][n], 0, 0, 0); __builtin_amdgcn_s_setprio(0); } while (0)
#define PG8_WAIT_V(n) asm volatile("s_waitcnt vmcnt(" #n ")" ::: "memory")
#define PG8_WAIT_L(n) asm volatile("s_waitcnt lgkmcnt(" #n ")" ::: "memory")
#define PG8_BAR __builtin_amdgcn_s_barrier()
#define PG8_SCHED __builtin_amdgcn_sched_barrier(0)
    Unit cur, nxt; int ui = 0;
    if (!S.next(0, cur)) return;
    f32x4 acc[2][2][4][2];
#pragma unroll
    for (int a = 0; a < 2; ++a)
#pragma unroll
        for (int b = 0; b < 2; ++b)
#pragma unroll
            for (int m = 0; m < 4; ++m)
#pragma unroll
                for (int n = 0; n < 2; ++n) acc[a][b][m][n] = (f32x4){0.f, 0.f, 0.f, 0.f};
    bf16x8 At[4][2], B0[2][2], B1[2][2];
    const char* cA = (const char*)g.A + (size_t)cur.pm * tstep; const char* cB = (const char*)g.Bt + (size_t)cur.pn * tstep;
    S.a_ready(cur);
    PG8_STAGE(PG8_SB(0, 0), cB, voffB); PG8_STAGE(PG8_SA(0, 0), cA, voffA); PG8_STAGE(PG8_SB(0, 1), cB + hstep, voffB); PG8_STAGE(PG8_SA(0, 1), cA + hstep, voffA);
    if (wr == 1) PG8_BAR;
    PG8_WAIT_V(4); PG8_BAR;
    PG8_STAGE(PG8_SB(1, 0), cB + kstep, voffB); PG8_STAGE(PG8_SA(1, 0), cA + kstep, voffA); PG8_STAGE(PG8_SB(1, 1), cB + hstep + kstep, voffB);
    PG8_WAIT_V(6); PG8_BAR;
    PG8_STAMP();
    for (;;) {
        const bool has_next = S.next(ui + 1, nxt);
        const char* nA = has_next ? (const char*)g.A + (size_t)nxt.pm * tstep : cA; const char* nB = has_next ? (const char*)g.Bt + (size_t)nxt.pn * tstep : cB;
        for (int t = 0; t < nt; t += 2) {
            const bool last = (t == nt - 2);
            const char* a1 = cA + (size_t)(t + 1) * kstep;
            const char* a2 = last ? nA : cA + (size_t)(t + 2) * kstep; const char* b2 = last ? nB : cB + (size_t)(t + 2) * kstep;
            const char* a3 = a2 + kstep; const char* b3 = b2 + kstep;
            if (last && has_next) S.a_ready(nxt);
            PG8_LDB(B0, 0, 0); PG8_SCHED; PG8_LDA(At, 0, 0); PG8_STAGE(PG8_SA(1, 1), a1 + hstep, voffA);
            PG8_WAIT_L(8); PG8_BAR; PG8_WAIT_L(0); PG8_MMA(0, 0, At, B0); PG8_BAR; PG8_SCHED;
            PG8_LDB(B1, 0, 1); PG8_STAGE(PG8_SB(0, 0), b2, voffB);
            PG8_BAR; PG8_WAIT_L(0); PG8_MMA(0, 1, At, B1); PG8_BAR;
            PG8_LDA(At, 0, 1); PG8_STAGE(PG8_SA(0, 0), a2, voffA);
            PG8_BAR; PG8_WAIT_L(0); PG8_MMA(1, 0, At, B0); PG8_BAR; PG8_SCHED;
            PG8_STAGE(PG8_SB(0, 1), b2 + hstep, voffB);
            PG8_WAIT_V(6); PG8_BAR; PG8_MMA(1, 1, At, B1); PG8_BAR;
            PG8_LDB(B0, 1, 0); PG8_SCHED; PG8_LDA(At, 1, 0); PG8_STAGE(PG8_SA(0, 1), a2 + hstep, voffA);
            PG8_WAIT_L(8); PG8_BAR; PG8_WAIT_L(0); PG8_MMA(0, 0, At, B0); PG8_BAR; PG8_SCHED;
            PG8_LDB(B1, 1, 1); PG8_STAGE(PG8_SB(1, 0), b3, voffB);
            PG8_BAR; PG8_WAIT_L(0); PG8_MMA(0, 1, At, B1); PG8_BAR;
            PG8_LDA(At, 1, 1); PG8_STAGE(PG8_SA(1, 0), a3, voffA);
            PG8_BAR; PG8_WAIT_L(0); PG8_MMA(1, 0, At, B0); PG8_BAR; PG8_SCHED;
            PG8_STAGE(PG8_SB(1, 1), b3 + hstep, voffB);
            PG8_WAIT_V(6); PG8_BAR; PG8_MMA(1, 1, At, B1); PG8_BAR;
        }
        PG8_STAMP();
        if constexpr (!Epi::AFTER_DRAIN) { E(acc, cur, wr, wc, fr, fq); S.done(cur); }
        PG8_STAMP();
        if (!has_next) break;
#pragma unroll
        for (int a = 0; a < 2; ++a)
#pragma unroll
            for (int b = 0; b < 2; ++b)
#pragma unroll
                for (int m = 0; m < 4; ++m)
#pragma unroll
                    for (int n = 0; n < 2; ++n) acc[a][b][m][n] = (f32x4){0.f, 0.f, 0.f, 0.f};
        cur = nxt; cA = nA; cB = nB; ++ui;
    }
    PG8_WAIT_V(0);
    if (wr == 0) PG8_BAR;
    PG8_BAR;
    if constexpr (Epi::AFTER_DRAIN) { E.fused(acc, cur, wr, wc, fr, fq, lds, wid, lane); S.done(cur); }
    PG8_STAMP();
    if (STAMP && wid == 0) { stamps[lane] = lane < nts ? (((unsigned long long)(unsigned)ts_hi << 32) | (unsigned)ts_lo) : 0ull;
        if (lane == 62) stamps[62] = rt_entry; if (lane == 63) stamps[63] = (unsigned long long)wall_clock64(); }
#undef PG8_STAMP
#undef PG8_SA
#undef PG8_SB
#undef PG8_STAGE
#undef PG8_LDA
#undef PG8_LDB
#undef PG8_MMA
#undef PG8_WAIT_V
#undef PG8_WAIT_L
#undef PG8_BAR
#undef PG8_SCHED
}
}
using pg8::bf16_t; using pg8::bf16x8; using pg8::f32x4; using pg8::u32x4; using pg8::Unit;
#define LAS __attribute__((address_space(3)))
typedef unsigned u32x2 __attribute__((ext_vector_type(2)));
typedef LAS unsigned char* lds_t;
struct Params;
__device__ __forceinline__ int lane_id_() { return (int)__builtin_amdgcn_mbcnt_hi(~0u, __builtin_amdgcn_mbcnt_lo(~0u, 0u)); }
typedef float f32x2_t __attribute__((ext_vector_type(2)));

enum { I_XP = 0, I_XS, I_C, I_CCTX, I_CKV, I_CKR, I_SGLA, I_SS5, I_NORMW, I_WADA, I_BADA, I_WIN, I_WA2, I_BA, I_ONORM, I_QNORM, I_WUQ, I_KVNORM, I_WUK, I_WUV,
       I_QHNORM, I_KHNORM, I_ARE, I_AIM, I_LOGDT, I_BRE, I_BIM, I_CRE, I_CIM, I_S5D, I_WGLU, I_BGLU, I_WBOG, I_WBOM, I_WBOS, I_WOUT, N_IN };
struct KParams { const float* in[N_IN]; float* out; unsigned char* ws; };
struct Params { const float* const* in; float* out; unsigned char* ws; int wid; };
__device__ __forceinline__ int tid_opaque(const Params& p) { int t = (p.wid << 6) | lane_id_(); asm volatile("" : "+v"(t)); return t; }

constexpr int LDZ = 6912;
constexpr int ZQ = 0, ZK = 256, ZV = 512, ZGA = 1024, ZGG = 1056, ZMQ = 1568, ZMKV = 1952, ZMKR = 2208, ZMG = 2240, ZSU = 2752, ZSG = 3264, ZMERGE = 3776;
constexpr size_t OUT_YP = 0, OUT_CKV = 8388608, OUT_KR = 10485760, OUT_GLA = 10747904, OUT_S5 = 12845056;
constexpr size_t OFF_WIN = 0;

constexpr size_t OFF_WUQ = OFF_WIN + 14155776;
constexpr size_t OFF_WKV = OFF_WUQ + 393216;
constexpr size_t OFF_WGLU = OFF_WKV + 393216;
constexpr size_t OFF_WBO = OFF_WGLU + 1048576;
constexpr size_t OFF_WOUT = OFF_WBO + 3145728;
constexpr size_t OFF_S5M = OFF_WOUT + 2097152;
constexpr size_t OFF_V = OFF_S5M;
constexpr size_t OFF_P16 = OFF_S5M + 12582912;
constexpr size_t OFF_ADA = OFF_P16 + 32768;
constexpr size_t OFF_ROPE = OFF_ADA + 122880;
constexpr size_t OFF_CTX0 = OFF_ROPE + 131072;
constexpr size_t OFF_CKVN = OFF_CTX0 + 1048576;
constexpr size_t OFF_CTX1 = OFF_CKVN + 4194304;
constexpr size_t OFF_HB = OFF_CTX1 + 1048576;
constexpr size_t OFF_Z = OFF_HB + 16777216;
constexpr size_t OFF_KV = OFF_Z + 113246208;
constexpr size_t OFF_AGLA = OFF_KV, OFF_AMLA = OFF_KV + 8388608;
constexpr size_t OFF_QD = OFF_KV + 16777216;
constexpr size_t OFF_OIB = OFF_QD + 8388608;
constexpr size_t OFF_DEC = OFF_KV + 33554432;
constexpr size_t OFF_ST = OFF_DEC + 262144;
constexpr size_t OFF_AQ = OFF_ST + 16777216;
constexpr size_t OFF_QRAW = OFF_AQ + 6291456;
constexpr size_t OFF_AS5 = OFF_QRAW + 6291456;
constexpr size_t OFF_YG = OFF_AS5 + 8388608;
constexpr size_t OFF_TBL = OFF_YG + 8388608;
constexpr size_t OFF_BAR = OFF_TBL + 512;
constexpr size_t OFF_KF = OFF_BAR + 16384;
constexpr size_t WS_END = OFF_KF + 7864320;
constexpr int DYN_LDS = 147456;

__device__ __forceinline__ float bf2f(bf16_t b) { return __uint_as_float(((unsigned)b) << 16); }
__device__ __forceinline__ bf16_t f2bf(float f) { unsigned u = __float_as_uint(f); u += 0x7FFFu + ((u >> 16) & 1u); return (bf16_t)(u >> 16); }
__device__ __forceinline__ unsigned pk2(float lo, float hi) { return pg8::cvt_pk_bf16(lo, hi); }
__device__ __forceinline__ float lo16(unsigned w) { return __uint_as_float(w << 16); }
__device__ __forceinline__ float hi16(unsigned w) { return __uint_as_float(w & 0xffff0000u); }
__device__ __forceinline__ float sigmoidf_(float x) { return 1.f / (1.f + __expf(-x)); }
__device__ __forceinline__ float siluf_(float x) { return x / (1.f + __expf(-x)); }
__device__ __forceinline__ void store8(bf16_t* p, const f32x4& a, const f32x4& b) { u32x4 w; w.x = pk2(a[0], a[1]); w.y = pk2(a[2], a[3]); w.z = pk2(b[0], b[1]); w.w = pk2(b[2], b[3]); *(u32x4*)p = w; }
#define MFMA16(a, b, c) __builtin_amdgcn_mfma_f32_16x16x32_bf16(a, b, c, 0, 0, 0)
#define LDSFRAG(ptr) (*(const LAS bf16x8*)(ptr))

struct Order : pg8::StaticOrder { int wid;
    __device__ void setup(int M, int N, int rot, int wid_) { wid = wid_; const int G = (int)gridDim.x; init(M, N, G, (int)((blockIdx.x + (unsigned)rot) % (unsigned)G)); }
};

struct EpiZ { static constexpr bool PERM = true, AFTER_DRAIN = false; bf16_t* Z;
    __device__ __forceinline__ void operator()(const f32x4 (&acc)[2][2][4][2], const Unit& u, int wr, int wc, int fr_, int fq_) const {
        int fr = fr_, fq = fq_; asm volatile("" : "+v"(fr), "+v"(fq));
        const int row0 = u.pm * 256 + wr * 64 + fr, col0 = u.pn * 256 + wc * 32 + 8 * fq;
#pragma unroll
        for (int ai = 0; ai < 2; ++ai)
#pragma unroll
            for (int m = 0; m < 4; ++m) { bf16_t* rp = Z + (size_t)(row0 + ai * 128 + m * 16) * LDZ + col0;
#pragma unroll
                for (int bj = 0; bj < 2; ++bj) store8(rp + bj * 128, acc[ai][bj][m][0], acc[ai][bj][m][1]); }
    } };
struct EpiQ { static constexpr bool PERM = true, AFTER_DRAIN = false; bf16_t* Q;
    __device__ __forceinline__ void operator()(const f32x4 (&acc)[2][2][4][2], const Unit& u, int wr, int wc, int fr_, int fq_) const {
        int fr = fr_, fq = fq_; asm volatile("" : "+v"(fr), "+v"(fq));
        const int row0 = u.pm * 256 + wr * 64 + fr, col0 = u.pn * 256 + wc * 32 + 8 * fq;
#pragma unroll
        for (int ai = 0; ai < 2; ++ai)
#pragma unroll
            for (int m = 0; m < 4; ++m) { bf16_t* rp = Q + (size_t)(row0 + ai * 128 + m * 16) * 384 + col0;
#pragma unroll
                for (int bj = 0; bj < 2; ++bj) if (col0 + bj * 128 < 384) store8(rp + bj * 128, acc[ai][bj][m][0], acc[ai][bj][m][1]);
                }
    } };
struct EpiKV { static constexpr bool PERM = true, AFTER_DRAIN = false; bf16_t* KF; bf16_t* V; int layer; const bf16_t* Z; const float* ckr; const float* khn; const float* R;
    __device__ __forceinline__ void operator()(const f32x4 (&acc)[2][2][4][2], const Unit& u, int wr, int wc, int fr_, int fq_) const {
        int fr = fr_, fq = fq_; asm volatile("" : "+v"(fr), "+v"(fq));
        int rb = u.pm * 256; if (layer == 0) rb = rb < 2048 ? 8192 + rb : rb - 2048;
        const int row0 = rb + wr * 64 + fr;
        if (u.pn > 0) {
#pragma unroll
            for (int ai = 0; ai < 2; ++ai)
#pragma unroll
                for (int m = 0; m < 4; ++m) { const int r = row0 + ai * 128 + m * 16; bf16_t* bp; int st;
                    if (r < 4096) { bp = V + (size_t)(r >> 8) * 4 * 128 * 256 + (r & 255); st = 256; }
                    else if (r < 8192) { bp = V + 2097152 + (size_t)((r - 4096) >> 10) * 4 * 128 * 1536 + 512 + ((r - 4096) & 1023); st = 1536; }
                    else { bp = V + 2097152 + (size_t)((r - 8192) >> 9) * 4 * 128 * 1536 + ((r - 8192) & 511); st = 1536; }
#pragma unroll
                    for (int bj = 0; bj < 2; ++bj) { bf16_t* hp = bp + (size_t)((((u.pn - 1) * 2 + bj) * 128) + wc * 32 + 8 * fq) * st;
#pragma unroll
                        for (int i = 0; i < 8; i += 2) { const unsigned w = pk2(acc[ai][bj][m][i >> 2][i & 3], acc[ai][bj][m][i >> 2][(i & 3) + 1]); hp[0] = (bf16_t)(w & 0xffffu); hp[st] = (bf16_t)(w >> 16); hp += 2 * st; } }
                    __builtin_amdgcn_sched_barrier(0); }
            return; }
        float w1[4], w2[4];
#pragma unroll
        for (int i = 0; i < 4; ++i) { w1[i] = khn[64 + 4 * fq + i]; w2[i] = khn[80 + 4 * fq + i]; }
#pragma unroll
        for (int ai = 0; ai < 2; ++ai)
#pragma unroll
          for (int mh = 0; mh < 4; mh += 1) {
            float x1[4][4], x2[4][4], cs[4][4], sn[4][4];
#pragma unroll
            for (int m = mh; m < mh + 1; ++m) { const int r = row0 + ai * 128 + m * 16;
                if (r >= 8192) { const int j = r - 8192; const float* kr = ckr + ((size_t)(((j >> 9) * 2 + layer) * 512 + (j & 511))) * 32 + 4 * fq;
                    const f32x4 a = *(const f32x4*)kr, b = *(const f32x4*)(kr + 16);
#pragma unroll
                    for (int i = 0; i < 4; ++i) { x1[m][i] = a[i]; x2[m][i] = b[i]; } }
                else { const bf16_t* kr = Z + (size_t)r * LDZ + ZMKR + 4 * fq; const u32x2 a = *(const u32x2*)kr, b = *(const u32x2*)(kr + 16);
                    x1[m][0] = lo16(a.x); x1[m][1] = hi16(a.x); x1[m][2] = lo16(a.y); x1[m][3] = hi16(a.y); x2[m][0] = lo16(b.x); x2[m][1] = hi16(b.x); x2[m][2] = lo16(b.y); x2[m][3] = hi16(b.y); }
                const bool rot = r >= 4096 && r < 8192; const int pos = (r - 4096) & 1023;
                if (rot) { const f32x4 c = *(const f32x4*)(R + pos * 16 + 4 * fq), s_ = *(const f32x4*)(R + 16384 + pos * 16 + 4 * fq);
#pragma unroll
                    for (int i = 0; i < 4; ++i) { cs[m][i] = c[i]; sn[m][i] = s_[i]; } }
                else {
#pragma unroll
                    for (int i = 0; i < 4; ++i) { cs[m][i] = 1.f; sn[m][i] = 0.f; } } }
#pragma unroll
            for (int m = mh; m < mh + 1; ++m) { const int r = row0 + ai * 128 + m * 16;
                float ss = 0.f;
#pragma unroll
                for (int bj = 0; bj < 2; ++bj)
#pragma unroll
                    for (int i = 0; i < 8; ++i) { const float v = acc[ai][bj][m][i >> 2][i & 3]; ss += v * v; }
#pragma unroll
                for (int i = 0; i < 4; ++i) ss += x1[m][i] * x1[m][i] + x2[m][i] * x2[m][i];
                ss += __shfl_xor(ss, 16); ss += __shfl_xor(ss, 32);
                const float rstd = rsqrtf(ss * (1.f / 96.f) + 1e-6f);
                bf16_t* kp = KF + (size_t)r * 384 + wc * 96;
#pragma unroll
                for (int bj = 0; bj < 2; ++bj) { u32x4 w; const f32x4 v0 = acc[ai][bj][m][0], v1 = acc[ai][bj][m][1];
                    w.x = pk2(v0[0] * rstd, v0[1] * rstd); w.y = pk2(v0[2] * rstd, v0[3] * rstd);
                    w.z = pk2(v1[0] * rstd, v1[1] * rstd); w.w = pk2(v1[2] * rstd, v1[3] * rstd);
                    *(u32x4*)(kp + 32 * bj + 8 * fq) = w; }
                float o1[4], o2[4];
#pragma unroll
                for (int i = 0; i < 4; ++i) { const float a = x1[m][i] * rstd * w1[i], b = x2[m][i] * rstd * w2[i]; o1[i] = a * cs[m][i] - b * sn[m][i]; o2[i] = a * sn[m][i] + b * cs[m][i]; }
                *(u32x2*)(kp + 64 + 4 * fq) = (u32x2){pk2(o1[0], o1[1]), pk2(o1[2], o1[3])}; *(u32x2*)(kp + 80 + 4 * fq) = (u32x2){pk2(o2[0], o2[1]), pk2(o2[2], o2[3])}; }
            __builtin_amdgcn_sched_barrier(0); }
    } };
struct EpiGLU { static constexpr bool PERM = true, AFTER_DRAIN = false; bf16_t* O; const bf16_t* Z; const float* bias;
    __device__ __forceinline__ void operator()(const f32x4 (&acc)[2][2][4][2], const Unit& u, int wr, int wc, int fr_, int fq_) const {
        int fr = fr_, fq = fq_; asm volatile("" : "+v"(fr), "+v"(fq));
        const int row0 = u.pm * 256 + wr * 64 + fr, oc = u.pn * 128 + wc * 32 + 8 * fq;
#pragma unroll
        for (int ai = 0; ai < 2; ++ai) {
            float bv[8], bg[8];
            { const f32x4 b0 = *(const f32x4*)(bias + oc), b1 = *(const f32x4*)(bias + oc + 4), g0 = *(const f32x4*)(bias + 512 + oc), g1 = *(const f32x4*)(bias + 512 + oc + 4);
#pragma unroll
              for (int i = 0; i < 4; ++i) { bv[i] = b0[i]; bv[4 + i] = b1[i]; bg[i] = g0[i]; bg[4 + i] = g1[i]; } }
            u32x4 sgv[2][4];
#pragma unroll
            for (int m = 0; m < 4; ++m) sgv[ai][m] = *(const u32x4*)(Z + (size_t)(row0 + ai * 128 + m * 16) * LDZ + ZSG + oc);
#pragma unroll
            for (int m = 0; m < 4; ++m) { const size_t r = (size_t)(row0 + ai * 128 + m * 16);
                const u32x4 sg = sgv[ai][m];
                float g[8] = { lo16(sg.x), hi16(sg.x), lo16(sg.y), hi16(sg.y), lo16(sg.z), hi16(sg.z), lo16(sg.w), hi16(sg.w) };
                float o[8];
#pragma unroll
                for (int i = 0; i < 8; ++i) { const float zv = acc[ai][0][m][i >> 2][i & 3] + bv[i], zg = acc[ai][1][m][i >> 2][i & 3] + bg[i]; o[i] = zv * sigmoidf_(zg) * siluf_(g[i]); }
                u32x4 w; w.x = pk2(o[0], o[1]); w.y = pk2(o[2], o[3]); w.z = pk2(o[4], o[5]); w.w = pk2(o[6], o[7]);
                *(u32x4*)(O + r * 512 + oc) = w; }
            __builtin_amdgcn_sched_barrier(0); }
    } };
struct EpiBo { static constexpr bool PERM = true, AFTER_DRAIN = false; bf16_t* MIX; const bf16_t* Z; int branch;
    __device__ __forceinline__ void operator()(const f32x4 (&acc)[2][2][4][2], const Unit& u, int wr, int wc, int fr_, int fq_) const {
        int fr = fr_, fq = fq_; asm volatile("" : "+v"(fr), "+v"(fq));
        const int row0 = u.pm * 256 + wr * 64 + fr, col0 = u.pn * 256 + wc * 32 + 8 * fq;
#pragma unroll
        for (int ai = 0; ai < 2; ++ai)
#pragma unroll
          for (int mh = 0; mh < 4; mh += 2) {
            u32x4 gz[4][2], pv[4][2];
#pragma unroll
            for (int m = mh; m < mh + 2; ++m)
#pragma unroll
                for (int bj = 0; bj < 2; ++bj) { const size_t r = (size_t)(row0 + ai * 128 + m * 16);
                    gz[m][bj] = *(const u32x4*)(Z + r * LDZ + ZMERGE + branch * 1024 + col0 + bj * 128);
                    pv[m][bj] = branch > 0 ? *(const u32x4*)(MIX + r * 1024 + col0 + bj * 128) : (u32x4){0u, 0u, 0u, 0u}; }
#pragma unroll
            for (int m = mh; m < mh + 2; ++m) { const size_t r = (size_t)(row0 + ai * 128 + m * 16);
#pragma unroll
                for (int bj = 0; bj < 2; ++bj) { const u32x4 sg = gz[m][bj], pp = pv[m][bj];
                    const float g[8] = { lo16(sg.x), hi16(sg.x), lo16(sg.y), hi16(sg.y), lo16(sg.z), hi16(sg.z), lo16(sg.w), hi16(sg.w) };
                    const float q[8] = { lo16(pp.x), hi16(pp.x), lo16(pp.y), hi16(pp.y), lo16(pp.z), hi16(pp.z), lo16(pp.w), hi16(pp.w) };
                    float o[8];
#pragma unroll
                    for (int i = 0; i < 8; ++i) o[i] = q[i] + sigmoidf_(g[i]) * acc[ai][bj][m][i >> 2][i & 3];
                    u32x4 w; w.x = pk2(o[0], o[1]); w.y = pk2(o[2], o[3]); w.z = pk2(o[4], o[5]); w.w = pk2(o[6], o[7]);
                    *(u32x4*)(MIX + r * 1024 + col0 + bj * 128) = w; } }
            __builtin_amdgcn_sched_barrier(0); }
    } };
struct EpiOut { static constexpr bool PERM = false, AFTER_DRAIN = false; float* Y; const float* xp; const float* xs; const float* ada;
    __device__ __forceinline__ void operator()(const f32x4 (&acc)[2][2][4][2], const Unit& u, int wr, int wc, int fr_, int fq_) const {
        int fr = fr_, fq = fq_; asm volatile("" : "+v"(fr), "+v"(fq));
        const int row0 = u.pm * 256 + wr * 64 + fr, col0 = u.pn * 256 + wc * 32 + 4 * fq;
        const int ar = u.pm < 16 ? 0 : 1 + ((u.pm - 16) >> 2);
        const float* gp = ada + ar * 3072 + 2048;
        f32x4 gv[2][2];
#pragma unroll
        for (int bj = 0; bj < 2; ++bj)
#pragma unroll
            for (int n = 0; n < 2; ++n) gv[bj][n] = *(const f32x4*)(gp + col0 + bj * 128 + n * 16);
#pragma unroll
        for (int ai = 0; ai < 2; ++ai)
#pragma unroll
          for (int mh = 0; mh < 4; mh += 2) {
            f32x4 xv[4][2][2];
#pragma unroll
            for (int m = mh; m < mh + 2; ++m) { const int r = row0 + ai * 128 + m * 16;
                const float* xr = (r < 4096 ? xp + (size_t)r * 1024 : xs + (size_t)(r - 4096) * 1024) + col0;
#pragma unroll
                for (int bj = 0; bj < 2; ++bj)
#pragma unroll
                    for (int n = 0; n < 2; ++n) xv[m][bj][n] = *(const f32x4*)(xr + bj * 128 + n * 16); }
#pragma unroll
            for (int m = mh; m < mh + 2; ++m) { const int r = row0 + ai * 128 + m * 16;
                float* yr = Y + (size_t)r * 1024 + col0;
#pragma unroll
                for (int bj = 0; bj < 2; ++bj)
#pragma unroll
                    for (int n = 0; n < 2; ++n) *(f32x4*)(yr + bj * 128 + n * 16) = xv[m][bj][n] + gv[bj][n] * acc[ai][bj][m][n]; }
            __builtin_amdgcn_sched_barrier(0); }
    } };

__device__ __forceinline__ void job_ada(const Params& p, int j, lds_t lds) {
    LAS float* sc = (LAS float*)lds; LAS float* red = sc + 5 * 1024;
    const int l = j / 96, c0 = (j % 96) * 32, tid = tid_opaque(p);
    for (int i = tid; i < 5 * 1024; i += 512) { const int r = i >> 10, k = i & 1023; const float v = r == 0 ? p.in[I_CCTX][k] : p.in[I_C][(r - 1) * 1024 + k]; sc[i] = v / (1.f + expf(-v)); }
    __syncthreads();
    const int col = tid & 31, kg = tid >> 5; const float* W = p.in[I_WADA] + (size_t)l * 1024 * 3072 + (size_t)(kg * 64) * 3072 + c0 + col;
    float a0 = 0.f, a1 = 0.f, a2 = 0.f, a3 = 0.f, a4 = 0.f;
#pragma unroll 1
    for (int kb = 0; kb < 64; kb += 16) { float w[16];
#pragma unroll
        for (int i = 0; i < 16; ++i) w[i] = W[(size_t)(kb + i) * 3072];
#pragma unroll
        for (int i = 0; i < 16; ++i) { const int k = kg * 64 + kb + i; a0 += sc[k] * w[i]; a1 += sc[1024 + k] * w[i]; a2 += sc[2048 + k] * w[i]; a3 += sc[3072 + k] * w[i]; a4 += sc[4096 + k] * w[i]; } }
    red[(kg * 5 + 0) * 32 + col] = a0; red[(kg * 5 + 1) * 32 + col] = a1; red[(kg * 5 + 2) * 32 + col] = a2; red[(kg * 5 + 3) * 32 + col] = a3; red[(kg * 5 + 4) * 32 + col] = a4;
    __syncthreads();
    if (tid < 160) { const int r = tid >> 5, cc = tid & 31; float s = p.in[I_BADA][l * 3072 + c0 + cc];
        for (int g = 0; g < 16; ++g) s += red[(g * 5 + r) * 32 + cc];
        ((float*)(p.ws + OFF_ADA))[(l * 5 + r) * 3072 + c0 + cc] = s; }
    __syncthreads();
}
__device__ __forceinline__ void job_ctx(const Params& p, int j) {
    const int base = j * 4096 + tid_opaque(p) * 8; const int l = base / (2048 * 256), rem = base % (2048 * 256), row = rem >> 8, c = rem & 255, b = row >> 9, jj = row & 511;
    const float* s = p.in[I_CKV] + ((size_t)((b * 2 + l) * 512 + jj)) * 256 + c;
    const f32x4 v0 = *(const f32x4*)s, v1 = *(const f32x4*)(s + 4);
    bf16_t* d = (bf16_t*)(p.ws + (l == 0 ? OFF_CTX0 : OFF_CTX1)) + (size_t)row * 256 + c;
    store8(d, v0, v1);
}
__device__ __forceinline__ void job_rope(const Params& p, int j) {
    const int idx = j * 512 + tid_opaque(p), pos = idx >> 4, i = idx & 15, f = i & 7;
    const float inv = powf(10000.f, -(float)f / 8.f); const float ang = (float)(i < 8 ? (pos >> 6) : (pos & 63)) * inv;
    float* R = (float*)(p.ws + OFF_ROPE); R[idx] = cosf(ang); R[16384 + idx] = sinf(ang);
}

__device__ __forceinline__ void job_prep(const Params& p, int l, int j) {
    const int tid = tid_opaque(p), wid = tid >> 6, lane = tid & 63, row = j * 8 + wid;
    const float* x = l == 0 ? (row < 4096 ? p.in[I_XP] + (size_t)row * 1024 : p.in[I_XS] + (size_t)(row - 4096) * 1024) : p.out + (size_t)row * 1024;
    const int ar = row < 4096 ? 0 : 1 + ((row - 4096) >> 10);
    const float* ada = (const float*)(p.ws + OFF_ADA) + (l * 5 + ar) * 3072; const float* nw = p.in[I_NORMW] + l * 1024;
    f32x4 v[4]; float ss = 0.f;
#pragma unroll
    for (int i = 0; i < 4; ++i) { v[i] = *(const f32x4*)(x + i * 256 + lane * 4); ss += v[i][0] * v[i][0] + v[i][1] * v[i][1] + v[i][2] * v[i][2] + v[i][3] * v[i][3]; }
#pragma unroll
    for (int o = 1; o < 64; o <<= 1) ss += __shfl_xor(ss, o);
    const float rstd = rsqrtf(ss * (1.f / 1024.f) + 1e-6f);
    bf16_t* h = (bf16_t*)(p.ws + OFF_HB) + (size_t)row * 1024;
#pragma unroll
    for (int i = 0; i < 4; ++i) { const int c = i * 256 + lane * 4; const f32x4 w = *(const f32x4*)(nw + c), sh = *(const f32x4*)(ada + c), sc = *(const f32x4*)(ada + 1024 + c);
        float o[4];
#pragma unroll
        for (int k = 0; k < 4; ++k) o[k] = v[i][k] * rstd * w[k] * (1.f + sc[k]) + sh[k];
        u32x2 pk; pk.x = pk2(o[0], o[1]); pk.y = pk2(o[2], o[3]); *(u32x2*)(h + c) = pk; }
}
__device__ __forceinline__ void wt_tile(const Params& p, const float* src, int ldsrc, int sbase, int nvalid, int mode, bf16_t* dst, int K, int n0, int k0, lds_t lds) {
    LAS float* t = (LAS float*)lds; const int tid = tid_opaque(p);
    const int nn = tid & 255, kh = tid >> 8; const int sc = mode == 0 ? sbase + nn : mode == 1 ? ((nn >> 7) & 1) * 512 + sbase + (nn & 127) : ((nn >> 5) & 3) * 64 + (nn >> 7) * 32 + (nn & 31); const bool ok = mode != 0 || nn < nvalid;
    float v[32];
#pragma unroll
    for (int i = 0; i < 32; ++i) v[i] = ok ? src[(size_t)(k0 + 2 * i + kh) * ldsrc + sc] : 0.f;
#pragma unroll
    for (int i = 0; i < 32; ++i) t[(2 * i + kh) * 257 + nn] = v[i];
    __syncthreads();
#pragma unroll
    for (int ps = 0; ps < 4; ++ps) { const int n = ps * 64 + (tid >> 3), kc = tid & 7; const LAS float* s = t + (kc * 8) * 257 + n; u32x4 w;
        w.x = pk2(s[0], s[257]); w.y = pk2(s[514], s[771]); w.z = pk2(s[1028], s[1285]); w.w = pk2(s[1542], s[1799]);
        *(u32x4*)(dst + (size_t)(n0 + n) * K + k0 + kc * 8) = w; }
    __syncthreads();
}
constexpr int WT_WIN = 27 * 16, WT_WUQ = 2 * 6, WT_WKV = 3 * 4, WT_WGLU = 4 * 8, WT_WBO = 4 * 8, WT_WOUT = 4 * 16, WT_EARLY = WT_WIN + WT_WUQ + WT_WKV + WT_WGLU, WT_TOTAL = WT_EARLY + 3 * WT_WBO + WT_WOUT;
__device__ __forceinline__ void job_wt(const Params& p, int l, int t, lds_t lds) {
    if (t < WT_WIN) { const int nt = t / 16, kt = t % 16; wt_tile(p, p.in[I_WIN] + (size_t)l * 1024 * 6848, 6848, nt * 256, 6848 - nt * 256, 0, (bf16_t*)(p.ws + OFF_WIN), 1024, nt * 256, kt * 64, lds); return; } t -= WT_WIN;
    if (t < WT_WUQ) { const int nt = t / 6, kt = t % 6; wt_tile(p, p.in[I_WUQ] + (size_t)l * 384 * 384, 384, nt * 256, 384 - nt * 256, 0, (bf16_t*)(p.ws + OFF_WUQ), 384, nt * 256, kt * 64, lds); return; } t -= WT_WUQ;
    if (t < WT_WKV) { const int nt = t / 4, kt = t % 4;
        if (nt == 0) wt_tile(p, p.in[I_WUK] + (size_t)l * 256 * 256, 256, 0, 256, 2, (bf16_t*)(p.ws + OFF_WKV), 256, 0, kt * 64, lds);
        else wt_tile(p, p.in[I_WUV] + (size_t)l * 256 * 512, 512, (nt - 1) * 256, 256, 0, (bf16_t*)(p.ws + OFF_WKV), 256, nt * 256, kt * 64, lds);
        return; } t -= WT_WKV;
    if (t < WT_WGLU) { const int nt = t / 8, kt = t % 8; wt_tile(p, p.in[I_WGLU] + (size_t)l * 512 * 1024, 1024, nt * 128, 256, 1, (bf16_t*)(p.ws + OFF_WGLU), 512, nt * 256, kt * 64, lds); return; } t -= WT_WGLU;
    if (t < 3 * WT_WBO) { const int br = t / WT_WBO, tt = t % WT_WBO, nt = tt / 8, kt = tt % 8;
        wt_tile(p, p.in[I_WBOG + br] + (size_t)l * 512 * 1024, 1024, nt * 256, 256, 0, (bf16_t*)(p.ws + OFF_WBO) + (size_t)br * 1024 * 512, 512, nt * 256, kt * 64, lds); return; } t -= 3 * WT_WBO;
    { const int nt = t / 16, kt = t % 16; wt_tile(p, p.in[I_WOUT] + (size_t)l * 1024 * 1024, 1024, nt * 256, 256, 0, (bf16_t*)(p.ws + OFF_WOUT), 1024, nt * 256, kt * 64, lds); }
}
__device__ __forceinline__ void job_s5setup(const Params& p, int l, int j, lds_t lds) {
    const int g = j / 3, which = j % 3, tid = tid_opaque(p);
    LAS f32x2_t* pw = (LAS f32x2_t*)lds;
    LAS f32x2_t* Bt = pw + 2 * 17 * 64;
    LAS f32x2_t* Cn = Bt + 2 * 64 * 16;
    LAS float* Kt = (LAS float*)(Cn + 64 * 16);
    LAS float* raw = Kt + 8192;
    { const size_t gb = (size_t)(l * 32 + g) * 1024;
      for (int i = tid; i < 1024; i += 512) { raw[i] = p.in[I_BRE][gb + i]; raw[1024 + i] = p.in[I_BIM][gb + i]; raw[2048 + i] = p.in[I_CRE][gb + i]; raw[3072 + i] = p.in[I_CIM][gb + i]; }
      if (tid < 128) { const int d = tid >> 6, n = tid & 63; raw[4096 + tid] = p.in[I_ARE][((l * 2 + d) * 32 + g) * 64 + n]; raw[4224 + tid] = p.in[I_AIM][((l * 2 + d) * 32 + g) * 64 + n]; }
      if (tid < 2) raw[4352 + tid] = p.in[I_LOGDT][(l * 2 + tid) * 32 + g]; }
    __syncthreads();
    if (tid < 128) { const int d = tid >> 6, n = tid & 63;
        const float dt = expf(raw[4352 + d]);
        const float are = raw[4096 + tid], aim = raw[4224 + tid];
        for (int tau = 0; tau <= 16; ++tau) { const float mag = expf(are * dt * (float)tau); float s, c; sincosf(aim * dt * (float)tau, &s, &c); pw[(d * 17 + tau) * 64 + n] = (f32x2_t){mag * c, mag * s}; }
        float s1, c1; sincosf(aim * dt, &s1, &c1); float sh = sinf(0.5f * aim * dt);
        const float em1 = expm1f(are * dt), mag1 = em1 + 1.f;
        const float nre = em1 * c1 - 2.f * sh * sh, abim = mag1 * s1, den = are * are + aim * aim;
        const float cfr = (nre * are + abim * aim) / den, cfi = (abim * are - nre * aim) / den;
        for (int q = 0; q < 16; ++q) { const float br = raw[n * 16 + q], bi = raw[1024 + n * 16 + q];
            Bt[(d * 64 + n) * 16 + q] = (f32x2_t){cfr * br - cfi * bi, cfr * bi + cfi * br}; }
        if (which == 1) ((f32x2_t*)(p.ws + OFF_P16))[(g * 2 + d) * 64 + n] = pw[(d * 17 + 16) * 64 + n];
    }
    for (int i = tid; i < 1024; i += 512) { const int n = i >> 4, pp = i & 15; Cn[i] = (f32x2_t){raw[2048 + pp * 64 + n], raw[3072 + pp * 64 + n]}; }
    __syncthreads();
    bf16_t* M = (bf16_t*)(p.ws + OFF_S5M) + (size_t)(g * 3 + which) * 65536;
    if (which == 0) {
        for (int i = tid; i < 8192; i += 512) { const int d = i >> 12, tau = (i >> 8) & 15, pp = (i >> 4) & 15, q = i & 15; float s = 0.f;
#pragma unroll 16
            for (int n = 0; n < 64; ++n) { const f32x2_t c = Cn[n * 16 + pp], w = pw[(d * 17 + tau) * 64 + n], b = Bt[(d * 64 + n) * 16 + q];
                const float cwr = c.x * w.x - c.y * w.y, cwi = c.x * w.y + c.y * w.x; s += cwr * b.x - cwi * b.y; }
            Kt[i] = s; }
        __syncthreads();
#pragma unroll 8
        for (int i = tid; i < 65536; i += 512) { const int no = i >> 8, k = i & 255, t = no >> 4, pp = no & 15, s = k >> 4, q = k & 15; float v;
            if (t > s) v = Kt[(0 * 16 + (t - s)) * 256 + pp * 16 + q];
            else if (t < s) v = Kt[(1 * 16 + (s - t)) * 256 + pp * 16 + q];
            else { v = Kt[pp * 16 + q] + Kt[16 * 256 + pp * 16 + q]; if (pp == q) v += p.in[I_S5D][l * 512 + g * 16 + pp]; }
            M[i] = f2bf(v); }
    } else if (which == 1) {
#pragma unroll 8
        for (int i = tid; i < 65536; i += 512) { const int no = i >> 8, k = i & 255, d = no >> 7, ri = (no >> 6) & 1, n = no & 63, s = k >> 4, q = k & 15; const int e = d == 0 ? 15 - s : s;
            const f32x2_t w = pw[(d * 17 + e) * 64 + n], b = Bt[(d * 64 + n) * 16 + q];
            M[i] = f2bf(ri == 0 ? w.x * b.x - w.y * b.y : w.x * b.y + w.y * b.x); }
    } else {
#pragma unroll 8
        for (int i = tid; i < 65536; i += 512) { const int no = i >> 8, k = i & 255, t = no >> 4, pp = no & 15, d = k >> 7, ri = (k >> 6) & 1, n = k & 63; const int e = d == 0 ? t + 1 : 16 - t;
            const f32x2_t c = Cn[n * 16 + pp], w = pw[(d * 17 + e) * 64 + n];
            M[i] = f2bf(ri == 0 ? c.x * w.x - c.y * w.y : -(c.x * w.y + c.y * w.x)); }
    }
    __syncthreads();
}

__device__ __forceinline__ float gelu_tanh(float x) { const float u = 0.7978845608f * (x + 0.044715f * x * x * x); const float t = 1.f - 2.f / (1.f + __expf(2.f * u)); return 0.5f * x * (1.f + t); }
__device__ __forceinline__ void job_s5(const Params& p, int l, int j, lds_t lds) {
    const int tid = tid_opaque(p), wid = tid >> 6, lane = tid & 63, lr = lane & 15, lq = lane >> 4;
    int bb, g; if (j < 128) { bb = 16 + (j >> 5); g = j & 31; } else { bb = (j - 128) >> 5; g = (j - 128) & 31; }
    const int M = bb < 16 ? 16 : 64, MT = M >> 4; const int tok0 = bb < 16 ? bb * 256 : 4096 + (bb - 16) * 1024;
    LAS bf16_t* Us = (LAS bf16_t*)lds; LAS bf16_t* Xs = Us + 64 * 264; LAS float* Xin = (LAS float*)(lds + 2 * 64 * 264 * 2);
    const bf16_t* Z = (const bf16_t*)(p.ws + OFF_Z);
    const bf16_t* TT = (const bf16_t*)(p.ws + OFF_S5M) + (size_t)(g * 3) * 65536; const bf16_t* G = TT + 65536; const bf16_t* Cc = G + 65536;
    bf16x8 bq[8][2];
#pragma unroll
    for (int ks = 0; ks < 8; ++ks) { bq[ks][0] = *(const bf16x8*)(G + (size_t)(wid * 32 + lr) * 256 + ks * 32 + lq * 8); bq[ks][1] = *(const bf16x8*)(G + (size_t)(wid * 32 + 16 + lr) * 256 + ks * 32 + lq * 8); }
    f32x2_t a16 = {0.f, 0.f}; float xr = 0.f, xi = 0.f;
    if (tid < 128) { const int d = tid >> 6, n = tid & 63; a16 = ((const f32x2_t*)(p.ws + OFF_P16))[(g * 2 + d) * 64 + n];
        if (bb >= 16) { const size_t o = ((size_t)(((bb - 16) * 2 + l) * 2 + d) * 2) * 2048 + g * 64 + n; xr = p.in[I_SS5][o]; xi = p.in[I_SS5][o + 2048]; } }
    for (int idx = tid; idx < M * 32; idx += 512) { const int tok = idx >> 1, hf = idx & 1;
        *(LAS u32x4*)(Us + (tok >> 4) * 264 + (tok & 15) * 16 + hf * 8) = *(const u32x4*)(Z + (size_t)(tok0 + tok) * LDZ + ZSU + g * 16 + hf * 8); }
    __syncthreads();
    f32x4 acc[4][2];
#pragma unroll
    for (int a = 0; a < 4; ++a) { acc[a][0] = (f32x4){0.f, 0.f, 0.f, 0.f}; acc[a][1] = acc[a][0]; }
#pragma unroll
    for (int ks = 0; ks < 8; ++ks)
#pragma unroll
        for (int mt = 0; mt < 4; ++mt) if (mt < MT) { const bf16x8 a = LDSFRAG(Us + (mt * 16 + lr) * 264 + ks * 32 + lq * 8); acc[mt][0] = MFMA16(a, bq[ks][0], acc[mt][0]); acc[mt][1] = MFMA16(a, bq[ks][1], acc[mt][1]); }
    bf16x8 bc[8][2];
#pragma unroll
    for (int ks = 0; ks < 8; ++ks) { bq[ks][0] = *(const bf16x8*)(TT + (size_t)(wid * 32 + lr) * 256 + ks * 32 + lq * 8); bq[ks][1] = *(const bf16x8*)(TT + (size_t)(wid * 32 + 16 + lr) * 256 + ks * 32 + lq * 8);
        bc[ks][0] = *(const bf16x8*)(Cc + (size_t)(wid * 32 + lr) * 256 + ks * 32 + lq * 8); bc[ks][1] = *(const bf16x8*)(Cc + (size_t)(wid * 32 + 16 + lr) * 256 + ks * 32 + lq * 8); }
#pragma unroll
    for (int mt = 0; mt < 4; ++mt) if (mt < MT)
#pragma unroll
        for (int ct = 0; ct < 2; ++ct)
#pragma unroll
            for (int r = 0; r < 4; ++r) Xin[(mt * 16 + lq * 4 + r) * 260 + wid * 32 + ct * 16 + lr] = acc[mt][ct][r];
    __syncthreads();
    if (tid < 128) { const int d = tid >> 6, n = tid & 63;
        const int cre = d * 128 + n, cim = cre + 64;
        for (int i = 0; i < M; ++i) { const int c = d == 0 ? i : M - 1 - i;
            Xs[c * 264 + cre] = f2bf(xr); Xs[c * 264 + cim] = f2bf(xi);
            const float ur = Xin[c * 260 + cre], ui = Xin[c * 260 + cim];
            const float nr = a16.x * xr - a16.y * xi + ur, ni = a16.x * xi + a16.y * xr + ui; xr = nr; xi = ni; }
        if (bb < 16) { const size_t o = OUT_S5 + ((size_t)((bb * 2 + l) * 2 + d) * 2) * 2048 + g * 64 + n; p.out[o] = xr; p.out[o + 2048] = xi; }
    }
    __syncthreads();
#pragma unroll
    for (int a = 0; a < 4; ++a) { acc[a][0] = (f32x4){0.f, 0.f, 0.f, 0.f}; acc[a][1] = acc[a][0]; }
#pragma unroll
    for (int ks = 0; ks < 8; ++ks)
#pragma unroll
        for (int mt = 0; mt < 4; ++mt) if (mt < MT) { const bf16x8 a = LDSFRAG(Us + (mt * 16 + lr) * 264 + ks * 32 + lq * 8); acc[mt][0] = MFMA16(a, bq[ks][0], acc[mt][0]); acc[mt][1] = MFMA16(a, bq[ks][1], acc[mt][1]); }
#pragma unroll
    for (int ks = 0; ks < 8; ++ks)
#pragma unroll
        for (int mt = 0; mt < 4; ++mt) if (mt < MT) { const bf16x8 a = LDSFRAG(Xs + (mt * 16 + lr) * 264 + ks * 32 + lq * 8); acc[mt][0] = MFMA16(a, bc[ks][0], acc[mt][0]); acc[mt][1] = MFMA16(a, bc[ks][1], acc[mt][1]); }
    bf16_t* Yg = (bf16_t*)(p.ws + OFF_YG);
#pragma unroll
    for (int mt = 0; mt < 4; ++mt) if (mt < MT)
#pragma unroll
        for (int ct = 0; ct < 2; ++ct)
#pragma unroll
            for (int r = 0; r < 4; ++r) { const int chunk = mt * 16 + lq * 4 + r, t = wid * 2 + ct;
                Yg[(size_t)(tok0 + chunk * 16 + t) * 512 + g * 16 + lr] = f2bf(gelu_tanh(acc[mt][ct][r])); }
    __syncthreads();
}
__device__ __forceinline__ void job_mlaprep(const Params& p, int l, int j) {
    const int tid = tid_opaque(p), wid = tid >> 6, lane = tid & 63, row = j * 8 + wid;
    const bf16_t* z = (const bf16_t*)(p.ws + OFF_Z) + (size_t)row * LDZ;
    float q[6], kv[4]; float sq = 0.f, sk = 0.f;
#pragma unroll
    for (int i = 0; i < 6; ++i) { q[i] = bf2f(z[ZMQ + i * 64 + lane]); sq += q[i] * q[i]; }
#pragma unroll
    for (int i = 0; i < 4; ++i) { kv[i] = bf2f(z[ZMKV + i * 64 + lane]); sk += kv[i] * kv[i]; }
#pragma unroll
    for (int o = 1; o < 64; o <<= 1) { sq += __shfl_xor(sq, o); sk += __shfl_xor(sk, o); }
    const float rq = rsqrtf(sq * (1.f / 384.f) + 1e-6f), rk = rsqrtf(sk * (1.f / 256.f) + 1e-6f);
    bf16_t* aq = (bf16_t*)(p.ws + OFF_AQ) + (size_t)row * 384; bf16_t* ck = (bf16_t*)(p.ws + OFF_CKVN) + (size_t)row * 256;
#pragma unroll
    for (int i = 0; i < 6; ++i) aq[i * 64 + lane] = f2bf(q[i] * rq * p.in[I_QNORM][l * 384 + i * 64 + lane]);
    const bool prompt = row < 4096; const int b = row >> 8, t = row & 255;
#pragma unroll
    for (int i = 0; i < 4; ++i) { const float v = kv[i] * rk * p.in[I_KVNORM][l * 256 + i * 64 + lane]; ck[i * 64 + lane] = f2bf(v);
        if (prompt) p.out[OUT_CKV + ((size_t)((b * 2 + l) * 256 + t)) * 256 + i * 64 + lane] = v; }
    if (prompt && lane < 32) p.out[OUT_KR + ((size_t)((b * 2 + l) * 256 + t)) * 32 + lane] = bf2f(z[ZMKR + lane]);
}
__device__ __forceinline__ float logsigmoidf_(float x) { return fminf(x, 0.f) - __logf(1.f + __expf(-fabsf(x))); }
__device__ __forceinline__ void job_glaA(const Params& p, int l, int j, lds_t lds) {
    const int tid = tid_opaque(p), wid = tid >> 6, lane = tid & 63, lr = lane & 15, lq = lane >> 4;
    const int ck = j >> 2, h = j & 3, tok0 = ck * 64;
    LAS bf16_t* QDf = (LAS bf16_t*)lds; LAS bf16_t* QDb = QDf + 4608; LAS bf16_t* KDf = QDb + 4608; LAS bf16_t* KDb = KDf + 4608; LAS bf16_t* KRf = KDb + 4608; LAS bf16_t* KRb = KRf + 4608;
    LAS bf16_t* VT = KRb + 4608;
    LAS bf16_t* ATT = VT + 9216;
    LAS float* GA = (LAS float*)(ATT + 4608);
    LAS float* TOT = GA + 2048;
    const bf16_t* Z = (const bf16_t*)(p.ws + OFF_Z);
    { const int c = tid >> 3, part = tid & 7; const u32x2 gv = *(const u32x2*)(Z + (size_t)(tok0 + c) * LDZ + ZGA + part * 4);
      GA[c * 32 + part * 4 + 0] = lo16(gv.x); GA[c * 32 + part * 4 + 1] = hi16(gv.x); GA[c * 32 + part * 4 + 2] = lo16(gv.y); GA[c * 32 + part * 4 + 3] = hi16(gv.y);
      const bf16_t* vp = Z + (size_t)(tok0 + c) * LDZ + ZV + h * 128 + part * 16;
      const u32x4 v0 = *(const u32x4*)vp, v1 = *(const u32x4*)(vp + 8);
      const unsigned w[8] = { v0.x, v0.y, v0.z, v0.w, v1.x, v1.y, v1.z, v1.w };
#pragma unroll
      for (int i = 0; i < 8; ++i) { VT[(part * 16 + 2 * i) * 72 + c] = (bf16_t)(w[i] & 0xffffu); VT[(part * 16 + 2 * i + 1) * 72 + c] = (bf16_t)(w[i] >> 16); } }
    __syncthreads();
    const int d = tid & 63, cg_ = tid >> 6;
    float laf[8], lab[8]; bf16_t qraw[8], kraw[8];
#pragma unroll
    for (int i = 0; i < 8; ++i) { const size_t zr = (size_t)(tok0 + cg_ * 8 + i) * LDZ; qraw[i] = Z[zr + ZQ + h * 64 + d]; kraw[i] = Z[zr + ZK + h * 64 + d]; }
    { float wf[16], wb[16];
#pragma unroll
      for (int r = 0; r < 16; ++r) { wf[r] = p.in[I_WA2][((size_t)((l * 2 + 0) * 16 + r)) * 256 + h * 64 + d]; wb[r] = p.in[I_WA2][((size_t)((l * 2 + 1) * 16 + r)) * 256 + h * 64 + d]; }
      const float bf_ = p.in[I_BA][(l * 2 + 0) * 256 + h * 64 + d], bb_ = p.in[I_BA][(l * 2 + 1) * 256 + h * 64 + d];
#pragma unroll
      for (int i = 0; i < 8; ++i) { const int c = cg_ * 8 + i; float xf = bf_, xb = bb_;
#pragma unroll
          for (int r = 0; r < 16; ++r) { xf += GA[c * 32 + r] * wf[r]; xb += GA[c * 32 + 16 + r] * wb[r]; }
          laf[i] = logsigmoidf_(xf) * (1.f / 16.f); lab[i] = logsigmoidf_(xb) * (1.f / 16.f); } }
#pragma unroll
    for (int i = 1; i < 8; ++i) laf[i] += laf[i - 1];
#pragma unroll
    for (int i = 6; i >= 0; --i) lab[i] += lab[i + 1];
    TOT[(0 * 8 + cg_) * 64 + d] = laf[7]; TOT[(1 * 8 + cg_) * 64 + d] = lab[0];
    __syncthreads();
    float offf = 0.f, offb = 0.f, Tf = 0.f, Tb = 0.f;
#pragma unroll
    for (int g = 0; g < 8; ++g) { const float a = TOT[g * 64 + d], b = TOT[(8 + g) * 64 + d]; Tf += a; Tb += b; if (g < cg_) offf += a; if (g > cg_) offb += b; }
    bf16_t* QD = (bf16_t*)(p.ws + OFF_QD);
#pragma unroll
    for (int i = 0; i < 8; ++i) { const int c = cg_ * 8 + i;
        const float q = bf2f(qraw[i]) * 0.125f, k = bf2f(kraw[i]);
        const float bf_ = offf + laf[i], bb_ = offb + lab[i];
        const bf16_t qf = f2bf(q * __expf(bf_)), qb = f2bf(q * __expf(bb_));
        QDf[c * 72 + d] = qf; QDb[c * 72 + d] = qb;
        KDf[c * 72 + d] = f2bf(k * __expf(-bf_)); KDb[c * 72 + d] = f2bf(k * __expf(-bb_));
        KRf[d * 72 + c] = f2bf(k * __expf(Tf - bf_)); KRb[d * 72 + c] = f2bf(k * __expf(Tb - bb_));
        QD[(size_t)(tok0 + c) * 256 + h * 64 + d] = qf; QD[(size_t)(8192 + tok0 + c) * 256 + h * 64 + d] = qb; }
    if (cg_ == 0) { float* DEC = (float*)(p.ws + OFF_DEC); DEC[((0 * 128 + ck) * 4 + h) * 64 + d] = __expf(Tf); DEC[((1 * 128 + ck) * 4 + h) * 64 + d] = __expf(Tb); }
    __syncthreads();
#pragma unroll
    for (int q2 = 0; q2 < 2; ++q2) { const int tt = wid * 2 + q2, ti = tt >> 2, tj = tt & 3; f32x4 af = {0.f, 0.f, 0.f, 0.f}, ab = af;
#pragma unroll
        for (int ks = 0; ks < 2; ++ks) { const int ko = ks * 32 + lq * 8;
            af = MFMA16(LDSFRAG(QDf + (ti * 16 + lr) * 72 + ko), LDSFRAG(KDf + (tj * 16 + lr) * 72 + ko), af);
            ab = MFMA16(LDSFRAG(QDb + (ti * 16 + lr) * 72 + ko), LDSFRAG(KDb + (tj * 16 + lr) * 72 + ko), ab); }
#pragma unroll
        for (int r = 0; r < 4; ++r) { const int c = ti * 16 + lq * 4 + r, s = tj * 16 + lr; const float v = (s <= c ? af[r] : 0.f) + (s >= c ? ab[r] : 0.f); ATT[c * 72 + s] = f2bf(v); } }
    __syncthreads();
    bf16x8 vb[2];
#pragma unroll
    for (int ks = 0; ks < 2; ++ks) vb[ks] = LDSFRAG(VT + (wid * 16 + lr) * 72 + ks * 32 + lq * 8);
    bf16_t* OI = (bf16_t*)(p.ws + OFF_OIB); bf16_t* KV = (bf16_t*)(p.ws + OFF_KV);
#pragma unroll
    for (int ct = 0; ct < 4; ++ct) { f32x4 a = {0.f, 0.f, 0.f, 0.f};
#pragma unroll
        for (int ks = 0; ks < 2; ++ks) a = MFMA16(LDSFRAG(ATT + (ct * 16 + lr) * 72 + ks * 32 + lq * 8), vb[ks], a);
#pragma unroll
        for (int r = 0; r < 4; ++r) OI[(size_t)(tok0 + ct * 16 + lq * 4 + r) * 512 + h * 128 + wid * 16 + lr] = f2bf(a[r]); }
#pragma unroll
    for (int dir = 0; dir < 2; ++dir) { const LAS bf16_t* KR = dir == 0 ? KRf : KRb; bf16_t* kvp = KV + ((size_t)((dir * 128 + ck) * 4 + h)) * 8192;
#pragma unroll
        for (int dt = 0; dt < 4; ++dt) { f32x4 a = {0.f, 0.f, 0.f, 0.f};
#pragma unroll
            for (int ks = 0; ks < 2; ++ks) a = MFMA16(LDSFRAG(KR + (dt * 16 + lr) * 72 + ks * 32 + lq * 8), vb[ks], a);
#pragma unroll
            for (int r = 0; r < 4; ++r) kvp[(dt * 16 + lq * 4 + r) * 128 + wid * 16 + lr] = f2bf(a[r]); } }
    __syncthreads();
}

__device__ __forceinline__ void job_glaB(const Params& p, int l, int j) {
    const int qt = j & 3, h = (j >> 2) & 3, rest = j >> 4, bb = rest % 20, dir = rest / 20;
    const int idx0 = qt * 2048 + tid_opaque(p);
    const int nck = bb < 16 ? 4 : 16, ck0 = bb < 16 ? bb * 4 : 64 + (bb - 16) * 16;
    float S[4];
#pragma unroll
    for (int e = 0; e < 4; ++e) S[e] = bb >= 16 ? p.in[I_SGLA][((size_t)((((bb - 16) * 2 + l) * 2 + dir) * 4 + h)) * 8192 + idx0 + e * 512] : 0.f;
    const bf16_t* KV = (const bf16_t*)(p.ws + OFF_KV); const float* DEC = (const float*)(p.ws + OFF_DEC); bf16_t* ST = (bf16_t*)(p.ws + OFF_ST);
    for (int i0 = 0; i0 < nck; i0 += 4) { float dv[4][4]; bf16_t kv[4][4]; size_t its[4];
#pragma unroll
        for (int u = 0; u < 4; ++u) { const int i = i0 + u, ck = dir == 0 ? ck0 + i : ck0 + nck - 1 - i; its[u] = (size_t)((dir * 128 + ck) * 4 + h);
#pragma unroll
            for (int e = 0; e < 4; ++e) { const int idx = idx0 + e * 512; dv[u][e] = DEC[its[u] * 64 + (idx >> 7)]; kv[u][e] = KV[its[u] * 8192 + idx]; } }
#pragma unroll
        for (int u = 0; u < 4; ++u)
#pragma unroll
            for (int e = 0; e < 4; ++e) { ST[its[u] * 8192 + idx0 + e * 512] = f2bf(S[e]); S[e] = dv[u][e] * S[e] + bf2f(kv[u][e]); } }
    if (bb < 16) {
#pragma unroll
        for (int e = 0; e < 4; ++e) p.out[OUT_GLA + ((size_t)(((bb * 2 + l) * 2 + dir) * 4 + h)) * 8192 + idx0 + e * 512] = S[e]; }
}

__device__ __forceinline__ void job_glaC(const Params& p, int l, int j, lds_t lds) {
    const int tid = tid_opaque(p), wid = tid >> 6, lane = tid & 63, lr = lane & 15, lq = lane >> 4;
    const int ck = j >> 2, h = j & 3, tok0 = ck * 64;
    LAS bf16_t* Aq = (LAS bf16_t*)lds;
    LAS bf16_t* BT = Aq + 64 * 136;
    LAS float* Os = (LAS float*)(BT + 128 * 136);
    const bf16_t* QD = (const bf16_t*)(p.ws + OFF_QD); const bf16_t* ST = (const bf16_t*)(p.ws + OFF_ST);
#pragma unroll
    for (int it = 0; it < 2; ++it) { const int idx = tid + it * 512, c = idx >> 4, rem = idx & 15, dir = rem >> 3, dc = rem & 7;
        *(LAS u32x4*)(Aq + c * 136 + dir * 64 + dc * 8) = *(const u32x4*)(QD + (size_t)(dir * 8192 + tok0 + c) * 256 + h * 64 + dc * 8); }
#pragma unroll
    for (int it = 0; it < 4; ++it) { const int idx = tid + it * 512, dir = idx >> 10, d = (idx >> 4) & 63, ec = idx & 15;
        const u32x4 v = *(const u32x4*)(ST + ((size_t)((dir * 128 + ck) * 4 + h)) * 8192 + d * 128 + ec * 8);
        const unsigned w[4] = { v.x, v.y, v.z, v.w };
#pragma unroll
        for (int i = 0; i < 4; ++i) { BT[(ec * 8 + 2 * i) * 136 + dir * 64 + d] = (bf16_t)(w[i] & 0xffffu); BT[(ec * 8 + 2 * i + 1) * 136 + dir * 64 + d] = (bf16_t)(w[i] >> 16); } }
    __syncthreads();
    const int ct = wid & 3, eh = wid >> 2; const bf16_t* OI = (const bf16_t*)(p.ws + OFF_OIB);
    float oi[4][4];
#pragma unroll
    for (int e4 = 0; e4 < 4; ++e4)
#pragma unroll
        for (int r = 0; r < 4; ++r) oi[e4][r] = bf2f(OI[(size_t)(tok0 + ct * 16 + lq * 4 + r) * 512 + h * 128 + (eh * 4 + e4) * 16 + lr]);
    bf16x8 af[4];
#pragma unroll
    for (int ks = 0; ks < 4; ++ks) af[ks] = LDSFRAG(Aq + (ct * 16 + lr) * 136 + ks * 32 + lq * 8);
#pragma unroll
    for (int e4 = 0; e4 < 4; ++e4) { const int et = eh * 4 + e4; f32x4 a = {0.f, 0.f, 0.f, 0.f};
#pragma unroll
        for (int ks = 0; ks < 4; ++ks) a = MFMA16(af[ks], LDSFRAG(BT + (et * 16 + lr) * 136 + ks * 32 + lq * 8), a);
#pragma unroll
        for (int r = 0; r < 4; ++r) { const int row = ct * 16 + lq * 4 + r, col = et * 16 + lr; Os[row * 132 + col] = a[r] + oi[e4][r]; } }
    __syncthreads();
    { const int c = tid >> 3, part = tid & 7; float o[16]; float ss = 0.f;
#pragma unroll
      for (int i = 0; i < 16; ++i) { o[i] = Os[c * 132 + part * 16 + i]; ss += o[i] * o[i]; }
      ss += __shfl_xor(ss, 1); ss += __shfl_xor(ss, 2); ss += __shfl_xor(ss, 4);
      const float rstd = rsqrtf(ss * (1.f / 128.f) + 1e-6f);
      const bf16_t* gz = (const bf16_t*)(p.ws + OFF_Z) + (size_t)(tok0 + c) * LDZ + ZGG + h * 128 + part * 16;
      const u32x4 g0 = *(const u32x4*)gz, g1 = *(const u32x4*)(gz + 8);
      const unsigned gw[8] = { g0.x, g0.y, g0.z, g0.w, g1.x, g1.y, g1.z, g1.w };
      unsigned ow[8];
#pragma unroll
      for (int i = 0; i < 8; ++i) { const float n0 = p.in[I_ONORM][l * 128 + part * 16 + 2 * i], n1 = p.in[I_ONORM][l * 128 + part * 16 + 2 * i + 1];
          ow[i] = pk2(o[2 * i] * rstd * n0 * siluf_(lo16(gw[i])), o[2 * i + 1] * rstd * n1 * siluf_(hi16(gw[i]))); }
      bf16_t* ap = (bf16_t*)(p.ws + OFF_AGLA) + (size_t)(tok0 + c) * 512 + h * 128 + part * 16;
      *(u32x4*)ap = (u32x4){ow[0], ow[1], ow[2], ow[3]}; *(u32x4*)(ap + 8) = (u32x4){ow[4], ow[5], ow[6], ow[7]}; }
    __syncthreads();
}
__device__ __forceinline__ void head_row_finish(float (&x)[16], int p8, const float* nw, const float* nw2, bool rope, int pos, const float* R, float mul, LAS bf16_t* dst) {
    float ss = 0.f; const int cnt = p8 < 4 ? 16 : 8;
#pragma unroll
    for (int i = 0; i < 16; ++i) if (i < cnt) ss += x[i] * x[i];
    ss += __shfl_xor(ss, 1); ss += __shfl_xor(ss, 2); ss += __shfl_xor(ss, 4);
    const float rstd = rsqrtf(ss * (1.f / 96.f) + 1e-6f) * mul;
    if (p8 < 4) { unsigned w[8];
#pragma unroll
        for (int i = 0; i < 8; ++i) w[i] = pk2(x[2 * i] * rstd * nw[p8 * 16 + 2 * i] * nw2[p8 * 16 + 2 * i], x[2 * i + 1] * rstd * nw[p8 * 16 + 2 * i + 1] * nw2[p8 * 16 + 2 * i + 1]);
        *(LAS u32x4*)(dst + p8 * 16) = (u32x4){w[0], w[1], w[2], w[3]}; *(LAS u32x4*)(dst + p8 * 16 + 8) = (u32x4){w[4], w[5], w[6], w[7]};
    } else { const int i0 = (p8 - 4) * 4; float o1[4], o2[4];
#pragma unroll
        for (int i = 0; i < 4; ++i) { const float a = x[i] * rstd * nw[64 + i0 + i], b = x[4 + i] * rstd * nw[80 + i0 + i];
            if (rope) { const float c = R[pos * 16 + i0 + i], s = R[16384 + pos * 16 + i0 + i]; o1[i] = a * c - b * s; o2[i] = a * s + b * c; } else { o1[i] = a; o2[i] = b; } }
        *(LAS u32x2*)(dst + 64 + i0) = (u32x2){pk2(o1[0], o1[1]), pk2(o1[2], o1[3])}; *(LAS u32x2*)(dst + 80 + i0) = (u32x2){pk2(o2[0], o2[1]), pk2(o2[2], o2[3])}; }
}
__device__ __forceinline__ void ld16bf(const bf16_t* s, float (&x)[16]) { const u32x4 a = *(const u32x4*)s, b = *(const u32x4*)(s + 8);
    x[0] = lo16(a.x); x[1] = hi16(a.x); x[2] = lo16(a.y); x[3] = hi16(a.y); x[4] = lo16(a.z); x[5] = hi16(a.z); x[6] = lo16(a.w); x[7] = hi16(a.w);
    x[8] = lo16(b.x); x[9] = hi16(b.x); x[10] = lo16(b.y); x[11] = hi16(b.y); x[12] = lo16(b.z); x[13] = hi16(b.z); x[14] = lo16(b.w); x[15] = hi16(b.w); }
__device__ __forceinline__ void ld4bf(const bf16_t* s, float* x) { const u32x2 a = *(const u32x2*)s; x[0] = lo16(a.x); x[1] = hi16(a.x); x[2] = lo16(a.y); x[3] = hi16(a.y); }
__device__ __forceinline__ void job_attn(const Params& p, int l, int j, lds_t lds) {
    const int tid = tid_opaque(p), wid = tid >> 6, lane = tid & 63, lr = lane & 15, lq = lane >> 4;
    const bool smp = j < 256; int b, h, qb; if (smp) { b = j >> 6; h = (j >> 4) & 3; qb = j & 15; } else { const int jj = j - 256; b = jj >> 4; h = (jj >> 2) & 3; qb = jj & 3; }
    const int qtok0 = smp ? 4096 + b * 1024 + qb * 64 : b * 256 + qb * 64; const int nkt = smp ? 12 : 2;
    LAS bf16_t* Ks = (LAS bf16_t*)lds;
    LAS bf16_t* VTs = Ks + 128 * 104;
    LAS bf16_t* Ps = VTs + 128 * 136 + wid * 16 * 72;
    LAS float* Mg = (LAS float*)(lds + (128 * 104 + 128 * 136 + 8 * 16 * 72) * 2);
    const bf16_t* Z = (const bf16_t*)(p.ws + OFF_Z); const bf16_t* KF = (const bf16_t*)(p.ws + OFF_KF); const bf16_t* Vb = (const bf16_t*)(p.ws + OFF_V); const float* R = (const float*)(p.ws + OFF_ROPE);
    const float* qhn = p.in[I_QHNORM] + l * 96;
    u32x4 kreg[3], vreg[4];
    const int vst = smp ? 1536 : 256; const bf16_t* vtb = smp ? Vb + 2097152 + (size_t)(b * 4 + h) * 128 * 1536 : Vb + (size_t)(b * 4 + h) * 128 * 256;
    auto rowbase = [&](int kt) { return smp ? (kt < 4 ? 8192 + b * 512 + kt * 128 : 4096 + b * 1024 + (kt - 4) * 128) : b * 256 + kt * 128; };
    auto issue = [&](int kt) { const int rb = rowbase(kt);
#pragma unroll
        for (int i = 0; i < 3; ++i) { const int idx = tid + 512 * i, key = idx / 12, part = idx - key * 12; kreg[i] = *(const u32x4*)(KF + (size_t)(rb + key) * 384 + h * 96 + part * 8); }
#pragma unroll
        for (int i = 0; i < 4; ++i) { const int idx = tid + 512 * i, e = idx >> 4, part = idx & 15; vreg[i] = *(const u32x4*)(vtb + (size_t)e * vst + kt * 128 + part * 8); } };
    auto commit = [&]() {
#pragma unroll
        for (int i = 0; i < 3; ++i) { const int idx = tid + 512 * i, key = idx / 12, part = idx - key * 12; *(LAS u32x4*)(Ks + key * 104 + part * 8) = kreg[i]; }
#pragma unroll
        for (int i = 0; i < 4; ++i) { const int idx = tid + 512 * i, e = idx >> 4, part = idx & 15; *(LAS u32x4*)(VTs + e * 136 + part * 8) = vreg[i]; } };
    issue(0);
    { const int row = tid >> 3, p8 = tid & 7, tok = qtok0 + row; const bf16_t* qr = (const bf16_t*)(p.ws + OFF_QRAW) + (size_t)tok * 384 + h * 96; float x[16];
      if (p8 < 4) ld16bf(qr + p8 * 16, x); else { ld4bf(qr + 64 + (p8 - 4) * 4, x); ld4bf(qr + 80 + (p8 - 4) * 4, x + 4); }
      head_row_finish(x, p8, qhn, p.in[I_KHNORM] + l * 96, smp, qb * 64 + row, R, 0.10206207261596575f * 1.4426950408889634f, Ks + row * 104); }
    __syncthreads();
    const int rt = wid & 3, kh = wid >> 2;
    bf16x8 qa[3];
#pragma unroll
    for (int ks = 0; ks < 3; ++ks) qa[ks] = LDSFRAG(Ks + (rt * 16 + lr) * 104 + ks * 32 + lq * 8);
    __syncthreads();
    commit();
    __syncthreads();
    f32x4 oacc[8]; float mrow[4], lrow[4];
#pragma unroll
    for (int e = 0; e < 8; ++e) oacc[e] = (f32x4){0.f, 0.f, 0.f, 0.f};
#pragma unroll
    for (int r = 0; r < 4; ++r) { mrow[r] = -1e30f; lrow[r] = 0.f; }
    const int kbase = kh * 64;
    for (int kt = 0; kt < nkt; ++kt) {
        if (kt + 1 < nkt) issue(kt + 1);
        f32x4 sacc[4];
#pragma unroll
        for (int nt = 0; nt < 4; ++nt) { sacc[nt] = (f32x4){0.f, 0.f, 0.f, 0.f};
#pragma unroll
            for (int ks = 0; ks < 3; ++ks) sacc[nt] = MFMA16(qa[ks], LDSFRAG(Ks + (kbase + nt * 16 + lr) * 104 + ks * 32 + lq * 8), sacc[nt]); }
        float alpha[4];
#pragma unroll
        for (int r = 0; r < 4; ++r) { float mx = fmaxf(fmaxf(sacc[0][r], sacc[1][r]), fmaxf(sacc[2][r], sacc[3][r]));
            mx = fmaxf(mx, __shfl_xor(mx, 1)); mx = fmaxf(mx, __shfl_xor(mx, 2)); mx = fmaxf(mx, __shfl_xor(mx, 4)); mx = fmaxf(mx, __shfl_xor(mx, 8));
            const float mn = fmaxf(mrow[r], mx); alpha[r] = __builtin_amdgcn_exp2f(mrow[r] - mn); mrow[r] = mn; float rs = 0.f;
#pragma unroll
            for (int nt = 0; nt < 4; ++nt) { const float pv = __builtin_amdgcn_exp2f(sacc[nt][r] - mn); rs += pv; Ps[(lq * 4 + r) * 72 + nt * 16 + lr] = f2bf(pv); }
            lrow[r] = lrow[r] * alpha[r] + rs; }
#pragma unroll
        for (int e = 0; e < 8; ++e) { oacc[e][0] *= alpha[0]; oacc[e][1] *= alpha[1]; oacc[e][2] *= alpha[2]; oacc[e][3] *= alpha[3]; }
        asm volatile("s_waitcnt lgkmcnt(0)" ::: "memory");
#pragma unroll
        for (int k2 = 0; k2 < 2; ++k2) { const bf16x8 pa = LDSFRAG(Ps + lr * 72 + k2 * 32 + lq * 8);
#pragma unroll
            for (int e = 0; e < 8; ++e) { const int er = e * 16 + lr; oacc[e] = MFMA16(pa, LDSFRAG(VTs + er * 136 + kbase + k2 * 32 + lq * 8), oacc[e]); } }
        __syncthreads();
        if (kt + 1 < nkt) { commit(); __syncthreads(); }
    }
#pragma unroll
    for (int r = 0; r < 4; ++r) { float s = lrow[r]; s += __shfl_xor(s, 1); s += __shfl_xor(s, 2); s += __shfl_xor(s, 4); s += __shfl_xor(s, 8); lrow[r] = s; }
    LAS float* Mo = Mg + rt * 16 * 132; LAS float* Ml = Mg + 4 * 16 * 132 + rt * 32;
    bf16_t gtv[4][8];
    if (kh == 0) {
#pragma unroll
        for (int r = 0; r < 4; ++r)
#pragma unroll
            for (int e = 0; e < 8; ++e) gtv[r][e] = Z[(size_t)(qtok0 + rt * 16 + lq * 4 + r) * LDZ + ZMG + h * 128 + e * 16 + lr]; }
    if (kh == 1) {
#pragma unroll
        for (int e = 0; e < 8; ++e)
#pragma unroll
            for (int r = 0; r < 4; ++r) Mo[(lq * 4 + r) * 132 + e * 16 + lr] = oacc[e][r];
        if (lr == 0) {
#pragma unroll
            for (int r = 0; r < 4; ++r) { Ml[(lq * 4 + r) * 2] = mrow[r]; Ml[(lq * 4 + r) * 2 + 1] = lrow[r]; } }
    }
    __syncthreads();
    if (kh == 0) { bf16_t* AM = (bf16_t*)(p.ws + OFF_AMLA);
#pragma unroll
        for (int r = 0; r < 4; ++r) { const int row = lq * 4 + r; const float m2 = Ml[row * 2], l2 = Ml[row * 2 + 1]; const float mm = fmaxf(mrow[r], m2), a1 = exp2f(mrow[r] - mm), a2 = exp2f(m2 - mm);
            const float inv = 1.f / (lrow[r] * a1 + l2 * a2); const int tok = qtok0 + rt * 16 + row;
#pragma unroll
            for (int e = 0; e < 8; ++e) { const int col = e * 16 + lr; const float o = (oacc[e][r] * a1 + Mo[row * 132 + col] * a2) * inv;
                const float gt = bf2f(gtv[r][e]); AM[(size_t)tok * 512 + h * 128 + col] = f2bf(o * siluf_(gt)); } } }
    __syncthreads();
}


#define XB_TMO      128
#define XB_XCNT(j)  (256  + 64 * (j))
#define XB_XSUB(j)  (1280 + 64 * (j))
#define XB_XGEN(j)  (2304 + 64 * (j))
#define XB_TOP      3328
#define XB_TOPGEN   3392
#define XCD_BAR_WORDS 3456
#define XB_SPIN_CAP (1u << 18)

__device__ __forceinline__ unsigned xb_ld(unsigned* p)              { return __hip_atomic_load(p, __ATOMIC_RELAXED, __HIP_MEMORY_SCOPE_AGENT); }
__device__ __forceinline__ unsigned xb_add(unsigned* p, unsigned v) { return __hip_atomic_fetch_add(p, v, __ATOMIC_RELAXED, __HIP_MEMORY_SCOPE_AGENT); }
__device__ __forceinline__ unsigned xb_xcc_id() { return (unsigned)__builtin_amdgcn_s_getreg((3 << 11) | 20) & 0xFu; }
#define XB_SPIN(cond, bar) do { unsigned _sp = 0; while (cond) { __builtin_amdgcn_s_sleep(1); \
    if ((++_sp & 255u) == 0u) { if (xb_ld(&(bar)[XB_TMO])) break; if (_sp > XB_SPIN_CAP) { atomicAdd(&(bar)[XB_TMO], 1u); break; } } } } while (0)

struct XcdBarrier {
    int wid; unsigned* bar; unsigned x;
    volatile LAS unsigned* st;
};

__device__ __forceinline__ XcdBarrier xcd_barrier_post(unsigned* bar, volatile LAS unsigned* st) {
    XcdBarrier b; b.bar = bar; b.x = xb_xcc_id(); b.st = st;
    if (threadIdx.x == 0) (void)xb_add(&bar[XB_XCNT(b.x)], 1u);
    return b;
}
__device__ __forceinline__ void xcd_barrier_complete(unsigned* bar, unsigned x, unsigned& nloc, unsigned& nx) {
    const unsigned G = gridDim.x * gridDim.y * gridDim.z;
    unsigned sum, cnt, mine, sp = 0u;
    for (;;) {
        sum = 0u; cnt = 0u; mine = 0u;
#pragma unroll
        for (unsigned j = 0; j < 16; ++j) { const unsigned c = xb_ld(&bar[XB_XCNT(j)]); sum += c; cnt += (c > 0u) ? 1u : 0u; mine = (j == x) ? c : mine; }
        if (sum == G) break;
        __builtin_amdgcn_s_sleep(1);
        if ((++sp & 255u) == 0u) { if (xb_ld(&bar[XB_TMO])) break; if (sp > XB_SPIN_CAP) { atomicAdd(&bar[XB_TMO], 1u); break; } }
    }
    nloc = mine > 0u ? mine : 1u; nx = cnt > 0u ? cnt : 1u;
}

__device__ __forceinline__ void xcd_barrier(const XcdBarrier& b) {
    asm volatile("s_waitcnt vmcnt(0)" ::: "memory");
    __syncthreads();
    if (b.wid == 0 && lane_id_() == 0) {
        unsigned* bar = b.bar;
        __builtin_amdgcn_s_waitcnt(0);
        unsigned nloc = b.st[0], nx = b.st[1];
        if (nloc == 0u) { xcd_barrier_complete(bar, b.x, nloc, nx); b.st[0] = nloc; b.st[1] = nx; }
        const unsigned old = xb_add(&bar[XB_XSUB(b.x)], 1u);
        const unsigned gen = old / nloc;
        if (old + 1u == (gen + 1u) * nloc) {
            __builtin_amdgcn_fence(__ATOMIC_RELEASE, "agent");
            asm volatile("s_waitcnt vmcnt(0)" ::: "memory");
            const unsigned og = xb_add(&bar[XB_TOP], 1u);
            const unsigned tg = og / nx;
            if (og + 1u == (tg + 1u) * nx) xb_add(&bar[XB_TOPGEN], 1u);
            else XB_SPIN(xb_ld(&bar[XB_TOPGEN]) == tg, bar);
            __builtin_amdgcn_fence(__ATOMIC_ACQUIRE, "agent");
            xb_add(&bar[XB_XGEN(b.x)], 1u);
            asm volatile("s_waitcnt vmcnt(0)" ::: "memory");
        } else {
            XB_SPIN(xb_ld(&bar[XB_XGEN(b.x)]) == gen, bar);
            __builtin_amdgcn_fence(__ATOMIC_ACQUIRE, "agent");
            asm volatile("s_waitcnt vmcnt(0)" ::: "memory");
        }
    }
    __syncthreads();
}

constexpr int N_PHASES = 15;
#ifndef S3SEL
#define S3SEL 15
#endif
#ifndef REPEAT_MASK
#define REPEAT_MASK 0xff
#endif
#ifndef ONLY_S
#define ONLY_S -1
#endif
__device__ __forceinline__ void run_phase(const Params& p, int ph, lds_t lds, int mask = 0xff) {
    const int G = (int)gridDim.x, bid = (int)blockIdx.x;
    if (ph == 0 && (ONLY_S < 0 || ONLY_S == 7)) {
        for (int j = bid; j < 192 + 256 + 32; j += G) { if (j < 192) job_ada(p, j, lds); else if (j < 448) job_ctx(p, j - 192); else job_rope(p, j - 448); }
        return;
    }
    const int l = (ph - 1) / 7, s = (ph - 1) % 7;
    unsigned char* ws = p.ws;
    if (s == 0 && (ONLY_S < 0 || ONLY_S == 0)) {
        if (l == 0 || G < 256) { for (int j = bid; j < 96 + WT_TOTAL + 1024; j += G) { if (j < 96) { if (mask & 1) job_s5setup(p, l, j, lds); } else if (j < 96 + WT_TOTAL) { if (mask & 2) job_wt(p, l, j - 96, lds); } else if (mask & 4) job_prep(p, l, j - 96 - WT_TOTAL); } }
        else { for (int j = bid; j < WT_WOUT + 1024; j += G) { if (j < WT_WOUT) job_wt(p, l, WT_EARLY + 3 * WT_WBO + j, lds); else job_prep(p, l, j - WT_WOUT); } }
    } else if (s == 1 && (ONLY_S < 0 || ONLY_S == 1)) {
        Order S; S.setup(8192, 3840, 0, p.wid); pg8::Gemm g{(const bf16_t*)(ws + OFF_HB), (const bf16_t*)(ws + OFF_WIN), 8192, 3840, 1024}; EpiZ E{(bf16_t*)(ws + OFF_Z)};
        pg8::gemm_phase<EpiZ, Order>(lds, g, S, E, nullptr);
    } else if (s == 2 && (ONLY_S < 0 || ONLY_S == 2)) {
        for (int j = bid; j < 640 + 512 + 1024; j += G) { if (j < 640) { if (mask & 1) job_s5(p, l, j, lds); } else if (j < 1152) { if (mask & 2) job_glaA(p, l, j - 640, lds); } else if (mask & 4) job_mlaprep(p, l, j - 1152); }
    } else if (s == 3 && (ONLY_S < 0 || ONLY_S == 3)) {
        if (mask & 1) for (int j = bid; j < 640; j += G) job_glaB(p, l, j);
        if (mask & 16) { Order S; S.setup(8192, 3072, 0, p.wid); pg8::Gemm g{(const bf16_t*)(ws + OFF_HB), (const bf16_t*)(ws + OFF_WIN) + (size_t)3840 * 1024, 8192, 3072, 1024}; EpiZ E{(bf16_t*)(ws + OFF_Z) + 3840};
          pg8::gemm_phase<EpiZ, Order>(lds, g, S, E, nullptr); }
        if ((mask & 2) && (S3SEL & 2)) { Order S; S.setup(8192, 1024, 128, p.wid); pg8::Gemm g{(const bf16_t*)(ws + OFF_YG), (const bf16_t*)(ws + OFF_WGLU), 8192, 1024, 512}; EpiGLU E{(bf16_t*)(ws + OFF_AS5), (const bf16_t*)(ws + OFF_Z), p.in[I_BGLU] + l * 1024};
          pg8::gemm_phase<EpiGLU, Order>(lds, g, S, E, nullptr); }
        if ((mask & 4) && (S3SEL & 4)) { Order S; S.setup(10240, 768, 128, p.wid); pg8::Gemm g{(const bf16_t*)(ws + (l == 0 ? OFF_CTX0 : OFF_CKVN)), (const bf16_t*)(ws + OFF_WKV), 10240, 768, 256}; EpiKV E{(bf16_t*)(ws + OFF_KF), (bf16_t*)(ws + OFF_V), l, (const bf16_t*)(ws + OFF_Z), p.in[I_CKR], p.in[I_KHNORM] + l * 96, (const float*)(ws + OFF_ROPE)};
          pg8::gemm_phase<EpiKV, Order>(lds, g, S, E, nullptr); }
        if ((mask & 8) && (S3SEL & 8)) { Order S; S.setup(8192, 512, 64, p.wid); pg8::Gemm g{(const bf16_t*)(ws + OFF_AQ), (const bf16_t*)(ws + OFF_WUQ), 8192, 512, 384}; EpiQ E{(bf16_t*)(ws + OFF_QRAW)};
          pg8::gemm_phase<EpiQ, Order>(lds, g, S, E, nullptr); }
    } else if (s == 4 && (ONLY_S < 0 || ONLY_S == 4)) {
        for (int j = bid; j < 512 + 512; j += G) { if (j < 512) { if (mask & 1) job_attn(p, l, j, lds); } else if (mask & 2) job_glaC(p, l, j - 512, lds); }
    } else if (s == 5 && (ONLY_S < 0 || ONLY_S == 5)) {
        if (l == 0 && mask == 0xff && G >= 256 && bid >= 128) { for (int j = bid - 128; j < 96 + WT_EARLY; j += G - 128) { if (j < 96) job_s5setup(p, 1, j, lds); else job_wt(p, 1, j - 96, lds); } }
        for (int br = 0; br < 3; ++br) { Order S; S.setup(8192, 1024, 0, p.wid);
            pg8::Gemm g{(const bf16_t*)(ws + (br == 0 ? OFF_AGLA : br == 1 ? OFF_AMLA : OFF_AS5)), (const bf16_t*)(ws + OFF_WBO) + (size_t)br * 1024 * 512, 8192, 1024, 512};
            EpiBo E{(bf16_t*)(ws + OFF_HB), (const bf16_t*)(ws + OFF_Z), br};
            pg8::gemm_phase<EpiBo, Order>(lds, g, S, E, nullptr); }
    } else if (s == 6 && (ONLY_S < 0 || ONLY_S == 6)) {
        if (l == 0 && mask == 0xff && G >= 256 && bid >= 128) { for (int j = bid - 128; j < 3 * WT_WBO; j += G - 128) job_wt(p, 1, WT_EARLY + j, lds); }
        Order S; S.setup(8192, 1024, 0, p.wid); pg8::Gemm g{(const bf16_t*)(ws + OFF_HB), (const bf16_t*)(ws + OFF_WOUT), 8192, 1024, 1024};
        EpiOut E{p.out, l == 0 ? p.in[I_XP] : p.out, l == 0 ? p.in[I_XS] : p.out + (size_t)4096 * 1024, (const float*)(ws + OFF_ADA) + l * 5 * 3072};
        pg8::gemm_phase<EpiOut, Order>(lds, g, S, E, nullptr);
    }
}
__global__ __launch_bounds__(512, 2) void mega(KParams kp, int ph0, int ph1) {
    extern __shared__ __attribute__((aligned(16))) unsigned char shm[];
    lds_t lds = (lds_t)shm;
    if (threadIdx.x < N_IN) ((const float**)(kp.ws + OFF_TBL))[threadIdx.x] = kp.in[threadIdx.x];
    const int wid0 = __builtin_amdgcn_readfirstlane((int)threadIdx.x >> 6);
    volatile LAS unsigned* xst = (volatile LAS unsigned*)(lds + DYN_LDS - 16);
    if (threadIdx.x == 0) { xst[0] = 0u; xst[1] = 0u; }
    __threadfence(); __syncthreads();
    XcdBarrier xb = xcd_barrier_post((unsigned*)(kp.ws + OFF_BAR), xst);
    xb.wid = wid0;
    if (ph0 > ph1) cg::this_grid().sync();
    for (int ph = ph0; ph < ph1; ++ph) {
        Params p; p.wid = wid0; { const float* const* tb = (const float* const*)(kp.ws + OFF_TBL); float* o = kp.out; unsigned char* w = kp.ws; asm volatile("" : "+s"(tb), "+s"(o), "+s"(w)); p.in = tb; p.out = o; p.ws = w; }
        int nrep = 1;
#ifdef REPEAT_S
        if ((REPEAT_S == 7 && ph == 0) || (ph > 0 && (ph - 1) % 7 == REPEAT_S && (REPEAT_S != 6 || ph < 8))) nrep = 2;
#endif
        for (int rep = 0; rep < nrep; ++rep) { if (rep) xcd_barrier(xb); run_phase(p, ph, lds, rep ? REPEAT_MASK : 0xff); }
        if (ph + 1 < ph1) xcd_barrier(xb);
    }
}

#ifndef N_LAUNCH_MODE
#define N_LAUNCH_MODE 1
#endif
extern "C" void kernel_launch(void* const* d_in, const int* in_sizes, int n_in, void* d_out, int out_size, void* d_ws, size_t ws_size, hipStream_t stream) {
    static int grid = 0;
    if (grid == 0) {
        if (n_in != N_IN || ws_size < WS_END) { fprintf(stderr, "kernel_launch: unexpected n_in %d / ws %zu (need %zu)\n", n_in, ws_size, (size_t)WS_END); grid = -1; return; }
        int dev = 0, cus = 0, per_cu = 0;
        hipGetDevice(&dev); hipDeviceGetAttribute(&cus, hipDeviceAttributeMultiprocessorCount, dev);
        hipFuncSetAttribute((const void*)mega, hipFuncAttributeMaxDynamicSharedMemorySize, DYN_LDS);
        hipOccupancyMaxActiveBlocksPerMultiprocessor(&per_cu, (const void*)mega, 512, DYN_LDS);
        if (per_cu < 1) { fprintf(stderr, "kernel_launch: occupancy query says %d blocks per CU\n", per_cu); per_cu = 1; }
        (void)hipGetLastError();
        grid = cus;
    }
    if (grid < 0) return;
    hipMemsetAsync((char*)d_ws + OFF_BAR, 0, 16384, stream);
    KParams p{};
    for (int i = 0; i < N_IN; ++i) p.in[i] = (const float*)d_in[i];
    p.out = (float*)d_out; p.ws = (unsigned char*)d_ws;
#if N_LAUNCH_MODE == 0
    for (int ph = 0; ph < N_PHASES; ++ph) { hipLaunchKernelGGL(mega, dim3(grid), dim3(512), DYN_LDS, stream, p, ph, ph + 1); }
#else
    int ph0 = 0, ph1 = N_PHASES; void* args[] = {&p, &ph0, &ph1};
    hipError_t e = hipLaunchCooperativeKernel((const void*)mega, dim3(grid), dim3(512), args, DYN_LDS, stream);
    if (e != hipSuccess) fprintf(stderr, "cooperative launch failed: %s (grid %d)\n", hipGetErrorString(e), grid);
#endif
}
```

```cpp
#include <hip/hip_runtime.h>
#include <hip/hip_cooperative_groups.h>
#include <cstdio>
namespace cg = cooperative_groups;
namespace pg8 {
#define PG8_LAS __attribute__((address_space(3)))
typedef unsigned short bf16_t;
typedef short bf16x8 __attribute__((ext_vector_type(8)));
typedef float f32x4 __attribute__((ext_vector_type(4)));
typedef unsigned u32x4 __attribute__((ext_vector_type(4)));
constexpr int BM = 256, BK = 64, HALF = 128, HTB = HALF * BK * 2  , STAGE_BYTES = 8 * HTB, NXCD = 8, WGM = 8;

__host__ __device__ __forceinline__ int lds_byte(int r, int c) { const int st = (r >> 4) * 2 + (c >> 5), rr = r & 15, cc = c & 31, ob = rr * 64 + cc * 2; return st * 1024 + (ob ^ (((ob >> 9) & 1) << 5)); }
__host__ __device__ __forceinline__ void stage_rc(int b, int& R, int& C) { const int st = b / 1024, sb = b % 1024, swz = sb ^ (((sb >> 9) & 1) << 5); R = (st >> 1) * 16 + swz / 64; C = (st & 1) * 32 + (swz % 64) / 2; }
__host__ __device__ __forceinline__ int perm32(int rho) { const int n = rho >> 4, i = rho & 15; return 8 * (i >> 2) + 4 * n + (i & 3); }

struct Unit { int pm, pn; };
struct Gemm { const bf16_t* A; const bf16_t* Bt; int M, N, K; };

struct StaticOrder {
    int nM, nN, nwg, G, c;
    __host__ __device__ void init(int M, int N, int G_, int c_) { nM = M / BM; nN = N / BM; nwg = nM * nN; G = G_; c = c_; }
    __host__ __device__ bool next(int i, Unit& u) const {
        const long L = (long)i * G + c; if (L >= nwg) return false;
        int wgid = (int)L; { const int q = nwg / NXCD, r = nwg % NXCD, xcd = wgid % NXCD, off = wgid / NXCD; wgid = (xcd < r ? xcd * (q + 1) : r * (q + 1) + (xcd - r) * q) + off; }
        const int nig = WGM * nN, gid = wgid / nig, fm = gid * WGM, gsz = (nM - fm) < WGM ? (nM - fm) : WGM;
        u.pm = fm + ((wgid % nig) % gsz); u.pn = (wgid % nig) / gsz; return true;
    }
    __device__ __forceinline__ void a_ready(const Unit&) const {}
    __device__ __forceinline__ void done(const Unit&) const {}
};
__device__ __forceinline__ unsigned cvt_pk_bf16(float lo, float hi) { unsigned r; asm volatile("v_cvt_pk_bf16_f32 %0, %1, %2" : "=v"(r) : "v"(lo), "v"(hi)); return r; }
typedef float f32x2 __attribute__((ext_vector_type(2)));
template <class Epi, class Sched, bool STAMP = false>
__device__ __forceinline__ void gemm_phase(PG8_LAS unsigned char* lds, const Gemm g, const Sched& S, const Epi& E, unsigned long long* stamps) {
    int tid_ = (S.wid << 6) | (int)__builtin_amdgcn_mbcnt_hi(~0u, __builtin_amdgcn_mbcnt_lo(~0u, 0u)); asm volatile("" : "+v"(tid_)); const int tid = tid_, wid = __builtin_amdgcn_readfirstlane(tid >> 6), lane = tid & 63, wr = wid >> 2, wc = wid & 3, fr = lane & 15, fq = lane >> 4;
    int K_ = g.K; asm volatile("" : "+s"(K_)); const int K = K_, nt = K / BK;
    int ts_lo = 0, ts_hi = 0, nts = 0; const unsigned long long rt_entry = STAMP ? (unsigned long long)wall_clock64() : 0ull;
#define PG8_STAMP() do { if (STAMP && wid == 0 && nts < 64) { const unsigned long long _c = (unsigned long long)clock64(); \
        ts_lo = (lane == nts) ? (int)(unsigned)_c : ts_lo; ts_hi = (lane == nts) ? (int)(unsigned)(_c >> 32) : ts_hi; ++nts; } } while (0)
    PG8_STAMP();
    unsigned voffA[2], voffB[2];
#pragma unroll
    for (int i = 0; i < 2; ++i) { int R, C; stage_rc(tid * 16 + i * 8192, R, C); const int Rb = Epi::PERM ? ((R & ~31) + perm32(R & 31)) : R;
        voffA[i] = (unsigned)(R * K + C) * 2u; voffB[i] = (unsigned)(Rb * K + C) * 2u; }
    const size_t kstep = (size_t)(BK * 2);
    const size_t hstep = (size_t)HALF * K * 2;
    const size_t tstep = 2 * hstep;
    const unsigned ldsw = (unsigned)wid * 1024u;
    const int aoff = lds_byte(wr * 64 + fr, fq * 8), boff = lds_byte(wc * 32 + fr, fq * 8);
#define PG8_SA(b, h) (((b) * 2 + (h)) * HTB)
#define PG8_SB(b, h) ((4 + (b) * 2 + (h)) * HTB)
#define PG8_STAGE(bufoff, gbase, voff) do { _Pragma("unroll") for (int _i = 0; _i < 2; ++_i) \
        __builtin_amdgcn_global_load_lds((const unsigned*)((const char*)(gbase) + (voff)[_i]), (PG8_LAS unsigned*)(lds + (bufoff) + ldsw + _i * 8192), 16, 0, 0); } while (0)
#define PG8_LDA(dst, b, h) do { _Pragma("unroll") for (int m = 0; m < 4; ++m) _Pragma("unroll") for (int k = 0; k < 2; ++k) dst[m][k] = *(const PG8_LAS bf16x8*)(lds + PG8_SA(b, h) + aoff + m * 2048 + k * 1024); } while (0)
#define PG8_LDB(dst, b, h) do { _Pragma("unroll") for (int n = 0; n < 2; ++n) _Pragma("unroll") for (int k = 0; k < 2; ++k) dst[n][k] = *(const PG8_LAS bf16x8*)(lds + PG8_SB(b, h) + boff + n * 2048 + k * 1024); } while (0)
#define PG8_MMA(ai, bj, At, Bt) do { __builtin_amdgcn_s_setprio(1); _Pragma("unroll") for (int m = 0; m < 4; ++m) _Pragma("unroll") for (int n = 0; n < 2; ++n) _Pragma("unroll") for (int k = 0; k < 2; ++k) \
        acc[ai][bj][m][n] = __builtin_amdgcn_mfma_f32_16x16x32_bf16(Bt[n][k], At[m][k], acc[ai][bj][m][n], 0, 0, 0); __builtin_amdgcn_s_setprio(0); } while (0)
#define PG8_WAIT_V(n) asm volatile("s_waitcnt vmcnt(" #n ")" ::: "memory")
#define PG8_WAIT_L(n) asm volatile("s_waitcnt lgkmcnt(" #n ")" ::: "memory")
#define PG8_BAR __builtin_amdgcn_s_barrier()
#define PG8_SCHED __builtin_amdgcn_sched_barrier(0)
    Unit cur, nxt; int ui = 0;
    if (!S.next(0, cur)) return;
    f32x4 acc[2][2][4][2];
#pragma unroll
    for (int a = 0; a < 2; ++a)
#pragma unroll
        for (int b = 0; b < 2; ++b)
#pragma unroll
            for (int m = 0; m < 4; ++m)
#pragma unroll
                for (int n = 0; n < 2; ++n) acc[a][b][m][n] = (f32x4){0.f, 0.f, 0.f, 0.f};
    bf16x8 At[4][2], B0[2][2], B1[2][2];
    const char* cA = (const char*)g.A + (size_t)cur.pm * tstep; const char* cB = (const char*)g.Bt + (size_t)cur.pn * tstep;
    S.a_ready(cur);
    PG8_STAGE(PG8_SB(0, 0), cB, voffB); PG8_STAGE(PG8_SA(0, 0), cA, voffA); PG8_STAGE(PG8_SB(0, 1), cB + hstep, voffB); PG8_STAGE(PG8_SA(0, 1), cA + hstep, voffA);
    if (wr == 1) PG8_BAR;
    PG8_WAIT_V(4); PG8_BAR;
    PG8_STAGE(PG8_SB(1, 0), cB + kstep, voffB); PG8_STAGE(PG8_SA(1, 0), cA + kstep, voffA); PG8_STAGE(PG8_SB(1, 1), cB + hstep + kstep, voffB);
    PG8_WAIT_V(6); PG8_BAR;
    PG8_STAMP();
    for (;;) {
        const bool has_next = S.next(ui + 1, nxt);
        const char* nA = has_next ? (const char*)g.A + (size_t)nxt.pm * tstep : cA; const char* nB = has_next ? (const char*)g.Bt + (size_t)nxt.pn * tstep : cB;
        for (int t = 0; t < nt; t += 2) {
            const bool last = (t == nt - 2);
            const char* a1 = cA + (size_t)(t + 1) * kstep;
            const char* a2 = last ? nA : cA + (size_t)(t + 2) * kstep; const char* b2 = last ? nB : cB + (size_t)(t + 2) * kstep;
            const char* a3 = a2 + kstep; const char* b3 = b2 + kstep;
            if (last && has_next) S.a_ready(nxt);
            PG8_LDB(B0, 0, 0); PG8_SCHED; PG8_LDA(At, 0, 0); PG8_STAGE(PG8_SA(1, 1), a1 + hstep, voffA);
            PG8_WAIT_L(8); PG8_BAR; PG8_WAIT_L(0); PG8_MMA(0, 0, At, B0); PG8_BAR; PG8_SCHED;
            PG8_LDB(B1, 0, 1); PG8_STAGE(PG8_SB(0, 0), b2, voffB);
            PG8_BAR; PG8_WAIT_L(0); PG8_MMA(0, 1, At, B1); PG8_BAR;
            PG8_LDA(At, 0, 1); PG8_STAGE(PG8_SA(0, 0), a2, voffA);
            PG8_BAR; PG8_WAIT_L(0); PG8_MMA(1, 0, At, B0); PG8_BAR; PG8_SCHED;
            PG8_STAGE(PG8_SB(0, 1), b2 + hstep, voffB);
            PG8_WAIT_V(6); PG8_BAR; PG8_MMA(1, 1, At, B1); PG8_BAR;
            PG8_LDB(B0, 1, 0); PG8_SCHED; PG8_LDA(At, 1, 0); PG8_STAGE(PG8_SA(0, 1), a2 + hstep, voffA);
            PG8_WAIT_L(8); PG8_BAR; PG8_WAIT_L(0); PG8_MMA(0, 0, At, B0); PG8_BAR; PG8_SCHED;
            PG8_LDB(B1, 1, 1); PG8_STAGE(PG8_SB(1, 0), b3, voffB);
            PG8_BAR; PG8_WAIT_L(0); PG8_MMA(0, 1, At, B1); PG8_BAR;
            PG8_LDA(At, 1, 1); PG8_STAGE(PG8_SA(1, 0), a3, voffA);
            PG8_BAR; PG8_WAIT_L(0); PG8_MMA(1, 0, At, B0); PG8_BAR; PG8_SCHED;
            PG8_STAGE(PG8_SB(1, 1), b3 + hstep, voffB);
            PG8_WAIT_V(6); PG8_BAR; PG8_MMA(1, 1, At, B1); PG8_BAR;
        }
        PG8_STAMP();
        if constexpr (!Epi::AFTER_DRAIN) { E(acc, cur, wr, wc, fr, fq); S.done(cur); }
        PG8_STAMP();
        if (!has_next) break;
#pragma unroll
        for (int a = 0; a < 2; ++a)
#pragma unroll
            for (int b = 0; b < 2; ++b)
#pragma unroll
                for (int m = 0; m < 4; ++m)
#pragma unroll
                    for (int n = 0; n < 2; ++n) acc[a][b][m][n] = (f32x4){0.f, 0.f, 0.f, 0.f};
        cur = nxt; cA = nA; cB = nB; ++ui;
    }
    PG8_WAIT_V(0);
    if (wr == 0) PG8_BAR;
    PG8_BAR;
    if constexpr (Epi::AFTER_DRAIN) { E.fused(acc, cur, wr, wc, fr, fq, lds, wid, lane); S.done(cur); }
    PG8_STAMP();
    if (STAMP && wid == 0) { stamps[lane] = lane < nts ? (((unsigned long long)(unsigned)ts_hi << 32) | (unsigned)ts_lo) : 0ull;
        if (lane == 62) stamps[62] = rt_entry; if (lane == 63) stamps[63] = (unsigned long long)wall_clock64(); }
#undef PG8_STAMP
#undef PG8_SA
#undef PG8_SB
#undef PG8_STAGE
#undef PG8_LDA
#undef PG8_LDB
#undef PG8_MMA
#undef PG8_WAIT_V
#undef PG8_WAIT_L
#undef PG8_BAR
#undef PG8_SCHED
}
}
using pg8::bf16_t; using pg8::bf16x8; using pg8::f32x4; using pg8::u32x4; using pg8::Unit;
#define LAS __attribute__((address_space(3)))
typedef unsigned u32x2 __attribute__((ext_vector_type(2)));
typedef LAS unsigned char* lds_t;
struct Params;
__device__ __forceinline__ int lane_id_() { return (int)__builtin_amdgcn_mbcnt_hi(~0u, __builtin_amdgcn_mbcnt_lo(~0u, 0u)); }
typedef float f32x2_t __attribute__((ext_vector_type(2)));

enum { I_XP = 0, I_XS, I_C, I_CCTX, I_CKV, I_CKR, I_SGLA, I_SS5, I_NORMW, I_WADA, I_BADA, I_WIN, I_WA2, I_BA, I_ONORM, I_QNORM, I_WUQ, I_KVNORM, I_WUK, I_WUV,
       I_QHNORM, I_KHNORM, I_ARE, I_AIM, I_LOGDT, I_BRE, I_BIM, I_CRE, I_CIM, I_S5D, I_WGLU, I_BGLU, I_WBOG, I_WBOM, I_WBOS, I_WOUT, N_IN };
struct KParams { const float* in[N_IN]; float* out; unsigned char* ws; };
struct Params { const float* const* in; float* out; unsigned char* ws; int wid; };
__device__ __forceinline__ int tid_opaque(const Params& p) { int t = (p.wid << 6) | lane_id_(); asm volatile("" : "+v"(t)); return t; }

constexpr int LDZ = 6912;
constexpr int ZQ = 0, ZK = 256, ZV = 512, ZGA = 1024, ZGG = 1056, ZMQ = 1568, ZMKV = 1952, ZMKR = 2208, ZMG = 2240, ZSU = 2752, ZSG = 3264, ZMERGE = 3776;
constexpr size_t OUT_YP = 0, OUT_CKV = 8388608, OUT_KR = 10485760, OUT_GLA = 10747904, OUT_S5 = 12845056;
constexpr size_t OFF_WIN = 0;

constexpr size_t OFF_WUQ = OFF_WIN + 14155776;
constexpr size_t OFF_WKV = OFF_WUQ + 393216;
constexpr size_t OFF_WGLU = OFF_WKV + 393216;
constexpr size_t OFF_WBO = OFF_WGLU + 1048576;
constexpr size_t OFF_WOUT = OFF_WBO + 3145728;
constexpr size_t OFF_S5M = OFF_WOUT + 2097152;
constexpr size_t OFF_V = OFF_S5M;
constexpr size_t OFF_P16 = OFF_S5M + 12582912;
constexpr size_t OFF_ADA = OFF_P16 + 32768;
constexpr size_t OFF_ROPE = OFF_ADA + 122880;
constexpr size_t OFF_CTX0 = OFF_ROPE + 131072;
constexpr size_t OFF_CKVN = OFF_CTX0 + 1048576;
constexpr size_t OFF_CTX1 = OFF_CKVN + 4194304;
constexpr size_t OFF_HB = OFF_CTX1 + 1048576;
constexpr size_t OFF_Z = OFF_HB + 16777216;
constexpr size_t OFF_KV = OFF_Z + 113246208;
constexpr size_t OFF_AGLA = OFF_KV, OFF_AMLA = OFF_KV + 8388608;
constexpr size_t OFF_QD = OFF_KV + 16777216;
constexpr size_t OFF_OIB = OFF_QD + 8388608;
constexpr size_t OFF_DEC = OFF_KV + 33554432;
constexpr size_t OFF_ST = OFF_DEC + 262144;
constexpr size_t OFF_AQ = OFF_ST + 16777216;
constexpr size_t OFF_QRAW = OFF_AQ + 6291456;
constexpr size_t OFF_AS5 = OFF_QRAW + 6291456;
constexpr size_t OFF_YG = OFF_AS5 + 8388608;
constexpr size_t OFF_TBL = OFF_YG + 8388608;
constexpr size_t OFF_BAR = OFF_TBL + 512;
constexpr size_t OFF_KF = OFF_BAR + 16384;
constexpr size_t WS_END = OFF_KF + 7864320;
constexpr int DYN_LDS = 147456;

__device__ __forceinline__ float bf2f(bf16_t b) { return __uint_as_float(((unsigned)b) << 16); }
__device__ __forceinline__ bf16_t f2bf(float f) { unsigned u = __float_as_uint(f); u += 0x7FFFu + ((u >> 16) & 1u); return (bf16_t)(u >> 16); }
__device__ __forceinline__ unsigned pk2(float lo, float hi) { return pg8::cvt_pk_bf16(lo, hi); }
__device__ __forceinline__ float lo16(unsigned w) { return __uint_as_float(w << 16); }
__device__ __forceinline__ float hi16(unsigned w) { return __uint_as_float(w & 0xffff0000u); }
__device__ __forceinline__ float sigmoidf_(float x) { return 1.f / (1.f + __expf(-x)); }
__device__ __forceinline__ float siluf_(float x) { return x / (1.f + __expf(-x)); }
__device__ __forceinline__ void store8(bf16_t* p, const f32x4& a, const f32x4& b) { u32x4 w; w.x = pk2(a[0], a[1]); w.y = pk2(a[2], a[3]); w.z = pk2(b[0], b[1]); w.w = pk2(b[2], b[3]); *(u32x4*)p = w; }
#define MFMA16(a, b, c) __builtin_amdgcn_mfma_f32_16x16x32_bf16(a, b, c, 0, 0, 0)
#define LDSFRAG(ptr) (*(const LAS bf16x8*)(ptr))

struct Order : pg8::StaticOrder { int wid;
    __device__ void setup(int M, int N, int rot, int wid_) { wid = wid_; const int G = (int)gridDim.x; init(M, N, G, (int)((blockIdx.x + (unsigned)rot) % (unsigned)G)); }
};

struct EpiZ { static constexpr bool PERM = true, AFTER_DRAIN = false; bf16_t* Z;
    __device__ __forceinline__ void operator()(const f32x4 (&acc)[2][2][4][2], const Unit& u, int wr, int wc, int fr_, int fq_) const {
        int fr = fr_, fq = fq_; asm volatile("" : "+v"(fr), "+v"(fq));
        const int row0 = u.pm * 256 + wr * 64 + fr, col0 = u.pn * 256 + wc * 32 + 8 * fq;
#pragma unroll
        for (int ai = 0; ai < 2; ++ai)
#pragma unroll
            for (int m = 0; m < 4; ++m) { bf16_t* rp = Z + (size_t)(row0 + ai * 128 + m * 16) * LDZ + col0;
#pragma unroll
                for (int bj = 0; bj < 2; ++bj) store8(rp + bj * 128, acc[ai][bj][m][0], acc[ai][bj][m][1]); }
    } };
struct EpiQ { static constexpr bool PERM = true, AFTER_DRAIN = false; bf16_t* Q;
    __device__ __forceinline__ void operator()(const f32x4 (&acc)[2][2][4][2], const Unit& u, int wr, int wc, int fr_, int fq_) const {
        int fr = fr_, fq = fq_; asm volatile("" : "+v"(fr), "+v"(fq));
        const int row0 = u.pm * 256 + wr * 64 + fr, col0 = u.pn * 256 + wc * 32 + 8 * fq;
#pragma unroll
        for (int ai = 0; ai < 2; ++ai)
#pragma unroll
            for (int m = 0; m < 4; ++m) { bf16_t* rp = Q + (size_t)(row0 + ai * 128 + m * 16) * 384 + col0;
#pragma unroll
                for (int bj = 0; bj < 2; ++bj) if (col0 + bj * 128 < 384) store8(rp + bj * 128, acc[ai][bj][m][0], acc[ai][bj][m][1]);
                }
    } };
struct EpiKV { static constexpr bool PERM = true, AFTER_DRAIN = false; bf16_t* KF; bf16_t* V; int layer; const bf16_t* Z; const float* ckr; const float* khn; const float* R;
    __device__ __forceinline__ void operator()(const f32x4 (&acc)[2][2][4][2], const Unit& u, int wr, int wc, int fr_, int fq_) const {
        int fr = fr_, fq = fq_; asm volatile("" : "+v"(fr), "+v"(fq));
        int rb = u.pm * 256; if (layer == 0) rb = rb < 2048 ? 8192 + rb : rb - 2048;
        const int row0 = rb + wr * 64 + fr;
        if (u.pn > 0) {
#pragma unroll
            for (int ai = 0; ai < 2; ++ai)
#pragma unroll
                for (int m = 0; m < 4; ++m) { const int r = row0 + ai * 128 + m * 16; bf16_t* bp; int st;
                    if (r < 4096) { bp = V + (size_t)(r >> 8) * 4 * 128 * 256 + (r & 255); st = 256; }
                    else if (r < 8192) { bp = V + 2097152 + (size_t)((r - 4096) >> 10) * 4 * 128 * 1536 + 512 + ((r - 4096) & 1023); st = 1536; }
                    else { bp = V + 2097152 + (size_t)((r - 8192) >> 9) * 4 * 128 * 1536 + ((r - 8192) & 511); st = 1536; }
#pragma unroll
                    for (int bj = 0; bj < 2; ++bj) { bf16_t* hp = bp + (size_t)((((u.pn - 1) * 2 + bj) * 128) + wc * 32 + 8 * fq) * st;
#pragma unroll
                        for (int i = 0; i < 8; i += 2) { const unsigned w = pk2(acc[ai][bj][m][i >> 2][i & 3], acc[ai][bj][m][i >> 2][(i & 3) + 1]); hp[0] = (bf16_t)(w & 0xffffu); hp[st] = (bf16_t)(w >> 16); hp += 2 * st; } }
                    __builtin_amdgcn_sched_barrier(0); }
            return; }
        float w1[4], w2[4];
#pragma unroll
        for (int i = 0; i < 4; ++i) { w1[i] = khn[64 + 4 * fq + i]; w2[i] = khn[80 + 4 * fq + i]; }
#pragma unroll
        for (int ai = 0; ai < 2; ++ai)
#pragma unroll
          for (int mh = 0; mh < 4; mh += 1) {
            float x1[4][4], x2[4][4], cs[4][4], sn[4][4];
#pragma unroll
            for (int m = mh; m < mh + 1; ++m) { const int r = row0 + ai * 128 + m * 16;
                if (r >= 8192) { const int j = r - 8192; const float* kr = ckr + ((size_t)(((j >> 9) * 2 + layer) * 512 + (j & 511))) * 32 + 4 * fq;
                    const f32x4 a = *(const f32x4*)kr, b = *(const f32x4*)(kr + 16);
#pragma unroll
                    for (int i = 0; i < 4; ++i) { x1[m][i] = a[i]; x2[m][i] = b[i]; } }
                else { const bf16_t* kr = Z + (size_t)r * LDZ + ZMKR + 4 * fq; const u32x2 a = *(const u32x2*)kr, b = *(const u32x2*)(kr + 16);
                    x1[m][0] = lo16(a.x); x1[m][1] = hi16(a.x); x1[m][2] = lo16(a.y); x1[m][3] = hi16(a.y); x2[m][0] = lo16(b.x); x2[m][1] = hi16(b.x); x2[m][2] = lo16(b.y); x2[m][3] = hi16(b.y); }
                const bool rot = r >= 4096 && r < 8192; const int pos = (r - 4096) & 1023;
                if (rot) { const f32x4 c = *(const f32x4*)(R + pos * 16 + 4 * fq), s_ = *(const f32x4*)(R + 16384 + pos * 16 + 4 * fq);
#pragma unroll
                    for (int i = 0; i < 4; ++i) { cs[m][i] = c[i]; sn[m][i] = s_[i]; } }
                else {
#pragma unroll
                    for (int i = 0; i < 4; ++i) { cs[m][i] = 1.f; sn[m][i] = 0.f; } } }
#pragma unroll
            for (int m = mh; m < mh + 1; ++m) { const int r = row0 + ai * 128 + m * 16;
                float ss = 0.f;
#pragma unroll
                for (int bj = 0; bj < 2; ++bj)
#pragma unroll
                    for (int i = 0; i < 8; ++i) { const float v = acc[ai][bj][m][i >> 2][i & 3]; ss += v * v; }
#pragma unroll
                for (int i = 0; i < 4; ++i) ss += x1[m][i] * x1[m][i] + x2[m][i] * x2[m][i];
                ss += __shfl_xor(ss, 16); ss += __shfl_xor(ss, 32);
                const float rstd = rsqrtf(ss * (1.f / 96.f) + 1e-6f);
                bf16_t* kp = KF + (size_t)r * 384 + wc * 96;
#pragma unroll
                for (int bj = 0; bj < 2; ++bj) { u32x4 w; const f32x4 v0 = acc[ai][bj][m][0], v1 = acc[ai][bj][m][1];
                    w.x = pk2(v0[0] * rstd, v0[1] * rstd); w.y = pk2(v0[2] * rstd, v0[3] * rstd);
                    w.z = pk2(v1[0] * rstd, v1[1] * rstd); w.w = pk2(v1[2] * rstd, v1[3] * rstd);
                    *(u32x4*)(kp + 32 * bj + 8 * fq) = w; }
                float o1[4], o2[4];
#pragma unroll
                for (int i = 0; i < 4; ++i) { const float a = x1[m][i] * rstd * w1[i], b = x2[m][i] * rstd * w2[i]; o1[i] = a * cs[m][i] - b * sn[m][i]; o2[i] = a * sn[m][i] + b * cs[m][i]; }
                *(u32x2*)(kp + 64 + 4 * fq) = (u32x2){pk2(o1[0], o1[1]), pk2(o1[2], o1[3])}; *(u32x2*)(kp + 80 + 4 * fq) = (u32x2){pk2(o2[0], o2[1]), pk2(o2[2], o2[3])}; }
            __builtin_amdgcn_sched_barrier(0); }
    } };
struct EpiGLU { static constexpr bool PERM = true, AFTER_DRAIN = false; bf16_t* O; const bf16_t* Z; const float* bias;
    __device__ __forceinline__ void operator()(const f32x4 (&acc)[2][2][4][2], const Unit& u, int wr, int wc, int fr_, int fq_) const {
        int fr = fr_, fq = fq_; asm volatile("" : "+v"(fr), "+v"(fq));
        const int row0 = u.pm * 256 + wr * 64 + fr, oc = u.pn * 128 + wc * 32 + 8 * fq;
#pragma unroll
        for (int ai = 0; ai < 2; ++ai) {
            float bv[8], bg[8];
            { const f32x4 b0 = *(const f32x4*)(bias + oc), b1 = *(const f32x4*)(bias + oc + 4), g0 = *(const f32x4*)(bias + 512 + oc), g1 = *(const f32x4*)(bias + 512 + oc + 4);
#pragma unroll
              for (int i = 0; i < 4; ++i) { bv[i] = b0[i]; bv[4 + i] = b1[i]; bg[i] = g0[i]; bg[4 + i] = g1[i]; } }
            u32x4 sgv[2][4];
#pragma unroll
            for (int m = 0; m < 4; ++m) sgv[ai][m] = *(const u32x4*)(Z + (size_t)(row0 + ai * 128 + m * 16) * LDZ + ZSG + oc);
#pragma unroll
            for (int m = 0; m < 4; ++m) { const size_t r = (size_t)(row0 + ai * 128 + m * 16);
                const u32x4 sg = sgv[ai][m];
                float g[8] = { lo16(sg.x), hi16(sg.x), lo16(sg.y), hi16(sg.y), lo16(sg.z), hi16(sg.z), lo16(sg.w), hi16(sg.w) };
                float o[8];
#pragma unroll
                for (int i = 0; i < 8; ++i) { const float zv = acc[ai][0][m][i >> 2][i & 3] + bv[i], zg = acc[ai][1][m][i >> 2][i & 3] + bg[i]; o[i] = zv * sigmoidf_(zg) * siluf_(g[i]); }
                u32x4 w; w.x = pk2(o[0], o[1]); w.y = pk2(o[2], o[3]); w.z = pk2(o[4], o[5]); w.w = pk2(o[6], o[7]);
                *(u32x4*)(O + r * 512 + oc) = w; }
            __builtin_amdgcn_sched_barrier(0); }
    } };
struct EpiBo { static constexpr bool PERM = true, AFTER_DRAIN = true; bf16_t* MIX; const bf16_t* Z; int branch;
    __device__ __forceinline__ void fused(f32x4 (&acc)[2][2][4][2], const Unit& u, int wr, int wc, int fr_, int fq_, LAS unsigned char* lds, int wid, int lane_) const {
        int fr = fr_, fq = fq_, lane = lane_; asm volatile("" : "+v"(fr), "+v"(fq), "+v"(lane));
        const int row0 = u.pm * 256 + wr * 64 + fr, col0 = u.pn * 256 + wc * 32 + 8 * fq;
        LAS unsigned char* wl = lds + wid * 16384;
#pragma unroll
        for (int ai = 0; ai < 2; ++ai)
#pragma unroll
            for (int m = 0; m < 4; ++m)
#pragma unroll
                for (int bj = 0; bj < 2; ++bj)
                    __builtin_amdgcn_global_load_lds((const unsigned*)(Z + (size_t)(row0 + ai * 128 + m * 16) * LDZ + ZMERGE + branch * 1024 + col0 + bj * 128), (LAS unsigned*)(wl + ((ai * 4 + m) * 2 + bj) * 1024), 16, 0, 0);
#pragma unroll
        for (int ai = 0; ai < 2; ++ai) {
            u32x4 pv[4][2];
#pragma unroll
            for (int m = 0; m < 4; ++m)
#pragma unroll
                for (int bj = 0; bj < 2; ++bj) pv[m][bj] = branch > 0 ? *(const u32x4*)(MIX + (size_t)(row0 + ai * 128 + m * 16) * 1024 + col0 + bj * 128) : (u32x4){0u, 0u, 0u, 0u};
            if (ai == 0) { asm volatile("s_waitcnt vmcnt(0)" ::: "memory"); __builtin_amdgcn_s_barrier(); asm volatile("" ::: "memory"); }
#pragma unroll
            for (int m = 0; m < 4; ++m) { const size_t r = (size_t)(row0 + ai * 128 + m * 16);
#pragma unroll
                for (int bj = 0; bj < 2; ++bj) { const u32x4 sg = *(const LAS u32x4*)(wl + ((ai * 4 + m) * 2 + bj) * 1024 + lane * 16), pp = pv[m][bj];
                    const float g[8] = { lo16(sg.x), hi16(sg.x), lo16(sg.y), hi16(sg.y), lo16(sg.z), hi16(sg.z), lo16(sg.w), hi16(sg.w) };
                    const float q[8] = { lo16(pp.x), hi16(pp.x), lo16(pp.y), hi16(pp.y), lo16(pp.z), hi16(pp.z), lo16(pp.w), hi16(pp.w) };
                    float o[8];
#pragma unroll
                    for (int i = 0; i < 8; ++i) o[i] = q[i] + sigmoidf_(g[i]) * acc[ai][bj][m][i >> 2][i & 3];
                    u32x4 w; w.x = pk2(o[0], o[1]); w.y = pk2(o[2], o[3]); w.z = pk2(o[4], o[5]); w.w = pk2(o[6], o[7]);
                    *(u32x4*)(MIX + r * 1024 + col0 + bj * 128) = w; } }
            __builtin_amdgcn_sched_barrier(0); }
        __syncthreads();
    }
    __device__ __forceinline__ void operator()(const f32x4 (&acc)[2][2][4][2], const Unit& u, int wr, int wc, int fr_, int fq_) const {
        int fr = fr_, fq = fq_; asm volatile("" : "+v"(fr), "+v"(fq));
        const int row0 = u.pm * 256 + wr * 64 + fr, col0 = u.pn * 256 + wc * 32 + 8 * fq;
#pragma unroll
        for (int ai = 0; ai < 2; ++ai)
#pragma unroll
          for (int mh = 0; mh < 4; mh += 2) {
            u32x4 gz[4][2], pv[4][2];
#pragma unroll
            for (int m = mh; m < mh + 2; ++m)
#pragma unroll
                for (int bj = 0; bj < 2; ++bj) { const size_t r = (size_t)(row0 + ai * 128 + m * 16);
                    gz[m][bj] = *(const u32x4*)(Z + r * LDZ + ZMERGE + branch * 1024 + col0 + bj * 128);
                    pv[m][bj] = branch > 0 ? *(const u32x4*)(MIX + r * 1024 + col0 + bj * 128) : (u32x4){0u, 0u, 0u, 0u}; }
#pragma unroll
            for (int m = mh; m < mh + 2; ++m) { const size_t r = (size_t)(row0 + ai * 128 + m * 16);
#pragma unroll
                for (int bj = 0; bj < 2; ++bj) { const u32x4 sg = gz[m][bj], pp = pv[m][bj];
                    const float g[8] = { lo16(sg.x), hi16(sg.x), lo16(sg.y), hi16(sg.y), lo16(sg.z), hi16(sg.z), lo16(sg.w), hi16(sg.w) };
                    const float q[8] = { lo16(pp.x), hi16(pp.x), lo16(pp.y), hi16(pp.y), lo16(pp.z), hi16(pp.z), lo16(pp.w), hi16(pp.w) };
                    float o[8];
#pragma unroll
                    for (int i = 0; i < 8; ++i) o[i] = q[i] + sigmoidf_(g[i]) * acc[ai][bj][m][i >> 2][i & 3];
                    u32x4 w; w.x = pk2(o[0], o[1]); w.y = pk2(o[2], o[3]); w.z = pk2(o[4], o[5]); w.w = pk2(o[6], o[7]);
                    *(u32x4*)(MIX + r * 1024 + col0 + bj * 128) = w; } }
            __builtin_amdgcn_sched_barrier(0); }
    } };
struct EpiOut { static constexpr bool PERM = false, AFTER_DRAIN = true; float* Y; const float* xp; const float* xs; const float* ada;
    __device__ __forceinline__ void fused(f32x4 (&acc)[2][2][4][2], const Unit& u, int wr, int wc, int fr_, int fq_, LAS unsigned char* lds, int wid, int lane_) const {
        int fr = fr_, fq = fq_, lane = lane_; asm volatile("" : "+v"(fr), "+v"(fq), "+v"(lane));
        const int row0 = u.pm * 256 + wr * 64 + fr, col0 = u.pn * 256 + wc * 32 + 4 * fq;
        LAS unsigned char* wl = lds + wid * 16384;
        const float* xb = (u.pm < 16 ? xp + (size_t)row0 * 1024 : xs + (size_t)(row0 - 4096) * 1024) + col0;
#pragma unroll
        for (int m = 0; m < 4; ++m)
#pragma unroll
            for (int bj = 0; bj < 2; ++bj)
#pragma unroll
                for (int n = 0; n < 2; ++n) __builtin_amdgcn_global_load_lds((const unsigned*)(xb + (size_t)(m * 16) * 1024 + bj * 128 + n * 16), (LAS unsigned*)(wl + ((m * 2 + bj) * 2 + n) * 1024), 16, 0, 0);
        f32x4 x1[4][2][2];
#pragma unroll
        for (int m = 0; m < 4; ++m)
#pragma unroll
            for (int bj = 0; bj < 2; ++bj)
#pragma unroll
                for (int n = 0; n < 2; ++n) x1[m][bj][n] = *(const f32x4*)(xb + (size_t)(128 + m * 16) * 1024 + bj * 128 + n * 16);
        const int ar = u.pm < 16 ? 0 : 1 + ((u.pm - 16) >> 2);
        const float* gp = ada + ar * 3072 + 2048;
        f32x4 gv[2][2];
#pragma unroll
        for (int bj = 0; bj < 2; ++bj)
#pragma unroll
            for (int n = 0; n < 2; ++n) gv[bj][n] = *(const f32x4*)(gp + col0 + bj * 128 + n * 16);
        asm volatile("s_waitcnt vmcnt(0)" ::: "memory"); __builtin_amdgcn_s_barrier(); asm volatile("" ::: "memory");
        float* yb = Y + (size_t)row0 * 1024 + col0;
#pragma unroll
        for (int m = 0; m < 4; ++m)
#pragma unroll
            for (int bj = 0; bj < 2; ++bj)
#pragma unroll
                for (int n = 0; n < 2; ++n) { const f32x4 xv = *(const LAS f32x4*)(wl + ((m * 2 + bj) * 2 + n) * 1024 + lane * 16);
                    *(f32x4*)(yb + (size_t)(m * 16) * 1024 + bj * 128 + n * 16) = xv + gv[bj][n] * acc[0][bj][m][n];
                    *(f32x4*)(yb + (size_t)(128 + m * 16) * 1024 + bj * 128 + n * 16) = x1[m][bj][n] + gv[bj][n] * acc[1][bj][m][n]; }
        __syncthreads();
    }
    __device__ __forceinline__ void operator()(const f32x4 (&acc)[2][2][4][2], const Unit& u, int wr, int wc, int fr_, int fq_) const {
        int fr = fr_, fq = fq_; asm volatile("" : "+v"(fr), "+v"(fq));
        const int row0 = u.pm * 256 + wr * 64 + fr, col0 = u.pn * 256 + wc * 32 + 4 * fq;
        const int ar = u.pm < 16 ? 0 : 1 + ((u.pm - 16) >> 2);
        const float* gp = ada + ar * 3072 + 2048;
        f32x4 gv[2][2];
#pragma unroll
        for (int bj = 0; bj < 2; ++bj)
#pragma unroll
            for (int n = 0; n < 2; ++n) gv[bj][n] = *(const f32x4*)(gp + col0 + bj * 128 + n * 16);
#pragma unroll
        for (int ai = 0; ai < 2; ++ai)
#pragma unroll
          for (int mh = 0; mh < 4; mh += 2) {
            f32x4 xv[4][2][2];
#pragma unroll
            for (int m = mh; m < mh + 2; ++m) { const int r = row0 + ai * 128 + m * 16;
                const float* xr = (r < 4096 ? xp + (size_t)r * 1024 : xs + (size_t)(r - 4096) * 1024) + col0;
#pragma unroll
                for (int bj = 0; bj < 2; ++bj)
#pragma unroll
                    for (int n = 0; n < 2; ++n) xv[m][bj][n] = *(const f32x4*)(xr + bj * 128 + n * 16); }
#pragma unroll
            for (int m = mh; m < mh + 2; ++m) { const int r = row0 + ai * 128 + m * 16;
                float* yr = Y + (size_t)r * 1024 + col0;
#pragma unroll
                for (int bj = 0; bj < 2; ++bj)
#pragma unroll
                    for (int n = 0; n < 2; ++n) *(f32x4*)(yr + bj * 128 + n * 16) = xv[m][bj][n] + gv[bj][n] * acc[ai][bj][m][n]; }
            __builtin_amdgcn_sched_barrier(0); }
    } };

__device__ __forceinline__ void job_ada(const Params& p, int j, lds_t lds) {
    LAS float* sc = (LAS float*)lds; LAS float* red = sc + 5 * 1024;
    const int l = j / 96, c0 = (j % 96) * 32, tid = tid_opaque(p);
    for (int i = tid; i < 5 * 1024; i += 512) { const int r = i >> 10, k = i & 1023; const float v = r == 0 ? p.in[I_CCTX][k] : p.in[I_C][(r - 1) * 1024 + k]; sc[i] = v / (1.f + expf(-v)); }
    __syncthreads();
    const int col = tid & 31, kg = tid >> 5; const float* W = p.in[I_WADA] + (size_t)l * 1024 * 3072 + (size_t)(kg * 64) * 3072 + c0 + col;
    float a0 = 0.f, a1 = 0.f, a2 = 0.f, a3 = 0.f, a4 = 0.f;
#pragma unroll 1
    for (int kb = 0; kb < 64; kb += 16) { float w[16];
#pragma unroll
        for (int i = 0; i < 16; ++i) w[i] = W[(size_t)(kb + i) * 3072];
#pragma unroll
        for (int i = 0; i < 16; ++i) { const int k = kg * 64 + kb + i; a0 += sc[k] * w[i]; a1 += sc[1024 + k] * w[i]; a2 += sc[2048 + k] * w[i]; a3 += sc[3072 + k] * w[i]; a4 += sc[4096 + k] * w[i]; } }
    red[(kg * 5 + 0) * 32 + col] = a0; red[(kg * 5 + 1) * 32 + col] = a1; red[(kg * 5 + 2) * 32 + col] = a2; red[(kg * 5 + 3) * 32 + col] = a3; red[(kg * 5 + 4) * 32 + col] = a4;
    __syncthreads();
    if (tid < 160) { const int r = tid >> 5, cc = tid & 31; float s = p.in[I_BADA][l * 3072 + c0 + cc];
        for (int g = 0; g < 16; ++g) s += red[(g * 5 + r) * 32 + cc];
        ((float*)(p.ws + OFF_ADA))[(l * 5 + r) * 3072 + c0 + cc] = s; }
    __syncthreads();
}
__device__ __forceinline__ void job_ctx(const Params& p, int j) {
    const int base = j * 4096 + tid_opaque(p) * 8; const int l = base / (2048 * 256), rem = base % (2048 * 256), row = rem >> 8, c = rem & 255, b = row >> 9, jj = row & 511;
    const float* s = p.in[I_CKV] + ((size_t)((b * 2 + l) * 512 + jj)) * 256 + c;
    const f32x4 v0 = *(const f32x4*)s, v1 = *(const f32x4*)(s + 4);
    bf16_t* d = (bf16_t*)(p.ws + (l == 0 ? OFF_CTX0 : OFF_CTX1)) + (size_t)row * 256 + c;
    store8(d, v0, v1);
}
__device__ __forceinline__ void job_rope(const Params& p, int j) {
    const int idx = j * 512 + tid_opaque(p), pos = idx >> 4, i = idx & 15, f = i & 7;
    const float inv = powf(10000.f, -(float)f / 8.f); const float ang = (float)(i < 8 ? (pos >> 6) : (pos & 63)) * inv;
    float* R = (float*)(p.ws + OFF_ROPE); R[idx] = cosf(ang); R[16384 + idx] = sinf(ang);
}

__device__ __forceinline__ void job_prep(const Params& p, int l, int j) {
    const int tid = tid_opaque(p), wid = tid >> 6, lane = tid & 63, row = j * 8 + wid;
    const float* x = l == 0 ? (row < 4096 ? p.in[I_XP] + (size_t)row * 1024 : p.in[I_XS] + (size_t)(row - 4096) * 1024) : p.out + (size_t)row * 1024;
    const int ar = row < 4096 ? 0 : 1 + ((row - 4096) >> 10);
    const float* ada = (const float*)(p.ws + OFF_ADA) + (l * 5 + ar) * 3072; const float* nw = p.in[I_NORMW] + l * 1024;
    f32x4 v[4]; float ss = 0.f;
#pragma unroll
    for (int i = 0; i < 4; ++i) { v[i] = *(const f32x4*)(x + i * 256 + lane * 4); ss += v[i][0] * v[i][0] + v[i][1] * v[i][1] + v[i][2] * v[i][2] + v[i][3] * v[i][3]; }
#pragma unroll
    for (int o = 1; o < 64; o <<= 1) ss += __shfl_xor(ss, o);
    const float rstd = rsqrtf(ss * (1.f / 1024.f) + 1e-6f);
    bf16_t* h = (bf16_t*)(p.ws + OFF_HB) + (size_t)row * 1024;
#pragma unroll
    for (int i = 0; i < 4; ++i) { const int c = i * 256 + lane * 4; const f32x4 w = *(const f32x4*)(nw + c), sh = *(const f32x4*)(ada + c), sc = *(const f32x4*)(ada + 1024 + c);
        float o[4];
#pragma unroll
        for (int k = 0; k < 4; ++k) o[k] = v[i][k] * rstd * w[k] * (1.f + sc[k]) + sh[k];
        u32x2 pk; pk.x = pk2(o[0], o[1]); pk.y = pk2(o[2], o[3]); *(u32x2*)(h + c) = pk; }
}
__device__ __forceinline__ void wt_tile(const Params& p, const float* src, int ldsrc, int sbase, int nvalid, int mode, bf16_t* dst, int K, int n0, int k0, lds_t lds) {
    LAS float* t = (LAS float*)lds; const int tid = tid_opaque(p);
    const int nn = tid & 255, kh = tid >> 8; const int sc = mode == 0 ? sbase + nn : mode == 1 ? ((nn >> 7) & 1) * 512 + sbase + (nn & 127) : ((nn >> 5) & 3) * 64 + (nn >> 7) * 32 + (nn & 31); const bool ok = mode != 0 || nn < nvalid;
    float v[32];
#pragma unroll
    for (int i = 0; i < 32; ++i) v[i] = ok ? src[(size_t)(k0 + 2 * i + kh) * ldsrc + sc] : 0.f;
#pragma unroll
    for (int i = 0; i < 32; ++i) t[(2 * i + kh) * 257 + nn] = v[i];
    __syncthreads();
#pragma unroll
    for (int ps = 0; ps < 4; ++ps) { const int n = ps * 64 + (tid >> 3), kc = tid & 7; const LAS float* s = t + (kc * 8) * 257 + n; u32x4 w;
        w.x = pk2(s[0], s[257]); w.y = pk2(s[514], s[771]); w.z = pk2(s[1028], s[1285]); w.w = pk2(s[1542], s[1799]);
        *(u32x4*)(dst + (size_t)(n0 + n) * K + k0 + kc * 8) = w; }
    __syncthreads();
}
constexpr int WT_WIN = 27 * 16, WT_WUQ = 2 * 6, WT_WKV = 3 * 4, WT_WGLU = 4 * 8, WT_WBO = 4 * 8, WT_WOUT = 4 * 16, WT_EARLY = WT_WIN + WT_WUQ + WT_WKV + WT_WGLU, WT_TOTAL = WT_EARLY + 3 * WT_WBO + WT_WOUT;
__device__ __forceinline__ void job_wt(const Params& p, int l, int t, lds_t lds) {
    if (t < WT_WIN) { const int nt = t / 16, kt = t % 16; wt_tile(p, p.in[I_WIN] + (size_t)l * 1024 * 6848, 6848, nt * 256, 6848 - nt * 256, 0, (bf16_t*)(p.ws + OFF_WIN), 1024, nt * 256, kt * 64, lds); return; } t -= WT_WIN;
    if (t < WT_WUQ) { const int nt = t / 6, kt = t % 6; wt_tile(p, p.in[I_WUQ] + (size_t)l * 384 * 384, 384, nt * 256, 384 - nt * 256, 0, (bf16_t*)(p.ws + OFF_WUQ), 384, nt * 256, kt * 64, lds); return; } t -= WT_WUQ;
    if (t < WT_WKV) { const int nt = t / 4, kt = t % 4;
        if (nt == 0) wt_tile(p, p.in[I_WUK] + (size_t)l * 256 * 256, 256, 0, 256, 2, (bf16_t*)(p.ws + OFF_WKV), 256, 0, kt * 64, lds);
        else wt_tile(p, p.in[I_WUV] + (size_t)l * 256 * 512, 512, (nt - 1) * 256, 256, 0, (bf16_t*)(p.ws + OFF_WKV), 256, nt * 256, kt * 64, lds);
        return; } t -= WT_WKV;
    if (t < WT_WGLU) { const int nt = t / 8, kt = t % 8; wt_tile(p, p.in[I_WGLU] + (size_t)l * 512 * 1024, 1024, nt * 128, 256, 1, (bf16_t*)(p.ws + OFF_WGLU), 512, nt * 256, kt * 64, lds); return; } t -= WT_WGLU;
    if (t < 3 * WT_WBO) { const int br = t / WT_WBO, tt = t % WT_WBO, nt = tt / 8, kt = tt % 8;
        wt_tile(p, p.in[I_WBOG + br] + (size_t)l * 512 * 1024, 1024, nt * 256, 256, 0, (bf16_t*)(p.ws + OFF_WBO) + (size_t)br * 1024 * 512, 512, nt * 256, kt * 64, lds); return; } t -= 3 * WT_WBO;
    { const int nt = t / 16, kt = t % 16; wt_tile(p, p.in[I_WOUT] + (size_t)l * 1024 * 1024, 1024, nt * 256, 256, 0, (bf16_t*)(p.ws + OFF_WOUT), 1024, nt * 256, kt * 64, lds); }
}
__device__ __forceinline__ void job_s5setup(const Params& p, int l, int j, lds_t lds) {
    const int g = j / 3, which = j % 3, tid = tid_opaque(p);
    LAS f32x2_t* pw = (LAS f32x2_t*)lds;
    LAS f32x2_t* Bt = pw + 2 * 17 * 64;
    LAS f32x2_t* Cn = Bt + 2 * 64 * 16;
    LAS float* Kt = (LAS float*)(Cn + 64 * 16);
    LAS float* raw = Kt + 8192;
    { const size_t gb = (size_t)(l * 32 + g) * 1024;
      for (int i = tid; i < 1024; i += 512) { raw[i] = p.in[I_BRE][gb + i]; raw[1024 + i] = p.in[I_BIM][gb + i]; raw[2048 + i] = p.in[I_CRE][gb + i]; raw[3072 + i] = p.in[I_CIM][gb + i]; }
      if (tid < 128) { const int d = tid >> 6, n = tid & 63; raw[4096 + tid] = p.in[I_ARE][((l * 2 + d) * 32 + g) * 64 + n]; raw[4224 + tid] = p.in[I_AIM][((l * 2 + d) * 32 + g) * 64 + n]; }
      if (tid < 2) raw[4352 + tid] = p.in[I_LOGDT][(l * 2 + tid) * 32 + g]; }
    __syncthreads();
    if (tid < 128) { const int d = tid >> 6, n = tid & 63;
        const float dt = expf(raw[4352 + d]);
        const float are = raw[4096 + tid], aim = raw[4224 + tid];
        for (int tau = 0; tau <= 16; ++tau) { const float mag = expf(are * dt * (float)tau); float s, c; sincosf(aim * dt * (float)tau, &s, &c); pw[(d * 17 + tau) * 64 + n] = (f32x2_t){mag * c, mag * s}; }
        float s1, c1; sincosf(aim * dt, &s1, &c1); float sh = sinf(0.5f * aim * dt);
        const float em1 = expm1f(are * dt), mag1 = em1 + 1.f;
        const float nre = em1 * c1 - 2.f * sh * sh, abim = mag1 * s1, den = are * are + aim * aim;
        const float cfr = (nre * are + abim * aim) / den, cfi = (abim * are - nre * aim) / den;
        for (int q = 0; q < 16; ++q) { const float br = raw[n * 16 + q], bi = raw[1024 + n * 16 + q];
            Bt[(d * 64 + n) * 16 + q] = (f32x2_t){cfr * br - cfi * bi, cfr * bi + cfi * br}; }
        if (which == 1) ((f32x2_t*)(p.ws + OFF_P16))[(g * 2 + d) * 64 + n] = pw[(d * 17 + 16) * 64 + n];
    }
    for (int i = tid; i < 1024; i += 512) { const int n = i >> 4, pp = i & 15; Cn[i] = (f32x2_t){raw[2048 + pp * 64 + n], raw[3072 + pp * 64 + n]}; }
    __syncthreads();
    bf16_t* M = (bf16_t*)(p.ws + OFF_S5M) + (size_t)(g * 3 + which) * 65536;
    if (which == 0) {
        for (int i = tid; i < 8192; i += 512) { const int d = i >> 12, tau = (i >> 8) & 15, pp = (i >> 4) & 15, q = i & 15; float s = 0.f;
#pragma unroll 16
            for (int n = 0; n < 64; ++n) { const f32x2_t c = Cn[n * 16 + pp], w = pw[(d * 17 + tau) * 64 + n], b = Bt[(d * 64 + n) * 16 + q];
                const float cwr = c.x * w.x - c.y * w.y, cwi = c.x * w.y + c.y * w.x; s += cwr * b.x - cwi * b.y; }
            Kt[i] = s; }
        __syncthreads();
#pragma unroll 8
        for (int i = tid; i < 65536; i += 512) { const int no = i >> 8, k = i & 255, t = no >> 4, pp = no & 15, s = k >> 4, q = k & 15; float v;
            if (t > s) v = Kt[(0 * 16 + (t - s)) * 256 + pp * 16 + q];
            else if (t < s) v = Kt[(1 * 16 + (s - t)) * 256 + pp * 16 + q];
            else { v = Kt[pp * 16 + q] + Kt[16 * 256 + pp * 16 + q]; if (pp == q) v += p.in[I_S5D][l * 512 + g * 16 + pp]; }
            M[i] = f2bf(v); }
    } else if (which == 1) {
#pragma unroll 8
        for (int i = tid; i < 65536; i += 512) { const int no = i >> 8, k = i & 255, d = no >> 7, ri = (no >> 6) & 1, n = no & 63, s = k >> 4, q = k & 15; const int e = d == 0 ? 15 - s : s;
            const f32x2_t w = pw[(d * 17 + e) * 64 + n], b = Bt[(d * 64 + n) * 16 + q];
            M[i] = f2bf(ri == 0 ? w.x * b.x - w.y * b.y : w.x * b.y + w.y * b.x); }
    } else {
#pragma unroll 8
        for (int i = tid; i < 65536; i += 512) { const int no = i >> 8, k = i & 255, t = no >> 4, pp = no & 15, d = k >> 7, ri = (k >> 6) & 1, n = k & 63; const int e = d == 0 ? t + 1 : 16 - t;
            const f32x2_t c = Cn[n * 16 + pp], w = pw[(d * 17 + e) * 64 + n];
            M[i] = f2bf(ri == 0 ? c.x * w.x - c.y * w.y : -(c.x * w.y + c.y * w.x)); }
    }
    __syncthreads();
}

__device__ __forceinline__ float gelu_tanh(float x) { const float u = 0.7978845608f * (x + 0.044715f * x * x * x); const float t = 1.f - 2.f / (1.f + __expf(2.f * u)); return 0.5f * x * (1.f + t); }
__device__ __forceinline__ void job_s5(const Params& p, int l, int j, lds_t lds) {
    const int tid = tid_opaque(p), wid = tid >> 6, lane = tid & 63, lr = lane & 15, lq = lane >> 4;
    const int bb = j >> 5, g = j & 31;
    const int M = bb < 16 ? 16 : 64, MT = M >> 4; const int tok0 = bb < 16 ? bb * 256 : 4096 + (bb - 16) * 1024;
    LAS bf16_t* Us = (LAS bf16_t*)lds; LAS bf16_t* Xs = Us + 64 * 264; LAS float* Xin = (LAS float*)(lds + 2 * 64 * 264 * 2);
    const bf16_t* Z = (const bf16_t*)(p.ws + OFF_Z);
    const bf16_t* TT = (const bf16_t*)(p.ws + OFF_S5M) + (size_t)(g * 3) * 65536; const bf16_t* G = TT + 65536; const bf16_t* Cc = G + 65536;
    bf16x8 bq[8][2];
#pragma unroll
    for (int ks = 0; ks < 8; ++ks) { bq[ks][0] = *(const bf16x8*)(G + (size_t)(wid * 32 + lr) * 256 + ks * 32 + lq * 8); bq[ks][1] = *(const bf16x8*)(G + (size_t)(wid * 32 + 16 + lr) * 256 + ks * 32 + lq * 8); }
    f32x2_t a16 = {0.f, 0.f}; float xr = 0.f, xi = 0.f;
    if (tid < 128) { const int d = tid >> 6, n = tid & 63; a16 = ((const f32x2_t*)(p.ws + OFF_P16))[(g * 2 + d) * 64 + n];
        if (bb >= 16) { const size_t o = ((size_t)(((bb - 16) * 2 + l) * 2 + d) * 2) * 2048 + g * 64 + n; xr = p.in[I_SS5][o]; xi = p.in[I_SS5][o + 2048]; } }
    for (int idx = tid; idx < M * 32; idx += 512) { const int tok = idx >> 1, hf = idx & 1;
        *(LAS u32x4*)(Us + (tok >> 4) * 264 + (tok & 15) * 16 + hf * 8) = *(const u32x4*)(Z + (size_t)(tok0 + tok) * LDZ + ZSU + g * 16 + hf * 8); }
    __syncthreads();
    f32x4 acc[4][2];
#pragma unroll
    for (int a = 0; a < 4; ++a) { acc[a][0] = (f32x4){0.f, 0.f, 0.f, 0.f}; acc[a][1] = acc[a][0]; }
#pragma unroll
    for (int ks = 0; ks < 8; ++ks)
#pragma unroll
        for (int mt = 0; mt < 4; ++mt) if (mt < MT) { const bf16x8 a = LDSFRAG(Us + (mt * 16 + lr) * 264 + ks * 32 + lq * 8); acc[mt][0] = MFMA16(a, bq[ks][0], acc[mt][0]); acc[mt][1] = MFMA16(a, bq[ks][1], acc[mt][1]); }
    bf16x8 bc[8][2];
#pragma unroll
    for (int ks = 0; ks < 8; ++ks) { bq[ks][0] = *(const bf16x8*)(TT + (size_t)(wid * 32 + lr) * 256 + ks * 32 + lq * 8); bq[ks][1] = *(const bf16x8*)(TT + (size_t)(wid * 32 + 16 + lr) * 256 + ks * 32 + lq * 8);
        bc[ks][0] = *(const bf16x8*)(Cc + (size_t)(wid * 32 + lr) * 256 + ks * 32 + lq * 8); bc[ks][1] = *(const bf16x8*)(Cc + (size_t)(wid * 32 + 16 + lr) * 256 + ks * 32 + lq * 8); }
#pragma unroll
    for (int mt = 0; mt < 4; ++mt) if (mt < MT)
#pragma unroll
        for (int ct = 0; ct < 2; ++ct)
#pragma unroll
            for (int r = 0; r < 4; ++r) Xin[(mt * 16 + lq * 4 + r) * 260 + wid * 32 + ct * 16 + lr] = acc[mt][ct][r];
    __syncthreads();
    if (tid < 128) { const int d = tid >> 6, n = tid & 63;
        const int cre = d * 128 + n, cim = cre + 64;
        for (int i = 0; i < M; ++i) { const int c = d == 0 ? i : M - 1 - i;
            Xs[c * 264 + cre] = f2bf(xr); Xs[c * 264 + cim] = f2bf(xi);
            const float ur = Xin[c * 260 + cre], ui = Xin[c * 260 + cim];
            const float nr = a16.x * xr - a16.y * xi + ur, ni = a16.x * xi + a16.y * xr + ui; xr = nr; xi = ni; }
        if (bb < 16) { const size_t o = OUT_S5 + ((size_t)((bb * 2 + l) * 2 + d) * 2) * 2048 + g * 64 + n; p.out[o] = xr; p.out[o + 2048] = xi; }
    }
    __syncthreads();
#pragma unroll
    for (int a = 0; a < 4; ++a) { acc[a][0] = (f32x4){0.f, 0.f, 0.f, 0.f}; acc[a][1] = acc[a][0]; }
#pragma unroll
    for (int ks = 0; ks < 8; ++ks)
#pragma unroll
        for (int mt = 0; mt < 4; ++mt) if (mt < MT) { const bf16x8 a = LDSFRAG(Us + (mt * 16 + lr) * 264 + ks * 32 + lq * 8); acc[mt][0] = MFMA16(a, bq[ks][0], acc[mt][0]); acc[mt][1] = MFMA16(a, bq[ks][1], acc[mt][1]); }
#pragma unroll
    for (int ks = 0; ks < 8; ++ks)
#pragma unroll
        for (int mt = 0; mt < 4; ++mt) if (mt < MT) { const bf16x8 a = LDSFRAG(Xs + (mt * 16 + lr) * 264 + ks * 32 + lq * 8); acc[mt][0] = MFMA16(a, bc[ks][0], acc[mt][0]); acc[mt][1] = MFMA16(a, bc[ks][1], acc[mt][1]); }
    bf16_t* Yg = (bf16_t*)(p.ws + OFF_YG);
#pragma unroll
    for (int mt = 0; mt < 4; ++mt) if (mt < MT)
#pragma unroll
        for (int ct = 0; ct < 2; ++ct)
#pragma unroll
            for (int r = 0; r < 4; ++r) { const int chunk = mt * 16 + lq * 4 + r, t = wid * 2 + ct;
                Yg[(size_t)(tok0 + chunk * 16 + t) * 512 + g * 16 + lr] = f2bf(gelu_tanh(acc[mt][ct][r])); }
    __syncthreads();
}
__device__ __forceinline__ void job_mlaprep(const Params& p, int l, int j) {
    const int tid = tid_opaque(p), wid = tid >> 6, lane = tid & 63, row = j * 8 + wid;
    const bf16_t* z = (const bf16_t*)(p.ws + OFF_Z) + (size_t)row * LDZ;
    float q[6], kv[4]; float sq = 0.f, sk = 0.f;
#pragma unroll
    for (int i = 0; i < 6; ++i) { q[i] = bf2f(z[ZMQ + i * 64 + lane]); sq += q[i] * q[i]; }
#pragma unroll
    for (int i = 0; i < 4; ++i) { kv[i] = bf2f(z[ZMKV + i * 64 + lane]); sk += kv[i] * kv[i]; }
#pragma unroll
    for (int o = 1; o < 64; o <<= 1) { sq += __shfl_xor(sq, o); sk += __shfl_xor(sk, o); }
    const float rq = rsqrtf(sq * (1.f / 384.f) + 1e-6f), rk = rsqrtf(sk * (1.f / 256.f) + 1e-6f);
    bf16_t* aq = (bf16_t*)(p.ws + OFF_AQ) + (size_t)row * 384; bf16_t* ck = (bf16_t*)(p.ws + OFF_CKVN) + (size_t)row * 256;
#pragma unroll
    for (int i = 0; i < 6; ++i) aq[i * 64 + lane] = f2bf(q[i] * rq * p.in[I_QNORM][l * 384 + i * 64 + lane]);
    const bool prompt = row < 4096; const int b = row >> 8, t = row & 255;
#pragma unroll
    for (int i = 0; i < 4; ++i) { const float v = kv[i] * rk * p.in[I_KVNORM][l * 256 + i * 64 + lane]; ck[i * 64 + lane] = f2bf(v);
        if (prompt) p.out[OUT_CKV + ((size_t)((b * 2 + l) * 256 + t)) * 256 + i * 64 + lane] = v; }
    if (prompt && lane < 32) p.out[OUT_KR + ((size_t)((b * 2 + l) * 256 + t)) * 32 + lane] = bf2f(z[ZMKR + lane]);
}
__device__ __forceinline__ float logsigmoidf_(float x) { return fminf(x, 0.f) - __logf(1.f + __expf(-fabsf(x))); }
__device__ __forceinline__ void job_glaA(const Params& p, int l, int j, lds_t lds) {
    const int tid = tid_opaque(p), wid = tid >> 6, lane = tid & 63, lr = lane & 15, lq = lane >> 4;
    const int ck = j >> 2, h = j & 3, tok0 = ck * 64;
    LAS bf16_t* QDf = (LAS bf16_t*)lds; LAS bf16_t* QDb = QDf + 4608; LAS bf16_t* KDf = QDb + 4608; LAS bf16_t* KDb = KDf + 4608; LAS bf16_t* KRf = KDb + 4608; LAS bf16_t* KRb = KRf + 4608;
    LAS bf16_t* VT = KRb + 4608;
    LAS bf16_t* ATT = VT + 9216;
    LAS float* GA = (LAS float*)(ATT + 4608);
    LAS float* TOT = GA + 2048;
    const bf16_t* Z = (const bf16_t*)(p.ws + OFF_Z);
    { const int c = tid >> 3, part = tid & 7; const u32x2 gv = *(const u32x2*)(Z + (size_t)(tok0 + c) * LDZ + ZGA + part * 4);
      GA[c * 32 + part * 4 + 0] = lo16(gv.x); GA[c * 32 + part * 4 + 1] = hi16(gv.x); GA[c * 32 + part * 4 + 2] = lo16(gv.y); GA[c * 32 + part * 4 + 3] = hi16(gv.y);
      const bf16_t* vp = Z + (size_t)(tok0 + c) * LDZ + ZV + h * 128 + part * 16;
      const u32x4 v0 = *(const u32x4*)vp, v1 = *(const u32x4*)(vp + 8);
      const unsigned w[8] = { v0.x, v0.y, v0.z, v0.w, v1.x, v1.y, v1.z, v1.w };
#pragma unroll
      for (int i = 0; i < 8; ++i) { VT[(part * 16 + 2 * i) * 72 + c] = (bf16_t)(w[i] & 0xffffu); VT[(part * 16 + 2 * i + 1) * 72 + c] = (bf16_t)(w[i] >> 16); } }
    __syncthreads();
    const int d = tid & 63, cg_ = tid >> 6;
    float laf[8], lab[8]; bf16_t qraw[8], kraw[8];
#pragma unroll
    for (int i = 0; i < 8; ++i) { const size_t zr = (size_t)(tok0 + cg_ * 8 + i) * LDZ; qraw[i] = Z[zr + ZQ + h * 64 + d]; kraw[i] = Z[zr + ZK + h * 64 + d]; }
    { float wf[16], wb[16];
#pragma unroll
      for (int r = 0; r < 16; ++r) { wf[r] = p.in[I_WA2][((size_t)((l * 2 + 0) * 16 + r)) * 256 + h * 64 + d]; wb[r] = p.in[I_WA2][((size_t)((l * 2 + 1) * 16 + r)) * 256 + h * 64 + d]; }
      const float bf_ = p.in[I_BA][(l * 2 + 0) * 256 + h * 64 + d], bb_ = p.in[I_BA][(l * 2 + 1) * 256 + h * 64 + d];
#pragma unroll
      for (int i = 0; i < 8; ++i) { const int c = cg_ * 8 + i; float xf = bf_, xb = bb_;
#pragma unroll
          for (int r = 0; r < 16; ++r) { xf += GA[c * 32 + r] * wf[r]; xb += GA[c * 32 + 16 + r] * wb[r]; }
          laf[i] = logsigmoidf_(xf) * (1.f / 16.f); lab[i] = logsigmoidf_(xb) * (1.f / 16.f); } }
#pragma unroll
    for (int i = 1; i < 8; ++i) laf[i] += laf[i - 1];
#pragma unroll
    for (int i = 6; i >= 0; --i) lab[i] += lab[i + 1];
    TOT[(0 * 8 + cg_) * 64 + d] = laf[7]; TOT[(1 * 8 + cg_) * 64 + d] = lab[0];
    __syncthreads();
    float offf = 0.f, offb = 0.f, Tf = 0.f, Tb = 0.f;
#pragma unroll
    for (int g = 0; g < 8; ++g) { const float a = TOT[g * 64 + d], b = TOT[(8 + g) * 64 + d]; Tf += a; Tb += b; if (g < cg_) offf += a; if (g > cg_) offb += b; }
    bf16_t* QD = (bf16_t*)(p.ws + OFF_QD);
#pragma unroll
    for (int i = 0; i < 8; ++i) { const int c = cg_ * 8 + i;
        const float q = bf2f(qraw[i]) * 0.125f, k = bf2f(kraw[i]);
        const float bf_ = offf + laf[i], bb_ = offb + lab[i];
        const bf16_t qf = f2bf(q * __expf(bf_)), qb = f2bf(q * __expf(bb_));
        QDf[c * 72 + d] = qf; QDb[c * 72 + d] = qb;
        KDf[c * 72 + d] = f2bf(k * __expf(-bf_)); KDb[c * 72 + d] = f2bf(k * __expf(-bb_));
        KRf[d * 72 + c] = f2bf(k * __expf(Tf - bf_)); KRb[d * 72 + c] = f2bf(k * __expf(Tb - bb_));
        QD[(size_t)(tok0 + c) * 256 + h * 64 + d] = qf; QD[(size_t)(8192 + tok0 + c) * 256 + h * 64 + d] = qb; }
    if (cg_ == 0) { float* DEC = (float*)(p.ws + OFF_DEC); DEC[((0 * 128 + ck) * 4 + h) * 64 + d] = __expf(Tf); DEC[((1 * 128 + ck) * 4 + h) * 64 + d] = __expf(Tb); }
    __syncthreads();
#pragma unroll
    for (int q2 = 0; q2 < 2; ++q2) { const int tt = wid * 2 + q2, ti = tt >> 2, tj = tt & 3; f32x4 af = {0.f, 0.f, 0.f, 0.f}, ab = af;
#pragma unroll
        for (int ks = 0; ks < 2; ++ks) { const int ko = ks * 32 + lq * 8;
            af = MFMA16(LDSFRAG(QDf + (ti * 16 + lr) * 72 + ko), LDSFRAG(KDf + (tj * 16 + lr) * 72 + ko), af);
            ab = MFMA16(LDSFRAG(QDb + (ti * 16 + lr) * 72 + ko), LDSFRAG(KDb + (tj * 16 + lr) * 72 + ko), ab); }
#pragma unroll
        for (int r = 0; r < 4; ++r) { const int c = ti * 16 + lq * 4 + r, s = tj * 16 + lr; const float v = (s <= c ? af[r] : 0.f) + (s >= c ? ab[r] : 0.f); ATT[c * 72 + s] = f2bf(v); } }
    __syncthreads();
    bf16x8 vb[2];
#pragma unroll
    for (int ks = 0; ks < 2; ++ks) vb[ks] = LDSFRAG(VT + (wid * 16 + lr) * 72 + ks * 32 + lq * 8);
    bf16_t* OI = (bf16_t*)(p.ws + OFF_OIB); bf16_t* KV = (bf16_t*)(p.ws + OFF_KV);
#pragma unroll
    for (int ct = 0; ct < 4; ++ct) { f32x4 a = {0.f, 0.f, 0.f, 0.f};
#pragma unroll
        for (int ks = 0; ks < 2; ++ks) a = MFMA16(LDSFRAG(ATT + (ct * 16 + lr) * 72 + ks * 32 + lq * 8), vb[ks], a);
#pragma unroll
        for (int r = 0; r < 4; ++r) OI[(size_t)(tok0 + ct * 16 + lq * 4 + r) * 512 + h * 128 + wid * 16 + lr] = f2bf(a[r]); }
#pragma unroll
    for (int dir = 0; dir < 2; ++dir) { const LAS bf16_t* KR = dir == 0 ? KRf : KRb; bf16_t* kvp = KV + ((size_t)((dir * 128 + ck) * 4 + h)) * 8192;
#pragma unroll
        for (int dt = 0; dt < 4; ++dt) { f32x4 a = {0.f, 0.f, 0.f, 0.f};
#pragma unroll
            for (int ks = 0; ks < 2; ++ks) a = MFMA16(LDSFRAG(KR + (dt * 16 + lr) * 72 + ks * 32 + lq * 8), vb[ks], a);
#pragma unroll
            for (int r = 0; r < 4; ++r) kvp[(dt * 16 + lq * 4 + r) * 128 + wid * 16 + lr] = f2bf(a[r]); } }
    __syncthreads();
}

__device__ __forceinline__ void job_glaB(const Params& p, int l, int j) {
    const int qt = j & 3, h = (j >> 2) & 3, rest = j >> 4, bb = rest % 20, dir = rest / 20;
    const int idx0 = qt * 2048 + tid_opaque(p);
    const int nck = bb < 16 ? 4 : 16, ck0 = bb < 16 ? bb * 4 : 64 + (bb - 16) * 16;
    float S[4];
#pragma unroll
    for (int e = 0; e < 4; ++e) S[e] = bb >= 16 ? p.in[I_SGLA][((size_t)((((bb - 16) * 2 + l) * 2 + dir) * 4 + h)) * 8192 + idx0 + e * 512] : 0.f;
    const bf16_t* KV = (const bf16_t*)(p.ws + OFF_KV); const float* DEC = (const float*)(p.ws + OFF_DEC); bf16_t* ST = (bf16_t*)(p.ws + OFF_ST);
    for (int i0 = 0; i0 < nck; i0 += 4) { float dv[4][4]; bf16_t kv[4][4]; size_t its[4];
#pragma unroll
        for (int u = 0; u < 4; ++u) { const int i = i0 + u, ck = dir == 0 ? ck0 + i : ck0 + nck - 1 - i; its[u] = (size_t)((dir * 128 + ck) * 4 + h);
#pragma unroll
            for (int e = 0; e < 4; ++e) { const int idx = idx0 + e * 512; dv[u][e] = DEC[its[u] * 64 + (idx >> 7)]; kv[u][e] = KV[its[u] * 8192 + idx]; } }
#pragma unroll
        for (int u = 0; u < 4; ++u)
#pragma unroll
            for (int e = 0; e < 4; ++e) { ST[its[u] * 8192 + idx0 + e * 512] = f2bf(S[e]); S[e] = dv[u][e] * S[e] + bf2f(kv[u][e]); } }
    if (bb < 16) {
#pragma unroll
        for (int e = 0; e < 4; ++e) p.out[OUT_GLA + ((size_t)(((bb * 2 + l) * 2 + dir) * 4 + h)) * 8192 + idx0 + e * 512] = S[e]; }
}

__device__ __forceinline__ void job_glaC(const Params& p, int l, int j, lds_t lds) {
    const int tid = tid_opaque(p), wid = tid >> 6, lane = tid & 63, lr = lane & 15, lq = lane >> 4;
    const int ck = j >> 2, h = j & 3, tok0 = ck * 64;
    LAS bf16_t* Aq = (LAS bf16_t*)lds;
    LAS bf16_t* BT = Aq + 64 * 136;
    LAS float* Os = (LAS float*)(BT + 128 * 136);
    const bf16_t* QD = (const bf16_t*)(p.ws + OFF_QD); const bf16_t* ST = (const bf16_t*)(p.ws + OFF_ST);
#pragma unroll
    for (int it = 0; it < 2; ++it) { const int idx = tid + it * 512, c = idx >> 4, rem = idx & 15, dir = rem >> 3, dc = rem & 7;
        *(LAS u32x4*)(Aq + c * 136 + dir * 64 + dc * 8) = *(const u32x4*)(QD + (size_t)(dir * 8192 + tok0 + c) * 256 + h * 64 + dc * 8); }
#pragma unroll
    for (int it = 0; it < 4; ++it) { const int idx = tid + it * 512, dir = idx >> 10, d = (idx >> 4) & 63, ec = idx & 15;
        const u32x4 v = *(const u32x4*)(ST + ((size_t)((dir * 128 + ck) * 4 + h)) * 8192 + d * 128 + ec * 8);
        const unsigned w[4] = { v.x, v.y, v.z, v.w };
#pragma unroll
        for (int i = 0; i < 4; ++i) { BT[(ec * 8 + 2 * i) * 136 + dir * 64 + d] = (bf16_t)(w[i] & 0xffffu); BT[(ec * 8 + 2 * i + 1) * 136 + dir * 64 + d] = (bf16_t)(w[i] >> 16); } }
    const int ct = wid & 3, eh = wid >> 2; const bf16_t* OI = (const bf16_t*)(p.ws + OFF_OIB);
    bf16_t oi[4][4];
#pragma unroll
    for (int e4 = 0; e4 < 4; ++e4)
#pragma unroll
        for (int r = 0; r < 4; ++r) oi[e4][r] = OI[(size_t)(tok0 + ct * 16 + lq * 4 + r) * 512 + h * 128 + (eh * 4 + e4) * 16 + lr];
    const int nc = tid >> 3, npart = tid & 7;
    const bf16_t* gz = (const bf16_t*)(p.ws + OFF_Z) + (size_t)(tok0 + nc) * LDZ + ZGG + h * 128 + npart * 16;
    const u32x4 g0 = *(const u32x4*)gz, g1 = *(const u32x4*)(gz + 8);
    f32x4 onw[4];
#pragma unroll
    for (int i = 0; i < 4; ++i) onw[i] = *(const f32x4*)(p.in[I_ONORM] + l * 128 + npart * 16 + 4 * i);
    __syncthreads();
    bf16x8 af[4];
#pragma unroll
    for (int ks = 0; ks < 4; ++ks) af[ks] = LDSFRAG(Aq + (ct * 16 + lr) * 136 + ks * 32 + lq * 8);
#pragma unroll
    for (int e4 = 0; e4 < 4; ++e4) { const int et = eh * 4 + e4; f32x4 a = {0.f, 0.f, 0.f, 0.f};
#pragma unroll
        for (int ks = 0; ks < 4; ++ks) a = MFMA16(af[ks], LDSFRAG(BT + (et * 16 + lr) * 136 + ks * 32 + lq * 8), a);
#pragma unroll
        for (int r = 0; r < 4; ++r) { const int row = ct * 16 + lq * 4 + r, col = et * 16 + lr; Os[row * 132 + col] = a[r] + bf2f(oi[e4][r]); } }
    __syncthreads();
    { const int c = tid >> 3, part = tid & 7; float o[16]; float ss = 0.f;
#pragma unroll
      for (int i = 0; i < 16; ++i) { o[i] = Os[c * 132 + part * 16 + i]; ss += o[i] * o[i]; }
      ss += __shfl_xor(ss, 1); ss += __shfl_xor(ss, 2); ss += __shfl_xor(ss, 4);
      const float rstd = rsqrtf(ss * (1.f / 128.f) + 1e-6f);
      const unsigned gw[8] = { g0.x, g0.y, g0.z, g0.w, g1.x, g1.y, g1.z, g1.w };
      unsigned ow[8];
#pragma unroll
      for (int i = 0; i < 8; ++i) { const float n0 = onw[i >> 1][(2 * i) & 3], n1 = onw[i >> 1][(2 * i + 1) & 3];
          ow[i] = pk2(o[2 * i] * rstd * n0 * siluf_(lo16(gw[i])), o[2 * i + 1] * rstd * n1 * siluf_(hi16(gw[i]))); }
      bf16_t* ap = (bf16_t*)(p.ws + OFF_AGLA) + (size_t)(tok0 + c) * 512 + h * 128 + part * 16;
      *(u32x4*)ap = (u32x4){ow[0], ow[1], ow[2], ow[3]}; *(u32x4*)(ap + 8) = (u32x4){ow[4], ow[5], ow[6], ow[7]}; }
    __syncthreads();
}
__device__ __forceinline__ void head_row_finish(float (&x)[16], int p8, const float* nw, const float* nw2, bool rope, int pos, const float* R, float mul, LAS bf16_t* dst) {
    float ss = 0.f; const int cnt = p8 < 4 ? 16 : 8;
#pragma unroll
    for (int i = 0; i < 16; ++i) if (i < cnt) ss += x[i] * x[i];
    ss += __shfl_xor(ss, 1); ss += __shfl_xor(ss, 2); ss += __shfl_xor(ss, 4);
    const float rstd = rsqrtf(ss * (1.f / 96.f) + 1e-6f) * mul;
    if (p8 < 4) { unsigned w[8];
#pragma unroll
        for (int i = 0; i < 8; ++i) w[i] = pk2(x[2 * i] * rstd * nw[p8 * 16 + 2 * i] * nw2[p8 * 16 + 2 * i], x[2 * i + 1] * rstd * nw[p8 * 16 + 2 * i + 1] * nw2[p8 * 16 + 2 * i + 1]);
        *(LAS u32x4*)(dst + p8 * 16) = (u32x4){w[0], w[1], w[2], w[3]}; *(LAS u32x4*)(dst + p8 * 16 + 8) = (u32x4){w[4], w[5], w[6], w[7]};
    } else { const int i0 = (p8 - 4) * 4; float o1[4], o2[4];
#pragma unroll
        for (int i = 0; i < 4; ++i) { const float a = x[i] * rstd * nw[64 + i0 + i], b = x[4 + i] * rstd * nw[80 + i0 + i];
            if (rope) { const float c = R[pos * 16 + i0 + i], s = R[16384 + pos * 16 + i0 + i]; o1[i] = a * c - b * s; o2[i] = a * s + b * c; } else { o1[i] = a; o2[i] = b; } }
        *(LAS u32x2*)(dst + 64 + i0) = (u32x2){pk2(o1[0], o1[1]), pk2(o1[2], o1[3])}; *(LAS u32x2*)(dst + 80 + i0) = (u32x2){pk2(o2[0], o2[1]), pk2(o2[2], o2[3])}; }
}
__device__ __forceinline__ void ld16bf(const bf16_t* s, float (&x)[16]) { const u32x4 a = *(const u32x4*)s, b = *(const u32x4*)(s + 8);
    x[0] = lo16(a.x); x[1] = hi16(a.x); x[2] = lo16(a.y); x[3] = hi16(a.y); x[4] = lo16(a.z); x[5] = hi16(a.z); x[6] = lo16(a.w); x[7] = hi16(a.w);
    x[8] = lo16(b.x); x[9] = hi16(b.x); x[10] = lo16(b.y); x[11] = hi16(b.y); x[12] = lo16(b.z); x[13] = hi16(b.z); x[14] = lo16(b.w); x[15] = hi16(b.w); }
__device__ __forceinline__ void ld4bf(const bf16_t* s, float* x) { const u32x2 a = *(const u32x2*)s; x[0] = lo16(a.x); x[1] = hi16(a.x); x[2] = lo16(a.y); x[3] = hi16(a.y); }
__device__ __forceinline__ void job_attn(const Params& p, int l, int j, lds_t lds) {
    const int tid = tid_opaque(p), wid = tid >> 6, lane = tid & 63, lr = lane & 15, lq = lane >> 4;
    const bool smp = j < 128; int b, h, qb; if (smp) { b = j >> 5; h = (j >> 3) & 3; qb = j & 7; } else { const int jj = j - 128; b = jj >> 3; h = (jj >> 1) & 3; qb = jj & 1; }
    const int qtok0 = smp ? 4096 + b * 1024 + qb * 128 : b * 256 + qb * 128; const int nkt = smp ? 12 : 2;
    LAS bf16_t* Ks = (LAS bf16_t*)lds;
    LAS bf16_t* VTs = Ks + 128 * 104;
    LAS bf16_t* Ps = VTs + 128 * 136 + wid * 32 * 72;
    LAS float* Mg = (LAS float*)lds;
    const bf16_t* Z = (const bf16_t*)(p.ws + OFF_Z); const bf16_t* KF = (const bf16_t*)(p.ws + OFF_KF); const bf16_t* Vb = (const bf16_t*)(p.ws + OFF_V); const float* R = (const float*)(p.ws + OFF_ROPE);
    const float* qhn = p.in[I_QHNORM] + l * 96;
    u32x4 kreg[3], vreg[4];
    const int vst = smp ? 1536 : 256; const bf16_t* vtb = smp ? Vb + 2097152 + (size_t)(b * 4 + h) * 128 * 1536 : Vb + (size_t)(b * 4 + h) * 128 * 256;
    auto rowbase = [&](int kt) { return smp ? (kt < 4 ? 8192 + b * 512 + kt * 128 : 4096 + b * 1024 + (kt - 4) * 128) : b * 256 + kt * 128; };
    auto issue = [&](int kt) { const int rb = rowbase(kt);
#pragma unroll
        for (int i = 0; i < 3; ++i) { const int idx = tid + 512 * i, key = idx / 12, part = idx - key * 12; kreg[i] = *(const u32x4*)(KF + (size_t)(rb + key) * 384 + h * 96 + part * 8); }
#pragma unroll
        for (int i = 0; i < 4; ++i) { const int idx = tid + 512 * i, e = idx >> 4, part = idx & 15; vreg[i] = *(const u32x4*)(vtb + (size_t)e * vst + kt * 128 + part * 8); } };
    auto commit = [&]() {
#pragma unroll
        for (int i = 0; i < 3; ++i) { const int idx = tid + 512 * i, key = idx / 12, part = idx - key * 12; *(LAS u32x4*)(Ks + key * 104 + part * 8) = kreg[i]; }
#pragma unroll
        for (int i = 0; i < 4; ++i) { const int idx = tid + 512 * i, e = idx >> 4, part = idx & 15; *(LAS u32x4*)(VTs + e * 136 + part * 8) = vreg[i]; } };
    issue(0);
#pragma unroll
    for (int it = 0; it < 2; ++it) { const int row = it * 64 + (tid >> 3), p8 = tid & 7, tok = qtok0 + row; const bf16_t* qr = (const bf16_t*)(p.ws + OFF_QRAW) + (size_t)tok * 384 + h * 96; float x[16];
      if (p8 < 4) ld16bf(qr + p8 * 16, x); else { ld4bf(qr + 64 + (p8 - 4) * 4, x); ld4bf(qr + 80 + (p8 - 4) * 4, x + 4); }
      head_row_finish(x, p8, qhn, p.in[I_KHNORM] + l * 96, smp, qb * 128 + row, R, 0.10206207261596575f * 1.4426950408889634f, Ks + row * 104); }
    __syncthreads();
    const int rt = wid & 3, kh = wid >> 2;
    bf16x8 qa[2][3];
#pragma unroll
    for (int mt = 0; mt < 2; ++mt)
#pragma unroll
        for (int ks = 0; ks < 3; ++ks) qa[mt][ks] = LDSFRAG(Ks + (rt * 32 + mt * 16 + lr) * 104 + ks * 32 + lq * 8);
    __syncthreads();
    commit();
    __syncthreads();
    f32x4 oacc[2][8]; float mrow[2][4], lrow[2][4];
#pragma unroll
    for (int mt = 0; mt < 2; ++mt) {
#pragma unroll
        for (int e = 0; e < 8; ++e) oacc[mt][e] = (f32x4){0.f, 0.f, 0.f, 0.f};
#pragma unroll
        for (int r = 0; r < 4; ++r) { mrow[mt][r] = -1e30f; lrow[mt][r] = 0.f; } }
    const int kbase = kh * 64;
    for (int kt = 0; kt < nkt; ++kt) {
        if (kt + 1 < nkt) issue(kt + 1);
        f32x4 sacc[2][4];
#pragma unroll
        for (int nt = 0; nt < 4; ++nt) { sacc[0][nt] = (f32x4){0.f, 0.f, 0.f, 0.f}; sacc[1][nt] = sacc[0][nt];
#pragma unroll
            for (int ks = 0; ks < 3; ++ks) { const bf16x8 kf = LDSFRAG(Ks + (kbase + nt * 16 + lr) * 104 + ks * 32 + lq * 8); sacc[0][nt] = MFMA16(qa[0][ks], kf, sacc[0][nt]); sacc[1][nt] = MFMA16(qa[1][ks], kf, sacc[1][nt]); } }
#pragma unroll
        for (int mt = 0; mt < 2; ++mt) {
            float alpha[4];
#pragma unroll
            for (int r = 0; r < 4; ++r) { float mx = fmaxf(fmaxf(sacc[mt][0][r], sacc[mt][1][r]), fmaxf(sacc[mt][2][r], sacc[mt][3][r]));
                mx = fmaxf(mx, __shfl_xor(mx, 1)); mx = fmaxf(mx, __shfl_xor(mx, 2)); mx = fmaxf(mx, __shfl_xor(mx, 4)); mx = fmaxf(mx, __shfl_xor(mx, 8));
                const float mn = fmaxf(mrow[mt][r], mx); alpha[r] = __builtin_amdgcn_exp2f(mrow[mt][r] - mn); mrow[mt][r] = mn; float rs = 0.f;
#pragma unroll
                for (int nt = 0; nt < 4; ++nt) { const float pv = __builtin_amdgcn_exp2f(sacc[mt][nt][r] - mn); rs += pv; Ps[(mt * 16 + lq * 4 + r) * 72 + nt * 16 + lr] = f2bf(pv); }
                lrow[mt][r] = lrow[mt][r] * alpha[r] + rs; }
#pragma unroll
            for (int e = 0; e < 8; ++e) { oacc[mt][e][0] *= alpha[0]; oacc[mt][e][1] *= alpha[1]; oacc[mt][e][2] *= alpha[2]; oacc[mt][e][3] *= alpha[3]; } }
        asm volatile("s_waitcnt lgkmcnt(0)" ::: "memory");
#pragma unroll
        for (int k2 = 0; k2 < 2; ++k2) { const bf16x8 pa0 = LDSFRAG(Ps + lr * 72 + k2 * 32 + lq * 8), pa1 = LDSFRAG(Ps + (16 + lr) * 72 + k2 * 32 + lq * 8);
#pragma unroll
            for (int e = 0; e < 8; ++e) { const bf16x8 vf = LDSFRAG(VTs + (e * 16 + lr) * 136 + kbase + k2 * 32 + lq * 8); oacc[0][e] = MFMA16(pa0, vf, oacc[0][e]); oacc[1][e] = MFMA16(pa1, vf, oacc[1][e]); } }
        __syncthreads();
        if (kt + 1 < nkt) { commit(); __syncthreads(); }
    }
#pragma unroll
    for (int mt = 0; mt < 2; ++mt)
#pragma unroll
        for (int r = 0; r < 4; ++r) { float s_ = lrow[mt][r]; s_ += __shfl_xor(s_, 1); s_ += __shfl_xor(s_, 2); s_ += __shfl_xor(s_, 4); s_ += __shfl_xor(s_, 8); lrow[mt][r] = s_; }
    LAS float* Mo = Mg + rt * 32 * 132; LAS float* Ml = Mg + 4 * 32 * 132 + rt * 64;
    if (kh == 1) {
#pragma unroll
        for (int mt = 0; mt < 2; ++mt) {
#pragma unroll
            for (int e = 0; e < 8; ++e)
#pragma unroll
                for (int r = 0; r < 4; ++r) Mo[(mt * 16 + lq * 4 + r) * 132 + e * 16 + lr] = oacc[mt][e][r];
            if (lr == 0) {
#pragma unroll
                for (int r = 0; r < 4; ++r) { Ml[(mt * 16 + lq * 4 + r) * 2] = mrow[mt][r]; Ml[(mt * 16 + lq * 4 + r) * 2 + 1] = lrow[mt][r]; } } }
    }
    __syncthreads();
    if (kh == 0) { bf16_t* AM = (bf16_t*)(p.ws + OFF_AMLA);
#pragma unroll
        for (int mt = 0; mt < 2; ++mt)
#pragma unroll
            for (int r = 0; r < 4; ++r) { const int row = mt * 16 + lq * 4 + r; const float m2 = Ml[row * 2], l2 = Ml[row * 2 + 1]; const float mm = fmaxf(mrow[mt][r], m2), a1 = __builtin_amdgcn_exp2f(mrow[mt][r] - mm), a2 = __builtin_amdgcn_exp2f(m2 - mm);
                const float inv = 1.f / (lrow[mt][r] * a1 + l2 * a2); const int tok = qtok0 + rt * 32 + row;
                bf16_t gt[8];
#pragma unroll
                for (int e = 0; e < 8; ++e) gt[e] = Z[(size_t)tok * LDZ + ZMG + h * 128 + e * 16 + lr];
#pragma unroll
                for (int e = 0; e < 8; ++e) { const int col = e * 16 + lr; const float o = (oacc[mt][e][r] * a1 + Mo[row * 132 + col] * a2) * inv;
                    AM[(size_t)tok * 512 + h * 128 + col] = f2bf(o * siluf_(bf2f(gt[e]))); } } }
    __syncthreads();
}


#define XB_TMO      128
#define XB_XCNT(j)  (256  + 64 * (j))
#define XB_XSUB(j)  (1280 + 64 * (j))
#define XB_XGEN(j)  (2304 + 64 * (j))
#define XB_TOP      3328
#define XB_TOPGEN   3392
#define XCD_BAR_WORDS 3456
#define XB_SPIN_CAP (1u << 18)

__device__ __forceinline__ unsigned xb_ld(unsigned* p)              { return __hip_atomic_load(p, __ATOMIC_RELAXED, __HIP_MEMORY_SCOPE_AGENT); }
__device__ __forceinline__ unsigned xb_add(unsigned* p, unsigned v) { return __hip_atomic_fetch_add(p, v, __ATOMIC_RELAXED, __HIP_MEMORY_SCOPE_AGENT); }
__device__ __forceinline__ unsigned xb_xcc_id() { return (unsigned)__builtin_amdgcn_s_getreg((3 << 11) | 20) & 0xFu; }
#define XB_SPIN(cond, bar) do { unsigned _sp = 0; while (cond) { __builtin_amdgcn_s_sleep(1); \
    if ((++_sp & 255u) == 0u) { if (xb_ld(&(bar)[XB_TMO])) break; if (_sp > XB_SPIN_CAP) { atomicAdd(&(bar)[XB_TMO], 1u); break; } } } } while (0)

struct XcdBarrier {
    int wid; unsigned* bar; unsigned x;
    volatile LAS unsigned* st;
};

__device__ __forceinline__ XcdBarrier xcd_barrier_post(unsigned* bar, volatile LAS unsigned* st) {
    XcdBarrier b; b.bar = bar; b.x = xb_xcc_id(); b.st = st;
    if (threadIdx.x == 0) (void)xb_add(&bar[XB_XCNT(b.x)], 1u);
    return b;
}
__device__ __forceinline__ void xcd_barrier_complete(unsigned* bar, unsigned x, unsigned& nloc, unsigned& nx) {
    const unsigned G = gridDim.x * gridDim.y * gridDim.z;
    unsigned sum, cnt, mine, sp = 0u;
    for (;;) {
        sum = 0u; cnt = 0u; mine = 0u;
#pragma unroll
        for (unsigned j = 0; j < 16; ++j) { const unsigned c = xb_ld(&bar[XB_XCNT(j)]); sum += c; cnt += (c > 0u) ? 1u : 0u; mine = (j == x) ? c : mine; }
        if (sum == G) break;
        __builtin_amdgcn_s_sleep(1);
        if ((++sp & 255u) == 0u) { if (xb_ld(&bar[XB_TMO])) break; if (sp > XB_SPIN_CAP) { atomicAdd(&bar[XB_TMO], 1u); break; } }
    }
    nloc = mine > 0u ? mine : 1u; nx = cnt > 0u ? cnt : 1u;
}

__device__ __forceinline__ void xcd_barrier(const XcdBarrier& b) {
    asm volatile("s_waitcnt vmcnt(0)" ::: "memory");
    __syncthreads();
    if (b.wid == 0 && lane_id_() == 0) {
        unsigned* bar = b.bar;
        __builtin_amdgcn_s_waitcnt(0);
        unsigned nloc = b.st[0], nx = b.st[1];
        if (nloc == 0u) { xcd_barrier_complete(bar, b.x, nloc, nx); b.st[0] = nloc; b.st[1] = nx; }
        const unsigned old = xb_add(&bar[XB_XSUB(b.x)], 1u);
        const unsigned gen = old / nloc;
        if (old + 1u == (gen + 1u) * nloc) {
            __builtin_amdgcn_fence(__ATOMIC_RELEASE, "agent");
            asm volatile("s_waitcnt vmcnt(0)" ::: "memory");
            const unsigned og = xb_add(&bar[XB_TOP], 1u);
            const unsigned tg = og / nx;
            if (og + 1u == (tg + 1u) * nx) xb_add(&bar[XB_TOPGEN], 1u);
            else XB_SPIN(xb_ld(&bar[XB_TOPGEN]) == tg, bar);
            __builtin_amdgcn_fence(__ATOMIC_ACQUIRE, "agent");
            xb_add(&bar[XB_XGEN(b.x)], 1u);
            asm volatile("s_waitcnt vmcnt(0)" ::: "memory");
        } else {
            XB_SPIN(xb_ld(&bar[XB_XGEN(b.x)]) == gen, bar);
            __builtin_amdgcn_fence(__ATOMIC_ACQUIRE, "agent");
            asm volatile("s_waitcnt vmcnt(0)" ::: "memory");
        }
    }
    __syncthreads();
}

constexpr int N_PHASES = 15;
#ifndef S3SEL
#define S3SEL 15
#endif
#ifndef REPEAT_MASK
#define REPEAT_MASK 0xff
#endif
#ifndef ONLY_S
#define ONLY_S -1
#endif
__device__ __forceinline__ void run_phase(const Params& p, int ph, lds_t lds, int mask = 0xff) {
    const int G = (int)gridDim.x, bid = (int)blockIdx.x;
    if (ph == 0 && (ONLY_S < 0 || ONLY_S == 7)) {
        for (int j = bid; j < 96 + 192 + 256 + 32; j += G) { if (j < 96) job_s5setup(p, 0, j, lds); else if (j < 288) job_ada(p, j - 96, lds); else if (j < 544) job_ctx(p, j - 288); else job_rope(p, j - 544); }
        return;
    }
    const int l = (ph - 1) / 7, s = (ph - 1) % 7;
    unsigned char* ws = p.ws;
    if (s == 0 && (ONLY_S < 0 || ONLY_S == 0)) {
        if (l == 0 || G < 256) { for (int j = bid; j < 96 + WT_TOTAL + 1024; j += G) { if (j < 96) { if ((mask & 1) && l > 0) job_s5setup(p, l, j, lds); } else if (j < 96 + WT_TOTAL) { if (mask & 2) job_wt(p, l, j - 96, lds); } else if (mask & 4) job_prep(p, l, j - 96 - WT_TOTAL); } }
        else { for (int j = bid; j < WT_WOUT + 1024; j += G) { if (j < WT_WOUT) job_wt(p, l, WT_EARLY + 3 * WT_WBO + j, lds); else job_prep(p, l, j - WT_WOUT); } }
    } else if (s == 1 && (ONLY_S < 0 || ONLY_S == 1)) {
        Order S; S.setup(8192, 4096, 0, p.wid); pg8::Gemm g{(const bf16_t*)(ws + OFF_HB), (const bf16_t*)(ws + OFF_WIN), 8192, 4096, 1024}; EpiZ E{(bf16_t*)(ws + OFF_Z)};
        pg8::gemm_phase<EpiZ, Order>(lds, g, S, E, nullptr);
    } else if (s == 2 && (ONLY_S < 0 || ONLY_S == 2)) {
        if (G == 256) {
            if (mask & 1) for (int k = bid >> 3; k < 80; k += 32) { const int q = k >> 2, bb = q < 4 ? 16 + q : q - 4; job_s5(p, l, bb * 32 + 4 * (bid & 7) + (k & 3), lds); }
            for (int j = bid; j < 512 + 1024; j += G) { if (j < 512) { if (mask & 2) job_glaA(p, l, j, lds); } else if (mask & 4) job_mlaprep(p, l, j - 512); }
        } else for (int j = bid; j < 640 + 512 + 1024; j += G) { if (j < 640) { if (mask & 1) job_s5(p, l, j < 128 ? 512 + j : j - 128, lds); } else if (j < 1152) { if (mask & 2) job_glaA(p, l, j - 640, lds); } else if (mask & 4) job_mlaprep(p, l, j - 1152); }
    } else if (s == 3 && (ONLY_S < 0 || ONLY_S == 3)) {
        if (mask & 1) for (int j = bid; j < 640; j += G) job_glaB(p, l, j);
        if (mask & 16) { Order S; S.setup(8192, 2816, 0, p.wid); pg8::Gemm g{(const bf16_t*)(ws + OFF_HB), (const bf16_t*)(ws + OFF_WIN) + (size_t)4096 * 1024, 8192, 2816, 1024}; EpiZ E{(bf16_t*)(ws + OFF_Z) + 4096};
          pg8::gemm_phase<EpiZ, Order>(lds, g, S, E, nullptr); }
        if ((mask & 2) && (S3SEL & 2)) { Order S; S.setup(8192, 1024, 160, p.wid); pg8::Gemm g{(const bf16_t*)(ws + OFF_YG), (const bf16_t*)(ws + OFF_WGLU), 8192, 1024, 512}; EpiGLU E{(bf16_t*)(ws + OFF_AS5), (const bf16_t*)(ws + OFF_Z), p.in[I_BGLU] + l * 1024};
          pg8::gemm_phase<EpiGLU, Order>(lds, g, S, E, nullptr); }
        if ((mask & 4) && (S3SEL & 4)) { Order S; S.setup(10240, 768, 120, p.wid); pg8::Gemm g{(const bf16_t*)(ws + (l == 0 ? OFF_CTX0 : OFF_CKVN)), (const bf16_t*)(ws + OFF_WKV), 10240, 768, 256}; EpiKV E{(bf16_t*)(ws + OFF_KF), (bf16_t*)(ws + OFF_V), l, (const bf16_t*)(ws + OFF_Z), p.in[I_CKR], p.in[I_KHNORM] + l * 96, (const float*)(ws + OFF_ROPE)};
          pg8::gemm_phase<EpiKV, Order>(lds, g, S, E, nullptr); }
        if ((mask & 8) && (S3SEL & 8)) { Order S; S.setup(8192, 512, 160, p.wid); pg8::Gemm g{(const bf16_t*)(ws + OFF_AQ), (const bf16_t*)(ws + OFF_WUQ), 8192, 512, 384}; EpiQ E{(bf16_t*)(ws + OFF_QRAW)};
          pg8::gemm_phase<EpiQ, Order>(lds, g, S, E, nullptr); }
    } else if (s == 4 && (ONLY_S < 0 || ONLY_S == 4)) {
        if (G == 256) {
            if (bid < 128) { const int slot = bid >> 3, pair = 2 * (bid & 7) + (slot >> 3);
                if (mask & 1) job_attn(p, l, pair * 8 + (slot & 7), lds); }
            else { const int k = bid - 128; if (mask & 1) job_attn(p, l, 128 + k, lds); if (mask & 2) { job_glaC(p, l, k, lds); job_glaC(p, l, 128 + k, lds); job_glaC(p, l, 256 + k, lds); job_glaC(p, l, 384 + k, lds); } }
        } else for (int j = bid; j < 256 + 512; j += G) { if (j < 256) { if (mask & 1) job_attn(p, l, j, lds); } else if (mask & 2) job_glaC(p, l, j - 256, lds); }
    } else if (s == 5 && (ONLY_S < 0 || ONLY_S == 5)) {
        if (l == 0 && mask == 0xff && G >= 256 && bid >= 128) { for (int j = bid - 128; j < 96 + WT_EARLY; j += G - 128) { if (j < 96) job_s5setup(p, 1, j, lds); else job_wt(p, 1, j - 96, lds); } }
        for (int br = 0; br < 3; ++br) { Order S; S.setup(8192, 1024, 0, p.wid);
            pg8::Gemm g{(const bf16_t*)(ws + (br == 0 ? OFF_AGLA : br == 1 ? OFF_AMLA : OFF_AS5)), (const bf16_t*)(ws + OFF_WBO) + (size_t)br * 1024 * 512, 8192, 1024, 512};
            EpiBo E{(bf16_t*)(ws + OFF_HB), (const bf16_t*)(ws + OFF_Z), br};
            pg8::gemm_phase<EpiBo, Order>(lds, g, S, E, nullptr); }
    } else if (s == 6 && (ONLY_S < 0 || ONLY_S == 6)) {
        if (l == 0 && mask == 0xff && G >= 256 && bid >= 128) { for (int j = bid - 128; j < 3 * WT_WBO; j += G - 128) job_wt(p, 1, WT_EARLY + j, lds); }
        Order S; S.setup(8192, 1024, 0, p.wid); pg8::Gemm g{(const bf16_t*)(ws + OFF_HB), (const bf16_t*)(ws + OFF_WOUT), 8192, 1024, 1024};
        EpiOut E{p.out, l == 0 ? p.in[I_XP] : p.out, l == 0 ? p.in[I_XS] : p.out + (size_t)4096 * 1024, (const float*)(ws + OFF_ADA) + l * 5 * 3072};
        pg8::gemm_phase<EpiOut, Order>(lds, g, S, E, nullptr);
    }
}
__global__ __launch_bounds__(512, 2) void mega(KParams kp, int ph0, int ph1) {
    extern __shared__ __attribute__((aligned(16))) unsigned char shm[];
    lds_t lds = (lds_t)shm;
    if (threadIdx.x < N_IN) ((const float**)(kp.ws + OFF_TBL))[threadIdx.x] = kp.in[threadIdx.x];
    const int wid0 = __builtin_amdgcn_readfirstlane((int)threadIdx.x >> 6);
    volatile LAS unsigned* xst = (volatile LAS unsigned*)(lds + DYN_LDS - 16);
    if (threadIdx.x == 0) { xst[0] = 0u; xst[1] = 0u; }
    __threadfence(); __syncthreads();
    XcdBarrier xb = xcd_barrier_post((unsigned*)(kp.ws + OFF_BAR), xst);
    xb.wid = wid0;
    if (ph0 > ph1) cg::this_grid().sync();
    for (int ph = ph0; ph < ph1; ++ph) {
        Params p; p.wid = wid0; { const float* const* tb = (const float* const*)(kp.ws + OFF_TBL); float* o = kp.out; unsigned char* w = kp.ws; asm volatile("" : "+s"(tb), "+s"(o), "+s"(w)); p.in = tb; p.out = o; p.ws = w; }
        int nrep = 1;
#ifdef REPEAT_S
        if ((REPEAT_S == 7 && ph == 0) || (ph > 0 && (ph - 1) % 7 == REPEAT_S && (REPEAT_S != 6 || ph < 8))) nrep = 2;
#endif
        for (int rep = 0; rep < nrep; ++rep) { if (rep) xcd_barrier(xb); run_phase(p, ph, lds, rep ? REPEAT_MASK : 0xff); }
        if (ph + 1 < ph1) xcd_barrier(xb);
    }
}

#ifndef N_LAUNCH_MODE
#define N_LAUNCH_MODE 1
#endif
extern "C" void kernel_launch(void* const* d_in, const int* in_sizes, int n_in, void* d_out, int out_size, void* d_ws, size_t ws_size, hipStream_t stream) {
    static int grid = 0;
    if (grid == 0) {
        if (n_in != N_IN || ws_size < WS_END) { fprintf(stderr, "kernel_launch: unexpected n_in %d / ws %zu (need %zu)\n", n_in, ws_size, (size_t)WS_END); grid = -1; return; }
        int dev = 0, cus = 0, per_cu = 0;
        hipGetDevice(&dev); hipDeviceGetAttribute(&cus, hipDeviceAttributeMultiprocessorCount, dev);
        hipFuncSetAttribute((const void*)mega, hipFuncAttributeMaxDynamicSharedMemorySize, DYN_LDS);
        hipOccupancyMaxActiveBlocksPerMultiprocessor(&per_cu, (const void*)mega, 512, DYN_LDS);
        if (per_cu < 1) { fprintf(stderr, "kernel_launch: occupancy query says %d blocks per CU\n", per_cu); per_cu = 1; }
        (void)hipGetLastError();
        grid = cus;
    }
    if (grid < 0) return;
    hipMemsetAsync((char*)d_ws + OFF_BAR, 0, 16384, stream);
    KParams p{};
    for (int i = 0; i < N_IN; ++i) p.in[i] = (const float*)d_in[i];
    p.out = (float*)d_out; p.ws = (unsigned char*)d_ws;
#if N_LAUNCH_MODE == 0
    for (int ph = 0; ph < N_PHASES; ++ph) { hipLaunchKernelGGL(mega, dim3(grid), dim3(512), DYN_LDS, stream, p, ph, ph + 1); }
#else
    int ph0 = 0, ph1 = N_PHASES; void* args[] = {&p, &ph0, &ph1};
    hipError_t e = hipLaunchCooperativeKernel((const void*)mega, dim3(grid), dim3(512), args, DYN_LDS, stream);
    if (e != hipSuccess) fprintf(stderr, "cooperative launch failed: %s (grid %d)\n", hipGetErrorString(e), grid);
#endif
}
```

```cpp
#include <hip/hip_runtime.h>
#include <hip/hip_cooperative_groups.h>
#include <cstdio>
namespace cg = cooperative_groups;
namespace pg8 {
#define PG8_LAS __attribute__((address_space(3)))
typedef unsigned short bf16_t;
typedef short bf16x8 __attribute__((ext_vector_type(8)));
typedef float f32x4 __attribute__((ext_vector_type(4)));
typedef unsigned u32x4 __attribute__((ext_vector_type(4)));
constexpr int BM = 256, BK = 64, HALF = 128, HTB = HALF * BK * 2  , STAGE_BYTES = 8 * HTB, NXCD = 8, WGM = 8;

__host__ __device__ __forceinline__ int lds_byte(int r, int c) { const int st = (r >> 4) * 2 + (c >> 5), rr = r & 15, cc = c & 31, ob = rr * 64 + cc * 2; return st * 1024 + (ob ^ (((ob >> 9) & 1) << 5)); }
__host__ __device__ __forceinline__ void stage_rc(int b, int& R, int& C) { const int st = b / 1024, sb = b % 1024, swz = sb ^ (((sb >> 9) & 1) << 5); R = (st >> 1) * 16 + swz / 64; C = (st & 1) * 32 + (swz % 64) / 2; }
__host__ __device__ __forceinline__ int perm32(int rho) { const int n = rho >> 4, i = rho & 15; return 8 * (i >> 2) + 4 * n + (i & 3); }

struct Unit { int pm, pn; };
struct Gemm { const bf16_t* A; const bf16_t* Bt; int M, N, K; };

struct StaticOrder {
    int nM, nN, nwg, G, c;
    __host__ __device__ void init(int M, int N, int G_, int c_) { nM = M / BM; nN = N / BM; nwg = nM * nN; G = G_; c = c_; }
    __host__ __device__ bool next(int i, Unit& u) const {
        const long L = (long)i * G + c; if (L >= nwg) return false;
        int wgid = (int)L; { const int q = nwg / NXCD, r = nwg % NXCD, xcd = wgid % NXCD, off = wgid / NXCD; wgid = (xcd < r ? xcd * (q + 1) : r * (q + 1) + (xcd - r) * q) + off; }
        const int nig = WGM * nN, gid = wgid / nig, fm = gid * WGM, gsz = (nM - fm) < WGM ? (nM - fm) : WGM;
        u.pm = fm + ((wgid % nig) % gsz); u.pn = (wgid % nig) / gsz; return true;
    }
    __device__ __forceinline__ void a_ready(const Unit&) const {}
    __device__ __forceinline__ void done(const Unit&) const {}
};
__device__ __forceinline__ unsigned cvt_pk_bf16(float lo, float hi) { unsigned r; asm volatile("v_cvt_pk_bf16_f32 %0, %1, %2" : "=v"(r) : "v"(lo), "v"(hi)); return r; }
typedef float f32x2 __attribute__((ext_vector_type(2)));
template <class Epi, class Sched, bool STAMP = false>
__device__ __forceinline__ void gemm_phase(PG8_LAS unsigned char* lds, const Gemm g, const Sched& S, const Epi& E, unsigned long long* stamps) {
    int tid_ = (S.wid << 6) | (int)__builtin_amdgcn_mbcnt_hi(~0u, __builtin_amdgcn_mbcnt_lo(~0u, 0u)); asm volatile("" : "+v"(tid_)); const int tid = tid_, wid = __builtin_amdgcn_readfirstlane(tid >> 6), lane = tid & 63, wr = wid >> 2, wc = wid & 3, fr = lane & 15, fq = lane >> 4;
    int K_ = g.K; asm volatile("" : "+s"(K_)); const int K = K_, nt = K / BK;
    int ts_lo = 0, ts_hi = 0, nts = 0; const unsigned long long rt_entry = STAMP ? (unsigned long long)wall_clock64() : 0ull;
#define PG8_STAMP() do { if (STAMP && wid == 0 && nts < 64) { const unsigned long long _c = (unsigned long long)clock64(); \
        ts_lo = (lane == nts) ? (int)(unsigned)_c : ts_lo; ts_hi = (lane == nts) ? (int)(unsigned)(_c >> 32) : ts_hi; ++nts; } } while (0)
    PG8_STAMP();
    unsigned voffA[2], voffB[2];
#pragma unroll
    for (int i = 0; i < 2; ++i) { int R, C; stage_rc(tid * 16 + i * 8192, R, C); const int Rb = Epi::PERM ? ((R & ~31) + perm32(R & 31)) : R;
        voffA[i] = (unsigned)(R * K + C) * 2u; voffB[i] = (unsigned)(Rb * K + C) * 2u; }
    const size_t kstep = (size_t)(BK * 2);
    const size_t hstep = (size_t)HALF * K * 2;
    const size_t tstep = 2 * hstep;
    const unsigned ldsw = (unsigned)wid * 1024u;
    const int aoff = lds_byte(wr * 64 + fr, fq * 8), boff = lds_byte(wc * 32 + fr, fq * 8);
#define PG8_SA(b, h) (((b) * 2 + (h)) * HTB)
#define PG8_SB(b, h) ((4 + (b) * 2 + (h)) * HTB)
#define PG8_STAGE(bufoff, gbase, voff) do { _Pragma("unroll") for (int _i = 0; _i < 2; ++_i) \
        __builtin_amdgcn_global_load_lds((const unsigned*)((const char*)(gbase) + (voff)[_i]), (PG8_LAS unsigned*)(lds + (bufoff) + ldsw + _i * 8192), 16, 0, 0); } while (0)
#define PG8_LDA(dst, b, h) do { _Pragma("unroll") for (int m = 0; m < 4; ++m) _Pragma("unroll") for (int k = 0; k < 2; ++k) dst[m][k] = *(const PG8_LAS bf16x8*)(lds + PG8_SA(b, h) + aoff + m * 2048 + k * 1024); } while (0)
#define PG8_LDB(dst, b, h) do { _Pragma("unroll") for (int n = 0; n < 2; ++n) _Pragma("unroll") for (int k = 0; k < 2; ++k) dst[n][k] = *(const PG8_LAS bf16x8*)(lds + PG8_SB(b, h) + boff + n * 2048 + k * 1024); } while (0)
#define PG8_MMA(ai, bj, At, Bt) do { __builtin_amdgcn_s_setprio(1); _Pragma("unroll") for (int m = 0; m < 4; ++m) _Pragma("unroll") for (int n = 0; n < 2; ++n) _Pragma("unroll") for (int k = 0; k < 2; ++k) \
        acc[ai][bj][m][n] = __builtin_amdgcn_mfma_f32_16x16x32_bf16(Bt[n][k], At[m][k], acc[ai][bj][m][n], 0, 0, 0); __builtin_amdgcn_s_setprio(0); } while (0)
#define PG8_WAIT_V(n) asm volatile("s_waitcnt vmcnt(" #n ")" ::: "memory")
#define PG8_WAIT_L(n) asm volatile("s_waitcnt lgkmcnt(" #n ")" ::: "memory")
#define PG8_BAR __builtin_amdgcn_s_barrier()
#define PG8_SCHED __builtin_amdgcn_sched_barrier(0)
    Unit cur, nxt; int ui = 0;
    if (!S.next(0, cur)) return;
    f32x4 acc[2][2][4][2];
#pragma unroll
    for (int a = 0; a < 2; ++a)
#pragma unroll
        for (int b = 0; b < 2; ++b)
#pragma unroll
            for (int m = 0; m < 4; ++m)
#pragma unroll
                for (int n = 0; n < 2; ++n) acc[a][b][m][n] = (f32x4){0.f, 0.f, 0.f, 0.f};
    bf16x8 At[4][2], B0[2][2], B1[2][2];
    const char* cA = (const char*)g.A + (size_t)cur.pm * tstep; const char* cB = (const char*)g.Bt + (size_t)cur.pn * tstep;
    S.a_ready(cur);
    PG8_STAGE(PG8_SB(0, 0), cB, voffB); PG8_STAGE(PG8_SA(0, 0), cA, voffA); PG8_STAGE(PG8_SB(0, 1), cB + hstep, voffB); PG8_STAGE(PG8_SA(0, 1), cA + hstep, voffA);
    if (wr == 1) PG8_BAR;
    PG8_WAIT_V(4); PG8_BAR;
    PG8_STAGE(PG8_SB(1, 0), cB + kstep, voffB); PG8_STAGE(PG8_SA(1, 0), cA + kstep, voffA); PG8_STAGE(PG8_SB(1, 1), cB + hstep + kstep, voffB);
    PG8_WAIT_V(6); PG8_BAR;
    PG8_STAMP();
    for (;;) {
        const bool has_next = S.next(ui + 1, nxt);
        const char* nA = has_next ? (const char*)g.A + (size_t)nxt.pm * tstep : cA; const char* nB = has_next ? (const char*)g.Bt + (size_t)nxt.pn * tstep : cB;
        for (int t = 0; t < nt; t += 2) {
            const bool last = (t == nt - 2);
            const char* a1 = cA + (size_t)(t + 1) * kstep;
            const char* a2 = last ? nA : cA + (size_t)(t + 2) * kstep; const char* b2 = last ? nB : cB + (size_t)(t + 2) * kstep;
            const char* a3 = a2 + kstep; const char* b3 = b2 + kstep;
            if (last && has_next) S.a_ready(nxt);
            PG8_LDB(B0, 0, 0); PG8_SCHED; PG8_LDA(At, 0, 0); PG8_STAGE(PG8_SA(1, 1), a1 + hstep, voffA);
            PG8_WAIT_L(8); PG8_BAR; PG8_WAIT_L(0); PG8_MMA(0, 0, At, B0); PG8_BAR; PG8_SCHED;
            PG8_LDB(B1, 0, 1); PG8_STAGE(PG8_SB(0, 0), b2, voffB);
            PG8_BAR; PG8_WAIT_L(0); PG8_MMA(0, 1, At, B1); PG8_BAR;
            PG8_LDA(At, 0, 1); PG8_STAGE(PG8_SA(0, 0), a2, voffA);
            PG8_BAR; PG8_WAIT_L(0); PG8_MMA(1, 0, At, B0); PG8_BAR; PG8_SCHED;
            PG8_STAGE(PG8_SB(0, 1), b2 + hstep, voffB);
            PG8_WAIT_V(6); PG8_BAR; PG8_MMA(1, 1, At, B1); PG8_BAR;
            PG8_LDB(B0, 1, 0); PG8_SCHED; PG8_LDA(At, 1, 0); PG8_STAGE(PG8_SA(0, 1), a2 + hstep, voffA);
            PG8_WAIT_L(8); PG8_BAR; PG8_WAIT_L(0); PG8_MMA(0, 0, At, B0); PG8_BAR; PG8_SCHED;
            PG8_LDB(B1, 1, 1); PG8_STAGE(PG8_SB(1, 0), b3, voffB);
            PG8_BAR; PG8_WAIT_L(0); PG8_MMA(0, 1, At, B1); PG8_BAR;
            PG8_LDA(At, 1, 1); PG8_STAGE(PG8_SA(1, 0), a3, voffA);
            PG8_BAR; PG8_WAIT_L(0); PG8_MMA(1, 0, At, B0); PG8_BAR; PG8_SCHED;
            PG8_STAGE(PG8_SB(1, 1), b3 + hstep, voffB);
            PG8_WAIT_V(6); PG8_BAR; PG8_MMA(1, 1, At, B1); PG8_BAR;
        }
        PG8_STAMP();
        if constexpr (!Epi::AFTER_DRAIN) { E(acc, cur, wr, wc, fr, fq); S.done(cur); }
        PG8_STAMP();
        if (!has_next) break;
#pragma unroll
        for (int a = 0; a < 2; ++a)
#pragma unroll
            for (int b = 0; b < 2; ++b)
#pragma unroll
                for (int m = 0; m < 4; ++m)
#pragma unroll
                    for (int n = 0; n < 2; ++n) acc[a][b][m][n] = (f32x4){0.f, 0.f, 0.f, 0.f};
        cur = nxt; cA = nA; cB = nB; ++ui;
    }
    PG8_WAIT_V(0);
    if (wr == 0) PG8_BAR;
    PG8_BAR;
    if constexpr (Epi::AFTER_DRAIN) { E.fused(acc, cur, wr, wc, fr, fq, lds, wid, lane); S.done(cur); }
    PG8_STAMP();
    if (STAMP && wid == 0) { stamps[lane] = lane < nts ? (((unsigned long long)(unsigned)ts_hi << 32) | (unsigned)ts_lo) : 0ull;
        if (lane == 62) stamps[62] = rt_entry; if (lane == 63) stamps[63] = (unsigned long long)wall_clock64(); }
#undef PG8_STAMP
#undef PG8_SA
#undef PG8_SB
#undef PG8_STAGE
#undef PG8_LDA
#undef PG8_LDB
#undef PG8_MMA
#undef PG8_WAIT_V
#undef PG8_WAIT_L
#undef PG8_BAR
#undef PG8_SCHED
}
}
using pg8::bf16_t; using pg8::bf16x8; using pg8::f32x4; using pg8::u32x4; using pg8::Unit;
#define LAS __attribute__((address_space(3)))
typedef unsigned u32x2 __attribute__((ext_vector_type(2)));
typedef LAS unsigned char* lds_t;
struct Params;
__device__ __forceinline__ int lane_id_() { return (int)__builtin_amdgcn_mbcnt_hi(~0u, __builtin_amdgcn_mbcnt_lo(~0u, 0u)); }
typedef float f32x2_t __attribute__((ext_vector_type(2)));

enum { I_XP = 0, I_XS, I_C, I_CCTX, I_CKV, I_CKR, I_SGLA, I_SS5, I_NORMW, I_WADA, I_BADA, I_WIN, I_WA2, I_BA, I_ONORM, I_QNORM, I_WUQ, I_KVNORM, I_WUK, I_WUV,
       I_QHNORM, I_KHNORM, I_ARE, I_AIM, I_LOGDT, I_BRE, I_BIM, I_CRE, I_CIM, I_S5D, I_WGLU, I_BGLU, I_WBOG, I_WBOM, I_WBOS, I_WOUT, N_IN };
struct KParams { const float* in[N_IN]; float* out; unsigned char* ws; };
struct Params { const float* const* in; float* out; unsigned char* ws; int wid; };
__device__ __forceinline__ int tid_opaque(const Params& p) { int t = (p.wid << 6) | lane_id_(); asm volatile("" : "+v"(t)); return t; }

constexpr int LDZ = 6912;
constexpr int ZQ = 0, ZK = 256, ZV = 512, ZGA = 1024, ZGG = 1056, ZMQ = 1568, ZMKV = 1952, ZMKR = 2208, ZMG = 2240, ZSU = 2752, ZSG = 3264, ZMERGE = 3776;
constexpr size_t OUT_YP = 0, OUT_CKV = 8388608, OUT_KR = 10485760, OUT_GLA = 10747904, OUT_S5 = 12845056;
constexpr size_t OFF_WIN = 0;

constexpr size_t OFF_WUQ = OFF_WIN + 14155776;
constexpr size_t OFF_WKV = OFF_WUQ + 393216;
constexpr size_t OFF_WGLU = OFF_WKV + 393216;
constexpr size_t OFF_WBO = OFF_WGLU + 1048576;
constexpr size_t OFF_WOUT = OFF_WBO + 3145728;
constexpr size_t OFF_S5M = OFF_WOUT + 2097152;
constexpr size_t OFF_V = OFF_S5M;
constexpr size_t OFF_P16 = OFF_S5M + 12582912;
constexpr size_t OFF_ADA = OFF_P16 + 32768;
constexpr size_t OFF_ROPE = OFF_ADA + 122880;
constexpr size_t OFF_CTX0 = OFF_ROPE + 131072;
constexpr size_t OFF_CKVN = OFF_CTX0 + 1048576;
constexpr size_t OFF_CTX1 = OFF_CKVN + 4194304;
constexpr size_t OFF_HB = OFF_CTX1 + 1048576;
constexpr size_t OFF_Z = OFF_HB + 16777216;
constexpr size_t OFF_KV = OFF_Z + 113246208;
constexpr size_t OFF_AGLA = OFF_KV, OFF_AMLA = OFF_KV + 8388608;
constexpr size_t OFF_QD = OFF_KV + 16777216;
constexpr size_t OFF_OIB = OFF_QD + 8388608;
constexpr size_t OFF_DEC = OFF_KV + 33554432;
constexpr size_t OFF_ST = OFF_DEC + 262144;
constexpr size_t OFF_AQ = OFF_ST + 16777216;
constexpr size_t OFF_QRAW = OFF_AQ + 6291456;
constexpr size_t OFF_AS5 = OFF_QRAW + 6291456;
constexpr size_t OFF_YG = OFF_AS5 + 8388608;
constexpr size_t OFF_TBL = OFF_YG + 8388608;
constexpr size_t OFF_BAR = OFF_TBL + 512;
constexpr size_t OFF_KF = OFF_BAR + 16384;
constexpr size_t WS_END = OFF_KF + 7864320;
constexpr int DYN_LDS = 147456;

__device__ __forceinline__ float bf2f(bf16_t b) { return __uint_as_float(((unsigned)b) << 16); }
__device__ __forceinline__ bf16_t f2bf(float f) { unsigned u = __float_as_uint(f); u += 0x7FFFu + ((u >> 16) & 1u); return (bf16_t)(u >> 16); }
__device__ __forceinline__ unsigned pk2(float lo, float hi) { return pg8::cvt_pk_bf16(lo, hi); }
__device__ __forceinline__ float lo16(unsigned w) { return __uint_as_float(w << 16); }
__device__ __forceinline__ float hi16(unsigned w) { return __uint_as_float(w & 0xffff0000u); }
__device__ __forceinline__ float sigmoidf_(float x) { return 1.f / (1.f + __expf(-x)); }
__device__ __forceinline__ float siluf_(float x) { return x / (1.f + __expf(-x)); }
__device__ __forceinline__ void store8(bf16_t* p, const f32x4& a, const f32x4& b) { u32x4 w; w.x = pk2(a[0], a[1]); w.y = pk2(a[2], a[3]); w.z = pk2(b[0], b[1]); w.w = pk2(b[2], b[3]); *(u32x4*)p = w; }
#define MFMA16(a, b, c) __builtin_amdgcn_mfma_f32_16x16x32_bf16(a, b, c, 0, 0, 0)
#define LDSFRAG(ptr) (*(const LAS bf16x8*)(ptr))

struct Order : pg8::StaticOrder { int wid;
    __device__ void setup(int M, int N, int rot, int wid_) { wid = wid_; const int G = (int)gridDim.x; init(M, N, G, (int)((blockIdx.x + (unsigned)rot) % (unsigned)G)); }
};

struct EpiZ { static constexpr bool PERM = true, AFTER_DRAIN = false; bf16_t* Z;
    __device__ __forceinline__ void operator()(const f32x4 (&acc)[2][2][4][2], const Unit& u, int wr, int wc, int fr_, int fq_) const {
        int fr = fr_, fq = fq_; asm volatile("" : "+v"(fr), "+v"(fq));
        const int row0 = u.pm * 256 + wr * 64 + fr, col0 = u.pn * 256 + wc * 32 + 8 * fq;
#pragma unroll
        for (int ai = 0; ai < 2; ++ai)
#pragma unroll
            for (int m = 0; m < 4; ++m) { bf16_t* rp = Z + (size_t)(row0 + ai * 128 + m * 16) * LDZ + col0;
#pragma unroll
                for (int bj = 0; bj < 2; ++bj) store8(rp + bj * 128, acc[ai][bj][m][0], acc[ai][bj][m][1]); }
    } };
struct EpiQ { static constexpr bool PERM = true, AFTER_DRAIN = false; bf16_t* Q;
    __device__ __forceinline__ void operator()(const f32x4 (&acc)[2][2][4][2], const Unit& u, int wr, int wc, int fr_, int fq_) const {
        int fr = fr_, fq = fq_; asm volatile("" : "+v"(fr), "+v"(fq));
        const int row0 = u.pm * 256 + wr * 64 + fr, col0 = u.pn * 256 + wc * 32 + 8 * fq;
#pragma unroll
        for (int ai = 0; ai < 2; ++ai)
#pragma unroll
            for (int m = 0; m < 4; ++m) { bf16_t* rp = Q + (size_t)(row0 + ai * 128 + m * 16) * 384 + col0;
#pragma unroll
                for (int bj = 0; bj < 2; ++bj) if (col0 + bj * 128 < 384) store8(rp + bj * 128, acc[ai][bj][m][0], acc[ai][bj][m][1]);
                }
    } };
struct EpiKV { static constexpr bool PERM = true, AFTER_DRAIN = false; bf16_t* KF; bf16_t* V; int layer; const bf16_t* Z; const float* ckr; const float* khn; const float* R;
    __device__ __forceinline__ void operator()(const f32x4 (&acc)[2][2][4][2], const Unit& u, int wr, int wc, int fr_, int fq_) const {
        int fr = fr_, fq = fq_; asm volatile("" : "+v"(fr), "+v"(fq));
        int rb = u.pm * 256; if (layer == 0) rb = rb < 2048 ? 8192 + rb : rb - 2048;
        const int row0 = rb + wr * 64 + fr;
        if (u.pn > 0) {
#pragma unroll
            for (int ai = 0; ai < 2; ++ai)
#pragma unroll
                for (int m = 0; m < 4; ++m) { const int r = row0 + ai * 128 + m * 16; bf16_t* bp; int st;
                    if (r < 4096) { bp = V + (size_t)(r >> 8) * 4 * 128 * 256 + (r & 255); st = 256; }
                    else if (r < 8192) { bp = V + 2097152 + (size_t)((r - 4096) >> 10) * 4 * 128 * 1536 + 512 + ((r - 4096) & 1023); st = 1536; }
                    else { bp = V + 2097152 + (size_t)((r - 8192) >> 9) * 4 * 128 * 1536 + ((r - 8192) & 511); st = 1536; }
#pragma unroll
                    for (int bj = 0; bj < 2; ++bj) { bf16_t* hp = bp + (size_t)((((u.pn - 1) * 2 + bj) * 128) + wc * 32 + 8 * fq) * st;
#pragma unroll
                        for (int i = 0; i < 8; i += 2) { const unsigned w = pk2(acc[ai][bj][m][i >> 2][i & 3], acc[ai][bj][m][i >> 2][(i & 3) + 1]); hp[0] = (bf16_t)(w & 0xffffu); hp[st] = (bf16_t)(w >> 16); hp += 2 * st; } }
                    __builtin_amdgcn_sched_barrier(0); }
            return; }
        float w1[4], w2[4];
#pragma unroll
        for (int i = 0; i < 4; ++i) { w1[i] = khn[64 + 4 * fq + i]; w2[i] = khn[80 + 4 * fq + i]; }
#pragma unroll
        for (int ai = 0; ai < 2; ++ai)
#pragma unroll
          for (int mh = 0; mh < 4; mh += 1) {
            float x1[4][4], x2[4][4], cs[4][4], sn[4][4];
#pragma unroll
            for (int m = mh; m < mh + 1; ++m) { const int r = row0 + ai * 128 + m * 16;
                if (r >= 8192) { const int j = r - 8192; const float* kr = ckr + ((size_t)(((j >> 9) * 2 + layer) * 512 + (j & 511))) * 32 + 4 * fq;
                    const f32x4 a = *(const f32x4*)kr, b = *(const f32x4*)(kr + 16);
#pragma unroll
                    for (int i = 0; i < 4; ++i) { x1[m][i] = a[i]; x2[m][i] = b[i]; } }
                else { const bf16_t* kr = Z + (size_t)r * LDZ + ZMKR + 4 * fq; const u32x2 a = *(const u32x2*)kr, b = *(const u32x2*)(kr + 16);
                    x1[m][0] = lo16(a.x); x1[m][1] = hi16(a.x); x1[m][2] = lo16(a.y); x1[m][3] = hi16(a.y); x2[m][0] = lo16(b.x); x2[m][1] = hi16(b.x); x2[m][2] = lo16(b.y); x2[m][3] = hi16(b.y); }
                const bool rot = r >= 4096 && r < 8192; const int pos = (r - 4096) & 1023;
                if (rot) { const f32x4 c = *(const f32x4*)(R + pos * 16 + 4 * fq), s_ = *(const f32x4*)(R + 16384 + pos * 16 + 4 * fq);
#pragma unroll
                    for (int i = 0; i < 4; ++i) { cs[m][i] = c[i]; sn[m][i] = s_[i]; } }
                else {
#pragma unroll
                    for (int i = 0; i < 4; ++i) { cs[m][i] = 1.f; sn[m][i] = 0.f; } } }
#pragma unroll
            for (int m = mh; m < mh + 1; ++m) { const int r = row0 + ai * 128 + m * 16;
                float ss = 0.f;
#pragma unroll
                for (int bj = 0; bj < 2; ++bj)
#pragma unroll
                    for (int i = 0; i < 8; ++i) { const float v = acc[ai][bj][m][i >> 2][i & 3]; ss += v * v; }
#pragma unroll
                for (int i = 0; i < 4; ++i) ss += x1[m][i] * x1[m][i] + x2[m][i] * x2[m][i];
                ss += __shfl_xor(ss, 16); ss += __shfl_xor(ss, 32);
                const float rstd = rsqrtf(ss * (1.f / 96.f) + 1e-6f);
                bf16_t* kp = KF + (size_t)r * 384 + wc * 96;
#pragma unroll
                for (int bj = 0; bj < 2; ++bj) { u32x4 w; const f32x4 v0 = acc[ai][bj][m][0], v1 = acc[ai][bj][m][1];
                    w.x = pk2(v0[0] * rstd, v0[1] * rstd); w.y = pk2(v0[2] * rstd, v0[3] * rstd);
                    w.z = pk2(v1[0] * rstd, v1[1] * rstd); w.w = pk2(v1[2] * rstd, v1[3] * rstd);
                    *(u32x4*)(kp + 32 * bj + 8 * fq) = w; }
                float o1[4], o2[4];
#pragma unroll
                for (int i = 0; i < 4; ++i) { const float a = x1[m][i] * rstd * w1[i], b = x2[m][i] * rstd * w2[i]; o1[i] = a * cs[m][i] - b * sn[m][i]; o2[i] = a * sn[m][i] + b * cs[m][i]; }
                *(u32x2*)(kp + 64 + 4 * fq) = (u32x2){pk2(o1[0], o1[1]), pk2(o1[2], o1[3])}; *(u32x2*)(kp + 80 + 4 * fq) = (u32x2){pk2(o2[0], o2[1]), pk2(o2[2], o2[3])}; }
            __builtin_amdgcn_sched_barrier(0); }
    } };
struct EpiGLU { static constexpr bool PERM = true, AFTER_DRAIN = false; bf16_t* O; const bf16_t* Z; const float* bias;
    __device__ __forceinline__ void operator()(const f32x4 (&acc)[2][2][4][2], const Unit& u, int wr, int wc, int fr_, int fq_) const {
        int fr = fr_, fq = fq_; asm volatile("" : "+v"(fr), "+v"(fq));
        const int row0 = u.pm * 256 + wr * 64 + fr, oc = u.pn * 128 + wc * 32 + 8 * fq;
#pragma unroll
        for (int ai = 0; ai < 2; ++ai) {
            float bv[8], bg[8];
            { const f32x4 b0 = *(const f32x4*)(bias + oc), b1 = *(const f32x4*)(bias + oc + 4), g0 = *(const f32x4*)(bias + 512 + oc), g1 = *(const f32x4*)(bias + 512 + oc + 4);
#pragma unroll
              for (int i = 0; i < 4; ++i) { bv[i] = b0[i]; bv[4 + i] = b1[i]; bg[i] = g0[i]; bg[4 + i] = g1[i]; } }
            u32x4 sgv[2][4];
#pragma unroll
            for (int m = 0; m < 4; ++m) sgv[ai][m] = *(const u32x4*)(Z + (size_t)(row0 + ai * 128 + m * 16) * LDZ + ZSG + oc);
#pragma unroll
            for (int m = 0; m < 4; ++m) { const size_t r = (size_t)(row0 + ai * 128 + m * 16);
                const u32x4 sg = sgv[ai][m];
                float g[8] = { lo16(sg.x), hi16(sg.x), lo16(sg.y), hi16(sg.y), lo16(sg.z), hi16(sg.z), lo16(sg.w), hi16(sg.w) };
                float o[8];
#pragma unroll
                for (int i = 0; i < 8; ++i) { const float zv = acc[ai][0][m][i >> 2][i & 3] + bv[i], zg = acc[ai][1][m][i >> 2][i & 3] + bg[i]; o[i] = zv * sigmoidf_(zg) * siluf_(g[i]); }
                u32x4 w; w.x = pk2(o[0], o[1]); w.y = pk2(o[2], o[3]); w.z = pk2(o[4], o[5]); w.w = pk2(o[6], o[7]);
                *(u32x4*)(O + r * 512 + oc) = w; }
            __builtin_amdgcn_sched_barrier(0); }
    } };
struct EpiBo { static constexpr bool PERM = true, AFTER_DRAIN = true; bf16_t* MIX; const bf16_t* Z; int branch;
    __device__ __forceinline__ void fused(f32x4 (&acc)[2][2][4][2], const Unit& u, int wr, int wc, int fr_, int fq_, LAS unsigned char* lds, int wid, int lane_) const {
        int fr = fr_, fq = fq_, lane = lane_; asm volatile("" : "+v"(fr), "+v"(fq), "+v"(lane));
        const int row0 = u.pm * 256 + wr * 64 + fr, col0 = u.pn * 256 + wc * 32 + 8 * fq;
        LAS unsigned char* wl = lds + wid * 16384;
#pragma unroll
        for (int ai = 0; ai < 2; ++ai)
#pragma unroll
            for (int m = 0; m < 4; ++m)
#pragma unroll
                for (int bj = 0; bj < 2; ++bj)
                    __builtin_amdgcn_global_load_lds((const unsigned*)(Z + (size_t)(row0 + ai * 128 + m * 16) * LDZ + ZMERGE + branch * 1024 + col0 + bj * 128), (LAS unsigned*)(wl + ((ai * 4 + m) * 2 + bj) * 1024), 16, 0, 0);
#pragma unroll
        for (int ai = 0; ai < 2; ++ai) {
            u32x4 pv[4][2];
#pragma unroll
            for (int m = 0; m < 4; ++m)
#pragma unroll
                for (int bj = 0; bj < 2; ++bj) pv[m][bj] = branch > 0 ? *(const u32x4*)(MIX + (size_t)(row0 + ai * 128 + m * 16) * 1024 + col0 + bj * 128) : (u32x4){0u, 0u, 0u, 0u};
            if (ai == 0) { asm volatile("s_waitcnt vmcnt(0)" ::: "memory"); __builtin_amdgcn_s_barrier(); asm volatile("" ::: "memory"); }
#pragma unroll
            for (int m = 0; m < 4; ++m) { const size_t r = (size_t)(row0 + ai * 128 + m * 16);
#pragma unroll
                for (int bj = 0; bj < 2; ++bj) { const u32x4 sg = *(const LAS u32x4*)(wl + ((ai * 4 + m) * 2 + bj) * 1024 + lane * 16), pp = pv[m][bj];
                    const float g[8] = { lo16(sg.x), hi16(sg.x), lo16(sg.y), hi16(sg.y), lo16(sg.z), hi16(sg.z), lo16(sg.w), hi16(sg.w) };
                    const float q[8] = { lo16(pp.x), hi16(pp.x), lo16(pp.y), hi16(pp.y), lo16(pp.z), hi16(pp.z), lo16(pp.w), hi16(pp.w) };
                    float o[8];
#pragma unroll
                    for (int i = 0; i < 8; ++i) o[i] = q[i] + sigmoidf_(g[i]) * acc[ai][bj][m][i >> 2][i & 3];
                    u32x4 w; w.x = pk2(o[0], o[1]); w.y = pk2(o[2], o[3]); w.z = pk2(o[4], o[5]); w.w = pk2(o[6], o[7]);
                    *(u32x4*)(MIX + r * 1024 + col0 + bj * 128) = w; } }
            __builtin_amdgcn_sched_barrier(0); }
        __syncthreads();
    }
    __device__ __forceinline__ void operator()(const f32x4 (&acc)[2][2][4][2], const Unit& u, int wr, int wc, int fr_, int fq_) const {
        int fr = fr_, fq = fq_; asm volatile("" : "+v"(fr), "+v"(fq));
        const int row0 = u.pm * 256 + wr * 64 + fr, col0 = u.pn * 256 + wc * 32 + 8 * fq;
#pragma unroll
        for (int ai = 0; ai < 2; ++ai)
#pragma unroll
          for (int mh = 0; mh < 4; mh += 2) {
            u32x4 gz[4][2], pv[4][2];
#pragma unroll
            for (int m = mh; m < mh + 2; ++m)
#pragma unroll
                for (int bj = 0; bj < 2; ++bj) { const size_t r = (size_t)(row0 + ai * 128 + m * 16);
                    gz[m][bj] = *(const u32x4*)(Z + r * LDZ + ZMERGE + branch * 1024 + col0 + bj * 128);
                    pv[m][bj] = branch > 0 ? *(const u32x4*)(MIX + r * 1024 + col0 + bj * 128) : (u32x4){0u, 0u, 0u, 0u}; }
#pragma unroll
            for (int m = mh; m < mh + 2; ++m) { const size_t r = (size_t)(row0 + ai * 128 + m * 16);
#pragma unroll
                for (int bj = 0; bj < 2; ++bj) { const u32x4 sg = gz[m][bj], pp = pv[m][bj];
                    const float g[8] = { lo16(sg.x), hi16(sg.x), lo16(sg.y), hi16(sg.y), lo16(sg.z), hi16(sg.z), lo16(sg.w), hi16(sg.w) };
                    const float q[8] = { lo16(pp.x), hi16(pp.x), lo16(pp.y), hi16(pp.y), lo16(pp.z), hi16(pp.z), lo16(pp.w), hi16(pp.w) };
                    float o[8];
#pragma unroll
                    for (int i = 0; i < 8; ++i) o[i] = q[i] + sigmoidf_(g[i]) * acc[ai][bj][m][i >> 2][i & 3];
                    u32x4 w; w.x = pk2(o[0], o[1]); w.y = pk2(o[2], o[3]); w.z = pk2(o[4], o[5]); w.w = pk2(o[6], o[7]);
                    *(u32x4*)(MIX + r * 1024 + col0 + bj * 128) = w; } }
            __builtin_amdgcn_sched_barrier(0); }
    } };
struct EpiOut { static constexpr bool PERM = false, AFTER_DRAIN = true; float* Y; const float* xp; const float* xs; const float* ada;
    __device__ __forceinline__ void fused(f32x4 (&acc)[2][2][4][2], const Unit& u, int wr, int wc, int fr_, int fq_, LAS unsigned char* lds, int wid, int lane_) const {
        int fr = fr_, fq = fq_, lane = lane_; asm volatile("" : "+v"(fr), "+v"(fq), "+v"(lane));
        const int row0 = u.pm * 256 + wr * 64 + fr, col0 = u.pn * 256 + wc * 32 + 4 * fq;
        LAS unsigned char* wl = lds + wid * 16384;
        const float* xb = (u.pm < 16 ? xp + (size_t)row0 * 1024 : xs + (size_t)(row0 - 4096) * 1024) + col0;
#pragma unroll
        for (int m = 0; m < 4; ++m)
#pragma unroll
            for (int bj = 0; bj < 2; ++bj)
#pragma unroll
                for (int n = 0; n < 2; ++n) __builtin_amdgcn_global_load_lds((const unsigned*)(xb + (size_t)(m * 16) * 1024 + bj * 128 + n * 16), (LAS unsigned*)(wl + ((m * 2 + bj) * 2 + n) * 1024), 16, 0, 0);
        f32x4 x1[4][2][2];
#pragma unroll
        for (int m = 0; m < 4; ++m)
#pragma unroll
            for (int bj = 0; bj < 2; ++bj)
#pragma unroll
                for (int n = 0; n < 2; ++n) x1[m][bj][n] = *(const f32x4*)(xb + (size_t)(128 + m * 16) * 1024 + bj * 128 + n * 16);
        const int ar = u.pm < 16 ? 0 : 1 + ((u.pm - 16) >> 2);
        const float* gp = ada + ar * 3072 + 2048;
        f32x4 gv[2][2];
#pragma unroll
        for (int bj = 0; bj < 2; ++bj)
#pragma unroll
            for (int n = 0; n < 2; ++n) gv[bj][n] = *(const f32x4*)(gp + col0 + bj * 128 + n * 16);
        asm volatile("s_waitcnt vmcnt(0)" ::: "memory"); __builtin_amdgcn_s_barrier(); asm volatile("" ::: "memory");
        float* yb = Y + (size_t)row0 * 1024 + col0;
#pragma unroll
        for (int m = 0; m < 4; ++m)
#pragma unroll
            for (int bj = 0; bj < 2; ++bj)
#pragma unroll
                for (int n = 0; n < 2; ++n) { const f32x4 xv = *(const LAS f32x4*)(wl + ((m * 2 + bj) * 2 + n) * 1024 + lane * 16);
                    *(f32x4*)(yb + (size_t)(m * 16) * 1024 + bj * 128 + n * 16) = xv + gv[bj][n] * acc[0][bj][m][n];
                    *(f32x4*)(yb + (size_t)(128 + m * 16) * 1024 + bj * 128 + n * 16) = x1[m][bj][n] + gv[bj][n] * acc[1][bj][m][n]; }
        __syncthreads();
    }
    __device__ __forceinline__ void operator()(const f32x4 (&acc)[2][2][4][2], const Unit& u, int wr, int wc, int fr_, int fq_) const {
        int fr = fr_, fq = fq_; asm volatile("" : "+v"(fr), "+v"(fq));
        const int row0 = u.pm * 256 + wr * 64 + fr, col0 = u.pn * 256 + wc * 32 + 4 * fq;
        const int ar = u.pm < 16 ? 0 : 1 + ((u.pm - 16) >> 2);
        const float* gp = ada + ar * 3072 + 2048;
        f32x4 gv[2][2];
#pragma unroll
        for (int bj = 0; bj < 2; ++bj)
#pragma unroll
            for (int n = 0; n < 2; ++n) gv[bj][n] = *(const f32x4*)(gp + col0 + bj * 128 + n * 16);
#pragma unroll
        for (int ai = 0; ai < 2; ++ai)
#pragma unroll
          for (int mh = 0; mh < 4; mh += 2) {
            f32x4 xv[4][2][2];
#pragma unroll
            for (int m = mh; m < mh + 2; ++m) { const int r = row0 + ai * 128 + m * 16;
                const float* xr = (r < 4096 ? xp + (size_t)r * 1024 : xs + (size_t)(r - 4096) * 1024) + col0;
#pragma unroll
                for (int bj = 0; bj < 2; ++bj)
#pragma unroll
                    for (int n = 0; n < 2; ++n) xv[m][bj][n] = *(const f32x4*)(xr + bj * 128 + n * 16); }
#pragma unroll
            for (int m = mh; m < mh + 2; ++m) { const int r = row0 + ai * 128 + m * 16;
                float* yr = Y + (size_t)r * 1024 + col0;
#pragma unroll
                for (int bj = 0; bj < 2; ++bj)
#pragma unroll
                    for (int n = 0; n < 2; ++n) *(f32x4*)(yr + bj * 128 + n * 16) = xv[m][bj][n] + gv[bj][n] * acc[ai][bj][m][n]; }
            __builtin_amdgcn_sched_barrier(0); }
    } };

__device__ __forceinline__ void job_ada(const Params& p, int j, lds_t lds) {
    LAS float* sc = (LAS float*)lds; LAS float* red = sc + 5 * 1024;
    const int l = j / 96, c0 = (j % 96) * 32, tid = tid_opaque(p);
    for (int i = tid; i < 5 * 1024; i += 512) { const int r = i >> 10, k = i & 1023; const float v = r == 0 ? p.in[I_CCTX][k] : p.in[I_C][(r - 1) * 1024 + k]; sc[i] = v / (1.f + expf(-v)); }
    __syncthreads();
    const int col = tid & 31, kg = tid >> 5; const float* W = p.in[I_WADA] + (size_t)l * 1024 * 3072 + (size_t)(kg * 64) * 3072 + c0 + col;
    float a0 = 0.f, a1 = 0.f, a2 = 0.f, a3 = 0.f, a4 = 0.f;
#pragma unroll 1
    for (int kb = 0; kb < 64; kb += 16) { float w[16];
#pragma unroll
        for (int i = 0; i < 16; ++i) w[i] = W[(size_t)(kb + i) * 3072];
#pragma unroll
        for (int i = 0; i < 16; ++i) { const int k = kg * 64 + kb + i; a0 += sc[k] * w[i]; a1 += sc[1024 + k] * w[i]; a2 += sc[2048 + k] * w[i]; a3 += sc[3072 + k] * w[i]; a4 += sc[4096 + k] * w[i]; } }
    red[(kg * 5 + 0) * 32 + col] = a0; red[(kg * 5 + 1) * 32 + col] = a1; red[(kg * 5 + 2) * 32 + col] = a2; red[(kg * 5 + 3) * 32 + col] = a3; red[(kg * 5 + 4) * 32 + col] = a4;
    __syncthreads();
    if (tid < 160) { const int r = tid >> 5, cc = tid & 31; float s = p.in[I_BADA][l * 3072 + c0 + cc];
        for (int g = 0; g < 16; ++g) s += red[(g * 5 + r) * 32 + cc];
        ((float*)(p.ws + OFF_ADA))[(l * 5 + r) * 3072 + c0 + cc] = s; }
    __syncthreads();
}
__device__ __forceinline__ void job_ctx(const Params& p, int j) {
    const int base = j * 4096 + tid_opaque(p) * 8; const int l = base / (2048 * 256), rem = base % (2048 * 256), row = rem >> 8, c = rem & 255, b = row >> 9, jj = row & 511;
    const float* s = p.in[I_CKV] + ((size_t)((b * 2 + l) * 512 + jj)) * 256 + c;
    const f32x4 v0 = *(const f32x4*)s, v1 = *(const f32x4*)(s + 4);
    bf16_t* d = (bf16_t*)(p.ws + (l == 0 ? OFF_CTX0 : OFF_CTX1)) + (size_t)row * 256 + c;
    store8(d, v0, v1);
}
__device__ __forceinline__ void job_rope(const Params& p, int j) {
    const int idx = j * 512 + tid_opaque(p), pos = idx >> 4, i = idx & 15, f = i & 7;
    const float inv = powf(10000.f, -(float)f / 8.f); const float ang = (float)(i < 8 ? (pos >> 6) : (pos & 63)) * inv;
    float* R = (float*)(p.ws + OFF_ROPE); R[idx] = cosf(ang); R[16384 + idx] = sinf(ang);
}

__device__ __forceinline__ void job_prep(const Params& p, int l, int j) {
    const int tid = tid_opaque(p), wid = tid >> 6, lane = tid & 63, row = j * 8 + wid;
    const float* x = l == 0 ? (row < 4096 ? p.in[I_XP] + (size_t)row * 1024 : p.in[I_XS] + (size_t)(row - 4096) * 1024) : p.out + (size_t)row * 1024;
    const int ar = row < 4096 ? 0 : 1 + ((row - 4096) >> 10);
    const float* ada = (const float*)(p.ws + OFF_ADA) + (l * 5 + ar) * 3072; const float* nw = p.in[I_NORMW] + l * 1024;
    f32x4 v[4]; float ss = 0.f;
#pragma unroll
    for (int i = 0; i < 4; ++i) { v[i] = *(const f32x4*)(x + i * 256 + lane * 4); ss += v[i][0] * v[i][0] + v[i][1] * v[i][1] + v[i][2] * v[i][2] + v[i][3] * v[i][3]; }
#pragma unroll
    for (int o = 1; o < 64; o <<= 1) ss += __shfl_xor(ss, o);
    const float rstd = rsqrtf(ss * (1.f / 1024.f) + 1e-6f);
    bf16_t* h = (bf16_t*)(p.ws + OFF_HB) + (size_t)row * 1024;
#pragma unroll
    for (int i = 0; i < 4; ++i) { const int c = i * 256 + lane * 4; const f32x4 w = *(const f32x4*)(nw + c), sh = *(const f32x4*)(ada + c), sc = *(const f32x4*)(ada + 1024 + c);
        float o[4];
#pragma unroll
        for (int k = 0; k < 4; ++k) o[k] = v[i][k] * rstd * w[k] * (1.f + sc[k]) + sh[k];
        u32x2 pk; pk.x = pk2(o[0], o[1]); pk.y = pk2(o[2], o[3]); *(u32x2*)(h + c) = pk; }
}
__device__ __forceinline__ void wt_tile(const Params& p, const float* src, int ldsrc, int sbase, int nvalid, int mode, bf16_t* dst, int K, int n0, int k0, lds_t lds) {
    LAS float* t = (LAS float*)lds; const int tid = tid_opaque(p);
    const int nn = tid & 255, kh = tid >> 8; const int sc = mode == 0 ? sbase + nn : mode == 1 ? ((nn >> 7) & 1) * 512 + sbase + (nn & 127) : ((nn >> 5) & 3) * 64 + (nn >> 7) * 32 + (nn & 31); const bool ok = mode != 0 || nn < nvalid;
    float v[32];
#pragma unroll
    for (int i = 0; i < 32; ++i) v[i] = ok ? src[(size_t)(k0 + 2 * i + kh) * ldsrc + sc] : 0.f;
#pragma unroll
    for (int i = 0; i < 32; ++i) t[(2 * i + kh) * 257 + nn] = v[i];
    __syncthreads();
#pragma unroll
    for (int ps = 0; ps < 4; ++ps) { const int n = ps * 64 + (tid >> 3), kc = tid & 7; const LAS float* s = t + (kc * 8) * 257 + n; u32x4 w;
        w.x = pk2(s[0], s[257]); w.y = pk2(s[514], s[771]); w.z = pk2(s[1028], s[1285]); w.w = pk2(s[1542], s[1799]);
        *(u32x4*)(dst + (size_t)(n0 + n) * K + k0 + kc * 8) = w; }
    __syncthreads();
}
constexpr int WT_WIN = 27 * 16, WT_WUQ = 2 * 6, WT_WKV = 3 * 4, WT_WGLU = 4 * 8, WT_WBO = 4 * 8, WT_WOUT = 4 * 16, WT_EARLY = WT_WIN + WT_WUQ + WT_WKV + WT_WGLU, WT_TOTAL = WT_EARLY + 3 * WT_WBO + WT_WOUT;
__device__ __forceinline__ void job_wt(const Params& p, int l, int t, lds_t lds) {
    if (t < WT_WIN) { const int nt = t / 16, kt = t % 16; wt_tile(p, p.in[I_WIN] + (size_t)l * 1024 * 6848, 6848, nt * 256, 6848 - nt * 256, 0, (bf16_t*)(p.ws + OFF_WIN), 1024, nt * 256, kt * 64, lds); return; } t -= WT_WIN;
    if (t < WT_WUQ) { const int nt = t / 6, kt = t % 6; wt_tile(p, p.in[I_WUQ] + (size_t)l * 384 * 384, 384, nt * 256, 384 - nt * 256, 0, (bf16_t*)(p.ws + OFF_WUQ), 384, nt * 256, kt * 64, lds); return; } t -= WT_WUQ;
    if (t < WT_WKV) { const int nt = t / 4, kt = t % 4;
        if (nt == 0) wt_tile(p, p.in[I_WUK] + (size_t)l * 256 * 256, 256, 0, 256, 2, (bf16_t*)(p.ws + OFF_WKV), 256, 0, kt * 64, lds);
        else wt_tile(p, p.in[I_WUV] + (size_t)l * 256 * 512, 512, (nt - 1) * 256, 256, 0, (bf16_t*)(p.ws + OFF_WKV), 256, nt * 256, kt * 64, lds);
        return; } t -= WT_WKV;
    if (t < WT_WGLU) { const int nt = t / 8, kt = t % 8; wt_tile(p, p.in[I_WGLU] + (size_t)l * 512 * 1024, 1024, nt * 128, 256, 1, (bf16_t*)(p.ws + OFF_WGLU), 512, nt * 256, kt * 64, lds); return; } t -= WT_WGLU;
    if (t < 3 * WT_WBO) { const int br = t / WT_WBO, tt = t % WT_WBO, nt = tt / 8, kt = tt % 8;
        wt_tile(p, p.in[I_WBOG + br] + (size_t)l * 512 * 1024, 1024, nt * 256, 256, 0, (bf16_t*)(p.ws + OFF_WBO) + (size_t)br * 1024 * 512, 512, nt * 256, kt * 64, lds); return; } t -= 3 * WT_WBO;
    { const int nt = t / 16, kt = t % 16; wt_tile(p, p.in[I_WOUT] + (size_t)l * 1024 * 1024, 1024, nt * 256, 256, 0, (bf16_t*)(p.ws + OFF_WOUT), 1024, nt * 256, kt * 64, lds); }
}
__device__ __forceinline__ void job_s5setup(const Params& p, int l, int j, lds_t lds) {
    const int g = j / 3, which = j % 3, tid = tid_opaque(p);
    LAS f32x2_t* pw = (LAS f32x2_t*)lds;
    LAS f32x2_t* Bt = pw + 2 * 17 * 64;
    LAS f32x2_t* Cn = Bt + 2 * 64 * 16;
    LAS float* Kt = (LAS float*)(Cn + 64 * 16);
    LAS float* raw = Kt + 8192;
    { const size_t gb = (size_t)(l * 32 + g) * 1024;
      for (int i = tid; i < 1024; i += 512) { raw[i] = p.in[I_BRE][gb + i]; raw[1024 + i] = p.in[I_BIM][gb + i]; raw[2048 + i] = p.in[I_CRE][gb + i]; raw[3072 + i] = p.in[I_CIM][gb + i]; }
      if (tid < 128) { const int d = tid >> 6, n = tid & 63; raw[4096 + tid] = p.in[I_ARE][((l * 2 + d) * 32 + g) * 64 + n]; raw[4224 + tid] = p.in[I_AIM][((l * 2 + d) * 32 + g) * 64 + n]; }
      if (tid < 2) raw[4352 + tid] = p.in[I_LOGDT][(l * 2 + tid) * 32 + g]; }
    __syncthreads();
    if (tid < 128) { const int d = tid >> 6, n = tid & 63;
        const float dt = expf(raw[4352 + d]);
        const float are = raw[4096 + tid], aim = raw[4224 + tid];
        for (int tau = 0; tau <= 16; ++tau) { const float mag = expf(are * dt * (float)tau); float s, c; sincosf(aim * dt * (float)tau, &s, &c); pw[(d * 17 + tau) * 64 + n] = (f32x2_t){mag * c, mag * s}; }
        float s1, c1; sincosf(aim * dt, &s1, &c1); float sh = sinf(0.5f * aim * dt);
        const float em1 = expm1f(are * dt), mag1 = em1 + 1.f;
        const float nre = em1 * c1 - 2.f * sh * sh, abim = mag1 * s1, den = are * are + aim * aim;
        const float cfr = (nre * are + abim * aim) / den, cfi = (abim * are - nre * aim) / den;
        for (int q = 0; q < 16; ++q) { const float br = raw[n * 16 + q], bi = raw[1024 + n * 16 + q];
            Bt[(d * 64 + n) * 16 + q] = (f32x2_t){cfr * br - cfi * bi, cfr * bi + cfi * br}; }
        if (which == 1) ((f32x2_t*)(p.ws + OFF_P16))[(g * 2 + d) * 64 + n] = pw[(d * 17 + 16) * 64 + n];
    }
    for (int i = tid; i < 1024; i += 512) { const int n = i >> 4, pp = i & 15; Cn[i] = (f32x2_t){raw[2048 + pp * 64 + n], raw[3072 + pp * 64 + n]}; }
    __syncthreads();
    bf16_t* M = (bf16_t*)(p.ws + OFF_S5M) + (size_t)(g * 3 + which) * 65536;
    if (which == 0) {
        for (int i = tid; i < 8192; i += 512) { const int d = i >> 12, tau = (i >> 8) & 15, pp = (i >> 4) & 15, q = i & 15; float s = 0.f;
#pragma unroll 16
            for (int n = 0; n < 64; ++n) { const f32x2_t c = Cn[n * 16 + pp], w = pw[(d * 17 + tau) * 64 + n], b = Bt[(d * 64 + n) * 16 + q];
                const float cwr = c.x * w.x - c.y * w.y, cwi = c.x * w.y + c.y * w.x; s += cwr * b.x - cwi * b.y; }
            Kt[i] = s; }
        __syncthreads();
#pragma unroll 8
        for (int i = tid; i < 65536; i += 512) { const int no = i >> 8, k = i & 255, t = no >> 4, pp = no & 15, s = k >> 4, q = k & 15; float v;
            if (t > s) v = Kt[(0 * 16 + (t - s)) * 256 + pp * 16 + q];
            else if (t < s) v = Kt[(1 * 16 + (s - t)) * 256 + pp * 16 + q];
            else { v = Kt[pp * 16 + q] + Kt[16 * 256 + pp * 16 + q]; if (pp == q) v += p.in[I_S5D][l * 512 + g * 16 + pp]; }
            M[i] = f2bf(v); }
    } else if (which == 1) {
#pragma unroll 8
        for (int i = tid; i < 65536; i += 512) { const int no = i >> 8, k = i & 255, d = no >> 7, ri = (no >> 6) & 1, n = no & 63, s = k >> 4, q = k & 15; const int e = d == 0 ? 15 - s : s;
            const f32x2_t w = pw[(d * 17 + e) * 64 + n], b = Bt[(d * 64 + n) * 16 + q];
            M[i] = f2bf(ri == 0 ? w.x * b.x - w.y * b.y : w.x * b.y + w.y * b.x); }
    } else {
#pragma unroll 8
        for (int i = tid; i < 65536; i += 512) { const int no = i >> 8, k = i & 255, t = no >> 4, pp = no & 15, d = k >> 7, ri = (k >> 6) & 1, n = k & 63; const int e = d == 0 ? t + 1 : 16 - t;
            const f32x2_t c = Cn[n * 16 + pp], w = pw[(d * 17 + e) * 64 + n];
            M[i] = f2bf(ri == 0 ? c.x * w.x - c.y * w.y : -(c.x * w.y + c.y * w.x)); }
    }
    __syncthreads();
}

__device__ __forceinline__ float gelu_tanh(float x) { const float u = 0.7978845608f * (x + 0.044715f * x * x * x); const float t = 1.f - 2.f / (1.f + __expf(2.f * u)); return 0.5f * x * (1.f + t); }
__device__ __forceinline__ void job_s5(const Params& p, int l, int j, lds_t lds) {
    const int tid = tid_opaque(p), wid = tid >> 6, lane = tid & 63, lr = lane & 15, lq = lane >> 4;
    const int bb = j >> 5, g = j & 31;
    const int M = bb < 16 ? 16 : 64, MT = M >> 4; const int tok0 = bb < 16 ? bb * 256 : 4096 + (bb - 16) * 1024;
    LAS bf16_t* Us = (LAS bf16_t*)lds; LAS bf16_t* Xs = Us + 64 * 264; LAS float* Xin = (LAS float*)(lds + 2 * 64 * 264 * 2);
    const bf16_t* Z = (const bf16_t*)(p.ws + OFF_Z);
    const bf16_t* TT = (const bf16_t*)(p.ws + OFF_S5M) + (size_t)(g * 3) * 65536; const bf16_t* G = TT + 65536; const bf16_t* Cc = G + 65536;
    bf16x8 bq[8][2];
#pragma unroll
    for (int ks = 0; ks < 8; ++ks) { bq[ks][0] = *(const bf16x8*)(G + (size_t)(wid * 32 + lr) * 256 + ks * 32 + lq * 8); bq[ks][1] = *(const bf16x8*)(G + (size_t)(wid * 32 + 16 + lr) * 256 + ks * 32 + lq * 8); }
    f32x2_t a16 = {0.f, 0.f}; float xr = 0.f, xi = 0.f;
    if (tid < 128) { const int d = tid >> 6, n = tid & 63; a16 = ((const f32x2_t*)(p.ws + OFF_P16))[(g * 2 + d) * 64 + n];
        if (bb >= 16) { const size_t o = ((size_t)(((bb - 16) * 2 + l) * 2 + d) * 2) * 2048 + g * 64 + n; xr = p.in[I_SS5][o]; xi = p.in[I_SS5][o + 2048]; } }
    for (int idx = tid; idx < M * 32; idx += 512) { const int tok = idx >> 1, hf = idx & 1;
        *(LAS u32x4*)(Us + (tok >> 4) * 264 + (tok & 15) * 16 + hf * 8) = *(const u32x4*)(Z + (size_t)(tok0 + tok) * LDZ + ZSU + g * 16 + hf * 8); }
    __syncthreads();
    f32x4 acc[4][2];
#pragma unroll
    for (int a = 0; a < 4; ++a) { acc[a][0] = (f32x4){0.f, 0.f, 0.f, 0.f}; acc[a][1] = acc[a][0]; }
#pragma unroll
    for (int ks = 0; ks < 8; ++ks)
#pragma unroll
        for (int mt = 0; mt < 4; ++mt) if (mt < MT) { const bf16x8 a = LDSFRAG(Us + (mt * 16 + lr) * 264 + ks * 32 + lq * 8); acc[mt][0] = MFMA16(a, bq[ks][0], acc[mt][0]); acc[mt][1] = MFMA16(a, bq[ks][1], acc[mt][1]); }
    bf16x8 bc[8][2];
#pragma unroll
    for (int ks = 0; ks < 8; ++ks) { bq[ks][0] = *(const bf16x8*)(TT + (size_t)(wid * 32 + lr) * 256 + ks * 32 + lq * 8); bq[ks][1] = *(const bf16x8*)(TT + (size_t)(wid * 32 + 16 + lr) * 256 + ks * 32 + lq * 8);
        bc[ks][0] = *(const bf16x8*)(Cc + (size_t)(wid * 32 + lr) * 256 + ks * 32 + lq * 8); bc[ks][1] = *(const bf16x8*)(Cc + (size_t)(wid * 32 + 16 + lr) * 256 + ks * 32 + lq * 8); }
#pragma unroll
    for (int mt = 0; mt < 4; ++mt) if (mt < MT)
#pragma unroll
        for (int ct = 0; ct < 2; ++ct)
#pragma unroll
            for (int r = 0; r < 4; ++r) Xin[(mt * 16 + lq * 4 + r) * 260 + wid * 32 + ct * 16 + lr] = acc[mt][ct][r];
    __syncthreads();
    if (tid < 128) { const int d = tid >> 6, n = tid & 63;
        const int cre = d * 128 + n, cim = cre + 64;
        for (int i = 0; i < M; ++i) { const int c = d == 0 ? i : M - 1 - i;
            Xs[c * 264 + cre] = f2bf(xr); Xs[c * 264 + cim] = f2bf(xi);
            const float ur = Xin[c * 260 + cre], ui = Xin[c * 260 + cim];
            const float nr = a16.x * xr - a16.y * xi + ur, ni = a16.x * xi + a16.y * xr + ui; xr = nr; xi = ni; }
        if (bb < 16) { const size_t o = OUT_S5 + ((size_t)((bb * 2 + l) * 2 + d) * 2) * 2048 + g * 64 + n; p.out[o] = xr; p.out[o + 2048] = xi; }
    }
    __syncthreads();
#pragma unroll
    for (int a = 0; a < 4; ++a) { acc[a][0] = (f32x4){0.f, 0.f, 0.f, 0.f}; acc[a][1] = acc[a][0]; }
#pragma unroll
    for (int ks = 0; ks < 8; ++ks)
#pragma unroll
        for (int mt = 0; mt < 4; ++mt) if (mt < MT) { const bf16x8 a = LDSFRAG(Us + (mt * 16 + lr) * 264 + ks * 32 + lq * 8); acc[mt][0] = MFMA16(a, bq[ks][0], acc[mt][0]); acc[mt][1] = MFMA16(a, bq[ks][1], acc[mt][1]); }
#pragma unroll
    for (int ks = 0; ks < 8; ++ks)
#pragma unroll
        for (int mt = 0; mt < 4; ++mt) if (mt < MT) { const bf16x8 a = LDSFRAG(Xs + (mt * 16 + lr) * 264 + ks * 32 + lq * 8); acc[mt][0] = MFMA16(a, bc[ks][0], acc[mt][0]); acc[mt][1] = MFMA16(a, bc[ks][1], acc[mt][1]); }
    bf16_t* Yg = (bf16_t*)(p.ws + OFF_YG);
#pragma unroll
    for (int mt = 0; mt < 4; ++mt) if (mt < MT)
#pragma unroll
        for (int ct = 0; ct < 2; ++ct)
#pragma unroll
            for (int r = 0; r < 4; ++r) { const int chunk = mt * 16 + lq * 4 + r, t = wid * 2 + ct;
                Yg[(size_t)(tok0 + chunk * 16 + t) * 512 + g * 16 + lr] = f2bf(gelu_tanh(acc[mt][ct][r])); }
    __syncthreads();
}
__device__ __forceinline__ void job_mlaprep(const Params& p, int l, int j) {
    const int tid = tid_opaque(p), wid = tid >> 6, lane = tid & 63, row = j * 8 + wid;
    const bf16_t* z = (const bf16_t*)(p.ws + OFF_Z) + (size_t)row * LDZ;
    float q[6], kv[4]; float sq = 0.f, sk = 0.f;
#pragma unroll
    for (int i = 0; i < 6; ++i) { q[i] = bf2f(z[ZMQ + i * 64 + lane]); sq += q[i] * q[i]; }
#pragma unroll
    for (int i = 0; i < 4; ++i) { kv[i] = bf2f(z[ZMKV + i * 64 + lane]); sk += kv[i] * kv[i]; }
#pragma unroll
    for (int o = 1; o < 64; o <<= 1) { sq += __shfl_xor(sq, o); sk += __shfl_xor(sk, o); }
    const float rq = rsqrtf(sq * (1.f / 384.f) + 1e-6f), rk = rsqrtf(sk * (1.f / 256.f) + 1e-6f);
    bf16_t* aq = (bf16_t*)(p.ws + OFF_AQ) + (size_t)row * 384; bf16_t* ck = (bf16_t*)(p.ws + OFF_CKVN) + (size_t)row * 256;
#pragma unroll
    for (int i = 0; i < 6; ++i) aq[i * 64 + lane] = f2bf(q[i] * rq * p.in[I_QNORM][l * 384 + i * 64 + lane]);
    const bool prompt = row < 4096; const int b = row >> 8, t = row & 255;
#pragma unroll
    for (int i = 0; i < 4; ++i) { const float v = kv[i] * rk * p.in[I_KVNORM][l * 256 + i * 64 + lane]; ck[i * 64 + lane] = f2bf(v);
        if (prompt) p.out[OUT_CKV + ((size_t)((b * 2 + l) * 256 + t)) * 256 + i * 64 + lane] = v; }
    if (prompt && lane < 32) p.out[OUT_KR + ((size_t)((b * 2 + l) * 256 + t)) * 32 + lane] = bf2f(z[ZMKR + lane]);
}
__device__ __forceinline__ float logsigmoidf_(float x) { return fminf(x, 0.f) - __logf(1.f + __expf(-fabsf(x))); }
__device__ __forceinline__ void job_glaA(const Params& p, int l, int j, lds_t lds) {
    const int tid = tid_opaque(p), wid = tid >> 6, lane = tid & 63, lr = lane & 15, lq = lane >> 4;
    const int ck = j >> 2, h = j & 3, tok0 = ck * 64;
    LAS bf16_t* QDf = (LAS bf16_t*)lds; LAS bf16_t* QDb = QDf + 4608; LAS bf16_t* KDf = QDb + 4608; LAS bf16_t* KDb = KDf + 4608; LAS bf16_t* KRf = KDb + 4608; LAS bf16_t* KRb = KRf + 4608;
    LAS bf16_t* VT = KRb + 4608;
    LAS bf16_t* ATT = VT + 9216;
    LAS float* GA = (LAS float*)(ATT + 4608);
    LAS float* TOT = GA + 2048;
    const bf16_t* Z = (const bf16_t*)(p.ws + OFF_Z);
    { const int c = tid >> 3, part = tid & 7; const u32x2 gv = *(const u32x2*)(Z + (size_t)(tok0 + c) * LDZ + ZGA + part * 4);
      GA[c * 32 + part * 4 + 0] = lo16(gv.x); GA[c * 32 + part * 4 + 1] = hi16(gv.x); GA[c * 32 + part * 4 + 2] = lo16(gv.y); GA[c * 32 + part * 4 + 3] = hi16(gv.y);
      const bf16_t* vp = Z + (size_t)(tok0 + c) * LDZ + ZV + h * 128 + part * 16;
      const u32x4 v0 = *(const u32x4*)vp, v1 = *(const u32x4*)(vp + 8);
      const unsigned w[8] = { v0.x, v0.y, v0.z, v0.w, v1.x, v1.y, v1.z, v1.w };
#pragma unroll
      for (int i = 0; i < 8; ++i) { VT[(part * 16 + 2 * i) * 72 + c] = (bf16_t)(w[i] & 0xffffu); VT[(part * 16 + 2 * i + 1) * 72 + c] = (bf16_t)(w[i] >> 16); } }
    __syncthreads();
    const int d = tid & 63, cg_ = tid >> 6;
    float laf[8], lab[8]; bf16_t qraw[8], kraw[8];
#pragma unroll
    for (int i = 0; i < 8; ++i) { const size_t zr = (size_t)(tok0 + cg_ * 8 + i) * LDZ; qraw[i] = Z[zr + ZQ + h * 64 + d]; kraw[i] = Z[zr + ZK + h * 64 + d]; }
    { float wf[16], wb[16];
#pragma unroll
      for (int r = 0; r < 16; ++r) { wf[r] = p.in[I_WA2][((size_t)((l * 2 + 0) * 16 + r)) * 256 + h * 64 + d]; wb[r] = p.in[I_WA2][((size_t)((l * 2 + 1) * 16 + r)) * 256 + h * 64 + d]; }
      const float bf_ = p.in[I_BA][(l * 2 + 0) * 256 + h * 64 + d], bb_ = p.in[I_BA][(l * 2 + 1) * 256 + h * 64 + d];
#pragma unroll
      for (int i = 0; i < 8; ++i) { const int c = cg_ * 8 + i; float xf = bf_, xb = bb_;
#pragma unroll
          for (int r = 0; r < 16; ++r) { xf += GA[c * 32 + r] * wf[r]; xb += GA[c * 32 + 16 + r] * wb[r]; }
          laf[i] = logsigmoidf_(xf) * (1.f / 16.f); lab[i] = logsigmoidf_(xb) * (1.f / 16.f); } }
#pragma unroll
    for (int i = 1; i < 8; ++i) laf[i] += laf[i - 1];
#pragma unroll
    for (int i = 6; i >= 0; --i) lab[i] += lab[i + 1];
    TOT[(0 * 8 + cg_) * 64 + d] = laf[7]; TOT[(1 * 8 + cg_) * 64 + d] = lab[0];
    __syncthreads();
    float offf = 0.f, offb = 0.f, Tf = 0.f, Tb = 0.f;
#pragma unroll
    for (int g = 0; g < 8; ++g) { const float a = TOT[g * 64 + d], b = TOT[(8 + g) * 64 + d]; Tf += a; Tb += b; if (g < cg_) offf += a; if (g > cg_) offb += b; }
    bf16_t* QD = (bf16_t*)(p.ws + OFF_QD);
#pragma unroll
    for (int i = 0; i < 8; ++i) { const int c = cg_ * 8 + i;
        const float q = bf2f(qraw[i]) * 0.125f, k = bf2f(kraw[i]);
        const float bf_ = offf + laf[i], bb_ = offb + lab[i];
        const bf16_t qf = f2bf(q * __expf(bf_)), qb = f2bf(q * __expf(bb_));
        QDf[c * 72 + d] = qf; QDb[c * 72 + d] = qb;
        KDf[c * 72 + d] = f2bf(k * __expf(-bf_)); KDb[c * 72 + d] = f2bf(k * __expf(-bb_));
        KRf[d * 72 + c] = f2bf(k * __expf(Tf - bf_)); KRb[d * 72 + c] = f2bf(k * __expf(Tb - bb_));
        QD[(size_t)(tok0 + c) * 256 + h * 64 + d] = qf; QD[(size_t)(8192 + tok0 + c) * 256 + h * 64 + d] = qb; }
    if (cg_ == 0) { float* DEC = (float*)(p.ws + OFF_DEC); DEC[((0 * 128 + ck) * 4 + h) * 64 + d] = __expf(Tf); DEC[((1 * 128 + ck) * 4 + h) * 64 + d] = __expf(Tb); }
    __syncthreads();
#pragma unroll
    for (int q2 = 0; q2 < 2; ++q2) { const int tt = wid * 2 + q2, ti = tt >> 2, tj = tt & 3; f32x4 af = {0.f, 0.f, 0.f, 0.f}, ab = af;
#pragma unroll
        for (int ks = 0; ks < 2; ++ks) { const int ko = ks * 32 + lq * 8;
            af = MFMA16(LDSFRAG(QDf + (ti * 16 + lr) * 72 + ko), LDSFRAG(KDf + (tj * 16 + lr) * 72 + ko), af);
            ab = MFMA16(LDSFRAG(QDb + (ti * 16 + lr) * 72 + ko), LDSFRAG(KDb + (tj * 16 + lr) * 72 + ko), ab); }
#pragma unroll
        for (int r = 0; r < 4; ++r) { const int c = ti * 16 + lq * 4 + r, s = tj * 16 + lr; const float v = (s <= c ? af[r] : 0.f) + (s >= c ? ab[r] : 0.f); ATT[c * 72 + s] = f2bf(v); } }
    __syncthreads();
    bf16x8 vb[2];
#pragma unroll
    for (int ks = 0; ks < 2; ++ks) vb[ks] = LDSFRAG(VT + (wid * 16 + lr) * 72 + ks * 32 + lq * 8);
    bf16_t* OI = (bf16_t*)(p.ws + OFF_OIB); bf16_t* KV = (bf16_t*)(p.ws + OFF_KV);
#pragma unroll
    for (int ct = 0; ct < 4; ++ct) { f32x4 a = {0.f, 0.f, 0.f, 0.f};
#pragma unroll
        for (int ks = 0; ks < 2; ++ks) a = MFMA16(LDSFRAG(ATT + (ct * 16 + lr) * 72 + ks * 32 + lq * 8), vb[ks], a);
#pragma unroll
        for (int r = 0; r < 4; ++r) OI[(size_t)(tok0 + ct * 16 + lq * 4 + r) * 512 + h * 128 + wid * 16 + lr] = f2bf(a[r]); }
#pragma unroll
    for (int dir = 0; dir < 2; ++dir) { const LAS bf16_t* KR = dir == 0 ? KRf : KRb; bf16_t* kvp = KV + ((size_t)((dir * 128 + ck) * 4 + h)) * 8192;
#pragma unroll
        for (int dt = 0; dt < 4; ++dt) { f32x4 a = {0.f, 0.f, 0.f, 0.f};
#pragma unroll
            for (int ks = 0; ks < 2; ++ks) a = MFMA16(LDSFRAG(KR + (dt * 16 + lr) * 72 + ks * 32 + lq * 8), vb[ks], a);
#pragma unroll
            for (int r = 0; r < 4; ++r) kvp[(dt * 16 + lq * 4 + r) * 128 + wid * 16 + lr] = f2bf(a[r]); } }
    __syncthreads();
}

__device__ __forceinline__ void job_glaB(const Params& p, int l, int j) {
    const int qt = j & 3, h = (j >> 2) & 3, rest = j >> 4, bb = rest % 20, dir = rest / 20;
    const int idx0 = qt * 2048 + tid_opaque(p);
    const int nck = bb < 16 ? 4 : 16, ck0 = bb < 16 ? bb * 4 : 64 + (bb - 16) * 16;
    float S[4];
#pragma unroll
    for (int e = 0; e < 4; ++e) S[e] = bb >= 16 ? p.in[I_SGLA][((size_t)((((bb - 16) * 2 + l) * 2 + dir) * 4 + h)) * 8192 + idx0 + e * 512] : 0.f;
    const bf16_t* KV = (const bf16_t*)(p.ws + OFF_KV); const float* DEC = (const float*)(p.ws + OFF_DEC); bf16_t* ST = (bf16_t*)(p.ws + OFF_ST);
    for (int i0 = 0; i0 < nck; i0 += 4) { float dv[4][4]; bf16_t kv[4][4]; size_t its[4];
#pragma unroll
        for (int u = 0; u < 4; ++u) { const int i = i0 + u, ck = dir == 0 ? ck0 + i : ck0 + nck - 1 - i; its[u] = (size_t)((dir * 128 + ck) * 4 + h);
#pragma unroll
            for (int e = 0; e < 4; ++e) { const int idx = idx0 + e * 512; dv[u][e] = DEC[its[u] * 64 + (idx >> 7)]; kv[u][e] = KV[its[u] * 8192 + idx]; } }
#pragma unroll
        for (int u = 0; u < 4; ++u)
#pragma unroll
            for (int e = 0; e < 4; ++e) { ST[its[u] * 8192 + idx0 + e * 512] = f2bf(S[e]); S[e] = dv[u][e] * S[e] + bf2f(kv[u][e]); } }
    if (bb < 16) {
#pragma unroll
        for (int e = 0; e < 4; ++e) p.out[OUT_GLA + ((size_t)(((bb * 2 + l) * 2 + dir) * 4 + h)) * 8192 + idx0 + e * 512] = S[e]; }
}

__device__ __forceinline__ void job_glaC(const Params& p, int l, int j, lds_t lds) {
    const int tid = tid_opaque(p), wid = tid >> 6, lane = tid & 63, lr = lane & 15, lq = lane >> 4;
    const int ck = j >> 2, h = j & 3, tok0 = ck * 64;
    LAS bf16_t* Aq = (LAS bf16_t*)lds;
    LAS bf16_t* BT = Aq + 64 * 136;
    LAS float* Os = (LAS float*)(BT + 128 * 136);
    const bf16_t* QD = (const bf16_t*)(p.ws + OFF_QD); const bf16_t* ST = (const bf16_t*)(p.ws + OFF_ST);
#pragma unroll
    for (int it = 0; it < 2; ++it) { const int idx = tid + it * 512, c = idx >> 4, rem = idx & 15, dir = rem >> 3, dc = rem & 7;
        *(LAS u32x4*)(Aq + c * 136 + dir * 64 + dc * 8) = *(const u32x4*)(QD + (size_t)(dir * 8192 + tok0 + c) * 256 + h * 64 + dc * 8); }
#pragma unroll
    for (int it = 0; it < 4; ++it) { const int idx = tid + it * 512, dir = idx >> 10, d = (idx >> 4) & 63, ec = idx & 15;
        const u32x4 v = *(const u32x4*)(ST + ((size_t)((dir * 128 + ck) * 4 + h)) * 8192 + d * 128 + ec * 8);
        const unsigned w[4] = { v.x, v.y, v.z, v.w };
#pragma unroll
        for (int i = 0; i < 4; ++i) { BT[(ec * 8 + 2 * i) * 136 + dir * 64 + d] = (bf16_t)(w[i] & 0xffffu); BT[(ec * 8 + 2 * i + 1) * 136 + dir * 64 + d] = (bf16_t)(w[i] >> 16); } }
    const int ct = wid & 3, eh = wid >> 2; const bf16_t* OI = (const bf16_t*)(p.ws + OFF_OIB);
    bf16_t oi[4][4];
#pragma unroll
    for (int e4 = 0; e4 < 4; ++e4)
#pragma unroll
        for (int r = 0; r < 4; ++r) oi[e4][r] = OI[(size_t)(tok0 + ct * 16 + lq * 4 + r) * 512 + h * 128 + (eh * 4 + e4) * 16 + lr];
    const int nc = tid >> 3, npart = tid & 7;
    const bf16_t* gz = (const bf16_t*)(p.ws + OFF_Z) + (size_t)(tok0 + nc) * LDZ + ZGG + h * 128 + npart * 16;
    const u32x4 g0 = *(const u32x4*)gz, g1 = *(const u32x4*)(gz + 8);
    f32x4 onw[4];
#pragma unroll
    for (int i = 0; i < 4; ++i) onw[i] = *(const f32x4*)(p.in[I_ONORM] + l * 128 + npart * 16 + 4 * i);
    __syncthreads();
    bf16x8 af[4];
#pragma unroll
    for (int ks = 0; ks < 4; ++ks) af[ks] = LDSFRAG(Aq + (ct * 16 + lr) * 136 + ks * 32 + lq * 8);
#pragma unroll
    for (int e4 = 0; e4 < 4; ++e4) { const int et = eh * 4 + e4; f32x4 a = {0.f, 0.f, 0.f, 0.f};
#pragma unroll
        for (int ks = 0; ks < 4; ++ks) a = MFMA16(af[ks], LDSFRAG(BT + (et * 16 + lr) * 136 + ks * 32 + lq * 8), a);
#pragma unroll
        for (int r = 0; r < 4; ++r) { const int row = ct * 16 + lq * 4 + r, col = et * 16 + lr; Os[row * 132 + col] = a[r] + bf2f(oi[e4][r]); } }
    __syncthreads();
    { const int c = tid >> 3, part = tid & 7; float o[16]; float ss = 0.f;
#pragma unroll
      for (int i = 0; i < 16; ++i) { o[i] = Os[c * 132 + part * 16 + i]; ss += o[i] * o[i]; }
      ss += __shfl_xor(ss, 1); ss += __shfl_xor(ss, 2); ss += __shfl_xor(ss, 4);
      const float rstd = rsqrtf(ss * (1.f / 128.f) + 1e-6f);
      const unsigned gw[8] = { g0.x, g0.y, g0.z, g0.w, g1.x, g1.y, g1.z, g1.w };
      unsigned ow[8];
#pragma unroll
      for (int i = 0; i < 8; ++i) { const float n0 = onw[i >> 1][(2 * i) & 3], n1 = onw[i >> 1][(2 * i + 1) & 3];
          ow[i] = pk2(o[2 * i] * rstd * n0 * siluf_(lo16(gw[i])), o[2 * i + 1] * rstd * n1 * siluf_(hi16(gw[i]))); }
      bf16_t* ap = (bf16_t*)(p.ws + OFF_AGLA) + (size_t)(tok0 + c) * 512 + h * 128 + part * 16;
      *(u32x4*)ap = (u32x4){ow[0], ow[1], ow[2], ow[3]}; *(u32x4*)(ap + 8) = (u32x4){ow[4], ow[5], ow[6], ow[7]}; }
    __syncthreads();
}
__device__ __forceinline__ void head_row_finish(float (&x)[16], int p8, const float* nw, const float* nw2, bool rope, int pos, const float* R, float mul, LAS bf16_t* dst) {
    float ss = 0.f; const int cnt = p8 < 4 ? 16 : 8;
#pragma unroll
    for (int i = 0; i < 16; ++i) if (i < cnt) ss += x[i] * x[i];
    ss += __shfl_xor(ss, 1); ss += __shfl_xor(ss, 2); ss += __shfl_xor(ss, 4);
    const float rstd = rsqrtf(ss * (1.f / 96.f) + 1e-6f) * mul;
    if (p8 < 4) { unsigned w[8];
#pragma unroll
        for (int i = 0; i < 8; ++i) w[i] = pk2(x[2 * i] * rstd * nw[p8 * 16 + 2 * i] * nw2[p8 * 16 + 2 * i], x[2 * i + 1] * rstd * nw[p8 * 16 + 2 * i + 1] * nw2[p8 * 16 + 2 * i + 1]);
        *(LAS u32x4*)(dst + p8 * 16) = (u32x4){w[0], w[1], w[2], w[3]}; *(LAS u32x4*)(dst + p8 * 16 + 8) = (u32x4){w[4], w[5], w[6], w[7]};
    } else { const int i0 = (p8 - 4) * 4; float o1[4], o2[4];
#pragma unroll
        for (int i = 0; i < 4; ++i) { const float a = x[i] * rstd * nw[64 + i0 + i], b = x[4 + i] * rstd * nw[80 + i0 + i];
            if (rope) { const float c = R[pos * 16 + i0 + i], s = R[16384 + pos * 16 + i0 + i]; o1[i] = a * c - b * s; o2[i] = a * s + b * c; } else { o1[i] = a; o2[i] = b; } }
        *(LAS u32x2*)(dst + 64 + i0) = (u32x2){pk2(o1[0], o1[1]), pk2(o1[2], o1[3])}; *(LAS u32x2*)(dst + 80 + i0) = (u32x2){pk2(o2[0], o2[1]), pk2(o2[2], o2[3])}; }
}
__device__ __forceinline__ void ld16bf(const bf16_t* s, float (&x)[16]) { const u32x4 a = *(const u32x4*)s, b = *(const u32x4*)(s + 8);
    x[0] = lo16(a.x); x[1] = hi16(a.x); x[2] = lo16(a.y); x[3] = hi16(a.y); x[4] = lo16(a.z); x[5] = hi16(a.z); x[6] = lo16(a.w); x[7] = hi16(a.w);
    x[8] = lo16(b.x); x[9] = hi16(b.x); x[10] = lo16(b.y); x[11] = hi16(b.y); x[12] = lo16(b.z); x[13] = hi16(b.z); x[14] = lo16(b.w); x[15] = hi16(b.w); }
__device__ __forceinline__ void ld4bf(const bf16_t* s, float* x) { const u32x2 a = *(const u32x2*)s; x[0] = lo16(a.x); x[1] = hi16(a.x); x[2] = lo16(a.y); x[3] = hi16(a.y); }
__device__ __forceinline__ void job_attn(const Params& p, int l, int j, lds_t lds) {
    const int tid = tid_opaque(p), wid = tid >> 6, lane = tid & 63, lr = lane & 15, lq = lane >> 4;
    const bool smp = j < 128; int b, h, qb; if (smp) { b = j >> 5; h = (j >> 3) & 3; qb = j & 7; } else { const int jj = j - 128; b = jj >> 3; h = (jj >> 1) & 3; qb = jj & 1; }
    const int qtok0 = smp ? 4096 + b * 1024 + qb * 128 : b * 256 + qb * 128; const int nkt = smp ? 12 : 2;
    LAS bf16_t* Ks = (LAS bf16_t*)lds;
    LAS bf16_t* VTs = Ks + 128 * 104;
    LAS bf16_t* Ps = VTs + 128 * 136 + wid * 32 * 72;
    LAS float* Mg = (LAS float*)lds;
    const bf16_t* Z = (const bf16_t*)(p.ws + OFF_Z); const bf16_t* KF = (const bf16_t*)(p.ws + OFF_KF); const bf16_t* Vb = (const bf16_t*)(p.ws + OFF_V); const float* R = (const float*)(p.ws + OFF_ROPE);
    const float* qhn = p.in[I_QHNORM] + l * 96;
    u32x4 kreg[3], vreg[4];
    const int vst = smp ? 1536 : 256; const bf16_t* vtb = smp ? Vb + 2097152 + (size_t)(b * 4 + h) * 128 * 1536 : Vb + (size_t)(b * 4 + h) * 128 * 256;
    auto rowbase = [&](int kt) { return smp ? (kt < 4 ? 8192 + b * 512 + kt * 128 : 4096 + b * 1024 + (kt - 4) * 128) : b * 256 + kt * 128; };
    auto issue = [&](int kt) { const int rb = rowbase(kt);
#pragma unroll
        for (int i = 0; i < 3; ++i) { const int idx = tid + 512 * i, key = idx / 12, part = idx - key * 12; kreg[i] = *(const u32x4*)(KF + (size_t)(rb + key) * 384 + h * 96 + part * 8); }
#pragma unroll
        for (int i = 0; i < 4; ++i) { const int idx = tid + 512 * i, e = idx >> 4, part = idx & 15; vreg[i] = *(const u32x4*)(vtb + (size_t)e * vst + kt * 128 + part * 8); } };
    auto commit = [&]() {
#pragma unroll
        for (int i = 0; i < 3; ++i) { const int idx = tid + 512 * i, key = idx / 12, part = idx - key * 12; *(LAS u32x4*)(Ks + key * 104 + part * 8) = kreg[i]; }
#pragma unroll
        for (int i = 0; i < 4; ++i) { const int idx = tid + 512 * i, e = idx >> 4, part = idx & 15; *(LAS u32x4*)(VTs + e * 136 + part * 8) = vreg[i]; } };
    issue(0);
#pragma unroll
    for (int it = 0; it < 2; ++it) { const int row = it * 64 + (tid >> 3), p8 = tid & 7, tok = qtok0 + row; const bf16_t* qr = (const bf16_t*)(p.ws + OFF_QRAW) + (size_t)tok * 384 + h * 96; float x[16];
      if (p8 < 4) ld16bf(qr + p8 * 16, x); else { ld4bf(qr + 64 + (p8 - 4) * 4, x); ld4bf(qr + 80 + (p8 - 4) * 4, x + 4); }
      head_row_finish(x, p8, qhn, p.in[I_KHNORM] + l * 96, smp, qb * 128 + row, R, 0.10206207261596575f * 1.4426950408889634f, Ks + row * 104); }
    __syncthreads();
    const int rt = wid & 3, kh = wid >> 2;
    bf16x8 qa[2][3];
#pragma unroll
    for (int mt = 0; mt < 2; ++mt)
#pragma unroll
        for (int ks = 0; ks < 3; ++ks) qa[mt][ks] = LDSFRAG(Ks + (rt * 32 + mt * 16 + lr) * 104 + ks * 32 + lq * 8);
    __syncthreads();
    commit();
    __syncthreads();
    f32x4 oacc[2][8]; float mrow[2], lrow[2];
#pragma unroll
    for (int mt = 0; mt < 2; ++mt) {
#pragma unroll
        for (int e = 0; e < 8; ++e) oacc[mt][e] = (f32x4){0.f, 0.f, 0.f, 0.f};
        mrow[mt] = -1e30f; lrow[mt] = 0.f; }
    const int kbase = kh * 64;
    for (int kt = 0; kt < nkt; ++kt) {
        if (kt + 1 < nkt) issue(kt + 1);
        f32x4 sacc[2][4];
#pragma unroll
        for (int nt = 0; nt < 4; ++nt) { sacc[0][nt] = (f32x4){0.f, 0.f, 0.f, 0.f}; sacc[1][nt] = sacc[0][nt];
#pragma unroll
            for (int ks = 0; ks < 3; ++ks) { const bf16x8 kf = LDSFRAG(Ks + (kbase + nt * 16 + lr) * 104 + ks * 32 + lq * 8); sacc[0][nt] = MFMA16(kf, qa[0][ks], sacc[0][nt]); sacc[1][nt] = MFMA16(kf, qa[1][ks], sacc[1][nt]); } }
        bf16x8 pb[2][2];
#pragma unroll
        for (int mt = 0; mt < 2; ++mt) {
            float mx = -1e30f;
#pragma unroll
            for (int nt = 0; nt < 4; ++nt) mx = fmaxf(mx, fmaxf(fmaxf(sacc[mt][nt][0], sacc[mt][nt][1]), fmaxf(sacc[mt][nt][2], sacc[mt][nt][3])));
            mx = fmaxf(mx, __shfl_xor(mx, 16)); mx = fmaxf(mx, __shfl_xor(mx, 32));
            const float mn = fmaxf(mrow[mt], mx), alpha = __builtin_amdgcn_exp2f(mrow[mt] - mn); mrow[mt] = mn;
            float pv[4][4]; float rs = 0.f;
#pragma unroll
            for (int nt = 0; nt < 4; ++nt)
#pragma unroll
                for (int r = 0; r < 4; ++r) { pv[nt][r] = __builtin_amdgcn_exp2f(sacc[mt][nt][r] - mn); rs += pv[nt][r]; }
            lrow[mt] = lrow[mt] * alpha + rs;
#pragma unroll
            for (int k2 = 0; k2 < 2; ++k2) { u32x4 w; w.x = pk2(pv[2 * k2][0], pv[2 * k2][1]); w.y = pk2(pv[2 * k2][2], pv[2 * k2][3]); w.z = pk2(pv[2 * k2 + 1][0], pv[2 * k2 + 1][1]); w.w = pk2(pv[2 * k2 + 1][2], pv[2 * k2 + 1][3]);
                pb[mt][k2] = __builtin_bit_cast(bf16x8, w); }
#pragma unroll
            for (int e = 0; e < 8; ++e) oacc[mt][e] *= alpha; }
#pragma unroll
        for (int k2 = 0; k2 < 2; ++k2)
#pragma unroll
            for (int e = 0; e < 8; ++e) { const LAS bf16_t* vp = VTs + (e * 16 + lr) * 136 + kbase + k2 * 32 + 4 * lq;
                const u32x2 lo = *(const LAS u32x2*)vp, hi = *(const LAS u32x2*)(vp + 16);
                const bf16x8 vf = __builtin_bit_cast(bf16x8, (u32x4){lo.x, lo.y, hi.x, hi.y});
                oacc[0][e] = MFMA16(vf, pb[0][k2], oacc[0][e]); oacc[1][e] = MFMA16(vf, pb[1][k2], oacc[1][e]); }
        __syncthreads();
        if (kt + 1 < nkt) { commit(); __syncthreads(); }
    }
#pragma unroll
    for (int mt = 0; mt < 2; ++mt) { float s_ = lrow[mt]; s_ += __shfl_xor(s_, 16); s_ += __shfl_xor(s_, 32); lrow[mt] = s_; }
    LAS float* Mo = Mg + rt * 32 * 132; LAS float* Ml = Mg + 4 * 32 * 132 + rt * 64;
    if (kh == 1) {
#pragma unroll
        for (int mt = 0; mt < 2; ++mt) {
#pragma unroll
            for (int e = 0; e < 8; ++e) *(LAS f32x4*)(Mo + (mt * 16 + lr) * 132 + e * 16 + 4 * lq) = oacc[mt][e];
            if (lq == 0) { Ml[(mt * 16 + lr) * 2] = mrow[mt]; Ml[(mt * 16 + lr) * 2 + 1] = lrow[mt]; } }
    }
    __syncthreads();
    if (kh == 0) { bf16_t* AM = (bf16_t*)(p.ws + OFF_AMLA);
#pragma unroll
        for (int mt = 0; mt < 2; ++mt) { const int row = mt * 16 + lr, tok = qtok0 + rt * 32 + row;
            u32x2 gt[8];
#pragma unroll
            for (int e = 0; e < 8; ++e) gt[e] = *(const u32x2*)(Z + (size_t)tok * LDZ + ZMG + h * 128 + e * 16 + 4 * lq);
            const float m2 = Ml[row * 2], l2 = Ml[row * 2 + 1]; const float mm = fmaxf(mrow[mt], m2), a1 = __builtin_amdgcn_exp2f(mrow[mt] - mm), a2 = __builtin_amdgcn_exp2f(m2 - mm);
            const float inv = 1.f / (lrow[mt] * a1 + l2 * a2);
#pragma unroll
            for (int e = 0; e < 8; ++e) { const f32x4 o2 = *(const LAS f32x4*)(Mo + row * 132 + e * 16 + 4 * lq); float o[4];
#pragma unroll
                for (int r = 0; r < 4; ++r) o[r] = (oacc[mt][e][r] * a1 + o2[r] * a2) * inv;
                const float g0 = lo16(gt[e].x), g1 = hi16(gt[e].x), g2 = lo16(gt[e].y), g3 = hi16(gt[e].y);
                *(u32x2*)(AM + (size_t)tok * 512 + h * 128 + e * 16 + 4 * lq) = (u32x2){pk2(o[0] * siluf_(g0), o[1] * siluf_(g1)), pk2(o[2] * siluf_(g2), o[3] * siluf_(g3))}; } } }
    __syncthreads();
}


#define XB_TMO      128
#define XB_XCNT(j)  (256  + 64 * (j))
#define XB_XSUB(j)  (1280 + 64 * (j))
#define XB_XGEN(j)  (2304 + 64 * (j))
#define XB_TOP      3328
#define XB_TOPGEN   3392
#define XCD_BAR_WORDS 3456
#define XB_SPIN_CAP (1u << 18)

__device__ __forceinline__ unsigned xb_ld(unsigned* p)              { return __hip_atomic_load(p, __ATOMIC_RELAXED, __HIP_MEMORY_SCOPE_AGENT); }
__device__ __forceinline__ unsigned xb_add(unsigned* p, unsigned v) { return __hip_atomic_fetch_add(p, v, __ATOMIC_RELAXED, __HIP_MEMORY_SCOPE_AGENT); }
__device__ __forceinline__ unsigned xb_xcc_id() { return (unsigned)__builtin_amdgcn_s_getreg((3 << 11) | 20) & 0xFu; }
#define XB_SPIN(cond, bar) do { unsigned _sp = 0; while (cond) { __builtin_amdgcn_s_sleep(1); \
    if ((++_sp & 255u) == 0u) { if (xb_ld(&(bar)[XB_TMO])) break; if (_sp > XB_SPIN_CAP) { atomicAdd(&(bar)[XB_TMO], 1u); break; } } } } while (0)

struct XcdBarrier {
    int wid; unsigned* bar; unsigned x;
    volatile LAS unsigned* st;
};

__device__ __forceinline__ XcdBarrier xcd_barrier_post(unsigned* bar, volatile LAS unsigned* st) {
    XcdBarrier b; b.bar = bar; b.x = xb_xcc_id(); b.st = st;
    if (threadIdx.x == 0) (void)xb_add(&bar[XB_XCNT(b.x)], 1u);
    return b;
}
__device__ __forceinline__ void xcd_barrier_complete(unsigned* bar, unsigned x, unsigned& nloc, unsigned& nx) {
    const unsigned G = gridDim.x * gridDim.y * gridDim.z;
    unsigned sum, cnt, mine, sp = 0u;
    for (;;) {
        sum = 0u; cnt = 0u; mine = 0u;
#pragma unroll
        for (unsigned j = 0; j < 16; ++j) { const unsigned c = xb_ld(&bar[XB_XCNT(j)]); sum += c; cnt += (c > 0u) ? 1u : 0u; mine = (j == x) ? c : mine; }
        if (sum == G) break;
        __builtin_amdgcn_s_sleep(1);
        if ((++sp & 255u) == 0u) { if (xb_ld(&bar[XB_TMO])) break; if (sp > XB_SPIN_CAP) { atomicAdd(&bar[XB_TMO], 1u); break; } }
    }
    nloc = mine > 0u ? mine : 1u; nx = cnt > 0u ? cnt : 1u;
}

__device__ __forceinline__ void xcd_barrier(const XcdBarrier& b) {
    asm volatile("s_waitcnt vmcnt(0)" ::: "memory");
    __syncthreads();
    if (b.wid == 0 && lane_id_() == 0) {
        unsigned* bar = b.bar;
        __builtin_amdgcn_s_waitcnt(0);
        unsigned nloc = b.st[0], nx = b.st[1];
        if (nloc == 0u) { xcd_barrier_complete(bar, b.x, nloc, nx); b.st[0] = nloc; b.st[1] = nx; }
        const unsigned old = xb_add(&bar[XB_XSUB(b.x)], 1u);
        const unsigned gen = old / nloc;
        if (old + 1u == (gen + 1u) * nloc) {
            __builtin_amdgcn_fence(__ATOMIC_RELEASE, "agent");
            asm volatile("s_waitcnt vmcnt(0)" ::: "memory");
            const unsigned og = xb_add(&bar[XB_TOP], 1u);
            const unsigned tg = og / nx;
            if (og + 1u == (tg + 1u) * nx) xb_add(&bar[XB_TOPGEN], 1u);
            else XB_SPIN(xb_ld(&bar[XB_TOPGEN]) == tg, bar);
            __builtin_amdgcn_fence(__ATOMIC_ACQUIRE, "agent");
            xb_add(&bar[XB_XGEN(b.x)], 1u);
            asm volatile("s_waitcnt vmcnt(0)" ::: "memory");
        } else {
            XB_SPIN(xb_ld(&bar[XB_XGEN(b.x)]) == gen, bar);
            __builtin_amdgcn_fence(__ATOMIC_ACQUIRE, "agent");
            asm volatile("s_waitcnt vmcnt(0)" ::: "memory");
        }
    }
    __syncthreads();
}

constexpr int N_PHASES = 15;
#ifndef S3SEL
#define S3SEL 15
#endif
#ifndef REPEAT_MASK
#define REPEAT_MASK 0xff
#endif
#ifndef ONLY_S
#define ONLY_S -1
#endif
__device__ __forceinline__ void run_phase(const Params& p, int ph, lds_t lds, int mask = 0xff) {
    const int G = (int)gridDim.x, bid = (int)blockIdx.x;
    if (ph == 0 && (ONLY_S < 0 || ONLY_S == 7)) {
        for (int j = bid; j < 96 + 192 + 256 + 32; j += G) { if (j < 96) job_s5setup(p, 0, j, lds); else if (j < 288) job_ada(p, j - 96, lds); else if (j < 544) job_ctx(p, j - 288); else job_rope(p, j - 544); }
        return;
    }
    const int l = (ph - 1) / 7, s = (ph - 1) % 7;
    unsigned char* ws = p.ws;
    if (s == 0 && (ONLY_S < 0 || ONLY_S == 0)) {
        if (l == 0 || G < 256) { for (int j = bid; j < 96 + WT_TOTAL + 1024; j += G) { if (j < 96) { if ((mask & 1) && l > 0) job_s5setup(p, l, j, lds); } else if (j < 96 + WT_TOTAL) { if (mask & 2) job_wt(p, l, j - 96, lds); } else if (mask & 4) job_prep(p, l, j - 96 - WT_TOTAL); } }
        else { for (int j = bid; j < WT_WOUT + 1024; j += G) { if (j < WT_WOUT) job_wt(p, l, WT_EARLY + 3 * WT_WBO + j, lds); else job_prep(p, l, j - WT_WOUT); } }
    } else if (s == 1 && (ONLY_S < 0 || ONLY_S == 1)) {
        Order S; S.setup(8192, 4096, 0, p.wid); pg8::Gemm g{(const bf16_t*)(ws + OFF_HB), (const bf16_t*)(ws + OFF_WIN), 8192, 4096, 1024}; EpiZ E{(bf16_t*)(ws + OFF_Z)};
        pg8::gemm_phase<EpiZ, Order>(lds, g, S, E, nullptr);
    } else if (s == 2 && (ONLY_S < 0 || ONLY_S == 2)) {
        if (G == 256) {
            if (mask & 1) for (int k = bid >> 3; k < 80; k += 32) { const int q = k >> 2, bb = q < 4 ? 16 + q : q - 4; job_s5(p, l, bb * 32 + 4 * (bid & 7) + (k & 3), lds); }
            for (int j = bid; j < 512 + 1024; j += G) { if (j < 512) { if (mask & 2) job_glaA(p, l, j, lds); } else if (mask & 4) job_mlaprep(p, l, j - 512); }
        } else for (int j = bid; j < 640 + 512 + 1024; j += G) { if (j < 640) { if (mask & 1) job_s5(p, l, j < 128 ? 512 + j : j - 128, lds); } else if (j < 1152) { if (mask & 2) job_glaA(p, l, j - 640, lds); } else if (mask & 4) job_mlaprep(p, l, j - 1152); }
    } else if (s == 3 && (ONLY_S < 0 || ONLY_S == 3)) {
        if (mask & 1) for (int j = bid; j < 640; j += G) job_glaB(p, l, j);
        if (mask & 16) { Order S; S.setup(8192, 2816, 0, p.wid); pg8::Gemm g{(const bf16_t*)(ws + OFF_HB), (const bf16_t*)(ws + OFF_WIN) + (size_t)4096 * 1024, 8192, 2816, 1024}; EpiZ E{(bf16_t*)(ws + OFF_Z) + 4096};
          pg8::gemm_phase<EpiZ, Order>(lds, g, S, E, nullptr); }
        if ((mask & 2) && (S3SEL & 2)) { Order S; S.setup(8192, 1024, 160, p.wid); pg8::Gemm g{(const bf16_t*)(ws + OFF_YG), (const bf16_t*)(ws + OFF_WGLU), 8192, 1024, 512}; EpiGLU E{(bf16_t*)(ws + OFF_AS5), (const bf16_t*)(ws + OFF_Z), p.in[I_BGLU] + l * 1024};
          pg8::gemm_phase<EpiGLU, Order>(lds, g, S, E, nullptr); }
        if ((mask & 4) && (S3SEL & 4)) { Order S; S.setup(10240, 768, 120, p.wid); pg8::Gemm g{(const bf16_t*)(ws + (l == 0 ? OFF_CTX0 : OFF_CKVN)), (const bf16_t*)(ws + OFF_WKV), 10240, 768, 256}; EpiKV E{(bf16_t*)(ws + OFF_KF), (bf16_t*)(ws + OFF_V), l, (const bf16_t*)(ws + OFF_Z), p.in[I_CKR], p.in[I_KHNORM] + l * 96, (const float*)(ws + OFF_ROPE)};
          pg8::gemm_phase<EpiKV, Order>(lds, g, S, E, nullptr); }
        if ((mask & 8) && (S3SEL & 8)) { Order S; S.setup(8192, 512, 160, p.wid); pg8::Gemm g{(const bf16_t*)(ws + OFF_AQ), (const bf16_t*)(ws + OFF_WUQ), 8192, 512, 384}; EpiQ E{(bf16_t*)(ws + OFF_QRAW)};
          pg8::gemm_phase<EpiQ, Order>(lds, g, S, E, nullptr); }
    } else if (s == 4 && (ONLY_S < 0 || ONLY_S == 4)) {
        if (G == 256) {
            if (bid < 128) { const int slot = bid >> 3, pair = 2 * (bid & 7) + (slot >> 3);
                if (mask & 1) job_attn(p, l, pair * 8 + (slot & 7), lds); }
            else { const int k = bid - 128; if (mask & 1) job_attn(p, l, 128 + k, lds); if (mask & 2) { job_glaC(p, l, k, lds); job_glaC(p, l, 128 + k, lds); job_glaC(p, l, 256 + k, lds); job_glaC(p, l, 384 + k, lds); } }
        } else for (int j = bid; j < 256 + 512; j += G) { if (j < 256) { if (mask & 1) job_attn(p, l, j, lds); } else if (mask & 2) job_glaC(p, l, j - 256, lds); }
    } else if (s == 5 && (ONLY_S < 0 || ONLY_S == 5)) {
        if (l == 0 && mask == 0xff && G >= 256 && bid >= 128) { for (int j = bid - 128; j < 96 + WT_EARLY; j += G - 128) { if (j < 96) job_s5setup(p, 1, j, lds); else job_wt(p, 1, j - 96, lds); } }
        for (int br = 0; br < 3; ++br) { Order S; S.setup(8192, 1024, 0, p.wid);
            pg8::Gemm g{(const bf16_t*)(ws + (br == 0 ? OFF_AGLA : br == 1 ? OFF_AMLA : OFF_AS5)), (const bf16_t*)(ws + OFF_WBO) + (size_t)br * 1024 * 512, 8192, 1024, 512};
            EpiBo E{(bf16_t*)(ws + OFF_HB), (const bf16_t*)(ws + OFF_Z), br};
            pg8::gemm_phase<EpiBo, Order>(lds, g, S, E, nullptr); }
    } else if (s == 6 && (ONLY_S < 0 || ONLY_S == 6)) {
        if (l == 0 && mask == 0xff && G >= 256 && bid >= 128) { for (int j = bid - 128; j < 3 * WT_WBO; j += G - 128) job_wt(p, 1, WT_EARLY + j, lds); }
        Order S; S.setup(8192, 1024, 0, p.wid); pg8::Gemm g{(const bf16_t*)(ws + OFF_HB), (const bf16_t*)(ws + OFF_WOUT), 8192, 1024, 1024};
        EpiOut E{p.out, l == 0 ? p.in[I_XP] : p.out, l == 0 ? p.in[I_XS] : p.out + (size_t)4096 * 1024, (const float*)(ws + OFF_ADA) + l * 5 * 3072};
        pg8::gemm_phase<EpiOut, Order>(lds, g, S, E, nullptr);
    }
}
__global__ __launch_bounds__(512, 2) void mega(KParams kp, int ph0, int ph1) {
    extern __shared__ __attribute__((aligned(16))) unsigned char shm[];
    lds_t lds = (lds_t)shm;
    if (threadIdx.x < N_IN) ((const float**)(kp.ws + OFF_TBL))[threadIdx.x] = kp.in[threadIdx.x];
    const int wid0 = __builtin_amdgcn_readfirstlane((int)threadIdx.x >> 6);
    volatile LAS unsigned* xst = (volatile LAS unsigned*)(lds + DYN_LDS - 16);
    if (threadIdx.x == 0) { xst[0] = 0u; xst[1] = 0u; }
    __threadfence(); __syncthreads();
    XcdBarrier xb = xcd_barrier_post((unsigned*)(kp.ws + OFF_BAR), xst);
    xb.wid = wid0;
    if (ph0 > ph1) cg::this_grid().sync();
    for (int ph = ph0; ph < ph1; ++ph) {
        Params p; p.wid = wid0; { const float* const* tb = (const float* const*)(kp.ws + OFF_TBL); float* o = kp.out; unsigned char* w = kp.ws; asm volatile("" : "+s"(tb), "+s"(o), "+s"(w)); p.in = tb; p.out = o; p.ws = w; }
        int nrep = 1;
#ifdef REPEAT_S
        if ((REPEAT_S == 7 && ph == 0) || (ph > 0 && (ph - 1) % 7 == REPEAT_S && (REPEAT_S != 6 || ph < 8))) nrep = 2;
#endif
        for (int rep = 0; rep < nrep; ++rep) { if (rep) xcd_barrier(xb); run_phase(p, ph, lds, rep ? REPEAT_MASK : 0xff); }
        if (ph + 1 < ph1) xcd_barrier(xb);
    }
}

#ifndef N_LAUNCH_MODE
#define N_LAUNCH_MODE 1
#endif
extern "C" void kernel_launch(void* const* d_in, const int* in_sizes, int n_in, void* d_out, int out_size, void* d_ws, size_t ws_size, hipStream_t stream) {
    static int grid = 0;
    if (grid == 0) {
        if (n_in != N_IN || ws_size < WS_END) { fprintf(stderr, "kernel_launch: unexpected n_in %d / ws %zu (need %zu)\n", n_in, ws_size, (size_t)WS_END); grid = -1; return; }
        int dev = 0, cus = 0, per_cu = 0;
        hipGetDevice(&dev); hipDeviceGetAttribute(&cus, hipDeviceAttributeMultiprocessorCount, dev);
        hipFuncSetAttribute((const void*)mega, hipFuncAttributeMaxDynamicSharedMemorySize, DYN_LDS);
        hipOccupancyMaxActiveBlocksPerMultiprocessor(&per_cu, (const void*)mega, 512, DYN_LDS);
        if (per_cu < 1) { fprintf(stderr, "kernel_launch: occupancy query says %d blocks per CU\n", per_cu); per_cu = 1; }
        (void)hipGetLastError();
        grid = cus;
    }
    if (grid < 0) return;
    hipMemsetAsync((char*)d_ws + OFF_BAR, 0, 16384, stream);
    KParams p{};
    for (int i = 0; i < N_IN; ++i) p.in[i] = (const float*)d_in[i];
    p.out = (float*)d_out; p.ws = (unsigned char*)d_ws;
#if N_LAUNCH_MODE == 0
    for (int ph = 0; ph < N_PHASES; ++ph) { hipLaunchKernelGGL(mega, dim3(grid), dim3(512), DYN_LDS, stream, p, ph, ph + 1); }
#else
    int ph0 = 0, ph1 = N_PHASES; void* args[] = {&p, &ph0, &ph1};
    hipError_t e = hipLaunchCooperativeKernel((const void*)mega, dim3(grid), dim3(512), args, DYN_LDS, stream);
    if (e != hipSuccess) fprintf(stderr, "cooperative launch failed: %s (grid %d)\n", hipGetErrorString(e), grid);
#endif
}
```

```cpp
#include <hip/hip_runtime.h>
#include <hip/hip_cooperative_groups.h>
#include <cstdio>
namespace cg = cooperative_groups;
namespace pg8 {
#define PG8_LAS __attribute__((address_space(3)))
typedef unsigned short bf16_t;
typedef short bf16x8 __attribute__((ext_vector_type(8)));
typedef float f32x4 __attribute__((ext_vector_type(4)));
typedef unsigned u32x4 __attribute__((ext_vector_type(4)));
constexpr int BM = 256, BK = 64, HALF = 128, HTB = HALF * BK * 2  , STAGE_BYTES = 8 * HTB, NXCD = 8, WGM = 8;

__host__ __device__ __forceinline__ int lds_byte(int r, int c) { const int st = (r >> 4) * 2 + (c >> 5), rr = r & 15, cc = c & 31, ob = rr * 64 + cc * 2; return st * 1024 + (ob ^ (((ob >> 9) & 1) << 5)); }
__host__ __device__ __forceinline__ void stage_rc(int b, int& R, int& C) { const int st = b / 1024, sb = b % 1024, swz = sb ^ (((sb >> 9) & 1) << 5); R = (st >> 1) * 16 + swz / 64; C = (st & 1) * 32 + (swz % 64) / 2; }
__host__ __device__ __forceinline__ int perm32(int rho) { const int n = rho >> 4, i = rho & 15; return 8 * (i >> 2) + 4 * n + (i & 3); }

struct Unit { int pm, pn; };
struct Gemm { const bf16_t* A; const bf16_t* Bt; int M, N, K; };

struct StaticOrder {
    int nM, nN, nwg, G, c;
    __host__ __device__ void init(int M, int N, int G_, int c_) { nM = M / BM; nN = N / BM; nwg = nM * nN; G = G_; c = c_; }
    __host__ __device__ bool next(int i, Unit& u) const {
        const long L = (long)i * G + c; if (L >= nwg) return false;
        int wgid = (int)L; { const int q = nwg / NXCD, r = nwg % NXCD, xcd = wgid % NXCD, off = wgid / NXCD; wgid = (xcd < r ? xcd * (q + 1) : r * (q + 1) + (xcd - r) * q) + off; }
        const int nig = WGM * nN, gid = wgid / nig, fm = gid * WGM, gsz = (nM - fm) < WGM ? (nM - fm) : WGM;
        u.pm = fm + ((wgid % nig) % gsz); u.pn = (wgid % nig) / gsz; return true;
    }
    __device__ __forceinline__ void a_ready(const Unit&) const {}
    __device__ __forceinline__ void done(const Unit&) const {}
};
__device__ __forceinline__ unsigned cvt_pk_bf16(float lo, float hi) { unsigned r; asm volatile("v_cvt_pk_bf16_f32 %0, %1, %2" : "=v"(r) : "v"(lo), "v"(hi)); return r; }
typedef float f32x2 __attribute__((ext_vector_type(2)));
template <class Epi, class Sched, bool STAMP = false>
__device__ __forceinline__ void gemm_phase(PG8_LAS unsigned char* lds, const Gemm g, const Sched& S, const Epi& E, unsigned long long* stamps) {
    int tid_ = (S.wid << 6) | (int)__builtin_amdgcn_mbcnt_hi(~0u, __builtin_amdgcn_mbcnt_lo(~0u, 0u)); asm volatile("" : "+v"(tid_)); const int tid = tid_, wid = __builtin_amdgcn_readfirstlane(tid >> 6), lane = tid & 63, wr = wid >> 2, wc = wid & 3, fr = lane & 15, fq = lane >> 4;
    int K_ = g.K; asm volatile("" : "+s"(K_)); const int K = K_, nt = K / BK;
    int ts_lo = 0, ts_hi = 0, nts = 0; const unsigned long long rt_entry = STAMP ? (unsigned long long)wall_clock64() : 0ull;
#define PG8_STAMP() do { if (STAMP && wid == 0 && nts < 64) { const unsigned long long _c = (unsigned long long)clock64(); \
        ts_lo = (lane == nts) ? (int)(unsigned)_c : ts_lo; ts_hi = (lane == nts) ? (int)(unsigned)(_c >> 32) : ts_hi; ++nts; } } while (0)
    PG8_STAMP();
    unsigned voffA[2], voffB[2];
#pragma unroll
    for (int i = 0; i < 2; ++i) { int R, C; stage_rc(tid * 16 + i * 8192, R, C); const int Rb = Epi::PERM ? ((R & ~31) + perm32(R & 31)) : R;
        voffA[i] = (unsigned)(R * K + C) * 2u; voffB[i] = (unsigned)(Rb * K + C) * 2u; }
    const size_t kstep = (size_t)(BK * 2);
    const size_t hstep = (size_t)HALF * K * 2;
    const size_t tstep = 2 * hstep;
    const unsigned ldsw = (unsigned)wid * 1024u;
    const int aoff = lds_byte(wr * 64 + fr, fq * 8), boff = lds_byte(wc * 32 + fr, fq * 8);
#define PG8_SA(b, h) (((b) * 2 + (h)) * HTB)
#define PG8_SB(b, h) ((4 + (b) * 2 + (h)) * HTB)
#define PG8_STAGE(bufoff, gbase, voff) do { _Pragma("unroll") for (int _i = 0; _i < 2; ++_i) \
        __builtin_amdgcn_global_load_lds((const unsigned*)((const char*)(gbase) + (voff)[_i]), (PG8_LAS unsigned*)(lds + (bufoff) + ldsw + _i * 8192), 16, 0, 0); } while (0)
#define PG8_LDA(dst, b, h) do { _Pragma("unroll") for (int m = 0; m < 4; ++m) _Pragma("unroll") for (int k = 0; k < 2; ++k) dst[m][k] = *(const PG8_LAS bf16x8*)(lds + PG8_SA(b, h) + aoff + m * 2048 + k * 1024); } while (0)
#define PG8_LDB(dst, b, h) do { _Pragma("unroll") for (int n = 0; n < 2; ++n) _Pragma("unroll") for (int k = 0; k < 2; ++k) dst[n][k] = *(const PG8_LAS bf16x8*)(lds + PG8_SB(b, h) + boff + n * 2048 + k * 1024); } while (0)
#define PG8_MMA(ai, bj, At, Bt) do { __builtin_amdgcn_s_setprio(1); _Pragma("unroll") for (int m = 0; m < 4; ++m) _Pragma("unroll") for (int n = 0; n < 2; ++n) _Pragma("unroll") for (int k = 0; k < 2; ++k) \
        acc[ai][bj][m][n] = __builtin_amdgcn_mfma_f32_16x16x32_bf16(Bt[n][k], At[m][k], acc[ai][bj][m][n], 0, 0, 0); __builtin_amdgcn_s_setprio(0); } while (0)
#define PG8_WAIT_V(n) asm volatile("s_waitcnt vmcnt(" #n ")" ::: "memory")
#define PG8_WAIT_L(n) asm volatile("s_waitcnt lgkmcnt(" #n ")" ::: "memory")
#define PG8_BAR __builtin_amdgcn_s_barrier()
#define PG8_SCHED __builtin_amdgcn_sched_barrier(0)
    Unit cur, nxt; int ui = 0;
    if (!S.next(0, cur)) return;
    f32x4 acc[2][2][4][2];
#pragma unroll
    for (int a = 0; a < 2; ++a)
#pragma unroll
        for (int b = 0; b < 2; ++b)
#pragma unroll
            for (int m = 0; m < 4; ++m)
#pragma unroll
                for (int n = 0; n < 2; ++n) acc[a][b][m][n] = (f32x4){0.f, 0.f, 0.f, 0.f};
    bf16x8 At[4][2], B0[2][2], B1[2][2];
    const char* cA = (const char*)g.A + (size_t)cur.pm * tstep; const char* cB = (const char*)g.Bt + (size_t)cur.pn * tstep;
    S.a_ready(cur);
    PG8_STAGE(PG8_SB(0, 0), cB, voffB); PG8_STAGE(PG8_SA(0, 0), cA, voffA); PG8_STAGE(PG8_SB(0, 1), cB + hstep, voffB); PG8_STAGE(PG8_SA(0, 1), cA + hstep, voffA);
    if (wr == 1) PG8_BAR;
    PG8_WAIT_V(4); PG8_BAR;
    PG8_STAGE(PG8_SB(1, 0), cB + kstep, voffB); PG8_STAGE(PG8_SA(1, 0), cA + kstep, voffA); PG8_STAGE(PG8_SB(1, 1), cB + hstep + kstep, voffB);
    PG8_WAIT_V(6); PG8_BAR;
    PG8_STAMP();
    for (;;) {
        const bool has_next = S.next(ui + 1, nxt);
        const char* nA = has_next ? (const char*)g.A + (size_t)nxt.pm * tstep : cA; const char* nB = has_next ? (const char*)g.Bt + (size_t)nxt.pn * tstep : cB;
        for (int t = 0; t < nt; t += 2) {
            const bool last = (t == nt - 2);
            const char* a1 = cA + (size_t)(t + 1) * kstep;
            const char* a2 = last ? nA : cA + (size_t)(t + 2) * kstep; const char* b2 = last ? nB : cB + (size_t)(t + 2) * kstep;
            const char* a3 = a2 + kstep; const char* b3 = b2 + kstep;
            if (last && has_next) S.a_ready(nxt);
            PG8_LDB(B0, 0, 0); PG8_SCHED; PG8_LDA(At, 0, 0); PG8_STAGE(PG8_SA(1, 1), a1 + hstep, voffA);
            PG8_WAIT_L(8); PG8_BAR; PG8_WAIT_L(0); PG8_MMA(0, 0, At, B0); PG8_BAR; PG8_SCHED;
            PG8_LDB(B1, 0, 1); PG8_STAGE(PG8_SB(0, 0), b2, voffB);
            PG8_BAR; PG8_WAIT_L(0); PG8_MMA(0, 1, At, B1); PG8_BAR;
            PG8_LDA(At, 0, 1); PG8_STAGE(PG8_SA(0, 0), a2, voffA);
            PG8_BAR; PG8_WAIT_L(0); PG8_MMA(1, 0, At, B0); PG8_BAR; PG8_SCHED;
            PG8_STAGE(PG8_SB(0, 1), b2 + hstep, voffB);
            PG8_WAIT_V(6); PG8_BAR; PG8_MMA(1, 1, At, B1); PG8_BAR;
            PG8_LDB(B0, 1, 0); PG8_SCHED; PG8_LDA(At, 1, 0); PG8_STAGE(PG8_SA(0, 1), a2 + hstep, voffA);
            PG8_WAIT_L(8); PG8_BAR; PG8_WAIT_L(0); PG8_MMA(0, 0, At, B0); PG8_BAR; PG8_SCHED;
            PG8_LDB(B1, 1, 1); PG8_STAGE(PG8_SB(1, 0), b3, voffB);
            PG8_BAR; PG8_WAIT_L(0); PG8_MMA(0, 1, At, B1); PG8_BAR;
            PG8_LDA(At, 1, 1); PG8_STAGE(PG8_SA(1, 0), a3, voffA);
            PG8_BAR; PG8_WAIT_L(0); PG8_MMA(1, 0, At, B0); PG8_BAR; PG8_SCHED;
            PG8_STAGE(PG8_SB(1, 1), b3 + hstep, voffB);
            PG8_WAIT_V(6); PG8_BAR; PG8_MMA(1, 1, At, B1); PG8_BAR;
        }
        PG8_STAMP();
        if constexpr (!Epi::AFTER_DRAIN) { E(acc, cur, wr, wc, fr, fq); S.done(cur); }
        PG8_STAMP();
        if (!has_next) break;
#pragma unroll
        for (int a = 0; a < 2; ++a)
#pragma unroll
            for (int b = 0; b < 2; ++b)
#pragma unroll
                for (int m = 0; m < 4; ++m)
#pragma unroll
                    for (int n = 0; n < 2; ++n) acc[a][b][m][n] = (f32x4){0.f, 0.f, 0.f, 0.f};
        cur = nxt; cA = nA; cB = nB; ++ui;
    }
    PG8_WAIT_V(0);
    if (wr == 0) PG8_BAR;
    PG8_BAR;
    if constexpr (Epi::AFTER_DRAIN) { E.fused(acc, cur, wr, wc, fr, fq, lds, wid, lane); S.done(cur); }
    PG8_STAMP();
    if (STAMP && wid == 0) { stamps[lane] = lane < nts ? (((unsigned long long)(unsigned)ts_hi << 32) | (unsigned)ts_lo) : 0ull;
        if (lane == 62) stamps[62] = rt_entry; if (lane == 63) stamps[63] = (unsigned long long)wall_clock64(); }
#undef PG8_STAMP
#undef PG8_SA
#undef PG8_SB
#undef PG8_STAGE
#undef PG8_LDA
#undef PG8_LDB
#undef PG8_MMA
#undef PG8_WAIT_V
#undef PG8_WAIT_L
#undef PG8_BAR
#undef PG8_SCHED
}
}
using pg8::bf16_t; using pg8::bf16x8; using pg8::f32x4; using pg8::u32x4; using pg8::Unit;
#define LAS __attribute__((address_space(3)))
typedef unsigned u32x2 __attribute__((ext_vector_type(2)));
typedef LAS unsigned char* lds_t;
struct Params;
__device__ __forceinline__ int lane_id_() { return (int)__builtin_amdgcn_mbcnt_hi(~0u, __builtin_amdgcn_mbcnt_lo(~0u, 0u)); }
typedef float f32x2_t __attribute__((ext_vector_type(2)));

enum { I_XP = 0, I_XS, I_C, I_CCTX, I_CKV, I_CKR, I_SGLA, I_SS5, I_NORMW, I_WADA, I_BADA, I_WIN, I_WA2, I_BA, I_ONORM, I_QNORM, I_WUQ, I_KVNORM, I_WUK, I_WUV,
       I_QHNORM, I_KHNORM, I_ARE, I_AIM, I_LOGDT, I_BRE, I_BIM, I_CRE, I_CIM, I_S5D, I_WGLU, I_BGLU, I_WBOG, I_WBOM, I_WBOS, I_WOUT, N_IN };
struct KParams { const float* in[N_IN]; float* out; unsigned char* ws; };
struct Params { const float* const* in; float* out; unsigned char* ws; int wid; };
__device__ __forceinline__ int tid_opaque(const Params& p) { int t = (p.wid << 6) | lane_id_(); asm volatile("" : "+v"(t)); return t; }

constexpr int LDZ = 6912;
constexpr int ZQ = 0, ZK = 256, ZV = 512, ZGA = 1024, ZGG = 1056, ZMQ = 1568, ZMKV = 1952, ZMKR = 2208, ZMG = 2240, ZSU = 2752, ZSG = 3264, ZMERGE = 3776;
constexpr size_t OUT_YP = 0, OUT_CKV = 8388608, OUT_KR = 10485760, OUT_GLA = 10747904, OUT_S5 = 12845056;
constexpr size_t OFF_WIN = 0;

constexpr size_t OFF_WUQ = OFF_WIN + 14155776;
constexpr size_t OFF_WKV = OFF_WUQ + 393216;
constexpr size_t OFF_WGLU = OFF_WKV + 393216;
constexpr size_t OFF_WBO = OFF_WGLU + 1048576;
constexpr size_t OFF_WOUT = OFF_WBO + 3145728;
constexpr size_t OFF_S5M = OFF_WOUT + 2097152;
constexpr size_t OFF_V = OFF_S5M;
constexpr size_t OFF_P16 = OFF_S5M + 12582912;
constexpr size_t OFF_ADA = OFF_P16 + 32768;
constexpr size_t OFF_ROPE = OFF_ADA + 122880;
constexpr size_t OFF_CTX0 = OFF_ROPE + 131072;
constexpr size_t OFF_CKVN = OFF_CTX0 + 1048576;
constexpr size_t OFF_CTX1 = OFF_CKVN + 4194304;
constexpr size_t OFF_HB = OFF_CTX1 + 1048576;
constexpr size_t OFF_Z = OFF_HB + 16777216;
constexpr size_t OFF_KV = OFF_Z + 113246208;
constexpr size_t OFF_AGLA = OFF_KV, OFF_AMLA = OFF_KV + 8388608;
constexpr size_t OFF_QD = OFF_KV + 16777216;
constexpr size_t OFF_OIB = OFF_QD + 8388608;
constexpr size_t OFF_DEC = OFF_KV + 33554432;
constexpr size_t OFF_ST = OFF_DEC + 262144;
constexpr size_t OFF_AQ = OFF_ST + 16777216;
constexpr size_t OFF_QRAW = OFF_AQ + 6291456;
constexpr size_t OFF_AS5 = OFF_QRAW + 6291456;
constexpr size_t OFF_YG = OFF_AS5 + 8388608;
constexpr size_t OFF_TBL = OFF_YG + 8388608;
constexpr size_t OFF_BAR = OFF_TBL + 512;
constexpr size_t OFF_KF = OFF_BAR + 16384;
constexpr size_t WS_END = OFF_KF + 7864320;
constexpr int DYN_LDS = 147456;

__device__ __forceinline__ float bf2f(bf16_t b) { return __uint_as_float(((unsigned)b) << 16); }
__device__ __forceinline__ bf16_t f2bf(float f) { unsigned u = __float_as_uint(f); u += 0x7FFFu + ((u >> 16) & 1u); return (bf16_t)(u >> 16); }
__device__ __forceinline__ unsigned pk2(float lo, float hi) { return pg8::cvt_pk_bf16(lo, hi); }
__device__ __forceinline__ float lo16(unsigned w) { return __uint_as_float(w << 16); }
__device__ __forceinline__ float hi16(unsigned w) { return __uint_as_float(w & 0xffff0000u); }
__device__ __forceinline__ float sigmoidf_(float x) { return 1.f / (1.f + __expf(-x)); }
__device__ __forceinline__ float siluf_(float x) { return x / (1.f + __expf(-x)); }
__device__ __forceinline__ void store8(bf16_t* p, const f32x4& a, const f32x4& b) { u32x4 w; w.x = pk2(a[0], a[1]); w.y = pk2(a[2], a[3]); w.z = pk2(b[0], b[1]); w.w = pk2(b[2], b[3]); *(u32x4*)p = w; }
#define MFMA16(a, b, c) __builtin_amdgcn_mfma_f32_16x16x32_bf16(a, b, c, 0, 0, 0)
#define LDSFRAG(ptr) (*(const LAS bf16x8*)(ptr))

struct Order : pg8::StaticOrder { int wid;
    __device__ void setup(int M, int N, int rot, int wid_) { wid = wid_; const int G = (int)gridDim.x; init(M, N, G, (int)((blockIdx.x + (unsigned)rot) % (unsigned)G)); }
};

struct EpiZ { static constexpr bool PERM = true, AFTER_DRAIN = false; bf16_t* Z;
    __device__ __forceinline__ void operator()(const f32x4 (&acc)[2][2][4][2], const Unit& u, int wr, int wc, int fr_, int fq_) const {
        int fr = fr_, fq = fq_; asm volatile("" : "+v"(fr), "+v"(fq));
        const int row0 = u.pm * 256 + wr * 64 + fr, col0 = u.pn * 256 + wc * 32 + 8 * fq;
#pragma unroll
        for (int ai = 0; ai < 2; ++ai)
#pragma unroll
            for (int m = 0; m < 4; ++m) { bf16_t* rp = Z + (size_t)(row0 + ai * 128 + m * 16) * LDZ + col0;
#pragma unroll
                for (int bj = 0; bj < 2; ++bj) store8(rp + bj * 128, acc[ai][bj][m][0], acc[ai][bj][m][1]); }
    } };
struct EpiQ { static constexpr bool PERM = true, AFTER_DRAIN = false; bf16_t* Q;
    __device__ __forceinline__ void operator()(const f32x4 (&acc)[2][2][4][2], const Unit& u, int wr, int wc, int fr_, int fq_) const {
        int fr = fr_, fq = fq_; asm volatile("" : "+v"(fr), "+v"(fq));
        const int row0 = u.pm * 256 + wr * 64 + fr, col0 = u.pn * 256 + wc * 32 + 8 * fq;
#pragma unroll
        for (int ai = 0; ai < 2; ++ai)
#pragma unroll
            for (int m = 0; m < 4; ++m) { bf16_t* rp = Q + (size_t)(row0 + ai * 128 + m * 16) * 384 + col0;
#pragma unroll
                for (int bj = 0; bj < 2; ++bj) if (col0 + bj * 128 < 384) store8(rp + bj * 128, acc[ai][bj][m][0], acc[ai][bj][m][1]);
                }
    } };
struct EpiKV { static constexpr bool PERM = true, AFTER_DRAIN = false; bf16_t* KF; bf16_t* V; int layer; const bf16_t* Z; const float* ckr; const float* khn; const float* R;
    __device__ __forceinline__ void operator()(const f32x4 (&acc)[2][2][4][2], const Unit& u, int wr, int wc, int fr_, int fq_) const {
        int fr = fr_, fq = fq_; asm volatile("" : "+v"(fr), "+v"(fq));
        int rb = u.pm * 256; if (layer == 0) rb = rb < 2048 ? 8192 + rb : rb - 2048;
        const int row0 = rb + wr * 64 + fr;
        if (u.pn > 0) {
#pragma unroll
            for (int ai = 0; ai < 2; ++ai)
#pragma unroll
                for (int m = 0; m < 4; ++m) { const int r = row0 + ai * 128 + m * 16; bf16_t* bp; int st;
                    if (r < 4096) { bp = V + (size_t)(r >> 8) * 4 * 128 * 256 + (r & 255); st = 256; }
                    else if (r < 8192) { bp = V + 2097152 + (size_t)((r - 4096) >> 10) * 4 * 128 * 1536 + 512 + ((r - 4096) & 1023); st = 1536; }
                    else { bp = V + 2097152 + (size_t)((r - 8192) >> 9) * 4 * 128 * 1536 + ((r - 8192) & 511); st = 1536; }
#pragma unroll
                    for (int bj = 0; bj < 2; ++bj) { bf16_t* hp = bp + (size_t)((((u.pn - 1) * 2 + bj) * 128) + wc * 32 + 8 * fq) * st;
#pragma unroll
                        for (int i = 0; i < 8; i += 2) { const unsigned w = pk2(acc[ai][bj][m][i >> 2][i & 3], acc[ai][bj][m][i >> 2][(i & 3) + 1]); hp[0] = (bf16_t)(w & 0xffffu); hp[st] = (bf16_t)(w >> 16); hp += 2 * st; } }
                    __builtin_amdgcn_sched_barrier(0); }
            return; }
        float w1[4], w2[4];
#pragma unroll
        for (int i = 0; i < 4; ++i) { w1[i] = khn[64 + 4 * fq + i]; w2[i] = khn[80 + 4 * fq + i]; }
#pragma unroll
        for (int ai = 0; ai < 2; ++ai)
#pragma unroll
          for (int mh = 0; mh < 4; mh += 1) {
            float x1[4][4], x2[4][4], cs[4][4], sn[4][4];
#pragma unroll
            for (int m = mh; m < mh + 1; ++m) { const int r = row0 + ai * 128 + m * 16;
                if (r >= 8192) { const int j = r - 8192; const float* kr = ckr + ((size_t)(((j >> 9) * 2 + layer) * 512 + (j & 511))) * 32 + 4 * fq;
                    const f32x4 a = *(const f32x4*)kr, b = *(const f32x4*)(kr + 16);
#pragma unroll
                    for (int i = 0; i < 4; ++i) { x1[m][i] = a[i]; x2[m][i] = b[i]; } }
                else { const bf16_t* kr = Z + (size_t)r * LDZ + ZMKR + 4 * fq; const u32x2 a = *(const u32x2*)kr, b = *(const u32x2*)(kr + 16);
                    x1[m][0] = lo16(a.x); x1[m][1] = hi16(a.x); x1[m][2] = lo16(a.y); x1[m][3] = hi16(a.y); x2[m][0] = lo16(b.x); x2[m][1] = hi16(b.x); x2[m][2] = lo16(b.y); x2[m][3] = hi16(b.y); }
                const bool rot = r >= 4096 && r < 8192; const int pos = (r - 4096) & 1023;
                if (rot) { const f32x4 c = *(const f32x4*)(R + pos * 16 + 4 * fq), s_ = *(const f32x4*)(R + 16384 + pos * 16 + 4 * fq);
#pragma unroll
                    for (int i = 0; i < 4; ++i) { cs[m][i] = c[i]; sn[m][i] = s_[i]; } }
                else {
#pragma unroll
                    for (int i = 0; i < 4; ++i) { cs[m][i] = 1.f; sn[m][i] = 0.f; } } }
#pragma unroll
            for (int m = mh; m < mh + 1; ++m) { const int r = row0 + ai * 128 + m * 16;
                float ss = 0.f;
#pragma unroll
                for (int bj = 0; bj < 2; ++bj)
#pragma unroll
                    for (int i = 0; i < 8; ++i) { const float v = acc[ai][bj][m][i >> 2][i & 3]; ss += v * v; }
#pragma unroll
                for (int i = 0; i < 4; ++i) ss += x1[m][i] * x1[m][i] + x2[m][i] * x2[m][i];
                ss += __shfl_xor(ss, 16); ss += __shfl_xor(ss, 32);
                const float rstd = rsqrtf(ss * (1.f / 96.f) + 1e-6f);
                bf16_t* kp = KF + (size_t)r * 384 + wc * 96;
#pragma unroll
                for (int bj = 0; bj < 2; ++bj) { u32x4 w; const f32x4 v0 = acc[ai][bj][m][0], v1 = acc[ai][bj][m][1];
                    w.x = pk2(v0[0] * rstd, v0[1] * rstd); w.y = pk2(v0[2] * rstd, v0[3] * rstd);
                    w.z = pk2(v1[0] * rstd, v1[1] * rstd); w.w = pk2(v1[2] * rstd, v1[3] * rstd);
                    *(u32x4*)(kp + 32 * bj + 8 * fq) = w; }
                float o1[4], o2[4];
#pragma unroll
                for (int i = 0; i < 4; ++i) { const float a = x1[m][i] * rstd * w1[i], b = x2[m][i] * rstd * w2[i]; o1[i] = a * cs[m][i] - b * sn[m][i]; o2[i] = a * sn[m][i] + b * cs[m][i]; }
                *(u32x2*)(kp + 64 + 4 * fq) = (u32x2){pk2(o1[0], o1[1]), pk2(o1[2], o1[3])}; *(u32x2*)(kp + 80 + 4 * fq) = (u32x2){pk2(o2[0], o2[1]), pk2(o2[2], o2[3])}; }
            __builtin_amdgcn_sched_barrier(0); }
    } };
struct EpiGLU { static constexpr bool PERM = true, AFTER_DRAIN = false; bf16_t* O; const bf16_t* Z; const float* bias;
    __device__ __forceinline__ void operator()(const f32x4 (&acc)[2][2][4][2], const Unit& u, int wr, int wc, int fr_, int fq_) const {
        int fr = fr_, fq = fq_; asm volatile("" : "+v"(fr), "+v"(fq));
        const int row0 = u.pm * 256 + wr * 64 + fr, oc = u.pn * 128 + wc * 32 + 8 * fq;
#pragma unroll
        for (int ai = 0; ai < 2; ++ai) {
            float bv[8], bg[8];
            { const f32x4 b0 = *(const f32x4*)(bias + oc), b1 = *(const f32x4*)(bias + oc + 4), g0 = *(const f32x4*)(bias + 512 + oc), g1 = *(const f32x4*)(bias + 512 + oc + 4);
#pragma unroll
              for (int i = 0; i < 4; ++i) { bv[i] = b0[i]; bv[4 + i] = b1[i]; bg[i] = g0[i]; bg[4 + i] = g1[i]; } }
            u32x4 sgv[2][4];
#pragma unroll
            for (int m = 0; m < 4; ++m) sgv[ai][m] = *(const u32x4*)(Z + (size_t)(row0 + ai * 128 + m * 16) * LDZ + ZSG + oc);
#pragma unroll
            for (int m = 0; m < 4; ++m) { const size_t r = (size_t)(row0 + ai * 128 + m * 16);
                const u32x4 sg = sgv[ai][m];
                float g[8] = { lo16(sg.x), hi16(sg.x), lo16(sg.y), hi16(sg.y), lo16(sg.z), hi16(sg.z), lo16(sg.w), hi16(sg.w) };
                float o[8];
#pragma unroll
                for (int i = 0; i < 8; ++i) { const float zv = acc[ai][0][m][i >> 2][i & 3] + bv[i], zg = acc[ai][1][m][i >> 2][i & 3] + bg[i]; o[i] = zv * sigmoidf_(zg) * siluf_(g[i]); }
                u32x4 w; w.x = pk2(o[0], o[1]); w.y = pk2(o[2], o[3]); w.z = pk2(o[4], o[5]); w.w = pk2(o[6], o[7]);
                *(u32x4*)(O + r * 512 + oc) = w; }
            __builtin_amdgcn_sched_barrier(0); }
    } };
struct EpiBo { static constexpr bool PERM = true, AFTER_DRAIN = true; bf16_t* MIX; const bf16_t* Z; int branch;
    __device__ __forceinline__ void fused(f32x4 (&acc)[2][2][4][2], const Unit& u, int wr, int wc, int fr_, int fq_, LAS unsigned char* lds, int wid, int lane_) const {
        int fr = fr_, fq = fq_, lane = lane_; asm volatile("" : "+v"(fr), "+v"(fq), "+v"(lane));
        const int row0 = u.pm * 256 + wr * 64 + fr, col0 = u.pn * 256 + wc * 32 + 8 * fq;
        LAS unsigned char* wl = lds + wid * 16384;
#pragma unroll
        for (int ai = 0; ai < 2; ++ai)
#pragma unroll
            for (int m = 0; m < 4; ++m)
#pragma unroll
                for (int bj = 0; bj < 2; ++bj)
                    __builtin_amdgcn_global_load_lds((const unsigned*)(Z + (size_t)(row0 + ai * 128 + m * 16) * LDZ + ZMERGE + branch * 1024 + col0 + bj * 128), (LAS unsigned*)(wl + ((ai * 4 + m) * 2 + bj) * 1024), 16, 0, 0);
#pragma unroll
        for (int ai = 0; ai < 2; ++ai) {
            u32x4 pv[4][2];
#pragma unroll
            for (int m = 0; m < 4; ++m)
#pragma unroll
                for (int bj = 0; bj < 2; ++bj) pv[m][bj] = branch > 0 ? *(const u32x4*)(MIX + (size_t)(row0 + ai * 128 + m * 16) * 1024 + col0 + bj * 128) : (u32x4){0u, 0u, 0u, 0u};
            if (ai == 0) { asm volatile("s_waitcnt vmcnt(0)" ::: "memory"); __builtin_amdgcn_s_barrier(); asm volatile("" ::: "memory"); }
#pragma unroll
            for (int m = 0; m < 4; ++m) { const size_t r = (size_t)(row0 + ai * 128 + m * 16);
#pragma unroll
                for (int bj = 0; bj < 2; ++bj) { const u32x4 sg = *(const LAS u32x4*)(wl + ((ai * 4 + m) * 2 + bj) * 1024 + lane * 16), pp = pv[m][bj];
                    const float g[8] = { lo16(sg.x), hi16(sg.x), lo16(sg.y), hi16(sg.y), lo16(sg.z), hi16(sg.z), lo16(sg.w), hi16(sg.w) };
                    const float q[8] = { lo16(pp.x), hi16(pp.x), lo16(pp.y), hi16(pp.y), lo16(pp.z), hi16(pp.z), lo16(pp.w), hi16(pp.w) };
                    float o[8];
#pragma unroll
                    for (int i = 0; i < 8; ++i) o[i] = q[i] + sigmoidf_(g[i]) * acc[ai][bj][m][i >> 2][i & 3];
                    u32x4 w; w.x = pk2(o[0], o[1]); w.y = pk2(o[2], o[3]); w.z = pk2(o[4], o[5]); w.w = pk2(o[6], o[7]);
                    *(u32x4*)(MIX + r * 1024 + col0 + bj * 128) = w; } }
            __builtin_amdgcn_sched_barrier(0); }
        __syncthreads();
    }
    __device__ __forceinline__ void operator()(const f32x4 (&acc)[2][2][4][2], const Unit& u, int wr, int wc, int fr_, int fq_) const {
        int fr = fr_, fq = fq_; asm volatile("" : "+v"(fr), "+v"(fq));
        const int row0 = u.pm * 256 + wr * 64 + fr, col0 = u.pn * 256 + wc * 32 + 8 * fq;
#pragma unroll
        for (int ai = 0; ai < 2; ++ai)
#pragma unroll
          for (int mh = 0; mh < 4; mh += 2) {
            u32x4 gz[4][2], pv[4][2];
#pragma unroll
            for (int m = mh; m < mh + 2; ++m)
#pragma unroll
                for (int bj = 0; bj < 2; ++bj) { const size_t r = (size_t)(row0 + ai * 128 + m * 16);
                    gz[m][bj] = *(const u32x4*)(Z + r * LDZ + ZMERGE + branch * 1024 + col0 + bj * 128);
                    pv[m][bj] = branch > 0 ? *(const u32x4*)(MIX + r * 1024 + col0 + bj * 128) : (u32x4){0u, 0u, 0u, 0u}; }
#pragma unroll
            for (int m = mh; m < mh + 2; ++m) { const size_t r = (size_t)(row0 + ai * 128 + m * 16);
#pragma unroll
                for (int bj = 0; bj < 2; ++bj) { const u32x4 sg = gz[m][bj], pp = pv[m][bj];
                    const float g[8] = { lo16(sg.x), hi16(sg.x), lo16(sg.y), hi16(sg.y), lo16(sg.z), hi16(sg.z), lo16(sg.w), hi16(sg.w) };
                    const float q[8] = { lo16(pp.x), hi16(pp.x), lo16(pp.y), hi16(pp.y), lo16(pp.z), hi16(pp.z), lo16(pp.w), hi16(pp.w) };
                    float o[8];
#pragma unroll
                    for (int i = 0; i < 8; ++i) o[i] = q[i] + sigmoidf_(g[i]) * acc[ai][bj][m][i >> 2][i & 3];
                    u32x4 w; w.x = pk2(o[0], o[1]); w.y = pk2(o[2], o[3]); w.z = pk2(o[4], o[5]); w.w = pk2(o[6], o[7]);
                    *(u32x4*)(MIX + r * 1024 + col0 + bj * 128) = w; } }
            __builtin_amdgcn_sched_barrier(0); }
    } };
struct EpiOut { static constexpr bool PERM = false, AFTER_DRAIN = true; float* Y; const float* xp; const float* xs; const float* ada;
    __device__ __forceinline__ void fused(f32x4 (&acc)[2][2][4][2], const Unit& u, int wr, int wc, int fr_, int fq_, LAS unsigned char* lds, int wid, int lane_) const {
        int fr = fr_, fq = fq_, lane = lane_; asm volatile("" : "+v"(fr), "+v"(fq), "+v"(lane));
        const int row0 = u.pm * 256 + wr * 64 + fr, col0 = u.pn * 256 + wc * 32 + 4 * fq;
        LAS unsigned char* wl = lds + wid * 16384;
        const float* xb = (u.pm < 16 ? xp + (size_t)row0 * 1024 : xs + (size_t)(row0 - 4096) * 1024) + col0;
#pragma unroll
        for (int m = 0; m < 4; ++m)
#pragma unroll
            for (int bj = 0; bj < 2; ++bj)
#pragma unroll
                for (int n = 0; n < 2; ++n) __builtin_amdgcn_global_load_lds((const unsigned*)(xb + (size_t)(m * 16) * 1024 + bj * 128 + n * 16), (LAS unsigned*)(wl + ((m * 2 + bj) * 2 + n) * 1024), 16, 0, 0);
        f32x4 x1[4][2][2];
#pragma unroll
        for (int m = 0; m < 4; ++m)
#pragma unroll
            for (int bj = 0; bj < 2; ++bj)
#pragma unroll
                for (int n = 0; n < 2; ++n) x1[m][bj][n] = *(const f32x4*)(xb + (size_t)(128 + m * 16) * 1024 + bj * 128 + n * 16);
        const int ar = u.pm < 16 ? 0 : 1 + ((u.pm - 16) >> 2);
        const float* gp = ada + ar * 3072 + 2048;
        f32x4 gv[2][2];
#pragma unroll
        for (int bj = 0; bj < 2; ++bj)
#pragma unroll
            for (int n = 0; n < 2; ++n) gv[bj][n] = *(const f32x4*)(gp + col0 + bj * 128 + n * 16);
        asm volatile("s_waitcnt vmcnt(0)" ::: "memory"); __builtin_amdgcn_s_barrier(); asm volatile("" ::: "memory");
        float* yb = Y + (size_t)row0 * 1024 + col0;
#pragma unroll
        for (int m = 0; m < 4; ++m)
#pragma unroll
            for (int bj = 0; bj < 2; ++bj)
#pragma unroll
                for (int n = 0; n < 2; ++n) { const f32x4 xv = *(const LAS f32x4*)(wl + ((m * 2 + bj) * 2 + n) * 1024 + lane * 16);
                    *(f32x4*)(yb + (size_t)(m * 16) * 1024 + bj * 128 + n * 16) = xv + gv[bj][n] * acc[0][bj][m][n];
                    *(f32x4*)(yb + (size_t)(128 + m * 16) * 1024 + bj * 128 + n * 16) = x1[m][bj][n] + gv[bj][n] * acc[1][bj][m][n]; }
        __syncthreads();
    }
    __device__ __forceinline__ void operator()(const f32x4 (&acc)[2][2][4][2], const Unit& u, int wr, int wc, int fr_, int fq_) const {
        int fr = fr_, fq = fq_; asm volatile("" : "+v"(fr), "+v"(fq));
        const int row0 = u.pm * 256 + wr * 64 + fr, col0 = u.pn * 256 + wc * 32 + 4 * fq;
        const int ar = u.pm < 16 ? 0 : 1 + ((u.pm - 16) >> 2);
        const float* gp = ada + ar * 3072 + 2048;
        f32x4 gv[2][2];
#pragma unroll
        for (int bj = 0; bj < 2; ++bj)
#pragma unroll
            for (int n = 0; n < 2; ++n) gv[bj][n] = *(const f32x4*)(gp + col0 + bj * 128 + n * 16);
#pragma unroll
        for (int ai = 0; ai < 2; ++ai)
#pragma unroll
          for (int mh = 0; mh < 4; mh += 2) {
            f32x4 xv[4][2][2];
#pragma unroll
            for (int m = mh; m < mh + 2; ++m) { const int r = row0 + ai * 128 + m * 16;
                const float* xr = (r < 4096 ? xp + (size_t)r * 1024 : xs + (size_t)(r - 4096) * 1024) + col0;
#pragma unroll
                for (int bj = 0; bj < 2; ++bj)
#pragma unroll
                    for (int n = 0; n < 2; ++n) xv[m][bj][n] = *(const f32x4*)(xr + bj * 128 + n * 16); }
#pragma unroll
            for (int m = mh; m < mh + 2; ++m) { const int r = row0 + ai * 128 + m * 16;
                float* yr = Y + (size_t)r * 1024 + col0;
#pragma unroll
                for (int bj = 0; bj < 2; ++bj)
#pragma unroll
                    for (int n = 0; n < 2; ++n) *(f32x4*)(yr + bj * 128 + n * 16) = xv[m][bj][n] + gv[bj][n] * acc[ai][bj][m][n]; }
            __builtin_amdgcn_sched_barrier(0); }
    } };

__device__ __forceinline__ void job_ada(const Params& p, int j, lds_t lds) {
    LAS float* sc = (LAS float*)lds; LAS float* red = sc + 5 * 1024;
    const int l = j / 96, c0 = (j % 96) * 32, tid = tid_opaque(p);
    for (int i = tid; i < 5 * 1024; i += 512) { const int r = i >> 10, k = i & 1023; const float v = r == 0 ? p.in[I_CCTX][k] : p.in[I_C][(r - 1) * 1024 + k]; sc[i] = v / (1.f + expf(-v)); }
    __syncthreads();
    const int col = tid & 31, kg = tid >> 5; const float* W = p.in[I_WADA] + (size_t)l * 1024 * 3072 + (size_t)(kg * 64) * 3072 + c0 + col;
    float a0 = 0.f, a1 = 0.f, a2 = 0.f, a3 = 0.f, a4 = 0.f;
#pragma unroll 1
    for (int kb = 0; kb < 64; kb += 16) { float w[16];
#pragma unroll
        for (int i = 0; i < 16; ++i) w[i] = W[(size_t)(kb + i) * 3072];
#pragma unroll
        for (int i = 0; i < 16; ++i) { const int k = kg * 64 + kb + i; a0 += sc[k] * w[i]; a1 += sc[1024 + k] * w[i]; a2 += sc[2048 + k] * w[i]; a3 += sc[3072 + k] * w[i]; a4 += sc[4096 + k] * w[i]; } }
    red[(kg * 5 + 0) * 32 + col] = a0; red[(kg * 5 + 1) * 32 + col] = a1; red[(kg * 5 + 2) * 32 + col] = a2; red[(kg * 5 + 3) * 32 + col] = a3; red[(kg * 5 + 4) * 32 + col] = a4;
    __syncthreads();
    if (tid < 160) { const int r = tid >> 5, cc = tid & 31; float s = p.in[I_BADA][l * 3072 + c0 + cc];
        for (int g = 0; g < 16; ++g) s += red[(g * 5 + r) * 32 + cc];
        ((float*)(p.ws + OFF_ADA))[(l * 5 + r) * 3072 + c0 + cc] = s; }
    __syncthreads();
}
__device__ __forceinline__ void job_ctx(const Params& p, int j) {
    const int base = j * 4096 + tid_opaque(p) * 8; const int l = base / (2048 * 256), rem = base % (2048 * 256), row = rem >> 8, c = rem & 255, b = row >> 9, jj = row & 511;
    const float* s = p.in[I_CKV] + ((size_t)((b * 2 + l) * 512 + jj)) * 256 + c;
    const f32x4 v0 = *(const f32x4*)s, v1 = *(const f32x4*)(s + 4);
    bf16_t* d = (bf16_t*)(p.ws + (l == 0 ? OFF_CTX0 : OFF_CTX1)) + (size_t)row * 256 + c;
    store8(d, v0, v1);
}
__device__ __forceinline__ void job_rope(const Params& p, int j) {
    const int idx = j * 512 + tid_opaque(p), pos = idx >> 4, i = idx & 15, f = i & 7;
    const float inv = powf(10000.f, -(float)f / 8.f); const float ang = (float)(i < 8 ? (pos >> 6) : (pos & 63)) * inv;
    float* R = (float*)(p.ws + OFF_ROPE); R[idx] = cosf(ang); R[16384 + idx] = sinf(ang);
}

__device__ __forceinline__ void job_prep(const Params& p, int l, int j) {
    const int tid = tid_opaque(p), wid = tid >> 6, lane = tid & 63, row = j * 8 + wid;
    const float* x = l == 0 ? (row < 4096 ? p.in[I_XP] + (size_t)row * 1024 : p.in[I_XS] + (size_t)(row - 4096) * 1024) : p.out + (size_t)row * 1024;
    const int ar = row < 4096 ? 0 : 1 + ((row - 4096) >> 10);
    const float* ada = (const float*)(p.ws + OFF_ADA) + (l * 5 + ar) * 3072; const float* nw = p.in[I_NORMW] + l * 1024;
    f32x4 v[4]; float ss = 0.f;
#pragma unroll
    for (int i = 0; i < 4; ++i) { v[i] = *(const f32x4*)(x + i * 256 + lane * 4); ss += v[i][0] * v[i][0] + v[i][1] * v[i][1] + v[i][2] * v[i][2] + v[i][3] * v[i][3]; }
#pragma unroll
    for (int o = 1; o < 64; o <<= 1) ss += __shfl_xor(ss, o);
    const float rstd = rsqrtf(ss * (1.f / 1024.f) + 1e-6f);
    bf16_t* h = (bf16_t*)(p.ws + OFF_HB) + (size_t)row * 1024;
#pragma unroll
    for (int i = 0; i < 4; ++i) { const int c = i * 256 + lane * 4; const f32x4 w = *(const f32x4*)(nw + c), sh = *(const f32x4*)(ada + c), sc = *(const f32x4*)(ada + 1024 + c);
        float o[4];
#pragma unroll
        for (int k = 0; k < 4; ++k) o[k] = v[i][k] * rstd * w[k] * (1.f + sc[k]) + sh[k];
        u32x2 pk; pk.x = pk2(o[0], o[1]); pk.y = pk2(o[2], o[3]); *(u32x2*)(h + c) = pk; }
}
__device__ __forceinline__ void wt_tile(const Params& p, const float* src, int ldsrc, int sbase, int nvalid, int mode, bf16_t* dst, int K, int n0, int k0, lds_t lds) {
    LAS float* t = (LAS float*)lds; const int tid = tid_opaque(p);
    const int nn = tid & 255, kh = tid >> 8; const int sc = mode == 0 ? sbase + nn : mode == 1 ? ((nn >> 7) & 1) * 512 + sbase + (nn & 127) : ((nn >> 5) & 3) * 64 + (nn >> 7) * 32 + (nn & 31); const bool ok = mode != 0 || nn < nvalid;
    float v[32];
#pragma unroll
    for (int i = 0; i < 32; ++i) v[i] = ok ? src[(size_t)(k0 + 2 * i + kh) * ldsrc + sc] : 0.f;
#pragma unroll
    for (int i = 0; i < 32; ++i) t[(2 * i + kh) * 257 + nn] = v[i];
    __syncthreads();
#pragma unroll
    for (int ps = 0; ps < 4; ++ps) { const int n = ps * 64 + (tid >> 3), kc = tid & 7; const LAS float* s = t + (kc * 8) * 257 + n; u32x4 w;
        w.x = pk2(s[0], s[257]); w.y = pk2(s[514], s[771]); w.z = pk2(s[1028], s[1285]); w.w = pk2(s[1542], s[1799]);
        *(u32x4*)(dst + (size_t)(n0 + n) * K + k0 + kc * 8) = w; }
    __syncthreads();
}
constexpr int WT_WIN = 27 * 16, WT_WUQ = 2 * 6, WT_WKV = 3 * 4, WT_WGLU = 4 * 8, WT_WBO = 4 * 8, WT_WOUT = 4 * 16, WT_EARLY = WT_WIN + WT_WUQ + WT_WKV + WT_WGLU, WT_TOTAL = WT_EARLY + 3 * WT_WBO + WT_WOUT;
__device__ __forceinline__ void job_wt(const Params& p, int l, int t, lds_t lds) {
    if (t < WT_WIN) { const int nt = t / 16, kt = t % 16; wt_tile(p, p.in[I_WIN] + (size_t)l * 1024 * 6848, 6848, nt * 256, 6848 - nt * 256, 0, (bf16_t*)(p.ws + OFF_WIN), 1024, nt * 256, kt * 64, lds); return; } t -= WT_WIN;
    if (t < WT_WUQ) { const int nt = t / 6, kt = t % 6; wt_tile(p, p.in[I_WUQ] + (size_t)l * 384 * 384, 384, nt * 256, 384 - nt * 256, 0, (bf16_t*)(p.ws + OFF_WUQ), 384, nt * 256, kt * 64, lds); return; } t -= WT_WUQ;
    if (t < WT_WKV) { const int nt = t / 4, kt = t % 4;
        if (nt == 0) wt_tile(p, p.in[I_WUK] + (size_t)l * 256 * 256, 256, 0, 256, 2, (bf16_t*)(p.ws + OFF_WKV), 256, 0, kt * 64, lds);
        else wt_tile(p, p.in[I_WUV] + (size_t)l * 256 * 512, 512, (nt - 1) * 256, 256, 0, (bf16_t*)(p.ws + OFF_WKV), 256, nt * 256, kt * 64, lds);
        return; } t -= WT_WKV;
    if (t < WT_WGLU) { const int nt = t / 8, kt = t % 8; wt_tile(p, p.in[I_WGLU] + (size_t)l * 512 * 1024, 1024, nt * 128, 256, 1, (bf16_t*)(p.ws + OFF_WGLU), 512, nt * 256, kt * 64, lds); return; } t -= WT_WGLU;
    if (t < 3 * WT_WBO) { const int br = t / WT_WBO, tt = t % WT_WBO, nt = tt / 8, kt = tt % 8;
        wt_tile(p, p.in[I_WBOG + br] + (size_t)l * 512 * 1024, 1024, nt * 256, 256, 0, (bf16_t*)(p.ws + OFF_WBO) + (size_t)br * 1024 * 512, 512, nt * 256, kt * 64, lds); return; } t -= 3 * WT_WBO;
    { const int nt = t / 16, kt = t % 16; wt_tile(p, p.in[I_WOUT] + (size_t)l * 1024 * 1024, 1024, nt * 256, 256, 0, (bf16_t*)(p.ws + OFF_WOUT), 1024, nt * 256, kt * 64, lds); }
}
__device__ __forceinline__ void job_s5setup(const Params& p, int l, int j, lds_t lds) {
    const int g = j / 3, which = j % 3, tid = tid_opaque(p);
    LAS f32x2_t* pw = (LAS f32x2_t*)lds;
    LAS f32x2_t* Bt = pw + 2 * 17 * 64;
    LAS f32x2_t* Cn = Bt + 2 * 64 * 16;
    LAS float* Kt = (LAS float*)(Cn + 64 * 16);
    LAS float* raw = Kt + 8192;
    { const size_t gb = (size_t)(l * 32 + g) * 1024;
      for (int i = tid; i < 1024; i += 512) { raw[i] = p.in[I_BRE][gb + i]; raw[1024 + i] = p.in[I_BIM][gb + i]; raw[2048 + i] = p.in[I_CRE][gb + i]; raw[3072 + i] = p.in[I_CIM][gb + i]; }
      if (tid < 128) { const int d = tid >> 6, n = tid & 63; raw[4096 + tid] = p.in[I_ARE][((l * 2 + d) * 32 + g) * 64 + n]; raw[4224 + tid] = p.in[I_AIM][((l * 2 + d) * 32 + g) * 64 + n]; }
      if (tid < 2) raw[4352 + tid] = p.in[I_LOGDT][(l * 2 + tid) * 32 + g]; }
    __syncthreads();
    if (tid < 128) { const int d = tid >> 6, n = tid & 63;
        const float dt = expf(raw[4352 + d]);
        const float are = raw[4096 + tid], aim = raw[4224 + tid];
        float s1, c1; sincosf(aim * dt, &s1, &c1); float sh = sinf(0.5f * aim * dt);
        const float em1 = expm1f(are * dt), mag1 = em1 + 1.f;
        { float pr = 1.f, pi = 0.f; const float ar1 = mag1 * c1, ai1 = mag1 * s1;
          for (int tau = 0; tau <= 16; ++tau) { pw[(d * 17 + tau) * 64 + n] = (f32x2_t){pr, pi}; const float nr = pr * ar1 - pi * ai1, ni = pr * ai1 + pi * ar1; pr = nr; pi = ni; } }
        const float nre = em1 * c1 - 2.f * sh * sh, abim = mag1 * s1, den = are * are + aim * aim;
        const float cfr = (nre * are + abim * aim) / den, cfi = (abim * are - nre * aim) / den;
        for (int q = 0; q < 16; ++q) { const float br = raw[n * 16 + q], bi = raw[1024 + n * 16 + q];
            Bt[(d * 64 + n) * 16 + q] = (f32x2_t){cfr * br - cfi * bi, cfr * bi + cfi * br}; }
        if (which == 1) ((f32x2_t*)(p.ws + OFF_P16))[(g * 2 + d) * 64 + n] = pw[(d * 17 + 16) * 64 + n];
    }
    for (int i = tid; i < 1024; i += 512) { const int n = i >> 4, pp = i & 15; Cn[i] = (f32x2_t){raw[2048 + pp * 64 + n], raw[3072 + pp * 64 + n]}; }
    __syncthreads();
    bf16_t* M = (bf16_t*)(p.ws + OFF_S5M) + (size_t)(g * 3 + which) * 65536;
    if (which == 0) {
        { const int wid_ = tid >> 6, ln = tid & 63, lr_ = ln & 15, kq = ln >> 4;
          for (int c4 = 0; c4 < 4; ++c4) { const int dt_ = wid_ * 4 + c4, d = dt_ >> 4, tau = dt_ & 15; f32x4 acc = {0.f, 0.f, 0.f, 0.f};
#pragma unroll 4
            for (int ks = 0; ks < 16; ++ks) { const int n = ks * 4 + kq; const f32x2_t c = Cn[n * 16 + lr_], w = pw[(d * 17 + tau) * 64 + n], b = Bt[(d * 64 + n) * 16 + lr_];
                const float cwr = c.x * w.x - c.y * w.y, cwi = c.x * w.y + c.y * w.x;
                acc = __builtin_amdgcn_mfma_f32_16x16x4f32(cwr, b.x, acc, 0, 0, 0); acc = __builtin_amdgcn_mfma_f32_16x16x4f32(-cwi, b.y, acc, 0, 0, 0); }
#pragma unroll
            for (int r = 0; r < 4; ++r) Kt[dt_ * 256 + (kq * 4 + r) * 16 + lr_] = acc[r]; } }
        __syncthreads();
#pragma unroll 8
        for (int i = tid; i < 65536; i += 512) { const int no = i >> 8, k = i & 255, t = no >> 4, pp = no & 15, s = k >> 4, q = k & 15; float v;
            if (t > s) v = Kt[(0 * 16 + (t - s)) * 256 + pp * 16 + q];
            else if (t < s) v = Kt[(1 * 16 + (s - t)) * 256 + pp * 16 + q];
            else { v = Kt[pp * 16 + q] + Kt[16 * 256 + pp * 16 + q]; if (pp == q) v += p.in[I_S5D][l * 512 + g * 16 + pp]; }
            M[i] = f2bf(v); }
    } else if (which == 1) {
#pragma unroll 8
        for (int i = tid; i < 65536; i += 512) { const int no = i >> 8, k = i & 255, d = no >> 7, ri = (no >> 6) & 1, n = no & 63, s = k >> 4, q = k & 15; const int e = d == 0 ? 15 - s : s;
            const f32x2_t w = pw[(d * 17 + e) * 64 + n], b = Bt[(d * 64 + n) * 16 + q];
            M[i] = f2bf(ri == 0 ? w.x * b.x - w.y * b.y : w.x * b.y + w.y * b.x); }
    } else {
#pragma unroll 8
        for (int i = tid; i < 65536; i += 512) { const int no = i >> 8, k = i & 255, t = no >> 4, pp = no & 15, d = k >> 7, ri = (k >> 6) & 1, n = k & 63; const int e = d == 0 ? t + 1 : 16 - t;
            const f32x2_t c = Cn[n * 16 + pp], w = pw[(d * 17 + e) * 64 + n];
            M[i] = f2bf(ri == 0 ? c.x * w.x - c.y * w.y : -(c.x * w.y + c.y * w.x)); }
    }
    __syncthreads();
}

__device__ __forceinline__ float gelu_tanh(float x) { const float u = 0.7978845608f * (x + 0.044715f * x * x * x); const float t = 1.f - 2.f / (1.f + __expf(2.f * u)); return 0.5f * x * (1.f + t); }
__device__ __forceinline__ void job_s5(const Params& p, int l, int j, lds_t lds) {
    const int tid = tid_opaque(p), wid = tid >> 6, lane = tid & 63, lr = lane & 15, lq = lane >> 4;
    const int bb = j >> 5, g = j & 31;
    const int M = bb < 16 ? 16 : 64, MT = M >> 4; const int tok0 = bb < 16 ? bb * 256 : 4096 + (bb - 16) * 1024;
    LAS bf16_t* Us = (LAS bf16_t*)lds; LAS bf16_t* Xs = Us + 64 * 264; LAS float* Xin = (LAS float*)(lds + 2 * 64 * 264 * 2);
    const bf16_t* Z = (const bf16_t*)(p.ws + OFF_Z);
    const bf16_t* TT = (const bf16_t*)(p.ws + OFF_S5M) + (size_t)(g * 3) * 65536; const bf16_t* G = TT + 65536; const bf16_t* Cc = G + 65536;
    bf16x8 bq[8][2];
#pragma unroll
    for (int ks = 0; ks < 8; ++ks) { bq[ks][0] = *(const bf16x8*)(G + (size_t)(wid * 32 + lr) * 256 + ks * 32 + lq * 8); bq[ks][1] = *(const bf16x8*)(G + (size_t)(wid * 32 + 16 + lr) * 256 + ks * 32 + lq * 8); }
    f32x2_t a16 = {0.f, 0.f}; float xr = 0.f, xi = 0.f;
    if (tid < 128) { const int d = tid >> 6, n = tid & 63; a16 = ((const f32x2_t*)(p.ws + OFF_P16))[(g * 2 + d) * 64 + n];
        if (bb >= 16) { const size_t o = ((size_t)(((bb - 16) * 2 + l) * 2 + d) * 2) * 2048 + g * 64 + n; xr = p.in[I_SS5][o]; xi = p.in[I_SS5][o + 2048]; } }
    for (int idx = tid; idx < M * 32; idx += 512) { const int tok = idx >> 1, hf = idx & 1;
        *(LAS u32x4*)(Us + (tok >> 4) * 264 + (tok & 15) * 16 + hf * 8) = *(const u32x4*)(Z + (size_t)(tok0 + tok) * LDZ + ZSU + g * 16 + hf * 8); }
    __syncthreads();
    f32x4 acc[4][2];
#pragma unroll
    for (int a = 0; a < 4; ++a) { acc[a][0] = (f32x4){0.f, 0.f, 0.f, 0.f}; acc[a][1] = acc[a][0]; }
#pragma unroll
    for (int ks = 0; ks < 8; ++ks)
#pragma unroll
        for (int mt = 0; mt < 4; ++mt) if (mt < MT) { const bf16x8 a = LDSFRAG(Us + (mt * 16 + lr) * 264 + ks * 32 + lq * 8); acc[mt][0] = MFMA16(a, bq[ks][0], acc[mt][0]); acc[mt][1] = MFMA16(a, bq[ks][1], acc[mt][1]); }
    bf16x8 bc[8][2];
#pragma unroll
    for (int ks = 0; ks < 8; ++ks) { bq[ks][0] = *(const bf16x8*)(TT + (size_t)(wid * 32 + lr) * 256 + ks * 32 + lq * 8); bq[ks][1] = *(const bf16x8*)(TT + (size_t)(wid * 32 + 16 + lr) * 256 + ks * 32 + lq * 8);
        bc[ks][0] = *(const bf16x8*)(Cc + (size_t)(wid * 32 + lr) * 256 + ks * 32 + lq * 8); bc[ks][1] = *(const bf16x8*)(Cc + (size_t)(wid * 32 + 16 + lr) * 256 + ks * 32 + lq * 8); }
#pragma unroll
    for (int mt = 0; mt < 4; ++mt) if (mt < MT)
#pragma unroll
        for (int ct = 0; ct < 2; ++ct)
#pragma unroll
            for (int r = 0; r < 4; ++r) Xin[(mt * 16 + lq * 4 + r) * 260 + wid * 32 + ct * 16 + lr] = acc[mt][ct][r];
    __syncthreads();
    if (tid < 128) { const int d = tid >> 6, n = tid & 63;
        const int cre = d * 128 + n, cim = cre + 64;
        for (int i = 0; i < M; ++i) { const int c = d == 0 ? i : M - 1 - i;
            Xs[c * 264 + cre] = f2bf(xr); Xs[c * 264 + cim] = f2bf(xi);
            const float ur = Xin[c * 260 + cre], ui = Xin[c * 260 + cim];
            const float nr = a16.x * xr - a16.y * xi + ur, ni = a16.x * xi + a16.y * xr + ui; xr = nr; xi = ni; }
        if (bb < 16) { const size_t o = OUT_S5 + ((size_t)((bb * 2 + l) * 2 + d) * 2) * 2048 + g * 64 + n; p.out[o] = xr; p.out[o + 2048] = xi; }
    }
    __syncthreads();
#pragma unroll
    for (int a = 0; a < 4; ++a) { acc[a][0] = (f32x4){0.f, 0.f, 0.f, 0.f}; acc[a][1] = acc[a][0]; }
#pragma unroll
    for (int ks = 0; ks < 8; ++ks)
#pragma unroll
        for (int mt = 0; mt < 4; ++mt) if (mt < MT) { const bf16x8 a = LDSFRAG(Us + (mt * 16 + lr) * 264 + ks * 32 + lq * 8); acc[mt][0] = MFMA16(a, bq[ks][0], acc[mt][0]); acc[mt][1] = MFMA16(a, bq[ks][1], acc[mt][1]); }
#pragma unroll
    for (int ks = 0; ks < 8; ++ks)
#pragma unroll
        for (int mt = 0; mt < 4; ++mt) if (mt < MT) { const bf16x8 a = LDSFRAG(Xs + (mt * 16 + lr) * 264 + ks * 32 + lq * 8); acc[mt][0] = MFMA16(a, bc[ks][0], acc[mt][0]); acc[mt][1] = MFMA16(a, bc[ks][1], acc[mt][1]); }
    bf16_t* Yg = (bf16_t*)(p.ws + OFF_YG);
#pragma unroll
    for (int mt = 0; mt < 4; ++mt) if (mt < MT)
#pragma unroll
        for (int ct = 0; ct < 2; ++ct)
#pragma unroll
            for (int r = 0; r < 4; ++r) { const int chunk = mt * 16 + lq * 4 + r, t = wid * 2 + ct;
                Yg[(size_t)(tok0 + chunk * 16 + t) * 512 + g * 16 + lr] = f2bf(gelu_tanh(acc[mt][ct][r])); }
    __syncthreads();
}
__device__ __forceinline__ void job_mlaprep(const Params& p, int l, int j) {
    const int tid = tid_opaque(p), wid = tid >> 6, lane = tid & 63, row = j * 8 + wid;
    const bf16_t* z = (const bf16_t*)(p.ws + OFF_Z) + (size_t)row * LDZ;
    float q[6], kv[4]; float sq = 0.f, sk = 0.f;
#pragma unroll
    for (int i = 0; i < 6; ++i) { q[i] = bf2f(z[ZMQ + i * 64 + lane]); sq += q[i] * q[i]; }
#pragma unroll
    for (int i = 0; i < 4; ++i) { kv[i] = bf2f(z[ZMKV + i * 64 + lane]); sk += kv[i] * kv[i]; }
#pragma unroll
    for (int o = 1; o < 64; o <<= 1) { sq += __shfl_xor(sq, o); sk += __shfl_xor(sk, o); }
    const float rq = rsqrtf(sq * (1.f / 384.f) + 1e-6f), rk = rsqrtf(sk * (1.f / 256.f) + 1e-6f);
    bf16_t* aq = (bf16_t*)(p.ws + OFF_AQ) + (size_t)row * 384; bf16_t* ck = (bf16_t*)(p.ws + OFF_CKVN) + (size_t)row * 256;
#pragma unroll
    for (int i = 0; i < 6; ++i) aq[i * 64 + lane] = f2bf(q[i] * rq * p.in[I_QNORM][l * 384 + i * 64 + lane]);
    const bool prompt = row < 4096; const int b = row >> 8, t = row & 255;
#pragma unroll
    for (int i = 0; i < 4; ++i) { const float v = kv[i] * rk * p.in[I_KVNORM][l * 256 + i * 64 + lane]; ck[i * 64 + lane] = f2bf(v);
        if (prompt) p.out[OUT_CKV + ((size_t)((b * 2 + l) * 256 + t)) * 256 + i * 64 + lane] = v; }
    if (prompt && lane < 32) p.out[OUT_KR + ((size_t)((b * 2 + l) * 256 + t)) * 32 + lane] = bf2f(z[ZMKR + lane]);
}
__device__ __forceinline__ float logsigmoidf_(float x) { return fminf(x, 0.f) - __logf(1.f + __expf(-fabsf(x))); }
__device__ __forceinline__ void job_glaA(const Params& p, int l, int j, lds_t lds) {
    const int tid = tid_opaque(p), wid = tid >> 6, lane = tid & 63, lr = lane & 15, lq = lane >> 4;
    const int ck = j >> 2, h = j & 3, tok0 = ck * 64;
    LAS bf16_t* QDf = (LAS bf16_t*)lds; LAS bf16_t* QDb = QDf + 4608; LAS bf16_t* KDf = QDb + 4608; LAS bf16_t* KDb = KDf + 4608; LAS bf16_t* KRf = KDb + 4608; LAS bf16_t* KRb = KRf + 4608;
    LAS bf16_t* VT = KRb + 4608;
    LAS bf16_t* ATT = VT + 9216;
    LAS float* GA = (LAS float*)(ATT + 4608);
    LAS float* TOT = GA + 2048;
    const bf16_t* Z = (const bf16_t*)(p.ws + OFF_Z);
    { const int c = tid >> 3, part = tid & 7; const u32x2 gv = *(const u32x2*)(Z + (size_t)(tok0 + c) * LDZ + ZGA + part * 4);
      GA[c * 32 + part * 4 + 0] = lo16(gv.x); GA[c * 32 + part * 4 + 1] = hi16(gv.x); GA[c * 32 + part * 4 + 2] = lo16(gv.y); GA[c * 32 + part * 4 + 3] = hi16(gv.y);
      const bf16_t* vp = Z + (size_t)(tok0 + c) * LDZ + ZV + h * 128 + part * 16;
      const u32x4 v0 = *(const u32x4*)vp, v1 = *(const u32x4*)(vp + 8);
      const unsigned w[8] = { v0.x, v0.y, v0.z, v0.w, v1.x, v1.y, v1.z, v1.w };
#pragma unroll
      for (int i = 0; i < 8; ++i) { VT[(part * 16 + 2 * i) * 72 + c] = (bf16_t)(w[i] & 0xffffu); VT[(part * 16 + 2 * i + 1) * 72 + c] = (bf16_t)(w[i] >> 16); } }
    __syncthreads();
    const int d = tid & 63, cg_ = tid >> 6;
    float laf[8], lab[8]; bf16_t qraw[8], kraw[8];
#pragma unroll
    for (int i = 0; i < 8; ++i) { const size_t zr = (size_t)(tok0 + cg_ * 8 + i) * LDZ; qraw[i] = Z[zr + ZQ + h * 64 + d]; kraw[i] = Z[zr + ZK + h * 64 + d]; }
    { float wf[16], wb[16];
#pragma unroll
      for (int r = 0; r < 16; ++r) { wf[r] = p.in[I_WA2][((size_t)((l * 2 + 0) * 16 + r)) * 256 + h * 64 + d]; wb[r] = p.in[I_WA2][((size_t)((l * 2 + 1) * 16 + r)) * 256 + h * 64 + d]; }
      const float bf_ = p.in[I_BA][(l * 2 + 0) * 256 + h * 64 + d], bb_ = p.in[I_BA][(l * 2 + 1) * 256 + h * 64 + d];
#pragma unroll
      for (int i = 0; i < 8; ++i) { const int c = cg_ * 8 + i; float xf = bf_, xb = bb_;
#pragma unroll
          for (int r = 0; r < 16; ++r) { xf += GA[c * 32 + r] * wf[r]; xb += GA[c * 32 + 16 + r] * wb[r]; }
          laf[i] = logsigmoidf_(xf) * (1.f / 16.f); lab[i] = logsigmoidf_(xb) * (1.f / 16.f); } }
#pragma unroll
    for (int i = 1; i < 8; ++i) laf[i] += laf[i - 1];
#pragma unroll
    for (int i = 6; i >= 0; --i) lab[i] += lab[i + 1];
    TOT[(0 * 8 + cg_) * 64 + d] = laf[7]; TOT[(1 * 8 + cg_) * 64 + d] = lab[0];
    __syncthreads();
    float offf = 0.f, offb = 0.f, Tf = 0.f, Tb = 0.f;
#pragma unroll
    for (int g = 0; g < 8; ++g) { const float a = TOT[g * 64 + d], b = TOT[(8 + g) * 64 + d]; Tf += a; Tb += b; if (g < cg_) offf += a; if (g > cg_) offb += b; }
    bf16_t* QD = (bf16_t*)(p.ws + OFF_QD);
#pragma unroll
    for (int i = 0; i < 8; ++i) { const int c = cg_ * 8 + i;
        const float q = bf2f(qraw[i]) * 0.125f, k = bf2f(kraw[i]);
        const float bf_ = offf + laf[i], bb_ = offb + lab[i];
        const bf16_t qf = f2bf(q * __expf(bf_)), qb = f2bf(q * __expf(bb_));
        QDf[c * 72 + d] = qf; QDb[c * 72 + d] = qb;
        KDf[c * 72 + d] = f2bf(k * __expf(-bf_)); KDb[c * 72 + d] = f2bf(k * __expf(-bb_));
        KRf[d * 72 + c] = f2bf(k * __expf(Tf - bf_)); KRb[d * 72 + c] = f2bf(k * __expf(Tb - bb_));
        QD[(size_t)(tok0 + c) * 256 + h * 64 + d] = qf; QD[(size_t)(8192 + tok0 + c) * 256 + h * 64 + d] = qb; }
    if (cg_ == 0) { float* DEC = (float*)(p.ws + OFF_DEC); DEC[((0 * 128 + ck) * 4 + h) * 64 + d] = __expf(Tf); DEC[((1 * 128 + ck) * 4 + h) * 64 + d] = __expf(Tb); }
    __syncthreads();
#pragma unroll
    for (int q2 = 0; q2 < 2; ++q2) { const int tt = wid * 2 + q2, ti = tt >> 2, tj = tt & 3; f32x4 af = {0.f, 0.f, 0.f, 0.f}, ab = af;
#pragma unroll
        for (int ks = 0; ks < 2; ++ks) { const int ko = ks * 32 + lq * 8;
            af = MFMA16(LDSFRAG(QDf + (ti * 16 + lr) * 72 + ko), LDSFRAG(KDf + (tj * 16 + lr) * 72 + ko), af);
            ab = MFMA16(LDSFRAG(QDb + (ti * 16 + lr) * 72 + ko), LDSFRAG(KDb + (tj * 16 + lr) * 72 + ko), ab); }
#pragma unroll
        for (int r = 0; r < 4; ++r) { const int c = ti * 16 + lq * 4 + r, s = tj * 16 + lr; const float v = (s <= c ? af[r] : 0.f) + (s >= c ? ab[r] : 0.f); ATT[c * 72 + s] = f2bf(v); } }
    __syncthreads();
    bf16x8 vb[2];
#pragma unroll
    for (int ks = 0; ks < 2; ++ks) vb[ks] = LDSFRAG(VT + (wid * 16 + lr) * 72 + ks * 32 + lq * 8);
    bf16_t* OI = (bf16_t*)(p.ws + OFF_OIB); bf16_t* KV = (bf16_t*)(p.ws + OFF_KV);
#pragma unroll
    for (int ct = 0; ct < 4; ++ct) { f32x4 a = {0.f, 0.f, 0.f, 0.f};
#pragma unroll
        for (int ks = 0; ks < 2; ++ks) a = MFMA16(LDSFRAG(ATT + (ct * 16 + lr) * 72 + ks * 32 + lq * 8), vb[ks], a);
#pragma unroll
        for (int r = 0; r < 4; ++r) OI[(size_t)(tok0 + ct * 16 + lq * 4 + r) * 512 + h * 128 + wid * 16 + lr] = f2bf(a[r]); }
#pragma unroll
    for (int dir = 0; dir < 2; ++dir) { const LAS bf16_t* KR = dir == 0 ? KRf : KRb; bf16_t* kvp = KV + ((size_t)((dir * 128 + ck) * 4 + h)) * 8192;
#pragma unroll
        for (int dt = 0; dt < 4; ++dt) { f32x4 a = {0.f, 0.f, 0.f, 0.f};
#pragma unroll
            for (int ks = 0; ks < 2; ++ks) a = MFMA16(LDSFRAG(KR + (dt * 16 + lr) * 72 + ks * 32 + lq * 8), vb[ks], a);
#pragma unroll
            for (int r = 0; r < 4; ++r) kvp[(dt * 16 + lq * 4 + r) * 128 + wid * 16 + lr] = f2bf(a[r]); } }
    __syncthreads();
}

__device__ __forceinline__ void job_glaB(const Params& p, int l, int j) {
    const int qt = j & 3, h = (j >> 2) & 3, rest = j >> 4, bb = rest % 20, dir = rest / 20;
    const int idx0 = qt * 2048 + tid_opaque(p);
    const int nck = bb < 16 ? 4 : 16, ck0 = bb < 16 ? bb * 4 : 64 + (bb - 16) * 16;
    float S[4];
#pragma unroll
    for (int e = 0; e < 4; ++e) S[e] = bb >= 16 ? p.in[I_SGLA][((size_t)((((bb - 16) * 2 + l) * 2 + dir) * 4 + h)) * 8192 + idx0 + e * 512] : 0.f;
    const bf16_t* KV = (const bf16_t*)(p.ws + OFF_KV); const float* DEC = (const float*)(p.ws + OFF_DEC); bf16_t* ST = (bf16_t*)(p.ws + OFF_ST);
    for (int i0 = 0; i0 < nck; i0 += 4) { float dv[4][4]; bf16_t kv[4][4]; size_t its[4];
#pragma unroll
        for (int u = 0; u < 4; ++u) { const int i = i0 + u, ck = dir == 0 ? ck0 + i : ck0 + nck - 1 - i; its[u] = (size_t)((dir * 128 + ck) * 4 + h);
#pragma unroll
            for (int e = 0; e < 4; ++e) { const int idx = idx0 + e * 512; dv[u][e] = DEC[its[u] * 64 + (idx >> 7)]; kv[u][e] = KV[its[u] * 8192 + idx]; } }
#pragma unroll
        for (int u = 0; u < 4; ++u)
#pragma unroll
            for (int e = 0; e < 4; ++e) { ST[its[u] * 8192 + idx0 + e * 512] = f2bf(S[e]); S[e] = dv[u][e] * S[e] + bf2f(kv[u][e]); } }
    if (bb < 16) {
#pragma unroll
        for (int e = 0; e < 4; ++e) p.out[OUT_GLA + ((size_t)(((bb * 2 + l) * 2 + dir) * 4 + h)) * 8192 + idx0 + e * 512] = S[e]; }
}

__device__ __forceinline__ void job_glaC(const Params& p, int l, int j, lds_t lds) {
    const int tid = tid_opaque(p), wid = tid >> 6, lane = tid & 63, lr = lane & 15, lq = lane >> 4;
    const int ck = j >> 2, h = j & 3, tok0 = ck * 64;
    LAS bf16_t* Aq = (LAS bf16_t*)lds;
    LAS bf16_t* BT = Aq + 64 * 136;
    LAS float* Os = (LAS float*)(BT + 128 * 136);
    const bf16_t* QD = (const bf16_t*)(p.ws + OFF_QD); const bf16_t* ST = (const bf16_t*)(p.ws + OFF_ST);
#pragma unroll
    for (int it = 0; it < 2; ++it) { const int idx = tid + it * 512, c = idx >> 4, rem = idx & 15, dir = rem >> 3, dc = rem & 7;
        *(LAS u32x4*)(Aq + c * 136 + dir * 64 + dc * 8) = *(const u32x4*)(QD + (size_t)(dir * 8192 + tok0 + c) * 256 + h * 64 + dc * 8); }
#pragma unroll
    for (int it = 0; it < 4; ++it) { const int idx = tid + it * 512, dir = idx >> 10, d = (idx >> 4) & 63, ec = idx & 15;
        const u32x4 v = *(const u32x4*)(ST + ((size_t)((dir * 128 + ck) * 4 + h)) * 8192 + d * 128 + ec * 8);
        const unsigned w[4] = { v.x, v.y, v.z, v.w };
#pragma unroll
        for (int i = 0; i < 4; ++i) { BT[(ec * 8 + 2 * i) * 136 + dir * 64 + d] = (bf16_t)(w[i] & 0xffffu); BT[(ec * 8 + 2 * i + 1) * 136 + dir * 64 + d] = (bf16_t)(w[i] >> 16); } }
    const int ct = wid & 3, eh = wid >> 2; const bf16_t* OI = (const bf16_t*)(p.ws + OFF_OIB);
    bf16_t oi[4][4];
#pragma unroll
    for (int e4 = 0; e4 < 4; ++e4)
#pragma unroll
        for (int r = 0; r < 4; ++r) oi[e4][r] = OI[(size_t)(tok0 + ct * 16 + lq * 4 + r) * 512 + h * 128 + (eh * 4 + e4) * 16 + lr];
    const int nc = tid >> 3, npart = tid & 7;
    const bf16_t* gz = (const bf16_t*)(p.ws + OFF_Z) + (size_t)(tok0 + nc) * LDZ + ZGG + h * 128 + npart * 16;
    const u32x4 g0 = *(const u32x4*)gz, g1 = *(const u32x4*)(gz + 8);
    f32x4 onw[4];
#pragma unroll
    for (int i = 0; i < 4; ++i) onw[i] = *(const f32x4*)(p.in[I_ONORM] + l * 128 + npart * 16 + 4 * i);
    __syncthreads();
    bf16x8 af[4];
#pragma unroll
    for (int ks = 0; ks < 4; ++ks) af[ks] = LDSFRAG(Aq + (ct * 16 + lr) * 136 + ks * 32 + lq * 8);
#pragma unroll
    for (int e4 = 0; e4 < 4; ++e4) { const int et = eh * 4 + e4; f32x4 a = {0.f, 0.f, 0.f, 0.f};
#pragma unroll
        for (int ks = 0; ks < 4; ++ks) a = MFMA16(af[ks], LDSFRAG(BT + (et * 16 + lr) * 136 + ks * 32 + lq * 8), a);
#pragma unroll
        for (int r = 0; r < 4; ++r) { const int row = ct * 16 + lq * 4 + r, col = et * 16 + lr; Os[row * 132 + col] = a[r] + bf2f(oi[e4][r]); } }
    __syncthreads();
    { const int c = tid >> 3, part = tid & 7; float o[16]; float ss = 0.f;
#pragma unroll
      for (int i = 0; i < 16; ++i) { o[i] = Os[c * 132 + part * 16 + i]; ss += o[i] * o[i]; }
      ss += __shfl_xor(ss, 1); ss += __shfl_xor(ss, 2); ss += __shfl_xor(ss, 4);
      const float rstd = rsqrtf(ss * (1.f / 128.f) + 1e-6f);
      const unsigned gw[8] = { g0.x, g0.y, g0.z, g0.w, g1.x, g1.y, g1.z, g1.w };
      unsigned ow[8];
#pragma unroll
      for (int i = 0; i < 8; ++i) { const float n0 = onw[i >> 1][(2 * i) & 3], n1 = onw[i >> 1][(2 * i + 1) & 3];
          ow[i] = pk2(o[2 * i] * rstd * n0 * siluf_(lo16(gw[i])), o[2 * i + 1] * rstd * n1 * siluf_(hi16(gw[i]))); }
      bf16_t* ap = (bf16_t*)(p.ws + OFF_AGLA) + (size_t)(tok0 + c) * 512 + h * 128 + part * 16;
      *(u32x4*)ap = (u32x4){ow[0], ow[1], ow[2], ow[3]}; *(u32x4*)(ap + 8) = (u32x4){ow[4], ow[5], ow[6], ow[7]}; }
    __syncthreads();
}
__device__ __forceinline__ void head_row_finish(float (&x)[16], int p8, const float* nw, const float* nw2, bool rope, int pos, const float* R, float mul, LAS bf16_t* dst) {
    float ss = 0.f; const int cnt = p8 < 4 ? 16 : 8;
#pragma unroll
    for (int i = 0; i < 16; ++i) if (i < cnt) ss += x[i] * x[i];
    ss += __shfl_xor(ss, 1); ss += __shfl_xor(ss, 2); ss += __shfl_xor(ss, 4);
    const float rstd = rsqrtf(ss * (1.f / 96.f) + 1e-6f) * mul;
    if (p8 < 4) { unsigned w[8];
#pragma unroll
        for (int i = 0; i < 8; ++i) w[i] = pk2(x[2 * i] * rstd * nw[p8 * 16 + 2 * i] * nw2[p8 * 16 + 2 * i], x[2 * i + 1] * rstd * nw[p8 * 16 + 2 * i + 1] * nw2[p8 * 16 + 2 * i + 1]);
        *(LAS u32x4*)(dst + p8 * 16) = (u32x4){w[0], w[1], w[2], w[3]}; *(LAS u32x4*)(dst + p8 * 16 + 8) = (u32x4){w[4], w[5], w[6], w[7]};
    } else { const int i0 = (p8 - 4) * 4; float o1[4], o2[4];
#pragma unroll
        for (int i = 0; i < 4; ++i) { const float a = x[i] * rstd * nw[64 + i0 + i], b = x[4 + i] * rstd * nw[80 + i0 + i];
            if (rope) { const float c = R[pos * 16 + i0 + i], s = R[16384 + pos * 16 + i0 + i]; o1[i] = a * c - b * s; o2[i] = a * s + b * c; } else { o1[i] = a; o2[i] = b; } }
        *(LAS u32x2*)(dst + 64 + i0) = (u32x2){pk2(o1[0], o1[1]), pk2(o1[2], o1[3])}; *(LAS u32x2*)(dst + 80 + i0) = (u32x2){pk2(o2[0], o2[1]), pk2(o2[2], o2[3])}; }
}
__device__ __forceinline__ void ld16bf(const bf16_t* s, float (&x)[16]) { const u32x4 a = *(const u32x4*)s, b = *(const u32x4*)(s + 8);
    x[0] = lo16(a.x); x[1] = hi16(a.x); x[2] = lo16(a.y); x[3] = hi16(a.y); x[4] = lo16(a.z); x[5] = hi16(a.z); x[6] = lo16(a.w); x[7] = hi16(a.w);
    x[8] = lo16(b.x); x[9] = hi16(b.x); x[10] = lo16(b.y); x[11] = hi16(b.y); x[12] = lo16(b.z); x[13] = hi16(b.z); x[14] = lo16(b.w); x[15] = hi16(b.w); }
__device__ __forceinline__ void ld4bf(const bf16_t* s, float* x) { const u32x2 a = *(const u32x2*)s; x[0] = lo16(a.x); x[1] = hi16(a.x); x[2] = lo16(a.y); x[3] = hi16(a.y); }
__device__ __forceinline__ void job_attn(const Params& p, int l, int j, lds_t lds) {
    const int tid = tid_opaque(p), wid = tid >> 6, lane = tid & 63, lr = lane & 15, lq = lane >> 4;
    const bool smp = j < 128; int b, h, qb; if (smp) { b = j >> 5; h = (j >> 3) & 3; qb = j & 7; } else { const int jj = j - 128; b = jj >> 3; h = (jj >> 1) & 3; qb = jj & 1; }
    const int qtok0 = smp ? 4096 + b * 1024 + qb * 128 : b * 256 + qb * 128; const int nkt = smp ? 12 : 2;
    LAS bf16_t* Ks = (LAS bf16_t*)lds;
    LAS bf16_t* VTs = Ks + 128 * 104;
    LAS bf16_t* Ps = VTs + 128 * 136 + wid * 32 * 72;
    LAS float* Mg = (LAS float*)lds;
    const bf16_t* Z = (const bf16_t*)(p.ws + OFF_Z); const bf16_t* KF = (const bf16_t*)(p.ws + OFF_KF); const bf16_t* Vb = (const bf16_t*)(p.ws + OFF_V); const float* R = (const float*)(p.ws + OFF_ROPE);
    const float* qhn = p.in[I_QHNORM] + l * 96;
    u32x4 kreg[3], vreg[4];
    const int vst = smp ? 1536 : 256; const bf16_t* vtb = smp ? Vb + 2097152 + (size_t)(b * 4 + h) * 128 * 1536 : Vb + (size_t)(b * 4 + h) * 128 * 256;
    auto rowbase = [&](int kt) { return smp ? (kt < 4 ? 8192 + b * 512 + kt * 128 : 4096 + b * 1024 + (kt - 4) * 128) : b * 256 + kt * 128; };
    auto issue = [&](int kt) { const int rb = rowbase(kt);
#pragma unroll
        for (int i = 0; i < 3; ++i) { const int idx = tid + 512 * i, key = idx / 12, part = idx - key * 12; kreg[i] = *(const u32x4*)(KF + (size_t)(rb + key) * 384 + h * 96 + part * 8); }
#pragma unroll
        for (int i = 0; i < 4; ++i) { const int idx = tid + 512 * i, e = idx >> 4, part = idx & 15; vreg[i] = *(const u32x4*)(vtb + (size_t)e * vst + kt * 128 + part * 8); } };
    auto commit = [&]() {
#pragma unroll
        for (int i = 0; i < 3; ++i) { const int idx = tid + 512 * i, key = idx / 12, part = idx - key * 12; *(LAS u32x4*)(Ks + key * 104 + part * 8) = kreg[i]; }
#pragma unroll
        for (int i = 0; i < 4; ++i) { const int idx = tid + 512 * i, e = idx >> 4, part = idx & 15; *(LAS u32x4*)(VTs + e * 136 + part * 8) = vreg[i]; } };
    issue(0);
#pragma unroll
    for (int it = 0; it < 2; ++it) { const int row = it * 64 + (tid >> 3), p8 = tid & 7, tok = qtok0 + row; const bf16_t* qr = (const bf16_t*)(p.ws + OFF_QRAW) + (size_t)tok * 384 + h * 96; float x[16];
      if (p8 < 4) ld16bf(qr + p8 * 16, x); else { ld4bf(qr + 64 + (p8 - 4) * 4, x); ld4bf(qr + 80 + (p8 - 4) * 4, x + 4); }
      head_row_finish(x, p8, qhn, p.in[I_KHNORM] + l * 96, smp, qb * 128 + row, R, 0.10206207261596575f * 1.4426950408889634f, Ks + row * 104); }
    __syncthreads();
    const int rt = wid & 3, kh = wid >> 2;
    bf16x8 qa[2][3];
#pragma unroll
    for (int mt = 0; mt < 2; ++mt)
#pragma unroll
        for (int ks = 0; ks < 3; ++ks) qa[mt][ks] = LDSFRAG(Ks + (rt * 32 + mt * 16 + lr) * 104 + ks * 32 + lq * 8);
    __syncthreads();
    commit();
    __syncthreads();
    f32x4 oacc[2][8]; float mrow[2], lrow[2];
#pragma unroll
    for (int mt = 0; mt < 2; ++mt) {
#pragma unroll
        for (int e = 0; e < 8; ++e) oacc[mt][e] = (f32x4){0.f, 0.f, 0.f, 0.f};
        mrow[mt] = -1e30f; lrow[mt] = 0.f; }
    const int kbase = kh * 64;
    for (int kt = 0; kt < nkt; ++kt) {
        if (kt + 1 < nkt) issue(kt + 1);
        f32x4 sacc[2][4];
#pragma unroll
        for (int nt = 0; nt < 4; ++nt) { sacc[0][nt] = (f32x4){0.f, 0.f, 0.f, 0.f}; sacc[1][nt] = sacc[0][nt];
#pragma unroll
            for (int ks = 0; ks < 3; ++ks) { const bf16x8 kf = LDSFRAG(Ks + (kbase + nt * 16 + lr) * 104 + ks * 32 + lq * 8); sacc[0][nt] = MFMA16(kf, qa[0][ks], sacc[0][nt]); sacc[1][nt] = MFMA16(kf, qa[1][ks], sacc[1][nt]); } }
        bf16x8 pb[2][2];
#pragma unroll
        for (int mt = 0; mt < 2; ++mt) {
            float mx = -1e30f;
#pragma unroll
            for (int nt = 0; nt < 4; ++nt) mx = fmaxf(mx, fmaxf(fmaxf(sacc[mt][nt][0], sacc[mt][nt][1]), fmaxf(sacc[mt][nt][2], sacc[mt][nt][3])));
            mx = fmaxf(mx, __shfl_xor(mx, 16)); mx = fmaxf(mx, __shfl_xor(mx, 32));
            const float mn = fmaxf(mrow[mt], mx), alpha = __builtin_amdgcn_exp2f(mrow[mt] - mn); mrow[mt] = mn;
            float pv[4][4]; float rs = 0.f;
#pragma unroll
            for (int nt = 0; nt < 4; ++nt)
#pragma unroll
                for (int r = 0; r < 4; ++r) { pv[nt][r] = __builtin_amdgcn_exp2f(sacc[mt][nt][r] - mn); rs += pv[nt][r]; }
            lrow[mt] = lrow[mt] * alpha + rs;
#pragma unroll
            for (int k2 = 0; k2 < 2; ++k2) { u32x4 w; w.x = pk2(pv[2 * k2][0], pv[2 * k2][1]); w.y = pk2(pv[2 * k2][2], pv[2 * k2][3]); w.z = pk2(pv[2 * k2 + 1][0], pv[2 * k2 + 1][1]); w.w = pk2(pv[2 * k2 + 1][2], pv[2 * k2 + 1][3]);
                pb[mt][k2] = __builtin_bit_cast(bf16x8, w); }
#pragma unroll
            for (int e = 0; e < 8; ++e) oacc[mt][e] *= alpha; }
#pragma unroll
        for (int k2 = 0; k2 < 2; ++k2)
#pragma unroll
            for (int e = 0; e < 8; ++e) { const LAS bf16_t* vp = VTs + (e * 16 + lr) * 136 + kbase + k2 * 32 + 4 * lq;
                const u32x2 lo = *(const LAS u32x2*)vp, hi = *(const LAS u32x2*)(vp + 16);
                const bf16x8 vf = __builtin_bit_cast(bf16x8, (u32x4){lo.x, lo.y, hi.x, hi.y});
                oacc[0][e] = MFMA16(vf, pb[0][k2], oacc[0][e]); oacc[1][e] = MFMA16(vf, pb[1][k2], oacc[1][e]); }
        __syncthreads();
        if (kt + 1 < nkt) { commit(); __syncthreads(); }
    }
#pragma unroll
    for (int mt = 0; mt < 2; ++mt) { float s_ = lrow[mt]; s_ += __shfl_xor(s_, 16); s_ += __shfl_xor(s_, 32); lrow[mt] = s_; }
    LAS float* Mo = Mg + rt * 32 * 132; LAS float* Ml = Mg + 4 * 32 * 132 + rt * 64;
    if (kh == 1) {
#pragma unroll
        for (int mt = 0; mt < 2; ++mt) {
#pragma unroll
            for (int e = 0; e < 8; ++e) *(LAS f32x4*)(Mo + (mt * 16 + lr) * 132 + e * 16 + 4 * lq) = oacc[mt][e];
            if (lq == 0) { Ml[(mt * 16 + lr) * 2] = mrow[mt]; Ml[(mt * 16 + lr) * 2 + 1] = lrow[mt]; } }
    }
    __syncthreads();
    if (kh == 0) { bf16_t* AM = (bf16_t*)(p.ws + OFF_AMLA);
#pragma unroll
        for (int mt = 0; mt < 2; ++mt) { const int row = mt * 16 + lr, tok = qtok0 + rt * 32 + row;
            u32x2 gt[8];
#pragma unroll
            for (int e = 0; e < 8; ++e) gt[e] = *(const u32x2*)(Z + (size_t)tok * LDZ + ZMG + h * 128 + e * 16 + 4 * lq);
            const float m2 = Ml[row * 2], l2 = Ml[row * 2 + 1]; const float mm = fmaxf(mrow[mt], m2), a1 = __builtin_amdgcn_exp2f(mrow[mt] - mm), a2 = __builtin_amdgcn_exp2f(m2 - mm);
            const float inv = 1.f / (lrow[mt] * a1 + l2 * a2);
#pragma unroll
            for (int e = 0; e < 8; ++e) { const f32x4 o2 = *(const LAS f32x4*)(Mo + row * 132 + e * 16 + 4 * lq); float o[4];
#pragma unroll
                for (int r = 0; r < 4; ++r) o[r] = (oacc[mt][e][r] * a1 + o2[r] * a2) * inv;
                const float g0 = lo16(gt[e].x), g1 = hi16(gt[e].x), g2 = lo16(gt[e].y), g3 = hi16(gt[e].y);
                *(u32x2*)(AM + (size_t)tok * 512 + h * 128 + e * 16 + 4 * lq) = (u32x2){pk2(o[0] * siluf_(g0), o[1] * siluf_(g1)), pk2(o[2] * siluf_(g2), o[3] * siluf_(g3))}; } } }
    __syncthreads();
}


#define XB_TMO      128
#define XB_XCNT(j)  (256  + 64 * (j))
#define XB_XSUB(j)  (1280 + 64 * (j))
#define XB_XGEN(j)  (2304 + 64 * (j))
#define XB_TOP      3328
#define XB_TOPGEN   3392
#define XCD_BAR_WORDS 3456
#define XB_SPIN_CAP (1u << 18)

__device__ __forceinline__ unsigned xb_ld(unsigned* p)              { return __hip_atomic_load(p, __ATOMIC_RELAXED, __HIP_MEMORY_SCOPE_AGENT); }
__device__ __forceinline__ unsigned xb_add(unsigned* p, unsigned v) { return __hip_atomic_fetch_add(p, v, __ATOMIC_RELAXED, __HIP_MEMORY_SCOPE_AGENT); }
__device__ __forceinline__ unsigned xb_xcc_id() { return (unsigned)__builtin_amdgcn_s_getreg((3 << 11) | 20) & 0xFu; }
#define XB_SPIN(cond, bar) do { unsigned _sp = 0; while (cond) { __builtin_amdgcn_s_sleep(1); \
    if ((++_sp & 255u) == 0u) { if (xb_ld(&(bar)[XB_TMO])) break; if (_sp > XB_SPIN_CAP) { atomicAdd(&(bar)[XB_TMO], 1u); break; } } } } while (0)

struct XcdBarrier {
    int wid; unsigned* bar; unsigned x;
    volatile LAS unsigned* st;
};

__device__ __forceinline__ XcdBarrier xcd_barrier_post(unsigned* bar, volatile LAS unsigned* st) {
    XcdBarrier b; b.bar = bar; b.x = xb_xcc_id(); b.st = st;
    if (threadIdx.x == 0) (void)xb_add(&bar[XB_XCNT(b.x)], 1u);
    return b;
}
__device__ __forceinline__ void xcd_barrier_complete(unsigned* bar, unsigned x, unsigned& nloc, unsigned& nx) {
    const unsigned G = gridDim.x * gridDim.y * gridDim.z;
    unsigned sum, cnt, mine, sp = 0u;
    for (;;) {
        sum = 0u; cnt = 0u; mine = 0u;
#pragma unroll
        for (unsigned j = 0; j < 16; ++j) { const unsigned c = xb_ld(&bar[XB_XCNT(j)]); sum += c; cnt += (c > 0u) ? 1u : 0u; mine = (j == x) ? c : mine; }
        if (sum == G) break;
        __builtin_amdgcn_s_sleep(1);
        if ((++sp & 255u) == 0u) { if (xb_ld(&bar[XB_TMO])) break; if (sp > XB_SPIN_CAP) { atomicAdd(&bar[XB_TMO], 1u); break; } }
    }
    nloc = mine > 0u ? mine : 1u; nx = cnt > 0u ? cnt : 1u;
}

__device__ __forceinline__ void xcd_barrier(const XcdBarrier& b) {
    asm volatile("s_waitcnt vmcnt(0)" ::: "memory");
    __syncthreads();
    if (b.wid == 0 && lane_id_() == 0) {
        unsigned* bar = b.bar;
        __builtin_amdgcn_s_waitcnt(0);
        unsigned nloc = b.st[0], nx = b.st[1];
        if (nloc == 0u) { xcd_barrier_complete(bar, b.x, nloc, nx); b.st[0] = nloc; b.st[1] = nx; }
        const unsigned old = xb_add(&bar[XB_XSUB(b.x)], 1u);
        const unsigned gen = old / nloc;
        if (old + 1u == (gen + 1u) * nloc) {
            __builtin_amdgcn_fence(__ATOMIC_RELEASE, "agent");
            asm volatile("s_waitcnt vmcnt(0)" ::: "memory");
            const unsigned og = xb_add(&bar[XB_TOP], 1u);
            const unsigned tg = og / nx;
            if (og + 1u == (tg + 1u) * nx) xb_add(&bar[XB_TOPGEN], 1u);
            else XB_SPIN(xb_ld(&bar[XB_TOPGEN]) == tg, bar);
            __builtin_amdgcn_fence(__ATOMIC_ACQUIRE, "agent");
            xb_add(&bar[XB_XGEN(b.x)], 1u);
            asm volatile("s_waitcnt vmcnt(0)" ::: "memory");
        } else {
            XB_SPIN(xb_ld(&bar[XB_XGEN(b.x)]) == gen, bar);
            __builtin_amdgcn_fence(__ATOMIC_ACQUIRE, "agent");
            asm volatile("s_waitcnt vmcnt(0)" ::: "memory");
        }
    }
    __syncthreads();
}

constexpr int N_PHASES = 15;
#ifndef S3SEL
#define S3SEL 15
#endif
#ifndef REPEAT_MASK
#define REPEAT_MASK 0xff
#endif
#ifndef ONLY_S
#define ONLY_S -1
#endif
__device__ __forceinline__ void run_phase(const Params& p, int ph, lds_t lds, int mask = 0xff) {
    const int G = (int)gridDim.x, bid = (int)blockIdx.x;
    if (ph == 0 && (ONLY_S < 0 || ONLY_S == 7)) {
        for (int j = bid; j < 96 + 192 + 256 + 32; j += G) { if (j < 96) job_s5setup(p, 0, j, lds); else if (j < 288) job_ada(p, j - 96, lds); else if (j < 544) job_ctx(p, j - 288); else job_rope(p, j - 544); }
        return;
    }
    const int l = (ph - 1) / 7, s = (ph - 1) % 7;
    unsigned char* ws = p.ws;
    if (s == 0 && (ONLY_S < 0 || ONLY_S == 0)) {
        if (l == 0 || G < 256) { for (int j = bid; j < 96 + WT_TOTAL + 1024; j += G) { if (j < 96) { if ((mask & 1) && l > 0) job_s5setup(p, l, j, lds); } else if (j < 96 + WT_TOTAL) { if (mask & 2) job_wt(p, l, j - 96, lds); } else if (mask & 4) job_prep(p, l, j - 96 - WT_TOTAL); } }
        else { for (int j = bid; j < WT_WOUT + 1024; j += G) { if (j < WT_WOUT) job_wt(p, l, WT_EARLY + 3 * WT_WBO + j, lds); else job_prep(p, l, j - WT_WOUT); } }
    } else if (s == 1 && (ONLY_S < 0 || ONLY_S == 1)) {
        Order S; S.setup(8192, 4096, 0, p.wid); pg8::Gemm g{(const bf16_t*)(ws + OFF_HB), (const bf16_t*)(ws + OFF_WIN), 8192, 4096, 1024}; EpiZ E{(bf16_t*)(ws + OFF_Z)};
        pg8::gemm_phase<EpiZ, Order>(lds, g, S, E, nullptr);
    } else if (s == 2 && (ONLY_S < 0 || ONLY_S == 2)) {
        if (G == 256) {
            if (mask & 1) for (int k = bid >> 3; k < 80; k += 32) { const int q = k >> 2, bb = q < 4 ? 16 + q : q - 4; job_s5(p, l, bb * 32 + 4 * (bid & 7) + (k & 3), lds); }
            if (mask & 2) { job_glaA(p, l, bid, lds); job_glaA(p, l, 256 + bid, lds); }
            if ((mask & 4) && bid >= 128) for (int j = bid - 128; j < 1024; j += 128) job_mlaprep(p, l, j);
        } else for (int j = bid; j < 640 + 512 + 1024; j += G) { if (j < 640) { if (mask & 1) job_s5(p, l, j < 128 ? 512 + j : j - 128, lds); } else if (j < 1152) { if (mask & 2) job_glaA(p, l, j - 640, lds); } else if (mask & 4) job_mlaprep(p, l, j - 1152); }
    } else if (s == 3 && (ONLY_S < 0 || ONLY_S == 3)) {
        if (mask & 1) for (int j = bid; j < 640; j += G) job_glaB(p, l, j);
        if (mask & 16) { Order S; S.setup(8192, 2816, 0, p.wid); pg8::Gemm g{(const bf16_t*)(ws + OFF_HB), (const bf16_t*)(ws + OFF_WIN) + (size_t)4096 * 1024, 8192, 2816, 1024}; EpiZ E{(bf16_t*)(ws + OFF_Z) + 4096};
          pg8::gemm_phase<EpiZ, Order>(lds, g, S, E, nullptr); }
        if ((mask & 2) && (S3SEL & 2)) { Order S; S.setup(8192, 1024, 160, p.wid); pg8::Gemm g{(const bf16_t*)(ws + OFF_YG), (const bf16_t*)(ws + OFF_WGLU), 8192, 1024, 512}; EpiGLU E{(bf16_t*)(ws + OFF_AS5), (const bf16_t*)(ws + OFF_Z), p.in[I_BGLU] + l * 1024};
          pg8::gemm_phase<EpiGLU, Order>(lds, g, S, E, nullptr); }
        if ((mask & 4) && (S3SEL & 4)) { Order S; S.setup(10240, 768, 120, p.wid); pg8::Gemm g{(const bf16_t*)(ws + (l == 0 ? OFF_CTX0 : OFF_CKVN)), (const bf16_t*)(ws + OFF_WKV), 10240, 768, 256}; EpiKV E{(bf16_t*)(ws + OFF_KF), (bf16_t*)(ws + OFF_V), l, (const bf16_t*)(ws + OFF_Z), p.in[I_CKR], p.in[I_KHNORM] + l * 96, (const float*)(ws + OFF_ROPE)};
          pg8::gemm_phase<EpiKV, Order>(lds, g, S, E, nullptr); }
        if ((mask & 8) && (S3SEL & 8)) { Order S; S.setup(8192, 512, 160, p.wid); pg8::Gemm g{(const bf16_t*)(ws + OFF_AQ), (const bf16_t*)(ws + OFF_WUQ), 8192, 512, 384}; EpiQ E{(bf16_t*)(ws + OFF_QRAW)};
          pg8::gemm_phase<EpiQ, Order>(lds, g, S, E, nullptr); }
    } else if (s == 4 && (ONLY_S < 0 || ONLY_S == 4)) {
        if (G == 256) {
            if (bid < 128) { const int slot = bid >> 3, pair = 2 * (bid & 7) + (slot >> 3);
                if (mask & 1) job_attn(p, l, pair * 8 + (slot & 7), lds); }
            else { const int k = bid - 128; if (mask & 1) job_attn(p, l, 128 + k, lds); if (mask & 2) { job_glaC(p, l, k, lds); job_glaC(p, l, 128 + k, lds); job_glaC(p, l, 256 + k, lds); job_glaC(p, l, 384 + k, lds); } }
        } else for (int j = bid; j < 256 + 512; j += G) { if (j < 256) { if (mask & 1) job_attn(p, l, j, lds); } else if (mask & 2) job_glaC(p, l, j - 256, lds); }
    } else if (s == 5 && (ONLY_S < 0 || ONLY_S == 5)) {
        if (l == 0 && mask == 0xff && G >= 256 && bid >= 128) { for (int j = bid - 128; j < 96 + WT_EARLY; j += G - 128) { if (j < 96) job_s5setup(p, 1, j, lds); else job_wt(p, 1, j - 96, lds); } }
        for (int br = 0; br < 3; ++br) { Order S; S.setup(8192, 1024, 0, p.wid);
            pg8::Gemm g{(const bf16_t*)(ws + (br == 0 ? OFF_AGLA : br == 1 ? OFF_AMLA : OFF_AS5)), (const bf16_t*)(ws + OFF_WBO) + (size_t)br * 1024 * 512, 8192, 1024, 512};
            EpiBo E{(bf16_t*)(ws + OFF_HB), (const bf16_t*)(ws + OFF_Z), br};
            pg8::gemm_phase<EpiBo, Order>(lds, g, S, E, nullptr); }
    } else if (s == 6 && (ONLY_S < 0 || ONLY_S == 6)) {
        if (l == 0 && mask == 0xff && G >= 256 && bid >= 128) { for (int j = bid - 128; j < 3 * WT_WBO; j += G - 128) job_wt(p, 1, WT_EARLY + j, lds); }
        Order S; S.setup(8192, 1024, 0, p.wid); pg8::Gemm g{(const bf16_t*)(ws + OFF_HB), (const bf16_t*)(ws + OFF_WOUT), 8192, 1024, 1024};
        EpiOut E{p.out, l == 0 ? p.in[I_XP] : p.out, l == 0 ? p.in[I_XS] : p.out + (size_t)4096 * 1024, (const float*)(ws + OFF_ADA) + l * 5 * 3072};
        pg8::gemm_phase<EpiOut, Order>(lds, g, S, E, nullptr);
    }
}
__global__ __launch_bounds__(512, 2) void mega(KParams kp, int ph0, int ph1) {
    extern __shared__ __attribute__((aligned(16))) unsigned char shm[];
    lds_t lds = (lds_t)shm;
    if (threadIdx.x < N_IN) ((const float**)(kp.ws + OFF_TBL))[threadIdx.x] = kp.in[threadIdx.x];
    const int wid0 = __builtin_amdgcn_readfirstlane((int)threadIdx.x >> 6);
    volatile LAS unsigned* xst = (volatile LAS unsigned*)(lds + DYN_LDS - 16);
    if (threadIdx.x == 0) { xst[0] = 0u; xst[1] = 0u; }
    __threadfence(); __syncthreads();
    XcdBarrier xb = xcd_barrier_post((unsigned*)(kp.ws + OFF_BAR), xst);
    xb.wid = wid0;
    if (ph0 > ph1) cg::this_grid().sync();
    for (int ph = ph0; ph < ph1; ++ph) {
        Params p; p.wid = wid0; { const float* const* tb = (const float* const*)(kp.ws + OFF_TBL); float* o = kp.out; unsigned char* w = kp.ws; asm volatile("" : "+s"(tb), "+s"(o), "+s"(w)); p.in = tb; p.out = o; p.ws = w; }
        int nrep = 1;
#ifdef REPEAT_S
        if ((REPEAT_S == 7 && ph == 0) || (ph > 0 && (ph - 1) % 7 == REPEAT_S && (REPEAT_S != 6 || ph < 8))) nrep = 2;
#endif
        for (int rep = 0; rep < nrep; ++rep) { if (rep) xcd_barrier(xb); run_phase(p, ph, lds, rep ? REPEAT_MASK : 0xff); }
        if (ph + 1 < ph1) xcd_barrier(xb);
    }
}

#ifndef N_LAUNCH_MODE
#define N_LAUNCH_MODE 1
#endif
extern "C" void kernel_launch(void* const* d_in, const int* in_sizes, int n_in, void* d_out, int out_size, void* d_ws, size_t ws_size, hipStream_t stream) {
    static int grid = 0;
    if (grid == 0) {
        if (n_in != N_IN || ws_size < WS_END) { fprintf(stderr, "kernel_launch: unexpected n_in %d / ws %zu (need %zu)\n", n_in, ws_size, (size_t)WS_END); grid = -1; return; }
        int dev = 0, cus = 0, per_cu = 0;
        hipGetDevice(&dev); hipDeviceGetAttribute(&cus, hipDeviceAttributeMultiprocessorCount, dev);
        hipFuncSetAttribute((const void*)mega, hipFuncAttributeMaxDynamicSharedMemorySize, DYN_LDS);
        hipOccupancyMaxActiveBlocksPerMultiprocessor(&per_cu, (const void*)mega, 512, DYN_LDS);
        if (per_cu < 1) { fprintf(stderr, "kernel_launch: occupancy query says %d blocks per CU\n", per_cu); per_cu = 1; }
        (void)hipGetLastError();
        grid = cus;
    }
    if (grid < 0) return;
    hipMemsetAsync((char*)d_ws + OFF_BAR, 0, 16384, stream);
    KParams p{};
    for (int i = 0; i < N_IN; ++i) p.in[i] = (const float*)d_in[i];
    p.out = (float*)d_out; p.ws = (unsigned char*)d_ws;
#if N_LAUNCH_MODE == 0
    for (int ph = 0; ph < N_PHASES; ++ph) { hipLaunchKernelGGL(mega, dim3(grid), dim3(512), DYN_LDS, stream, p, ph, ph + 1); }
#else
    int ph0 = 0, ph1 = N_PHASES; void* args[] = {&p, &ph0, &ph1};
    hipError_t e = hipLaunchCooperativeKernel((const void*)mega, dim3(grid), dim3(512), args, DYN_LDS, stream);
    if (e != hipSuccess) fprintf(stderr, "cooperative launch failed: %s (grid %d)\n", hipGetErrorString(e), grid);
#endif
}
```

```cpp
#include <hip/hip_runtime.h>
#include <hip/hip_cooperative_groups.h>
#include <cstdio>
namespace cg = cooperative_groups;
namespace pg8 {
#define PG8_LAS __attribute__((address_space(3)))
typedef unsigned short bf16_t;
typedef short bf16x8 __attribute__((ext_vector_type(8)));
typedef float f32x4 __attribute__((ext_vector_type(4)));
typedef unsigned u32x4 __attribute__((ext_vector_type(4)));
constexpr int BM = 256, BK = 64, HALF = 128, HTB = HALF * BK * 2  , STAGE_BYTES = 8 * HTB, NXCD = 8, WGM = 8;

__host__ __device__ __forceinline__ int lds_byte(int r, int c) { const int st = (r >> 4) * 2 + (c >> 5), rr = r & 15, cc = c & 31, ob = rr * 64 + cc * 2; return st * 1024 + (ob ^ (((ob >> 9) & 1) << 5)); }
__host__ __device__ __forceinline__ void stage_rc(int b, int& R, int& C) { const int st = b / 1024, sb = b % 1024, swz = sb ^ (((sb >> 9) & 1) << 5); R = (st >> 1) * 16 + swz / 64; C = (st & 1) * 32 + (swz % 64) / 2; }
__host__ __device__ __forceinline__ int perm32(int rho) { const int n = rho >> 4, i = rho & 15; return 8 * (i >> 2) + 4 * n + (i & 3); }

struct Unit { int pm, pn; };
struct Gemm { const bf16_t* A; const bf16_t* Bt; int M, N, K; };

struct StaticOrder {
    int nM, nN, nwg, G, c;
    __host__ __device__ void init(int M, int N, int G_, int c_) { nM = M / BM; nN = N / BM; nwg = nM * nN; G = G_; c = c_; }
    __host__ __device__ bool next(int i, Unit& u) const {
        const long L = (long)i * G + c; if (L >= nwg) return false;
        int wgid = (int)L; { const int q = nwg / NXCD, r = nwg % NXCD, xcd = wgid % NXCD, off = wgid / NXCD; wgid = (xcd < r ? xcd * (q + 1) : r * (q + 1) + (xcd - r) * q) + off; }
        const int nig = WGM * nN, gid = wgid / nig, fm = gid * WGM, gsz = (nM - fm) < WGM ? (nM - fm) : WGM;
        u.pm = fm + ((wgid % nig) % gsz); u.pn = (wgid % nig) / gsz; return true;
    }
    __device__ __forceinline__ void a_ready(const Unit&) const {}
    __device__ __forceinline__ void done(const Unit&) const {}
};
__device__ __forceinline__ unsigned cvt_pk_bf16(float lo, float hi) { unsigned r; asm volatile("v_cvt_pk_bf16_f32 %0, %1, %2" : "=v"(r) : "v"(lo), "v"(hi)); return r; }
typedef float f32x2 __attribute__((ext_vector_type(2)));
template <class Epi, class Sched, bool STAMP = false>
__device__ __forceinline__ void gemm_phase(PG8_LAS unsigned char* lds, const Gemm g, const Sched& S, const Epi& E, unsigned long long* stamps) {
    int tid_ = (S.wid << 6) | (int)__builtin_amdgcn_mbcnt_hi(~0u, __builtin_amdgcn_mbcnt_lo(~0u, 0u)); asm volatile("" : "+v"(tid_)); const int tid = tid_, wid = __builtin_amdgcn_readfirstlane(tid >> 6), lane = tid & 63, wr = wid >> 2, wc = wid & 3, fr = lane & 15, fq = lane >> 4;
    int K_ = g.K; asm volatile("" : "+s"(K_)); const int K = K_, nt = K / BK;
    int ts_lo = 0, ts_hi = 0, nts = 0; const unsigned long long rt_entry = STAMP ? (unsigned long long)wall_clock64() : 0ull;
#define PG8_STAMP() do { if (STAMP && wid == 0 && nts < 64) { const unsigned long long _c = (unsigned long long)clock64(); \
        ts_lo = (lane == nts) ? (int)(unsigned)_c : ts_lo; ts_hi = (lane == nts) ? (int)(unsigned)(_c >> 32) : ts_hi; ++nts; } } while (0)
    PG8_STAMP();
    unsigned voffA[2], voffB[2];
#pragma unroll
    for (int i = 0; i < 2; ++i) { int R, C; stage_rc(tid * 16 + i * 8192, R, C); const int Rb = Epi::PERM ? ((R & ~31) + perm32(R & 31)) : R;
        voffA[i] = (unsigned)(R * K + C) * 2u; voffB[i] = (unsigned)(Rb * K + C) * 2u; }
    const size_t kstep = (size_t)(BK * 2);
    const size_t hstep = (size_t)HALF * K * 2;
    const size_t tstep = 2 * hstep;
    const unsigned ldsw = (unsigned)wid * 1024u;
    const int aoff = lds_byte(wr * 64 + fr, fq * 8), boff = lds_byte(wc * 32 + fr, fq * 8);
#define PG8_SA(b, h) (((b) * 2 + (h)) * HTB)
#define PG8_SB(b, h) ((4 + (b) * 2 + (h)) * HTB)
#define PG8_STAGE(bufoff, gbase, voff) do { _Pragma("unroll") for (int _i = 0; _i < 2; ++_i) \
        __builtin_amdgcn_global_load_lds((const unsigned*)((const char*)(gbase) + (voff)[_i]), (PG8_LAS unsigned*)(lds + (bufoff) + ldsw + _i * 8192), 16, 0, 0); } while (0)
#define PG8_LDA(dst, b, h) do { _Pragma("unroll") for (int m = 0; m < 4; ++m) _Pragma("unroll") for (int k = 0; k < 2; ++k) dst[m][k] = *(const PG8_LAS bf16x8*)(lds + PG8_SA(b, h) + aoff + m * 2048 + k * 1024); } while (0)
#define PG8_LDB(dst, b, h) do { _Pragma("unroll") for (int n = 0; n < 2; ++n) _Pragma("unroll") for (int k = 0; k < 2; ++k) dst[n][k] = *(const PG8_LAS bf16x8*)(lds + PG8_SB(b, h) + boff + n * 2048 + k * 1024); } while (0)
#define PG8_MMA(ai, bj, At, Bt) do { __builtin_amdgcn_s_setprio(1); _Pragma("unroll") for (int m = 0; m < 4; ++m) _Pragma("unroll") for (int n = 0; n < 2; ++n) _Pragma("unroll") for (int k = 0; k < 2; ++k) \
        acc[ai][bj][m][n] = __builtin_amdgcn_mfma_f32_16x16x32_bf16(Bt[n][k], At[m][k], acc[ai][bj][m][n], 0, 0, 0); __builtin_amdgcn_s_setprio(0); } while (0)
#define PG8_WAIT_V(n) asm volatile("s_waitcnt vmcnt(" #n ")" ::: "memory")
#define PG8_WAIT_L(n) asm volatile("s_waitcnt lgkmcnt(" #n ")" ::: "memory")
#define PG8_BAR __builtin_amdgcn_s_barrier()
#define PG8_SCHED __builtin_amdgcn_sched_barrier(0)
    Unit cur, nxt; int ui = 0;
    if (!S.next(0, cur)) return;
    f32x4 acc[2][2][4][2];
#pragma unroll
    for (int a = 0; a < 2; ++a)
#pragma unroll
        for (int b = 0; b < 2; ++b)
#pragma unroll
            for (int m = 0; m < 4; ++m)
#pragma unroll
                for (int n = 0; n < 2; ++n) acc[a][b][m][n] = (f32x4){0.f, 0.f, 0.f, 0.f};
    bf16x8 At[4][2], B0[2][2], B1[2][2];
    const char* cA = (const char*)g.A + (size_t)cur.pm * tstep; const char* cB = (const char*)g.Bt + (size_t)cur.pn * tstep;
    S.a_ready(cur);
    PG8_STAGE(PG8_SB(0, 0), cB, voffB); PG8_STAGE(PG8_SA(0, 0), cA, voffA); PG8_STAGE(PG8_SB(0, 1), cB + hstep, voffB); PG8_STAGE(PG8_SA(0, 1), cA + hstep, voffA);
    if (wr == 1) PG8_BAR;
    PG8_WAIT_V(4); PG8_BAR;
    PG8_STAGE(PG8_SB(1, 0), cB + kstep, voffB); PG8_STAGE(PG8_SA(1, 0), cA + kstep, voffA); PG8_STAGE(PG8_SB(1, 1), cB + hstep + kstep, voffB);
    PG8_WAIT_V(6); PG8_BAR;
    PG8_STAMP();
    for (;;) {
        const bool has_next = S.next(ui + 1, nxt);
        const char* nA = has_next ? (const char*)g.A + (size_t)nxt.pm * tstep : cA; const char* nB = has_next ? (const char*)g.Bt + (size_t)nxt.pn * tstep : cB;
        for (int t = 0; t < nt; t += 2) {
            const bool last = (t == nt - 2);
            const char* a1 = cA + (size_t)(t + 1) * kstep;
            const char* a2 = last ? nA : cA + (size_t)(t + 2) * kstep; const char* b2 = last ? nB : cB + (size_t)(t + 2) * kstep;
            const char* a3 = a2 + kstep; const char* b3 = b2 + kstep;
            if (last && has_next) S.a_ready(nxt);
            PG8_LDB(B0, 0, 0); PG8_SCHED; PG8_LDA(At, 0, 0); PG8_STAGE(PG8_SA(1, 1), a1 + hstep, voffA);
            PG8_WAIT_L(8); PG8_BAR; PG8_WAIT_L(0); PG8_MMA(0, 0, At, B0); PG8_BAR; PG8_SCHED;
            PG8_LDB(B1, 0, 1); PG8_STAGE(PG8_SB(0, 0), b2, voffB);
            PG8_BAR; PG8_WAIT_L(0); PG8_MMA(0, 1, At, B1); PG8_BAR;
            PG8_LDA(At, 0, 1); PG8_STAGE(PG8_SA(0, 0), a2, voffA);
            PG8_BAR; PG8_WAIT_L(0); PG8_MMA(1, 0, At, B0); PG8_BAR; PG8_SCHED;
            PG8_STAGE(PG8_SB(0, 1), b2 + hstep, voffB);
            PG8_WAIT_V(6); PG8_BAR; PG8_MMA(1, 1, At, B1); PG8_BAR;
            PG8_LDB(B0, 1, 0); PG8_SCHED; PG8_LDA(At, 1, 0); PG8_STAGE(PG8_SA(0, 1), a2 + hstep, voffA);
            PG8_WAIT_L(8); PG8_BAR; PG8_WAIT_L(0); PG8_MMA(0, 0, At, B0); PG8_BAR; PG8_SCHED;
            PG8_LDB(B1, 1, 1); PG8_STAGE(PG8_SB(1, 0), b3, voffB);
            PG8_BAR; PG8_WAIT_L(0); PG8_MMA(0, 1, At, B1); PG8_BAR;
            PG8_LDA(At, 1, 1); PG8_STAGE(PG8_SA(1, 0), a3, voffA);
            PG8_BAR; PG8_WAIT_L(0); PG8_MMA(1, 0, At, B0); PG8_BAR; PG8_SCHED;
            PG8_STAGE(PG8_SB(1, 1), b3 + hstep, voffB);
            PG8_WAIT_V(6); PG8_BAR; PG8_MMA(1, 1, At, B1); PG8_BAR;
        }
        PG8_STAMP();
        if constexpr (!Epi::AFTER_DRAIN) { E(acc, cur, wr, wc, fr, fq); S.done(cur); }
        PG8_STAMP();
        if (!has_next) break;
#pragma unroll
        for (int a = 0; a < 2; ++a)
#pragma unroll
            for (int b = 0; b < 2; ++b)
#pragma unroll
                for (int m = 0; m < 4; ++m)
#pragma unroll
                    for (int n = 0; n < 2; ++n) acc[a][b][m][n] = (f32x4){0.f, 0.f, 0.f, 0.f};
        cur = nxt; cA = nA; cB = nB; ++ui;
    }
    PG8_WAIT_V(0);
    if (wr == 0) PG8_BAR;
    PG8_BAR;
    if constexpr (Epi::AFTER_DRAIN) { E.fused(acc, cur, wr, wc, fr, fq, lds, wid, lane); S.done(cur); }
    PG8_STAMP();
    if (STAMP && wid == 0) { stamps[lane] = lane < nts ? (((unsigned long long)(unsigned)ts_hi << 32) | (unsigned)ts_lo) : 0ull;
        if (lane == 62) stamps[62] = rt_entry; if (lane == 63) stamps[63] = (unsigned long long)wall_clock64(); }
#undef PG8_STAMP
#undef PG8_SA
#undef PG8_SB
#undef PG8_STAGE
#undef PG8_LDA
#undef PG8_LDB
#undef PG8_MMA
#undef PG8_WAIT_V
#undef PG8_WAIT_L
#undef PG8_BAR
#undef PG8_SCHED
}
}
using pg8::bf16_t; using pg8::bf16x8; using pg8::f32x4; using pg8::u32x4; using pg8::Unit;
#define LAS __attribute__((address_space(3)))
typedef unsigned u32x2 __attribute__((ext_vector_type(2)));
typedef LAS unsigned char* lds_t;
struct Params;
__device__ __forceinline__ int lane_id_() { return (int)__builtin_amdgcn_mbcnt_hi(~0u, __builtin_amdgcn_mbcnt_lo(~0u, 0u)); }
typedef float f32x2_t __attribute__((ext_vector_type(2)));

enum { I_XP = 0, I_XS, I_C, I_CCTX, I_CKV, I_CKR, I_SGLA, I_SS5, I_NORMW, I_WADA, I_BADA, I_WIN, I_WA2, I_BA, I_ONORM, I_QNORM, I_WUQ, I_KVNORM, I_WUK, I_WUV,
       I_QHNORM, I_KHNORM, I_ARE, I_AIM, I_LOGDT, I_BRE, I_BIM, I_CRE, I_CIM, I_S5D, I_WGLU, I_BGLU, I_WBOG, I_WBOM, I_WBOS, I_WOUT, N_IN };
struct KParams { const float* in[N_IN]; float* out; unsigned char* ws; };
struct Params { const float* const* in; float* out; unsigned char* ws; int wid; };
__device__ __forceinline__ int tid_opaque(const Params& p) { int t = (p.wid << 6) | lane_id_(); asm volatile("" : "+v"(t)); return t; }

constexpr int LDZ = 6912;
constexpr int ZQ = 0, ZK = 256, ZV = 512, ZGA = 1024, ZGG = 1056, ZMQ = 1568, ZMKV = 1952, ZMKR = 2208, ZMG = 2240, ZSU = 2752, ZSG = 3264, ZMERGE = 3776;
constexpr size_t OUT_YP = 0, OUT_CKV = 8388608, OUT_KR = 10485760, OUT_GLA = 10747904, OUT_S5 = 12845056;
constexpr size_t OFF_WIN = 0;

constexpr size_t OFF_WUQ = OFF_WIN + 14155776;
constexpr size_t OFF_WKV = OFF_WUQ + 393216;
constexpr size_t OFF_WGLU = OFF_WKV + 393216;
constexpr size_t OFF_WBO = OFF_WGLU + 1048576;
constexpr size_t OFF_WOUT = OFF_WBO + 3145728;
constexpr size_t OFF_S5M = OFF_WOUT + 2097152;
constexpr size_t OFF_V = OFF_S5M;
constexpr size_t OFF_P16 = OFF_S5M + 12582912;
constexpr size_t OFF_ADA = OFF_P16 + 32768;
constexpr size_t OFF_ROPE = OFF_ADA + 122880;
constexpr size_t OFF_CTX0 = OFF_ROPE + 131072;
constexpr size_t OFF_CKVN = OFF_CTX0 + 1048576;
constexpr size_t OFF_CTX1 = OFF_CKVN + 4194304;
constexpr size_t OFF_HB = OFF_CTX1 + 1048576;
constexpr size_t OFF_Z = OFF_HB + 16777216;
constexpr size_t OFF_KV = OFF_Z + 113246208;
constexpr size_t OFF_AGLA = OFF_KV, OFF_AMLA = OFF_KV + 8388608;
constexpr size_t OFF_QD = OFF_KV + 16777216;
constexpr size_t OFF_OIB = OFF_QD + 8388608;
constexpr size_t OFF_DEC = OFF_KV + 33554432;
constexpr size_t OFF_ST = OFF_DEC + 262144;
constexpr size_t OFF_AQ = OFF_ST + 16777216;
constexpr size_t OFF_QRAW = OFF_AQ + 6291456;
constexpr size_t OFF_AS5 = OFF_QRAW + 6291456;
constexpr size_t OFF_YG = OFF_AS5 + 8388608;
constexpr size_t OFF_TBL = OFF_YG + 8388608;
constexpr size_t OFF_BAR = OFF_TBL + 512;
constexpr size_t OFF_KF = OFF_BAR + 16384;
constexpr size_t WS_END = OFF_KF + 7864320;
constexpr int DYN_LDS = 147456;

__device__ __forceinline__ float bf2f(bf16_t b) { return __uint_as_float(((unsigned)b) << 16); }
__device__ __forceinline__ bf16_t f2bf(float f) { unsigned u = __float_as_uint(f); u += 0x7FFFu + ((u >> 16) & 1u); return (bf16_t)(u >> 16); }
__device__ __forceinline__ unsigned pk2(float lo, float hi) { return pg8::cvt_pk_bf16(lo, hi); }
__device__ __forceinline__ float lo16(unsigned w) { return __uint_as_float(w << 16); }
__device__ __forceinline__ float hi16(unsigned w) { return __uint_as_float(w & 0xffff0000u); }
__device__ __forceinline__ float sigmoidf_(float x) { return 1.f / (1.f + __expf(-x)); }
__device__ __forceinline__ float siluf_(float x) { return x / (1.f + __expf(-x)); }
__device__ __forceinline__ void store8(bf16_t* p, const f32x4& a, const f32x4& b) { u32x4 w; w.x = pk2(a[0], a[1]); w.y = pk2(a[2], a[3]); w.z = pk2(b[0], b[1]); w.w = pk2(b[2], b[3]); *(u32x4*)p = w; }
#define MFMA16(a, b, c) __builtin_amdgcn_mfma_f32_16x16x32_bf16(a, b, c, 0, 0, 0)
#define LDSFRAG(ptr) (*(const LAS bf16x8*)(ptr))

struct Order : pg8::StaticOrder { int wid;
    __device__ void setup(int M, int N, int rot, int wid_) { wid = wid_; const int G = (int)gridDim.x; init(M, N, G, (int)((blockIdx.x + (unsigned)rot) % (unsigned)G)); }
};

struct EpiZ { static constexpr bool PERM = true, AFTER_DRAIN = false; bf16_t* Z;
    __device__ __forceinline__ void operator()(const f32x4 (&acc)[2][2][4][2], const Unit& u, int wr, int wc, int fr_, int fq_) const {
        int fr = fr_, fq = fq_; asm volatile("" : "+v"(fr), "+v"(fq));
        const int row0 = u.pm * 256 + wr * 64 + fr, col0 = u.pn * 256 + wc * 32 + 8 * fq;
#pragma unroll
        for (int ai = 0; ai < 2; ++ai)
#pragma unroll
            for (int m = 0; m < 4; ++m) { bf16_t* rp = Z + (size_t)(row0 + ai * 128 + m * 16) * LDZ + col0;
#pragma unroll
                for (int bj = 0; bj < 2; ++bj) store8(rp + bj * 128, acc[ai][bj][m][0], acc[ai][bj][m][1]); }
    } };
struct EpiQ { static constexpr bool PERM = true, AFTER_DRAIN = false; bf16_t* Q;
    __device__ __forceinline__ void operator()(const f32x4 (&acc)[2][2][4][2], const Unit& u, int wr, int wc, int fr_, int fq_) const {
        int fr = fr_, fq = fq_; asm volatile("" : "+v"(fr), "+v"(fq));
        const int row0 = u.pm * 256 + wr * 64 + fr, col0 = u.pn * 256 + wc * 32 + 8 * fq;
#pragma unroll
        for (int ai = 0; ai < 2; ++ai)
#pragma unroll
            for (int m = 0; m < 4; ++m) { bf16_t* rp = Q + (size_t)(row0 + ai * 128 + m * 16) * 384 + col0;
#pragma unroll
                for (int bj = 0; bj < 2; ++bj) if (col0 + bj * 128 < 384) store8(rp + bj * 128, acc[ai][bj][m][0], acc[ai][bj][m][1]);
                }
    } };
struct EpiKV { static constexpr bool PERM = true, AFTER_DRAIN = true; bf16_t* KF; bf16_t* V; int layer; const bf16_t* Z; const float* ckr; const float* khn; const float* R;
    __device__ __forceinline__ void fused(f32x4 (&acc)[2][2][4][2], const Unit& u, int wr, int wc, int fr_, int fq_, LAS unsigned char* lds, int wid, int lane_) const {
        if (u.pn == 0) { (*this)(acc, u, wr, wc, fr_, fq_); return; }
        int fr = fr_, fq = fq_, lane = lane_; asm volatile("" : "+v"(fr), "+v"(fq), "+v"(lane));
        LAS bf16_t* T = (LAS bf16_t*)lds;
#pragma unroll
        for (int ai = 0; ai < 2; ++ai)
#pragma unroll
            for (int m = 0; m < 4; ++m) { const int kl = ai * 128 + wr * 64 + m * 16 + fr;
#pragma unroll
                for (int bj = 0; bj < 2; ++bj) { const int el = bj * 128 + wc * 32 + 8 * fq;
#pragma unroll
                    for (int i = 0; i < 8; i += 2) { const unsigned w = pk2(acc[ai][bj][m][i >> 2][i & 3], acc[ai][bj][m][i >> 2][(i & 3) + 1]); T[(el + i) * 264 + kl] = (bf16_t)(w & 0xffffu); T[(el + i + 1) * 264 + kl] = (bf16_t)(w >> 16); } } }
        __syncthreads();
        int rb = u.pm * 256; if (layer == 0) rb = rb < 2048 ? 8192 + rb : rb - 2048;
        bf16_t* bp; int st;
        if (rb < 4096) { bp = V + (size_t)(rb >> 8) * 4 * 128 * 256; st = 256; }
        else if (rb < 8192) { bp = V + 2097152 + (size_t)((rb - 4096) >> 10) * 4 * 128 * 1536 + 512 + ((rb - 4096) & 1023); st = 1536; }
        else { bp = V + 2097152 + (size_t)((rb - 8192) >> 9) * 4 * 128 * 1536 + ((rb - 8192) & 511); st = 1536; }
        const int tid = wid * 64 + lane;
#pragma unroll
        for (int i = 0; i < 16; ++i) { const int idx = tid + 512 * i, el = idx >> 5, part = idx & 31;
            *(u32x4*)(bp + (size_t)((u.pn - 1) * 256 + el) * st + part * 8) = *(const LAS u32x4*)(T + el * 264 + part * 8); }
        __syncthreads();
    }
    __device__ __forceinline__ void operator()(const f32x4 (&acc)[2][2][4][2], const Unit& u, int wr, int wc, int fr_, int fq_) const {
        int fr = fr_, fq = fq_; asm volatile("" : "+v"(fr), "+v"(fq));
        int rb = u.pm * 256; if (layer == 0) rb = rb < 2048 ? 8192 + rb : rb - 2048;
        const int row0 = rb + wr * 64 + fr;
        float w1[4], w2[4];
#pragma unroll
        for (int i = 0; i < 4; ++i) { w1[i] = khn[64 + 4 * fq + i]; w2[i] = khn[80 + 4 * fq + i]; }
#pragma unroll
        for (int ai = 0; ai < 2; ++ai)
#pragma unroll
          for (int mh = 0; mh < 4; mh += 1) {
            float x1[4][4], x2[4][4], cs[4][4], sn[4][4];
#pragma unroll
            for (int m = mh; m < mh + 1; ++m) { const int r = row0 + ai * 128 + m * 16;
                if (r >= 8192) { const int j = r - 8192; const float* kr = ckr + ((size_t)(((j >> 9) * 2 + layer) * 512 + (j & 511))) * 32 + 4 * fq;
                    const f32x4 a = *(const f32x4*)kr, b = *(const f32x4*)(kr + 16);
#pragma unroll
                    for (int i = 0; i < 4; ++i) { x1[m][i] = a[i]; x2[m][i] = b[i]; } }
                else { const bf16_t* kr = Z + (size_t)r * LDZ + ZMKR + 4 * fq; const u32x2 a = *(const u32x2*)kr, b = *(const u32x2*)(kr + 16);
                    x1[m][0] = lo16(a.x); x1[m][1] = hi16(a.x); x1[m][2] = lo16(a.y); x1[m][3] = hi16(a.y); x2[m][0] = lo16(b.x); x2[m][1] = hi16(b.x); x2[m][2] = lo16(b.y); x2[m][3] = hi16(b.y); }
                const bool rot = r >= 4096 && r < 8192; const int pos = (r - 4096) & 1023;
                if (rot) { const f32x4 c = *(const f32x4*)(R + pos * 16 + 4 * fq), s_ = *(const f32x4*)(R + 16384 + pos * 16 + 4 * fq);
#pragma unroll
                    for (int i = 0; i < 4; ++i) { cs[m][i] = c[i]; sn[m][i] = s_[i]; } }
                else {
#pragma unroll
                    for (int i = 0; i < 4; ++i) { cs[m][i] = 1.f; sn[m][i] = 0.f; } } }
#pragma unroll
            for (int m = mh; m < mh + 1; ++m) { const int r = row0 + ai * 128 + m * 16;
                float ss = 0.f;
#pragma unroll
                for (int bj = 0; bj < 2; ++bj)
#pragma unroll
                    for (int i = 0; i < 8; ++i) { const float v = acc[ai][bj][m][i >> 2][i & 3]; ss += v * v; }
#pragma unroll
                for (int i = 0; i < 4; ++i) ss += x1[m][i] * x1[m][i] + x2[m][i] * x2[m][i];
                ss += __shfl_xor(ss, 16); ss += __shfl_xor(ss, 32);
                const float rstd = rsqrtf(ss * (1.f / 96.f) + 1e-6f);
                bf16_t* kp = KF + (size_t)r * 384 + wc * 96;
#pragma unroll
                for (int bj = 0; bj < 2; ++bj) { u32x4 w; const f32x4 v0 = acc[ai][bj][m][0], v1 = acc[ai][bj][m][1];
                    w.x = pk2(v0[0] * rstd, v0[1] * rstd); w.y = pk2(v0[2] * rstd, v0[3] * rstd);
                    w.z = pk2(v1[0] * rstd, v1[1] * rstd); w.w = pk2(v1[2] * rstd, v1[3] * rstd);
                    *(u32x4*)(kp + 32 * bj + 8 * fq) = w; }
                float o1[4], o2[4];
#pragma unroll
                for (int i = 0; i < 4; ++i) { const float a = x1[m][i] * rstd * w1[i], b = x2[m][i] * rstd * w2[i]; o1[i] = a * cs[m][i] - b * sn[m][i]; o2[i] = a * sn[m][i] + b * cs[m][i]; }
                *(u32x2*)(kp + 64 + 4 * fq) = (u32x2){pk2(o1[0], o1[1]), pk2(o1[2], o1[3])}; *(u32x2*)(kp + 80 + 4 * fq) = (u32x2){pk2(o2[0], o2[1]), pk2(o2[2], o2[3])}; }
            __builtin_amdgcn_sched_barrier(0); }
    } };
struct EpiGLU { static constexpr bool PERM = true, AFTER_DRAIN = false; bf16_t* O; const bf16_t* Z; const float* bias;
    __device__ __forceinline__ void operator()(const f32x4 (&acc)[2][2][4][2], const Unit& u, int wr, int wc, int fr_, int fq_) const {
        int fr = fr_, fq = fq_; asm volatile("" : "+v"(fr), "+v"(fq));
        const int row0 = u.pm * 256 + wr * 64 + fr, oc = u.pn * 128 + wc * 32 + 8 * fq;
#pragma unroll
        for (int ai = 0; ai < 2; ++ai) {
            float bv[8], bg[8];
            { const f32x4 b0 = *(const f32x4*)(bias + oc), b1 = *(const f32x4*)(bias + oc + 4), g0 = *(const f32x4*)(bias + 512 + oc), g1 = *(const f32x4*)(bias + 512 + oc + 4);
#pragma unroll
              for (int i = 0; i < 4; ++i) { bv[i] = b0[i]; bv[4 + i] = b1[i]; bg[i] = g0[i]; bg[4 + i] = g1[i]; } }
            u32x4 sgv[2][4];
#pragma unroll
            for (int m = 0; m < 4; ++m) sgv[ai][m] = *(const u32x4*)(Z + (size_t)(row0 + ai * 128 + m * 16) * LDZ + ZSG + oc);
#pragma unroll
            for (int m = 0; m < 4; ++m) { const size_t r = (size_t)(row0 + ai * 128 + m * 16);
                const u32x4 sg = sgv[ai][m];
                float g[8] = { lo16(sg.x), hi16(sg.x), lo16(sg.y), hi16(sg.y), lo16(sg.z), hi16(sg.z), lo16(sg.w), hi16(sg.w) };
                float o[8];
#pragma unroll
                for (int i = 0; i < 8; ++i) { const float zv = acc[ai][0][m][i >> 2][i & 3] + bv[i], zg = acc[ai][1][m][i >> 2][i & 3] + bg[i]; o[i] = zv * sigmoidf_(zg) * siluf_(g[i]); }
                u32x4 w; w.x = pk2(o[0], o[1]); w.y = pk2(o[2], o[3]); w.z = pk2(o[4], o[5]); w.w = pk2(o[6], o[7]);
                *(u32x4*)(O + r * 512 + oc) = w; }
            __builtin_amdgcn_sched_barrier(0); }
    } };
struct EpiBo { static constexpr bool PERM = true, AFTER_DRAIN = true; bf16_t* MIX; const bf16_t* Z; int branch;
    __device__ __forceinline__ void fused(f32x4 (&acc)[2][2][4][2], const Unit& u, int wr, int wc, int fr_, int fq_, LAS unsigned char* lds, int wid, int lane_) const {
        int fr = fr_, fq = fq_, lane = lane_; asm volatile("" : "+v"(fr), "+v"(fq), "+v"(lane));
        const int row0 = u.pm * 256 + wr * 64 + fr, col0 = u.pn * 256 + wc * 32 + 8 * fq;
        LAS unsigned char* wl = lds + wid * 16384;
#pragma unroll
        for (int ai = 0; ai < 2; ++ai)
#pragma unroll
            for (int m = 0; m < 4; ++m)
#pragma unroll
                for (int bj = 0; bj < 2; ++bj)
                    __builtin_amdgcn_global_load_lds((const unsigned*)(Z + (size_t)(row0 + ai * 128 + m * 16) * LDZ + ZMERGE + branch * 1024 + col0 + bj * 128), (LAS unsigned*)(wl + ((ai * 4 + m) * 2 + bj) * 1024), 16, 0, 0);
#pragma unroll
        for (int ai = 0; ai < 2; ++ai) {
            u32x4 pv[4][2];
#pragma unroll
            for (int m = 0; m < 4; ++m)
#pragma unroll
                for (int bj = 0; bj < 2; ++bj) pv[m][bj] = branch > 0 ? *(const u32x4*)(MIX + (size_t)(row0 + ai * 128 + m * 16) * 1024 + col0 + bj * 128) : (u32x4){0u, 0u, 0u, 0u};
            if (ai == 0) { asm volatile("s_waitcnt vmcnt(0)" ::: "memory"); __builtin_amdgcn_s_barrier(); asm volatile("" ::: "memory"); }
#pragma unroll
            for (int m = 0; m < 4; ++m) { const size_t r = (size_t)(row0 + ai * 128 + m * 16);
#pragma unroll
                for (int bj = 0; bj < 2; ++bj) { const u32x4 sg = *(const LAS u32x4*)(wl + ((ai * 4 + m) * 2 + bj) * 1024 + lane * 16), pp = pv[m][bj];
                    const float g[8] = { lo16(sg.x), hi16(sg.x), lo16(sg.y), hi16(sg.y), lo16(sg.z), hi16(sg.z), lo16(sg.w), hi16(sg.w) };
                    const float q[8] = { lo16(pp.x), hi16(pp.x), lo16(pp.y), hi16(pp.y), lo16(pp.z), hi16(pp.z), lo16(pp.w), hi16(pp.w) };
                    float o[8];
#pragma unroll
                    for (int i = 0; i < 8; ++i) o[i] = q[i] + sigmoidf_(g[i]) * acc[ai][bj][m][i >> 2][i & 3];
                    u32x4 w; w.x = pk2(o[0], o[1]); w.y = pk2(o[2], o[3]); w.z = pk2(o[4], o[5]); w.w = pk2(o[6], o[7]);
                    *(u32x4*)(MIX + r * 1024 + col0 + bj * 128) = w; } }
            __builtin_amdgcn_sched_barrier(0); }
        __syncthreads();
    }
    __device__ __forceinline__ void operator()(const f32x4 (&acc)[2][2][4][2], const Unit& u, int wr, int wc, int fr_, int fq_) const {
        int fr = fr_, fq = fq_; asm volatile("" : "+v"(fr), "+v"(fq));
        const int row0 = u.pm * 256 + wr * 64 + fr, col0 = u.pn * 256 + wc * 32 + 8 * fq;
#pragma unroll
        for (int ai = 0; ai < 2; ++ai)
#pragma unroll
          for (int mh = 0; mh < 4; mh += 2) {
            u32x4 gz[4][2], pv[4][2];
#pragma unroll
            for (int m = mh; m < mh + 2; ++m)
#pragma unroll
                for (int bj = 0; bj < 2; ++bj) { const size_t r = (size_t)(row0 + ai * 128 + m * 16);
                    gz[m][bj] = *(const u32x4*)(Z + r * LDZ + ZMERGE + branch * 1024 + col0 + bj * 128);
                    pv[m][bj] = branch > 0 ? *(const u32x4*)(MIX + r * 1024 + col0 + bj * 128) : (u32x4){0u, 0u, 0u, 0u}; }
#pragma unroll
            for (int m = mh; m < mh + 2; ++m) { const size_t r = (size_t)(row0 + ai * 128 + m * 16);
#pragma unroll
                for (int bj = 0; bj < 2; ++bj) { const u32x4 sg = gz[m][bj], pp = pv[m][bj];
                    const float g[8] = { lo16(sg.x), hi16(sg.x), lo16(sg.y), hi16(sg.y), lo16(sg.z), hi16(sg.z), lo16(sg.w), hi16(sg.w) };
                    const float q[8] = { lo16(pp.x), hi16(pp.x), lo16(pp.y), hi16(pp.y), lo16(pp.z), hi16(pp.z), lo16(pp.w), hi16(pp.w) };
                    float o[8];
#pragma unroll
                    for (int i = 0; i < 8; ++i) o[i] = q[i] + sigmoidf_(g[i]) * acc[ai][bj][m][i >> 2][i & 3];
                    u32x4 w; w.x = pk2(o[0], o[1]); w.y = pk2(o[2], o[3]); w.z = pk2(o[4], o[5]); w.w = pk2(o[6], o[7]);
                    *(u32x4*)(MIX + r * 1024 + col0 + bj * 128) = w; } }
            __builtin_amdgcn_sched_barrier(0); }
    } };
struct EpiOut { static constexpr bool PERM = false, AFTER_DRAIN = true; float* Y; const float* xp; const float* xs; const float* ada;
    __device__ __forceinline__ void fused(f32x4 (&acc)[2][2][4][2], const Unit& u, int wr, int wc, int fr_, int fq_, LAS unsigned char* lds, int wid, int lane_) const {
        int fr = fr_, fq = fq_, lane = lane_; asm volatile("" : "+v"(fr), "+v"(fq), "+v"(lane));
        const int row0 = u.pm * 256 + wr * 64 + fr, col0 = u.pn * 256 + wc * 32 + 4 * fq;
        LAS unsigned char* wl = lds + wid * 16384;
        const float* xb = (u.pm < 16 ? xp + (size_t)row0 * 1024 : xs + (size_t)(row0 - 4096) * 1024) + col0;
#pragma unroll
        for (int m = 0; m < 4; ++m)
#pragma unroll
            for (int bj = 0; bj < 2; ++bj)
#pragma unroll
                for (int n = 0; n < 2; ++n) __builtin_amdgcn_global_load_lds((const unsigned*)(xb + (size_t)(m * 16) * 1024 + bj * 128 + n * 16), (LAS unsigned*)(wl + ((m * 2 + bj) * 2 + n) * 1024), 16, 0, 0);
        f32x4 x1[4][2][2];
#pragma unroll
        for (int m = 0; m < 4; ++m)
#pragma unroll
            for (int bj = 0; bj < 2; ++bj)
#pragma unroll
                for (int n = 0; n < 2; ++n) x1[m][bj][n] = *(const f32x4*)(xb + (size_t)(128 + m * 16) * 1024 + bj * 128 + n * 16);
        const int ar = u.pm < 16 ? 0 : 1 + ((u.pm - 16) >> 2);
        const float* gp = ada + ar * 3072 + 2048;
        f32x4 gv[2][2];
#pragma unroll
        for (int bj = 0; bj < 2; ++bj)
#pragma unroll
            for (int n = 0; n < 2; ++n) gv[bj][n] = *(const f32x4*)(gp + col0 + bj * 128 + n * 16);
        asm volatile("s_waitcnt vmcnt(0)" ::: "memory"); __builtin_amdgcn_s_barrier(); asm volatile("" ::: "memory");
        float* yb = Y + (size_t)row0 * 1024 + col0;
#pragma unroll
        for (int m = 0; m < 4; ++m)
#pragma unroll
            for (int bj = 0; bj < 2; ++bj)
#pragma unroll
                for (int n = 0; n < 2; ++n) { const f32x4 xv = *(const LAS f32x4*)(wl + ((m * 2 + bj) * 2 + n) * 1024 + lane * 16);
                    *(f32x4*)(yb + (size_t)(m * 16) * 1024 + bj * 128 + n * 16) = xv + gv[bj][n] * acc[0][bj][m][n];
                    *(f32x4*)(yb + (size_t)(128 + m * 16) * 1024 + bj * 128 + n * 16) = x1[m][bj][n] + gv[bj][n] * acc[1][bj][m][n]; }
        __syncthreads();
    }
    __device__ __forceinline__ void operator()(const f32x4 (&acc)[2][2][4][2], const Unit& u, int wr, int wc, int fr_, int fq_) const {
        int fr = fr_, fq = fq_; asm volatile("" : "+v"(fr), "+v"(fq));
        const int row0 = u.pm * 256 + wr * 64 + fr, col0 = u.pn * 256 + wc * 32 + 4 * fq;
        const int ar = u.pm < 16 ? 0 : 1 + ((u.pm - 16) >> 2);
        const float* gp = ada + ar * 3072 + 2048;
        f32x4 gv[2][2];
#pragma unroll
        for (int bj = 0; bj < 2; ++bj)
#pragma unroll
            for (int n = 0; n < 2; ++n) gv[bj][n] = *(const f32x4*)(gp + col0 + bj * 128 + n * 16);
#pragma unroll
        for (int ai = 0; ai < 2; ++ai)
#pragma unroll
          for (int mh = 0; mh < 4; mh += 2) {
            f32x4 xv[4][2][2];
#pragma unroll
            for (int m = mh; m < mh + 2; ++m) { const int r = row0 + ai * 128 + m * 16;
                const float* xr = (r < 4096 ? xp + (size_t)r * 1024 : xs + (size_t)(r - 4096) * 1024) + col0;
#pragma unroll
                for (int bj = 0; bj < 2; ++bj)
#pragma unroll
                    for (int n = 0; n < 2; ++n) xv[m][bj][n] = *(const f32x4*)(xr + bj * 128 + n * 16); }
#pragma unroll
            for (int m = mh; m < mh + 2; ++m) { const int r = row0 + ai * 128 + m * 16;
                float* yr = Y + (size_t)r * 1024 + col0;
#pragma unroll
                for (int bj = 0; bj < 2; ++bj)
#pragma unroll
                    for (int n = 0; n < 2; ++n) *(f32x4*)(yr + bj * 128 + n * 16) = xv[m][bj][n] + gv[bj][n] * acc[ai][bj][m][n]; }
            __builtin_amdgcn_sched_barrier(0); }
    } };

__device__ __forceinline__ void job_ada(const Params& p, int j, lds_t lds) {
    LAS float* sc = (LAS float*)lds; LAS float* red = sc + 5 * 1024;
    const int l = j / 96, c0 = (j % 96) * 32, tid = tid_opaque(p);
    for (int i = tid; i < 5 * 1024; i += 512) { const int r = i >> 10, k = i & 1023; const float v = r == 0 ? p.in[I_CCTX][k] : p.in[I_C][(r - 1) * 1024 + k]; sc[i] = v / (1.f + expf(-v)); }
    __syncthreads();
    const int col = tid & 31, kg = tid >> 5; const float* W = p.in[I_WADA] + (size_t)l * 1024 * 3072 + (size_t)(kg * 64) * 3072 + c0 + col;
    float a0 = 0.f, a1 = 0.f, a2 = 0.f, a3 = 0.f, a4 = 0.f;
#pragma unroll 1
    for (int kb = 0; kb < 64; kb += 16) { float w[16];
#pragma unroll
        for (int i = 0; i < 16; ++i) w[i] = W[(size_t)(kb + i) * 3072];
#pragma unroll
        for (int i = 0; i < 16; ++i) { const int k = kg * 64 + kb + i; a0 += sc[k] * w[i]; a1 += sc[1024 + k] * w[i]; a2 += sc[2048 + k] * w[i]; a3 += sc[3072 + k] * w[i]; a4 += sc[4096 + k] * w[i]; } }
    red[(kg * 5 + 0) * 32 + col] = a0; red[(kg * 5 + 1) * 32 + col] = a1; red[(kg * 5 + 2) * 32 + col] = a2; red[(kg * 5 + 3) * 32 + col] = a3; red[(kg * 5 + 4) * 32 + col] = a4;
    __syncthreads();
    if (tid < 160) { const int r = tid >> 5, cc = tid & 31; float s = p.in[I_BADA][l * 3072 + c0 + cc];
        for (int g = 0; g < 16; ++g) s += red[(g * 5 + r) * 32 + cc];
        ((float*)(p.ws + OFF_ADA))[(l * 5 + r) * 3072 + c0 + cc] = s; }
    __syncthreads();
}
__device__ __forceinline__ void job_ctx(const Params& p, int j) {
    const int base = j * 4096 + tid_opaque(p) * 8; const int l = base / (2048 * 256), rem = base % (2048 * 256), row = rem >> 8, c = rem & 255, b = row >> 9, jj = row & 511;
    const float* s = p.in[I_CKV] + ((size_t)((b * 2 + l) * 512 + jj)) * 256 + c;
    const f32x4 v0 = *(const f32x4*)s, v1 = *(const f32x4*)(s + 4);
    bf16_t* d = (bf16_t*)(p.ws + (l == 0 ? OFF_CTX0 : OFF_CTX1)) + (size_t)row * 256 + c;
    store8(d, v0, v1);
}
__device__ __forceinline__ void job_rope(const Params& p, int j) {
    const int idx = j * 512 + tid_opaque(p), pos = idx >> 4, i = idx & 15, f = i & 7;
    const float inv = powf(10000.f, -(float)f / 8.f); const float ang = (float)(i < 8 ? (pos >> 6) : (pos & 63)) * inv;
    float* R = (float*)(p.ws + OFF_ROPE); R[idx] = cosf(ang); R[16384 + idx] = sinf(ang);
}

__device__ __forceinline__ void job_prep(const Params& p, int l, int j) {
    const int tid = tid_opaque(p), wid = tid >> 6, lane = tid & 63, row = j * 8 + wid;
    const float* x = l == 0 ? (row < 4096 ? p.in[I_XP] + (size_t)row * 1024 : p.in[I_XS] + (size_t)(row - 4096) * 1024) : p.out + (size_t)row * 1024;
    const int ar = row < 4096 ? 0 : 1 + ((row - 4096) >> 10);
    const float* ada = (const float*)(p.ws + OFF_ADA) + (l * 5 + ar) * 3072; const float* nw = p.in[I_NORMW] + l * 1024;
    f32x4 v[4]; float ss = 0.f;
#pragma unroll
    for (int i = 0; i < 4; ++i) { v[i] = *(const f32x4*)(x + i * 256 + lane * 4); ss += v[i][0] * v[i][0] + v[i][1] * v[i][1] + v[i][2] * v[i][2] + v[i][3] * v[i][3]; }
#pragma unroll
    for (int o = 1; o < 64; o <<= 1) ss += __shfl_xor(ss, o);
    const float rstd = rsqrtf(ss * (1.f / 1024.f) + 1e-6f);
    bf16_t* h = (bf16_t*)(p.ws + OFF_HB) + (size_t)row * 1024;
#pragma unroll
    for (int i = 0; i < 4; ++i) { const int c = i * 256 + lane * 4; const f32x4 w = *(const f32x4*)(nw + c), sh = *(const f32x4*)(ada + c), sc = *(const f32x4*)(ada + 1024 + c);
        float o[4];
#pragma unroll
        for (int k = 0; k < 4; ++k) o[k] = v[i][k] * rstd * w[k] * (1.f + sc[k]) + sh[k];
        u32x2 pk; pk.x = pk2(o[0], o[1]); pk.y = pk2(o[2], o[3]); *(u32x2*)(h + c) = pk; }
}
__device__ __forceinline__ void wt_tile(const Params& p, const float* src, int ldsrc, int sbase, int nvalid, int mode, bf16_t* dst, int K, int n0, int k0, lds_t lds) {
    LAS float* t = (LAS float*)lds; const int tid = tid_opaque(p);
    const int nn = tid & 255, kh = tid >> 8; const int sc = mode == 0 ? sbase + nn : mode == 1 ? ((nn >> 7) & 1) * 512 + sbase + (nn & 127) : ((nn >> 5) & 3) * 64 + (nn >> 7) * 32 + (nn & 31); const bool ok = mode != 0 || nn < nvalid;
    float v[32];
#pragma unroll
    for (int i = 0; i < 32; ++i) v[i] = ok ? src[(size_t)(k0 + 2 * i + kh) * ldsrc + sc] : 0.f;
#pragma unroll
    for (int i = 0; i < 32; ++i) t[(2 * i + kh) * 257 + nn] = v[i];
    __syncthreads();
#pragma unroll
    for (int ps = 0; ps < 4; ++ps) { const int n = ps * 64 + (tid >> 3), kc = tid & 7; const LAS float* s = t + (kc * 8) * 257 + n; u32x4 w;
        w.x = pk2(s[0], s[257]); w.y = pk2(s[514], s[771]); w.z = pk2(s[1028], s[1285]); w.w = pk2(s[1542], s[1799]);
        *(u32x4*)(dst + (size_t)(n0 + n) * K + k0 + kc * 8) = w; }
    __syncthreads();
}
constexpr int WT_WIN = 27 * 16, WT_WUQ = 2 * 6, WT_WKV = 3 * 4, WT_WGLU = 4 * 8, WT_WBO = 4 * 8, WT_WOUT = 4 * 16, WT_EARLY = WT_WIN + WT_WUQ + WT_WKV + WT_WGLU, WT_TOTAL = WT_EARLY + 3 * WT_WBO + WT_WOUT;
__device__ __forceinline__ void job_wt(const Params& p, int l, int t, lds_t lds) {
    if (t < WT_WIN) { const int nt = t / 16, kt = t % 16; wt_tile(p, p.in[I_WIN] + (size_t)l * 1024 * 6848, 6848, nt * 256, 6848 - nt * 256, 0, (bf16_t*)(p.ws + OFF_WIN), 1024, nt * 256, kt * 64, lds); return; } t -= WT_WIN;
    if (t < WT_WUQ) { const int nt = t / 6, kt = t % 6; wt_tile(p, p.in[I_WUQ] + (size_t)l * 384 * 384, 384, nt * 256, 384 - nt * 256, 0, (bf16_t*)(p.ws + OFF_WUQ), 384, nt * 256, kt * 64, lds); return; } t -= WT_WUQ;
    if (t < WT_WKV) { const int nt = t / 4, kt = t % 4;
        if (nt == 0) wt_tile(p, p.in[I_WUK] + (size_t)l * 256 * 256, 256, 0, 256, 2, (bf16_t*)(p.ws + OFF_WKV), 256, 0, kt * 64, lds);
        else wt_tile(p, p.in[I_WUV] + (size_t)l * 256 * 512, 512, (nt - 1) * 256, 256, 0, (bf16_t*)(p.ws + OFF_WKV), 256, nt * 256, kt * 64, lds);
        return; } t -= WT_WKV;
    if (t < WT_WGLU) { const int nt = t / 8, kt = t % 8; wt_tile(p, p.in[I_WGLU] + (size_t)l * 512 * 1024, 1024, nt * 128, 256, 1, (bf16_t*)(p.ws + OFF_WGLU), 512, nt * 256, kt * 64, lds); return; } t -= WT_WGLU;
    if (t < 3 * WT_WBO) { const int br = t / WT_WBO, tt = t % WT_WBO, nt = tt / 8, kt = tt % 8;
        wt_tile(p, p.in[I_WBOG + br] + (size_t)l * 512 * 1024, 1024, nt * 256, 256, 0, (bf16_t*)(p.ws + OFF_WBO) + (size_t)br * 1024 * 512, 512, nt * 256, kt * 64, lds); return; } t -= 3 * WT_WBO;
    { const int nt = t / 16, kt = t % 16; wt_tile(p, p.in[I_WOUT] + (size_t)l * 1024 * 1024, 1024, nt * 256, 256, 0, (bf16_t*)(p.ws + OFF_WOUT), 1024, nt * 256, kt * 64, lds); }
}
__device__ __forceinline__ void job_s5setup(const Params& p, int l, int j, lds_t lds) {
    const int g = j / 3, which = j % 3, tid = tid_opaque(p);
    LAS f32x2_t* pw = (LAS f32x2_t*)lds;
    LAS f32x2_t* Bt = pw + 2 * 17 * 64;
    LAS f32x2_t* Cn = Bt + 2 * 64 * 16;
    LAS float* Kt = (LAS float*)(Cn + 64 * 16);
    LAS float* raw = Kt + 8192;
    { const size_t gb = (size_t)(l * 32 + g) * 1024;
      for (int i = tid; i < 1024; i += 512) { raw[i] = p.in[I_BRE][gb + i]; raw[1024 + i] = p.in[I_BIM][gb + i]; raw[2048 + i] = p.in[I_CRE][gb + i]; raw[3072 + i] = p.in[I_CIM][gb + i]; }
      if (tid < 128) { const int d = tid >> 6, n = tid & 63; raw[4096 + tid] = p.in[I_ARE][((l * 2 + d) * 32 + g) * 64 + n]; raw[4224 + tid] = p.in[I_AIM][((l * 2 + d) * 32 + g) * 64 + n]; }
      if (tid < 2) raw[4352 + tid] = p.in[I_LOGDT][(l * 2 + tid) * 32 + g]; }
    __syncthreads();
    if (tid < 128) { const int d = tid >> 6, n = tid & 63;
        const float dt = expf(raw[4352 + d]);
        const float are = raw[4096 + tid], aim = raw[4224 + tid];
        float s1, c1; sincosf(aim * dt, &s1, &c1); float sh = sinf(0.5f * aim * dt);
        const float em1 = expm1f(are * dt), mag1 = em1 + 1.f;
        { float pr = 1.f, pi = 0.f; const float ar1 = mag1 * c1, ai1 = mag1 * s1;
          for (int tau = 0; tau <= 16; ++tau) { pw[(d * 17 + tau) * 64 + n] = (f32x2_t){pr, pi}; const float nr = pr * ar1 - pi * ai1, ni = pr * ai1 + pi * ar1; pr = nr; pi = ni; } }
        const float nre = em1 * c1 - 2.f * sh * sh, abim = mag1 * s1, den = are * are + aim * aim;
        const float cfr = (nre * are + abim * aim) / den, cfi = (abim * are - nre * aim) / den;
        for (int q = 0; q < 16; ++q) { const float br = raw[n * 16 + q], bi = raw[1024 + n * 16 + q];
            Bt[(d * 64 + n) * 16 + q] = (f32x2_t){cfr * br - cfi * bi, cfr * bi + cfi * br}; }
        if (which == 1) ((f32x2_t*)(p.ws + OFF_P16))[(g * 2 + d) * 64 + n] = pw[(d * 17 + 16) * 64 + n];
    }
    for (int i = tid; i < 1024; i += 512) { const int n = i >> 4, pp = i & 15; Cn[i] = (f32x2_t){raw[2048 + pp * 64 + n], raw[3072 + pp * 64 + n]}; }
    __syncthreads();
    bf16_t* M = (bf16_t*)(p.ws + OFF_S5M) + (size_t)(g * 3 + which) * 65536;
    if (which == 0) {
        { const int wid_ = tid >> 6, ln = tid & 63, lr_ = ln & 15, kq = ln >> 4;
          for (int c4 = 0; c4 < 4; ++c4) { const int dt_ = wid_ * 4 + c4, d = dt_ >> 4, tau = dt_ & 15; f32x4 acc = {0.f, 0.f, 0.f, 0.f};
#pragma unroll 4
            for (int ks = 0; ks < 16; ++ks) { const int n = ks * 4 + kq; const f32x2_t c = Cn[n * 16 + lr_], w = pw[(d * 17 + tau) * 64 + n], b = Bt[(d * 64 + n) * 16 + lr_];
                const float cwr = c.x * w.x - c.y * w.y, cwi = c.x * w.y + c.y * w.x;
                acc = __builtin_amdgcn_mfma_f32_16x16x4f32(cwr, b.x, acc, 0, 0, 0); acc = __builtin_amdgcn_mfma_f32_16x16x4f32(-cwi, b.y, acc, 0, 0, 0); }
#pragma unroll
            for (int r = 0; r < 4; ++r) Kt[dt_ * 256 + (kq * 4 + r) * 16 + lr_] = acc[r]; } }
        __syncthreads();
#pragma unroll 8
        for (int i = tid; i < 65536; i += 512) { const int no = i >> 8, k = i & 255, t = no >> 4, pp = no & 15, s = k >> 4, q = k & 15; float v;
            if (t > s) v = Kt[(0 * 16 + (t - s)) * 256 + pp * 16 + q];
            else if (t < s) v = Kt[(1 * 16 + (s - t)) * 256 + pp * 16 + q];
            else { v = Kt[pp * 16 + q] + Kt[16 * 256 + pp * 16 + q]; if (pp == q) v += p.in[I_S5D][l * 512 + g * 16 + pp]; }
            M[i] = f2bf(v); }
    } else if (which == 1) {
#pragma unroll 8
        for (int i = tid; i < 65536; i += 512) { const int no = i >> 8, k = i & 255, d = no >> 7, ri = (no >> 6) & 1, n = no & 63, s = k >> 4, q = k & 15; const int e = d == 0 ? 15 - s : s;
            const f32x2_t w = pw[(d * 17 + e) * 64 + n], b = Bt[(d * 64 + n) * 16 + q];
            M[i] = f2bf(ri == 0 ? w.x * b.x - w.y * b.y : w.x * b.y + w.y * b.x); }
    } else {
#pragma unroll 8
        for (int i = tid; i < 65536; i += 512) { const int no = i >> 8, k = i & 255, t = no >> 4, pp = no & 15, d = k >> 7, ri = (k >> 6) & 1, n = k & 63; const int e = d == 0 ? t + 1 : 16 - t;
            const f32x2_t c = Cn[n * 16 + pp], w = pw[(d * 17 + e) * 64 + n];
            M[i] = f2bf(ri == 0 ? c.x * w.x - c.y * w.y : -(c.x * w.y + c.y * w.x)); }
    }
    __syncthreads();
}

__device__ __forceinline__ float gelu_tanh(float x) { const float u = 0.7978845608f * (x + 0.044715f * x * x * x); const float t = 1.f - 2.f / (1.f + __expf(2.f * u)); return 0.5f * x * (1.f + t); }
__device__ __forceinline__ void job_s5(const Params& p, int l, int j, lds_t lds) {
    const int tid = tid_opaque(p), wid = tid >> 6, lane = tid & 63, lr = lane & 15, lq = lane >> 4;
    const int bb = j >> 5, g = j & 31;
    const int M = bb < 16 ? 16 : 64, MT = M >> 4; const int tok0 = bb < 16 ? bb * 256 : 4096 + (bb - 16) * 1024;
    LAS bf16_t* Us = (LAS bf16_t*)lds; LAS bf16_t* Xs = Us + 64 * 264; LAS float* Xin = (LAS float*)(lds + 2 * 64 * 264 * 2);
    const bf16_t* Z = (const bf16_t*)(p.ws + OFF_Z);
    const bf16_t* TT = (const bf16_t*)(p.ws + OFF_S5M) + (size_t)(g * 3) * 65536; const bf16_t* G = TT + 65536; const bf16_t* Cc = G + 65536;
    bf16x8 bq[8][2];
#pragma unroll
    for (int ks = 0; ks < 8; ++ks) { bq[ks][0] = *(const bf16x8*)(G + (size_t)(wid * 32 + lr) * 256 + ks * 32 + lq * 8); bq[ks][1] = *(const bf16x8*)(G + (size_t)(wid * 32 + 16 + lr) * 256 + ks * 32 + lq * 8); }
    f32x2_t a16 = {0.f, 0.f}; float xr = 0.f, xi = 0.f;
    if (tid < 128) { const int d = tid >> 6, n = tid & 63; a16 = ((const f32x2_t*)(p.ws + OFF_P16))[(g * 2 + d) * 64 + n];
        if (bb >= 16) { const size_t o = ((size_t)(((bb - 16) * 2 + l) * 2 + d) * 2) * 2048 + g * 64 + n; xr = p.in[I_SS5][o]; xi = p.in[I_SS5][o + 2048]; } }
    for (int idx = tid; idx < M * 32; idx += 512) { const int tok = idx >> 1, hf = idx & 1;
        *(LAS u32x4*)(Us + (tok >> 4) * 264 + (tok & 15) * 16 + hf * 8) = *(const u32x4*)(Z + (size_t)(tok0 + tok) * LDZ + ZSU + g * 16 + hf * 8); }
    __syncthreads();
    f32x4 acc[4][2];
#pragma unroll
    for (int a = 0; a < 4; ++a) { acc[a][0] = (f32x4){0.f, 0.f, 0.f, 0.f}; acc[a][1] = acc[a][0]; }
#pragma unroll
    for (int ks = 0; ks < 8; ++ks)
#pragma unroll
        for (int mt = 0; mt < 4; ++mt) if (mt < MT) { const bf16x8 a = LDSFRAG(Us + (mt * 16 + lr) * 264 + ks * 32 + lq * 8); acc[mt][0] = MFMA16(a, bq[ks][0], acc[mt][0]); acc[mt][1] = MFMA16(a, bq[ks][1], acc[mt][1]); }
    bf16x8 bc[8][2];
#pragma unroll
    for (int ks = 0; ks < 8; ++ks) { bq[ks][0] = *(const bf16x8*)(TT + (size_t)(wid * 32 + lr) * 256 + ks * 32 + lq * 8); bq[ks][1] = *(const bf16x8*)(TT + (size_t)(wid * 32 + 16 + lr) * 256 + ks * 32 + lq * 8);
        bc[ks][0] = *(const bf16x8*)(Cc + (size_t)(wid * 32 + lr) * 256 + ks * 32 + lq * 8); bc[ks][1] = *(const bf16x8*)(Cc + (size_t)(wid * 32 + 16 + lr) * 256 + ks * 32 + lq * 8); }
#pragma unroll
    for (int mt = 0; mt < 4; ++mt) if (mt < MT)
#pragma unroll
        for (int ct = 0; ct < 2; ++ct)
#pragma unroll
            for (int r = 0; r < 4; ++r) Xin[(mt * 16 + lq * 4 + r) * 260 + wid * 32 + ct * 16 + lr] = acc[mt][ct][r];
    __syncthreads();
    if (tid < 128) { const int d = tid >> 6, n = tid & 63;
        const int cre = d * 128 + n, cim = cre + 64;
        for (int i = 0; i < M; ++i) { const int c = d == 0 ? i : M - 1 - i;
            Xs[c * 264 + cre] = f2bf(xr); Xs[c * 264 + cim] = f2bf(xi);
            const float ur = Xin[c * 260 + cre], ui = Xin[c * 260 + cim];
            const float nr = a16.x * xr - a16.y * xi + ur, ni = a16.x * xi + a16.y * xr + ui; xr = nr; xi = ni; }
        if (bb < 16) { const size_t o = OUT_S5 + ((size_t)((bb * 2 + l) * 2 + d) * 2) * 2048 + g * 64 + n; p.out[o] = xr; p.out[o + 2048] = xi; }
    }
    __syncthreads();
#pragma unroll
    for (int a = 0; a < 4; ++a) { acc[a][0] = (f32x4){0.f, 0.f, 0.f, 0.f}; acc[a][1] = acc[a][0]; }
#pragma unroll
    for (int ks = 0; ks < 8; ++ks)
#pragma unroll
        for (int mt = 0; mt < 4; ++mt) if (mt < MT) { const bf16x8 a = LDSFRAG(Us + (mt * 16 + lr) * 264 + ks * 32 + lq * 8); acc[mt][0] = MFMA16(a, bq[ks][0], acc[mt][0]); acc[mt][1] = MFMA16(a, bq[ks][1], acc[mt][1]); }
#pragma unroll
    for (int ks = 0; ks < 8; ++ks)
#pragma unroll
        for (int mt = 0; mt < 4; ++mt) if (mt < MT) { const bf16x8 a = LDSFRAG(Xs + (mt * 16 + lr) * 264 + ks * 32 + lq * 8); acc[mt][0] = MFMA16(a, bc[ks][0], acc[mt][0]); acc[mt][1] = MFMA16(a, bc[ks][1], acc[mt][1]); }
    bf16_t* Yg = (bf16_t*)(p.ws + OFF_YG);
#pragma unroll
    for (int mt = 0; mt < 4; ++mt) if (mt < MT)
#pragma unroll
        for (int ct = 0; ct < 2; ++ct)
#pragma unroll
            for (int r = 0; r < 4; ++r) { const int chunk = mt * 16 + lq * 4 + r, t = wid * 2 + ct;
                Yg[(size_t)(tok0 + chunk * 16 + t) * 512 + g * 16 + lr] = f2bf(gelu_tanh(acc[mt][ct][r])); }
    __syncthreads();
}
__device__ __forceinline__ void job_mlaprep(const Params& p, int l, int j) {
    const int tid = tid_opaque(p), wid = tid >> 6, lane = tid & 63, row = j * 8 + wid;
    const bf16_t* z = (const bf16_t*)(p.ws + OFF_Z) + (size_t)row * LDZ;
    float q[6], kv[4]; float sq = 0.f, sk = 0.f;
#pragma unroll
    for (int i = 0; i < 6; ++i) { q[i] = bf2f(z[ZMQ + i * 64 + lane]); sq += q[i] * q[i]; }
#pragma unroll
    for (int i = 0; i < 4; ++i) { kv[i] = bf2f(z[ZMKV + i * 64 + lane]); sk += kv[i] * kv[i]; }
#pragma unroll
    for (int o = 1; o < 64; o <<= 1) { sq += __shfl_xor(sq, o); sk += __shfl_xor(sk, o); }
    const float rq = rsqrtf(sq * (1.f / 384.f) + 1e-6f), rk = rsqrtf(sk * (1.f / 256.f) + 1e-6f);
    bf16_t* aq = (bf16_t*)(p.ws + OFF_AQ) + (size_t)row * 384; bf16_t* ck = (bf16_t*)(p.ws + OFF_CKVN) + (size_t)row * 256;
#pragma unroll
    for (int i = 0; i < 6; ++i) aq[i * 64 + lane] = f2bf(q[i] * rq * p.in[I_QNORM][l * 384 + i * 64 + lane]);
    const bool prompt = row < 4096; const int b = row >> 8, t = row & 255;
#pragma unroll
    for (int i = 0; i < 4; ++i) { const float v = kv[i] * rk * p.in[I_KVNORM][l * 256 + i * 64 + lane]; ck[i * 64 + lane] = f2bf(v);
        if (prompt) p.out[OUT_CKV + ((size_t)((b * 2 + l) * 256 + t)) * 256 + i * 64 + lane] = v; }
    if (prompt && lane < 32) p.out[OUT_KR + ((size_t)((b * 2 + l) * 256 + t)) * 32 + lane] = bf2f(z[ZMKR + lane]);
}
__device__ __forceinline__ float logsigmoidf_(float x) { return fminf(x, 0.f) - __logf(1.f + __expf(-fabsf(x))); }
__device__ __forceinline__ void job_glaA(const Params& p, int l, int j, lds_t lds) {
    const int tid = tid_opaque(p), wid = tid >> 6, lane = tid & 63, lr = lane & 15, lq = lane >> 4;
    const int ck = j >> 2, h = j & 3, tok0 = ck * 64;
    LAS bf16_t* QDf = (LAS bf16_t*)lds; LAS bf16_t* QDb = QDf + 4608; LAS bf16_t* KDf = QDb + 4608; LAS bf16_t* KDb = KDf + 4608; LAS bf16_t* KRf = KDb + 4608; LAS bf16_t* KRb = KRf + 4608;
    LAS bf16_t* VT = KRb + 4608;
    LAS bf16_t* ATT = VT + 9216;
    LAS float* GA = (LAS float*)(ATT + 4608);
    LAS float* TOT = GA + 2048;
    const bf16_t* Z = (const bf16_t*)(p.ws + OFF_Z);
    { const int c = tid >> 3, part = tid & 7; const u32x2 gv = *(const u32x2*)(Z + (size_t)(tok0 + c) * LDZ + ZGA + part * 4);
      GA[c * 32 + part * 4 + 0] = lo16(gv.x); GA[c * 32 + part * 4 + 1] = hi16(gv.x); GA[c * 32 + part * 4 + 2] = lo16(gv.y); GA[c * 32 + part * 4 + 3] = hi16(gv.y);
      const bf16_t* vp = Z + (size_t)(tok0 + c) * LDZ + ZV + h * 128 + part * 16;
      const u32x4 v0 = *(const u32x4*)vp, v1 = *(const u32x4*)(vp + 8);
      const unsigned w[8] = { v0.x, v0.y, v0.z, v0.w, v1.x, v1.y, v1.z, v1.w };
#pragma unroll
      for (int i = 0; i < 8; ++i) { VT[(part * 16 + 2 * i) * 72 + c] = (bf16_t)(w[i] & 0xffffu); VT[(part * 16 + 2 * i + 1) * 72 + c] = (bf16_t)(w[i] >> 16); } }
    __syncthreads();
    const int d = tid & 63, cg_ = tid >> 6;
    float laf[8], lab[8]; bf16_t qraw[8], kraw[8];
#pragma unroll
    for (int i = 0; i < 8; ++i) { const size_t zr = (size_t)(tok0 + cg_ * 8 + i) * LDZ; qraw[i] = Z[zr + ZQ + h * 64 + d]; kraw[i] = Z[zr + ZK + h * 64 + d]; }
    { float wf[16], wb[16];
#pragma unroll
      for (int r = 0; r < 16; ++r) { wf[r] = p.in[I_WA2][((size_t)((l * 2 + 0) * 16 + r)) * 256 + h * 64 + d]; wb[r] = p.in[I_WA2][((size_t)((l * 2 + 1) * 16 + r)) * 256 + h * 64 + d]; }
      const float bf_ = p.in[I_BA][(l * 2 + 0) * 256 + h * 64 + d], bb_ = p.in[I_BA][(l * 2 + 1) * 256 + h * 64 + d];
#pragma unroll
      for (int i = 0; i < 8; ++i) { const int c = cg_ * 8 + i; float xf = bf_, xb = bb_;
#pragma unroll
          for (int r = 0; r < 16; ++r) { xf += GA[c * 32 + r] * wf[r]; xb += GA[c * 32 + 16 + r] * wb[r]; }
          laf[i] = logsigmoidf_(xf) * (1.f / 16.f); lab[i] = logsigmoidf_(xb) * (1.f / 16.f); } }
#pragma unroll
    for (int i = 1; i < 8; ++i) laf[i] += laf[i - 1];
#pragma unroll
    for (int i = 6; i >= 0; --i) lab[i] += lab[i + 1];
    TOT[(0 * 8 + cg_) * 64 + d] = laf[7]; TOT[(1 * 8 + cg_) * 64 + d] = lab[0];
    __syncthreads();
    float offf = 0.f, offb = 0.f, Tf = 0.f, Tb = 0.f;
#pragma unroll
    for (int g = 0; g < 8; ++g) { const float a = TOT[g * 64 + d], b = TOT[(8 + g) * 64 + d]; Tf += a; Tb += b; if (g < cg_) offf += a; if (g > cg_) offb += b; }
    bf16_t* QD = (bf16_t*)(p.ws + OFF_QD);
#pragma unroll
    for (int i = 0; i < 8; ++i) { const int c = cg_ * 8 + i;
        const float q = bf2f(qraw[i]) * 0.125f, k = bf2f(kraw[i]);
        const float bf_ = offf + laf[i], bb_ = offb + lab[i];
        const bf16_t qf = f2bf(q * __expf(bf_)), qb = f2bf(q * __expf(bb_));
        QDf[c * 72 + d] = qf; QDb[c * 72 + d] = qb;
        KDf[c * 72 + d] = f2bf(k * __expf(-bf_)); KDb[c * 72 + d] = f2bf(k * __expf(-bb_));
        KRf[d * 72 + c] = f2bf(k * __expf(Tf - bf_)); KRb[d * 72 + c] = f2bf(k * __expf(Tb - bb_));
        QD[(size_t)(tok0 + c) * 256 + h * 64 + d] = qf; QD[(size_t)(8192 + tok0 + c) * 256 + h * 64 + d] = qb; }
    if (cg_ == 0) { float* DEC = (float*)(p.ws + OFF_DEC); DEC[((0 * 128 + ck) * 4 + h) * 64 + d] = __expf(Tf); DEC[((1 * 128 + ck) * 4 + h) * 64 + d] = __expf(Tb); }
    __syncthreads();
#pragma unroll
    for (int q2 = 0; q2 < 2; ++q2) { const int tt = wid * 2 + q2, ti = tt >> 2, tj = tt & 3; f32x4 af = {0.f, 0.f, 0.f, 0.f}, ab = af;
#pragma unroll
        for (int ks = 0; ks < 2; ++ks) { const int ko = ks * 32 + lq * 8;
            af = MFMA16(LDSFRAG(QDf + (ti * 16 + lr) * 72 + ko), LDSFRAG(KDf + (tj * 16 + lr) * 72 + ko), af);
            ab = MFMA16(LDSFRAG(QDb + (ti * 16 + lr) * 72 + ko), LDSFRAG(KDb + (tj * 16 + lr) * 72 + ko), ab); }
#pragma unroll
        for (int r = 0; r < 4; ++r) { const int c = ti * 16 + lq * 4 + r, s = tj * 16 + lr; const float v = (s <= c ? af[r] : 0.f) + (s >= c ? ab[r] : 0.f); ATT[c * 72 + s] = f2bf(v); } }
    __syncthreads();
    bf16x8 vb[2];
#pragma unroll
    for (int ks = 0; ks < 2; ++ks) vb[ks] = LDSFRAG(VT + (wid * 16 + lr) * 72 + ks * 32 + lq * 8);
    bf16_t* OI = (bf16_t*)(p.ws + OFF_OIB); bf16_t* KV = (bf16_t*)(p.ws + OFF_KV);
#pragma unroll
    for (int ct = 0; ct < 4; ++ct) { f32x4 a = {0.f, 0.f, 0.f, 0.f};
#pragma unroll
        for (int ks = 0; ks < 2; ++ks) a = MFMA16(LDSFRAG(ATT + (ct * 16 + lr) * 72 + ks * 32 + lq * 8), vb[ks], a);
#pragma unroll
        for (int r = 0; r < 4; ++r) OI[(size_t)(tok0 + ct * 16 + lq * 4 + r) * 512 + h * 128 + wid * 16 + lr] = f2bf(a[r]); }
#pragma unroll
    for (int dir = 0; dir < 2; ++dir) { const LAS bf16_t* KR = dir == 0 ? KRf : KRb; bf16_t* kvp = KV + ((size_t)((dir * 128 + ck) * 4 + h)) * 8192;
#pragma unroll
        for (int dt = 0; dt < 4; ++dt) { f32x4 a = {0.f, 0.f, 0.f, 0.f};
#pragma unroll
            for (int ks = 0; ks < 2; ++ks) a = MFMA16(LDSFRAG(KR + (dt * 16 + lr) * 72 + ks * 32 + lq * 8), vb[ks], a);
#pragma unroll
            for (int r = 0; r < 4; ++r) kvp[(dt * 16 + lq * 4 + r) * 128 + wid * 16 + lr] = f2bf(a[r]); } }
    __syncthreads();
}

__device__ __forceinline__ void job_glaB(const Params& p, int l, int j) {
    const int qt = j & 3, h = (j >> 2) & 3, rest = j >> 4, bb = rest % 20, dir = rest / 20;
    const int idx0 = qt * 2048 + tid_opaque(p);
    const int nck = bb < 16 ? 4 : 16, ck0 = bb < 16 ? bb * 4 : 64 + (bb - 16) * 16;
    float S[4];
#pragma unroll
    for (int e = 0; e < 4; ++e) S[e] = bb >= 16 ? p.in[I_SGLA][((size_t)((((bb - 16) * 2 + l) * 2 + dir) * 4 + h)) * 8192 + idx0 + e * 512] : 0.f;
    const bf16_t* KV = (const bf16_t*)(p.ws + OFF_KV); const float* DEC = (const float*)(p.ws + OFF_DEC); bf16_t* ST = (bf16_t*)(p.ws + OFF_ST);
    for (int i0 = 0; i0 < nck; i0 += 4) { float dv[4][4]; bf16_t kv[4][4]; size_t its[4];
#pragma unroll
        for (int u = 0; u < 4; ++u) { const int i = i0 + u, ck = dir == 0 ? ck0 + i : ck0 + nck - 1 - i; its[u] = (size_t)((dir * 128 + ck) * 4 + h);
#pragma unroll
            for (int e = 0; e < 4; ++e) { const int idx = idx0 + e * 512; dv[u][e] = DEC[its[u] * 64 + (idx >> 7)]; kv[u][e] = KV[its[u] * 8192 + idx]; } }
#pragma unroll
        for (int u = 0; u < 4; ++u)
#pragma unroll
            for (int e = 0; e < 4; ++e) { ST[its[u] * 8192 + idx0 + e * 512] = f2bf(S[e]); S[e] = dv[u][e] * S[e] + bf2f(kv[u][e]); } }
    if (bb < 16) {
#pragma unroll
        for (int e = 0; e < 4; ++e) p.out[OUT_GLA + ((size_t)(((bb * 2 + l) * 2 + dir) * 4 + h)) * 8192 + idx0 + e * 512] = S[e]; }
}

__device__ __forceinline__ void job_glaC(const Params& p, int l, int j, lds_t lds) {
    const int tid = tid_opaque(p), wid = tid >> 6, lane = tid & 63, lr = lane & 15, lq = lane >> 4;
    const int ck = j >> 2, h = j & 3, tok0 = ck * 64;
    LAS bf16_t* Aq = (LAS bf16_t*)lds;
    LAS bf16_t* BT = Aq + 64 * 136;
    LAS float* Os = (LAS float*)(BT + 128 * 136);
    const bf16_t* QD = (const bf16_t*)(p.ws + OFF_QD); const bf16_t* ST = (const bf16_t*)(p.ws + OFF_ST);
#pragma unroll
    for (int it = 0; it < 2; ++it) { const int idx = tid + it * 512, c = idx >> 4, rem = idx & 15, dir = rem >> 3, dc = rem & 7;
        *(LAS u32x4*)(Aq + c * 136 + dir * 64 + dc * 8) = *(const u32x4*)(QD + (size_t)(dir * 8192 + tok0 + c) * 256 + h * 64 + dc * 8); }
#pragma unroll
    for (int it = 0; it < 4; ++it) { const int idx = tid + it * 512, dir = idx >> 10, d = (idx >> 4) & 63, ec = idx & 15;
        const u32x4 v = *(const u32x4*)(ST + ((size_t)((dir * 128 + ck) * 4 + h)) * 8192 + d * 128 + ec * 8);
        const unsigned w[4] = { v.x, v.y, v.z, v.w };
#pragma unroll
        for (int i = 0; i < 4; ++i) { BT[(ec * 8 + 2 * i) * 136 + dir * 64 + d] = (bf16_t)(w[i] & 0xffffu); BT[(ec * 8 + 2 * i + 1) * 136 + dir * 64 + d] = (bf16_t)(w[i] >> 16); } }
    const int ct = wid & 3, eh = wid >> 2; const bf16_t* OI = (const bf16_t*)(p.ws + OFF_OIB);
    bf16_t oi[4][4];
#pragma unroll
    for (int e4 = 0; e4 < 4; ++e4)
#pragma unroll
        for (int r = 0; r < 4; ++r) oi[e4][r] = OI[(size_t)(tok0 + ct * 16 + lq * 4 + r) * 512 + h * 128 + (eh * 4 + e4) * 16 + lr];
    const int nc = tid >> 3, npart = tid & 7;
    const bf16_t* gz = (const bf16_t*)(p.ws + OFF_Z) + (size_t)(tok0 + nc) * LDZ + ZGG + h * 128 + npart * 16;
    const u32x4 g0 = *(const u32x4*)gz, g1 = *(const u32x4*)(gz + 8);
    f32x4 onw[4];
#pragma unroll
    for (int i = 0; i < 4; ++i) onw[i] = *(const f32x4*)(p.in[I_ONORM] + l * 128 + npart * 16 + 4 * i);
    __syncthreads();
    bf16x8 af[4];
#pragma unroll
    for (int ks = 0; ks < 4; ++ks) af[ks] = LDSFRAG(Aq + (ct * 16 + lr) * 136 + ks * 32 + lq * 8);
#pragma unroll
    for (int e4 = 0; e4 < 4; ++e4) { const int et = eh * 4 + e4; f32x4 a = {0.f, 0.f, 0.f, 0.f};
#pragma unroll
        for (int ks = 0; ks < 4; ++ks) a = MFMA16(af[ks], LDSFRAG(BT + (et * 16 + lr) * 136 + ks * 32 + lq * 8), a);
#pragma unroll
        for (int r = 0; r < 4; ++r) { const int row = ct * 16 + lq * 4 + r, col = et * 16 + lr; Os[row * 132 + col] = a[r] + bf2f(oi[e4][r]); } }
    __syncthreads();
    { const int c = tid >> 3, part = tid & 7; float o[16]; float ss = 0.f;
#pragma unroll
      for (int i = 0; i < 16; ++i) { o[i] = Os[c * 132 + part * 16 + i]; ss += o[i] * o[i]; }
      ss += __shfl_xor(ss, 1); ss += __shfl_xor(ss, 2); ss += __shfl_xor(ss, 4);
      const float rstd = rsqrtf(ss * (1.f / 128.f) + 1e-6f);
      const unsigned gw[8] = { g0.x, g0.y, g0.z, g0.w, g1.x, g1.y, g1.z, g1.w };
      unsigned ow[8];
#pragma unroll
      for (int i = 0; i < 8; ++i) { const float n0 = onw[i >> 1][(2 * i) & 3], n1 = onw[i >> 1][(2 * i + 1) & 3];
          ow[i] = pk2(o[2 * i] * rstd * n0 * siluf_(lo16(gw[i])), o[2 * i + 1] * rstd * n1 * siluf_(hi16(gw[i]))); }
      bf16_t* ap = (bf16_t*)(p.ws + OFF_AGLA) + (size_t)(tok0 + c) * 512 + h * 128 + part * 16;
      *(u32x4*)ap = (u32x4){ow[0], ow[1], ow[2], ow[3]}; *(u32x4*)(ap + 8) = (u32x4){ow[4], ow[5], ow[6], ow[7]}; }
    __syncthreads();
}
__device__ __forceinline__ void head_row_finish(float (&x)[16], int p8, const float* nw, const float* nw2, bool rope, int pos, const float* R, float mul, LAS bf16_t* dst) {
    float ss = 0.f; const int cnt = p8 < 4 ? 16 : 8;
#pragma unroll
    for (int i = 0; i < 16; ++i) if (i < cnt) ss += x[i] * x[i];
    ss += __shfl_xor(ss, 1); ss += __shfl_xor(ss, 2); ss += __shfl_xor(ss, 4);
    const float rstd = rsqrtf(ss * (1.f / 96.f) + 1e-6f) * mul;
    if (p8 < 4) { unsigned w[8];
#pragma unroll
        for (int i = 0; i < 8; ++i) w[i] = pk2(x[2 * i] * rstd * nw[p8 * 16 + 2 * i] * nw2[p8 * 16 + 2 * i], x[2 * i + 1] * rstd * nw[p8 * 16 + 2 * i + 1] * nw2[p8 * 16 + 2 * i + 1]);
        *(LAS u32x4*)(dst + p8 * 16) = (u32x4){w[0], w[1], w[2], w[3]}; *(LAS u32x4*)(dst + p8 * 16 + 8) = (u32x4){w[4], w[5], w[6], w[7]};
    } else { const int i0 = (p8 - 4) * 4; float o1[4], o2[4];
#pragma unroll
        for (int i = 0; i < 4; ++i) { const float a = x[i] * rstd * nw[64 + i0 + i], b = x[4 + i] * rstd * nw[80 + i0 + i];
            if (rope) { const float c = R[pos * 16 + i0 + i], s = R[16384 + pos * 16 + i0 + i]; o1[i] = a * c - b * s; o2[i] = a * s + b * c; } else { o1[i] = a; o2[i] = b; } }
        *(LAS u32x2*)(dst + 64 + i0) = (u32x2){pk2(o1[0], o1[1]), pk2(o1[2], o1[3])}; *(LAS u32x2*)(dst + 80 + i0) = (u32x2){pk2(o2[0], o2[1]), pk2(o2[2], o2[3])}; }
}
__device__ __forceinline__ void ld16bf(const bf16_t* s, float (&x)[16]) { const u32x4 a = *(const u32x4*)s, b = *(const u32x4*)(s + 8);
    x[0] = lo16(a.x); x[1] = hi16(a.x); x[2] = lo16(a.y); x[3] = hi16(a.y); x[4] = lo16(a.z); x[5] = hi16(a.z); x[6] = lo16(a.w); x[7] = hi16(a.w);
    x[8] = lo16(b.x); x[9] = hi16(b.x); x[10] = lo16(b.y); x[11] = hi16(b.y); x[12] = lo16(b.z); x[13] = hi16(b.z); x[14] = lo16(b.w); x[15] = hi16(b.w); }
__device__ __forceinline__ void ld4bf(const bf16_t* s, float* x) { const u32x2 a = *(const u32x2*)s; x[0] = lo16(a.x); x[1] = hi16(a.x); x[2] = lo16(a.y); x[3] = hi16(a.y); }
__device__ __forceinline__ void job_attn(const Params& p, int l, int j, lds_t lds) {
    const int tid = tid_opaque(p), wid = tid >> 6, lane = tid & 63, lr = lane & 15, lq = lane >> 4;
    const bool smp = j < 128; int b, h, qb; if (smp) { b = j >> 5; h = (j >> 3) & 3; qb = j & 7; } else { const int jj = j - 128; b = jj >> 3; h = (jj >> 1) & 3; qb = jj & 1; }
    const int qtok0 = smp ? 4096 + b * 1024 + qb * 128 : b * 256 + qb * 128; const int nkt = smp ? 12 : 2;
    LAS bf16_t* Ks = (LAS bf16_t*)lds;
    LAS bf16_t* VTs = Ks + 128 * 104;
    LAS bf16_t* Ps = VTs + 128 * 136 + wid * 32 * 72;
    LAS float* Mg = (LAS float*)lds;
    const bf16_t* Z = (const bf16_t*)(p.ws + OFF_Z); const bf16_t* KF = (const bf16_t*)(p.ws + OFF_KF); const bf16_t* Vb = (const bf16_t*)(p.ws + OFF_V); const float* R = (const float*)(p.ws + OFF_ROPE);
    const float* qhn = p.in[I_QHNORM] + l * 96;
    u32x4 kreg[3], vreg[4];
    const int vst = smp ? 1536 : 256; const bf16_t* vtb = smp ? Vb + 2097152 + (size_t)(b * 4 + h) * 128 * 1536 : Vb + (size_t)(b * 4 + h) * 128 * 256;
    auto rowbase = [&](int kt) { return smp ? (kt < 4 ? 8192 + b * 512 + kt * 128 : 4096 + b * 1024 + (kt - 4) * 128) : b * 256 + kt * 128; };
    auto issue = [&](int kt) { const int rb = rowbase(kt);
#pragma unroll
        for (int i = 0; i < 3; ++i) { const int idx = tid + 512 * i, key = idx / 12, part = idx - key * 12; kreg[i] = *(const u32x4*)(KF + (size_t)(rb + key) * 384 + h * 96 + part * 8); }
#pragma unroll
        for (int i = 0; i < 4; ++i) { const int idx = tid + 512 * i, e = idx >> 4, part = idx & 15; vreg[i] = *(const u32x4*)(vtb + (size_t)e * vst + kt * 128 + part * 8); } };
    auto commit = [&]() {
#pragma unroll
        for (int i = 0; i < 3; ++i) { const int idx = tid + 512 * i, key = idx / 12, part = idx - key * 12; *(LAS u32x4*)(Ks + key * 104 + part * 8) = kreg[i]; }
#pragma unroll
        for (int i = 0; i < 4; ++i) { const int idx = tid + 512 * i, e = idx >> 4, part = idx & 15; *(LAS u32x4*)(VTs + e * 136 + part * 8) = vreg[i]; } };
    issue(0);
#pragma unroll
    for (int it = 0; it < 2; ++it) { const int row = it * 64 + (tid >> 3), p8 = tid & 7, tok = qtok0 + row; const bf16_t* qr = (const bf16_t*)(p.ws + OFF_QRAW) + (size_t)tok * 384 + h * 96; float x[16];
      if (p8 < 4) ld16bf(qr + p8 * 16, x); else { ld4bf(qr + 64 + (p8 - 4) * 4, x); ld4bf(qr + 80 + (p8 - 4) * 4, x + 4); }
      head_row_finish(x, p8, qhn, p.in[I_KHNORM] + l * 96, smp, qb * 128 + row, R, 0.10206207261596575f * 1.4426950408889634f, Ks + row * 104); }
    __syncthreads();
    const int rt = wid & 3, kh = wid >> 2;
    bf16x8 qa[2][3];
#pragma unroll
    for (int mt = 0; mt < 2; ++mt)
#pragma unroll
        for (int ks = 0; ks < 3; ++ks) qa[mt][ks] = LDSFRAG(Ks + (rt * 32 + mt * 16 + lr) * 104 + ks * 32 + lq * 8);
    __syncthreads();
    commit();
    __syncthreads();
    f32x4 oacc[2][8]; float mrow[2], lrow[2];
#pragma unroll
    for (int mt = 0; mt < 2; ++mt) {
#pragma unroll
        for (int e = 0; e < 8; ++e) oacc[mt][e] = (f32x4){0.f, 0.f, 0.f, 0.f};
        mrow[mt] = -1e30f; lrow[mt] = 0.f; }
    const int kbase = kh * 64;
    for (int kt = 0; kt < nkt; ++kt) {
        if (kt + 1 < nkt) issue(kt + 1);
        f32x4 sacc[2][4];
#pragma unroll
        for (int nt = 0; nt < 4; ++nt) { sacc[0][nt] = (f32x4){0.f, 0.f, 0.f, 0.f}; sacc[1][nt] = sacc[0][nt];
#pragma unroll
            for (int ks = 0; ks < 3; ++ks) { const bf16x8 kf = LDSFRAG(Ks + (kbase + nt * 16 + lr) * 104 + ks * 32 + lq * 8); sacc[0][nt] = MFMA16(kf, qa[0][ks], sacc[0][nt]); sacc[1][nt] = MFMA16(kf, qa[1][ks], sacc[1][nt]); } }
        bf16x8 pb[2][2];
#pragma unroll
        for (int mt = 0; mt < 2; ++mt) {
            float mx = -1e30f;
#pragma unroll
            for (int nt = 0; nt < 4; ++nt) mx = fmaxf(mx, fmaxf(fmaxf(sacc[mt][nt][0], sacc[mt][nt][1]), fmaxf(sacc[mt][nt][2], sacc[mt][nt][3])));
            mx = fmaxf(mx, __shfl_xor(mx, 16)); mx = fmaxf(mx, __shfl_xor(mx, 32));
            const float mn = fmaxf(mrow[mt], mx), alpha = __builtin_amdgcn_exp2f(mrow[mt] - mn); mrow[mt] = mn;
            float pv[4][4]; float rs = 0.f;
#pragma unroll
            for (int nt = 0; nt < 4; ++nt)
#pragma unroll
                for (int r = 0; r < 4; ++r) { pv[nt][r] = __builtin_amdgcn_exp2f(sacc[mt][nt][r] - mn); rs += pv[nt][r]; }
            lrow[mt] = lrow[mt] * alpha + rs;
#pragma unroll
            for (int k2 = 0; k2 < 2; ++k2) { u32x4 w; w.x = pk2(pv[2 * k2][0], pv[2 * k2][1]); w.y = pk2(pv[2 * k2][2], pv[2 * k2][3]); w.z = pk2(pv[2 * k2 + 1][0], pv[2 * k2 + 1][1]); w.w = pk2(pv[2 * k2 + 1][2], pv[2 * k2 + 1][3]);
                pb[mt][k2] = __builtin_bit_cast(bf16x8, w); }
#pragma unroll
            for (int e = 0; e < 8; ++e) oacc[mt][e] *= alpha; }
#pragma unroll
        for (int k2 = 0; k2 < 2; ++k2)
#pragma unroll
            for (int e = 0; e < 8; ++e) { const LAS bf16_t* vp = VTs + (e * 16 + lr) * 136 + kbase + k2 * 32 + 4 * lq;
                const u32x2 lo = *(const LAS u32x2*)vp, hi = *(const LAS u32x2*)(vp + 16);
                const bf16x8 vf = __builtin_bit_cast(bf16x8, (u32x4){lo.x, lo.y, hi.x, hi.y});
                oacc[0][e] = MFMA16(vf, pb[0][k2], oacc[0][e]); oacc[1][e] = MFMA16(vf, pb[1][k2], oacc[1][e]); }
        __syncthreads();
        if (kt + 1 < nkt) { commit(); __syncthreads(); }
    }
#pragma unroll
    for (int mt = 0; mt < 2; ++mt) { float s_ = lrow[mt]; s_ += __shfl_xor(s_, 16); s_ += __shfl_xor(s_, 32); lrow[mt] = s_; }
    LAS float* Mo = Mg + rt * 32 * 132; LAS float* Ml = Mg + 4 * 32 * 132 + rt * 64;
    if (kh == 1) {
#pragma unroll
        for (int mt = 0; mt < 2; ++mt) {
#pragma unroll
            for (int e = 0; e < 8; ++e) *(LAS f32x4*)(Mo + (mt * 16 + lr) * 132 + e * 16 + 4 * lq) = oacc[mt][e];
            if (lq == 0) { Ml[(mt * 16 + lr) * 2] = mrow[mt]; Ml[(mt * 16 + lr) * 2 + 1] = lrow[mt]; } }
    }
    __syncthreads();
    if (kh == 0) { bf16_t* AM = (bf16_t*)(p.ws + OFF_AMLA);
#pragma unroll
        for (int mt = 0; mt < 2; ++mt) { const int row = mt * 16 + lr, tok = qtok0 + rt * 32 + row;
            u32x2 gt[8];
#pragma unroll
            for (int e = 0; e < 8; ++e) gt[e] = *(const u32x2*)(Z + (size_t)tok * LDZ + ZMG + h * 128 + e * 16 + 4 * lq);
            const float m2 = Ml[row * 2], l2 = Ml[row * 2 + 1]; const float mm = fmaxf(mrow[mt], m2), a1 = __builtin_amdgcn_exp2f(mrow[mt] - mm), a2 = __builtin_amdgcn_exp2f(m2 - mm);
            const float inv = 1.f / (lrow[mt] * a1 + l2 * a2);
#pragma unroll
            for (int e = 0; e < 8; ++e) { const f32x4 o2 = *(const LAS f32x4*)(Mo + row * 132 + e * 16 + 4 * lq); float o[4];
#pragma unroll
                for (int r = 0; r < 4; ++r) o[r] = (oacc[mt][e][r] * a1 + o2[r] * a2) * inv;
                const float g0 = lo16(gt[e].x), g1 = hi16(gt[e].x), g2 = lo16(gt[e].y), g3 = hi16(gt[e].y);
                *(u32x2*)(AM + (size_t)tok * 512 + h * 128 + e * 16 + 4 * lq) = (u32x2){pk2(o[0] * siluf_(g0), o[1] * siluf_(g1)), pk2(o[2] * siluf_(g2), o[3] * siluf_(g3))}; } } }
    __syncthreads();
}


#define XB_TMO      128
#define XB_XCNT(j)  (256  + 64 * (j))
#define XB_XSUB(j)  (1280 + 64 * (j))
#define XB_XGEN(j)  (2304 + 64 * (j))
#define XB_TOP      3328
#define XB_TOPGEN   3392
#define XCD_BAR_WORDS 3456
#define XB_SPIN_CAP (1u << 18)

__device__ __forceinline__ unsigned xb_ld(unsigned* p)              { return __hip_atomic_load(p, __ATOMIC_RELAXED, __HIP_MEMORY_SCOPE_AGENT); }
__device__ __forceinline__ unsigned xb_add(unsigned* p, unsigned v) { return __hip_atomic_fetch_add(p, v, __ATOMIC_RELAXED, __HIP_MEMORY_SCOPE_AGENT); }
__device__ __forceinline__ unsigned xb_xcc_id() { return (unsigned)__builtin_amdgcn_s_getreg((3 << 11) | 20) & 0xFu; }
#define XB_SPIN(cond, bar) do { unsigned _sp = 0; while (cond) { __builtin_amdgcn_s_sleep(1); \
    if ((++_sp & 255u) == 0u) { if (xb_ld(&(bar)[XB_TMO])) break; if (_sp > XB_SPIN_CAP) { atomicAdd(&(bar)[XB_TMO], 1u); break; } } } } while (0)

struct XcdBarrier {
    int wid; unsigned* bar; unsigned x;
    volatile LAS unsigned* st;
};

__device__ __forceinline__ XcdBarrier xcd_barrier_post(unsigned* bar, volatile LAS unsigned* st) {
    XcdBarrier b; b.bar = bar; b.x = xb_xcc_id(); b.st = st;
    if (threadIdx.x == 0) (void)xb_add(&bar[XB_XCNT(b.x)], 1u);
    return b;
}
__device__ __forceinline__ void xcd_barrier_complete(unsigned* bar, unsigned x, unsigned& nloc, unsigned& nx) {
    const unsigned G = gridDim.x * gridDim.y * gridDim.z;
    unsigned sum, cnt, mine, sp = 0u;
    for (;;) {
        sum = 0u; cnt = 0u; mine = 0u;
#pragma unroll
        for (unsigned j = 0; j < 16; ++j) { const unsigned c = xb_ld(&bar[XB_XCNT(j)]); sum += c; cnt += (c > 0u) ? 1u : 0u; mine = (j == x) ? c : mine; }
        if (sum == G) break;
        __builtin_amdgcn_s_sleep(1);
        if ((++sp & 255u) == 0u) { if (xb_ld(&bar[XB_TMO])) break; if (sp > XB_SPIN_CAP) { atomicAdd(&bar[XB_TMO], 1u); break; } }
    }
    nloc = mine > 0u ? mine : 1u; nx = cnt > 0u ? cnt : 1u;
}

__device__ __forceinline__ void xcd_barrier(const XcdBarrier& b) {
    asm volatile("s_waitcnt vmcnt(0)" ::: "memory");
    __syncthreads();
    if (b.wid == 0 && lane_id_() == 0) {
        unsigned* bar = b.bar;
        __builtin_amdgcn_s_waitcnt(0);
        unsigned nloc = b.st[0], nx = b.st[1];
        if (nloc == 0u) { xcd_barrier_complete(bar, b.x, nloc, nx); b.st[0] = nloc; b.st[1] = nx; }
        const unsigned old = xb_add(&bar[XB_XSUB(b.x)], 1u);
        const unsigned gen = old / nloc;
        if (old + 1u == (gen + 1u) * nloc) {
            __builtin_amdgcn_fence(__ATOMIC_RELEASE, "agent");
            asm volatile("s_waitcnt vmcnt(0)" ::: "memory");
            const unsigned og = xb_add(&bar[XB_TOP], 1u);
            const unsigned tg = og / nx;
            if (og + 1u == (tg + 1u) * nx) xb_add(&bar[XB_TOPGEN], 1u);
            else XB_SPIN(xb_ld(&bar[XB_TOPGEN]) == tg, bar);
            __builtin_amdgcn_fence(__ATOMIC_ACQUIRE, "agent");
            xb_add(&bar[XB_XGEN(b.x)], 1u);
            asm volatile("s_waitcnt vmcnt(0)" ::: "memory");
        } else {
            XB_SPIN(xb_ld(&bar[XB_XGEN(b.x)]) == gen, bar);
            __builtin_amdgcn_fence(__ATOMIC_ACQUIRE, "agent");
            asm volatile("s_waitcnt vmcnt(0)" ::: "memory");
        }
    }
    __syncthreads();
}

constexpr int N_PHASES = 15;
#ifndef S3SEL
#define S3SEL 15
#endif
#ifndef REPEAT_MASK
#define REPEAT_MASK 0xff
#endif
#ifndef ONLY_S
#define ONLY_S -1
#endif
__device__ __forceinline__ void run_phase(const Params& p, int ph, lds_t lds, int mask = 0xff) {
    const int G = (int)gridDim.x, bid = (int)blockIdx.x;
    if (ph == 0 && (ONLY_S < 0 || ONLY_S == 7)) {
        for (int j = bid; j < 96 + 192 + 256 + 32; j += G) { if (j < 96) job_s5setup(p, 0, j, lds); else if (j < 288) job_ada(p, j - 96, lds); else if (j < 544) job_ctx(p, j - 288); else job_rope(p, j - 544); }
        return;
    }
    const int l = (ph - 1) / 7, s = (ph - 1) % 7;
    unsigned char* ws = p.ws;
    if (s == 0 && (ONLY_S < 0 || ONLY_S == 0)) {
        if (l == 0 || G < 256) { for (int j = bid; j < 96 + WT_TOTAL + 1024; j += G) { if (j < 96) { if ((mask & 1) && l > 0) job_s5setup(p, l, j, lds); } else if (j < 96 + WT_TOTAL) { if (mask & 2) job_wt(p, l, j - 96, lds); } else if (mask & 4) job_prep(p, l, j - 96 - WT_TOTAL); } }
        else { for (int j = bid; j < WT_WOUT + 1024; j += G) { if (j < WT_WOUT) job_wt(p, l, WT_EARLY + 3 * WT_WBO + j, lds); else job_prep(p, l, j - WT_WOUT); } }
    } else if (s == 1 && (ONLY_S < 0 || ONLY_S == 1)) {
        Order S; S.setup(8192, 4096, 0, p.wid); pg8::Gemm g{(const bf16_t*)(ws + OFF_HB), (const bf16_t*)(ws + OFF_WIN), 8192, 4096, 1024}; EpiZ E{(bf16_t*)(ws + OFF_Z)};
        pg8::gemm_phase<EpiZ, Order>(lds, g, S, E, nullptr);
    } else if (s == 2 && (ONLY_S < 0 || ONLY_S == 2)) {
        if (G == 256) {
            if (mask & 1) for (int k = bid >> 3; k < 80; k += 32) { const int q = k >> 2, bb = q < 4 ? 16 + q : q - 4; job_s5(p, l, bb * 32 + 4 * (bid & 7) + (k & 3), lds); }
            if (mask & 2) { job_glaA(p, l, bid, lds); job_glaA(p, l, 256 + bid, lds); }
            if ((mask & 4) && bid >= 128) for (int j = bid - 128; j < 1024; j += 128) job_mlaprep(p, l, j);
        } else for (int j = bid; j < 640 + 512 + 1024; j += G) { if (j < 640) { if (mask & 1) job_s5(p, l, j < 128 ? 512 + j : j - 128, lds); } else if (j < 1152) { if (mask & 2) job_glaA(p, l, j - 640, lds); } else if (mask & 4) job_mlaprep(p, l, j - 1152); }
    } else if (s == 3 && (ONLY_S < 0 || ONLY_S == 3)) {
        if (mask & 1) { if (G == 256) { if (bid < 96) for (int j = bid; j < 640; j += 96) job_glaB(p, l, j); } else for (int j = bid; j < 640; j += G) job_glaB(p, l, j); }
        if (mask & 16) { Order S; S.setup(8192, 2816, 0, p.wid); pg8::Gemm g{(const bf16_t*)(ws + OFF_HB), (const bf16_t*)(ws + OFF_WIN) + (size_t)4096 * 1024, 8192, 2816, 1024}; EpiZ E{(bf16_t*)(ws + OFF_Z) + 4096};
          pg8::gemm_phase<EpiZ, Order>(lds, g, S, E, nullptr); }
        if ((mask & 2) && (S3SEL & 2)) { Order S; S.setup(8192, 1024, 160, p.wid); pg8::Gemm g{(const bf16_t*)(ws + OFF_YG), (const bf16_t*)(ws + OFF_WGLU), 8192, 1024, 512}; EpiGLU E{(bf16_t*)(ws + OFF_AS5), (const bf16_t*)(ws + OFF_Z), p.in[I_BGLU] + l * 1024};
          pg8::gemm_phase<EpiGLU, Order>(lds, g, S, E, nullptr); }
        if ((mask & 4) && (S3SEL & 4)) { Order S; S.setup(10240, 768, 120, p.wid); pg8::Gemm g{(const bf16_t*)(ws + (l == 0 ? OFF_CTX0 : OFF_CKVN)), (const bf16_t*)(ws + OFF_WKV), 10240, 768, 256}; EpiKV E{(bf16_t*)(ws + OFF_KF), (bf16_t*)(ws + OFF_V), l, (const bf16_t*)(ws + OFF_Z), p.in[I_CKR], p.in[I_KHNORM] + l * 96, (const float*)(ws + OFF_ROPE)};
          pg8::gemm_phase<EpiKV, Order>(lds, g, S, E, nullptr); }
        if ((mask & 8) && (S3SEL & 8)) { Order S; S.setup(8192, 512, 160, p.wid); if (G == 256) S.c = (bid >= 96 && bid < 136) ? bid - 96 : (bid >= 224 && bid < 248) ? bid - 184 : (1 << 20); pg8::Gemm g{(const bf16_t*)(ws + OFF_AQ), (const bf16_t*)(ws + OFF_WUQ), 8192, 512, 384}; EpiQ E{(bf16_t*)(ws + OFF_QRAW)};
          pg8::gemm_phase<EpiQ, Order>(lds, g, S, E, nullptr); }
    } else if (s == 4 && (ONLY_S < 0 || ONLY_S == 4)) {
        if (G == 256) {
            if (bid < 128) { const int slot = bid >> 3, pair = 2 * (bid & 7) + (slot >> 3);
                if (mask & 1) job_attn(p, l, pair * 8 + (slot & 7), lds); }
            else { const int k = bid - 128; if (mask & 1) job_attn(p, l, 128 + k, lds); if (mask & 2) { job_glaC(p, l, k, lds); job_glaC(p, l, 128 + k, lds); job_glaC(p, l, 256 + k, lds); job_glaC(p, l, 384 + k, lds); } }
        } else for (int j = bid; j < 256 + 512; j += G) { if (j < 256) { if (mask & 1) job_attn(p, l, j, lds); } else if (mask & 2) job_glaC(p, l, j - 256, lds); }
    } else if (s == 5 && (ONLY_S < 0 || ONLY_S == 5)) {
        if (l == 0 && mask == 0xff && G >= 256 && bid >= 128) { for (int j = bid - 128; j < 96 + WT_EARLY; j += G - 128) { if (j < 96) job_s5setup(p, 1, j, lds); else job_wt(p, 1, j - 96, lds); } }
        for (int br = 0; br < 3; ++br) { Order S; S.setup(8192, 1024, 0, p.wid);
            pg8::Gemm g{(const bf16_t*)(ws + (br == 0 ? OFF_AGLA : br == 1 ? OFF_AMLA : OFF_AS5)), (const bf16_t*)(ws + OFF_WBO) + (size_t)br * 1024 * 512, 8192, 1024, 512};
            EpiBo E{(bf16_t*)(ws + OFF_HB), (const bf16_t*)(ws + OFF_Z), br};
            pg8::gemm_phase<EpiBo, Order>(lds, g, S, E, nullptr); }
    } else if (s == 6 && (ONLY_S < 0 || ONLY_S == 6)) {
        if (l == 0 && mask == 0xff && G >= 256 && bid >= 128) { for (int j = bid - 128; j < 3 * WT_WBO; j += G - 128) job_wt(p, 1, WT_EARLY + j, lds); }
        Order S; S.setup(8192, 1024, 0, p.wid); pg8::Gemm g{(const bf16_t*)(ws + OFF_HB), (const bf16_t*)(ws + OFF_WOUT), 8192, 1024, 1024};
        EpiOut E{p.out, l == 0 ? p.in[I_XP] : p.out, l == 0 ? p.in[I_XS] : p.out + (size_t)4096 * 1024, (const float*)(ws + OFF_ADA) + l * 5 * 3072};
        pg8::gemm_phase<EpiOut, Order>(lds, g, S, E, nullptr);
    }
}
__global__ __launch_bounds__(512, 2) void mega(KParams kp, int ph0, int ph1) {
    extern __shared__ __attribute__((aligned(16))) unsigned char shm[];
    lds_t lds = (lds_t)shm;
    if (threadIdx.x < N_IN) ((const float**)(kp.ws + OFF_TBL))[threadIdx.x] = kp.in[threadIdx.x];
    const int wid0 = __builtin_amdgcn_readfirstlane((int)threadIdx.x >> 6);
    volatile LAS unsigned* xst = (volatile LAS unsigned*)(lds + DYN_LDS - 16);
    if (threadIdx.x == 0) { xst[0] = 0u; xst[1] = 0u; }
    __threadfence(); __syncthreads();
    XcdBarrier xb = xcd_barrier_post((unsigned*)(kp.ws + OFF_BAR), xst);
    xb.wid = wid0;
    if (ph0 > ph1) cg::this_grid().sync();
    for (int ph = ph0; ph < ph1; ++ph) {
        Params p; p.wid = wid0; { const float* const* tb = (const float* const*)(kp.ws + OFF_TBL); float* o = kp.out; unsigned char* w = kp.ws; asm volatile("" : "+s"(tb), "+s"(o), "+s"(w)); p.in = tb; p.out = o; p.ws = w; }
        int nrep = 1;
#ifdef REPEAT_S
        if ((REPEAT_S == 7 && ph == 0) || (ph > 0 && (ph - 1) % 7 == REPEAT_S && (REPEAT_S != 6 || ph < 8))) nrep = 2;
#endif
        for (int rep = 0; rep < nrep; ++rep) { if (rep) xcd_barrier(xb); run_phase(p, ph, lds, rep ? REPEAT_MASK : 0xff); }
        if (ph + 1 < ph1) xcd_barrier(xb);
    }
}

#ifndef N_LAUNCH_MODE
#define N_LAUNCH_MODE 1
#endif
extern "C" void kernel_launch(void* const* d_in, const int* in_sizes, int n_in, void* d_out, int out_size, void* d_ws, size_t ws_size, hipStream_t stream) {
    static int grid = 0;
    if (grid == 0) {
        if (n_in != N_IN || ws_size < WS_END) { fprintf(stderr, "kernel_launch: unexpected n_in %d / ws %zu (need %zu)\n", n_in, ws_size, (size_t)WS_END); grid = -1; return; }
        int dev = 0, cus = 0, per_cu = 0;
        hipGetDevice(&dev); hipDeviceGetAttribute(&cus, hipDeviceAttributeMultiprocessorCount, dev);
        hipFuncSetAttribute((const void*)mega, hipFuncAttributeMaxDynamicSharedMemorySize, DYN_LDS);
        hipOccupancyMaxActiveBlocksPerMultiprocessor(&per_cu, (const void*)mega, 512, DYN_LDS);
        if (per_cu < 1) { fprintf(stderr, "kernel_launch: occupancy query says %d blocks per CU\n", per_cu); per_cu = 1; }
        (void)hipGetLastError();
        grid = cus;
    }
    if (grid < 0) return;
    hipMemsetAsync((char*)d_ws + OFF_BAR, 0, 16384, stream);
    KParams p{};
    for (int i = 0; i < N_IN; ++i) p.in[i] = (const float*)d_in[i];
    p.out = (float*)d_out; p.ws = (unsigned char*)d_ws;
#if N_LAUNCH_MODE == 0
    for (int ph = 0; ph < N_PHASES; ++ph) { hipLaunchKernelGGL(mega, dim3(grid), dim3(512), DYN_LDS, stream, p, ph, ph + 1); }
#else
    int ph0 = 0, ph1 = N_PHASES; void* args[] = {&p, &ph0, &ph1};
    hipError_t e = hipLaunchCooperativeKernel((const void*)mega, dim3(grid), dim3(512), args, DYN_LDS, stream);
    if (e != hipSuccess) fprintf(stderr, "cooperative launch failed: %s (grid %d)\n", hipGetErrorString(e), grid);
#endif
}
```

```cpp
#include <hip/hip_runtime.h>
#include <hip/hip_cooperative_groups.h>
#include <cstdio>
namespace cg = cooperative_groups;
namespace pg8 {
#define PG8_LAS __attribute__((address_space(3)))
typedef unsigned short bf16_t;
typedef short bf16x8 __attribute__((ext_vector_type(8)));
typedef float f32x4 __attribute__((ext_vector_type(4)));
typedef unsigned u32x4 __attribute__((ext_vector_type(4)));
constexpr int BM = 256, BK = 64, HALF = 128, HTB = HALF * BK * 2  , STAGE_BYTES = 8 * HTB, NXCD = 8, WGM = 8;

__host__ __device__ __forceinline__ int lds_byte(int r, int c) { const int st = (r >> 4) * 2 + (c >> 5), rr = r & 15, cc = c & 31, ob = rr * 64 + cc * 2; return st * 1024 + (ob ^ (((ob >> 9) & 1) << 5)); }
__host__ __device__ __forceinline__ void stage_rc(int b, int& R, int& C) { const int st = b / 1024, sb = b % 1024, swz = sb ^ (((sb >> 9) & 1) << 5); R = (st >> 1) * 16 + swz / 64; C = (st & 1) * 32 + (swz % 64) / 2; }
__host__ __device__ __forceinline__ int perm32(int rho) { const int n = rho >> 4, i = rho & 15; return 8 * (i >> 2) + 4 * n + (i & 3); }

struct Unit { int pm, pn; };
struct Gemm { const bf16_t* A; const bf16_t* Bt; int M, N, K; };

struct StaticOrder {
    int nM, nN, nwg, G, c;
    __host__ __device__ void init(int M, int N, int G_, int c_) { nM = M / BM; nN = N / BM; nwg = nM * nN; G = G_; c = c_; }
    __host__ __device__ bool next(int i, Unit& u) const {
        const long L = (long)i * G + c; if (L >= nwg) return false;
        int wgid = (int)L; { const int q = nwg / NXCD, r = nwg % NXCD, xcd = wgid % NXCD, off = wgid / NXCD; wgid = (xcd < r ? xcd * (q + 1) : r * (q + 1) + (xcd - r) * q) + off; }
        const int nig = WGM * nN, gid = wgid / nig, fm = gid * WGM, gsz = (nM - fm) < WGM ? (nM - fm) : WGM;
        u.pm = fm + ((wgid % nig) % gsz); u.pn = (wgid % nig) / gsz; return true;
    }
    __device__ __forceinline__ void a_ready(const Unit&) const {}
    __device__ __forceinline__ void done(const Unit&) const {}
};
__device__ __forceinline__ unsigned cvt_pk_bf16(float lo, float hi) { unsigned r; asm volatile("v_cvt_pk_bf16_f32 %0, %1, %2" : "=v"(r) : "v"(lo), "v"(hi)); return r; }
typedef float f32x2 __attribute__((ext_vector_type(2)));
template <class Epi, class Sched, bool STAMP = false>
__device__ __forceinline__ void gemm_phase(PG8_LAS unsigned char* lds, const Gemm g, const Sched& S, const Epi& E, unsigned long long* stamps) {
    int tid_ = (S.wid << 6) | (int)__builtin_amdgcn_mbcnt_hi(~0u, __builtin_amdgcn_mbcnt_lo(~0u, 0u)); asm volatile("" : "+v"(tid_)); const int tid = tid_, wid = __builtin_amdgcn_readfirstlane(tid >> 6), lane = tid & 63, wr = wid >> 2, wc = wid & 3, fr = lane & 15, fq = lane >> 4;
    int K_ = g.K; asm volatile("" : "+s"(K_)); const int K = K_, nt = K / BK;
    int ts_lo = 0, ts_hi = 0, nts = 0; const unsigned long long rt_entry = STAMP ? (unsigned long long)wall_clock64() : 0ull;
#define PG8_STAMP() do { if (STAMP && wid == 0 && nts < 64) { const unsigned long long _c = (unsigned long long)clock64(); \
        ts_lo = (lane == nts) ? (int)(unsigned)_c : ts_lo; ts_hi = (lane == nts) ? (int)(unsigned)(_c >> 32) : ts_hi; ++nts; } } while (0)
    PG8_STAMP();
    unsigned voffA[2], voffB[2];
#pragma unroll
    for (int i = 0; i < 2; ++i) { int R, C; stage_rc(tid * 16 + i * 8192, R, C); const int Rb = Epi::PERM ? ((R & ~31) + perm32(R & 31)) : R;
        voffA[i] = (unsigned)(R * K + C) * 2u; voffB[i] = (unsigned)(Rb * K + C) * 2u; }
    const size_t kstep = (size_t)(BK * 2);
    const size_t hstep = (size_t)HALF * K * 2;
    const size_t tstep = 2 * hstep;
    const unsigned ldsw = (unsigned)wid * 1024u;
    const int aoff = lds_byte(wr * 64 + fr, fq * 8), boff = lds_byte(wc * 32 + fr, fq * 8);
#define PG8_SA(b, h) (((b) * 2 + (h)) * HTB)
#define PG8_SB(b, h) ((4 + (b) * 2 + (h)) * HTB)
#define PG8_STAGE(bufoff, gbase, voff) do { _Pragma("unroll") for (int _i = 0; _i < 2; ++_i) \
        __builtin_amdgcn_global_load_lds((const unsigned*)((const char*)(gbase) + (voff)[_i]), (PG8_LAS unsigned*)(lds + (bufoff) + ldsw + _i * 8192), 16, 0, 0); } while (0)
#define PG8_LDA(dst, b, h) do { _Pragma("unroll") for (int m = 0; m < 4; ++m) _Pragma("unroll") for (int k = 0; k < 2; ++k) dst[m][k] = *(const PG8_LAS bf16x8*)(lds + PG8_SA(b, h) + aoff + m * 2048 + k * 1024); } while (0)
#define PG8_LDB(dst, b, h) do { _Pragma("unroll") for (int n = 0; n < 2; ++n) _Pragma("unroll") for (int k = 0; k < 2; ++k) dst[n][k] = *(const PG8_LAS bf16x8*)(lds + PG8_SB(b, h) + boff + n * 2048 + k * 1024); } while (0)
#define PG8_MMA(ai, bj, At, Bt) do { __builtin_amdgcn_s_setprio(1); _Pragma("unroll") for (int m = 0; m < 4; ++m) _Pragma("unroll") for (int n = 0; n < 2; ++n) _Pragma("unroll") for (int k = 0; k < 2; ++k) \
        acc[ai][bj][m][n] = __builtin_amdgcn_mfma_f32_16x16x32_bf16(Bt[n][k], At[m][k], acc[ai][bj][m][n], 0, 0, 0); __builtin_amdgcn_s_setprio(0); } while (0)
#define PG8_WAIT_V(n) asm volatile("s_waitcnt vmcnt(" #n ")" ::: "memory")
#define PG8_WAIT_L(n) asm volatile("s_waitcnt lgkmcnt(" #n ")" ::: "memory")
#define PG8_BAR __builtin_amdgcn_s_barrier()
#define PG8_SCHED __builtin_amdgcn_sched_barrier(0)
    Unit cur, nxt; int ui = 0;
    if (!S.next(0, cur)) return;
    f32x4 acc[2][2][4][2];
#pragma unroll
    for (int a = 0; a < 2; ++a)
#pragma unroll
        for (int b = 0; b < 2; ++b)
#pragma unroll
            for (int m = 0; m < 4; ++m)
#pragma unroll
                for (int n = 0; n < 2; ++n) acc[a][b][m][n] = (f32x4){0.f, 0.f, 0.f, 0.f};
    bf16x8 At[4][2], B0[2][2], B1[2][2];
    const char* cA = (const char*)g.A + (size_t)cur.pm * tstep; const char* cB = (const char*)g.Bt + (size_t)cur.pn * tstep;
    S.a_ready(cur);
    PG8_STAGE(PG8_SB(0, 0), cB, voffB); PG8_STAGE(PG8_SA(0, 0), cA, voffA); PG8_STAGE(PG8_SB(0, 1), cB + hstep, voffB); PG8_STAGE(PG8_SA(0, 1), cA + hstep, voffA);
    if (wr == 1) PG8_BAR;
    PG8_WAIT_V(4); PG8_BAR;
    PG8_STAGE(PG8_SB(1, 0), cB + kstep, voffB); PG8_STAGE(PG8_SA(1, 0), cA + kstep, voffA); PG8_STAGE(PG8_SB(1, 1), cB + hstep + kstep, voffB);
    PG8_WAIT_V(6); PG8_BAR;
    PG8_STAMP();
    for (;;) {
        const bool has_next = S.next(ui + 1, nxt);
        const char* nA = has_next ? (const char*)g.A + (size_t)nxt.pm * tstep : cA; const char* nB = has_next ? (const char*)g.Bt + (size_t)nxt.pn * tstep : cB;
        for (int t = 0; t < nt; t += 2) {
            const bool last = (t == nt - 2);
            const char* a1 = cA + (size_t)(t + 1) * kstep;
            const char* a2 = last ? nA : cA + (size_t)(t + 2) * kstep; const char* b2 = last ? nB : cB + (size_t)(t + 2) * kstep;
            const char* a3 = a2 + kstep; const char* b3 = b2 + kstep;
            if (last && has_next) S.a_ready(nxt);
            PG8_LDB(B0, 0, 0); PG8_SCHED; PG8_LDA(At, 0, 0); PG8_STAGE(PG8_SA(1, 1), a1 + hstep, voffA);
            PG8_WAIT_L(8); PG8_BAR; PG8_WAIT_L(0); PG8_MMA(0, 0, At, B0); PG8_BAR; PG8_SCHED;
            PG8_LDB(B1, 0, 1); PG8_STAGE(PG8_SB(0, 0), b2, voffB);
            PG8_BAR; PG8_WAIT_L(0); PG8_MMA(0, 1, At, B1); PG8_BAR;
            PG8_LDA(At, 0, 1); PG8_STAGE(PG8_SA(0, 0), a2, voffA);
            PG8_BAR; PG8_WAIT_L(0); PG8_MMA(1, 0, At, B0); PG8_BAR; PG8_SCHED;
            PG8_STAGE(PG8_SB(0, 1), b2 + hstep, voffB);
            PG8_WAIT_V(6); PG8_BAR; PG8_MMA(1, 1, At, B1); PG8_BAR;
            PG8_LDB(B0, 1, 0); PG8_SCHED; PG8_LDA(At, 1, 0); PG8_STAGE(PG8_SA(0, 1), a2 + hstep, voffA);
            PG8_WAIT_L(8); PG8_BAR; PG8_WAIT_L(0); PG8_MMA(0, 0, At, B0); PG8_BAR; PG8_SCHED;
            PG8_LDB(B1, 1, 1); PG8_STAGE(PG8_SB(1, 0), b3, voffB);
            PG8_BAR; PG8_WAIT_L(0); PG8_MMA(0, 1, At, B1); PG8_BAR;
            PG8_LDA(At, 1, 1); PG8_STAGE(PG8_SA(1, 0), a3, voffA);
            PG8_BAR; PG8_WAIT_L(0); PG8_MMA(1, 0, At, B0); PG8_BAR; PG8_SCHED;
            PG8_STAGE(PG8_SB(1, 1), b3 + hstep, voffB);
            PG8_WAIT_V(6); PG8_BAR; PG8_MMA(1, 1, At, B1); PG8_BAR;
        }
        PG8_STAMP();
        if constexpr (!Epi::AFTER_DRAIN) { E(acc, cur, wr, wc, fr, fq); S.done(cur); }
        PG8_STAMP();
        if (!has_next) break;
#pragma unroll
        for (int a = 0; a < 2; ++a)
#pragma unroll
            for (int b = 0; b < 2; ++b)
#pragma unroll
                for (int m = 0; m < 4; ++m)
#pragma unroll
                    for (int n = 0; n < 2; ++n) acc[a][b][m][n] = (f32x4){0.f, 0.f, 0.f, 0.f};
        cur = nxt; cA = nA; cB = nB; ++ui;
    }
    PG8_WAIT_V(0);
    if (wr == 0) PG8_BAR;
    PG8_BAR;
    if constexpr (Epi::AFTER_DRAIN) { E.fused(acc, cur, wr, wc, fr, fq, lds, wid, lane); S.done(cur); }
    PG8_STAMP();
    if (STAMP && wid == 0) { stamps[lane] = lane < nts ? (((unsigned long long)(unsigned)ts_hi << 32) | (unsigned)ts_lo) : 0ull;
        if (lane == 62) stamps[62] = rt_entry; if (lane == 63) stamps[63] = (unsigned long long)wall_clock64(); }
#undef PG8_STAMP
#undef PG8_SA
#undef PG8_SB
#undef PG8_STAGE
#undef PG8_LDA
#undef PG8_LDB
#undef PG8_MMA
#undef PG8_WAIT_V
#undef PG8_WAIT_L
#undef PG8_BAR
#undef PG8_SCHED
}
}
using pg8::bf16_t; using pg8::bf16x8; using pg8::f32x4; using pg8::u32x4; using pg8::Unit;
#define LAS __attribute__((address_space(3)))
typedef unsigned u32x2 __attribute__((ext_vector_type(2)));
typedef LAS unsigned char* lds_t;
struct Params;
__device__ __forceinline__ int lane_id_() { return (int)__builtin_amdgcn_mbcnt_hi(~0u, __builtin_amdgcn_mbcnt_lo(~0u, 0u)); }
typedef float f32x2_t __attribute__((ext_vector_type(2)));

enum { I_XP = 0, I_XS, I_C, I_CCTX, I_CKV, I_CKR, I_SGLA, I_SS5, I_NORMW, I_WADA, I_BADA, I_WIN, I_WA2, I_BA, I_ONORM, I_QNORM, I_WUQ, I_KVNORM, I_WUK, I_WUV,
       I_QHNORM, I_KHNORM, I_ARE, I_AIM, I_LOGDT, I_BRE, I_BIM, I_CRE, I_CIM, I_S5D, I_WGLU, I_BGLU, I_WBOG, I_WBOM, I_WBOS, I_WOUT, N_IN };
struct KParams { const float* in[N_IN]; float* out; unsigned char* ws; };
struct Params { const float* const* in; float* out; unsigned char* ws; int wid; };
__device__ __forceinline__ int tid_opaque(const Params& p) { int t = (p.wid << 6) | lane_id_(); asm volatile("" : "+v"(t)); return t; }

constexpr int LDZ = 6912;
constexpr int ZQ = 0, ZK = 256, ZV = 512, ZGA = 1024, ZGG = 1056, ZMQ = 1568, ZMKV = 1952, ZMKR = 2208, ZMG = 2240, ZSU = 2752, ZSG = 3264, ZMERGE = 3776;
constexpr size_t OUT_YP = 0, OUT_CKV = 8388608, OUT_KR = 10485760, OUT_GLA = 10747904, OUT_S5 = 12845056;
constexpr size_t OFF_WIN = 0;

constexpr size_t OFF_WUQ = OFF_WIN + 14155776;
constexpr size_t OFF_WKV = OFF_WUQ + 393216;
constexpr size_t OFF_WGLU = OFF_WKV + 393216;
constexpr size_t OFF_WBO = OFF_WGLU + 1048576;
constexpr size_t OFF_WOUT = OFF_WBO + 3145728;
constexpr size_t OFF_S5M = OFF_WOUT + 2097152;
constexpr size_t OFF_V = OFF_S5M;
constexpr size_t OFF_P16 = OFF_S5M + 12582912;
constexpr size_t OFF_ADA = OFF_P16 + 32768;
constexpr size_t OFF_ROPE = OFF_ADA + 122880;
constexpr size_t OFF_CTX0 = OFF_ROPE + 131072;
constexpr size_t OFF_CKVN = OFF_CTX0 + 1048576;
constexpr size_t OFF_CTX1 = OFF_CKVN + 4194304;
constexpr size_t OFF_HB = OFF_CTX1 + 1048576;
constexpr size_t OFF_Z = OFF_HB + 16777216;
constexpr size_t OFF_KV = OFF_Z + 113246208;
constexpr size_t OFF_AGLA = OFF_KV, OFF_AMLA = OFF_KV + 8388608;
constexpr size_t OFF_QD = OFF_KV + 16777216;
constexpr size_t OFF_OIB = OFF_QD + 8388608;
constexpr size_t OFF_DEC = OFF_KV + 33554432;
constexpr size_t OFF_ST = OFF_DEC + 262144;
constexpr size_t OFF_AQ = OFF_ST + 16777216;
constexpr size_t OFF_QRAW = OFF_AQ + 6291456;
constexpr size_t OFF_AS5 = OFF_QRAW + 6291456;
constexpr size_t OFF_YG = OFF_AS5 + 8388608;
constexpr size_t OFF_TBL = OFF_YG + 8388608;
constexpr size_t OFF_BAR = OFF_TBL + 512;
constexpr size_t OFF_KF = OFF_BAR + 16384;
constexpr size_t WS_END = OFF_KF + 7864320;
constexpr int DYN_LDS = 147456;

__device__ __forceinline__ float bf2f(bf16_t b) { return __uint_as_float(((unsigned)b) << 16); }
__device__ __forceinline__ bf16_t f2bf(float f) { unsigned u = __float_as_uint(f); u += 0x7FFFu + ((u >> 16) & 1u); return (bf16_t)(u >> 16); }
__device__ __forceinline__ unsigned pk2(float lo, float hi) { return pg8::cvt_pk_bf16(lo, hi); }
__device__ __forceinline__ float lo16(unsigned w) { return __uint_as_float(w << 16); }
__device__ __forceinline__ float hi16(unsigned w) { return __uint_as_float(w & 0xffff0000u); }
__device__ __forceinline__ float sigmoidf_(float x) { return 1.f / (1.f + __expf(-x)); }
__device__ __forceinline__ float siluf_(float x) { return x / (1.f + __expf(-x)); }
__device__ __forceinline__ void store8(bf16_t* p, const f32x4& a, const f32x4& b) { u32x4 w; w.x = pk2(a[0], a[1]); w.y = pk2(a[2], a[3]); w.z = pk2(b[0], b[1]); w.w = pk2(b[2], b[3]); *(u32x4*)p = w; }
#define MFMA16(a, b, c) __builtin_amdgcn_mfma_f32_16x16x32_bf16(a, b, c, 0, 0, 0)
#define LDSFRAG(ptr) (*(const LAS bf16x8*)(ptr))

struct Order : pg8::StaticOrder { int wid;
    __device__ void setup(int M, int N, int rot, int wid_) { wid = wid_; const int G = (int)gridDim.x; init(M, N, G, (int)((blockIdx.x + (unsigned)rot) % (unsigned)G)); }
};

struct EpiZ { static constexpr bool PERM = true, AFTER_DRAIN = false; bf16_t* Z;
    __device__ __forceinline__ void operator()(const f32x4 (&acc)[2][2][4][2], const Unit& u, int wr, int wc, int fr_, int fq_) const {
        int fr = fr_, fq = fq_; asm volatile("" : "+v"(fr), "+v"(fq));
        const int row0 = u.pm * 256 + wr * 64 + fr, col0 = u.pn * 256 + wc * 32 + 8 * fq;
#pragma unroll
        for (int ai = 0; ai < 2; ++ai)
#pragma unroll
            for (int m = 0; m < 4; ++m) { bf16_t* rp = Z + (size_t)(row0 + ai * 128 + m * 16) * LDZ + col0;
#pragma unroll
                for (int bj = 0; bj < 2; ++bj) store8(rp + bj * 128, acc[ai][bj][m][0], acc[ai][bj][m][1]); }
    } };
struct EpiQ { static constexpr bool PERM = true, AFTER_DRAIN = false; bf16_t* Q;
    __device__ __forceinline__ void operator()(const f32x4 (&acc)[2][2][4][2], const Unit& u, int wr, int wc, int fr_, int fq_) const {
        int fr = fr_, fq = fq_; asm volatile("" : "+v"(fr), "+v"(fq));
        const int row0 = u.pm * 256 + wr * 64 + fr, col0 = u.pn * 256 + wc * 32 + 8 * fq;
#pragma unroll
        for (int ai = 0; ai < 2; ++ai)
#pragma unroll
            for (int m = 0; m < 4; ++m) { bf16_t* rp = Q + (size_t)(row0 + ai * 128 + m * 16) * 384 + col0;
#pragma unroll
                for (int bj = 0; bj < 2; ++bj) if (col0 + bj * 128 < 384) store8(rp + bj * 128, acc[ai][bj][m][0], acc[ai][bj][m][1]);
                }
    } };
struct EpiKV { static constexpr bool PERM = true, AFTER_DRAIN = true; bf16_t* KF; bf16_t* V; int layer; const bf16_t* Z; const float* ckr; const float* khn; const float* R;
    __device__ __forceinline__ void fused(f32x4 (&acc)[2][2][4][2], const Unit& u, int wr, int wc, int fr_, int fq_, LAS unsigned char* lds, int wid, int lane_) const {
        if (u.pn == 0) { (*this)(acc, u, wr, wc, fr_, fq_); return; }
        int fr = fr_, fq = fq_, lane = lane_; asm volatile("" : "+v"(fr), "+v"(fq), "+v"(lane));
        LAS bf16_t* T = (LAS bf16_t*)lds;
#pragma unroll
        for (int ai = 0; ai < 2; ++ai)
#pragma unroll
            for (int m = 0; m < 4; ++m) { const int kl = ai * 128 + wr * 64 + m * 16 + fr;
#pragma unroll
                for (int bj = 0; bj < 2; ++bj) { const int el = bj * 128 + wc * 32 + 8 * fq;
#pragma unroll
                    for (int i = 0; i < 8; i += 2) { const unsigned w = pk2(acc[ai][bj][m][i >> 2][i & 3], acc[ai][bj][m][i >> 2][(i & 3) + 1]); T[(el + i) * 264 + kl] = (bf16_t)(w & 0xffffu); T[(el + i + 1) * 264 + kl] = (bf16_t)(w >> 16); } } }
        __syncthreads();
        int rb = u.pm * 256; if (layer == 0) rb = rb < 2048 ? 8192 + rb : rb - 2048;
        bf16_t* bp; int st;
        if (rb < 4096) { bp = V + (size_t)(rb >> 8) * 4 * 128 * 256; st = 256; }
        else if (rb < 8192) { bp = V + 2097152 + (size_t)((rb - 4096) >> 10) * 4 * 128 * 1536 + 512 + ((rb - 4096) & 1023); st = 1536; }
        else { bp = V + 2097152 + (size_t)((rb - 8192) >> 9) * 4 * 128 * 1536 + ((rb - 8192) & 511); st = 1536; }
        const int tid = wid * 64 + lane;
#pragma unroll
        for (int i = 0; i < 16; ++i) { const int idx = tid + 512 * i, el = idx >> 5, part = idx & 31;
            *(u32x4*)(bp + (size_t)((u.pn - 1) * 256 + el) * st + part * 8) = *(const LAS u32x4*)(T + el * 264 + part * 8); }
        __syncthreads();
    }
    __device__ __forceinline__ void operator()(const f32x4 (&acc)[2][2][4][2], const Unit& u, int wr, int wc, int fr_, int fq_) const {
        int fr = fr_, fq = fq_; asm volatile("" : "+v"(fr), "+v"(fq));
        int rb = u.pm * 256; if (layer == 0) rb = rb < 2048 ? 8192 + rb : rb - 2048;
        const int row0 = rb + wr * 64 + fr;
        float w1[4], w2[4];
#pragma unroll
        for (int i = 0; i < 4; ++i) { w1[i] = khn[64 + 4 * fq + i]; w2[i] = khn[80 + 4 * fq + i]; }
#pragma unroll
        for (int ai = 0; ai < 2; ++ai)
#pragma unroll
          for (int mh = 0; mh < 4; mh += 1) {
            float x1[4][4], x2[4][4], cs[4][4], sn[4][4];
#pragma unroll
            for (int m = mh; m < mh + 1; ++m) { const int r = row0 + ai * 128 + m * 16;
                if (r >= 8192) { const int j = r - 8192; const float* kr = ckr + ((size_t)(((j >> 9) * 2 + layer) * 512 + (j & 511))) * 32 + 4 * fq;
                    const f32x4 a = *(const f32x4*)kr, b = *(const f32x4*)(kr + 16);
#pragma unroll
                    for (int i = 0; i < 4; ++i) { x1[m][i] = a[i]; x2[m][i] = b[i]; } }
                else { const bf16_t* kr = Z + (size_t)r * LDZ + ZMKR + 4 * fq; const u32x2 a = *(const u32x2*)kr, b = *(const u32x2*)(kr + 16);
                    x1[m][0] = lo16(a.x); x1[m][1] = hi16(a.x); x1[m][2] = lo16(a.y); x1[m][3] = hi16(a.y); x2[m][0] = lo16(b.x); x2[m][1] = hi16(b.x); x2[m][2] = lo16(b.y); x2[m][3] = hi16(b.y); }
                const bool rot = r >= 4096 && r < 8192; const int pos = (r - 4096) & 1023;
                if (rot) { const f32x4 c = *(const f32x4*)(R + pos * 16 + 4 * fq), s_ = *(const f32x4*)(R + 16384 + pos * 16 + 4 * fq);
#pragma unroll
                    for (int i = 0; i < 4; ++i) { cs[m][i] = c[i]; sn[m][i] = s_[i]; } }
                else {
#pragma unroll
                    for (int i = 0; i < 4; ++i) { cs[m][i] = 1.f; sn[m][i] = 0.f; } } }
#pragma unroll
            for (int m = mh; m < mh + 1; ++m) { const int r = row0 + ai * 128 + m * 16;
                float ss = 0.f;
#pragma unroll
                for (int bj = 0; bj < 2; ++bj)
#pragma unroll
                    for (int i = 0; i < 8; ++i) { const float v = acc[ai][bj][m][i >> 2][i & 3]; ss += v * v; }
#pragma unroll
                for (int i = 0; i < 4; ++i) ss += x1[m][i] * x1[m][i] + x2[m][i] * x2[m][i];
                ss += __shfl_xor(ss, 16); ss += __shfl_xor(ss, 32);
                const float rstd = rsqrtf(ss * (1.f / 96.f) + 1e-6f);
                bf16_t* kp = KF + (size_t)r * 384 + wc * 96;
#pragma unroll
                for (int bj = 0; bj < 2; ++bj) { u32x4 w; const f32x4 v0 = acc[ai][bj][m][0], v1 = acc[ai][bj][m][1];
                    w.x = pk2(v0[0] * rstd, v0[1] * rstd); w.y = pk2(v0[2] * rstd, v0[3] * rstd);
                    w.z = pk2(v1[0] * rstd, v1[1] * rstd); w.w = pk2(v1[2] * rstd, v1[3] * rstd);
                    *(u32x4*)(kp + 32 * bj + 8 * fq) = w; }
                float o1[4], o2[4];
#pragma unroll
                for (int i = 0; i < 4; ++i) { const float a = x1[m][i] * rstd * w1[i], b = x2[m][i] * rstd * w2[i]; o1[i] = a * cs[m][i] - b * sn[m][i]; o2[i] = a * sn[m][i] + b * cs[m][i]; }
                *(u32x2*)(kp + 64 + 4 * fq) = (u32x2){pk2(o1[0], o1[1]), pk2(o1[2], o1[3])}; *(u32x2*)(kp + 80 + 4 * fq) = (u32x2){pk2(o2[0], o2[1]), pk2(o2[2], o2[3])}; }
            __builtin_amdgcn_sched_barrier(0); }
    } };
struct EpiGLU { static constexpr bool PERM = true, AFTER_DRAIN = false; bf16_t* O; const bf16_t* Z; const float* bias;
    __device__ __forceinline__ void operator()(const f32x4 (&acc)[2][2][4][2], const Unit& u, int wr, int wc, int fr_, int fq_) const {
        int fr = fr_, fq = fq_; asm volatile("" : "+v"(fr), "+v"(fq));
        const int row0 = u.pm * 256 + wr * 64 + fr, oc = u.pn * 128 + wc * 32 + 8 * fq;
#pragma unroll
        for (int ai = 0; ai < 2; ++ai) {
            float bv[8], bg[8];
            { const f32x4 b0 = *(const f32x4*)(bias + oc), b1 = *(const f32x4*)(bias + oc + 4), g0 = *(const f32x4*)(bias + 512 + oc), g1 = *(const f32x4*)(bias + 512 + oc + 4);
#pragma unroll
              for (int i = 0; i < 4; ++i) { bv[i] = b0[i]; bv[4 + i] = b1[i]; bg[i] = g0[i]; bg[4 + i] = g1[i]; } }
            u32x4 sgv[2][4];
#pragma unroll
            for (int m = 0; m < 4; ++m) sgv[ai][m] = *(const u32x4*)(Z + (size_t)(row0 + ai * 128 + m * 16) * LDZ + ZSG + oc);
#pragma unroll
            for (int m = 0; m < 4; ++m) { const size_t r = (size_t)(row0 + ai * 128 + m * 16);
                const u32x4 sg = sgv[ai][m];
                float g[8] = { lo16(sg.x), hi16(sg.x), lo16(sg.y), hi16(sg.y), lo16(sg.z), hi16(sg.z), lo16(sg.w), hi16(sg.w) };
                float o[8];
#pragma unroll
                for (int i = 0; i < 8; ++i) { const float zv = acc[ai][0][m][i >> 2][i & 3] + bv[i], zg = acc[ai][1][m][i >> 2][i & 3] + bg[i]; o[i] = zv * sigmoidf_(zg) * siluf_(g[i]); }
                u32x4 w; w.x = pk2(o[0], o[1]); w.y = pk2(o[2], o[3]); w.z = pk2(o[4], o[5]); w.w = pk2(o[6], o[7]);
                *(u32x4*)(O + r * 512 + oc) = w; }
            __builtin_amdgcn_sched_barrier(0); }
    } };
struct EpiBo { static constexpr bool PERM = true, AFTER_DRAIN = true; bf16_t* MIX; const bf16_t* Z; int branch;
    __device__ __forceinline__ void fused(f32x4 (&acc)[2][2][4][2], const Unit& u, int wr, int wc, int fr_, int fq_, LAS unsigned char* lds, int wid, int lane_) const {
        int fr = fr_, fq = fq_, lane = lane_; asm volatile("" : "+v"(fr), "+v"(fq), "+v"(lane));
        const int row0 = u.pm * 256 + wr * 64 + fr, col0 = u.pn * 256 + wc * 32 + 8 * fq;
        LAS unsigned char* wl = lds + wid * 16384;
#pragma unroll
        for (int ai = 0; ai < 2; ++ai)
#pragma unroll
            for (int m = 0; m < 4; ++m)
#pragma unroll
                for (int bj = 0; bj < 2; ++bj)
                    __builtin_amdgcn_global_load_lds((const unsigned*)(Z + (size_t)(row0 + ai * 128 + m * 16) * LDZ + ZMERGE + branch * 1024 + col0 + bj * 128), (LAS unsigned*)(wl + ((ai * 4 + m) * 2 + bj) * 1024), 16, 0, 0);
#pragma unroll
        for (int ai = 0; ai < 2; ++ai) {
            u32x4 pv[4][2];
#pragma unroll
            for (int m = 0; m < 4; ++m)
#pragma unroll
                for (int bj = 0; bj < 2; ++bj) pv[m][bj] = branch > 0 ? *(const u32x4*)(MIX + (size_t)(row0 + ai * 128 + m * 16) * 1024 + col0 + bj * 128) : (u32x4){0u, 0u, 0u, 0u};
            if (ai == 0) { asm volatile("s_waitcnt vmcnt(0)" ::: "memory"); __builtin_amdgcn_s_barrier(); asm volatile("" ::: "memory"); }
#pragma unroll
            for (int m = 0; m < 4; ++m) { const size_t r = (size_t)(row0 + ai * 128 + m * 16);
#pragma unroll
                for (int bj = 0; bj < 2; ++bj) { const u32x4 sg = *(const LAS u32x4*)(wl + ((ai * 4 + m) * 2 + bj) * 1024 + lane * 16), pp = pv[m][bj];
                    const float g[8] = { lo16(sg.x), hi16(sg.x), lo16(sg.y), hi16(sg.y), lo16(sg.z), hi16(sg.z), lo16(sg.w), hi16(sg.w) };
                    const float q[8] = { lo16(pp.x), hi16(pp.x), lo16(pp.y), hi16(pp.y), lo16(pp.z), hi16(pp.z), lo16(pp.w), hi16(pp.w) };
                    float o[8];
#pragma unroll
                    for (int i = 0; i < 8; ++i) o[i] = q[i] + sigmoidf_(g[i]) * acc[ai][bj][m][i >> 2][i & 3];
                    u32x4 w; w.x = pk2(o[0], o[1]); w.y = pk2(o[2], o[3]); w.z = pk2(o[4], o[5]); w.w = pk2(o[6], o[7]);
                    *(u32x4*)(MIX + r * 1024 + col0 + bj * 128) = w; } }
            __builtin_amdgcn_sched_barrier(0); }
        __syncthreads();
    }
    __device__ __forceinline__ void operator()(const f32x4 (&acc)[2][2][4][2], const Unit& u, int wr, int wc, int fr_, int fq_) const {
        int fr = fr_, fq = fq_; asm volatile("" : "+v"(fr), "+v"(fq));
        const int row0 = u.pm * 256 + wr * 64 + fr, col0 = u.pn * 256 + wc * 32 + 8 * fq;
#pragma unroll
        for (int ai = 0; ai < 2; ++ai)
#pragma unroll
          for (int mh = 0; mh < 4; mh += 2) {
            u32x4 gz[4][2], pv[4][2];
#pragma unroll
            for (int m = mh; m < mh + 2; ++m)
#pragma unroll
                for (int bj = 0; bj < 2; ++bj) { const size_t r = (size_t)(row0 + ai * 128 + m * 16);
                    gz[m][bj] = *(const u32x4*)(Z + r * LDZ + ZMERGE + branch * 1024 + col0 + bj * 128);
                    pv[m][bj] = branch > 0 ? *(const u32x4*)(MIX + r * 1024 + col0 + bj * 128) : (u32x4){0u, 0u, 0u, 0u}; }
#pragma unroll
            for (int m = mh; m < mh + 2; ++m) { const size_t r = (size_t)(row0 + ai * 128 + m * 16);
#pragma unroll
                for (int bj = 0; bj < 2; ++bj) { const u32x4 sg = gz[m][bj], pp = pv[m][bj];
                    const float g[8] = { lo16(sg.x), hi16(sg.x), lo16(sg.y), hi16(sg.y), lo16(sg.z), hi16(sg.z), lo16(sg.w), hi16(sg.w) };
                    const float q[8] = { lo16(pp.x), hi16(pp.x), lo16(pp.y), hi16(pp.y), lo16(pp.z), hi16(pp.z), lo16(pp.w), hi16(pp.w) };
                    float o[8];
#pragma unroll
                    for (int i = 0; i < 8; ++i) o[i] = q[i] + sigmoidf_(g[i]) * acc[ai][bj][m][i >> 2][i & 3];
                    u32x4 w; w.x = pk2(o[0], o[1]); w.y = pk2(o[2], o[3]); w.z = pk2(o[4], o[5]); w.w = pk2(o[6], o[7]);
                    *(u32x4*)(MIX + r * 1024 + col0 + bj * 128) = w; } }
            __builtin_amdgcn_sched_barrier(0); }
    } };
struct EpiOut { static constexpr bool PERM = false, AFTER_DRAIN = true; float* Y; const float* xp; const float* xs; const float* ada;
    __device__ __forceinline__ void fused(f32x4 (&acc)[2][2][4][2], const Unit& u, int wr, int wc, int fr_, int fq_, LAS unsigned char* lds, int wid, int lane_) const {
        int fr = fr_, fq = fq_, lane = lane_; asm volatile("" : "+v"(fr), "+v"(fq), "+v"(lane));
        const int row0 = u.pm * 256 + wr * 64 + fr, col0 = u.pn * 256 + wc * 32 + 4 * fq;
        LAS unsigned char* wl = lds + wid * 16384;
        const float* xb = (u.pm < 16 ? xp + (size_t)row0 * 1024 : xs + (size_t)(row0 - 4096) * 1024) + col0;
#pragma unroll
        for (int m = 0; m < 4; ++m)
#pragma unroll
            for (int bj = 0; bj < 2; ++bj)
#pragma unroll
                for (int n = 0; n < 2; ++n) __builtin_amdgcn_global_load_lds((const unsigned*)(xb + (size_t)(m * 16) * 1024 + bj * 128 + n * 16), (LAS unsigned*)(wl + ((m * 2 + bj) * 2 + n) * 1024), 16, 0, 0);
        f32x4 x1[4][2][2];
#pragma unroll
        for (int m = 0; m < 4; ++m)
#pragma unroll
            for (int bj = 0; bj < 2; ++bj)
#pragma unroll
                for (int n = 0; n < 2; ++n) x1[m][bj][n] = *(const f32x4*)(xb + (size_t)(128 + m * 16) * 1024 + bj * 128 + n * 16);
        const int ar = u.pm < 16 ? 0 : 1 + ((u.pm - 16) >> 2);
        const float* gp = ada + ar * 3072 + 2048;
        f32x4 gv[2][2];
#pragma unroll
        for (int bj = 0; bj < 2; ++bj)
#pragma unroll
            for (int n = 0; n < 2; ++n) gv[bj][n] = *(const f32x4*)(gp + col0 + bj * 128 + n * 16);
        asm volatile("s_waitcnt vmcnt(0)" ::: "memory"); __builtin_amdgcn_s_barrier(); asm volatile("" ::: "memory");
        float* yb = Y + (size_t)row0 * 1024 + col0;
#pragma unroll
        for (int m = 0; m < 4; ++m)
#pragma unroll
            for (int bj = 0; bj < 2; ++bj)
#pragma unroll
                for (int n = 0; n < 2; ++n) { const f32x4 xv = *(const LAS f32x4*)(wl + ((m * 2 + bj) * 2 + n) * 1024 + lane * 16);
                    *(f32x4*)(yb + (size_t)(m * 16) * 1024 + bj * 128 + n * 16) = xv + gv[bj][n] * acc[0][bj][m][n];
                    *(f32x4*)(yb + (size_t)(128 + m * 16) * 1024 + bj * 128 + n * 16) = x1[m][bj][n] + gv[bj][n] * acc[1][bj][m][n]; }
        __syncthreads();
    }
    __device__ __forceinline__ void operator()(const f32x4 (&acc)[2][2][4][2], const Unit& u, int wr, int wc, int fr_, int fq_) const {
        int fr = fr_, fq = fq_; asm volatile("" : "+v"(fr), "+v"(fq));
        const int row0 = u.pm * 256 + wr * 64 + fr, col0 = u.pn * 256 + wc * 32 + 4 * fq;
        const int ar = u.pm < 16 ? 0 : 1 + ((u.pm - 16) >> 2);
        const float* gp = ada + ar * 3072 + 2048;
        f32x4 gv[2][2];
#pragma unroll
        for (int bj = 0; bj < 2; ++bj)
#pragma unroll
            for (int n = 0; n < 2; ++n) gv[bj][n] = *(const f32x4*)(gp + col0 + bj * 128 + n * 16);
#pragma unroll
        for (int ai = 0; ai < 2; ++ai)
#pragma unroll
          for (int mh = 0; mh < 4; mh += 2) {
            f32x4 xv[4][2][2];
#pragma unroll
            for (int m = mh; m < mh + 2; ++m) { const int r = row0 + ai * 128 + m * 16;
                const float* xr = (r < 4096 ? xp + (size_t)r * 1024 : xs + (size_t)(r - 4096) * 1024) + col0;
#pragma unroll
                for (int bj = 0; bj < 2; ++bj)
#pragma unroll
                    for (int n = 0; n < 2; ++n) xv[m][bj][n] = *(const f32x4*)(xr + bj * 128 + n * 16); }
#pragma unroll
            for (int m = mh; m < mh + 2; ++m) { const int r = row0 + ai * 128 + m * 16;
                float* yr = Y + (size_t)r * 1024 + col0;
#pragma unroll
                for (int bj = 0; bj < 2; ++bj)
#pragma unroll
                    for (int n = 0; n < 2; ++n) *(f32x4*)(yr + bj * 128 + n * 16) = xv[m][bj][n] + gv[bj][n] * acc[ai][bj][m][n]; }
            __builtin_amdgcn_sched_barrier(0); }
    } };

__device__ __forceinline__ void job_ada(const Params& p, int j, lds_t lds) {
    LAS float* sc = (LAS float*)lds; LAS float* red = sc + 5 * 1024;
    const int l = j / 96, c0 = (j % 96) * 32, tid = tid_opaque(p);
    for (int i = tid; i < 5 * 1024; i += 512) { const int r = i >> 10, k = i & 1023; const float v = r == 0 ? p.in[I_CCTX][k] : p.in[I_C][(r - 1) * 1024 + k]; sc[i] = v / (1.f + expf(-v)); }
    __syncthreads();
    const int col = tid & 31, kg = tid >> 5; const float* W = p.in[I_WADA] + (size_t)l * 1024 * 3072 + (size_t)(kg * 64) * 3072 + c0 + col;
    float a0 = 0.f, a1 = 0.f, a2 = 0.f, a3 = 0.f, a4 = 0.f;
#pragma unroll 1
    for (int kb = 0; kb < 64; kb += 16) { float w[16];
#pragma unroll
        for (int i = 0; i < 16; ++i) w[i] = W[(size_t)(kb + i) * 3072];
#pragma unroll
        for (int i = 0; i < 16; ++i) { const int k = kg * 64 + kb + i; a0 += sc[k] * w[i]; a1 += sc[1024 + k] * w[i]; a2 += sc[2048 + k] * w[i]; a3 += sc[3072 + k] * w[i]; a4 += sc[4096 + k] * w[i]; } }
    red[(kg * 5 + 0) * 32 + col] = a0; red[(kg * 5 + 1) * 32 + col] = a1; red[(kg * 5 + 2) * 32 + col] = a2; red[(kg * 5 + 3) * 32 + col] = a3; red[(kg * 5 + 4) * 32 + col] = a4;
    __syncthreads();
    if (tid < 160) { const int r = tid >> 5, cc = tid & 31; float s = p.in[I_BADA][l * 3072 + c0 + cc];
        for (int g = 0; g < 16; ++g) s += red[(g * 5 + r) * 32 + cc];
        ((float*)(p.ws + OFF_ADA))[(l * 5 + r) * 3072 + c0 + cc] = s; }
    __syncthreads();
}
__device__ __forceinline__ void job_ctx(const Params& p, int j) {
    const int base = j * 4096 + tid_opaque(p) * 8; const int l = base / (2048 * 256), rem = base % (2048 * 256), row = rem >> 8, c = rem & 255, b = row >> 9, jj = row & 511;
    const float* s = p.in[I_CKV] + ((size_t)((b * 2 + l) * 512 + jj)) * 256 + c;
    const f32x4 v0 = *(const f32x4*)s, v1 = *(const f32x4*)(s + 4);
    bf16_t* d = (bf16_t*)(p.ws + (l == 0 ? OFF_CTX0 : OFF_CTX1)) + (size_t)row * 256 + c;
    store8(d, v0, v1);
}
__device__ __forceinline__ void job_rope(const Params& p, int j) {
    const int idx = j * 512 + tid_opaque(p), pos = idx >> 4, i = idx & 15, f = i & 7;
    const float inv = powf(10000.f, -(float)f / 8.f); const float ang = (float)(i < 8 ? (pos >> 6) : (pos & 63)) * inv;
    float* R = (float*)(p.ws + OFF_ROPE); R[idx] = cosf(ang); R[16384 + idx] = sinf(ang);
}

__device__ __forceinline__ void job_prep(const Params& p, int l, int j) {
    const int tid = tid_opaque(p), wid = tid >> 6, lane = tid & 63, row = j * 8 + wid;
    const float* x = l == 0 ? (row < 4096 ? p.in[I_XP] + (size_t)row * 1024 : p.in[I_XS] + (size_t)(row - 4096) * 1024) : p.out + (size_t)row * 1024;
    const int ar = row < 4096 ? 0 : 1 + ((row - 4096) >> 10);
    const float* ada = (const float*)(p.ws + OFF_ADA) + (l * 5 + ar) * 3072; const float* nw = p.in[I_NORMW] + l * 1024;
    f32x4 v[4]; float ss = 0.f;
#pragma unroll
    for (int i = 0; i < 4; ++i) { v[i] = *(const f32x4*)(x + i * 256 + lane * 4); ss += v[i][0] * v[i][0] + v[i][1] * v[i][1] + v[i][2] * v[i][2] + v[i][3] * v[i][3]; }
#pragma unroll
    for (int o = 1; o < 64; o <<= 1) ss += __shfl_xor(ss, o);
    const float rstd = rsqrtf(ss * (1.f / 1024.f) + 1e-6f);
    bf16_t* h = (bf16_t*)(p.ws + OFF_HB) + (size_t)row * 1024;
#pragma unroll
    for (int i = 0; i < 4; ++i) { const int c = i * 256 + lane * 4; const f32x4 w = *(const f32x4*)(nw + c), sh = *(const f32x4*)(ada + c), sc = *(const f32x4*)(ada + 1024 + c);
        float o[4];
#pragma unroll
        for (int k = 0; k < 4; ++k) o[k] = v[i][k] * rstd * w[k] * (1.f + sc[k]) + sh[k];
        u32x2 pk; pk.x = pk2(o[0], o[1]); pk.y = pk2(o[2], o[3]); *(u32x2*)(h + c) = pk; }
}
__device__ __forceinline__ void wt_tile(const Params& p, const float* src, int ldsrc, int sbase, int nvalid, int mode, bf16_t* dst, int K, int n0, int k0, lds_t lds) {
    LAS float* t = (LAS float*)lds; const int tid = tid_opaque(p);
    const int nn = tid & 255, kh = tid >> 8; const int sc = mode == 0 ? sbase + nn : mode == 1 ? ((nn >> 7) & 1) * 512 + sbase + (nn & 127) : ((nn >> 5) & 3) * 64 + (nn >> 7) * 32 + (nn & 31); const bool ok = mode != 0 || nn < nvalid;
    float v[32];
#pragma unroll
    for (int i = 0; i < 32; ++i) v[i] = ok ? src[(size_t)(k0 + 2 * i + kh) * ldsrc + sc] : 0.f;
#pragma unroll
    for (int i = 0; i < 32; ++i) t[(2 * i + kh) * 257 + nn] = v[i];
    __syncthreads();
#pragma unroll
    for (int ps = 0; ps < 4; ++ps) { const int n = ps * 64 + (tid >> 3), kc = tid & 7; const LAS float* s = t + (kc * 8) * 257 + n; u32x4 w;
        w.x = pk2(s[0], s[257]); w.y = pk2(s[514], s[771]); w.z = pk2(s[1028], s[1285]); w.w = pk2(s[1542], s[1799]);
        *(u32x4*)(dst + (size_t)(n0 + n) * K + k0 + kc * 8) = w; }
    __syncthreads();
}
constexpr int WT_WIN = 27 * 16, WT_WUQ = 2 * 6, WT_WKV = 3 * 4, WT_WGLU = 4 * 8, WT_WBO = 4 * 8, WT_WOUT = 4 * 16, WT_EARLY = WT_WIN + WT_WUQ + WT_WKV + WT_WGLU, WT_TOTAL = WT_EARLY + 3 * WT_WBO + WT_WOUT;
__device__ __forceinline__ void job_wt(const Params& p, int l, int t, lds_t lds) {
    if (t < WT_WIN) { const int nt = t / 16, kt = t % 16; wt_tile(p, p.in[I_WIN] + (size_t)l * 1024 * 6848, 6848, nt * 256, 6848 - nt * 256, 0, (bf16_t*)(p.ws + OFF_WIN), 1024, nt * 256, kt * 64, lds); return; } t -= WT_WIN;
    if (t < WT_WUQ) { const int nt = t / 6, kt = t % 6; wt_tile(p, p.in[I_WUQ] + (size_t)l * 384 * 384, 384, nt * 256, 384 - nt * 256, 0, (bf16_t*)(p.ws + OFF_WUQ), 384, nt * 256, kt * 64, lds); return; } t -= WT_WUQ;
    if (t < WT_WKV) { const int nt = t / 4, kt = t % 4;
        if (nt == 0) wt_tile(p, p.in[I_WUK] + (size_t)l * 256 * 256, 256, 0, 256, 2, (bf16_t*)(p.ws + OFF_WKV), 256, 0, kt * 64, lds);
        else wt_tile(p, p.in[I_WUV] + (size_t)l * 256 * 512, 512, (nt - 1) * 256, 256, 0, (bf16_t*)(p.ws + OFF_WKV), 256, nt * 256, kt * 64, lds);
        return; } t -= WT_WKV;
    if (t < WT_WGLU) { const int nt = t / 8, kt = t % 8; wt_tile(p, p.in[I_WGLU] + (size_t)l * 512 * 1024, 1024, nt * 128, 256, 1, (bf16_t*)(p.ws + OFF_WGLU), 512, nt * 256, kt * 64, lds); return; } t -= WT_WGLU;
    if (t < 3 * WT_WBO) { const int br = t / WT_WBO, tt = t % WT_WBO, nt = tt / 8, kt = tt % 8;
        wt_tile(p, p.in[I_WBOG + br] + (size_t)l * 512 * 1024, 1024, nt * 256, 256, 0, (bf16_t*)(p.ws + OFF_WBO) + (size_t)br * 1024 * 512, 512, nt * 256, kt * 64, lds); return; } t -= 3 * WT_WBO;
    { const int nt = t / 16, kt = t % 16; wt_tile(p, p.in[I_WOUT] + (size_t)l * 1024 * 1024, 1024, nt * 256, 256, 0, (bf16_t*)(p.ws + OFF_WOUT), 1024, nt * 256, kt * 64, lds); }
}
__device__ __forceinline__ void job_s5setup(const Params& p, int l, int jq, lds_t lds) {
    const int j = jq >> 2, qtr = jq & 3, g = j / 3, which = j % 3, tid = tid_opaque(p);
    LAS f32x2_t* pw = (LAS f32x2_t*)lds;
    LAS f32x2_t* Bt = pw + 2 * 17 * 64;
    LAS f32x2_t* Cn = Bt + 2 * 64 * 16;
    LAS float* Kt = (LAS float*)(Cn + 64 * 16);
    LAS float* raw = Kt + 8192;
    { const size_t gb = (size_t)(l * 32 + g) * 1024;
      for (int i = tid; i < 1024; i += 512) { raw[i] = p.in[I_BRE][gb + i]; raw[1024 + i] = p.in[I_BIM][gb + i]; raw[2048 + i] = p.in[I_CRE][gb + i]; raw[3072 + i] = p.in[I_CIM][gb + i]; }
      if (tid < 128) { const int d = tid >> 6, n = tid & 63; raw[4096 + tid] = p.in[I_ARE][((l * 2 + d) * 32 + g) * 64 + n]; raw[4224 + tid] = p.in[I_AIM][((l * 2 + d) * 32 + g) * 64 + n]; }
      if (tid < 2) raw[4352 + tid] = p.in[I_LOGDT][(l * 2 + tid) * 32 + g]; }
    __syncthreads();
    if (tid < 128) { const int d = tid >> 6, n = tid & 63;
        const float dt = expf(raw[4352 + d]);
        const float are = raw[4096 + tid], aim = raw[4224 + tid];
        float s1, c1; sincosf(aim * dt, &s1, &c1); float sh = sinf(0.5f * aim * dt);
        const float em1 = expm1f(are * dt), mag1 = em1 + 1.f;
        { float pr = 1.f, pi = 0.f; const float ar1 = mag1 * c1, ai1 = mag1 * s1;
          for (int tau = 0; tau <= 16; ++tau) { pw[(d * 17 + tau) * 64 + n] = (f32x2_t){pr, pi}; const float nr = pr * ar1 - pi * ai1, ni = pr * ai1 + pi * ar1; pr = nr; pi = ni; } }
        const float nre = em1 * c1 - 2.f * sh * sh, abim = mag1 * s1, den = are * are + aim * aim;
        const float cfr = (nre * are + abim * aim) / den, cfi = (abim * are - nre * aim) / den;
        for (int q = 0; q < 16; ++q) { const float br = raw[n * 16 + q], bi = raw[1024 + n * 16 + q];
            Bt[(d * 64 + n) * 16 + q] = (f32x2_t){cfr * br - cfi * bi, cfr * bi + cfi * br}; }
        if (which == 1 && qtr == 0) ((f32x2_t*)(p.ws + OFF_P16))[(g * 2 + d) * 64 + n] = pw[(d * 17 + 16) * 64 + n];
    }
    for (int i = tid; i < 1024; i += 512) { const int n = i >> 4, pp = i & 15; Cn[i] = (f32x2_t){raw[2048 + pp * 64 + n], raw[3072 + pp * 64 + n]}; }
    __syncthreads();
    bf16_t* M = (bf16_t*)(p.ws + OFF_S5M) + (size_t)(g * 3 + which) * 65536;
    if (which == 0) {
        { const int wid_ = tid >> 6, ln = tid & 63, lr_ = ln & 15, kq = ln >> 4;
          for (int c4 = 0; c4 < 4; ++c4) { const int dt_ = wid_ * 4 + c4, d = dt_ >> 4, tau = dt_ & 15; f32x4 acc = {0.f, 0.f, 0.f, 0.f};
#pragma unroll 4
            for (int ks = 0; ks < 16; ++ks) { const int n = ks * 4 + kq; const f32x2_t c = Cn[n * 16 + lr_], w = pw[(d * 17 + tau) * 64 + n], b = Bt[(d * 64 + n) * 16 + lr_];
                const float cwr = c.x * w.x - c.y * w.y, cwi = c.x * w.y + c.y * w.x;
                acc = __builtin_amdgcn_mfma_f32_16x16x4f32(cwr, b.x, acc, 0, 0, 0); acc = __builtin_amdgcn_mfma_f32_16x16x4f32(-cwi, b.y, acc, 0, 0, 0); }
#pragma unroll
            for (int r = 0; r < 4; ++r) Kt[dt_ * 256 + (kq * 4 + r) * 16 + lr_] = acc[r]; } }
        __syncthreads();
#pragma unroll 8
        for (int i = qtr * 16384 + tid; i < (qtr + 1) * 16384; i += 512) { const int no = i >> 8, k = i & 255, t = no >> 4, pp = no & 15, s = k >> 4, q = k & 15; float v;
            if (t > s) v = Kt[(0 * 16 + (t - s)) * 256 + pp * 16 + q];
            else if (t < s) v = Kt[(1 * 16 + (s - t)) * 256 + pp * 16 + q];
            else { v = Kt[pp * 16 + q] + Kt[16 * 256 + pp * 16 + q]; if (pp == q) v += p.in[I_S5D][l * 512 + g * 16 + pp]; }
            M[i] = f2bf(v); }
    } else if (which == 1) {
#pragma unroll 8
        for (int i = qtr * 16384 + tid; i < (qtr + 1) * 16384; i += 512) { const int no = i >> 8, k = i & 255, d = no >> 7, ri = (no >> 6) & 1, n = no & 63, s = k >> 4, q = k & 15; const int e = d == 0 ? 15 - s : s;
            const f32x2_t w = pw[(d * 17 + e) * 64 + n], b = Bt[(d * 64 + n) * 16 + q];
            M[i] = f2bf(ri == 0 ? w.x * b.x - w.y * b.y : w.x * b.y + w.y * b.x); }
    } else {
#pragma unroll 8
        for (int i = qtr * 16384 + tid; i < (qtr + 1) * 16384; i += 512) { const int no = i >> 8, k = i & 255, t = no >> 4, pp = no & 15, d = k >> 7, ri = (k >> 6) & 1, n = k & 63; const int e = d == 0 ? t + 1 : 16 - t;
            const f32x2_t c = Cn[n * 16 + pp], w = pw[(d * 17 + e) * 64 + n];
            M[i] = f2bf(ri == 0 ? c.x * w.x - c.y * w.y : -(c.x * w.y + c.y * w.x)); }
    }
    __syncthreads();
}

__device__ __forceinline__ float gelu_tanh(float x) { const float u = 0.7978845608f * (x + 0.044715f * x * x * x); const float t = 1.f - 2.f / (1.f + __expf(2.f * u)); return 0.5f * x * (1.f + t); }
__device__ __forceinline__ void job_s5(const Params& p, int l, int j, lds_t lds) {
    const int tid = tid_opaque(p), wid = tid >> 6, lane = tid & 63, lr = lane & 15, lq = lane >> 4;
    const int bb = j >> 5, g = j & 31;
    const int M = bb < 16 ? 16 : 64, MT = M >> 4; const int tok0 = bb < 16 ? bb * 256 : 4096 + (bb - 16) * 1024;
    LAS bf16_t* Us = (LAS bf16_t*)lds; LAS bf16_t* Xs = Us + 64 * 264; LAS float* Xin = (LAS float*)(lds + 2 * 64 * 264 * 2);
    const bf16_t* Z = (const bf16_t*)(p.ws + OFF_Z);
    const bf16_t* TT = (const bf16_t*)(p.ws + OFF_S5M) + (size_t)(g * 3) * 65536; const bf16_t* G = TT + 65536; const bf16_t* Cc = G + 65536;
    bf16x8 bq[8][2];
#pragma unroll
    for (int ks = 0; ks < 8; ++ks) { bq[ks][0] = *(const bf16x8*)(G + (size_t)(wid * 32 + lr) * 256 + ks * 32 + lq * 8); bq[ks][1] = *(const bf16x8*)(G + (size_t)(wid * 32 + 16 + lr) * 256 + ks * 32 + lq * 8); }
    f32x2_t a16 = {0.f, 0.f}; float xr = 0.f, xi = 0.f;
    if (tid < 128) { const int d = tid >> 6, n = tid & 63; a16 = ((const f32x2_t*)(p.ws + OFF_P16))[(g * 2 + d) * 64 + n];
        if (bb >= 16) { const size_t o = ((size_t)(((bb - 16) * 2 + l) * 2 + d) * 2) * 2048 + g * 64 + n; xr = p.in[I_SS5][o]; xi = p.in[I_SS5][o + 2048]; } }
    for (int idx = tid; idx < M * 32; idx += 512) { const int tok = idx >> 1, hf = idx & 1;
        *(LAS u32x4*)(Us + (tok >> 4) * 264 + (tok & 15) * 16 + hf * 8) = *(const u32x4*)(Z + (size_t)(tok0 + tok) * LDZ + ZSU + g * 16 + hf * 8); }
    __syncthreads();
    f32x4 acc[4][2];
#pragma unroll
    for (int a = 0; a < 4; ++a) { acc[a][0] = (f32x4){0.f, 0.f, 0.f, 0.f}; acc[a][1] = acc[a][0]; }
#pragma unroll
    for (int ks = 0; ks < 8; ++ks)
#pragma unroll
        for (int mt = 0; mt < 4; ++mt) if (mt < MT) { const bf16x8 a = LDSFRAG(Us + (mt * 16 + lr) * 264 + ks * 32 + lq * 8); acc[mt][0] = MFMA16(a, bq[ks][0], acc[mt][0]); acc[mt][1] = MFMA16(a, bq[ks][1], acc[mt][1]); }
    bf16x8 bc[8][2];
#pragma unroll
    for (int ks = 0; ks < 8; ++ks) { bq[ks][0] = *(const bf16x8*)(TT + (size_t)(wid * 32 + lr) * 256 + ks * 32 + lq * 8); bq[ks][1] = *(const bf16x8*)(TT + (size_t)(wid * 32 + 16 + lr) * 256 + ks * 32 + lq * 8);
        bc[ks][0] = *(const bf16x8*)(Cc + (size_t)(wid * 32 + lr) * 256 + ks * 32 + lq * 8); bc[ks][1] = *(const bf16x8*)(Cc + (size_t)(wid * 32 + 16 + lr) * 256 + ks * 32 + lq * 8); }
#pragma unroll
    for (int mt = 0; mt < 4; ++mt) if (mt < MT)
#pragma unroll
        for (int ct = 0; ct < 2; ++ct)
#pragma unroll
            for (int r = 0; r < 4; ++r) Xin[(mt * 16 + lq * 4 + r) * 260 + wid * 32 + ct * 16 + lr] = acc[mt][ct][r];
    __syncthreads();
    if (tid < 128) { const int d = tid >> 6, n = tid & 63;
        const int cre = d * 128 + n, cim = cre + 64;
        for (int i = 0; i < M; ++i) { const int c = d == 0 ? i : M - 1 - i;
            Xs[c * 264 + cre] = f2bf(xr); Xs[c * 264 + cim] = f2bf(xi);
            const float ur = Xin[c * 260 + cre], ui = Xin[c * 260 + cim];
            const float nr = a16.x * xr - a16.y * xi + ur, ni = a16.x * xi + a16.y * xr + ui; xr = nr; xi = ni; }
        if (bb < 16) { const size_t o = OUT_S5 + ((size_t)((bb * 2 + l) * 2 + d) * 2) * 2048 + g * 64 + n; p.out[o] = xr; p.out[o + 2048] = xi; }
    }
    __syncthreads();
#pragma unroll
    for (int a = 0; a < 4; ++a) { acc[a][0] = (f32x4){0.f, 0.f, 0.f, 0.f}; acc[a][1] = acc[a][0]; }
#pragma unroll
    for (int ks = 0; ks < 8; ++ks)
#pragma unroll
        for (int mt = 0; mt < 4; ++mt) if (mt < MT) { const bf16x8 a = LDSFRAG(Us + (mt * 16 + lr) * 264 + ks * 32 + lq * 8); acc[mt][0] = MFMA16(a, bq[ks][0], acc[mt][0]); acc[mt][1] = MFMA16(a, bq[ks][1], acc[mt][1]); }
#pragma unroll
    for (int ks = 0; ks < 8; ++ks)
#pragma unroll
        for (int mt = 0; mt < 4; ++mt) if (mt < MT) { const bf16x8 a = LDSFRAG(Xs + (mt * 16 + lr) * 264 + ks * 32 + lq * 8); acc[mt][0] = MFMA16(a, bc[ks][0], acc[mt][0]); acc[mt][1] = MFMA16(a, bc[ks][1], acc[mt][1]); }
    bf16_t* Yg = (bf16_t*)(p.ws + OFF_YG);
#pragma unroll
    for (int mt = 0; mt < 4; ++mt) if (mt < MT)
#pragma unroll
        for (int ct = 0; ct < 2; ++ct)
#pragma unroll
            for (int r = 0; r < 4; ++r) { const int chunk = mt * 16 + lq * 4 + r, t = wid * 2 + ct;
                Yg[(size_t)(tok0 + chunk * 16 + t) * 512 + g * 16 + lr] = f2bf(gelu_tanh(acc[mt][ct][r])); }
    __syncthreads();
}
__device__ __forceinline__ void job_mlaprep(const Params& p, int l, int j) {
    const int tid = tid_opaque(p), wid = tid >> 6, lane = tid & 63, row = j * 8 + wid;
    const bf16_t* z = (const bf16_t*)(p.ws + OFF_Z) + (size_t)row * LDZ;
    float q[6], kv[4]; float sq = 0.f, sk = 0.f;
#pragma unroll
    for (int i = 0; i < 6; ++i) { q[i] = bf2f(z[ZMQ + i * 64 + lane]); sq += q[i] * q[i]; }
#pragma unroll
    for (int i = 0; i < 4; ++i) { kv[i] = bf2f(z[ZMKV + i * 64 + lane]); sk += kv[i] * kv[i]; }
#pragma unroll
    for (int o = 1; o < 64; o <<= 1) { sq += __shfl_xor(sq, o); sk += __shfl_xor(sk, o); }
    const float rq = rsqrtf(sq * (1.f / 384.f) + 1e-6f), rk = rsqrtf(sk * (1.f / 256.f) + 1e-6f);
    bf16_t* aq = (bf16_t*)(p.ws + OFF_AQ) + (size_t)row * 384; bf16_t* ck = (bf16_t*)(p.ws + OFF_CKVN) + (size_t)row * 256;
#pragma unroll
    for (int i = 0; i < 6; ++i) aq[i * 64 + lane] = f2bf(q[i] * rq * p.in[I_QNORM][l * 384 + i * 64 + lane]);
    const bool prompt = row < 4096; const int b = row >> 8, t = row & 255;
#pragma unroll
    for (int i = 0; i < 4; ++i) { const float v = kv[i] * rk * p.in[I_KVNORM][l * 256 + i * 64 + lane]; ck[i * 64 + lane] = f2bf(v);
        if (prompt) p.out[OUT_CKV + ((size_t)((b * 2 + l) * 256 + t)) * 256 + i * 64 + lane] = v; }
    if (prompt && lane < 32) p.out[OUT_KR + ((size_t)((b * 2 + l) * 256 + t)) * 32 + lane] = bf2f(z[ZMKR + lane]);
}
__device__ __forceinline__ float logsigmoidf_(float x) { return fminf(x, 0.f) - __logf(1.f + __expf(-fabsf(x))); }
__device__ __forceinline__ void job_glaA(const Params& p, int l, int j, lds_t lds) {
    const int tid = tid_opaque(p), wid = tid >> 6, lane = tid & 63, lr = lane & 15, lq = lane >> 4;
    const int ck = j >> 2, h = j & 3, tok0 = ck * 64;
    LAS bf16_t* QDf = (LAS bf16_t*)lds; LAS bf16_t* QDb = QDf + 4608; LAS bf16_t* KDf = QDb + 4608; LAS bf16_t* KDb = KDf + 4608; LAS bf16_t* KRf = KDb + 4608; LAS bf16_t* KRb = KRf + 4608;
    LAS bf16_t* VT = KRb + 4608;
    LAS bf16_t* ATT = VT + 9216;
    LAS float* GA = (LAS float*)(ATT + 4608);
    LAS float* TOT = GA + 2048;
    const bf16_t* Z = (const bf16_t*)(p.ws + OFF_Z);
    { const int c = tid >> 3, part = tid & 7; const u32x2 gv = *(const u32x2*)(Z + (size_t)(tok0 + c) * LDZ + ZGA + part * 4);
      GA[c * 32 + part * 4 + 0] = lo16(gv.x); GA[c * 32 + part * 4 + 1] = hi16(gv.x); GA[c * 32 + part * 4 + 2] = lo16(gv.y); GA[c * 32 + part * 4 + 3] = hi16(gv.y);
      const bf16_t* vp = Z + (size_t)(tok0 + c) * LDZ + ZV + h * 128 + part * 16;
      const u32x4 v0 = *(const u32x4*)vp, v1 = *(const u32x4*)(vp + 8);
      const unsigned w[8] = { v0.x, v0.y, v0.z, v0.w, v1.x, v1.y, v1.z, v1.w };
#pragma unroll
      for (int i = 0; i < 8; ++i) { VT[(part * 16 + 2 * i) * 72 + c] = (bf16_t)(w[i] & 0xffffu); VT[(part * 16 + 2 * i + 1) * 72 + c] = (bf16_t)(w[i] >> 16); } }
    __syncthreads();
    const int d = tid & 63, cg_ = tid >> 6;
    float laf[8], lab[8]; bf16_t qraw[8], kraw[8];
#pragma unroll
    for (int i = 0; i < 8; ++i) { const size_t zr = (size_t)(tok0 + cg_ * 8 + i) * LDZ; qraw[i] = Z[zr + ZQ + h * 64 + d]; kraw[i] = Z[zr + ZK + h * 64 + d]; }
    { float wf[16], wb[16];
#pragma unroll
      for (int r = 0; r < 16; ++r) { wf[r] = p.in[I_WA2][((size_t)((l * 2 + 0) * 16 + r)) * 256 + h * 64 + d]; wb[r] = p.in[I_WA2][((size_t)((l * 2 + 1) * 16 + r)) * 256 + h * 64 + d]; }
      const float bf_ = p.in[I_BA][(l * 2 + 0) * 256 + h * 64 + d], bb_ = p.in[I_BA][(l * 2 + 1) * 256 + h * 64 + d];
#pragma unroll
      for (int i = 0; i < 8; ++i) { const int c = cg_ * 8 + i; float xf = bf_, xb = bb_;
#pragma unroll
          for (int r = 0; r < 16; ++r) { xf += GA[c * 32 + r] * wf[r]; xb += GA[c * 32 + 16 + r] * wb[r]; }
          laf[i] = logsigmoidf_(xf) * (1.f / 16.f); lab[i] = logsigmoidf_(xb) * (1.f / 16.f); } }
#pragma unroll
    for (int i = 1; i < 8; ++i) laf[i] += laf[i - 1];
#pragma unroll
    for (int i = 6; i >= 0; --i) lab[i] += lab[i + 1];
    TOT[(0 * 8 + cg_) * 64 + d] = laf[7]; TOT[(1 * 8 + cg_) * 64 + d] = lab[0];
    __syncthreads();
    float offf = 0.f, offb = 0.f, Tf = 0.f, Tb = 0.f;
#pragma unroll
    for (int g = 0; g < 8; ++g) { const float a = TOT[g * 64 + d], b = TOT[(8 + g) * 64 + d]; Tf += a; Tb += b; if (g < cg_) offf += a; if (g > cg_) offb += b; }
    bf16_t* QD = (bf16_t*)(p.ws + OFF_QD);
#pragma unroll
    for (int i = 0; i < 8; ++i) { const int c = cg_ * 8 + i;
        const float q = bf2f(qraw[i]) * 0.125f, k = bf2f(kraw[i]);
        const float bf_ = offf + laf[i], bb_ = offb + lab[i];
        const bf16_t qf = f2bf(q * __expf(bf_)), qb = f2bf(q * __expf(bb_));
        QDf[c * 72 + d] = qf; QDb[c * 72 + d] = qb;
        KDf[c * 72 + d] = f2bf(k * __expf(-bf_)); KDb[c * 72 + d] = f2bf(k * __expf(-bb_));
        KRf[d * 72 + c] = f2bf(k * __expf(Tf - bf_)); KRb[d * 72 + c] = f2bf(k * __expf(Tb - bb_));
        QD[(size_t)(tok0 + c) * 256 + h * 64 + d] = qf; QD[(size_t)(8192 + tok0 + c) * 256 + h * 64 + d] = qb; }
    if (cg_ == 0) { float* DEC = (float*)(p.ws + OFF_DEC); DEC[((0 * 128 + ck) * 4 + h) * 64 + d] = __expf(Tf); DEC[((1 * 128 + ck) * 4 + h) * 64 + d] = __expf(Tb); }
    __syncthreads();
#pragma unroll
    for (int q2 = 0; q2 < 2; ++q2) { const int tt = wid * 2 + q2, ti = tt >> 2, tj = tt & 3; f32x4 af = {0.f, 0.f, 0.f, 0.f}, ab = af;
#pragma unroll
        for (int ks = 0; ks < 2; ++ks) { const int ko = ks * 32 + lq * 8;
            af = MFMA16(LDSFRAG(QDf + (ti * 16 + lr) * 72 + ko), LDSFRAG(KDf + (tj * 16 + lr) * 72 + ko), af);
            ab = MFMA16(LDSFRAG(QDb + (ti * 16 + lr) * 72 + ko), LDSFRAG(KDb + (tj * 16 + lr) * 72 + ko), ab); }
#pragma unroll
        for (int r = 0; r < 4; ++r) { const int c = ti * 16 + lq * 4 + r, s = tj * 16 + lr; const float v = (s <= c ? af[r] : 0.f) + (s >= c ? ab[r] : 0.f); ATT[c * 72 + s] = f2bf(v); } }
    __syncthreads();
    bf16x8 vb[2];
#pragma unroll
    for (int ks = 0; ks < 2; ++ks) vb[ks] = LDSFRAG(VT + (wid * 16 + lr) * 72 + ks * 32 + lq * 8);
    bf16_t* OI = (bf16_t*)(p.ws + OFF_OIB); bf16_t* KV = (bf16_t*)(p.ws + OFF_KV);
#pragma unroll
    for (int ct = 0; ct < 4; ++ct) { f32x4 a = {0.f, 0.f, 0.f, 0.f};
#pragma unroll
        for (int ks = 0; ks < 2; ++ks) a = MFMA16(LDSFRAG(ATT + (ct * 16 + lr) * 72 + ks * 32 + lq * 8), vb[ks], a);
#pragma unroll
        for (int r = 0; r < 4; ++r) OI[(size_t)(tok0 + ct * 16 + lq * 4 + r) * 512 + h * 128 + wid * 16 + lr] = f2bf(a[r]); }
#pragma unroll
    for (int dir = 0; dir < 2; ++dir) { const LAS bf16_t* KR = dir == 0 ? KRf : KRb; bf16_t* kvp = KV + ((size_t)((dir * 128 + ck) * 4 + h)) * 8192;
#pragma unroll
        for (int dt = 0; dt < 4; ++dt) { f32x4 a = {0.f, 0.f, 0.f, 0.f};
#pragma unroll
            for (int ks = 0; ks < 2; ++ks) a = MFMA16(LDSFRAG(KR + (dt * 16 + lr) * 72 + ks * 32 + lq * 8), vb[ks], a);
#pragma unroll
            for (int r = 0; r < 4; ++r) kvp[(dt * 16 + lq * 4 + r) * 128 + wid * 16 + lr] = f2bf(a[r]); } }
    __syncthreads();
}

__device__ __forceinline__ void job_glaB(const Params& p, int l, int j) {
    const int qt = j & 3, h = (j >> 2) & 3, rest = j >> 4, bb = rest % 20, dir = rest / 20;
    const int idx0 = qt * 2048 + tid_opaque(p);
    const int nck = bb < 16 ? 4 : 16, ck0 = bb < 16 ? bb * 4 : 64 + (bb - 16) * 16;
    float S[4];
#pragma unroll
    for (int e = 0; e < 4; ++e) S[e] = bb >= 16 ? p.in[I_SGLA][((size_t)((((bb - 16) * 2 + l) * 2 + dir) * 4 + h)) * 8192 + idx0 + e * 512] : 0.f;
    const bf16_t* KV = (const bf16_t*)(p.ws + OFF_KV); const float* DEC = (const float*)(p.ws + OFF_DEC); bf16_t* ST = (bf16_t*)(p.ws + OFF_ST);
    for (int i0 = 0; i0 < nck; i0 += 4) { float dv[4][4]; bf16_t kv[4][4]; size_t its[4];
#pragma unroll
        for (int u = 0; u < 4; ++u) { const int i = i0 + u, ck = dir == 0 ? ck0 + i : ck0 + nck - 1 - i; its[u] = (size_t)((dir * 128 + ck) * 4 + h);
#pragma unroll
            for (int e = 0; e < 4; ++e) { const int idx = idx0 + e * 512; dv[u][e] = DEC[its[u] * 64 + (idx >> 7)]; kv[u][e] = KV[its[u] * 8192 + idx]; } }
#pragma unroll
        for (int u = 0; u < 4; ++u)
#pragma unroll
            for (int e = 0; e < 4; ++e) { ST[its[u] * 8192 + idx0 + e * 512] = f2bf(S[e]); S[e] = dv[u][e] * S[e] + bf2f(kv[u][e]); } }
    if (bb < 16) {
#pragma unroll
        for (int e = 0; e < 4; ++e) p.out[OUT_GLA + ((size_t)(((bb * 2 + l) * 2 + dir) * 4 + h)) * 8192 + idx0 + e * 512] = S[e]; }
}

__device__ __forceinline__ void job_glaC(const Params& p, int l, int j, lds_t lds) {
    const int tid = tid_opaque(p), wid = tid >> 6, lane = tid & 63, lr = lane & 15, lq = lane >> 4;
    const int ck = j >> 2, h = j & 3, tok0 = ck * 64;
    LAS bf16_t* Aq = (LAS bf16_t*)lds;
    LAS bf16_t* BT = Aq + 64 * 136;
    LAS float* Os = (LAS float*)(BT + 128 * 136);
    const bf16_t* QD = (const bf16_t*)(p.ws + OFF_QD); const bf16_t* ST = (const bf16_t*)(p.ws + OFF_ST);
#pragma unroll
    for (int it = 0; it < 2; ++it) { const int idx = tid + it * 512, c = idx >> 4, rem = idx & 15, dir = rem >> 3, dc = rem & 7;
        *(LAS u32x4*)(Aq + c * 136 + dir * 64 + dc * 8) = *(const u32x4*)(QD + (size_t)(dir * 8192 + tok0 + c) * 256 + h * 64 + dc * 8); }
#pragma unroll
    for (int it = 0; it < 4; ++it) { const int idx = tid + it * 512, dir = idx >> 10, d = (idx >> 4) & 63, ec = idx & 15;
        const u32x4 v = *(const u32x4*)(ST + ((size_t)((dir * 128 + ck) * 4 + h)) * 8192 + d * 128 + ec * 8);
        const unsigned w[4] = { v.x, v.y, v.z, v.w };
#pragma unroll
        for (int i = 0; i < 4; ++i) { BT[(ec * 8 + 2 * i) * 136 + dir * 64 + d] = (bf16_t)(w[i] & 0xffffu); BT[(ec * 8 + 2 * i + 1) * 136 + dir * 64 + d] = (bf16_t)(w[i] >> 16); } }
    const int ct = wid & 3, eh = wid >> 2; const bf16_t* OI = (const bf16_t*)(p.ws + OFF_OIB);
    bf16_t oi[4][4];
#pragma unroll
    for (int e4 = 0; e4 < 4; ++e4)
#pragma unroll
        for (int r = 0; r < 4; ++r) oi[e4][r] = OI[(size_t)(tok0 + ct * 16 + lq * 4 + r) * 512 + h * 128 + (eh * 4 + e4) * 16 + lr];
    const int nc = tid >> 3, npart = tid & 7;
    const bf16_t* gz = (const bf16_t*)(p.ws + OFF_Z) + (size_t)(tok0 + nc) * LDZ + ZGG + h * 128 + npart * 16;
    const u32x4 g0 = *(const u32x4*)gz, g1 = *(const u32x4*)(gz + 8);
    f32x4 onw[4];
#pragma unroll
    for (int i = 0; i < 4; ++i) onw[i] = *(const f32x4*)(p.in[I_ONORM] + l * 128 + npart * 16 + 4 * i);
    __syncthreads();
    bf16x8 af[4];
#pragma unroll
    for (int ks = 0; ks < 4; ++ks) af[ks] = LDSFRAG(Aq + (ct * 16 + lr) * 136 + ks * 32 + lq * 8);
#pragma unroll
    for (int e4 = 0; e4 < 4; ++e4) { const int et = eh * 4 + e4; f32x4 a = {0.f, 0.f, 0.f, 0.f};
#pragma unroll
        for (int ks = 0; ks < 4; ++ks) a = MFMA16(af[ks], LDSFRAG(BT + (et * 16 + lr) * 136 + ks * 32 + lq * 8), a);
#pragma unroll
        for (int r = 0; r < 4; ++r) { const int row = ct * 16 + lq * 4 + r, col = et * 16 + lr; Os[row * 132 + col] = a[r] + bf2f(oi[e4][r]); } }
    __syncthreads();
    { const int c = tid >> 3, part = tid & 7; float o[16]; float ss = 0.f;
#pragma unroll
      for (int i = 0; i < 16; ++i) { o[i] = Os[c * 132 + part * 16 + i]; ss += o[i] * o[i]; }
      ss += __shfl_xor(ss, 1); ss += __shfl_xor(ss, 2); ss += __shfl_xor(ss, 4);
      const float rstd = rsqrtf(ss * (1.f / 128.f) + 1e-6f);
      const unsigned gw[8] = { g0.x, g0.y, g0.z, g0.w, g1.x, g1.y, g1.z, g1.w };
      unsigned ow[8];
#pragma unroll
      for (int i = 0; i < 8; ++i) { const float n0 = onw[i >> 1][(2 * i) & 3], n1 = onw[i >> 1][(2 * i + 1) & 3];
          ow[i] = pk2(o[2 * i] * rstd * n0 * siluf_(lo16(gw[i])), o[2 * i + 1] * rstd * n1 * siluf_(hi16(gw[i]))); }
      bf16_t* ap = (bf16_t*)(p.ws + OFF_AGLA) + (size_t)(tok0 + c) * 512 + h * 128 + part * 16;
      *(u32x4*)ap = (u32x4){ow[0], ow[1], ow[2], ow[3]}; *(u32x4*)(ap + 8) = (u32x4){ow[4], ow[5], ow[6], ow[7]}; }
    __syncthreads();
}
__device__ __forceinline__ void head_row_finish(float (&x)[16], int p8, const float* nw, const float* nw2, bool rope, int pos, const float* R, float mul, LAS bf16_t* dst) {
    float ss = 0.f; const int cnt = p8 < 4 ? 16 : 8;
#pragma unroll
    for (int i = 0; i < 16; ++i) if (i < cnt) ss += x[i] * x[i];
    ss += __shfl_xor(ss, 1); ss += __shfl_xor(ss, 2); ss += __shfl_xor(ss, 4);
    const float rstd = rsqrtf(ss * (1.f / 96.f) + 1e-6f) * mul;
    if (p8 < 4) { unsigned w[8];
#pragma unroll
        for (int i = 0; i < 8; ++i) w[i] = pk2(x[2 * i] * rstd * nw[p8 * 16 + 2 * i] * nw2[p8 * 16 + 2 * i], x[2 * i + 1] * rstd * nw[p8 * 16 + 2 * i + 1] * nw2[p8 * 16 + 2 * i + 1]);
        *(LAS u32x4*)(dst + p8 * 16) = (u32x4){w[0], w[1], w[2], w[3]}; *(LAS u32x4*)(dst + p8 * 16 + 8) = (u32x4){w[4], w[5], w[6], w[7]};
    } else { const int i0 = (p8 - 4) * 4; float o1[4], o2[4];
#pragma unroll
        for (int i = 0; i < 4; ++i) { const float a = x[i] * rstd * nw[64 + i0 + i], b = x[4 + i] * rstd * nw[80 + i0 + i];
            if (rope) { const float c = R[pos * 16 + i0 + i], s = R[16384 + pos * 16 + i0 + i]; o1[i] = a * c - b * s; o2[i] = a * s + b * c; } else { o1[i] = a; o2[i] = b; } }
        *(LAS u32x2*)(dst + 64 + i0) = (u32x2){pk2(o1[0], o1[1]), pk2(o1[2], o1[3])}; *(LAS u32x2*)(dst + 80 + i0) = (u32x2){pk2(o2[0], o2[1]), pk2(o2[2], o2[3])}; }
}
__device__ __forceinline__ void ld16bf(const bf16_t* s, float (&x)[16]) { const u32x4 a = *(const u32x4*)s, b = *(const u32x4*)(s + 8);
    x[0] = lo16(a.x); x[1] = hi16(a.x); x[2] = lo16(a.y); x[3] = hi16(a.y); x[4] = lo16(a.z); x[5] = hi16(a.z); x[6] = lo16(a.w); x[7] = hi16(a.w);
    x[8] = lo16(b.x); x[9] = hi16(b.x); x[10] = lo16(b.y); x[11] = hi16(b.y); x[12] = lo16(b.z); x[13] = hi16(b.z); x[14] = lo16(b.w); x[15] = hi16(b.w); }
__device__ __forceinline__ void ld4bf(const bf16_t* s, float* x) { const u32x2 a = *(const u32x2*)s; x[0] = lo16(a.x); x[1] = hi16(a.x); x[2] = lo16(a.y); x[3] = hi16(a.y); }
__device__ __forceinline__ void job_attn(const Params& p, int l, int j, lds_t lds) {
    const int tid = tid_opaque(p), wid = tid >> 6, lane = tid & 63, lr = lane & 15, lq = lane >> 4;
    const bool smp = j < 128; int b, h, qb; if (smp) { b = j >> 5; h = (j >> 3) & 3; qb = j & 7; } else { const int jj = j - 128; b = jj >> 3; h = (jj >> 1) & 3; qb = jj & 1; }
    const int qtok0 = smp ? 4096 + b * 1024 + qb * 128 : b * 256 + qb * 128; const int nkt = smp ? 12 : 2;
    LAS bf16_t* Ks0 = (LAS bf16_t*)lds;
    LAS bf16_t* VTs0 = Ks0 + 2 * 128 * 104;
    LAS float* Mg = (LAS float*)lds;
    const bf16_t* Z = (const bf16_t*)(p.ws + OFF_Z); const bf16_t* KF = (const bf16_t*)(p.ws + OFF_KF); const bf16_t* Vb = (const bf16_t*)(p.ws + OFF_V); const float* R = (const float*)(p.ws + OFF_ROPE);
    const float* qhn = p.in[I_QHNORM] + l * 96;
    u32x4 kreg[3], vreg[4];
    const int vst = smp ? 1536 : 256; const bf16_t* vtb = smp ? Vb + 2097152 + (size_t)(b * 4 + h) * 128 * 1536 : Vb + (size_t)(b * 4 + h) * 128 * 256;
    auto rowbase = [&](int kt) { return smp ? (kt < 4 ? 8192 + b * 512 + kt * 128 : 4096 + b * 1024 + (kt - 4) * 128) : b * 256 + kt * 128; };
    auto issue = [&](int kt) { const int rb = rowbase(kt);
#pragma unroll
        for (int i = 0; i < 3; ++i) { const int idx = tid + 512 * i, key = idx / 12, part = idx - key * 12; kreg[i] = *(const u32x4*)(KF + (size_t)(rb + key) * 384 + h * 96 + part * 8); }
#pragma unroll
        for (int i = 0; i < 4; ++i) { const int idx = tid + 512 * i, e = idx >> 4, part = idx & 15; vreg[i] = *(const u32x4*)(vtb + (size_t)e * vst + kt * 128 + part * 8); } };
    auto commit = [&](int buf) { LAS bf16_t* Ks = Ks0 + buf * 128 * 104; LAS bf16_t* VTs = VTs0 + buf * 128 * 136;
#pragma unroll
        for (int i = 0; i < 3; ++i) { const int idx = tid + 512 * i, key = idx / 12, part = idx - key * 12; *(LAS u32x4*)(Ks + key * 104 + part * 8) = kreg[i]; }
#pragma unroll
        for (int i = 0; i < 4; ++i) { const int idx = tid + 512 * i, e = idx >> 4, part = idx & 15; *(LAS u32x4*)(VTs + e * 136 + part * 8) = vreg[i]; } };
    issue(0);
#pragma unroll
    for (int it = 0; it < 2; ++it) { const int row = it * 64 + (tid >> 3), p8 = tid & 7, tok = qtok0 + row; const bf16_t* qr = (const bf16_t*)(p.ws + OFF_QRAW) + (size_t)tok * 384 + h * 96; float x[16];
      if (p8 < 4) ld16bf(qr + p8 * 16, x); else { ld4bf(qr + 64 + (p8 - 4) * 4, x); ld4bf(qr + 80 + (p8 - 4) * 4, x + 4); }
      head_row_finish(x, p8, qhn, p.in[I_KHNORM] + l * 96, smp, qb * 128 + row, R, 0.10206207261596575f * 1.4426950408889634f, Ks0 + 128 * 104 + row * 104); }
    __syncthreads();
    const int rt = wid & 3, kh = wid >> 2;
    bf16x8 qa[2][3];
#pragma unroll
    for (int mt = 0; mt < 2; ++mt)
#pragma unroll
        for (int ks = 0; ks < 3; ++ks) qa[mt][ks] = LDSFRAG(Ks0 + 128 * 104 + (rt * 32 + mt * 16 + lr) * 104 + ks * 32 + lq * 8);
    commit(0);
    __syncthreads();
    f32x4 oacc[2][8]; float mrow[2], lrow[2];
#pragma unroll
    for (int mt = 0; mt < 2; ++mt) {
#pragma unroll
        for (int e = 0; e < 8; ++e) oacc[mt][e] = (f32x4){0.f, 0.f, 0.f, 0.f};
        mrow[mt] = -1e30f; lrow[mt] = 0.f; }
    const int kbase = kh * 64;
    for (int kt = 0; kt < nkt; ++kt) {
        if (kt + 1 < nkt) issue(kt + 1);
        const LAS bf16_t* Ks = Ks0 + (kt & 1) * 128 * 104; const LAS bf16_t* VTs = VTs0 + (kt & 1) * 128 * 136;
        f32x4 sacc[2][4];
#pragma unroll
        for (int nt = 0; nt < 4; ++nt) { sacc[0][nt] = (f32x4){0.f, 0.f, 0.f, 0.f}; sacc[1][nt] = sacc[0][nt];
#pragma unroll
            for (int ks = 0; ks < 3; ++ks) { const bf16x8 kf = LDSFRAG(Ks + (kbase + nt * 16 + lr) * 104 + ks * 32 + lq * 8); sacc[0][nt] = MFMA16(kf, qa[0][ks], sacc[0][nt]); sacc[1][nt] = MFMA16(kf, qa[1][ks], sacc[1][nt]); } }
        bf16x8 pb[2][2];
#pragma unroll
        for (int mt = 0; mt < 2; ++mt) {
            float mx = -1e30f;
#pragma unroll
            for (int nt = 0; nt < 4; ++nt) mx = fmaxf(mx, fmaxf(fmaxf(sacc[mt][nt][0], sacc[mt][nt][1]), fmaxf(sacc[mt][nt][2], sacc[mt][nt][3])));
            mx = fmaxf(mx, __shfl_xor(mx, 16)); mx = fmaxf(mx, __shfl_xor(mx, 32));
            const float mn = fmaxf(mrow[mt], mx), alpha = __builtin_amdgcn_exp2f(mrow[mt] - mn); mrow[mt] = mn;
            float pv[4][4]; float rs = 0.f;
#pragma unroll
            for (int nt = 0; nt < 4; ++nt)
#pragma unroll
                for (int r = 0; r < 4; ++r) { pv[nt][r] = __builtin_amdgcn_exp2f(sacc[mt][nt][r] - mn); rs += pv[nt][r]; }
            lrow[mt] = lrow[mt] * alpha + rs;
#pragma unroll
            for (int k2 = 0; k2 < 2; ++k2) { u32x4 w; w.x = pk2(pv[2 * k2][0], pv[2 * k2][1]); w.y = pk2(pv[2 * k2][2], pv[2 * k2][3]); w.z = pk2(pv[2 * k2 + 1][0], pv[2 * k2 + 1][1]); w.w = pk2(pv[2 * k2 + 1][2], pv[2 * k2 + 1][3]);
                pb[mt][k2] = __builtin_bit_cast(bf16x8, w); }
#pragma unroll
            for (int e = 0; e < 8; ++e) oacc[mt][e] *= alpha; }
#pragma unroll
        for (int k2 = 0; k2 < 2; ++k2)
#pragma unroll
            for (int e = 0; e < 8; ++e) { const LAS bf16_t* vp = VTs + (e * 16 + lr) * 136 + kbase + k2 * 32 + 4 * lq;
                const u32x2 lo = *(const LAS u32x2*)vp, hi = *(const LAS u32x2*)(vp + 16);
                const bf16x8 vf = __builtin_bit_cast(bf16x8, (u32x4){lo.x, lo.y, hi.x, hi.y});
                oacc[0][e] = MFMA16(vf, pb[0][k2], oacc[0][e]); oacc[1][e] = MFMA16(vf, pb[1][k2], oacc[1][e]); }
        if (kt + 1 < nkt) commit((kt + 1) & 1);
        __syncthreads();
    }
#pragma unroll
    for (int mt = 0; mt < 2; ++mt) { float s_ = lrow[mt]; s_ += __shfl_xor(s_, 16); s_ += __shfl_xor(s_, 32); lrow[mt] = s_; }
    LAS float* Mo = Mg + rt * 32 * 132; LAS float* Ml = Mg + 4 * 32 * 132 + rt * 64;
    if (kh == 1) {
#pragma unroll
        for (int mt = 0; mt < 2; ++mt) {
#pragma unroll
            for (int e = 0; e < 8; ++e) *(LAS f32x4*)(Mo + (mt * 16 + lr) * 132 + e * 16 + 4 * lq) = oacc[mt][e];
            if (lq == 0) { Ml[(mt * 16 + lr) * 2] = mrow[mt]; Ml[(mt * 16 + lr) * 2 + 1] = lrow[mt]; } }
    }
    __syncthreads();
    if (kh == 0) { bf16_t* AM = (bf16_t*)(p.ws + OFF_AMLA);
#pragma unroll
        for (int mt = 0; mt < 2; ++mt) { const int row = mt * 16 + lr, tok = qtok0 + rt * 32 + row;
            u32x2 gt[8];
#pragma unroll
            for (int e = 0; e < 8; ++e) gt[e] = *(const u32x2*)(Z + (size_t)tok * LDZ + ZMG + h * 128 + e * 16 + 4 * lq);
            const float m2 = Ml[row * 2], l2 = Ml[row * 2 + 1]; const float mm = fmaxf(mrow[mt], m2), a1 = __builtin_amdgcn_exp2f(mrow[mt] - mm), a2 = __builtin_amdgcn_exp2f(m2 - mm);
            const float inv = 1.f / (lrow[mt] * a1 + l2 * a2);
#pragma unroll
            for (int e = 0; e < 8; ++e) { const f32x4 o2 = *(const LAS f32x4*)(Mo + row * 132 + e * 16 + 4 * lq); float o[4];
#pragma unroll
                for (int r = 0; r < 4; ++r) o[r] = (oacc[mt][e][r] * a1 + o2[r] * a2) * inv;
                const float g0 = lo16(gt[e].x), g1 = hi16(gt[e].x), g2 = lo16(gt[e].y), g3 = hi16(gt[e].y);
                *(u32x2*)(AM + (size_t)tok * 512 + h * 128 + e * 16 + 4 * lq) = (u32x2){pk2(o[0] * siluf_(g0), o[1] * siluf_(g1)), pk2(o[2] * siluf_(g2), o[3] * siluf_(g3))}; } } }
    __syncthreads();
}


#define XB_TMO      128
#define XB_XCNT(j)  (256  + 64 * (j))
#define XB_XSUB(j)  (1280 + 64 * (j))
#define XB_XGEN(j)  (2304 + 64 * (j))
#define XB_TOP      3328
#define XB_TOPGEN   3392
#define XCD_BAR_WORDS 3456
#define XB_SPIN_CAP (1u << 18)

__device__ __forceinline__ unsigned xb_ld(unsigned* p)              { return __hip_atomic_load(p, __ATOMIC_RELAXED, __HIP_MEMORY_SCOPE_AGENT); }
__device__ __forceinline__ unsigned xb_add(unsigned* p, unsigned v) { return __hip_atomic_fetch_add(p, v, __ATOMIC_RELAXED, __HIP_MEMORY_SCOPE_AGENT); }
__device__ __forceinline__ unsigned xb_xcc_id() { return (unsigned)__builtin_amdgcn_s_getreg((3 << 11) | 20) & 0xFu; }
#define XB_SPIN(cond, bar) do { unsigned _sp = 0; while (cond) { __builtin_amdgcn_s_sleep(1); \
    if ((++_sp & 255u) == 0u) { if (xb_ld(&(bar)[XB_TMO])) break; if (_sp > XB_SPIN_CAP) { atomicAdd(&(bar)[XB_TMO], 1u); break; } } } } while (0)

struct XcdBarrier {
    int wid; unsigned* bar; unsigned x;
    volatile LAS unsigned* st;
};

__device__ __forceinline__ XcdBarrier xcd_barrier_post(unsigned* bar, volatile LAS unsigned* st) {
    XcdBarrier b; b.bar = bar; b.x = xb_xcc_id(); b.st = st;
    if (threadIdx.x == 0) (void)xb_add(&bar[XB_XCNT(b.x)], 1u);
    return b;
}
__device__ __forceinline__ void xcd_barrier_complete(unsigned* bar, unsigned x, unsigned& nloc, unsigned& nx) {
    const unsigned G = gridDim.x * gridDim.y * gridDim.z;
    unsigned sum, cnt, mine, sp = 0u;
    for (;;) {
        sum = 0u; cnt = 0u; mine = 0u;
#pragma unroll
        for (unsigned j = 0; j < 16; ++j) { const unsigned c = xb_ld(&bar[XB_XCNT(j)]); sum += c; cnt += (c > 0u) ? 1u : 0u; mine = (j == x) ? c : mine; }
        if (sum == G) break;
        __builtin_amdgcn_s_sleep(1);
        if ((++sp & 255u) == 0u) { if (xb_ld(&bar[XB_TMO])) break; if (sp > XB_SPIN_CAP) { atomicAdd(&bar[XB_TMO], 1u); break; } }
    }
    nloc = mine > 0u ? mine : 1u; nx = cnt > 0u ? cnt : 1u;
}

__device__ __forceinline__ void xcd_barrier(const XcdBarrier& b) {
    asm volatile("s_waitcnt vmcnt(0)" ::: "memory");
    __syncthreads();
    if (b.wid == 0 && lane_id_() == 0) {
        unsigned* bar = b.bar;
        __builtin_amdgcn_s_waitcnt(0);
        unsigned nloc = b.st[0], nx = b.st[1];
        if (nloc == 0u) { xcd_barrier_complete(bar, b.x, nloc, nx); b.st[0] = nloc; b.st[1] = nx; }
        const unsigned old = xb_add(&bar[XB_XSUB(b.x)], 1u);
        const unsigned gen = old / nloc;
        if (old + 1u == (gen + 1u) * nloc) {
            __builtin_amdgcn_fence(__ATOMIC_RELEASE, "agent");
            asm volatile("s_waitcnt vmcnt(0)" ::: "memory");
            const unsigned og = xb_add(&bar[XB_TOP], 1u);
            const unsigned tg = og / nx;
            if (og + 1u == (tg + 1u) * nx) xb_add(&bar[XB_TOPGEN], 1u);
            else XB_SPIN(xb_ld(&bar[XB_TOPGEN]) == tg, bar);
            __builtin_amdgcn_fence(__ATOMIC_ACQUIRE, "agent");
            xb_add(&bar[XB_XGEN(b.x)], 1u);
            asm volatile("s_waitcnt vmcnt(0)" ::: "memory");
        } else {
            XB_SPIN(xb_ld(&bar[XB_XGEN(b.x)]) == gen, bar);
            __builtin_amdgcn_fence(__ATOMIC_ACQUIRE, "agent");
            asm volatile("s_waitcnt vmcnt(0)" ::: "memory");
        }
    }
    __syncthreads();
}

constexpr int N_PHASES = 15;
#ifndef S3SEL
#define S3SEL 15
#endif
#ifndef REPEAT_MASK
#define REPEAT_MASK 0xff
#endif
#ifndef ONLY_S
#define ONLY_S -1
#endif
__device__ __forceinline__ void run_phase(const Params& p, int ph, lds_t lds, int mask = 0xff) {
    const int G = (int)gridDim.x, bid = (int)blockIdx.x;
    if (ph == 0 && (ONLY_S < 0 || ONLY_S == 7)) {
        for (int j = bid; j < 384 + 192 + 256 + 32; j += G) { if (j < 384) job_s5setup(p, 0, j, lds); else if (j < 576) job_ada(p, j - 384, lds); else if (j < 832) job_ctx(p, j - 576); else job_rope(p, j - 832); }
        return;
    }
    const int l = (ph - 1) / 7, s = (ph - 1) % 7;
    unsigned char* ws = p.ws;
    if (s == 0 && (ONLY_S < 0 || ONLY_S == 0)) {
        if (l == 0 || G < 256) { for (int j = bid; j < 384 + WT_TOTAL + 1024; j += G) { if (j < 384) { if ((mask & 1) && l > 0) job_s5setup(p, l, j, lds); } else if (j < 384 + WT_TOTAL) { if (mask & 2) job_wt(p, l, j - 384, lds); } else if (mask & 4) job_prep(p, l, j - 384 - WT_TOTAL); } }
        else { for (int j = bid; j < WT_WOUT + 1024; j += G) { if (j < WT_WOUT) job_wt(p, l, WT_EARLY + 3 * WT_WBO + j, lds); else job_prep(p, l, j - WT_WOUT); } }
    } else if (s == 1 && (ONLY_S < 0 || ONLY_S == 1)) {
        Order S; S.setup(8192, 4096, 0, p.wid); pg8::Gemm g{(const bf16_t*)(ws + OFF_HB), (const bf16_t*)(ws + OFF_WIN), 8192, 4096, 1024}; EpiZ E{(bf16_t*)(ws + OFF_Z)};
        pg8::gemm_phase<EpiZ, Order>(lds, g, S, E, nullptr);
    } else if (s == 2 && (ONLY_S < 0 || ONLY_S == 2)) {
        if (G == 256) {
            if (mask & 1) for (int k = bid >> 3; k < 80; k += 32) { const int q = k >> 2, bb = q < 4 ? 16 + q : q - 4; job_s5(p, l, bb * 32 + 4 * (bid & 7) + (k & 3), lds); }
            if (mask & 2) { job_glaA(p, l, bid, lds); job_glaA(p, l, 256 + bid, lds); }
            if ((mask & 4) && bid >= 128) for (int j = bid - 128; j < 1024; j += 128) job_mlaprep(p, l, j);
        } else for (int j = bid; j < 640 + 512 + 1024; j += G) { if (j < 640) { if (mask & 1) job_s5(p, l, j < 128 ? 512 + j : j - 128, lds); } else if (j < 1152) { if (mask & 2) job_glaA(p, l, j - 640, lds); } else if (mask & 4) job_mlaprep(p, l, j - 1152); }
    } else if (s == 3 && (ONLY_S < 0 || ONLY_S == 3)) {
        if (mask & 1) { if (G == 256) { if (bid < 96) for (int j = bid; j < 640; j += 96) job_glaB(p, l, j); } else for (int j = bid; j < 640; j += G) job_glaB(p, l, j); }
        if (mask & 16) { Order S; S.setup(8192, 2816, 0, p.wid); pg8::Gemm g{(const bf16_t*)(ws + OFF_HB), (const bf16_t*)(ws + OFF_WIN) + (size_t)4096 * 1024, 8192, 2816, 1024}; EpiZ E{(bf16_t*)(ws + OFF_Z) + 4096};
          pg8::gemm_phase<EpiZ, Order>(lds, g, S, E, nullptr); }
        if ((mask & 2) && (S3SEL & 2)) { Order S; S.setup(8192, 1024, 160, p.wid); pg8::Gemm g{(const bf16_t*)(ws + OFF_YG), (const bf16_t*)(ws + OFF_WGLU), 8192, 1024, 512}; EpiGLU E{(bf16_t*)(ws + OFF_AS5), (const bf16_t*)(ws + OFF_Z), p.in[I_BGLU] + l * 1024};
          pg8::gemm_phase<EpiGLU, Order>(lds, g, S, E, nullptr); }
        if ((mask & 4) && (S3SEL & 4)) { Order S; S.setup(10240, 768, 120, p.wid); pg8::Gemm g{(const bf16_t*)(ws + (l == 0 ? OFF_CTX0 : OFF_CKVN)), (const bf16_t*)(ws + OFF_WKV), 10240, 768, 256}; EpiKV E{(bf16_t*)(ws + OFF_KF), (bf16_t*)(ws + OFF_V), l, (const bf16_t*)(ws + OFF_Z), p.in[I_CKR], p.in[I_KHNORM] + l * 96, (const float*)(ws + OFF_ROPE)};
          pg8::gemm_phase<EpiKV, Order>(lds, g, S, E, nullptr); }
        if ((mask & 8) && (S3SEL & 8)) { Order S; S.setup(8192, 512, 160, p.wid); if (G == 256) S.c = (bid >= 96 && bid < 136) ? bid - 96 : (bid >= 224 && bid < 248) ? bid - 184 : (1 << 20); pg8::Gemm g{(const bf16_t*)(ws + OFF_AQ), (const bf16_t*)(ws + OFF_WUQ), 8192, 512, 384}; EpiQ E{(bf16_t*)(ws + OFF_QRAW)};
          pg8::gemm_phase<EpiQ, Order>(lds, g, S, E, nullptr); }
    } else if (s == 4 && (ONLY_S < 0 || ONLY_S == 4)) {
        if (G == 256) {
            if (bid < 128) { const int slot = bid >> 3, pair = 2 * (bid & 7) + (slot >> 3);
                if (mask & 1) job_attn(p, l, pair * 8 + (slot & 7), lds); }
            else { const int k = bid - 128; if (mask & 1) job_attn(p, l, 128 + k, lds); if (mask & 2) { job_glaC(p, l, k, lds); job_glaC(p, l, 128 + k, lds); job_glaC(p, l, 256 + k, lds); job_glaC(p, l, 384 + k, lds); } }
        } else for (int j = bid; j < 256 + 512; j += G) { if (j < 256) { if (mask & 1) job_attn(p, l, j, lds); } else if (mask & 2) job_glaC(p, l, j - 256, lds); }
    } else if (s == 5 && (ONLY_S < 0 || ONLY_S == 5)) {
        if (l == 0 && mask == 0xff && G >= 256 && bid >= 128) { for (int j = bid - 128; j < 384 + WT_EARLY; j += G - 128) { if (j < 384) job_s5setup(p, 1, j, lds); else job_wt(p, 1, j - 384, lds); } }
        for (int br = 0; br < 3; ++br) { Order S; S.setup(8192, 1024, 0, p.wid);
            pg8::Gemm g{(const bf16_t*)(ws + (br == 0 ? OFF_AGLA : br == 1 ? OFF_AMLA : OFF_AS5)), (const bf16_t*)(ws + OFF_WBO) + (size_t)br * 1024 * 512, 8192, 1024, 512};
            EpiBo E{(bf16_t*)(ws + OFF_HB), (const bf16_t*)(ws + OFF_Z), br};
            pg8::gemm_phase<EpiBo, Order>(lds, g, S, E, nullptr); }
    } else if (s == 6 && (ONLY_S < 0 || ONLY_S == 6)) {
        if (l == 0 && mask == 0xff && G >= 256 && bid >= 128) { for (int j = bid - 128; j < 3 * WT_WBO; j += G - 128) job_wt(p, 1, WT_EARLY + j, lds); }
        Order S; S.setup(8192, 1024, 0, p.wid); pg8::Gemm g{(const bf16_t*)(ws + OFF_HB), (const bf16_t*)(ws + OFF_WOUT), 8192, 1024, 1024};
        EpiOut E{p.out, l == 0 ? p.in[I_XP] : p.out, l == 0 ? p.in[I_XS] : p.out + (size_t)4096 * 1024, (const float*)(ws + OFF_ADA) + l * 5 * 3072};
        pg8::gemm_phase<EpiOut, Order>(lds, g, S, E, nullptr);
    }
}
__global__ __launch_bounds__(512, 2) void mega(KParams kp, int ph0, int ph1) {
    extern __shared__ __attribute__((aligned(16))) unsigned char shm[];
    lds_t lds = (lds_t)shm;
    if (threadIdx.x < N_IN) ((const float**)(kp.ws + OFF_TBL))[threadIdx.x] = kp.in[threadIdx.x];
    const int wid0 = __builtin_amdgcn_readfirstlane((int)threadIdx.x >> 6);
    volatile LAS unsigned* xst = (volatile LAS unsigned*)(lds + DYN_LDS - 16);
    if (threadIdx.x == 0) { xst[0] = 0u; xst[1] = 0u; }
    __threadfence(); __syncthreads();
    XcdBarrier xb = xcd_barrier_post((unsigned*)(kp.ws + OFF_BAR), xst);
    xb.wid = wid0;
    if (ph0 > ph1) cg::this_grid().sync();
    for (int ph = ph0; ph < ph1; ++ph) {
        Params p; p.wid = wid0; { const float* const* tb = (const float* const*)(kp.ws + OFF_TBL); float* o = kp.out; unsigned char* w = kp.ws; asm volatile("" : "+s"(tb), "+s"(o), "+s"(w)); p.in = tb; p.out = o; p.ws = w; }
        int nrep = 1;
#ifdef REPEAT_S
        if ((REPEAT_S == 7 && ph == 0) || (ph > 0 && (ph - 1) % 7 == REPEAT_S && (REPEAT_S != 6 || ph < 8))) nrep = 2;
#endif
        for (int rep = 0; rep < nrep; ++rep) { if (rep) xcd_barrier(xb); run_phase(p, ph, lds, rep ? REPEAT_MASK : 0xff); }
        if (ph + 1 < ph1) xcd_barrier(xb);
    }
}

#ifndef N_LAUNCH_MODE
#define N_LAUNCH_MODE 1
#endif
extern "C" void kernel_launch(void* const* d_in, const int* in_sizes, int n_in, void* d_out, int out_size, void* d_ws, size_t ws_size, hipStream_t stream) {
    static int grid = 0;
    if (grid == 0) {
        if (n_in != N_IN || ws_size < WS_END) { fprintf(stderr, "kernel_launch: unexpected n_in %d / ws %zu (need %zu)\n", n_in, ws_size, (size_t)WS_END); grid = -1; return; }
        int dev = 0, cus = 0, per_cu = 0;
        hipGetDevice(&dev); hipDeviceGetAttribute(&cus, hipDeviceAttributeMultiprocessorCount, dev);
        hipFuncSetAttribute((const void*)mega, hipFuncAttributeMaxDynamicSharedMemorySize, DYN_LDS);
        hipOccupancyMaxActiveBlocksPerMultiprocessor(&per_cu, (const void*)mega, 512, DYN_LDS);
        if (per_cu < 1) { fprintf(stderr, "kernel_launch: occupancy query says %d blocks per CU\n", per_cu); per_cu = 1; }
        (void)hipGetLastError();
        grid = cus;
    }
    if (grid < 0) return;
    hipMemsetAsync((char*)d_ws + OFF_BAR, 0, 16384, stream);
    KParams p{};
    for (int i = 0; i < N_IN; ++i) p.in[i] = (const float*)d_in[i];
    p.out = (float*)d_out; p.ws = (unsigned char*)d_ws;
#if N_LAUNCH_MODE == 0
    for (int ph = 0; ph < N_PHASES; ++ph) { hipLaunchKernelGGL(mega, dim3(grid), dim3(512), DYN_LDS, stream, p, ph, ph + 1); }
#else
    int ph0 = 0, ph1 = N_PHASES; void* args[] = {&p, &ph0, &ph1};
    hipError_t e = hipLaunchCooperativeKernel((const void*)mega, dim3(grid), dim3(512), args, DYN_LDS, stream);
    if (e != hipSuccess) fprintf(stderr, "cooperative launch failed: %s (grid %d)\n", hipGetErrorString(e), grid);
#endif
}
```

```cpp
#include <hip/hip_runtime.h>
#include <hip/hip_cooperative_groups.h>
#include <cstdio>
namespace cg = cooperative_groups;
namespace pg8 {
#define PG8_LAS __attribute__((address_space(3)))
typedef unsigned short bf16_t;
typedef short bf16x8 __attribute__((ext_vector_type(8)));
typedef float f32x4 __attribute__((ext_vector_type(4)));
typedef unsigned u32x4 __attribute__((ext_vector_type(4)));
constexpr int BM = 256, BK = 64, HALF = 128, HTB = HALF * BK * 2  , STAGE_BYTES = 8 * HTB, NXCD = 8, WGM = 8;

__host__ __device__ __forceinline__ int lds_byte(int r, int c) { const int st = (r >> 4) * 2 + (c >> 5), rr = r & 15, cc = c & 31, ob = rr * 64 + cc * 2; return st * 1024 + (ob ^ (((ob >> 9) & 1) << 5)); }
__host__ __device__ __forceinline__ void stage_rc(int b, int& R, int& C) { const int st = b / 1024, sb = b % 1024, swz = sb ^ (((sb >> 9) & 1) << 5); R = (st >> 1) * 16 + swz / 64; C = (st & 1) * 32 + (swz % 64) / 2; }
__host__ __device__ __forceinline__ int perm32(int rho) { const int n = rho >> 4, i = rho & 15; return 8 * (i >> 2) + 4 * n + (i & 3); }

struct Unit { int pm, pn; };
struct Gemm { const bf16_t* A; const bf16_t* Bt; int M, N, K; };

struct StaticOrder {
    int nM, nN, nwg, G, c;
    __host__ __device__ void init(int M, int N, int G_, int c_) { nM = M / BM; nN = N / BM; nwg = nM * nN; G = G_; c = c_; }
    __host__ __device__ bool next(int i, Unit& u) const {
        const long L = (long)i * G + c; if (L >= nwg) return false;
        int wgid = (int)L; { const int q = nwg / NXCD, r = nwg % NXCD, xcd = wgid % NXCD, off = wgid / NXCD; wgid = (xcd < r ? xcd * (q + 1) : r * (q + 1) + (xcd - r) * q) + off; }
        const int nig = WGM * nN, gid = wgid / nig, fm = gid * WGM, gsz = (nM - fm) < WGM ? (nM - fm) : WGM;
        u.pm = fm + ((wgid % nig) % gsz); u.pn = (wgid % nig) / gsz; return true;
    }
    __device__ __forceinline__ void a_ready(const Unit&) const {}
    __device__ __forceinline__ void done(const Unit&) const {}
};
__device__ __forceinline__ unsigned cvt_pk_bf16(float lo, float hi) { unsigned r; asm volatile("v_cvt_pk_bf16_f32 %0, %1, %2" : "=v"(r) : "v"(lo), "v"(hi)); return r; }
typedef float f32x2 __attribute__((ext_vector_type(2)));
template <class Epi, class Sched, bool STAMP = false>
__device__ __forceinline__ void gemm_phase(PG8_LAS unsigned char* lds, const Gemm g, const Sched& S, const Epi& E, unsigned long long* stamps) {
    int tid_ = (S.wid << 6) | (int)__builtin_amdgcn_mbcnt_hi(~0u, __builtin_amdgcn_mbcnt_lo(~0u, 0u)); asm volatile("" : "+v"(tid_)); const int tid = tid_, wid = __builtin_amdgcn_readfirstlane(tid >> 6), lane = tid & 63, wr = wid >> 2, wc = wid & 3, fr = lane & 15, fq = lane >> 4;
    int K_ = g.K; asm volatile("" : "+s"(K_)); const int K = K_, nt = K / BK;
    int ts_lo = 0, ts_hi = 0, nts = 0; const unsigned long long rt_entry = STAMP ? (unsigned long long)wall_clock64() : 0ull;
#define PG8_STAMP() do { if (STAMP && wid == 0 && nts < 64) { const unsigned long long _c = (unsigned long long)clock64(); \
        ts_lo = (lane == nts) ? (int)(unsigned)_c : ts_lo; ts_hi = (lane == nts) ? (int)(unsigned)(_c >> 32) : ts_hi; ++nts; } } while (0)
    PG8_STAMP();
    unsigned voffA[2], voffB[2];
#pragma unroll
    for (int i = 0; i < 2; ++i) { int R, C; stage_rc(tid * 16 + i * 8192, R, C); const int Rb = Epi::PERM ? ((R & ~31) + perm32(R & 31)) : R;
        voffA[i] = (unsigned)(R * K + C) * 2u; voffB[i] = (unsigned)(Rb * K + C) * 2u; }
    const size_t kstep = (size_t)(BK * 2);
    const size_t hstep = (size_t)HALF * K * 2;
    const size_t tstep = 2 * hstep;
    const unsigned ldsw = (unsigned)wid * 1024u;
    const int aoff = lds_byte(wr * 64 + fr, fq * 8), boff = lds_byte(wc * 32 + fr, fq * 8);
#define PG8_SA(b, h) (((b) * 2 + (h)) * HTB)
#define PG8_SB(b, h) ((4 + (b) * 2 + (h)) * HTB)
#define PG8_STAGE(bufoff, gbase, voff) do { _Pragma("unroll") for (int _i = 0; _i < 2; ++_i) \
        __builtin_amdgcn_global_load_lds((const unsigned*)((const char*)(gbase) + (voff)[_i]), (PG8_LAS unsigned*)(lds + (bufoff) + ldsw + _i * 8192), 16, 0, 0); } while (0)
#define PG8_LDA(dst, b, h) do { _Pragma("unroll") for (int m = 0; m < 4; ++m) _Pragma("unroll") for (int k = 0; k < 2; ++k) dst[m][k] = *(const PG8_LAS bf16x8*)(lds + PG8_SA(b, h) + aoff + m * 2048 + k * 1024); } while (0)
#define PG8_LDB(dst, b, h) do { _Pragma("unroll") for (int n = 0; n < 2; ++n) _Pragma("unroll") for (int k = 0; k < 2; ++k) dst[n][k] = *(const PG8_LAS bf16x8*)(lds + PG8_SB(b, h) + boff + n * 2048 + k * 1024); } while (0)
#define PG8_MMA(ai, bj, At, Bt) do { __builtin_amdgcn_s_setprio(1); _Pragma("unroll") for (int m = 0; m < 4; ++m) _Pragma("unroll") for (int n = 0; n < 2; ++n) _Pragma("unroll") for (int k = 0; k < 2; ++k) \
        acc[ai][bj][m][n] = __builtin_amdgcn_mfma_f32_16x16x32_bf16(Bt[n][k], At[m][k], acc[ai][bj][m][n], 0, 0, 0); __builtin_amdgcn_s_setprio(0); } while (0)
#define PG8_WAIT_V(n) asm volatile("s_waitcnt vmcnt(" #n ")" ::: "memory")
#define PG8_WAIT_L(n) asm volatile("s_waitcnt lgkmcnt(" #n ")" ::: "memory")
#define PG8_BAR __builtin_amdgcn_s_barrier()
#define PG8_SCHED __builtin_amdgcn_sched_barrier(0)
    Unit cur, nxt; int ui = 0;
    if (!S.next(0, cur)) return;
    f32x4 acc[2][2][4][2];
#pragma unroll
    for (int a = 0; a < 2; ++a)
#pragma unroll
        for (int b = 0; b < 2; ++b)
#pragma unroll
            for (int m = 0; m < 4; ++m)
#pragma unroll
                for (int n = 0; n < 2; ++n) acc[a][b][m][n] = (f32x4){0.f, 0.f, 0.f, 0.f};
    bf16x8 At[4][2], B0[2][2], B1[2][2];
    const char* cA = (const char*)g.A + (size_t)cur.pm * tstep; const char* cB = (const char*)g.Bt + (size_t)cur.pn * tstep;
    S.a_ready(cur);
    PG8_STAGE(PG8_SB(0, 0), cB, voffB); PG8_STAGE(PG8_SA(0, 0), cA, voffA); PG8_STAGE(PG8_SB(0, 1), cB + hstep, voffB); PG8_STAGE(PG8_SA(0, 1), cA + hstep, voffA);
    if (wr == 1) PG8_BAR;
    PG8_WAIT_V(4); PG8_BAR;
    PG8_STAGE(PG8_SB(1, 0), cB + kstep, voffB); PG8_STAGE(PG8_SA(1, 0), cA + kstep, voffA); PG8_STAGE(PG8_SB(1, 1), cB + hstep + kstep, voffB);
    PG8_WAIT_V(6); PG8_BAR;
    PG8_STAMP();
    for (;;) {
        const bool has_next = S.next(ui + 1, nxt);
        const char* nA = has_next ? (const char*)g.A + (size_t)nxt.pm * tstep : cA; const char* nB = has_next ? (const char*)g.Bt + (size_t)nxt.pn * tstep : cB;
        for (int t = 0; t < nt; t += 2) {
            const bool last = (t == nt - 2);
            const char* a1 = cA + (size_t)(t + 1) * kstep;
            const char* a2 = last ? nA : cA + (size_t)(t + 2) * kstep; const char* b2 = last ? nB : cB + (size_t)(t + 2) * kstep;
            const char* a3 = a2 + kstep; const char* b3 = b2 + kstep;
            if (last && has_next) S.a_ready(nxt);
            PG8_LDB(B0, 0, 0); PG8_SCHED; PG8_LDA(At, 0, 0); PG8_STAGE(PG8_SA(1, 1), a1 + hstep, voffA);
            PG8_WAIT_L(8); PG8_BAR; PG8_WAIT_L(0); PG8_MMA(0, 0, At, B0); PG8_BAR; PG8_SCHED;
            PG8_LDB(B1, 0, 1); PG8_STAGE(PG8_SB(0, 0), b2, voffB);
            PG8_BAR; PG8_WAIT_L(0); PG8_MMA(0, 1, At, B1); PG8_BAR;
            PG8_LDA(At, 0, 1); PG8_STAGE(PG8_SA(0, 0), a2, voffA);
            PG8_BAR; PG8_WAIT_L(0); PG8_MMA(1, 0, At, B0); PG8_BAR; PG8_SCHED;
            PG8_STAGE(PG8_SB(0, 1), b2 + hstep, voffB);
            PG8_WAIT_V(6); PG8_BAR; PG8_MMA(1, 1, At, B1); PG8_BAR;
            PG8_LDB(B0, 1, 0); PG8_SCHED; PG8_LDA(At, 1, 0); PG8_STAGE(PG8_SA(0, 1), a2 + hstep, voffA);
            PG8_WAIT_L(8); PG8_BAR; PG8_WAIT_L(0); PG8_MMA(0, 0, At, B0); PG8_BAR; PG8_SCHED;
            PG8_LDB(B1, 1, 1); PG8_STAGE(PG8_SB(1, 0), b3, voffB);
            PG8_BAR; PG8_WAIT_L(0); PG8_MMA(0, 1, At, B1); PG8_BAR;
            PG8_LDA(At, 1, 1); PG8_STAGE(PG8_SA(1, 0), a3, voffA);
            PG8_BAR; PG8_WAIT_L(0); PG8_MMA(1, 0, At, B0); PG8_BAR; PG8_SCHED;
            PG8_STAGE(PG8_SB(1, 1), b3 + hstep, voffB);
            PG8_WAIT_V(6); PG8_BAR; PG8_MMA(1, 1, At, B1); PG8_BAR;
        }
        PG8_STAMP();
        if constexpr (!Epi::AFTER_DRAIN) { E(acc, cur, wr, wc, fr, fq); S.done(cur); }
        PG8_STAMP();
        if (!has_next) break;
#pragma unroll
        for (int a = 0; a < 2; ++a)
#pragma unroll
            for (int b = 0; b < 2; ++b)
#pragma unroll
                for (int m = 0; m < 4; ++m)
#pragma unroll
                    for (int n = 0; n < 2; ++n) acc[a][b][m][n] = (f32x4){0.f, 0.f, 0.f, 0.f};
        cur = nxt; cA = nA; cB = nB; ++ui;
    }
    PG8_WAIT_V(0);
    if (wr == 0) PG8_BAR;
    PG8_BAR;
    if constexpr (Epi::AFTER_DRAIN) { E.fused(acc, cur, wr, wc, fr, fq, lds, wid, lane); S.done(cur); }
    PG8_STAMP();
    if (STAMP && wid == 0) { stamps[lane] = lane < nts ? (((unsigned long long)(unsigned)ts_hi << 32) | (unsigned)ts_lo) : 0ull;
        if (lane == 62) stamps[62] = rt_entry; if (lane == 63) stamps[63] = (unsigned long long)wall_clock64(); }
#undef PG8_STAMP
#undef PG8_SA
#undef PG8_SB
#undef PG8_STAGE
#undef PG8_LDA
#undef PG8_LDB
#undef PG8_MMA
#undef PG8_WAIT_V
#undef PG8_WAIT_L
#undef PG8_BAR
#undef PG8_SCHED
}
}
using pg8::bf16_t; using pg8::bf16x8; using pg8::f32x4; using pg8::u32x4; using pg8::Unit;
#define LAS __attribute__((address_space(3)))
typedef unsigned u32x2 __attribute__((ext_vector_type(2)));
typedef LAS unsigned char* lds_t;
struct Params;
__device__ __forceinline__ int lane_id_() { return (int)__builtin_amdgcn_mbcnt_hi(~0u, __builtin_amdgcn_mbcnt_lo(~0u, 0u)); }
typedef float f32x2_t __attribute__((ext_vector_type(2)));

enum { I_XP = 0, I_XS, I_C, I_CCTX, I_CKV, I_CKR, I_SGLA, I_SS5, I_NORMW, I_WADA, I_BADA, I_WIN, I_WA2, I_BA, I_ONORM, I_QNORM, I_WUQ, I_KVNORM, I_WUK, I_WUV,
       I_QHNORM, I_KHNORM, I_ARE, I_AIM, I_LOGDT, I_BRE, I_BIM, I_CRE, I_CIM, I_S5D, I_WGLU, I_BGLU, I_WBOG, I_WBOM, I_WBOS, I_WOUT, N_IN };
struct KParams { const float* in[N_IN]; float* out; unsigned char* ws; };
struct Params { const float* const* in; float* out; unsigned char* ws; int wid; };
__device__ __forceinline__ int tid_opaque(const Params& p) { int t = (p.wid << 6) | lane_id_(); asm volatile("" : "+v"(t)); return t; }

constexpr int LDZ = 6912;
constexpr int ZQ = 0, ZK = 256, ZV = 512, ZGA = 1024, ZGG = 1056, ZMQ = 1568, ZMKV = 1952, ZMKR = 2208, ZMG = 2240, ZSU = 2752, ZSG = 3264, ZMERGE = 3776;
constexpr size_t OUT_YP = 0, OUT_CKV = 8388608, OUT_KR = 10485760, OUT_GLA = 10747904, OUT_S5 = 12845056;
constexpr size_t OFF_WIN = 0;

constexpr size_t OFF_WUQ = OFF_WIN + 14155776;
constexpr size_t OFF_WKV = OFF_WUQ + 393216;
constexpr size_t OFF_WGLU = OFF_WKV + 393216;
constexpr size_t OFF_WBO = OFF_WGLU + 1048576;
constexpr size_t OFF_WOUT = OFF_WBO + 3145728;
constexpr size_t OFF_S5M = OFF_WOUT + 2097152;
constexpr size_t OFF_V = OFF_S5M;
constexpr size_t OFF_P16 = OFF_S5M + 12582912;
constexpr size_t OFF_ADA = OFF_P16 + 32768;
constexpr size_t OFF_ROPE = OFF_ADA + 122880;
constexpr size_t OFF_CTX0 = OFF_ROPE + 131072;
constexpr size_t OFF_CKVN = OFF_CTX0 + 1048576;
constexpr size_t OFF_CTX1 = OFF_CKVN + 4194304;
constexpr size_t OFF_HB = OFF_CTX1 + 1048576;
constexpr size_t OFF_Z = OFF_HB + 16777216;
constexpr size_t OFF_KV = OFF_Z + 113246208;
constexpr size_t OFF_AGLA = OFF_KV, OFF_AMLA = OFF_KV + 8388608;
constexpr size_t OFF_QD = OFF_KV + 16777216;
constexpr size_t OFF_OIB = OFF_QD + 8388608;
constexpr size_t OFF_DEC = OFF_KV + 33554432;
constexpr size_t OFF_ST = OFF_DEC + 262144;
constexpr size_t OFF_AQ = OFF_ST + 16777216;
constexpr size_t OFF_QRAW = OFF_AQ + 6291456;
constexpr size_t OFF_AS5 = OFF_QRAW + 6291456;
constexpr size_t OFF_YG = OFF_AS5 + 8388608;
constexpr size_t OFF_TBL = OFF_YG + 8388608;
constexpr size_t OFF_BAR = OFF_TBL + 512;
constexpr size_t OFF_KF = OFF_BAR + 16384;
constexpr size_t WS_END = OFF_KF + 7864320;
constexpr int DYN_LDS = 147456;

__device__ __forceinline__ float bf2f(bf16_t b) { return __uint_as_float(((unsigned)b) << 16); }
__device__ __forceinline__ bf16_t f2bf(float f) { unsigned u = __float_as_uint(f); u += 0x7FFFu + ((u >> 16) & 1u); return (bf16_t)(u >> 16); }
__device__ __forceinline__ unsigned pk2(float lo, float hi) { return pg8::cvt_pk_bf16(lo, hi); }
__device__ __forceinline__ float lo16(unsigned w) { return __uint_as_float(w << 16); }
__device__ __forceinline__ float hi16(unsigned w) { return __uint_as_float(w & 0xffff0000u); }
__device__ __forceinline__ float sigmoidf_(float x) { return 1.f / (1.f + __expf(-x)); }
__device__ __forceinline__ float siluf_(float x) { return x / (1.f + __expf(-x)); }
__device__ __forceinline__ void store8(bf16_t* p, const f32x4& a, const f32x4& b) { u32x4 w; w.x = pk2(a[0], a[1]); w.y = pk2(a[2], a[3]); w.z = pk2(b[0], b[1]); w.w = pk2(b[2], b[3]); *(u32x4*)p = w; }
#define MFMA16(a, b, c) __builtin_amdgcn_mfma_f32_16x16x32_bf16(a, b, c, 0, 0, 0)
#define LDSFRAG(ptr) (*(const LAS bf16x8*)(ptr))

struct Order : pg8::StaticOrder { int wid;
    __device__ void setup(int M, int N, int rot, int wid_) { wid = wid_; const int G = (int)gridDim.x; init(M, N, G, (int)((blockIdx.x + (unsigned)rot) % (unsigned)G)); }
};

struct EpiZ { static constexpr bool PERM = true, AFTER_DRAIN = false; bf16_t* Z;
    __device__ __forceinline__ void operator()(const f32x4 (&acc)[2][2][4][2], const Unit& u, int wr, int wc, int fr_, int fq_) const {
        int fr = fr_, fq = fq_; asm volatile("" : "+v"(fr), "+v"(fq));
        const int row0 = u.pm * 256 + wr * 64 + fr, col0 = u.pn * 256 + wc * 32 + 8 * fq;
#pragma unroll
        for (int ai = 0; ai < 2; ++ai)
#pragma unroll
            for (int m = 0; m < 4; ++m) { bf16_t* rp = Z + (size_t)(row0 + ai * 128 + m * 16) * LDZ + col0;
#pragma unroll
                for (int bj = 0; bj < 2; ++bj) store8(rp + bj * 128, acc[ai][bj][m][0], acc[ai][bj][m][1]); }
    } };
struct EpiQ { static constexpr bool PERM = true, AFTER_DRAIN = false; bf16_t* Q;
    __device__ __forceinline__ void operator()(const f32x4 (&acc)[2][2][4][2], const Unit& u, int wr, int wc, int fr_, int fq_) const {
        int fr = fr_, fq = fq_; asm volatile("" : "+v"(fr), "+v"(fq));
        const int row0 = u.pm * 256 + wr * 64 + fr, col0 = u.pn * 256 + wc * 32 + 8 * fq;
#pragma unroll
        for (int ai = 0; ai < 2; ++ai)
#pragma unroll
            for (int m = 0; m < 4; ++m) { bf16_t* rp = Q + (size_t)(row0 + ai * 128 + m * 16) * 384 + col0;
#pragma unroll
                for (int bj = 0; bj < 2; ++bj) if (col0 + bj * 128 < 384) store8(rp + bj * 128, acc[ai][bj][m][0], acc[ai][bj][m][1]);
                }
    } };
struct EpiKV { static constexpr bool PERM = true, AFTER_DRAIN = true; bf16_t* KF; bf16_t* V; int layer; const bf16_t* Z; const float* ckr; const float* khn; const float* R;
    __device__ __forceinline__ void fused(f32x4 (&acc)[2][2][4][2], const Unit& u, int wr, int wc, int fr_, int fq_, LAS unsigned char* lds, int wid, int lane_) const {
        if (u.pn == 0) { (*this)(acc, u, wr, wc, fr_, fq_); return; }
        int fr = fr_, fq = fq_, lane = lane_; asm volatile("" : "+v"(fr), "+v"(fq), "+v"(lane));
        LAS bf16_t* T = (LAS bf16_t*)lds;
#pragma unroll
        for (int ai = 0; ai < 2; ++ai)
#pragma unroll
            for (int m = 0; m < 4; ++m) { const int kl = ai * 128 + wr * 64 + m * 16 + fr;
#pragma unroll
                for (int bj = 0; bj < 2; ++bj) { const int el = bj * 128 + wc * 32 + 8 * fq;
#pragma unroll
                    for (int i = 0; i < 8; i += 2) { const unsigned w = pk2(acc[ai][bj][m][i >> 2][i & 3], acc[ai][bj][m][i >> 2][(i & 3) + 1]); T[(el + i) * 264 + kl] = (bf16_t)(w & 0xffffu); T[(el + i + 1) * 264 + kl] = (bf16_t)(w >> 16); } } }
        __syncthreads();
        int rb = u.pm * 256; if (layer == 0) rb = rb < 2048 ? 8192 + rb : rb - 2048;
        bf16_t* bp; int st;
        if (rb < 4096) { bp = V + (size_t)(rb >> 8) * 4 * 128 * 256; st = 256; }
        else if (rb < 8192) { bp = V + 2097152 + (size_t)((rb - 4096) >> 10) * 4 * 128 * 1536 + 512 + ((rb - 4096) & 1023); st = 1536; }
        else { bp = V + 2097152 + (size_t)((rb - 8192) >> 9) * 4 * 128 * 1536 + ((rb - 8192) & 511); st = 1536; }
        const int tid = wid * 64 + lane;
#pragma unroll
        for (int i = 0; i < 16; ++i) { const int idx = tid + 512 * i, el = idx >> 5, part = idx & 31;
            *(u32x4*)(bp + (size_t)((u.pn - 1) * 256 + el) * st + part * 8) = *(const LAS u32x4*)(T + el * 264 + part * 8); }
        __syncthreads();
    }
    __device__ __forceinline__ void operator()(const f32x4 (&acc)[2][2][4][2], const Unit& u, int wr, int wc, int fr_, int fq_) const {
        int fr = fr_, fq = fq_; asm volatile("" : "+v"(fr), "+v"(fq));
        int rb = u.pm * 256; if (layer == 0) rb = rb < 2048 ? 8192 + rb : rb - 2048;
        const int row0 = rb + wr * 64 + fr;
        float w1[4], w2[4];
#pragma unroll
        for (int i = 0; i < 4; ++i) { w1[i] = khn[64 + 4 * fq + i]; w2[i] = khn[80 + 4 * fq + i]; }
#pragma unroll
        for (int ai = 0; ai < 2; ++ai)
#pragma unroll
          for (int mh = 0; mh < 4; mh += 1) {
            float x1[4][4], x2[4][4], cs[4][4], sn[4][4];
#pragma unroll
            for (int m = mh; m < mh + 1; ++m) { const int r = row0 + ai * 128 + m * 16;
                if (r >= 8192) { const int j = r - 8192; const float* kr = ckr + ((size_t)(((j >> 9) * 2 + layer) * 512 + (j & 511))) * 32 + 4 * fq;
                    const f32x4 a = *(const f32x4*)kr, b = *(const f32x4*)(kr + 16);
#pragma unroll
                    for (int i = 0; i < 4; ++i) { x1[m][i] = a[i]; x2[m][i] = b[i]; } }
                else { const bf16_t* kr = Z + (size_t)r * LDZ + ZMKR + 4 * fq; const u32x2 a = *(const u32x2*)kr, b = *(const u32x2*)(kr + 16);
                    x1[m][0] = lo16(a.x); x1[m][1] = hi16(a.x); x1[m][2] = lo16(a.y); x1[m][3] = hi16(a.y); x2[m][0] = lo16(b.x); x2[m][1] = hi16(b.x); x2[m][2] = lo16(b.y); x2[m][3] = hi16(b.y); }
                const bool rot = r >= 4096 && r < 8192; const int pos = (r - 4096) & 1023;
                if (rot) { const f32x4 c = *(const f32x4*)(R + pos * 16 + 4 * fq), s_ = *(const f32x4*)(R + 16384 + pos * 16 + 4 * fq);
#pragma unroll
                    for (int i = 0; i < 4; ++i) { cs[m][i] = c[i]; sn[m][i] = s_[i]; } }
                else {
#pragma unroll
                    for (int i = 0; i < 4; ++i) { cs[m][i] = 1.f; sn[m][i] = 0.f; } } }
#pragma unroll
            for (int m = mh; m < mh + 1; ++m) { const int r = row0 + ai * 128 + m * 16;
                float ss = 0.f;
#pragma unroll
                for (int bj = 0; bj < 2; ++bj)
#pragma unroll
                    for (int i = 0; i < 8; ++i) { const float v = acc[ai][bj][m][i >> 2][i & 3]; ss += v * v; }
#pragma unroll
                for (int i = 0; i < 4; ++i) ss += x1[m][i] * x1[m][i] + x2[m][i] * x2[m][i];
                ss += __shfl_xor(ss, 16); ss += __shfl_xor(ss, 32);
                const float rstd = rsqrtf(ss * (1.f / 96.f) + 1e-6f);
                bf16_t* kp = KF + (size_t)r * 384 + wc * 96;
#pragma unroll
                for (int bj = 0; bj < 2; ++bj) { u32x4 w; const f32x4 v0 = acc[ai][bj][m][0], v1 = acc[ai][bj][m][1];
                    w.x = pk2(v0[0] * rstd, v0[1] * rstd); w.y = pk2(v0[2] * rstd, v0[3] * rstd);
                    w.z = pk2(v1[0] * rstd, v1[1] * rstd); w.w = pk2(v1[2] * rstd, v1[3] * rstd);
                    *(u32x4*)(kp + 32 * bj + 8 * fq) = w; }
                float o1[4], o2[4];
#pragma unroll
                for (int i = 0; i < 4; ++i) { const float a = x1[m][i] * rstd * w1[i], b = x2[m][i] * rstd * w2[i]; o1[i] = a * cs[m][i] - b * sn[m][i]; o2[i] = a * sn[m][i] + b * cs[m][i]; }
                *(u32x2*)(kp + 64 + 4 * fq) = (u32x2){pk2(o1[0], o1[1]), pk2(o1[2], o1[3])}; *(u32x2*)(kp + 80 + 4 * fq) = (u32x2){pk2(o2[0], o2[1]), pk2(o2[2], o2[3])}; }
            __builtin_amdgcn_sched_barrier(0); }
    } };
struct EpiGLU { static constexpr bool PERM = true, AFTER_DRAIN = false; bf16_t* O; const bf16_t* Z; const float* bias;
    __device__ __forceinline__ void operator()(const f32x4 (&acc)[2][2][4][2], const Unit& u, int wr, int wc, int fr_, int fq_) const {
        int fr = fr_, fq = fq_; asm volatile("" : "+v"(fr), "+v"(fq));
        const int row0 = u.pm * 256 + wr * 64 + fr, oc = u.pn * 128 + wc * 32 + 8 * fq;
#pragma unroll
        for (int ai = 0; ai < 2; ++ai) {
            float bv[8], bg[8];
            { const f32x4 b0 = *(const f32x4*)(bias + oc), b1 = *(const f32x4*)(bias + oc + 4), g0 = *(const f32x4*)(bias + 512 + oc), g1 = *(const f32x4*)(bias + 512 + oc + 4);
#pragma unroll
              for (int i = 0; i < 4; ++i) { bv[i] = b0[i]; bv[4 + i] = b1[i]; bg[i] = g0[i]; bg[4 + i] = g1[i]; } }
            u32x4 sgv[2][4];
#pragma unroll
            for (int m = 0; m < 4; ++m) sgv[ai][m] = *(const u32x4*)(Z + (size_t)(row0 + ai * 128 + m * 16) * LDZ + ZSG + oc);
#pragma unroll
            for (int m = 0; m < 4; ++m) { const size_t r = (size_t)(row0 + ai * 128 + m * 16);
                const u32x4 sg = sgv[ai][m];
                float g[8] = { lo16(sg.x), hi16(sg.x), lo16(sg.y), hi16(sg.y), lo16(sg.z), hi16(sg.z), lo16(sg.w), hi16(sg.w) };
                float o[8];
#pragma unroll
                for (int i = 0; i < 8; ++i) { const float zv = acc[ai][0][m][i >> 2][i & 3] + bv[i], zg = acc[ai][1][m][i >> 2][i & 3] + bg[i]; o[i] = zv * sigmoidf_(zg) * siluf_(g[i]); }
                u32x4 w; w.x = pk2(o[0], o[1]); w.y = pk2(o[2], o[3]); w.z = pk2(o[4], o[5]); w.w = pk2(o[6], o[7]);
                *(u32x4*)(O + r * 512 + oc) = w; }
            __builtin_amdgcn_sched_barrier(0); }
    } };
struct EpiBo { static constexpr bool PERM = true, AFTER_DRAIN = true; bf16_t* MIX; const bf16_t* Z; int branch;
    __device__ __forceinline__ void fused(f32x4 (&acc)[2][2][4][2], const Unit& u, int wr, int wc, int fr_, int fq_, LAS unsigned char* lds, int wid, int lane_) const {
        int fr = fr_, fq = fq_, lane = lane_; asm volatile("" : "+v"(fr), "+v"(fq), "+v"(lane));
        const int row0 = u.pm * 256 + wr * 64 + fr, col0 = u.pn * 256 + wc * 32 + 8 * fq;
        LAS unsigned char* wl = lds + wid * 16384;
#pragma unroll
        for (int ai = 0; ai < 2; ++ai)
#pragma unroll
            for (int m = 0; m < 4; ++m)
#pragma unroll
                for (int bj = 0; bj < 2; ++bj)
                    __builtin_amdgcn_global_load_lds((const unsigned*)(Z + (size_t)(row0 + ai * 128 + m * 16) * LDZ + ZMERGE + branch * 1024 + col0 + bj * 128), (LAS unsigned*)(wl + ((ai * 4 + m) * 2 + bj) * 1024), 16, 0, 0);
#pragma unroll
        for (int ai = 0; ai < 2; ++ai) {
            u32x4 pv[4][2];
#pragma unroll
            for (int m = 0; m < 4; ++m)
#pragma unroll
                for (int bj = 0; bj < 2; ++bj) pv[m][bj] = branch > 0 ? *(const u32x4*)(MIX + (size_t)(row0 + ai * 128 + m * 16) * 1024 + col0 + bj * 128) : (u32x4){0u, 0u, 0u, 0u};
            if (ai == 0) { asm volatile("s_waitcnt vmcnt(0)" ::: "memory"); __builtin_amdgcn_s_barrier(); asm volatile("" ::: "memory"); }
#pragma unroll
            for (int m = 0; m < 4; ++m) { const size_t r = (size_t)(row0 + ai * 128 + m * 16);
#pragma unroll
                for (int bj = 0; bj < 2; ++bj) { const u32x4 sg = *(const LAS u32x4*)(wl + ((ai * 4 + m) * 2 + bj) * 1024 + lane * 16), pp = pv[m][bj];
                    const float g[8] = { lo16(sg.x), hi16(sg.x), lo16(sg.y), hi16(sg.y), lo16(sg.z), hi16(sg.z), lo16(sg.w), hi16(sg.w) };
                    const float q[8] = { lo16(pp.x), hi16(pp.x), lo16(pp.y), hi16(pp.y), lo16(pp.z), hi16(pp.z), lo16(pp.w), hi16(pp.w) };
                    float o[8];
#pragma unroll
                    for (int i = 0; i < 8; ++i) o[i] = q[i] + sigmoidf_(g[i]) * acc[ai][bj][m][i >> 2][i & 3];
                    u32x4 w; w.x = pk2(o[0], o[1]); w.y = pk2(o[2], o[3]); w.z = pk2(o[4], o[5]); w.w = pk2(o[6], o[7]);
                    *(u32x4*)(MIX + r * 1024 + col0 + bj * 128) = w; } }
            __builtin_amdgcn_sched_barrier(0); }
        __syncthreads();
    }
    __device__ __forceinline__ void operator()(const f32x4 (&acc)[2][2][4][2], const Unit& u, int wr, int wc, int fr_, int fq_) const {
        int fr = fr_, fq = fq_; asm volatile("" : "+v"(fr), "+v"(fq));
        const int row0 = u.pm * 256 + wr * 64 + fr, col0 = u.pn * 256 + wc * 32 + 8 * fq;
#pragma unroll
        for (int ai = 0; ai < 2; ++ai)
#pragma unroll
          for (int mh = 0; mh < 4; mh += 2) {
            u32x4 gz[4][2], pv[4][2];
#pragma unroll
            for (int m = mh; m < mh + 2; ++m)
#pragma unroll
                for (int bj = 0; bj < 2; ++bj) { const size_t r = (size_t)(row0 + ai * 128 + m * 16);
                    gz[m][bj] = *(const u32x4*)(Z + r * LDZ + ZMERGE + branch * 1024 + col0 + bj * 128);
                    pv[m][bj] = branch > 0 ? *(const u32x4*)(MIX + r * 1024 + col0 + bj * 128) : (u32x4){0u, 0u, 0u, 0u}; }
#pragma unroll
            for (int m = mh; m < mh + 2; ++m) { const size_t r = (size_t)(row0 + ai * 128 + m * 16);
#pragma unroll
                for (int bj = 0; bj < 2; ++bj) { const u32x4 sg = gz[m][bj], pp = pv[m][bj];
                    const float g[8] = { lo16(sg.x), hi16(sg.x), lo16(sg.y), hi16(sg.y), lo16(sg.z), hi16(sg.z), lo16(sg.w), hi16(sg.w) };
                    const float q[8] = { lo16(pp.x), hi16(pp.x), lo16(pp.y), hi16(pp.y), lo16(pp.z), hi16(pp.z), lo16(pp.w), hi16(pp.w) };
                    float o[8];
#pragma unroll
                    for (int i = 0; i < 8; ++i) o[i] = q[i] + sigmoidf_(g[i]) * acc[ai][bj][m][i >> 2][i & 3];
                    u32x4 w; w.x = pk2(o[0], o[1]); w.y = pk2(o[2], o[3]); w.z = pk2(o[4], o[5]); w.w = pk2(o[6], o[7]);
                    *(u32x4*)(MIX + r * 1024 + col0 + bj * 128) = w; } }
            __builtin_amdgcn_sched_barrier(0); }
    } };
struct EpiOut { static constexpr bool PERM = false, AFTER_DRAIN = true; float* Y; const float* xp; const float* xs; const float* ada;
    __device__ __forceinline__ void fused(f32x4 (&acc)[2][2][4][2], const Unit& u, int wr, int wc, int fr_, int fq_, LAS unsigned char* lds, int wid, int lane_) const {
        int fr = fr_, fq = fq_, lane = lane_; asm volatile("" : "+v"(fr), "+v"(fq), "+v"(lane));
        const int row0 = u.pm * 256 + wr * 64 + fr, col0 = u.pn * 256 + wc * 32 + 4 * fq;
        LAS unsigned char* wl = lds + wid * 16384;
        const float* xb = (u.pm < 16 ? xp + (size_t)row0 * 1024 : xs + (size_t)(row0 - 4096) * 1024) + col0;
#pragma unroll
        for (int m = 0; m < 4; ++m)
#pragma unroll
            for (int bj = 0; bj < 2; ++bj)
#pragma unroll
                for (int n = 0; n < 2; ++n) __builtin_amdgcn_global_load_lds((const unsigned*)(xb + (size_t)(m * 16) * 1024 + bj * 128 + n * 16), (LAS unsigned*)(wl + ((m * 2 + bj) * 2 + n) * 1024), 16, 0, 0);
        f32x4 x1[4][2][2];
#pragma unroll
        for (int m = 0; m < 4; ++m)
#pragma unroll
            for (int bj = 0; bj < 2; ++bj)
#pragma unroll
                for (int n = 0; n < 2; ++n) x1[m][bj][n] = *(const f32x4*)(xb + (size_t)(128 + m * 16) * 1024 + bj * 128 + n * 16);
        const int ar = u.pm < 16 ? 0 : 1 + ((u.pm - 16) >> 2);
        const float* gp = ada + ar * 3072 + 2048;
        f32x4 gv[2][2];
#pragma unroll
        for (int bj = 0; bj < 2; ++bj)
#pragma unroll
            for (int n = 0; n < 2; ++n) gv[bj][n] = *(const f32x4*)(gp + col0 + bj * 128 + n * 16);
        asm volatile("s_waitcnt vmcnt(0)" ::: "memory"); __builtin_amdgcn_s_barrier(); asm volatile("" ::: "memory");
        float* yb = Y + (size_t)row0 * 1024 + col0;
#pragma unroll
        for (int m = 0; m < 4; ++m)
#pragma unroll
            for (int bj = 0; bj < 2; ++bj)
#pragma unroll
                for (int n = 0; n < 2; ++n) { const f32x4 xv = *(const LAS f32x4*)(wl + ((m * 2 + bj) * 2 + n) * 1024 + lane * 16);
                    *(f32x4*)(yb + (size_t)(m * 16) * 1024 + bj * 128 + n * 16) = xv + gv[bj][n] * acc[0][bj][m][n];
                    *(f32x4*)(yb + (size_t)(128 + m * 16) * 1024 + bj * 128 + n * 16) = x1[m][bj][n] + gv[bj][n] * acc[1][bj][m][n]; }
        __syncthreads();
    }
    __device__ __forceinline__ void operator()(const f32x4 (&acc)[2][2][4][2], const Unit& u, int wr, int wc, int fr_, int fq_) const {
        int fr = fr_, fq = fq_; asm volatile("" : "+v"(fr), "+v"(fq));
        const int row0 = u.pm * 256 + wr * 64 + fr, col0 = u.pn * 256 + wc * 32 + 4 * fq;
        const int ar = u.pm < 16 ? 0 : 1 + ((u.pm - 16) >> 2);
        const float* gp = ada + ar * 3072 + 2048;
        f32x4 gv[2][2];
#pragma unroll
        for (int bj = 0; bj < 2; ++bj)
#pragma unroll
            for (int n = 0; n < 2; ++n) gv[bj][n] = *(const f32x4*)(gp + col0 + bj * 128 + n * 16);
#pragma unroll
        for (int ai = 0; ai < 2; ++ai)
#pragma unroll
          for (int mh = 0; mh < 4; mh += 2) {
            f32x4 xv[4][2][2];
#pragma unroll
            for (int m = mh; m < mh + 2; ++m) { const int r = row0 + ai * 128 + m * 16;
                const float* xr = (r < 4096 ? xp + (size_t)r * 1024 : xs + (size_t)(r - 4096) * 1024) + col0;
#pragma unroll
                for (int bj = 0; bj < 2; ++bj)
#pragma unroll
                    for (int n = 0; n < 2; ++n) xv[m][bj][n] = *(const f32x4*)(xr + bj * 128 + n * 16); }
#pragma unroll
            for (int m = mh; m < mh + 2; ++m) { const int r = row0 + ai * 128 + m * 16;
                float* yr = Y + (size_t)r * 1024 + col0;
#pragma unroll
                for (int bj = 0; bj < 2; ++bj)
#pragma unroll
                    for (int n = 0; n < 2; ++n) *(f32x4*)(yr + bj * 128 + n * 16) = xv[m][bj][n] + gv[bj][n] * acc[ai][bj][m][n]; }
            __builtin_amdgcn_sched_barrier(0); }
    } };

__device__ __forceinline__ void job_ada(const Params& p, int j, lds_t lds) {
    LAS float* sc = (LAS float*)lds; LAS float* red = sc + 5 * 1024;
    const int l = j / 96, c0 = (j % 96) * 32, tid = tid_opaque(p);
    for (int i = tid; i < 5 * 1024; i += 512) { const int r = i >> 10, k = i & 1023; const float v = r == 0 ? p.in[I_CCTX][k] : p.in[I_C][(r - 1) * 1024 + k]; sc[i] = v / (1.f + expf(-v)); }
    __syncthreads();
    const int col = tid & 31, kg = tid >> 5; const float* W = p.in[I_WADA] + (size_t)l * 1024 * 3072 + (size_t)(kg * 64) * 3072 + c0 + col;
    float a0 = 0.f, a1 = 0.f, a2 = 0.f, a3 = 0.f, a4 = 0.f;
#pragma unroll 1
    for (int kb = 0; kb < 64; kb += 16) { float w[16];
#pragma unroll
        for (int i = 0; i < 16; ++i) w[i] = W[(size_t)(kb + i) * 3072];
#pragma unroll
        for (int i = 0; i < 16; ++i) { const int k = kg * 64 + kb + i; a0 += sc[k] * w[i]; a1 += sc[1024 + k] * w[i]; a2 += sc[2048 + k] * w[i]; a3 += sc[3072 + k] * w[i]; a4 += sc[4096 + k] * w[i]; } }
    red[(kg * 5 + 0) * 32 + col] = a0; red[(kg * 5 + 1) * 32 + col] = a1; red[(kg * 5 + 2) * 32 + col] = a2; red[(kg * 5 + 3) * 32 + col] = a3; red[(kg * 5 + 4) * 32 + col] = a4;
    __syncthreads();
    if (tid < 160) { const int r = tid >> 5, cc = tid & 31; float s = p.in[I_BADA][l * 3072 + c0 + cc];
        for (int g = 0; g < 16; ++g) s += red[(g * 5 + r) * 32 + cc];
        ((float*)(p.ws + OFF_ADA))[(l * 5 + r) * 3072 + c0 + cc] = s; }
    __syncthreads();
}
__device__ __forceinline__ void job_ctx(const Params& p, int j) {
    const int base = j * 4096 + tid_opaque(p) * 8; const int l = base / (2048 * 256), rem = base % (2048 * 256), row = rem >> 8, c = rem & 255, b = row >> 9, jj = row & 511;
    const float* s = p.in[I_CKV] + ((size_t)((b * 2 + l) * 512 + jj)) * 256 + c;
    const f32x4 v0 = *(const f32x4*)s, v1 = *(const f32x4*)(s + 4);
    bf16_t* d = (bf16_t*)(p.ws + (l == 0 ? OFF_CTX0 : OFF_CTX1)) + (size_t)row * 256 + c;
    store8(d, v0, v1);
}
__device__ __forceinline__ void job_rope(const Params& p, int j) {
    const int idx = j * 512 + tid_opaque(p), pos = idx >> 4, i = idx & 15, f = i & 7;
    const float inv = powf(10000.f, -(float)f / 8.f); const float ang = (float)(i < 8 ? (pos >> 6) : (pos & 63)) * inv;
    float* R = (float*)(p.ws + OFF_ROPE); R[idx] = cosf(ang); R[16384 + idx] = sinf(ang);
}

__device__ __forceinline__ void job_prep(const Params& p, int l, int j) {
    const int tid = tid_opaque(p), wid = tid >> 6, lane = tid & 63, row = j * 8 + wid;
    const float* x = l == 0 ? (row < 4096 ? p.in[I_XP] + (size_t)row * 1024 : p.in[I_XS] + (size_t)(row - 4096) * 1024) : p.out + (size_t)row * 1024;
    const int ar = row < 4096 ? 0 : 1 + ((row - 4096) >> 10);
    const float* ada = (const float*)(p.ws + OFF_ADA) + (l * 5 + ar) * 3072; const float* nw = p.in[I_NORMW] + l * 1024;
    f32x4 v[4]; float ss = 0.f;
#pragma unroll
    for (int i = 0; i < 4; ++i) { v[i] = *(const f32x4*)(x + i * 256 + lane * 4); ss += v[i][0] * v[i][0] + v[i][1] * v[i][1] + v[i][2] * v[i][2] + v[i][3] * v[i][3]; }
#pragma unroll
    for (int o = 1; o < 64; o <<= 1) ss += __shfl_xor(ss, o);
    const float rstd = rsqrtf(ss * (1.f / 1024.f) + 1e-6f);
    bf16_t* h = (bf16_t*)(p.ws + OFF_HB) + (size_t)row * 1024;
#pragma unroll
    for (int i = 0; i < 4; ++i) { const int c = i * 256 + lane * 4; const f32x4 w = *(const f32x4*)(nw + c), sh = *(const f32x4*)(ada + c), sc = *(const f32x4*)(ada + 1024 + c);
        float o[4];
#pragma unroll
        for (int k = 0; k < 4; ++k) o[k] = v[i][k] * rstd * w[k] * (1.f + sc[k]) + sh[k];
        u32x2 pk; pk.x = pk2(o[0], o[1]); pk.y = pk2(o[2], o[3]); *(u32x2*)(h + c) = pk; }
}
__device__ __forceinline__ void wt_tile(const Params& p, const float* src, int ldsrc, int sbase, int nvalid, int mode, bf16_t* dst, int K, int n0, int k0, lds_t lds) {
    LAS float* t = (LAS float*)lds; const int tid = tid_opaque(p);
    const int nn = tid & 255, kh = tid >> 8; const int sc = mode == 0 ? sbase + nn : mode == 1 ? ((nn >> 7) & 1) * 512 + sbase + (nn & 127) : ((nn >> 5) & 3) * 64 + (nn >> 7) * 32 + (nn & 31); const bool ok = mode != 0 || nn < nvalid;
    float v[32];
#pragma unroll
    for (int i = 0; i < 32; ++i) v[i] = ok ? src[(size_t)(k0 + 2 * i + kh) * ldsrc + sc] : 0.f;
#pragma unroll
    for (int i = 0; i < 32; ++i) t[(2 * i + kh) * 257 + nn] = v[i];
    __syncthreads();
#pragma unroll
    for (int ps = 0; ps < 4; ++ps) { const int n = ps * 64 + (tid >> 3), kc = tid & 7; const LAS float* s = t + (kc * 8) * 257 + n; u32x4 w;
        w.x = pk2(s[0], s[257]); w.y = pk2(s[514], s[771]); w.z = pk2(s[1028], s[1285]); w.w = pk2(s[1542], s[1799]);
        *(u32x4*)(dst + (size_t)(n0 + n) * K + k0 + kc * 8) = w; }
    __syncthreads();
}
constexpr int WT_WIN = 27 * 16, WT_WUQ = 2 * 6, WT_WKV = 3 * 4, WT_WGLU = 4 * 8, WT_WBO = 4 * 8, WT_WOUT = 4 * 16, WT_EARLY = WT_WIN + WT_WUQ + WT_WKV + WT_WGLU, WT_TOTAL = WT_EARLY + 3 * WT_WBO + WT_WOUT;
__device__ __forceinline__ void job_wt(const Params& p, int l, int t, lds_t lds) {
    if (t < WT_WIN) { const int nt = t / 16, kt = t % 16; wt_tile(p, p.in[I_WIN] + (size_t)l * 1024 * 6848, 6848, nt * 256, 6848 - nt * 256, 0, (bf16_t*)(p.ws + OFF_WIN), 1024, nt * 256, kt * 64, lds); return; } t -= WT_WIN;
    if (t < WT_WUQ) { const int nt = t / 6, kt = t % 6; wt_tile(p, p.in[I_WUQ] + (size_t)l * 384 * 384, 384, nt * 256, 384 - nt * 256, 0, (bf16_t*)(p.ws + OFF_WUQ), 384, nt * 256, kt * 64, lds); return; } t -= WT_WUQ;
    if (t < WT_WKV) { const int nt = t / 4, kt = t % 4;
        if (nt == 0) wt_tile(p, p.in[I_WUK] + (size_t)l * 256 * 256, 256, 0, 256, 2, (bf16_t*)(p.ws + OFF_WKV), 256, 0, kt * 64, lds);
        else wt_tile(p, p.in[I_WUV] + (size_t)l * 256 * 512, 512, (nt - 1) * 256, 256, 0, (bf16_t*)(p.ws + OFF_WKV), 256, nt * 256, kt * 64, lds);
        return; } t -= WT_WKV;
    if (t < WT_WGLU) { const int nt = t / 8, kt = t % 8; wt_tile(p, p.in[I_WGLU] + (size_t)l * 512 * 1024, 1024, nt * 128, 256, 1, (bf16_t*)(p.ws + OFF_WGLU), 512, nt * 256, kt * 64, lds); return; } t -= WT_WGLU;
    if (t < 3 * WT_WBO) { const int br = t / WT_WBO, tt = t % WT_WBO, nt = tt / 8, kt = tt % 8;
        wt_tile(p, p.in[I_WBOG + br] + (size_t)l * 512 * 1024, 1024, nt * 256, 256, 0, (bf16_t*)(p.ws + OFF_WBO) + (size_t)br * 1024 * 512, 512, nt * 256, kt * 64, lds); return; } t -= 3 * WT_WBO;
    { const int nt = t / 16, kt = t % 16; wt_tile(p, p.in[I_WOUT] + (size_t)l * 1024 * 1024, 1024, nt * 256, 256, 0, (bf16_t*)(p.ws + OFF_WOUT), 1024, nt * 256, kt * 64, lds); }
}
__device__ __forceinline__ void job_s5setup(const Params& p, int l, int jq, lds_t lds) {
    const int j = jq >> 2, qtr = jq & 3, g = j / 3, which = j % 3, tid = tid_opaque(p);
    LAS f32x2_t* pw = (LAS f32x2_t*)lds;
    LAS f32x2_t* Bt = pw + 2 * 17 * 64;
    LAS f32x2_t* Cn = Bt + 2 * 64 * 16;
    LAS float* Kt = (LAS float*)(Cn + 64 * 16);
    LAS float* raw = Kt + 8192;
    { const size_t gb = (size_t)(l * 32 + g) * 1024;
      for (int i = tid; i < 1024; i += 512) { raw[i] = p.in[I_BRE][gb + i]; raw[1024 + i] = p.in[I_BIM][gb + i]; raw[2048 + i] = p.in[I_CRE][gb + i]; raw[3072 + i] = p.in[I_CIM][gb + i]; }
      if (tid < 128) { const int d = tid >> 6, n = tid & 63; raw[4096 + tid] = p.in[I_ARE][((l * 2 + d) * 32 + g) * 64 + n]; raw[4224 + tid] = p.in[I_AIM][((l * 2 + d) * 32 + g) * 64 + n]; }
      if (tid < 2) raw[4352 + tid] = p.in[I_LOGDT][(l * 2 + tid) * 32 + g]; }
    __syncthreads();
    if (tid < 128) { const int d = tid >> 6, n = tid & 63;
        const float dt = expf(raw[4352 + d]);
        const float are = raw[4096 + tid], aim = raw[4224 + tid];
        float s1, c1; sincosf(aim * dt, &s1, &c1); float sh = sinf(0.5f * aim * dt);
        const float em1 = expm1f(are * dt), mag1 = em1 + 1.f;
        { float pr = 1.f, pi = 0.f; const float ar1 = mag1 * c1, ai1 = mag1 * s1;
          for (int tau = 0; tau <= 16; ++tau) { pw[(d * 17 + tau) * 64 + n] = (f32x2_t){pr, pi}; const float nr = pr * ar1 - pi * ai1, ni = pr * ai1 + pi * ar1; pr = nr; pi = ni; } }
        const float nre = em1 * c1 - 2.f * sh * sh, abim = mag1 * s1, den = are * are + aim * aim;
        const float cfr = (nre * are + abim * aim) / den, cfi = (abim * are - nre * aim) / den;
        for (int q = 0; q < 16; ++q) { const float br = raw[n * 16 + q], bi = raw[1024 + n * 16 + q];
            Bt[(d * 64 + n) * 16 + q] = (f32x2_t){cfr * br - cfi * bi, cfr * bi + cfi * br}; }
        if (which == 1 && qtr == 0) ((f32x2_t*)(p.ws + OFF_P16))[(g * 2 + d) * 64 + n] = pw[(d * 17 + 16) * 64 + n];
    }
    for (int i = tid; i < 1024; i += 512) { const int n = i >> 4, pp = i & 15; Cn[i] = (f32x2_t){raw[2048 + pp * 64 + n], raw[3072 + pp * 64 + n]}; }
    __syncthreads();
    bf16_t* M = (bf16_t*)(p.ws + OFF_S5M) + (size_t)(g * 3 + which) * 65536;
    if (which == 0) {
        { const int wid_ = tid >> 6, ln = tid & 63, lr_ = ln & 15, kq = ln >> 4;
          for (int c4 = 0; c4 < 4; ++c4) { const int dt_ = wid_ * 4 + c4, d = dt_ >> 4, tau = dt_ & 15; f32x4 acc = {0.f, 0.f, 0.f, 0.f};
#pragma unroll 4
            for (int ks = 0; ks < 16; ++ks) { const int n = ks * 4 + kq; const f32x2_t c = Cn[n * 16 + lr_], w = pw[(d * 17 + tau) * 64 + n], b = Bt[(d * 64 + n) * 16 + lr_];
                const float cwr = c.x * w.x - c.y * w.y, cwi = c.x * w.y + c.y * w.x;
                acc = __builtin_amdgcn_mfma_f32_16x16x4f32(cwr, b.x, acc, 0, 0, 0); acc = __builtin_amdgcn_mfma_f32_16x16x4f32(-cwi, b.y, acc, 0, 0, 0); }
#pragma unroll
            for (int r = 0; r < 4; ++r) Kt[dt_ * 256 + (kq * 4 + r) * 16 + lr_] = acc[r]; } }
        __syncthreads();
#pragma unroll 8
        for (int i = qtr * 16384 + tid; i < (qtr + 1) * 16384; i += 512) { const int no = i >> 8, k = i & 255, t = no >> 4, pp = no & 15, s = k >> 4, q = k & 15; float v;
            if (t > s) v = Kt[(0 * 16 + (t - s)) * 256 + pp * 16 + q];
            else if (t < s) v = Kt[(1 * 16 + (s - t)) * 256 + pp * 16 + q];
            else { v = Kt[pp * 16 + q] + Kt[16 * 256 + pp * 16 + q]; if (pp == q) v += p.in[I_S5D][l * 512 + g * 16 + pp]; }
            M[i] = f2bf(v); }
    } else if (which == 1) {
#pragma unroll 8
        for (int i = qtr * 16384 + tid; i < (qtr + 1) * 16384; i += 512) { const int no = i >> 8, k = i & 255, d = no >> 7, ri = (no >> 6) & 1, n = no & 63, s = k >> 4, q = k & 15; const int e = d == 0 ? 15 - s : s;
            const f32x2_t w = pw[(d * 17 + e) * 64 + n], b = Bt[(d * 64 + n) * 16 + q];
            M[i] = f2bf(ri == 0 ? w.x * b.x - w.y * b.y : w.x * b.y + w.y * b.x); }
    } else {
#pragma unroll 8
        for (int i = qtr * 16384 + tid; i < (qtr + 1) * 16384; i += 512) { const int no = i >> 8, k = i & 255, t = no >> 4, pp = no & 15, d = k >> 7, ri = (k >> 6) & 1, n = k & 63; const int e = d == 0 ? t + 1 : 16 - t;
            const f32x2_t c = Cn[n * 16 + pp], w = pw[(d * 17 + e) * 64 + n];
            M[i] = f2bf(ri == 0 ? c.x * w.x - c.y * w.y : -(c.x * w.y + c.y * w.x)); }
    }
    __syncthreads();
}

__device__ __forceinline__ float gelu_tanh(float x) { const float u = 0.7978845608f * (x + 0.044715f * x * x * x); const float t = 1.f - 2.f / (1.f + __expf(2.f * u)); return 0.5f * x * (1.f + t); }
__device__ __forceinline__ void job_s5(const Params& p, int l, int j, lds_t lds) {
    const int tid = tid_opaque(p), wid = tid >> 6, lane = tid & 63, lr = lane & 15, lq = lane >> 4;
    const int bb = j >> 5, g = j & 31;
    const int M = bb < 16 ? 16 : 64, MT = M >> 4; const int tok0 = bb < 16 ? bb * 256 : 4096 + (bb - 16) * 1024;
    LAS bf16_t* Us = (LAS bf16_t*)lds; LAS bf16_t* Xs = Us + 64 * 264; LAS float* Xin = (LAS float*)(lds + 2 * 64 * 264 * 2);
    const bf16_t* Z = (const bf16_t*)(p.ws + OFF_Z);
    const bf16_t* TT = (const bf16_t*)(p.ws + OFF_S5M) + (size_t)(g * 3) * 65536; const bf16_t* G = TT + 65536; const bf16_t* Cc = G + 65536;
    bf16x8 bq[8][2];
#pragma unroll
    for (int ks = 0; ks < 8; ++ks) { bq[ks][0] = *(const bf16x8*)(G + (size_t)(wid * 32 + lr) * 256 + ks * 32 + lq * 8); bq[ks][1] = *(const bf16x8*)(G + (size_t)(wid * 32 + 16 + lr) * 256 + ks * 32 + lq * 8); }
    f32x2_t a16 = {0.f, 0.f}; float xr = 0.f, xi = 0.f;
    if (tid < 128) { const int d = tid >> 6, n = tid & 63; a16 = ((const f32x2_t*)(p.ws + OFF_P16))[(g * 2 + d) * 64 + n];
        if (bb >= 16) { const size_t o = ((size_t)(((bb - 16) * 2 + l) * 2 + d) * 2) * 2048 + g * 64 + n; xr = p.in[I_SS5][o]; xi = p.in[I_SS5][o + 2048]; } }
    for (int idx = tid; idx < M * 32; idx += 512) { const int tok = idx >> 1, hf = idx & 1;
        *(LAS u32x4*)(Us + (tok >> 4) * 264 + (tok & 15) * 16 + hf * 8) = *(const u32x4*)(Z + (size_t)(tok0 + tok) * LDZ + ZSU + g * 16 + hf * 8); }
    __syncthreads();
    f32x4 acc[4][2];
#pragma unroll
    for (int a = 0; a < 4; ++a) { acc[a][0] = (f32x4){0.f, 0.f, 0.f, 0.f}; acc[a][1] = acc[a][0]; }
#pragma unroll
    for (int ks = 0; ks < 8; ++ks)
#pragma unroll
        for (int mt = 0; mt < 4; ++mt) if (mt < MT) { const bf16x8 a = LDSFRAG(Us + (mt * 16 + lr) * 264 + ks * 32 + lq * 8); acc[mt][0] = MFMA16(a, bq[ks][0], acc[mt][0]); acc[mt][1] = MFMA16(a, bq[ks][1], acc[mt][1]); }
    bf16x8 bc[8][2];
#pragma unroll
    for (int ks = 0; ks < 8; ++ks) { bq[ks][0] = *(const bf16x8*)(TT + (size_t)(wid * 32 + lr) * 256 + ks * 32 + lq * 8); bq[ks][1] = *(const bf16x8*)(TT + (size_t)(wid * 32 + 16 + lr) * 256 + ks * 32 + lq * 8);
        bc[ks][0] = *(const bf16x8*)(Cc + (size_t)(wid * 32 + lr) * 256 + ks * 32 + lq * 8); bc[ks][1] = *(const bf16x8*)(Cc + (size_t)(wid * 32 + 16 + lr) * 256 + ks * 32 + lq * 8); }
#pragma unroll
    for (int mt = 0; mt < 4; ++mt) if (mt < MT)
#pragma unroll
        for (int ct = 0; ct < 2; ++ct)
#pragma unroll
            for (int r = 0; r < 4; ++r) Xin[(mt * 16 + lq * 4 + r) * 260 + wid * 32 + ct * 16 + lr] = acc[mt][ct][r];
    __syncthreads();
    if (tid < 128) { const int d = tid >> 6, n = tid & 63;
        const int cre = d * 128 + n, cim = cre + 64;
        for (int i = 0; i < M; ++i) { const int c = d == 0 ? i : M - 1 - i;
            Xs[c * 264 + cre] = f2bf(xr); Xs[c * 264 + cim] = f2bf(xi);
            const float ur = Xin[c * 260 + cre], ui = Xin[c * 260 + cim];
            const float nr = a16.x * xr - a16.y * xi + ur, ni = a16.x * xi + a16.y * xr + ui; xr = nr; xi = ni; }
        if (bb < 16) { const size_t o = OUT_S5 + ((size_t)((bb * 2 + l) * 2 + d) * 2) * 2048 + g * 64 + n; p.out[o] = xr; p.out[o + 2048] = xi; }
    }
    __syncthreads();
#pragma unroll
    for (int a = 0; a < 4; ++a) { acc[a][0] = (f32x4){0.f, 0.f, 0.f, 0.f}; acc[a][1] = acc[a][0]; }
#pragma unroll
    for (int ks = 0; ks < 8; ++ks)
#pragma unroll
        for (int mt = 0; mt < 4; ++mt) if (mt < MT) { const bf16x8 a = LDSFRAG(Us + (mt * 16 + lr) * 264 + ks * 32 + lq * 8); acc[mt][0] = MFMA16(a, bq[ks][0], acc[mt][0]); acc[mt][1] = MFMA16(a, bq[ks][1], acc[mt][1]); }
#pragma unroll
    for (int ks = 0; ks < 8; ++ks)
#pragma unroll
        for (int mt = 0; mt < 4; ++mt) if (mt < MT) { const bf16x8 a = LDSFRAG(Xs + (mt * 16 + lr) * 264 + ks * 32 + lq * 8); acc[mt][0] = MFMA16(a, bc[ks][0], acc[mt][0]); acc[mt][1] = MFMA16(a, bc[ks][1], acc[mt][1]); }
    bf16_t* Yg = (bf16_t*)(p.ws + OFF_YG);
#pragma unroll
    for (int mt = 0; mt < 4; ++mt) if (mt < MT)
#pragma unroll
        for (int ct = 0; ct < 2; ++ct)
#pragma unroll
            for (int r = 0; r < 4; ++r) { const int chunk = mt * 16 + lq * 4 + r, t = wid * 2 + ct;
                Yg[(size_t)(tok0 + chunk * 16 + t) * 512 + g * 16 + lr] = f2bf(gelu_tanh(acc[mt][ct][r])); }
    __syncthreads();
}
__device__ __forceinline__ void job_mlaprep(const Params& p, int l, int j) {
    const int tid = tid_opaque(p), wid = tid >> 6, lane = tid & 63, row = j * 8 + wid;
    const bf16_t* z = (const bf16_t*)(p.ws + OFF_Z) + (size_t)row * LDZ;
    float q[6], kv[4]; float sq = 0.f, sk = 0.f;
#pragma unroll
    for (int i = 0; i < 6; ++i) { q[i] = bf2f(z[ZMQ + i * 64 + lane]); sq += q[i] * q[i]; }
#pragma unroll
    for (int i = 0; i < 4; ++i) { kv[i] = bf2f(z[ZMKV + i * 64 + lane]); sk += kv[i] * kv[i]; }
#pragma unroll
    for (int o = 1; o < 64; o <<= 1) { sq += __shfl_xor(sq, o); sk += __shfl_xor(sk, o); }
    const float rq = rsqrtf(sq * (1.f / 384.f) + 1e-6f), rk = rsqrtf(sk * (1.f / 256.f) + 1e-6f);
    bf16_t* aq = (bf16_t*)(p.ws + OFF_AQ) + (size_t)row * 384; bf16_t* ck = (bf16_t*)(p.ws + OFF_CKVN) + (size_t)row * 256;
#pragma unroll
    for (int i = 0; i < 6; ++i) aq[i * 64 + lane] = f2bf(q[i] * rq * p.in[I_QNORM][l * 384 + i * 64 + lane]);
    const bool prompt = row < 4096; const int b = row >> 8, t = row & 255;
#pragma unroll
    for (int i = 0; i < 4; ++i) { const float v = kv[i] * rk * p.in[I_KVNORM][l * 256 + i * 64 + lane]; ck[i * 64 + lane] = f2bf(v);
        if (prompt) p.out[OUT_CKV + ((size_t)((b * 2 + l) * 256 + t)) * 256 + i * 64 + lane] = v; }
    if (prompt && lane < 32) p.out[OUT_KR + ((size_t)((b * 2 + l) * 256 + t)) * 32 + lane] = bf2f(z[ZMKR + lane]);
}
__device__ __forceinline__ float logsigmoidf_(float x) { return fminf(x, 0.f) - __logf(1.f + __expf(-fabsf(x))); }
__device__ __forceinline__ void job_glaA(const Params& p, int l, int j, lds_t lds) {
    const int tid = tid_opaque(p), wid = tid >> 6, lane = tid & 63, lr = lane & 15, lq = lane >> 4;
    const int ck = j >> 2, h = j & 3, tok0 = ck * 64;
    LAS bf16_t* QDf = (LAS bf16_t*)lds; LAS bf16_t* QDb = QDf + 4608; LAS bf16_t* KDf = QDb + 4608; LAS bf16_t* KDb = KDf + 4608; LAS bf16_t* KRf = KDb + 4608; LAS bf16_t* KRb = KRf + 4608;
    LAS bf16_t* VT = KRb + 4608;
    LAS bf16_t* ATT = VT + 9216;
    LAS float* GA = (LAS float*)(ATT + 4608);
    LAS float* TOT = GA + 2048;
    const bf16_t* Z = (const bf16_t*)(p.ws + OFF_Z);
    const int d = tid & 63, cg_ = tid >> 6;
    bf16_t qraw[8], kraw[8]; float wf[16], wb[16];
#pragma unroll
    for (int i = 0; i < 8; ++i) { const size_t zr = (size_t)(tok0 + cg_ * 8 + i) * LDZ; qraw[i] = Z[zr + ZQ + h * 64 + d]; kraw[i] = Z[zr + ZK + h * 64 + d]; }
#pragma unroll
    for (int r = 0; r < 16; ++r) { wf[r] = p.in[I_WA2][((size_t)((l * 2 + 0) * 16 + r)) * 256 + h * 64 + d]; wb[r] = p.in[I_WA2][((size_t)((l * 2 + 1) * 16 + r)) * 256 + h * 64 + d]; }
    const float bf_ = p.in[I_BA][(l * 2 + 0) * 256 + h * 64 + d], bb_ = p.in[I_BA][(l * 2 + 1) * 256 + h * 64 + d];
    { const int c = tid >> 3, part = tid & 7; const u32x2 gv = *(const u32x2*)(Z + (size_t)(tok0 + c) * LDZ + ZGA + part * 4);
      GA[c * 32 + part * 4 + 0] = lo16(gv.x); GA[c * 32 + part * 4 + 1] = hi16(gv.x); GA[c * 32 + part * 4 + 2] = lo16(gv.y); GA[c * 32 + part * 4 + 3] = hi16(gv.y);
      const bf16_t* vp = Z + (size_t)(tok0 + c) * LDZ + ZV + h * 128 + part * 16;
      const u32x4 v0 = *(const u32x4*)vp, v1 = *(const u32x4*)(vp + 8);
      const unsigned w[8] = { v0.x, v0.y, v0.z, v0.w, v1.x, v1.y, v1.z, v1.w };
#pragma unroll
      for (int i = 0; i < 8; ++i) { VT[(part * 16 + 2 * i) * 72 + c] = (bf16_t)(w[i] & 0xffffu); VT[(part * 16 + 2 * i + 1) * 72 + c] = (bf16_t)(w[i] >> 16); } }
    __syncthreads();
    float laf[8], lab[8];
    {
#pragma unroll
      for (int i = 0; i < 8; ++i) { const int c = cg_ * 8 + i; float xf = bf_, xb = bb_;
#pragma unroll
          for (int r = 0; r < 16; ++r) { xf += GA[c * 32 + r] * wf[r]; xb += GA[c * 32 + 16 + r] * wb[r]; }
          laf[i] = logsigmoidf_(xf) * (1.f / 16.f); lab[i] = logsigmoidf_(xb) * (1.f / 16.f); } }
#pragma unroll
    for (int i = 1; i < 8; ++i) laf[i] += laf[i - 1];
#pragma unroll
    for (int i = 6; i >= 0; --i) lab[i] += lab[i + 1];
    TOT[(0 * 8 + cg_) * 64 + d] = laf[7]; TOT[(1 * 8 + cg_) * 64 + d] = lab[0];
    __syncthreads();
    float offf = 0.f, offb = 0.f, Tf = 0.f, Tb = 0.f;
#pragma unroll
    for (int g = 0; g < 8; ++g) { const float a = TOT[g * 64 + d], b = TOT[(8 + g) * 64 + d]; Tf += a; Tb += b; if (g < cg_) offf += a; if (g > cg_) offb += b; }
    bf16_t* QD = (bf16_t*)(p.ws + OFF_QD);
#pragma unroll
    for (int i = 0; i < 8; ++i) { const int c = cg_ * 8 + i;
        const float q = bf2f(qraw[i]) * 0.125f, k = bf2f(kraw[i]);
        const float bf_ = offf + laf[i], bb_ = offb + lab[i];
        const bf16_t qf = f2bf(q * __expf(bf_)), qb = f2bf(q * __expf(bb_));
        QDf[c * 72 + d] = qf; QDb[c * 72 + d] = qb;
        KDf[c * 72 + d] = f2bf(k * __expf(-bf_)); KDb[c * 72 + d] = f2bf(k * __expf(-bb_));
        KRf[d * 72 + c] = f2bf(k * __expf(Tf - bf_)); KRb[d * 72 + c] = f2bf(k * __expf(Tb - bb_));
        QD[(size_t)(tok0 + c) * 256 + h * 64 + d] = qf; QD[(size_t)(8192 + tok0 + c) * 256 + h * 64 + d] = qb; }
    if (cg_ == 0) { float* DEC = (float*)(p.ws + OFF_DEC); DEC[((0 * 128 + ck) * 4 + h) * 64 + d] = __expf(Tf); DEC[((1 * 128 + ck) * 4 + h) * 64 + d] = __expf(Tb); }
    __syncthreads();
#pragma unroll
    for (int q2 = 0; q2 < 2; ++q2) { const int tt = wid * 2 + q2, ti = tt >> 2, tj = tt & 3; f32x4 af = {0.f, 0.f, 0.f, 0.f}, ab = af;
#pragma unroll
        for (int ks = 0; ks < 2; ++ks) { const int ko = ks * 32 + lq * 8;
            af = MFMA16(LDSFRAG(QDf + (ti * 16 + lr) * 72 + ko), LDSFRAG(KDf + (tj * 16 + lr) * 72 + ko), af);
            ab = MFMA16(LDSFRAG(QDb + (ti * 16 + lr) * 72 + ko), LDSFRAG(KDb + (tj * 16 + lr) * 72 + ko), ab); }
#pragma unroll
        for (int r = 0; r < 4; ++r) { const int c = ti * 16 + lq * 4 + r, s = tj * 16 + lr; const float v = (s <= c ? af[r] : 0.f) + (s >= c ? ab[r] : 0.f); ATT[c * 72 + s] = f2bf(v); } }
    __syncthreads();
    bf16x8 vb[2];
#pragma unroll
    for (int ks = 0; ks < 2; ++ks) vb[ks] = LDSFRAG(VT + (wid * 16 + lr) * 72 + ks * 32 + lq * 8);
    bf16_t* OI = (bf16_t*)(p.ws + OFF_OIB); bf16_t* KV = (bf16_t*)(p.ws + OFF_KV);
#pragma unroll
    for (int ct = 0; ct < 4; ++ct) { f32x4 a = {0.f, 0.f, 0.f, 0.f};
#pragma unroll
        for (int ks = 0; ks < 2; ++ks) a = MFMA16(LDSFRAG(ATT + (ct * 16 + lr) * 72 + ks * 32 + lq * 8), vb[ks], a);
#pragma unroll
        for (int r = 0; r < 4; ++r) OI[(size_t)(tok0 + ct * 16 + lq * 4 + r) * 512 + h * 128 + wid * 16 + lr] = f2bf(a[r]); }
#pragma unroll
    for (int dir = 0; dir < 2; ++dir) { const LAS bf16_t* KR = dir == 0 ? KRf : KRb; bf16_t* kvp = KV + ((size_t)((dir * 128 + ck) * 4 + h)) * 8192;
#pragma unroll
        for (int dt = 0; dt < 4; ++dt) { f32x4 a = {0.f, 0.f, 0.f, 0.f};
#pragma unroll
            for (int ks = 0; ks < 2; ++ks) a = MFMA16(LDSFRAG(KR + (dt * 16 + lr) * 72 + ks * 32 + lq * 8), vb[ks], a);
#pragma unroll
            for (int r = 0; r < 4; ++r) kvp[(dt * 16 + lq * 4 + r) * 128 + wid * 16 + lr] = f2bf(a[r]); } }
    __syncthreads();
}

__device__ __forceinline__ void job_glaB(const Params& p, int l, int j) {
    const int qt = j & 3, h = (j >> 2) & 3, rest = j >> 4, bb = rest % 20, dir = rest / 20;
    const int idx0 = qt * 2048 + tid_opaque(p);
    const int nck = bb < 16 ? 4 : 16, ck0 = bb < 16 ? bb * 4 : 64 + (bb - 16) * 16;
    float S[4];
#pragma unroll
    for (int e = 0; e < 4; ++e) S[e] = bb >= 16 ? p.in[I_SGLA][((size_t)((((bb - 16) * 2 + l) * 2 + dir) * 4 + h)) * 8192 + idx0 + e * 512] : 0.f;
    const bf16_t* KV = (const bf16_t*)(p.ws + OFF_KV); const float* DEC = (const float*)(p.ws + OFF_DEC); bf16_t* ST = (bf16_t*)(p.ws + OFF_ST);
    for (int i0 = 0; i0 < nck; i0 += 4) { float dv[4][4]; bf16_t kv[4][4]; size_t its[4];
#pragma unroll
        for (int u = 0; u < 4; ++u) { const int i = i0 + u, ck = dir == 0 ? ck0 + i : ck0 + nck - 1 - i; its[u] = (size_t)((dir * 128 + ck) * 4 + h);
#pragma unroll
            for (int e = 0; e < 4; ++e) { const int idx = idx0 + e * 512; dv[u][e] = DEC[its[u] * 64 + (idx >> 7)]; kv[u][e] = KV[its[u] * 8192 + idx]; } }
#pragma unroll
        for (int u = 0; u < 4; ++u)
#pragma unroll
            for (int e = 0; e < 4; ++e) { ST[its[u] * 8192 + idx0 + e * 512] = f2bf(S[e]); S[e] = dv[u][e] * S[e] + bf2f(kv[u][e]); } }
    if (bb < 16) {
#pragma unroll
        for (int e = 0; e < 4; ++e) p.out[OUT_GLA + ((size_t)(((bb * 2 + l) * 2 + dir) * 4 + h)) * 8192 + idx0 + e * 512] = S[e]; }
}

__device__ __forceinline__ void job_glaC(const Params& p, int l, int j, lds_t lds) {
    const int tid = tid_opaque(p), wid = tid >> 6, lane = tid & 63, lr = lane & 15, lq = lane >> 4;
    const int ck = j >> 2, h = j & 3, tok0 = ck * 64;
    LAS bf16_t* Aq = (LAS bf16_t*)lds;
    LAS bf16_t* BT = Aq + 64 * 136;
    LAS float* Os = (LAS float*)(BT + 128 * 136);
    const bf16_t* QD = (const bf16_t*)(p.ws + OFF_QD); const bf16_t* ST = (const bf16_t*)(p.ws + OFF_ST);
#pragma unroll
    for (int it = 0; it < 2; ++it) { const int idx = tid + it * 512, c = idx >> 4, rem = idx & 15, dir = rem >> 3, dc = rem & 7;
        *(LAS u32x4*)(Aq + c * 136 + dir * 64 + dc * 8) = *(const u32x4*)(QD + (size_t)(dir * 8192 + tok0 + c) * 256 + h * 64 + dc * 8); }
#pragma unroll
    for (int it = 0; it < 4; ++it) { const int idx = tid + it * 512, dir = idx >> 10, d = (idx >> 4) & 63, ec = idx & 15;
        const u32x4 v = *(const u32x4*)(ST + ((size_t)((dir * 128 + ck) * 4 + h)) * 8192 + d * 128 + ec * 8);
        const unsigned w[4] = { v.x, v.y, v.z, v.w };
#pragma unroll
        for (int i = 0; i < 4; ++i) { BT[(ec * 8 + 2 * i) * 136 + dir * 64 + d] = (bf16_t)(w[i] & 0xffffu); BT[(ec * 8 + 2 * i + 1) * 136 + dir * 64 + d] = (bf16_t)(w[i] >> 16); } }
    const int ct = wid & 3, eh = wid >> 2; const bf16_t* OI = (const bf16_t*)(p.ws + OFF_OIB);
    bf16_t oi[4][4];
#pragma unroll
    for (int e4 = 0; e4 < 4; ++e4)
#pragma unroll
        for (int r = 0; r < 4; ++r) oi[e4][r] = OI[(size_t)(tok0 + ct * 16 + lq * 4 + r) * 512 + h * 128 + (eh * 4 + e4) * 16 + lr];
    const int nc = tid >> 3, npart = tid & 7;
    const bf16_t* gz = (const bf16_t*)(p.ws + OFF_Z) + (size_t)(tok0 + nc) * LDZ + ZGG + h * 128 + npart * 16;
    const u32x4 g0 = *(const u32x4*)gz, g1 = *(const u32x4*)(gz + 8);
    f32x4 onw[4];
#pragma unroll
    for (int i = 0; i < 4; ++i) onw[i] = *(const f32x4*)(p.in[I_ONORM] + l * 128 + npart * 16 + 4 * i);
    __syncthreads();
    bf16x8 af[4];
#pragma unroll
    for (int ks = 0; ks < 4; ++ks) af[ks] = LDSFRAG(Aq + (ct * 16 + lr) * 136 + ks * 32 + lq * 8);
#pragma unroll
    for (int e4 = 0; e4 < 4; ++e4) { const int et = eh * 4 + e4; f32x4 a = {0.f, 0.f, 0.f, 0.f};
#pragma unroll
        for (int ks = 0; ks < 4; ++ks) a = MFMA16(af[ks], LDSFRAG(BT + (et * 16 + lr) * 136 + ks * 32 + lq * 8), a);
#pragma unroll
        for (int r = 0; r < 4; ++r) { const int row = ct * 16 + lq * 4 + r, col = et * 16 + lr; Os[row * 132 + col] = a[r] + bf2f(oi[e4][r]); } }
    __syncthreads();
    { const int c = tid >> 3, part = tid & 7; float o[16]; float ss = 0.f;
#pragma unroll
      for (int i = 0; i < 16; ++i) { o[i] = Os[c * 132 + part * 16 + i]; ss += o[i] * o[i]; }
      ss += __shfl_xor(ss, 1); ss += __shfl_xor(ss, 2); ss += __shfl_xor(ss, 4);
      const float rstd = rsqrtf(ss * (1.f / 128.f) + 1e-6f);
      const unsigned gw[8] = { g0.x, g0.y, g0.z, g0.w, g1.x, g1.y, g1.z, g1.w };
      unsigned ow[8];
#pragma unroll
      for (int i = 0; i < 8; ++i) { const float n0 = onw[i >> 1][(2 * i) & 3], n1 = onw[i >> 1][(2 * i + 1) & 3];
          ow[i] = pk2(o[2 * i] * rstd * n0 * siluf_(lo16(gw[i])), o[2 * i + 1] * rstd * n1 * siluf_(hi16(gw[i]))); }
      bf16_t* ap = (bf16_t*)(p.ws + OFF_AGLA) + (size_t)(tok0 + c) * 512 + h * 128 + part * 16;
      *(u32x4*)ap = (u32x4){ow[0], ow[1], ow[2], ow[3]}; *(u32x4*)(ap + 8) = (u32x4){ow[4], ow[5], ow[6], ow[7]}; }
    __syncthreads();
}
__device__ __forceinline__ void head_row_finish(float (&x)[16], int p8, const float* nw, const float* nw2, bool rope, int pos, const float* R, float mul, LAS bf16_t* dst) {
    float ss = 0.f; const int cnt = p8 < 4 ? 16 : 8;
#pragma unroll
    for (int i = 0; i < 16; ++i) if (i < cnt) ss += x[i] * x[i];
    ss += __shfl_xor(ss, 1); ss += __shfl_xor(ss, 2); ss += __shfl_xor(ss, 4);
    const float rstd = rsqrtf(ss * (1.f / 96.f) + 1e-6f) * mul;
    if (p8 < 4) { unsigned w[8];
#pragma unroll
        for (int i = 0; i < 8; ++i) w[i] = pk2(x[2 * i] * rstd * nw[p8 * 16 + 2 * i] * nw2[p8 * 16 + 2 * i], x[2 * i + 1] * rstd * nw[p8 * 16 + 2 * i + 1] * nw2[p8 * 16 + 2 * i + 1]);
        *(LAS u32x4*)(dst + p8 * 16) = (u32x4){w[0], w[1], w[2], w[3]}; *(LAS u32x4*)(dst + p8 * 16 + 8) = (u32x4){w[4], w[5], w[6], w[7]};
    } else { const int i0 = (p8 - 4) * 4; float o1[4], o2[4];
#pragma unroll
        for (int i = 0; i < 4; ++i) { const float a = x[i] * rstd * nw[64 + i0 + i], b = x[4 + i] * rstd * nw[80 + i0 + i];
            if (rope) { const float c = R[pos * 16 + i0 + i], s = R[16384 + pos * 16 + i0 + i]; o1[i] = a * c - b * s; o2[i] = a * s + b * c; } else { o1[i] = a; o2[i] = b; } }
        *(LAS u32x2*)(dst + 64 + i0) = (u32x2){pk2(o1[0], o1[1]), pk2(o1[2], o1[3])}; *(LAS u32x2*)(dst + 80 + i0) = (u32x2){pk2(o2[0], o2[1]), pk2(o2[2], o2[3])}; }
}
__device__ __forceinline__ void ld16bf(const bf16_t* s, float (&x)[16]) { const u32x4 a = *(const u32x4*)s, b = *(const u32x4*)(s + 8);
    x[0] = lo16(a.x); x[1] = hi16(a.x); x[2] = lo16(a.y); x[3] = hi16(a.y); x[4] = lo16(a.z); x[5] = hi16(a.z); x[6] = lo16(a.w); x[7] = hi16(a.w);
    x[8] = lo16(b.x); x[9] = hi16(b.x); x[10] = lo16(b.y); x[11] = hi16(b.y); x[12] = lo16(b.z); x[13] = hi16(b.z); x[14] = lo16(b.w); x[15] = hi16(b.w); }
__device__ __forceinline__ void ld4bf(const bf16_t* s, float* x) { const u32x2 a = *(const u32x2*)s; x[0] = lo16(a.x); x[1] = hi16(a.x); x[2] = lo16(a.y); x[3] = hi16(a.y); }
__device__ __forceinline__ void job_attn(const Params& p, int l, int j, lds_t lds) {
    const int tid = tid_opaque(p), wid = tid >> 6, lane = tid & 63, lr = lane & 15, lq = lane >> 4;
    const bool smp = j < 128; int b, h, qb; if (smp) { b = j >> 5; h = (j >> 3) & 3; qb = j & 7; } else { const int jj = j - 128; b = jj >> 3; h = (jj >> 1) & 3; qb = jj & 1; }
    const int qtok0 = smp ? 4096 + b * 1024 + qb * 128 : b * 256 + qb * 128; const int nkt = smp ? 12 : 2;
    LAS bf16_t* Ks0 = (LAS bf16_t*)lds;
    LAS bf16_t* VTs0 = Ks0 + 2 * 128 * 104;
    LAS float* Mg = (LAS float*)lds;
    const bf16_t* Z = (const bf16_t*)(p.ws + OFF_Z); const bf16_t* KF = (const bf16_t*)(p.ws + OFF_KF); const bf16_t* Vb = (const bf16_t*)(p.ws + OFF_V); const float* R = (const float*)(p.ws + OFF_ROPE);
    const float* qhn = p.in[I_QHNORM] + l * 96;
    u32x4 kreg[3], vreg[4];
    const int vst = smp ? 1536 : 256; const bf16_t* vtb = smp ? Vb + 2097152 + (size_t)(b * 4 + h) * 128 * 1536 : Vb + (size_t)(b * 4 + h) * 128 * 256;
    auto rowbase = [&](int kt) { return smp ? (kt < 4 ? 8192 + b * 512 + kt * 128 : 4096 + b * 1024 + (kt - 4) * 128) : b * 256 + kt * 128; };
    auto issue = [&](int kt) { const int rb = rowbase(kt);
#pragma unroll
        for (int i = 0; i < 3; ++i) { const int idx = tid + 512 * i, key = idx / 12, part = idx - key * 12; kreg[i] = *(const u32x4*)(KF + (size_t)(rb + key) * 384 + h * 96 + part * 8); }
#pragma unroll
        for (int i = 0; i < 4; ++i) { const int idx = tid + 512 * i, e = idx >> 4, part = idx & 15; vreg[i] = *(const u32x4*)(vtb + (size_t)e * vst + kt * 128 + part * 8); } };
    auto commit = [&](int buf) { LAS bf16_t* Ks = Ks0 + buf * 128 * 104; LAS bf16_t* VTs = VTs0 + buf * 128 * 136;
#pragma unroll
        for (int i = 0; i < 3; ++i) { const int idx = tid + 512 * i, key = idx / 12, part = idx - key * 12; *(LAS u32x4*)(Ks + key * 104 + part * 8) = kreg[i]; }
#pragma unroll
        for (int i = 0; i < 4; ++i) { const int idx = tid + 512 * i, e = idx >> 4, part = idx & 15; *(LAS u32x4*)(VTs + e * 136 + part * 8) = vreg[i]; } };
    issue(0);
#pragma unroll
    for (int it = 0; it < 2; ++it) { const int row = it * 64 + (tid >> 3), p8 = tid & 7, tok = qtok0 + row; const bf16_t* qr = (const bf16_t*)(p.ws + OFF_QRAW) + (size_t)tok * 384 + h * 96; float x[16];
      if (p8 < 4) ld16bf(qr + p8 * 16, x); else { ld4bf(qr + 64 + (p8 - 4) * 4, x); ld4bf(qr + 80 + (p8 - 4) * 4, x + 4); }
      head_row_finish(x, p8, qhn, p.in[I_KHNORM] + l * 96, smp, qb * 128 + row, R, 0.10206207261596575f * 1.4426950408889634f, Ks0 + 128 * 104 + row * 104); }
    __syncthreads();
    const int rt = wid & 3, kh = wid >> 2;
    bf16x8 qa[2][3];
#pragma unroll
    for (int mt = 0; mt < 2; ++mt)
#pragma unroll
        for (int ks = 0; ks < 3; ++ks) qa[mt][ks] = LDSFRAG(Ks0 + 128 * 104 + (rt * 32 + mt * 16 + lr) * 104 + ks * 32 + lq * 8);
    commit(0);
    __syncthreads();
    f32x4 oacc[2][8]; float mrow[2], lrow[2];
#pragma unroll
    for (int mt = 0; mt < 2; ++mt) {
#pragma unroll
        for (int e = 0; e < 8; ++e) oacc[mt][e] = (f32x4){0.f, 0.f, 0.f, 0.f};
        mrow[mt] = -1e30f; lrow[mt] = 0.f; }
    const int kbase = kh * 64;
    for (int kt = 0; kt < nkt; ++kt) {
        if (kt + 1 < nkt) issue(kt + 1);
        const LAS bf16_t* Ks = Ks0 + (kt & 1) * 128 * 104; const LAS bf16_t* VTs = VTs0 + (kt & 1) * 128 * 136;
        f32x4 sacc[2][4];
#pragma unroll
        for (int nt = 0; nt < 4; ++nt) { sacc[0][nt] = (f32x4){0.f, 0.f, 0.f, 0.f}; sacc[1][nt] = sacc[0][nt];
#pragma unroll
            for (int ks = 0; ks < 3; ++ks) { const bf16x8 kf = LDSFRAG(Ks + (kbase + nt * 16 + lr) * 104 + ks * 32 + lq * 8); sacc[0][nt] = MFMA16(kf, qa[0][ks], sacc[0][nt]); sacc[1][nt] = MFMA16(kf, qa[1][ks], sacc[1][nt]); } }
        bf16x8 pb[2][2];
#pragma unroll
        for (int mt = 0; mt < 2; ++mt) {
            float mx = -1e30f;
#pragma unroll
            for (int nt = 0; nt < 4; ++nt) mx = fmaxf(mx, fmaxf(fmaxf(sacc[mt][nt][0], sacc[mt][nt][1]), fmaxf(sacc[mt][nt][2], sacc[mt][nt][3])));
            mx = fmaxf(mx, __shfl_xor(mx, 16)); mx = fmaxf(mx, __shfl_xor(mx, 32));
            const float mn = fmaxf(mrow[mt], mx), alpha = __builtin_amdgcn_exp2f(mrow[mt] - mn); mrow[mt] = mn;
            float pv[4][4]; float rs = 0.f;
#pragma unroll
            for (int nt = 0; nt < 4; ++nt)
#pragma unroll
                for (int r = 0; r < 4; ++r) { pv[nt][r] = __builtin_amdgcn_exp2f(sacc[mt][nt][r] - mn); rs += pv[nt][r]; }
            lrow[mt] = lrow[mt] * alpha + rs;
#pragma unroll
            for (int k2 = 0; k2 < 2; ++k2) { u32x4 w; w.x = pk2(pv[2 * k2][0], pv[2 * k2][1]); w.y = pk2(pv[2 * k2][2], pv[2 * k2][3]); w.z = pk2(pv[2 * k2 + 1][0], pv[2 * k2 + 1][1]); w.w = pk2(pv[2 * k2 + 1][2], pv[2 * k2 + 1][3]);
                pb[mt][k2] = __builtin_bit_cast(bf16x8, w); }
#pragma unroll
            for (int e = 0; e < 8; ++e) oacc[mt][e] *= alpha; }
#pragma unroll
        for (int k2 = 0; k2 < 2; ++k2)
#pragma unroll
            for (int e = 0; e < 8; ++e) { const LAS bf16_t* vp = VTs + (e * 16 + lr) * 136 + kbase + k2 * 32 + 4 * lq;
                const u32x2 lo = *(const LAS u32x2*)vp, hi = *(const LAS u32x2*)(vp + 16);
                const bf16x8 vf = __builtin_bit_cast(bf16x8, (u32x4){lo.x, lo.y, hi.x, hi.y});
                oacc[0][e] = MFMA16(vf, pb[0][k2], oacc[0][e]); oacc[1][e] = MFMA16(vf, pb[1][k2], oacc[1][e]); }
        if (kt + 1 < nkt) commit((kt + 1) & 1);
        __syncthreads();
    }
#pragma unroll
    for (int mt = 0; mt < 2; ++mt) { float s_ = lrow[mt]; s_ += __shfl_xor(s_, 16); s_ += __shfl_xor(s_, 32); lrow[mt] = s_; }
    LAS float* Mo = Mg + rt * 32 * 132; LAS float* Ml = Mg + 4 * 32 * 132 + rt * 64;
    if (kh == 1) {
#pragma unroll
        for (int mt = 0; mt < 2; ++mt) {
#pragma unroll
            for (int e = 0; e < 8; ++e) *(LAS f32x4*)(Mo + (mt * 16 + lr) * 132 + e * 16 + 4 * lq) = oacc[mt][e];
            if (lq == 0) { Ml[(mt * 16 + lr) * 2] = mrow[mt]; Ml[(mt * 16 + lr) * 2 + 1] = lrow[mt]; } }
    }
    __syncthreads();
    if (kh == 0) { bf16_t* AM = (bf16_t*)(p.ws + OFF_AMLA);
#pragma unroll
        for (int mt = 0; mt < 2; ++mt) { const int row = mt * 16 + lr, tok = qtok0 + rt * 32 + row;
            u32x2 gt[8];
#pragma unroll
            for (int e = 0; e < 8; ++e) gt[e] = *(const u32x2*)(Z + (size_t)tok * LDZ + ZMG + h * 128 + e * 16 + 4 * lq);
            const float m2 = Ml[row * 2], l2 = Ml[row * 2 + 1]; const float mm = fmaxf(mrow[mt], m2), a1 = __builtin_amdgcn_exp2f(mrow[mt] - mm), a2 = __builtin_amdgcn_exp2f(m2 - mm);
            const float inv = 1.f / (lrow[mt] * a1 + l2 * a2);
#pragma unroll
            for (int e = 0; e < 8; ++e) { const f32x4 o2 = *(const LAS f32x4*)(Mo + row * 132 + e * 16 + 4 * lq); float o[4];
#pragma unroll
                for (int r = 0; r < 4; ++r) o[r] = (oacc[mt][e][r] * a1 + o2[r] * a2) * inv;
                const float g0 = lo16(gt[e].x), g1 = hi16(gt[e].x), g2 = lo16(gt[e].y), g3 = hi16(gt[e].y);
                *(u32x2*)(AM + (size_t)tok * 512 + h * 128 + e * 16 + 4 * lq) = (u32x2){pk2(o[0] * siluf_(g0), o[1] * siluf_(g1)), pk2(o[2] * siluf_(g2), o[3] * siluf_(g3))}; } } }
    __syncthreads();
}


#define XB_TMO      128
#define XB_XCNT(j)  (256  + 64 * (j))
#define XB_XSUB(j)  (1280 + 64 * (j))
#define XB_XGEN(j)  (2304 + 64 * (j))
#define XB_TOP      3328
#define XB_TOPGEN   3392
#define XCD_BAR_WORDS 3456
#define XB_SPIN_CAP (1u << 18)

__device__ __forceinline__ unsigned xb_ld(unsigned* p)              { return __hip_atomic_load(p, __ATOMIC_RELAXED, __HIP_MEMORY_SCOPE_AGENT); }
__device__ __forceinline__ unsigned xb_add(unsigned* p, unsigned v) { return __hip_atomic_fetch_add(p, v, __ATOMIC_RELAXED, __HIP_MEMORY_SCOPE_AGENT); }
__device__ __forceinline__ unsigned xb_xcc_id() { return (unsigned)__builtin_amdgcn_s_getreg((3 << 11) | 20) & 0xFu; }
#define XB_SPIN(cond, bar) do { unsigned _sp = 0; while (cond) { __builtin_amdgcn_s_sleep(1); \
    if ((++_sp & 255u) == 0u) { if (xb_ld(&(bar)[XB_TMO])) break; if (_sp > XB_SPIN_CAP) { atomicAdd(&(bar)[XB_TMO], 1u); break; } } } } while (0)

struct XcdBarrier {
    int wid; unsigned* bar; unsigned x;
    volatile LAS unsigned* st;
};

__device__ __forceinline__ XcdBarrier xcd_barrier_post(unsigned* bar, volatile LAS unsigned* st) {
    XcdBarrier b; b.bar = bar; b.x = xb_xcc_id(); b.st = st;
    if (threadIdx.x == 0) (void)xb_add(&bar[XB_XCNT(b.x)], 1u);
    return b;
}
__device__ __forceinline__ void xcd_barrier_complete(unsigned* bar, unsigned x, unsigned& nloc, unsigned& nx) {
    const unsigned G = gridDim.x * gridDim.y * gridDim.z;
    unsigned sum, cnt, mine, sp = 0u;
    for (;;) {
        sum = 0u; cnt = 0u; mine = 0u;
#pragma unroll
        for (unsigned j = 0; j < 16; ++j) { const unsigned c = xb_ld(&bar[XB_XCNT(j)]); sum += c; cnt += (c > 0u) ? 1u : 0u; mine = (j == x) ? c : mine; }
        if (sum == G) break;
        __builtin_amdgcn_s_sleep(1);
        if ((++sp & 255u) == 0u) { if (xb_ld(&bar[XB_TMO])) break; if (sp > XB_SPIN_CAP) { atomicAdd(&bar[XB_TMO], 1u); break; } }
    }
    nloc = mine > 0u ? mine : 1u; nx = cnt > 0u ? cnt : 1u;
}

__device__ __forceinline__ void xcd_barrier(const XcdBarrier& b) {
    asm volatile("s_waitcnt vmcnt(0)" ::: "memory");
    __syncthreads();
    if (b.wid == 0 && lane_id_() == 0) {
        unsigned* bar = b.bar;
        __builtin_amdgcn_s_waitcnt(0);
        unsigned nloc = b.st[0], nx = b.st[1];
        if (nloc == 0u) { xcd_barrier_complete(bar, b.x, nloc, nx); b.st[0] = nloc; b.st[1] = nx; }
        const unsigned old = xb_add(&bar[XB_XSUB(b.x)], 1u);
        const unsigned gen = old / nloc;
        if (old + 1u == (gen + 1u) * nloc) {
            __builtin_amdgcn_fence(__ATOMIC_RELEASE, "agent");
            asm volatile("s_waitcnt vmcnt(0)" ::: "memory");
            const unsigned og = xb_add(&bar[XB_TOP], 1u);
            const unsigned tg = og / nx;
            if (og + 1u == (tg + 1u) * nx) xb_add(&bar[XB_TOPGEN], 1u);
            else XB_SPIN(xb_ld(&bar[XB_TOPGEN]) == tg, bar);
            __builtin_amdgcn_fence(__ATOMIC_ACQUIRE, "agent");
            xb_add(&bar[XB_XGEN(b.x)], 1u);
            asm volatile("s_waitcnt vmcnt(0)" ::: "memory");
        } else {
            XB_SPIN(xb_ld(&bar[XB_XGEN(b.x)]) == gen, bar);
            __builtin_amdgcn_fence(__ATOMIC_ACQUIRE, "agent");
            asm volatile("s_waitcnt vmcnt(0)" ::: "memory");
        }
    }
    __syncthreads();
}

constexpr int N_PHASES = 15;
#ifndef S3SEL
#define S3SEL 15
#endif
#ifndef REPEAT_MASK
#define REPEAT_MASK 0xff
#endif
#ifndef ONLY_S
#define ONLY_S -1
#endif
__device__ __forceinline__ void run_phase(const Params& p, int ph, lds_t lds, int mask = 0xff) {
    const int G = (int)gridDim.x, bid = (int)blockIdx.x;
    if (ph == 0 && (ONLY_S < 0 || ONLY_S == 7)) {
        for (int j = bid; j < 384 + 192 + 256 + 32; j += G) { if (j < 384) job_s5setup(p, 0, j, lds); else if (j < 576) job_ada(p, j - 384, lds); else if (j < 832) job_ctx(p, j - 576); else job_rope(p, j - 832); }
        return;
    }
    const int l = (ph - 1) / 7, s = (ph - 1) % 7;
    unsigned char* ws = p.ws;
    if (s == 0 && (ONLY_S < 0 || ONLY_S == 0)) {
        if (l == 0 || G < 256) { for (int j = bid; j < 384 + WT_TOTAL + 1024; j += G) { if (j < 384) { if ((mask & 1) && l > 0) job_s5setup(p, l, j, lds); } else if (j < 384 + WT_TOTAL) { if (mask & 2) job_wt(p, l, j - 384, lds); } else if (mask & 4) job_prep(p, l, j - 384 - WT_TOTAL); } }
        else { for (int j = bid; j < WT_WOUT + 1024; j += G) { if (j < WT_WOUT) job_wt(p, l, WT_EARLY + 3 * WT_WBO + j, lds); else job_prep(p, l, j - WT_WOUT); } }
    } else if (s == 1 && (ONLY_S < 0 || ONLY_S == 1)) {
        Order S; S.setup(8192, 4096, 0, p.wid); pg8::Gemm g{(const bf16_t*)(ws + OFF_HB), (const bf16_t*)(ws + OFF_WIN), 8192, 4096, 1024}; EpiZ E{(bf16_t*)(ws + OFF_Z)};
        pg8::gemm_phase<EpiZ, Order>(lds, g, S, E, nullptr);
    } else if (s == 2 && (ONLY_S < 0 || ONLY_S == 2)) {
        if (G == 256) {
            if (mask & 1) for (int k = bid >> 3; k < 80; k += 32) { const int q = k >> 2, bb = q < 4 ? 16 + q : q - 4; job_s5(p, l, bb * 32 + 4 * (bid & 7) + (k & 3), lds); }
            if (mask & 2) { job_glaA(p, l, bid, lds); job_glaA(p, l, 256 + bid, lds); }
            if ((mask & 4) && bid >= 128) for (int j = bid - 128; j < 1024; j += 128) job_mlaprep(p, l, j);
        } else for (int j = bid; j < 640 + 512 + 1024; j += G) { if (j < 640) { if (mask & 1) job_s5(p, l, j < 128 ? 512 + j : j - 128, lds); } else if (j < 1152) { if (mask & 2) job_glaA(p, l, j - 640, lds); } else if (mask & 4) job_mlaprep(p, l, j - 1152); }
    } else if (s == 3 && (ONLY_S < 0 || ONLY_S == 3)) {
        if (mask & 1) { if (G == 256) { if (bid < 96) for (int j = bid; j < 640; j += 96) job_glaB(p, l, j); } else for (int j = bid; j < 640; j += G) job_glaB(p, l, j); }
        if (mask & 16) { Order S; S.setup(8192, 2816, 0, p.wid); pg8::Gemm g{(const bf16_t*)(ws + OFF_HB), (const bf16_t*)(ws + OFF_WIN) + (size_t)4096 * 1024, 8192, 2816, 1024}; EpiZ E{(bf16_t*)(ws + OFF_Z) + 4096};
          pg8::gemm_phase<EpiZ, Order>(lds, g, S, E, nullptr); }
        if ((mask & 2) && (S3SEL & 2)) { Order S; S.setup(8192, 1024, 160, p.wid); pg8::Gemm g{(const bf16_t*)(ws + OFF_YG), (const bf16_t*)(ws + OFF_WGLU), 8192, 1024, 512}; EpiGLU E{(bf16_t*)(ws + OFF_AS5), (const bf16_t*)(ws + OFF_Z), p.in[I_BGLU] + l * 1024};
          pg8::gemm_phase<EpiGLU, Order>(lds, g, S, E, nullptr); }
        if ((mask & 4) && (S3SEL & 4)) { Order S; S.setup(10240, 768, 120, p.wid); pg8::Gemm g{(const bf16_t*)(ws + (l == 0 ? OFF_CTX0 : OFF_CKVN)), (const bf16_t*)(ws + OFF_WKV), 10240, 768, 256}; EpiKV E{(bf16_t*)(ws + OFF_KF), (bf16_t*)(ws + OFF_V), l, (const bf16_t*)(ws + OFF_Z), p.in[I_CKR], p.in[I_KHNORM] + l * 96, (const float*)(ws + OFF_ROPE)};
          pg8::gemm_phase<EpiKV, Order>(lds, g, S, E, nullptr); }
        if ((mask & 8) && (S3SEL & 8)) { Order S; S.setup(8192, 512, 160, p.wid); if (G == 256) S.c = (bid >= 96 && bid < 136) ? bid - 96 : (bid >= 224 && bid < 248) ? bid - 184 : (1 << 20); pg8::Gemm g{(const bf16_t*)(ws + OFF_AQ), (const bf16_t*)(ws + OFF_WUQ), 8192, 512, 384}; EpiQ E{(bf16_t*)(ws + OFF_QRAW)};
          pg8::gemm_phase<EpiQ, Order>(lds, g, S, E, nullptr); }
    } else if (s == 4 && (ONLY_S < 0 || ONLY_S == 4)) {
        if (G == 256) {
            if (bid < 128) { const int slot = bid >> 3, pair = 2 * (bid & 7) + (slot >> 3);
                if (mask & 1) job_attn(p, l, pair * 8 + (slot & 7), lds); }
            else { const int k = bid - 128; if (mask & 1) job_attn(p, l, 128 + k, lds); if (mask & 2) { job_glaC(p, l, k, lds); job_glaC(p, l, 128 + k, lds); job_glaC(p, l, 256 + k, lds); job_glaC(p, l, 384 + k, lds); } }
        } else for (int j = bid; j < 256 + 512; j += G) { if (j < 256) { if (mask & 1) job_attn(p, l, j, lds); } else if (mask & 2) job_glaC(p, l, j - 256, lds); }
    } else if (s == 5 && (ONLY_S < 0 || ONLY_S == 5)) {
        if (l == 0 && mask == 0xff && G >= 256 && bid >= 128) { for (int j = bid - 128; j < 384 + WT_EARLY; j += G - 128) { if (j < 384) job_s5setup(p, 1, j, lds); else job_wt(p, 1, j - 384, lds); } }
        for (int br = 0; br < 3; ++br) { Order S; S.setup(8192, 1024, 0, p.wid);
            pg8::Gemm g{(const bf16_t*)(ws + (br == 0 ? OFF_AGLA : br == 1 ? OFF_AMLA : OFF_AS5)), (const bf16_t*)(ws + OFF_WBO) + (size_t)br * 1024 * 512, 8192, 1024, 512};
            EpiBo E{(bf16_t*)(ws + OFF_HB), (const bf16_t*)(ws + OFF_Z), br};
            pg8::gemm_phase<EpiBo, Order>(lds, g, S, E, nullptr); }
    } else if (s == 6 && (ONLY_S < 0 || ONLY_S == 6)) {
        if (l == 0 && mask == 0xff && G >= 256 && bid >= 128) { for (int j = bid - 128; j < 3 * WT_WBO; j += G - 128) job_wt(p, 1, WT_EARLY + j, lds); }
        Order S; S.setup(8192, 1024, 0, p.wid); pg8::Gemm g{(const bf16_t*)(ws + OFF_HB), (const bf16_t*)(ws + OFF_WOUT), 8192, 1024, 1024};
        EpiOut E{p.out, l == 0 ? p.in[I_XP] : p.out, l == 0 ? p.in[I_XS] : p.out + (size_t)4096 * 1024, (const float*)(ws + OFF_ADA) + l * 5 * 3072};
        pg8::gemm_phase<EpiOut, Order>(lds, g, S, E, nullptr);
    }
}
__global__ __launch_bounds__(512, 2) void mega(KParams kp, int ph0, int ph1) {
    extern __shared__ __attribute__((aligned(16))) unsigned char shm[];
    lds_t lds = (lds_t)shm;
    if (threadIdx.x < N_IN) ((const float**)(kp.ws + OFF_TBL))[threadIdx.x] = kp.in[threadIdx.x];
    const int wid0 = __builtin_amdgcn_readfirstlane((int)threadIdx.x >> 6);
    volatile LAS unsigned* xst = (volatile LAS unsigned*)(lds + DYN_LDS - 16);
    if (threadIdx.x == 0) { xst[0] = 0u; xst[1] = 0u; }
    __threadfence(); __syncthreads();
    XcdBarrier xb = xcd_barrier_post((unsigned*)(kp.ws + OFF_BAR), xst);
    xb.wid = wid0;
    if (ph0 > ph1) cg::this_grid().sync();
    for (int ph = ph0; ph < ph1; ++ph) {
        Params p; p.wid = wid0; { const float* const* tb = (const float* const*)(kp.ws + OFF_TBL); float* o = kp.out; unsigned char* w = kp.ws; asm volatile("" : "+s"(tb), "+s"(o), "+s"(w)); p.in = tb; p.out = o; p.ws = w; }
        int nrep = 1;
#ifdef REPEAT_S
        if ((REPEAT_S == 7 && ph == 0) || (ph > 0 && (ph - 1) % 7 == REPEAT_S && (REPEAT_S != 6 || ph < 8))) nrep = 2;
#endif
        for (int rep = 0; rep < nrep; ++rep) { if (rep) xcd_barrier(xb); run_phase(p, ph, lds, rep ? REPEAT_MASK : 0xff); }
        if (ph + 1 < ph1) xcd_barrier(xb);
    }
}

#ifndef N_LAUNCH_MODE
#define N_LAUNCH_MODE 1
#endif
extern "C" void kernel_launch(void* const* d_in, const int* in_sizes, int n_in, void* d_out, int out_size, void* d_ws, size_t ws_size, hipStream_t stream) {
    static int grid = 0;
    if (grid == 0) {
        if (n_in != N_IN || ws_size < WS_END) { fprintf(stderr, "kernel_launch: unexpected n_in %d / ws %zu (need %zu)\n", n_in, ws_size, (size_t)WS_END); grid = -1; return; }
        int dev = 0, cus = 0, per_cu = 0;
        hipGetDevice(&dev); hipDeviceGetAttribute(&cus, hipDeviceAttributeMultiprocessorCount, dev);
        hipFuncSetAttribute((const void*)mega, hipFuncAttributeMaxDynamicSharedMemorySize, DYN_LDS);
        hipOccupancyMaxActiveBlocksPerMultiprocessor(&per_cu, (const void*)mega, 512, DYN_LDS);
        if (per_cu < 1) { fprintf(stderr, "kernel_launch: occupancy query says %d blocks per CU\n", per_cu); per_cu = 1; }
        (void)hipGetLastError();
        grid = cus;
    }
    if (grid < 0) return;
    hipMemsetAsync((char*)d_ws + OFF_BAR, 0, 16384, stream);
    KParams p{};
    for (int i = 0; i < N_IN; ++i) p.in[i] = (const float*)d_in[i];
    p.out = (float*)d_out; p.ws = (unsigned char*)d_ws;
#if N_LAUNCH_MODE == 0
    for (int ph = 0; ph < N_PHASES; ++ph) { hipLaunchKernelGGL(mega, dim3(grid), dim3(512), DYN_LDS, stream, p, ph, ph + 1); }
#else
    int ph0 = 0, ph1 = N_PHASES; void* args[] = {&p, &ph0, &ph1};
    hipError_t e = hipLaunchCooperativeKernel((const void*)mega, dim3(grid), dim3(512), args, DYN_LDS, stream);
    if (e != hipSuccess) fprintf(stderr, "cooperative launch failed: %s (grid %d)\n", hipGetErrorString(e), grid);
#endif
}
```

```cpp
#include <hip/hip_runtime.h>
#include <hip/hip_cooperative_groups.h>
#include <cstdio>
namespace cg = cooperative_groups;
namespace pg8 {
#define PG8_LAS __attribute__((address_space(3)))
typedef unsigned short bf16_t;
typedef short bf16x8 __attribute__((ext_vector_type(8)));
typedef float f32x4 __attribute__((ext_vector_type(4)));
typedef unsigned u32x4 __attribute__((ext_vector_type(4)));
constexpr int BM = 256, BK = 64, HALF = 128, HTB = HALF * BK * 2  , STAGE_BYTES = 8 * HTB, NXCD = 8, WGM = 8;

__host__ __device__ __forceinline__ int lds_byte(int r, int c) { const int st = (r >> 4) * 2 + (c >> 5), rr = r & 15, cc = c & 31, ob = rr * 64 + cc * 2; return st * 1024 + (ob ^ (((ob >> 9) & 1) << 5)); }
__host__ __device__ __forceinline__ void stage_rc(int b, int& R, int& C) { const int st = b / 1024, sb = b % 1024, swz = sb ^ (((sb >> 9) & 1) << 5); R = (st >> 1) * 16 + swz / 64; C = (st & 1) * 32 + (swz % 64) / 2; }
__host__ __device__ __forceinline__ int perm32(int rho) { const int n = rho >> 4, i = rho & 15; return 8 * (i >> 2) + 4 * n + (i & 3); }

struct Unit { int pm, pn; };
struct Gemm { const bf16_t* A; const bf16_t* Bt; int M, N, K; };

struct StaticOrder {
    int nM, nN, nwg, G, c;
    __host__ __device__ void init(int M, int N, int G_, int c_) { nM = M / BM; nN = N / BM; nwg = nM * nN; G = G_; c = c_; }
    __host__ __device__ bool next(int i, Unit& u) const {
        const long L = (long)i * G + c; if (L >= nwg) return false;
        int wgid = (int)L; { const int q = nwg / NXCD, r = nwg % NXCD, xcd = wgid % NXCD, off = wgid / NXCD; wgid = (xcd < r ? xcd * (q + 1) : r * (q + 1) + (xcd - r) * q) + off; }
        const int nig = WGM * nN, gid = wgid / nig, fm = gid * WGM, gsz = (nM - fm) < WGM ? (nM - fm) : WGM;
        u.pm = fm + ((wgid % nig) % gsz); u.pn = (wgid % nig) / gsz; return true;
    }
    __device__ __forceinline__ void a_ready(const Unit&) const {}
    __device__ __forceinline__ void done(const Unit&) const {}
};
__device__ __forceinline__ unsigned cvt_pk_bf16(float lo, float hi) { unsigned r; asm volatile("v_cvt_pk_bf16_f32 %0, %1, %2" : "=v"(r) : "v"(lo), "v"(hi)); return r; }
typedef float f32x2 __attribute__((ext_vector_type(2)));
template <class Epi, class Sched, bool STAMP = false>
__device__ __forceinline__ void gemm_phase(PG8_LAS unsigned char* lds, const Gemm g, const Sched& S, const Epi& E, unsigned long long* stamps) {
    int tid_ = (S.wid << 6) | (int)__builtin_amdgcn_mbcnt_hi(~0u, __builtin_amdgcn_mbcnt_lo(~0u, 0u)); asm volatile("" : "+v"(tid_)); const int tid = tid_, wid = __builtin_amdgcn_readfirstlane(tid >> 6), lane = tid & 63, wr = wid >> 2, wc = wid & 3, fr = lane & 15, fq = lane >> 4;
    int K_ = g.K; asm volatile("" : "+s"(K_)); const int K = K_, nt = K / BK;
    int ts_lo = 0, ts_hi = 0, nts = 0; const unsigned long long rt_entry = STAMP ? (unsigned long long)wall_clock64() : 0ull;
#define PG8_STAMP() do { if (STAMP && wid == 0 && nts < 64) { const unsigned long long _c = (unsigned long long)clock64(); \
        ts_lo = (lane == nts) ? (int)(unsigned)_c : ts_lo; ts_hi = (lane == nts) ? (int)(unsigned)(_c >> 32) : ts_hi; ++nts; } } while (0)
    PG8_STAMP();
    unsigned voffA[2], voffB[2];
#pragma unroll
    for (int i = 0; i < 2; ++i) { int R, C; stage_rc(tid * 16 + i * 8192, R, C); const int Rb = Epi::PERM ? ((R & ~31) + perm32(R & 31)) : R;
        voffA[i] = (unsigned)(R * K + C) * 2u; voffB[i] = (unsigned)(Rb * K + C) * 2u; }
    const size_t kstep = (size_t)(BK * 2);
    const size_t hstep = (size_t)HALF * K * 2;
    const size_t tstep = 2 * hstep;
    const unsigned ldsw = (unsigned)wid * 1024u;
    const int aoff = lds_byte(wr * 64 + fr, fq * 8), boff = lds_byte(wc * 32 + fr, fq * 8);
#define PG8_SA(b, h) (((b) * 2 + (h)) * HTB)
#define PG8_SB(b, h) ((4 + (b) * 2 + (h)) * HTB)
#define PG8_STAGE(bufoff, gbase, voff) do { _Pragma("unroll") for (int _i = 0; _i < 2; ++_i) \
        __builtin_amdgcn_global_load_lds((const unsigned*)((const char*)(gbase) + (voff)[_i]), (PG8_LAS unsigned*)(lds + (bufoff) + ldsw + _i * 8192), 16, 0, 0); } while (0)
#define PG8_LDA(dst, b, h) do { _Pragma("unroll") for (int m = 0; m < 4; ++m) _Pragma("unroll") for (int k = 0; k < 2; ++k) dst[m][k] = *(const PG8_LAS bf16x8*)(lds + PG8_SA(b, h) + aoff + m * 2048 + k * 1024); } while (0)
#define PG8_LDB(dst, b, h) do { _Pragma("unroll") for (int n = 0; n < 2; ++n) _Pragma("unroll") for (int k = 0; k < 2; ++k) dst[n][k] = *(const PG8_LAS bf16x8*)(lds + PG8_SB(b, h) + boff + n * 2048 + k * 1024); } while (0)
#define PG8_MMA(ai, bj, At, Bt) do { __builtin_amdgcn_s_setprio(1); _Pragma("unroll") for (int m = 0; m < 4; ++m) _Pragma("unroll") for (int n = 0; n < 2; ++n) _Pragma("unroll") for (int k = 0; k < 2; ++k) \
        acc[ai][bj][m][n] = __builtin_amdgcn_mfma_f32_16x16x32_bf16(Bt[n][k], At[m][k], acc[ai][bj][m][n], 0, 0, 0); __builtin_amdgcn_s_setprio(0); } while (0)
#define PG8_WAIT_V(n) asm volatile("s_waitcnt vmcnt(" #n ")" ::: "memory")
#define PG8_WAIT_L(n) asm volatile("s_waitcnt lgkmcnt(" #n ")" ::: "memory")
#define PG8_BAR __builtin_amdgcn_s_barrier()
#define PG8_SCHED __builtin_amdgcn_sched_barrier(0)
    Unit cur, nxt; int ui = 0;
    if (!S.next(0, cur)) return;
    f32x4 acc[2][2][4][2];
#pragma unroll
    for (int a = 0; a < 2; ++a)
#pragma unroll
        for (int b = 0; b < 2; ++b)
#pragma unroll
            for (int m = 0; m < 4; ++m)
#pragma unroll
                for (int n = 0; n < 2; ++n) acc[a][b][m][n] = (f32x4){0.f, 0.f, 0.f, 0.f};
    bf16x8 At[4][2], B0[2][2], B1[2][2];
    const char* cA = (const char*)g.A + (size_t)cur.pm * tstep; const char* cB = (const char*)g.Bt + (size_t)cur.pn * tstep;
    S.a_ready(cur);
    PG8_STAGE(PG8_SB(0, 0), cB, voffB); PG8_STAGE(PG8_SA(0, 0), cA, voffA); PG8_STAGE(PG8_SB(0, 1), cB + hstep, voffB); PG8_STAGE(PG8_SA(0, 1), cA + hstep, voffA);
    if (wr == 1) PG8_BAR;
    PG8_WAIT_V(4); PG8_BAR;
    PG8_STAGE(PG8_SB(1, 0), cB + kstep, voffB); PG8_STAGE(PG8_SA(1, 0), cA + kstep, voffA); PG8_STAGE(PG8_SB(1, 1), cB + hstep + kstep, voffB);
    PG8_WAIT_V(6); PG8_BAR;
    PG8_STAMP();
    for (;;) {
        const bool has_next = S.next(ui + 1, nxt);
        const char* nA = has_next ? (const char*)g.A + (size_t)nxt.pm * tstep : cA; const char* nB = has_next ? (const char*)g.Bt + (size_t)nxt.pn * tstep : cB;
        for (int t = 0; t < nt; t += 2) {
            const bool last = (t == nt - 2);
            const char* a1 = cA + (size_t)(t + 1) * kstep;
            const char* a2 = last ? nA : cA + (size_t)(t + 2) * kstep; const char* b2 = last ? nB : cB + (size_t)(t + 2) * kstep;
            const char* a3 = a2 + kstep; const char* b3 = b2 + kstep;
            if (last && has_next) S.a_ready(nxt);
            PG8_LDB(B0, 0, 0); PG8_SCHED; PG8_LDA(At, 0, 0); PG8_STAGE(PG8_SA(1, 1), a1 + hstep, voffA);
            PG8_WAIT_L(8); PG8_BAR; PG8_WAIT_L(0); PG8_MMA(0, 0, At, B0); PG8_BAR; PG8_SCHED;
            PG8_LDB(B1, 0, 1); PG8_STAGE(PG8_SB(0, 0), b2, voffB);
            PG8_BAR; PG8_WAIT_L(0); PG8_MMA(0, 1, At, B1); PG8_BAR;
            PG8_LDA(At, 0, 1); PG8_STAGE(PG8_SA(0, 0), a2, voffA);
            PG8_BAR; PG8_WAIT_L(0); PG8_MMA(1, 0, At, B0); PG8_BAR; PG8_SCHED;
            PG8_STAGE(PG8_SB(0, 1), b2 + hstep, voffB);
            PG8_WAIT_V(6); PG8_BAR; PG8_MMA(1, 1, At, B1); PG8_BAR;
            PG8_LDB(B0, 1, 0); PG8_SCHED; PG8_LDA(At, 1, 0); PG8_STAGE(PG8_SA(0, 1), a2 + hstep, voffA);
            PG8_WAIT_L(8); PG8_BAR; PG8_WAIT_L(0); PG8_MMA(0, 0, At, B0); PG8_BAR; PG8_SCHED;
            PG8_LDB(B1, 1, 1); PG8_STAGE(PG8_SB(1, 0), b3, voffB);
            PG8_BAR; PG8_WAIT_L(0); PG8_MMA(0, 1, At, B1); PG8_BAR;
            PG8_LDA(At, 1, 1); PG8_STAGE(PG8_SA(1, 0), a3, voffA);
            PG8_BAR; PG8_WAIT_L(0); PG8_MMA(1, 0, At, B0); PG8_BAR; PG8_SCHED;
            PG8_STAGE(PG8_SB(1, 1), b3 + hstep, voffB);
            PG8_WAIT_V(6); PG8_BAR; PG8_MMA(1, 1, At, B1); PG8_BAR;
        }
        PG8_STAMP();
        if constexpr (!Epi::AFTER_DRAIN) { E(acc, cur, wr, wc, fr, fq); S.done(cur); }
        PG8_STAMP();
        if (!has_next) break;
#pragma unroll
        for (int a = 0; a < 2; ++a)
#pragma unroll
            for (int b = 0; b < 2; ++b)
#pragma unroll
                for (int m = 0; m < 4; ++m)
#pragma unroll
                    for (int n = 0; n < 2; ++n) acc[a][b][m][n] = (f32x4){0.f, 0.f, 0.f, 0.f};
        cur = nxt; cA = nA; cB = nB; ++ui;
    }
    PG8_WAIT_V(0);
    if (wr == 0) PG8_BAR;
    PG8_BAR;
    if constexpr (Epi::AFTER_DRAIN) { E.fused(acc, cur, wr, wc, fr, fq, lds, wid, lane); S.done(cur); }
    PG8_STAMP();
    if (STAMP && wid == 0) { stamps[lane] = lane < nts ? (((unsigned long long)(unsigned)ts_hi << 32) | (unsigned)ts_lo) : 0ull;
        if (lane == 62) stamps[62] = rt_entry; if (lane == 63) stamps[63] = (unsigned long long)wall_clock64(); }
#undef PG8_STAMP
#undef PG8_SA
#undef PG8_SB
#undef PG8_STAGE
#undef PG8_LDA
#undef PG8_LDB
#undef PG8_MMA
#undef PG8_WAIT_V
#undef PG8_WAIT_L
#undef PG8_BAR
#undef PG8_SCHED
}
}
using pg8::bf16_t; using pg8::bf16x8; using pg8::f32x4; using pg8::u32x4; using pg8::Unit;
#define LAS __attribute__((address_space(3)))
typedef unsigned u32x2 __attribute__((ext_vector_type(2)));
typedef LAS unsigned char* lds_t;
struct Params;
__device__ __forceinline__ int lane_id_() { return (int)__builtin_amdgcn_mbcnt_hi(~0u, __builtin_amdgcn_mbcnt_lo(~0u, 0u)); }
typedef float f32x2_t __attribute__((ext_vector_type(2)));

enum { I_XP = 0, I_XS, I_C, I_CCTX, I_CKV, I_CKR, I_SGLA, I_SS5, I_NORMW, I_WADA, I_BADA, I_WIN, I_WA2, I_BA, I_ONORM, I_QNORM, I_WUQ, I_KVNORM, I_WUK, I_WUV,
       I_QHNORM, I_KHNORM, I_ARE, I_AIM, I_LOGDT, I_BRE, I_BIM, I_CRE, I_CIM, I_S5D, I_WGLU, I_BGLU, I_WBOG, I_WBOM, I_WBOS, I_WOUT, N_IN };
struct KParams { const float* in[N_IN]; float* out; unsigned char* ws; };
struct Params { const float* const* in; float* out; unsigned char* ws; int wid; };
__device__ __forceinline__ int tid_opaque(const Params& p) { int t = (p.wid << 6) | lane_id_(); asm volatile("" : "+v"(t)); return t; }

constexpr int LDZ = 6912;
constexpr int ZQ = 0, ZK = 256, ZV = 512, ZGA = 1024, ZGG = 1056, ZMQ = 1568, ZMKV = 1952, ZMKR = 2208, ZMG = 2240, ZSU = 2752, ZSG = 3264, ZMERGE = 3776;
constexpr size_t OUT_YP = 0, OUT_CKV = 8388608, OUT_KR = 10485760, OUT_GLA = 10747904, OUT_S5 = 12845056;
constexpr size_t OFF_WIN = 0;

constexpr size_t OFF_WUQ = OFF_WIN + 14155776;
constexpr size_t OFF_WKV = OFF_WUQ + 393216;
constexpr size_t OFF_WGLU = OFF_WKV + 393216;
constexpr size_t OFF_WBO = OFF_WGLU + 1048576;
constexpr size_t OFF_WOUT = OFF_WBO + 3145728;
constexpr size_t OFF_S5M = OFF_WOUT + 2097152;
constexpr size_t OFF_V = OFF_S5M;
constexpr size_t OFF_P16 = OFF_S5M + 12582912;
constexpr size_t OFF_ADA = OFF_P16 + 32768;
constexpr size_t OFF_ROPE = OFF_ADA + 122880;
constexpr size_t OFF_CTX0 = OFF_ROPE + 131072;
constexpr size_t OFF_CKVN = OFF_CTX0 + 1048576;
constexpr size_t OFF_CTX1 = OFF_CKVN + 4194304;
constexpr size_t OFF_HB = OFF_CTX1 + 1048576;
constexpr size_t OFF_Z = OFF_HB + 16777216;
constexpr size_t OFF_KV = OFF_Z + 113246208;
constexpr size_t OFF_AGLA = OFF_KV, OFF_AMLA = OFF_KV + 8388608;
constexpr size_t OFF_QD = OFF_KV + 16777216;
constexpr size_t OFF_OIB = OFF_QD + 8388608;
constexpr size_t OFF_DEC = OFF_KV + 33554432;
constexpr size_t OFF_ST = OFF_DEC + 262144;
constexpr size_t OFF_AQ = OFF_ST + 16777216;
constexpr size_t OFF_QRAW = OFF_AQ + 6291456;
constexpr size_t OFF_AS5 = OFF_QRAW + 6291456;
constexpr size_t OFF_YG = OFF_AS5 + 8388608;
constexpr size_t OFF_TBL = OFF_YG + 8388608;
constexpr size_t OFF_BAR = OFF_TBL + 512;
constexpr size_t OFF_KF = OFF_BAR + 16384;
constexpr size_t WS_END = OFF_KF + 7864320;
constexpr int DYN_LDS = 147456;

__device__ __forceinline__ float bf2f(bf16_t b) { return __uint_as_float(((unsigned)b) << 16); }
__device__ __forceinline__ bf16_t f2bf(float f) { unsigned u = __float_as_uint(f); u += 0x7FFFu + ((u >> 16) & 1u); return (bf16_t)(u >> 16); }
__device__ __forceinline__ unsigned pk2(float lo, float hi) { return pg8::cvt_pk_bf16(lo, hi); }
__device__ __forceinline__ float lo16(unsigned w) { return __uint_as_float(w << 16); }
__device__ __forceinline__ float hi16(unsigned w) { return __uint_as_float(w & 0xffff0000u); }
__device__ __forceinline__ float sigmoidf_(float x) { return 1.f / (1.f + __expf(-x)); }
__device__ __forceinline__ float siluf_(float x) { return x / (1.f + __expf(-x)); }
__device__ __forceinline__ void store8(bf16_t* p, const f32x4& a, const f32x4& b) { u32x4 w; w.x = pk2(a[0], a[1]); w.y = pk2(a[2], a[3]); w.z = pk2(b[0], b[1]); w.w = pk2(b[2], b[3]); *(u32x4*)p = w; }
#define MFMA16(a, b, c) __builtin_amdgcn_mfma_f32_16x16x32_bf16(a, b, c, 0, 0, 0)
#define LDSFRAG(ptr) (*(const LAS bf16x8*)(ptr))

struct Order : pg8::StaticOrder { int wid;
    __device__ void setup(int M, int N, int rot, int wid_) { wid = wid_; const int G = (int)gridDim.x; init(M, N, G, (int)((blockIdx.x + (unsigned)rot) % (unsigned)G)); }
};

struct EpiZ { static constexpr bool PERM = true, AFTER_DRAIN = false; bf16_t* Z;
    __device__ __forceinline__ void operator()(const f32x4 (&acc)[2][2][4][2], const Unit& u, int wr, int wc, int fr_, int fq_) const {
        int fr = fr_, fq = fq_; asm volatile("" : "+v"(fr), "+v"(fq));
        const int row0 = u.pm * 256 + wr * 64 + fr, col0 = u.pn * 256 + wc * 32 + 8 * fq;
#pragma unroll
        for (int ai = 0; ai < 2; ++ai)
#pragma unroll
            for (int m = 0; m < 4; ++m) { bf16_t* rp = Z + (size_t)(row0 + ai * 128 + m * 16) * LDZ + col0;
#pragma unroll
                for (int bj = 0; bj < 2; ++bj) store8(rp + bj * 128, acc[ai][bj][m][0], acc[ai][bj][m][1]); }
    } };
struct EpiQ { static constexpr bool PERM = true, AFTER_DRAIN = false; bf16_t* Q;
    __device__ __forceinline__ void operator()(const f32x4 (&acc)[2][2][4][2], const Unit& u, int wr, int wc, int fr_, int fq_) const {
        int fr = fr_, fq = fq_; asm volatile("" : "+v"(fr), "+v"(fq));
        const int row0 = u.pm * 256 + wr * 64 + fr, col0 = u.pn * 256 + wc * 32 + 8 * fq;
#pragma unroll
        for (int ai = 0; ai < 2; ++ai)
#pragma unroll
            for (int m = 0; m < 4; ++m) { bf16_t* rp = Q + (size_t)(row0 + ai * 128 + m * 16) * 384 + col0;
#pragma unroll
                for (int bj = 0; bj < 2; ++bj) if (col0 + bj * 128 < 384) store8(rp + bj * 128, acc[ai][bj][m][0], acc[ai][bj][m][1]);
                }
    } };
struct EpiKV { static constexpr bool PERM = true, AFTER_DRAIN = true; bf16_t* KF; bf16_t* V; int layer; const bf16_t* Z; const float* ckr; const float* khn; const float* R;
    __device__ __forceinline__ void fused(f32x4 (&acc)[2][2][4][2], const Unit& u, int wr, int wc, int fr_, int fq_, LAS unsigned char* lds, int wid, int lane_) const {
        if (u.pn == 0) { (*this)(acc, u, wr, wc, fr_, fq_); return; }
        int fr = fr_, fq = fq_, lane = lane_; asm volatile("" : "+v"(fr), "+v"(fq), "+v"(lane));
        LAS bf16_t* T = (LAS bf16_t*)lds;
#pragma unroll
        for (int ai = 0; ai < 2; ++ai)
#pragma unroll
            for (int m = 0; m < 4; ++m) { const int kl = ai * 128 + wr * 64 + m * 16 + fr;
#pragma unroll
                for (int bj = 0; bj < 2; ++bj) { const int el = bj * 128 + wc * 32 + 8 * fq;
#pragma unroll
                    for (int i = 0; i < 8; i += 2) { const unsigned w = pk2(acc[ai][bj][m][i >> 2][i & 3], acc[ai][bj][m][i >> 2][(i & 3) + 1]); T[(el + i) * 264 + kl] = (bf16_t)(w & 0xffffu); T[(el + i + 1) * 264 + kl] = (bf16_t)(w >> 16); } } }
        __syncthreads();
        int rb = u.pm * 256; if (layer == 0) rb = rb < 2048 ? 8192 + rb : rb - 2048;
        bf16_t* bp; int st;
        if (rb < 4096) { bp = V + (size_t)(rb >> 8) * 4 * 128 * 256; st = 256; }
        else if (rb < 8192) { bp = V + 2097152 + (size_t)((rb - 4096) >> 10) * 4 * 128 * 1536 + 512 + ((rb - 4096) & 1023); st = 1536; }
        else { bp = V + 2097152 + (size_t)((rb - 8192) >> 9) * 4 * 128 * 1536 + ((rb - 8192) & 511); st = 1536; }
        const int tid = wid * 64 + lane;
#pragma unroll
        for (int i = 0; i < 16; ++i) { const int idx = tid + 512 * i, el = idx >> 5, part = idx & 31;
            *(u32x4*)(bp + (size_t)((u.pn - 1) * 256 + el) * st + part * 8) = *(const LAS u32x4*)(T + el * 264 + part * 8); }
        __syncthreads();
    }
    __device__ __forceinline__ void operator()(const f32x4 (&acc)[2][2][4][2], const Unit& u, int wr, int wc, int fr_, int fq_) const {
        int fr = fr_, fq = fq_; asm volatile("" : "+v"(fr), "+v"(fq));
        int rb = u.pm * 256; if (layer == 0) rb = rb < 2048 ? 8192 + rb : rb - 2048;
        const int row0 = rb + wr * 64 + fr;
        float w1[4], w2[4];
#pragma unroll
        for (int i = 0; i < 4; ++i) { w1[i] = khn[64 + 4 * fq + i]; w2[i] = khn[80 + 4 * fq + i]; }
#pragma unroll
        for (int ai = 0; ai < 2; ++ai)
#pragma unroll
          for (int mh = 0; mh < 4; mh += 1) {
            float x1[4][4], x2[4][4], cs[4][4], sn[4][4];
#pragma unroll
            for (int m = mh; m < mh + 1; ++m) { const int r = row0 + ai * 128 + m * 16;
                if (r >= 8192) { const int j = r - 8192; const float* kr = ckr + ((size_t)(((j >> 9) * 2 + layer) * 512 + (j & 511))) * 32 + 4 * fq;
                    const f32x4 a = *(const f32x4*)kr, b = *(const f32x4*)(kr + 16);
#pragma unroll
                    for (int i = 0; i < 4; ++i) { x1[m][i] = a[i]; x2[m][i] = b[i]; } }
                else { const bf16_t* kr = Z + (size_t)r * LDZ + ZMKR + 4 * fq; const u32x2 a = *(const u32x2*)kr, b = *(const u32x2*)(kr + 16);
                    x1[m][0] = lo16(a.x); x1[m][1] = hi16(a.x); x1[m][2] = lo16(a.y); x1[m][3] = hi16(a.y); x2[m][0] = lo16(b.x); x2[m][1] = hi16(b.x); x2[m][2] = lo16(b.y); x2[m][3] = hi16(b.y); }
                const bool rot = r >= 4096 && r < 8192; const int pos = (r - 4096) & 1023;
                if (rot) { const f32x4 c = *(const f32x4*)(R + pos * 16 + 4 * fq), s_ = *(const f32x4*)(R + 16384 + pos * 16 + 4 * fq);
#pragma unroll
                    for (int i = 0; i < 4; ++i) { cs[m][i] = c[i]; sn[m][i] = s_[i]; } }
                else {
#pragma unroll
                    for (int i = 0; i < 4; ++i) { cs[m][i] = 1.f; sn[m][i] = 0.f; } } }
#pragma unroll
            for (int m = mh; m < mh + 1; ++m) { const int r = row0 + ai * 128 + m * 16;
                float ss = 0.f;
#pragma unroll
                for (int bj = 0; bj < 2; ++bj)
#pragma unroll
                    for (int i = 0; i < 8; ++i) { const float v = acc[ai][bj][m][i >> 2][i & 3]; ss += v * v; }
#pragma unroll
                for (int i = 0; i < 4; ++i) ss += x1[m][i] * x1[m][i] + x2[m][i] * x2[m][i];
                ss += __shfl_xor(ss, 16); ss += __shfl_xor(ss, 32);
                const float rstd = rsqrtf(ss * (1.f / 96.f) + 1e-6f);
                bf16_t* kp = KF + (size_t)r * 384 + wc * 96;
#pragma unroll
                for (int bj = 0; bj < 2; ++bj) { u32x4 w; const f32x4 v0 = acc[ai][bj][m][0], v1 = acc[ai][bj][m][1];
                    w.x = pk2(v0[0] * rstd, v0[1] * rstd); w.y = pk2(v0[2] * rstd, v0[3] * rstd);
                    w.z = pk2(v1[0] * rstd, v1[1] * rstd); w.w = pk2(v1[2] * rstd, v1[3] * rstd);
                    *(u32x4*)(kp + 32 * bj + 8 * fq) = w; }
                float o1[4], o2[4];
#pragma unroll
                for (int i = 0; i < 4; ++i) { const float a = x1[m][i] * rstd * w1[i], b = x2[m][i] * rstd * w2[i]; o1[i] = a * cs[m][i] - b * sn[m][i]; o2[i] = a * sn[m][i] + b * cs[m][i]; }
                *(u32x2*)(kp + 64 + 4 * fq) = (u32x2){pk2(o1[0], o1[1]), pk2(o1[2], o1[3])}; *(u32x2*)(kp + 80 + 4 * fq) = (u32x2){pk2(o2[0], o2[1]), pk2(o2[2], o2[3])}; }
            __builtin_amdgcn_sched_barrier(0); }
    } };
struct EpiGLU { static constexpr bool PERM = true, AFTER_DRAIN = false; bf16_t* O; const bf16_t* Z; const float* bias;
    __device__ __forceinline__ void operator()(const f32x4 (&acc)[2][2][4][2], const Unit& u, int wr, int wc, int fr_, int fq_) const {
        int fr = fr_, fq = fq_; asm volatile("" : "+v"(fr), "+v"(fq));
        const int row0 = u.pm * 256 + wr * 64 + fr, oc = u.pn * 128 + wc * 32 + 8 * fq;
#pragma unroll
        for (int ai = 0; ai < 2; ++ai) {
            float bv[8], bg[8];
            { const f32x4 b0 = *(const f32x4*)(bias + oc), b1 = *(const f32x4*)(bias + oc + 4), g0 = *(const f32x4*)(bias + 512 + oc), g1 = *(const f32x4*)(bias + 512 + oc + 4);
#pragma unroll
              for (int i = 0; i < 4; ++i) { bv[i] = b0[i]; bv[4 + i] = b1[i]; bg[i] = g0[i]; bg[4 + i] = g1[i]; } }
            u32x4 sgv[2][4];
#pragma unroll
            for (int m = 0; m < 4; ++m) sgv[ai][m] = *(const u32x4*)(Z + (size_t)(row0 + ai * 128 + m * 16) * LDZ + ZSG + oc);
#pragma unroll
            for (int m = 0; m < 4; ++m) { const size_t r = (size_t)(row0 + ai * 128 + m * 16);
                const u32x4 sg = sgv[ai][m];
                float g[8] = { lo16(sg.x), hi16(sg.x), lo16(sg.y), hi16(sg.y), lo16(sg.z), hi16(sg.z), lo16(sg.w), hi16(sg.w) };
                float o[8];
#pragma unroll
                for (int i = 0; i < 8; ++i) { const float zv = acc[ai][0][m][i >> 2][i & 3] + bv[i], zg = acc[ai][1][m][i >> 2][i & 3] + bg[i]; o[i] = zv * sigmoidf_(zg) * siluf_(g[i]); }
                u32x4 w; w.x = pk2(o[0], o[1]); w.y = pk2(o[2], o[3]); w.z = pk2(o[4], o[5]); w.w = pk2(o[6], o[7]);
                *(u32x4*)(O + r * 512 + oc) = w; }
            __builtin_amdgcn_sched_barrier(0); }
    } };
struct EpiBo { static constexpr bool PERM = true, AFTER_DRAIN = true; bf16_t* MIX; const bf16_t* Z; int branch;
    __device__ __forceinline__ void fused(f32x4 (&acc)[2][2][4][2], const Unit& u, int wr, int wc, int fr_, int fq_, LAS unsigned char* lds, int wid, int lane_) const {
        int fr = fr_, fq = fq_, lane = lane_; asm volatile("" : "+v"(fr), "+v"(fq), "+v"(lane));
        const int row0 = u.pm * 256 + wr * 64 + fr, col0 = u.pn * 256 + wc * 32 + 8 * fq;
        LAS unsigned char* wl = lds + wid * 16384;
#pragma unroll
        for (int ai = 0; ai < 2; ++ai)
#pragma unroll
            for (int m = 0; m < 4; ++m)
#pragma unroll
                for (int bj = 0; bj < 2; ++bj)
                    __builtin_amdgcn_global_load_lds((const unsigned*)(Z + (size_t)(row0 + ai * 128 + m * 16) * LDZ + ZMERGE + branch * 1024 + col0 + bj * 128), (LAS unsigned*)(wl + ((ai * 4 + m) * 2 + bj) * 1024), 16, 0, 0);
#pragma unroll
        for (int ai = 0; ai < 2; ++ai) {
            u32x4 pv[4][2];
#pragma unroll
            for (int m = 0; m < 4; ++m)
#pragma unroll
                for (int bj = 0; bj < 2; ++bj) pv[m][bj] = branch > 0 ? *(const u32x4*)(MIX + (size_t)(row0 + ai * 128 + m * 16) * 1024 + col0 + bj * 128) : (u32x4){0u, 0u, 0u, 0u};
            if (ai == 0) { asm volatile("s_waitcnt vmcnt(0)" ::: "memory"); __builtin_amdgcn_s_barrier(); asm volatile("" ::: "memory"); }
#pragma unroll
            for (int m = 0; m < 4; ++m) { const size_t r = (size_t)(row0 + ai * 128 + m * 16);
#pragma unroll
                for (int bj = 0; bj < 2; ++bj) { const u32x4 sg = *(const LAS u32x4*)(wl + ((ai * 4 + m) * 2 + bj) * 1024 + lane * 16), pp = pv[m][bj];
                    const float g[8] = { lo16(sg.x), hi16(sg.x), lo16(sg.y), hi16(sg.y), lo16(sg.z), hi16(sg.z), lo16(sg.w), hi16(sg.w) };
                    const float q[8] = { lo16(pp.x), hi16(pp.x), lo16(pp.y), hi16(pp.y), lo16(pp.z), hi16(pp.z), lo16(pp.w), hi16(pp.w) };
                    float o[8];
#pragma unroll
                    for (int i = 0; i < 8; ++i) o[i] = q[i] + sigmoidf_(g[i]) * acc[ai][bj][m][i >> 2][i & 3];
                    u32x4 w; w.x = pk2(o[0], o[1]); w.y = pk2(o[2], o[3]); w.z = pk2(o[4], o[5]); w.w = pk2(o[6], o[7]);
                    *(u32x4*)(MIX + r * 1024 + col0 + bj * 128) = w; } }
            __builtin_amdgcn_sched_barrier(0); }
        __syncthreads();
    }
    __device__ __forceinline__ void operator()(const f32x4 (&acc)[2][2][4][2], const Unit& u, int wr, int wc, int fr_, int fq_) const {
        int fr = fr_, fq = fq_; asm volatile("" : "+v"(fr), "+v"(fq));
        const int row0 = u.pm * 256 + wr * 64 + fr, col0 = u.pn * 256 + wc * 32 + 8 * fq;
#pragma unroll
        for (int ai = 0; ai < 2; ++ai)
#pragma unroll
          for (int mh = 0; mh < 4; mh += 2) {
            u32x4 gz[4][2], pv[4][2];
#pragma unroll
            for (int m = mh; m < mh + 2; ++m)
#pragma unroll
                for (int bj = 0; bj < 2; ++bj) { const size_t r = (size_t)(row0 + ai * 128 + m * 16);
                    gz[m][bj] = *(const u32x4*)(Z + r * LDZ + ZMERGE + branch * 1024 + col0 + bj * 128);
                    pv[m][bj] = branch > 0 ? *(const u32x4*)(MIX + r * 1024 + col0 + bj * 128) : (u32x4){0u, 0u, 0u, 0u}; }
#pragma unroll
            for (int m = mh; m < mh + 2; ++m) { const size_t r = (size_t)(row0 + ai * 128 + m * 16);
#pragma unroll
                for (int bj = 0; bj < 2; ++bj) { const u32x4 sg = gz[m][bj], pp = pv[m][bj];
                    const float g[8] = { lo16(sg.x), hi16(sg.x), lo16(sg.y), hi16(sg.y), lo16(sg.z), hi16(sg.z), lo16(sg.w), hi16(sg.w) };
                    const float q[8] = { lo16(pp.x), hi16(pp.x), lo16(pp.y), hi16(pp.y), lo16(pp.z), hi16(pp.z), lo16(pp.w), hi16(pp.w) };
                    float o[8];
#pragma unroll
                    for (int i = 0; i < 8; ++i) o[i] = q[i] + sigmoidf_(g[i]) * acc[ai][bj][m][i >> 2][i & 3];
                    u32x4 w; w.x = pk2(o[0], o[1]); w.y = pk2(o[2], o[3]); w.z = pk2(o[4], o[5]); w.w = pk2(o[6], o[7]);
                    *(u32x4*)(MIX + r * 1024 + col0 + bj * 128) = w; } }
            __builtin_amdgcn_sched_barrier(0); }
    } };
struct EpiOut { static constexpr bool PERM = false, AFTER_DRAIN = true; float* Y; const float* xp; const float* xs; const float* ada;
    __device__ __forceinline__ void fused(f32x4 (&acc)[2][2][4][2], const Unit& u, int wr, int wc, int fr_, int fq_, LAS unsigned char* lds, int wid, int lane_) const {
        int fr = fr_, fq = fq_, lane = lane_; asm volatile("" : "+v"(fr), "+v"(fq), "+v"(lane));
        const int row0 = u.pm * 256 + wr * 64 + fr, col0 = u.pn * 256 + wc * 32 + 4 * fq;
        LAS unsigned char* wl = lds + wid * 16384;
        const float* xb = (u.pm < 16 ? xp + (size_t)row0 * 1024 : xs + (size_t)(row0 - 4096) * 1024) + col0;
#pragma unroll
        for (int m = 0; m < 4; ++m)
#pragma unroll
            for (int bj = 0; bj < 2; ++bj)
#pragma unroll
                for (int n = 0; n < 2; ++n) __builtin_amdgcn_global_load_lds((const unsigned*)(xb + (size_t)(m * 16) * 1024 + bj * 128 + n * 16), (LAS unsigned*)(wl + ((m * 2 + bj) * 2 + n) * 1024), 16, 0, 0);
        f32x4 x1[4][2][2];
#pragma unroll
        for (int m = 0; m < 4; ++m)
#pragma unroll
            for (int bj = 0; bj < 2; ++bj)
#pragma unroll
                for (int n = 0; n < 2; ++n) x1[m][bj][n] = *(const f32x4*)(xb + (size_t)(128 + m * 16) * 1024 + bj * 128 + n * 16);
        const int ar = u.pm < 16 ? 0 : 1 + ((u.pm - 16) >> 2);
        const float* gp = ada + ar * 3072 + 2048;
        f32x4 gv[2][2];
#pragma unroll
        for (int bj = 0; bj < 2; ++bj)
#pragma unroll
            for (int n = 0; n < 2; ++n) gv[bj][n] = *(const f32x4*)(gp + col0 + bj * 128 + n * 16);
        asm volatile("s_waitcnt vmcnt(0)" ::: "memory"); __builtin_amdgcn_s_barrier(); asm volatile("" ::: "memory");
        float* yb = Y + (size_t)row0 * 1024 + col0;
#pragma unroll
        for (int m = 0; m < 4; ++m)
#pragma unroll
            for (int bj = 0; bj < 2; ++bj)
#pragma unroll
                for (int n = 0; n < 2; ++n) { const f32x4 xv = *(const LAS f32x4*)(wl + ((m * 2 + bj) * 2 + n) * 1024 + lane * 16);
                    *(f32x4*)(yb + (size_t)(m * 16) * 1024 + bj * 128 + n * 16) = xv + gv[bj][n] * acc[0][bj][m][n];
                    *(f32x4*)(yb + (size_t)(128 + m * 16) * 1024 + bj * 128 + n * 16) = x1[m][bj][n] + gv[bj][n] * acc[1][bj][m][n]; }
        __syncthreads();
    }
    __device__ __forceinline__ void operator()(const f32x4 (&acc)[2][2][4][2], const Unit& u, int wr, int wc, int fr_, int fq_) const {
        int fr = fr_, fq = fq_; asm volatile("" : "+v"(fr), "+v"(fq));
        const int row0 = u.pm * 256 + wr * 64 + fr, col0 = u.pn * 256 + wc * 32 + 4 * fq;
        const int ar = u.pm < 16 ? 0 : 1 + ((u.pm - 16) >> 2);
        const float* gp = ada + ar * 3072 + 2048;
        f32x4 gv[2][2];
#pragma unroll
        for (int bj = 0; bj < 2; ++bj)
#pragma unroll
            for (int n = 0; n < 2; ++n) gv[bj][n] = *(const f32x4*)(gp + col0 + bj * 128 + n * 16);
#pragma unroll
        for (int ai = 0; ai < 2; ++ai)
#pragma unroll
          for (int mh = 0; mh < 4; mh += 2) {
            f32x4 xv[4][2][2];
#pragma unroll
            for (int m = mh; m < mh + 2; ++m) { const int r = row0 + ai * 128 + m * 16;
                const float* xr = (r < 4096 ? xp + (size_t)r * 1024 : xs + (size_t)(r - 4096) * 1024) + col0;
#pragma unroll
                for (int bj = 0; bj < 2; ++bj)
#pragma unroll
                    for (int n = 0; n < 2; ++n) xv[m][bj][n] = *(const f32x4*)(xr + bj * 128 + n * 16); }
#pragma unroll
            for (int m = mh; m < mh + 2; ++m) { const int r = row0 + ai * 128 + m * 16;
                float* yr = Y + (size_t)r * 1024 + col0;
#pragma unroll
                for (int bj = 0; bj < 2; ++bj)
#pragma unroll
                    for (int n = 0; n < 2; ++n) *(f32x4*)(yr + bj * 128 + n * 16) = xv[m][bj][n] + gv[bj][n] * acc[ai][bj][m][n]; }
            __builtin_amdgcn_sched_barrier(0); }
    } };

__device__ __forceinline__ void job_ada(const Params& p, int j, lds_t lds) {
    LAS float* sc = (LAS float*)lds; LAS float* red = sc + 5 * 1024;
    const int l = j / 96, c0 = (j % 96) * 32, tid = tid_opaque(p);
    for (int i = tid; i < 5 * 1024; i += 512) { const int r = i >> 10, k = i & 1023; const float v = r == 0 ? p.in[I_CCTX][k] : p.in[I_C][(r - 1) * 1024 + k]; sc[i] = v / (1.f + expf(-v)); }
    __syncthreads();
    const int col = tid & 31, kg = tid >> 5; const float* W = p.in[I_WADA] + (size_t)l * 1024 * 3072 + (size_t)(kg * 64) * 3072 + c0 + col;
    float a0 = 0.f, a1 = 0.f, a2 = 0.f, a3 = 0.f, a4 = 0.f;
#pragma unroll 1
    for (int kb = 0; kb < 64; kb += 16) { float w[16];
#pragma unroll
        for (int i = 0; i < 16; ++i) w[i] = W[(size_t)(kb + i) * 3072];
#pragma unroll
        for (int i = 0; i < 16; ++i) { const int k = kg * 64 + kb + i; a0 += sc[k] * w[i]; a1 += sc[1024 + k] * w[i]; a2 += sc[2048 + k] * w[i]; a3 += sc[3072 + k] * w[i]; a4 += sc[4096 + k] * w[i]; } }
    red[(kg * 5 + 0) * 32 + col] = a0; red[(kg * 5 + 1) * 32 + col] = a1; red[(kg * 5 + 2) * 32 + col] = a2; red[(kg * 5 + 3) * 32 + col] = a3; red[(kg * 5 + 4) * 32 + col] = a4;
    __syncthreads();
    if (tid < 160) { const int r = tid >> 5, cc = tid & 31; float s = p.in[I_BADA][l * 3072 + c0 + cc];
        for (int g = 0; g < 16; ++g) s += red[(g * 5 + r) * 32 + cc];
        ((float*)(p.ws + OFF_ADA))[(l * 5 + r) * 3072 + c0 + cc] = s; }
    __syncthreads();
}
__device__ __forceinline__ void job_ctx(const Params& p, int j) {
    const int base = j * 4096 + tid_opaque(p) * 8; const int l = base / (2048 * 256), rem = base % (2048 * 256), row = rem >> 8, c = rem & 255, b = row >> 9, jj = row & 511;
    const float* s = p.in[I_CKV] + ((size_t)((b * 2 + l) * 512 + jj)) * 256 + c;
    const f32x4 v0 = *(const f32x4*)s, v1 = *(const f32x4*)(s + 4);
    bf16_t* d = (bf16_t*)(p.ws + (l == 0 ? OFF_CTX0 : OFF_CTX1)) + (size_t)row * 256 + c;
    store8(d, v0, v1);
}
__device__ __forceinline__ void job_rope(const Params& p, int j) {
    const int idx = j * 512 + tid_opaque(p), pos = idx >> 4, i = idx & 15, f = i & 7;
    const float inv = powf(10000.f, -(float)f / 8.f); const float ang = (float)(i < 8 ? (pos >> 6) : (pos & 63)) * inv;
    float* R = (float*)(p.ws + OFF_ROPE); R[idx] = cosf(ang); R[16384 + idx] = sinf(ang);
}

__device__ __forceinline__ void job_prep(const Params& p, int l, int j) {
    const int tid = tid_opaque(p), wid = tid >> 6, lane = tid & 63, row = j * 8 + wid;
    const float* x = l == 0 ? (row < 4096 ? p.in[I_XP] + (size_t)row * 1024 : p.in[I_XS] + (size_t)(row - 4096) * 1024) : p.out + (size_t)row * 1024;
    const int ar = row < 4096 ? 0 : 1 + ((row - 4096) >> 10);
    const float* ada = (const float*)(p.ws + OFF_ADA) + (l * 5 + ar) * 3072; const float* nw = p.in[I_NORMW] + l * 1024;
    f32x4 v[4]; float ss = 0.f;
#pragma unroll
    for (int i = 0; i < 4; ++i) { v[i] = *(const f32x4*)(x + i * 256 + lane * 4); ss += v[i][0] * v[i][0] + v[i][1] * v[i][1] + v[i][2] * v[i][2] + v[i][3] * v[i][3]; }
#pragma unroll
    for (int o = 1; o < 64; o <<= 1) ss += __shfl_xor(ss, o);
    const float rstd = rsqrtf(ss * (1.f / 1024.f) + 1e-6f);
    bf16_t* h = (bf16_t*)(p.ws + OFF_HB) + (size_t)row * 1024;
#pragma unroll
    for (int i = 0; i < 4; ++i) { const int c = i * 256 + lane * 4; const f32x4 w = *(const f32x4*)(nw + c), sh = *(const f32x4*)(ada + c), sc = *(const f32x4*)(ada + 1024 + c);
        float o[4];
#pragma unroll
        for (int k = 0; k < 4; ++k) o[k] = v[i][k] * rstd * w[k] * (1.f + sc[k]) + sh[k];
        u32x2 pk; pk.x = pk2(o[0], o[1]); pk.y = pk2(o[2], o[3]); *(u32x2*)(h + c) = pk; }
}
__device__ __forceinline__ void wt_tile(const Params& p, const float* src, int ldsrc, int sbase, int nvalid, int mode, bf16_t* dst, int K, int n0, int k0, lds_t lds) {
    LAS float* t = (LAS float*)lds; const int tid = tid_opaque(p);
    const int nn = tid & 255, kh = tid >> 8; const int sc = mode == 0 ? sbase + nn : mode == 1 ? ((nn >> 7) & 1) * 512 + sbase + (nn & 127) : ((nn >> 5) & 3) * 64 + (nn >> 7) * 32 + (nn & 31); const bool ok = mode != 0 || nn < nvalid;
    float v[32];
#pragma unroll
    for (int i = 0; i < 32; ++i) v[i] = ok ? src[(size_t)(k0 + 2 * i + kh) * ldsrc + sc] : 0.f;
#pragma unroll
    for (int i = 0; i < 32; ++i) t[(2 * i + kh) * 257 + nn] = v[i];
    __syncthreads();
#pragma unroll
    for (int ps = 0; ps < 4; ++ps) { const int n = ps * 64 + (tid >> 3), kc = tid & 7; const LAS float* s = t + (kc * 8) * 257 + n; u32x4 w;
        w.x = pk2(s[0], s[257]); w.y = pk2(s[514], s[771]); w.z = pk2(s[1028], s[1285]); w.w = pk2(s[1542], s[1799]);
        *(u32x4*)(dst + (size_t)(n0 + n) * K + k0 + kc * 8) = w; }
    __syncthreads();
}
constexpr int WT_WIN = 27 * 16, WT_WUQ = 2 * 6, WT_WKV = 3 * 4, WT_WGLU = 4 * 8, WT_WBO = 4 * 8, WT_WOUT = 4 * 16, WT_EARLY = WT_WIN + WT_WUQ + WT_WKV + WT_WGLU, WT_TOTAL = WT_EARLY + 3 * WT_WBO + WT_WOUT;
__device__ __forceinline__ void job_wt(const Params& p, int l, int t, lds_t lds) {
    if (t < WT_WIN) { const int nt = t / 16, kt = t % 16; wt_tile(p, p.in[I_WIN] + (size_t)l * 1024 * 6848, 6848, nt * 256, 6848 - nt * 256, 0, (bf16_t*)(p.ws + OFF_WIN), 1024, nt * 256, kt * 64, lds); return; } t -= WT_WIN;
    if (t < WT_WUQ) { const int nt = t / 6, kt = t % 6; wt_tile(p, p.in[I_WUQ] + (size_t)l * 384 * 384, 384, nt * 256, 384 - nt * 256, 0, (bf16_t*)(p.ws + OFF_WUQ), 384, nt * 256, kt * 64, lds); return; } t -= WT_WUQ;
    if (t < WT_WKV) { const int nt = t / 4, kt = t % 4;
        if (nt == 0) wt_tile(p, p.in[I_WUK] + (size_t)l * 256 * 256, 256, 0, 256, 2, (bf16_t*)(p.ws + OFF_WKV), 256, 0, kt * 64, lds);
        else wt_tile(p, p.in[I_WUV] + (size_t)l * 256 * 512, 512, (nt - 1) * 256, 256, 0, (bf16_t*)(p.ws + OFF_WKV), 256, nt * 256, kt * 64, lds);
        return; } t -= WT_WKV;
    if (t < WT_WGLU) { const int nt = t / 8, kt = t % 8; wt_tile(p, p.in[I_WGLU] + (size_t)l * 512 * 1024, 1024, nt * 128, 256, 1, (bf16_t*)(p.ws + OFF_WGLU), 512, nt * 256, kt * 64, lds); return; } t -= WT_WGLU;
    if (t < 3 * WT_WBO) { const int br = t / WT_WBO, tt = t % WT_WBO, nt = tt / 8, kt = tt % 8;
        wt_tile(p, p.in[I_WBOG + br] + (size_t)l * 512 * 1024, 1024, nt * 256, 256, 0, (bf16_t*)(p.ws + OFF_WBO) + (size_t)br * 1024 * 512, 512, nt * 256, kt * 64, lds); return; } t -= 3 * WT_WBO;
    { const int nt = t / 16, kt = t % 16; wt_tile(p, p.in[I_WOUT] + (size_t)l * 1024 * 1024, 1024, nt * 256, 256, 0, (bf16_t*)(p.ws + OFF_WOUT), 1024, nt * 256, kt * 64, lds); }
}
__device__ __forceinline__ void job_s5setup(const Params& p, int l, int jq, lds_t lds) {
    const int j = jq >> 2, qtr = jq & 3, g = j / 3, which = j % 3, tid = tid_opaque(p);
    LAS f32x2_t* pw = (LAS f32x2_t*)lds;
    LAS f32x2_t* Bt = pw + 2 * 17 * 64;
    LAS f32x2_t* Cn = Bt + 2 * 64 * 16;
    LAS float* Kt = (LAS float*)(Cn + 64 * 16);
    LAS float* raw = Kt + 8192;
    { const size_t gb = (size_t)(l * 32 + g) * 1024;
      for (int i = tid; i < 1024; i += 512) { raw[i] = p.in[I_BRE][gb + i]; raw[1024 + i] = p.in[I_BIM][gb + i]; raw[2048 + i] = p.in[I_CRE][gb + i]; raw[3072 + i] = p.in[I_CIM][gb + i]; }
      if (tid < 128) { const int d = tid >> 6, n = tid & 63; raw[4096 + tid] = p.in[I_ARE][((l * 2 + d) * 32 + g) * 64 + n]; raw[4224 + tid] = p.in[I_AIM][((l * 2 + d) * 32 + g) * 64 + n]; }
      if (tid < 2) raw[4352 + tid] = p.in[I_LOGDT][(l * 2 + tid) * 32 + g]; }
    __syncthreads();
    if (tid < 128) { const int d = tid >> 6, n = tid & 63;
        const float dt = expf(raw[4352 + d]);
        const float are = raw[4096 + tid], aim = raw[4224 + tid];
        float s1, c1; sincosf(aim * dt, &s1, &c1); float sh = sinf(0.5f * aim * dt);
        const float em1 = expm1f(are * dt), mag1 = em1 + 1.f;
        { float pr = 1.f, pi = 0.f; const float ar1 = mag1 * c1, ai1 = mag1 * s1;
          for (int tau = 0; tau <= 16; ++tau) { pw[(d * 17 + tau) * 64 + n] = (f32x2_t){pr, pi}; const float nr = pr * ar1 - pi * ai1, ni = pr * ai1 + pi * ar1; pr = nr; pi = ni; } }
        const float nre = em1 * c1 - 2.f * sh * sh, abim = mag1 * s1, den = are * are + aim * aim;
        const float cfr = (nre * are + abim * aim) / den, cfi = (abim * are - nre * aim) / den;
        for (int q = 0; q < 16; ++q) { const float br = raw[n * 16 + q], bi = raw[1024 + n * 16 + q];
            Bt[(d * 64 + n) * 16 + q] = (f32x2_t){cfr * br - cfi * bi, cfr * bi + cfi * br}; }
        if (which == 1 && qtr == 0) ((f32x2_t*)(p.ws + OFF_P16))[(g * 2 + d) * 64 + n] = pw[(d * 17 + 16) * 64 + n];
    }
    for (int i = tid; i < 1024; i += 512) { const int n = i >> 4, pp = i & 15; Cn[i] = (f32x2_t){raw[2048 + pp * 64 + n], raw[3072 + pp * 64 + n]}; }
    __syncthreads();
    bf16_t* M = (bf16_t*)(p.ws + OFF_S5M) + (size_t)(g * 3 + which) * 65536;
    if (which == 0) {
        { const int wid_ = tid >> 6, ln = tid & 63, lr_ = ln & 15, kq = ln >> 4;
          for (int c4 = 0; c4 < 4; ++c4) { const int dt_ = wid_ * 4 + c4, d = dt_ >> 4, tau = dt_ & 15; f32x4 acc = {0.f, 0.f, 0.f, 0.f};
#pragma unroll 4
            for (int ks = 0; ks < 16; ++ks) { const int n = ks * 4 + kq; const f32x2_t c = Cn[n * 16 + lr_], w = pw[(d * 17 + tau) * 64 + n], b = Bt[(d * 64 + n) * 16 + lr_];
                const float cwr = c.x * w.x - c.y * w.y, cwi = c.x * w.y + c.y * w.x;
                acc = __builtin_amdgcn_mfma_f32_16x16x4f32(cwr, b.x, acc, 0, 0, 0); acc = __builtin_amdgcn_mfma_f32_16x16x4f32(-cwi, b.y, acc, 0, 0, 0); }
#pragma unroll
            for (int r = 0; r < 4; ++r) Kt[dt_ * 256 + (kq * 4 + r) * 16 + lr_] = acc[r]; } }
        __syncthreads();
#pragma unroll 8
        for (int i = qtr * 16384 + tid; i < (qtr + 1) * 16384; i += 512) { const int no = i >> 8, k = i & 255, t = no >> 4, pp = no & 15, s = k >> 4, q = k & 15; float v;
            if (t > s) v = Kt[(0 * 16 + (t - s)) * 256 + pp * 16 + q];
            else if (t < s) v = Kt[(1 * 16 + (s - t)) * 256 + pp * 16 + q];
            else { v = Kt[pp * 16 + q] + Kt[16 * 256 + pp * 16 + q]; if (pp == q) v += p.in[I_S5D][l * 512 + g * 16 + pp]; }
            M[i] = f2bf(v); }
    } else if (which == 1) {
#pragma unroll 8
        for (int i = qtr * 16384 + tid; i < (qtr + 1) * 16384; i += 512) { const int no = i >> 8, k = i & 255, d = no >> 7, ri = (no >> 6) & 1, n = no & 63, s = k >> 4, q = k & 15; const int e = d == 0 ? 15 - s : s;
            const f32x2_t w = pw[(d * 17 + e) * 64 + n], b = Bt[(d * 64 + n) * 16 + q];
            M[i] = f2bf(ri == 0 ? w.x * b.x - w.y * b.y : w.x * b.y + w.y * b.x); }
    } else {
#pragma unroll 8
        for (int i = qtr * 16384 + tid; i < (qtr + 1) * 16384; i += 512) { const int no = i >> 8, k = i & 255, t = no >> 4, pp = no & 15, d = k >> 7, ri = (k >> 6) & 1, n = k & 63; const int e = d == 0 ? t + 1 : 16 - t;
            const f32x2_t c = Cn[n * 16 + pp], w = pw[(d * 17 + e) * 64 + n];
            M[i] = f2bf(ri == 0 ? c.x * w.x - c.y * w.y : -(c.x * w.y + c.y * w.x)); }
    }
    __syncthreads();
}

__device__ __forceinline__ float gelu_tanh(float x) { const float u = 0.7978845608f * (x + 0.044715f * x * x * x); const float t = 1.f - 2.f / (1.f + __expf(2.f * u)); return 0.5f * x * (1.f + t); }
__device__ __forceinline__ void job_s5(const Params& p, int l, int j, lds_t lds) {
    const int tid = tid_opaque(p), wid = tid >> 6, lane = tid & 63, lr = lane & 15, lq = lane >> 4;
    const int bcd = j >> 5, g = j & 31;
    const bool smp = bcd < 4;
    constexpr int M = 64, MT = 4; const int tok0 = smp ? 4096 + bcd * 1024 : (bcd - 4) * 1024;
    LAS bf16_t* Us = (LAS bf16_t*)lds; LAS bf16_t* Xs = Us + 64 * 264; LAS float* Xin = (LAS float*)(lds + 2 * 64 * 264 * 2);
    const bf16_t* Z = (const bf16_t*)(p.ws + OFF_Z);
    const bf16_t* TT = (const bf16_t*)(p.ws + OFF_S5M) + (size_t)(g * 3) * 65536; const bf16_t* G = TT + 65536; const bf16_t* Cc = G + 65536;
    bf16x8 bq[8][2];
#pragma unroll
    for (int ks = 0; ks < 8; ++ks) { bq[ks][0] = *(const bf16x8*)(G + (size_t)(wid * 32 + lr) * 256 + ks * 32 + lq * 8); bq[ks][1] = *(const bf16x8*)(G + (size_t)(wid * 32 + 16 + lr) * 256 + ks * 32 + lq * 8); }
    f32x2_t a16 = {0.f, 0.f}; float xr = 0.f, xi = 0.f;
    if (tid < 128) { const int d = tid >> 6, n = tid & 63; a16 = ((const f32x2_t*)(p.ws + OFF_P16))[(g * 2 + d) * 64 + n];
        if (smp) { const size_t o = ((size_t)((bcd * 2 + l) * 2 + d) * 2) * 2048 + g * 64 + n; xr = p.in[I_SS5][o]; xi = p.in[I_SS5][o + 2048]; } }
    for (int idx = tid; idx < M * 32; idx += 512) { const int tok = idx >> 1, hf = idx & 1;
        *(LAS u32x4*)(Us + (tok >> 4) * 264 + (tok & 15) * 16 + hf * 8) = *(const u32x4*)(Z + (size_t)(tok0 + tok) * LDZ + ZSU + g * 16 + hf * 8); }
    __syncthreads();
    f32x4 acc[4][2];
#pragma unroll
    for (int a = 0; a < 4; ++a) { acc[a][0] = (f32x4){0.f, 0.f, 0.f, 0.f}; acc[a][1] = acc[a][0]; }
#pragma unroll
    for (int ks = 0; ks < 8; ++ks)
#pragma unroll
        for (int mt = 0; mt < 4; ++mt) if (mt < MT) { const bf16x8 a = LDSFRAG(Us + (mt * 16 + lr) * 264 + ks * 32 + lq * 8); acc[mt][0] = MFMA16(a, bq[ks][0], acc[mt][0]); acc[mt][1] = MFMA16(a, bq[ks][1], acc[mt][1]); }
    bf16x8 bc[8][2];
#pragma unroll
    for (int ks = 0; ks < 8; ++ks) { bq[ks][0] = *(const bf16x8*)(TT + (size_t)(wid * 32 + lr) * 256 + ks * 32 + lq * 8); bq[ks][1] = *(const bf16x8*)(TT + (size_t)(wid * 32 + 16 + lr) * 256 + ks * 32 + lq * 8);
        bc[ks][0] = *(const bf16x8*)(Cc + (size_t)(wid * 32 + lr) * 256 + ks * 32 + lq * 8); bc[ks][1] = *(const bf16x8*)(Cc + (size_t)(wid * 32 + 16 + lr) * 256 + ks * 32 + lq * 8); }
#pragma unroll
    for (int mt = 0; mt < 4; ++mt) if (mt < MT)
#pragma unroll
        for (int ct = 0; ct < 2; ++ct)
#pragma unroll
            for (int r = 0; r < 4; ++r) Xin[(mt * 16 + lq * 4 + r) * 260 + wid * 32 + ct * 16 + lr] = acc[mt][ct][r];
    __syncthreads();
    if (tid < 128) { const int d = tid >> 6, n = tid & 63;
        const int cre = d * 128 + n, cim = cre + 64;
        const int nseg = smp ? 1 : 4, L = 64 / nseg;
        for (int sg = 0; sg < nseg; ++sg) {
            if (!smp) { xr = 0.f; xi = 0.f; }
            for (int i = 0; i < L; ++i) { const int c = sg * L + (d == 0 ? i : L - 1 - i);
                Xs[c * 264 + cre] = f2bf(xr); Xs[c * 264 + cim] = f2bf(xi);
                const float ur = Xin[c * 260 + cre], ui = Xin[c * 260 + cim];
                const float nr = a16.x * xr - a16.y * xi + ur, ni = a16.x * xi + a16.y * xr + ui; xr = nr; xi = ni; }
            if (!smp) { const int bb = (bcd - 4) * 4 + sg; const size_t o = OUT_S5 + ((size_t)((bb * 2 + l) * 2 + d) * 2) * 2048 + g * 64 + n; p.out[o] = xr; p.out[o + 2048] = xi; } }
    }
    __syncthreads();
#pragma unroll
    for (int a = 0; a < 4; ++a) { acc[a][0] = (f32x4){0.f, 0.f, 0.f, 0.f}; acc[a][1] = acc[a][0]; }
#pragma unroll
    for (int ks = 0; ks < 8; ++ks)
#pragma unroll
        for (int mt = 0; mt < 4; ++mt) if (mt < MT) { const bf16x8 a = LDSFRAG(Us + (mt * 16 + lr) * 264 + ks * 32 + lq * 8); acc[mt][0] = MFMA16(a, bq[ks][0], acc[mt][0]); acc[mt][1] = MFMA16(a, bq[ks][1], acc[mt][1]); }
#pragma unroll
    for (int ks = 0; ks < 8; ++ks)
#pragma unroll
        for (int mt = 0; mt < 4; ++mt) if (mt < MT) { const bf16x8 a = LDSFRAG(Xs + (mt * 16 + lr) * 264 + ks * 32 + lq * 8); acc[mt][0] = MFMA16(a, bc[ks][0], acc[mt][0]); acc[mt][1] = MFMA16(a, bc[ks][1], acc[mt][1]); }
    bf16_t* Yg = (bf16_t*)(p.ws + OFF_YG);
#pragma unroll
    for (int mt = 0; mt < 4; ++mt) if (mt < MT)
#pragma unroll
        for (int ct = 0; ct < 2; ++ct)
#pragma unroll
            for (int r = 0; r < 4; ++r) { const int chunk = mt * 16 + lq * 4 + r, t = wid * 2 + ct;
                Yg[(size_t)(tok0 + chunk * 16 + t) * 512 + g * 16 + lr] = f2bf(gelu_tanh(acc[mt][ct][r])); }
    __syncthreads();
}
__device__ __forceinline__ void job_mlaprep(const Params& p, int l, int j) {
    const int tid = tid_opaque(p), wid = tid >> 6, lane = tid & 63, row = j * 8 + wid;
    const bf16_t* z = (const bf16_t*)(p.ws + OFF_Z) + (size_t)row * LDZ;
    float q[6], kv[4]; float sq = 0.f, sk = 0.f;
#pragma unroll
    for (int i = 0; i < 6; ++i) { q[i] = bf2f(z[ZMQ + i * 64 + lane]); sq += q[i] * q[i]; }
#pragma unroll
    for (int i = 0; i < 4; ++i) { kv[i] = bf2f(z[ZMKV + i * 64 + lane]); sk += kv[i] * kv[i]; }
#pragma unroll
    for (int o = 1; o < 64; o <<= 1) { sq += __shfl_xor(sq, o); sk += __shfl_xor(sk, o); }
    const float rq = rsqrtf(sq * (1.f / 384.f) + 1e-6f), rk = rsqrtf(sk * (1.f / 256.f) + 1e-6f);
    bf16_t* aq = (bf16_t*)(p.ws + OFF_AQ) + (size_t)row * 384; bf16_t* ck = (bf16_t*)(p.ws + OFF_CKVN) + (size_t)row * 256;
#pragma unroll
    for (int i = 0; i < 6; ++i) aq[i * 64 + lane] = f2bf(q[i] * rq * p.in[I_QNORM][l * 384 + i * 64 + lane]);
    const bool prompt = row < 4096; const int b = row >> 8, t = row & 255;
#pragma unroll
    for (int i = 0; i < 4; ++i) { const float v = kv[i] * rk * p.in[I_KVNORM][l * 256 + i * 64 + lane]; ck[i * 64 + lane] = f2bf(v);
        if (prompt) p.out[OUT_CKV + ((size_t)((b * 2 + l) * 256 + t)) * 256 + i * 64 + lane] = v; }
    if (prompt && lane < 32) p.out[OUT_KR + ((size_t)((b * 2 + l) * 256 + t)) * 32 + lane] = bf2f(z[ZMKR + lane]);
}
__device__ __forceinline__ float logsigmoidf_(float x) { return fminf(x, 0.f) - __logf(1.f + __expf(-fabsf(x))); }
__device__ __forceinline__ void job_glaA(const Params& p, int l, int j, lds_t lds) {
    const int tid = tid_opaque(p), wid = tid >> 6, lane = tid & 63, lr = lane & 15, lq = lane >> 4;
    const int ck = j >> 2, h = j & 3, tok0 = ck * 64;
    LAS bf16_t* QDf = (LAS bf16_t*)lds; LAS bf16_t* QDb = QDf + 4608; LAS bf16_t* KDf = QDb + 4608; LAS bf16_t* KDb = KDf + 4608; LAS bf16_t* KRf = KDb + 4608; LAS bf16_t* KRb = KRf + 4608;
    LAS bf16_t* VT = KRb + 4608;
    LAS bf16_t* ATT = VT + 9216;
    LAS float* GA = (LAS float*)(ATT + 4608);
    LAS float* TOT = GA + 2048;
    const bf16_t* Z = (const bf16_t*)(p.ws + OFF_Z);
    const int d = tid & 63, cg_ = tid >> 6;
    bf16_t qraw[8], kraw[8]; float wf[16], wb[16];
#pragma unroll
    for (int i = 0; i < 8; ++i) { const size_t zr = (size_t)(tok0 + cg_ * 8 + i) * LDZ; qraw[i] = Z[zr + ZQ + h * 64 + d]; kraw[i] = Z[zr + ZK + h * 64 + d]; }
#pragma unroll
    for (int r = 0; r < 16; ++r) { wf[r] = p.in[I_WA2][((size_t)((l * 2 + 0) * 16 + r)) * 256 + h * 64 + d]; wb[r] = p.in[I_WA2][((size_t)((l * 2 + 1) * 16 + r)) * 256 + h * 64 + d]; }
    const float bf_ = p.in[I_BA][(l * 2 + 0) * 256 + h * 64 + d], bb_ = p.in[I_BA][(l * 2 + 1) * 256 + h * 64 + d];
    { const int c = tid >> 3, part = tid & 7; const u32x2 gv = *(const u32x2*)(Z + (size_t)(tok0 + c) * LDZ + ZGA + part * 4);
      GA[c * 32 + part * 4 + 0] = lo16(gv.x); GA[c * 32 + part * 4 + 1] = hi16(gv.x); GA[c * 32 + part * 4 + 2] = lo16(gv.y); GA[c * 32 + part * 4 + 3] = hi16(gv.y);
      const bf16_t* vp = Z + (size_t)(tok0 + c) * LDZ + ZV + h * 128 + part * 16;
      const u32x4 v0 = *(const u32x4*)vp, v1 = *(const u32x4*)(vp + 8);
      const unsigned w[8] = { v0.x, v0.y, v0.z, v0.w, v1.x, v1.y, v1.z, v1.w };
#pragma unroll
      for (int i = 0; i < 8; ++i) { VT[(part * 16 + 2 * i) * 72 + c] = (bf16_t)(w[i] & 0xffffu); VT[(part * 16 + 2 * i + 1) * 72 + c] = (bf16_t)(w[i] >> 16); } }
    __syncthreads();
    float laf[8], lab[8];
    {
#pragma unroll
      for (int i = 0; i < 8; ++i) { const int c = cg_ * 8 + i; float xf = bf_, xb = bb_;
#pragma unroll
          for (int r = 0; r < 16; ++r) { xf += GA[c * 32 + r] * wf[r]; xb += GA[c * 32 + 16 + r] * wb[r]; }
          laf[i] = logsigmoidf_(xf) * (1.f / 16.f); lab[i] = logsigmoidf_(xb) * (1.f / 16.f); } }
#pragma unroll
    for (int i = 1; i < 8; ++i) laf[i] += laf[i - 1];
#pragma unroll
    for (int i = 6; i >= 0; --i) lab[i] += lab[i + 1];
    TOT[(0 * 8 + cg_) * 64 + d] = laf[7]; TOT[(1 * 8 + cg_) * 64 + d] = lab[0];
    __syncthreads();
    float offf = 0.f, offb = 0.f, Tf = 0.f, Tb = 0.f;
#pragma unroll
    for (int g = 0; g < 8; ++g) { const float a = TOT[g * 64 + d], b = TOT[(8 + g) * 64 + d]; Tf += a; Tb += b; if (g < cg_) offf += a; if (g > cg_) offb += b; }
    bf16_t* QD = (bf16_t*)(p.ws + OFF_QD);
#pragma unroll
    for (int i = 0; i < 8; ++i) { const int c = cg_ * 8 + i;
        const float q = bf2f(qraw[i]) * 0.125f, k = bf2f(kraw[i]);
        const float bf_ = offf + laf[i], bb_ = offb + lab[i];
        const bf16_t qf = f2bf(q * __expf(bf_)), qb = f2bf(q * __expf(bb_));
        QDf[c * 72 + d] = qf; QDb[c * 72 + d] = qb;
        KDf[c * 72 + d] = f2bf(k * __expf(-bf_)); KDb[c * 72 + d] = f2bf(k * __expf(-bb_));
        KRf[d * 72 + c] = f2bf(k * __expf(Tf - bf_)); KRb[d * 72 + c] = f2bf(k * __expf(Tb - bb_));
        QD[(size_t)(tok0 + c) * 256 + h * 64 + d] = qf; QD[(size_t)(8192 + tok0 + c) * 256 + h * 64 + d] = qb; }
    if (cg_ == 0) { float* DEC = (float*)(p.ws + OFF_DEC); DEC[((0 * 128 + ck) * 4 + h) * 64 + d] = __expf(Tf); DEC[((1 * 128 + ck) * 4 + h) * 64 + d] = __expf(Tb); }
    __syncthreads();
#pragma unroll
    for (int q2 = 0; q2 < 2; ++q2) { const int tt = wid * 2 + q2, ti = tt >> 2, tj = tt & 3; f32x4 af = {0.f, 0.f, 0.f, 0.f}, ab = af;
#pragma unroll
        for (int ks = 0; ks < 2; ++ks) { const int ko = ks * 32 + lq * 8;
            af = MFMA16(LDSFRAG(QDf + (ti * 16 + lr) * 72 + ko), LDSFRAG(KDf + (tj * 16 + lr) * 72 + ko), af);
            ab = MFMA16(LDSFRAG(QDb + (ti * 16 + lr) * 72 + ko), LDSFRAG(KDb + (tj * 16 + lr) * 72 + ko), ab); }
#pragma unroll
        for (int r = 0; r < 4; ++r) { const int c = ti * 16 + lq * 4 + r, s = tj * 16 + lr; const float v = (s <= c ? af[r] : 0.f) + (s >= c ? ab[r] : 0.f); ATT[c * 72 + s] = f2bf(v); } }
    __syncthreads();
    bf16x8 vb[2];
#pragma unroll
    for (int ks = 0; ks < 2; ++ks) vb[ks] = LDSFRAG(VT + (wid * 16 + lr) * 72 + ks * 32 + lq * 8);
    bf16_t* OI = (bf16_t*)(p.ws + OFF_OIB); bf16_t* KV = (bf16_t*)(p.ws + OFF_KV);
#pragma unroll
    for (int ct = 0; ct < 4; ++ct) { f32x4 a = {0.f, 0.f, 0.f, 0.f};
#pragma unroll
        for (int ks = 0; ks < 2; ++ks) a = MFMA16(LDSFRAG(ATT + (ct * 16 + lr) * 72 + ks * 32 + lq * 8), vb[ks], a);
#pragma unroll
        for (int r = 0; r < 4; ++r) OI[(size_t)(tok0 + ct * 16 + lq * 4 + r) * 512 + h * 128 + wid * 16 + lr] = f2bf(a[r]); }
#pragma unroll
    for (int dir = 0; dir < 2; ++dir) { const LAS bf16_t* KR = dir == 0 ? KRf : KRb; bf16_t* kvp = KV + ((size_t)((dir * 128 + ck) * 4 + h)) * 8192;
#pragma unroll
        for (int dt = 0; dt < 4; ++dt) { f32x4 a = {0.f, 0.f, 0.f, 0.f};
#pragma unroll
            for (int ks = 0; ks < 2; ++ks) a = MFMA16(LDSFRAG(KR + (dt * 16 + lr) * 72 + ks * 32 + lq * 8), vb[ks], a);
#pragma unroll
            for (int r = 0; r < 4; ++r) kvp[(dt * 16 + lq * 4 + r) * 128 + wid * 16 + lr] = f2bf(a[r]); } }
    __syncthreads();
}

__device__ __forceinline__ void job_glaB(const Params& p, int l, int j) {
    const int qt = j & 3, h = (j >> 2) & 3, rest = j >> 4, bb = rest % 20, dir = rest / 20;
    const int idx0 = qt * 2048 + tid_opaque(p);
    const int nck = bb < 16 ? 4 : 16, ck0 = bb < 16 ? bb * 4 : 64 + (bb - 16) * 16;
    float S[4];
#pragma unroll
    for (int e = 0; e < 4; ++e) S[e] = bb >= 16 ? p.in[I_SGLA][((size_t)((((bb - 16) * 2 + l) * 2 + dir) * 4 + h)) * 8192 + idx0 + e * 512] : 0.f;
    const bf16_t* KV = (const bf16_t*)(p.ws + OFF_KV); const float* DEC = (const float*)(p.ws + OFF_DEC); bf16_t* ST = (bf16_t*)(p.ws + OFF_ST);
    for (int i0 = 0; i0 < nck; i0 += 4) { float dv[4][4]; bf16_t kv[4][4]; size_t its[4];
#pragma unroll
        for (int u = 0; u < 4; ++u) { const int i = i0 + u, ck = dir == 0 ? ck0 + i : ck0 + nck - 1 - i; its[u] = (size_t)((dir * 128 + ck) * 4 + h);
#pragma unroll
            for (int e = 0; e < 4; ++e) { const int idx = idx0 + e * 512; dv[u][e] = DEC[its[u] * 64 + (idx >> 7)]; kv[u][e] = KV[its[u] * 8192 + idx]; } }
#pragma unroll
        for (int u = 0; u < 4; ++u)
#pragma unroll
            for (int e = 0; e < 4; ++e) { ST[its[u] * 8192 + idx0 + e * 512] = f2bf(S[e]); S[e] = dv[u][e] * S[e] + bf2f(kv[u][e]); } }
    if (bb < 16) {
#pragma unroll
        for (int e = 0; e < 4; ++e) p.out[OUT_GLA + ((size_t)(((bb * 2 + l) * 2 + dir) * 4 + h)) * 8192 + idx0 + e * 512] = S[e]; }
}

__device__ __forceinline__ void job_glaC(const Params& p, int l, int j, lds_t lds) {
    const int tid = tid_opaque(p), wid = tid >> 6, lane = tid & 63, lr = lane & 15, lq = lane >> 4;
    const int ck = j >> 2, h = j & 3, tok0 = ck * 64;
    LAS bf16_t* Aq = (LAS bf16_t*)lds;
    LAS bf16_t* BT = Aq + 64 * 136;
    LAS float* Os = (LAS float*)(BT + 128 * 136);
    const bf16_t* QD = (const bf16_t*)(p.ws + OFF_QD); const bf16_t* ST = (const bf16_t*)(p.ws + OFF_ST);
#pragma unroll
    for (int it = 0; it < 2; ++it) { const int idx = tid + it * 512, c = idx >> 4, rem = idx & 15, dir = rem >> 3, dc = rem & 7;
        *(LAS u32x4*)(Aq + c * 136 + dir * 64 + dc * 8) = *(const u32x4*)(QD + (size_t)(dir * 8192 + tok0 + c) * 256 + h * 64 + dc * 8); }
#pragma unroll
    for (int it = 0; it < 4; ++it) { const int idx = tid + it * 512, dir = idx >> 10, d = (idx >> 4) & 63, ec = idx & 15;
        const u32x4 v = *(const u32x4*)(ST + ((size_t)((dir * 128 + ck) * 4 + h)) * 8192 + d * 128 + ec * 8);
        const unsigned w[4] = { v.x, v.y, v.z, v.w };
#pragma unroll
        for (int i = 0; i < 4; ++i) { BT[(ec * 8 + 2 * i) * 136 + dir * 64 + d] = (bf16_t)(w[i] & 0xffffu); BT[(ec * 8 + 2 * i + 1) * 136 + dir * 64 + d] = (bf16_t)(w[i] >> 16); } }
    const int ct = wid & 3, eh = wid >> 2; const bf16_t* OI = (const bf16_t*)(p.ws + OFF_OIB);
    bf16_t oi[4][4];
#pragma unroll
    for (int e4 = 0; e4 < 4; ++e4)
#pragma unroll
        for (int r = 0; r < 4; ++r) oi[e4][r] = OI[(size_t)(tok0 + ct * 16 + lq * 4 + r) * 512 + h * 128 + (eh * 4 + e4) * 16 + lr];
    const int nc = tid >> 3, npart = tid & 7;
    const bf16_t* gz = (const bf16_t*)(p.ws + OFF_Z) + (size_t)(tok0 + nc) * LDZ + ZGG + h * 128 + npart * 16;
    const u32x4 g0 = *(const u32x4*)gz, g1 = *(const u32x4*)(gz + 8);
    f32x4 onw[4];
#pragma unroll
    for (int i = 0; i < 4; ++i) onw[i] = *(const f32x4*)(p.in[I_ONORM] + l * 128 + npart * 16 + 4 * i);
    __syncthreads();
    bf16x8 af[4];
#pragma unroll
    for (int ks = 0; ks < 4; ++ks) af[ks] = LDSFRAG(Aq + (ct * 16 + lr) * 136 + ks * 32 + lq * 8);
#pragma unroll
    for (int e4 = 0; e4 < 4; ++e4) { const int et = eh * 4 + e4; f32x4 a = {0.f, 0.f, 0.f, 0.f};
#pragma unroll
        for (int ks = 0; ks < 4; ++ks) a = MFMA16(af[ks], LDSFRAG(BT + (et * 16 + lr) * 136 + ks * 32 + lq * 8), a);
#pragma unroll
        for (int r = 0; r < 4; ++r) { const int row = ct * 16 + lq * 4 + r, col = et * 16 + lr; Os[row * 132 + col] = a[r] + bf2f(oi[e4][r]); } }
    __syncthreads();
    { const int c = tid >> 3, part = tid & 7; float o[16]; float ss = 0.f;
#pragma unroll
      for (int i = 0; i < 16; ++i) { o[i] = Os[c * 132 + part * 16 + i]; ss += o[i] * o[i]; }
      ss += __shfl_xor(ss, 1); ss += __shfl_xor(ss, 2); ss += __shfl_xor(ss, 4);
      const float rstd = rsqrtf(ss * (1.f / 128.f) + 1e-6f);
      const unsigned gw[8] = { g0.x, g0.y, g0.z, g0.w, g1.x, g1.y, g1.z, g1.w };
      unsigned ow[8];
#pragma unroll
      for (int i = 0; i < 8; ++i) { const float n0 = onw[i >> 1][(2 * i) & 3], n1 = onw[i >> 1][(2 * i + 1) & 3];
          ow[i] = pk2(o[2 * i] * rstd * n0 * siluf_(lo16(gw[i])), o[2 * i + 1] * rstd * n1 * siluf_(hi16(gw[i]))); }
      bf16_t* ap = (bf16_t*)(p.ws + OFF_AGLA) + (size_t)(tok0 + c) * 512 + h * 128 + part * 16;
      *(u32x4*)ap = (u32x4){ow[0], ow[1], ow[2], ow[3]}; *(u32x4*)(ap + 8) = (u32x4){ow[4], ow[5], ow[6], ow[7]}; }
    __syncthreads();
}
__device__ __forceinline__ void head_row_finish(float (&x)[16], int p8, const float* nw, const float* nw2, bool rope, int pos, const float* R, float mul, LAS bf16_t* dst) {
    float ss = 0.f; const int cnt = p8 < 4 ? 16 : 8;
#pragma unroll
    for (int i = 0; i < 16; ++i) if (i < cnt) ss += x[i] * x[i];
    ss += __shfl_xor(ss, 1); ss += __shfl_xor(ss, 2); ss += __shfl_xor(ss, 4);
    const float rstd = rsqrtf(ss * (1.f / 96.f) + 1e-6f) * mul;
    if (p8 < 4) { unsigned w[8];
#pragma unroll
        for (int i = 0; i < 8; ++i) w[i] = pk2(x[2 * i] * rstd * nw[p8 * 16 + 2 * i] * nw2[p8 * 16 + 2 * i], x[2 * i + 1] * rstd * nw[p8 * 16 + 2 * i + 1] * nw2[p8 * 16 + 2 * i + 1]);
        *(LAS u32x4*)(dst + p8 * 16) = (u32x4){w[0], w[1], w[2], w[3]}; *(LAS u32x4*)(dst + p8 * 16 + 8) = (u32x4){w[4], w[5], w[6], w[7]};
    } else { const int i0 = (p8 - 4) * 4; float o1[4], o2[4];
#pragma unroll
        for (int i = 0; i < 4; ++i) { const float a = x[i] * rstd * nw[64 + i0 + i], b = x[4 + i] * rstd * nw[80 + i0 + i];
            if (rope) { const float c = R[pos * 16 + i0 + i], s = R[16384 + pos * 16 + i0 + i]; o1[i] = a * c - b * s; o2[i] = a * s + b * c; } else { o1[i] = a; o2[i] = b; } }
        *(LAS u32x2*)(dst + 64 + i0) = (u32x2){pk2(o1[0], o1[1]), pk2(o1[2], o1[3])}; *(LAS u32x2*)(dst + 80 + i0) = (u32x2){pk2(o2[0], o2[1]), pk2(o2[2], o2[3])}; }
}
__device__ __forceinline__ void ld16bf(const bf16_t* s, float (&x)[16]) { const u32x4 a = *(const u32x4*)s, b = *(const u32x4*)(s + 8);
    x[0] = lo16(a.x); x[1] = hi16(a.x); x[2] = lo16(a.y); x[3] = hi16(a.y); x[4] = lo16(a.z); x[5] = hi16(a.z); x[6] = lo16(a.w); x[7] = hi16(a.w);
    x[8] = lo16(b.x); x[9] = hi16(b.x); x[10] = lo16(b.y); x[11] = hi16(b.y); x[12] = lo16(b.z); x[13] = hi16(b.z); x[14] = lo16(b.w); x[15] = hi16(b.w); }
__device__ __forceinline__ void ld4bf(const bf16_t* s, float* x) { const u32x2 a = *(const u32x2*)s; x[0] = lo16(a.x); x[1] = hi16(a.x); x[2] = lo16(a.y); x[3] = hi16(a.y); }
__device__ __forceinline__ void job_attn(const Params& p, int l, int j, lds_t lds) {
    const int tid = tid_opaque(p), wid = tid >> 6, lane = tid & 63, lr = lane & 15, lq = lane >> 4;
    const bool smp = j < 128; int b, h, qb; if (smp) { b = j >> 5; h = (j >> 3) & 3; qb = j & 7; } else { const int jj = j - 128; b = jj >> 3; h = (jj >> 1) & 3; qb = jj & 1; }
    const int qtok0 = smp ? 4096 + b * 1024 + qb * 128 : b * 256 + qb * 128; const int nkt = smp ? 12 : 2;
    LAS bf16_t* Ks0 = (LAS bf16_t*)lds;
    LAS bf16_t* VTs0 = Ks0 + 2 * 128 * 104;
    LAS float* Mg = (LAS float*)lds;
    const bf16_t* Z = (const bf16_t*)(p.ws + OFF_Z); const bf16_t* KF = (const bf16_t*)(p.ws + OFF_KF); const bf16_t* Vb = (const bf16_t*)(p.ws + OFF_V); const float* R = (const float*)(p.ws + OFF_ROPE);
    const float* qhn = p.in[I_QHNORM] + l * 96;
    u32x4 kreg[3], vreg[4];
    const int vst = smp ? 1536 : 256; const bf16_t* vtb = smp ? Vb + 2097152 + (size_t)(b * 4 + h) * 128 * 1536 : Vb + (size_t)(b * 4 + h) * 128 * 256;
    auto rowbase = [&](int kt) { return smp ? (kt < 4 ? 8192 + b * 512 + kt * 128 : 4096 + b * 1024 + (kt - 4) * 128) : b * 256 + kt * 128; };
    auto issue = [&](int kt) { const int rb = rowbase(kt);
#pragma unroll
        for (int i = 0; i < 3; ++i) { const int idx = tid + 512 * i, key = idx / 12, part = idx - key * 12; kreg[i] = *(const u32x4*)(KF + (size_t)(rb + key) * 384 + h * 96 + part * 8); }
#pragma unroll
        for (int i = 0; i < 4; ++i) { const int idx = tid + 512 * i, e = idx >> 4, part = idx & 15; vreg[i] = *(const u32x4*)(vtb + (size_t)e * vst + kt * 128 + part * 8); } };
    auto commit = [&](int buf) { LAS bf16_t* Ks = Ks0 + buf * 128 * 104; LAS bf16_t* VTs = VTs0 + buf * 128 * 136;
#pragma unroll
        for (int i = 0; i < 3; ++i) { const int idx = tid + 512 * i, key = idx / 12, part = idx - key * 12; *(LAS u32x4*)(Ks + key * 104 + part * 8) = kreg[i]; }
#pragma unroll
        for (int i = 0; i < 4; ++i) { const int idx = tid + 512 * i, e = idx >> 4, part = idx & 15; *(LAS u32x4*)(VTs + e * 136 + part * 8) = vreg[i]; } };
    issue(0);
#pragma unroll
    for (int it = 0; it < 2; ++it) { const int row = it * 64 + (tid >> 3), p8 = tid & 7, tok = qtok0 + row; const bf16_t* qr = (const bf16_t*)(p.ws + OFF_QRAW) + (size_t)tok * 384 + h * 96; float x[16];
      if (p8 < 4) ld16bf(qr + p8 * 16, x); else { ld4bf(qr + 64 + (p8 - 4) * 4, x); ld4bf(qr + 80 + (p8 - 4) * 4, x + 4); }
      head_row_finish(x, p8, qhn, p.in[I_KHNORM] + l * 96, smp, qb * 128 + row, R, 0.10206207261596575f * 1.4426950408889634f, Ks0 + 128 * 104 + row * 104); }
    __syncthreads();
    const int rt = wid & 3, kh = wid >> 2;
    bf16x8 qa[2][3];
#pragma unroll
    for (int mt = 0; mt < 2; ++mt)
#pragma unroll
        for (int ks = 0; ks < 3; ++ks) qa[mt][ks] = LDSFRAG(Ks0 + 128 * 104 + (rt * 32 + mt * 16 + lr) * 104 + ks * 32 + lq * 8);
    commit(0);
    __syncthreads();
    f32x4 oacc[2][8]; float mrow[2], lrow[2];
#pragma unroll
    for (int mt = 0; mt < 2; ++mt) {
#pragma unroll
        for (int e = 0; e < 8; ++e) oacc[mt][e] = (f32x4){0.f, 0.f, 0.f, 0.f};
        mrow[mt] = -1e30f; lrow[mt] = 0.f; }
    const int kbase = kh * 64;
    for (int kt = 0; kt < nkt; ++kt) {
        if (kt + 1 < nkt) issue(kt + 1);
        const LAS bf16_t* Ks = Ks0 + (kt & 1) * 128 * 104; const LAS bf16_t* VTs = VTs0 + (kt & 1) * 128 * 136;
        f32x4 sacc[2][4];
#pragma unroll
        for (int nt = 0; nt < 4; ++nt) { sacc[0][nt] = (f32x4){0.f, 0.f, 0.f, 0.f}; sacc[1][nt] = sacc[0][nt];
#pragma unroll
            for (int ks = 0; ks < 3; ++ks) { const bf16x8 kf = LDSFRAG(Ks + (kbase + nt * 16 + lr) * 104 + ks * 32 + lq * 8); sacc[0][nt] = MFMA16(kf, qa[0][ks], sacc[0][nt]); sacc[1][nt] = MFMA16(kf, qa[1][ks], sacc[1][nt]); } }
        bf16x8 pb[2][2];
#pragma unroll
        for (int mt = 0; mt < 2; ++mt) {
            float mx = -1e30f;
#pragma unroll
            for (int nt = 0; nt < 4; ++nt) mx = fmaxf(mx, fmaxf(fmaxf(sacc[mt][nt][0], sacc[mt][nt][1]), fmaxf(sacc[mt][nt][2], sacc[mt][nt][3])));
            mx = fmaxf(mx, __shfl_xor(mx, 16)); mx = fmaxf(mx, __shfl_xor(mx, 32));
            const float mn = fmaxf(mrow[mt], mx), alpha = __builtin_amdgcn_exp2f(mrow[mt] - mn); mrow[mt] = mn;
            float pv[4][4]; float rs = 0.f;
#pragma unroll
            for (int nt = 0; nt < 4; ++nt)
#pragma unroll
                for (int r = 0; r < 4; ++r) { pv[nt][r] = __builtin_amdgcn_exp2f(sacc[mt][nt][r] - mn); rs += pv[nt][r]; }
            lrow[mt] = lrow[mt] * alpha + rs;
#pragma unroll
            for (int k2 = 0; k2 < 2; ++k2) { u32x4 w; w.x = pk2(pv[2 * k2][0], pv[2 * k2][1]); w.y = pk2(pv[2 * k2][2], pv[2 * k2][3]); w.z = pk2(pv[2 * k2 + 1][0], pv[2 * k2 + 1][1]); w.w = pk2(pv[2 * k2 + 1][2], pv[2 * k2 + 1][3]);
                pb[mt][k2] = __builtin_bit_cast(bf16x8, w); }
#pragma unroll
            for (int e = 0; e < 8; ++e) oacc[mt][e] *= alpha; }
#pragma unroll
        for (int k2 = 0; k2 < 2; ++k2)
#pragma unroll
            for (int e = 0; e < 8; ++e) { const LAS bf16_t* vp = VTs + (e * 16 + lr) * 136 + kbase + k2 * 32 + 4 * lq;
                const u32x2 lo = *(const LAS u32x2*)vp, hi = *(const LAS u32x2*)(vp + 16);
                const bf16x8 vf = __builtin_bit_cast(bf16x8, (u32x4){lo.x, lo.y, hi.x, hi.y});
                oacc[0][e] = MFMA16(vf, pb[0][k2], oacc[0][e]); oacc[1][e] = MFMA16(vf, pb[1][k2], oacc[1][e]); }
        if (kt + 1 < nkt) commit((kt + 1) & 1);
        __syncthreads();
    }
#pragma unroll
    for (int mt = 0; mt < 2; ++mt) { float s_ = lrow[mt]; s_ += __shfl_xor(s_, 16); s_ += __shfl_xor(s_, 32); lrow[mt] = s_; }
    LAS float* Mo = Mg + rt * 32 * 132; LAS float* Ml = Mg + 4 * 32 * 132 + rt * 64;
    if (kh == 1) {
#pragma unroll
        for (int mt = 0; mt < 2; ++mt) {
#pragma unroll
            for (int e = 0; e < 8; ++e) *(LAS f32x4*)(Mo + (mt * 16 + lr) * 132 + e * 16 + 4 * lq) = oacc[mt][e];
            if (lq == 0) { Ml[(mt * 16 + lr) * 2] = mrow[mt]; Ml[(mt * 16 + lr) * 2 + 1] = lrow[mt]; } }
    }
    __syncthreads();
    if (kh == 0) { bf16_t* AM = (bf16_t*)(p.ws + OFF_AMLA);
#pragma unroll
        for (int mt = 0; mt < 2; ++mt) { const int row = mt * 16 + lr, tok = qtok0 + rt * 32 + row;
            u32x2 gt[8];
#pragma unroll
            for (int e = 0; e < 8; ++e) gt[e] = *(const u32x2*)(Z + (size_t)tok * LDZ + ZMG + h * 128 + e * 16 + 4 * lq);
            const float m2 = Ml[row * 2], l2 = Ml[row * 2 + 1]; const float mm = fmaxf(mrow[mt], m2), a1 = __builtin_amdgcn_exp2f(mrow[mt] - mm), a2 = __builtin_amdgcn_exp2f(m2 - mm);
            const float inv = 1.f / (lrow[mt] * a1 + l2 * a2);
#pragma unroll
            for (int e = 0; e < 8; ++e) { const f32x4 o2 = *(const LAS f32x4*)(Mo + row * 132 + e * 16 + 4 * lq); float o[4];
#pragma unroll
                for (int r = 0; r < 4; ++r) o[r] = (oacc[mt][e][r] * a1 + o2[r] * a2) * inv;
                const float g0 = lo16(gt[e].x), g1 = hi16(gt[e].x), g2 = lo16(gt[e].y), g3 = hi16(gt[e].y);
                *(u32x2*)(AM + (size_t)tok * 512 + h * 128 + e * 16 + 4 * lq) = (u32x2){pk2(o[0] * siluf_(g0), o[1] * siluf_(g1)), pk2(o[2] * siluf_(g2), o[3] * siluf_(g3))}; } } }
    __syncthreads();
}


#define XB_TMO      128
#define XB_XCNT(j)  (256  + 64 * (j))
#define XB_XSUB(j)  (1280 + 64 * (j))
#define XB_XGEN(j)  (2304 + 64 * (j))
#define XB_TOP      3328
#define XB_TOPGEN   3392
#define XCD_BAR_WORDS 3456
#define XB_SPIN_CAP (1u << 18)

__device__ __forceinline__ unsigned xb_ld(unsigned* p)              { return __hip_atomic_load(p, __ATOMIC_RELAXED, __HIP_MEMORY_SCOPE_AGENT); }
__device__ __forceinline__ unsigned xb_add(unsigned* p, unsigned v) { return __hip_atomic_fetch_add(p, v, __ATOMIC_RELAXED, __HIP_MEMORY_SCOPE_AGENT); }
__device__ __forceinline__ unsigned xb_xcc_id() { return (unsigned)__builtin_amdgcn_s_getreg((3 << 11) | 20) & 0xFu; }
#define XB_SPIN(cond, bar) do { unsigned _sp = 0; while (cond) { __builtin_amdgcn_s_sleep(1); \
    if ((++_sp & 255u) == 0u) { if (xb_ld(&(bar)[XB_TMO])) break; if (_sp > XB_SPIN_CAP) { atomicAdd(&(bar)[XB_TMO], 1u); break; } } } } while (0)

struct XcdBarrier {
    int wid; unsigned* bar; unsigned x;
    volatile LAS unsigned* st;
};

__device__ __forceinline__ XcdBarrier xcd_barrier_post(unsigned* bar, volatile LAS unsigned* st) {
    XcdBarrier b; b.bar = bar; b.x = xb_xcc_id(); b.st = st;
    if (threadIdx.x == 0) (void)xb_add(&bar[XB_XCNT(b.x)], 1u);
    return b;
}
__device__ __forceinline__ void xcd_barrier_complete(unsigned* bar, unsigned x, unsigned& nloc, unsigned& nx) {
    const unsigned G = gridDim.x * gridDim.y * gridDim.z;
    unsigned sum, cnt, mine, sp = 0u;
    for (;;) {
        sum = 0u; cnt = 0u; mine = 0u;
#pragma unroll
        for (unsigned j = 0; j < 16; ++j) { const unsigned c = xb_ld(&bar[XB_XCNT(j)]); sum += c; cnt += (c > 0u) ? 1u : 0u; mine = (j == x) ? c : mine; }
        if (sum == G) break;
        __builtin_amdgcn_s_sleep(1);
        if ((++sp & 255u) == 0u) { if (xb_ld(&bar[XB_TMO])) break; if (sp > XB_SPIN_CAP) { atomicAdd(&bar[XB_TMO], 1u); break; } }
    }
    nloc = mine > 0u ? mine : 1u; nx = cnt > 0u ? cnt : 1u;
}

__device__ __forceinline__ void xcd_barrier(const XcdBarrier& b) {
    asm volatile("s_waitcnt vmcnt(0)" ::: "memory");
    __syncthreads();
    if (b.wid == 0 && lane_id_() == 0) {
        unsigned* bar = b.bar;
        __builtin_amdgcn_s_waitcnt(0);
        unsigned nloc = b.st[0], nx = b.st[1];
        if (nloc == 0u) { xcd_barrier_complete(bar, b.x, nloc, nx); b.st[0] = nloc; b.st[1] = nx; }
        const unsigned old = xb_add(&bar[XB_XSUB(b.x)], 1u);
        const unsigned gen = old / nloc;
        if (old + 1u == (gen + 1u) * nloc) {
            __builtin_amdgcn_fence(__ATOMIC_RELEASE, "agent");
            asm volatile("s_waitcnt vmcnt(0)" ::: "memory");
            const unsigned og = xb_add(&bar[XB_TOP], 1u);
            const unsigned tg = og / nx;
            if (og + 1u == (tg + 1u) * nx) xb_add(&bar[XB_TOPGEN], 1u);
            else XB_SPIN(xb_ld(&bar[XB_TOPGEN]) == tg, bar);
            __builtin_amdgcn_fence(__ATOMIC_ACQUIRE, "agent");
            xb_add(&bar[XB_XGEN(b.x)], 1u);
            asm volatile("s_waitcnt vmcnt(0)" ::: "memory");
        } else {
            XB_SPIN(xb_ld(&bar[XB_XGEN(b.x)]) == gen, bar);
            __builtin_amdgcn_fence(__ATOMIC_ACQUIRE, "agent");
            asm volatile("s_waitcnt vmcnt(0)" ::: "memory");
        }
    }
    __syncthreads();
}

constexpr int N_PHASES = 15;
#ifndef S3SEL
#define S3SEL 15
#endif
#ifndef REPEAT_MASK
#define REPEAT_MASK 0xff
#endif
#ifndef ONLY_S
#define ONLY_S -1
#endif
__device__ __forceinline__ void run_phase(const Params& p, int ph, lds_t lds, int mask = 0xff) {
    const int G = (int)gridDim.x, bid = (int)blockIdx.x;
    if (ph == 0 && (ONLY_S < 0 || ONLY_S == 7)) {
        for (int j = bid; j < 384 + 192 + 256 + 32; j += G) { if (j < 384) job_s5setup(p, 0, j, lds); else if (j < 576) job_ada(p, j - 384, lds); else if (j < 832) job_ctx(p, j - 576); else job_rope(p, j - 832); }
        return;
    }
    const int l = (ph - 1) / 7, s = (ph - 1) % 7;
    unsigned char* ws = p.ws;
    if (s == 0 && (ONLY_S < 0 || ONLY_S == 0)) {
        if (l == 0 || G < 256) { for (int j = bid; j < 384 + WT_TOTAL + 1024; j += G) { if (j < 384) { if ((mask & 1) && l > 0) job_s5setup(p, l, j, lds); } else if (j < 384 + WT_TOTAL) { if (mask & 2) job_wt(p, l, j - 384, lds); } else if (mask & 4) job_prep(p, l, j - 384 - WT_TOTAL); } }
        else { for (int j = bid; j < WT_WOUT + 1024; j += G) { if (j < WT_WOUT) job_wt(p, l, WT_EARLY + 3 * WT_WBO + j, lds); else job_prep(p, l, j - WT_WOUT); } }
    } else if (s == 1 && (ONLY_S < 0 || ONLY_S == 1)) {
        Order S; S.setup(8192, 4096, 0, p.wid); pg8::Gemm g{(const bf16_t*)(ws + OFF_HB), (const bf16_t*)(ws + OFF_WIN), 8192, 4096, 1024}; EpiZ E{(bf16_t*)(ws + OFF_Z)};
        pg8::gemm_phase<EpiZ, Order>(lds, g, S, E, nullptr);
    } else if (s == 2 && (ONLY_S < 0 || ONLY_S == 2)) {
        if (G == 256) {
            if (mask & 1) { const int slot = bid >> 3; job_s5(p, l, (slot >> 2) * 32 + 4 * (bid & 7) + (slot & 3), lds); }
            if (mask & 2) { job_glaA(p, l, bid, lds); job_glaA(p, l, 256 + bid, lds); }
            if (mask & 4) for (int j = bid; j < 1024; j += G) job_mlaprep(p, l, j);
        } else for (int j = bid; j < 256 + 512 + 1024; j += G) { if (j < 256) { if (mask & 1) job_s5(p, l, j, lds); } else if (j < 768) { if (mask & 2) job_glaA(p, l, j - 256, lds); } else if (mask & 4) job_mlaprep(p, l, j - 768); }
    } else if (s == 3 && (ONLY_S < 0 || ONLY_S == 3)) {
        if (mask & 1) { if (G == 256) { if (bid < 96) for (int j = bid; j < 640; j += 96) job_glaB(p, l, j); } else for (int j = bid; j < 640; j += G) job_glaB(p, l, j); }
        if (mask & 16) { Order S; S.setup(8192, 2816, 0, p.wid); pg8::Gemm g{(const bf16_t*)(ws + OFF_HB), (const bf16_t*)(ws + OFF_WIN) + (size_t)4096 * 1024, 8192, 2816, 1024}; EpiZ E{(bf16_t*)(ws + OFF_Z) + 4096};
          pg8::gemm_phase<EpiZ, Order>(lds, g, S, E, nullptr); }
        if ((mask & 2) && (S3SEL & 2)) { Order S; S.setup(8192, 1024, 160, p.wid); pg8::Gemm g{(const bf16_t*)(ws + OFF_YG), (const bf16_t*)(ws + OFF_WGLU), 8192, 1024, 512}; EpiGLU E{(bf16_t*)(ws + OFF_AS5), (const bf16_t*)(ws + OFF_Z), p.in[I_BGLU] + l * 1024};
          pg8::gemm_phase<EpiGLU, Order>(lds, g, S, E, nullptr); }
        if ((mask & 4) && (S3SEL & 4)) { Order S; S.setup(10240, 768, 120, p.wid); pg8::Gemm g{(const bf16_t*)(ws + (l == 0 ? OFF_CTX0 : OFF_CKVN)), (const bf16_t*)(ws + OFF_WKV), 10240, 768, 256}; EpiKV E{(bf16_t*)(ws + OFF_KF), (bf16_t*)(ws + OFF_V), l, (const bf16_t*)(ws + OFF_Z), p.in[I_CKR], p.in[I_KHNORM] + l * 96, (const float*)(ws + OFF_ROPE)};
          pg8::gemm_phase<EpiKV, Order>(lds, g, S, E, nullptr); }
        if ((mask & 8) && (S3SEL & 8)) { Order S; S.setup(8192, 512, 160, p.wid); if (G == 256) S.c = (bid >= 96 && bid < 136) ? bid - 96 : (bid >= 224 && bid < 248) ? bid - 184 : (1 << 20); pg8::Gemm g{(const bf16_t*)(ws + OFF_AQ), (const bf16_t*)(ws + OFF_WUQ), 8192, 512, 384}; EpiQ E{(bf16_t*)(ws + OFF_QRAW)};
          pg8::gemm_phase<EpiQ, Order>(lds, g, S, E, nullptr); }
    } else if (s == 4 && (ONLY_S < 0 || ONLY_S == 4)) {
        if (G == 256) {
            if (bid < 128) { const int slot = bid >> 3, pair = 2 * (bid & 7) + (slot >> 3);
                if (mask & 1) job_attn(p, l, pair * 8 + (slot & 7), lds); }
            else { const int k = bid - 128; if (mask & 1) job_attn(p, l, 128 + k, lds); if (mask & 2) { job_glaC(p, l, k, lds); job_glaC(p, l, 128 + k, lds); job_glaC(p, l, 256 + k, lds); job_glaC(p, l, 384 + k, lds); } }
        } else for (int j = bid; j < 256 + 512; j += G) { if (j < 256) { if (mask & 1) job_attn(p, l, j, lds); } else if (mask & 2) job_glaC(p, l, j - 256, lds); }
    } else if (s == 5 && (ONLY_S < 0 || ONLY_S == 5)) {
        if (l == 0 && mask == 0xff && G >= 256 && bid >= 128) { for (int j = bid - 128; j < 384 + WT_EARLY; j += G - 128) { if (j < 384) job_s5setup(p, 1, j, lds); else job_wt(p, 1, j - 384, lds); } }
        for (int br = 0; br < 3; ++br) { Order S; S.setup(8192, 1024, 0, p.wid);
            pg8::Gemm g{(const bf16_t*)(ws + (br == 0 ? OFF_AGLA : br == 1 ? OFF_AMLA : OFF_AS5)), (const bf16_t*)(ws + OFF_WBO) + (size_t)br * 1024 * 512, 8192, 1024, 512};
            EpiBo E{(bf16_t*)(ws + OFF_HB), (const bf16_t*)(ws + OFF_Z), br};
            pg8::gemm_phase<EpiBo, Order>(lds, g, S, E, nullptr); }
    } else if (s == 6 && (ONLY_S < 0 || ONLY_S == 6)) {
        if (l == 0 && mask == 0xff && G >= 256 && bid >= 128) { for (int j = bid - 128; j < 3 * WT_WBO; j += G - 128) job_wt(p, 1, WT_EARLY + j, lds); }
        Order S; S.setup(8192, 1024, 0, p.wid); pg8::Gemm g{(const bf16_t*)(ws + OFF_HB), (const bf16_t*)(ws + OFF_WOUT), 8192, 1024, 1024};
        EpiOut E{p.out, l == 0 ? p.in[I_XP] : p.out, l == 0 ? p.in[I_XS] : p.out + (size_t)4096 * 1024, (const float*)(ws + OFF_ADA) + l * 5 * 3072};
        pg8::gemm_phase<EpiOut, Order>(lds, g, S, E, nullptr);
    }
}
__global__ __launch_bounds__(512, 2) void mega(KParams kp, int ph0, int ph1) {
    extern __shared__ __attribute__((aligned(16))) unsigned char shm[];
    lds_t lds = (lds_t)shm;
    if (threadIdx.x < N_IN) ((const float**)(kp.ws + OFF_TBL))[threadIdx.x] = kp.in[threadIdx.x];
    const int wid0 = __builtin_amdgcn_readfirstlane((int)threadIdx.x >> 6);
    volatile LAS unsigned* xst = (volatile LAS unsigned*)(lds + DYN_LDS - 16);
    if (threadIdx.x == 0) { xst[0] = 0u; xst[1] = 0u; }
    __threadfence(); __syncthreads();
    XcdBarrier xb = xcd_barrier_post((unsigned*)(kp.ws + OFF_BAR), xst);
    xb.wid = wid0;
    if (ph0 > ph1) cg::this_grid().sync();
    for (int ph = ph0; ph < ph1; ++ph) {
        Params p; p.wid = wid0; { const float* const* tb = (const float* const*)(kp.ws + OFF_TBL); float* o = kp.out; unsigned char* w = kp.ws; asm volatile("" : "+s"(tb), "+s"(o), "+s"(w)); p.in = tb; p.out = o; p.ws = w; }
        int nrep = 1;
#ifdef REPEAT_S
        if ((REPEAT_S == 7 && ph == 0) || (ph > 0 && (ph - 1) % 7 == REPEAT_S && (REPEAT_S != 6 || ph < 8))) nrep = 2;
#endif
        for (int rep = 0; rep < nrep; ++rep) { if (rep) xcd_barrier(xb); run_phase(p, ph, lds, rep ? REPEAT_MASK : 0xff); }
        if (ph + 1 < ph1) xcd_barrier(xb);
    }
}

#ifndef N_LAUNCH_MODE
#define N_LAUNCH_MODE 1
#endif
extern "C" void kernel_launch(void* const* d_in, const int* in_sizes, int n_in, void* d_out, int out_size, void* d_ws, size_t ws_size, hipStream_t stream) {
    static int grid = 0;
    if (grid == 0) {
        if (n_in != N_IN || ws_size < WS_END) { fprintf(stderr, "kernel_launch: unexpected n_in %d / ws %zu (need %zu)\n", n_in, ws_size, (size_t)WS_END); grid = -1; return; }
        int dev = 0, cus = 0, per_cu = 0;
        hipGetDevice(&dev); hipDeviceGetAttribute(&cus, hipDeviceAttributeMultiprocessorCount, dev);
        hipFuncSetAttribute((const void*)mega, hipFuncAttributeMaxDynamicSharedMemorySize, DYN_LDS);
        hipOccupancyMaxActiveBlocksPerMultiprocessor(&per_cu, (const void*)mega, 512, DYN_LDS);
        if (per_cu < 1) { fprintf(stderr, "kernel_launch: occupancy query says %d blocks per CU\n", per_cu); per_cu = 1; }
        (void)hipGetLastError();
        grid = cus;
    }
    if (grid < 0) return;
    hipMemsetAsync((char*)d_ws + OFF_BAR, 0, 16384, stream);
    KParams p{};
    for (int i = 0; i < N_IN; ++i) p.in[i] = (const float*)d_in[i];
    p.out = (float*)d_out; p.ws = (unsigned char*)d_ws;
#if N_LAUNCH_MODE == 0
    for (int ph = 0; ph < N_PHASES; ++ph) { hipLaunchKernelGGL(mega, dim3(grid), dim3(512), DYN_LDS, stream, p, ph, ph + 1); }
#else
    int ph0 = 0, ph1 = N_PHASES; void* args[] = {&p, &ph0, &ph1};
    hipError_t e = hipLaunchCooperativeKernel((const void*)mega, dim3(grid), dim3(512), args, DYN_LDS, stream);
    if (e != hipSuccess) fprintf(stderr, "cooperative launch failed: %s (grid %d)\n", hipGetErrorString(e), grid);
#endif
}
```

```cpp
#include <hip/hip_runtime.h>
#include <hip/hip_cooperative_groups.h>
#include <cstdio>
namespace cg = cooperative_groups;
namespace pg8 {
#define PG8_LAS __attribute__((address_space(3)))
typedef unsigned short bf16_t;
typedef short bf16x8 __attribute__((ext_vector_type(8)));
typedef float f32x4 __attribute__((ext_vector_type(4)));
typedef unsigned u32x4 __attribute__((ext_vector_type(4)));
constexpr int BM = 256, BK = 64, HALF = 128, HTB = HALF * BK * 2  , STAGE_BYTES = 8 * HTB, NXCD = 8, WGM = 8;

__host__ __device__ __forceinline__ int lds_byte(int r, int c) { const int st = (r >> 4) * 2 + (c >> 5), rr = r & 15, cc = c & 31, ob = rr * 64 + cc * 2; return st * 1024 + (ob ^ (((ob >> 9) & 1) << 5)); }
__host__ __device__ __forceinline__ void stage_rc(int b, int& R, int& C) { const int st = b / 1024, sb = b % 1024, swz = sb ^ (((sb >> 9) & 1) << 5); R = (st >> 1) * 16 + swz / 64; C = (st & 1) * 32 + (swz % 64) / 2; }
__host__ __device__ __forceinline__ int perm32(int rho) { const int n = rho >> 4, i = rho & 15; return 8 * (i >> 2) + 4 * n + (i & 3); }

struct Unit { int pm, pn; };
struct Gemm { const bf16_t* A; const bf16_t* Bt; int M, N, K; };

struct StaticOrder {
    int nM, nN, nwg, G, c;
    __host__ __device__ void init(int M, int N, int G_, int c_) { nM = M / BM; nN = N / BM; nwg = nM * nN; G = G_; c = c_; }
    __host__ __device__ bool next(int i, Unit& u) const {
        const long L = (long)i * G + c; if (L >= nwg) return false;
        int wgid = (int)L; { const int q = nwg / NXCD, r = nwg % NXCD, xcd = wgid % NXCD, off = wgid / NXCD; wgid = (xcd < r ? xcd * (q + 1) : r * (q + 1) + (xcd - r) * q) + off; }
        const int nig = WGM * nN, gid = wgid / nig, fm = gid * WGM, gsz = (nM - fm) < WGM ? (nM - fm) : WGM;
        u.pm = fm + ((wgid % nig) % gsz); u.pn = (wgid % nig) / gsz; return true;
    }
    __device__ __forceinline__ void a_ready(const Unit&) const {}
    __device__ __forceinline__ void done(const Unit&) const {}
};
__device__ __forceinline__ unsigned cvt_pk_bf16(float lo, float hi) { unsigned r; asm volatile("v_cvt_pk_bf16_f32 %0, %1, %2" : "=v"(r) : "v"(lo), "v"(hi)); return r; }
typedef float f32x2 __attribute__((ext_vector_type(2)));
template <class Epi, class Sched, bool STAMP = false>
__device__ __forceinline__ void gemm_phase(PG8_LAS unsigned char* lds, const Gemm g, const Sched& S, const Epi& E, unsigned long long* stamps) {
    int tid_ = (S.wid << 6) | (int)__builtin_amdgcn_mbcnt_hi(~0u, __builtin_amdgcn_mbcnt_lo(~0u, 0u)); asm volatile("" : "+v"(tid_)); const int tid = tid_, wid = __builtin_amdgcn_readfirstlane(tid >> 6), lane = tid & 63, wr = wid >> 2, wc = wid & 3, fr = lane & 15, fq = lane >> 4;
    int K_ = g.K; asm volatile("" : "+s"(K_)); const int K = K_, nt = K / BK;
    int ts_lo = 0, ts_hi = 0, nts = 0; const unsigned long long rt_entry = STAMP ? (unsigned long long)wall_clock64() : 0ull;
#define PG8_STAMP() do { if (STAMP && wid == 0 && nts < 64) { const unsigned long long _c = (unsigned long long)clock64(); \
        ts_lo = (lane == nts) ? (int)(unsigned)_c : ts_lo; ts_hi = (lane == nts) ? (int)(unsigned)(_c >> 32) : ts_hi; ++nts; } } while (0)
    PG8_STAMP();
    unsigned voffA[2], voffB[2];
#pragma unroll
    for (int i = 0; i < 2; ++i) { int R, C; stage_rc(tid * 16 + i * 8192, R, C); const int Rb = Epi::PERM ? ((R & ~31) + perm32(R & 31)) : R;
        voffA[i] = (unsigned)(R * K + C) * 2u; voffB[i] = (unsigned)(Rb * K + C) * 2u; }
    const size_t kstep = (size_t)(BK * 2);
    const size_t hstep = (size_t)HALF * K * 2;
    const size_t tstep = 2 * hstep;
    const unsigned ldsw = (unsigned)wid * 1024u;
    const int aoff = lds_byte(wr * 64 + fr, fq * 8), boff = lds_byte(wc * 32 + fr, fq * 8);
#define PG8_SA(b, h) (((b) * 2 + (h)) * HTB)
#define PG8_SB(b, h) ((4 + (b) * 2 + (h)) * HTB)
#define PG8_STAGE(bufoff, gbase, voff) do { _Pragma("unroll") for (int _i = 0; _i < 2; ++_i) \
        __builtin_amdgcn_global_load_lds((const unsigned*)((const char*)(gbase) + (voff)[_i]), (PG8_LAS unsigned*)(lds + (bufoff) + ldsw + _i * 8192), 16, 0, 0); } while (0)
#define PG8_LDA(dst, b, h) do { _Pragma("unroll") for (int m = 0; m < 4; ++m) _Pragma("unroll") for (int k = 0; k < 2; ++k) dst[m][k] = *(const PG8_LAS bf16x8*)(lds + PG8_SA(b, h) + aoff + m * 2048 + k * 1024); } while (0)
#define PG8_LDB(dst, b, h) do { _Pragma("unroll") for (int n = 0; n < 2; ++n) _Pragma("unroll") for (int k = 0; k < 2; ++k) dst[n][k] = *(const PG8_LAS bf16x8*)(lds + PG8_SB(b, h) + boff + n * 2048 + k * 1024); } while (0)
#define PG8_MMA(ai, bj, At, Bt) do { __builtin_amdgcn_s_setprio(1); _Pragma("unroll") for (int m = 0; m < 4; ++m) _Pragma("unroll") for (int n = 0; n < 2; ++n) _Pragma("unroll") for (int k = 0; k < 2; ++k) \
        acc[ai][bj][m][n] = __builtin_amdgcn_mfma_f32_16x16x32_bf16(Bt[n][k], At[m][k], acc[ai][bj][m][n], 0, 0, 0); __builtin_amdgcn_s_setprio(0); } while (0)
#define PG8_WAIT_V(n) asm volatile("s_waitcnt vmcnt(" #n ")" ::: "memory")
#define PG8_WAIT_L(n) asm volatile("s_waitcnt lgkmcnt(" #n ")" ::: "memory")
#define PG8_BAR __builtin_amdgcn_s_barrier()
#define PG8_SCHED __builtin_amdgcn_sched_barrier(0)
    Unit cur, nxt; int ui = 0;
    if (!S.next(0, cur)) return;
    f32x4 acc[2][2][4][2];
#pragma unroll
    for (int a = 0; a < 2; ++a)
#pragma unroll
        for (int b = 0; b < 2; ++b)
#pragma unroll
            for (int m = 0; m < 4; ++m)
#pragma unroll
                for (int n = 0; n < 2; ++n) acc[a][b][m][n] = (f32x4){0.f, 0.f, 0.f, 0.f};
    bf16x8 At[4][2], B0[2][2], B1[2][2];
    const char* cA = (const char*)g.A + (size_t)cur.pm * tstep; const char* cB = (const char*)g.Bt + (size_t)cur.pn * tstep;
    S.a_ready(cur);
    PG8_STAGE(PG8_SB(0, 0), cB, voffB); PG8_STAGE(PG8_SA(0, 0), cA, voffA); PG8_STAGE(PG8_SB(0, 1), cB + hstep, voffB); PG8_STAGE(PG8_SA(0, 1), cA + hstep, voffA);
    if (wr == 1) PG8_BAR;
    PG8_WAIT_V(4); PG8_BAR;
    PG8_STAGE(PG8_SB(1, 0), cB + kstep, voffB); PG8_STAGE(PG8_SA(1, 0), cA + kstep, voffA); PG8_STAGE(PG8_SB(1, 1), cB + hstep + kstep, voffB);
    PG8_WAIT_V(6); PG8_BAR;
    PG8_STAMP();
    for (;;) {
        const bool has_next = S.next(ui + 1, nxt);
        const char* nA = has_next ? (const char*)g.A + (size_t)nxt.pm * tstep : cA; const char* nB = has_next ? (const char*)g.Bt + (size_t)nxt.pn * tstep : cB;
        for (int t = 0; t < nt; t += 2) {
            const bool last = (t == nt - 2);
            const char* a1 = cA + (size_t)(t + 1) * kstep;
            const char* a2 = last ? nA : cA + (size_t)(t + 2) * kstep; const char* b2 = last ? nB : cB + (size_t)(t + 2) * kstep;
            const char* a3 = a2 + kstep; const char* b3 = b2 + kstep;
            if (last && has_next) S.a_ready(nxt);
            PG8_LDB(B0, 0, 0); PG8_SCHED; PG8_LDA(At, 0, 0); PG8_STAGE(PG8_SA(1, 1), a1 + hstep, voffA);
            PG8_WAIT_L(8); PG8_BAR; PG8_WAIT_L(0); PG8_MMA(0, 0, At, B0); PG8_BAR; PG8_SCHED;
            PG8_LDB(B1, 0, 1); PG8_STAGE(PG8_SB(0, 0), b2, voffB);
            PG8_BAR; PG8_WAIT_L(0); PG8_MMA(0, 1, At, B1); PG8_BAR;
            PG8_LDA(At, 0, 1); PG8_STAGE(PG8_SA(0, 0), a2, voffA);
            PG8_BAR; PG8_WAIT_L(0); PG8_MMA(1, 0, At, B0); PG8_BAR; PG8_SCHED;
            PG8_STAGE(PG8_SB(0, 1), b2 + hstep, voffB);
            PG8_WAIT_V(6); PG8_BAR; PG8_MMA(1, 1, At, B1); PG8_BAR;
            PG8_LDB(B0, 1, 0); PG8_SCHED; PG8_LDA(At, 1, 0); PG8_STAGE(PG8_SA(0, 1), a2 + hstep, voffA);
            PG8_WAIT_L(8); PG8_BAR; PG8_WAIT_L(0); PG8_MMA(0, 0, At, B0); PG8_BAR; PG8_SCHED;
            PG8_LDB(B1, 1, 1); PG8_STAGE(PG8_SB(1, 0), b3, voffB);
            PG8_BAR; PG8_WAIT_L(0); PG8_MMA(0, 1, At, B1); PG8_BAR;
            PG8_LDA(At, 1, 1); PG8_STAGE(PG8_SA(1, 0), a3, voffA);
            PG8_BAR; PG8_WAIT_L(0); PG8_MMA(1, 0, At, B0); PG8_BAR; PG8_SCHED;
            PG8_STAGE(PG8_SB(1, 1), b3 + hstep, voffB);
            PG8_WAIT_V(6); PG8_BAR; PG8_MMA(1, 1, At, B1); PG8_BAR;
        }
        PG8_STAMP();
        if constexpr (!Epi::AFTER_DRAIN) { E(acc, cur, wr, wc, fr, fq); S.done(cur); }
        PG8_STAMP();
        if (!has_next) break;
#pragma unroll
        for (int a = 0; a < 2; ++a)
#pragma unroll
            for (int b = 0; b < 2; ++b)
#pragma unroll
                for (int m = 0; m < 4; ++m)
#pragma unroll
                    for (int n = 0; n < 2; ++n) acc[a][b][m][n] = (f32x4){0.f, 0.f, 0.f, 0.f};
        cur = nxt; cA = nA; cB = nB; ++ui;
    }
    PG8_WAIT_V(0);
    if (wr == 0) PG8_BAR;
    PG8_BAR;
    if constexpr (Epi::AFTER_DRAIN) { E.fused(acc, cur, wr, wc, fr, fq, lds, wid, lane); S.done(cur); }
    PG8_STAMP();
    if (STAMP && wid == 0) { stamps[lane] = lane < nts ? (((unsigned long long)(unsigned)ts_hi << 32) | (unsigned)ts_lo) : 0ull;
        if (lane == 62) stamps[62] = rt_entry; if (lane == 63) stamps[63] = (unsigned long long)wall_clock64(); }
#undef PG8_STAMP
#undef PG8_SA
#undef PG8_SB
#undef PG8_STAGE
#undef PG8_LDA
#undef PG8_LDB
#undef PG8_MMA
#undef PG8_WAIT_V
#undef PG8_WAIT_L
#undef PG8_BAR
#undef PG8_SCHED
}
}
using pg8::bf16_t; using pg8::bf16x8; using pg8::f32x4; using pg8::u32x4; using pg8::Unit;
#define LAS __attribute__((address_space(3)))
typedef unsigned u32x2 __attribute__((ext_vector_type(2)));
typedef LAS unsigned char* lds_t;
struct Params;
__device__ __forceinline__ int lane_id_() { return (int)__builtin_amdgcn_mbcnt_hi(~0u, __builtin_amdgcn_mbcnt_lo(~0u, 0u)); }
typedef float f32x2_t __attribute__((ext_vector_type(2)));

enum { I_XP = 0, I_XS, I_C, I_CCTX, I_CKV, I_CKR, I_SGLA, I_SS5, I_NORMW, I_WADA, I_BADA, I_WIN, I_WA2, I_BA, I_ONORM, I_QNORM, I_WUQ, I_KVNORM, I_WUK, I_WUV,
       I_QHNORM, I_KHNORM, I_ARE, I_AIM, I_LOGDT, I_BRE, I_BIM, I_CRE, I_CIM, I_S5D, I_WGLU, I_BGLU, I_WBOG, I_WBOM, I_WBOS, I_WOUT, N_IN };
struct KParams { const float* in[N_IN]; float* out; unsigned char* ws; };
struct Params { const float* const* in; float* out; unsigned char* ws; int wid; };
__device__ __forceinline__ int tid_opaque(const Params& p) { int t = (p.wid << 6) | lane_id_(); asm volatile("" : "+v"(t)); return t; }

constexpr int LDZ = 6912;
constexpr int ZQ = 0, ZK = 256, ZV = 512, ZGA = 1024, ZGG = 1056, ZMQ = 1568, ZMKV = 1952, ZMKR = 2208, ZMG = 2240, ZSU = 2752, ZSG = 3264, ZMERGE = 3776;
constexpr size_t OUT_YP = 0, OUT_CKV = 8388608, OUT_KR = 10485760, OUT_GLA = 10747904, OUT_S5 = 12845056;
constexpr size_t OFF_WIN = 0;

constexpr size_t OFF_WUQ = OFF_WIN + 14155776;
constexpr size_t OFF_WKV = OFF_WUQ + 393216;
constexpr size_t OFF_WGLU = OFF_WKV + 393216;
constexpr size_t OFF_WBO = OFF_WGLU + 1048576;
constexpr size_t OFF_WOUT = OFF_WBO + 3145728;
constexpr size_t OFF_S5M = OFF_WOUT + 2097152;
constexpr size_t OFF_V = OFF_S5M;
constexpr size_t OFF_P16 = OFF_S5M + 12582912;
constexpr size_t OFF_ADA = OFF_P16 + 32768;
constexpr size_t OFF_ROPE = OFF_ADA + 122880;
constexpr size_t OFF_CTX0 = OFF_ROPE + 131072;
constexpr size_t OFF_CKVN = OFF_CTX0 + 1048576;
constexpr size_t OFF_CTX1 = OFF_CKVN + 4194304;
constexpr size_t OFF_HB = OFF_CTX1 + 1048576;
constexpr size_t OFF_Z = OFF_HB + 16777216;
constexpr size_t OFF_KV = OFF_Z + 113246208;
constexpr size_t OFF_AGLA = OFF_KV, OFF_AMLA = OFF_KV + 8388608;
constexpr size_t OFF_QD = OFF_KV + 16777216;
constexpr size_t OFF_OIB = OFF_QD + 8388608;
constexpr size_t OFF_DEC = OFF_KV + 33554432;
constexpr size_t OFF_ST = OFF_DEC + 262144;
constexpr size_t OFF_AQ = OFF_ST + 16777216;
constexpr size_t OFF_QRAW = OFF_AQ + 6291456;
constexpr size_t OFF_AS5 = OFF_QRAW + 6291456;
constexpr size_t OFF_YG = OFF_AS5 + 8388608;
constexpr size_t OFF_TBL = OFF_YG + 8388608;
constexpr size_t OFF_BAR = OFF_TBL + 512;
constexpr size_t OFF_KF = OFF_BAR + 16384;
constexpr size_t WS_END = OFF_KF + 7864320;
constexpr int DYN_LDS = 147456;

__device__ __forceinline__ float bf2f(bf16_t b) { return __uint_as_float(((unsigned)b) << 16); }
__device__ __forceinline__ bf16_t f2bf(float f) { unsigned u = __float_as_uint(f); u += 0x7FFFu + ((u >> 16) & 1u); return (bf16_t)(u >> 16); }
__device__ __forceinline__ unsigned pk2(float lo, float hi) { return pg8::cvt_pk_bf16(lo, hi); }
__device__ __forceinline__ float lo16(unsigned w) { return __uint_as_float(w << 16); }
__device__ __forceinline__ float hi16(unsigned w) { return __uint_as_float(w & 0xffff0000u); }
__device__ __forceinline__ float sigmoidf_(float x) { return 1.f / (1.f + __expf(-x)); }
__device__ __forceinline__ float siluf_(float x) { return x / (1.f + __expf(-x)); }
__device__ __forceinline__ void store8(bf16_t* p, const f32x4& a, const f32x4& b) { u32x4 w; w.x = pk2(a[0], a[1]); w.y = pk2(a[2], a[3]); w.z = pk2(b[0], b[1]); w.w = pk2(b[2], b[3]); *(u32x4*)p = w; }
#define MFMA16(a, b, c) __builtin_amdgcn_mfma_f32_16x16x32_bf16(a, b, c, 0, 0, 0)
#define LDSFRAG(ptr) (*(const LAS bf16x8*)(ptr))

struct Order : pg8::StaticOrder { int wid;
    __device__ void setup(int M, int N, int rot, int wid_) { wid = wid_; const int G = (int)gridDim.x; init(M, N, G, (int)((blockIdx.x + (unsigned)rot) % (unsigned)G)); }
};

struct EpiZ { static constexpr bool PERM = true, AFTER_DRAIN = false; bf16_t* Z;
    __device__ __forceinline__ void operator()(const f32x4 (&acc)[2][2][4][2], const Unit& u, int wr, int wc, int fr_, int fq_) const {
        int fr = fr_, fq = fq_; asm volatile("" : "+v"(fr), "+v"(fq));
        const int row0 = u.pm * 256 + wr * 64 + fr, col0 = u.pn * 256 + wc * 32 + 8 * fq;
#pragma unroll
        for (int ai = 0; ai < 2; ++ai)
#pragma unroll
            for (int m = 0; m < 4; ++m) { bf16_t* rp = Z + (size_t)(row0 + ai * 128 + m * 16) * LDZ + col0;
#pragma unroll
                for (int bj = 0; bj < 2; ++bj) store8(rp + bj * 128, acc[ai][bj][m][0], acc[ai][bj][m][1]); }
    } };
struct EpiQ { static constexpr bool PERM = true, AFTER_DRAIN = false; bf16_t* Q;
    __device__ __forceinline__ void operator()(const f32x4 (&acc)[2][2][4][2], const Unit& u, int wr, int wc, int fr_, int fq_) const {
        int fr = fr_, fq = fq_; asm volatile("" : "+v"(fr), "+v"(fq));
        const int row0 = u.pm * 256 + wr * 64 + fr, col0 = u.pn * 256 + wc * 32 + 8 * fq;
#pragma unroll
        for (int ai = 0; ai < 2; ++ai)
#pragma unroll
            for (int m = 0; m < 4; ++m) { bf16_t* rp = Q + (size_t)(row0 + ai * 128 + m * 16) * 384 + col0;
#pragma unroll
                for (int bj = 0; bj < 2; ++bj) if (col0 + bj * 128 < 384) store8(rp + bj * 128, acc[ai][bj][m][0], acc[ai][bj][m][1]);
                }
    } };
struct EpiKV { static constexpr bool PERM = true, AFTER_DRAIN = true; bf16_t* KF; bf16_t* V; int layer; const bf16_t* Z; const float* ckr; const float* khn; const float* R;
    __device__ __forceinline__ void fused(f32x4 (&acc)[2][2][4][2], const Unit& u, int wr, int wc, int fr_, int fq_, LAS unsigned char* lds, int wid, int lane_) const {
        if (u.pn == 0) { (*this)(acc, u, wr, wc, fr_, fq_); return; }
        int fr = fr_, fq = fq_, lane = lane_; asm volatile("" : "+v"(fr), "+v"(fq), "+v"(lane));
        LAS bf16_t* T = (LAS bf16_t*)lds;
#pragma unroll
        for (int ai = 0; ai < 2; ++ai)
#pragma unroll
            for (int m = 0; m < 4; ++m) { const int kl = ai * 128 + wr * 64 + m * 16 + fr;
#pragma unroll
                for (int bj = 0; bj < 2; ++bj) { const int el = bj * 128 + wc * 32 + 8 * fq;
#pragma unroll
                    for (int i = 0; i < 8; i += 2) { const unsigned w = pk2(acc[ai][bj][m][i >> 2][i & 3], acc[ai][bj][m][i >> 2][(i & 3) + 1]); T[(el + i) * 264 + kl] = (bf16_t)(w & 0xffffu); T[(el + i + 1) * 264 + kl] = (bf16_t)(w >> 16); } } }
        __syncthreads();
        int rb = u.pm * 256; if (layer == 0) rb = rb < 2048 ? 8192 + rb : rb - 2048;
        bf16_t* bp; int st;
        if (rb < 4096) { bp = V + (size_t)(rb >> 8) * 4 * 128 * 256; st = 256; }
        else if (rb < 8192) { bp = V + 2097152 + (size_t)((rb - 4096) >> 10) * 4 * 128 * 1536 + 512 + ((rb - 4096) & 1023); st = 1536; }
        else { bp = V + 2097152 + (size_t)((rb - 8192) >> 9) * 4 * 128 * 1536 + ((rb - 8192) & 511); st = 1536; }
        const int tid = wid * 64 + lane;
#pragma unroll
        for (int i = 0; i < 16; ++i) { const int idx = tid + 512 * i, el = idx >> 5, part = idx & 31;
            *(u32x4*)(bp + (size_t)((u.pn - 1) * 256 + el) * st + part * 8) = *(const LAS u32x4*)(T + el * 264 + part * 8); }
        __syncthreads();
    }
    __device__ __forceinline__ void operator()(const f32x4 (&acc)[2][2][4][2], const Unit& u, int wr, int wc, int fr_, int fq_) const {
        int fr = fr_, fq = fq_; asm volatile("" : "+v"(fr), "+v"(fq));
        int rb = u.pm * 256; if (layer == 0) rb = rb < 2048 ? 8192 + rb : rb - 2048;
        const int row0 = rb + wr * 64 + fr;
        float w1[4], w2[4];
#pragma unroll
        for (int i = 0; i < 4; ++i) { w1[i] = khn[64 + 4 * fq + i]; w2[i] = khn[80 + 4 * fq + i]; }
#pragma unroll
        for (int ai = 0; ai < 2; ++ai)
#pragma unroll
          for (int mh = 0; mh < 4; mh += 1) {
            float x1[4][4], x2[4][4], cs[4][4], sn[4][4];
#pragma unroll
            for (int m = mh; m < mh + 1; ++m) { const int r = row0 + ai * 128 + m * 16;
                if (r >= 8192) { const int j = r - 8192; const float* kr = ckr + ((size_t)(((j >> 9) * 2 + layer) * 512 + (j & 511))) * 32 + 4 * fq;
                    const f32x4 a = *(const f32x4*)kr, b = *(const f32x4*)(kr + 16);
#pragma unroll
                    for (int i = 0; i < 4; ++i) { x1[m][i] = a[i]; x2[m][i] = b[i]; } }
                else { const bf16_t* kr = Z + (size_t)r * LDZ + ZMKR + 4 * fq; const u32x2 a = *(const u32x2*)kr, b = *(const u32x2*)(kr + 16);
                    x1[m][0] = lo16(a.x); x1[m][1] = hi16(a.x); x1[m][2] = lo16(a.y); x1[m][3] = hi16(a.y); x2[m][0] = lo16(b.x); x2[m][1] = hi16(b.x); x2[m][2] = lo16(b.y); x2[m][3] = hi16(b.y); }
                const bool rot = r >= 4096 && r < 8192; const int pos = (r - 4096) & 1023;
                if (rot) { const f32x4 c = *(const f32x4*)(R + pos * 16 + 4 * fq), s_ = *(const f32x4*)(R + 16384 + pos * 16 + 4 * fq);
#pragma unroll
                    for (int i = 0; i < 4; ++i) { cs[m][i] = c[i]; sn[m][i] = s_[i]; } }
                else {
#pragma unroll
                    for (int i = 0; i < 4; ++i) { cs[m][i] = 1.f; sn[m][i] = 0.f; } } }
#pragma unroll
            for (int m = mh; m < mh + 1; ++m) { const int r = row0 + ai * 128 + m * 16;
                float ss = 0.f;
#pragma unroll
                for (int bj = 0; bj < 2; ++bj)
#pragma unroll
                    for (int i = 0; i < 8; ++i) { const float v = acc[ai][bj][m][i >> 2][i & 3]; ss += v * v; }
#pragma unroll
                for (int i = 0; i < 4; ++i) ss += x1[m][i] * x1[m][i] + x2[m][i] * x2[m][i];
                ss += __shfl_xor(ss, 16); ss += __shfl_xor(ss, 32);
                const float rstd = rsqrtf(ss * (1.f / 96.f) + 1e-6f);
                bf16_t* kp = KF + (size_t)r * 384 + wc * 96;
#pragma unroll
                for (int bj = 0; bj < 2; ++bj) { u32x4 w; const f32x4 v0 = acc[ai][bj][m][0], v1 = acc[ai][bj][m][1];
                    w.x = pk2(v0[0] * rstd, v0[1] * rstd); w.y = pk2(v0[2] * rstd, v0[3] * rstd);
                    w.z = pk2(v1[0] * rstd, v1[1] * rstd); w.w = pk2(v1[2] * rstd, v1[3] * rstd);
                    *(u32x4*)(kp + 32 * bj + 8 * fq) = w; }
                float o1[4], o2[4];
#pragma unroll
                for (int i = 0; i < 4; ++i) { const float a = x1[m][i] * rstd * w1[i], b = x2[m][i] * rstd * w2[i]; o1[i] = a * cs[m][i] - b * sn[m][i]; o2[i] = a * sn[m][i] + b * cs[m][i]; }
                *(u32x2*)(kp + 64 + 4 * fq) = (u32x2){pk2(o1[0], o1[1]), pk2(o1[2], o1[3])}; *(u32x2*)(kp + 80 + 4 * fq) = (u32x2){pk2(o2[0], o2[1]), pk2(o2[2], o2[3])}; }
            __builtin_amdgcn_sched_barrier(0); }
    } };
struct EpiGLU { static constexpr bool PERM = true, AFTER_DRAIN = false; bf16_t* O; const bf16_t* Z; const float* bias;
    __device__ __forceinline__ void operator()(const f32x4 (&acc)[2][2][4][2], const Unit& u, int wr, int wc, int fr_, int fq_) const {
        int fr = fr_, fq = fq_; asm volatile("" : "+v"(fr), "+v"(fq));
        const int row0 = u.pm * 256 + wr * 64 + fr, oc = u.pn * 128 + wc * 32 + 8 * fq;
#pragma unroll
        for (int ai = 0; ai < 2; ++ai) {
            float bv[8], bg[8];
            { const f32x4 b0 = *(const f32x4*)(bias + oc), b1 = *(const f32x4*)(bias + oc + 4), g0 = *(const f32x4*)(bias + 512 + oc), g1 = *(const f32x4*)(bias + 512 + oc + 4);
#pragma unroll
              for (int i = 0; i < 4; ++i) { bv[i] = b0[i]; bv[4 + i] = b1[i]; bg[i] = g0[i]; bg[4 + i] = g1[i]; } }
            u32x4 sgv[2][4];
#pragma unroll
            for (int m = 0; m < 4; ++m) sgv[ai][m] = *(const u32x4*)(Z + (size_t)(row0 + ai * 128 + m * 16) * LDZ + ZSG + oc);
#pragma unroll
            for (int m = 0; m < 4; ++m) { const size_t r = (size_t)(row0 + ai * 128 + m * 16);
                const u32x4 sg = sgv[ai][m];
                float g[8] = { lo16(sg.x), hi16(sg.x), lo16(sg.y), hi16(sg.y), lo16(sg.z), hi16(sg.z), lo16(sg.w), hi16(sg.w) };
                float o[8];
#pragma unroll
                for (int i = 0; i < 8; ++i) { const float zv = acc[ai][0][m][i >> 2][i & 3] + bv[i], zg = acc[ai][1][m][i >> 2][i & 3] + bg[i]; o[i] = zv * sigmoidf_(zg) * siluf_(g[i]); }
                u32x4 w; w.x = pk2(o[0], o[1]); w.y = pk2(o[2], o[3]); w.z = pk2(o[4], o[5]); w.w = pk2(o[6], o[7]);
                *(u32x4*)(O + r * 512 + oc) = w; }
            __builtin_amdgcn_sched_barrier(0); }
    } };
struct EpiBo { static constexpr bool PERM = true, AFTER_DRAIN = true; bf16_t* MIX; const bf16_t* Z; int branch;
    __device__ __forceinline__ void fused(f32x4 (&acc)[2][2][4][2], const Unit& u, int wr, int wc, int fr_, int fq_, LAS unsigned char* lds, int wid, int lane_) const {
        int fr = fr_, fq = fq_, lane = lane_; asm volatile("" : "+v"(fr), "+v"(fq), "+v"(lane));
        const int row0 = u.pm * 256 + wr * 64 + fr, col0 = u.pn * 256 + wc * 32 + 8 * fq;
        LAS unsigned char* wl = lds + wid * 16384;
#pragma unroll
        for (int ai = 0; ai < 2; ++ai)
#pragma unroll
            for (int m = 0; m < 4; ++m)
#pragma unroll
                for (int bj = 0; bj < 2; ++bj)
                    __builtin_amdgcn_global_load_lds((const unsigned*)(Z + (size_t)(row0 + ai * 128 + m * 16) * LDZ + ZMERGE + branch * 1024 + col0 + bj * 128), (LAS unsigned*)(wl + ((ai * 4 + m) * 2 + bj) * 1024), 16, 0, 0);
#pragma unroll
        for (int ai = 0; ai < 2; ++ai) {
            u32x4 pv[4][2];
#pragma unroll
            for (int m = 0; m < 4; ++m)
#pragma unroll
                for (int bj = 0; bj < 2; ++bj) pv[m][bj] = branch > 0 ? *(const u32x4*)(MIX + (size_t)(row0 + ai * 128 + m * 16) * 1024 + col0 + bj * 128) : (u32x4){0u, 0u, 0u, 0u};
            if (ai == 0) { asm volatile("s_waitcnt vmcnt(0)" ::: "memory"); __builtin_amdgcn_s_barrier(); asm volatile("" ::: "memory"); }
#pragma unroll
            for (int m = 0; m < 4; ++m) { const size_t r = (size_t)(row0 + ai * 128 + m * 16);
#pragma unroll
                for (int bj = 0; bj < 2; ++bj) { const u32x4 sg = *(const LAS u32x4*)(wl + ((ai * 4 + m) * 2 + bj) * 1024 + lane * 16), pp = pv[m][bj];
                    const float g[8] = { lo16(sg.x), hi16(sg.x), lo16(sg.y), hi16(sg.y), lo16(sg.z), hi16(sg.z), lo16(sg.w), hi16(sg.w) };
                    const float q[8] = { lo16(pp.x), hi16(pp.x), lo16(pp.y), hi16(pp.y), lo16(pp.z), hi16(pp.z), lo16(pp.w), hi16(pp.w) };
                    float o[8];
#pragma unroll
                    for (int i = 0; i < 8; ++i) o[i] = q[i] + sigmoidf_(g[i]) * acc[ai][bj][m][i >> 2][i & 3];
                    u32x4 w; w.x = pk2(o[0], o[1]); w.y = pk2(o[2], o[3]); w.z = pk2(o[4], o[5]); w.w = pk2(o[6], o[7]);
                    *(u32x4*)(MIX + r * 1024 + col0 + bj * 128) = w; } }
            __builtin_amdgcn_sched_barrier(0); }
        __syncthreads();
    }
    __device__ __forceinline__ void operator()(const f32x4 (&acc)[2][2][4][2], const Unit& u, int wr, int wc, int fr_, int fq_) const {
        int fr = fr_, fq = fq_; asm volatile("" : "+v"(fr), "+v"(fq));
        const int row0 = u.pm * 256 + wr * 64 + fr, col0 = u.pn * 256 + wc * 32 + 8 * fq;
#pragma unroll
        for (int ai = 0; ai < 2; ++ai)
#pragma unroll
          for (int mh = 0; mh < 4; mh += 2) {
            u32x4 gz[4][2], pv[4][2];
#pragma unroll
            for (int m = mh; m < mh + 2; ++m)
#pragma unroll
                for (int bj = 0; bj < 2; ++bj) { const size_t r = (size_t)(row0 + ai * 128 + m * 16);
                    gz[m][bj] = *(const u32x4*)(Z + r * LDZ + ZMERGE + branch * 1024 + col0 + bj * 128);
                    pv[m][bj] = branch > 0 ? *(const u32x4*)(MIX + r * 1024 + col0 + bj * 128) : (u32x4){0u, 0u, 0u, 0u}; }
#pragma unroll
            for (int m = mh; m < mh + 2; ++m) { const size_t r = (size_t)(row0 + ai * 128 + m * 16);
#pragma unroll
                for (int bj = 0; bj < 2; ++bj) { const u32x4 sg = gz[m][bj], pp = pv[m][bj];
                    const float g[8] = { lo16(sg.x), hi16(sg.x), lo16(sg.y), hi16(sg.y), lo16(sg.z), hi16(sg.z), lo16(sg.w), hi16(sg.w) };
                    const float q[8] = { lo16(pp.x), hi16(pp.x), lo16(pp.y), hi16(pp.y), lo16(pp.z), hi16(pp.z), lo16(pp.w), hi16(pp.w) };
                    float o[8];
#pragma unroll
                    for (int i = 0; i < 8; ++i) o[i] = q[i] + sigmoidf_(g[i]) * acc[ai][bj][m][i >> 2][i & 3];
                    u32x4 w; w.x = pk2(o[0], o[1]); w.y = pk2(o[2], o[3]); w.z = pk2(o[4], o[5]); w.w = pk2(o[6], o[7]);
                    *(u32x4*)(MIX + r * 1024 + col0 + bj * 128) = w; } }
            __builtin_amdgcn_sched_barrier(0); }
    } };
struct EpiOut { static constexpr bool PERM = false, AFTER_DRAIN = true; float* Y; const float* xp; const float* xs; const float* ada;
    __device__ __forceinline__ void fused(f32x4 (&acc)[2][2][4][2], const Unit& u, int wr, int wc, int fr_, int fq_, LAS unsigned char* lds, int wid, int lane_) const {
        int fr = fr_, fq = fq_, lane = lane_; asm volatile("" : "+v"(fr), "+v"(fq), "+v"(lane));
        const int row0 = u.pm * 256 + wr * 64 + fr, col0 = u.pn * 256 + wc * 32 + 4 * fq;
        LAS unsigned char* wl = lds + wid * 16384;
        const float* xb = (u.pm < 16 ? xp + (size_t)row0 * 1024 : xs + (size_t)(row0 - 4096) * 1024) + col0;
#pragma unroll
        for (int m = 0; m < 4; ++m)
#pragma unroll
            for (int bj = 0; bj < 2; ++bj)
#pragma unroll
                for (int n = 0; n < 2; ++n) __builtin_amdgcn_global_load_lds((const unsigned*)(xb + (size_t)(m * 16) * 1024 + bj * 128 + n * 16), (LAS unsigned*)(wl + ((m * 2 + bj) * 2 + n) * 1024), 16, 0, 0);
        f32x4 x1[4][2][2];
#pragma unroll
        for (int m = 0; m < 4; ++m)
#pragma unroll
            for (int bj = 0; bj < 2; ++bj)
#pragma unroll
                for (int n = 0; n < 2; ++n) x1[m][bj][n] = *(const f32x4*)(xb + (size_t)(128 + m * 16) * 1024 + bj * 128 + n * 16);
        const int ar = u.pm < 16 ? 0 : 1 + ((u.pm - 16) >> 2);
        const float* gp = ada + ar * 3072 + 2048;
        f32x4 gv[2][2];
#pragma unroll
        for (int bj = 0; bj < 2; ++bj)
#pragma unroll
            for (int n = 0; n < 2; ++n) gv[bj][n] = *(const f32x4*)(gp + col0 + bj * 128 + n * 16);
        asm volatile("s_waitcnt vmcnt(0)" ::: "memory"); __builtin_amdgcn_s_barrier(); asm volatile("" ::: "memory");
        float* yb = Y + (size_t)row0 * 1024 + col0;
#pragma unroll
        for (int m = 0; m < 4; ++m)
#pragma unroll
            for (int bj = 0; bj < 2; ++bj)
#pragma unroll
                for (int n = 0; n < 2; ++n) { const f32x4 xv = *(const LAS f32x4*)(wl + ((m * 2 + bj) * 2 + n) * 1024 + lane * 16);
                    *(f32x4*)(yb + (size_t)(m * 16) * 1024 + bj * 128 + n * 16) = xv + gv[bj][n] * acc[0][bj][m][n];
                    *(f32x4*)(yb + (size_t)(128 + m * 16) * 1024 + bj * 128 + n * 16) = x1[m][bj][n] + gv[bj][n] * acc[1][bj][m][n]; }
        __syncthreads();
    }
    __device__ __forceinline__ void operator()(const f32x4 (&acc)[2][2][4][2], const Unit& u, int wr, int wc, int fr_, int fq_) const {
        int fr = fr_, fq = fq_; asm volatile("" : "+v"(fr), "+v"(fq));
        const int row0 = u.pm * 256 + wr * 64 + fr, col0 = u.pn * 256 + wc * 32 + 4 * fq;
        const int ar = u.pm < 16 ? 0 : 1 + ((u.pm - 16) >> 2);
        const float* gp = ada + ar * 3072 + 2048;
        f32x4 gv[2][2];
#pragma unroll
        for (int bj = 0; bj < 2; ++bj)
#pragma unroll
            for (int n = 0; n < 2; ++n) gv[bj][n] = *(const f32x4*)(gp + col0 + bj * 128 + n * 16);
#pragma unroll
        for (int ai = 0; ai < 2; ++ai)
#pragma unroll
          for (int mh = 0; mh < 4; mh += 2) {
            f32x4 xv[4][2][2];
#pragma unroll
            for (int m = mh; m < mh + 2; ++m) { const int r = row0 + ai * 128 + m * 16;
                const float* xr = (r < 4096 ? xp + (size_t)r * 1024 : xs + (size_t)(r - 4096) * 1024) + col0;
#pragma unroll
                for (int bj = 0; bj < 2; ++bj)
#pragma unroll
                    for (int n = 0; n < 2; ++n) xv[m][bj][n] = *(const f32x4*)(xr + bj * 128 + n * 16); }
#pragma unroll
            for (int m = mh; m < mh + 2; ++m) { const int r = row0 + ai * 128 + m * 16;
                float* yr = Y + (size_t)r * 1024 + col0;
#pragma unroll
                for (int bj = 0; bj < 2; ++bj)
#pragma unroll
                    for (int n = 0; n < 2; ++n) *(f32x4*)(yr + bj * 128 + n * 16) = xv[m][bj][n] + gv[bj][n] * acc[ai][bj][m][n]; }
            __builtin_amdgcn_sched_barrier(0); }
    } };

__device__ __forceinline__ void job_ada(const Params& p, int j, lds_t lds) {
    LAS float* sc = (LAS float*)lds; LAS float* red = sc + 5 * 1024;
    const int l = j / 96, c0 = (j % 96) * 32, tid = tid_opaque(p);
    for (int i = tid; i < 5 * 1024; i += 512) { const int r = i >> 10, k = i & 1023; const float v = r == 0 ? p.in[I_CCTX][k] : p.in[I_C][(r - 1) * 1024 + k]; sc[i] = v / (1.f + expf(-v)); }
    __syncthreads();
    const int col = tid & 31, kg = tid >> 5; const float* W = p.in[I_WADA] + (size_t)l * 1024 * 3072 + (size_t)(kg * 64) * 3072 + c0 + col;
    float a0 = 0.f, a1 = 0.f, a2 = 0.f, a3 = 0.f, a4 = 0.f;
#pragma unroll 1
    for (int kb = 0; kb < 64; kb += 16) { float w[16];
#pragma unroll
        for (int i = 0; i < 16; ++i) w[i] = W[(size_t)(kb + i) * 3072];
#pragma unroll
        for (int i = 0; i < 16; ++i) { const int k = kg * 64 + kb + i; a0 += sc[k] * w[i]; a1 += sc[1024 + k] * w[i]; a2 += sc[2048 + k] * w[i]; a3 += sc[3072 + k] * w[i]; a4 += sc[4096 + k] * w[i]; } }
    red[(kg * 5 + 0) * 32 + col] = a0; red[(kg * 5 + 1) * 32 + col] = a1; red[(kg * 5 + 2) * 32 + col] = a2; red[(kg * 5 + 3) * 32 + col] = a3; red[(kg * 5 + 4) * 32 + col] = a4;
    __syncthreads();
    if (tid < 160) { const int r = tid >> 5, cc = tid & 31; float s = p.in[I_BADA][l * 3072 + c0 + cc];
        for (int g = 0; g < 16; ++g) s += red[(g * 5 + r) * 32 + cc];
        ((float*)(p.ws + OFF_ADA))[(l * 5 + r) * 3072 + c0 + cc] = s; }
    __syncthreads();
}
__device__ __forceinline__ void job_ctx(const Params& p, int j) {
    const int base = j * 4096 + tid_opaque(p) * 8; const int l = base / (2048 * 256), rem = base % (2048 * 256), row = rem >> 8, c = rem & 255, b = row >> 9, jj = row & 511;
    const float* s = p.in[I_CKV] + ((size_t)((b * 2 + l) * 512 + jj)) * 256 + c;
    const f32x4 v0 = *(const f32x4*)s, v1 = *(const f32x4*)(s + 4);
    bf16_t* d = (bf16_t*)(p.ws + (l == 0 ? OFF_CTX0 : OFF_CTX1)) + (size_t)row * 256 + c;
    store8(d, v0, v1);
}
__device__ __forceinline__ void job_rope(const Params& p, int j) {
    const int idx = j * 512 + tid_opaque(p), pos = idx >> 4, i = idx & 15, f = i & 7;
    const float inv = powf(10000.f, -(float)f / 8.f); const float ang = (float)(i < 8 ? (pos >> 6) : (pos & 63)) * inv;
    float* R = (float*)(p.ws + OFF_ROPE); R[idx] = cosf(ang); R[16384 + idx] = sinf(ang);
}

__device__ __forceinline__ void job_prep(const Params& p, int l, int j) {
    const int tid = tid_opaque(p), wid = tid >> 6, lane = tid & 63;
    const float* nw = p.in[I_NORMW] + l * 1024;
    f32x4 v[4][4]; float ss[4];
#pragma unroll
    for (int q = 0; q < 4; ++q) { const int row = j * 32 + wid * 4 + q;
        const float* x = l == 0 ? (row < 4096 ? p.in[I_XP] + (size_t)row * 1024 : p.in[I_XS] + (size_t)(row - 4096) * 1024) : p.out + (size_t)row * 1024;
#pragma unroll
        for (int i = 0; i < 4; ++i) v[q][i] = *(const f32x4*)(x + i * 256 + lane * 4); }
#pragma unroll
    for (int q = 0; q < 4; ++q) { float s_ = 0.f;
#pragma unroll
        for (int i = 0; i < 4; ++i) s_ += v[q][i][0] * v[q][i][0] + v[q][i][1] * v[q][i][1] + v[q][i][2] * v[q][i][2] + v[q][i][3] * v[q][i][3];
#pragma unroll
        for (int o = 1; o < 64; o <<= 1) s_ += __shfl_xor(s_, o);
        ss[q] = s_; }
#pragma unroll
    for (int q = 0; q < 4; ++q) { const int row = j * 32 + wid * 4 + q; const int ar = row < 4096 ? 0 : 1 + ((row - 4096) >> 10);
        const float* ada = (const float*)(p.ws + OFF_ADA) + (l * 5 + ar) * 3072;
        const float rstd = rsqrtf(ss[q] * (1.f / 1024.f) + 1e-6f);
        bf16_t* h = (bf16_t*)(p.ws + OFF_HB) + (size_t)row * 1024;
#pragma unroll
        for (int i = 0; i < 4; ++i) { const int c = i * 256 + lane * 4; const f32x4 w = *(const f32x4*)(nw + c), sh = *(const f32x4*)(ada + c), sc = *(const f32x4*)(ada + 1024 + c);
            float o[4];
#pragma unroll
            for (int k = 0; k < 4; ++k) o[k] = v[q][i][k] * rstd * w[k] * (1.f + sc[k]) + sh[k];
            u32x2 pk; pk.x = pk2(o[0], o[1]); pk.y = pk2(o[2], o[3]); *(u32x2*)(h + c) = pk; } }
}
__device__ __forceinline__ void wt_tile(const Params& p, const float* src, int ldsrc, int sbase, int nvalid, int mode, bf16_t* dst, int K, int n0, int k0, lds_t lds) {
    LAS float* t = (LAS float*)lds; const int tid = tid_opaque(p);
    const int nn = tid & 255, kh = tid >> 8; const int sc = mode == 0 ? sbase + nn : mode == 1 ? ((nn >> 7) & 1) * 512 + sbase + (nn & 127) : ((nn >> 5) & 3) * 64 + (nn >> 7) * 32 + (nn & 31); const bool ok = mode != 0 || nn < nvalid;
    float v[32];
#pragma unroll
    for (int i = 0; i < 32; ++i) v[i] = ok ? src[(size_t)(k0 + 2 * i + kh) * ldsrc + sc] : 0.f;
#pragma unroll
    for (int i = 0; i < 32; ++i) t[(2 * i + kh) * 257 + nn] = v[i];
    __syncthreads();
#pragma unroll
    for (int ps = 0; ps < 4; ++ps) { const int n = ps * 64 + (tid >> 3), kc = tid & 7; const LAS float* s = t + (kc * 8) * 257 + n; u32x4 w;
        w.x = pk2(s[0], s[257]); w.y = pk2(s[514], s[771]); w.z = pk2(s[1028], s[1285]); w.w = pk2(s[1542], s[1799]);
        *(u32x4*)(dst + (size_t)(n0 + n) * K + k0 + kc * 8) = w; }
    __syncthreads();
}
constexpr int WT_WIN = 27 * 16, WT_WUQ = 2 * 6, WT_WKV = 3 * 4, WT_WGLU = 4 * 8, WT_WBO = 4 * 8, WT_WOUT = 4 * 16, WT_EARLY = WT_WIN + WT_WUQ + WT_WKV + WT_WGLU, WT_TOTAL = WT_EARLY + 3 * WT_WBO + WT_WOUT;
__device__ __forceinline__ void job_wt(const Params& p, int l, int t, lds_t lds) {
    if (t < WT_WIN) { const int nt = t / 16, kt = t % 16; wt_tile(p, p.in[I_WIN] + (size_t)l * 1024 * 6848, 6848, nt * 256, 6848 - nt * 256, 0, (bf16_t*)(p.ws + OFF_WIN), 1024, nt * 256, kt * 64, lds); return; } t -= WT_WIN;
    if (t < WT_WUQ) { const int nt = t / 6, kt = t % 6; wt_tile(p, p.in[I_WUQ] + (size_t)l * 384 * 384, 384, nt * 256, 384 - nt * 256, 0, (bf16_t*)(p.ws + OFF_WUQ), 384, nt * 256, kt * 64, lds); return; } t -= WT_WUQ;
    if (t < WT_WKV) { const int nt = t / 4, kt = t % 4;
        if (nt == 0) wt_tile(p, p.in[I_WUK] + (size_t)l * 256 * 256, 256, 0, 256, 2, (bf16_t*)(p.ws + OFF_WKV), 256, 0, kt * 64, lds);
        else wt_tile(p, p.in[I_WUV] + (size_t)l * 256 * 512, 512, (nt - 1) * 256, 256, 0, (bf16_t*)(p.ws + OFF_WKV), 256, nt * 256, kt * 64, lds);
        return; } t -= WT_WKV;
    if (t < WT_WGLU) { const int nt = t / 8, kt = t % 8; wt_tile(p, p.in[I_WGLU] + (size_t)l * 512 * 1024, 1024, nt * 128, 256, 1, (bf16_t*)(p.ws + OFF_WGLU), 512, nt * 256, kt * 64, lds); return; } t -= WT_WGLU;
    if (t < 3 * WT_WBO) { const int br = t / WT_WBO, tt = t % WT_WBO, nt = tt / 8, kt = tt % 8;
        wt_tile(p, p.in[I_WBOG + br] + (size_t)l * 512 * 1024, 1024, nt * 256, 256, 0, (bf16_t*)(p.ws + OFF_WBO) + (size_t)br * 1024 * 512, 512, nt * 256, kt * 64, lds); return; } t -= 3 * WT_WBO;
    { const int nt = t / 16, kt = t % 16; wt_tile(p, p.in[I_WOUT] + (size_t)l * 1024 * 1024, 1024, nt * 256, 256, 0, (bf16_t*)(p.ws + OFF_WOUT), 1024, nt * 256, kt * 64, lds); }
}
__device__ __forceinline__ void job_s5setup(const Params& p, int l, int jq, lds_t lds) {
    const int j = jq >> 2, qtr = jq & 3, g = j / 3, which = j % 3, tid = tid_opaque(p);
    LAS f32x2_t* pw = (LAS f32x2_t*)lds;
    LAS f32x2_t* Bt = pw + 2 * 17 * 64;
    LAS f32x2_t* Cn = Bt + 2 * 64 * 16;
    LAS float* Kt = (LAS float*)(Cn + 64 * 16);
    LAS float* raw = Kt + 8192;
    { const size_t gb = (size_t)(l * 32 + g) * 1024;
      for (int i = tid; i < 1024; i += 512) { raw[i] = p.in[I_BRE][gb + i]; raw[1024 + i] = p.in[I_BIM][gb + i]; raw[2048 + i] = p.in[I_CRE][gb + i]; raw[3072 + i] = p.in[I_CIM][gb + i]; }
      if (tid < 128) { const int d = tid >> 6, n = tid & 63; raw[4096 + tid] = p.in[I_ARE][((l * 2 + d) * 32 + g) * 64 + n]; raw[4224 + tid] = p.in[I_AIM][((l * 2 + d) * 32 + g) * 64 + n]; }
      if (tid < 2) raw[4352 + tid] = p.in[I_LOGDT][(l * 2 + tid) * 32 + g]; }
    __syncthreads();
    if (tid < 128) { const int d = tid >> 6, n = tid & 63;
        const float dt = expf(raw[4352 + d]);
        const float are = raw[4096 + tid], aim = raw[4224 + tid];
        float s1, c1; sincosf(aim * dt, &s1, &c1); float sh = sinf(0.5f * aim * dt);
        const float em1 = expm1f(are * dt), mag1 = em1 + 1.f;
        { float pr = 1.f, pi = 0.f; const float ar1 = mag1 * c1, ai1 = mag1 * s1;
          for (int tau = 0; tau <= 16; ++tau) { pw[(d * 17 + tau) * 64 + n] = (f32x2_t){pr, pi}; const float nr = pr * ar1 - pi * ai1, ni = pr * ai1 + pi * ar1; pr = nr; pi = ni; } }
        const float nre = em1 * c1 - 2.f * sh * sh, abim = mag1 * s1, den = are * are + aim * aim;
        const float cfr = (nre * are + abim * aim) / den, cfi = (abim * are - nre * aim) / den;
        for (int q = 0; q < 16; ++q) { const float br = raw[n * 16 + q], bi = raw[1024 + n * 16 + q];
            Bt[(d * 64 + n) * 16 + q] = (f32x2_t){cfr * br - cfi * bi, cfr * bi + cfi * br}; }
        if (which == 1 && qtr == 0) ((f32x2_t*)(p.ws + OFF_P16))[(g * 2 + d) * 64 + n] = pw[(d * 17 + 16) * 64 + n];
    }
    for (int i = tid; i < 1024; i += 512) { const int n = i >> 4, pp = i & 15; Cn[i] = (f32x2_t){raw[2048 + pp * 64 + n], raw[3072 + pp * 64 + n]}; }
    __syncthreads();
    bf16_t* M = (bf16_t*)(p.ws + OFF_S5M) + (size_t)(g * 3 + which) * 65536;
    if (which == 0) {
        { const int wid_ = tid >> 6, ln = tid & 63, lr_ = ln & 15, kq = ln >> 4;
          for (int c4 = 0; c4 < 4; ++c4) { const int dt_ = wid_ * 4 + c4, d = dt_ >> 4, tau = dt_ & 15; f32x4 acc = {0.f, 0.f, 0.f, 0.f};
#pragma unroll 4
            for (int ks = 0; ks < 16; ++ks) { const int n = ks * 4 + kq; const f32x2_t c = Cn[n * 16 + lr_], w = pw[(d * 17 + tau) * 64 + n], b = Bt[(d * 64 + n) * 16 + lr_];
                const float cwr = c.x * w.x - c.y * w.y, cwi = c.x * w.y + c.y * w.x;
                acc = __builtin_amdgcn_mfma_f32_16x16x4f32(cwr, b.x, acc, 0, 0, 0); acc = __builtin_amdgcn_mfma_f32_16x16x4f32(-cwi, b.y, acc, 0, 0, 0); }
#pragma unroll
            for (int r = 0; r < 4; ++r) Kt[dt_ * 256 + (kq * 4 + r) * 16 + lr_] = acc[r]; } }
        __syncthreads();
#pragma unroll 8
        for (int i = qtr * 16384 + tid; i < (qtr + 1) * 16384; i += 512) { const int no = i >> 8, k = i & 255, t = no >> 4, pp = no & 15, s = k >> 4, q = k & 15; float v;
            if (t > s) v = Kt[(0 * 16 + (t - s)) * 256 + pp * 16 + q];
            else if (t < s) v = Kt[(1 * 16 + (s - t)) * 256 + pp * 16 + q];
            else { v = Kt[pp * 16 + q] + Kt[16 * 256 + pp * 16 + q]; if (pp == q) v += p.in[I_S5D][l * 512 + g * 16 + pp]; }
            M[i] = f2bf(v); }
    } else if (which == 1) {
#pragma unroll 8
        for (int i = qtr * 16384 + tid; i < (qtr + 1) * 16384; i += 512) { const int no = i >> 8, k = i & 255, d = no >> 7, ri = (no >> 6) & 1, n = no & 63, s = k >> 4, q = k & 15; const int e = d == 0 ? 15 - s : s;
            const f32x2_t w = pw[(d * 17 + e) * 64 + n], b = Bt[(d * 64 + n) * 16 + q];
            M[i] = f2bf(ri == 0 ? w.x * b.x - w.y * b.y : w.x * b.y + w.y * b.x); }
    } else {
#pragma unroll 8
        for (int i = qtr * 16384 + tid; i < (qtr + 1) * 16384; i += 512) { const int no = i >> 8, k = i & 255, t = no >> 4, pp = no & 15, d = k >> 7, ri = (k >> 6) & 1, n = k & 63; const int e = d == 0 ? t + 1 : 16 - t;
            const f32x2_t c = Cn[n * 16 + pp], w = pw[(d * 17 + e) * 64 + n];
            M[i] = f2bf(ri == 0 ? c.x * w.x - c.y * w.y : -(c.x * w.y + c.y * w.x)); }
    }
    __syncthreads();
}

__device__ __forceinline__ float gelu_tanh(float x) { const float u = 0.7978845608f * (x + 0.044715f * x * x * x); const float t = 1.f - 2.f / (1.f + __expf(2.f * u)); return 0.5f * x * (1.f + t); }
__device__ __forceinline__ void job_s5(const Params& p, int l, int j, lds_t lds) {
    const int tid = tid_opaque(p), wid = tid >> 6, lane = tid & 63, lr = lane & 15, lq = lane >> 4;
    const int bcd = j >> 5, g = j & 31;
    const bool smp = bcd < 4;
    constexpr int M = 64, MT = 4; const int tok0 = smp ? 4096 + bcd * 1024 : (bcd - 4) * 1024;
    LAS bf16_t* Us = (LAS bf16_t*)lds; LAS bf16_t* Xs = Us + 64 * 264; LAS float* Xin = (LAS float*)(lds + 2 * 64 * 264 * 2);
    const bf16_t* Z = (const bf16_t*)(p.ws + OFF_Z);
    const bf16_t* TT = (const bf16_t*)(p.ws + OFF_S5M) + (size_t)(g * 3) * 65536; const bf16_t* G = TT + 65536; const bf16_t* Cc = G + 65536;
    bf16x8 bq[8][2];
#pragma unroll
    for (int ks = 0; ks < 8; ++ks) { bq[ks][0] = *(const bf16x8*)(G + (size_t)(wid * 32 + lr) * 256 + ks * 32 + lq * 8); bq[ks][1] = *(const bf16x8*)(G + (size_t)(wid * 32 + 16 + lr) * 256 + ks * 32 + lq * 8); }
    f32x2_t a16 = {0.f, 0.f}; float xr = 0.f, xi = 0.f;
    if (tid < 128) { const int d = tid >> 6, n = tid & 63; a16 = ((const f32x2_t*)(p.ws + OFF_P16))[(g * 2 + d) * 64 + n];
        if (smp) { const size_t o = ((size_t)((bcd * 2 + l) * 2 + d) * 2) * 2048 + g * 64 + n; xr = p.in[I_SS5][o]; xi = p.in[I_SS5][o + 2048]; } }
    for (int idx = tid; idx < M * 32; idx += 512) { const int tok = idx >> 1, hf = idx & 1;
        *(LAS u32x4*)(Us + (tok >> 4) * 264 + (tok & 15) * 16 + hf * 8) = *(const u32x4*)(Z + (size_t)(tok0 + tok) * LDZ + ZSU + g * 16 + hf * 8); }
    __syncthreads();
    f32x4 acc[4][2];
#pragma unroll
    for (int a = 0; a < 4; ++a) { acc[a][0] = (f32x4){0.f, 0.f, 0.f, 0.f}; acc[a][1] = acc[a][0]; }
#pragma unroll
    for (int ks = 0; ks < 8; ++ks)
#pragma unroll
        for (int mt = 0; mt < 4; ++mt) if (mt < MT) { const bf16x8 a = LDSFRAG(Us + (mt * 16 + lr) * 264 + ks * 32 + lq * 8); acc[mt][0] = MFMA16(a, bq[ks][0], acc[mt][0]); acc[mt][1] = MFMA16(a, bq[ks][1], acc[mt][1]); }
    bf16x8 bc[8][2];
#pragma unroll
    for (int ks = 0; ks < 8; ++ks) { bq[ks][0] = *(const bf16x8*)(TT + (size_t)(wid * 32 + lr) * 256 + ks * 32 + lq * 8); bq[ks][1] = *(const bf16x8*)(TT + (size_t)(wid * 32 + 16 + lr) * 256 + ks * 32 + lq * 8);
        bc[ks][0] = *(const bf16x8*)(Cc + (size_t)(wid * 32 + lr) * 256 + ks * 32 + lq * 8); bc[ks][1] = *(const bf16x8*)(Cc + (size_t)(wid * 32 + 16 + lr) * 256 + ks * 32 + lq * 8); }
#pragma unroll
    for (int mt = 0; mt < 4; ++mt) if (mt < MT)
#pragma unroll
        for (int ct = 0; ct < 2; ++ct)
#pragma unroll
            for (int r = 0; r < 4; ++r) Xin[(mt * 16 + lq * 4 + r) * 260 + wid * 32 + ct * 16 + lr] = acc[mt][ct][r];
    __syncthreads();
    if (tid < 128) { const int d = tid >> 6, n = tid & 63;
        const int cre = d * 128 + n, cim = cre + 64;
        const int nseg = smp ? 1 : 4, L = 64 / nseg;
        for (int sg = 0; sg < nseg; ++sg) {
            if (!smp) { xr = 0.f; xi = 0.f; }
            for (int i = 0; i < L; ++i) { const int c = sg * L + (d == 0 ? i : L - 1 - i);
                Xs[c * 264 + cre] = f2bf(xr); Xs[c * 264 + cim] = f2bf(xi);
                const float ur = Xin[c * 260 + cre], ui = Xin[c * 260 + cim];
                const float nr = a16.x * xr - a16.y * xi + ur, ni = a16.x * xi + a16.y * xr + ui; xr = nr; xi = ni; }
            if (!smp) { const int bb = (bcd - 4) * 4 + sg; const size_t o = OUT_S5 + ((size_t)((bb * 2 + l) * 2 + d) * 2) * 2048 + g * 64 + n; p.out[o] = xr; p.out[o + 2048] = xi; } }
    }
    __syncthreads();
#pragma unroll
    for (int a = 0; a < 4; ++a) { acc[a][0] = (f32x4){0.f, 0.f, 0.f, 0.f}; acc[a][1] = acc[a][0]; }
#pragma unroll
    for (int ks = 0; ks < 8; ++ks)
#pragma unroll
        for (int mt = 0; mt < 4; ++mt) if (mt < MT) { const bf16x8 a = LDSFRAG(Us + (mt * 16 + lr) * 264 + ks * 32 + lq * 8); acc[mt][0] = MFMA16(a, bq[ks][0], acc[mt][0]); acc[mt][1] = MFMA16(a, bq[ks][1], acc[mt][1]); }
#pragma unroll
    for (int ks = 0; ks < 8; ++ks)
#pragma unroll
        for (int mt = 0; mt < 4; ++mt) if (mt < MT) { const bf16x8 a = LDSFRAG(Xs + (mt * 16 + lr) * 264 + ks * 32 + lq * 8); acc[mt][0] = MFMA16(a, bc[ks][0], acc[mt][0]); acc[mt][1] = MFMA16(a, bc[ks][1], acc[mt][1]); }
    bf16_t* Yg = (bf16_t*)(p.ws + OFF_YG);
#pragma unroll
    for (int mt = 0; mt < 4; ++mt) if (mt < MT)
#pragma unroll
        for (int ct = 0; ct < 2; ++ct)
#pragma unroll
            for (int r = 0; r < 4; ++r) { const int chunk = mt * 16 + lq * 4 + r, t = wid * 2 + ct;
                Yg[(size_t)(tok0 + chunk * 16 + t) * 512 + g * 16 + lr] = f2bf(gelu_tanh(acc[mt][ct][r])); }
    __syncthreads();
}
__device__ __forceinline__ void job_mlaprep(const Params& p, int l, int j) {
    const int tid = tid_opaque(p), wid = tid >> 6, lane = tid & 63;
    bf16_t qr[4][6], kr[4][4], rr[4];
#pragma unroll
    for (int t4 = 0; t4 < 4; ++t4) { const int row = j * 32 + wid * 4 + t4; const bf16_t* z = (const bf16_t*)(p.ws + OFF_Z) + (size_t)row * LDZ;
#pragma unroll
        for (int i = 0; i < 6; ++i) qr[t4][i] = z[ZMQ + i * 64 + lane];
#pragma unroll
        for (int i = 0; i < 4; ++i) kr[t4][i] = z[ZMKV + i * 64 + lane];
        rr[t4] = z[ZMKR + (lane & 31)]; }
    float qn[6], kn[4];
#pragma unroll
    for (int i = 0; i < 6; ++i) qn[i] = p.in[I_QNORM][l * 384 + i * 64 + lane];
#pragma unroll
    for (int i = 0; i < 4; ++i) kn[i] = p.in[I_KVNORM][l * 256 + i * 64 + lane];
#pragma unroll
    for (int t4 = 0; t4 < 4; ++t4) { const int row = j * 32 + wid * 4 + t4;
        float q[6], kv[4]; float sq = 0.f, sk = 0.f;
#pragma unroll
        for (int i = 0; i < 6; ++i) { q[i] = bf2f(qr[t4][i]); sq += q[i] * q[i]; }
#pragma unroll
        for (int i = 0; i < 4; ++i) { kv[i] = bf2f(kr[t4][i]); sk += kv[i] * kv[i]; }
#pragma unroll
        for (int o = 1; o < 64; o <<= 1) { sq += __shfl_xor(sq, o); sk += __shfl_xor(sk, o); }
        const float rq = rsqrtf(sq * (1.f / 384.f) + 1e-6f), rk = rsqrtf(sk * (1.f / 256.f) + 1e-6f);
        bf16_t* aq = (bf16_t*)(p.ws + OFF_AQ) + (size_t)row * 384; bf16_t* ck = (bf16_t*)(p.ws + OFF_CKVN) + (size_t)row * 256;
#pragma unroll
        for (int i = 0; i < 6; ++i) aq[i * 64 + lane] = f2bf(q[i] * rq * qn[i]);
        const bool prompt = row < 4096; const int b = row >> 8, t = row & 255;
#pragma unroll
        for (int i = 0; i < 4; ++i) { const float v = kv[i] * rk * kn[i]; ck[i * 64 + lane] = f2bf(v);
            if (prompt) p.out[OUT_CKV + ((size_t)((b * 2 + l) * 256 + t)) * 256 + i * 64 + lane] = v; }
        if (prompt && lane < 32) p.out[OUT_KR + ((size_t)((b * 2 + l) * 256 + t)) * 32 + lane] = bf2f(rr[t4]); }
}
__device__ __forceinline__ float logsigmoidf_(float x) { return fminf(x, 0.f) - __logf(1.f + __expf(-fabsf(x))); }
__device__ __forceinline__ void job_glaA(const Params& p, int l, int j, lds_t lds) {
    const int tid = tid_opaque(p), wid = tid >> 6, lane = tid & 63, lr = lane & 15, lq = lane >> 4;
    const int ck = j >> 2, h = j & 3, tok0 = ck * 64;
    LAS bf16_t* QDf = (LAS bf16_t*)lds; LAS bf16_t* QDb = QDf + 4608; LAS bf16_t* KDf = QDb + 4608; LAS bf16_t* KDb = KDf + 4608; LAS bf16_t* KRf = KDb + 4608; LAS bf16_t* KRb = KRf + 4608;
    LAS bf16_t* VT = KRb + 4608;
    LAS bf16_t* ATT = VT + 9216;
    LAS float* GA = (LAS float*)(ATT + 4608);
    LAS float* TOT = GA + 2048;
    const bf16_t* Z = (const bf16_t*)(p.ws + OFF_Z);
    const int d = tid & 63, cg_ = tid >> 6;
    bf16_t qraw[8], kraw[8]; float wf[16], wb[16];
#pragma unroll
    for (int i = 0; i < 8; ++i) { const size_t zr = (size_t)(tok0 + cg_ * 8 + i) * LDZ; qraw[i] = Z[zr + ZQ + h * 64 + d]; kraw[i] = Z[zr + ZK + h * 64 + d]; }
#pragma unroll
    for (int r = 0; r < 16; ++r) { wf[r] = p.in[I_WA2][((size_t)((l * 2 + 0) * 16 + r)) * 256 + h * 64 + d]; wb[r] = p.in[I_WA2][((size_t)((l * 2 + 1) * 16 + r)) * 256 + h * 64 + d]; }
    const float bf_ = p.in[I_BA][(l * 2 + 0) * 256 + h * 64 + d], bb_ = p.in[I_BA][(l * 2 + 1) * 256 + h * 64 + d];
    { const int c = tid >> 3, part = tid & 7; const u32x2 gv = *(const u32x2*)(Z + (size_t)(tok0 + c) * LDZ + ZGA + part * 4);
      GA[c * 32 + part * 4 + 0] = lo16(gv.x); GA[c * 32 + part * 4 + 1] = hi16(gv.x); GA[c * 32 + part * 4 + 2] = lo16(gv.y); GA[c * 32 + part * 4 + 3] = hi16(gv.y);
      const bf16_t* vp = Z + (size_t)(tok0 + c) * LDZ + ZV + h * 128 + part * 16;
      const u32x4 v0 = *(const u32x4*)vp, v1 = *(const u32x4*)(vp + 8);
      const unsigned w[8] = { v0.x, v0.y, v0.z, v0.w, v1.x, v1.y, v1.z, v1.w };
#pragma unroll
      for (int i = 0; i < 8; ++i) { VT[(part * 16 + 2 * i) * 72 + c] = (bf16_t)(w[i] & 0xffffu); VT[(part * 16 + 2 * i + 1) * 72 + c] = (bf16_t)(w[i] >> 16); } }
    __syncthreads();
    float laf[8], lab[8];
    {
#pragma unroll
      for (int i = 0; i < 8; ++i) { const int c = cg_ * 8 + i; float xf = bf_, xb = bb_;
#pragma unroll
          for (int r = 0; r < 16; ++r) { xf += GA[c * 32 + r] * wf[r]; xb += GA[c * 32 + 16 + r] * wb[r]; }
          laf[i] = logsigmoidf_(xf) * (1.f / 16.f); lab[i] = logsigmoidf_(xb) * (1.f / 16.f); } }
#pragma unroll
    for (int i = 1; i < 8; ++i) laf[i] += laf[i - 1];
#pragma unroll
    for (int i = 6; i >= 0; --i) lab[i] += lab[i + 1];
    TOT[(0 * 8 + cg_) * 64 + d] = laf[7]; TOT[(1 * 8 + cg_) * 64 + d] = lab[0];
    __syncthreads();
    float offf = 0.f, offb = 0.f, Tf = 0.f, Tb = 0.f;
#pragma unroll
    for (int g = 0; g < 8; ++g) { const float a = TOT[g * 64 + d], b = TOT[(8 + g) * 64 + d]; Tf += a; Tb += b; if (g < cg_) offf += a; if (g > cg_) offb += b; }
    bf16_t* QD = (bf16_t*)(p.ws + OFF_QD);
#pragma unroll
    for (int i = 0; i < 8; ++i) { const int c = cg_ * 8 + i;
        const float q = bf2f(qraw[i]) * 0.125f, k = bf2f(kraw[i]);
        const float bf_ = offf + laf[i], bb_ = offb + lab[i];
        const bf16_t qf = f2bf(q * __expf(bf_)), qb = f2bf(q * __expf(bb_));
        QDf[c * 72 + d] = qf; QDb[c * 72 + d] = qb;
        KDf[c * 72 + d] = f2bf(k * __expf(-bf_)); KDb[c * 72 + d] = f2bf(k * __expf(-bb_));
        KRf[d * 72 + c] = f2bf(k * __expf(Tf - bf_)); KRb[d * 72 + c] = f2bf(k * __expf(Tb - bb_));
        QD[(size_t)(tok0 + c) * 256 + h * 64 + d] = qf; QD[(size_t)(8192 + tok0 + c) * 256 + h * 64 + d] = qb; }
    if (cg_ == 0) { float* DEC = (float*)(p.ws + OFF_DEC); DEC[((0 * 128 + ck) * 4 + h) * 64 + d] = __expf(Tf); DEC[((1 * 128 + ck) * 4 + h) * 64 + d] = __expf(Tb); }
    __syncthreads();
#pragma unroll
    for (int q2 = 0; q2 < 2; ++q2) { const int tt = wid * 2 + q2, ti = tt >> 2, tj = tt & 3; f32x4 af = {0.f, 0.f, 0.f, 0.f}, ab = af;
#pragma unroll
        for (int ks = 0; ks < 2; ++ks) { const int ko = ks * 32 + lq * 8;
            af = MFMA16(LDSFRAG(QDf + (ti * 16 + lr) * 72 + ko), LDSFRAG(KDf + (tj * 16 + lr) * 72 + ko), af);
            ab = MFMA16(LDSFRAG(QDb + (ti * 16 + lr) * 72 + ko), LDSFRAG(KDb + (tj * 16 + lr) * 72 + ko), ab); }
#pragma unroll
        for (int r = 0; r < 4; ++r) { const int c = ti * 16 + lq * 4 + r, s = tj * 16 + lr; const float v = (s <= c ? af[r] : 0.f) + (s >= c ? ab[r] : 0.f); ATT[c * 72 + s] = f2bf(v); } }
    __syncthreads();
    bf16x8 vb[2];
#pragma unroll
    for (int ks = 0; ks < 2; ++ks) vb[ks] = LDSFRAG(VT + (wid * 16 + lr) * 72 + ks * 32 + lq * 8);
    bf16_t* OI = (bf16_t*)(p.ws + OFF_OIB); bf16_t* KV = (bf16_t*)(p.ws + OFF_KV);
#pragma unroll
    for (int ct = 0; ct < 4; ++ct) { f32x4 a = {0.f, 0.f, 0.f, 0.f};
#pragma unroll
        for (int ks = 0; ks < 2; ++ks) a = MFMA16(LDSFRAG(ATT + (ct * 16 + lr) * 72 + ks * 32 + lq * 8), vb[ks], a);
#pragma unroll
        for (int r = 0; r < 4; ++r) OI[(size_t)(tok0 + ct * 16 + lq * 4 + r) * 512 + h * 128 + wid * 16 + lr] = f2bf(a[r]); }
#pragma unroll
    for (int dir = 0; dir < 2; ++dir) { const LAS bf16_t* KR = dir == 0 ? KRf : KRb; bf16_t* kvp = KV + ((size_t)((dir * 128 + ck) * 4 + h)) * 8192;
#pragma unroll
        for (int dt = 0; dt < 4; ++dt) { f32x4 a = {0.f, 0.f, 0.f, 0.f};
#pragma unroll
            for (int ks = 0; ks < 2; ++ks) a = MFMA16(LDSFRAG(KR + (dt * 16 + lr) * 72 + ks * 32 + lq * 8), vb[ks], a);
#pragma unroll
            for (int r = 0; r < 4; ++r) kvp[(dt * 16 + lq * 4 + r) * 128 + wid * 16 + lr] = f2bf(a[r]); } }
    __syncthreads();
}

__device__ __forceinline__ void job_glaB(const Params& p, int l, int j) {
    const int qt = j & 3, h = (j >> 2) & 3, rest = j >> 4, bb = rest % 20, dir = rest / 20;
    const int idx0 = qt * 2048 + tid_opaque(p);
    const int nck = bb < 16 ? 4 : 16, ck0 = bb < 16 ? bb * 4 : 64 + (bb - 16) * 16;
    float S[4];
#pragma unroll
    for (int e = 0; e < 4; ++e) S[e] = bb >= 16 ? p.in[I_SGLA][((size_t)((((bb - 16) * 2 + l) * 2 + dir) * 4 + h)) * 8192 + idx0 + e * 512] : 0.f;
    const bf16_t* KV = (const bf16_t*)(p.ws + OFF_KV); const float* DEC = (const float*)(p.ws + OFF_DEC); bf16_t* ST = (bf16_t*)(p.ws + OFF_ST);
    for (int i0 = 0; i0 < nck; i0 += 4) { float dv[4][4]; bf16_t kv[4][4]; size_t its[4];
#pragma unroll
        for (int u = 0; u < 4; ++u) { const int i = i0 + u, ck = dir == 0 ? ck0 + i : ck0 + nck - 1 - i; its[u] = (size_t)((dir * 128 + ck) * 4 + h);
#pragma unroll
            for (int e = 0; e < 4; ++e) { const int idx = idx0 + e * 512; dv[u][e] = DEC[its[u] * 64 + (idx >> 7)]; kv[u][e] = KV[its[u] * 8192 + idx]; } }
#pragma unroll
        for (int u = 0; u < 4; ++u)
#pragma unroll
            for (int e = 0; e < 4; ++e) { ST[its[u] * 8192 + idx0 + e * 512] = f2bf(S[e]); S[e] = dv[u][e] * S[e] + bf2f(kv[u][e]); } }
    if (bb < 16) {
#pragma unroll
        for (int e = 0; e < 4; ++e) p.out[OUT_GLA + ((size_t)(((bb * 2 + l) * 2 + dir) * 4 + h)) * 8192 + idx0 + e * 512] = S[e]; }
}

__device__ __forceinline__ void job_glaC(const Params& p, int l, int j, lds_t lds) {
    const int tid = tid_opaque(p), wid = tid >> 6, lane = tid & 63, lr = lane & 15, lq = lane >> 4;
    const int ck = j >> 2, h = j & 3, tok0 = ck * 64;
    LAS bf16_t* Aq = (LAS bf16_t*)lds;
    LAS bf16_t* BT = Aq + 64 * 136;
    LAS float* Os = (LAS float*)(BT + 128 * 136);
    const bf16_t* QD = (const bf16_t*)(p.ws + OFF_QD); const bf16_t* ST = (const bf16_t*)(p.ws + OFF_ST);
#pragma unroll
    for (int it = 0; it < 2; ++it) { const int idx = tid + it * 512, c = idx >> 4, rem = idx & 15, dir = rem >> 3, dc = rem & 7;
        *(LAS u32x4*)(Aq + c * 136 + dir * 64 + dc * 8) = *(const u32x4*)(QD + (size_t)(dir * 8192 + tok0 + c) * 256 + h * 64 + dc * 8); }
#pragma unroll
    for (int it = 0; it < 4; ++it) { const int idx = tid + it * 512, dir = idx >> 10, d = (idx >> 4) & 63, ec = idx & 15;
        const u32x4 v = *(const u32x4*)(ST + ((size_t)((dir * 128 + ck) * 4 + h)) * 8192 + d * 128 + ec * 8);
        const unsigned w[4] = { v.x, v.y, v.z, v.w };
#pragma unroll
        for (int i = 0; i < 4; ++i) { BT[(ec * 8 + 2 * i) * 136 + dir * 64 + d] = (bf16_t)(w[i] & 0xffffu); BT[(ec * 8 + 2 * i + 1) * 136 + dir * 64 + d] = (bf16_t)(w[i] >> 16); } }
    const int ct = wid & 3, eh = wid >> 2; const bf16_t* OI = (const bf16_t*)(p.ws + OFF_OIB);
    bf16_t oi[4][4];
#pragma unroll
    for (int e4 = 0; e4 < 4; ++e4)
#pragma unroll
        for (int r = 0; r < 4; ++r) oi[e4][r] = OI[(size_t)(tok0 + ct * 16 + lq * 4 + r) * 512 + h * 128 + (eh * 4 + e4) * 16 + lr];
    const int nc = tid >> 3, npart = tid & 7;
    const bf16_t* gz = (const bf16_t*)(p.ws + OFF_Z) + (size_t)(tok0 + nc) * LDZ + ZGG + h * 128 + npart * 16;
    const u32x4 g0 = *(const u32x4*)gz, g1 = *(const u32x4*)(gz + 8);
    f32x4 onw[4];
#pragma unroll
    for (int i = 0; i < 4; ++i) onw[i] = *(const f32x4*)(p.in[I_ONORM] + l * 128 + npart * 16 + 4 * i);
    __syncthreads();
    bf16x8 af[4];
#pragma unroll
    for (int ks = 0; ks < 4; ++ks) af[ks] = LDSFRAG(Aq + (ct * 16 + lr) * 136 + ks * 32 + lq * 8);
#pragma unroll
    for (int e4 = 0; e4 < 4; ++e4) { const int et = eh * 4 + e4; f32x4 a = {0.f, 0.f, 0.f, 0.f};
#pragma unroll
        for (int ks = 0; ks < 4; ++ks) a = MFMA16(af[ks], LDSFRAG(BT + (et * 16 + lr) * 136 + ks * 32 + lq * 8), a);
#pragma unroll
        for (int r = 0; r < 4; ++r) { const int row = ct * 16 + lq * 4 + r, col = et * 16 + lr; Os[row * 132 + col] = a[r] + bf2f(oi[e4][r]); } }
    __syncthreads();
    { const int c = tid >> 3, part = tid & 7; float o[16]; float ss = 0.f;
#pragma unroll
      for (int i = 0; i < 16; ++i) { o[i] = Os[c * 132 + part * 16 + i]; ss += o[i] * o[i]; }
      ss += __shfl_xor(ss, 1); ss += __shfl_xor(ss, 2); ss += __shfl_xor(ss, 4);
      const float rstd = rsqrtf(ss * (1.f / 128.f) + 1e-6f);
      const unsigned gw[8] = { g0.x, g0.y, g0.z, g0.w, g1.x, g1.y, g1.z, g1.w };
      unsigned ow[8];
#pragma unroll
      for (int i = 0; i < 8; ++i) { const float n0 = onw[i >> 1][(2 * i) & 3], n1 = onw[i >> 1][(2 * i + 1) & 3];
          ow[i] = pk2(o[2 * i] * rstd * n0 * siluf_(lo16(gw[i])), o[2 * i + 1] * rstd * n1 * siluf_(hi16(gw[i]))); }
      bf16_t* ap = (bf16_t*)(p.ws + OFF_AGLA) + (size_t)(tok0 + c) * 512 + h * 128 + part * 16;
      *(u32x4*)ap = (u32x4){ow[0], ow[1], ow[2], ow[3]}; *(u32x4*)(ap + 8) = (u32x4){ow[4], ow[5], ow[6], ow[7]}; }
    __syncthreads();
}
__device__ __forceinline__ void head_row_finish(float (&x)[16], int p8, const float* nw, const float* nw2, bool rope, int pos, const float* R, float mul, LAS bf16_t* dst) {
    float ss = 0.f; const int cnt = p8 < 4 ? 16 : 8;
#pragma unroll
    for (int i = 0; i < 16; ++i) if (i < cnt) ss += x[i] * x[i];
    ss += __shfl_xor(ss, 1); ss += __shfl_xor(ss, 2); ss += __shfl_xor(ss, 4);
    const float rstd = rsqrtf(ss * (1.f / 96.f) + 1e-6f) * mul;
    if (p8 < 4) { unsigned w[8];
#pragma unroll
        for (int i = 0; i < 8; ++i) w[i] = pk2(x[2 * i] * rstd * nw[p8 * 16 + 2 * i] * nw2[p8 * 16 + 2 * i], x[2 * i + 1] * rstd * nw[p8 * 16 + 2 * i + 1] * nw2[p8 * 16 + 2 * i + 1]);
        *(LAS u32x4*)(dst + p8 * 16) = (u32x4){w[0], w[1], w[2], w[3]}; *(LAS u32x4*)(dst + p8 * 16 + 8) = (u32x4){w[4], w[5], w[6], w[7]};
    } else { const int i0 = (p8 - 4) * 4; float o1[4], o2[4];
#pragma unroll
        for (int i = 0; i < 4; ++i) { const float a = x[i] * rstd * nw[64 + i0 + i], b = x[4 + i] * rstd * nw[80 + i0 + i];
            if (rope) { const float c = R[pos * 16 + i0 + i], s = R[16384 + pos * 16 + i0 + i]; o1[i] = a * c - b * s; o2[i] = a * s + b * c; } else { o1[i] = a; o2[i] = b; } }
        *(LAS u32x2*)(dst + 64 + i0) = (u32x2){pk2(o1[0], o1[1]), pk2(o1[2], o1[3])}; *(LAS u32x2*)(dst + 80 + i0) = (u32x2){pk2(o2[0], o2[1]), pk2(o2[2], o2[3])}; }
}
__device__ __forceinline__ void ld16bf(const bf16_t* s, float (&x)[16]) { const u32x4 a = *(const u32x4*)s, b = *(const u32x4*)(s + 8);
    x[0] = lo16(a.x); x[1] = hi16(a.x); x[2] = lo16(a.y); x[3] = hi16(a.y); x[4] = lo16(a.z); x[5] = hi16(a.z); x[6] = lo16(a.w); x[7] = hi16(a.w);
    x[8] = lo16(b.x); x[9] = hi16(b.x); x[10] = lo16(b.y); x[11] = hi16(b.y); x[12] = lo16(b.z); x[13] = hi16(b.z); x[14] = lo16(b.w); x[15] = hi16(b.w); }
__device__ __forceinline__ void ld4bf(const bf16_t* s, float* x) { const u32x2 a = *(const u32x2*)s; x[0] = lo16(a.x); x[1] = hi16(a.x); x[2] = lo16(a.y); x[3] = hi16(a.y); }
__device__ __forceinline__ void job_attn(const Params& p, int l, int j, lds_t lds) {
    const int tid = tid_opaque(p), wid = tid >> 6, lane = tid & 63, lr = lane & 15, lq = lane >> 4;
    const bool smp = j < 128; int b, h, qb; if (smp) { b = j >> 5; h = (j >> 3) & 3; qb = j & 7; } else { const int jj = j - 128; b = jj >> 3; h = (jj >> 1) & 3; qb = jj & 1; }
    const int qtok0 = smp ? 4096 + b * 1024 + qb * 128 : b * 256 + qb * 128; const int nkt = smp ? 12 : 2;
    LAS bf16_t* Ks0 = (LAS bf16_t*)lds;
    LAS bf16_t* VTs0 = Ks0 + 2 * 128 * 104;
    LAS float* Mg = (LAS float*)lds;
    const bf16_t* Z = (const bf16_t*)(p.ws + OFF_Z); const bf16_t* KF = (const bf16_t*)(p.ws + OFF_KF); const bf16_t* Vb = (const bf16_t*)(p.ws + OFF_V); const float* R = (const float*)(p.ws + OFF_ROPE);
    const float* qhn = p.in[I_QHNORM] + l * 96;
    u32x4 kreg[3], vreg[4];
    const int vst = smp ? 1536 : 256; const bf16_t* vtb = smp ? Vb + 2097152 + (size_t)(b * 4 + h) * 128 * 1536 : Vb + (size_t)(b * 4 + h) * 128 * 256;
    auto rowbase = [&](int kt) { return smp ? (kt < 4 ? 8192 + b * 512 + kt * 128 : 4096 + b * 1024 + (kt - 4) * 128) : b * 256 + kt * 128; };
    auto issue = [&](int kt) { const int rb = rowbase(kt);
#pragma unroll
        for (int i = 0; i < 3; ++i) { const int idx = tid + 512 * i, key = idx / 12, part = idx - key * 12; kreg[i] = *(const u32x4*)(KF + (size_t)(rb + key) * 384 + h * 96 + part * 8); }
#pragma unroll
        for (int i = 0; i < 4; ++i) { const int idx = tid + 512 * i, e = idx >> 4, part = idx & 15; vreg[i] = *(const u32x4*)(vtb + (size_t)e * vst + kt * 128 + part * 8); } };
    auto commit = [&](int buf) { LAS bf16_t* Ks = Ks0 + buf * 128 * 104; LAS bf16_t* VTs = VTs0 + buf * 128 * 136;
#pragma unroll
        for (int i = 0; i < 3; ++i) { const int idx = tid + 512 * i, key = idx / 12, part = idx - key * 12; *(LAS u32x4*)(Ks + key * 104 + part * 8) = kreg[i]; }
#pragma unroll
        for (int i = 0; i < 4; ++i) { const int idx = tid + 512 * i, e = idx >> 4, part = idx & 15; *(LAS u32x4*)(VTs + e * 136 + part * 8) = vreg[i]; } };
    issue(0);
#pragma unroll
    for (int it = 0; it < 2; ++it) { const int row = it * 64 + (tid >> 3), p8 = tid & 7, tok = qtok0 + row; const bf16_t* qr = (const bf16_t*)(p.ws + OFF_QRAW) + (size_t)tok * 384 + h * 96; float x[16];
      if (p8 < 4) ld16bf(qr + p8 * 16, x); else { ld4bf(qr + 64 + (p8 - 4) * 4, x); ld4bf(qr + 80 + (p8 - 4) * 4, x + 4); }
      head_row_finish(x, p8, qhn, p.in[I_KHNORM] + l * 96, smp, qb * 128 + row, R, 0.10206207261596575f * 1.4426950408889634f, Ks0 + 128 * 104 + row * 104); }
    __syncthreads();
    const int rt = wid & 3, kh = wid >> 2;
    bf16x8 qa[2][3];
#pragma unroll
    for (int mt = 0; mt < 2; ++mt)
#pragma unroll
        for (int ks = 0; ks < 3; ++ks) qa[mt][ks] = LDSFRAG(Ks0 + 128 * 104 + (rt * 32 + mt * 16 + lr) * 104 + ks * 32 + lq * 8);
    commit(0);
    __syncthreads();
    f32x4 oacc[2][8]; float mrow[2], lrow[2];
#pragma unroll
    for (int mt = 0; mt < 2; ++mt) {
#pragma unroll
        for (int e = 0; e < 8; ++e) oacc[mt][e] = (f32x4){0.f, 0.f, 0.f, 0.f};
        mrow[mt] = -1e30f; lrow[mt] = 0.f; }
    const int kbase = kh * 64;
    for (int kt = 0; kt < nkt; ++kt) {
        if (kt + 1 < nkt) issue(kt + 1);
        const LAS bf16_t* Ks = Ks0 + (kt & 1) * 128 * 104; const LAS bf16_t* VTs = VTs0 + (kt & 1) * 128 * 136;
        f32x4 sacc[2][4];
#pragma unroll
        for (int nt = 0; nt < 4; ++nt) { sacc[0][nt] = (f32x4){0.f, 0.f, 0.f, 0.f}; sacc[1][nt] = sacc[0][nt];
#pragma unroll
            for (int ks = 0; ks < 3; ++ks) { const bf16x8 kf = LDSFRAG(Ks + (kbase + nt * 16 + lr) * 104 + ks * 32 + lq * 8); sacc[0][nt] = MFMA16(kf, qa[0][ks], sacc[0][nt]); sacc[1][nt] = MFMA16(kf, qa[1][ks], sacc[1][nt]); } }
        bf16x8 pb[2][2];
#pragma unroll
        for (int mt = 0; mt < 2; ++mt) {
            float mx = -1e30f;
#pragma unroll
            for (int nt = 0; nt < 4; ++nt) mx = fmaxf(mx, fmaxf(fmaxf(sacc[mt][nt][0], sacc[mt][nt][1]), fmaxf(sacc[mt][nt][2], sacc[mt][nt][3])));
            mx = fmaxf(mx, __shfl_xor(mx, 16)); mx = fmaxf(mx, __shfl_xor(mx, 32));
            const float mn = fmaxf(mrow[mt], mx), alpha = __builtin_amdgcn_exp2f(mrow[mt] - mn); mrow[mt] = mn;
            float pv[4][4]; float rs = 0.f;
#pragma unroll
            for (int nt = 0; nt < 4; ++nt)
#pragma unroll
                for (int r = 0; r < 4; ++r) { pv[nt][r] = __builtin_amdgcn_exp2f(sacc[mt][nt][r] - mn); rs += pv[nt][r]; }
            lrow[mt] = lrow[mt] * alpha + rs;
#pragma unroll
            for (int k2 = 0; k2 < 2; ++k2) { u32x4 w; w.x = pk2(pv[2 * k2][0], pv[2 * k2][1]); w.y = pk2(pv[2 * k2][2], pv[2 * k2][3]); w.z = pk2(pv[2 * k2 + 1][0], pv[2 * k2 + 1][1]); w.w = pk2(pv[2 * k2 + 1][2], pv[2 * k2 + 1][3]);
                pb[mt][k2] = __builtin_bit_cast(bf16x8, w); }
#pragma unroll
            for (int e = 0; e < 8; ++e) oacc[mt][e] *= alpha; }
#pragma unroll
        for (int k2 = 0; k2 < 2; ++k2)
#pragma unroll
            for (int e = 0; e < 8; ++e) { const LAS bf16_t* vp = VTs + (e * 16 + lr) * 136 + kbase + k2 * 32 + 4 * lq;
                const u32x2 lo = *(const LAS u32x2*)vp, hi = *(const LAS u32x2*)(vp + 16);
                const bf16x8 vf = __builtin_bit_cast(bf16x8, (u32x4){lo.x, lo.y, hi.x, hi.y});
                oacc[0][e] = MFMA16(vf, pb[0][k2], oacc[0][e]); oacc[1][e] = MFMA16(vf, pb[1][k2], oacc[1][e]); }
        if (kt + 1 < nkt) commit((kt + 1) & 1);
        __syncthreads();
    }
#pragma unroll
    for (int mt = 0; mt < 2; ++mt) { float s_ = lrow[mt]; s_ += __shfl_xor(s_, 16); s_ += __shfl_xor(s_, 32); lrow[mt] = s_; }
    LAS float* Mo = Mg + rt * 32 * 132; LAS float* Ml = Mg + 4 * 32 * 132 + rt * 64;
    if (kh == 1) {
#pragma unroll
        for (int mt = 0; mt < 2; ++mt) {
#pragma unroll
            for (int e = 0; e < 8; ++e) *(LAS f32x4*)(Mo + (mt * 16 + lr) * 132 + e * 16 + 4 * lq) = oacc[mt][e];
            if (lq == 0) { Ml[(mt * 16 + lr) * 2] = mrow[mt]; Ml[(mt * 16 + lr) * 2 + 1] = lrow[mt]; } }
    }
    __syncthreads();
    if (kh == 0) { bf16_t* AM = (bf16_t*)(p.ws + OFF_AMLA);
#pragma unroll
        for (int mt = 0; mt < 2; ++mt) { const int row = mt * 16 + lr, tok = qtok0 + rt * 32 + row;
            u32x2 gt[8];
#pragma unroll
            for (int e = 0; e < 8; ++e) gt[e] = *(const u32x2*)(Z + (size_t)tok * LDZ + ZMG + h * 128 + e * 16 + 4 * lq);
            const float m2 = Ml[row * 2], l2 = Ml[row * 2 + 1]; const float mm = fmaxf(mrow[mt], m2), a1 = __builtin_amdgcn_exp2f(mrow[mt] - mm), a2 = __builtin_amdgcn_exp2f(m2 - mm);
            const float inv = 1.f / (lrow[mt] * a1 + l2 * a2);
#pragma unroll
            for (int e = 0; e < 8; ++e) { const f32x4 o2 = *(const LAS f32x4*)(Mo + row * 132 + e * 16 + 4 * lq); float o[4];
#pragma unroll
                for (int r = 0; r < 4; ++r) o[r] = (oacc[mt][e][r] * a1 + o2[r] * a2) * inv;
                const float g0 = lo16(gt[e].x), g1 = hi16(gt[e].x), g2 = lo16(gt[e].y), g3 = hi16(gt[e].y);
                *(u32x2*)(AM + (size_t)tok * 512 + h * 128 + e * 16 + 4 * lq) = (u32x2){pk2(o[0] * siluf_(g0), o[1] * siluf_(g1)), pk2(o[2] * siluf_(g2), o[3] * siluf_(g3))}; } } }
    __syncthreads();
}


#define XB_TMO      128
#define XB_XCNT(j)  (256  + 64 * (j))
#define XB_XSUB(j)  (1280 + 64 * (j))
#define XB_XGEN(j)  (2304 + 64 * (j))
#define XB_TOP      3328
#define XB_TOPGEN   3392
#define XCD_BAR_WORDS 3456
#define XB_SPIN_CAP (1u << 18)

__device__ __forceinline__ unsigned xb_ld(unsigned* p)              { return __hip_atomic_load(p, __ATOMIC_RELAXED, __HIP_MEMORY_SCOPE_AGENT); }
__device__ __forceinline__ unsigned xb_add(unsigned* p, unsigned v) { return __hip_atomic_fetch_add(p, v, __ATOMIC_RELAXED, __HIP_MEMORY_SCOPE_AGENT); }
__device__ __forceinline__ unsigned xb_xcc_id() { return (unsigned)__builtin_amdgcn_s_getreg((3 << 11) | 20) & 0xFu; }
#define XB_SPIN(cond, bar) do { unsigned _sp = 0; while (cond) { __builtin_amdgcn_s_sleep(1); \
    if ((++_sp & 255u) == 0u) { if (xb_ld(&(bar)[XB_TMO])) break; if (_sp > XB_SPIN_CAP) { atomicAdd(&(bar)[XB_TMO], 1u); break; } } } } while (0)

struct XcdBarrier {
    int wid; unsigned* bar; unsigned x;
    volatile LAS unsigned* st;
};

__device__ __forceinline__ XcdBarrier xcd_barrier_post(unsigned* bar, volatile LAS unsigned* st) {
    XcdBarrier b; b.bar = bar; b.x = xb_xcc_id(); b.st = st;
    if (threadIdx.x == 0) (void)xb_add(&bar[XB_XCNT(b.x)], 1u);
    return b;
}
__device__ __forceinline__ void xcd_barrier_complete(unsigned* bar, unsigned x, unsigned& nloc, unsigned& nx) {
    const unsigned G = gridDim.x * gridDim.y * gridDim.z;
    unsigned sum, cnt, mine, sp = 0u;
    for (;;) {
        sum = 0u; cnt = 0u; mine = 0u;
#pragma unroll
        for (unsigned j = 0; j < 16; ++j) { const unsigned c = xb_ld(&bar[XB_XCNT(j)]); sum += c; cnt += (c > 0u) ? 1u : 0u; mine = (j == x) ? c : mine; }
        if (sum == G) break;
        __builtin_amdgcn_s_sleep(1);
        if ((++sp & 255u) == 0u) { if (xb_ld(&bar[XB_TMO])) break; if (sp > XB_SPIN_CAP) { atomicAdd(&bar[XB_TMO], 1u); break; } }
    }
    nloc = mine > 0u ? mine : 1u; nx = cnt > 0u ? cnt : 1u;
}

__device__ __forceinline__ void xcd_barrier(const XcdBarrier& b) {
    asm volatile("s_waitcnt vmcnt(0)" ::: "memory");
    __syncthreads();
    if (b.wid == 0 && lane_id_() == 0) {
        unsigned* bar = b.bar;
        __builtin_amdgcn_s_waitcnt(0);
        unsigned nloc = b.st[0], nx = b.st[1];
        if (nloc == 0u) { xcd_barrier_complete(bar, b.x, nloc, nx); b.st[0] = nloc; b.st[1] = nx; }
        const unsigned old = xb_add(&bar[XB_XSUB(b.x)], 1u);
        const unsigned gen = old / nloc;
        if (old + 1u == (gen + 1u) * nloc) {
            __builtin_amdgcn_fence(__ATOMIC_RELEASE, "agent");
            asm volatile("s_waitcnt vmcnt(0)" ::: "memory");
            const unsigned og = xb_add(&bar[XB_TOP], 1u);
            const unsigned tg = og / nx;
            if (og + 1u == (tg + 1u) * nx) xb_add(&bar[XB_TOPGEN], 1u);
            else XB_SPIN(xb_ld(&bar[XB_TOPGEN]) == tg, bar);
            __builtin_amdgcn_fence(__ATOMIC_ACQUIRE, "agent");
            xb_add(&bar[XB_XGEN(b.x)], 1u);
            asm volatile("s_waitcnt vmcnt(0)" ::: "memory");
        } else {
            XB_SPIN(xb_ld(&bar[XB_XGEN(b.x)]) == gen, bar);
            __builtin_amdgcn_fence(__ATOMIC_ACQUIRE, "agent");
            asm volatile("s_waitcnt vmcnt(0)" ::: "memory");
        }
    }
    __syncthreads();
}

constexpr int N_PHASES = 15;
#ifndef S3SEL
#define S3SEL 15
#endif
#ifndef REPEAT_MASK
#define REPEAT_MASK 0xff
#endif
#ifndef ONLY_S
#define ONLY_S -1
#endif
__device__ __forceinline__ void run_phase(const Params& p, int ph, lds_t lds, int mask = 0xff) {
    const int G = (int)gridDim.x, bid = (int)blockIdx.x;
    if (ph == 0 && (ONLY_S < 0 || ONLY_S == 7)) {
        for (int j = bid; j < 384 + 192 + 256 + 32; j += G) { if (j < 384) job_s5setup(p, 0, j, lds); else if (j < 576) job_ada(p, j - 384, lds); else if (j < 832) job_ctx(p, j - 576); else job_rope(p, j - 832); }
        return;
    }
    const int l = (ph - 1) / 7, s = (ph - 1) % 7;
    unsigned char* ws = p.ws;
    if (s == 0 && (ONLY_S < 0 || ONLY_S == 0)) {
        if (l == 0 || G < 256) { for (int j = bid; j < 384 + WT_TOTAL + 256; j += G) { if (j < 384) { if ((mask & 1) && l > 0) job_s5setup(p, l, j, lds); } else if (j < 384 + WT_TOTAL) { if (mask & 2) job_wt(p, l, j - 384, lds); } else if (mask & 4) job_prep(p, l, j - 384 - WT_TOTAL); } }
        else { for (int j = bid; j < WT_WOUT + 256; j += G) { if (j < WT_WOUT) job_wt(p, l, WT_EARLY + 3 * WT_WBO + j, lds); else job_prep(p, l, j - WT_WOUT); } }
    } else if (s == 1 && (ONLY_S < 0 || ONLY_S == 1)) {
        Order S; S.setup(8192, 4096, 0, p.wid); pg8::Gemm g{(const bf16_t*)(ws + OFF_HB), (const bf16_t*)(ws + OFF_WIN), 8192, 4096, 1024}; EpiZ E{(bf16_t*)(ws + OFF_Z)};
        pg8::gemm_phase<EpiZ, Order>(lds, g, S, E, nullptr);
    } else if (s == 2 && (ONLY_S < 0 || ONLY_S == 2)) {
        if (G == 256) {
            if (mask & 1) { const int slot = bid >> 3; job_s5(p, l, (slot >> 2) * 32 + 4 * (bid & 7) + (slot & 3), lds); }
            if (mask & 2) { job_glaA(p, l, bid, lds); job_glaA(p, l, 256 + bid, lds); }
            if (mask & 4) for (int j = bid; j < 256; j += G) job_mlaprep(p, l, j);
        } else for (int j = bid; j < 256 + 512 + 256; j += G) { if (j < 256) { if (mask & 1) job_s5(p, l, j, lds); } else if (j < 768) { if (mask & 2) job_glaA(p, l, j - 256, lds); } else if (mask & 4) job_mlaprep(p, l, j - 768); }
    } else if (s == 3 && (ONLY_S < 0 || ONLY_S == 3)) {
        if (mask & 1) { if (G == 256) { if (bid < 96) for (int j = bid; j < 640; j += 96) job_glaB(p, l, j); } else for (int j = bid; j < 640; j += G) job_glaB(p, l, j); }
        if (mask & 16) { Order S; S.setup(8192, 2816, 0, p.wid); pg8::Gemm g{(const bf16_t*)(ws + OFF_HB), (const bf16_t*)(ws + OFF_WIN) + (size_t)4096 * 1024, 8192, 2816, 1024}; EpiZ E{(bf16_t*)(ws + OFF_Z) + 4096};
          pg8::gemm_phase<EpiZ, Order>(lds, g, S, E, nullptr); }
        if ((mask & 2) && (S3SEL & 2)) { Order S; S.setup(8192, 1024, 160, p.wid); pg8::Gemm g{(const bf16_t*)(ws + OFF_YG), (const bf16_t*)(ws + OFF_WGLU), 8192, 1024, 512}; EpiGLU E{(bf16_t*)(ws + OFF_AS5), (const bf16_t*)(ws + OFF_Z), p.in[I_BGLU] + l * 1024};
          pg8::gemm_phase<EpiGLU, Order>(lds, g, S, E, nullptr); }
        if ((mask & 4) && (S3SEL & 4)) { Order S; S.setup(10240, 768, 120, p.wid); pg8::Gemm g{(const bf16_t*)(ws + (l == 0 ? OFF_CTX0 : OFF_CKVN)), (const bf16_t*)(ws + OFF_WKV), 10240, 768, 256}; EpiKV E{(bf16_t*)(ws + OFF_KF), (bf16_t*)(ws + OFF_V), l, (const bf16_t*)(ws + OFF_Z), p.in[I_CKR], p.in[I_KHNORM] + l * 96, (const float*)(ws + OFF_ROPE)};
          pg8::gemm_phase<EpiKV, Order>(lds, g, S, E, nullptr); }
        if ((mask & 8) && (S3SEL & 8)) { Order S; S.setup(8192, 512, 160, p.wid); if (G == 256) S.c = (bid >= 96 && bid < 136) ? bid - 96 : (bid >= 224 && bid < 248) ? bid - 184 : (1 << 20); pg8::Gemm g{(const bf16_t*)(ws + OFF_AQ), (const bf16_t*)(ws + OFF_WUQ), 8192, 512, 384}; EpiQ E{(bf16_t*)(ws + OFF_QRAW)};
          pg8::gemm_phase<EpiQ, Order>(lds, g, S, E, nullptr); }
    } else if (s == 4 && (ONLY_S < 0 || ONLY_S == 4)) {
        if (G == 256) {
            if (bid < 128) { const int slot = bid >> 3, pair = 2 * (bid & 7) + (slot >> 3);
                if (mask & 1) job_attn(p, l, pair * 8 + (slot & 7), lds); }
            else { const int k = bid - 128; if (mask & 1) job_attn(p, l, 128 + k, lds); if (mask & 2) { job_glaC(p, l, k, lds); job_glaC(p, l, 128 + k, lds); job_glaC(p, l, 256 + k, lds); job_glaC(p, l, 384 + k, lds); } }
        } else for (int j = bid; j < 256 + 512; j += G) { if (j < 256) { if (mask & 1) job_attn(p, l, j, lds); } else if (mask & 2) job_glaC(p, l, j - 256, lds); }
    } else if (s == 5 && (ONLY_S < 0 || ONLY_S == 5)) {
        if (l == 0 && mask == 0xff && G >= 256 && bid >= 128) { for (int j = bid - 128; j < 384 + WT_EARLY; j += G - 128) { if (j < 384) job_s5setup(p, 1, j, lds); else job_wt(p, 1, j - 384, lds); } }
        for (int br = 0; br < 3; ++br) { Order S; S.setup(8192, 1024, 0, p.wid);
            pg8::Gemm g{(const bf16_t*)(ws + (br == 0 ? OFF_AGLA : br == 1 ? OFF_AMLA : OFF_AS5)), (const bf16_t*)(ws + OFF_WBO) + (size_t)br * 1024 * 512, 8192, 1024, 512};
            EpiBo E{(bf16_t*)(ws + OFF_HB), (const bf16_t*)(ws + OFF_Z), br};
            pg8::gemm_phase<EpiBo, Order>(lds, g, S, E, nullptr); }
    } else if (s == 6 && (ONLY_S < 0 || ONLY_S == 6)) {
        if (l == 0 && mask == 0xff && G >= 256 && bid >= 128) { for (int j = bid - 128; j < 3 * WT_WBO; j += G - 128) job_wt(p, 1, WT_EARLY + j, lds); }
        Order S; S.setup(8192, 1024, 0, p.wid); pg8::Gemm g{(const bf16_t*)(ws + OFF_HB), (const bf16_t*)(ws + OFF_WOUT), 8192, 1024, 1024};
        EpiOut E{p.out, l == 0 ? p.in[I_XP] : p.out, l == 0 ? p.in[I_XS] : p.out + (size_t)4096 * 1024, (const float*)(ws + OFF_ADA) + l * 5 * 3072};
        pg8::gemm_phase<EpiOut, Order>(lds, g, S, E, nullptr);
    }
}
__global__ __launch_bounds__(512, 2) void mega(KParams kp, int ph0, int ph1) {
    extern __shared__ __attribute__((aligned(16))) unsigned char shm[];
    lds_t lds = (lds_t)shm;
    if (threadIdx.x < N_IN) ((const float**)(kp.ws + OFF_TBL))[threadIdx.x] = kp.in[threadIdx.x];
    const int wid0 = __builtin_amdgcn_readfirstlane((int)threadIdx.x >> 6);
    volatile LAS unsigned* xst = (volatile LAS unsigned*)(lds + DYN_LDS - 16);
    if (threadIdx.x == 0) { xst[0] = 0u; xst[1] = 0u; }
    __threadfence(); __syncthreads();
    XcdBarrier xb = xcd_barrier_post((unsigned*)(kp.ws + OFF_BAR), xst);
    xb.wid = wid0;
    if (ph0 > ph1) cg::this_grid().sync();
    for (int ph = ph0; ph < ph1; ++ph) {
        Params p; p.wid = wid0; { const float* const* tb = (const float* const*)(kp.ws + OFF_TBL); float* o = kp.out; unsigned char* w = kp.ws; asm volatile("" : "+s"(tb), "+s"(o), "+s"(w)); p.in = tb; p.out = o; p.ws = w; }
        int nrep = 1;
#ifdef REPEAT_S
        if ((REPEAT_S == 7 && ph == 0) || (ph > 0 && (ph - 1) % 7 == REPEAT_S && (REPEAT_S != 6 || ph < 8))) nrep = 2;
#endif
        for (int rep = 0; rep < nrep; ++rep) { if (rep) xcd_barrier(xb); run_phase(p, ph, lds, rep ? REPEAT_MASK : 0xff); }
        if (ph + 1 < ph1) xcd_barrier(xb);
    }
}

#ifndef N_LAUNCH_MODE
#define N_LAUNCH_MODE 1
#endif
extern "C" void kernel_launch(void* const* d_in, const int* in_sizes, int n_in, void* d_out, int out_size, void* d_ws, size_t ws_size, hipStream_t stream) {
    static int grid = 0;
    if (grid == 0) {
        if (n_in != N_IN || ws_size < WS_END) { fprintf(stderr, "kernel_launch: unexpected n_in %d / ws %zu (need %zu)\n", n_in, ws_size, (size_t)WS_END); grid = -1; return; }
        int dev = 0, cus = 0, per_cu = 0;
        hipGetDevice(&dev); hipDeviceGetAttribute(&cus, hipDeviceAttributeMultiprocessorCount, dev);
        hipFuncSetAttribute((const void*)mega, hipFuncAttributeMaxDynamicSharedMemorySize, DYN_LDS);
        hipOccupancyMaxActiveBlocksPerMultiprocessor(&per_cu, (const void*)mega, 512, DYN_LDS);
        if (per_cu < 1) { fprintf(stderr, "kernel_launch: occupancy query says %d blocks per CU\n", per_cu); per_cu = 1; }
        (void)hipGetLastError();
        grid = cus;
    }
    if (grid < 0) return;
    hipMemsetAsync((char*)d_ws + OFF_BAR, 0, 16384, stream);
    KParams p{};
    for (int i = 0; i < N_IN; ++i) p.in[i] = (const float*)d_in[i];
    p.out = (float*)d_out; p.ws = (unsigned char*)d_ws;
#if N_LAUNCH_MODE == 0
    for (int ph = 0; ph < N_PHASES; ++ph) { hipLaunchKernelGGL(mega, dim3(grid), dim3(512), DYN_LDS, stream, p, ph, ph + 1); }
#else
    int ph0 = 0, ph1 = N_PHASES; void* args[] = {&p, &ph0, &ph1};
    hipError_t e = hipLaunchCooperativeKernel((const void*)mega, dim3(grid), dim3(512), args, DYN_LDS, stream);
    if (e != hipSuccess) fprintf(stderr, "cooperative launch failed: %s (grid %d)\n", hipGetErrorString(e), grid);
#endif
}
```

```cpp
#include <hip/hip_runtime.h>
#include <hip/hip_cooperative_groups.h>
#include <cstdio>
namespace cg = cooperative_groups;
namespace pg8 {
#define PG8_LAS __attribute__((address_space(3)))
typedef unsigned short bf16_t;
typedef short bf16x8 __attribute__((ext_vector_type(8)));
typedef float f32x4 __attribute__((ext_vector_type(4)));
typedef unsigned u32x4 __attribute__((ext_vector_type(4)));
constexpr int BM = 256, BK = 64, HALF = 128, HTB = HALF * BK * 2  , STAGE_BYTES = 8 * HTB, NXCD = 8, WGM = 8;

__host__ __device__ __forceinline__ int lds_byte(int r, int c) { const int st = (r >> 4) * 2 + (c >> 5), rr = r & 15, cc = c & 31, ob = rr * 64 + cc * 2; return st * 1024 + (ob ^ (((ob >> 9) & 1) << 5)); }
__host__ __device__ __forceinline__ void stage_rc(int b, int& R, int& C) { const int st = b / 1024, sb = b % 1024, swz = sb ^ (((sb >> 9) & 1) << 5); R = (st >> 1) * 16 + swz / 64; C = (st & 1) * 32 + (swz % 64) / 2; }
__host__ __device__ __forceinline__ int perm32(int rho) { const int n = rho >> 4, i = rho & 15; return 8 * (i >> 2) + 4 * n + (i & 3); }

struct Unit { int pm, pn; };
struct Gemm { const bf16_t* A; const bf16_t* Bt; int M, N, K; };

struct StaticOrder {
    int nM, nN, nwg, G, c;
    __host__ __device__ void init(int M, int N, int G_, int c_) { nM = M / BM; nN = N / BM; nwg = nM * nN; G = G_; c = c_; }
    __host__ __device__ bool next(int i, Unit& u) const {
        const long L = (long)i * G + c; if (L >= nwg) return false;
        int wgid = (int)L; { const int q = nwg / NXCD, r = nwg % NXCD, xcd = wgid % NXCD, off = wgid / NXCD; wgid = (xcd < r ? xcd * (q + 1) : r * (q + 1) + (xcd - r) * q) + off; }
        const int nig = WGM * nN, gid = wgid / nig, fm = gid * WGM, gsz = (nM - fm) < WGM ? (nM - fm) : WGM;
        u.pm = fm + ((wgid % nig) % gsz); u.pn = (wgid % nig) / gsz; return true;
    }
    __device__ __forceinline__ void a_ready(const Unit&) const {}
    __device__ __forceinline__ void done(const Unit&) const {}
};
__device__ __forceinline__ unsigned cvt_pk_bf16(float lo, float hi) { unsigned r; asm volatile("v_cvt_pk_bf16_f32 %0, %1, %2" : "=v"(r) : "v"(lo), "v"(hi)); return r; }
typedef float f32x2 __attribute__((ext_vector_type(2)));
template <class Epi, class Sched, bool STAMP = false>
__device__ __forceinline__ void gemm_phase(PG8_LAS unsigned char* lds, const Gemm g, const Sched& S, const Epi& E, unsigned long long* stamps) {
    int tid_ = (S.wid << 6) | (int)__builtin_amdgcn_mbcnt_hi(~0u, __builtin_amdgcn_mbcnt_lo(~0u, 0u)); asm volatile("" : "+v"(tid_)); const int tid = tid_, wid = __builtin_amdgcn_readfirstlane(tid >> 6), lane = tid & 63, wr = wid >> 2, wc = wid & 3, fr = lane & 15, fq = lane >> 4;
    int K_ = g.K; asm volatile("" : "+s"(K_)); const int K = K_, nt = K / BK;
    int ts_lo = 0, ts_hi = 0, nts = 0; const unsigned long long rt_entry = STAMP ? (unsigned long long)wall_clock64() : 0ull;
#define PG8_STAMP() do { if (STAMP && wid == 0 && nts < 64) { const unsigned long long _c = (unsigned long long)clock64(); \
        ts_lo = (lane == nts) ? (int)(unsigned)_c : ts_lo; ts_hi = (lane == nts) ? (int)(unsigned)(_c >> 32) : ts_hi; ++nts; } } while (0)
    PG8_STAMP();
    unsigned voffA[2], voffB[2];
#pragma unroll
    for (int i = 0; i < 2; ++i) { int R, C; stage_rc(tid * 16 + i * 8192, R, C); const int Rb = Epi::PERM ? ((R & ~31) + perm32(R & 31)) : R;
        voffA[i] = (unsigned)(R * K + C) * 2u; voffB[i] = (unsigned)(Rb * K + C) * 2u; }
    const size_t kstep = (size_t)(BK * 2);
    const size_t hstep = (size_t)HALF * K * 2;
    const size_t tstep = 2 * hstep;
    const unsigned ldsw = (unsigned)wid * 1024u;
    const int aoff = lds_byte(wr * 64 + fr, fq * 8), boff = lds_byte(wc * 32 + fr, fq * 8);
#define PG8_SA(b, h) (((b) * 2 + (h)) * HTB)
#define PG8_SB(b, h) ((4 + (b) * 2 + (h)) * HTB)
#define PG8_STAGE(bufoff, gbase, voff) do { _Pragma("unroll") for (int _i = 0; _i < 2; ++_i) \
        __builtin_amdgcn_global_load_lds((const unsigned*)((const char*)(gbase) + (voff)[_i]), (PG8_LAS unsigned*)(lds + (bufoff) + ldsw + _i * 8192), 16, 0, 0); } while (0)
#define PG8_LDA(dst, b, h) do { _Pragma("unroll") for (int m = 0; m < 4; ++m) _Pragma("unroll") for (int k = 0; k < 2; ++k) dst[m][k] = *(const PG8_LAS bf16x8*)(lds + PG8_SA(b, h) + aoff + m * 2048 + k * 1024); } while (0)
#define PG8_LDB(dst, b, h) do { _Pragma("unroll") for (int n = 0; n < 2; ++n) _Pragma("unroll") for (int k = 0; k < 2; ++k) dst[n][k] = *(const PG8_LAS bf16x8*)(lds + PG8_SB(b, h) + boff + n * 2048 + k * 1024); } while (0)
#define PG8_MMA(ai, bj, At, Bt) do { __builtin_amdgcn_s_setprio(1); _Pragma("unroll") for (int m = 0; m < 4; ++m) _Pragma("unroll") for (int n = 0; n < 2; ++n) _Pragma("unroll") for (int k = 0; k < 2; ++k) \
        acc[ai][bj][m][n] = __builtin_amdgcn_mfma_f32_16x16x32_bf16(Bt[n][k], At[m][k], acc[ai][bj][m][n], 0, 0, 0); __builtin_amdgcn_s_setprio(0); } while (0)
#define PG8_WAIT_V(n) asm volatile("s_waitcnt vmcnt(" #n ")" ::: "memory")
#define PG8_WAIT_L(n) asm volatile("s_waitcnt lgkmcnt(" #n ")" ::: "memory")
#define PG8_BAR __builtin_amdgcn_s_barrier()
#define PG8_SCHED __builtin_amdgcn_sched_barrier(0)
    Unit cur, nxt; int ui = 0;
    if (!S.next(0, cur)) return;
    f32x4 acc[2][2][4][2];
#pragma unroll
    for (int a = 0; a < 2; ++a)
#pragma unroll
        for (int b = 0; b < 2; ++b)
#pragma unroll
            for (int m = 0; m < 4; ++m)
#pragma unroll
                for (int n = 0; n < 2; ++n) acc[a][b][m][n] = (f32x4){0.f, 0.f, 0.f, 0.f};
    bf16x8 At[4][2], B0[2][2], B1[2][2];
    const char* cA = (const char*)g.A + (size_t)cur.pm * tstep; const char* cB = (const char*)g.Bt + (size_t)cur.pn * tstep;
    S.a_ready(cur);
    PG8_STAGE(PG8_SB(0, 0), cB, voffB); PG8_STAGE(PG8_SA(0, 0), cA, voffA); PG8_STAGE(PG8_SB(0, 1), cB + hstep, voffB); PG8_STAGE(PG8_SA(0, 1), cA + hstep, voffA);
    if (wr == 1) PG8_BAR;
    PG8_WAIT_V(4); PG8_BAR;
    PG8_STAGE(PG8_SB(1, 0), cB + kstep, voffB); PG8_STAGE(PG8_SA(1, 0), cA + kstep, voffA); PG8_STAGE(PG8_SB(1, 1), cB + hstep + kstep, voffB);
    PG8_WAIT_V(6); PG8_BAR;
    PG8_STAMP();
    for (;;) {
        const bool has_next = S.next(ui + 1, nxt);
        const char* nA = has_next ? (const char*)g.A + (size_t)nxt.pm * tstep : cA; const char* nB = has_next ? (const char*)g.Bt + (size_t)nxt.pn * tstep : cB;
        for (int t = 0; t < nt; t += 2) {
            const bool last = (t == nt - 2);
            const char* a1 = cA + (size_t)(t + 1) * kstep;
            const char* a2 = last ? nA : cA + (size_t)(t + 2) * kstep; const char* b2 = last ? nB : cB + (size_t)(t + 2) * kstep;
            const char* a3 = a2 + kstep; const char* b3 = b2 + kstep;
            if (last && has_next) S.a_ready(nxt);
            PG8_LDB(B0, 0, 0); PG8_SCHED; PG8_LDA(At, 0, 0); PG8_STAGE(PG8_SA(1, 1), a1 + hstep, voffA);
            PG8_WAIT_L(8); PG8_BAR; PG8_WAIT_L(0); PG8_MMA(0, 0, At, B0); PG8_BAR; PG8_SCHED;
            PG8_LDB(B1, 0, 1); PG8_STAGE(PG8_SB(0, 0), b2, voffB);
            PG8_BAR; PG8_WAIT_L(0); PG8_MMA(0, 1, At, B1); PG8_BAR;
            PG8_LDA(At, 0, 1); PG8_STAGE(PG8_SA(0, 0), a2, voffA);
            PG8_BAR; PG8_WAIT_L(0); PG8_MMA(1, 0, At, B0); PG8_BAR; PG8_SCHED;
            PG8_STAGE(PG8_SB(0, 1), b2 + hstep, voffB);
            PG8_WAIT_V(6); PG8_BAR; PG8_MMA(1, 1, At, B1); PG8_BAR;
            PG8_LDB(B0, 1, 0); PG8_SCHED; PG8_LDA(At, 1, 0); PG8_STAGE(PG8_SA(0, 1), a2 + hstep, voffA);
            PG8_WAIT_L(8); PG8_BAR; PG8_WAIT_L(0); PG8_MMA(0, 0, At, B0); PG8_BAR; PG8_SCHED;
            PG8_LDB(B1, 1, 1); PG8_STAGE(PG8_SB(1, 0), b3, voffB);
            PG8_BAR; PG8_WAIT_L(0); PG8_MMA(0, 1, At, B1); PG8_BAR;
            PG8_LDA(At, 1, 1); PG8_STAGE(PG8_SA(1, 0), a3, voffA);
            PG8_BAR; PG8_WAIT_L(0); PG8_MMA(1, 0, At, B0); PG8_BAR; PG8_SCHED;
            PG8_STAGE(PG8_SB(1, 1), b3 + hstep, voffB);
            PG8_WAIT_V(6); PG8_BAR; PG8_MMA(1, 1, At, B1); PG8_BAR;
        }
        PG8_STAMP();
        if constexpr (!Epi::AFTER_DRAIN) { E(acc, cur, wr, wc, fr, fq); S.done(cur); }
        PG8_STAMP();
        if (!has_next) break;
#pragma unroll
        for (int a = 0; a < 2; ++a)
#pragma unroll
            for (int b = 0; b < 2; ++b)
#pragma unroll
                for (int m = 0; m < 4; ++m)
#pragma unroll
                    for (int n = 0; n < 2; ++n) acc[a][b][m][n] = (f32x4){0.f, 0.f, 0.f, 0.f};
        cur = nxt; cA = nA; cB = nB; ++ui;
    }
    PG8_WAIT_V(0);
    if (wr == 0) PG8_BAR;
    PG8_BAR;
    if constexpr (Epi::AFTER_DRAIN) { E.fused(acc, cur, wr, wc, fr, fq, lds, wid, lane); S.done(cur); }
    PG8_STAMP();
    if (STAMP && wid == 0) { stamps[lane] = lane < nts ? (((unsigned long long)(unsigned)ts_hi << 32) | (unsigned)ts_lo) : 0ull;
        if (lane == 62) stamps[62] = rt_entry; if (lane == 63) stamps[63] = (unsigned long long)wall_clock64(); }
#undef PG8_STAMP
#undef PG8_SA
#undef PG8_SB
#undef PG8_STAGE
#undef PG8_LDA
#undef PG8_LDB
#undef PG8_MMA
#undef PG8_WAIT_V
#undef PG8_WAIT_L
#undef PG8_BAR
#undef PG8_SCHED
}
}
using pg8::bf16_t; using pg8::bf16x8; using pg8::f32x4; using pg8::u32x4; using pg8::Unit;
#define LAS __attribute__((address_space(3)))
typedef unsigned u32x2 __attribute__((ext_vector_type(2)));
typedef LAS unsigned char* lds_t;
struct Params;
__device__ __forceinline__ int lane_id_() { return (int)__builtin_amdgcn_mbcnt_hi(~0u, __builtin_amdgcn_mbcnt_lo(~0u, 0u)); }
typedef float f32x2_t __attribute__((ext_vector_type(2)));

enum { I_XP = 0, I_XS, I_C, I_CCTX, I_CKV, I_CKR, I_SGLA, I_SS5, I_NORMW, I_WADA, I_BADA, I_WIN, I_WA2, I_BA, I_ONORM, I_QNORM, I_WUQ, I_KVNORM, I_WUK, I_WUV,
       I_QHNORM, I_KHNORM, I_ARE, I_AIM, I_LOGDT, I_BRE, I_BIM, I_CRE, I_CIM, I_S5D, I_WGLU, I_BGLU, I_WBOG, I_WBOM, I_WBOS, I_WOUT, N_IN };
struct KParams { const float* in[N_IN]; float* out; unsigned char* ws; };
struct Params { const float* const* in; float* out; unsigned char* ws; int wid; };
__device__ __forceinline__ int tid_opaque(const Params& p) { int t = (p.wid << 6) | lane_id_(); asm volatile("" : "+v"(t)); return t; }

constexpr int LDZ = 6912;
constexpr int ZQ = 0, ZK = 256, ZV = 512, ZGA = 1024, ZGG = 1056, ZMQ = 1568, ZMKV = 1952, ZMKR = 2208, ZMG = 2240, ZSU = 2752, ZSG = 3264, ZMERGE = 3776;
constexpr size_t OUT_YP = 0, OUT_CKV = 8388608, OUT_KR = 10485760, OUT_GLA = 10747904, OUT_S5 = 12845056;
constexpr size_t OFF_WIN = 0;

constexpr size_t OFF_WUQ = OFF_WIN + 14155776;
constexpr size_t OFF_WKV = OFF_WUQ + 393216;
constexpr size_t OFF_WGLU = OFF_WKV + 393216;
constexpr size_t OFF_WBO = OFF_WGLU + 1048576;
constexpr size_t OFF_WOUT = OFF_WBO + 3145728;
constexpr size_t OFF_S5M = OFF_WOUT + 2097152;
constexpr size_t OFF_V = OFF_S5M;
constexpr size_t OFF_P16 = OFF_S5M + 12582912;
constexpr size_t OFF_ADA = OFF_P16 + 32768;
constexpr size_t OFF_ROPE = OFF_ADA + 122880;
constexpr size_t OFF_CTX0 = OFF_ROPE + 131072;
constexpr size_t OFF_CKVN = OFF_CTX0 + 1048576;
constexpr size_t OFF_CTX1 = OFF_CKVN + 4194304;
constexpr size_t OFF_HB = OFF_CTX1 + 1048576;
constexpr size_t OFF_Z = OFF_HB + 16777216;
constexpr size_t OFF_KV = OFF_Z + 113246208;
constexpr size_t OFF_AGLA = OFF_KV, OFF_AMLA = OFF_KV + 8388608;
constexpr size_t OFF_QD = OFF_KV + 16777216;
constexpr size_t OFF_OIB = OFF_QD + 8388608;
constexpr size_t OFF_DEC = OFF_KV + 33554432;
constexpr size_t OFF_ST = OFF_DEC + 262144;
constexpr size_t OFF_AQ = OFF_ST + 16777216;
constexpr size_t OFF_QRAW = OFF_AQ + 6291456;
constexpr size_t OFF_AS5 = OFF_QRAW + 6291456;
constexpr size_t OFF_YG = OFF_AS5 + 8388608;
constexpr size_t OFF_TBL = OFF_YG + 8388608;
constexpr size_t OFF_BAR = OFF_TBL + 512;
constexpr size_t OFF_KF = OFF_BAR + 16384;
constexpr size_t OFF_WOUT2 = OFF_KF + 7864320;
constexpr size_t WS_END = OFF_WOUT2 + 2097152;
static_assert(WS_END <= 268435456, "workspace map exceeds 256 MiB");
constexpr int DYN_LDS = 147456;

__device__ __forceinline__ float bf2f(bf16_t b) { return __uint_as_float(((unsigned)b) << 16); }
__device__ __forceinline__ bf16_t f2bf(float f) { unsigned u = __float_as_uint(f); u += 0x7FFFu + ((u >> 16) & 1u); return (bf16_t)(u >> 16); }
__device__ __forceinline__ unsigned pk2(float lo, float hi) { return pg8::cvt_pk_bf16(lo, hi); }
__device__ __forceinline__ float lo16(unsigned w) { return __uint_as_float(w << 16); }
__device__ __forceinline__ float hi16(unsigned w) { return __uint_as_float(w & 0xffff0000u); }
__device__ __forceinline__ float sigmoidf_(float x) { return 1.f / (1.f + __expf(-x)); }
__device__ __forceinline__ float siluf_(float x) { return x / (1.f + __expf(-x)); }
__device__ __forceinline__ void store8(bf16_t* p, const f32x4& a, const f32x4& b) { u32x4 w; w.x = pk2(a[0], a[1]); w.y = pk2(a[2], a[3]); w.z = pk2(b[0], b[1]); w.w = pk2(b[2], b[3]); *(u32x4*)p = w; }
#define MFMA16(a, b, c) __builtin_amdgcn_mfma_f32_16x16x32_bf16(a, b, c, 0, 0, 0)
#define LDSFRAG(ptr) (*(const LAS bf16x8*)(ptr))

struct Order : pg8::StaticOrder { int wid;
    __device__ void setup(int M, int N, int rot, int wid_) { wid = wid_; const int G = (int)gridDim.x; init(M, N, G, (int)((blockIdx.x + (unsigned)rot) % (unsigned)G)); }
};

struct EpiZ { static constexpr bool PERM = true, AFTER_DRAIN = false; bf16_t* Z;
    __device__ __forceinline__ void operator()(const f32x4 (&acc)[2][2][4][2], const Unit& u, int wr, int wc, int fr_, int fq_) const {
        int fr = fr_, fq = fq_; asm volatile("" : "+v"(fr), "+v"(fq));
        const int row0 = u.pm * 256 + wr * 64 + fr, col0 = u.pn * 256 + wc * 32 + 8 * fq;
#pragma unroll
        for (int ai = 0; ai < 2; ++ai)
#pragma unroll
            for (int m = 0; m < 4; ++m) { bf16_t* rp = Z + (size_t)(row0 + ai * 128 + m * 16) * LDZ + col0;
#pragma unroll
                for (int bj = 0; bj < 2; ++bj) store8(rp + bj * 128, acc[ai][bj][m][0], acc[ai][bj][m][1]); }
    } };
struct EpiQ { static constexpr bool PERM = true, AFTER_DRAIN = false; bf16_t* Q;
    __device__ __forceinline__ void operator()(const f32x4 (&acc)[2][2][4][2], const Unit& u, int wr, int wc, int fr_, int fq_) const {
        int fr = fr_, fq = fq_; asm volatile("" : "+v"(fr), "+v"(fq));
        const int row0 = u.pm * 256 + wr * 64 + fr, col0 = u.pn * 256 + wc * 32 + 8 * fq;
#pragma unroll
        for (int ai = 0; ai < 2; ++ai)
#pragma unroll
            for (int m = 0; m < 4; ++m) { bf16_t* rp = Q + (size_t)(row0 + ai * 128 + m * 16) * 384 + col0;
#pragma unroll
                for (int bj = 0; bj < 2; ++bj) if (col0 + bj * 128 < 384) store8(rp + bj * 128, acc[ai][bj][m][0], acc[ai][bj][m][1]);
                }
    } };
struct EpiKV { static constexpr bool PERM = true, AFTER_DRAIN = true; bf16_t* KF; bf16_t* V; int layer; const bf16_t* Z; const float* ckr; const float* khn; const float* R;
    __device__ __forceinline__ void fused(f32x4 (&acc)[2][2][4][2], const Unit& u, int wr, int wc, int fr_, int fq_, LAS unsigned char* lds, int wid, int lane_) const {
        if (u.pn == 0) { (*this)(acc, u, wr, wc, fr_, fq_); return; }
        int fr = fr_, fq = fq_, lane = lane_; asm volatile("" : "+v"(fr), "+v"(fq), "+v"(lane));
        LAS bf16_t* T = (LAS bf16_t*)lds;
#pragma unroll
        for (int ai = 0; ai < 2; ++ai)
#pragma unroll
            for (int m = 0; m < 4; ++m) { const int kl = ai * 128 + wr * 64 + m * 16 + fr;
#pragma unroll
                for (int bj = 0; bj < 2; ++bj) { const int el = bj * 128 + wc * 32 + 8 * fq;
#pragma unroll
                    for (int i = 0; i < 8; i += 2) { const unsigned w = pk2(acc[ai][bj][m][i >> 2][i & 3], acc[ai][bj][m][i >> 2][(i & 3) + 1]); T[(el + i) * 264 + kl] = (bf16_t)(w & 0xffffu); T[(el + i + 1) * 264 + kl] = (bf16_t)(w >> 16); } } }
        __syncthreads();
        int rb = u.pm * 256; if (layer == 0) rb = rb < 2048 ? 8192 + rb : rb - 2048;
        bf16_t* bp; int st;
        if (rb < 4096) { bp = V + (size_t)(rb >> 8) * 4 * 128 * 256; st = 256; }
        else if (rb < 8192) { bp = V + 2097152 + (size_t)((rb - 4096) >> 10) * 4 * 128 * 1536 + 512 + ((rb - 4096) & 1023); st = 1536; }
        else { bp = V + 2097152 + (size_t)((rb - 8192) >> 9) * 4 * 128 * 1536 + ((rb - 8192) & 511); st = 1536; }
        const int tid = wid * 64 + lane;
#pragma unroll
        for (int i = 0; i < 16; ++i) { const int idx = tid + 512 * i, el = idx >> 5, part = idx & 31;
            *(u32x4*)(bp + (size_t)((u.pn - 1) * 256 + el) * st + part * 8) = *(const LAS u32x4*)(T + el * 264 + part * 8); }
        __syncthreads();
    }
    __device__ __forceinline__ void operator()(const f32x4 (&acc)[2][2][4][2], const Unit& u, int wr, int wc, int fr_, int fq_) const {
        int fr = fr_, fq = fq_; asm volatile("" : "+v"(fr), "+v"(fq));
        int rb = u.pm * 256; if (layer == 0) rb = rb < 2048 ? 8192 + rb : rb - 2048;
        const int row0 = rb + wr * 64 + fr;
        float w1[4], w2[4];
#pragma unroll
        for (int i = 0; i < 4; ++i) { w1[i] = khn[64 + 4 * fq + i]; w2[i] = khn[80 + 4 * fq + i]; }
#pragma unroll
        for (int ai = 0; ai < 2; ++ai)
#pragma unroll
          for (int mh = 0; mh < 4; mh += 1) {
            float x1[4][4], x2[4][4], cs[4][4], sn[4][4];
#pragma unroll
            for (int m = mh; m < mh + 1; ++m) { const int r = row0 + ai * 128 + m * 16;
                if (r >= 8192) { const int j = r - 8192; const float* kr = ckr + ((size_t)(((j >> 9) * 2 + layer) * 512 + (j & 511))) * 32 + 4 * fq;
                    const f32x4 a = *(const f32x4*)kr, b = *(const f32x4*)(kr + 16);
#pragma unroll
                    for (int i = 0; i < 4; ++i) { x1[m][i] = a[i]; x2[m][i] = b[i]; } }
                else { const bf16_t* kr = Z + (size_t)r * LDZ + ZMKR + 4 * fq; const u32x2 a = *(const u32x2*)kr, b = *(const u32x2*)(kr + 16);
                    x1[m][0] = lo16(a.x); x1[m][1] = hi16(a.x); x1[m][2] = lo16(a.y); x1[m][3] = hi16(a.y); x2[m][0] = lo16(b.x); x2[m][1] = hi16(b.x); x2[m][2] = lo16(b.y); x2[m][3] = hi16(b.y); }
                const bool rot = r >= 4096 && r < 8192; const int pos = (r - 4096) & 1023;
                if (rot) { const f32x4 c = *(const f32x4*)(R + pos * 16 + 4 * fq), s_ = *(const f32x4*)(R + 16384 + pos * 16 + 4 * fq);
#pragma unroll
                    for (int i = 0; i < 4; ++i) { cs[m][i] = c[i]; sn[m][i] = s_[i]; } }
                else {
#pragma unroll
                    for (int i = 0; i < 4; ++i) { cs[m][i] = 1.f; sn[m][i] = 0.f; } } }
#pragma unroll
            for (int m = mh; m < mh + 1; ++m) { const int r = row0 + ai * 128 + m * 16;
                float ss = 0.f;
#pragma unroll
                for (int bj = 0; bj < 2; ++bj)
#pragma unroll
                    for (int i = 0; i < 8; ++i) { const float v = acc[ai][bj][m][i >> 2][i & 3]; ss += v * v; }
#pragma unroll
                for (int i = 0; i < 4; ++i) ss += x1[m][i] * x1[m][i] + x2[m][i] * x2[m][i];
                ss += __shfl_xor(ss, 16); ss += __shfl_xor(ss, 32);
                const float rstd = rsqrtf(ss * (1.f / 96.f) + 1e-6f);
                bf16_t* kp = KF + (size_t)r * 384 + wc * 96;
#pragma unroll
                for (int bj = 0; bj < 2; ++bj) { u32x4 w; const f32x4 v0 = acc[ai][bj][m][0], v1 = acc[ai][bj][m][1];
                    w.x = pk2(v0[0] * rstd, v0[1] * rstd); w.y = pk2(v0[2] * rstd, v0[3] * rstd);
                    w.z = pk2(v1[0] * rstd, v1[1] * rstd); w.w = pk2(v1[2] * rstd, v1[3] * rstd);
                    *(u32x4*)(kp + 32 * bj + 8 * fq) = w; }
                float o1[4], o2[4];
#pragma unroll
                for (int i = 0; i < 4; ++i) { const float a = x1[m][i] * rstd * w1[i], b = x2[m][i] * rstd * w2[i]; o1[i] = a * cs[m][i] - b * sn[m][i]; o2[i] = a * sn[m][i] + b * cs[m][i]; }
                *(u32x2*)(kp + 64 + 4 * fq) = (u32x2){pk2(o1[0], o1[1]), pk2(o1[2], o1[3])}; *(u32x2*)(kp + 80 + 4 * fq) = (u32x2){pk2(o2[0], o2[1]), pk2(o2[2], o2[3])}; }
            __builtin_amdgcn_sched_barrier(0); }
    } };
struct EpiGLU { static constexpr bool PERM = true, AFTER_DRAIN = false; bf16_t* O; const bf16_t* Z; const float* bias;
    __device__ __forceinline__ void operator()(const f32x4 (&acc)[2][2][4][2], const Unit& u, int wr, int wc, int fr_, int fq_) const {
        int fr = fr_, fq = fq_; asm volatile("" : "+v"(fr), "+v"(fq));
        const int row0 = u.pm * 256 + wr * 64 + fr, oc = u.pn * 128 + wc * 32 + 8 * fq;
#pragma unroll
        for (int ai = 0; ai < 2; ++ai) {
            float bv[8], bg[8];
            { const f32x4 b0 = *(const f32x4*)(bias + oc), b1 = *(const f32x4*)(bias + oc + 4), g0 = *(const f32x4*)(bias + 512 + oc), g1 = *(const f32x4*)(bias + 512 + oc + 4);
#pragma unroll
              for (int i = 0; i < 4; ++i) { bv[i] = b0[i]; bv[4 + i] = b1[i]; bg[i] = g0[i]; bg[4 + i] = g1[i]; } }
            u32x4 sgv[2][4];
#pragma unroll
            for (int m = 0; m < 4; ++m) sgv[ai][m] = *(const u32x4*)(Z + (size_t)(row0 + ai * 128 + m * 16) * LDZ + ZSG + oc);
#pragma unroll
            for (int m = 0; m < 4; ++m) { const size_t r = (size_t)(row0 + ai * 128 + m * 16);
                const u32x4 sg = sgv[ai][m];
                float g[8] = { lo16(sg.x), hi16(sg.x), lo16(sg.y), hi16(sg.y), lo16(sg.z), hi16(sg.z), lo16(sg.w), hi16(sg.w) };
                float o[8];
#pragma unroll
                for (int i = 0; i < 8; ++i) { const float zv = acc[ai][0][m][i >> 2][i & 3] + bv[i], zg = acc[ai][1][m][i >> 2][i & 3] + bg[i]; o[i] = zv * sigmoidf_(zg) * siluf_(g[i]); }
                u32x4 w; w.x = pk2(o[0], o[1]); w.y = pk2(o[2], o[3]); w.z = pk2(o[4], o[5]); w.w = pk2(o[6], o[7]);
                *(u32x4*)(O + r * 512 + oc) = w; }
            __builtin_amdgcn_sched_barrier(0); }
    } };
struct EpiBo { static constexpr bool PERM = true, AFTER_DRAIN = true; bf16_t* MIX; const bf16_t* Z; int branch;
    __device__ __forceinline__ void fused(f32x4 (&acc)[2][2][4][2], const Unit& u, int wr, int wc, int fr_, int fq_, LAS unsigned char* lds, int wid, int lane_) const {
        int fr = fr_, fq = fq_, lane = lane_; asm volatile("" : "+v"(fr), "+v"(fq), "+v"(lane));
        const int row0 = u.pm * 256 + wr * 64 + fr, col0 = u.pn * 256 + wc * 32 + 8 * fq;
        LAS unsigned char* wl = lds + wid * 16384;
#pragma unroll
        for (int ai = 0; ai < 2; ++ai)
#pragma unroll
            for (int m = 0; m < 4; ++m)
#pragma unroll
                for (int bj = 0; bj < 2; ++bj)
                    __builtin_amdgcn_global_load_lds((const unsigned*)(Z + (size_t)(row0 + ai * 128 + m * 16) * LDZ + ZMERGE + branch * 1024 + col0 + bj * 128), (LAS unsigned*)(wl + ((ai * 4 + m) * 2 + bj) * 1024), 16, 0, 0);
#pragma unroll
        for (int ai = 0; ai < 2; ++ai) {
            u32x4 pv[4][2];
#pragma unroll
            for (int m = 0; m < 4; ++m)
#pragma unroll
                for (int bj = 0; bj < 2; ++bj) pv[m][bj] = branch > 0 ? *(const u32x4*)(MIX + (size_t)(row0 + ai * 128 + m * 16) * 1024 + col0 + bj * 128) : (u32x4){0u, 0u, 0u, 0u};
            if (ai == 0) { asm volatile("s_waitcnt vmcnt(0)" ::: "memory"); __builtin_amdgcn_s_barrier(); asm volatile("" ::: "memory"); }
#pragma unroll
            for (int m = 0; m < 4; ++m) { const size_t r = (size_t)(row0 + ai * 128 + m * 16);
#pragma unroll
                for (int bj = 0; bj < 2; ++bj) { const u32x4 sg = *(const LAS u32x4*)(wl + ((ai * 4 + m) * 2 + bj) * 1024 + lane * 16), pp = pv[m][bj];
                    const float g[8] = { lo16(sg.x), hi16(sg.x), lo16(sg.y), hi16(sg.y), lo16(sg.z), hi16(sg.z), lo16(sg.w), hi16(sg.w) };
                    const float q[8] = { lo16(pp.x), hi16(pp.x), lo16(pp.y), hi16(pp.y), lo16(pp.z), hi16(pp.z), lo16(pp.w), hi16(pp.w) };
                    float o[8];
#pragma unroll
                    for (int i = 0; i < 8; ++i) o[i] = q[i] + sigmoidf_(g[i]) * acc[ai][bj][m][i >> 2][i & 3];
                    u32x4 w; w.x = pk2(o[0], o[1]); w.y = pk2(o[2], o[3]); w.z = pk2(o[4], o[5]); w.w = pk2(o[6], o[7]);
                    *(u32x4*)(MIX + r * 1024 + col0 + bj * 128) = w; } }
            __builtin_amdgcn_sched_barrier(0); }
        __syncthreads();
    }
    __device__ __forceinline__ void operator()(const f32x4 (&acc)[2][2][4][2], const Unit& u, int wr, int wc, int fr_, int fq_) const {
        int fr = fr_, fq = fq_; asm volatile("" : "+v"(fr), "+v"(fq));
        const int row0 = u.pm * 256 + wr * 64 + fr, col0 = u.pn * 256 + wc * 32 + 8 * fq;
#pragma unroll
        for (int ai = 0; ai < 2; ++ai)
#pragma unroll
          for (int mh = 0; mh < 4; mh += 2) {
            u32x4 gz[4][2], pv[4][2];
#pragma unroll
            for (int m = mh; m < mh + 2; ++m)
#pragma unroll
                for (int bj = 0; bj < 2; ++bj) { const size_t r = (size_t)(row0 + ai * 128 + m * 16);
                    gz[m][bj] = *(const u32x4*)(Z + r * LDZ + ZMERGE + branch * 1024 + col0 + bj * 128);
                    pv[m][bj] = branch > 0 ? *(const u32x4*)(MIX + r * 1024 + col0 + bj * 128) : (u32x4){0u, 0u, 0u, 0u}; }
#pragma unroll
            for (int m = mh; m < mh + 2; ++m) { const size_t r = (size_t)(row0 + ai * 128 + m * 16);
#pragma unroll
                for (int bj = 0; bj < 2; ++bj) { const u32x4 sg = gz[m][bj], pp = pv[m][bj];
                    const float g[8] = { lo16(sg.x), hi16(sg.x), lo16(sg.y), hi16(sg.y), lo16(sg.z), hi16(sg.z), lo16(sg.w), hi16(sg.w) };
                    const float q[8] = { lo16(pp.x), hi16(pp.x), lo16(pp.y), hi16(pp.y), lo16(pp.z), hi16(pp.z), lo16(pp.w), hi16(pp.w) };
                    float o[8];
#pragma unroll
                    for (int i = 0; i < 8; ++i) o[i] = q[i] + sigmoidf_(g[i]) * acc[ai][bj][m][i >> 2][i & 3];
                    u32x4 w; w.x = pk2(o[0], o[1]); w.y = pk2(o[2], o[3]); w.z = pk2(o[4], o[5]); w.w = pk2(o[6], o[7]);
                    *(u32x4*)(MIX + r * 1024 + col0 + bj * 128) = w; } }
            __builtin_amdgcn_sched_barrier(0); }
    } };
struct EpiOut { static constexpr bool PERM = false, AFTER_DRAIN = true; float* Y; const float* xp; const float* xs; const float* ada;
    __device__ __forceinline__ void fused(f32x4 (&acc)[2][2][4][2], const Unit& u, int wr, int wc, int fr_, int fq_, LAS unsigned char* lds, int wid, int lane_) const {
        int fr = fr_, fq = fq_, lane = lane_; asm volatile("" : "+v"(fr), "+v"(fq), "+v"(lane));
        const int row0 = u.pm * 256 + wr * 64 + fr, col0 = u.pn * 256 + wc * 32 + 4 * fq;
        LAS unsigned char* wl = lds + wid * 16384;
        const float* xb = (u.pm < 16 ? xp + (size_t)row0 * 1024 : xs + (size_t)(row0 - 4096) * 1024) + col0;
#pragma unroll
        for (int m = 0; m < 4; ++m)
#pragma unroll
            for (int bj = 0; bj < 2; ++bj)
#pragma unroll
                for (int n = 0; n < 2; ++n) __builtin_amdgcn_global_load_lds((const unsigned*)(xb + (size_t)(m * 16) * 1024 + bj * 128 + n * 16), (LAS unsigned*)(wl + ((m * 2 + bj) * 2 + n) * 1024), 16, 0, 0);
        f32x4 x1[4][2][2];
#pragma unroll
        for (int m = 0; m < 4; ++m)
#pragma unroll
            for (int bj = 0; bj < 2; ++bj)
#pragma unroll
                for (int n = 0; n < 2; ++n) x1[m][bj][n] = *(const f32x4*)(xb + (size_t)(128 + m * 16) * 1024 + bj * 128 + n * 16);
        const int ar = u.pm < 16 ? 0 : 1 + ((u.pm - 16) >> 2);
        const float* gp = ada + ar * 3072 + 2048;
        f32x4 gv[2][2];
#pragma unroll
        for (int bj = 0; bj < 2; ++bj)
#pragma unroll
            for (int n = 0; n < 2; ++n) gv[bj][n] = *(const f32x4*)(gp + col0 + bj * 128 + n * 16);
        asm volatile("s_waitcnt vmcnt(0)" ::: "memory"); __builtin_amdgcn_s_barrier(); asm volatile("" ::: "memory");
        float* yb = Y + (size_t)row0 * 1024 + col0;
#pragma unroll
        for (int m = 0; m < 4; ++m)
#pragma unroll
            for (int bj = 0; bj < 2; ++bj)
#pragma unroll
                for (int n = 0; n < 2; ++n) { const f32x4 xv = *(const LAS f32x4*)(wl + ((m * 2 + bj) * 2 + n) * 1024 + lane * 16);
                    *(f32x4*)(yb + (size_t)(m * 16) * 1024 + bj * 128 + n * 16) = xv + gv[bj][n] * acc[0][bj][m][n];
                    *(f32x4*)(yb + (size_t)(128 + m * 16) * 1024 + bj * 128 + n * 16) = x1[m][bj][n] + gv[bj][n] * acc[1][bj][m][n]; }
        __syncthreads();
    }
    __device__ __forceinline__ void operator()(const f32x4 (&acc)[2][2][4][2], const Unit& u, int wr, int wc, int fr_, int fq_) const {
        int fr = fr_, fq = fq_; asm volatile("" : "+v"(fr), "+v"(fq));
        const int row0 = u.pm * 256 + wr * 64 + fr, col0 = u.pn * 256 + wc * 32 + 4 * fq;
        const int ar = u.pm < 16 ? 0 : 1 + ((u.pm - 16) >> 2);
        const float* gp = ada + ar * 3072 + 2048;
        f32x4 gv[2][2];
#pragma unroll
        for (int bj = 0; bj < 2; ++bj)
#pragma unroll
            for (int n = 0; n < 2; ++n) gv[bj][n] = *(const f32x4*)(gp + col0 + bj * 128 + n * 16);
#pragma unroll
        for (int ai = 0; ai < 2; ++ai)
#pragma unroll
          for (int mh = 0; mh < 4; mh += 2) {
            f32x4 xv[4][2][2];
#pragma unroll
            for (int m = mh; m < mh + 2; ++m) { const int r = row0 + ai * 128 + m * 16;
                const float* xr = (r < 4096 ? xp + (size_t)r * 1024 : xs + (size_t)(r - 4096) * 1024) + col0;
#pragma unroll
                for (int bj = 0; bj < 2; ++bj)
#pragma unroll
                    for (int n = 0; n < 2; ++n) xv[m][bj][n] = *(const f32x4*)(xr + bj * 128 + n * 16); }
#pragma unroll
            for (int m = mh; m < mh + 2; ++m) { const int r = row0 + ai * 128 + m * 16;
                float* yr = Y + (size_t)r * 1024 + col0;
#pragma unroll
                for (int bj = 0; bj < 2; ++bj)
#pragma unroll
                    for (int n = 0; n < 2; ++n) *(f32x4*)(yr + bj * 128 + n * 16) = xv[m][bj][n] + gv[bj][n] * acc[ai][bj][m][n]; }
            __builtin_amdgcn_sched_barrier(0); }
    } };

__device__ __forceinline__ void job_ada(const Params& p, int j, lds_t lds) {
    LAS float* sc = (LAS float*)lds; LAS float* red = sc + 5 * 1024;
    const int l = j / 96, c0 = (j % 96) * 32, tid = tid_opaque(p);
    for (int i = tid; i < 5 * 1024; i += 512) { const int r = i >> 10, k = i & 1023; const float v = r == 0 ? p.in[I_CCTX][k] : p.in[I_C][(r - 1) * 1024 + k]; sc[i] = v / (1.f + expf(-v)); }
    __syncthreads();
    const int col = tid & 31, kg = tid >> 5; const float* W = p.in[I_WADA] + (size_t)l * 1024 * 3072 + (size_t)(kg * 64) * 3072 + c0 + col;
    float a0 = 0.f, a1 = 0.f, a2 = 0.f, a3 = 0.f, a4 = 0.f;
#pragma unroll 1
    for (int kb = 0; kb < 64; kb += 16) { float w[16];
#pragma unroll
        for (int i = 0; i < 16; ++i) w[i] = W[(size_t)(kb + i) * 3072];
#pragma unroll
        for (int i = 0; i < 16; ++i) { const int k = kg * 64 + kb + i; a0 += sc[k] * w[i]; a1 += sc[1024 + k] * w[i]; a2 += sc[2048 + k] * w[i]; a3 += sc[3072 + k] * w[i]; a4 += sc[4096 + k] * w[i]; } }
    red[(kg * 5 + 0) * 32 + col] = a0; red[(kg * 5 + 1) * 32 + col] = a1; red[(kg * 5 + 2) * 32 + col] = a2; red[(kg * 5 + 3) * 32 + col] = a3; red[(kg * 5 + 4) * 32 + col] = a4;
    __syncthreads();
    if (tid < 160) { const int r = tid >> 5, cc = tid & 31; float s = p.in[I_BADA][l * 3072 + c0 + cc];
        for (int g = 0; g < 16; ++g) s += red[(g * 5 + r) * 32 + cc];
        ((float*)(p.ws + OFF_ADA))[(l * 5 + r) * 3072 + c0 + cc] = s; }
    __syncthreads();
}
__device__ __forceinline__ void job_ctx(const Params& p, int j) {
    const int base = j * 4096 + tid_opaque(p) * 8; const int l = base / (2048 * 256), rem = base % (2048 * 256), row = rem >> 8, c = rem & 255, b = row >> 9, jj = row & 511;
    const float* s = p.in[I_CKV] + ((size_t)((b * 2 + l) * 512 + jj)) * 256 + c;
    const f32x4 v0 = *(const f32x4*)s, v1 = *(const f32x4*)(s + 4);
    bf16_t* d = (bf16_t*)(p.ws + (l == 0 ? OFF_CTX0 : OFF_CTX1)) + (size_t)row * 256 + c;
    store8(d, v0, v1);
}
__device__ __forceinline__ void job_rope(const Params& p, int j) {
    const int idx = j * 512 + tid_opaque(p), pos = idx >> 4, i = idx & 15, f = i & 7;
    const float inv = powf(10000.f, -(float)f / 8.f); const float ang = (float)(i < 8 ? (pos >> 6) : (pos & 63)) * inv;
    float* R = (float*)(p.ws + OFF_ROPE); R[idx] = cosf(ang); R[16384 + idx] = sinf(ang);
}

__device__ __forceinline__ void job_prep(const Params& p, int l, int j) {
    const int tid = tid_opaque(p), wid = tid >> 6, lane = tid & 63;
    const float* nw = p.in[I_NORMW] + l * 1024;
    f32x4 v[4][4]; float ss[4];
#pragma unroll
    for (int q = 0; q < 4; ++q) { const int row = j * 32 + wid * 4 + q;
        const float* x = l == 0 ? (row < 4096 ? p.in[I_XP] + (size_t)row * 1024 : p.in[I_XS] + (size_t)(row - 4096) * 1024) : p.out + (size_t)row * 1024;
#pragma unroll
        for (int i = 0; i < 4; ++i) v[q][i] = *(const f32x4*)(x + i * 256 + lane * 4); }
#pragma unroll
    for (int q = 0; q < 4; ++q) { float s_ = 0.f;
#pragma unroll
        for (int i = 0; i < 4; ++i) s_ += v[q][i][0] * v[q][i][0] + v[q][i][1] * v[q][i][1] + v[q][i][2] * v[q][i][2] + v[q][i][3] * v[q][i][3];
#pragma unroll
        for (int o = 1; o < 64; o <<= 1) s_ += __shfl_xor(s_, o);
        ss[q] = s_; }
#pragma unroll
    for (int q = 0; q < 4; ++q) { const int row = j * 32 + wid * 4 + q; const int ar = row < 4096 ? 0 : 1 + ((row - 4096) >> 10);
        const float* ada = (const float*)(p.ws + OFF_ADA) + (l * 5 + ar) * 3072;
        const float rstd = rsqrtf(ss[q] * (1.f / 1024.f) + 1e-6f);
        bf16_t* h = (bf16_t*)(p.ws + OFF_HB) + (size_t)row * 1024;
#pragma unroll
        for (int i = 0; i < 4; ++i) { const int c = i * 256 + lane * 4; const f32x4 w = *(const f32x4*)(nw + c), sh = *(const f32x4*)(ada + c), sc = *(const f32x4*)(ada + 1024 + c);
            float o[4];
#pragma unroll
            for (int k = 0; k < 4; ++k) o[k] = v[q][i][k] * rstd * w[k] * (1.f + sc[k]) + sh[k];
            u32x2 pk; pk.x = pk2(o[0], o[1]); pk.y = pk2(o[2], o[3]); *(u32x2*)(h + c) = pk; } }
}
__device__ __forceinline__ void wt_tile(const Params& p, const float* src, int ldsrc, int sbase, int nvalid, int mode, bf16_t* dst, int K, int n0, int k0, lds_t lds) {
    LAS float* t = (LAS float*)lds; const int tid = tid_opaque(p);
    const int nn = tid & 255, kh = tid >> 8; const int sc = mode == 0 ? sbase + nn : mode == 1 ? ((nn >> 7) & 1) * 512 + sbase + (nn & 127) : ((nn >> 5) & 3) * 64 + (nn >> 7) * 32 + (nn & 31); const bool ok = mode != 0 || nn < nvalid;
    float v[32];
#pragma unroll
    for (int i = 0; i < 32; ++i) v[i] = ok ? src[(size_t)(k0 + 2 * i + kh) * ldsrc + sc] : 0.f;
#pragma unroll
    for (int i = 0; i < 32; ++i) t[(2 * i + kh) * 257 + nn] = v[i];
    __syncthreads();
#pragma unroll
    for (int ps = 0; ps < 4; ++ps) { const int n = ps * 64 + (tid >> 3), kc = tid & 7; const LAS float* s = t + (kc * 8) * 257 + n; u32x4 w;
        w.x = pk2(s[0], s[257]); w.y = pk2(s[514], s[771]); w.z = pk2(s[1028], s[1285]); w.w = pk2(s[1542], s[1799]);
        *(u32x4*)(dst + (size_t)(n0 + n) * K + k0 + kc * 8) = w; }
    __syncthreads();
}
constexpr int WT_WIN = 27 * 16, WT_WUQ = 2 * 6, WT_WKV = 3 * 4, WT_WGLU = 4 * 8, WT_WBO = 4 * 8, WT_WOUT = 4 * 16, WT_EARLY = WT_WIN + WT_WUQ + WT_WKV + WT_WGLU, WT_TOTAL = WT_EARLY + 3 * WT_WBO + WT_WOUT;
__device__ __forceinline__ void job_wt(const Params& p, int l, int t, lds_t lds) {
    if (t < WT_WIN) { const int nt = t / 16, kt = t % 16; wt_tile(p, p.in[I_WIN] + (size_t)l * 1024 * 6848, 6848, nt * 256, 6848 - nt * 256, 0, (bf16_t*)(p.ws + OFF_WIN), 1024, nt * 256, kt * 64, lds); return; } t -= WT_WIN;
    if (t < WT_WUQ) { const int nt = t / 6, kt = t % 6; wt_tile(p, p.in[I_WUQ] + (size_t)l * 384 * 384, 384, nt * 256, 384 - nt * 256, 0, (bf16_t*)(p.ws + OFF_WUQ), 384, nt * 256, kt * 64, lds); return; } t -= WT_WUQ;
    if (t < WT_WKV) { const int nt = t / 4, kt = t % 4;
        if (nt == 0) wt_tile(p, p.in[I_WUK] + (size_t)l * 256 * 256, 256, 0, 256, 2, (bf16_t*)(p.ws + OFF_WKV), 256, 0, kt * 64, lds);
        else wt_tile(p, p.in[I_WUV] + (size_t)l * 256 * 512, 512, (nt - 1) * 256, 256, 0, (bf16_t*)(p.ws + OFF_WKV), 256, nt * 256, kt * 64, lds);
        return; } t -= WT_WKV;
    if (t < WT_WGLU) { const int nt = t / 8, kt = t % 8; wt_tile(p, p.in[I_WGLU] + (size_t)l * 512 * 1024, 1024, nt * 128, 256, 1, (bf16_t*)(p.ws + OFF_WGLU), 512, nt * 256, kt * 64, lds); return; } t -= WT_WGLU;
    if (t < 3 * WT_WBO) { const int br = t / WT_WBO, tt = t % WT_WBO, nt = tt / 8, kt = tt % 8;
        wt_tile(p, p.in[I_WBOG + br] + (size_t)l * 512 * 1024, 1024, nt * 256, 256, 0, (bf16_t*)(p.ws + OFF_WBO) + (size_t)br * 1024 * 512, 512, nt * 256, kt * 64, lds); return; } t -= 3 * WT_WBO;
    { const int nt = t / 16, kt = t % 16; wt_tile(p, p.in[I_WOUT] + (size_t)l * 1024 * 1024, 1024, nt * 256, 256, 0, (bf16_t*)(p.ws + (l == 0 ? OFF_WOUT : OFF_WOUT2)), 1024, nt * 256, kt * 64, lds); }
}
__device__ __forceinline__ void job_s5setup(const Params& p, int l, int jq, lds_t lds) {
    const int j = jq >> 2, qtr = jq & 3, g = j / 3, which = j % 3, tid = tid_opaque(p);
    LAS f32x2_t* pw = (LAS f32x2_t*)lds;
    LAS f32x2_t* Bt = pw + 2 * 17 * 64;
    LAS f32x2_t* Cn = Bt + 2 * 64 * 16;
    LAS float* Kt = (LAS float*)(Cn + 64 * 16);
    LAS float* raw = Kt + 8192;
    { const size_t gb = (size_t)(l * 32 + g) * 1024;
      for (int i = tid; i < 1024; i += 512) { raw[i] = p.in[I_BRE][gb + i]; raw[1024 + i] = p.in[I_BIM][gb + i]; raw[2048 + i] = p.in[I_CRE][gb + i]; raw[3072 + i] = p.in[I_CIM][gb + i]; }
      if (tid < 128) { const int d = tid >> 6, n = tid & 63; raw[4096 + tid] = p.in[I_ARE][((l * 2 + d) * 32 + g) * 64 + n]; raw[4224 + tid] = p.in[I_AIM][((l * 2 + d) * 32 + g) * 64 + n]; }
      if (tid < 2) raw[4352 + tid] = p.in[I_LOGDT][(l * 2 + tid) * 32 + g]; }
    __syncthreads();
    if (tid < 128) { const int d = tid >> 6, n = tid & 63;
        const float dt = expf(raw[4352 + d]);
        const float are = raw[4096 + tid], aim = raw[4224 + tid];
        float s1, c1; sincosf(aim * dt, &s1, &c1); float sh = sinf(0.5f * aim * dt);
        const float em1 = expm1f(are * dt), mag1 = em1 + 1.f;
        { float pr = 1.f, pi = 0.f; const float ar1 = mag1 * c1, ai1 = mag1 * s1;
          for (int tau = 0; tau <= 16; ++tau) { pw[(d * 17 + tau) * 64 + n] = (f32x2_t){pr, pi}; const float nr = pr * ar1 - pi * ai1, ni = pr * ai1 + pi * ar1; pr = nr; pi = ni; } }
        const float nre = em1 * c1 - 2.f * sh * sh, abim = mag1 * s1, den = are * are + aim * aim;
        const float cfr = (nre * are + abim * aim) / den, cfi = (abim * are - nre * aim) / den;
        for (int q = 0; q < 16; ++q) { const float br = raw[n * 16 + q], bi = raw[1024 + n * 16 + q];
            Bt[(d * 64 + n) * 16 + q] = (f32x2_t){cfr * br - cfi * bi, cfr * bi + cfi * br}; }
        if (which == 1 && qtr == 0) ((f32x2_t*)(p.ws + OFF_P16))[(g * 2 + d) * 64 + n] = pw[(d * 17 + 16) * 64 + n];
    }
    for (int i = tid; i < 1024; i += 512) { const int n = i >> 4, pp = i & 15; Cn[i] = (f32x2_t){raw[2048 + pp * 64 + n], raw[3072 + pp * 64 + n]}; }
    __syncthreads();
    bf16_t* M = (bf16_t*)(p.ws + OFF_S5M) + (size_t)(g * 3 + which) * 65536;
    if (which == 0) {
        { const int wid_ = tid >> 6, ln = tid & 63, lr_ = ln & 15, kq = ln >> 4;
          for (int c4 = 0; c4 < 4; ++c4) { const int dt_ = wid_ * 4 + c4, d = dt_ >> 4, tau = dt_ & 15; f32x4 acc = {0.f, 0.f, 0.f, 0.f};
#pragma unroll 4
            for (int ks = 0; ks < 16; ++ks) { const int n = ks * 4 + kq; const f32x2_t c = Cn[n * 16 + lr_], w = pw[(d * 17 + tau) * 64 + n], b = Bt[(d * 64 + n) * 16 + lr_];
                const float cwr = c.x * w.x - c.y * w.y, cwi = c.x * w.y + c.y * w.x;
                acc = __builtin_amdgcn_mfma_f32_16x16x4f32(cwr, b.x, acc, 0, 0, 0); acc = __builtin_amdgcn_mfma_f32_16x16x4f32(-cwi, b.y, acc, 0, 0, 0); }
#pragma unroll
            for (int r = 0; r < 4; ++r) Kt[dt_ * 256 + (kq * 4 + r) * 16 + lr_] = acc[r]; } }
        __syncthreads();
#pragma unroll 8
        for (int i = qtr * 16384 + tid; i < (qtr + 1) * 16384; i += 512) { const int no = i >> 8, k = i & 255, t = no >> 4, pp = no & 15, s = k >> 4, q = k & 15; float v;
            if (t > s) v = Kt[(0 * 16 + (t - s)) * 256 + pp * 16 + q];
            else if (t < s) v = Kt[(1 * 16 + (s - t)) * 256 + pp * 16 + q];
            else { v = Kt[pp * 16 + q] + Kt[16 * 256 + pp * 16 + q]; if (pp == q) v += p.in[I_S5D][l * 512 + g * 16 + pp]; }
            M[i] = f2bf(v); }
    } else if (which == 1) {
#pragma unroll 8
        for (int i = qtr * 16384 + tid; i < (qtr + 1) * 16384; i += 512) { const int no = i >> 8, k = i & 255, d = no >> 7, ri = (no >> 6) & 1, n = no & 63, s = k >> 4, q = k & 15; const int e = d == 0 ? 15 - s : s;
            const f32x2_t w = pw[(d * 17 + e) * 64 + n], b = Bt[(d * 64 + n) * 16 + q];
            M[i] = f2bf(ri == 0 ? w.x * b.x - w.y * b.y : w.x * b.y + w.y * b.x); }
    } else {
#pragma unroll 8
        for (int i = qtr * 16384 + tid; i < (qtr + 1) * 16384; i += 512) { const int no = i >> 8, k = i & 255, t = no >> 4, pp = no & 15, d = k >> 7, ri = (k >> 6) & 1, n = k & 63; const int e = d == 0 ? t + 1 : 16 - t;
            const f32x2_t c = Cn[n * 16 + pp], w = pw[(d * 17 + e) * 64 + n];
            M[i] = f2bf(ri == 0 ? c.x * w.x - c.y * w.y : -(c.x * w.y + c.y * w.x)); }
    }
    __syncthreads();
}

__device__ __forceinline__ float gelu_tanh(float x) { const float u = 0.7978845608f * (x + 0.044715f * x * x * x); const float t = 1.f - 2.f / (1.f + __expf(2.f * u)); return 0.5f * x * (1.f + t); }
__device__ __forceinline__ void job_s5(const Params& p, int l, int j, lds_t lds) {
    const int tid = tid_opaque(p), wid = tid >> 6, lane = tid & 63, lr = lane & 15, lq = lane >> 4;
    const int bcd = j >> 5, g = j & 31;
    const bool smp = bcd < 4;
    constexpr int M = 64, MT = 4; const int tok0 = smp ? 4096 + bcd * 1024 : (bcd - 4) * 1024;
    LAS bf16_t* Us = (LAS bf16_t*)lds; LAS bf16_t* Xs = Us + 64 * 264; LAS float* Xin = (LAS float*)(lds + 2 * 64 * 264 * 2);
    const bf16_t* Z = (const bf16_t*)(p.ws + OFF_Z);
    const bf16_t* TT = (const bf16_t*)(p.ws + OFF_S5M) + (size_t)(g * 3) * 65536; const bf16_t* G = TT + 65536; const bf16_t* Cc = G + 65536;
    bf16x8 bq[8][2];
#pragma unroll
    for (int ks = 0; ks < 8; ++ks) { bq[ks][0] = *(const bf16x8*)(G + (size_t)(wid * 32 + lr) * 256 + ks * 32 + lq * 8); bq[ks][1] = *(const bf16x8*)(G + (size_t)(wid * 32 + 16 + lr) * 256 + ks * 32 + lq * 8); }
    f32x2_t a16 = {0.f, 0.f}; float xr = 0.f, xi = 0.f;
    if (tid < 128) { const int d = tid >> 6, n = tid & 63; a16 = ((const f32x2_t*)(p.ws + OFF_P16))[(g * 2 + d) * 64 + n];
        if (smp) { const size_t o = ((size_t)((bcd * 2 + l) * 2 + d) * 2) * 2048 + g * 64 + n; xr = p.in[I_SS5][o]; xi = p.in[I_SS5][o + 2048]; } }
    for (int idx = tid; idx < M * 32; idx += 512) { const int tok = idx >> 1, hf = idx & 1;
        *(LAS u32x4*)(Us + (tok >> 4) * 264 + (tok & 15) * 16 + hf * 8) = *(const u32x4*)(Z + (size_t)(tok0 + tok) * LDZ + ZSU + g * 16 + hf * 8); }
    __syncthreads();
    f32x4 acc[4][2];
#pragma unroll
    for (int a = 0; a < 4; ++a) { acc[a][0] = (f32x4){0.f, 0.f, 0.f, 0.f}; acc[a][1] = acc[a][0]; }
#pragma unroll
    for (int ks = 0; ks < 8; ++ks)
#pragma unroll
        for (int mt = 0; mt < 4; ++mt) if (mt < MT) { const bf16x8 a = LDSFRAG(Us + (mt * 16 + lr) * 264 + ks * 32 + lq * 8); acc[mt][0] = MFMA16(a, bq[ks][0], acc[mt][0]); acc[mt][1] = MFMA16(a, bq[ks][1], acc[mt][1]); }
    bf16x8 bc[8][2];
#pragma unroll
    for (int ks = 0; ks < 8; ++ks) { bq[ks][0] = *(const bf16x8*)(TT + (size_t)(wid * 32 + lr) * 256 + ks * 32 + lq * 8); bq[ks][1] = *(const bf16x8*)(TT + (size_t)(wid * 32 + 16 + lr) * 256 + ks * 32 + lq * 8);
        bc[ks][0] = *(const bf16x8*)(Cc + (size_t)(wid * 32 + lr) * 256 + ks * 32 + lq * 8); bc[ks][1] = *(const bf16x8*)(Cc + (size_t)(wid * 32 + 16 + lr) * 256 + ks * 32 + lq * 8); }
#pragma unroll
    for (int mt = 0; mt < 4; ++mt) if (mt < MT)
#pragma unroll
        for (int ct = 0; ct < 2; ++ct)
#pragma unroll
            for (int r = 0; r < 4; ++r) Xin[(mt * 16 + lq * 4 + r) * 260 + wid * 32 + ct * 16 + lr] = acc[mt][ct][r];
    __syncthreads();
    if (tid < 128) { const int d = tid >> 6, n = tid & 63;
        const int cre = d * 128 + n, cim = cre + 64;
        const int nseg = smp ? 1 : 4, L = 64 / nseg;
        for (int sg = 0; sg < nseg; ++sg) {
            if (!smp) { xr = 0.f; xi = 0.f; }
            for (int i = 0; i < L; ++i) { const int c = sg * L + (d == 0 ? i : L - 1 - i);
                Xs[c * 264 + cre] = f2bf(xr); Xs[c * 264 + cim] = f2bf(xi);
                const float ur = Xin[c * 260 + cre], ui = Xin[c * 260 + cim];
                const float nr = a16.x * xr - a16.y * xi + ur, ni = a16.x * xi + a16.y * xr + ui; xr = nr; xi = ni; }
            if (!smp) { const int bb = (bcd - 4) * 4 + sg; const size_t o = OUT_S5 + ((size_t)((bb * 2 + l) * 2 + d) * 2) * 2048 + g * 64 + n; p.out[o] = xr; p.out[o + 2048] = xi; } }
    }
    __syncthreads();
#pragma unroll
    for (int a = 0; a < 4; ++a) { acc[a][0] = (f32x4){0.f, 0.f, 0.f, 0.f}; acc[a][1] = acc[a][0]; }
#pragma unroll
    for (int ks = 0; ks < 8; ++ks)
#pragma unroll
        for (int mt = 0; mt < 4; ++mt) if (mt < MT) { const bf16x8 a = LDSFRAG(Us + (mt * 16 + lr) * 264 + ks * 32 + lq * 8); acc[mt][0] = MFMA16(a, bq[ks][0], acc[mt][0]); acc[mt][1] = MFMA16(a, bq[ks][1], acc[mt][1]); }
#pragma unroll
    for (int ks = 0; ks < 8; ++ks)
#pragma unroll
        for (int mt = 0; mt < 4; ++mt) if (mt < MT) { const bf16x8 a = LDSFRAG(Xs + (mt * 16 + lr) * 264 + ks * 32 + lq * 8); acc[mt][0] = MFMA16(a, bc[ks][0], acc[mt][0]); acc[mt][1] = MFMA16(a, bc[ks][1], acc[mt][1]); }
    bf16_t* Yg = (bf16_t*)(p.ws + OFF_YG);
#pragma unroll
    for (int mt = 0; mt < 4; ++mt) if (mt < MT)
#pragma unroll
        for (int ct = 0; ct < 2; ++ct)
#pragma unroll
            for (int r = 0; r < 4; ++r) { const int chunk = mt * 16 + lq * 4 + r, t = wid * 2 + ct;
                Yg[(size_t)(tok0 + chunk * 16 + t) * 512 + g * 16 + lr] = f2bf(gelu_tanh(acc[mt][ct][r])); }
    __syncthreads();
}
__device__ __forceinline__ void job_mlaprep(const Params& p, int l, int j) {
    const int tid = tid_opaque(p), wid = tid >> 6, lane = tid & 63;
    bf16_t qr[4][6], kr[4][4], rr[4];
#pragma unroll
    for (int t4 = 0; t4 < 4; ++t4) { const int row = j * 32 + wid * 4 + t4; const bf16_t* z = (const bf16_t*)(p.ws + OFF_Z) + (size_t)row * LDZ;
#pragma unroll
        for (int i = 0; i < 6; ++i) qr[t4][i] = z[ZMQ + i * 64 + lane];
#pragma unroll
        for (int i = 0; i < 4; ++i) kr[t4][i] = z[ZMKV + i * 64 + lane];
        rr[t4] = z[ZMKR + (lane & 31)]; }
    float qn[6], kn[4];
#pragma unroll
    for (int i = 0; i < 6; ++i) qn[i] = p.in[I_QNORM][l * 384 + i * 64 + lane];
#pragma unroll
    for (int i = 0; i < 4; ++i) kn[i] = p.in[I_KVNORM][l * 256 + i * 64 + lane];
#pragma unroll
    for (int t4 = 0; t4 < 4; ++t4) { const int row = j * 32 + wid * 4 + t4;
        float q[6], kv[4]; float sq = 0.f, sk = 0.f;
#pragma unroll
        for (int i = 0; i < 6; ++i) { q[i] = bf2f(qr[t4][i]); sq += q[i] * q[i]; }
#pragma unroll
        for (int i = 0; i < 4; ++i) { kv[i] = bf2f(kr[t4][i]); sk += kv[i] * kv[i]; }
#pragma unroll
        for (int o = 1; o < 64; o <<= 1) { sq += __shfl_xor(sq, o); sk += __shfl_xor(sk, o); }
        const float rq = rsqrtf(sq * (1.f / 384.f) + 1e-6f), rk = rsqrtf(sk * (1.f / 256.f) + 1e-6f);
        bf16_t* aq = (bf16_t*)(p.ws + OFF_AQ) + (size_t)row * 384; bf16_t* ck = (bf16_t*)(p.ws + OFF_CKVN) + (size_t)row * 256;
#pragma unroll
        for (int i = 0; i < 6; ++i) aq[i * 64 + lane] = f2bf(q[i] * rq * qn[i]);
        const bool prompt = row < 4096; const int b = row >> 8, t = row & 255;
#pragma unroll
        for (int i = 0; i < 4; ++i) { const float v = kv[i] * rk * kn[i]; ck[i * 64 + lane] = f2bf(v);
            if (prompt) p.out[OUT_CKV + ((size_t)((b * 2 + l) * 256 + t)) * 256 + i * 64 + lane] = v; }
        if (prompt && lane < 32) p.out[OUT_KR + ((size_t)((b * 2 + l) * 256 + t)) * 32 + lane] = bf2f(rr[t4]); }
}
__device__ __forceinline__ float logsigmoidf_(float x) { return fminf(x, 0.f) - __logf(1.f + __expf(-fabsf(x))); }
__device__ __forceinline__ void job_glaA(const Params& p, int l, int j, lds_t lds) {
    const int tid = tid_opaque(p), wid = tid >> 6, lane = tid & 63, lr = lane & 15, lq = lane >> 4;
    const int ck = j >> 2, h = j & 3, tok0 = ck * 64;
    LAS bf16_t* QDf = (LAS bf16_t*)lds; LAS bf16_t* QDb = QDf + 4608; LAS bf16_t* KDf = QDb + 4608; LAS bf16_t* KDb = KDf + 4608; LAS bf16_t* KRf = KDb + 4608; LAS bf16_t* KRb = KRf + 4608;
    LAS bf16_t* VT = KRb + 4608;
    LAS bf16_t* ATT = VT + 9216;
    LAS float* GA = (LAS float*)(ATT + 4608);
    LAS float* TOT = GA + 2048;
    const bf16_t* Z = (const bf16_t*)(p.ws + OFF_Z);
    const int d = tid & 63, cg_ = tid >> 6;
    bf16_t qraw[8], kraw[8]; float wf[16], wb[16];
#pragma unroll
    for (int i = 0; i < 8; ++i) { const size_t zr = (size_t)(tok0 + cg_ * 8 + i) * LDZ; qraw[i] = Z[zr + ZQ + h * 64 + d]; kraw[i] = Z[zr + ZK + h * 64 + d]; }
#pragma unroll
    for (int r = 0; r < 16; ++r) { wf[r] = p.in[I_WA2][((size_t)((l * 2 + 0) * 16 + r)) * 256 + h * 64 + d]; wb[r] = p.in[I_WA2][((size_t)((l * 2 + 1) * 16 + r)) * 256 + h * 64 + d]; }
    const float bf_ = p.in[I_BA][(l * 2 + 0) * 256 + h * 64 + d], bb_ = p.in[I_BA][(l * 2 + 1) * 256 + h * 64 + d];
    { const int c = tid >> 3, part = tid & 7; const u32x2 gv = *(const u32x2*)(Z + (size_t)(tok0 + c) * LDZ + ZGA + part * 4);
      GA[c * 32 + part * 4 + 0] = lo16(gv.x); GA[c * 32 + part * 4 + 1] = hi16(gv.x); GA[c * 32 + part * 4 + 2] = lo16(gv.y); GA[c * 32 + part * 4 + 3] = hi16(gv.y);
      const bf16_t* vp = Z + (size_t)(tok0 + c) * LDZ + ZV + h * 128 + part * 16;
      const u32x4 v0 = *(const u32x4*)vp, v1 = *(const u32x4*)(vp + 8);
      const unsigned w[8] = { v0.x, v0.y, v0.z, v0.w, v1.x, v1.y, v1.z, v1.w };
#pragma unroll
      for (int i = 0; i < 8; ++i) { VT[(part * 16 + 2 * i) * 72 + c] = (bf16_t)(w[i] & 0xffffu); VT[(part * 16 + 2 * i + 1) * 72 + c] = (bf16_t)(w[i] >> 16); } }
    __syncthreads();
    float laf[8], lab[8];
    {
#pragma unroll
      for (int i = 0; i < 8; ++i) { const int c = cg_ * 8 + i; float xf = bf_, xb = bb_;
#pragma unroll
          for (int r = 0; r < 16; ++r) { xf += GA[c * 32 + r] * wf[r]; xb += GA[c * 32 + 16 + r] * wb[r]; }
          laf[i] = logsigmoidf_(xf) * (1.f / 16.f); lab[i] = logsigmoidf_(xb) * (1.f / 16.f); } }
#pragma unroll
    for (int i = 1; i < 8; ++i) laf[i] += laf[i - 1];
#pragma unroll
    for (int i = 6; i >= 0; --i) lab[i] += lab[i + 1];
    TOT[(0 * 8 + cg_) * 64 + d] = laf[7]; TOT[(1 * 8 + cg_) * 64 + d] = lab[0];
    __syncthreads();
    float offf = 0.f, offb = 0.f, Tf = 0.f, Tb = 0.f;
#pragma unroll
    for (int g = 0; g < 8; ++g) { const float a = TOT[g * 64 + d], b = TOT[(8 + g) * 64 + d]; Tf += a; Tb += b; if (g < cg_) offf += a; if (g > cg_) offb += b; }
    bf16_t* QD = (bf16_t*)(p.ws + OFF_QD);
#pragma unroll
    for (int i = 0; i < 8; ++i) { const int c = cg_ * 8 + i;
        const float q = bf2f(qraw[i]) * 0.125f, k = bf2f(kraw[i]);
        const float bf_ = offf + laf[i], bb_ = offb + lab[i];
        const bf16_t qf = f2bf(q * __expf(bf_)), qb = f2bf(q * __expf(bb_));
        QDf[c * 72 + d] = qf; QDb[c * 72 + d] = qb;
        KDf[c * 72 + d] = f2bf(k * __expf(-bf_)); KDb[c * 72 + d] = f2bf(k * __expf(-bb_));
        KRf[d * 72 + c] = f2bf(k * __expf(Tf - bf_)); KRb[d * 72 + c] = f2bf(k * __expf(Tb - bb_));
        QD[(size_t)(tok0 + c) * 256 + h * 64 + d] = qf; QD[(size_t)(8192 + tok0 + c) * 256 + h * 64 + d] = qb; }
    if (cg_ == 0) { float* DEC = (float*)(p.ws + OFF_DEC); DEC[((0 * 128 + ck) * 4 + h) * 64 + d] = __expf(Tf); DEC[((1 * 128 + ck) * 4 + h) * 64 + d] = __expf(Tb); }
    __syncthreads();
#pragma unroll
    for (int q2 = 0; q2 < 2; ++q2) { const int tt = wid * 2 + q2, ti = tt >> 2, tj = tt & 3; f32x4 af = {0.f, 0.f, 0.f, 0.f}, ab = af;
#pragma unroll
        for (int ks = 0; ks < 2; ++ks) { const int ko = ks * 32 + lq * 8;
            af = MFMA16(LDSFRAG(QDf + (ti * 16 + lr) * 72 + ko), LDSFRAG(KDf + (tj * 16 + lr) * 72 + ko), af);
            ab = MFMA16(LDSFRAG(QDb + (ti * 16 + lr) * 72 + ko), LDSFRAG(KDb + (tj * 16 + lr) * 72 + ko), ab); }
#pragma unroll
        for (int r = 0; r < 4; ++r) { const int c = ti * 16 + lq * 4 + r, s = tj * 16 + lr; const float v = (s <= c ? af[r] : 0.f) + (s >= c ? ab[r] : 0.f); ATT[c * 72 + s] = f2bf(v); } }
    __syncthreads();
    bf16x8 vb[2];
#pragma unroll
    for (int ks = 0; ks < 2; ++ks) vb[ks] = LDSFRAG(VT + (wid * 16 + lr) * 72 + ks * 32 + lq * 8);
    bf16_t* OI = (bf16_t*)(p.ws + OFF_OIB); bf16_t* KV = (bf16_t*)(p.ws + OFF_KV);
#pragma unroll
    for (int ct = 0; ct < 4; ++ct) { f32x4 a = {0.f, 0.f, 0.f, 0.f};
#pragma unroll
        for (int ks = 0; ks < 2; ++ks) a = MFMA16(LDSFRAG(ATT + (ct * 16 + lr) * 72 + ks * 32 + lq * 8), vb[ks], a);
#pragma unroll
        for (int r = 0; r < 4; ++r) OI[(size_t)(tok0 + ct * 16 + lq * 4 + r) * 512 + h * 128 + wid * 16 + lr] = f2bf(a[r]); }
#pragma unroll
    for (int dir = 0; dir < 2; ++dir) { const LAS bf16_t* KR = dir == 0 ? KRf : KRb; bf16_t* kvp = KV + ((size_t)((dir * 128 + ck) * 4 + h)) * 8192;
#pragma unroll
        for (int dt = 0; dt < 4; ++dt) { f32x4 a = {0.f, 0.f, 0.f, 0.f};
#pragma unroll
            for (int ks = 0; ks < 2; ++ks) a = MFMA16(LDSFRAG(KR + (dt * 16 + lr) * 72 + ks * 32 + lq * 8), vb[ks], a);
#pragma unroll
            for (int r = 0; r < 4; ++r) kvp[(dt * 16 + lq * 4 + r) * 128 + wid * 16 + lr] = f2bf(a[r]); } }
    __syncthreads();
}

__device__ __forceinline__ void job_glaB(const Params& p, int l, int j) {
    const int qt = j & 3, h = (j >> 2) & 3, rest = j >> 4, bb = rest % 20, dir = rest / 20;
    const int idx0 = qt * 2048 + tid_opaque(p);
    const int nck = bb < 16 ? 4 : 16, ck0 = bb < 16 ? bb * 4 : 64 + (bb - 16) * 16;
    float S[4];
#pragma unroll
    for (int e = 0; e < 4; ++e) S[e] = bb >= 16 ? p.in[I_SGLA][((size_t)((((bb - 16) * 2 + l) * 2 + dir) * 4 + h)) * 8192 + idx0 + e * 512] : 0.f;
    const bf16_t* KV = (const bf16_t*)(p.ws + OFF_KV); const float* DEC = (const float*)(p.ws + OFF_DEC); bf16_t* ST = (bf16_t*)(p.ws + OFF_ST);
    for (int i0 = 0; i0 < nck; i0 += 4) { float dv[4][4]; bf16_t kv[4][4]; size_t its[4];
#pragma unroll
        for (int u = 0; u < 4; ++u) { const int i = i0 + u, ck = dir == 0 ? ck0 + i : ck0 + nck - 1 - i; its[u] = (size_t)((dir * 128 + ck) * 4 + h);
#pragma unroll
            for (int e = 0; e < 4; ++e) { const int idx = idx0 + e * 512; dv[u][e] = DEC[its[u] * 64 + (idx >> 7)]; kv[u][e] = KV[its[u] * 8192 + idx]; } }
#pragma unroll
        for (int u = 0; u < 4; ++u)
#pragma unroll
            for (int e = 0; e < 4; ++e) { ST[its[u] * 8192 + idx0 + e * 512] = f2bf(S[e]); S[e] = dv[u][e] * S[e] + bf2f(kv[u][e]); } }
    if (bb < 16) {
#pragma unroll
        for (int e = 0; e < 4; ++e) p.out[OUT_GLA + ((size_t)(((bb * 2 + l) * 2 + dir) * 4 + h)) * 8192 + idx0 + e * 512] = S[e]; }
}

__device__ __forceinline__ void job_glaC(const Params& p, int l, int j, lds_t lds) {
    const int tid = tid_opaque(p), wid = tid >> 6, lane = tid & 63, lr = lane & 15, lq = lane >> 4;
    const int ck = j >> 2, h = j & 3, tok0 = ck * 64;
    LAS bf16_t* Aq = (LAS bf16_t*)lds;
    LAS bf16_t* BT = Aq + 64 * 136;
    LAS float* Os = (LAS float*)(BT + 128 * 136);
    const bf16_t* QD = (const bf16_t*)(p.ws + OFF_QD); const bf16_t* ST = (const bf16_t*)(p.ws + OFF_ST);
#pragma unroll
    for (int it = 0; it < 2; ++it) { const int idx = tid + it * 512, c = idx >> 4, rem = idx & 15, dir = rem >> 3, dc = rem & 7;
        *(LAS u32x4*)(Aq + c * 136 + dir * 64 + dc * 8) = *(const u32x4*)(QD + (size_t)(dir * 8192 + tok0 + c) * 256 + h * 64 + dc * 8); }
#pragma unroll
    for (int it = 0; it < 4; ++it) { const int idx = tid + it * 512, dir = idx >> 10, d = (idx >> 4) & 63, ec = idx & 15;
        const u32x4 v = *(const u32x4*)(ST + ((size_t)((dir * 128 + ck) * 4 + h)) * 8192 + d * 128 + ec * 8);
        const unsigned w[4] = { v.x, v.y, v.z, v.w };
#pragma unroll
        for (int i = 0; i < 4; ++i) { BT[(ec * 8 + 2 * i) * 136 + dir * 64 + d] = (bf16_t)(w[i] & 0xffffu); BT[(ec * 8 + 2 * i + 1) * 136 + dir * 64 + d] = (bf16_t)(w[i] >> 16); } }
    const int ct = wid & 3, eh = wid >> 2; const bf16_t* OI = (const bf16_t*)(p.ws + OFF_OIB);
    bf16_t oi[4][4];
#pragma unroll
    for (int e4 = 0; e4 < 4; ++e4)
#pragma unroll
        for (int r = 0; r < 4; ++r) oi[e4][r] = OI[(size_t)(tok0 + ct * 16 + lq * 4 + r) * 512 + h * 128 + (eh * 4 + e4) * 16 + lr];
    const int nc = tid >> 3, npart = tid & 7;
    const bf16_t* gz = (const bf16_t*)(p.ws + OFF_Z) + (size_t)(tok0 + nc) * LDZ + ZGG + h * 128 + npart * 16;
    const u32x4 g0 = *(const u32x4*)gz, g1 = *(const u32x4*)(gz + 8);
    f32x4 onw[4];
#pragma unroll
    for (int i = 0; i < 4; ++i) onw[i] = *(const f32x4*)(p.in[I_ONORM] + l * 128 + npart * 16 + 4 * i);
    __syncthreads();
    bf16x8 af[4];
#pragma unroll
    for (int ks = 0; ks < 4; ++ks) af[ks] = LDSFRAG(Aq + (ct * 16 + lr) * 136 + ks * 32 + lq * 8);
#pragma unroll
    for (int e4 = 0; e4 < 4; ++e4) { const int et = eh * 4 + e4; f32x4 a = {0.f, 0.f, 0.f, 0.f};
#pragma unroll
        for (int ks = 0; ks < 4; ++ks) a = MFMA16(af[ks], LDSFRAG(BT + (et * 16 + lr) * 136 + ks * 32 + lq * 8), a);
#pragma unroll
        for (int r = 0; r < 4; ++r) { const int row = ct * 16 + lq * 4 + r, col = et * 16 + lr; Os[row * 132 + col] = a[r] + bf2f(oi[e4][r]); } }
    __syncthreads();
    { const int c = tid >> 3, part = tid & 7; float o[16]; float ss = 0.f;
#pragma unroll
      for (int i = 0; i < 16; ++i) { o[i] = Os[c * 132 + part * 16 + i]; ss += o[i] * o[i]; }
      ss += __shfl_xor(ss, 1); ss += __shfl_xor(ss, 2); ss += __shfl_xor(ss, 4);
      const float rstd = rsqrtf(ss * (1.f / 128.f) + 1e-6f);
      const unsigned gw[8] = { g0.x, g0.y, g0.z, g0.w, g1.x, g1.y, g1.z, g1.w };
      unsigned ow[8];
#pragma unroll
      for (int i = 0; i < 8; ++i) { const float n0 = onw[i >> 1][(2 * i) & 3], n1 = onw[i >> 1][(2 * i + 1) & 3];
          ow[i] = pk2(o[2 * i] * rstd * n0 * siluf_(lo16(gw[i])), o[2 * i + 1] * rstd * n1 * siluf_(hi16(gw[i]))); }
      bf16_t* ap = (bf16_t*)(p.ws + OFF_AGLA) + (size_t)(tok0 + c) * 512 + h * 128 + part * 16;
      *(u32x4*)ap = (u32x4){ow[0], ow[1], ow[2], ow[3]}; *(u32x4*)(ap + 8) = (u32x4){ow[4], ow[5], ow[6], ow[7]}; }
    __syncthreads();
}
__device__ __forceinline__ void head_row_finish(float (&x)[16], int p8, const float* nw, const float* nw2, bool rope, int pos, const float* R, float mul, LAS bf16_t* dst) {
    float ss = 0.f; const int cnt = p8 < 4 ? 16 : 8;
#pragma unroll
    for (int i = 0; i < 16; ++i) if (i < cnt) ss += x[i] * x[i];
    ss += __shfl_xor(ss, 1); ss += __shfl_xor(ss, 2); ss += __shfl_xor(ss, 4);
    const float rstd = rsqrtf(ss * (1.f / 96.f) + 1e-6f) * mul;
    if (p8 < 4) { unsigned w[8];
#pragma unroll
        for (int i = 0; i < 8; ++i) w[i] = pk2(x[2 * i] * rstd * nw[p8 * 16 + 2 * i] * nw2[p8 * 16 + 2 * i], x[2 * i + 1] * rstd * nw[p8 * 16 + 2 * i + 1] * nw2[p8 * 16 + 2 * i + 1]);
        *(LAS u32x4*)(dst + p8 * 16) = (u32x4){w[0], w[1], w[2], w[3]}; *(LAS u32x4*)(dst + p8 * 16 + 8) = (u32x4){w[4], w[5], w[6], w[7]};
    } else { const int i0 = (p8 - 4) * 4; float o1[4], o2[4];
#pragma unroll
        for (int i = 0; i < 4; ++i) { const float a = x[i] * rstd * nw[64 + i0 + i], b = x[4 + i] * rstd * nw[80 + i0 + i];
            if (rope) { const float c = R[pos * 16 + i0 + i], s = R[16384 + pos * 16 + i0 + i]; o1[i] = a * c - b * s; o2[i] = a * s + b * c; } else { o1[i] = a; o2[i] = b; } }
        *(LAS u32x2*)(dst + 64 + i0) = (u32x2){pk2(o1[0], o1[1]), pk2(o1[2], o1[3])}; *(LAS u32x2*)(dst + 80 + i0) = (u32x2){pk2(o2[0], o2[1]), pk2(o2[2], o2[3])}; }
}
__device__ __forceinline__ void ld16bf(const bf16_t* s, float (&x)[16]) { const u32x4 a = *(const u32x4*)s, b = *(const u32x4*)(s + 8);
    x[0] = lo16(a.x); x[1] = hi16(a.x); x[2] = lo16(a.y); x[3] = hi16(a.y); x[4] = lo16(a.z); x[5] = hi16(a.z); x[6] = lo16(a.w); x[7] = hi16(a.w);
    x[8] = lo16(b.x); x[9] = hi16(b.x); x[10] = lo16(b.y); x[11] = hi16(b.y); x[12] = lo16(b.z); x[13] = hi16(b.z); x[14] = lo16(b.w); x[15] = hi16(b.w); }
__device__ __forceinline__ void ld4bf(const bf16_t* s, float* x) { const u32x2 a = *(const u32x2*)s; x[0] = lo16(a.x); x[1] = hi16(a.x); x[2] = lo16(a.y); x[3] = hi16(a.y); }
__device__ __forceinline__ void job_attn(const Params& p, int l, int j, lds_t lds) {
    const int tid = tid_opaque(p), wid = tid >> 6, lane = tid & 63, lr = lane & 15, lq = lane >> 4;
    const bool smp = j < 128; int b, h, qb; if (smp) { b = j >> 5; h = (j >> 3) & 3; qb = j & 7; } else { const int jj = j - 128; b = jj >> 3; h = (jj >> 1) & 3; qb = jj & 1; }
    const int qtok0 = smp ? 4096 + b * 1024 + qb * 128 : b * 256 + qb * 128; const int nkt = smp ? 12 : 2;
    LAS bf16_t* Ks0 = (LAS bf16_t*)lds;
    LAS bf16_t* VTs0 = Ks0 + 2 * 128 * 104;
    LAS float* Mg = (LAS float*)lds;
    const bf16_t* Z = (const bf16_t*)(p.ws + OFF_Z); const bf16_t* KF = (const bf16_t*)(p.ws + OFF_KF); const bf16_t* Vb = (const bf16_t*)(p.ws + OFF_V); const float* R = (const float*)(p.ws + OFF_ROPE);
    const float* qhn = p.in[I_QHNORM] + l * 96;
    u32x4 kreg[3], vreg[4];
    const int vst = smp ? 1536 : 256; const bf16_t* vtb = smp ? Vb + 2097152 + (size_t)(b * 4 + h) * 128 * 1536 : Vb + (size_t)(b * 4 + h) * 128 * 256;
    auto rowbase = [&](int kt) { return smp ? (kt < 4 ? 8192 + b * 512 + kt * 128 : 4096 + b * 1024 + (kt - 4) * 128) : b * 256 + kt * 128; };
    auto issue = [&](int kt) { const int rb = rowbase(kt);
#pragma unroll
        for (int i = 0; i < 3; ++i) { const int idx = tid + 512 * i, key = idx / 12, part = idx - key * 12; kreg[i] = *(const u32x4*)(KF + (size_t)(rb + key) * 384 + h * 96 + part * 8); }
#pragma unroll
        for (int i = 0; i < 4; ++i) { const int idx = tid + 512 * i, e = idx >> 4, part = idx & 15; vreg[i] = *(const u32x4*)(vtb + (size_t)e * vst + kt * 128 + part * 8); } };
    auto commit = [&](int buf) { LAS bf16_t* Ks = Ks0 + buf * 128 * 104; LAS bf16_t* VTs = VTs0 + buf * 128 * 136;
#pragma unroll
        for (int i = 0; i < 3; ++i) { const int idx = tid + 512 * i, key = idx / 12, part = idx - key * 12; *(LAS u32x4*)(Ks + key * 104 + part * 8) = kreg[i]; }
#pragma unroll
        for (int i = 0; i < 4; ++i) { const int idx = tid + 512 * i, e = idx >> 4, part = idx & 15; *(LAS u32x4*)(VTs + e * 136 + part * 8) = vreg[i]; } };
    issue(0);
#pragma unroll
    for (int it = 0; it < 2; ++it) { const int row = it * 64 + (tid >> 3), p8 = tid & 7, tok = qtok0 + row; const bf16_t* qr = (const bf16_t*)(p.ws + OFF_QRAW) + (size_t)tok * 384 + h * 96; float x[16];
      if (p8 < 4) ld16bf(qr + p8 * 16, x); else { ld4bf(qr + 64 + (p8 - 4) * 4, x); ld4bf(qr + 80 + (p8 - 4) * 4, x + 4); }
      head_row_finish(x, p8, qhn, p.in[I_KHNORM] + l * 96, smp, qb * 128 + row, R, 0.10206207261596575f * 1.4426950408889634f, Ks0 + 128 * 104 + row * 104); }
    __syncthreads();
    const int rt = wid & 3, kh = wid >> 2;
    bf16x8 qa[2][3];
#pragma unroll
    for (int mt = 0; mt < 2; ++mt)
#pragma unroll
        for (int ks = 0; ks < 3; ++ks) qa[mt][ks] = LDSFRAG(Ks0 + 128 * 104 + (rt * 32 + mt * 16 + lr) * 104 + ks * 32 + lq * 8);
    commit(0);
    __syncthreads();
    f32x4 oacc[2][8]; float mrow[2], lrow[2];
#pragma unroll
    for (int mt = 0; mt < 2; ++mt) {
#pragma unroll
        for (int e = 0; e < 8; ++e) oacc[mt][e] = (f32x4){0.f, 0.f, 0.f, 0.f};
        mrow[mt] = -1e30f; lrow[mt] = 0.f; }
    const int kbase = kh * 64;
    for (int kt = 0; kt < nkt; ++kt) {
        if (kt + 1 < nkt) issue(kt + 1);
        const LAS bf16_t* Ks = Ks0 + (kt & 1) * 128 * 104; const LAS bf16_t* VTs = VTs0 + (kt & 1) * 128 * 136;
        f32x4 sacc[2][4];
#pragma unroll
        for (int nt = 0; nt < 4; ++nt) { sacc[0][nt] = (f32x4){0.f, 0.f, 0.f, 0.f}; sacc[1][nt] = sacc[0][nt];
#pragma unroll
            for (int ks = 0; ks < 3; ++ks) { const bf16x8 kf = LDSFRAG(Ks + (kbase + nt * 16 + lr) * 104 + ks * 32 + lq * 8); sacc[0][nt] = MFMA16(kf, qa[0][ks], sacc[0][nt]); sacc[1][nt] = MFMA16(kf, qa[1][ks], sacc[1][nt]); } }
        bf16x8 pb[2][2];
#pragma unroll
        for (int mt = 0; mt < 2; ++mt) {
            float mx = -1e30f;
#pragma unroll
            for (int nt = 0; nt < 4; ++nt) mx = fmaxf(mx, fmaxf(fmaxf(sacc[mt][nt][0], sacc[mt][nt][1]), fmaxf(sacc[mt][nt][2], sacc[mt][nt][3])));
            mx = fmaxf(mx, __shfl_xor(mx, 16)); mx = fmaxf(mx, __shfl_xor(mx, 32));
            const float mn = fmaxf(mrow[mt], mx), alpha = __builtin_amdgcn_exp2f(mrow[mt] - mn); mrow[mt] = mn;
            float pv[4][4]; float rs = 0.f;
#pragma unroll
            for (int nt = 0; nt < 4; ++nt)
#pragma unroll
                for (int r = 0; r < 4; ++r) { pv[nt][r] = __builtin_amdgcn_exp2f(sacc[mt][nt][r] - mn); rs += pv[nt][r]; }
            lrow[mt] = lrow[mt] * alpha + rs;
#pragma unroll
            for (int k2 = 0; k2 < 2; ++k2) { u32x4 w; w.x = pk2(pv[2 * k2][0], pv[2 * k2][1]); w.y = pk2(pv[2 * k2][2], pv[2 * k2][3]); w.z = pk2(pv[2 * k2 + 1][0], pv[2 * k2 + 1][1]); w.w = pk2(pv[2 * k2 + 1][2], pv[2 * k2 + 1][3]);
                pb[mt][k2] = __builtin_bit_cast(bf16x8, w); }
#pragma unroll
            for (int e = 0; e < 8; ++e) oacc[mt][e] *= alpha; }
#pragma unroll
        for (int k2 = 0; k2 < 2; ++k2)
#pragma unroll
            for (int e = 0; e < 8; ++e) { const LAS bf16_t* vp = VTs + (e * 16 + lr) * 136 + kbase + k2 * 32 + 4 * lq;
                const u32x2 lo = *(const LAS u32x2*)vp, hi = *(const LAS u32x2*)(vp + 16);
                const bf16x8 vf = __builtin_bit_cast(bf16x8, (u32x4){lo.x, lo.y, hi.x, hi.y});
                oacc[0][e] = MFMA16(vf, pb[0][k2], oacc[0][e]); oacc[1][e] = MFMA16(vf, pb[1][k2], oacc[1][e]); }
        if (kt + 1 < nkt) commit((kt + 1) & 1);
        __syncthreads();
    }
#pragma unroll
    for (int mt = 0; mt < 2; ++mt) { float s_ = lrow[mt]; s_ += __shfl_xor(s_, 16); s_ += __shfl_xor(s_, 32); lrow[mt] = s_; }
    LAS float* Mo = Mg + rt * 32 * 132; LAS float* Ml = Mg + 4 * 32 * 132 + rt * 64;
    if (kh == 1) {
#pragma unroll
        for (int mt = 0; mt < 2; ++mt) {
#pragma unroll
            for (int e = 0; e < 8; ++e) *(LAS f32x4*)(Mo + (mt * 16 + lr) * 132 + e * 16 + 4 * lq) = oacc[mt][e];
            if (lq == 0) { Ml[(mt * 16 + lr) * 2] = mrow[mt]; Ml[(mt * 16 + lr) * 2 + 1] = lrow[mt]; } }
    }
    __syncthreads();
    if (kh == 0) { bf16_t* AM = (bf16_t*)(p.ws + OFF_AMLA);
#pragma unroll
        for (int mt = 0; mt < 2; ++mt) { const int row = mt * 16 + lr, tok = qtok0 + rt * 32 + row;
            u32x2 gt[8];
#pragma unroll
            for (int e = 0; e < 8; ++e) gt[e] = *(const u32x2*)(Z + (size_t)tok * LDZ + ZMG + h * 128 + e * 16 + 4 * lq);
            const float m2 = Ml[row * 2], l2 = Ml[row * 2 + 1]; const float mm = fmaxf(mrow[mt], m2), a1 = __builtin_amdgcn_exp2f(mrow[mt] - mm), a2 = __builtin_amdgcn_exp2f(m2 - mm);
            const float inv = 1.f / (lrow[mt] * a1 + l2 * a2);
#pragma unroll
            for (int e = 0; e < 8; ++e) { const f32x4 o2 = *(const LAS f32x4*)(Mo + row * 132 + e * 16 + 4 * lq); float o[4];
#pragma unroll
                for (int r = 0; r < 4; ++r) o[r] = (oacc[mt][e][r] * a1 + o2[r] * a2) * inv;
                const float g0 = lo16(gt[e].x), g1 = hi16(gt[e].x), g2 = lo16(gt[e].y), g3 = hi16(gt[e].y);
                *(u32x2*)(AM + (size_t)tok * 512 + h * 128 + e * 16 + 4 * lq) = (u32x2){pk2(o[0] * siluf_(g0), o[1] * siluf_(g1)), pk2(o[2] * siluf_(g2), o[3] * siluf_(g3))}; } } }
    __syncthreads();
}


#define XB_TMO      128
#define XB_XCNT(j)  (256  + 64 * (j))
#define XB_XSUB(j)  (1280 + 64 * (j))
#define XB_XGEN(j)  (2304 + 64 * (j))
#define XB_TOP      3328
#define XB_TOPGEN   3392
#define XCD_BAR_WORDS 3456
#define XB_SPIN_CAP (1u << 18)

__device__ __forceinline__ unsigned xb_ld(unsigned* p)              { return __hip_atomic_load(p, __ATOMIC_RELAXED, __HIP_MEMORY_SCOPE_AGENT); }
__device__ __forceinline__ unsigned xb_add(unsigned* p, unsigned v) { return __hip_atomic_fetch_add(p, v, __ATOMIC_RELAXED, __HIP_MEMORY_SCOPE_AGENT); }
__device__ __forceinline__ unsigned xb_xcc_id() { return (unsigned)__builtin_amdgcn_s_getreg((3 << 11) | 20) & 0xFu; }
#define XB_SPIN(cond, bar) do { unsigned _sp = 0; while (cond) { __builtin_amdgcn_s_sleep(1); \
    if ((++_sp & 255u) == 0u) { if (xb_ld(&(bar)[XB_TMO])) break; if (_sp > XB_SPIN_CAP) { atomicAdd(&(bar)[XB_TMO], 1u); break; } } } } while (0)

struct XcdBarrier {
    int wid; unsigned* bar; unsigned x;
    volatile LAS unsigned* st;
};

__device__ __forceinline__ XcdBarrier xcd_barrier_post(unsigned* bar, volatile LAS unsigned* st) {
    XcdBarrier b; b.bar = bar; b.x = xb_xcc_id(); b.st = st;
    if (threadIdx.x == 0) (void)xb_add(&bar[XB_XCNT(b.x)], 1u);
    return b;
}
__device__ __forceinline__ void xcd_barrier_complete(unsigned* bar, unsigned x, unsigned& nloc, unsigned& nx) {
    const unsigned G = gridDim.x * gridDim.y * gridDim.z;
    unsigned sum, cnt, mine, sp = 0u;
    for (;;) {
        sum = 0u; cnt = 0u; mine = 0u;
#pragma unroll
        for (unsigned j = 0; j < 16; ++j) { const unsigned c = xb_ld(&bar[XB_XCNT(j)]); sum += c; cnt += (c > 0u) ? 1u : 0u; mine = (j == x) ? c : mine; }
        if (sum == G) break;
        __builtin_amdgcn_s_sleep(1);
        if ((++sp & 255u) == 0u) { if (xb_ld(&bar[XB_TMO])) break; if (sp > XB_SPIN_CAP) { atomicAdd(&bar[XB_TMO], 1u); break; } }
    }
    nloc = mine > 0u ? mine : 1u; nx = cnt > 0u ? cnt : 1u;
}

__device__ __forceinline__ void xcd_barrier(const XcdBarrier& b) {
    asm volatile("s_waitcnt vmcnt(0)" ::: "memory");
    __syncthreads();
    if (b.wid == 0 && lane_id_() == 0) {
        unsigned* bar = b.bar;
        __builtin_amdgcn_s_waitcnt(0);
        unsigned nloc = b.st[0], nx = b.st[1];
        if (nloc == 0u) { xcd_barrier_complete(bar, b.x, nloc, nx); b.st[0] = nloc; b.st[1] = nx; }
        const unsigned old = xb_add(&bar[XB_XSUB(b.x)], 1u);
        const unsigned gen = old / nloc;
        if (old + 1u == (gen + 1u) * nloc) {
            __builtin_amdgcn_fence(__ATOMIC_RELEASE, "agent");
            asm volatile("s_waitcnt vmcnt(0)" ::: "memory");
            const unsigned og = xb_add(&bar[XB_TOP], 1u);
            const unsigned tg = og / nx;
            if (og + 1u == (tg + 1u) * nx) xb_add(&bar[XB_TOPGEN], 1u);
            else XB_SPIN(xb_ld(&bar[XB_TOPGEN]) == tg, bar);
            __builtin_amdgcn_fence(__ATOMIC_ACQUIRE, "agent");
            xb_add(&bar[XB_XGEN(b.x)], 1u);
            asm volatile("s_waitcnt vmcnt(0)" ::: "memory");
        } else {
            XB_SPIN(xb_ld(&bar[XB_XGEN(b.x)]) == gen, bar);
            __builtin_amdgcn_fence(__ATOMIC_ACQUIRE, "agent");
            asm volatile("s_waitcnt vmcnt(0)" ::: "memory");
        }
    }
    __syncthreads();
}

constexpr int N_PHASES = 15;
#ifndef S3SEL
#define S3SEL 15
#endif
#ifndef REPEAT_MASK
#define REPEAT_MASK 0xff
#endif
#ifndef ONLY_S
#define ONLY_S -1
#endif
__device__ __forceinline__ void run_phase(const Params& p, int ph, lds_t lds, int mask = 0xff) {
    const int G = (int)gridDim.x, bid = (int)blockIdx.x;
    if (ph == 0 && (ONLY_S < 0 || ONLY_S == 7)) {
        for (int j = bid; j < 384 + 192 + 256 + 32; j += G) { if (j < 384) job_s5setup(p, 0, j, lds); else if (j < 576) job_ada(p, j - 384, lds); else if (j < 832) job_ctx(p, j - 576); else job_rope(p, j - 832); }
        return;
    }
    const int l = (ph - 1) / 7, s = (ph - 1) % 7;
    unsigned char* ws = p.ws;
    if (s == 0 && (ONLY_S < 0 || ONLY_S == 0)) {
        if (l == 0 || G < 256) { for (int j = bid; j < 384 + WT_TOTAL + 256; j += G) { if (j < 384) { if ((mask & 1) && l > 0) job_s5setup(p, l, j, lds); } else if (j < 384 + WT_TOTAL) { if (mask & 2) job_wt(p, l, j - 384, lds); } else if (mask & 4) job_prep(p, l, j - 384 - WT_TOTAL); } }
        else { for (int j = bid; j < 256; j += G) job_prep(p, l, j); }
    } else if (s == 1 && (ONLY_S < 0 || ONLY_S == 1)) {
        Order S; S.setup(8192, 4096, 0, p.wid); pg8::Gemm g{(const bf16_t*)(ws + OFF_HB), (const bf16_t*)(ws + OFF_WIN), 8192, 4096, 1024}; EpiZ E{(bf16_t*)(ws + OFF_Z)};
        pg8::gemm_phase<EpiZ, Order>(lds, g, S, E, nullptr);
    } else if (s == 2 && (ONLY_S < 0 || ONLY_S == 2)) {
        if (G == 256) {
            if (mask & 1) { const int slot = bid >> 3; job_s5(p, l, (slot >> 2) * 32 + 4 * (bid & 7) + (slot & 3), lds); }
            if (mask & 2) { job_glaA(p, l, bid, lds); job_glaA(p, l, 256 + bid, lds); }
            if (mask & 4) for (int j = bid; j < 256; j += G) job_mlaprep(p, l, j);
        } else for (int j = bid; j < 256 + 512 + 256; j += G) { if (j < 256) { if (mask & 1) job_s5(p, l, j, lds); } else if (j < 768) { if (mask & 2) job_glaA(p, l, j - 256, lds); } else if (mask & 4) job_mlaprep(p, l, j - 768); }
    } else if (s == 3 && (ONLY_S < 0 || ONLY_S == 3)) {
        if (mask & 1) { if (G == 256) { if (bid < 96) for (int j = bid; j < 640; j += 96) job_glaB(p, l, j); } else for (int j = bid; j < 640; j += G) job_glaB(p, l, j); }
        if (mask & 16) { Order S; S.setup(8192, 2816, 0, p.wid); pg8::Gemm g{(const bf16_t*)(ws + OFF_HB), (const bf16_t*)(ws + OFF_WIN) + (size_t)4096 * 1024, 8192, 2816, 1024}; EpiZ E{(bf16_t*)(ws + OFF_Z) + 4096};
          pg8::gemm_phase<EpiZ, Order>(lds, g, S, E, nullptr); }
        if ((mask & 2) && (S3SEL & 2)) { Order S; S.setup(8192, 1024, 160, p.wid); pg8::Gemm g{(const bf16_t*)(ws + OFF_YG), (const bf16_t*)(ws + OFF_WGLU), 8192, 1024, 512}; EpiGLU E{(bf16_t*)(ws + OFF_AS5), (const bf16_t*)(ws + OFF_Z), p.in[I_BGLU] + l * 1024};
          pg8::gemm_phase<EpiGLU, Order>(lds, g, S, E, nullptr); }
        if ((mask & 4) && (S3SEL & 4)) { Order S; S.setup(10240, 768, 120, p.wid); pg8::Gemm g{(const bf16_t*)(ws + (l == 0 ? OFF_CTX0 : OFF_CKVN)), (const bf16_t*)(ws + OFF_WKV), 10240, 768, 256}; EpiKV E{(bf16_t*)(ws + OFF_KF), (bf16_t*)(ws + OFF_V), l, (const bf16_t*)(ws + OFF_Z), p.in[I_CKR], p.in[I_KHNORM] + l * 96, (const float*)(ws + OFF_ROPE)};
          pg8::gemm_phase<EpiKV, Order>(lds, g, S, E, nullptr); }
        if ((mask & 8) && (S3SEL & 8)) { Order S; S.setup(8192, 512, 160, p.wid); if (G == 256) S.c = (bid >= 96 && bid < 136) ? bid - 96 : (bid >= 224 && bid < 248) ? bid - 184 : (1 << 20); pg8::Gemm g{(const bf16_t*)(ws + OFF_AQ), (const bf16_t*)(ws + OFF_WUQ), 8192, 512, 384}; EpiQ E{(bf16_t*)(ws + OFF_QRAW)};
          pg8::gemm_phase<EpiQ, Order>(lds, g, S, E, nullptr); }
    } else if (s == 4 && (ONLY_S < 0 || ONLY_S == 4)) {
        if (G == 256) {
            if (bid < 128) { const int slot = bid >> 3, pair = 2 * (bid & 7) + (slot >> 3);
                if (mask & 1) job_attn(p, l, pair * 8 + (slot & 7), lds); }
            else { const int k = bid - 128; if (mask & 1) job_attn(p, l, 128 + k, lds); if (mask & 2) { job_glaC(p, l, k, lds); job_glaC(p, l, 128 + k, lds); job_glaC(p, l, 256 + k, lds); job_glaC(p, l, 384 + k, lds); } }
        } else for (int j = bid; j < 256 + 512; j += G) { if (j < 256) { if (mask & 1) job_attn(p, l, j, lds); } else if (mask & 2) job_glaC(p, l, j - 256, lds); }
    } else if (s == 5 && (ONLY_S < 0 || ONLY_S == 5)) {
        if (l == 0 && mask == 0xff && G >= 256 && bid >= 128) { for (int j = bid - 128; j < 384 + WT_EARLY; j += G - 128) { if (j < 384) job_s5setup(p, 1, j, lds); else job_wt(p, 1, j - 384, lds); } }
        for (int br = 0; br < 3; ++br) { Order S; S.setup(8192, 1024, 0, p.wid);
            pg8::Gemm g{(const bf16_t*)(ws + (br == 0 ? OFF_AGLA : br == 1 ? OFF_AMLA : OFF_AS5)), (const bf16_t*)(ws + OFF_WBO) + (size_t)br * 1024 * 512, 8192, 1024, 512};
            EpiBo E{(bf16_t*)(ws + OFF_HB), (const bf16_t*)(ws + OFF_Z), br};
            pg8::gemm_phase<EpiBo, Order>(lds, g, S, E, nullptr); }
    } else if (s == 6 && (ONLY_S < 0 || ONLY_S == 6)) {
        if (l == 0 && mask == 0xff && G >= 256 && bid >= 128) { for (int j = bid - 128; j < 3 * WT_WBO + WT_WOUT; j += G - 128) job_wt(p, 1, WT_EARLY + j, lds); }
        Order S; S.setup(8192, 1024, 0, p.wid); pg8::Gemm g{(const bf16_t*)(ws + OFF_HB), (const bf16_t*)(ws + (l == 0 ? OFF_WOUT : OFF_WOUT2)), 8192, 1024, 1024};
        EpiOut E{p.out, l == 0 ? p.in[I_XP] : p.out, l == 0 ? p.in[I_XS] : p.out + (size_t)4096 * 1024, (const float*)(ws + OFF_ADA) + l * 5 * 3072};
        pg8::gemm_phase<EpiOut, Order>(lds, g, S, E, nullptr);
    }
}
__global__ __launch_bounds__(512, 2) void mega(KParams kp, int ph0, int ph1) {
    extern __shared__ __attribute__((aligned(16))) unsigned char shm[];
    lds_t lds = (lds_t)shm;
    if (threadIdx.x < N_IN) ((const float**)(kp.ws + OFF_TBL))[threadIdx.x] = kp.in[threadIdx.x];
    const int wid0 = __builtin_amdgcn_readfirstlane((int)threadIdx.x >> 6);
    volatile LAS unsigned* xst = (volatile LAS unsigned*)(lds + DYN_LDS - 16);
    if (threadIdx.x == 0) { xst[0] = 0u; xst[1] = 0u; }
    __threadfence(); __syncthreads();
    XcdBarrier xb = xcd_barrier_post((unsigned*)(kp.ws + OFF_BAR), xst);
    xb.wid = wid0;
    if (ph0 > ph1) cg::this_grid().sync();
    for (int ph = ph0; ph < ph1; ++ph) {
        Params p; p.wid = wid0; { const float* const* tb = (const float* const*)(kp.ws + OFF_TBL); float* o = kp.out; unsigned char* w = kp.ws; asm volatile("" : "+s"(tb), "+s"(o), "+s"(w)); p.in = tb; p.out = o; p.ws = w; }
        int nrep = 1;
#ifdef REPEAT_S
        if ((REPEAT_S == 7 && ph == 0) || (ph > 0 && (ph - 1) % 7 == REPEAT_S && (REPEAT_S != 6 || ph < 8))) nrep = 2;
#endif
        for (int rep = 0; rep < nrep; ++rep) { if (rep) xcd_barrier(xb); run_phase(p, ph, lds, rep ? REPEAT_MASK : 0xff); }
        if (ph + 1 < ph1) xcd_barrier(xb);
    }
}

#ifndef N_LAUNCH_MODE
#define N_LAUNCH_MODE 1
#endif
extern "C" void kernel_launch(void* const* d_in, const int* in_sizes, int n_in, void* d_out, int out_size, void* d_ws, size_t ws_size, hipStream_t stream) {
    static int grid = 0;
    if (grid == 0) {
        if (n_in != N_IN || ws_size < WS_END) { fprintf(stderr, "kernel_launch: unexpected n_in %d / ws %zu (need %zu)\n", n_in, ws_size, (size_t)WS_END); grid = -1; return; }
        int dev = 0, cus = 0, per_cu = 0;
        hipGetDevice(&dev); hipDeviceGetAttribute(&cus, hipDeviceAttributeMultiprocessorCount, dev);
        hipFuncSetAttribute((const void*)mega, hipFuncAttributeMaxDynamicSharedMemorySize, DYN_LDS);
        hipOccupancyMaxActiveBlocksPerMultiprocessor(&per_cu, (const void*)mega, 512, DYN_LDS);
        if (per_cu < 1) { fprintf(stderr, "kernel_launch: occupancy query says %d blocks per CU\n", per_cu); per_cu = 1; }
        (void)hipGetLastError();
        grid = cus;
    }
    if (grid < 0) return;
    hipMemsetAsync((char*)d_ws + OFF_BAR, 0, 16384, stream);
    KParams p{};
    for (int i = 0; i < N_IN; ++i) p.in[i] = (const float*)d_in[i];
    p.out = (float*)d_out; p.ws = (unsigned char*)d_ws;
#if N_LAUNCH_MODE == 0
    for (int ph = 0; ph < N_PHASES; ++ph) { hipLaunchKernelGGL(mega, dim3(grid), dim3(512), DYN_LDS, stream, p, ph, ph + 1); }
#else
    int ph0 = 0, ph1 = N_PHASES; void* args[] = {&p, &ph0, &ph1};
    hipError_t e = hipLaunchCooperativeKernel((const void*)mega, dim3(grid), dim3(512), args, DYN_LDS, stream);
    if (e != hipSuccess) fprintf(stderr, "cooperative launch failed: %s (grid %d)\n", hipGetErrorString(e), grid);
#endif
}
```

```cpp
#include <hip/hip_runtime.h>
#include <hip/hip_cooperative_groups.h>
#include <cstdio>
namespace cg = cooperative_groups;
namespace pg8 {
#define PG8_LAS __attribute__((address_space(3)))
typedef unsigned short bf16_t;
typedef short bf16x8 __attribute__((ext_vector_type(8)));
typedef float f32x4 __attribute__((ext_vector_type(4)));
typedef unsigned u32x4 __attribute__((ext_vector_type(4)));
constexpr int BM = 256, BK = 64, HALF = 128, HTB = HALF * BK * 2  , STAGE_BYTES = 8 * HTB, NXCD = 8, WGM = 8;

__host__ __device__ __forceinline__ int lds_byte(int r, int c) { const int st = (r >> 4) * 2 + (c >> 5), rr = r & 15, cc = c & 31, ob = rr * 64 + cc * 2; return st * 1024 + (ob ^ (((ob >> 9) & 1) << 5)); }
__host__ __device__ __forceinline__ void stage_rc(int b, int& R, int& C) { const int st = b / 1024, sb = b % 1024, swz = sb ^ (((sb >> 9) & 1) << 5); R = (st >> 1) * 16 + swz / 64; C = (st & 1) * 32 + (swz % 64) / 2; }
__host__ __device__ __forceinline__ int perm32(int rho) { const int n = rho >> 4, i = rho & 15; return 8 * (i >> 2) + 4 * n + (i & 3); }

struct Unit { int pm, pn; };
struct Gemm { const bf16_t* A; const bf16_t* Bt; int M, N, K; };

struct StaticOrder {
    int nM, nN, nwg, G, c;
    __host__ __device__ void init(int M, int N, int G_, int c_) { nM = M / BM; nN = N / BM; nwg = nM * nN; G = G_; c = c_; }
    __host__ __device__ bool next(int i, Unit& u) const {
        const long L = (long)i * G + c; if (L >= nwg) return false;
        int wgid = (int)L; { const int q = nwg / NXCD, r = nwg % NXCD, xcd = wgid % NXCD, off = wgid / NXCD; wgid = (xcd < r ? xcd * (q + 1) : r * (q + 1) + (xcd - r) * q) + off; }
        const int nig = WGM * nN, gid = wgid / nig, fm = gid * WGM, gsz = (nM - fm) < WGM ? (nM - fm) : WGM;
        u.pm = fm + ((wgid % nig) % gsz); u.pn = (wgid % nig) / gsz; return true;
    }
    __device__ __forceinline__ void a_ready(const Unit&) const {}
    __device__ __forceinline__ void done(const Unit&) const {}
};
__device__ __forceinline__ unsigned cvt_pk_bf16(float lo, float hi) { unsigned r; asm volatile("v_cvt_pk_bf16_f32 %0, %1, %2" : "=v"(r) : "v"(lo), "v"(hi)); return r; }
typedef float f32x2 __attribute__((ext_vector_type(2)));
template <class Epi, class Sched, bool STAMP = false>
__device__ __forceinline__ void gemm_phase(PG8_LAS unsigned char* lds, const Gemm g, const Sched& S, const Epi& E, unsigned long long* stamps) {
    int tid_ = (S.wid << 6) | (int)__builtin_amdgcn_mbcnt_hi(~0u, __builtin_amdgcn_mbcnt_lo(~0u, 0u)); asm volatile("" : "+v"(tid_)); const int tid = tid_, wid = __builtin_amdgcn_readfirstlane(tid >> 6), lane = tid & 63, wr = wid >> 2, wc = wid & 3, fr = lane & 15, fq = lane >> 4;
    int K_ = g.K; asm volatile("" : "+s"(K_)); const int K = K_, nt = K / BK;
    int ts_lo = 0, ts_hi = 0, nts = 0; const unsigned long long rt_entry = STAMP ? (unsigned long long)wall_clock64() : 0ull;
#define PG8_STAMP() do { if (STAMP && wid == 0 && nts < 64) { const unsigned long long _c = (unsigned long long)clock64(); \
        ts_lo = (lane == nts) ? (int)(unsigned)_c : ts_lo; ts_hi = (lane == nts) ? (int)(unsigned)(_c >> 32) : ts_hi; ++nts; } } while (0)
    PG8_STAMP();
    unsigned voffA[2], voffB[2];
#pragma unroll
    for (int i = 0; i < 2; ++i) { int R, C; stage_rc(tid * 16 + i * 8192, R, C); const int Rb = Epi::PERM ? ((R & ~31) + perm32(R & 31)) : R;
        voffA[i] = (unsigned)(R * K + C) * 2u; voffB[i] = (unsigned)(Rb * K + C) * 2u; }
    const size_t kstep = (size_t)(BK * 2);
    const size_t hstep = (size_t)HALF * K * 2;
    const size_t tstep = 2 * hstep;
    const unsigned ldsw = (unsigned)wid * 1024u;
    const int aoff = lds_byte(wr * 64 + fr, fq * 8), boff = lds_byte(wc * 32 + fr, fq * 8);
#define PG8_SA(b, h) (((b) * 2 + (h)) * HTB)
#define PG8_SB(b, h) ((4 + (b) * 2 + (h)) * HTB)
#define PG8_STAGE(bufoff, gbase, voff) do { _Pragma("unroll") for (int _i = 0; _i < 2; ++_i) \
        __builtin_amdgcn_global_load_lds((const unsigned*)((const char*)(gbase) + (voff)[_i]), (PG8_LAS unsigned*)(lds + (bufoff) + ldsw + _i * 8192), 16, 0, 0); } while (0)
#define PG8_LDA(dst, b, h) do { _Pragma("unroll") for (int m = 0; m < 4; ++m) _Pragma("unroll") for (int k = 0; k < 2; ++k) dst[m][k] = *(const PG8_LAS bf16x8*)(lds + PG8_SA(b, h) + aoff + m * 2048 + k * 1024); } while (0)
#define PG8_LDB(dst, b, h) do { _Pragma("unroll") for (int n = 0; n < 2; ++n) _Pragma("unroll") for (int k = 0; k < 2; ++k) dst[n][k] = *(const PG8_LAS bf16x8*)(lds + PG8_SB(b, h) + boff + n * 2048 + k * 1024); } while (0)
#define PG8_MMA(ai, bj, At, Bt) do { __builtin_amdgcn_s_setprio(1); _Pragma("unroll") for (int m = 0; m < 4; ++m) _Pragma("unroll") for (int n = 0; n < 2; ++n) _Pragma("unroll") for (int k = 0; k < 2; ++k) \
        acc[ai][bj][m][n] = __builtin_amdgcn_mfma_f32_16x16x32_bf16(Bt[n][k], At[m][k], acc[ai][bj][m][n], 0, 0, 0); __builtin_amdgcn_s_setprio(0); } while (0)
#define PG8_WAIT_V(n) asm volatile("s_waitcnt vmcnt(" #n ")" ::: "memory")
#define PG8_WAIT_L(n) asm volatile("s_waitcnt lgkmcnt(" #n ")" ::: "memory")
#define PG8_BAR __builtin_amdgcn_s_barrier()
#define PG8_SCHED __builtin_amdgcn_sched_barrier(0)
    Unit cur, nxt; int ui = 0;
    if (!S.next(0, cur)) return;
    f32x4 acc[2][2][4][2];
#pragma unroll
    for (int a = 0; a < 2; ++a)
#pragma unroll
        for (int b = 0; b < 2; ++b)
#pragma unroll
            for (int m = 0; m < 4; ++m)
#pragma unroll
                for (int n = 0; n < 2; ++n) acc[a][b][m][n] = (f32x4){0.f, 0.f, 0.f, 0.f};
    bf16x8 At[4][2], B0[2][2], B1[2][2];
    const char* cA = (const char*)g.A + (size_t)cur.pm * tstep; const char* cB = (const char*)g.Bt + (size_t)cur.pn * tstep;
    S.a_ready(cur);
    PG8_STAGE(PG8_SB(0, 0), cB, voffB); PG8_STAGE(PG8_SA(0, 0), cA, voffA); PG8_STAGE(PG8_SB(0, 1), cB + hstep, voffB); PG8_STAGE(PG8_SA(0, 1), cA + hstep, voffA);
    if (wr == 1) PG8_BAR;
    PG8_WAIT_V(4); PG8_BAR;
    PG8_STAGE(PG8_SB(1, 0), cB + kstep, voffB); PG8_STAGE(PG8_SA(1, 0), cA + kstep, voffA); PG8_STAGE(PG8_SB(1, 1), cB + hstep + kstep, voffB);
    PG8_WAIT_V(6); PG8_BAR;
    PG8_STAMP();
    for (;;) {
        const bool has_next = S.next(ui + 1, nxt);
        const char* nA = has_next ? (const char*)g.A + (size_t)nxt.pm * tstep : cA; const char* nB = has_next ? (const char*)g.Bt + (size_t)nxt.pn * tstep : cB;
        for (int t = 0; t < nt; t += 2) {
            const bool last = (t == nt - 2);
            const char* a1 = cA + (size_t)(t + 1) * kstep;
            const char* a2 = last ? nA : cA + (size_t)(t + 2) * kstep; const char* b2 = last ? nB : cB + (size_t)(t + 2) * kstep;
            const char* a3 = a2 + kstep; const char* b3 = b2 + kstep;
            if (last && has_next) S.a_ready(nxt);
            PG8_LDB(B0, 0, 0); PG8_SCHED; PG8_LDA(At, 0, 0); PG8_STAGE(PG8_SA(1, 1), a1 + hstep, voffA);
            PG8_WAIT_L(8); PG8_BAR; PG8_WAIT_L(0); PG8_MMA(0, 0, At, B0); PG8_BAR; PG8_SCHED;
            PG8_LDB(B1, 0, 1); PG8_STAGE(PG8_SB(0, 0), b2, voffB);
            PG8_BAR; PG8_WAIT_L(0); PG8_MMA(0, 1, At, B1); PG8_BAR;
            PG8_LDA(At, 0, 1); PG8_STAGE(PG8_SA(0, 0), a2, voffA);
            PG8_BAR; PG8_WAIT_L(0); PG8_MMA(1, 0, At, B0); PG8_BAR; PG8_SCHED;
            PG8_STAGE(PG8_SB(0, 1), b2 + hstep, voffB);
            PG8_WAIT_V(6); PG8_BAR; PG8_MMA(1, 1, At, B1); PG8_BAR;
            PG8_LDB(B0, 1, 0); PG8_SCHED; PG8_LDA(At, 1, 0); PG8_STAGE(PG8_SA(0, 1), a2 + hstep, voffA);
            PG8_WAIT_L(8); PG8_BAR; PG8_WAIT_L(0); PG8_MMA(0, 0, At, B0); PG8_BAR; PG8_SCHED;
            PG8_LDB(B1, 1, 1); PG8_STAGE(PG8_SB(1, 0), b3, voffB);
            PG8_BAR; PG8_WAIT_L(0); PG8_MMA(0, 1, At, B1); PG8_BAR;
            PG8_LDA(At, 1, 1); PG8_STAGE(PG8_SA(1, 0), a3, voffA);
            PG8_BAR; PG8_WAIT_L(0); PG8_MMA(1, 0, At, B0); PG8_BAR; PG8_SCHED;
            PG8_STAGE(PG8_SB(1, 1), b3 + hstep, voffB);
            PG8_WAIT_V(6); PG8_BAR; PG8_MMA(1, 1, At, B1); PG8_BAR;
        }
        PG8_STAMP();
        if constexpr (!Epi::AFTER_DRAIN) { E(acc, cur, wr, wc, fr, fq); S.done(cur); }
        PG8_STAMP();
        if (!has_next) break;
#pragma unroll
        for (int a = 0; a < 2; ++a)
#pragma unroll
            for (int b = 0; b < 2; ++b)
#pragma unroll
                for (int m = 0; m < 4; ++m)
#pragma unroll
                    for (int n = 0; n < 2; ++n) acc[a][b][m][n] = (f32x4){0.f, 0.f, 0.f, 0.f};
        cur = nxt; cA = nA; cB = nB; ++ui;
    }
    PG8_WAIT_V(0);
    if (wr == 0) PG8_BAR;
    PG8_BAR;
    if constexpr (Epi::AFTER_DRAIN) { E.fused(acc, cur, wr, wc, fr, fq, lds, wid, lane); S.done(cur); }
    PG8_STAMP();
    if (STAMP && wid == 0) { stamps[lane] = lane < nts ? (((unsigned long long)(unsigned)ts_hi << 32) | (unsigned)ts_lo) : 0ull;
        if (lane == 62) stamps[62] = rt_entry; if (lane == 63) stamps[63] = (unsigned long long)wall_clock64(); }
#undef PG8_STAMP
#undef PG8_SA
#undef PG8_SB
#undef PG8_STAGE
#undef PG8_LDA
#undef PG8_LDB
#undef PG8_MMA
#undef PG8_WAIT_V
#undef PG8_WAIT_L
#undef PG8_BAR
#undef PG8_SCHED
}
}
using pg8::bf16_t; using pg8::bf16x8; using pg8::f32x4; using pg8::u32x4; using pg8::Unit;
#define LAS __attribute__((address_space(3)))
typedef unsigned u32x2 __attribute__((ext_vector_type(2)));
typedef LAS unsigned char* lds_t;
struct Params;
__device__ __forceinline__ int lane_id_() { return (int)__builtin_amdgcn_mbcnt_hi(~0u, __builtin_amdgcn_mbcnt_lo(~0u, 0u)); }
typedef float f32x2_t __attribute__((ext_vector_type(2)));

enum { I_XP = 0, I_XS, I_C, I_CCTX, I_CKV, I_CKR, I_SGLA, I_SS5, I_NORMW, I_WADA, I_BADA, I_WIN, I_WA2, I_BA, I_ONORM, I_QNORM, I_WUQ, I_KVNORM, I_WUK, I_WUV,
       I_QHNORM, I_KHNORM, I_ARE, I_AIM, I_LOGDT, I_BRE, I_BIM, I_CRE, I_CIM, I_S5D, I_WGLU, I_BGLU, I_WBOG, I_WBOM, I_WBOS, I_WOUT, N_IN };
struct KParams { const float* in[N_IN]; float* out; unsigned char* ws; };
struct Params { const float* const* in; float* out; unsigned char* ws; int wid; };
__device__ __forceinline__ int tid_opaque(const Params& p) { int t = (p.wid << 6) | lane_id_(); asm volatile("" : "+v"(t)); return t; }

constexpr int LDZ = 6912;
constexpr int ZQ = 0, ZK = 256, ZV = 512, ZGA = 1024, ZGG = 1056, ZMQ = 1568, ZMKV = 1952, ZMKR = 2208, ZMG = 2240, ZSU = 2752, ZSG = 3264, ZMERGE = 3776;
constexpr size_t OUT_YP = 0, OUT_CKV = 8388608, OUT_KR = 10485760, OUT_GLA = 10747904, OUT_S5 = 12845056;
constexpr size_t OFF_WIN = 0;

constexpr size_t OFF_WUQ = OFF_WIN + 14155776;
constexpr size_t OFF_WKV = OFF_WUQ + 393216;
constexpr size_t OFF_WGLU = OFF_WKV + 393216;
constexpr size_t OFF_WBO = OFF_WGLU + 1048576;
constexpr size_t OFF_WOUT = OFF_WBO + 3145728;
constexpr size_t OFF_S5M = OFF_WOUT + 2097152;
constexpr size_t OFF_V = OFF_S5M;
constexpr size_t OFF_P16 = OFF_S5M + 12582912;
constexpr size_t OFF_ADA = OFF_P16 + 32768;
constexpr size_t OFF_ROPE = OFF_ADA + 122880;
constexpr size_t OFF_CTX0 = OFF_ROPE + 131072;
constexpr size_t OFF_CKVN = OFF_CTX0 + 1048576;
constexpr size_t OFF_CTX1 = OFF_CKVN + 4194304;
constexpr size_t OFF_HB = OFF_CTX1 + 1048576;
constexpr size_t OFF_Z = OFF_HB + 16777216;
constexpr size_t OFF_KV = OFF_Z + 113246208;
constexpr size_t OFF_AGLA = OFF_KV, OFF_AMLA = OFF_KV + 8388608;
constexpr size_t OFF_QD = OFF_KV + 16777216;
constexpr size_t OFF_OIB = OFF_QD + 8388608;
constexpr size_t OFF_DEC = OFF_KV + 33554432;
constexpr size_t OFF_ST = OFF_DEC + 262144;
constexpr size_t OFF_AQ = OFF_ST + 16777216;
constexpr size_t OFF_QRAW = OFF_AQ + 6291456;
constexpr size_t OFF_AS5 = OFF_QRAW + 6291456;
constexpr size_t OFF_YG = OFF_AS5 + 8388608;
constexpr size_t OFF_TBL = OFF_YG + 8388608;
constexpr size_t OFF_BAR = OFF_TBL + 512;
constexpr size_t OFF_KF = OFF_BAR + 16384;
constexpr size_t OFF_WOUT2 = OFF_KF + 7864320;
constexpr size_t WS_END = OFF_WOUT2 + 2097152;
static_assert(WS_END <= 268435456, "workspace map exceeds 256 MiB");
constexpr int DYN_LDS = 147456;

__device__ __forceinline__ float bf2f(bf16_t b) { return __uint_as_float(((unsigned)b) << 16); }
__device__ __forceinline__ bf16_t f2bf(float f) { unsigned u = __float_as_uint(f); u += 0x7FFFu + ((u >> 16) & 1u); return (bf16_t)(u >> 16); }
__device__ __forceinline__ unsigned pk2(float lo, float hi) { return pg8::cvt_pk_bf16(lo, hi); }
__device__ __forceinline__ float lo16(unsigned w) { return __uint_as_float(w << 16); }
__device__ __forceinline__ float hi16(unsigned w) { return __uint_as_float(w & 0xffff0000u); }
__device__ __forceinline__ float sigmoidf_(float x) { return 1.f / (1.f + __expf(-x)); }
__device__ __forceinline__ float siluf_(float x) { return x / (1.f + __expf(-x)); }
__device__ __forceinline__ void store8(bf16_t* p, const f32x4& a, const f32x4& b) { u32x4 w; w.x = pk2(a[0], a[1]); w.y = pk2(a[2], a[3]); w.z = pk2(b[0], b[1]); w.w = pk2(b[2], b[3]); *(u32x4*)p = w; }
#define MFMA16(a, b, c) __builtin_amdgcn_mfma_f32_16x16x32_bf16(a, b, c, 0, 0, 0)
#define LDSFRAG(ptr) (*(const LAS bf16x8*)(ptr))

struct Order : pg8::StaticOrder { int wid;
    __device__ void setup(int M, int N, int rot, int wid_) { wid = wid_; const int G = (int)gridDim.x; init(M, N, G, (int)((blockIdx.x + (unsigned)rot) % (unsigned)G)); }
};

struct EpiZ { static constexpr bool PERM = true, AFTER_DRAIN = false; bf16_t* Z;
    __device__ __forceinline__ void operator()(const f32x4 (&acc)[2][2][4][2], const Unit& u, int wr, int wc, int fr_, int fq_) const {
        int fr = fr_, fq = fq_; asm volatile("" : "+v"(fr), "+v"(fq));
        const int row0 = u.pm * 256 + wr * 64 + fr, col0 = u.pn * 256 + wc * 32 + 8 * fq;
#pragma unroll
        for (int ai = 0; ai < 2; ++ai)
#pragma unroll
            for (int m = 0; m < 4; ++m) { bf16_t* rp = Z + (size_t)(row0 + ai * 128 + m * 16) * LDZ + col0;
#pragma unroll
                for (int bj = 0; bj < 2; ++bj) store8(rp + bj * 128, acc[ai][bj][m][0], acc[ai][bj][m][1]); }
    } };
struct EpiQ { static constexpr bool PERM = true, AFTER_DRAIN = false; bf16_t* Q;
    __device__ __forceinline__ void operator()(const f32x4 (&acc)[2][2][4][2], const Unit& u, int wr, int wc, int fr_, int fq_) const {
        int fr = fr_, fq = fq_; asm volatile("" : "+v"(fr), "+v"(fq));
        const int row0 = u.pm * 256 + wr * 64 + fr, col0 = u.pn * 256 + wc * 32 + 8 * fq;
#pragma unroll
        for (int ai = 0; ai < 2; ++ai)
#pragma unroll
            for (int m = 0; m < 4; ++m) { bf16_t* rp = Q + (size_t)(row0 + ai * 128 + m * 16) * 384 + col0;
#pragma unroll
                for (int bj = 0; bj < 2; ++bj) if (col0 + bj * 128 < 384) store8(rp + bj * 128, acc[ai][bj][m][0], acc[ai][bj][m][1]);
                }
    } };
struct EpiKV { static constexpr bool PERM = true, AFTER_DRAIN = true; bf16_t* KF; bf16_t* V; int layer; const bf16_t* Z; const float* ckr; const float* khn; const float* R;
    __device__ __forceinline__ void fused(f32x4 (&acc)[2][2][4][2], const Unit& u, int wr, int wc, int fr_, int fq_, LAS unsigned char* lds, int wid, int lane_) const {
        if (u.pn == 0) { (*this)(acc, u, wr, wc, fr_, fq_); return; }
        int fr = fr_, fq = fq_, lane = lane_; asm volatile("" : "+v"(fr), "+v"(fq), "+v"(lane));
        LAS bf16_t* T = (LAS bf16_t*)lds;
#pragma unroll
        for (int ai = 0; ai < 2; ++ai)
#pragma unroll
            for (int m = 0; m < 4; ++m) { const int kl = ai * 128 + wr * 64 + m * 16 + fr;
#pragma unroll
                for (int bj = 0; bj < 2; ++bj) { const int el = bj * 128 + wc * 32 + 8 * fq;
#pragma unroll
                    for (int i = 0; i < 8; i += 2) { const unsigned w = pk2(acc[ai][bj][m][i >> 2][i & 3], acc[ai][bj][m][i >> 2][(i & 3) + 1]); T[(el + i) * 264 + kl] = (bf16_t)(w & 0xffffu); T[(el + i + 1) * 264 + kl] = (bf16_t)(w >> 16); } } }
        __syncthreads();
        int rb = u.pm * 256; if (layer == 0) rb = rb < 2048 ? 8192 + rb : rb - 2048;
        bf16_t* bp; int st;
        if (rb < 4096) { bp = V + (size_t)(rb >> 8) * 4 * 128 * 256; st = 256; }
        else if (rb < 8192) { bp = V + 2097152 + (size_t)((rb - 4096) >> 10) * 4 * 128 * 1536 + 512 + ((rb - 4096) & 1023); st = 1536; }
        else { bp = V + 2097152 + (size_t)((rb - 8192) >> 9) * 4 * 128 * 1536 + ((rb - 8192) & 511); st = 1536; }
        const int tid = wid * 64 + lane;
#pragma unroll
        for (int i = 0; i < 16; ++i) { const int idx = tid + 512 * i, el = idx >> 5, part = idx & 31;
            *(u32x4*)(bp + (size_t)((u.pn - 1) * 256 + el) * st + part * 8) = *(const LAS u32x4*)(T + el * 264 + part * 8); }
        __syncthreads();
    }
    __device__ __forceinline__ void operator()(const f32x4 (&acc)[2][2][4][2], const Unit& u, int wr, int wc, int fr_, int fq_) const {
        int fr = fr_, fq = fq_; asm volatile("" : "+v"(fr), "+v"(fq));
        int rb = u.pm * 256; if (layer == 0) rb = rb < 2048 ? 8192 + rb : rb - 2048;
        const int row0 = rb + wr * 64 + fr;
        float w1[4], w2[4];
#pragma unroll
        for (int i = 0; i < 4; ++i) { w1[i] = khn[64 + 4 * fq + i]; w2[i] = khn[80 + 4 * fq + i]; }
#pragma unroll
        for (int ai = 0; ai < 2; ++ai)
#pragma unroll
          for (int mh = 0; mh < 4; mh += 1) {
            float x1[4][4], x2[4][4], cs[4][4], sn[4][4];
#pragma unroll
            for (int m = mh; m < mh + 1; ++m) { const int r = row0 + ai * 128 + m * 16;
                if (r >= 8192) { const int j = r - 8192; const float* kr = ckr + ((size_t)(((j >> 9) * 2 + layer) * 512 + (j & 511))) * 32 + 4 * fq;
                    const f32x4 a = *(const f32x4*)kr, b = *(const f32x4*)(kr + 16);
#pragma unroll
                    for (int i = 0; i < 4; ++i) { x1[m][i] = a[i]; x2[m][i] = b[i]; } }
                else { const bf16_t* kr = Z + (size_t)r * LDZ + ZMKR + 4 * fq; const u32x2 a = *(const u32x2*)kr, b = *(const u32x2*)(kr + 16);
                    x1[m][0] = lo16(a.x); x1[m][1] = hi16(a.x); x1[m][2] = lo16(a.y); x1[m][3] = hi16(a.y); x2[m][0] = lo16(b.x); x2[m][1] = hi16(b.x); x2[m][2] = lo16(b.y); x2[m][3] = hi16(b.y); }
                const bool rot = r >= 4096 && r < 8192; const int pos = (r - 4096) & 1023;
                if (rot) { const f32x4 c = *(const f32x4*)(R + pos * 16 + 4 * fq), s_ = *(const f32x4*)(R + 16384 + pos * 16 + 4 * fq);
#pragma unroll
                    for (int i = 0; i < 4; ++i) { cs[m][i] = c[i]; sn[m][i] = s_[i]; } }
                else {
#pragma unroll
                    for (int i = 0; i < 4; ++i) { cs[m][i] = 1.f; sn[m][i] = 0.f; } } }
#pragma unroll
            for (int m = mh; m < mh + 1; ++m) { const int r = row0 + ai * 128 + m * 16;
                float ss = 0.f;
#pragma unroll
                for (int bj = 0; bj < 2; ++bj)
#pragma unroll
                    for (int i = 0; i < 8; ++i) { const float v = acc[ai][bj][m][i >> 2][i & 3]; ss += v * v; }
#pragma unroll
                for (int i = 0; i < 4; ++i) ss += x1[m][i] * x1[m][i] + x2[m][i] * x2[m][i];
                ss += __shfl_xor(ss, 16); ss += __shfl_xor(ss, 32);
                const float rstd = rsqrtf(ss * (1.f / 96.f) + 1e-6f);
                bf16_t* kp = KF + (size_t)r * 384 + wc * 96;
#pragma unroll
                for (int bj = 0; bj < 2; ++bj) { u32x4 w; const f32x4 v0 = acc[ai][bj][m][0], v1 = acc[ai][bj][m][1];
                    w.x = pk2(v0[0] * rstd, v0[1] * rstd); w.y = pk2(v0[2] * rstd, v0[3] * rstd);
                    w.z = pk2(v1[0] * rstd, v1[1] * rstd); w.w = pk2(v1[2] * rstd, v1[3] * rstd);
                    *(u32x4*)(kp + 32 * bj + 8 * fq) = w; }
                float o1[4], o2[4];
#pragma unroll
                for (int i = 0; i < 4; ++i) { const float a = x1[m][i] * rstd * w1[i], b = x2[m][i] * rstd * w2[i]; o1[i] = a * cs[m][i] - b * sn[m][i]; o2[i] = a * sn[m][i] + b * cs[m][i]; }
                *(u32x2*)(kp + 64 + 4 * fq) = (u32x2){pk2(o1[0], o1[1]), pk2(o1[2], o1[3])}; *(u32x2*)(kp + 80 + 4 * fq) = (u32x2){pk2(o2[0], o2[1]), pk2(o2[2], o2[3])}; }
            __builtin_amdgcn_sched_barrier(0); }
    } };
struct EpiGLU { static constexpr bool PERM = true, AFTER_DRAIN = false; bf16_t* O; const bf16_t* Z; const float* bias;
    __device__ __forceinline__ void operator()(const f32x4 (&acc)[2][2][4][2], const Unit& u, int wr, int wc, int fr_, int fq_) const {
        int fr = fr_, fq = fq_; asm volatile("" : "+v"(fr), "+v"(fq));
        const int row0 = u.pm * 256 + wr * 64 + fr, oc = u.pn * 128 + wc * 32 + 8 * fq;
#pragma unroll
        for (int ai = 0; ai < 2; ++ai) {
            float bv[8], bg[8];
            { const f32x4 b0 = *(const f32x4*)(bias + oc), b1 = *(const f32x4*)(bias + oc + 4), g0 = *(const f32x4*)(bias + 512 + oc), g1 = *(const f32x4*)(bias + 512 + oc + 4);
#pragma unroll
              for (int i = 0; i < 4; ++i) { bv[i] = b0[i]; bv[4 + i] = b1[i]; bg[i] = g0[i]; bg[4 + i] = g1[i]; } }
            u32x4 sgv[2][4];
#pragma unroll
            for (int m = 0; m < 4; ++m) sgv[ai][m] = *(const u32x4*)(Z + (size_t)(row0 + ai * 128 + m * 16) * LDZ + ZSG + oc);
#pragma unroll
            for (int m = 0; m < 4; ++m) { const size_t r = (size_t)(row0 + ai * 128 + m * 16);
                const u32x4 sg = sgv[ai][m];
                float g[8] = { lo16(sg.x), hi16(sg.x), lo16(sg.y), hi16(sg.y), lo16(sg.z), hi16(sg.z), lo16(sg.w), hi16(sg.w) };
                float o[8];
#pragma unroll
                for (int i = 0; i < 8; ++i) { const float zv = acc[ai][0][m][i >> 2][i & 3] + bv[i], zg = acc[ai][1][m][i >> 2][i & 3] + bg[i]; o[i] = zv * sigmoidf_(zg) * siluf_(g[i]); }
                u32x4 w; w.x = pk2(o[0], o[1]); w.y = pk2(o[2], o[3]); w.z = pk2(o[4], o[5]); w.w = pk2(o[6], o[7]);
                *(u32x4*)(O + r * 512 + oc) = w; }
            __builtin_amdgcn_sched_barrier(0); }
    } };
struct EpiBo { static constexpr bool PERM = true, AFTER_DRAIN = true; bf16_t* MIX; const bf16_t* Z; int branch; int first;
    __device__ __forceinline__ void fused(f32x4 (&acc)[2][2][4][2], const Unit& u, int wr, int wc, int fr_, int fq_, LAS unsigned char* lds, int wid, int lane_) const {
        int fr = fr_, fq = fq_, lane = lane_; asm volatile("" : "+v"(fr), "+v"(fq), "+v"(lane));
        const int row0 = u.pm * 256 + wr * 64 + fr, col0 = u.pn * 256 + wc * 32 + 8 * fq;
        LAS unsigned char* wl = lds + wid * 16384;
#pragma unroll
        for (int ai = 0; ai < 2; ++ai)
#pragma unroll
            for (int m = 0; m < 4; ++m)
#pragma unroll
                for (int bj = 0; bj < 2; ++bj)
                    __builtin_amdgcn_global_load_lds((const unsigned*)(Z + (size_t)(row0 + ai * 128 + m * 16) * LDZ + ZMERGE + branch * 1024 + col0 + bj * 128), (LAS unsigned*)(wl + ((ai * 4 + m) * 2 + bj) * 1024), 16, 0, 0);
#pragma unroll
        for (int ai = 0; ai < 2; ++ai) {
            u32x4 pv[4][2];
#pragma unroll
            for (int m = 0; m < 4; ++m)
#pragma unroll
                for (int bj = 0; bj < 2; ++bj) pv[m][bj] = first == 0 ? *(const u32x4*)(MIX + (size_t)(row0 + ai * 128 + m * 16) * 1024 + col0 + bj * 128) : (u32x4){0u, 0u, 0u, 0u};
            if (ai == 0) { asm volatile("s_waitcnt vmcnt(0)" ::: "memory"); __builtin_amdgcn_s_barrier(); asm volatile("" ::: "memory"); }
#pragma unroll
            for (int m = 0; m < 4; ++m) { const size_t r = (size_t)(row0 + ai * 128 + m * 16);
#pragma unroll
                for (int bj = 0; bj < 2; ++bj) { const u32x4 sg = *(const LAS u32x4*)(wl + ((ai * 4 + m) * 2 + bj) * 1024 + lane * 16), pp = pv[m][bj];
                    const float g[8] = { lo16(sg.x), hi16(sg.x), lo16(sg.y), hi16(sg.y), lo16(sg.z), hi16(sg.z), lo16(sg.w), hi16(sg.w) };
                    const float q[8] = { lo16(pp.x), hi16(pp.x), lo16(pp.y), hi16(pp.y), lo16(pp.z), hi16(pp.z), lo16(pp.w), hi16(pp.w) };
                    float o[8];
#pragma unroll
                    for (int i = 0; i < 8; ++i) o[i] = q[i] + sigmoidf_(g[i]) * acc[ai][bj][m][i >> 2][i & 3];
                    u32x4 w; w.x = pk2(o[0], o[1]); w.y = pk2(o[2], o[3]); w.z = pk2(o[4], o[5]); w.w = pk2(o[6], o[7]);
                    *(u32x4*)(MIX + r * 1024 + col0 + bj * 128) = w; } }
            __builtin_amdgcn_sched_barrier(0); }
        __syncthreads();
    }
    __device__ __forceinline__ void operator()(const f32x4 (&acc)[2][2][4][2], const Unit& u, int wr, int wc, int fr_, int fq_) const {
        int fr = fr_, fq = fq_; asm volatile("" : "+v"(fr), "+v"(fq));
        const int row0 = u.pm * 256 + wr * 64 + fr, col0 = u.pn * 256 + wc * 32 + 8 * fq;
#pragma unroll
        for (int ai = 0; ai < 2; ++ai)
#pragma unroll
          for (int mh = 0; mh < 4; mh += 2) {
            u32x4 gz[4][2], pv[4][2];
#pragma unroll
            for (int m = mh; m < mh + 2; ++m)
#pragma unroll
                for (int bj = 0; bj < 2; ++bj) { const size_t r = (size_t)(row0 + ai * 128 + m * 16);
                    gz[m][bj] = *(const u32x4*)(Z + r * LDZ + ZMERGE + branch * 1024 + col0 + bj * 128);
                    pv[m][bj] = first == 0 ? *(const u32x4*)(MIX + r * 1024 + col0 + bj * 128) : (u32x4){0u, 0u, 0u, 0u}; }
#pragma unroll
            for (int m = mh; m < mh + 2; ++m) { const size_t r = (size_t)(row0 + ai * 128 + m * 16);
#pragma unroll
                for (int bj = 0; bj < 2; ++bj) { const u32x4 sg = gz[m][bj], pp = pv[m][bj];
                    const float g[8] = { lo16(sg.x), hi16(sg.x), lo16(sg.y), hi16(sg.y), lo16(sg.z), hi16(sg.z), lo16(sg.w), hi16(sg.w) };
                    const float q[8] = { lo16(pp.x), hi16(pp.x), lo16(pp.y), hi16(pp.y), lo16(pp.z), hi16(pp.z), lo16(pp.w), hi16(pp.w) };
                    float o[8];
#pragma unroll
                    for (int i = 0; i < 8; ++i) o[i] = q[i] + sigmoidf_(g[i]) * acc[ai][bj][m][i >> 2][i & 3];
                    u32x4 w; w.x = pk2(o[0], o[1]); w.y = pk2(o[2], o[3]); w.z = pk2(o[4], o[5]); w.w = pk2(o[6], o[7]);
                    *(u32x4*)(MIX + r * 1024 + col0 + bj * 128) = w; } }
            __builtin_amdgcn_sched_barrier(0); }
    } };
struct EpiOut { static constexpr bool PERM = false, AFTER_DRAIN = true; float* Y; const float* xp; const float* xs; const float* ada;
    __device__ __forceinline__ void fused(f32x4 (&acc)[2][2][4][2], const Unit& u, int wr, int wc, int fr_, int fq_, LAS unsigned char* lds, int wid, int lane_) const {
        int fr = fr_, fq = fq_, lane = lane_; asm volatile("" : "+v"(fr), "+v"(fq), "+v"(lane));
        const int row0 = u.pm * 256 + wr * 64 + fr, col0 = u.pn * 256 + wc * 32 + 4 * fq;
        LAS unsigned char* wl = lds + wid * 16384;
        const float* xb = (u.pm < 16 ? xp + (size_t)row0 * 1024 : xs + (size_t)(row0 - 4096) * 1024) + col0;
#pragma unroll
        for (int m = 0; m < 4; ++m)
#pragma unroll
            for (int bj = 0; bj < 2; ++bj)
#pragma unroll
                for (int n = 0; n < 2; ++n) __builtin_amdgcn_global_load_lds((const unsigned*)(xb + (size_t)(m * 16) * 1024 + bj * 128 + n * 16), (LAS unsigned*)(wl + ((m * 2 + bj) * 2 + n) * 1024), 16, 0, 0);
        f32x4 x1[4][2][2];
#pragma unroll
        for (int m = 0; m < 4; ++m)
#pragma unroll
            for (int bj = 0; bj < 2; ++bj)
#pragma unroll
                for (int n = 0; n < 2; ++n) x1[m][bj][n] = *(const f32x4*)(xb + (size_t)(128 + m * 16) * 1024 + bj * 128 + n * 16);
        const int ar = u.pm < 16 ? 0 : 1 + ((u.pm - 16) >> 2);
        const float* gp = ada + ar * 3072 + 2048;
        f32x4 gv[2][2];
#pragma unroll
        for (int bj = 0; bj < 2; ++bj)
#pragma unroll
            for (int n = 0; n < 2; ++n) gv[bj][n] = *(const f32x4*)(gp + col0 + bj * 128 + n * 16);
        asm volatile("s_waitcnt vmcnt(0)" ::: "memory"); __builtin_amdgcn_s_barrier(); asm volatile("" ::: "memory");
        float* yb = Y + (size_t)row0 * 1024 + col0;
#pragma unroll
        for (int m = 0; m < 4; ++m)
#pragma unroll
            for (int bj = 0; bj < 2; ++bj)
#pragma unroll
                for (int n = 0; n < 2; ++n) { const f32x4 xv = *(const LAS f32x4*)(wl + ((m * 2 + bj) * 2 + n) * 1024 + lane * 16);
                    *(f32x4*)(yb + (size_t)(m * 16) * 1024 + bj * 128 + n * 16) = xv + gv[bj][n] * acc[0][bj][m][n];
                    *(f32x4*)(yb + (size_t)(128 + m * 16) * 1024 + bj * 128 + n * 16) = x1[m][bj][n] + gv[bj][n] * acc[1][bj][m][n]; }
        __syncthreads();
    }
    __device__ __forceinline__ void operator()(const f32x4 (&acc)[2][2][4][2], const Unit& u, int wr, int wc, int fr_, int fq_) const {
        int fr = fr_, fq = fq_; asm volatile("" : "+v"(fr), "+v"(fq));
        const int row0 = u.pm * 256 + wr * 64 + fr, col0 = u.pn * 256 + wc * 32 + 4 * fq;
        const int ar = u.pm < 16 ? 0 : 1 + ((u.pm - 16) >> 2);
        const float* gp = ada + ar * 3072 + 2048;
        f32x4 gv[2][2];
#pragma unroll
        for (int bj = 0; bj < 2; ++bj)
#pragma unroll
            for (int n = 0; n < 2; ++n) gv[bj][n] = *(const f32x4*)(gp + col0 + bj * 128 + n * 16);
#pragma unroll
        for (int ai = 0; ai < 2; ++ai)
#pragma unroll
          for (int mh = 0; mh < 4; mh += 2) {
            f32x4 xv[4][2][2];
#pragma unroll
            for (int m = mh; m < mh + 2; ++m) { const int r = row0 + ai * 128 + m * 16;
                const float* xr = (r < 4096 ? xp + (size_t)r * 1024 : xs + (size_t)(r - 4096) * 1024) + col0;
#pragma unroll
                for (int bj = 0; bj < 2; ++bj)
#pragma unroll
                    for (int n = 0; n < 2; ++n) xv[m][bj][n] = *(const f32x4*)(xr + bj * 128 + n * 16); }
#pragma unroll
            for (int m = mh; m < mh + 2; ++m) { const int r = row0 + ai * 128 + m * 16;
                float* yr = Y + (size_t)r * 1024 + col0;
#pragma unroll
                for (int bj = 0; bj < 2; ++bj)
#pragma unroll
                    for (int n = 0; n < 2; ++n) *(f32x4*)(yr + bj * 128 + n * 16) = xv[m][bj][n] + gv[bj][n] * acc[ai][bj][m][n]; }
            __builtin_amdgcn_sched_barrier(0); }
    } };

__device__ __forceinline__ void job_ada(const Params& p, int j, lds_t lds) {
    LAS float* sc = (LAS float*)lds; LAS float* red = sc + 5 * 1024;
    const int l = j / 96, c0 = (j % 96) * 32, tid = tid_opaque(p);
    for (int i = tid; i < 5 * 1024; i += 512) { const int r = i >> 10, k = i & 1023; const float v = r == 0 ? p.in[I_CCTX][k] : p.in[I_C][(r - 1) * 1024 + k]; sc[i] = v / (1.f + expf(-v)); }
    __syncthreads();
    const int col = tid & 31, kg = tid >> 5; const float* W = p.in[I_WADA] + (size_t)l * 1024 * 3072 + (size_t)(kg * 64) * 3072 + c0 + col;
    float a0 = 0.f, a1 = 0.f, a2 = 0.f, a3 = 0.f, a4 = 0.f;
#pragma unroll 1
    for (int kb = 0; kb < 64; kb += 16) { float w[16];
#pragma unroll
        for (int i = 0; i < 16; ++i) w[i] = W[(size_t)(kb + i) * 3072];
#pragma unroll
        for (int i = 0; i < 16; ++i) { const int k = kg * 64 + kb + i; a0 += sc[k] * w[i]; a1 += sc[1024 + k] * w[i]; a2 += sc[2048 + k] * w[i]; a3 += sc[3072 + k] * w[i]; a4 += sc[4096 + k] * w[i]; } }
    red[(kg * 5 + 0) * 32 + col] = a0; red[(kg * 5 + 1) * 32 + col] = a1; red[(kg * 5 + 2) * 32 + col] = a2; red[(kg * 5 + 3) * 32 + col] = a3; red[(kg * 5 + 4) * 32 + col] = a4;
    __syncthreads();
    if (tid < 160) { const int r = tid >> 5, cc = tid & 31; float s = p.in[I_BADA][l * 3072 + c0 + cc];
        for (int g = 0; g < 16; ++g) s += red[(g * 5 + r) * 32 + cc];
        ((float*)(p.ws + OFF_ADA))[(l * 5 + r) * 3072 + c0 + cc] = s; }
    __syncthreads();
}
__device__ __forceinline__ void job_ctx(const Params& p, int j) {
    const int base = j * 4096 + tid_opaque(p) * 8; const int l = base / (2048 * 256), rem = base % (2048 * 256), row = rem >> 8, c = rem & 255, b = row >> 9, jj = row & 511;
    const float* s = p.in[I_CKV] + ((size_t)((b * 2 + l) * 512 + jj)) * 256 + c;
    const f32x4 v0 = *(const f32x4*)s, v1 = *(const f32x4*)(s + 4);
    bf16_t* d = (bf16_t*)(p.ws + (l == 0 ? OFF_CTX0 : OFF_CTX1)) + (size_t)row * 256 + c;
    store8(d, v0, v1);
}
__device__ __forceinline__ void job_rope(const Params& p, int j) {
    const int idx = j * 512 + tid_opaque(p), pos = idx >> 4, i = idx & 15, f = i & 7;
    const float inv = powf(10000.f, -(float)f / 8.f); const float ang = (float)(i < 8 ? (pos >> 6) : (pos & 63)) * inv;
    float* R = (float*)(p.ws + OFF_ROPE); R[idx] = cosf(ang); R[16384 + idx] = sinf(ang);
}

__device__ __forceinline__ void job_prep(const Params& p, int l, int j) {
    const int tid = tid_opaque(p), wid = tid >> 6, lane = tid & 63;
    const float* nw = p.in[I_NORMW] + l * 1024;
    f32x4 v[4][4]; float ss[4];
#pragma unroll
    for (int q = 0; q < 4; ++q) { const int row = j * 32 + wid * 4 + q;
        const float* x = l == 0 ? (row < 4096 ? p.in[I_XP] + (size_t)row * 1024 : p.in[I_XS] + (size_t)(row - 4096) * 1024) : p.out + (size_t)row * 1024;
#pragma unroll
        for (int i = 0; i < 4; ++i) v[q][i] = *(const f32x4*)(x + i * 256 + lane * 4); }
#pragma unroll
    for (int q = 0; q < 4; ++q) { float s_ = 0.f;
#pragma unroll
        for (int i = 0; i < 4; ++i) s_ += v[q][i][0] * v[q][i][0] + v[q][i][1] * v[q][i][1] + v[q][i][2] * v[q][i][2] + v[q][i][3] * v[q][i][3];
#pragma unroll
        for (int o = 1; o < 64; o <<= 1) s_ += __shfl_xor(s_, o);
        ss[q] = s_; }
#pragma unroll
    for (int q = 0; q < 4; ++q) { const int row = j * 32 + wid * 4 + q; const int ar = row < 4096 ? 0 : 1 + ((row - 4096) >> 10);
        const float* ada = (const float*)(p.ws + OFF_ADA) + (l * 5 + ar) * 3072;
        const float rstd = rsqrtf(ss[q] * (1.f / 1024.f) + 1e-6f);
        bf16_t* h = (bf16_t*)(p.ws + OFF_HB) + (size_t)row * 1024;
#pragma unroll
        for (int i = 0; i < 4; ++i) { const int c = i * 256 + lane * 4; const f32x4 w = *(const f32x4*)(nw + c), sh = *(const f32x4*)(ada + c), sc = *(const f32x4*)(ada + 1024 + c);
            float o[4];
#pragma unroll
            for (int k = 0; k < 4; ++k) o[k] = v[q][i][k] * rstd * w[k] * (1.f + sc[k]) + sh[k];
            u32x2 pk; pk.x = pk2(o[0], o[1]); pk.y = pk2(o[2], o[3]); *(u32x2*)(h + c) = pk; } }
}
__device__ __forceinline__ void wt_tile(const Params& p, const float* src, int ldsrc, int sbase, int nvalid, int mode, bf16_t* dst, int K, int n0, int k0, lds_t lds) {
    LAS float* t = (LAS float*)lds; const int tid = tid_opaque(p);
    const int nn = tid & 255, kh = tid >> 8; const int sc = mode == 0 ? sbase + nn : mode == 1 ? ((nn >> 7) & 1) * 512 + sbase + (nn & 127) : ((nn >> 5) & 3) * 64 + (nn >> 7) * 32 + (nn & 31); const bool ok = mode != 0 || nn < nvalid;
    float v[32];
#pragma unroll
    for (int i = 0; i < 32; ++i) v[i] = ok ? src[(size_t)(k0 + 2 * i + kh) * ldsrc + sc] : 0.f;
#pragma unroll
    for (int i = 0; i < 32; ++i) t[(2 * i + kh) * 257 + nn] = v[i];
    __syncthreads();
#pragma unroll
    for (int ps = 0; ps < 4; ++ps) { const int n = ps * 64 + (tid >> 3), kc = tid & 7; const LAS float* s = t + (kc * 8) * 257 + n; u32x4 w;
        w.x = pk2(s[0], s[257]); w.y = pk2(s[514], s[771]); w.z = pk2(s[1028], s[1285]); w.w = pk2(s[1542], s[1799]);
        *(u32x4*)(dst + (size_t)(n0 + n) * K + k0 + kc * 8) = w; }
    __syncthreads();
}
constexpr int WT_WIN = 27 * 16, WT_WUQ = 2 * 6, WT_WKV = 3 * 4, WT_WGLU = 4 * 8, WT_WBO = 4 * 8, WT_WOUT = 4 * 16, WT_EARLY = WT_WIN + WT_WUQ + WT_WKV + WT_WGLU, WT_TOTAL = WT_EARLY + 3 * WT_WBO + WT_WOUT;
__device__ __forceinline__ void job_wt(const Params& p, int l, int t, lds_t lds) {
    if (t < WT_WIN) { const int nt = t / 16, kt = t % 16; wt_tile(p, p.in[I_WIN] + (size_t)l * 1024 * 6848, 6848, nt * 256, 6848 - nt * 256, 0, (bf16_t*)(p.ws + OFF_WIN), 1024, nt * 256, kt * 64, lds); return; } t -= WT_WIN;
    if (t < WT_WUQ) { const int nt = t / 6, kt = t % 6; wt_tile(p, p.in[I_WUQ] + (size_t)l * 384 * 384, 384, nt * 256, 384 - nt * 256, 0, (bf16_t*)(p.ws + OFF_WUQ), 384, nt * 256, kt * 64, lds); return; } t -= WT_WUQ;
    if (t < WT_WKV) { const int nt = t / 4, kt = t % 4;
        if (nt == 0) wt_tile(p, p.in[I_WUK] + (size_t)l * 256 * 256, 256, 0, 256, 2, (bf16_t*)(p.ws + OFF_WKV), 256, 0, kt * 64, lds);
        else wt_tile(p, p.in[I_WUV] + (size_t)l * 256 * 512, 512, (nt - 1) * 256, 256, 0, (bf16_t*)(p.ws + OFF_WKV), 256, nt * 256, kt * 64, lds);
        return; } t -= WT_WKV;
    if (t < WT_WGLU) { const int nt = t / 8, kt = t % 8; wt_tile(p, p.in[I_WGLU] + (size_t)l * 512 * 1024, 1024, nt * 128, 256, 1, (bf16_t*)(p.ws + OFF_WGLU), 512, nt * 256, kt * 64, lds); return; } t -= WT_WGLU;
    if (t < 3 * WT_WBO) { const int br = t / WT_WBO, tt = t % WT_WBO, nt = tt / 8, kt = tt % 8;
        wt_tile(p, p.in[I_WBOG + br] + (size_t)l * 512 * 1024, 1024, nt * 256, 256, 0, (bf16_t*)(p.ws + OFF_WBO) + (size_t)br * 1024 * 512, 512, nt * 256, kt * 64, lds); return; } t -= 3 * WT_WBO;
    { const int nt = t / 16, kt = t % 16; wt_tile(p, p.in[I_WOUT] + (size_t)l * 1024 * 1024, 1024, nt * 256, 256, 0, (bf16_t*)(p.ws + (l == 0 ? OFF_WOUT : OFF_WOUT2)), 1024, nt * 256, kt * 64, lds); }
}
__device__ __forceinline__ void job_s5setup(const Params& p, int l, int jq, lds_t lds) {
    const int j = jq >> 2, qtr = jq & 3, g = j / 3, which = j % 3, tid = tid_opaque(p);
    LAS f32x2_t* pw = (LAS f32x2_t*)lds;
    LAS f32x2_t* Bt = pw + 2 * 17 * 64;
    LAS f32x2_t* Cn = Bt + 2 * 64 * 16;
    LAS float* Kt = (LAS float*)(Cn + 64 * 16);
    LAS float* raw = Kt + 8192;
    { const size_t gb = (size_t)(l * 32 + g) * 1024;
      for (int i = tid; i < 1024; i += 512) { raw[i] = p.in[I_BRE][gb + i]; raw[1024 + i] = p.in[I_BIM][gb + i]; raw[2048 + i] = p.in[I_CRE][gb + i]; raw[3072 + i] = p.in[I_CIM][gb + i]; }
      if (tid < 128) { const int d = tid >> 6, n = tid & 63; raw[4096 + tid] = p.in[I_ARE][((l * 2 + d) * 32 + g) * 64 + n]; raw[4224 + tid] = p.in[I_AIM][((l * 2 + d) * 32 + g) * 64 + n]; }
      if (tid < 2) raw[4352 + tid] = p.in[I_LOGDT][(l * 2 + tid) * 32 + g]; }
    __syncthreads();
    if (tid < 128) { const int d = tid >> 6, n = tid & 63;
        const float dt = expf(raw[4352 + d]);
        const float are = raw[4096 + tid], aim = raw[4224 + tid];
        float s1, c1; sincosf(aim * dt, &s1, &c1); float sh = sinf(0.5f * aim * dt);
        const float em1 = expm1f(are * dt), mag1 = em1 + 1.f;
        { float pr = 1.f, pi = 0.f; const float ar1 = mag1 * c1, ai1 = mag1 * s1;
          for (int tau = 0; tau <= 16; ++tau) { pw[(d * 17 + tau) * 64 + n] = (f32x2_t){pr, pi}; const float nr = pr * ar1 - pi * ai1, ni = pr * ai1 + pi * ar1; pr = nr; pi = ni; } }
        const float nre = em1 * c1 - 2.f * sh * sh, abim = mag1 * s1, den = are * are + aim * aim;
        const float cfr = (nre * are + abim * aim) / den, cfi = (abim * are - nre * aim) / den;
        for (int q = 0; q < 16; ++q) { const float br = raw[n * 16 + q], bi = raw[1024 + n * 16 + q];
            Bt[(d * 64 + n) * 16 + q] = (f32x2_t){cfr * br - cfi * bi, cfr * bi + cfi * br}; }
        if (which == 1 && qtr == 0) ((f32x2_t*)(p.ws + OFF_P16))[(g * 2 + d) * 64 + n] = pw[(d * 17 + 16) * 64 + n];
    }
    for (int i = tid; i < 1024; i += 512) { const int n = i >> 4, pp = i & 15; Cn[i] = (f32x2_t){raw[2048 + pp * 64 + n], raw[3072 + pp * 64 + n]}; }
    __syncthreads();
    bf16_t* M = (bf16_t*)(p.ws + OFF_S5M) + (size_t)(g * 3 + which) * 65536;
    if (which == 0) {
        { const int wid_ = tid >> 6, ln = tid & 63, lr_ = ln & 15, kq = ln >> 4;
          for (int c4 = 0; c4 < 4; ++c4) { const int dt_ = wid_ * 4 + c4, d = dt_ >> 4, tau = dt_ & 15; f32x4 acc = {0.f, 0.f, 0.f, 0.f};
#pragma unroll 4
            for (int ks = 0; ks < 16; ++ks) { const int n = ks * 4 + kq; const f32x2_t c = Cn[n * 16 + lr_], w = pw[(d * 17 + tau) * 64 + n], b = Bt[(d * 64 + n) * 16 + lr_];
                const float cwr = c.x * w.x - c.y * w.y, cwi = c.x * w.y + c.y * w.x;
                acc = __builtin_amdgcn_mfma_f32_16x16x4f32(cwr, b.x, acc, 0, 0, 0); acc = __builtin_amdgcn_mfma_f32_16x16x4f32(-cwi, b.y, acc, 0, 0, 0); }
#pragma unroll
            for (int r = 0; r < 4; ++r) Kt[dt_ * 256 + (kq * 4 + r) * 16 + lr_] = acc[r]; } }
        __syncthreads();
#pragma unroll 8
        for (int i = qtr * 16384 + tid; i < (qtr + 1) * 16384; i += 512) { const int no = i >> 8, k = i & 255, t = no >> 4, pp = no & 15, s = k >> 4, q = k & 15; float v;
            if (t > s) v = Kt[(0 * 16 + (t - s)) * 256 + pp * 16 + q];
            else if (t < s) v = Kt[(1 * 16 + (s - t)) * 256 + pp * 16 + q];
            else { v = Kt[pp * 16 + q] + Kt[16 * 256 + pp * 16 + q]; if (pp == q) v += p.in[I_S5D][l * 512 + g * 16 + pp]; }
            M[i] = f2bf(v); }
    } else if (which == 1) {
#pragma unroll 8
        for (int i = qtr * 16384 + tid; i < (qtr + 1) * 16384; i += 512) { const int no = i >> 8, k = i & 255, d = no >> 7, ri = (no >> 6) & 1, n = no & 63, s = k >> 4, q = k & 15; const int e = d == 0 ? 15 - s : s;
            const f32x2_t w = pw[(d * 17 + e) * 64 + n], b = Bt[(d * 64 + n) * 16 + q];
            M[i] = f2bf(ri == 0 ? w.x * b.x - w.y * b.y : w.x * b.y + w.y * b.x); }
    } else {
#pragma unroll 8
        for (int i = qtr * 16384 + tid; i < (qtr + 1) * 16384; i += 512) { const int no = i >> 8, k = i & 255, t = no >> 4, pp = no & 15, d = k >> 7, ri = (k >> 6) & 1, n = k & 63; const int e = d == 0 ? t + 1 : 16 - t;
            const f32x2_t c = Cn[n * 16 + pp], w = pw[(d * 17 + e) * 64 + n];
            M[i] = f2bf(ri == 0 ? c.x * w.x - c.y * w.y : -(c.x * w.y + c.y * w.x)); }
    }
    __syncthreads();
}

__device__ __forceinline__ float gelu_tanh(float x) { const float u = 0.7978845608f * (x + 0.044715f * x * x * x); const float t = 1.f - 2.f / (1.f + __expf(2.f * u)); return 0.5f * x * (1.f + t); }
__device__ __forceinline__ void job_s5(const Params& p, int l, int j, lds_t lds) {
    const int tid = tid_opaque(p), wid = tid >> 6, lane = tid & 63, lr = lane & 15, lq = lane >> 4;
    const int bcd = j >> 5, g = j & 31;
    const bool smp = bcd < 4;
    constexpr int M = 64, MT = 4; const int tok0 = smp ? 4096 + bcd * 1024 : (bcd - 4) * 1024;
    LAS bf16_t* Us = (LAS bf16_t*)lds; LAS bf16_t* Xs = Us + 64 * 264; LAS float* Xin = (LAS float*)(lds + 2 * 64 * 264 * 2);
    const bf16_t* Z = (const bf16_t*)(p.ws + OFF_Z);
    const bf16_t* TT = (const bf16_t*)(p.ws + OFF_S5M) + (size_t)(g * 3) * 65536; const bf16_t* G = TT + 65536; const bf16_t* Cc = G + 65536;
    bf16x8 bq[8][2];
#pragma unroll
    for (int ks = 0; ks < 8; ++ks) { bq[ks][0] = *(const bf16x8*)(G + (size_t)(wid * 32 + lr) * 256 + ks * 32 + lq * 8); bq[ks][1] = *(const bf16x8*)(G + (size_t)(wid * 32 + 16 + lr) * 256 + ks * 32 + lq * 8); }
    f32x2_t a16 = {0.f, 0.f}; float xr = 0.f, xi = 0.f;
    if (tid < 128) { const int d = tid >> 6, n = tid & 63; a16 = ((const f32x2_t*)(p.ws + OFF_P16))[(g * 2 + d) * 64 + n];
        if (smp) { const size_t o = ((size_t)((bcd * 2 + l) * 2 + d) * 2) * 2048 + g * 64 + n; xr = p.in[I_SS5][o]; xi = p.in[I_SS5][o + 2048]; } }
    for (int idx = tid; idx < M * 32; idx += 512) { const int tok = idx >> 1, hf = idx & 1;
        *(LAS u32x4*)(Us + (tok >> 4) * 264 + (tok & 15) * 16 + hf * 8) = *(const u32x4*)(Z + (size_t)(tok0 + tok) * LDZ + ZSU + g * 16 + hf * 8); }
    __syncthreads();
    f32x4 acc[4][2];
#pragma unroll
    for (int a = 0; a < 4; ++a) { acc[a][0] = (f32x4){0.f, 0.f, 0.f, 0.f}; acc[a][1] = acc[a][0]; }
#pragma unroll
    for (int ks = 0; ks < 8; ++ks)
#pragma unroll
        for (int mt = 0; mt < 4; ++mt) if (mt < MT) { const bf16x8 a = LDSFRAG(Us + (mt * 16 + lr) * 264 + ks * 32 + lq * 8); acc[mt][0] = MFMA16(a, bq[ks][0], acc[mt][0]); acc[mt][1] = MFMA16(a, bq[ks][1], acc[mt][1]); }
    bf16x8 bc[8][2];
#pragma unroll
    for (int ks = 0; ks < 8; ++ks) { bq[ks][0] = *(const bf16x8*)(TT + (size_t)(wid * 32 + lr) * 256 + ks * 32 + lq * 8); bq[ks][1] = *(const bf16x8*)(TT + (size_t)(wid * 32 + 16 + lr) * 256 + ks * 32 + lq * 8);
        bc[ks][0] = *(const bf16x8*)(Cc + (size_t)(wid * 32 + lr) * 256 + ks * 32 + lq * 8); bc[ks][1] = *(const bf16x8*)(Cc + (size_t)(wid * 32 + 16 + lr) * 256 + ks * 32 + lq * 8); }
#pragma unroll
    for (int mt = 0; mt < 4; ++mt) if (mt < MT)
#pragma unroll
        for (int ct = 0; ct < 2; ++ct)
#pragma unroll
            for (int r = 0; r < 4; ++r) Xin[(mt * 16 + lq * 4 + r) * 260 + wid * 32 + ct * 16 + lr] = acc[mt][ct][r];
    __syncthreads();
    if (tid < 128) { const int d = tid >> 6, n = tid & 63;
        const int cre = d * 128 + n, cim = cre + 64;
        const int nseg = smp ? 1 : 4, L = 64 / nseg;
        for (int sg = 0; sg < nseg; ++sg) {
            if (!smp) { xr = 0.f; xi = 0.f; }
            for (int i = 0; i < L; ++i) { const int c = sg * L + (d == 0 ? i : L - 1 - i);
                Xs[c * 264 + cre] = f2bf(xr); Xs[c * 264 + cim] = f2bf(xi);
                const float ur = Xin[c * 260 + cre], ui = Xin[c * 260 + cim];
                const float nr = a16.x * xr - a16.y * xi + ur, ni = a16.x * xi + a16.y * xr + ui; xr = nr; xi = ni; }
            if (!smp) { const int bb = (bcd - 4) * 4 + sg; const size_t o = OUT_S5 + ((size_t)((bb * 2 + l) * 2 + d) * 2) * 2048 + g * 64 + n; p.out[o] = xr; p.out[o + 2048] = xi; } }
    }
    __syncthreads();
#pragma unroll
    for (int a = 0; a < 4; ++a) { acc[a][0] = (f32x4){0.f, 0.f, 0.f, 0.f}; acc[a][1] = acc[a][0]; }
#pragma unroll
    for (int ks = 0; ks < 8; ++ks)
#pragma unroll
        for (int mt = 0; mt < 4; ++mt) if (mt < MT) { const bf16x8 a = LDSFRAG(Us + (mt * 16 + lr) * 264 + ks * 32 + lq * 8); acc[mt][0] = MFMA16(a, bq[ks][0], acc[mt][0]); acc[mt][1] = MFMA16(a, bq[ks][1], acc[mt][1]); }
#pragma unroll
    for (int ks = 0; ks < 8; ++ks)
#pragma unroll
        for (int mt = 0; mt < 4; ++mt) if (mt < MT) { const bf16x8 a = LDSFRAG(Xs + (mt * 16 + lr) * 264 + ks * 32 + lq * 8); acc[mt][0] = MFMA16(a, bc[ks][0], acc[mt][0]); acc[mt][1] = MFMA16(a, bc[ks][1], acc[mt][1]); }
    bf16_t* Yg = (bf16_t*)(p.ws + OFF_YG);
#pragma unroll
    for (int mt = 0; mt < 4; ++mt) if (mt < MT)
#pragma unroll
        for (int ct = 0; ct < 2; ++ct)
#pragma unroll
            for (int r = 0; r < 4; ++r) { const int chunk = mt * 16 + lq * 4 + r, t = wid * 2 + ct;
                Yg[(size_t)(tok0 + chunk * 16 + t) * 512 + g * 16 + lr] = f2bf(gelu_tanh(acc[mt][ct][r])); }
    __syncthreads();
}
__device__ __forceinline__ void job_mlaprep(const Params& p, int l, int j) {
    const int tid = tid_opaque(p), wid = tid >> 6, lane = tid & 63;
    bf16_t qr[4][6], kr[4][4], rr[4];
#pragma unroll
    for (int t4 = 0; t4 < 4; ++t4) { const int row = j * 32 + wid * 4 + t4; const bf16_t* z = (const bf16_t*)(p.ws + OFF_Z) + (size_t)row * LDZ;
#pragma unroll
        for (int i = 0; i < 6; ++i) qr[t4][i] = z[ZMQ + i * 64 + lane];
#pragma unroll
        for (int i = 0; i < 4; ++i) kr[t4][i] = z[ZMKV + i * 64 + lane];
        rr[t4] = z[ZMKR + (lane & 31)]; }
    float qn[6], kn[4];
#pragma unroll
    for (int i = 0; i < 6; ++i) qn[i] = p.in[I_QNORM][l * 384 + i * 64 + lane];
#pragma unroll
    for (int i = 0; i < 4; ++i) kn[i] = p.in[I_KVNORM][l * 256 + i * 64 + lane];
#pragma unroll
    for (int t4 = 0; t4 < 4; ++t4) { const int row = j * 32 + wid * 4 + t4;
        float q[6], kv[4]; float sq = 0.f, sk = 0.f;
#pragma unroll
        for (int i = 0; i < 6; ++i) { q[i] = bf2f(qr[t4][i]); sq += q[i] * q[i]; }
#pragma unroll
        for (int i = 0; i < 4; ++i) { kv[i] = bf2f(kr[t4][i]); sk += kv[i] * kv[i]; }
#pragma unroll
        for (int o = 1; o < 64; o <<= 1) { sq += __shfl_xor(sq, o); sk += __shfl_xor(sk, o); }
        const float rq = rsqrtf(sq * (1.f / 384.f) + 1e-6f), rk = rsqrtf(sk * (1.f / 256.f) + 1e-6f);
        bf16_t* aq = (bf16_t*)(p.ws + OFF_AQ) + (size_t)row * 384; bf16_t* ck = (bf16_t*)(p.ws + OFF_CKVN) + (size_t)row * 256;
#pragma unroll
        for (int i = 0; i < 6; ++i) aq[i * 64 + lane] = f2bf(q[i] * rq * qn[i]);
        const bool prompt = row < 4096; const int b = row >> 8, t = row & 255;
#pragma unroll
        for (int i = 0; i < 4; ++i) { const float v = kv[i] * rk * kn[i]; ck[i * 64 + lane] = f2bf(v);
            if (prompt) p.out[OUT_CKV + ((size_t)((b * 2 + l) * 256 + t)) * 256 + i * 64 + lane] = v; }
        if (prompt && lane < 32) p.out[OUT_KR + ((size_t)((b * 2 + l) * 256 + t)) * 32 + lane] = bf2f(rr[t4]); }
}
__device__ __forceinline__ float logsigmoidf_(float x) { return fminf(x, 0.f) - __logf(1.f + __expf(-fabsf(x))); }
__device__ __forceinline__ void job_glaA(const Params& p, int l, int j, lds_t lds) {
    const int tid = tid_opaque(p), wid = tid >> 6, lane = tid & 63, lr = lane & 15, lq = lane >> 4;
    const int ck = j >> 2, h = j & 3, tok0 = ck * 64;
    LAS bf16_t* QDf = (LAS bf16_t*)lds; LAS bf16_t* QDb = QDf + 4608; LAS bf16_t* KDf = QDb + 4608; LAS bf16_t* KDb = KDf + 4608; LAS bf16_t* KRf = KDb + 4608; LAS bf16_t* KRb = KRf + 4608;
    LAS bf16_t* VT = KRb + 4608;
    LAS bf16_t* ATT = VT + 9216;
    LAS float* GA = (LAS float*)(ATT + 4608);
    LAS float* TOT = GA + 2048;
    const bf16_t* Z = (const bf16_t*)(p.ws + OFF_Z);
    const int d = tid & 63, cg_ = tid >> 6;
    bf16_t qraw[8], kraw[8]; float wf[16], wb[16];
#pragma unroll
    for (int i = 0; i < 8; ++i) { const size_t zr = (size_t)(tok0 + cg_ * 8 + i) * LDZ; qraw[i] = Z[zr + ZQ + h * 64 + d]; kraw[i] = Z[zr + ZK + h * 64 + d]; }
#pragma unroll
    for (int r = 0; r < 16; ++r) { wf[r] = p.in[I_WA2][((size_t)((l * 2 + 0) * 16 + r)) * 256 + h * 64 + d]; wb[r] = p.in[I_WA2][((size_t)((l * 2 + 1) * 16 + r)) * 256 + h * 64 + d]; }
    const float bf_ = p.in[I_BA][(l * 2 + 0) * 256 + h * 64 + d], bb_ = p.in[I_BA][(l * 2 + 1) * 256 + h * 64 + d];
    { const int c = tid >> 3, part = tid & 7; const u32x2 gv = *(const u32x2*)(Z + (size_t)(tok0 + c) * LDZ + ZGA + part * 4);
      GA[c * 32 + part * 4 + 0] = lo16(gv.x); GA[c * 32 + part * 4 + 1] = hi16(gv.x); GA[c * 32 + part * 4 + 2] = lo16(gv.y); GA[c * 32 + part * 4 + 3] = hi16(gv.y);
      const bf16_t* vp = Z + (size_t)(tok0 + c) * LDZ + ZV + h * 128 + part * 16;
      const u32x4 v0 = *(const u32x4*)vp, v1 = *(const u32x4*)(vp + 8);
      const unsigned w[8] = { v0.x, v0.y, v0.z, v0.w, v1.x, v1.y, v1.z, v1.w };
#pragma unroll
      for (int i = 0; i < 8; ++i) { VT[(part * 16 + 2 * i) * 72 + c] = (bf16_t)(w[i] & 0xffffu); VT[(part * 16 + 2 * i + 1) * 72 + c] = (bf16_t)(w[i] >> 16); } }
    __syncthreads();
    float laf[8], lab[8];
    {
#pragma unroll
      for (int i = 0; i < 8; ++i) { const int c = cg_ * 8 + i; float xf = bf_, xb = bb_;
#pragma unroll
          for (int r = 0; r < 16; ++r) { xf += GA[c * 32 + r] * wf[r]; xb += GA[c * 32 + 16 + r] * wb[r]; }
          laf[i] = logsigmoidf_(xf) * (1.f / 16.f); lab[i] = logsigmoidf_(xb) * (1.f / 16.f); } }
#pragma unroll
    for (int i = 1; i < 8; ++i) laf[i] += laf[i - 1];
#pragma unroll
    for (int i = 6; i >= 0; --i) lab[i] += lab[i + 1];
    TOT[(0 * 8 + cg_) * 64 + d] = laf[7]; TOT[(1 * 8 + cg_) * 64 + d] = lab[0];
    __syncthreads();
    float offf = 0.f, offb = 0.f, Tf = 0.f, Tb = 0.f;
#pragma unroll
    for (int g = 0; g < 8; ++g) { const float a = TOT[g * 64 + d], b = TOT[(8 + g) * 64 + d]; Tf += a; Tb += b; if (g < cg_) offf += a; if (g > cg_) offb += b; }
    bf16_t* QD = (bf16_t*)(p.ws + OFF_QD);
#pragma unroll
    for (int i = 0; i < 8; ++i) { const int c = cg_ * 8 + i;
        const float q = bf2f(qraw[i]) * 0.125f, k = bf2f(kraw[i]);
        const float bf_ = offf + laf[i], bb_ = offb + lab[i];
        const bf16_t qf = f2bf(q * __expf(bf_)), qb = f2bf(q * __expf(bb_));
        QDf[c * 72 + d] = qf; QDb[c * 72 + d] = qb;
        KDf[c * 72 + d] = f2bf(k * __expf(-bf_)); KDb[c * 72 + d] = f2bf(k * __expf(-bb_));
        KRf[d * 72 + c] = f2bf(k * __expf(Tf - bf_)); KRb[d * 72 + c] = f2bf(k * __expf(Tb - bb_));
        QD[(size_t)(tok0 + c) * 256 + h * 64 + d] = qf; QD[(size_t)(8192 + tok0 + c) * 256 + h * 64 + d] = qb; }
    if (cg_ == 0) { float* DEC = (float*)(p.ws + OFF_DEC); DEC[((0 * 128 + ck) * 4 + h) * 64 + d] = __expf(Tf); DEC[((1 * 128 + ck) * 4 + h) * 64 + d] = __expf(Tb); }
    __syncthreads();
#pragma unroll
    for (int q2 = 0; q2 < 2; ++q2) { const int tt = wid * 2 + q2, ti = tt >> 2, tj = tt & 3; f32x4 af = {0.f, 0.f, 0.f, 0.f}, ab = af;
#pragma unroll
        for (int ks = 0; ks < 2; ++ks) { const int ko = ks * 32 + lq * 8;
            af = MFMA16(LDSFRAG(QDf + (ti * 16 + lr) * 72 + ko), LDSFRAG(KDf + (tj * 16 + lr) * 72 + ko), af);
            ab = MFMA16(LDSFRAG(QDb + (ti * 16 + lr) * 72 + ko), LDSFRAG(KDb + (tj * 16 + lr) * 72 + ko), ab); }
#pragma unroll
        for (int r = 0; r < 4; ++r) { const int c = ti * 16 + lq * 4 + r, s = tj * 16 + lr; const float v = (s <= c ? af[r] : 0.f) + (s >= c ? ab[r] : 0.f); ATT[c * 72 + s] = f2bf(v); } }
    __syncthreads();
    bf16x8 vb[2];
#pragma unroll
    for (int ks = 0; ks < 2; ++ks) vb[ks] = LDSFRAG(VT + (wid * 16 + lr) * 72 + ks * 32 + lq * 8);
    bf16_t* OI = (bf16_t*)(p.ws + OFF_OIB); bf16_t* KV = (bf16_t*)(p.ws + OFF_KV);
#pragma unroll
    for (int ct = 0; ct < 4; ++ct) { f32x4 a = {0.f, 0.f, 0.f, 0.f};
#pragma unroll
        for (int ks = 0; ks < 2; ++ks) a = MFMA16(LDSFRAG(ATT + (ct * 16 + lr) * 72 + ks * 32 + lq * 8), vb[ks], a);
#pragma unroll
        for (int r = 0; r < 4; ++r) OI[(size_t)(tok0 + ct * 16 + lq * 4 + r) * 512 + h * 128 + wid * 16 + lr] = f2bf(a[r]); }
#pragma unroll
    for (int dir = 0; dir < 2; ++dir) { const LAS bf16_t* KR = dir == 0 ? KRf : KRb; bf16_t* kvp = KV + ((size_t)((dir * 128 + ck) * 4 + h)) * 8192;
#pragma unroll
        for (int dt = 0; dt < 4; ++dt) { f32x4 a = {0.f, 0.f, 0.f, 0.f};
#pragma unroll
            for (int ks = 0; ks < 2; ++ks) a = MFMA16(LDSFRAG(KR + (dt * 16 + lr) * 72 + ks * 32 + lq * 8), vb[ks], a);
#pragma unroll
            for (int r = 0; r < 4; ++r) kvp[(dt * 16 + lq * 4 + r) * 128 + wid * 16 + lr] = f2bf(a[r]); } }
    __syncthreads();
}

__device__ __forceinline__ void job_glaB(const Params& p, int l, int j) {
    const int qt = j & 3, h = (j >> 2) & 3, rest = j >> 4, bb = rest % 20, dir = rest / 20;
    const int idx0 = qt * 2048 + tid_opaque(p);
    const int nck = bb < 16 ? 4 : 16, ck0 = bb < 16 ? bb * 4 : 64 + (bb - 16) * 16;
    float S[4];
#pragma unroll
    for (int e = 0; e < 4; ++e) S[e] = bb >= 16 ? p.in[I_SGLA][((size_t)((((bb - 16) * 2 + l) * 2 + dir) * 4 + h)) * 8192 + idx0 + e * 512] : 0.f;
    const bf16_t* KV = (const bf16_t*)(p.ws + OFF_KV); const float* DEC = (const float*)(p.ws + OFF_DEC); bf16_t* ST = (bf16_t*)(p.ws + OFF_ST);
    for (int i0 = 0; i0 < nck; i0 += 4) { float dv[4][4]; bf16_t kv[4][4]; size_t its[4];
#pragma unroll
        for (int u = 0; u < 4; ++u) { const int i = i0 + u, ck = dir == 0 ? ck0 + i : ck0 + nck - 1 - i; its[u] = (size_t)((dir * 128 + ck) * 4 + h);
#pragma unroll
            for (int e = 0; e < 4; ++e) { const int idx = idx0 + e * 512; dv[u][e] = DEC[its[u] * 64 + (idx >> 7)]; kv[u][e] = KV[its[u] * 8192 + idx]; } }
#pragma unroll
        for (int u = 0; u < 4; ++u)
#pragma unroll
            for (int e = 0; e < 4; ++e) { ST[its[u] * 8192 + idx0 + e * 512] = f2bf(S[e]); S[e] = dv[u][e] * S[e] + bf2f(kv[u][e]); } }
    if (bb < 16) {
#pragma unroll
        for (int e = 0; e < 4; ++e) p.out[OUT_GLA + ((size_t)(((bb * 2 + l) * 2 + dir) * 4 + h)) * 8192 + idx0 + e * 512] = S[e]; }
}

__device__ __forceinline__ void job_glaC(const Params& p, int l, int j, lds_t lds) {
    const int tid = tid_opaque(p), wid = tid >> 6, lane = tid & 63, lr = lane & 15, lq = lane >> 4;
    const int ck = j >> 2, h = j & 3, tok0 = ck * 64;
    LAS bf16_t* Aq = (LAS bf16_t*)lds;
    LAS bf16_t* BT = Aq + 64 * 136;
    LAS float* Os = (LAS float*)(BT + 128 * 136);
    const bf16_t* QD = (const bf16_t*)(p.ws + OFF_QD); const bf16_t* ST = (const bf16_t*)(p.ws + OFF_ST);
#pragma unroll
    for (int it = 0; it < 2; ++it) { const int idx = tid + it * 512, c = idx >> 4, rem = idx & 15, dir = rem >> 3, dc = rem & 7;
        *(LAS u32x4*)(Aq + c * 136 + dir * 64 + dc * 8) = *(const u32x4*)(QD + (size_t)(dir * 8192 + tok0 + c) * 256 + h * 64 + dc * 8); }
#pragma unroll
    for (int it = 0; it < 4; ++it) { const int idx = tid + it * 512, dir = idx >> 10, d = (idx >> 4) & 63, ec = idx & 15;
        const u32x4 v = *(const u32x4*)(ST + ((size_t)((dir * 128 + ck) * 4 + h)) * 8192 + d * 128 + ec * 8);
        const unsigned w[4] = { v.x, v.y, v.z, v.w };
#pragma unroll
        for (int i = 0; i < 4; ++i) { BT[(ec * 8 + 2 * i) * 136 + dir * 64 + d] = (bf16_t)(w[i] & 0xffffu); BT[(ec * 8 + 2 * i + 1) * 136 + dir * 64 + d] = (bf16_t)(w[i] >> 16); } }
    const int ct = wid & 3, eh = wid >> 2; const bf16_t* OI = (const bf16_t*)(p.ws + OFF_OIB);
    bf16_t oi[4][4];
#pragma unroll
    for (int e4 = 0; e4 < 4; ++e4)
#pragma unroll
        for (int r = 0; r < 4; ++r) oi[e4][r] = OI[(size_t)(tok0 + ct * 16 + lq * 4 + r) * 512 + h * 128 + (eh * 4 + e4) * 16 + lr];
    const int nc = tid >> 3, npart = tid & 7;
    const bf16_t* gz = (const bf16_t*)(p.ws + OFF_Z) + (size_t)(tok0 + nc) * LDZ + ZGG + h * 128 + npart * 16;
    const u32x4 g0 = *(const u32x4*)gz, g1 = *(const u32x4*)(gz + 8);
    f32x4 onw[4];
#pragma unroll
    for (int i = 0; i < 4; ++i) onw[i] = *(const f32x4*)(p.in[I_ONORM] + l * 128 + npart * 16 + 4 * i);
    __syncthreads();
    bf16x8 af[4];
#pragma unroll
    for (int ks = 0; ks < 4; ++ks) af[ks] = LDSFRAG(Aq + (ct * 16 + lr) * 136 + ks * 32 + lq * 8);
#pragma unroll
    for (int e4 = 0; e4 < 4; ++e4) { const int et = eh * 4 + e4; f32x4 a = {0.f, 0.f, 0.f, 0.f};
#pragma unroll
        for (int ks = 0; ks < 4; ++ks) a = MFMA16(af[ks], LDSFRAG(BT + (et * 16 + lr) * 136 + ks * 32 + lq * 8), a);
#pragma unroll
        for (int r = 0; r < 4; ++r) { const int row = ct * 16 + lq * 4 + r, col = et * 16 + lr; Os[row * 132 + col] = a[r] + bf2f(oi[e4][r]); } }
    __syncthreads();
    { const int c = tid >> 3, part = tid & 7; float o[16]; float ss = 0.f;
#pragma unroll
      for (int i = 0; i < 16; ++i) { o[i] = Os[c * 132 + part * 16 + i]; ss += o[i] * o[i]; }
      ss += __shfl_xor(ss, 1); ss += __shfl_xor(ss, 2); ss += __shfl_xor(ss, 4);
      const float rstd = rsqrtf(ss * (1.f / 128.f) + 1e-6f);
      const unsigned gw[8] = { g0.x, g0.y, g0.z, g0.w, g1.x, g1.y, g1.z, g1.w };
      unsigned ow[8];
#pragma unroll
      for (int i = 0; i < 8; ++i) { const float n0 = onw[i >> 1][(2 * i) & 3], n1 = onw[i >> 1][(2 * i + 1) & 3];
          ow[i] = pk2(o[2 * i] * rstd * n0 * siluf_(lo16(gw[i])), o[2 * i + 1] * rstd * n1 * siluf_(hi16(gw[i]))); }
      bf16_t* ap = (bf16_t*)(p.ws + OFF_AGLA) + (size_t)(tok0 + c) * 512 + h * 128 + part * 16;
      *(u32x4*)ap = (u32x4){ow[0], ow[1], ow[2], ow[3]}; *(u32x4*)(ap + 8) = (u32x4){ow[4], ow[5], ow[6], ow[7]}; }
    __syncthreads();
}
__device__ __forceinline__ void head_row_finish(float (&x)[16], int p8, const float* nw, const float* nw2, bool rope, int pos, const float* R, float mul, LAS bf16_t* dst) {
    float ss = 0.f; const int cnt = p8 < 4 ? 16 : 8;
#pragma unroll
    for (int i = 0; i < 16; ++i) if (i < cnt) ss += x[i] * x[i];
    ss += __shfl_xor(ss, 1); ss += __shfl_xor(ss, 2); ss += __shfl_xor(ss, 4);
    const float rstd = rsqrtf(ss * (1.f / 96.f) + 1e-6f) * mul;
    if (p8 < 4) { unsigned w[8];
#pragma unroll
        for (int i = 0; i < 8; ++i) w[i] = pk2(x[2 * i] * rstd * nw[p8 * 16 + 2 * i] * nw2[p8 * 16 + 2 * i], x[2 * i + 1] * rstd * nw[p8 * 16 + 2 * i + 1] * nw2[p8 * 16 + 2 * i + 1]);
        *(LAS u32x4*)(dst + p8 * 16) = (u32x4){w[0], w[1], w[2], w[3]}; *(LAS u32x4*)(dst + p8 * 16 + 8) = (u32x4){w[4], w[5], w[6], w[7]};
    } else { const int i0 = (p8 - 4) * 4; float o1[4], o2[4];
#pragma unroll
        for (int i = 0; i < 4; ++i) { const float a = x[i] * rstd * nw[64 + i0 + i], b = x[4 + i] * rstd * nw[80 + i0 + i];
            if (rope) { const float c = R[pos * 16 + i0 + i], s = R[16384 + pos * 16 + i0 + i]; o1[i] = a * c - b * s; o2[i] = a * s + b * c; } else { o1[i] = a; o2[i] = b; } }
        *(LAS u32x2*)(dst + 64 + i0) = (u32x2){pk2(o1[0], o1[1]), pk2(o1[2], o1[3])}; *(LAS u32x2*)(dst + 80 + i0) = (u32x2){pk2(o2[0], o2[1]), pk2(o2[2], o2[3])}; }
}
__device__ __forceinline__ void ld16bf(const bf16_t* s, float (&x)[16]) { const u32x4 a = *(const u32x4*)s, b = *(const u32x4*)(s + 8);
    x[0] = lo16(a.x); x[1] = hi16(a.x); x[2] = lo16(a.y); x[3] = hi16(a.y); x[4] = lo16(a.z); x[5] = hi16(a.z); x[6] = lo16(a.w); x[7] = hi16(a.w);
    x[8] = lo16(b.x); x[9] = hi16(b.x); x[10] = lo16(b.y); x[11] = hi16(b.y); x[12] = lo16(b.z); x[13] = hi16(b.z); x[14] = lo16(b.w); x[15] = hi16(b.w); }
__device__ __forceinline__ void ld4bf(const bf16_t* s, float* x) { const u32x2 a = *(const u32x2*)s; x[0] = lo16(a.x); x[1] = hi16(a.x); x[2] = lo16(a.y); x[3] = hi16(a.y); }
__device__ __forceinline__ void job_attn(const Params& p, int l, int j, lds_t lds) {
    const int tid = tid_opaque(p), wid = tid >> 6, lane = tid & 63, lr = lane & 15, lq = lane >> 4;
    const bool smp = j < 128; int b, h, qb; if (smp) { b = j >> 5; h = (j >> 3) & 3; qb = j & 7; } else { const int jj = j - 128; b = jj >> 3; h = (jj >> 1) & 3; qb = jj & 1; }
    const int qtok0 = smp ? 4096 + b * 1024 + qb * 128 : b * 256 + qb * 128; const int nkt = smp ? 12 : 2;
    LAS bf16_t* Ks0 = (LAS bf16_t*)lds;
    LAS bf16_t* VTs0 = Ks0 + 2 * 128 * 104;
    LAS float* Mg = (LAS float*)lds;
    const bf16_t* Z = (const bf16_t*)(p.ws + OFF_Z); const bf16_t* KF = (const bf16_t*)(p.ws + OFF_KF); const bf16_t* Vb = (const bf16_t*)(p.ws + OFF_V); const float* R = (const float*)(p.ws + OFF_ROPE);
    const float* qhn = p.in[I_QHNORM] + l * 96;
    u32x4 kreg[3], vreg[4];
    const int vst = smp ? 1536 : 256; const bf16_t* vtb = smp ? Vb + 2097152 + (size_t)(b * 4 + h) * 128 * 1536 : Vb + (size_t)(b * 4 + h) * 128 * 256;
    auto rowbase = [&](int kt) { return smp ? (kt < 4 ? 8192 + b * 512 + kt * 128 : 4096 + b * 1024 + (kt - 4) * 128) : b * 256 + kt * 128; };
    auto issue = [&](int kt) { const int rb = rowbase(kt);
#pragma unroll
        for (int i = 0; i < 3; ++i) { const int idx = tid + 512 * i, key = idx / 12, part = idx - key * 12; kreg[i] = *(const u32x4*)(KF + (size_t)(rb + key) * 384 + h * 96 + part * 8); }
#pragma unroll
        for (int i = 0; i < 4; ++i) { const int idx = tid + 512 * i, e = idx >> 4, part = idx & 15; vreg[i] = *(const u32x4*)(vtb + (size_t)e * vst + kt * 128 + part * 8); } };
    auto commit = [&](int buf) { LAS bf16_t* Ks = Ks0 + buf * 128 * 104; LAS bf16_t* VTs = VTs0 + buf * 128 * 136;
#pragma unroll
        for (int i = 0; i < 3; ++i) { const int idx = tid + 512 * i, key = idx / 12, part = idx - key * 12; *(LAS u32x4*)(Ks + key * 104 + part * 8) = kreg[i]; }
#pragma unroll
        for (int i = 0; i < 4; ++i) { const int idx = tid + 512 * i, e = idx >> 4, part = idx & 15; *(LAS u32x4*)(VTs + e * 136 + part * 8) = vreg[i]; } };
    issue(0);
#pragma unroll
    for (int it = 0; it < 2; ++it) { const int row = it * 64 + (tid >> 3), p8 = tid & 7, tok = qtok0 + row; const bf16_t* qr = (const bf16_t*)(p.ws + OFF_QRAW) + (size_t)tok * 384 + h * 96; float x[16];
      if (p8 < 4) ld16bf(qr + p8 * 16, x); else { ld4bf(qr + 64 + (p8 - 4) * 4, x); ld4bf(qr + 80 + (p8 - 4) * 4, x + 4); }
      head_row_finish(x, p8, qhn, p.in[I_KHNORM] + l * 96, smp, qb * 128 + row, R, 0.10206207261596575f * 1.4426950408889634f, Ks0 + 128 * 104 + row * 104); }
    __syncthreads();
    const int rt = wid & 3, kh = wid >> 2;
    bf16x8 qa[2][3];
#pragma unroll
    for (int mt = 0; mt < 2; ++mt)
#pragma unroll
        for (int ks = 0; ks < 3; ++ks) qa[mt][ks] = LDSFRAG(Ks0 + 128 * 104 + (rt * 32 + mt * 16 + lr) * 104 + ks * 32 + lq * 8);
    commit(0);
    __syncthreads();
    f32x4 oacc[2][8]; float mrow[2], lrow[2];
#pragma unroll
    for (int mt = 0; mt < 2; ++mt) {
#pragma unroll
        for (int e = 0; e < 8; ++e) oacc[mt][e] = (f32x4){0.f, 0.f, 0.f, 0.f};
        mrow[mt] = -1e30f; lrow[mt] = 0.f; }
    const int kbase = kh * 64;
    for (int kt = 0; kt < nkt; ++kt) {
        if (kt + 1 < nkt) issue(kt + 1);
        const LAS bf16_t* Ks = Ks0 + (kt & 1) * 128 * 104; const LAS bf16_t* VTs = VTs0 + (kt & 1) * 128 * 136;
        f32x4 sacc[2][4];
#pragma unroll
        for (int nt = 0; nt < 4; ++nt) { sacc[0][nt] = (f32x4){0.f, 0.f, 0.f, 0.f}; sacc[1][nt] = sacc[0][nt];
#pragma unroll
            for (int ks = 0; ks < 3; ++ks) { const bf16x8 kf = LDSFRAG(Ks + (kbase + nt * 16 + lr) * 104 + ks * 32 + lq * 8); sacc[0][nt] = MFMA16(kf, qa[0][ks], sacc[0][nt]); sacc[1][nt] = MFMA16(kf, qa[1][ks], sacc[1][nt]); } }
        bf16x8 pb[2][2];
#pragma unroll
        for (int mt = 0; mt < 2; ++mt) {
            float mx = -1e30f;
#pragma unroll
            for (int nt = 0; nt < 4; ++nt) mx = fmaxf(mx, fmaxf(fmaxf(sacc[mt][nt][0], sacc[mt][nt][1]), fmaxf(sacc[mt][nt][2], sacc[mt][nt][3])));
            mx = fmaxf(mx, __shfl_xor(mx, 16)); mx = fmaxf(mx, __shfl_xor(mx, 32));
            const float mn = fmaxf(mrow[mt], mx), alpha = __builtin_amdgcn_exp2f(mrow[mt] - mn); mrow[mt] = mn;
            float pv[4][4]; float rs = 0.f;
#pragma unroll
            for (int nt = 0; nt < 4; ++nt)
#pragma unroll
                for (int r = 0; r < 4; ++r) { pv[nt][r] = __builtin_amdgcn_exp2f(sacc[mt][nt][r] - mn); rs += pv[nt][r]; }
            lrow[mt] = lrow[mt] * alpha + rs;
#pragma unroll
            for (int k2 = 0; k2 < 2; ++k2) { u32x4 w; w.x = pk2(pv[2 * k2][0], pv[2 * k2][1]); w.y = pk2(pv[2 * k2][2], pv[2 * k2][3]); w.z = pk2(pv[2 * k2 + 1][0], pv[2 * k2 + 1][1]); w.w = pk2(pv[2 * k2 + 1][2], pv[2 * k2 + 1][3]);
                pb[mt][k2] = __builtin_bit_cast(bf16x8, w); }
#pragma unroll
            for (int e = 0; e < 8; ++e) oacc[mt][e] *= alpha; }
#pragma unroll
        for (int k2 = 0; k2 < 2; ++k2)
#pragma unroll
            for (int e = 0; e < 8; ++e) { const LAS bf16_t* vp = VTs + (e * 16 + lr) * 136 + kbase + k2 * 32 + 4 * lq;
                const u32x2 lo = *(const LAS u32x2*)vp, hi = *(const LAS u32x2*)(vp + 16);
                const bf16x8 vf = __builtin_bit_cast(bf16x8, (u32x4){lo.x, lo.y, hi.x, hi.y});
                oacc[0][e] = MFMA16(vf, pb[0][k2], oacc[0][e]); oacc[1][e] = MFMA16(vf, pb[1][k2], oacc[1][e]); }
        if (kt + 1 < nkt) commit((kt + 1) & 1);
        __syncthreads();
    }
#pragma unroll
    for (int mt = 0; mt < 2; ++mt) { float s_ = lrow[mt]; s_ += __shfl_xor(s_, 16); s_ += __shfl_xor(s_, 32); lrow[mt] = s_; }
    LAS float* Mo = Mg + rt * 32 * 132; LAS float* Ml = Mg + 4 * 32 * 132 + rt * 64;
    if (kh == 1) {
#pragma unroll
        for (int mt = 0; mt < 2; ++mt) {
#pragma unroll
            for (int e = 0; e < 8; ++e) *(LAS f32x4*)(Mo + (mt * 16 + lr) * 132 + e * 16 + 4 * lq) = oacc[mt][e];
            if (lq == 0) { Ml[(mt * 16 + lr) * 2] = mrow[mt]; Ml[(mt * 16 + lr) * 2 + 1] = lrow[mt]; } }
    }
    __syncthreads();
    if (kh == 0) { bf16_t* AM = (bf16_t*)(p.ws + OFF_AMLA);
#pragma unroll
        for (int mt = 0; mt < 2; ++mt) { const int row = mt * 16 + lr, tok = qtok0 + rt * 32 + row;
            u32x2 gt[8];
#pragma unroll
            for (int e = 0; e < 8; ++e) gt[e] = *(const u32x2*)(Z + (size_t)tok * LDZ + ZMG + h * 128 + e * 16 + 4 * lq);
            const float m2 = Ml[row * 2], l2 = Ml[row * 2 + 1]; const float mm = fmaxf(mrow[mt], m2), a1 = __builtin_amdgcn_exp2f(mrow[mt] - mm), a2 = __builtin_amdgcn_exp2f(m2 - mm);
            const float inv = 1.f / (lrow[mt] * a1 + l2 * a2);
#pragma unroll
            for (int e = 0; e < 8; ++e) { const f32x4 o2 = *(const LAS f32x4*)(Mo + row * 132 + e * 16 + 4 * lq); float o[4];
#pragma unroll
                for (int r = 0; r < 4; ++r) o[r] = (oacc[mt][e][r] * a1 + o2[r] * a2) * inv;
                const float g0 = lo16(gt[e].x), g1 = hi16(gt[e].x), g2 = lo16(gt[e].y), g3 = hi16(gt[e].y);
                *(u32x2*)(AM + (size_t)tok * 512 + h * 128 + e * 16 + 4 * lq) = (u32x2){pk2(o[0] * siluf_(g0), o[1] * siluf_(g1)), pk2(o[2] * siluf_(g2), o[3] * siluf_(g3))}; } } }
    __syncthreads();
}


#define XB_TMO      128
#define XB_XCNT(j)  (256  + 64 * (j))
#define XB_XSUB(j)  (1280 + 64 * (j))
#define XB_XGEN(j)  (2304 + 64 * (j))
#define XB_TOP      3328
#define XB_TOPGEN   3392
#define XCD_BAR_WORDS 3456
#define XB_SPIN_CAP (1u << 18)

__device__ __forceinline__ unsigned xb_ld(unsigned* p)              { return __hip_atomic_load(p, __ATOMIC_RELAXED, __HIP_MEMORY_SCOPE_AGENT); }
__device__ __forceinline__ unsigned xb_add(unsigned* p, unsigned v) { return __hip_atomic_fetch_add(p, v, __ATOMIC_RELAXED, __HIP_MEMORY_SCOPE_AGENT); }
__device__ __forceinline__ unsigned xb_xcc_id() { return (unsigned)__builtin_amdgcn_s_getreg((3 << 11) | 20) & 0xFu; }
#define XB_SPIN(cond, bar) do { unsigned _sp = 0; while (cond) { __builtin_amdgcn_s_sleep(1); \
    if ((++_sp & 255u) == 0u) { if (xb_ld(&(bar)[XB_TMO])) break; if (_sp > XB_SPIN_CAP) { atomicAdd(&(bar)[XB_TMO], 1u); break; } } } } while (0)

struct XcdBarrier {
    int wid; unsigned* bar; unsigned x;
    volatile LAS unsigned* st;
};

__device__ __forceinline__ XcdBarrier xcd_barrier_post(unsigned* bar, volatile LAS unsigned* st) {
    XcdBarrier b; b.bar = bar; b.x = xb_xcc_id(); b.st = st;
    if (threadIdx.x == 0) (void)xb_add(&bar[XB_XCNT(b.x)], 1u);
    return b;
}
__device__ __forceinline__ void xcd_barrier_complete(unsigned* bar, unsigned x, unsigned& nloc, unsigned& nx) {
    const unsigned G = gridDim.x * gridDim.y * gridDim.z;
    unsigned sum, cnt, mine, sp = 0u;
    for (;;) {
        sum = 0u; cnt = 0u; mine = 0u;
#pragma unroll
        for (unsigned j = 0; j < 16; ++j) { const unsigned c = xb_ld(&bar[XB_XCNT(j)]); sum += c; cnt += (c > 0u) ? 1u : 0u; mine = (j == x) ? c : mine; }
        if (sum == G) break;
        __builtin_amdgcn_s_sleep(1);
        if ((++sp & 255u) == 0u) { if (xb_ld(&bar[XB_TMO])) break; if (sp > XB_SPIN_CAP) { atomicAdd(&bar[XB_TMO], 1u); break; } }
    }
    nloc = mine > 0u ? mine : 1u; nx = cnt > 0u ? cnt : 1u;
}

__device__ __forceinline__ void xcd_barrier(const XcdBarrier& b) {
    asm volatile("s_waitcnt vmcnt(0)" ::: "memory");
    __syncthreads();
    if (b.wid == 0 && lane_id_() == 0) {
        unsigned* bar = b.bar;
        __builtin_amdgcn_s_waitcnt(0);
        unsigned nloc = b.st[0], nx = b.st[1];
        if (nloc == 0u) { xcd_barrier_complete(bar, b.x, nloc, nx); b.st[0] = nloc; b.st[1] = nx; }
        const unsigned old = xb_add(&bar[XB_XSUB(b.x)], 1u);
        const unsigned gen = old / nloc;
        if (old + 1u == (gen + 1u) * nloc) {
            __builtin_amdgcn_fence(__ATOMIC_RELEASE, "agent");
            asm volatile("s_waitcnt vmcnt(0)" ::: "memory");
            const unsigned og = xb_add(&bar[XB_TOP], 1u);
            const unsigned tg = og / nx;
            if (og + 1u == (tg + 1u) * nx) xb_add(&bar[XB_TOPGEN], 1u);
            else XB_SPIN(xb_ld(&bar[XB_TOPGEN]) == tg, bar);
            __builtin_amdgcn_fence(__ATOMIC_ACQUIRE, "agent");
            xb_add(&bar[XB_XGEN(b.x)], 1u);
            asm volatile("s_waitcnt vmcnt(0)" ::: "memory");
        } else {
            XB_SPIN(xb_ld(&bar[XB_XGEN(b.x)]) == gen, bar);
            __builtin_amdgcn_fence(__ATOMIC_ACQUIRE, "agent");
            asm volatile("s_waitcnt vmcnt(0)" ::: "memory");
        }
    }
    __syncthreads();
}

constexpr int N_PHASES = 15;
#ifndef S3SEL
#define S3SEL 15
#endif
#ifndef REPEAT_MASK
#define REPEAT_MASK 0xff
#endif
#ifndef ONLY_S
#define ONLY_S -1
#endif
__device__ __forceinline__ void run_phase(const Params& p, int ph, lds_t lds, int mask = 0xff) {
    const int G = (int)gridDim.x, bid = (int)blockIdx.x;
    if (ph == 0 && (ONLY_S < 0 || ONLY_S == 7)) {
        for (int j = bid; j < 384 + 192 + 256 + 32; j += G) { if (j < 384) job_s5setup(p, 0, j, lds); else if (j < 576) job_ada(p, j - 384, lds); else if (j < 832) job_ctx(p, j - 576); else job_rope(p, j - 832); }
        return;
    }
    const int l = (ph - 1) / 7, s = (ph - 1) % 7;
    unsigned char* ws = p.ws;
    if (s == 0 && (ONLY_S < 0 || ONLY_S == 0)) {
        if (l == 0 || G < 256) { for (int j = bid; j < 384 + WT_TOTAL + 256; j += G) { if (j < 384) { if ((mask & 1) && l > 0) job_s5setup(p, l, j, lds); } else if (j < 384 + WT_TOTAL) { if (mask & 2) job_wt(p, l, j - 384, lds); } else if (mask & 4) job_prep(p, l, j - 384 - WT_TOTAL); } }
        else { for (int j = bid; j < 256; j += G) job_prep(p, l, j); }
    } else if (s == 1 && (ONLY_S < 0 || ONLY_S == 1)) {
        Order S; S.setup(8192, 4096, 0, p.wid); pg8::Gemm g{(const bf16_t*)(ws + OFF_HB), (const bf16_t*)(ws + OFF_WIN), 8192, 4096, 1024}; EpiZ E{(bf16_t*)(ws + OFF_Z)};
        pg8::gemm_phase<EpiZ, Order>(lds, g, S, E, nullptr);
    } else if (s == 2 && (ONLY_S < 0 || ONLY_S == 2)) {
        if (G == 256) {
            if (mask & 1) { const int slot = bid >> 3; job_s5(p, l, (slot >> 2) * 32 + 4 * (bid & 7) + (slot & 3), lds); }
            if (mask & 2) { job_glaA(p, l, bid, lds); job_glaA(p, l, 256 + bid, lds); }
            if (mask & 4) for (int j = bid; j < 256; j += G) job_mlaprep(p, l, j);
        } else for (int j = bid; j < 256 + 512 + 256; j += G) { if (j < 256) { if (mask & 1) job_s5(p, l, j, lds); } else if (j < 768) { if (mask & 2) job_glaA(p, l, j - 256, lds); } else if (mask & 4) job_mlaprep(p, l, j - 768); }
    } else if (s == 3 && (ONLY_S < 0 || ONLY_S == 3)) {
        if (mask & 1) { if (G == 256) { if (bid < 96) for (int j = bid; j < 640; j += 96) job_glaB(p, l, j); } else for (int j = bid; j < 640; j += G) job_glaB(p, l, j); }
        if (mask & 16) { Order S; S.setup(8192, 2816, 0, p.wid); pg8::Gemm g{(const bf16_t*)(ws + OFF_HB), (const bf16_t*)(ws + OFF_WIN) + (size_t)4096 * 1024, 8192, 2816, 1024}; EpiZ E{(bf16_t*)(ws + OFF_Z) + 4096};
          pg8::gemm_phase<EpiZ, Order>(lds, g, S, E, nullptr); }
        if ((mask & 2) && (S3SEL & 2)) { Order S; S.setup(8192, 1024, 160, p.wid); pg8::Gemm g{(const bf16_t*)(ws + OFF_YG), (const bf16_t*)(ws + OFF_WGLU), 8192, 1024, 512}; EpiGLU E{(bf16_t*)(ws + OFF_AS5), (const bf16_t*)(ws + OFF_Z), p.in[I_BGLU] + l * 1024};
          pg8::gemm_phase<EpiGLU, Order>(lds, g, S, E, nullptr); }
        if ((mask & 4) && (S3SEL & 4)) { Order S; S.setup(10240, 768, 120, p.wid); pg8::Gemm g{(const bf16_t*)(ws + (l == 0 ? OFF_CTX0 : OFF_CKVN)), (const bf16_t*)(ws + OFF_WKV), 10240, 768, 256}; EpiKV E{(bf16_t*)(ws + OFF_KF), (bf16_t*)(ws + OFF_V), l, (const bf16_t*)(ws + OFF_Z), p.in[I_CKR], p.in[I_KHNORM] + l * 96, (const float*)(ws + OFF_ROPE)};
          pg8::gemm_phase<EpiKV, Order>(lds, g, S, E, nullptr); }
        if ((mask & 8) && (S3SEL & 8)) { Order S; S.setup(8192, 512, 160, p.wid); if (G == 256) S.c = (bid >= 96 && bid < 136) ? bid - 96 : (bid >= 224 && bid < 248) ? bid - 184 : (1 << 20); pg8::Gemm g{(const bf16_t*)(ws + OFF_AQ), (const bf16_t*)(ws + OFF_WUQ), 8192, 512, 384}; EpiQ E{(bf16_t*)(ws + OFF_QRAW)};
          pg8::gemm_phase<EpiQ, Order>(lds, g, S, E, nullptr); }
    } else if (s == 4 && (ONLY_S < 0 || ONLY_S == 4)) {
        if (G == 256) {
            if (bid < 128) { const int slot = bid >> 3, pair = 2 * (bid & 7) + (slot >> 3);
                if (mask & 1) job_attn(p, l, pair * 8 + (slot & 7), lds); if (mask & 2) job_glaC(p, l, 384 + bid, lds); }
            else { const int k = bid - 128; if (mask & 1) job_attn(p, l, 128 + k, lds); if (mask & 2) { job_glaC(p, l, k, lds); job_glaC(p, l, 128 + k, lds); job_glaC(p, l, 256 + k, lds); } }
        } else for (int j = bid; j < 256 + 512; j += G) { if (j < 256) { if (mask & 1) job_attn(p, l, j, lds); } else if (mask & 2) job_glaC(p, l, j - 256, lds); }
        { __syncthreads(); Order S; S.setup(8192, 1024, 128, p.wid);
          pg8::Gemm g{(const bf16_t*)(ws + OFF_AS5), (const bf16_t*)(ws + OFF_WBO) + (size_t)2 * 1024 * 512, 8192, 1024, 512};
          EpiBo E{(bf16_t*)(ws + OFF_HB), (const bf16_t*)(ws + OFF_Z), 2, 1};
          pg8::gemm_phase<EpiBo, Order>(lds, g, S, E, nullptr); }
    } else if (s == 5 && (ONLY_S < 0 || ONLY_S == 5)) {
        if (l == 0 && mask == 0xff && G >= 256 && bid >= 128) { for (int j = bid - 128; j < 384 + WT_EARLY; j += G - 128) { if (j < 384) job_s5setup(p, 1, j, lds); else job_wt(p, 1, j - 384, lds); } }
        for (int br = 0; br < 2; ++br) { Order S; S.setup(8192, 1024, 0, p.wid);
            pg8::Gemm g{(const bf16_t*)(ws + (br == 0 ? OFF_AGLA : br == 1 ? OFF_AMLA : OFF_AS5)), (const bf16_t*)(ws + OFF_WBO) + (size_t)br * 1024 * 512, 8192, 1024, 512};
            EpiBo E{(bf16_t*)(ws + OFF_HB), (const bf16_t*)(ws + OFF_Z), br, 0};
            pg8::gemm_phase<EpiBo, Order>(lds, g, S, E, nullptr); }
    } else if (s == 6 && (ONLY_S < 0 || ONLY_S == 6)) {
        if (l == 0 && mask == 0xff && G >= 256 && bid >= 128) { for (int j = bid - 128; j < 3 * WT_WBO + WT_WOUT; j += G - 128) job_wt(p, 1, WT_EARLY + j, lds); }
        Order S; S.setup(8192, 1024, 0, p.wid); pg8::Gemm g{(const bf16_t*)(ws + OFF_HB), (const bf16_t*)(ws + (l == 0 ? OFF_WOUT : OFF_WOUT2)), 8192, 1024, 1024};
        EpiOut E{p.out, l == 0 ? p.in[I_XP] : p.out, l == 0 ? p.in[I_XS] : p.out + (size_t)4096 * 1024, (const float*)(ws + OFF_ADA) + l * 5 * 3072};
        pg8::gemm_phase<EpiOut, Order>(lds, g, S, E, nullptr);
    }
}
__global__ __launch_bounds__(512, 2) void mega(KParams kp, int ph0, int ph1) {
    extern __shared__ __attribute__((aligned(16))) unsigned char shm[];
    lds_t lds = (lds_t)shm;
    if (threadIdx.x < N_IN) ((const float**)(kp.ws + OFF_TBL))[threadIdx.x] = kp.in[threadIdx.x];
    const int wid0 = __builtin_amdgcn_readfirstlane((int)threadIdx.x >> 6);
    volatile LAS unsigned* xst = (volatile LAS unsigned*)(lds + DYN_LDS - 16);
    if (threadIdx.x == 0) { xst[0] = 0u; xst[1] = 0u; }
    __threadfence(); __syncthreads();
    XcdBarrier xb = xcd_barrier_post((unsigned*)(kp.ws + OFF_BAR), xst);
    xb.wid = wid0;
    if (ph0 > ph1) cg::this_grid().sync();
    for (int ph = ph0; ph < ph1; ++ph) {
        Params p; p.wid = wid0; { const float* const* tb = (const float* const*)(kp.ws + OFF_TBL); float* o = kp.out; unsigned char* w = kp.ws; asm volatile("" : "+s"(tb), "+s"(o), "+s"(w)); p.in = tb; p.out = o; p.ws = w; }
        int nrep = 1;
#ifdef REPEAT_S
        if ((REPEAT_S == 7 && ph == 0) || (ph > 0 && (ph - 1) % 7 == REPEAT_S && (REPEAT_S != 6 || ph < 8))) nrep = 2;
#endif
        for (int rep = 0; rep < nrep; ++rep) { if (rep) xcd_barrier(xb); run_phase(p, ph, lds, rep ? REPEAT_MASK : 0xff); }
        if (ph + 1 < ph1) xcd_barrier(xb);
    }
}

#ifndef N_LAUNCH_MODE
#define N_LAUNCH_MODE 1
#endif
extern "C" void kernel_launch(void* const* d_in, const int* in_sizes, int n_in, void* d_out, int out_size, void* d_ws, size_t ws_size, hipStream_t stream) {
    static int grid = 0;
    if (grid == 0) {
        if (n_in != N_IN || ws_size < WS_END) { fprintf(stderr, "kernel_launch: unexpected n_in %d / ws %zu (need %zu)\n", n_in, ws_size, (size_t)WS_END); grid = -1; return; }
        int dev = 0, cus = 0, per_cu = 0;
        hipGetDevice(&dev); hipDeviceGetAttribute(&cus, hipDeviceAttributeMultiprocessorCount, dev);
        hipFuncSetAttribute((const void*)mega, hipFuncAttributeMaxDynamicSharedMemorySize, DYN_LDS);
        hipOccupancyMaxActiveBlocksPerMultiprocessor(&per_cu, (const void*)mega, 512, DYN_LDS);
        if (per_cu < 1) { fprintf(stderr, "kernel_launch: occupancy query says %d blocks per CU\n", per_cu); per_cu = 1; }
        (void)hipGetLastError();
        grid = cus;
    }
    if (grid < 0) return;
    hipMemsetAsync((char*)d_ws + OFF_BAR, 0, 16384, stream);
    KParams p{};
    for (int i = 0; i < N_IN; ++i) p.in[i] = (const float*)d_in[i];
    p.out = (float*)d_out; p.ws = (unsigned char*)d_ws;
#if N_LAUNCH_MODE == 0
    for (int ph = 0; ph < N_PHASES; ++ph) { hipLaunchKernelGGL(mega, dim3(grid), dim3(512), DYN_LDS, stream, p, ph, ph + 1); }
#else
    int ph0 = 0, ph1 = N_PHASES; void* args[] = {&p, &ph0, &ph1};
    hipError_t e = hipLaunchCooperativeKernel((const void*)mega, dim3(grid), dim3(512), args, DYN_LDS, stream);
    if (e != hipSuccess) fprintf(stderr, "cooperative launch failed: %s (grid %d)\n", hipGetErrorString(e), grid);
#endif
}
```

```cpp
#include <hip/hip_runtime.h>
#include <hip/hip_cooperative_groups.h>
#include <cstdio>
namespace cg = cooperative_groups;
namespace pg8 {
#define PG8_LAS __attribute__((address_space(3)))
typedef unsigned short bf16_t;
typedef short bf16x8 __attribute__((ext_vector_type(8)));
typedef float f32x4 __attribute__((ext_vector_type(4)));
typedef unsigned u32x4 __attribute__((ext_vector_type(4)));
constexpr int BM = 256, BK = 64, HALF = 128, HTB = HALF * BK * 2  , STAGE_BYTES = 8 * HTB, NXCD = 8, WGM = 8;

__host__ __device__ __forceinline__ int lds_byte(int r, int c) { const int st = (r >> 4) * 2 + (c >> 5), rr = r & 15, cc = c & 31, ob = rr * 64 + cc * 2; return st * 1024 + (ob ^ (((ob >> 9) & 1) << 5)); }
__host__ __device__ __forceinline__ void stage_rc(int b, int& R, int& C) { const int st = b / 1024, sb = b % 1024, swz = sb ^ (((sb >> 9) & 1) << 5); R = (st >> 1) * 16 + swz / 64; C = (st & 1) * 32 + (swz % 64) / 2; }
__host__ __device__ __forceinline__ int perm32(int rho) { const int n = rho >> 4, i = rho & 15; return 8 * (i >> 2) + 4 * n + (i & 3); }

struct Unit { int pm, pn; };
struct Gemm { const bf16_t* A; const bf16_t* Bt; int M, N, K; };

struct StaticOrder {
    int nM, nN, nwg, G, c;
    __host__ __device__ void init(int M, int N, int G_, int c_) { nM = M / BM; nN = N / BM; nwg = nM * nN; G = G_; c = c_; }
    __host__ __device__ bool next(int i, Unit& u) const {
        const long L = (long)i * G + c; if (L >= nwg) return false;
        int wgid = (int)L; { const int q = nwg / NXCD, r = nwg % NXCD, xcd = wgid % NXCD, off = wgid / NXCD; wgid = (xcd < r ? xcd * (q + 1) : r * (q + 1) + (xcd - r) * q) + off; }
        const int nig = WGM * nN, gid = wgid / nig, fm = gid * WGM, gsz = (nM - fm) < WGM ? (nM - fm) : WGM;
        u.pm = fm + ((wgid % nig) % gsz); u.pn = (wgid % nig) / gsz; return true;
    }
    __device__ __forceinline__ void a_ready(const Unit&) const {}
    __device__ __forceinline__ void done(const Unit&) const {}
};
__device__ __forceinline__ unsigned cvt_pk_bf16(float lo, float hi) { unsigned r; asm volatile("v_cvt_pk_bf16_f32 %0, %1, %2" : "=v"(r) : "v"(lo), "v"(hi)); return r; }
typedef float f32x2 __attribute__((ext_vector_type(2)));
template <class Epi, class Sched, bool STAMP = false>
__device__ __forceinline__ void gemm_phase(PG8_LAS unsigned char* lds, const Gemm g, const Sched& S, const Epi& E, unsigned long long* stamps) {
    int tid_ = (S.wid << 6) | (int)__builtin_amdgcn_mbcnt_hi(~0u, __builtin_amdgcn_mbcnt_lo(~0u, 0u)); asm volatile("" : "+v"(tid_)); const int tid = tid_, wid = __builtin_amdgcn_readfirstlane(tid >> 6), lane = tid & 63, wr = wid >> 2, wc = wid & 3, fr = lane & 15, fq = lane >> 4;
    int K_ = g.K; asm volatile("" : "+s"(K_)); const int K = K_, nt = K / BK;
    int ts_lo = 0, ts_hi = 0, nts = 0; const unsigned long long rt_entry = STAMP ? (unsigned long long)wall_clock64() : 0ull;
#define PG8_STAMP() do { if (STAMP && wid == 0 && nts < 64) { const unsigned long long _c = (unsigned long long)clock64(); \
        ts_lo = (lane == nts) ? (int)(unsigned)_c : ts_lo; ts_hi = (lane == nts) ? (int)(unsigned)(_c >> 32) : ts_hi; ++nts; } } while (0)
    PG8_STAMP();
    unsigned voffA[2], voffB[2];
#pragma unroll
    for (int i = 0; i < 2; ++i) { int R, C; stage_rc(tid * 16 + i * 8192, R, C); const int Rb = Epi::PERM ? ((R & ~31) + perm32(R & 31)) : R;
        voffA[i] = (unsigned)(R * K + C) * 2u; voffB[i] = (unsigned)(Rb * K + C) * 2u; }
    const size_t kstep = (size_t)(BK * 2);
    const size_t hstep = (size_t)HALF * K * 2;
    const size_t tstep = 2 * hstep;
    const unsigned ldsw = (unsigned)wid * 1024u;
    const int aoff = lds_byte(wr * 64 + fr, fq * 8), boff = lds_byte(wc * 32 + fr, fq * 8);
#define PG8_SA(b, h) (((b) * 2 + (h)) * HTB)
#define PG8_SB(b, h) ((4 + (b) * 2 + (h)) * HTB)
#define PG8_STAGE(bufoff, gbase, voff) do { _Pragma("unroll") for (int _i = 0; _i < 2; ++_i) \
        __builtin_amdgcn_global_load_lds((const unsigned*)((const char*)(gbase) + (voff)[_i]), (PG8_LAS unsigned*)(lds + (bufoff) + ldsw + _i * 8192), 16, 0, 0); } while (0)
#define PG8_LDA(dst, b, h) do { _Pragma("unroll") for (int m = 0; m < 4; ++m) _Pragma("unroll") for (int k = 0; k < 2; ++k) dst[m][k] = *(const PG8_LAS bf16x8*)(lds + PG8_SA(b, h) + aoff + m * 2048 + k * 1024); } while (0)
#define PG8_LDB(dst, b, h) do { _Pragma("unroll") for (int n = 0; n < 2; ++n) _Pragma("unroll") for (int k = 0; k < 2; ++k) dst[n][k] = *(const PG8_LAS bf16x8*)(lds + PG8_SB(b, h) + boff + n * 2048 + k * 1024); } while (0)
#define PG8_MMA(ai, bj, At, Bt) do { __builtin_amdgcn_s_setprio(1); _Pragma("unroll") for (int m = 0; m < 4; ++m) _Pragma("unroll") for (int n = 0; n < 2; ++n) _Pragma("unroll") for (int k = 0; k < 2; ++k) \
        acc[ai][bj][m][n] = __builtin_amdgcn_mfma_f32_16x16x32_bf16(Bt[n][k], At[m][k], acc[ai][bj][m][n], 0, 0, 0); __builtin_amdgcn_s_setprio(0); } while (0)
#define PG8_WAIT_V(n) asm volatile("s_waitcnt vmcnt(" #n ")" ::: "memory")
#define PG8_WAIT_L(n) asm volatile("s_waitcnt lgkmcnt(" #n ")" ::: "memory")
#define PG8_BAR __builtin_amdgcn_s_barrier()
#define PG8_SCHED __builtin_amdgcn_sched_barrier(0)
    Unit cur, nxt; int ui = 0;
    if (!S.next(0, cur)) return;
    f32x4 acc[2][2][4][2];
#pragma unroll
    for (int a = 0; a < 2; ++a)
#pragma unroll
        for (int b = 0; b < 2; ++b)
#pragma unroll
            for (int m = 0; m < 4; ++m)
#pragma unroll
                for (int n = 0; n < 2; ++n) acc[a][b][m][n] = (f32x4){0.f, 0.f, 0.f, 0.f};
    bf16x8 At[4][2], B0[2][2], B1[2][2];
    const char* cA = (const char*)g.A + (size_t)cur.pm * tstep; const char* cB = (const char*)g.Bt + (size_t)cur.pn * tstep;
    S.a_ready(cur);
    PG8_STAGE(PG8_SB(0, 0), cB, voffB); PG8_STAGE(PG8_SA(0, 0), cA, voffA); PG8_STAGE(PG8_SB(0, 1), cB + hstep, voffB); PG8_STAGE(PG8_SA(0, 1), cA + hstep, voffA);
    if (wr == 1) PG8_BAR;
    PG8_WAIT_V(4); PG8_BAR;
    PG8_STAGE(PG8_SB(1, 0), cB + kstep, voffB); PG8_STAGE(PG8_SA(1, 0), cA + kstep, voffA); PG8_STAGE(PG8_SB(1, 1), cB + hstep + kstep, voffB);
    PG8_WAIT_V(6); PG8_BAR;
    PG8_STAMP();
    for (;;) {
        const bool has_next = S.next(ui + 1, nxt);
        const char* nA = has_next ? (const char*)g.A + (size_t)nxt.pm * tstep : cA; const char* nB = has_next ? (const char*)g.Bt + (size_t)nxt.pn * tstep : cB;
        for (int t = 0; t < nt; t += 2) {
            const bool last = (t == nt - 2);
            const char* a1 = cA + (size_t)(t + 1) * kstep;
            const char* a2 = last ? nA : cA + (size_t)(t + 2) * kstep; const char* b2 = last ? nB : cB + (size_t)(t + 2) * kstep;
            const char* a3 = a2 + kstep; const char* b3 = b2 + kstep;
            if (last && has_next) S.a_ready(nxt);
            PG8_LDB(B0, 0, 0); PG8_SCHED; PG8_LDA(At, 0, 0); PG8_STAGE(PG8_SA(1, 1), a1 + hstep, voffA);
            PG8_WAIT_L(8); PG8_BAR; PG8_WAIT_L(0); PG8_MMA(0, 0, At, B0); PG8_BAR; PG8_SCHED;
            PG8_LDB(B1, 0, 1); PG8_STAGE(PG8_SB(0, 0), b2, voffB);
            PG8_BAR; PG8_WAIT_L(0); PG8_MMA(0, 1, At, B1); PG8_BAR;
            PG8_LDA(At, 0, 1); PG8_STAGE(PG8_SA(0, 0), a2, voffA);
            PG8_BAR; PG8_WAIT_L(0); PG8_MMA(1, 0, At, B0); PG8_BAR; PG8_SCHED;
            PG8_STAGE(PG8_SB(0, 1), b2 + hstep, voffB);
            PG8_WAIT_V(6); PG8_BAR; PG8_MMA(1, 1, At, B1); PG8_BAR;
            PG8_LDB(B0, 1, 0); PG8_SCHED; PG8_LDA(At, 1, 0); PG8_STAGE(PG8_SA(0, 1), a2 + hstep, voffA);
            PG8_WAIT_L(8); PG8_BAR; PG8_WAIT_L(0); PG8_MMA(0, 0, At, B0); PG8_BAR; PG8_SCHED;
            PG8_LDB(B1, 1, 1); PG8_STAGE(PG8_SB(1, 0), b3, voffB);
            PG8_BAR; PG8_WAIT_L(0); PG8_MMA(0, 1, At, B1); PG8_BAR;
            PG8_LDA(At, 1, 1); PG8_STAGE(PG8_SA(1, 0), a3, voffA);
            PG8_BAR; PG8_WAIT_L(0); PG8_MMA(1, 0, At, B0); PG8_BAR; PG8_SCHED;
            PG8_STAGE(PG8_SB(1, 1), b3 + hstep, voffB);
            PG8_WAIT_V(6); PG8_BAR; PG8_MMA(1, 1, At, B1); PG8_BAR;
        }
        PG8_STAMP();
        if constexpr (!Epi::AFTER_DRAIN) { E(acc, cur, wr, wc, fr, fq); S.done(cur); }
        PG8_STAMP();
        if (!has_next) break;
#pragma unroll
        for (int a = 0; a < 2; ++a)
#pragma unroll
            for (int b = 0; b < 2; ++b)
#pragma unroll
                for (int m = 0; m < 4; ++m)
#pragma unroll
                    for (int n = 0; n < 2; ++n) acc[a][b][m][n] = (f32x4){0.f, 0.f, 0.f, 0.f};
        cur = nxt; cA = nA; cB = nB; ++ui;
    }
    PG8_WAIT_V(0);
    if (wr == 0) PG8_BAR;
    PG8_BAR;
    if constexpr (Epi::AFTER_DRAIN) { E.fused(acc, cur, wr, wc, fr, fq, lds, wid, lane); S.done(cur); }
    PG8_STAMP();
    if (STAMP && wid == 0) { stamps[lane] = lane < nts ? (((unsigned long long)(unsigned)ts_hi << 32) | (unsigned)ts_lo) : 0ull;
        if (lane == 62) stamps[62] = rt_entry; if (lane == 63) stamps[63] = (unsigned long long)wall_clock64(); }
#undef PG8_STAMP
#undef PG8_SA
#undef PG8_SB
#undef PG8_STAGE
#undef PG8_LDA
#undef PG8_LDB
#undef PG8_MMA
#undef PG8_WAIT_V
#undef PG8_WAIT_L
#undef PG8_BAR
#undef PG8_SCHED
}
}
using pg8::bf16_t; using pg8::bf16x8; using pg8::f32x4; using pg8::u32x4; using pg8::Unit;
#define LAS __attribute__((address_space(3)))
typedef unsigned u32x2 __attribute__((ext_vector_type(2)));
typedef LAS unsigned char* lds_t;
struct Params;
__device__ __forceinline__ int lane_id_() { return (int)__builtin_amdgcn_mbcnt_hi(~0u, __builtin_amdgcn_mbcnt_lo(~0u, 0u)); }
typedef float f32x2_t __attribute__((ext_vector_type(2)));

enum { I_XP = 0, I_XS, I_C, I_CCTX, I_CKV, I_CKR, I_SGLA, I_SS5, I_NORMW, I_WADA, I_BADA, I_WIN, I_WA2, I_BA, I_ONORM, I_QNORM, I_WUQ, I_KVNORM, I_WUK, I_WUV,
       I_QHNORM, I_KHNORM, I_ARE, I_AIM, I_LOGDT, I_BRE, I_BIM, I_CRE, I_CIM, I_S5D, I_WGLU, I_BGLU, I_WBOG, I_WBOM, I_WBOS, I_WOUT, N_IN };
struct KParams { const float* in[N_IN]; float* out; unsigned char* ws; };
struct Params { const float* const* in; float* out; unsigned char* ws; int wid; };
__device__ __forceinline__ int tid_opaque(const Params& p) { int t = (p.wid << 6) | lane_id_(); asm volatile("" : "+v"(t)); return t; }

constexpr int LDZ = 6912;
constexpr int ZQ = 0, ZK = 256, ZV = 512, ZGA = 1024, ZGG = 1056, ZMQ = 1568, ZMKV = 1952, ZMKR = 2208, ZMG = 2240, ZSU = 2752, ZSG = 3264, ZMERGE = 3776;
constexpr size_t OUT_YP = 0, OUT_CKV = 8388608, OUT_KR = 10485760, OUT_GLA = 10747904, OUT_S5 = 12845056;
constexpr size_t OFF_WIN = 0;

constexpr size_t OFF_WUQ = OFF_WIN + 14155776;
constexpr size_t OFF_WKV = OFF_WUQ + 393216;
constexpr size_t OFF_WGLU = OFF_WKV + 393216;
constexpr size_t OFF_WBO = OFF_WGLU + 1048576;
constexpr size_t OFF_WOUT = OFF_WBO + 3145728;
constexpr size_t OFF_S5M = OFF_WOUT + 2097152;
constexpr size_t OFF_V = OFF_S5M;
constexpr size_t OFF_P16 = OFF_S5M + 12582912;
constexpr size_t OFF_ADA = OFF_P16 + 32768;
constexpr size_t OFF_ROPE = OFF_ADA + 122880;
constexpr size_t OFF_CTX0 = OFF_ROPE + 131072;
constexpr size_t OFF_CKVN = OFF_CTX0 + 1048576;
constexpr size_t OFF_CTX1 = OFF_CKVN + 4194304;
constexpr size_t OFF_HB = OFF_CTX1 + 1048576;
constexpr size_t OFF_Z = OFF_HB + 16777216;
constexpr size_t OFF_KV = OFF_Z + 113246208;
constexpr size_t OFF_AGLA = OFF_KV, OFF_AMLA = OFF_KV + 8388608;
constexpr size_t OFF_QD = OFF_KV + 16777216;
constexpr size_t OFF_OIB = OFF_QD + 8388608;
constexpr size_t OFF_DEC = OFF_KV + 33554432;
constexpr size_t OFF_ST = OFF_DEC + 262144;
constexpr size_t OFF_AQ = OFF_ST + 16777216;
constexpr size_t OFF_QRAW = OFF_AQ + 6291456;
constexpr size_t OFF_AS5 = OFF_QRAW + 6291456;
constexpr size_t OFF_YG = OFF_AS5 + 8388608;
constexpr size_t OFF_TBL = OFF_YG + 8388608;
constexpr size_t OFF_BAR = OFF_TBL + 512;
constexpr size_t OFF_KF = OFF_BAR + 16384;
constexpr size_t OFF_WOUT2 = OFF_KF + 7864320;
constexpr size_t WS_END = OFF_WOUT2 + 2097152;
static_assert(WS_END <= 268435456, "workspace map exceeds 256 MiB");
constexpr int DYN_LDS = 147456;

__device__ __forceinline__ float bf2f(bf16_t b) { return __uint_as_float(((unsigned)b) << 16); }
__device__ __forceinline__ bf16_t f2bf(float f) { unsigned u = __float_as_uint(f); u += 0x7FFFu + ((u >> 16) & 1u); return (bf16_t)(u >> 16); }
__device__ __forceinline__ unsigned pk2(float lo, float hi) { return pg8::cvt_pk_bf16(lo, hi); }
__device__ __forceinline__ float lo16(unsigned w) { return __uint_as_float(w << 16); }
__device__ __forceinline__ float hi16(unsigned w) { return __uint_as_float(w & 0xffff0000u); }
__device__ __forceinline__ float sigmoidf_(float x) { return 1.f / (1.f + __expf(-x)); }
__device__ __forceinline__ float siluf_(float x) { return x / (1.f + __expf(-x)); }
__device__ __forceinline__ void store8(bf16_t* p, const f32x4& a, const f32x4& b) { u32x4 w; w.x = pk2(a[0], a[1]); w.y = pk2(a[2], a[3]); w.z = pk2(b[0], b[1]); w.w = pk2(b[2], b[3]); *(u32x4*)p = w; }
#define MFMA16(a, b, c) __builtin_amdgcn_mfma_f32_16x16x32_bf16(a, b, c, 0, 0, 0)
#define LDSFRAG(ptr) (*(const LAS bf16x8*)(ptr))

struct Order : pg8::StaticOrder { int wid;
    __device__ void setup(int M, int N, int rot, int wid_) { wid = wid_; const int G = (int)gridDim.x; init(M, N, G, (int)((blockIdx.x + (unsigned)rot) % (unsigned)G)); }
};

struct EpiZ { static constexpr bool PERM = true, AFTER_DRAIN = false; bf16_t* Z;
    __device__ __forceinline__ void operator()(const f32x4 (&acc)[2][2][4][2], const Unit& u, int wr, int wc, int fr_, int fq_) const {
        int fr = fr_, fq = fq_; asm volatile("" : "+v"(fr), "+v"(fq));
        const int row0 = u.pm * 256 + wr * 64 + fr, col0 = u.pn * 256 + wc * 32 + 8 * fq;
#pragma unroll
        for (int ai = 0; ai < 2; ++ai)
#pragma unroll
            for (int m = 0; m < 4; ++m) { bf16_t* rp = Z + (size_t)(row0 + ai * 128 + m * 16) * LDZ + col0;
#pragma unroll
                for (int bj = 0; bj < 2; ++bj) store8(rp + bj * 128, acc[ai][bj][m][0], acc[ai][bj][m][1]); }
    } };
struct EpiQ { static constexpr bool PERM = true, AFTER_DRAIN = false; bf16_t* Q;
    __device__ __forceinline__ void operator()(const f32x4 (&acc)[2][2][4][2], const Unit& u, int wr, int wc, int fr_, int fq_) const {
        int fr = fr_, fq = fq_; asm volatile("" : "+v"(fr), "+v"(fq));
        const int row0 = u.pm * 256 + wr * 64 + fr, col0 = u.pn * 256 + wc * 32 + 8 * fq;
#pragma unroll
        for (int ai = 0; ai < 2; ++ai)
#pragma unroll
            for (int m = 0; m < 4; ++m) { bf16_t* rp = Q + (size_t)(row0 + ai * 128 + m * 16) * 384 + col0;
#pragma unroll
                for (int bj = 0; bj < 2; ++bj) if (col0 + bj * 128 < 384) store8(rp + bj * 128, acc[ai][bj][m][0], acc[ai][bj][m][1]);
                }
    } };
struct EpiKV { static constexpr bool PERM = true, AFTER_DRAIN = true; bf16_t* KF; bf16_t* V; int layer; const bf16_t* Z; const float* ckr; const float* khn; const float* R;
    __device__ __forceinline__ void fused(f32x4 (&acc)[2][2][4][2], const Unit& u, int wr, int wc, int fr_, int fq_, LAS unsigned char* lds, int wid, int lane_) const {
        if (u.pn == 0) { (*this)(acc, u, wr, wc, fr_, fq_); return; }
        int fr = fr_, fq = fq_, lane = lane_; asm volatile("" : "+v"(fr), "+v"(fq), "+v"(lane));
        LAS bf16_t* T = (LAS bf16_t*)lds;
#pragma unroll
        for (int ai = 0; ai < 2; ++ai)
#pragma unroll
            for (int m = 0; m < 4; ++m) { const int kl = ai * 128 + wr * 64 + m * 16 + fr;
#pragma unroll
                for (int bj = 0; bj < 2; ++bj) { const int el = bj * 128 + wc * 32 + 8 * fq;
#pragma unroll
                    for (int i = 0; i < 8; i += 2) { const unsigned w = pk2(acc[ai][bj][m][i >> 2][i & 3], acc[ai][bj][m][i >> 2][(i & 3) + 1]); T[(el + i) * 264 + kl] = (bf16_t)(w & 0xffffu); T[(el + i + 1) * 264 + kl] = (bf16_t)(w >> 16); } } }
        __syncthreads();
        int rb = u.pm * 256; if (layer == 0) rb = rb < 2048 ? 8192 + rb : rb - 2048;
        bf16_t* bp; int st;
        if (rb < 4096) { bp = V + (size_t)(rb >> 8) * 4 * 128 * 256; st = 256; }
        else if (rb < 8192) { bp = V + 2097152 + (size_t)((rb - 4096) >> 10) * 4 * 128 * 1536 + 512 + ((rb - 4096) & 1023); st = 1536; }
        else { bp = V + 2097152 + (size_t)((rb - 8192) >> 9) * 4 * 128 * 1536 + ((rb - 8192) & 511); st = 1536; }
        const int tid = wid * 64 + lane;
#pragma unroll
        for (int i = 0; i < 16; ++i) { const int idx = tid + 512 * i, el = idx >> 5, part = idx & 31;
            *(u32x4*)(bp + (size_t)((u.pn - 1) * 256 + el) * st + part * 8) = *(const LAS u32x4*)(T + el * 264 + part * 8); }
        __syncthreads();
    }
    __device__ __forceinline__ void operator()(const f32x4 (&acc)[2][2][4][2], const Unit& u, int wr, int wc, int fr_, int fq_) const {
        int fr = fr_, fq = fq_; asm volatile("" : "+v"(fr), "+v"(fq));
        int rb = u.pm * 256; if (layer == 0) rb = rb < 2048 ? 8192 + rb : rb - 2048;
        const int row0 = rb + wr * 64 + fr;
        float w1[4], w2[4];
#pragma unroll
        for (int i = 0; i < 4; ++i) { w1[i] = khn[64 + 4 * fq + i]; w2[i] = khn[80 + 4 * fq + i]; }
#pragma unroll
        for (int ai = 0; ai < 2; ++ai)
#pragma unroll
          for (int mh = 0; mh < 4; mh += 1) {
            float x1[4][4], x2[4][4], cs[4][4], sn[4][4];
#pragma unroll
            for (int m = mh; m < mh + 1; ++m) { const int r = row0 + ai * 128 + m * 16;
                if (r >= 8192) { const int j = r - 8192; const float* kr = ckr + ((size_t)(((j >> 9) * 2 + layer) * 512 + (j & 511))) * 32 + 4 * fq;
                    const f32x4 a = *(const f32x4*)kr, b = *(const f32x4*)(kr + 16);
#pragma unroll
                    for (int i = 0; i < 4; ++i) { x1[m][i] = a[i]; x2[m][i] = b[i]; } }
                else { const bf16_t* kr = Z + (size_t)r * LDZ + ZMKR + 4 * fq; const u32x2 a = *(const u32x2*)kr, b = *(const u32x2*)(kr + 16);
                    x1[m][0] = lo16(a.x); x1[m][1] = hi16(a.x); x1[m][2] = lo16(a.y); x1[m][3] = hi16(a.y); x2[m][0] = lo16(b.x); x2[m][1] = hi16(b.x); x2[m][2] = lo16(b.y); x2[m][3] = hi16(b.y); }
                const bool rot = r >= 4096 && r < 8192; const int pos = (r - 4096) & 1023;
                if (rot) { const f32x4 c = *(const f32x4*)(R + pos * 16 + 4 * fq), s_ = *(const f32x4*)(R + 16384 + pos * 16 + 4 * fq);
#pragma unroll
                    for (int i = 0; i < 4; ++i) { cs[m][i] = c[i]; sn[m][i] = s_[i]; } }
                else {
#pragma unroll
                    for (int i = 0; i < 4; ++i) { cs[m][i] = 1.f; sn[m][i] = 0.f; } } }
#pragma unroll
            for (int m = mh; m < mh + 1; ++m) { const int r = row0 + ai * 128 + m * 16;
                float ss = 0.f;
#pragma unroll
                for (int bj = 0; bj < 2; ++bj)
#pragma unroll
                    for (int i = 0; i < 8; ++i) { const float v = acc[ai][bj][m][i >> 2][i & 3]; ss += v * v; }
#pragma unroll
                for (int i = 0; i < 4; ++i) ss += x1[m][i] * x1[m][i] + x2[m][i] * x2[m][i];
                ss += __shfl_xor(ss, 16); ss += __shfl_xor(ss, 32);
                const float rstd = rsqrtf(ss * (1.f / 96.f) + 1e-6f);
                bf16_t* kp = KF + (size_t)r * 384 + wc * 96;
#pragma unroll
                for (int bj = 0; bj < 2; ++bj) { u32x4 w; const f32x4 v0 = acc[ai][bj][m][0], v1 = acc[ai][bj][m][1];
                    w.x = pk2(v0[0] * rstd, v0[1] * rstd); w.y = pk2(v0[2] * rstd, v0[3] * rstd);
                    w.z = pk2(v1[0] * rstd, v1[1] * rstd); w.w = pk2(v1[2] * rstd, v1[3] * rstd);
                    *(u32x4*)(kp + 32 * bj + 8 * fq) = w; }
                float o1[4], o2[4];
#pragma unroll
                for (int i = 0; i < 4; ++i) { const float a = x1[m][i] * rstd * w1[i], b = x2[m][i] * rstd * w2[i]; o1[i] = a * cs[m][i] - b * sn[m][i]; o2[i] = a * sn[m][i] + b * cs[m][i]; }
                *(u32x2*)(kp + 64 + 4 * fq) = (u32x2){pk2(o1[0], o1[1]), pk2(o1[2], o1[3])}; *(u32x2*)(kp + 80 + 4 * fq) = (u32x2){pk2(o2[0], o2[1]), pk2(o2[2], o2[3])}; }
            __builtin_amdgcn_sched_barrier(0); }
    } };
struct EpiGLU { static constexpr bool PERM = true, AFTER_DRAIN = false; bf16_t* O; const bf16_t* Z; const float* bias;
    __device__ __forceinline__ void operator()(const f32x4 (&acc)[2][2][4][2], const Unit& u, int wr, int wc, int fr_, int fq_) const {
        int fr = fr_, fq = fq_; asm volatile("" : "+v"(fr), "+v"(fq));
        const int row0 = u.pm * 256 + wr * 64 + fr, oc = u.pn * 128 + wc * 32 + 8 * fq;
#pragma unroll
        for (int ai = 0; ai < 2; ++ai) {
            float bv[8], bg[8];
            { const f32x4 b0 = *(const f32x4*)(bias + oc), b1 = *(const f32x4*)(bias + oc + 4), g0 = *(const f32x4*)(bias + 512 + oc), g1 = *(const f32x4*)(bias + 512 + oc + 4);
#pragma unroll
              for (int i = 0; i < 4; ++i) { bv[i] = b0[i]; bv[4 + i] = b1[i]; bg[i] = g0[i]; bg[4 + i] = g1[i]; } }
            u32x4 sgv[2][4];
#pragma unroll
            for (int m = 0; m < 4; ++m) sgv[ai][m] = *(const u32x4*)(Z + (size_t)(row0 + ai * 128 + m * 16) * LDZ + ZSG + oc);
#pragma unroll
            for (int m = 0; m < 4; ++m) { const size_t r = (size_t)(row0 + ai * 128 + m * 16);
                const u32x4 sg = sgv[ai][m];
                float g[8] = { lo16(sg.x), hi16(sg.x), lo16(sg.y), hi16(sg.y), lo16(sg.z), hi16(sg.z), lo16(sg.w), hi16(sg.w) };
                float o[8];
#pragma unroll
                for (int i = 0; i < 8; ++i) { const float zv = acc[ai][0][m][i >> 2][i & 3] + bv[i], zg = acc[ai][1][m][i >> 2][i & 3] + bg[i]; o[i] = zv * sigmoidf_(zg) * siluf_(g[i]); }
                u32x4 w; w.x = pk2(o[0], o[1]); w.y = pk2(o[2], o[3]); w.z = pk2(o[4], o[5]); w.w = pk2(o[6], o[7]);
                *(u32x4*)(O + r * 512 + oc) = w; }
            __builtin_amdgcn_sched_barrier(0); }
    } };
struct EpiBo { static constexpr bool PERM = true, AFTER_DRAIN = true; bf16_t* MIX; const bf16_t* Z; int branch; int first;
    unsigned* flag_set; unsigned* flag_wait;
    __device__ __forceinline__ void fused(f32x4 (&acc)[2][2][4][2], const Unit& u, int wr, int wc, int fr_, int fq_, LAS unsigned char* lds, int wid, int lane_) const {
        int fr = fr_, fq = fq_, lane = lane_; asm volatile("" : "+v"(fr), "+v"(fq), "+v"(lane));
        const int row0 = u.pm * 256 + wr * 64 + fr, col0 = u.pn * 256 + wc * 32 + 8 * fq;
        LAS unsigned char* wl = lds + wid * 16384;
#pragma unroll
        for (int ai = 0; ai < 2; ++ai)
#pragma unroll
            for (int m = 0; m < 4; ++m)
#pragma unroll
                for (int bj = 0; bj < 2; ++bj)
                    __builtin_amdgcn_global_load_lds((const unsigned*)(Z + (size_t)(row0 + ai * 128 + m * 16) * LDZ + ZMERGE + branch * 1024 + col0 + bj * 128), (LAS unsigned*)(wl + ((ai * 4 + m) * 2 + bj) * 1024), 16, 0, 0);
        const int tile_ = u.pm * 4 + u.pn;
        if (flag_wait != nullptr) {
            if (wid == 0) { unsigned sp = 0u;
                while ((unsigned)__builtin_amdgcn_readfirstlane((int)__hip_atomic_load(flag_wait + tile_, __ATOMIC_RELAXED, __HIP_MEMORY_SCOPE_AGENT)) == 0u) { __builtin_amdgcn_s_sleep(2); if (++sp > (1u << 20)) break; }
                __builtin_amdgcn_fence(__ATOMIC_ACQUIRE, "agent"); asm volatile("s_waitcnt vmcnt(0)" ::: "memory"); }
            __syncthreads(); }
#pragma unroll
        for (int ai = 0; ai < 2; ++ai) {
            u32x4 pv[4][2];
#pragma unroll
            for (int m = 0; m < 4; ++m)
#pragma unroll
                for (int bj = 0; bj < 2; ++bj) pv[m][bj] = first == 0 ? *(const u32x4*)(MIX + (size_t)(row0 + ai * 128 + m * 16) * 1024 + col0 + bj * 128) : (u32x4){0u, 0u, 0u, 0u};
            if (ai == 0) { asm volatile("s_waitcnt vmcnt(0)" ::: "memory"); __builtin_amdgcn_s_barrier(); asm volatile("" ::: "memory"); }
#pragma unroll
            for (int m = 0; m < 4; ++m) { const size_t r = (size_t)(row0 + ai * 128 + m * 16);
#pragma unroll
                for (int bj = 0; bj < 2; ++bj) { const u32x4 sg = *(const LAS u32x4*)(wl + ((ai * 4 + m) * 2 + bj) * 1024 + lane * 16), pp = pv[m][bj];
                    const float g[8] = { lo16(sg.x), hi16(sg.x), lo16(sg.y), hi16(sg.y), lo16(sg.z), hi16(sg.z), lo16(sg.w), hi16(sg.w) };
                    const float q[8] = { lo16(pp.x), hi16(pp.x), lo16(pp.y), hi16(pp.y), lo16(pp.z), hi16(pp.z), lo16(pp.w), hi16(pp.w) };
                    float o[8];
#pragma unroll
                    for (int i = 0; i < 8; ++i) o[i] = q[i] + sigmoidf_(g[i]) * acc[ai][bj][m][i >> 2][i & 3];
                    u32x4 w; w.x = pk2(o[0], o[1]); w.y = pk2(o[2], o[3]); w.z = pk2(o[4], o[5]); w.w = pk2(o[6], o[7]);
                    *(u32x4*)(MIX + r * 1024 + col0 + bj * 128) = w; } }
            __builtin_amdgcn_sched_barrier(0); }
        if (flag_set != nullptr) { asm volatile("s_waitcnt vmcnt(0)" ::: "memory"); __syncthreads();
            if (wid == 0 && lane == 0) { __builtin_amdgcn_fence(__ATOMIC_RELEASE, "agent"); asm volatile("s_waitcnt vmcnt(0)" ::: "memory"); __hip_atomic_store(flag_set + tile_, 1u, __ATOMIC_RELAXED, __HIP_MEMORY_SCOPE_AGENT); } }
        __syncthreads();
    }
    __device__ __forceinline__ void operator()(const f32x4 (&acc)[2][2][4][2], const Unit& u, int wr, int wc, int fr_, int fq_) const {
        int fr = fr_, fq = fq_; asm volatile("" : "+v"(fr), "+v"(fq));
        const int row0 = u.pm * 256 + wr * 64 + fr, col0 = u.pn * 256 + wc * 32 + 8 * fq;
#pragma unroll
        for (int ai = 0; ai < 2; ++ai)
#pragma unroll
          for (int mh = 0; mh < 4; mh += 2) {
            u32x4 gz[4][2], pv[4][2];
#pragma unroll
            for (int m = mh; m < mh + 2; ++m)
#pragma unroll
                for (int bj = 0; bj < 2; ++bj) { const size_t r = (size_t)(row0 + ai * 128 + m * 16);
                    gz[m][bj] = *(const u32x4*)(Z + r * LDZ + ZMERGE + branch * 1024 + col0 + bj * 128);
                    pv[m][bj] = first == 0 ? *(const u32x4*)(MIX + r * 1024 + col0 + bj * 128) : (u32x4){0u, 0u, 0u, 0u}; }
#pragma unroll
            for (int m = mh; m < mh + 2; ++m) { const size_t r = (size_t)(row0 + ai * 128 + m * 16);
#pragma unroll
                for (int bj = 0; bj < 2; ++bj) { const u32x4 sg = gz[m][bj], pp = pv[m][bj];
                    const float g[8] = { lo16(sg.x), hi16(sg.x), lo16(sg.y), hi16(sg.y), lo16(sg.z), hi16(sg.z), lo16(sg.w), hi16(sg.w) };
                    const float q[8] = { lo16(pp.x), hi16(pp.x), lo16(pp.y), hi16(pp.y), lo16(pp.z), hi16(pp.z), lo16(pp.w), hi16(pp.w) };
                    float o[8];
#pragma unroll
                    for (int i = 0; i < 8; ++i) o[i] = q[i] + sigmoidf_(g[i]) * acc[ai][bj][m][i >> 2][i & 3];
                    u32x4 w; w.x = pk2(o[0], o[1]); w.y = pk2(o[2], o[3]); w.z = pk2(o[4], o[5]); w.w = pk2(o[6], o[7]);
                    *(u32x4*)(MIX + r * 1024 + col0 + bj * 128) = w; } }
            __builtin_amdgcn_sched_barrier(0); }
    } };
struct EpiOut { static constexpr bool PERM = false, AFTER_DRAIN = true; float* Y; const float* xp; const float* xs; const float* ada;
    __device__ __forceinline__ void fused(f32x4 (&acc)[2][2][4][2], const Unit& u, int wr, int wc, int fr_, int fq_, LAS unsigned char* lds, int wid, int lane_) const {
        int fr = fr_, fq = fq_, lane = lane_; asm volatile("" : "+v"(fr), "+v"(fq), "+v"(lane));
        const int row0 = u.pm * 256 + wr * 64 + fr, col0 = u.pn * 256 + wc * 32 + 4 * fq;
        LAS unsigned char* wl = lds + wid * 16384;
        const float* xb = (u.pm < 16 ? xp + (size_t)row0 * 1024 : xs + (size_t)(row0 - 4096) * 1024) + col0;
#pragma unroll
        for (int m = 0; m < 4; ++m)
#pragma unroll
            for (int bj = 0; bj < 2; ++bj)
#pragma unroll
                for (int n = 0; n < 2; ++n) __builtin_amdgcn_global_load_lds((const unsigned*)(xb + (size_t)(m * 16) * 1024 + bj * 128 + n * 16), (LAS unsigned*)(wl + ((m * 2 + bj) * 2 + n) * 1024), 16, 0, 0);
        f32x4 x1[4][2][2];
#pragma unroll
        for (int m = 0; m < 4; ++m)
#pragma unroll
            for (int bj = 0; bj < 2; ++bj)
#pragma unroll
                for (int n = 0; n < 2; ++n) x1[m][bj][n] = *(const f32x4*)(xb + (size_t)(128 + m * 16) * 1024 + bj * 128 + n * 16);
        const int ar = u.pm < 16 ? 0 : 1 + ((u.pm - 16) >> 2);
        const float* gp = ada + ar * 3072 + 2048;
        f32x4 gv[2][2];
#pragma unroll
        for (int bj = 0; bj < 2; ++bj)
#pragma unroll
            for (int n = 0; n < 2; ++n) gv[bj][n] = *(const f32x4*)(gp + col0 + bj * 128 + n * 16);
        asm volatile("s_waitcnt vmcnt(0)" ::: "memory"); __builtin_amdgcn_s_barrier(); asm volatile("" ::: "memory");
        float* yb = Y + (size_t)row0 * 1024 + col0;
#pragma unroll
        for (int m = 0; m < 4; ++m)
#pragma unroll
            for (int bj = 0; bj < 2; ++bj)
#pragma unroll
                for (int n = 0; n < 2; ++n) { const f32x4 xv = *(const LAS f32x4*)(wl + ((m * 2 + bj) * 2 + n) * 1024 + lane * 16);
                    *(f32x4*)(yb + (size_t)(m * 16) * 1024 + bj * 128 + n * 16) = xv + gv[bj][n] * acc[0][bj][m][n];
                    *(f32x4*)(yb + (size_t)(128 + m * 16) * 1024 + bj * 128 + n * 16) = x1[m][bj][n] + gv[bj][n] * acc[1][bj][m][n]; }
        __syncthreads();
    }
    __device__ __forceinline__ void operator()(const f32x4 (&acc)[2][2][4][2], const Unit& u, int wr, int wc, int fr_, int fq_) const {
        int fr = fr_, fq = fq_; asm volatile("" : "+v"(fr), "+v"(fq));
        const int row0 = u.pm * 256 + wr * 64 + fr, col0 = u.pn * 256 + wc * 32 + 4 * fq;
        const int ar = u.pm < 16 ? 0 : 1 + ((u.pm - 16) >> 2);
        const float* gp = ada + ar * 3072 + 2048;
        f32x4 gv[2][2];
#pragma unroll
        for (int bj = 0; bj < 2; ++bj)
#pragma unroll
            for (int n = 0; n < 2; ++n) gv[bj][n] = *(const f32x4*)(gp + col0 + bj * 128 + n * 16);
#pragma unroll
        for (int ai = 0; ai < 2; ++ai)
#pragma unroll
          for (int mh = 0; mh < 4; mh += 2) {
            f32x4 xv[4][2][2];
#pragma unroll
            for (int m = mh; m < mh + 2; ++m) { const int r = row0 + ai * 128 + m * 16;
                const float* xr = (r < 4096 ? xp + (size_t)r * 1024 : xs + (size_t)(r - 4096) * 1024) + col0;
#pragma unroll
                for (int bj = 0; bj < 2; ++bj)
#pragma unroll
                    for (int n = 0; n < 2; ++n) xv[m][bj][n] = *(const f32x4*)(xr + bj * 128 + n * 16); }
#pragma unroll
            for (int m = mh; m < mh + 2; ++m) { const int r = row0 + ai * 128 + m * 16;
                float* yr = Y + (size_t)r * 1024 + col0;
#pragma unroll
                for (int bj = 0; bj < 2; ++bj)
#pragma unroll
                    for (int n = 0; n < 2; ++n) *(f32x4*)(yr + bj * 128 + n * 16) = xv[m][bj][n] + gv[bj][n] * acc[ai][bj][m][n]; }
            __builtin_amdgcn_sched_barrier(0); }
    } };

__device__ __forceinline__ void job_ada(const Params& p, int j, lds_t lds) {
    LAS float* sc = (LAS float*)lds; LAS float* red = sc + 5 * 1024;
    const int l = j / 96, c0 = (j % 96) * 32, tid = tid_opaque(p);
    for (int i = tid; i < 5 * 1024; i += 512) { const int r = i >> 10, k = i & 1023; const float v = r == 0 ? p.in[I_CCTX][k] : p.in[I_C][(r - 1) * 1024 + k]; sc[i] = v / (1.f + expf(-v)); }
    __syncthreads();
    const int col = tid & 31, kg = tid >> 5; const float* W = p.in[I_WADA] + (size_t)l * 1024 * 3072 + (size_t)(kg * 64) * 3072 + c0 + col;
    float a0 = 0.f, a1 = 0.f, a2 = 0.f, a3 = 0.f, a4 = 0.f;
#pragma unroll 1
    for (int kb = 0; kb < 64; kb += 16) { float w[16];
#pragma unroll
        for (int i = 0; i < 16; ++i) w[i] = W[(size_t)(kb + i) * 3072];
#pragma unroll
        for (int i = 0; i < 16; ++i) { const int k = kg * 64 + kb + i; a0 += sc[k] * w[i]; a1 += sc[1024 + k] * w[i]; a2 += sc[2048 + k] * w[i]; a3 += sc[3072 + k] * w[i]; a4 += sc[4096 + k] * w[i]; } }
    red[(kg * 5 + 0) * 32 + col] = a0; red[(kg * 5 + 1) * 32 + col] = a1; red[(kg * 5 + 2) * 32 + col] = a2; red[(kg * 5 + 3) * 32 + col] = a3; red[(kg * 5 + 4) * 32 + col] = a4;
    __syncthreads();
    if (tid < 160) { const int r = tid >> 5, cc = tid & 31; float s = p.in[I_BADA][l * 3072 + c0 + cc];
        for (int g = 0; g < 16; ++g) s += red[(g * 5 + r) * 32 + cc];
        ((float*)(p.ws + OFF_ADA))[(l * 5 + r) * 3072 + c0 + cc] = s; }
    __syncthreads();
}
__device__ __forceinline__ void job_ctx(const Params& p, int j) {
    const int base = j * 4096 + tid_opaque(p) * 8; const int l = base / (2048 * 256), rem = base % (2048 * 256), row = rem >> 8, c = rem & 255, b = row >> 9, jj = row & 511;
    const float* s = p.in[I_CKV] + ((size_t)((b * 2 + l) * 512 + jj)) * 256 + c;
    const f32x4 v0 = *(const f32x4*)s, v1 = *(const f32x4*)(s + 4);
    bf16_t* d = (bf16_t*)(p.ws + (l == 0 ? OFF_CTX0 : OFF_CTX1)) + (size_t)row * 256 + c;
    store8(d, v0, v1);
}
__device__ __forceinline__ void job_rope(const Params& p, int j) {
    const int idx = j * 512 + tid_opaque(p), pos = idx >> 4, i = idx & 15, f = i & 7;
    const float inv = powf(10000.f, -(float)f / 8.f); const float ang = (float)(i < 8 ? (pos >> 6) : (pos & 63)) * inv;
    float* R = (float*)(p.ws + OFF_ROPE); R[idx] = cosf(ang); R[16384 + idx] = sinf(ang);
}

__device__ __forceinline__ void job_prep(const Params& p, int l, int j) {
    const int tid = tid_opaque(p), wid = tid >> 6, lane = tid & 63;
    const float* nw = p.in[I_NORMW] + l * 1024;
    f32x4 v[4][4]; float ss[4];
#pragma unroll
    for (int q = 0; q < 4; ++q) { const int row = j * 32 + wid * 4 + q;
        const float* x = l == 0 ? (row < 4096 ? p.in[I_XP] + (size_t)row * 1024 : p.in[I_XS] + (size_t)(row - 4096) * 1024) : p.out + (size_t)row * 1024;
#pragma unroll
        for (int i = 0; i < 4; ++i) v[q][i] = *(const f32x4*)(x + i * 256 + lane * 4); }
#pragma unroll
    for (int q = 0; q < 4; ++q) { float s_ = 0.f;
#pragma unroll
        for (int i = 0; i < 4; ++i) s_ += v[q][i][0] * v[q][i][0] + v[q][i][1] * v[q][i][1] + v[q][i][2] * v[q][i][2] + v[q][i][3] * v[q][i][3];
#pragma unroll
        for (int o = 1; o < 64; o <<= 1) s_ += __shfl_xor(s_, o);
        ss[q] = s_; }
#pragma unroll
    for (int q = 0; q < 4; ++q) { const int row = j * 32 + wid * 4 + q; const int ar = row < 4096 ? 0 : 1 + ((row - 4096) >> 10);
        const float* ada = (const float*)(p.ws + OFF_ADA) + (l * 5 + ar) * 3072;
        const float rstd = rsqrtf(ss[q] * (1.f / 1024.f) + 1e-6f);
        bf16_t* h = (bf16_t*)(p.ws + OFF_HB) + (size_t)row * 1024;
#pragma unroll
        for (int i = 0; i < 4; ++i) { const int c = i * 256 + lane * 4; const f32x4 w = *(const f32x4*)(nw + c), sh = *(const f32x4*)(ada + c), sc = *(const f32x4*)(ada + 1024 + c);
            float o[4];
#pragma unroll
            for (int k = 0; k < 4; ++k) o[k] = v[q][i][k] * rstd * w[k] * (1.f + sc[k]) + sh[k];
            u32x2 pk; pk.x = pk2(o[0], o[1]); pk.y = pk2(o[2], o[3]); *(u32x2*)(h + c) = pk; } }
}
__device__ __forceinline__ void wt_tile(const Params& p, const float* src, int ldsrc, int sbase, int nvalid, int mode, bf16_t* dst, int K, int n0, int k0, lds_t lds) {
    LAS float* t = (LAS float*)lds; const int tid = tid_opaque(p);
    const int nn = tid & 255, kh = tid >> 8; const int sc = mode == 0 ? sbase + nn : mode == 1 ? ((nn >> 7) & 1) * 512 + sbase + (nn & 127) : ((nn >> 5) & 3) * 64 + (nn >> 7) * 32 + (nn & 31); const bool ok = mode != 0 || nn < nvalid;
    float v[32];
#pragma unroll
    for (int i = 0; i < 32; ++i) v[i] = ok ? src[(size_t)(k0 + 2 * i + kh) * ldsrc + sc] : 0.f;
#pragma unroll
    for (int i = 0; i < 32; ++i) t[(2 * i + kh) * 257 + nn] = v[i];
    __syncthreads();
#pragma unroll
    for (int ps = 0; ps < 4; ++ps) { const int n = ps * 64 + (tid >> 3), kc = tid & 7; const LAS float* s = t + (kc * 8) * 257 + n; u32x4 w;
        w.x = pk2(s[0], s[257]); w.y = pk2(s[514], s[771]); w.z = pk2(s[1028], s[1285]); w.w = pk2(s[1542], s[1799]);
        *(u32x4*)(dst + (size_t)(n0 + n) * K + k0 + kc * 8) = w; }
    __syncthreads();
}
constexpr int WT_WIN = 27 * 16, WT_WUQ = 2 * 6, WT_WKV = 3 * 4, WT_WGLU = 4 * 8, WT_WBO = 4 * 8, WT_WOUT = 4 * 16, WT_EARLY = WT_WIN + WT_WUQ + WT_WKV + WT_WGLU, WT_TOTAL = WT_EARLY + 3 * WT_WBO + WT_WOUT;
__device__ __forceinline__ void job_wt(const Params& p, int l, int t, lds_t lds) {
    if (t < WT_WIN) { const int nt = t / 16, kt = t % 16; wt_tile(p, p.in[I_WIN] + (size_t)l * 1024 * 6848, 6848, nt * 256, 6848 - nt * 256, 0, (bf16_t*)(p.ws + OFF_WIN), 1024, nt * 256, kt * 64, lds); return; } t -= WT_WIN;
    if (t < WT_WUQ) { const int nt = t / 6, kt = t % 6; wt_tile(p, p.in[I_WUQ] + (size_t)l * 384 * 384, 384, nt * 256, 384 - nt * 256, 0, (bf16_t*)(p.ws + OFF_WUQ), 384, nt * 256, kt * 64, lds); return; } t -= WT_WUQ;
    if (t < WT_WKV) { const int nt = t / 4, kt = t % 4;
        if (nt == 0) wt_tile(p, p.in[I_WUK] + (size_t)l * 256 * 256, 256, 0, 256, 2, (bf16_t*)(p.ws + OFF_WKV), 256, 0, kt * 64, lds);
        else wt_tile(p, p.in[I_WUV] + (size_t)l * 256 * 512, 512, (nt - 1) * 256, 256, 0, (bf16_t*)(p.ws + OFF_WKV), 256, nt * 256, kt * 64, lds);
        return; } t -= WT_WKV;
    if (t < WT_WGLU) { const int nt = t / 8, kt = t % 8; wt_tile(p, p.in[I_WGLU] + (size_t)l * 512 * 1024, 1024, nt * 128, 256, 1, (bf16_t*)(p.ws + OFF_WGLU), 512, nt * 256, kt * 64, lds); return; } t -= WT_WGLU;
    if (t < 3 * WT_WBO) { const int br = t / WT_WBO, tt = t % WT_WBO, nt = tt / 8, kt = tt % 8;
        wt_tile(p, p.in[I_WBOG + br] + (size_t)l * 512 * 1024, 1024, nt * 256, 256, 0, (bf16_t*)(p.ws + OFF_WBO) + (size_t)br * 1024 * 512, 512, nt * 256, kt * 64, lds); return; } t -= 3 * WT_WBO;
    { const int nt = t / 16, kt = t % 16; wt_tile(p, p.in[I_WOUT] + (size_t)l * 1024 * 1024, 1024, nt * 256, 256, 0, (bf16_t*)(p.ws + (l == 0 ? OFF_WOUT : OFF_WOUT2)), 1024, nt * 256, kt * 64, lds); }
}
__device__ __forceinline__ void job_s5setup(const Params& p, int l, int jq, lds_t lds) {
    const int j = jq >> 2, qtr = jq & 3, g = j / 3, which = j % 3, tid = tid_opaque(p);
    LAS f32x2_t* pw = (LAS f32x2_t*)lds;
    LAS f32x2_t* Bt = pw + 2 * 17 * 64;
    LAS f32x2_t* Cn = Bt + 2 * 64 * 16;
    LAS float* Kt = (LAS float*)(Cn + 64 * 16);
    LAS float* raw = Kt + 8192;
    { const size_t gb = (size_t)(l * 32 + g) * 1024;
      for (int i = tid; i < 1024; i += 512) { raw[i] = p.in[I_BRE][gb + i]; raw[1024 + i] = p.in[I_BIM][gb + i]; raw[2048 + i] = p.in[I_CRE][gb + i]; raw[3072 + i] = p.in[I_CIM][gb + i]; }
      if (tid < 128) { const int d = tid >> 6, n = tid & 63; raw[4096 + tid] = p.in[I_ARE][((l * 2 + d) * 32 + g) * 64 + n]; raw[4224 + tid] = p.in[I_AIM][((l * 2 + d) * 32 + g) * 64 + n]; }
      if (tid < 2) raw[4352 + tid] = p.in[I_LOGDT][(l * 2 + tid) * 32 + g]; }
    __syncthreads();
    if (tid < 128) { const int d = tid >> 6, n = tid & 63;
        const float dt = expf(raw[4352 + d]);
        const float are = raw[4096 + tid], aim = raw[4224 + tid];
        float s1, c1; sincosf(aim * dt, &s1, &c1); float sh = sinf(0.5f * aim * dt);
        const float em1 = expm1f(are * dt), mag1 = em1 + 1.f;
        { float pr = 1.f, pi = 0.f; const float ar1 = mag1 * c1, ai1 = mag1 * s1;
          for (int tau = 0; tau <= 16; ++tau) { pw[(d * 17 + tau) * 64 + n] = (f32x2_t){pr, pi}; const float nr = pr * ar1 - pi * ai1, ni = pr * ai1 + pi * ar1; pr = nr; pi = ni; } }
        const float nre = em1 * c1 - 2.f * sh * sh, abim = mag1 * s1, den = are * are + aim * aim;
        const float cfr = (nre * are + abim * aim) / den, cfi = (abim * are - nre * aim) / den;
        for (int q = 0; q < 16; ++q) { const float br = raw[n * 16 + q], bi = raw[1024 + n * 16 + q];
            Bt[(d * 64 + n) * 16 + q] = (f32x2_t){cfr * br - cfi * bi, cfr * bi + cfi * br}; }
        if (which == 1 && qtr == 0) ((f32x2_t*)(p.ws + OFF_P16))[(g * 2 + d) * 64 + n] = pw[(d * 17 + 16) * 64 + n];
    }
    for (int i = tid; i < 1024; i += 512) { const int n = i >> 4, pp = i & 15; Cn[i] = (f32x2_t){raw[2048 + pp * 64 + n], raw[3072 + pp * 64 + n]}; }
    __syncthreads();
    bf16_t* M = (bf16_t*)(p.ws + OFF_S5M) + (size_t)(g * 3 + which) * 65536;
    if (which == 0) {
        { const int wid_ = tid >> 6, ln = tid & 63, lr_ = ln & 15, kq = ln >> 4;
          for (int c4 = 0; c4 < 4; ++c4) { const int dt_ = wid_ * 4 + c4, d = dt_ >> 4, tau = dt_ & 15; f32x4 acc = {0.f, 0.f, 0.f, 0.f};
#pragma unroll 4
            for (int ks = 0; ks < 16; ++ks) { const int n = ks * 4 + kq; const f32x2_t c = Cn[n * 16 + lr_], w = pw[(d * 17 + tau) * 64 + n], b = Bt[(d * 64 + n) * 16 + lr_];
                const float cwr = c.x * w.x - c.y * w.y, cwi = c.x * w.y + c.y * w.x;
                acc = __builtin_amdgcn_mfma_f32_16x16x4f32(cwr, b.x, acc, 0, 0, 0); acc = __builtin_amdgcn_mfma_f32_16x16x4f32(-cwi, b.y, acc, 0, 0, 0); }
#pragma unroll
            for (int r = 0; r < 4; ++r) Kt[dt_ * 256 + (kq * 4 + r) * 16 + lr_] = acc[r]; } }
        __syncthreads();
#pragma unroll 8
        for (int i = qtr * 16384 + tid; i < (qtr + 1) * 16384; i += 512) { const int no = i >> 8, k = i & 255, t = no >> 4, pp = no & 15, s = k >> 4, q = k & 15; float v;
            if (t > s) v = Kt[(0 * 16 + (t - s)) * 256 + pp * 16 + q];
            else if (t < s) v = Kt[(1 * 16 + (s - t)) * 256 + pp * 16 + q];
            else { v = Kt[pp * 16 + q] + Kt[16 * 256 + pp * 16 + q]; if (pp == q) v += p.in[I_S5D][l * 512 + g * 16 + pp]; }
            M[i] = f2bf(v); }
    } else if (which == 1) {
#pragma unroll 8
        for (int i = qtr * 16384 + tid; i < (qtr + 1) * 16384; i += 512) { const int no = i >> 8, k = i & 255, d = no >> 7, ri = (no >> 6) & 1, n = no & 63, s = k >> 4, q = k & 15; const int e = d == 0 ? 15 - s : s;
            const f32x2_t w = pw[(d * 17 + e) * 64 + n], b = Bt[(d * 64 + n) * 16 + q];
            M[i] = f2bf(ri == 0 ? w.x * b.x - w.y * b.y : w.x * b.y + w.y * b.x); }
    } else {
#pragma unroll 8
        for (int i = qtr * 16384 + tid; i < (qtr + 1) * 16384; i += 512) { const int no = i >> 8, k = i & 255, t = no >> 4, pp = no & 15, d = k >> 7, ri = (k >> 6) & 1, n = k & 63; const int e = d == 0 ? t + 1 : 16 - t;
            const f32x2_t c = Cn[n * 16 + pp], w = pw[(d * 17 + e) * 64 + n];
            M[i] = f2bf(ri == 0 ? c.x * w.x - c.y * w.y : -(c.x * w.y + c.y * w.x)); }
    }
    __syncthreads();
}

__device__ __forceinline__ float gelu_tanh(float x) { const float u = 0.7978845608f * (x + 0.044715f * x * x * x); const float t = 1.f - 2.f / (1.f + __expf(2.f * u)); return 0.5f * x * (1.f + t); }
__device__ __forceinline__ void job_s5(const Params& p, int l, int j, lds_t lds) {
    const int tid = tid_opaque(p), wid = tid >> 6, lane = tid & 63, lr = lane & 15, lq = lane >> 4;
    const int bcd = j >> 5, g = j & 31;
    const bool smp = bcd < 4;
    constexpr int M = 64, MT = 4; const int tok0 = smp ? 4096 + bcd * 1024 : (bcd - 4) * 1024;
    LAS bf16_t* Us = (LAS bf16_t*)lds; LAS bf16_t* Xs = Us + 64 * 264; LAS float* Xin = (LAS float*)(lds + 2 * 64 * 264 * 2);
    const bf16_t* Z = (const bf16_t*)(p.ws + OFF_Z);
    const bf16_t* TT = (const bf16_t*)(p.ws + OFF_S5M) + (size_t)(g * 3) * 65536; const bf16_t* G = TT + 65536; const bf16_t* Cc = G + 65536;
    bf16x8 bq[8][2];
#pragma unroll
    for (int ks = 0; ks < 8; ++ks) { bq[ks][0] = *(const bf16x8*)(G + (size_t)(wid * 32 + lr) * 256 + ks * 32 + lq * 8); bq[ks][1] = *(const bf16x8*)(G + (size_t)(wid * 32 + 16 + lr) * 256 + ks * 32 + lq * 8); }
    f32x2_t a16 = {0.f, 0.f}; float xr = 0.f, xi = 0.f;
    if (tid < 128) { const int d = tid >> 6, n = tid & 63; a16 = ((const f32x2_t*)(p.ws + OFF_P16))[(g * 2 + d) * 64 + n];
        if (smp) { const size_t o = ((size_t)((bcd * 2 + l) * 2 + d) * 2) * 2048 + g * 64 + n; xr = p.in[I_SS5][o]; xi = p.in[I_SS5][o + 2048]; } }
    for (int idx = tid; idx < M * 32; idx += 512) { const int tok = idx >> 1, hf = idx & 1;
        *(LAS u32x4*)(Us + (tok >> 4) * 264 + (tok & 15) * 16 + hf * 8) = *(const u32x4*)(Z + (size_t)(tok0 + tok) * LDZ + ZSU + g * 16 + hf * 8); }
    __syncthreads();
    f32x4 acc[4][2];
#pragma unroll
    for (int a = 0; a < 4; ++a) { acc[a][0] = (f32x4){0.f, 0.f, 0.f, 0.f}; acc[a][1] = acc[a][0]; }
#pragma unroll
    for (int ks = 0; ks < 8; ++ks)
#pragma unroll
        for (int mt = 0; mt < 4; ++mt) if (mt < MT) { const bf16x8 a = LDSFRAG(Us + (mt * 16 + lr) * 264 + ks * 32 + lq * 8); acc[mt][0] = MFMA16(a, bq[ks][0], acc[mt][0]); acc[mt][1] = MFMA16(a, bq[ks][1], acc[mt][1]); }
    bf16x8 bc[8][2];
#pragma unroll
    for (int ks = 0; ks < 8; ++ks) { bq[ks][0] = *(const bf16x8*)(TT + (size_t)(wid * 32 + lr) * 256 + ks * 32 + lq * 8); bq[ks][1] = *(const bf16x8*)(TT + (size_t)(wid * 32 + 16 + lr) * 256 + ks * 32 + lq * 8);
        bc[ks][0] = *(const bf16x8*)(Cc + (size_t)(wid * 32 + lr) * 256 + ks * 32 + lq * 8); bc[ks][1] = *(const bf16x8*)(Cc + (size_t)(wid * 32 + 16 + lr) * 256 + ks * 32 + lq * 8); }
#pragma unroll
    for (int mt = 0; mt < 4; ++mt) if (mt < MT)
#pragma unroll
        for (int ct = 0; ct < 2; ++ct)
#pragma unroll
            for (int r = 0; r < 4; ++r) Xin[(mt * 16 + lq * 4 + r) * 260 + wid * 32 + ct * 16 + lr] = acc[mt][ct][r];
    __syncthreads();
    if (tid < 128) { const int d = tid >> 6, n = tid & 63;
        const int cre = d * 128 + n, cim = cre + 64;
        const int nseg = smp ? 1 : 4, L = 64 / nseg;
        for (int sg = 0; sg < nseg; ++sg) {
            if (!smp) { xr = 0.f; xi = 0.f; }
            for (int i = 0; i < L; ++i) { const int c = sg * L + (d == 0 ? i : L - 1 - i);
                Xs[c * 264 + cre] = f2bf(xr); Xs[c * 264 + cim] = f2bf(xi);
                const float ur = Xin[c * 260 + cre], ui = Xin[c * 260 + cim];
                const float nr = a16.x * xr - a16.y * xi + ur, ni = a16.x * xi + a16.y * xr + ui; xr = nr; xi = ni; }
            if (!smp) { const int bb = (bcd - 4) * 4 + sg; const size_t o = OUT_S5 + ((size_t)((bb * 2 + l) * 2 + d) * 2) * 2048 + g * 64 + n; p.out[o] = xr; p.out[o + 2048] = xi; } }
    }
    __syncthreads();
#pragma unroll
    for (int a = 0; a < 4; ++a) { acc[a][0] = (f32x4){0.f, 0.f, 0.f, 0.f}; acc[a][1] = acc[a][0]; }
#pragma unroll
    for (int ks = 0; ks < 8; ++ks)
#pragma unroll
        for (int mt = 0; mt < 4; ++mt) if (mt < MT) { const bf16x8 a = LDSFRAG(Us + (mt * 16 + lr) * 264 + ks * 32 + lq * 8); acc[mt][0] = MFMA16(a, bq[ks][0], acc[mt][0]); acc[mt][1] = MFMA16(a, bq[ks][1], acc[mt][1]); }
#pragma unroll
    for (int ks = 0; ks < 8; ++ks)
#pragma unroll
        for (int mt = 0; mt < 4; ++mt) if (mt < MT) { const bf16x8 a = LDSFRAG(Xs + (mt * 16 + lr) * 264 + ks * 32 + lq * 8); acc[mt][0] = MFMA16(a, bc[ks][0], acc[mt][0]); acc[mt][1] = MFMA16(a, bc[ks][1], acc[mt][1]); }
    bf16_t* Yg = (bf16_t*)(p.ws + OFF_YG);
#pragma unroll
    for (int mt = 0; mt < 4; ++mt) if (mt < MT)
#pragma unroll
        for (int ct = 0; ct < 2; ++ct)
#pragma unroll
            for (int r = 0; r < 4; ++r) { const int chunk = mt * 16 + lq * 4 + r, t = wid * 2 + ct;
                Yg[(size_t)(tok0 + chunk * 16 + t) * 512 + g * 16 + lr] = f2bf(gelu_tanh(acc[mt][ct][r])); }
    __syncthreads();
}
__device__ __forceinline__ void job_mlaprep(const Params& p, int l, int j) {
    const int tid = tid_opaque(p), wid = tid >> 6, lane = tid & 63;
    bf16_t qr[4][6], kr[4][4], rr[4];
#pragma unroll
    for (int t4 = 0; t4 < 4; ++t4) { const int row = j * 32 + wid * 4 + t4; const bf16_t* z = (const bf16_t*)(p.ws + OFF_Z) + (size_t)row * LDZ;
#pragma unroll
        for (int i = 0; i < 6; ++i) qr[t4][i] = z[ZMQ + i * 64 + lane];
#pragma unroll
        for (int i = 0; i < 4; ++i) kr[t4][i] = z[ZMKV + i * 64 + lane];
        rr[t4] = z[ZMKR + (lane & 31)]; }
    float qn[6], kn[4];
#pragma unroll
    for (int i = 0; i < 6; ++i) qn[i] = p.in[I_QNORM][l * 384 + i * 64 + lane];
#pragma unroll
    for (int i = 0; i < 4; ++i) kn[i] = p.in[I_KVNORM][l * 256 + i * 64 + lane];
#pragma unroll
    for (int t4 = 0; t4 < 4; ++t4) { const int row = j * 32 + wid * 4 + t4;
        float q[6], kv[4]; float sq = 0.f, sk = 0.f;
#pragma unroll
        for (int i = 0; i < 6; ++i) { q[i] = bf2f(qr[t4][i]); sq += q[i] * q[i]; }
#pragma unroll
        for (int i = 0; i < 4; ++i) { kv[i] = bf2f(kr[t4][i]); sk += kv[i] * kv[i]; }
#pragma unroll
        for (int o = 1; o < 64; o <<= 1) { sq += __shfl_xor(sq, o); sk += __shfl_xor(sk, o); }
        const float rq = rsqrtf(sq * (1.f / 384.f) + 1e-6f), rk = rsqrtf(sk * (1.f / 256.f) + 1e-6f);
        bf16_t* aq = (bf16_t*)(p.ws + OFF_AQ) + (size_t)row * 384; bf16_t* ck = (bf16_t*)(p.ws + OFF_CKVN) + (size_t)row * 256;
#pragma unroll
        for (int i = 0; i < 6; ++i) aq[i * 64 + lane] = f2bf(q[i] * rq * qn[i]);
        const bool prompt = row < 4096; const int b = row >> 8, t = row & 255;
#pragma unroll
        for (int i = 0; i < 4; ++i) { const float v = kv[i] * rk * kn[i]; ck[i * 64 + lane] = f2bf(v);
            if (prompt) p.out[OUT_CKV + ((size_t)((b * 2 + l) * 256 + t)) * 256 + i * 64 + lane] = v; }
        if (prompt && lane < 32) p.out[OUT_KR + ((size_t)((b * 2 + l) * 256 + t)) * 32 + lane] = bf2f(rr[t4]); }
}
__device__ __forceinline__ float logsigmoidf_(float x) { return fminf(x, 0.f) - __logf(1.f + __expf(-fabsf(x))); }
__device__ __forceinline__ void job_glaA(const Params& p, int l, int j, lds_t lds) {
    const int tid = tid_opaque(p), wid = tid >> 6, lane = tid & 63, lr = lane & 15, lq = lane >> 4;
    const int ck = j >> 2, h = j & 3, tok0 = ck * 64;
    LAS bf16_t* QDf = (LAS bf16_t*)lds; LAS bf16_t* QDb = QDf + 4608; LAS bf16_t* KDf = QDb + 4608; LAS bf16_t* KDb = KDf + 4608; LAS bf16_t* KRf = KDb + 4608; LAS bf16_t* KRb = KRf + 4608;
    LAS bf16_t* VT = KRb + 4608;
    LAS bf16_t* ATT = VT + 9216;
    LAS float* GA = (LAS float*)(ATT + 4608);
    LAS float* TOT = GA + 2048;
    const bf16_t* Z = (const bf16_t*)(p.ws + OFF_Z);
    const int d = tid & 63, cg_ = tid >> 6;
    bf16_t qraw[8], kraw[8]; float wf[16], wb[16];
#pragma unroll
    for (int i = 0; i < 8; ++i) { const size_t zr = (size_t)(tok0 + cg_ * 8 + i) * LDZ; qraw[i] = Z[zr + ZQ + h * 64 + d]; kraw[i] = Z[zr + ZK + h * 64 + d]; }
#pragma unroll
    for (int r = 0; r < 16; ++r) { wf[r] = p.in[I_WA2][((size_t)((l * 2 + 0) * 16 + r)) * 256 + h * 64 + d]; wb[r] = p.in[I_WA2][((size_t)((l * 2 + 1) * 16 + r)) * 256 + h * 64 + d]; }
    const float bf_ = p.in[I_BA][(l * 2 + 0) * 256 + h * 64 + d], bb_ = p.in[I_BA][(l * 2 + 1) * 256 + h * 64 + d];
    { const int c = tid >> 3, part = tid & 7; const u32x2 gv = *(const u32x2*)(Z + (size_t)(tok0 + c) * LDZ + ZGA + part * 4);
      GA[c * 32 + part * 4 + 0] = lo16(gv.x); GA[c * 32 + part * 4 + 1] = hi16(gv.x); GA[c * 32 + part * 4 + 2] = lo16(gv.y); GA[c * 32 + part * 4 + 3] = hi16(gv.y);
      const bf16_t* vp = Z + (size_t)(tok0 + c) * LDZ + ZV + h * 128 + part * 16;
      const u32x4 v0 = *(const u32x4*)vp, v1 = *(const u32x4*)(vp + 8);
      const unsigned w[8] = { v0.x, v0.y, v0.z, v0.w, v1.x, v1.y, v1.z, v1.w };
#pragma unroll
      for (int i = 0; i < 8; ++i) { VT[(part * 16 + 2 * i) * 72 + c] = (bf16_t)(w[i] & 0xffffu); VT[(part * 16 + 2 * i + 1) * 72 + c] = (bf16_t)(w[i] >> 16); } }
    __syncthreads();
    float laf[8], lab[8];
    {
#pragma unroll
      for (int i = 0; i < 8; ++i) { const int c = cg_ * 8 + i; float xf = bf_, xb = bb_;
#pragma unroll
          for (int r = 0; r < 16; ++r) { xf += GA[c * 32 + r] * wf[r]; xb += GA[c * 32 + 16 + r] * wb[r]; }
          laf[i] = logsigmoidf_(xf) * (1.f / 16.f); lab[i] = logsigmoidf_(xb) * (1.f / 16.f); } }
#pragma unroll
    for (int i = 1; i < 8; ++i) laf[i] += laf[i - 1];
#pragma unroll
    for (int i = 6; i >= 0; --i) lab[i] += lab[i + 1];
    TOT[(0 * 8 + cg_) * 64 + d] = laf[7]; TOT[(1 * 8 + cg_) * 64 + d] = lab[0];
    __syncthreads();
    float offf = 0.f, offb = 0.f, Tf = 0.f, Tb = 0.f;
#pragma unroll
    for (int g = 0; g < 8; ++g) { const float a = TOT[g * 64 + d], b = TOT[(8 + g) * 64 + d]; Tf += a; Tb += b; if (g < cg_) offf += a; if (g > cg_) offb += b; }
    bf16_t* QD = (bf16_t*)(p.ws + OFF_QD);
#pragma unroll
    for (int i = 0; i < 8; ++i) { const int c = cg_ * 8 + i;
        const float q = bf2f(qraw[i]) * 0.125f, k = bf2f(kraw[i]);
        const float bf_ = offf + laf[i], bb_ = offb + lab[i];
        const bf16_t qf = f2bf(q * __expf(bf_)), qb = f2bf(q * __expf(bb_));
        QDf[c * 72 + d] = qf; QDb[c * 72 + d] = qb;
        KDf[c * 72 + d] = f2bf(k * __expf(-bf_)); KDb[c * 72 + d] = f2bf(k * __expf(-bb_));
        KRf[d * 72 + c] = f2bf(k * __expf(Tf - bf_)); KRb[d * 72 + c] = f2bf(k * __expf(Tb - bb_));
        QD[(size_t)(tok0 + c) * 256 + h * 64 + d] = qf; QD[(size_t)(8192 + tok0 + c) * 256 + h * 64 + d] = qb; }
    if (cg_ == 0) { float* DEC = (float*)(p.ws + OFF_DEC); DEC[((0 * 128 + ck) * 4 + h) * 64 + d] = __expf(Tf); DEC[((1 * 128 + ck) * 4 + h) * 64 + d] = __expf(Tb); }
    __syncthreads();
#pragma unroll
    for (int q2 = 0; q2 < 2; ++q2) { const int tt = wid * 2 + q2, ti = tt >> 2, tj = tt & 3; f32x4 af = {0.f, 0.f, 0.f, 0.f}, ab = af;
#pragma unroll
        for (int ks = 0; ks < 2; ++ks) { const int ko = ks * 32 + lq * 8;
            af = MFMA16(LDSFRAG(QDf + (ti * 16 + lr) * 72 + ko), LDSFRAG(KDf + (tj * 16 + lr) * 72 + ko), af);
            ab = MFMA16(LDSFRAG(QDb + (ti * 16 + lr) * 72 + ko), LDSFRAG(KDb + (tj * 16 + lr) * 72 + ko), ab); }
#pragma unroll
        for (int r = 0; r < 4; ++r) { const int c = ti * 16 + lq * 4 + r, s = tj * 16 + lr; const float v = (s <= c ? af[r] : 0.f) + (s >= c ? ab[r] : 0.f); ATT[c * 72 + s] = f2bf(v); } }
    __syncthreads();
    bf16x8 vb[2];
#pragma unroll
    for (int ks = 0; ks < 2; ++ks) vb[ks] = LDSFRAG(VT + (wid * 16 + lr) * 72 + ks * 32 + lq * 8);
    bf16_t* OI = (bf16_t*)(p.ws + OFF_OIB); bf16_t* KV = (bf16_t*)(p.ws + OFF_KV);
#pragma unroll
    for (int ct = 0; ct < 4; ++ct) { f32x4 a = {0.f, 0.f, 0.f, 0.f};
#pragma unroll
        for (int ks = 0; ks < 2; ++ks) a = MFMA16(LDSFRAG(ATT + (ct * 16 + lr) * 72 + ks * 32 + lq * 8), vb[ks], a);
#pragma unroll
        for (int r = 0; r < 4; ++r) OI[(size_t)(tok0 + ct * 16 + lq * 4 + r) * 512 + h * 128 + wid * 16 + lr] = f2bf(a[r]); }
#pragma unroll
    for (int dir = 0; dir < 2; ++dir) { const LAS bf16_t* KR = dir == 0 ? KRf : KRb; bf16_t* kvp = KV + ((size_t)((dir * 128 + ck) * 4 + h)) * 8192;
#pragma unroll
        for (int dt = 0; dt < 4; ++dt) { f32x4 a = {0.f, 0.f, 0.f, 0.f};
#pragma unroll
            for (int ks = 0; ks < 2; ++ks) a = MFMA16(LDSFRAG(KR + (dt * 16 + lr) * 72 + ks * 32 + lq * 8), vb[ks], a);
#pragma unroll
            for (int r = 0; r < 4; ++r) kvp[(dt * 16 + lq * 4 + r) * 128 + wid * 16 + lr] = f2bf(a[r]); } }
    __syncthreads();
}

__device__ __forceinline__ void job_glaB(const Params& p, int l, int j) {
    const int qt = j & 3, h = (j >> 2) & 3, rest = j >> 4, bb = rest % 20, dir = rest / 20;
    const int idx0 = qt * 2048 + tid_opaque(p);
    const int nck = bb < 16 ? 4 : 16, ck0 = bb < 16 ? bb * 4 : 64 + (bb - 16) * 16;
    float S[4];
#pragma unroll
    for (int e = 0; e < 4; ++e) S[e] = bb >= 16 ? p.in[I_SGLA][((size_t)((((bb - 16) * 2 + l) * 2 + dir) * 4 + h)) * 8192 + idx0 + e * 512] : 0.f;
    const bf16_t* KV = (const bf16_t*)(p.ws + OFF_KV); const float* DEC = (const float*)(p.ws + OFF_DEC); bf16_t* ST = (bf16_t*)(p.ws + OFF_ST);
    for (int i0 = 0; i0 < nck; i0 += 4) { float dv[4][4]; bf16_t kv[4][4]; size_t its[4];
#pragma unroll
        for (int u = 0; u < 4; ++u) { const int i = i0 + u, ck = dir == 0 ? ck0 + i : ck0 + nck - 1 - i; its[u] = (size_t)((dir * 128 + ck) * 4 + h);
#pragma unroll
            for (int e = 0; e < 4; ++e) { const int idx = idx0 + e * 512; dv[u][e] = DEC[its[u] * 64 + (idx >> 7)]; kv[u][e] = KV[its[u] * 8192 + idx]; } }
#pragma unroll
        for (int u = 0; u < 4; ++u)
#pragma unroll
            for (int e = 0; e < 4; ++e) { ST[its[u] * 8192 + idx0 + e * 512] = f2bf(S[e]); S[e] = dv[u][e] * S[e] + bf2f(kv[u][e]); } }
    if (bb < 16) {
#pragma unroll
        for (int e = 0; e < 4; ++e) p.out[OUT_GLA + ((size_t)(((bb * 2 + l) * 2 + dir) * 4 + h)) * 8192 + idx0 + e * 512] = S[e]; }
}

__device__ __forceinline__ void job_glaC(const Params& p, int l, int j, lds_t lds) {
    const int tid = tid_opaque(p), wid = tid >> 6, lane = tid & 63, lr = lane & 15, lq = lane >> 4;
    const int ck = j >> 2, h = j & 3, tok0 = ck * 64;
    LAS bf16_t* Aq = (LAS bf16_t*)lds;
    LAS bf16_t* BT = Aq + 64 * 136;
    LAS float* Os = (LAS float*)(BT + 128 * 136);
    const bf16_t* QD = (const bf16_t*)(p.ws + OFF_QD); const bf16_t* ST = (const bf16_t*)(p.ws + OFF_ST);
#pragma unroll
    for (int it = 0; it < 2; ++it) { const int idx = tid + it * 512, c = idx >> 4, rem = idx & 15, dir = rem >> 3, dc = rem & 7;
        *(LAS u32x4*)(Aq + c * 136 + dir * 64 + dc * 8) = *(const u32x4*)(QD + (size_t)(dir * 8192 + tok0 + c) * 256 + h * 64 + dc * 8); }
#pragma unroll
    for (int it = 0; it < 4; ++it) { const int idx = tid + it * 512, dir = idx >> 10, d = (idx >> 4) & 63, ec = idx & 15;
        const u32x4 v = *(const u32x4*)(ST + ((size_t)((dir * 128 + ck) * 4 + h)) * 8192 + d * 128 + ec * 8);
        const unsigned w[4] = { v.x, v.y, v.z, v.w };
#pragma unroll
        for (int i = 0; i < 4; ++i) { BT[(ec * 8 + 2 * i) * 136 + dir * 64 + d] = (bf16_t)(w[i] & 0xffffu); BT[(ec * 8 + 2 * i + 1) * 136 + dir * 64 + d] = (bf16_t)(w[i] >> 16); } }
    const int ct = wid & 3, eh = wid >> 2; const bf16_t* OI = (const bf16_t*)(p.ws + OFF_OIB);
    bf16_t oi[4][4];
#pragma unroll
    for (int e4 = 0; e4 < 4; ++e4)
#pragma unroll
        for (int r = 0; r < 4; ++r) oi[e4][r] = OI[(size_t)(tok0 + ct * 16 + lq * 4 + r) * 512 + h * 128 + (eh * 4 + e4) * 16 + lr];
    const int nc = tid >> 3, npart = tid & 7;
    const bf16_t* gz = (const bf16_t*)(p.ws + OFF_Z) + (size_t)(tok0 + nc) * LDZ + ZGG + h * 128 + npart * 16;
    const u32x4 g0 = *(const u32x4*)gz, g1 = *(const u32x4*)(gz + 8);
    f32x4 onw[4];
#pragma unroll
    for (int i = 0; i < 4; ++i) onw[i] = *(const f32x4*)(p.in[I_ONORM] + l * 128 + npart * 16 + 4 * i);
    __syncthreads();
    bf16x8 af[4];
#pragma unroll
    for (int ks = 0; ks < 4; ++ks) af[ks] = LDSFRAG(Aq + (ct * 16 + lr) * 136 + ks * 32 + lq * 8);
#pragma unroll
    for (int e4 = 0; e4 < 4; ++e4) { const int et = eh * 4 + e4; f32x4 a = {0.f, 0.f, 0.f, 0.f};
#pragma unroll
        for (int ks = 0; ks < 4; ++ks) a = MFMA16(af[ks], LDSFRAG(BT + (et * 16 + lr) * 136 + ks * 32 + lq * 8), a);
#pragma unroll
        for (int r = 0; r < 4; ++r) { const int row = ct * 16 + lq * 4 + r, col = et * 16 + lr; Os[row * 132 + col] = a[r] + bf2f(oi[e4][r]); } }
    __syncthreads();
    { const int c = tid >> 3, part = tid & 7; float o[16]; float ss = 0.f;
#pragma unroll
      for (int i = 0; i < 16; ++i) { o[i] = Os[c * 132 + part * 16 + i]; ss += o[i] * o[i]; }
      ss += __shfl_xor(ss, 1); ss += __shfl_xor(ss, 2); ss += __shfl_xor(ss, 4);
      const float rstd = rsqrtf(ss * (1.f / 128.f) + 1e-6f);
      const unsigned gw[8] = { g0.x, g0.y, g0.z, g0.w, g1.x, g1.y, g1.z, g1.w };
      unsigned ow[8];
#pragma unroll
      for (int i = 0; i < 8; ++i) { const float n0 = onw[i >> 1][(2 * i) & 3], n1 = onw[i >> 1][(2 * i + 1) & 3];
          ow[i] = pk2(o[2 * i] * rstd * n0 * siluf_(lo16(gw[i])), o[2 * i + 1] * rstd * n1 * siluf_(hi16(gw[i]))); }
      bf16_t* ap = (bf16_t*)(p.ws + OFF_AGLA) + (size_t)(tok0 + c) * 512 + h * 128 + part * 16;
      *(u32x4*)ap = (u32x4){ow[0], ow[1], ow[2], ow[3]}; *(u32x4*)(ap + 8) = (u32x4){ow[4], ow[5], ow[6], ow[7]}; }
    __syncthreads();
}
__device__ __forceinline__ void head_row_finish(float (&x)[16], int p8, const float* nw, const float* nw2, bool rope, int pos, const float* R, float mul, LAS bf16_t* dst) {
    float ss = 0.f; const int cnt = p8 < 4 ? 16 : 8;
#pragma unroll
    for (int i = 0; i < 16; ++i) if (i < cnt) ss += x[i] * x[i];
    ss += __shfl_xor(ss, 1); ss += __shfl_xor(ss, 2); ss += __shfl_xor(ss, 4);
    const float rstd = rsqrtf(ss * (1.f / 96.f) + 1e-6f) * mul;
    if (p8 < 4) { unsigned w[8];
#pragma unroll
        for (int i = 0; i < 8; ++i) w[i] = pk2(x[2 * i] * rstd * nw[p8 * 16 + 2 * i] * nw2[p8 * 16 + 2 * i], x[2 * i + 1] * rstd * nw[p8 * 16 + 2 * i + 1] * nw2[p8 * 16 + 2 * i + 1]);
        *(LAS u32x4*)(dst + p8 * 16) = (u32x4){w[0], w[1], w[2], w[3]}; *(LAS u32x4*)(dst + p8 * 16 + 8) = (u32x4){w[4], w[5], w[6], w[7]};
    } else { const int i0 = (p8 - 4) * 4; float o1[4], o2[4];
#pragma unroll
        for (int i = 0; i < 4; ++i) { const float a = x[i] * rstd * nw[64 + i0 + i], b = x[4 + i] * rstd * nw[80 + i0 + i];
            if (rope) { const float c = R[pos * 16 + i0 + i], s = R[16384 + pos * 16 + i0 + i]; o1[i] = a * c - b * s; o2[i] = a * s + b * c; } else { o1[i] = a; o2[i] = b; } }
        *(LAS u32x2*)(dst + 64 + i0) = (u32x2){pk2(o1[0], o1[1]), pk2(o1[2], o1[3])}; *(LAS u32x2*)(dst + 80 + i0) = (u32x2){pk2(o2[0], o2[1]), pk2(o2[2], o2[3])}; }
}
__device__ __forceinline__ void ld16bf(const bf16_t* s, float (&x)[16]) { const u32x4 a = *(const u32x4*)s, b = *(const u32x4*)(s + 8);
    x[0] = lo16(a.x); x[1] = hi16(a.x); x[2] = lo16(a.y); x[3] = hi16(a.y); x[4] = lo16(a.z); x[5] = hi16(a.z); x[6] = lo16(a.w); x[7] = hi16(a.w);
    x[8] = lo16(b.x); x[9] = hi16(b.x); x[10] = lo16(b.y); x[11] = hi16(b.y); x[12] = lo16(b.z); x[13] = hi16(b.z); x[14] = lo16(b.w); x[15] = hi16(b.w); }
__device__ __forceinline__ void ld4bf(const bf16_t* s, float* x) { const u32x2 a = *(const u32x2*)s; x[0] = lo16(a.x); x[1] = hi16(a.x); x[2] = lo16(a.y); x[3] = hi16(a.y); }
__device__ __forceinline__ void job_attn(const Params& p, int l, int j, lds_t lds) {
    const int tid = tid_opaque(p), wid = tid >> 6, lane = tid & 63, lr = lane & 15, lq = lane >> 4;
    const bool smp = j < 128; int b, h, qb; if (smp) { b = j >> 5; h = (j >> 3) & 3; qb = j & 7; } else { const int jj = j - 128; b = jj >> 3; h = (jj >> 1) & 3; qb = jj & 1; }
    const int qtok0 = smp ? 4096 + b * 1024 + qb * 128 : b * 256 + qb * 128; const int nkt = smp ? 12 : 2;
    LAS bf16_t* Ks0 = (LAS bf16_t*)lds;
    LAS bf16_t* VTs0 = Ks0 + 2 * 128 * 104;
    LAS float* Mg = (LAS float*)lds;
    const bf16_t* Z = (const bf16_t*)(p.ws + OFF_Z); const bf16_t* KF = (const bf16_t*)(p.ws + OFF_KF); const bf16_t* Vb = (const bf16_t*)(p.ws + OFF_V); const float* R = (const float*)(p.ws + OFF_ROPE);
    const float* qhn = p.in[I_QHNORM] + l * 96;
    u32x4 kreg[3], vreg[4];
    const int vst = smp ? 1536 : 256; const bf16_t* vtb = smp ? Vb + 2097152 + (size_t)(b * 4 + h) * 128 * 1536 : Vb + (size_t)(b * 4 + h) * 128 * 256;
    auto rowbase = [&](int kt) { return smp ? (kt < 4 ? 8192 + b * 512 + kt * 128 : 4096 + b * 1024 + (kt - 4) * 128) : b * 256 + kt * 128; };
    auto issue = [&](int kt) { const int rb = rowbase(kt);
#pragma unroll
        for (int i = 0; i < 3; ++i) { const int idx = tid + 512 * i, key = idx / 12, part = idx - key * 12; kreg[i] = *(const u32x4*)(KF + (size_t)(rb + key) * 384 + h * 96 + part * 8); }
#pragma unroll
        for (int i = 0; i < 4; ++i) { const int idx = tid + 512 * i, e = idx >> 4, part = idx & 15; vreg[i] = *(const u32x4*)(vtb + (size_t)e * vst + kt * 128 + part * 8); } };
    auto commit = [&](int buf) { LAS bf16_t* Ks = Ks0 + buf * 128 * 104; LAS bf16_t* VTs = VTs0 + buf * 128 * 136;
#pragma unroll
        for (int i = 0; i < 3; ++i) { const int idx = tid + 512 * i, key = idx / 12, part = idx - key * 12; *(LAS u32x4*)(Ks + key * 104 + part * 8) = kreg[i]; }
#pragma unroll
        for (int i = 0; i < 4; ++i) { const int idx = tid + 512 * i, e = idx >> 4, part = idx & 15; *(LAS u32x4*)(VTs + e * 136 + part * 8) = vreg[i]; } };
    issue(0);
#pragma unroll
    for (int it = 0; it < 2; ++it) { const int row = it * 64 + (tid >> 3), p8 = tid & 7, tok = qtok0 + row; const bf16_t* qr = (const bf16_t*)(p.ws + OFF_QRAW) + (size_t)tok * 384 + h * 96; float x[16];
      if (p8 < 4) ld16bf(qr + p8 * 16, x); else { ld4bf(qr + 64 + (p8 - 4) * 4, x); ld4bf(qr + 80 + (p8 - 4) * 4, x + 4); }
      head_row_finish(x, p8, qhn, p.in[I_KHNORM] + l * 96, smp, qb * 128 + row, R, 0.10206207261596575f * 1.4426950408889634f, Ks0 + 128 * 104 + row * 104); }
    __syncthreads();
    const int rt = wid & 3, kh = wid >> 2;
    bf16x8 qa[2][3];
#pragma unroll
    for (int mt = 0; mt < 2; ++mt)
#pragma unroll
        for (int ks = 0; ks < 3; ++ks) qa[mt][ks] = LDSFRAG(Ks0 + 128 * 104 + (rt * 32 + mt * 16 + lr) * 104 + ks * 32 + lq * 8);
    commit(0);
    __syncthreads();
    f32x4 oacc[2][8]; float mrow[2], lrow[2];
#pragma unroll
    for (int mt = 0; mt < 2; ++mt) {
#pragma unroll
        for (int e = 0; e < 8; ++e) oacc[mt][e] = (f32x4){0.f, 0.f, 0.f, 0.f};
        mrow[mt] = -1e30f; lrow[mt] = 0.f; }
    const int kbase = kh * 64;
    for (int kt = 0; kt < nkt; ++kt) {
        if (kt + 1 < nkt) issue(kt + 1);
        const LAS bf16_t* Ks = Ks0 + (kt & 1) * 128 * 104; const LAS bf16_t* VTs = VTs0 + (kt & 1) * 128 * 136;
        f32x4 sacc[2][4];
#pragma unroll
        for (int nt = 0; nt < 4; ++nt) { sacc[0][nt] = (f32x4){0.f, 0.f, 0.f, 0.f}; sacc[1][nt] = sacc[0][nt];
#pragma unroll
            for (int ks = 0; ks < 3; ++ks) { const bf16x8 kf = LDSFRAG(Ks + (kbase + nt * 16 + lr) * 104 + ks * 32 + lq * 8); sacc[0][nt] = MFMA16(kf, qa[0][ks], sacc[0][nt]); sacc[1][nt] = MFMA16(kf, qa[1][ks], sacc[1][nt]); } }
        bf16x8 pb[2][2];
#pragma unroll
        for (int mt = 0; mt < 2; ++mt) {
            float mx = -1e30f;
#pragma unroll
            for (int nt = 0; nt < 4; ++nt) mx = fmaxf(mx, fmaxf(fmaxf(sacc[mt][nt][0], sacc[mt][nt][1]), fmaxf(sacc[mt][nt][2], sacc[mt][nt][3])));
            mx = fmaxf(mx, __shfl_xor(mx, 16)); mx = fmaxf(mx, __shfl_xor(mx, 32));
            const float mn = fmaxf(mrow[mt], mx), alpha = __builtin_amdgcn_exp2f(mrow[mt] - mn); mrow[mt] = mn;
            float pv[4][4]; float rs = 0.f;
#pragma unroll
            for (int nt = 0; nt < 4; ++nt)
#pragma unroll
                for (int r = 0; r < 4; ++r) { pv[nt][r] = __builtin_amdgcn_exp2f(sacc[mt][nt][r] - mn); rs += pv[nt][r]; }
            lrow[mt] = lrow[mt] * alpha + rs;
#pragma unroll
            for (int k2 = 0; k2 < 2; ++k2) { u32x4 w; w.x = pk2(pv[2 * k2][0], pv[2 * k2][1]); w.y = pk2(pv[2 * k2][2], pv[2 * k2][3]); w.z = pk2(pv[2 * k2 + 1][0], pv[2 * k2 + 1][1]); w.w = pk2(pv[2 * k2 + 1][2], pv[2 * k2 + 1][3]);
                pb[mt][k2] = __builtin_bit_cast(bf16x8, w); }
#pragma unroll
            for (int e = 0; e < 8; ++e) oacc[mt][e] *= alpha; }
#pragma unroll
        for (int k2 = 0; k2 < 2; ++k2)
#pragma unroll
            for (int e = 0; e < 8; ++e) { const LAS bf16_t* vp = VTs + (e * 16 + lr) * 136 + kbase + k2 * 32 + 4 * lq;
                const u32x2 lo = *(const LAS u32x2*)vp, hi = *(const LAS u32x2*)(vp + 16);
                const bf16x8 vf = __builtin_bit_cast(bf16x8, (u32x4){lo.x, lo.y, hi.x, hi.y});
                oacc[0][e] = MFMA16(vf, pb[0][k2], oacc[0][e]); oacc[1][e] = MFMA16(vf, pb[1][k2], oacc[1][e]); }
        if (kt + 1 < nkt) commit((kt + 1) & 1);
        __syncthreads();
    }
#pragma unroll
    for (int mt = 0; mt < 2; ++mt) { float s_ = lrow[mt]; s_ += __shfl_xor(s_, 16); s_ += __shfl_xor(s_, 32); lrow[mt] = s_; }
    LAS float* Mo = Mg + rt * 32 * 132; LAS float* Ml = Mg + 4 * 32 * 132 + rt * 64;
    if (kh == 1) {
#pragma unroll
        for (int mt = 0; mt < 2; ++mt) {
#pragma unroll
            for (int e = 0; e < 8; ++e) *(LAS f32x4*)(Mo + (mt * 16 + lr) * 132 + e * 16 + 4 * lq) = oacc[mt][e];
            if (lq == 0) { Ml[(mt * 16 + lr) * 2] = mrow[mt]; Ml[(mt * 16 + lr) * 2 + 1] = lrow[mt]; } }
    }
    __syncthreads();
    if (kh == 0) { bf16_t* AM = (bf16_t*)(p.ws + OFF_AMLA);
#pragma unroll
        for (int mt = 0; mt < 2; ++mt) { const int row = mt * 16 + lr, tok = qtok0 + rt * 32 + row;
            u32x2 gt[8];
#pragma unroll
            for (int e = 0; e < 8; ++e) gt[e] = *(const u32x2*)(Z + (size_t)tok * LDZ + ZMG + h * 128 + e * 16 + 4 * lq);
            const float m2 = Ml[row * 2], l2 = Ml[row * 2 + 1]; const float mm = fmaxf(mrow[mt], m2), a1 = __builtin_amdgcn_exp2f(mrow[mt] - mm), a2 = __builtin_amdgcn_exp2f(m2 - mm);
            const float inv = 1.f / (lrow[mt] * a1 + l2 * a2);
#pragma unroll
            for (int e = 0; e < 8; ++e) { const f32x4 o2 = *(const LAS f32x4*)(Mo + row * 132 + e * 16 + 4 * lq); float o[4];
#pragma unroll
                for (int r = 0; r < 4; ++r) o[r] = (oacc[mt][e][r] * a1 + o2[r] * a2) * inv;
                const float g0 = lo16(gt[e].x), g1 = hi16(gt[e].x), g2 = lo16(gt[e].y), g3 = hi16(gt[e].y);
                *(u32x2*)(AM + (size_t)tok * 512 + h * 128 + e * 16 + 4 * lq) = (u32x2){pk2(o[0] * siluf_(g0), o[1] * siluf_(g1)), pk2(o[2] * siluf_(g2), o[3] * siluf_(g3))}; } } }
    __syncthreads();
}


#define XB_TMO      128
#define XB_XCNT(j)  (256  + 64 * (j))
#define XB_XSUB(j)  (1280 + 64 * (j))
#define XB_XGEN(j)  (2304 + 64 * (j))
#define XB_TOP      3328
#define XB_TOPGEN   3392
#define XCD_BAR_WORDS 3456
#define XB_SPIN_CAP (1u << 18)

__device__ __forceinline__ unsigned xb_ld(unsigned* p)              { return __hip_atomic_load(p, __ATOMIC_RELAXED, __HIP_MEMORY_SCOPE_AGENT); }
__device__ __forceinline__ unsigned xb_add(unsigned* p, unsigned v) { return __hip_atomic_fetch_add(p, v, __ATOMIC_RELAXED, __HIP_MEMORY_SCOPE_AGENT); }
__device__ __forceinline__ unsigned xb_xcc_id() { return (unsigned)__builtin_amdgcn_s_getreg((3 << 11) | 20) & 0xFu; }
#define XB_SPIN(cond, bar) do { unsigned _sp = 0; while (cond) { __builtin_amdgcn_s_sleep(1); \
    if ((++_sp & 255u) == 0u) { if (xb_ld(&(bar)[XB_TMO])) break; if (_sp > XB_SPIN_CAP) { atomicAdd(&(bar)[XB_TMO], 1u); break; } } } } while (0)

struct XcdBarrier {
    int wid; unsigned* bar; unsigned x;
    volatile LAS unsigned* st;
};

__device__ __forceinline__ XcdBarrier xcd_barrier_post(unsigned* bar, volatile LAS unsigned* st) {
    XcdBarrier b; b.bar = bar; b.x = xb_xcc_id(); b.st = st;
    if (threadIdx.x == 0) (void)xb_add(&bar[XB_XCNT(b.x)], 1u);
    return b;
}
__device__ __forceinline__ void xcd_barrier_complete(unsigned* bar, unsigned x, unsigned& nloc, unsigned& nx) {
    const unsigned G = gridDim.x * gridDim.y * gridDim.z;
    unsigned sum, cnt, mine, sp = 0u;
    for (;;) {
        sum = 0u; cnt = 0u; mine = 0u;
#pragma unroll
        for (unsigned j = 0; j < 16; ++j) { const unsigned c = xb_ld(&bar[XB_XCNT(j)]); sum += c; cnt += (c > 0u) ? 1u : 0u; mine = (j == x) ? c : mine; }
        if (sum == G) break;
        __builtin_amdgcn_s_sleep(1);
        if ((++sp & 255u) == 0u) { if (xb_ld(&bar[XB_TMO])) break; if (sp > XB_SPIN_CAP) { atomicAdd(&bar[XB_TMO], 1u); break; } }
    }
    nloc = mine > 0u ? mine : 1u; nx = cnt > 0u ? cnt : 1u;
}

__device__ __forceinline__ void xcd_barrier(const XcdBarrier& b) {
    asm volatile("s_waitcnt vmcnt(0)" ::: "memory");
    __syncthreads();
    if (b.wid == 0 && lane_id_() == 0) {
        unsigned* bar = b.bar;
        __builtin_amdgcn_s_waitcnt(0);
        unsigned nloc = b.st[0], nx = b.st[1];
        if (nloc == 0u) { xcd_barrier_complete(bar, b.x, nloc, nx); b.st[0] = nloc; b.st[1] = nx; }
        const unsigned old = xb_add(&bar[XB_XSUB(b.x)], 1u);
        const unsigned gen = old / nloc;
        if (old + 1u == (gen + 1u) * nloc) {
            __builtin_amdgcn_fence(__ATOMIC_RELEASE, "agent");
            asm volatile("s_waitcnt vmcnt(0)" ::: "memory");
            const unsigned og = xb_add(&bar[XB_TOP], 1u);
            const unsigned tg = og / nx;
            if (og + 1u == (tg + 1u) * nx) xb_add(&bar[XB_TOPGEN], 1u);
            else XB_SPIN(xb_ld(&bar[XB_TOPGEN]) == tg, bar);
            __builtin_amdgcn_fence(__ATOMIC_ACQUIRE, "agent");
            xb_add(&bar[XB_XGEN(b.x)], 1u);
            asm volatile("s_waitcnt vmcnt(0)" ::: "memory");
        } else {
            XB_SPIN(xb_ld(&bar[XB_XGEN(b.x)]) == gen, bar);
            __builtin_amdgcn_fence(__ATOMIC_ACQUIRE, "agent");
            asm volatile("s_waitcnt vmcnt(0)" ::: "memory");
        }
    }
    __syncthreads();
}

constexpr int N_PHASES = 15;
#ifndef S3SEL
#define S3SEL 15
#endif
#ifndef REPEAT_MASK
#define REPEAT_MASK 0xff
#endif
#ifndef ONLY_S
#define ONLY_S -1
#endif
__device__ __forceinline__ void run_phase(const Params& p, int ph, lds_t lds, int mask = 0xff) {
    const int G = (int)gridDim.x, bid = (int)blockIdx.x;
    if (ph == 0 && (ONLY_S < 0 || ONLY_S == 7)) {
        for (int j = bid; j < 384 + 192 + 256 + 32; j += G) { if (j < 384) job_s5setup(p, 0, j, lds); else if (j < 576) job_ada(p, j - 384, lds); else if (j < 832) job_ctx(p, j - 576); else job_rope(p, j - 832); }
        return;
    }
    const int l = (ph - 1) / 7, s = (ph - 1) % 7;
    unsigned char* ws = p.ws;
    if (s == 0 && (ONLY_S < 0 || ONLY_S == 0)) {
        if (l == 0 || G < 256) { for (int j = bid; j < 384 + WT_TOTAL + 256; j += G) { if (j < 384) { if ((mask & 1) && l > 0) job_s5setup(p, l, j, lds); } else if (j < 384 + WT_TOTAL) { if (mask & 2) job_wt(p, l, j - 384, lds); } else if (mask & 4) job_prep(p, l, j - 384 - WT_TOTAL); } }
        else { for (int j = bid; j < 256; j += G) job_prep(p, l, j); }
    } else if (s == 1 && (ONLY_S < 0 || ONLY_S == 1)) {
        Order S; S.setup(8192, 4096, 0, p.wid); pg8::Gemm g{(const bf16_t*)(ws + OFF_HB), (const bf16_t*)(ws + OFF_WIN), 8192, 4096, 1024}; EpiZ E{(bf16_t*)(ws + OFF_Z)};
        pg8::gemm_phase<EpiZ, Order>(lds, g, S, E, nullptr);
    } else if (s == 2 && (ONLY_S < 0 || ONLY_S == 2)) {
        if (G == 256) {
            if (mask & 1) { const int slot = bid >> 3; job_s5(p, l, (slot >> 2) * 32 + 4 * (bid & 7) + (slot & 3), lds); }
            if (mask & 2) { job_glaA(p, l, bid, lds); job_glaA(p, l, 256 + bid, lds); }
            if (mask & 4) for (int j = bid; j < 256; j += G) job_mlaprep(p, l, j);
        } else for (int j = bid; j < 256 + 512 + 256; j += G) { if (j < 256) { if (mask & 1) job_s5(p, l, j, lds); } else if (j < 768) { if (mask & 2) job_glaA(p, l, j - 256, lds); } else if (mask & 4) job_mlaprep(p, l, j - 768); }
    } else if (s == 3 && (ONLY_S < 0 || ONLY_S == 3)) {
        if (mask & 1) { if (G == 256) { if (bid < 96) for (int j = bid; j < 640; j += 96) job_glaB(p, l, j); } else for (int j = bid; j < 640; j += G) job_glaB(p, l, j); }
        if (mask & 16) { Order S; S.setup(8192, 2816, 0, p.wid); pg8::Gemm g{(const bf16_t*)(ws + OFF_HB), (const bf16_t*)(ws + OFF_WIN) + (size_t)4096 * 1024, 8192, 2816, 1024}; EpiZ E{(bf16_t*)(ws + OFF_Z) + 4096};
          pg8::gemm_phase<EpiZ, Order>(lds, g, S, E, nullptr); }
        if ((mask & 2) && (S3SEL & 2)) { Order S; S.setup(8192, 1024, 160, p.wid); pg8::Gemm g{(const bf16_t*)(ws + OFF_YG), (const bf16_t*)(ws + OFF_WGLU), 8192, 1024, 512}; EpiGLU E{(bf16_t*)(ws + OFF_AS5), (const bf16_t*)(ws + OFF_Z), p.in[I_BGLU] + l * 1024};
          pg8::gemm_phase<EpiGLU, Order>(lds, g, S, E, nullptr); }
        if ((mask & 4) && (S3SEL & 4)) { Order S; S.setup(10240, 768, 120, p.wid); pg8::Gemm g{(const bf16_t*)(ws + (l == 0 ? OFF_CTX0 : OFF_CKVN)), (const bf16_t*)(ws + OFF_WKV), 10240, 768, 256}; EpiKV E{(bf16_t*)(ws + OFF_KF), (bf16_t*)(ws + OFF_V), l, (const bf16_t*)(ws + OFF_Z), p.in[I_CKR], p.in[I_KHNORM] + l * 96, (const float*)(ws + OFF_ROPE)};
          pg8::gemm_phase<EpiKV, Order>(lds, g, S, E, nullptr); }
        if ((mask & 8) && (S3SEL & 8)) { Order S; S.setup(8192, 512, 160, p.wid); if (G == 256) S.c = (bid >= 96 && bid < 136) ? bid - 96 : (bid >= 224 && bid < 248) ? bid - 184 : (1 << 20); pg8::Gemm g{(const bf16_t*)(ws + OFF_AQ), (const bf16_t*)(ws + OFF_WUQ), 8192, 512, 384}; EpiQ E{(bf16_t*)(ws + OFF_QRAW)};
          pg8::gemm_phase<EpiQ, Order>(lds, g, S, E, nullptr); }
    } else if (s == 4 && (ONLY_S < 0 || ONLY_S == 4)) {
        if (G == 256) {
            if (bid < 128) { const int slot = bid >> 3, pair = 2 * (bid & 7) + (slot >> 3);
                if (mask & 1) job_attn(p, l, pair * 8 + (slot & 7), lds); if (mask & 2) job_glaC(p, l, 384 + bid, lds); }
            else { const int k = bid - 128; if (mask & 1) job_attn(p, l, 128 + k, lds); if (mask & 2) { job_glaC(p, l, k, lds); job_glaC(p, l, 128 + k, lds); job_glaC(p, l, 256 + k, lds); } }
        } else for (int j = bid; j < 256 + 512; j += G) { if (j < 256) { if (mask & 1) job_attn(p, l, j, lds); } else if (mask & 2) job_glaC(p, l, j - 256, lds); }
        { __syncthreads(); Order S; S.setup(8192, 1024, 128, p.wid);
          pg8::Gemm g{(const bf16_t*)(ws + OFF_AS5), (const bf16_t*)(ws + OFF_WBO) + (size_t)2 * 1024 * 512, 8192, 1024, 512};
          EpiBo E{(bf16_t*)(ws + OFF_HB), (const bf16_t*)(ws + OFF_Z), 2, 1, nullptr, nullptr};
          pg8::gemm_phase<EpiBo, Order>(lds, g, S, E, nullptr); }
    } else if (s == 5 && (ONLY_S < 0 || ONLY_S == 5)) {
        if (l == 0 && mask == 0xff && G >= 256 && bid >= 128) { for (int j = bid - 128; j < 384 + WT_EARLY; j += G - 128) { if (j < 384) job_s5setup(p, 1, j, lds); else job_wt(p, 1, j - 384, lds); } }
        if (l == 1 && G == 256) {
            unsigned* fl = (unsigned*)(ws + OFF_BAR) + 3520;
            for (int br = 0; br < 2; ++br) { Order S; S.setup(8192, 1024, br == 0 ? 0 : 128, p.wid);
                pg8::Gemm g{(const bf16_t*)(ws + (br == 0 ? OFF_AGLA : OFF_AMLA)), (const bf16_t*)(ws + OFF_WBO) + (size_t)br * 1024 * 512, 8192, 1024, 512};
                EpiBo E{(bf16_t*)(ws + OFF_HB), (const bf16_t*)(ws + OFF_Z), br, 0, br == 0 ? fl : nullptr, br == 0 ? nullptr : fl};
                pg8::gemm_phase<EpiBo, Order>(lds, g, S, E, nullptr); }
        } else
        for (int br = 0; br < 2; ++br) { Order S; S.setup(8192, 1024, 0, p.wid);
            pg8::Gemm g{(const bf16_t*)(ws + (br == 0 ? OFF_AGLA : br == 1 ? OFF_AMLA : OFF_AS5)), (const bf16_t*)(ws + OFF_WBO) + (size_t)br * 1024 * 512, 8192, 1024, 512};
            EpiBo E{(bf16_t*)(ws + OFF_HB), (const bf16_t*)(ws + OFF_Z), br, 0, nullptr, nullptr};
            pg8::gemm_phase<EpiBo, Order>(lds, g, S, E, nullptr); }
    } else if (s == 6 && (ONLY_S < 0 || ONLY_S == 6)) {
        if (l == 0 && mask == 0xff && G >= 256 && bid >= 128) { for (int j = bid - 128; j < 3 * WT_WBO + WT_WOUT; j += G - 128) job_wt(p, 1, WT_EARLY + j, lds); }
        Order S; S.setup(8192, 1024, 0, p.wid); pg8::Gemm g{(const bf16_t*)(ws + OFF_HB), (const bf16_t*)(ws + (l == 0 ? OFF_WOUT : OFF_WOUT2)), 8192, 1024, 1024};
        EpiOut E{p.out, l == 0 ? p.in[I_XP] : p.out, l == 0 ? p.in[I_XS] : p.out + (size_t)4096 * 1024, (const float*)(ws + OFF_ADA) + l * 5 * 3072};
        pg8::gemm_phase<EpiOut, Order>(lds, g, S, E, nullptr);
    }
}
__global__ __launch_bounds__(512, 2) void mega(KParams kp, int ph0, int ph1) {
    extern __shared__ __attribute__((aligned(16))) unsigned char shm[];
    lds_t lds = (lds_t)shm;
    if (threadIdx.x < N_IN) ((const float**)(kp.ws + OFF_TBL))[threadIdx.x] = kp.in[threadIdx.x];
    const int wid0 = __builtin_amdgcn_readfirstlane((int)threadIdx.x >> 6);
    volatile LAS unsigned* xst = (volatile LAS unsigned*)(lds + DYN_LDS - 16);
    if (threadIdx.x == 0) { xst[0] = 0u; xst[1] = 0u; }
    __threadfence(); __syncthreads();
    XcdBarrier xb = xcd_barrier_post((unsigned*)(kp.ws + OFF_BAR), xst);
    xb.wid = wid0;
    if (ph0 > ph1) cg::this_grid().sync();
    for (int ph = ph0; ph < ph1; ++ph) {
        Params p; p.wid = wid0; { const float* const* tb = (const float* const*)(kp.ws + OFF_TBL); float* o = kp.out; unsigned char* w = kp.ws; asm volatile("" : "+s"(tb), "+s"(o), "+s"(w)); p.in = tb; p.out = o; p.ws = w; }
        int nrep = 1;
#ifdef REPEAT_S
        if ((REPEAT_S == 7 && ph == 0) || (ph > 0 && (ph - 1) % 7 == REPEAT_S && (REPEAT_S != 6 || ph < 8))) nrep = 2;
#endif
        for (int rep = 0; rep < nrep; ++rep) { if (rep) xcd_barrier(xb); run_phase(p, ph, lds, rep ? REPEAT_MASK : 0xff); }
        if (ph + 1 < ph1) xcd_barrier(xb);
    }
}

#ifndef N_LAUNCH_MODE
#define N_LAUNCH_MODE 1
#endif
extern "C" void kernel_launch(void* const* d_in, const int* in_sizes, int n_in, void* d_out, int out_size, void* d_ws, size_t ws_size, hipStream_t stream) {
    static int grid = 0;
    if (grid == 0) {
        if (n_in != N_IN || ws_size < WS_END) { fprintf(stderr, "kernel_launch: unexpected n_in %d / ws %zu (need %zu)\n", n_in, ws_size, (size_t)WS_END); grid = -1; return; }
        int dev = 0, cus = 0, per_cu = 0;
        hipGetDevice(&dev); hipDeviceGetAttribute(&cus, hipDeviceAttributeMultiprocessorCount, dev);
        hipFuncSetAttribute((const void*)mega, hipFuncAttributeMaxDynamicSharedMemorySize, DYN_LDS);
        hipOccupancyMaxActiveBlocksPerMultiprocessor(&per_cu, (const void*)mega, 512, DYN_LDS);
        if (per_cu < 1) { fprintf(stderr, "kernel_launch: occupancy query says %d blocks per CU\n", per_cu); per_cu = 1; }
        (void)hipGetLastError();
        grid = cus;
    }
    if (grid < 0) return;
    hipMemsetAsync((char*)d_ws + OFF_BAR, 0, 16384, stream);
    KParams p{};
    for (int i = 0; i < N_IN; ++i) p.in[i] = (const float*)d_in[i];
    p.out = (float*)d_out; p.ws = (unsigned char*)d_ws;
#if N_LAUNCH_MODE == 0
    for (int ph = 0; ph < N_PHASES; ++ph) { hipLaunchKernelGGL(mega, dim3(grid), dim3(512), DYN_LDS, stream, p, ph, ph + 1); }
#else
    int ph0 = 0, ph1 = N_PHASES; void* args[] = {&p, &ph0, &ph1};
    hipError_t e = hipLaunchCooperativeKernel((const void*)mega, dim3(grid), dim3(512), args, DYN_LDS, stream);
    if (e != hipSuccess) fprintf(stderr, "cooperative launch failed: %s (grid %d)\n", hipGetErrorString(e), grid);
#endif
}
```
